# Optimizing an MI355X kernel written in HIP

```python
import jax, jax.numpy as jnp
from jax import lax
import numpy as np

D_MODEL = 1024
BATCH = 16
SEQ = 2048
DEPTH = 1

CHUNK = 64
HEAD_DIM = 64
N_HEADS_A = D_MODEL // (2 * HEAD_DIM)
N_HEADS_B = D_MODEL // (2 * HEAD_DIM)
D_A = N_HEADS_A * HEAD_DIM
D_B = N_HEADS_B * HEAD_DIM
D_MIX = D_A + D_B
LEFT_CHUNKS = 8
BAND = (LEFT_CHUNKS + 1) * CHUNK
MAX_REL = 128
SB_BLOCK = 128
N_EXPERTS = 256
TOP_K = 8
N_GROUPS = 8
TOPK_GROUPS = 4
EXPERTS_PER_GROUP = N_EXPERTS // N_GROUPS
D_EXPERT = D_MODEL // 4
ROUTED_SCALE = 2.5
ROW_BLOCK = 128
DN_ALPHA = (2 * DEPTH) ** 0.25
DN_BETA = (8 * DEPTH) ** -0.25
LN_EPS = 1e-5
RMS_EPS = 1e-6

kernel_name = 'hybrid_chunked_stickbreaking_moe_deepnorm'


def layer_norm(x, g, b):
    xf = x.astype(jnp.float32)
    mu = jnp.mean(xf, axis=-1, keepdims=True)
    var = jnp.mean(jnp.square(xf - mu), axis=-1, keepdims=True)
    return ((xf - mu) * lax.rsqrt(var + LN_EPS) * g.astype(jnp.float32) + b.astype(jnp.float32)).astype(x.dtype)


def rms_norm(x, g):
    xf = x.astype(jnp.float32)
    ms = jnp.mean(jnp.square(xf), axis=-1, keepdims=True)
    return (xf * lax.rsqrt(ms + RMS_EPS) * g.astype(jnp.float32)).astype(x.dtype)


def chunked_relpos_attention(q, k, v, rel_bias):
    B, S, H, Dh = q.shape
    n_chunks = S // CHUNK
    pad = LEFT_CHUNKS * CHUNK
    k_pad = jnp.pad(k, ((0, 0), (pad, 0), (0, 0), (0, 0)))
    v_pad = jnp.pad(v, ((0, 0), (pad, 0), (0, 0), (0, 0)))
    qi = jnp.arange(CHUNK)[:, None]
    kj = jnp.arange(BAND)[None, :]
    dist = jnp.clip(qi + pad - kj, -MAX_REL, MAX_REL) + MAX_REL
    bias = rel_bias[:, dist].astype(jnp.float32)
    scale = Dh ** -0.5

    def one_chunk(c):
        qc = lax.dynamic_slice_in_dim(q, c * CHUNK, CHUNK, axis=1)
        kc = lax.dynamic_slice_in_dim(k_pad, c * CHUNK, BAND, axis=1)
        vc = lax.dynamic_slice_in_dim(v_pad, c * CHUNK, BAND, axis=1)
        s = jnp.einsum('bqhd,bkhd->bhqk', qc, kc, preferred_element_type=jnp.float32) * scale + bias
        valid = kj >= pad - c * CHUNK
        s = jnp.where(valid, s, -jnp.inf)
        p = jax.nn.softmax(s, axis=-1)
        return jnp.einsum('bhqk,bkhd->bqhd', p.astype(v.dtype), vc)

    out = lax.map(one_chunk, jnp.arange(n_chunks))
    return out.transpose(1, 0, 2, 3, 4).reshape(B, S, H * Dh)


def stick_breaking_attention(q, k, v):
    B, S, H, Dh = q.shape
    n_blocks = S // SB_BLOCK
    scale = Dh ** -0.5
    key_pos = jnp.arange(S)

    def one_block(blk):
        q0 = blk * SB_BLOCK
        qb = lax.dynamic_slice_in_dim(q, q0, SB_BLOCK, axis=1)
        z = jnp.einsum('bqhd,bkhd->bhqk', qb, k, preferred_element_type=jnp.float32) * scale
        q_pos = q0 + jnp.arange(SB_BLOCK)
        causal = key_pos[None, :] < q_pos[:, None]
        log_beta = jax.nn.log_sigmoid(z)
        log_1m = jnp.where(causal, jax.nn.log_sigmoid(-z), 0.0)
        suffix = lax.cumsum(log_1m, axis=3, reverse=True) - log_1m
        a = jnp.where(causal, jnp.exp(log_beta + suffix), 0.0)
        return jnp.einsum('bhqk,bkhd->bqhd', a.astype(v.dtype), v)

    out = lax.map(one_block, jnp.arange(n_blocks))
    return out.transpose(1, 0, 2, 3, 4).reshape(B, S, H * Dh)


def hybrid_mixer(x, w_in, rel_bias, gain_a, gain_b, w_out):
    B, S, _ = x.shape
    proj = jnp.einsum('bsd,de->bse', x, w_in)
    qa, ka, va, qb, kb, vb = jnp.split(
        proj, [D_A, 2 * D_A, 3 * D_A, 3 * D_A + D_B, 3 * D_A + 2 * D_B], axis=-1)
    ha = lambda t: t.reshape(B, S, N_HEADS_A, HEAD_DIM)
    hb = lambda t: t.reshape(B, S, N_HEADS_B, HEAD_DIM)
    ya = chunked_relpos_attention(ha(qa), ha(ka), ha(va), rel_bias)
    yb = stick_breaking_attention(hb(qb), hb(kb), hb(vb))
    y = jnp.concatenate([rms_norm(ya, gain_a), rms_norm(yb, gain_b)], axis=-1)
    return jnp.einsum('bse,ed->bsd', y, w_out)


def moe_ffn(x, router_w, router_bias, w_gate, w_up, w_down, ws_gate, ws_up, ws_down):
    B, S, D = x.shape
    xt = x.reshape(-1, D)
    T = xt.shape[0]
    logits = jnp.einsum('td,de->te', xt, router_w, preferred_element_type=jnp.float32)
    scores = jax.nn.sigmoid(logits)
    sel = scores + router_bias.astype(jnp.float32)
    grp_score = lax.top_k(sel.reshape(T, N_GROUPS, EXPERTS_PER_GROUP), 2)[0].sum(-1)
    _, top_grp = lax.top_k(grp_score, TOPK_GROUPS)
    grp_mask = jnp.any(top_grp[:, :, None] == jnp.arange(N_GROUPS)[None, None, :], axis=1)
    sel = jnp.where(jnp.repeat(grp_mask, EXPERTS_PER_GROUP, axis=-1), sel, -jnp.inf)
    _, expert_idx = lax.top_k(sel, TOP_K)
    gate = jnp.take_along_axis(scores, expert_idx, axis=-1)
    gate = (gate / jnp.sum(gate, axis=-1, keepdims=True) * ROUTED_SCALE).astype(x.dtype)
    tk = T * TOP_K
    n_rows = tk + N_EXPERTS * ROW_BLOCK
    n_blocks = n_rows // ROW_BLOCK
    flat_e = expert_idx.reshape(-1)
    order = jnp.argsort(flat_e)
    sorted_e = flat_e[order]
    counts = jnp.bincount(flat_e, length=N_EXPERTS)
    padded = (counts + ROW_BLOCK - 1) // ROW_BLOCK * ROW_BLOCK
    start_sorted = jnp.cumsum(counts) - counts
    padded_ends = jnp.cumsum(padded)
    start_padded = padded_ends - padded
    dest = start_padded[sorted_e] + (jnp.arange(tk) - start_sorted[sorted_e])
    row_token = jnp.full((n_rows,), T, jnp.int32).at[dest].set((order // TOP_K).astype(jnp.int32))
    row_gate = jnp.zeros((n_rows,), x.dtype).at[dest].set(gate.reshape(-1)[order])
    block_expert = jnp.minimum(
        jnp.searchsorted(padded_ends, jnp.arange(n_blocks) * ROW_BLOCK, side='right'), N_EXPERTS - 1)
    xt_pad = jnp.concatenate([xt, jnp.zeros((1, D), xt.dtype)], axis=0)

    def expert_block(acc, blk):
        tok_b, gate_b, e = blk
        xb = xt_pad[tok_b]
        hb = jax.nn.silu(xb @ w_gate[e]) * (xb @ w_up[e])
        yb = (hb @ w_down[e]) * gate_b[:, None]
        return acc.at[tok_b].add(yb), None

    routed, _ = lax.scan(
        expert_block, jnp.zeros((T + 1, D), xt.dtype),
        (row_token.reshape(n_blocks, ROW_BLOCK), row_gate.reshape(n_blocks, ROW_BLOCK), block_expert))
    shared = (jax.nn.silu(xt @ ws_gate) * (xt @ ws_up)) @ ws_down
    return (routed[:T] + shared).reshape(B, S, D)


def setup_inputs(seed: int = 0) -> dict:
    key = jax.random.key(seed)
    ks = jax.random.split(key, 18)
    L = DEPTH
    nrm = lambda k, shape, scale: jax.random.normal(k, shape, jnp.float32) * scale
    return {
        'x': nrm(ks[0], (BATCH, SEQ, D_MODEL), 1.0),
        'w_in': nrm(ks[1], (L, D_MODEL, 3 * D_MIX), D_MODEL ** -0.5),
        'rel_bias': nrm(ks[2], (L, N_HEADS_A, 2 * MAX_REL + 1), 0.5),
        'gain_a': 1.0 + nrm(ks[3], (L, D_A), 0.02),
        'gain_b': 1.0 + nrm(ks[4], (L, D_B), 0.02),
        'w_out': nrm(ks[5], (L, D_MIX, D_MODEL), DN_BETA * D_MIX ** -0.5),
        'ln1_g': 1.0 + nrm(ks[6], (L, D_MODEL), 0.02),
        'ln1_b': nrm(ks[7], (L, D_MODEL), 0.02),
        'router_w': nrm(ks[8], (L, D_MODEL, N_EXPERTS), D_MODEL ** -0.5),
        'router_bias': nrm(ks[9], (L, N_EXPERTS), 0.01),
        'w_gate': nrm(ks[10], (L, N_EXPERTS, D_MODEL, D_EXPERT), D_MODEL ** -0.5),
        'w_up': nrm(ks[11], (L, N_EXPERTS, D_MODEL, D_EXPERT), D_MODEL ** -0.5),
        'w_down': nrm(ks[12], (L, N_EXPERTS, D_EXPERT, D_MODEL), DN_BETA * D_EXPERT ** -0.5),
        'ws_gate': nrm(ks[13], (L, D_MODEL, D_EXPERT), D_MODEL ** -0.5),
        'ws_up': nrm(ks[14], (L, D_MODEL, D_EXPERT), D_MODEL ** -0.5),
        'ws_down': nrm(ks[15], (L, D_EXPERT, D_MODEL), DN_BETA * D_EXPERT ** -0.5),
        'ln2_g': 1.0 + nrm(ks[16], (L, D_MODEL), 0.02),
        'ln2_b': nrm(ks[17], (L, D_MODEL), 0.02),
    }


def reference(x, w_in, rel_bias, gain_a, gain_b, w_out, ln1_g, ln1_b, router_w, router_bias,
              w_gate, w_up, w_down, ws_gate, ws_up, ws_down, ln2_g, ln2_b):
    for l in range(DEPTH):
        h = hybrid_mixer(x, w_in[l], rel_bias[l], gain_a[l], gain_b[l], w_out[l])
        x = layer_norm(DN_ALPHA * x + h, ln1_g[l], ln1_b[l])
        h = moe_ffn(x, router_w[l], router_bias[l], w_gate[l], w_up[l], w_down[l],
                    ws_gate[l], ws_up[l], ws_down[l])
        x = layer_norm(DN_ALPHA * x + h, ln2_g[l], ln2_b[l])
    return x
```

```cpp
#include <hip/hip_runtime.h>
#include <cstdint>
#include <cstdio>

typedef unsigned short bf16_t;

constexpr int D_MODEL = 1024, BATCH = 16, SEQ = 2048, T_TOK = BATCH * SEQ;
constexpr int HEAD_DIM = 64, NHA = 8, NHB = 8, NHH = 16;
constexpr int CHUNK = 64, LEFT_CHUNKS = 8, MAX_REL = 128;
constexpr int N_EXP = 256, TOP_K = 8, N_GROUPS = 8, TOPK_GROUPS = 4, EPG = 32, D_EXP = 256;
constexpr float ROUTED_SCALE = 2.5f, LN_EPS = 1e-5f, RMS_EPS = 1e-6f;
constexpr float DN_ALPHA = 1.189207115002721f;
constexpr float LOG2E = 1.4426950408889634f, LN2 = 0.6931471805599453f;
constexpr float QSCALE = 0.125f * LOG2E;
constexpr int CAP = T_TOK;
constexpr int ROWS_ALL = T_TOK * TOP_K + T_TOK;

__device__ __forceinline__ float bf2f(bf16_t v) { return __uint_as_float(((unsigned)v) << 16); }
__device__ __forceinline__ bf16_t f2bf(float f) { unsigned u = __float_as_uint(f); u += 0x7fffu + ((u >> 16) & 1u); return (bf16_t)(u >> 16); }

constexpr size_t MB = 1024ull * 1024ull;
constexpr size_t OFF_CTRL   = 0;
constexpr size_t OFF_X1     = 1 * MB;
constexpr size_t OFF_TOKL   = OFF_X1 + 64 * MB;
constexpr size_t OFF_GATEL  = OFF_TOKL + 32 * MB;
constexpr size_t OFF_EIDX   = OFF_GATEL + 32 * MB;
constexpr size_t OFF_GATE   = OFF_EIDX + 1 * MB;
constexpr size_t OFF_SLOT   = OFF_GATE + 1 * MB;
constexpr size_t OFF_H      = OFF_SLOT + 1 * MB;
constexpr size_t OFF_BIG    = OFF_H + 144 * MB;
constexpr size_t OFF_Y      = OFF_BIG;
constexpr size_t OFF_Q      = OFF_BIG;
constexpr size_t OFF_K      = OFF_BIG + 64 * MB;
constexpr size_t OFF_VT     = OFF_BIG + 128 * MB;
constexpr size_t OFF_YATT   = OFF_BIG + 192 * MB;
constexpr size_t OFF_R      = OFF_BIG + 256 * MB;
constexpr size_t OFF_YRAW   = OFF_BIG + 320 * MB;
constexpr size_t OFF_SCORES = OFF_BIG + 448 * MB;
constexpr int CW_COUNTS = 4096;
constexpr int CW_STARTS = 8192;

__device__ __forceinline__ float ldf(const float* p, size_t i) { return p[i]; }
__device__ __forceinline__ float ldf(const bf16_t* p, size_t i) { return bf2f(p[i]); }

template <class TA, class Epi>
__device__ __forceinline__ void naive_tile(const TA* A, const int* rows, int lda, const float* B, int ldb, int M, int K, int m0, int n0, const Epi& epi) {
    __shared__ float As[16][65], Bs[16][65];
    const int tx = threadIdx.x & 15, ty = threadIdx.x >> 4;
    float acc[4][4];
#pragma unroll
    for (int i = 0; i < 4; ++i)
#pragma unroll
        for (int j = 0; j < 4; ++j) acc[i][j] = 0.f;
    for (int k0 = 0; k0 < K; k0 += 16) {
#pragma unroll
        for (int i = 0; i < 4; ++i) {
            const int idx = threadIdx.x + i * 256, r = idx >> 4, c = idx & 15, row = m0 + r;
            float v = 0.f;
            if (row < M) { const int rr = rows ? rows[row] : row; v = ldf(A, (size_t)rr * lda + k0 + c); }
            As[c][r] = v;
        }
#pragma unroll
        for (int i = 0; i < 4; ++i) {
            const int idx = threadIdx.x + i * 256, kk = idx >> 6, c = idx & 63;
            Bs[kk][c] = B[(size_t)(k0 + kk) * ldb + n0 + c];
        }
        __syncthreads();
#pragma unroll
        for (int kk = 0; kk < 16; ++kk) {
            float a[4], b[4];
#pragma unroll
            for (int i = 0; i < 4; ++i) { a[i] = As[kk][ty * 4 + i]; b[i] = Bs[kk][tx * 4 + i]; }
#pragma unroll
            for (int i = 0; i < 4; ++i)
#pragma unroll
                for (int j = 0; j < 4; ++j) acc[i][j] += a[i] * b[j];
        }
        __syncthreads();
    }
#pragma unroll
    for (int i = 0; i < 4; ++i)
#pragma unroll
        for (int j = 0; j < 4; ++j) { const int row = m0 + ty * 4 + i; if (row < M) epi(row, n0 + tx * 4 + j, acc[i][j]); }
}

struct EpiQKV { bf16_t *Q, *Kb, *Vt;
    __device__ void operator()(int row, int n, float v) const {
        const int b = row / SEQ, s = row % SEQ, seg = n / 512, within = n % 512, head = within / 64, d = within % 64, type = seg % 3, grp = seg / 3, hh = grp * 8 + head;
        if (type == 0) Q[((size_t)(b * NHH + hh) * SEQ + s) * 64 + d] = f2bf(v * QSCALE);
        else if (type == 1) Kb[((size_t)(b * NHH + hh) * SEQ + s) * 64 + d] = f2bf(v);
        else Vt[((size_t)(b * NHH + hh) * 64 + d) * SEQ + s] = f2bf(v);
    } };
__global__ __launch_bounds__(256) void nk_qkv(const float* x, const float* w_in, bf16_t* Q, bf16_t* Kb, bf16_t* Vt) {
    EpiQKV e{Q, Kb, Vt};
    naive_tile<float>(x, nullptr, D_MODEL, w_in, 3072, T_TOK, D_MODEL, blockIdx.y * 64, blockIdx.x * 64, e);
}

__global__ __launch_bounds__(64) void nk_attn_a(const bf16_t* Q, const bf16_t* Kb, const bf16_t* Vt, const float* rel_bias, float* yraw) {
    const int gid = blockIdx.x;
    const int c = gid % (SEQ / CHUNK), h = (gid / (SEQ / CHUNK)) % NHA, b = gid / ((SEQ / CHUNK) * NHA);
    const int t = c * CHUNK + threadIdx.x;
    const bf16_t* qp = Q + ((size_t)(b * NHH + h) * SEQ + t) * 64;
    float q[64], o[64];
#pragma unroll
    for (int d = 0; d < 64; ++d) { q[d] = bf2f(qp[d]); o[d] = 0.f; }
    float m = -INFINITY, l = 0.f;
    const int s_lo = max(0, c * CHUNK - LEFT_CHUNKS * CHUNK), s_hi = c * CHUNK + CHUNK;
    const bf16_t* kbase = Kb + (size_t)(b * NHH + h) * SEQ * 64;
    const bf16_t* vbase = Vt + (size_t)(b * NHH + h) * 64 * SEQ;
    for (int s = s_lo; s < s_hi; ++s) {
        float sc = 0.f;
#pragma unroll
        for (int d = 0; d < 64; ++d) sc += q[d] * bf2f(kbase[(size_t)s * 64 + d]);
        int dist = t - s; dist = dist < -MAX_REL ? -MAX_REL : (dist > MAX_REL ? MAX_REL : dist);
        sc += rel_bias[h * (2 * MAX_REL + 1) + dist + MAX_REL] * LOG2E;
        const float mn = fmaxf(m, sc), corr = exp2f(m - mn), p = exp2f(sc - mn);
        l = l * corr + p; m = mn;
#pragma unroll
        for (int d = 0; d < 64; ++d) o[d] = o[d] * corr + p * bf2f(vbase[(size_t)d * SEQ + s]);
    }
    const float inv = 1.f / l;
    float* yp = yraw + (size_t)(b * SEQ + t) * D_MODEL + h * 64;
#pragma unroll
    for (int d = 0; d < 64; ++d) yp[d] = o[d] * inv;
}

__global__ __launch_bounds__(64) void nk_attn_b(const bf16_t* Q, const bf16_t* Kb, const bf16_t* Vt, float* yraw) {
    const int gid = blockIdx.x;
    const int c = gid % (SEQ / 64), h = (gid / (SEQ / 64)) % NHB, b = gid / ((SEQ / 64) * NHB);
    const int t = c * 64 + threadIdx.x, hh = NHA + h;
    const bf16_t* qp = Q + ((size_t)(b * NHH + hh) * SEQ + t) * 64;
    float q[64], o[64];
#pragma unroll
    for (int d = 0; d < 64; ++d) { q[d] = bf2f(qp[d]); o[d] = 0.f; }
    const bf16_t* kbase = Kb + (size_t)(b * NHH + hh) * SEQ * 64;
    const bf16_t* vbase = Vt + (size_t)(b * NHH + hh) * 64 * SEQ;
    float suffix = 0.f;
    for (int s = c * 64 + 62; s >= 0; --s) {
        float sc = 0.f;
#pragma unroll
        for (int d = 0; d < 64; ++d) sc += q[d] * bf2f(kbase[(size_t)s * 64 + d]);
        const float z = sc * LN2;
        const float sp_pos = fmaxf(z, 0.f) + log1pf(expf(-fabsf(z)));
        const float log_beta = z - sp_pos, log_1m = -sp_pos;
        if (s < t) {
            const float a = expf(log_beta + suffix);
            suffix += log_1m;
#pragma unroll
            for (int d = 0; d < 64; ++d) o[d] += a * bf2f(vbase[(size_t)d * SEQ + s]);
        }
    }
    float* yp = yraw + (size_t)(b * SEQ + t) * D_MODEL + 512 + h * 64;
#pragma unroll
    for (int d = 0; d < 64; ++d) yp[d] = o[d];
}

__global__ __launch_bounds__(256) void nk_rms(const float* yraw, const float* gain_a, const float* gain_b, bf16_t* y) {
    const int t = blockIdx.x * 4 + (threadIdx.x >> 6), lane = threadIdx.x & 63;
    const float* p = yraw + (size_t)t * D_MODEL;
#pragma unroll
    for (int g = 0; g < 2; ++g) {
        float v[8], ss = 0.f;
#pragma unroll
        for (int i = 0; i < 8; ++i) { v[i] = p[g * 512 + lane * 8 + i]; ss += v[i] * v[i]; }
#pragma unroll
        for (int o = 32; o >= 1; o >>= 1) ss += __shfl_xor(ss, o);
        const float rs = rsqrtf(ss * (1.f / 512.f) + RMS_EPS);
        const float* gn = g ? gain_b : gain_a;
#pragma unroll
        for (int i = 0; i < 8; ++i) y[(size_t)t * D_MODEL + g * 512 + lane * 8 + i] = f2bf(v[i] * rs * gn[lane * 8 + i]);
    }
}

struct EpiOut { const float* x; bf16_t* r;
    __device__ void operator()(int row, int n, float v) const { r[(size_t)row * D_MODEL + n] = f2bf(DN_ALPHA * x[(size_t)row * D_MODEL + n] + v); } };
__global__ __launch_bounds__(256) void nk_outproj(const bf16_t* y, const float* w_out, const float* x, bf16_t* r) {
    EpiOut e{x, r};
    naive_tile<bf16_t>(y, nullptr, D_MODEL, w_out, D_MODEL, T_TOK, D_MODEL, blockIdx.y * 64, blockIdx.x * 64, e);
}

__global__ __launch_bounds__(256) void nk_ln1(const bf16_t* r, const float* g, const float* bb, bf16_t* x1) {
    const int t = blockIdx.x * 4 + (threadIdx.x >> 6), lane = threadIdx.x & 63;
    float v[16], s = 0.f;
#pragma unroll
    for (int i = 0; i < 16; ++i) { v[i] = bf2f(r[(size_t)t * D_MODEL + lane * 16 + i]); s += v[i]; }
#pragma unroll
    for (int o = 32; o >= 1; o >>= 1) s += __shfl_xor(s, o);
    const float mu = s * (1.f / 1024.f);
    float q = 0.f;
#pragma unroll
    for (int i = 0; i < 16; ++i) { const float d = v[i] - mu; q += d * d; }
#pragma unroll
    for (int o = 32; o >= 1; o >>= 1) q += __shfl_xor(q, o);
    const float rstd = rsqrtf(q * (1.f / 1024.f) + LN_EPS);
#pragma unroll
    for (int i = 0; i < 16; ++i) { const int c = lane * 16 + i; x1[(size_t)t * D_MODEL + c] = f2bf((v[i] - mu) * rstd * g[c] + bb[c]); }
}

struct EpiRouter { float* scores;
    __device__ void operator()(int row, int n, float v) const { scores[(size_t)row * N_EXP + n] = 1.f / (1.f + expf(-v)); } };
__global__ __launch_bounds__(256) void nk_router(const bf16_t* x1, const float* rw, float* scores) {
    EpiRouter e{scores};
    naive_tile<bf16_t>(x1, nullptr, D_MODEL, rw, N_EXP, T_TOK, D_MODEL, blockIdx.y * 64, blockIdx.x * 64, e);
}

__global__ __launch_bounds__(256) void nk_topk(const float* scores, const float* rbias, int* eidx, float* gate) {
    const int t = blockIdx.x * 256 + threadIdx.x;
    const float* sc = scores + (size_t)t * N_EXP;
    float gs[N_GROUPS];
#pragma unroll
    for (int g = 0; g < N_GROUPS; ++g) {
        float m1 = -INFINITY, m2 = -INFINITY;
        for (int i = 0; i < EPG; ++i) { const float v = sc[g * EPG + i] + rbias[g * EPG + i]; if (v > m1) { m2 = m1; m1 = v; } else if (v > m2) m2 = v; }
        gs[g] = m1 + m2;
    }
    unsigned gmask = 0;
#pragma unroll
    for (int r = 0; r < TOPK_GROUPS; ++r) {
        float best = -INFINITY; int bi = 0;
#pragma unroll
        for (int g = 0; g < N_GROUPS; ++g) { const bool ok = !((gmask >> g) & 1u) && gs[g] > best; if (ok) { best = gs[g]; bi = g; } }
        gmask |= 1u << bi;
    }
    float pv = INFINITY; int pi = -1; float gsum = 0.f; float gv[TOP_K]; int gi[TOP_K];
#pragma unroll
    for (int r = 0; r < TOP_K; ++r) {
        float best = -INFINITY; int bi = 0;
        for (int e = 0; e < N_EXP; ++e) {
            if (!((gmask >> (e / EPG)) & 1u)) continue;
            const float v = sc[e] + rbias[e];
            const bool after = (v < pv) || (v == pv && e > pi);
            if (after && v > best) { best = v; bi = e; }
        }
        pv = best; pi = bi; gi[r] = bi; gv[r] = sc[bi]; gsum += gv[r];
    }
#pragma unroll
    for (int r = 0; r < TOP_K; ++r) { eidx[t * TOP_K + r] = gi[r]; gate[t * TOP_K + r] = gv[r] / gsum * ROUTED_SCALE; }
}

__global__ __launch_bounds__(256) void nk_dispatch(const int* eidx, const float* gate, int* counts, int* tokl, float* gatel, int* slot) {
    const int i = blockIdx.x * 256 + threadIdx.x;
    const int e = eidx[i], pos = atomicAdd(&counts[e], 1);
    tokl[(size_t)e * CAP + pos] = i / TOP_K; gatel[(size_t)e * CAP + pos] = gate[i]; slot[i] = e * CAP + pos;
}
__global__ void nk_prefix(const int* counts, int* starts) {
    if (threadIdx.x == 0) { int s = 0; for (int e = 0; e < N_EXP; ++e) { starts[e] = s; s += counts[e]; } starts[N_EXP] = s; starts[N_EXP + 1] = s + T_TOK; }
}

__global__ __launch_bounds__(256) void nk_moe_gu(const bf16_t* x1, const int* tokl, const int* counts, const int* starts,
                                                const float* w_gate, const float* w_up, const float* ws_gate, const float* ws_up, bf16_t* H) {
    __shared__ float As[16][65], Bg[16][65], Bu[16][65];
    const int e = blockIdx.y, n0 = blockIdx.x * 64;
    const int cnt = e < N_EXP ? counts[e] : T_TOK, st = starts[e];
    const float* wg = e < N_EXP ? w_gate + (size_t)e * D_MODEL * D_EXP : ws_gate;
    const float* wu = e < N_EXP ? w_up + (size_t)e * D_MODEL * D_EXP : ws_up;
    const int* rows = e < N_EXP ? tokl + (size_t)e * CAP : nullptr;
    const int tx = threadIdx.x & 15, ty = threadIdx.x >> 4;
    for (int m0 = blockIdx.z * 64; m0 < cnt; m0 += gridDim.z * 64) {
        float ag[4][4], au[4][4];
#pragma unroll
        for (int i = 0; i < 4; ++i)
#pragma unroll
            for (int j = 0; j < 4; ++j) { ag[i][j] = 0.f; au[i][j] = 0.f; }
        for (int k0 = 0; k0 < D_MODEL; k0 += 16) {
#pragma unroll
            for (int i = 0; i < 4; ++i) {
                const int idx = threadIdx.x + i * 256, r = idx >> 4, c = idx & 15, row = m0 + r;
                float v = 0.f;
                if (row < cnt) { const int rr = rows ? rows[row] : row; v = bf2f(x1[(size_t)rr * D_MODEL + k0 + c]); }
                As[c][r] = v;
            }
#pragma unroll
            for (int i = 0; i < 4; ++i) {
                const int idx = threadIdx.x + i * 256, kk = idx >> 6, c = idx & 63;
                Bg[kk][c] = wg[(size_t)(k0 + kk) * D_EXP + n0 + c]; Bu[kk][c] = wu[(size_t)(k0 + kk) * D_EXP + n0 + c];
            }
            __syncthreads();
#pragma unroll
            for (int kk = 0; kk < 16; ++kk) {
                float a[4], bg[4], bu[4];
#pragma unroll
                for (int i = 0; i < 4; ++i) { a[i] = As[kk][ty * 4 + i]; bg[i] = Bg[kk][tx * 4 + i]; bu[i] = Bu[kk][tx * 4 + i]; }
#pragma unroll
                for (int i = 0; i < 4; ++i)
#pragma unroll
                    for (int j = 0; j < 4; ++j) { ag[i][j] += a[i] * bg[j]; au[i][j] += a[i] * bu[j]; }
            }
            __syncthreads();
        }
#pragma unroll
        for (int i = 0; i < 4; ++i)
#pragma unroll
            for (int j = 0; j < 4; ++j) { const int row = m0 + ty * 4 + i;
                if (row < cnt) { const float g = ag[i][j]; H[(size_t)(st + row) * D_EXP + n0 + tx * 4 + j] = f2bf(g / (1.f + expf(-g)) * au[i][j]); } }
    }
}

struct EpiDown { bf16_t* Y; const float* gl; int st;
    __device__ void operator()(int row, int n, float v) const { Y[(size_t)(st + row) * D_MODEL + n] = f2bf(gl ? v * gl[row] : v); } };
__global__ __launch_bounds__(256) void nk_moe_down(const bf16_t* H, const int* counts, const int* starts, const float* gatel,
                                                  const float* w_down, const float* ws_down, bf16_t* Y) {
    const int e = blockIdx.y, n0 = blockIdx.x * 64;
    const int cnt = e < N_EXP ? counts[e] : T_TOK, st = starts[e];
    const float* wd = e < N_EXP ? w_down + (size_t)e * D_EXP * D_MODEL : ws_down;
    EpiDown ep{Y, e < N_EXP ? gatel + (size_t)e * CAP : nullptr, st};
    for (int m0 = blockIdx.z * 64; m0 < cnt; m0 += gridDim.z * 64)
        naive_tile<bf16_t>(H + (size_t)st * D_EXP, nullptr, D_EXP, wd, D_MODEL, cnt, D_EXP, m0, n0, ep);
}

__global__ __launch_bounds__(256) void nk_combine(const bf16_t* x1, const bf16_t* Y, const int* slot, const int* starts, const float* g, const float* bb, float* out) {
    const int t = blockIdx.x * 4 + (threadIdx.x >> 6), lane = threadIdx.x & 63;
    float v[16];
#pragma unroll
    for (int i = 0; i < 16; ++i) v[i] = DN_ALPHA * bf2f(x1[(size_t)t * D_MODEL + lane * 16 + i]) + bf2f(Y[(size_t)(starts[N_EXP] + t) * D_MODEL + lane * 16 + i]);
    for (int k = 0; k < TOP_K; ++k) {
        const int sl = slot[t * TOP_K + k], e = sl / CAP, pos = sl % CAP; const size_t row = (size_t)starts[e] + pos;
#pragma unroll
        for (int i = 0; i < 16; ++i) v[i] += bf2f(Y[row * D_MODEL + lane * 16 + i]);
    }
    float s = 0.f;
#pragma unroll
    for (int i = 0; i < 16; ++i) s += v[i];
#pragma unroll
    for (int o = 32; o >= 1; o >>= 1) s += __shfl_xor(s, o);
    const float mu = s * (1.f / 1024.f);
    float q = 0.f;
#pragma unroll
    for (int i = 0; i < 16; ++i) { const float d = v[i] - mu; q += d * d; }
#pragma unroll
    for (int o = 32; o >= 1; o >>= 1) q += __shfl_xor(q, o);
    const float rstd = rsqrtf(q * (1.f / 1024.f) + LN_EPS);
#pragma unroll
    for (int i = 0; i < 16; ++i) { const int c = lane * 16 + i; out[(size_t)t * D_MODEL + c] = (v[i] - mu) * rstd * g[c] + bb[c]; }
}

extern "C" void kernel_launch(void* const* d_in, const int* in_sizes, int n_in, void* d_out, int out_size, void* d_ws, size_t ws_size, hipStream_t stream) {
    const float* x = (const float*)d_in[0];      const float* w_in = (const float*)d_in[1];   const float* rel_bias = (const float*)d_in[2];
    const float* gain_a = (const float*)d_in[3]; const float* gain_b = (const float*)d_in[4]; const float* w_out = (const float*)d_in[5];
    const float* ln1_g = (const float*)d_in[6];  const float* ln1_b = (const float*)d_in[7];  const float* router_w = (const float*)d_in[8];
    const float* router_bias = (const float*)d_in[9]; const float* w_gate = (const float*)d_in[10]; const float* w_up = (const float*)d_in[11];
    const float* w_down = (const float*)d_in[12]; const float* ws_gate = (const float*)d_in[13]; const float* ws_up = (const float*)d_in[14];
    const float* ws_down = (const float*)d_in[15]; const float* ln2_g = (const float*)d_in[16]; const float* ln2_b = (const float*)d_in[17];
    char* ws = (char*)d_ws; float* out = (float*)d_out;
    int* ctrl = (int*)(ws + OFF_CTRL); int* counts = ctrl + CW_COUNTS; int* starts = ctrl + CW_STARTS;
    bf16_t* X1 = (bf16_t*)(ws + OFF_X1); int* tokl = (int*)(ws + OFF_TOKL); float* gatel = (float*)(ws + OFF_GATEL);
    int* eidx = (int*)(ws + OFF_EIDX); float* gate = (float*)(ws + OFF_GATE); int* slot = (int*)(ws + OFF_SLOT);
    bf16_t* H = (bf16_t*)(ws + OFF_H); bf16_t* Y = (bf16_t*)(ws + OFF_Y);
    bf16_t* Q = (bf16_t*)(ws + OFF_Q); bf16_t* Kb = (bf16_t*)(ws + OFF_K); bf16_t* Vt = (bf16_t*)(ws + OFF_VT);
    bf16_t* yatt = (bf16_t*)(ws + OFF_YATT); bf16_t* r = (bf16_t*)(ws + OFF_R); float* yraw = (float*)(ws + OFF_YRAW); float* scores = (float*)(ws + OFF_SCORES);

    hipMemsetAsync(ctrl, 0, 64 * 1024, stream);
    nk_qkv<<<dim3(3072 / 64, T_TOK / 64), 256, 0, stream>>>(x, w_in, Q, Kb, Vt);
    nk_attn_a<<<BATCH * NHA * (SEQ / 64), 64, 0, stream>>>(Q, Kb, Vt, rel_bias, yraw);
    nk_attn_b<<<BATCH * NHB * (SEQ / 64), 64, 0, stream>>>(Q, Kb, Vt, yraw);
    nk_rms<<<T_TOK / 4, 256, 0, stream>>>(yraw, gain_a, gain_b, yatt);
    nk_outproj<<<dim3(D_MODEL / 64, T_TOK / 64), 256, 0, stream>>>(yatt, w_out, x, r);
    nk_ln1<<<T_TOK / 4, 256, 0, stream>>>(r, ln1_g, ln1_b, X1);
    nk_router<<<dim3(N_EXP / 64, T_TOK / 64), 256, 0, stream>>>(X1, router_w, scores);
    nk_topk<<<T_TOK / 256, 256, 0, stream>>>(scores, router_bias, eidx, gate);
    nk_dispatch<<<T_TOK * TOP_K / 256, 256, 0, stream>>>(eidx, gate, counts, tokl, gatel, slot);
    nk_prefix<<<1, 64, 0, stream>>>(counts, starts);
    nk_moe_gu<<<dim3(D_EXP / 64, N_EXP + 1, 32), 256, 0, stream>>>(X1, tokl, counts, starts, w_gate, w_up, ws_gate, ws_up, H);
    nk_moe_down<<<dim3(D_MODEL / 64, N_EXP + 1, 32), 256, 0, stream>>>(H, counts, starts, gatel, w_down, ws_down, Y);
    nk_combine<<<T_TOK / 4, 256, 0, stream>>>(X1, Y, slot, starts, ln2_g, ln2_b, out);
}
```

```cpp
#include <hip/hip_runtime.h>
#include <cstdint>
#include <cstdio>

typedef unsigned short bf16_t;

constexpr int D_MODEL = 1024, BATCH = 16, SEQ = 2048, T_TOK = BATCH * SEQ;
constexpr int HEAD_DIM = 64, NHA = 8, NHB = 8, NHH = 16;
constexpr int CHUNK = 64, LEFT_CHUNKS = 8, MAX_REL = 128;
constexpr int N_EXP = 256, TOP_K = 8, N_GROUPS = 8, TOPK_GROUPS = 4, EPG = 32, D_EXP = 256;
constexpr float ROUTED_SCALE = 2.5f, LN_EPS = 1e-5f, RMS_EPS = 1e-6f;
constexpr float DN_ALPHA = 1.189207115002721f;
constexpr float LOG2E = 1.4426950408889634f, LN2 = 0.6931471805599453f;
constexpr float QSCALE = 0.125f * LOG2E;
constexpr int CAP = T_TOK;
constexpr int ROWS_ALL = T_TOK * TOP_K + T_TOK;

__device__ __forceinline__ float bf2f(bf16_t v) { return __uint_as_float(((unsigned)v) << 16); }
__device__ __forceinline__ bf16_t f2bf(float f) { unsigned u = __float_as_uint(f); u += 0x7fffu + ((u >> 16) & 1u); return (bf16_t)(u >> 16); }

constexpr size_t MB = 1024ull * 1024ull;
constexpr size_t OFF_CTRL   = 0;
constexpr size_t OFF_X1     = 1 * MB;
constexpr size_t OFF_TOKL   = OFF_X1 + 64 * MB;
constexpr size_t OFF_GATEL  = OFF_TOKL + 32 * MB;
constexpr size_t OFF_EIDX   = OFF_GATEL + 32 * MB;
constexpr size_t OFF_GATE   = OFF_EIDX + 1 * MB;
constexpr size_t OFF_SLOT   = OFF_GATE + 1 * MB;
constexpr size_t OFF_H      = OFF_SLOT + 1 * MB;
constexpr size_t OFF_BIG    = OFF_H + 144 * MB;
constexpr size_t OFF_Y      = OFF_BIG;
constexpr size_t OFF_Q      = OFF_BIG;
constexpr size_t OFF_K      = OFF_BIG + 64 * MB;
constexpr size_t OFF_VT     = OFF_BIG + 128 * MB;
constexpr size_t OFF_YATT   = OFF_BIG + 192 * MB;
constexpr size_t OFF_R      = OFF_BIG + 256 * MB;
constexpr size_t OFF_YRAW   = OFF_BIG + 320 * MB;
constexpr size_t OFF_SCORES = OFF_BIG + 448 * MB;
constexpr size_t OFF_XB     = OFF_BIG + 480 * MB;
constexpr size_t OFF_STATS  = OFF_BIG + 544 * MB;
constexpr size_t OFF_WTIN   = OFF_BIG + 548 * MB;
constexpr size_t OFF_WTOUT  = OFF_BIG + 554 * MB;
constexpr size_t OFF_WTR    = OFF_BIG + 556 * MB;
constexpr int CW_COUNTS = 4096;
constexpr int CW_STARTS = 8192;

__device__ __forceinline__ float ldf(const float* p, size_t i) { return p[i]; }
__device__ __forceinline__ float ldf(const bf16_t* p, size_t i) { return bf2f(p[i]); }

template <class TA, class Epi>
__device__ __forceinline__ void naive_tile(const TA* A, const int* rows, int lda, const float* B, int ldb, int M, int K, int m0, int n0, const Epi& epi) {
    __shared__ float As[16][65], Bs[16][65];
    const int tx = threadIdx.x & 15, ty = threadIdx.x >> 4;
    float acc[4][4];
#pragma unroll
    for (int i = 0; i < 4; ++i)
#pragma unroll
        for (int j = 0; j < 4; ++j) acc[i][j] = 0.f;
    for (int k0 = 0; k0 < K; k0 += 16) {
#pragma unroll
        for (int i = 0; i < 4; ++i) {
            const int idx = threadIdx.x + i * 256, r = idx >> 4, c = idx & 15, row = m0 + r;
            float v = 0.f;
            if (row < M) { const int rr = rows ? rows[row] : row; v = ldf(A, (size_t)rr * lda + k0 + c); }
            As[c][r] = v;
        }
#pragma unroll
        for (int i = 0; i < 4; ++i) {
            const int idx = threadIdx.x + i * 256, kk = idx >> 6, c = idx & 63;
            Bs[kk][c] = B[(size_t)(k0 + kk) * ldb + n0 + c];
        }
        __syncthreads();
#pragma unroll
        for (int kk = 0; kk < 16; ++kk) {
            float a[4], b[4];
#pragma unroll
            for (int i = 0; i < 4; ++i) { a[i] = As[kk][ty * 4 + i]; b[i] = Bs[kk][tx * 4 + i]; }
#pragma unroll
            for (int i = 0; i < 4; ++i)
#pragma unroll
                for (int j = 0; j < 4; ++j) acc[i][j] += a[i] * b[j];
        }
        __syncthreads();
    }
#pragma unroll
    for (int i = 0; i < 4; ++i)
#pragma unroll
        for (int j = 0; j < 4; ++j) { const int row = m0 + ty * 4 + i; if (row < M) epi(row, n0 + tx * 4 + j, acc[i][j]); }
}

struct EpiQKV { bf16_t *Q, *Kb, *Vt;
    __device__ void operator()(int row, int n, float v) const {
        const int b = row / SEQ, s = row % SEQ, seg = n / 512, within = n % 512, head = within / 64, d = within % 64, type = seg % 3, grp = seg / 3, hh = grp * 8 + head;
        if (type == 0) Q[((size_t)(b * NHH + hh) * SEQ + s) * 64 + d] = f2bf(v * QSCALE);
        else if (type == 1) Kb[((size_t)(b * NHH + hh) * SEQ + s) * 64 + d] = f2bf(v);
        else Vt[((size_t)(b * NHH + hh) * 64 + d) * SEQ + s] = f2bf(v);
    } };
__global__ __launch_bounds__(256) void nk_qkv(const float* x, const float* w_in, bf16_t* Q, bf16_t* Kb, bf16_t* Vt) {
    EpiQKV e{Q, Kb, Vt};
    naive_tile<float>(x, nullptr, D_MODEL, w_in, 3072, T_TOK, D_MODEL, blockIdx.y * 64, blockIdx.x * 64, e);
}

__global__ __launch_bounds__(64) void nk_attn_a(const bf16_t* Q, const bf16_t* Kb, const bf16_t* Vt, const float* rel_bias, float* yraw) {
    const int gid = blockIdx.x;
    const int c = gid % (SEQ / CHUNK), h = (gid / (SEQ / CHUNK)) % NHA, b = gid / ((SEQ / CHUNK) * NHA);
    const int t = c * CHUNK + threadIdx.x;
    const bf16_t* qp = Q + ((size_t)(b * NHH + h) * SEQ + t) * 64;
    float q[64], o[64];
#pragma unroll
    for (int d = 0; d < 64; ++d) { q[d] = bf2f(qp[d]); o[d] = 0.f; }
    float m = -INFINITY, l = 0.f;
    const int s_lo = max(0, c * CHUNK - LEFT_CHUNKS * CHUNK), s_hi = c * CHUNK + CHUNK;
    const bf16_t* kbase = Kb + (size_t)(b * NHH + h) * SEQ * 64;
    const bf16_t* vbase = Vt + (size_t)(b * NHH + h) * 64 * SEQ;
    for (int s = s_lo; s < s_hi; ++s) {
        float sc = 0.f;
#pragma unroll
        for (int d = 0; d < 64; ++d) sc += q[d] * bf2f(kbase[(size_t)s * 64 + d]);
        int dist = t - s; dist = dist < -MAX_REL ? -MAX_REL : (dist > MAX_REL ? MAX_REL : dist);
        sc += rel_bias[h * (2 * MAX_REL + 1) + dist + MAX_REL] * LOG2E;
        const float mn = fmaxf(m, sc), corr = exp2f(m - mn), p = exp2f(sc - mn);
        l = l * corr + p; m = mn;
#pragma unroll
        for (int d = 0; d < 64; ++d) o[d] = o[d] * corr + p * bf2f(vbase[(size_t)d * SEQ + s]);
    }
    const float inv = 1.f / l;
    float* yp = yraw + (size_t)(b * SEQ + t) * D_MODEL + h * 64;
#pragma unroll
    for (int d = 0; d < 64; ++d) yp[d] = o[d] * inv;
}

__global__ __launch_bounds__(64) void nk_attn_b(const bf16_t* Q, const bf16_t* Kb, const bf16_t* Vt, float* yraw) {
    const int gid = blockIdx.x;
    const int c = gid % (SEQ / 64), h = (gid / (SEQ / 64)) % NHB, b = gid / ((SEQ / 64) * NHB);
    const int t = c * 64 + threadIdx.x, hh = NHA + h;
    const bf16_t* qp = Q + ((size_t)(b * NHH + hh) * SEQ + t) * 64;
    float q[64], o[64];
#pragma unroll
    for (int d = 0; d < 64; ++d) { q[d] = bf2f(qp[d]); o[d] = 0.f; }
    const bf16_t* kbase = Kb + (size_t)(b * NHH + hh) * SEQ * 64;
    const bf16_t* vbase = Vt + (size_t)(b * NHH + hh) * 64 * SEQ;
    float suffix = 0.f;
    for (int s = c * 64 + 62; s >= 0; --s) {
        float sc = 0.f;
#pragma unroll
        for (int d = 0; d < 64; ++d) sc += q[d] * bf2f(kbase[(size_t)s * 64 + d]);
        const float z = sc * LN2;
        const float sp_pos = fmaxf(z, 0.f) + log1pf(expf(-fabsf(z)));
        const float log_beta = z - sp_pos, log_1m = -sp_pos;
        if (s < t) {
            const float a = expf(log_beta + suffix);
            suffix += log_1m;
#pragma unroll
            for (int d = 0; d < 64; ++d) o[d] += a * bf2f(vbase[(size_t)d * SEQ + s]);
        }
    }
    float* yp = yraw + (size_t)(b * SEQ + t) * D_MODEL + 512 + h * 64;
#pragma unroll
    for (int d = 0; d < 64; ++d) yp[d] = o[d];
}

__global__ __launch_bounds__(256) void nk_rms(const float* yraw, const float* gain_a, const float* gain_b, bf16_t* y) {
    const int t = blockIdx.x * 4 + (threadIdx.x >> 6), lane = threadIdx.x & 63;
    const float* p = yraw + (size_t)t * D_MODEL;
#pragma unroll
    for (int g = 0; g < 2; ++g) {
        float v[8], ss = 0.f;
#pragma unroll
        for (int i = 0; i < 8; ++i) { v[i] = p[g * 512 + lane * 8 + i]; ss += v[i] * v[i]; }
#pragma unroll
        for (int o = 32; o >= 1; o >>= 1) ss += __shfl_xor(ss, o);
        const float rs = rsqrtf(ss * (1.f / 512.f) + RMS_EPS);
        const float* gn = g ? gain_b : gain_a;
#pragma unroll
        for (int i = 0; i < 8; ++i) y[(size_t)t * D_MODEL + g * 512 + lane * 8 + i] = f2bf(v[i] * rs * gn[lane * 8 + i]);
    }
}

struct EpiOut { const float* x; bf16_t* r;
    __device__ void operator()(int row, int n, float v) const { r[(size_t)row * D_MODEL + n] = f2bf(DN_ALPHA * x[(size_t)row * D_MODEL + n] + v); } };
__global__ __launch_bounds__(256) void nk_outproj(const bf16_t* y, const float* w_out, const float* x, bf16_t* r) {
    EpiOut e{x, r};
    naive_tile<bf16_t>(y, nullptr, D_MODEL, w_out, D_MODEL, T_TOK, D_MODEL, blockIdx.y * 64, blockIdx.x * 64, e);
}

__global__ __launch_bounds__(256) void nk_ln1(const bf16_t* r, const float* g, const float* bb, bf16_t* x1) {
    const int t = blockIdx.x * 4 + (threadIdx.x >> 6), lane = threadIdx.x & 63;
    float v[16], s = 0.f;
#pragma unroll
    for (int i = 0; i < 16; ++i) { v[i] = bf2f(r[(size_t)t * D_MODEL + lane * 16 + i]); s += v[i]; }
#pragma unroll
    for (int o = 32; o >= 1; o >>= 1) s += __shfl_xor(s, o);
    const float mu = s * (1.f / 1024.f);
    float q = 0.f;
#pragma unroll
    for (int i = 0; i < 16; ++i) { const float d = v[i] - mu; q += d * d; }
#pragma unroll
    for (int o = 32; o >= 1; o >>= 1) q += __shfl_xor(q, o);
    const float rstd = rsqrtf(q * (1.f / 1024.f) + LN_EPS);
#pragma unroll
    for (int i = 0; i < 16; ++i) { const int c = lane * 16 + i; x1[(size_t)t * D_MODEL + c] = f2bf((v[i] - mu) * rstd * g[c] + bb[c]); }
}

struct EpiRouter { float* scores;
    __device__ void operator()(int row, int n, float v) const { scores[(size_t)row * N_EXP + n] = 1.f / (1.f + expf(-v)); } };
__global__ __launch_bounds__(256) void nk_router(const bf16_t* x1, const float* rw, float* scores) {
    EpiRouter e{scores};
    naive_tile<bf16_t>(x1, nullptr, D_MODEL, rw, N_EXP, T_TOK, D_MODEL, blockIdx.y * 64, blockIdx.x * 64, e);
}

__global__ __launch_bounds__(256) void nk_topk(const float* scores, const float* rbias, int* eidx, float* gate) {
    const int t = blockIdx.x * 256 + threadIdx.x;
    const float* sc = scores + (size_t)t * N_EXP;
    float gs[N_GROUPS];
#pragma unroll
    for (int g = 0; g < N_GROUPS; ++g) {
        float m1 = -INFINITY, m2 = -INFINITY;
        for (int i = 0; i < EPG; ++i) { const float v = sc[g * EPG + i] + rbias[g * EPG + i]; if (v > m1) { m2 = m1; m1 = v; } else if (v > m2) m2 = v; }
        gs[g] = m1 + m2;
    }
    unsigned gmask = 0;
#pragma unroll
    for (int r = 0; r < TOPK_GROUPS; ++r) {
        float best = -INFINITY; int bi = 0;
#pragma unroll
        for (int g = 0; g < N_GROUPS; ++g) { const bool ok = !((gmask >> g) & 1u) && gs[g] > best; if (ok) { best = gs[g]; bi = g; } }
        gmask |= 1u << bi;
    }
    float pv = INFINITY; int pi = -1; float gsum = 0.f; float gv[TOP_K]; int gi[TOP_K];
#pragma unroll
    for (int r = 0; r < TOP_K; ++r) {
        float best = -INFINITY; int bi = 0;
        for (int e = 0; e < N_EXP; ++e) {
            if (!((gmask >> (e / EPG)) & 1u)) continue;
            const float v = sc[e] + rbias[e];
            const bool after = (v < pv) || (v == pv && e > pi);
            if (after && v > best) { best = v; bi = e; }
        }
        pv = best; pi = bi; gi[r] = bi; gv[r] = sc[bi]; gsum += gv[r];
    }
#pragma unroll
    for (int r = 0; r < TOP_K; ++r) { eidx[t * TOP_K + r] = gi[r]; gate[t * TOP_K + r] = gv[r] / gsum * ROUTED_SCALE; }
}

__global__ __launch_bounds__(256) void nk_dispatch(const int* eidx, const float* gate, int* counts, int* tokl, float* gatel, int* slot) {
    const int i = blockIdx.x * 256 + threadIdx.x;
    const int e = eidx[i], pos = atomicAdd(&counts[e], 1);
    tokl[(size_t)e * CAP + pos] = i / TOP_K; gatel[(size_t)e * CAP + pos] = gate[i]; slot[i] = e * CAP + pos;
}
__global__ void nk_prefix(const int* counts, int* starts) {
    if (threadIdx.x == 0) { int s = 0; for (int e = 0; e < N_EXP; ++e) { starts[e] = s; s += counts[e]; } starts[N_EXP] = s; starts[N_EXP + 1] = s + T_TOK; }
}

__global__ __launch_bounds__(256) void nk_moe_gu(const bf16_t* x1, const int* tokl, const int* counts, const int* starts,
                                                const float* w_gate, const float* w_up, const float* ws_gate, const float* ws_up, bf16_t* H) {
    __shared__ float As[16][65], Bg[16][65], Bu[16][65];
    const int e = blockIdx.y, n0 = blockIdx.x * 64;
    const int cnt = e < N_EXP ? counts[e] : T_TOK, st = starts[e];
    const float* wg = e < N_EXP ? w_gate + (size_t)e * D_MODEL * D_EXP : ws_gate;
    const float* wu = e < N_EXP ? w_up + (size_t)e * D_MODEL * D_EXP : ws_up;
    const int* rows = e < N_EXP ? tokl + (size_t)e * CAP : nullptr;
    const int tx = threadIdx.x & 15, ty = threadIdx.x >> 4;
    for (int m0 = blockIdx.z * 64; m0 < cnt; m0 += gridDim.z * 64) {
        float ag[4][4], au[4][4];
#pragma unroll
        for (int i = 0; i < 4; ++i)
#pragma unroll
            for (int j = 0; j < 4; ++j) { ag[i][j] = 0.f; au[i][j] = 0.f; }
        for (int k0 = 0; k0 < D_MODEL; k0 += 16) {
#pragma unroll
            for (int i = 0; i < 4; ++i) {
                const int idx = threadIdx.x + i * 256, r = idx >> 4, c = idx & 15, row = m0 + r;
                float v = 0.f;
                if (row < cnt) { const int rr = rows ? rows[row] : row; v = bf2f(x1[(size_t)rr * D_MODEL + k0 + c]); }
                As[c][r] = v;
            }
#pragma unroll
            for (int i = 0; i < 4; ++i) {
                const int idx = threadIdx.x + i * 256, kk = idx >> 6, c = idx & 63;
                Bg[kk][c] = wg[(size_t)(k0 + kk) * D_EXP + n0 + c]; Bu[kk][c] = wu[(size_t)(k0 + kk) * D_EXP + n0 + c];
            }
            __syncthreads();
#pragma unroll
            for (int kk = 0; kk < 16; ++kk) {
                float a[4], bg[4], bu[4];
#pragma unroll
                for (int i = 0; i < 4; ++i) { a[i] = As[kk][ty * 4 + i]; bg[i] = Bg[kk][tx * 4 + i]; bu[i] = Bu[kk][tx * 4 + i]; }
#pragma unroll
                for (int i = 0; i < 4; ++i)
#pragma unroll
                    for (int j = 0; j < 4; ++j) { ag[i][j] += a[i] * bg[j]; au[i][j] += a[i] * bu[j]; }
            }
            __syncthreads();
        }
#pragma unroll
        for (int i = 0; i < 4; ++i)
#pragma unroll
            for (int j = 0; j < 4; ++j) { const int row = m0 + ty * 4 + i;
                if (row < cnt) { const float g = ag[i][j]; H[(size_t)(st + row) * D_EXP + n0 + tx * 4 + j] = f2bf(g / (1.f + expf(-g)) * au[i][j]); } }
    }
}

struct EpiDown { bf16_t* Y; const float* gl; int st;
    __device__ void operator()(int row, int n, float v) const { Y[(size_t)(st + row) * D_MODEL + n] = f2bf(gl ? v * gl[row] : v); } };
__global__ __launch_bounds__(256) void nk_moe_down(const bf16_t* H, const int* counts, const int* starts, const float* gatel,
                                                  const float* w_down, const float* ws_down, bf16_t* Y) {
    const int e = blockIdx.y, n0 = blockIdx.x * 64;
    const int cnt = e < N_EXP ? counts[e] : T_TOK, st = starts[e];
    const float* wd = e < N_EXP ? w_down + (size_t)e * D_EXP * D_MODEL : ws_down;
    EpiDown ep{Y, e < N_EXP ? gatel + (size_t)e * CAP : nullptr, st};
    for (int m0 = blockIdx.z * 64; m0 < cnt; m0 += gridDim.z * 64)
        naive_tile<bf16_t>(H + (size_t)st * D_EXP, nullptr, D_EXP, wd, D_MODEL, cnt, D_EXP, m0, n0, ep);
}

__global__ __launch_bounds__(256) void nk_combine(const bf16_t* x1, const bf16_t* Y, const int* slot, const int* starts, const float* g, const float* bb, float* out) {
    const int t = blockIdx.x * 4 + (threadIdx.x >> 6), lane = threadIdx.x & 63;
    float v[16];
#pragma unroll
    for (int i = 0; i < 16; ++i) v[i] = DN_ALPHA * bf2f(x1[(size_t)t * D_MODEL + lane * 16 + i]) + bf2f(Y[(size_t)(starts[N_EXP] + t) * D_MODEL + lane * 16 + i]);
    for (int k = 0; k < TOP_K; ++k) {
        const int sl = slot[t * TOP_K + k], e = sl / CAP, pos = sl % CAP; const size_t row = (size_t)starts[e] + pos;
#pragma unroll
        for (int i = 0; i < 16; ++i) v[i] += bf2f(Y[row * D_MODEL + lane * 16 + i]);
    }
    float s = 0.f;
#pragma unroll
    for (int i = 0; i < 16; ++i) s += v[i];
#pragma unroll
    for (int o = 32; o >= 1; o >>= 1) s += __shfl_xor(s, o);
    const float mu = s * (1.f / 1024.f);
    float q = 0.f;
#pragma unroll
    for (int i = 0; i < 16; ++i) { const float d = v[i] - mu; q += d * d; }
#pragma unroll
    for (int o = 32; o >= 1; o >>= 1) q += __shfl_xor(q, o);
    const float rstd = rsqrtf(q * (1.f / 1024.f) + LN_EPS);
#pragma unroll
    for (int i = 0; i < 16; ++i) { const int c = lane * 16 + i; out[(size_t)t * D_MODEL + c] = (v[i] - mu) * rstd * g[c] + bb[c]; }
}


typedef short bf16x8 __attribute__((ext_vector_type(8)));
typedef float f32x4 __attribute__((ext_vector_type(4)));
typedef float f32x2 __attribute__((ext_vector_type(2)));
typedef float f32x16 __attribute__((ext_vector_type(16)));
typedef unsigned u32x4 __attribute__((ext_vector_type(4)));
typedef unsigned u32x2 __attribute__((ext_vector_type(2)));
#define DI __device__ __forceinline__
constexpr int NTHR = 512, GRID = 256;
constexpr int LDS_BYTES = 147456;

typedef __bf16 bf16x2_t __attribute__((ext_vector_type(2)));
DI unsigned cvt_pk_bf16(float lo, float hi) { f32x2 v = {lo, hi}; bf16x2_t r = __builtin_convertvector(v, bf16x2_t); return __builtin_bit_cast(unsigned, r); }
DI int vblock() { return (int)((blockIdx.x & 7) * (GRID / 8) + (blockIdx.x >> 3)); }

template <int MT> struct Tile { static constexpr int BM = 32 * MT, A_BYTES = BM * 128, B_BYTES = 256 * 128, STAGE = A_BYTES + B_BYTES; };

template <int MT> struct ALoader {
    const bf16_t* p[MT / 2]; u32x4 v[MT / 2]; int off0;
    DI void init_rows(const bf16_t* A, int lda, int row0) {
        const int tid = threadIdx.x, kc = tid & 7, r = tid >> 3;
#pragma unroll
        for (int i = 0; i < MT / 2; ++i) p[i] = A + (size_t)(row0 + r + 64 * i) * lda + kc * 8;
        off0 = r * 128 + ((kc ^ ((r >> 1) & 7)) << 4);
    }
    DI void init_gather(const bf16_t* A, int lda, const int* rows, int cnt, int m0) {
        const int tid = threadIdx.x, kc = tid & 7, r = tid >> 3;
#pragma unroll
        for (int i = 0; i < MT / 2; ++i) { int rr = m0 + r + 64 * i; rr = rr < cnt ? rr : cnt - 1; const int g = rows ? rows[rr] : rr; p[i] = A + (size_t)g * lda + kc * 8; }
        off0 = r * 128 + ((kc ^ ((r >> 1) & 7)) << 4);
    }
    DI void load(int k0) {
#pragma unroll
        for (int i = 0; i < MT / 2; ++i) v[i] = *(const u32x4*)(p[i] + k0);
    }
    DI void store(char* ldsA) const {
#pragma unroll
        for (int i = 0; i < MT / 2; ++i) *(u32x4*)(ldsA + off0 + i * 8192) = v[i];
    }
};
struct BLoaderBt {
    const bf16_t* p[4]; u32x4 v[4]; int off0;
    DI void init(const bf16_t* Bt, int ldk, int n0) {
        const int tid = threadIdx.x, kc = tid & 7, r = tid >> 3;
#pragma unroll
        for (int i = 0; i < 4; ++i) p[i] = Bt + (size_t)(n0 + r + 64 * i) * ldk + kc * 8;
        off0 = r * 128 + ((kc ^ ((r >> 1) & 7)) << 4);
    }
    DI void load(int k0) {
#pragma unroll
        for (int i = 0; i < 4; ++i) v[i] = *(const u32x4*)(p[i] + k0);
    }
    DI void store(char* ldsB) const {
#pragma unroll
        for (int i = 0; i < 4; ++i) *(u32x4*)(ldsB + off0 + i * 8192) = v[i];
    }
};
template <bool GU> struct BLoaderF32 {
    const float* p[2]; int ldb; f32x2 v[2][8]; int off[2][2];
    DI void init(const float* P0, const float* P1, int ldb_) {
        const int tid = threadIdx.x, l = tid & 63, w = tid >> 6; ldb = ldb_;
        p[0] = P0 + (size_t)(8 * w) * ldb + 2 * l; p[1] = P1 + (size_t)(8 * w) * ldb + 2 * l;
#pragma unroll
        for (int jp = 0; jp < 2; ++jp)
#pragma unroll
            for (int jj = 0; jj < 2; ++jj) { const int c = 2 * l + jj; const int row = GU ? (64 * (c >> 5) + 32 * jp + (c & 31)) : (128 * jp + c); off[jp][jj] = row * 128 + ((w ^ ((row >> 1) & 7)) << 4); }
    }
    DI void load(int k0) {
#pragma unroll
        for (int jp = 0; jp < 2; ++jp)
#pragma unroll
            for (int kk = 0; kk < 8; ++kk) v[jp][kk] = *(const f32x2*)(p[jp] + (size_t)(k0 + kk) * ldb);
    }
    DI void store(char* ldsB) const {
#pragma unroll
        for (int jp = 0; jp < 2; ++jp) {
            u32x4 a, b;
            a.x = cvt_pk_bf16(v[jp][0].x, v[jp][1].x); a.y = cvt_pk_bf16(v[jp][2].x, v[jp][3].x); a.z = cvt_pk_bf16(v[jp][4].x, v[jp][5].x); a.w = cvt_pk_bf16(v[jp][6].x, v[jp][7].x);
            b.x = cvt_pk_bf16(v[jp][0].y, v[jp][1].y); b.y = cvt_pk_bf16(v[jp][2].y, v[jp][3].y); b.z = cvt_pk_bf16(v[jp][4].y, v[jp][5].y); b.w = cvt_pk_bf16(v[jp][6].y, v[jp][7].y);
            *(u32x4*)(ldsB + off[jp][0]) = a; *(u32x4*)(ldsB + off[jp][1]) = b;
        }
    }
};

template <int MT, bool TR, class AL, class BL>
DI void gemm_tile(char* lds, AL& al, BL& bl, int nk, f32x4 (&acc)[MT][4]) {
    typedef Tile<MT> TT;
    const int tid = threadIdx.x, wid = tid >> 6, lane = tid & 63, wr = wid >> 2, wc = wid & 3, fr = lane & 15, fq = lane >> 4;
#pragma unroll
    for (int m = 0; m < MT; ++m)
#pragma unroll
        for (int n = 0; n < 4; ++n) acc[m][n] = (f32x4){0.f, 0.f, 0.f, 0.f};
    int aoff[2], boff[2];
#pragma unroll
    for (int ks = 0; ks < 2; ++ks) { const int ch = (((4 * ks + fq) ^ (fr >> 1)) << 4); aoff[ks] = (16 * MT * wr + fr) * 128 + ch; boff[ks] = TT::A_BYTES + (64 * wc + fr) * 128 + ch; }
    al.load(0); bl.load(0);
    __syncthreads();
    al.store(lds); bl.store(lds + TT::A_BYTES);
    __syncthreads();
    for (int kt = 0; kt < nk; ++kt) {
        char* cur = lds + (kt & 1) * TT::STAGE; char* nxt = lds + ((kt & 1) ^ 1) * TT::STAGE;
        const bool more = kt + 1 < nk;
        if (more) { al.load((kt + 1) * 64); bl.load((kt + 1) * 64); }
#pragma unroll
        for (int ks = 0; ks < 2; ++ks) {
            bf16x8 a[MT], b[4];
#pragma unroll
            for (int m = 0; m < MT; ++m) a[m] = *(const bf16x8*)(cur + aoff[ks] + m * 2048);
#pragma unroll
            for (int n = 0; n < 4; ++n) b[n] = *(const bf16x8*)(cur + boff[ks] + n * 2048);
#pragma unroll
            for (int m = 0; m < MT; ++m)
#pragma unroll
                for (int n = 0; n < 4; ++n)
                    acc[m][n] = TR ? __builtin_amdgcn_mfma_f32_16x16x32_bf16(b[n], a[m], acc[m][n], 0, 0, 0) : __builtin_amdgcn_mfma_f32_16x16x32_bf16(a[m], b[n], acc[m][n], 0, 0, 0);
        }
        if (more) { al.store(nxt); bl.store(nxt + TT::A_BYTES); }
        __syncthreads();
    }
}

DI void transpose_cvt(const float* W, bf16_t* Wt, int K, int N, int unit, char* lds) {
    float* tile = (float*)lds;
    const int nbn = N / 64, kb = unit / nbn, nb = unit % nbn, tid = threadIdx.x;
    __syncthreads();
#pragma unroll
    for (int i = 0; i < 8; ++i) { const int idx = tid + i * 512, r = idx >> 6, c = idx & 63; tile[r * 65 + c] = W[(size_t)(kb * 64 + r) * N + nb * 64 + c]; }
    __syncthreads();
#pragma unroll
    for (int i = 0; i < 8; ++i) { const int idx = tid + i * 512, n = idx >> 6, k = idx & 63; Wt[(size_t)(nb * 64 + n) * K + kb * 64 + k] = f2bf(tile[k * 65 + n]); }
}
struct P0Args { const float* x; const float* w_in; const float* w_out; const float* router_w; bf16_t* xb; bf16_t* wt_in; bf16_t* wt_out; bf16_t* wt_r; };
DI void phase_prologue(const P0Args& a, char* lds) {
    const int vb = vblock();
    for (size_t i = (size_t)vb * NTHR + threadIdx.x; i < (size_t)T_TOK * D_MODEL / 8; i += (size_t)GRID * NTHR) {
        const f32x4 v0 = *(const f32x4*)(a.x + i * 8), v1 = *(const f32x4*)(a.x + i * 8 + 4);
        u32x4 o; o.x = cvt_pk_bf16(v0[0], v0[1]); o.y = cvt_pk_bf16(v0[2], v0[3]); o.z = cvt_pk_bf16(v1[0], v1[1]); o.w = cvt_pk_bf16(v1[2], v1[3]);
        *(u32x4*)(a.xb + i * 8) = o;
    }
    const int n_in = (1024 / 64) * (3072 / 64), n_out = 16 * 16, n_r = 16 * 4;
    for (int u = vb; u < n_in + n_out + n_r; u += GRID) {
        if (u < n_in) transpose_cvt(a.w_in, a.wt_in, 1024, 3072, u, lds);
        else if (u < n_in + n_out) transpose_cvt(a.w_out, a.wt_out, 1024, 1024, u - n_in, lds);
        else transpose_cvt(a.router_w, a.wt_r, 1024, 256, u - n_in - n_out, lds);
    }
}

struct P1Args { const bf16_t* xb; const bf16_t* wt_in; bf16_t* Q; bf16_t* Kb; bf16_t* Vt; };
DI void phase_qkv(const P1Args& a, char* lds) {
    const int tid = threadIdx.x, wid = tid >> 6, lane = tid & 63, wr = wid >> 2, wc = wid & 3, fr = lane & 15, fq = lane >> 4;
    for (int u = vblock(); u < (T_TOK / 128) * 12; u += GRID) {
        const int panel = u / 12, ct = u % 12, m0 = panel * 128, n0 = ct * 256;
        const int seg = ct >> 1, type = seg % 3, grp = seg / 3, hh = grp * 8 + 4 * (ct & 1) + wc;
        const int b = m0 / SEQ, s0 = m0 % SEQ;
        ALoader<4> al; al.init_rows(a.xb, D_MODEL, m0);
        BLoaderBt bl; bl.init(a.wt_in, D_MODEL, n0);
        f32x4 acc[4][4];
        if (type == 2) {
            gemm_tile<4, false>(lds, al, bl, D_MODEL / 64, acc);
#pragma unroll
            for (int m = 0; m < 4; ++m)
#pragma unroll
                for (int n = 0; n < 4; ++n) {
                    const int s = s0 + 64 * wr + 16 * m + 4 * fq, d = 16 * n + fr;
                    u32x2 o; o.x = cvt_pk_bf16(acc[m][n][0], acc[m][n][1]); o.y = cvt_pk_bf16(acc[m][n][2], acc[m][n][3]);
                    *(u32x2*)(a.Vt + ((size_t)(b * NHH + hh) * 64 + d) * SEQ + s) = o;
                }
        } else {
            gemm_tile<4, true>(lds, al, bl, D_MODEL / 64, acc);
            bf16_t* dst = type == 0 ? a.Q : a.Kb; const float sc = type == 0 ? QSCALE : 1.f;
#pragma unroll
            for (int m = 0; m < 4; ++m)
#pragma unroll
                for (int n = 0; n < 4; ++n) {
                    const int s = s0 + 64 * wr + 16 * m + fr, d = 16 * n + 4 * fq;
                    u32x2 o; o.x = cvt_pk_bf16(acc[m][n][0] * sc, acc[m][n][1] * sc); o.y = cvt_pk_bf16(acc[m][n][2] * sc, acc[m][n][3] * sc);
                    *(u32x2*)(dst + ((size_t)(b * NHH + hh) * SEQ + s) * 64 + d) = o;
                }
        }
    }
}

struct P3Args { const bf16_t* y; const bf16_t* wt_out; const float* x; bf16_t* r; float* stats; };
DI void phase_outproj(const P3Args& a, char* lds) {
    const int tid = threadIdx.x, wid = tid >> 6, lane = tid & 63, wr = wid >> 2, wc = wid & 3, fr = lane & 15, fq = lane >> 4;
    for (int u = vblock(); u < (T_TOK / 128) * 4; u += GRID) {
        const int panel = u / 4, ct = u % 4, m0 = panel * 128, n0 = ct * 256;
        ALoader<4> al; al.init_rows(a.y, D_MODEL, m0);
        BLoaderBt bl; bl.init(a.wt_out, D_MODEL, n0);
        f32x4 acc[4][4];
        gemm_tile<4, true>(lds, al, bl, D_MODEL / 64, acc);
#pragma unroll
        for (int m = 0; m < 4; ++m) {
            const int row = m0 + 64 * wr + 16 * m + fr; float s = 0.f, q = 0.f;
#pragma unroll
            for (int n = 0; n < 4; ++n) {
                const int col = n0 + 64 * wc + 16 * n + 4 * fq;
                const f32x4 xv = *(const f32x4*)(a.x + (size_t)row * D_MODEL + col);
                const f32x4 v = xv * DN_ALPHA + acc[m][n];
                s += (v[0] + v[1]) + (v[2] + v[3]); q += (v[0] * v[0] + v[1] * v[1]) + (v[2] * v[2] + v[3] * v[3]);
                u32x2 o; o.x = cvt_pk_bf16(v[0], v[1]); o.y = cvt_pk_bf16(v[2], v[3]);
                *(u32x2*)(a.r + (size_t)row * D_MODEL + col) = o;
            }
            s += __shfl_xor(s, 16); s += __shfl_xor(s, 32); q += __shfl_xor(q, 16); q += __shfl_xor(q, 32);
            if (fq == 0) *(f32x2*)(a.stats + ((size_t)row * 16 + ct * 4 + wc) * 2) = (f32x2){s, q};
        }
    }
}
__global__ __launch_bounds__(256) void k_ln1_stats(const bf16_t* r, const float* stats, const float* g, const float* bb, bf16_t* x1) {
    const int t = blockIdx.x * 4 + (threadIdx.x >> 6), lane = threadIdx.x & 63;
    float s = 0.f, q = 0.f;
#pragma unroll
    for (int i = 0; i < 16; ++i) { s += stats[((size_t)t * 16 + i) * 2]; q += stats[((size_t)t * 16 + i) * 2 + 1]; }
    const float mu = s * (1.f / 1024.f), var = q * (1.f / 1024.f) - mu * mu, rstd = rsqrtf(var + LN_EPS);
#pragma unroll
    for (int i = 0; i < 16; ++i) { const int c = lane * 16 + i; x1[(size_t)t * D_MODEL + c] = f2bf((bf2f(r[(size_t)t * D_MODEL + c]) - mu) * rstd * g[c] + bb[c]); }
}


constexpr int RS_SC = 289;
constexpr int LDS_HIST = 100 * 1024;
struct P4Args { const bf16_t* r; const float* stats; const float* ln_g; const float* ln_b; bf16_t* x1; const bf16_t* wt_r; const float* rbias;
                int* eidx; float* gate; int* counts; int* tokl; float* gatel; int* slot; };
DI void phase_router(const P4Args& a, char* lds) {
    const int tid = threadIdx.x, wid = tid >> 6, lane = tid & 63, wr = wid >> 2, wc = wid & 3, fr = lane & 15, fq = lane >> 4;
    float* sc = (float*)lds; int* hist = (int*)(lds + LDS_HIST); int* base = hist + 256;
    for (int u = vblock(); u < T_TOK / 128; u += GRID) {
        const int m0 = u * 128;
        for (int i = 0; i < 16; ++i) {
            const int t = m0 + wid * 16 + i;
            f32x2 st = (f32x2){0.f, 0.f};
            if (lane < 16) st = *(const f32x2*)(a.stats + ((size_t)t * 16 + lane) * 2);
            float s = st.x, q = st.y;
#pragma unroll
            for (int o = 1; o <= 8; o <<= 1) { s += __shfl_xor(s, o); q += __shfl_xor(q, o); }
            s = __shfl(s, 0); q = __shfl(q, 0);
            const float mu = s * (1.f / 1024.f), rstd = rsqrtf(q * (1.f / 1024.f) - mu * mu + LN_EPS);
            const u32x4 r0 = *(const u32x4*)(a.r + (size_t)t * D_MODEL + lane * 16), r1 = *(const u32x4*)(a.r + (size_t)t * D_MODEL + lane * 16 + 8);
            float v[16];
#pragma unroll
            for (int j = 0; j < 4; ++j) { v[2 * j] = __uint_as_float(r0[j] << 16); v[2 * j + 1] = __uint_as_float(r0[j] & 0xffff0000u); v[8 + 2 * j] = __uint_as_float(r1[j] << 16); v[8 + 2 * j + 1] = __uint_as_float(r1[j] & 0xffff0000u); }
            u32x4 o0, o1;
#pragma unroll
            for (int j = 0; j < 4; ++j) {
                const f32x4 g = *(const f32x4*)(a.ln_g + lane * 16 + 4 * j), bb = *(const f32x4*)(a.ln_b + lane * 16 + 4 * j);
                const float y0 = (v[4 * j] - mu) * rstd * g[0] + bb[0], y1 = (v[4 * j + 1] - mu) * rstd * g[1] + bb[1], y2 = (v[4 * j + 2] - mu) * rstd * g[2] + bb[2], y3 = (v[4 * j + 3] - mu) * rstd * g[3] + bb[3];
                const unsigned p0 = cvt_pk_bf16(y0, y1), p1 = cvt_pk_bf16(y2, y3);
                if (j < 2) { o0[2 * j] = p0; o0[2 * j + 1] = p1; } else { o1[2 * (j - 2)] = p0; o1[2 * (j - 2) + 1] = p1; }
            }
            *(u32x4*)(a.x1 + (size_t)t * D_MODEL + lane * 16) = o0; *(u32x4*)(a.x1 + (size_t)t * D_MODEL + lane * 16 + 8) = o1;
        }
        if (tid < 256) hist[tid] = 0;
        asm volatile("s_waitcnt vmcnt(0)" ::: "memory");
        __syncthreads();
        ALoader<4> al; al.init_rows(a.x1, D_MODEL, m0);
        BLoaderBt bl; bl.init(a.wt_r, D_MODEL, 0);
        f32x4 acc[4][4];
        gemm_tile<4, true>(lds, al, bl, D_MODEL / 64, acc);
        int my_idx[2], my_rank[2]; float my_gate[2];
#pragma unroll
        for (int p = 0; p < 2; ++p) {
            __syncthreads();
            if (wr == p) {
#pragma unroll
                for (int m = 0; m < 4; ++m)
#pragma unroll
                    for (int n = 0; n < 4; ++n) {
                        const int c0 = 64 * wc + 16 * n + 4 * fq; const f32x4 rb = *(const f32x4*)(a.rbias + c0);
#pragma unroll
                        for (int j = 0; j < 4; ++j) { const int c = c0 + j; sc[(16 * m + fr) * RS_SC + (c >> 5) * 36 + (c & 31)] = 1.f / (1.f + __expf(-acc[m][n][j])) + rb[j]; }
                    }
            }
            __syncthreads();
            const int row = tid >> 3, g = tid & 7, t = m0 + 64 * p + row;
            float sel[32];
#pragma unroll
            for (int i = 0; i < 32; ++i) sel[i] = sc[row * RS_SC + g * 36 + i];
            float m1 = -INFINITY, m2 = -INFINITY;
#pragma unroll
            for (int i = 0; i < 32; ++i) { const float v = sel[i]; m2 = fmaxf(m2, fminf(m1, v)); m1 = fmaxf(m1, v); }
            const float gs = m1 + m2; int rank = 0;
#pragma unroll
            for (int d = 1; d < 8; ++d) { const float o = __shfl_xor(gs, d); const int og = g ^ d; rank += (o > gs || (o == gs && og < g)) ? 1 : 0; }
            const bool en = rank < TOPK_GROUPS;
            float pv = INFINITY; int pi = -1; float myv = 0.f; int myi = 0;
#pragma unroll
            for (int k = 0; k < TOP_K; ++k) {
                float bv = -INFINITY; int bi = 1 << 20;
                if (en) {
#pragma unroll
                    for (int i = 0; i < 32; ++i) { const float v = sel[i]; const int e = g * 32 + i; const bool after = (v < pv) || (v == pv && e > pi); if (after && v > bv) { bv = v; bi = e; } }
                }
#pragma unroll
                for (int d = 1; d < 8; d <<= 1) { const float ov = __shfl_xor(bv, d); const int oi = __shfl_xor(bi, d); if (ov > bv || (ov == bv && oi < bi)) { bv = ov; bi = oi; } }
                pv = bv; pi = bi;
                if (g == k) { myv = bv; myi = bi; }
            }
            const float score = myv - a.rbias[myi];
            float gsum = score;
#pragma unroll
            for (int d = 1; d < 8; d <<= 1) gsum += __shfl_xor(gsum, d);
            const float gt = score / gsum * ROUTED_SCALE;
            a.eidx[t * TOP_K + g] = myi; a.gate[t * TOP_K + g] = gt;
            my_idx[p] = myi; my_gate[p] = gt; my_rank[p] = atomicAdd(&hist[myi], 1);
        }
        __syncthreads();
        if (tid < 256) { const int h = hist[tid]; base[tid] = h > 0 ? atomicAdd(&a.counts[tid], h) : 0; }
        __syncthreads();
#pragma unroll
        for (int p = 0; p < 2; ++p) {
            const int row = tid >> 3, g = tid & 7, t = m0 + 64 * p + row, e = my_idx[p], pos = base[e] + my_rank[p];
            a.tokl[(size_t)e * CAP + pos] = t; a.gatel[(size_t)e * CAP + pos] = my_gate[p]; a.slot[t * TOP_K + g] = e * CAP + pos;
        }
    }
}

constexpr int LDS_TAB = 120 * 1024;
template <int BM> DI void build_moe_tab(const int* counts, char* lds) {
    int* tstart = (int*)(lds + LDS_TAB); int* rstart = tstart + 264;
    const int tid = threadIdx.x, lane = tid & 63;
    __syncthreads();
    if (tid < 64) {
        int c[4], tl[4], cs = 0, ts = 0;
#pragma unroll
        for (int i = 0; i < 4; ++i) { c[i] = counts[lane * 4 + i]; tl[i] = (c[i] + BM - 1) / BM; cs += c[i]; ts += tl[i]; }
        int ci = cs, ti = ts;
#pragma unroll
        for (int o = 1; o < 64; o <<= 1) { const int n1 = __shfl_up(ci, o), n2 = __shfl_up(ti, o); if (lane >= o) { ci += n1; ti += n2; } }
        int ce = ci - cs, te = ti - ts;
#pragma unroll
        for (int i = 0; i < 4; ++i) { rstart[lane * 4 + i] = ce; tstart[lane * 4 + i] = te; ce += c[i]; te += tl[i]; }
        if (lane == 63) { rstart[256] = ce; tstart[256] = te; rstart[257] = ce + T_TOK; tstart[257] = te + T_TOK / BM; }
    }
    __syncthreads();
}
DI int find_expert(const int* tstart, int g) {
    int lo = 0, hi = 256;
#pragma unroll 1
    while (lo < hi) { const int mid = (lo + hi + 1) >> 1; if (tstart[mid] <= g) lo = mid; else hi = mid - 1; }
    return lo;
}

struct P6Args { const bf16_t* x1; const int* counts; const int* tokl; const float* w_gate; const float* w_up; const float* ws_gate; const float* ws_up; bf16_t* H; };
DI void phase_moe_gu(const P6Args& a, char* lds) {
    const int tid = threadIdx.x, wid = tid >> 6, lane = tid & 63, wr = wid >> 2, wc = wid & 3, fr = lane & 15, fq = lane >> 4;
    build_moe_tab<128>(a.counts, lds);
    const int* tstart = (const int*)(lds + LDS_TAB); const int* rstart = tstart + 264;
    const int nunits = tstart[257] * 2;
    for (int u = vblock(); u < nunits; u += GRID) {
        const int g = u >> 1, j = u & 1, e = find_expert(tstart, g), m0 = (g - tstart[e]) * 128, st = rstart[e];
        const int cnt = e < N_EXP ? a.counts[e] : T_TOK;
        const float* wg = (e < N_EXP ? a.w_gate + (size_t)e * D_MODEL * D_EXP : a.ws_gate) + 128 * j;
        const float* wu = (e < N_EXP ? a.w_up + (size_t)e * D_MODEL * D_EXP : a.ws_up) + 128 * j;
        ALoader<4> al; al.init_gather(a.x1, D_MODEL, e < N_EXP ? a.tokl + (size_t)e * CAP : nullptr, cnt, m0);
        BLoaderF32<true> bl; bl.init(wg, wu, D_EXP);
        f32x4 acc[4][4];
        gemm_tile<4, true>(lds, al, bl, D_MODEL / 64, acc);
#pragma unroll
        for (int m = 0; m < 4; ++m) {
            const int row = m0 + 64 * wr + 16 * m + fr;
            if (row < cnt) {
#pragma unroll
                for (int n = 0; n < 2; ++n) {
                    float h[4];
#pragma unroll
                    for (int jj = 0; jj < 4; ++jj) { const float gv = acc[m][n][jj]; h[jj] = gv / (1.f + __expf(-gv)) * acc[m][n + 2][jj]; }
                    u32x2 o; o.x = cvt_pk_bf16(h[0], h[1]); o.y = cvt_pk_bf16(h[2], h[3]);
                    *(u32x2*)(a.H + (size_t)(st + row) * D_EXP + 128 * j + 32 * wc + 16 * n + 4 * fq) = o;
                }
            }
        }
    }
}
struct P7Args { const bf16_t* H; const int* counts; const float* gatel; const float* w_down; const float* ws_down; bf16_t* Y; };
DI void phase_moe_down(const P7Args& a, char* lds) {
    const int tid = threadIdx.x, wid = tid >> 6, lane = tid & 63, wr = wid >> 2, wc = wid & 3, fr = lane & 15, fq = lane >> 4;
    build_moe_tab<128>(a.counts, lds);
    const int* tstart = (const int*)(lds + LDS_TAB); const int* rstart = tstart + 264;
    const int nunits = tstart[257] * 4;
    for (int u = vblock(); u < nunits; u += GRID) {
        const int g = u >> 2, ct = u & 3, e = find_expert(tstart, g), m0 = (g - tstart[e]) * 128, st = rstart[e], n0 = ct * 256;
        const int cnt = e < N_EXP ? a.counts[e] : T_TOK;
        const float* wd = (e < N_EXP ? a.w_down + (size_t)e * D_EXP * D_MODEL : a.ws_down) + n0;
        ALoader<4> al; al.init_gather(a.H + (size_t)st * D_EXP, D_EXP, nullptr, cnt, m0);
        BLoaderF32<false> bl; bl.init(wd, wd + 128, D_MODEL);
        f32x4 acc[4][4];
        gemm_tile<4, true>(lds, al, bl, D_EXP / 64, acc);
#pragma unroll
        for (int m = 0; m < 4; ++m) {
            const int row = m0 + 64 * wr + 16 * m + fr;
            if (row < cnt) {
                const float gt = e < N_EXP ? a.gatel[(size_t)e * CAP + row] : 1.f;
#pragma unroll
                for (int n = 0; n < 4; ++n) {
                    u32x2 o; o.x = cvt_pk_bf16(acc[m][n][0] * gt, acc[m][n][1] * gt); o.y = cvt_pk_bf16(acc[m][n][2] * gt, acc[m][n][3] * gt);
                    *(u32x2*)(a.Y + (size_t)(st + row) * D_MODEL + n0 + 64 * wc + 16 * n + 4 * fq) = o;
                }
            }
        }
    }
}
struct P8Args { const bf16_t* x1; const bf16_t* Y; const int* slot; const int* counts; const float* ln_g; const float* ln_b; float* out; };
DI void unpack16(const u32x4& a, const u32x4& b, float (&v)[16]) {
#pragma unroll
    for (int j = 0; j < 4; ++j) { v[2 * j] = __uint_as_float(a[j] << 16); v[2 * j + 1] = __uint_as_float(a[j] & 0xffff0000u); v[8 + 2 * j] = __uint_as_float(b[j] << 16); v[8 + 2 * j + 1] = __uint_as_float(b[j] & 0xffff0000u); }
}
DI void phase_combine(const P8Args& a, char* lds) {
    const int tid = threadIdx.x, wid = tid >> 6, lane = tid & 63;
    build_moe_tab<128>(a.counts, lds);
    const int* rstart = (const int*)(lds + LDS_TAB) + 264;
    const int sh0 = rstart[256];
    for (int t = vblock() * 8 + wid; t < T_TOK; t += GRID * 8) {
        float v[16], w[16];
        { const u32x4 p0 = *(const u32x4*)(a.x1 + (size_t)t * D_MODEL + lane * 16), p1 = *(const u32x4*)(a.x1 + (size_t)t * D_MODEL + lane * 16 + 8); unpack16(p0, p1, v); }
#pragma unroll
        for (int i = 0; i < 16; ++i) v[i] *= DN_ALPHA;
        { const bf16_t* yp = a.Y + (size_t)(sh0 + t) * D_MODEL + lane * 16; const u32x4 p0 = *(const u32x4*)yp, p1 = *(const u32x4*)(yp + 8); unpack16(p0, p1, w); }
#pragma unroll
        for (int i = 0; i < 16; ++i) v[i] += w[i];
        int sl = 0; if (lane < TOP_K) sl = a.slot[t * TOP_K + lane];
#pragma unroll
        for (int k = 0; k < TOP_K; ++k) {
            const int s = __shfl(sl, k), e = s / CAP, pos = s % CAP;
            const bf16_t* yp = a.Y + (size_t)(rstart[e] + pos) * D_MODEL + lane * 16; const u32x4 p0 = *(const u32x4*)yp, p1 = *(const u32x4*)(yp + 8); unpack16(p0, p1, w);
#pragma unroll
            for (int i = 0; i < 16; ++i) v[i] += w[i];
        }
        float s = 0.f;
#pragma unroll
        for (int i = 0; i < 16; ++i) s += v[i];
#pragma unroll
        for (int o = 32; o >= 1; o >>= 1) s += __shfl_xor(s, o);
        const float mu = s * (1.f / 1024.f);
        float q = 0.f;
#pragma unroll
        for (int i = 0; i < 16; ++i) { const float d = v[i] - mu; q += d * d; }
#pragma unroll
        for (int o = 32; o >= 1; o >>= 1) q += __shfl_xor(q, o);
        const float rstd = rsqrtf(q * (1.f / 1024.f) + LN_EPS);
#pragma unroll
        for (int j = 0; j < 4; ++j) {
            const f32x4 g = *(const f32x4*)(a.ln_g + lane * 16 + 4 * j), bb = *(const f32x4*)(a.ln_b + lane * 16 + 4 * j);
            f32x4 o; o[0] = (v[4 * j] - mu) * rstd * g[0] + bb[0]; o[1] = (v[4 * j + 1] - mu) * rstd * g[1] + bb[1]; o[2] = (v[4 * j + 2] - mu) * rstd * g[2] + bb[2]; o[3] = (v[4 * j + 3] - mu) * rstd * g[3] + bb[3];
            *(f32x4*)(a.out + (size_t)t * D_MODEL + lane * 16 + 4 * j) = o;
        }
    }
}

#define MFMA32(a, b, c) __builtin_amdgcn_mfma_f32_32x32x16_bf16((a), (b), (c), 0, 0, 0)
constexpr float SB_EXIT_THR = 1e-30f;
struct P2Args { const bf16_t* Q; const bf16_t* Kb; const bf16_t* Vt; const float* rel_bias; const float* gain_a; const float* gain_b; bf16_t* y; };

DI bf16x8 pack8(const f32x16& x, int s) {
    u32x4 p;
    if (s == 0) { p.x = cvt_pk_bf16(x[0], x[1]); p.y = cvt_pk_bf16(x[2], x[3]); p.z = cvt_pk_bf16(x[4], x[5]); p.w = cvt_pk_bf16(x[6], x[7]); }
    else        { p.x = cvt_pk_bf16(x[8], x[9]); p.y = cvt_pk_bf16(x[10], x[11]); p.z = cvt_pk_bf16(x[12], x[13]); p.w = cvt_pk_bf16(x[14], x[15]); }
    return __builtin_bit_cast(bf16x8, p);
}
DI void load_k(bf16x8 (&k)[4], const bf16_t* kp, int k0) {
#pragma unroll
    for (int kk = 0; kk < 4; ++kk) k[kk] = *(const bf16x8*)(kp + (size_t)k0 * 64 + 16 * kk);
}
DI void load_v(bf16x8 (&v)[2][2], const bf16_t* vp0, const bf16_t* vp1, int k0) {
#pragma unroll
    for (int s = 0; s < 2; ++s) {
        const u32x2 a0 = *(const u32x2*)(vp0 + k0 + 16 * s), a1 = *(const u32x2*)(vp0 + k0 + 16 * s + 8);
        const u32x2 b0 = *(const u32x2*)(vp1 + k0 + 16 * s), b1 = *(const u32x2*)(vp1 + k0 + 16 * s + 8);
        v[0][s] = __builtin_bit_cast(bf16x8, (u32x4){a0.x, a0.y, a1.x, a1.y});
        v[1][s] = __builtin_bit_cast(bf16x8, (u32x4){b0.x, b0.y, b1.x, b1.y});
    }
}

DI void phase_attn(const P2Args& a, char* lds) {
    const int tid = threadIdx.x, wid = tid >> 6, lane = tid & 63, r = lane & 31, h = lane >> 5;
    float* tbl = (float*)lds;
    float* ssq = (float*)(lds + 8 * 260 * 4);
    __syncthreads();
    for (int i = tid; i < NHA * 257; i += NTHR) { const int hd = i / 257, j = i % 257; tbl[hd * 260 + j] = a.rel_bias[i] * LOG2E; }
    __syncthreads();
    for (int u = vblock(); u < 2 * BATCH * (SEQ / 64); u += GRID) {
        const bool isB = u >= BATCH * (SEQ / 64); const int uu = isB ? u - BATCH * (SEQ / 64) : u;
        const int b = uu / (SEQ / 64), c = uu % (SEQ / 64), q0 = c * 64, hh = (isB ? NHA : 0) + wid;
        const size_t hb = (size_t)(b * NHH + hh) * SEQ * 64;
        const bf16_t* kp = a.Kb + hb + r * 64 + 8 * h;
        const bf16_t* vp0 = a.Vt + hb + (size_t)r * SEQ + 4 * h; const bf16_t* vp1 = vp0 + (size_t)32 * SEQ;
        bf16x8 qf[2][4];
#pragma unroll
        for (int qt = 0; qt < 2; ++qt)
#pragma unroll
            for (int kk = 0; kk < 4; ++kk) qf[qt][kk] = *(const bf16x8*)(a.Q + hb + (size_t)(q0 + 32 * qt + r) * 64 + 16 * kk + 8 * h);
        f32x16 ot[2][2];
#pragma unroll
        for (int dt = 0; dt < 2; ++dt)
#pragma unroll
            for (int qt = 0; qt < 2; ++qt)
#pragma unroll
                for (int i = 0; i < 16; ++i) ot[dt][qt][i] = 0.f;
        float linv[2] = {1.f, 1.f};
        if (!isB) {
            float mrun[2] = {-INFINITY, -INFINITY}, lrun[2] = {0.f, 0.f};
            const int klo = q0 - LEFT_CHUNKS * CHUNK < 0 ? 0 : q0 - LEFT_CHUNKS * CHUNK, khi = q0 + 64;
            const float cfar = tbl[wid * 260 + 256];
            bf16x8 kc[4], kn[4], vf[2][2]; load_k(kc, kp, klo);
            for (int k0 = klo; k0 < khi; k0 += 32) {
                load_v(vf, vp0, vp1, k0);
                load_k(kn, kp, k0 + 32 < khi ? k0 + 32 : k0);
#pragma unroll
                for (int qt = 0; qt < 2; ++qt) {
                    bf16x8 pf[2];
                    f32x16 st;
#pragma unroll
                    for (int i = 0; i < 16; ++i) st[i] = 0.f;
#pragma unroll
                    for (int kk = 0; kk < 4; ++kk) st = MFMA32(kc[kk], qf[qt][kk], st);
                    const int dmin = q0 + 32 * qt - k0 - 31;
                    if (dmin >= MAX_REL) {
#pragma unroll
                        for (int i = 0; i < 16; ++i) st[i] += cfar;
                    } else {
                        const int bidx = q0 + 32 * qt + r - k0 - 4 * h + MAX_REL;
#pragma unroll
                        for (int i = 0; i < 16; ++i) { int ix = bidx - ((i & 3) + 8 * (i >> 2)); ix = ix < 0 ? 0 : (ix > 2 * MAX_REL ? 2 * MAX_REL : ix); st[i] += tbl[wid * 260 + ix]; }
                    }
                    float mx = st[0];
#pragma unroll
                    for (int i = 1; i < 16; ++i) mx = fmaxf(mx, st[i]);
                    mx = fmaxf(mx, __shfl_xor(mx, 32));
                    const float mn = fmaxf(mrun[qt], mx), alpha = __builtin_amdgcn_exp2f(mrun[qt] - mn);
                    mrun[qt] = mn;
                    float ps = 0.f;
#pragma unroll
                    for (int i = 0; i < 16; ++i) { st[i] = __builtin_amdgcn_exp2f(st[i] - mn); ps += st[i]; }
                    lrun[qt] = lrun[qt] * alpha + ps;
#pragma unroll
                    for (int i = 0; i < 16; ++i) { ot[0][qt][i] *= alpha; ot[1][qt][i] *= alpha; }
                    pf[0] = pack8(st, 0); pf[1] = pack8(st, 1);
#pragma unroll
                    for (int dt = 0; dt < 2; ++dt)
#pragma unroll
                        for (int s = 0; s < 2; ++s) ot[dt][qt] = MFMA32(vf[dt][s], pf[s], ot[dt][qt]);
                }
#pragma unroll
                for (int kk = 0; kk < 4; ++kk) kc[kk] = kn[kk];
            }
#pragma unroll
            for (int qt = 0; qt < 2; ++qt) { const float lt = lrun[qt] + __shfl_xor(lrun[qt], 32); linv[qt] = 1.f / lt; }
        } else {
            float carry[2] = {1.f, 1.f};
            bf16x8 kc[4], kn[4], vf[2][2]; load_k(kc, kp, q0 + 32);
            for (int k0 = q0 + 32; k0 >= 0; k0 -= 32) {
                load_v(vf, vp0, vp1, k0);
                load_k(kn, kp, k0 >= 32 ? k0 - 32 : k0);
#pragma unroll
                for (int qt = 0; qt < 2; ++qt) {
                    bf16x8 pf[2];
                    f32x16 st;
#pragma unroll
                    for (int i = 0; i < 16; ++i) st[i] = 0.f;
                    const bool none = (k0 > q0 + 32 * qt + 30);
                    if (!none) {
#pragma unroll
                        for (int kk = 0; kk < 4; ++kk) st = MFMA32(kc[kk], qf[qt][kk], st);
                        const bool full = (k0 + 31 < q0 + 32 * qt);
                        const int lim = q0 + 32 * qt + r - k0 - 4 * h;
                        float om[16];
#pragma unroll
                        for (int i = 0; i < 16; ++i) {
                            const float e = __builtin_amdgcn_exp2f(-st[i]); float bta = __builtin_amdgcn_rcpf(1.f + e);
                            if (!full && !(((i & 3) + 8 * (i >> 2)) < lim)) bta = 0.f;
                            st[i] = bta; om[i] = 1.f - bta;
                        }
                        float G[4], Go[4];
#pragma unroll
                        for (int g = 0; g < 4; ++g) { G[g] = (om[4 * g] * om[4 * g + 1]) * (om[4 * g + 2] * om[4 * g + 3]); Go[g] = __shfl_xor(G[g], 32); }
                        float R = carry[qt];
#pragma unroll
                        for (int g = 3; g >= 0; --g) {
                            float run = h == 0 ? R * Go[g] : R;
#pragma unroll
                            for (int uu2 = 3; uu2 >= 0; --uu2) { const float bta = st[4 * g + uu2]; st[4 * g + uu2] = bta * run; run *= om[4 * g + uu2]; }
                            R = R * (G[g] * Go[g]);
                        }
                        carry[qt] = R;
                    }
                    if (!none) {
                        pf[0] = pack8(st, 0); pf[1] = pack8(st, 1);
#pragma unroll
                        for (int dt = 0; dt < 2; ++dt)
#pragma unroll
                            for (int s = 0; s < 2; ++s) ot[dt][qt] = MFMA32(vf[dt][s], pf[s], ot[dt][qt]);
                    }
                }
#pragma unroll
                for (int kk = 0; kk < 4; ++kk) kc[kk] = kn[kk];
                if (__all(carry[0] < SB_EXIT_THR && carry[1] < SB_EXIT_THR)) break;
            }
        }
        float ss[2];
#pragma unroll
        for (int qt = 0; qt < 2; ++qt) {
            float s2 = 0.f;
#pragma unroll
            for (int dt = 0; dt < 2; ++dt)
#pragma unroll
                for (int i = 0; i < 16; ++i) { ot[dt][qt][i] *= linv[qt]; s2 += ot[dt][qt][i] * ot[dt][qt][i]; }
            s2 += __shfl_xor(s2, 32); ss[qt] = s2;
        }
        __syncthreads();
        if (h == 0) { ssq[wid * 64 + r] = ss[0]; ssq[wid * 64 + 32 + r] = ss[1]; }
        __syncthreads();
        const float* gain = isB ? a.gain_b : a.gain_a;
#pragma unroll
        for (int qt = 0; qt < 2; ++qt) {
            float tot = 0.f;
#pragma unroll
            for (int w8 = 0; w8 < 8; ++w8) tot += ssq[w8 * 64 + 32 * qt + r];
            const float rs = rsqrtf(tot * (1.f / 512.f) + RMS_EPS);
            bf16_t* yp = a.y + (size_t)(b * SEQ + q0 + 32 * qt + r) * D_MODEL + (isB ? 512 : 0) + wid * 64;
#pragma unroll
            for (int dt = 0; dt < 2; ++dt)
#pragma unroll
                for (int g = 0; g < 4; ++g) {
                    const int d = 32 * dt + 8 * g + 4 * h; const f32x4 gn = *(const f32x4*)(gain + wid * 64 + d);
                    u32x2 o; o.x = cvt_pk_bf16(ot[dt][qt][4 * g] * rs * gn[0], ot[dt][qt][4 * g + 1] * rs * gn[1]); o.y = cvt_pk_bf16(ot[dt][qt][4 * g + 2] * rs * gn[2], ot[dt][qt][4 * g + 3] * rs * gn[3]);
                    *(u32x2*)(yp + d) = o;
                }
        }
    }
}
__global__ __launch_bounds__(NTHR, 2) void k_attn(P2Args a) { extern __shared__ __attribute__((aligned(16))) char smem[]; phase_attn(a, smem); }
__global__ __launch_bounds__(NTHR, 2) void k_router(P4Args a) { extern __shared__ __attribute__((aligned(16))) char smem[]; phase_router(a, smem); }
__global__ __launch_bounds__(NTHR, 2) void k_moe_gu(P6Args a) { extern __shared__ __attribute__((aligned(16))) char smem[]; phase_moe_gu(a, smem); }
__global__ __launch_bounds__(NTHR, 2) void k_moe_down(P7Args a) { extern __shared__ __attribute__((aligned(16))) char smem[]; phase_moe_down(a, smem); }
__global__ __launch_bounds__(NTHR, 2) void k_combine(P8Args a) { extern __shared__ __attribute__((aligned(16))) char smem[]; phase_combine(a, smem); }
__global__ __launch_bounds__(NTHR, 2) void k_prologue(P0Args a) { extern __shared__ __attribute__((aligned(16))) char smem[]; phase_prologue(a, smem); }
__global__ __launch_bounds__(NTHR, 2) void k_qkv(P1Args a) { extern __shared__ __attribute__((aligned(16))) char smem[]; phase_qkv(a, smem); }
__global__ __launch_bounds__(NTHR, 2) void k_outproj(P3Args a) { extern __shared__ __attribute__((aligned(16))) char smem[]; phase_outproj(a, smem); }

extern "C" void kernel_launch(void* const* d_in, const int* in_sizes, int n_in, void* d_out, int out_size, void* d_ws, size_t ws_size, hipStream_t stream) {
    const float* x = (const float*)d_in[0];      const float* w_in = (const float*)d_in[1];   const float* rel_bias = (const float*)d_in[2];
    const float* gain_a = (const float*)d_in[3]; const float* gain_b = (const float*)d_in[4]; const float* w_out = (const float*)d_in[5];
    const float* ln1_g = (const float*)d_in[6];  const float* ln1_b = (const float*)d_in[7];  const float* router_w = (const float*)d_in[8];
    const float* router_bias = (const float*)d_in[9]; const float* w_gate = (const float*)d_in[10]; const float* w_up = (const float*)d_in[11];
    const float* w_down = (const float*)d_in[12]; const float* ws_gate = (const float*)d_in[13]; const float* ws_up = (const float*)d_in[14];
    const float* ws_down = (const float*)d_in[15]; const float* ln2_g = (const float*)d_in[16]; const float* ln2_b = (const float*)d_in[17];
    char* ws = (char*)d_ws; float* out = (float*)d_out;
    int* ctrl = (int*)(ws + OFF_CTRL); int* counts = ctrl + CW_COUNTS; int* starts = ctrl + CW_STARTS;
    bf16_t* X1 = (bf16_t*)(ws + OFF_X1); int* tokl = (int*)(ws + OFF_TOKL); float* gatel = (float*)(ws + OFF_GATEL);
    int* eidx = (int*)(ws + OFF_EIDX); float* gate = (float*)(ws + OFF_GATE); int* slot = (int*)(ws + OFF_SLOT);
    bf16_t* H = (bf16_t*)(ws + OFF_H); bf16_t* Y = (bf16_t*)(ws + OFF_Y);
    bf16_t* Q = (bf16_t*)(ws + OFF_Q); bf16_t* Kb = (bf16_t*)(ws + OFF_K); bf16_t* Vt = (bf16_t*)(ws + OFF_VT);
    bf16_t* yatt = (bf16_t*)(ws + OFF_YATT); bf16_t* r = (bf16_t*)(ws + OFF_R); float* yraw = (float*)(ws + OFF_YRAW); float* scores = (float*)(ws + OFF_SCORES);

    hipMemsetAsync(ctrl, 0, 64 * 1024, stream);
    bf16_t* xb = (bf16_t*)(ws + OFF_XB); float* stats = (float*)(ws + OFF_STATS);
    bf16_t* wt_in = (bf16_t*)(ws + OFF_WTIN); bf16_t* wt_out = (bf16_t*)(ws + OFF_WTOUT); bf16_t* wt_r = (bf16_t*)(ws + OFF_WTR);
    static bool attr_done = false;
    if (!attr_done) {
        hipFuncSetAttribute((const void*)k_prologue, hipFuncAttributeMaxDynamicSharedMemorySize, LDS_BYTES);
        hipFuncSetAttribute((const void*)k_qkv, hipFuncAttributeMaxDynamicSharedMemorySize, LDS_BYTES);
        hipFuncSetAttribute((const void*)k_outproj, hipFuncAttributeMaxDynamicSharedMemorySize, LDS_BYTES);
        hipFuncSetAttribute((const void*)k_attn, hipFuncAttributeMaxDynamicSharedMemorySize, LDS_BYTES);
        hipFuncSetAttribute((const void*)k_router, hipFuncAttributeMaxDynamicSharedMemorySize, LDS_BYTES);
        hipFuncSetAttribute((const void*)k_moe_gu, hipFuncAttributeMaxDynamicSharedMemorySize, LDS_BYTES);
        hipFuncSetAttribute((const void*)k_moe_down, hipFuncAttributeMaxDynamicSharedMemorySize, LDS_BYTES);
        hipFuncSetAttribute((const void*)k_combine, hipFuncAttributeMaxDynamicSharedMemorySize, LDS_BYTES);
        attr_done = true;
    }
    { P0Args a{x, w_in, w_out, router_w, xb, wt_in, wt_out, wt_r}; k_prologue<<<GRID, NTHR, LDS_BYTES, stream>>>(a); }
    { P1Args a{xb, wt_in, Q, Kb, Vt}; k_qkv<<<GRID, NTHR, LDS_BYTES, stream>>>(a); }
    { P2Args a{Q, Kb, Vt, rel_bias, gain_a, gain_b, yatt}; k_attn<<<GRID, NTHR, LDS_BYTES, stream>>>(a); }
    { P3Args a{yatt, wt_out, x, r, stats}; k_outproj<<<GRID, NTHR, LDS_BYTES, stream>>>(a); }
    { P4Args a{r, stats, ln1_g, ln1_b, X1, wt_r, router_bias, eidx, gate, counts, tokl, gatel, slot}; k_router<<<GRID, NTHR, LDS_BYTES, stream>>>(a); }
    { P6Args a{X1, counts, tokl, w_gate, w_up, ws_gate, ws_up, H}; k_moe_gu<<<GRID, NTHR, LDS_BYTES, stream>>>(a); }
    { P7Args a{H, counts, gatel, w_down, ws_down, Y}; k_moe_down<<<GRID, NTHR, LDS_BYTES, stream>>>(a); }
    { P8Args a{X1, Y, slot, counts, ln2_g, ln2_b, out}; k_combine<<<GRID, NTHR, LDS_BYTES, stream>>>(a); }
}
```

```cpp
#include <hip/hip_runtime.h>
#include <cstdint>
#include <cstdio>

typedef unsigned short bf16_t;

constexpr int D_MODEL = 1024, BATCH = 16, SEQ = 2048, T_TOK = BATCH * SEQ;
constexpr int HEAD_DIM = 64, NHA = 8, NHB = 8, NHH = 16;
constexpr int CHUNK = 64, LEFT_CHUNKS = 8, MAX_REL = 128;
constexpr int N_EXP = 256, TOP_K = 8, N_GROUPS = 8, TOPK_GROUPS = 4, EPG = 32, D_EXP = 256;
constexpr float ROUTED_SCALE = 2.5f, LN_EPS = 1e-5f, RMS_EPS = 1e-6f;
constexpr float DN_ALPHA = 1.189207115002721f;
constexpr float LOG2E = 1.4426950408889634f, LN2 = 0.6931471805599453f;
constexpr float QSCALE = 0.125f * LOG2E;
constexpr int CAP = T_TOK;
constexpr int ROWS_ALL = T_TOK * TOP_K + T_TOK;

__device__ __forceinline__ float bf2f(bf16_t v) { return __uint_as_float(((unsigned)v) << 16); }
__device__ __forceinline__ bf16_t f2bf(float f) { unsigned u = __float_as_uint(f); u += 0x7fffu + ((u >> 16) & 1u); return (bf16_t)(u >> 16); }

constexpr size_t MB = 1024ull * 1024ull;
constexpr size_t OFF_CTRL   = 0;
constexpr size_t OFF_X1     = 1 * MB;
constexpr size_t OFF_TOKL   = OFF_X1 + 64 * MB;
constexpr size_t OFF_GATEL  = OFF_TOKL + 32 * MB;
constexpr size_t OFF_EIDX   = OFF_GATEL + 32 * MB;
constexpr size_t OFF_GATE   = OFF_EIDX + 1 * MB;
constexpr size_t OFF_SLOT   = OFF_GATE + 1 * MB;
constexpr size_t OFF_H      = OFF_SLOT + 1 * MB;
constexpr size_t OFF_BIG    = OFF_H + 144 * MB;
constexpr size_t OFF_Y      = OFF_BIG;
constexpr size_t OFF_Q      = OFF_BIG;
constexpr size_t OFF_K      = OFF_BIG + 64 * MB;
constexpr size_t OFF_VT     = OFF_BIG + 128 * MB;
constexpr size_t OFF_YATT   = OFF_BIG + 192 * MB;
constexpr size_t OFF_R      = OFF_BIG + 256 * MB;
constexpr size_t OFF_YRAW   = OFF_BIG + 320 * MB;
constexpr size_t OFF_SCORES = OFF_BIG + 448 * MB;
constexpr size_t OFF_XB     = OFF_BIG + 480 * MB;
constexpr size_t OFF_STATS  = OFF_BIG + 544 * MB;
constexpr size_t OFF_WTIN   = OFF_BIG + 548 * MB;
constexpr size_t OFF_WTOUT  = OFF_BIG + 554 * MB;
constexpr size_t OFF_WTR    = OFF_BIG + 556 * MB;
constexpr int CW_COUNTS = 4096;
constexpr int CW_STARTS = 8192;

__device__ __forceinline__ float ldf(const float* p, size_t i) { return p[i]; }
__device__ __forceinline__ float ldf(const bf16_t* p, size_t i) { return bf2f(p[i]); }

template <class TA, class Epi>
__device__ __forceinline__ void naive_tile(const TA* A, const int* rows, int lda, const float* B, int ldb, int M, int K, int m0, int n0, const Epi& epi) {
    __shared__ float As[16][65], Bs[16][65];
    const int tx = threadIdx.x & 15, ty = threadIdx.x >> 4;
    float acc[4][4];
#pragma unroll
    for (int i = 0; i < 4; ++i)
#pragma unroll
        for (int j = 0; j < 4; ++j) acc[i][j] = 0.f;
    for (int k0 = 0; k0 < K; k0 += 16) {
#pragma unroll
        for (int i = 0; i < 4; ++i) {
            const int idx = threadIdx.x + i * 256, r = idx >> 4, c = idx & 15, row = m0 + r;
            float v = 0.f;
            if (row < M) { const int rr = rows ? rows[row] : row; v = ldf(A, (size_t)rr * lda + k0 + c); }
            As[c][r] = v;
        }
#pragma unroll
        for (int i = 0; i < 4; ++i) {
            const int idx = threadIdx.x + i * 256, kk = idx >> 6, c = idx & 63;
            Bs[kk][c] = B[(size_t)(k0 + kk) * ldb + n0 + c];
        }
        __syncthreads();
#pragma unroll
        for (int kk = 0; kk < 16; ++kk) {
            float a[4], b[4];
#pragma unroll
            for (int i = 0; i < 4; ++i) { a[i] = As[kk][ty * 4 + i]; b[i] = Bs[kk][tx * 4 + i]; }
#pragma unroll
            for (int i = 0; i < 4; ++i)
#pragma unroll
                for (int j = 0; j < 4; ++j) acc[i][j] += a[i] * b[j];
        }
        __syncthreads();
    }
#pragma unroll
    for (int i = 0; i < 4; ++i)
#pragma unroll
        for (int j = 0; j < 4; ++j) { const int row = m0 + ty * 4 + i; if (row < M) epi(row, n0 + tx * 4 + j, acc[i][j]); }
}

struct EpiQKV { bf16_t *Q, *Kb, *Vt;
    __device__ void operator()(int row, int n, float v) const {
        const int b = row / SEQ, s = row % SEQ, seg = n / 512, within = n % 512, head = within / 64, d = within % 64, type = seg % 3, grp = seg / 3, hh = grp * 8 + head;
        if (type == 0) Q[((size_t)(b * NHH + hh) * SEQ + s) * 64 + d] = f2bf(v * QSCALE);
        else if (type == 1) Kb[((size_t)(b * NHH + hh) * SEQ + s) * 64 + d] = f2bf(v);
        else Vt[((size_t)(b * NHH + hh) * 64 + d) * SEQ + s] = f2bf(v);
    } };
__global__ __launch_bounds__(256) void nk_qkv(const float* x, const float* w_in, bf16_t* Q, bf16_t* Kb, bf16_t* Vt) {
    EpiQKV e{Q, Kb, Vt};
    naive_tile<float>(x, nullptr, D_MODEL, w_in, 3072, T_TOK, D_MODEL, blockIdx.y * 64, blockIdx.x * 64, e);
}

__global__ __launch_bounds__(64) void nk_attn_a(const bf16_t* Q, const bf16_t* Kb, const bf16_t* Vt, const float* rel_bias, float* yraw) {
    const int gid = blockIdx.x;
    const int c = gid % (SEQ / CHUNK), h = (gid / (SEQ / CHUNK)) % NHA, b = gid / ((SEQ / CHUNK) * NHA);
    const int t = c * CHUNK + threadIdx.x;
    const bf16_t* qp = Q + ((size_t)(b * NHH + h) * SEQ + t) * 64;
    float q[64], o[64];
#pragma unroll
    for (int d = 0; d < 64; ++d) { q[d] = bf2f(qp[d]); o[d] = 0.f; }
    float m = -INFINITY, l = 0.f;
    const int s_lo = max(0, c * CHUNK - LEFT_CHUNKS * CHUNK), s_hi = c * CHUNK + CHUNK;
    const bf16_t* kbase = Kb + (size_t)(b * NHH + h) * SEQ * 64;
    const bf16_t* vbase = Vt + (size_t)(b * NHH + h) * 64 * SEQ;
    for (int s = s_lo; s < s_hi; ++s) {
        float sc = 0.f;
#pragma unroll
        for (int d = 0; d < 64; ++d) sc += q[d] * bf2f(kbase[(size_t)s * 64 + d]);
        int dist = t - s; dist = dist < -MAX_REL ? -MAX_REL : (dist > MAX_REL ? MAX_REL : dist);
        sc += rel_bias[h * (2 * MAX_REL + 1) + dist + MAX_REL] * LOG2E;
        const float mn = fmaxf(m, sc), corr = exp2f(m - mn), p = exp2f(sc - mn);
        l = l * corr + p; m = mn;
#pragma unroll
        for (int d = 0; d < 64; ++d) o[d] = o[d] * corr + p * bf2f(vbase[(size_t)d * SEQ + s]);
    }
    const float inv = 1.f / l;
    float* yp = yraw + (size_t)(b * SEQ + t) * D_MODEL + h * 64;
#pragma unroll
    for (int d = 0; d < 64; ++d) yp[d] = o[d] * inv;
}

__global__ __launch_bounds__(64) void nk_attn_b(const bf16_t* Q, const bf16_t* Kb, const bf16_t* Vt, float* yraw) {
    const int gid = blockIdx.x;
    const int c = gid % (SEQ / 64), h = (gid / (SEQ / 64)) % NHB, b = gid / ((SEQ / 64) * NHB);
    const int t = c * 64 + threadIdx.x, hh = NHA + h;
    const bf16_t* qp = Q + ((size_t)(b * NHH + hh) * SEQ + t) * 64;
    float q[64], o[64];
#pragma unroll
    for (int d = 0; d < 64; ++d) { q[d] = bf2f(qp[d]); o[d] = 0.f; }
    const bf16_t* kbase = Kb + (size_t)(b * NHH + hh) * SEQ * 64;
    const bf16_t* vbase = Vt + (size_t)(b * NHH + hh) * 64 * SEQ;
    float suffix = 0.f;
    for (int s = c * 64 + 62; s >= 0; --s) {
        float sc = 0.f;
#pragma unroll
        for (int d = 0; d < 64; ++d) sc += q[d] * bf2f(kbase[(size_t)s * 64 + d]);
        const float z = sc * LN2;
        const float sp_pos = fmaxf(z, 0.f) + log1pf(expf(-fabsf(z)));
        const float log_beta = z - sp_pos, log_1m = -sp_pos;
        if (s < t) {
            const float a = expf(log_beta + suffix);
            suffix += log_1m;
#pragma unroll
            for (int d = 0; d < 64; ++d) o[d] += a * bf2f(vbase[(size_t)d * SEQ + s]);
        }
    }
    float* yp = yraw + (size_t)(b * SEQ + t) * D_MODEL + 512 + h * 64;
#pragma unroll
    for (int d = 0; d < 64; ++d) yp[d] = o[d];
}

__global__ __launch_bounds__(256) void nk_rms(const float* yraw, const float* gain_a, const float* gain_b, bf16_t* y) {
    const int t = blockIdx.x * 4 + (threadIdx.x >> 6), lane = threadIdx.x & 63;
    const float* p = yraw + (size_t)t * D_MODEL;
#pragma unroll
    for (int g = 0; g < 2; ++g) {
        float v[8], ss = 0.f;
#pragma unroll
        for (int i = 0; i < 8; ++i) { v[i] = p[g * 512 + lane * 8 + i]; ss += v[i] * v[i]; }
#pragma unroll
        for (int o = 32; o >= 1; o >>= 1) ss += __shfl_xor(ss, o);
        const float rs = rsqrtf(ss * (1.f / 512.f) + RMS_EPS);
        const float* gn = g ? gain_b : gain_a;
#pragma unroll
        for (int i = 0; i < 8; ++i) y[(size_t)t * D_MODEL + g * 512 + lane * 8 + i] = f2bf(v[i] * rs * gn[lane * 8 + i]);
    }
}

struct EpiOut { const float* x; bf16_t* r;
    __device__ void operator()(int row, int n, float v) const { r[(size_t)row * D_MODEL + n] = f2bf(DN_ALPHA * x[(size_t)row * D_MODEL + n] + v); } };
__global__ __launch_bounds__(256) void nk_outproj(const bf16_t* y, const float* w_out, const float* x, bf16_t* r) {
    EpiOut e{x, r};
    naive_tile<bf16_t>(y, nullptr, D_MODEL, w_out, D_MODEL, T_TOK, D_MODEL, blockIdx.y * 64, blockIdx.x * 64, e);
}

__global__ __launch_bounds__(256) void nk_ln1(const bf16_t* r, const float* g, const float* bb, bf16_t* x1) {
    const int t = blockIdx.x * 4 + (threadIdx.x >> 6), lane = threadIdx.x & 63;
    float v[16], s = 0.f;
#pragma unroll
    for (int i = 0; i < 16; ++i) { v[i] = bf2f(r[(size_t)t * D_MODEL + lane * 16 + i]); s += v[i]; }
#pragma unroll
    for (int o = 32; o >= 1; o >>= 1) s += __shfl_xor(s, o);
    const float mu = s * (1.f / 1024.f);
    float q = 0.f;
#pragma unroll
    for (int i = 0; i < 16; ++i) { const float d = v[i] - mu; q += d * d; }
#pragma unroll
    for (int o = 32; o >= 1; o >>= 1) q += __shfl_xor(q, o);
    const float rstd = rsqrtf(q * (1.f / 1024.f) + LN_EPS);
#pragma unroll
    for (int i = 0; i < 16; ++i) { const int c = lane * 16 + i; x1[(size_t)t * D_MODEL + c] = f2bf((v[i] - mu) * rstd * g[c] + bb[c]); }
}

struct EpiRouter { float* scores;
    __device__ void operator()(int row, int n, float v) const { scores[(size_t)row * N_EXP + n] = 1.f / (1.f + expf(-v)); } };
__global__ __launch_bounds__(256) void nk_router(const bf16_t* x1, const float* rw, float* scores) {
    EpiRouter e{scores};
    naive_tile<bf16_t>(x1, nullptr, D_MODEL, rw, N_EXP, T_TOK, D_MODEL, blockIdx.y * 64, blockIdx.x * 64, e);
}

__global__ __launch_bounds__(256) void nk_topk(const float* scores, const float* rbias, int* eidx, float* gate) {
    const int t = blockIdx.x * 256 + threadIdx.x;
    const float* sc = scores + (size_t)t * N_EXP;
    float gs[N_GROUPS];
#pragma unroll
    for (int g = 0; g < N_GROUPS; ++g) {
        float m1 = -INFINITY, m2 = -INFINITY;
        for (int i = 0; i < EPG; ++i) { const float v = sc[g * EPG + i] + rbias[g * EPG + i]; if (v > m1) { m2 = m1; m1 = v; } else if (v > m2) m2 = v; }
        gs[g] = m1 + m2;
    }
    unsigned gmask = 0;
#pragma unroll
    for (int r = 0; r < TOPK_GROUPS; ++r) {
        float best = -INFINITY; int bi = 0;
#pragma unroll
        for (int g = 0; g < N_GROUPS; ++g) { const bool ok = !((gmask >> g) & 1u) && gs[g] > best; if (ok) { best = gs[g]; bi = g; } }
        gmask |= 1u << bi;
    }
    float pv = INFINITY; int pi = -1; float gsum = 0.f; float gv[TOP_K]; int gi[TOP_K];
#pragma unroll
    for (int r = 0; r < TOP_K; ++r) {
        float best = -INFINITY; int bi = 0;
        for (int e = 0; e < N_EXP; ++e) {
            if (!((gmask >> (e / EPG)) & 1u)) continue;
            const float v = sc[e] + rbias[e];
            const bool after = (v < pv) || (v == pv && e > pi);
            if (after && v > best) { best = v; bi = e; }
        }
        pv = best; pi = bi; gi[r] = bi; gv[r] = sc[bi]; gsum += gv[r];
    }
#pragma unroll
    for (int r = 0; r < TOP_K; ++r) { eidx[t * TOP_K + r] = gi[r]; gate[t * TOP_K + r] = gv[r] / gsum * ROUTED_SCALE; }
}

__global__ __launch_bounds__(256) void nk_dispatch(const int* eidx, const float* gate, int* counts, int* tokl, float* gatel, int* slot) {
    const int i = blockIdx.x * 256 + threadIdx.x;
    const int e = eidx[i], pos = atomicAdd(&counts[e], 1);
    tokl[(size_t)e * CAP + pos] = i / TOP_K; gatel[(size_t)e * CAP + pos] = gate[i]; slot[i] = e * CAP + pos;
}
__global__ void nk_prefix(const int* counts, int* starts) {
    if (threadIdx.x == 0) { int s = 0; for (int e = 0; e < N_EXP; ++e) { starts[e] = s; s += counts[e]; } starts[N_EXP] = s; starts[N_EXP + 1] = s + T_TOK; }
}

__global__ __launch_bounds__(256) void nk_moe_gu(const bf16_t* x1, const int* tokl, const int* counts, const int* starts,
                                                const float* w_gate, const float* w_up, const float* ws_gate, const float* ws_up, bf16_t* H) {
    __shared__ float As[16][65], Bg[16][65], Bu[16][65];
    const int e = blockIdx.y, n0 = blockIdx.x * 64;
    const int cnt = e < N_EXP ? counts[e] : T_TOK, st = starts[e];
    const float* wg = e < N_EXP ? w_gate + (size_t)e * D_MODEL * D_EXP : ws_gate;
    const float* wu = e < N_EXP ? w_up + (size_t)e * D_MODEL * D_EXP : ws_up;
    const int* rows = e < N_EXP ? tokl + (size_t)e * CAP : nullptr;
    const int tx = threadIdx.x & 15, ty = threadIdx.x >> 4;
    for (int m0 = blockIdx.z * 64; m0 < cnt; m0 += gridDim.z * 64) {
        float ag[4][4], au[4][4];
#pragma unroll
        for (int i = 0; i < 4; ++i)
#pragma unroll
            for (int j = 0; j < 4; ++j) { ag[i][j] = 0.f; au[i][j] = 0.f; }
        for (int k0 = 0; k0 < D_MODEL; k0 += 16) {
#pragma unroll
            for (int i = 0; i < 4; ++i) {
                const int idx = threadIdx.x + i * 256, r = idx >> 4, c = idx & 15, row = m0 + r;
                float v = 0.f;
                if (row < cnt) { const int rr = rows ? rows[row] : row; v = bf2f(x1[(size_t)rr * D_MODEL + k0 + c]); }
                As[c][r] = v;
            }
#pragma unroll
            for (int i = 0; i < 4; ++i) {
                const int idx = threadIdx.x + i * 256, kk = idx >> 6, c = idx & 63;
                Bg[kk][c] = wg[(size_t)(k0 + kk) * D_EXP + n0 + c]; Bu[kk][c] = wu[(size_t)(k0 + kk) * D_EXP + n0 + c];
            }
            __syncthreads();
#pragma unroll
            for (int kk = 0; kk < 16; ++kk) {
                float a[4], bg[4], bu[4];
#pragma unroll
                for (int i = 0; i < 4; ++i) { a[i] = As[kk][ty * 4 + i]; bg[i] = Bg[kk][tx * 4 + i]; bu[i] = Bu[kk][tx * 4 + i]; }
#pragma unroll
                for (int i = 0; i < 4; ++i)
#pragma unroll
                    for (int j = 0; j < 4; ++j) { ag[i][j] += a[i] * bg[j]; au[i][j] += a[i] * bu[j]; }
            }
            __syncthreads();
        }
#pragma unroll
        for (int i = 0; i < 4; ++i)
#pragma unroll
            for (int j = 0; j < 4; ++j) { const int row = m0 + ty * 4 + i;
                if (row < cnt) { const float g = ag[i][j]; H[(size_t)(st + row) * D_EXP + n0 + tx * 4 + j] = f2bf(g / (1.f + expf(-g)) * au[i][j]); } }
    }
}

struct EpiDown { bf16_t* Y; const float* gl; int st;
    __device__ void operator()(int row, int n, float v) const { Y[(size_t)(st + row) * D_MODEL + n] = f2bf(gl ? v * gl[row] : v); } };
__global__ __launch_bounds__(256) void nk_moe_down(const bf16_t* H, const int* counts, const int* starts, const float* gatel,
                                                  const float* w_down, const float* ws_down, bf16_t* Y) {
    const int e = blockIdx.y, n0 = blockIdx.x * 64;
    const int cnt = e < N_EXP ? counts[e] : T_TOK, st = starts[e];
    const float* wd = e < N_EXP ? w_down + (size_t)e * D_EXP * D_MODEL : ws_down;
    EpiDown ep{Y, e < N_EXP ? gatel + (size_t)e * CAP : nullptr, st};
    for (int m0 = blockIdx.z * 64; m0 < cnt; m0 += gridDim.z * 64)
        naive_tile<bf16_t>(H + (size_t)st * D_EXP, nullptr, D_EXP, wd, D_MODEL, cnt, D_EXP, m0, n0, ep);
}

__global__ __launch_bounds__(256) void nk_combine(const bf16_t* x1, const bf16_t* Y, const int* slot, const int* starts, const float* g, const float* bb, float* out) {
    const int t = blockIdx.x * 4 + (threadIdx.x >> 6), lane = threadIdx.x & 63;
    float v[16];
#pragma unroll
    for (int i = 0; i < 16; ++i) v[i] = DN_ALPHA * bf2f(x1[(size_t)t * D_MODEL + lane * 16 + i]) + bf2f(Y[(size_t)(starts[N_EXP] + t) * D_MODEL + lane * 16 + i]);
    for (int k = 0; k < TOP_K; ++k) {
        const int sl = slot[t * TOP_K + k], e = sl / CAP, pos = sl % CAP; const size_t row = (size_t)starts[e] + pos;
#pragma unroll
        for (int i = 0; i < 16; ++i) v[i] += bf2f(Y[row * D_MODEL + lane * 16 + i]);
    }
    float s = 0.f;
#pragma unroll
    for (int i = 0; i < 16; ++i) s += v[i];
#pragma unroll
    for (int o = 32; o >= 1; o >>= 1) s += __shfl_xor(s, o);
    const float mu = s * (1.f / 1024.f);
    float q = 0.f;
#pragma unroll
    for (int i = 0; i < 16; ++i) { const float d = v[i] - mu; q += d * d; }
#pragma unroll
    for (int o = 32; o >= 1; o >>= 1) q += __shfl_xor(q, o);
    const float rstd = rsqrtf(q * (1.f / 1024.f) + LN_EPS);
#pragma unroll
    for (int i = 0; i < 16; ++i) { const int c = lane * 16 + i; out[(size_t)t * D_MODEL + c] = (v[i] - mu) * rstd * g[c] + bb[c]; }
}


typedef short bf16x8 __attribute__((ext_vector_type(8)));
typedef float f32x4 __attribute__((ext_vector_type(4)));
typedef float f32x2 __attribute__((ext_vector_type(2)));
typedef float f32x16 __attribute__((ext_vector_type(16)));
typedef unsigned u32x4 __attribute__((ext_vector_type(4)));
typedef unsigned u32x2 __attribute__((ext_vector_type(2)));
#define DI __device__ __forceinline__
constexpr int NTHR = 512, GRID = 256;
constexpr int LDS_BYTES = 147456;

typedef __bf16 bf16x2_t __attribute__((ext_vector_type(2)));
DI unsigned cvt_pk_bf16(float lo, float hi) { f32x2 v = {lo, hi}; bf16x2_t r = __builtin_convertvector(v, bf16x2_t); return __builtin_bit_cast(unsigned, r); }
DI int vblock() { return (int)((blockIdx.x & 7) * (GRID / 8) + (blockIdx.x >> 3)); }

template <int MT> struct Tile { static constexpr int BM = 32 * MT, A_BYTES = BM * 128, B_BYTES = 256 * 128, STAGE = A_BYTES + B_BYTES; };

template <int MT> struct ALoader {
    const bf16_t* p[MT / 2]; u32x4 v[MT / 2]; int off0;
    DI void init_rows(const bf16_t* A, int lda, int row0) {
        const int tid = threadIdx.x, kc = tid & 7, r = tid >> 3;
#pragma unroll
        for (int i = 0; i < MT / 2; ++i) p[i] = A + (size_t)(row0 + r + 64 * i) * lda + kc * 8;
        off0 = r * 128 + ((kc ^ ((r >> 1) & 7)) << 4);
    }
    DI void init_gather(const bf16_t* A, int lda, const int* rows, int cnt, int m0) {
        const int tid = threadIdx.x, kc = tid & 7, r = tid >> 3;
#pragma unroll
        for (int i = 0; i < MT / 2; ++i) { int rr = m0 + r + 64 * i; rr = rr < cnt ? rr : cnt - 1; const int g = rows ? rows[rr] : rr; p[i] = A + (size_t)g * lda + kc * 8; }
        off0 = r * 128 + ((kc ^ ((r >> 1) & 7)) << 4);
    }
    DI void load(int k0) {
#pragma unroll
        for (int i = 0; i < MT / 2; ++i) v[i] = *(const u32x4*)(p[i] + k0);
    }
    DI void store(char* ldsA) const {
#pragma unroll
        for (int i = 0; i < MT / 2; ++i) *(u32x4*)(ldsA + off0 + i * 8192) = v[i];
    }
};
struct BLoaderBt {
    const bf16_t* p[4]; u32x4 v[4]; int off0;
    DI void init(const bf16_t* Bt, int ldk, int n0) {
        const int tid = threadIdx.x, kc = tid & 7, r = tid >> 3;
#pragma unroll
        for (int i = 0; i < 4; ++i) p[i] = Bt + (size_t)(n0 + r + 64 * i) * ldk + kc * 8;
        off0 = r * 128 + ((kc ^ ((r >> 1) & 7)) << 4);
    }
    DI void load(int k0) {
#pragma unroll
        for (int i = 0; i < 4; ++i) v[i] = *(const u32x4*)(p[i] + k0);
    }
    DI void store(char* ldsB) const {
#pragma unroll
        for (int i = 0; i < 4; ++i) *(u32x4*)(ldsB + off0 + i * 8192) = v[i];
    }
};
template <bool GU> struct BLoaderF32 {
    const float* p[2]; int ldb; f32x2 v[2][8]; int off[2][2];
    DI void init(const float* P0, const float* P1, int ldb_) {
        const int tid = threadIdx.x, l = tid & 63, w = tid >> 6; ldb = ldb_;
        p[0] = P0 + (size_t)(8 * w) * ldb + 2 * l; p[1] = P1 + (size_t)(8 * w) * ldb + 2 * l;
#pragma unroll
        for (int jp = 0; jp < 2; ++jp)
#pragma unroll
            for (int jj = 0; jj < 2; ++jj) { const int c = 2 * l + jj; const int row = GU ? (64 * (c >> 5) + 32 * jp + (c & 31)) : (128 * jp + c); off[jp][jj] = row * 128 + ((w ^ ((row >> 1) & 7)) << 4); }
    }
    DI void load(int k0) {
#pragma unroll
        for (int jp = 0; jp < 2; ++jp)
#pragma unroll
            for (int kk = 0; kk < 8; ++kk) v[jp][kk] = *(const f32x2*)(p[jp] + (size_t)(k0 + kk) * ldb);
    }
    DI void store(char* ldsB) const {
#pragma unroll
        for (int jp = 0; jp < 2; ++jp) {
            u32x4 a, b;
            a.x = cvt_pk_bf16(v[jp][0].x, v[jp][1].x); a.y = cvt_pk_bf16(v[jp][2].x, v[jp][3].x); a.z = cvt_pk_bf16(v[jp][4].x, v[jp][5].x); a.w = cvt_pk_bf16(v[jp][6].x, v[jp][7].x);
            b.x = cvt_pk_bf16(v[jp][0].y, v[jp][1].y); b.y = cvt_pk_bf16(v[jp][2].y, v[jp][3].y); b.z = cvt_pk_bf16(v[jp][4].y, v[jp][5].y); b.w = cvt_pk_bf16(v[jp][6].y, v[jp][7].y);
            *(u32x4*)(ldsB + off[jp][0]) = a; *(u32x4*)(ldsB + off[jp][1]) = b;
        }
    }
};

template <int MT, bool TR, class AL, class BL>
DI void gemm_tile(char* lds, AL& al, BL& bl, int nk, f32x4 (&acc)[MT][4]) {
    typedef Tile<MT> TT;
    const int tid = threadIdx.x, wid = tid >> 6, lane = tid & 63, wr = wid >> 2, wc = wid & 3, fr = lane & 15, fq = lane >> 4;
#pragma unroll
    for (int m = 0; m < MT; ++m)
#pragma unroll
        for (int n = 0; n < 4; ++n) acc[m][n] = (f32x4){0.f, 0.f, 0.f, 0.f};
    int aoff[2], boff[2];
#pragma unroll
    for (int ks = 0; ks < 2; ++ks) { const int ch = (((4 * ks + fq) ^ (fr >> 1)) << 4); aoff[ks] = (16 * MT * wr + fr) * 128 + ch; boff[ks] = TT::A_BYTES + (64 * wc + fr) * 128 + ch; }
    al.load(0); bl.load(0);
    __syncthreads();
    al.store(lds); bl.store(lds + TT::A_BYTES);
    __syncthreads();
    for (int kt = 0; kt < nk; ++kt) {
        char* cur = lds + (kt & 1) * TT::STAGE; char* nxt = lds + ((kt & 1) ^ 1) * TT::STAGE;
        const bool more = kt + 1 < nk;
        if (more) { al.load((kt + 1) * 64); bl.load((kt + 1) * 64); }
#pragma unroll
        for (int ks = 0; ks < 2; ++ks) {
            bf16x8 a[MT], b[4];
#pragma unroll
            for (int m = 0; m < MT; ++m) a[m] = *(const bf16x8*)(cur + aoff[ks] + m * 2048);
#pragma unroll
            for (int n = 0; n < 4; ++n) b[n] = *(const bf16x8*)(cur + boff[ks] + n * 2048);
#pragma unroll
            for (int m = 0; m < MT; ++m)
#pragma unroll
                for (int n = 0; n < 4; ++n)
                    acc[m][n] = TR ? __builtin_amdgcn_mfma_f32_16x16x32_bf16(b[n], a[m], acc[m][n], 0, 0, 0) : __builtin_amdgcn_mfma_f32_16x16x32_bf16(a[m], b[n], acc[m][n], 0, 0, 0);
        }
        if (more) { al.store(nxt); bl.store(nxt + TT::A_BYTES); }
        __syncthreads();
    }
}

DI void transpose_cvt(const float* W, bf16_t* Wt, int K, int N, int unit, char* lds) {
    float* tile = (float*)lds;
    const int nbn = N / 64, kb = unit / nbn, nb = unit % nbn, tid = threadIdx.x;
    __syncthreads();
#pragma unroll
    for (int i = 0; i < 8; ++i) { const int idx = tid + i * 512, r = idx >> 6, c = idx & 63; tile[r * 65 + c] = W[(size_t)(kb * 64 + r) * N + nb * 64 + c]; }
    __syncthreads();
#pragma unroll
    for (int i = 0; i < 8; ++i) { const int idx = tid + i * 512, n = idx >> 6, k = idx & 63; Wt[(size_t)(nb * 64 + n) * K + kb * 64 + k] = f2bf(tile[k * 65 + n]); }
}
struct P0Args { const float* x; const float* w_in; const float* w_out; const float* router_w; bf16_t* xb; bf16_t* wt_in; bf16_t* wt_out; bf16_t* wt_r; };
DI void phase_prologue(const P0Args& a, char* lds) {
    const int vb = vblock();
    for (size_t i = (size_t)vb * NTHR + threadIdx.x; i < (size_t)T_TOK * D_MODEL / 8; i += (size_t)GRID * NTHR) {
        const f32x4 v0 = *(const f32x4*)(a.x + i * 8), v1 = *(const f32x4*)(a.x + i * 8 + 4);
        u32x4 o; o.x = cvt_pk_bf16(v0[0], v0[1]); o.y = cvt_pk_bf16(v0[2], v0[3]); o.z = cvt_pk_bf16(v1[0], v1[1]); o.w = cvt_pk_bf16(v1[2], v1[3]);
        *(u32x4*)(a.xb + i * 8) = o;
    }
    const int n_in = (1024 / 64) * (3072 / 64), n_out = 16 * 16, n_r = 16 * 4;
    for (int u = vb; u < n_in + n_out + n_r; u += GRID) {
        if (u < n_in) transpose_cvt(a.w_in, a.wt_in, 1024, 3072, u, lds);
        else if (u < n_in + n_out) transpose_cvt(a.w_out, a.wt_out, 1024, 1024, u - n_in, lds);
        else transpose_cvt(a.router_w, a.wt_r, 1024, 256, u - n_in - n_out, lds);
    }
}

struct P1Args { const bf16_t* xb; const bf16_t* wt_in; bf16_t* Q; bf16_t* Kb; bf16_t* Vt; };
DI void phase_qkv(const P1Args& a, char* lds) {
    const int tid = threadIdx.x, wid = tid >> 6, lane = tid & 63, wr = wid >> 2, wc = wid & 3, fr = lane & 15, fq = lane >> 4;
    for (int u = vblock(); u < (T_TOK / 128) * 12; u += GRID) {
        const int panel = u / 12, ct = u % 12, m0 = panel * 128, n0 = ct * 256;
        const int seg = ct >> 1, type = seg % 3, grp = seg / 3, hh = grp * 8 + 4 * (ct & 1) + wc;
        const int b = m0 / SEQ, s0 = m0 % SEQ;
        ALoader<4> al; al.init_rows(a.xb, D_MODEL, m0);
        BLoaderBt bl; bl.init(a.wt_in, D_MODEL, n0);
        f32x4 acc[4][4];
        if (type == 2) {
            gemm_tile<4, false>(lds, al, bl, D_MODEL / 64, acc);
#pragma unroll
            for (int m = 0; m < 4; ++m)
#pragma unroll
                for (int n = 0; n < 4; ++n) {
                    const int s = s0 + 64 * wr + 16 * m + 4 * fq, d = 16 * n + fr;
                    u32x2 o; o.x = cvt_pk_bf16(acc[m][n][0], acc[m][n][1]); o.y = cvt_pk_bf16(acc[m][n][2], acc[m][n][3]);
                    *(u32x2*)(a.Vt + ((size_t)(b * NHH + hh) * 64 + d) * SEQ + s) = o;
                }
        } else {
            gemm_tile<4, true>(lds, al, bl, D_MODEL / 64, acc);
            bf16_t* dst = type == 0 ? a.Q : a.Kb; const float sc = type == 0 ? QSCALE : 1.f;
#pragma unroll
            for (int m = 0; m < 4; ++m)
#pragma unroll
                for (int n = 0; n < 4; ++n) {
                    const int s = s0 + 64 * wr + 16 * m + fr, d = 16 * n + 4 * fq;
                    u32x2 o; o.x = cvt_pk_bf16(acc[m][n][0] * sc, acc[m][n][1] * sc); o.y = cvt_pk_bf16(acc[m][n][2] * sc, acc[m][n][3] * sc);
                    *(u32x2*)(dst + ((size_t)(b * NHH + hh) * SEQ + s) * 64 + d) = o;
                }
        }
    }
}

struct P3Args { const bf16_t* y; const bf16_t* wt_out; const float* x; bf16_t* r; float* stats; };
DI void phase_outproj(const P3Args& a, char* lds) {
    const int tid = threadIdx.x, wid = tid >> 6, lane = tid & 63, wr = wid >> 2, wc = wid & 3, fr = lane & 15, fq = lane >> 4;
    for (int u = vblock(); u < (T_TOK / 128) * 4; u += GRID) {
        const int panel = u / 4, ct = u % 4, m0 = panel * 128, n0 = ct * 256;
        ALoader<4> al; al.init_rows(a.y, D_MODEL, m0);
        BLoaderBt bl; bl.init(a.wt_out, D_MODEL, n0);
        f32x4 acc[4][4];
        gemm_tile<4, true>(lds, al, bl, D_MODEL / 64, acc);
#pragma unroll
        for (int m = 0; m < 4; ++m) {
            const int row = m0 + 64 * wr + 16 * m + fr; float s = 0.f, q = 0.f;
#pragma unroll
            for (int n = 0; n < 4; ++n) {
                const int col = n0 + 64 * wc + 16 * n + 4 * fq;
                const f32x4 xv = *(const f32x4*)(a.x + (size_t)row * D_MODEL + col);
                const f32x4 v = xv * DN_ALPHA + acc[m][n];
                s += (v[0] + v[1]) + (v[2] + v[3]); q += (v[0] * v[0] + v[1] * v[1]) + (v[2] * v[2] + v[3] * v[3]);
                u32x2 o; o.x = cvt_pk_bf16(v[0], v[1]); o.y = cvt_pk_bf16(v[2], v[3]);
                *(u32x2*)(a.r + (size_t)row * D_MODEL + col) = o;
            }
            s += __shfl_xor(s, 16); s += __shfl_xor(s, 32); q += __shfl_xor(q, 16); q += __shfl_xor(q, 32);
            if (fq == 0) *(f32x2*)(a.stats + ((size_t)row * 16 + ct * 4 + wc) * 2) = (f32x2){s, q};
        }
    }
}
__global__ __launch_bounds__(256) void k_ln1_stats(const bf16_t* r, const float* stats, const float* g, const float* bb, bf16_t* x1) {
    const int t = blockIdx.x * 4 + (threadIdx.x >> 6), lane = threadIdx.x & 63;
    float s = 0.f, q = 0.f;
#pragma unroll
    for (int i = 0; i < 16; ++i) { s += stats[((size_t)t * 16 + i) * 2]; q += stats[((size_t)t * 16 + i) * 2 + 1]; }
    const float mu = s * (1.f / 1024.f), var = q * (1.f / 1024.f) - mu * mu, rstd = rsqrtf(var + LN_EPS);
#pragma unroll
    for (int i = 0; i < 16; ++i) { const int c = lane * 16 + i; x1[(size_t)t * D_MODEL + c] = f2bf((bf2f(r[(size_t)t * D_MODEL + c]) - mu) * rstd * g[c] + bb[c]); }
}


constexpr int RS_SC = 289;
constexpr int LDS_HIST = 100 * 1024;
struct P4Args { const bf16_t* r; const float* stats; const float* ln_g; const float* ln_b; bf16_t* x1; const bf16_t* wt_r; const float* rbias;
                int* eidx; float* gate; int* counts; int* tokl; float* gatel; int* slot; };
DI void phase_router(const P4Args& a, char* lds) {
    const int tid = threadIdx.x, wid = tid >> 6, lane = tid & 63, wr = wid >> 2, wc = wid & 3, fr = lane & 15, fq = lane >> 4;
    float* sc = (float*)lds; int* hist = (int*)(lds + LDS_HIST); int* base = hist + 256;
    for (int u = vblock(); u < T_TOK / 128; u += GRID) {
        const int m0 = u * 128;
        for (int i = 0; i < 16; ++i) {
            const int t = m0 + wid * 16 + i;
            f32x2 st = (f32x2){0.f, 0.f};
            if (lane < 16) st = *(const f32x2*)(a.stats + ((size_t)t * 16 + lane) * 2);
            float s = st.x, q = st.y;
#pragma unroll
            for (int o = 1; o <= 8; o <<= 1) { s += __shfl_xor(s, o); q += __shfl_xor(q, o); }
            s = __shfl(s, 0); q = __shfl(q, 0);
            const float mu = s * (1.f / 1024.f), rstd = rsqrtf(q * (1.f / 1024.f) - mu * mu + LN_EPS);
            const u32x4 r0 = *(const u32x4*)(a.r + (size_t)t * D_MODEL + lane * 16), r1 = *(const u32x4*)(a.r + (size_t)t * D_MODEL + lane * 16 + 8);
            float v[16];
#pragma unroll
            for (int j = 0; j < 4; ++j) { v[2 * j] = __uint_as_float(r0[j] << 16); v[2 * j + 1] = __uint_as_float(r0[j] & 0xffff0000u); v[8 + 2 * j] = __uint_as_float(r1[j] << 16); v[8 + 2 * j + 1] = __uint_as_float(r1[j] & 0xffff0000u); }
            u32x4 o0, o1;
#pragma unroll
            for (int j = 0; j < 4; ++j) {
                const f32x4 g = *(const f32x4*)(a.ln_g + lane * 16 + 4 * j), bb = *(const f32x4*)(a.ln_b + lane * 16 + 4 * j);
                const float y0 = (v[4 * j] - mu) * rstd * g[0] + bb[0], y1 = (v[4 * j + 1] - mu) * rstd * g[1] + bb[1], y2 = (v[4 * j + 2] - mu) * rstd * g[2] + bb[2], y3 = (v[4 * j + 3] - mu) * rstd * g[3] + bb[3];
                const unsigned p0 = cvt_pk_bf16(y0, y1), p1 = cvt_pk_bf16(y2, y3);
                if (j < 2) { o0[2 * j] = p0; o0[2 * j + 1] = p1; } else { o1[2 * (j - 2)] = p0; o1[2 * (j - 2) + 1] = p1; }
            }
            *(u32x4*)(a.x1 + (size_t)t * D_MODEL + lane * 16) = o0; *(u32x4*)(a.x1 + (size_t)t * D_MODEL + lane * 16 + 8) = o1;
        }
        if (tid < 256) hist[tid] = 0;
        asm volatile("s_waitcnt vmcnt(0)" ::: "memory");
        __syncthreads();
        ALoader<4> al; al.init_rows(a.x1, D_MODEL, m0);
        BLoaderBt bl; bl.init(a.wt_r, D_MODEL, 0);
        f32x4 acc[4][4];
        gemm_tile<4, true>(lds, al, bl, D_MODEL / 64, acc);
        int my_idx[2], my_rank[2]; float my_gate[2];
#pragma unroll
        for (int p = 0; p < 2; ++p) {
            __syncthreads();
            if (wr == p) {
#pragma unroll
                for (int m = 0; m < 4; ++m)
#pragma unroll
                    for (int n = 0; n < 4; ++n) {
                        const int c0 = 64 * wc + 16 * n + 4 * fq; const f32x4 rb = *(const f32x4*)(a.rbias + c0);
#pragma unroll
                        for (int j = 0; j < 4; ++j) { const int c = c0 + j; sc[(16 * m + fr) * RS_SC + (c >> 5) * 36 + (c & 31)] = 1.f / (1.f + __expf(-acc[m][n][j])) + rb[j]; }
                    }
            }
            __syncthreads();
            const int row = tid >> 3, g = tid & 7, t = m0 + 64 * p + row;
            float sel[32];
#pragma unroll
            for (int i = 0; i < 32; ++i) sel[i] = sc[row * RS_SC + g * 36 + i];
            float m1 = -INFINITY, m2 = -INFINITY;
#pragma unroll
            for (int i = 0; i < 32; ++i) { const float v = sel[i]; m2 = fmaxf(m2, fminf(m1, v)); m1 = fmaxf(m1, v); }
            const float gs = m1 + m2; int rank = 0;
#pragma unroll
            for (int d = 1; d < 8; ++d) { const float o = __shfl_xor(gs, d); const int og = g ^ d; rank += (o > gs || (o == gs && og < g)) ? 1 : 0; }
            const bool en = rank < TOPK_GROUPS;
            float pv = INFINITY; int pi = -1; float myv = 0.f; int myi = 0;
#pragma unroll
            for (int k = 0; k < TOP_K; ++k) {
                float bv = -INFINITY; int bi = 1 << 20;
                if (en) {
#pragma unroll
                    for (int i = 0; i < 32; ++i) { const float v = sel[i]; const int e = g * 32 + i; const bool after = (v < pv) || (v == pv && e > pi); if (after && v > bv) { bv = v; bi = e; } }
                }
#pragma unroll
                for (int d = 1; d < 8; d <<= 1) { const float ov = __shfl_xor(bv, d); const int oi = __shfl_xor(bi, d); if (ov > bv || (ov == bv && oi < bi)) { bv = ov; bi = oi; } }
                pv = bv; pi = bi;
                if (g == k) { myv = bv; myi = bi; }
            }
            const float score = myv - a.rbias[myi];
            float gsum = score;
#pragma unroll
            for (int d = 1; d < 8; d <<= 1) gsum += __shfl_xor(gsum, d);
            const float gt = score / gsum * ROUTED_SCALE;
            a.eidx[t * TOP_K + g] = myi; a.gate[t * TOP_K + g] = gt;
            my_idx[p] = myi; my_gate[p] = gt; my_rank[p] = atomicAdd(&hist[myi], 1);
        }
        __syncthreads();
        if (tid < 256) { const int h = hist[tid]; base[tid] = h > 0 ? atomicAdd(&a.counts[tid], h) : 0; }
        __syncthreads();
#pragma unroll
        for (int p = 0; p < 2; ++p) {
            const int row = tid >> 3, g = tid & 7, t = m0 + 64 * p + row, e = my_idx[p], pos = base[e] + my_rank[p];
            a.tokl[(size_t)e * CAP + pos] = t; a.gatel[(size_t)e * CAP + pos] = my_gate[p]; a.slot[t * TOP_K + g] = e * CAP + pos;
        }
    }
}

constexpr int LDS_TAB = 120 * 1024;
template <int BM> DI void build_moe_tab(const int* counts, char* lds) {
    int* tstart = (int*)(lds + LDS_TAB); int* rstart = tstart + 264;
    const int tid = threadIdx.x, lane = tid & 63;
    __syncthreads();
    if (tid < 64) {
        int c[4], tl[4], cs = 0, ts = 0;
#pragma unroll
        for (int i = 0; i < 4; ++i) { c[i] = counts[lane * 4 + i]; tl[i] = (c[i] + BM - 1) / BM; cs += c[i]; ts += tl[i]; }
        int ci = cs, ti = ts;
#pragma unroll
        for (int o = 1; o < 64; o <<= 1) { const int n1 = __shfl_up(ci, o), n2 = __shfl_up(ti, o); if (lane >= o) { ci += n1; ti += n2; } }
        int ce = ci - cs, te = ti - ts;
#pragma unroll
        for (int i = 0; i < 4; ++i) { rstart[lane * 4 + i] = ce; tstart[lane * 4 + i] = te; ce += c[i]; te += tl[i]; }
        if (lane == 63) { rstart[256] = ce; tstart[256] = te; rstart[257] = ce + T_TOK; tstart[257] = te + T_TOK / BM; }
    }
    __syncthreads();
}
DI int find_expert(const int* tstart, int g) {
    int lo = 0, hi = 256;
#pragma unroll 1
    while (lo < hi) { const int mid = (lo + hi + 1) >> 1; if (tstart[mid] <= g) lo = mid; else hi = mid - 1; }
    return lo;
}

struct P6Args { const bf16_t* x1; const int* counts; const int* tokl; const float* w_gate; const float* w_up; const float* ws_gate; const float* ws_up; bf16_t* H; };
DI void phase_moe_gu(const P6Args& a, char* lds) {
    const int tid = threadIdx.x, wid = tid >> 6, lane = tid & 63, wr = wid >> 2, wc = wid & 3, fr = lane & 15, fq = lane >> 4;
    build_moe_tab<128>(a.counts, lds);
    const int* tstart = (const int*)(lds + LDS_TAB); const int* rstart = tstart + 264;
    const int nunits = tstart[257] * 2;
    for (int u = vblock(); u < nunits; u += GRID) {
        const int g = u >> 1, j = u & 1, e = find_expert(tstart, g), m0 = (g - tstart[e]) * 128, st = rstart[e];
        const int cnt = e < N_EXP ? a.counts[e] : T_TOK;
        const float* wg = (e < N_EXP ? a.w_gate + (size_t)e * D_MODEL * D_EXP : a.ws_gate) + 128 * j;
        const float* wu = (e < N_EXP ? a.w_up + (size_t)e * D_MODEL * D_EXP : a.ws_up) + 128 * j;
        ALoader<4> al; al.init_gather(a.x1, D_MODEL, e < N_EXP ? a.tokl + (size_t)e * CAP : nullptr, cnt, m0);
        BLoaderF32<true> bl; bl.init(wg, wu, D_EXP);
        f32x4 acc[4][4];
        gemm_tile<4, true>(lds, al, bl, D_MODEL / 64, acc);
#pragma unroll
        for (int m = 0; m < 4; ++m) {
            const int row = m0 + 64 * wr + 16 * m + fr;
            if (row < cnt) {
#pragma unroll
                for (int n = 0; n < 2; ++n) {
                    float h[4];
#pragma unroll
                    for (int jj = 0; jj < 4; ++jj) { const float gv = acc[m][n][jj]; h[jj] = gv / (1.f + __expf(-gv)) * acc[m][n + 2][jj]; }
                    u32x2 o; o.x = cvt_pk_bf16(h[0], h[1]); o.y = cvt_pk_bf16(h[2], h[3]);
                    *(u32x2*)(a.H + (size_t)(st + row) * D_EXP + 128 * j + 32 * wc + 16 * n + 4 * fq) = o;
                }
            }
        }
    }
}
struct P7Args { const bf16_t* H; const int* counts; const float* gatel; const float* w_down; const float* ws_down; bf16_t* Y; };
DI void phase_moe_down(const P7Args& a, char* lds) {
    const int tid = threadIdx.x, wid = tid >> 6, lane = tid & 63, wr = wid >> 2, wc = wid & 3, fr = lane & 15, fq = lane >> 4;
    build_moe_tab<128>(a.counts, lds);
    const int* tstart = (const int*)(lds + LDS_TAB); const int* rstart = tstart + 264;
    const int nunits = tstart[257] * 4;
    for (int u = vblock(); u < nunits; u += GRID) {
        const int g = u >> 2, ct = u & 3, e = find_expert(tstart, g), m0 = (g - tstart[e]) * 128, st = rstart[e], n0 = ct * 256;
        const int cnt = e < N_EXP ? a.counts[e] : T_TOK;
        const float* wd = (e < N_EXP ? a.w_down + (size_t)e * D_EXP * D_MODEL : a.ws_down) + n0;
        ALoader<4> al; al.init_gather(a.H + (size_t)st * D_EXP, D_EXP, nullptr, cnt, m0);
        BLoaderF32<false> bl; bl.init(wd, wd + 128, D_MODEL);
        f32x4 acc[4][4];
        gemm_tile<4, true>(lds, al, bl, D_EXP / 64, acc);
#pragma unroll
        for (int m = 0; m < 4; ++m) {
            const int row = m0 + 64 * wr + 16 * m + fr;
            if (row < cnt) {
                const float gt = e < N_EXP ? a.gatel[(size_t)e * CAP + row] : 1.f;
#pragma unroll
                for (int n = 0; n < 4; ++n) {
                    u32x2 o; o.x = cvt_pk_bf16(acc[m][n][0] * gt, acc[m][n][1] * gt); o.y = cvt_pk_bf16(acc[m][n][2] * gt, acc[m][n][3] * gt);
                    *(u32x2*)(a.Y + (size_t)(st + row) * D_MODEL + n0 + 64 * wc + 16 * n + 4 * fq) = o;
                }
            }
        }
    }
}
struct P8Args { const bf16_t* x1; const bf16_t* Y; const int* slot; const int* counts; const float* ln_g; const float* ln_b; float* out; };
DI void unpack16(const u32x4& a, const u32x4& b, float (&v)[16]) {
#pragma unroll
    for (int j = 0; j < 4; ++j) { v[2 * j] = __uint_as_float(a[j] << 16); v[2 * j + 1] = __uint_as_float(a[j] & 0xffff0000u); v[8 + 2 * j] = __uint_as_float(b[j] << 16); v[8 + 2 * j + 1] = __uint_as_float(b[j] & 0xffff0000u); }
}
DI void phase_combine(const P8Args& a, char* lds) {
    const int tid = threadIdx.x, wid = tid >> 6, lane = tid & 63;
    build_moe_tab<128>(a.counts, lds);
    const int* rstart = (const int*)(lds + LDS_TAB) + 264;
    const int sh0 = rstart[256];
    for (int t = vblock() * 8 + wid; t < T_TOK; t += GRID * 8) {
        float v[16], w[16];
        { const u32x4 p0 = *(const u32x4*)(a.x1 + (size_t)t * D_MODEL + lane * 16), p1 = *(const u32x4*)(a.x1 + (size_t)t * D_MODEL + lane * 16 + 8); unpack16(p0, p1, v); }
#pragma unroll
        for (int i = 0; i < 16; ++i) v[i] *= DN_ALPHA;
        { const bf16_t* yp = a.Y + (size_t)(sh0 + t) * D_MODEL + lane * 16; const u32x4 p0 = *(const u32x4*)yp, p1 = *(const u32x4*)(yp + 8); unpack16(p0, p1, w); }
#pragma unroll
        for (int i = 0; i < 16; ++i) v[i] += w[i];
        int sl = 0; if (lane < TOP_K) sl = a.slot[t * TOP_K + lane];
#pragma unroll
        for (int k = 0; k < TOP_K; ++k) {
            const int s = __shfl(sl, k), e = s / CAP, pos = s % CAP;
            const bf16_t* yp = a.Y + (size_t)(rstart[e] + pos) * D_MODEL + lane * 16; const u32x4 p0 = *(const u32x4*)yp, p1 = *(const u32x4*)(yp + 8); unpack16(p0, p1, w);
#pragma unroll
            for (int i = 0; i < 16; ++i) v[i] += w[i];
        }
        float s = 0.f;
#pragma unroll
        for (int i = 0; i < 16; ++i) s += v[i];
#pragma unroll
        for (int o = 32; o >= 1; o >>= 1) s += __shfl_xor(s, o);
        const float mu = s * (1.f / 1024.f);
        float q = 0.f;
#pragma unroll
        for (int i = 0; i < 16; ++i) { const float d = v[i] - mu; q += d * d; }
#pragma unroll
        for (int o = 32; o >= 1; o >>= 1) q += __shfl_xor(q, o);
        const float rstd = rsqrtf(q * (1.f / 1024.f) + LN_EPS);
#pragma unroll
        for (int j = 0; j < 4; ++j) {
            const f32x4 g = *(const f32x4*)(a.ln_g + lane * 16 + 4 * j), bb = *(const f32x4*)(a.ln_b + lane * 16 + 4 * j);
            f32x4 o; o[0] = (v[4 * j] - mu) * rstd * g[0] + bb[0]; o[1] = (v[4 * j + 1] - mu) * rstd * g[1] + bb[1]; o[2] = (v[4 * j + 2] - mu) * rstd * g[2] + bb[2]; o[3] = (v[4 * j + 3] - mu) * rstd * g[3] + bb[3];
            *(f32x4*)(a.out + (size_t)t * D_MODEL + lane * 16 + 4 * j) = o;
        }
    }
}

#define MFMA32(a, b, c) __builtin_amdgcn_mfma_f32_32x32x16_bf16((a), (b), (c), 0, 0, 0)
constexpr float SB_EXIT_THR = 1e-30f;
struct P2Args { const bf16_t* Q; const bf16_t* Kb; const bf16_t* Vt; const float* rel_bias; const float* gain_a; const float* gain_b; bf16_t* y; };

DI bf16x8 pack8(const f32x16& x, int s) {
    u32x4 p;
    if (s == 0) { p.x = cvt_pk_bf16(x[0], x[1]); p.y = cvt_pk_bf16(x[2], x[3]); p.z = cvt_pk_bf16(x[4], x[5]); p.w = cvt_pk_bf16(x[6], x[7]); }
    else        { p.x = cvt_pk_bf16(x[8], x[9]); p.y = cvt_pk_bf16(x[10], x[11]); p.z = cvt_pk_bf16(x[12], x[13]); p.w = cvt_pk_bf16(x[14], x[15]); }
    return __builtin_bit_cast(bf16x8, p);
}
DI void load_k(bf16x8 (&k)[4], const bf16_t* kp, int k0) {
#pragma unroll
    for (int kk = 0; kk < 4; ++kk) k[kk] = *(const bf16x8*)(kp + (size_t)k0 * 64 + 16 * kk);
}
DI void load_v(bf16x8 (&v)[2][2], const bf16_t* vp0, const bf16_t* vp1, int k0) {
#pragma unroll
    for (int s = 0; s < 2; ++s) {
        const u32x2 a0 = *(const u32x2*)(vp0 + k0 + 16 * s), a1 = *(const u32x2*)(vp0 + k0 + 16 * s + 8);
        const u32x2 b0 = *(const u32x2*)(vp1 + k0 + 16 * s), b1 = *(const u32x2*)(vp1 + k0 + 16 * s + 8);
        v[0][s] = __builtin_bit_cast(bf16x8, (u32x4){a0.x, a0.y, a1.x, a1.y});
        v[1][s] = __builtin_bit_cast(bf16x8, (u32x4){b0.x, b0.y, b1.x, b1.y});
    }
}

DI void phase_attn(const P2Args& a, char* lds) {
    const int tid = threadIdx.x, wid = tid >> 6, lane = tid & 63, r = lane & 31, h = lane >> 5;
    float* tbl = (float*)lds;
    float* ssq = (float*)(lds + 8 * 260 * 4);
    __syncthreads();
    for (int i = tid; i < NHA * 257; i += NTHR) { const int hd = i / 257, j = i % 257; tbl[hd * 260 + j] = a.rel_bias[i] * LOG2E; }
    __syncthreads();
    for (int u = vblock(); u < 2 * BATCH * (SEQ / 64); u += GRID) {
        const bool isB = u >= BATCH * (SEQ / 64); const int uu = isB ? u - BATCH * (SEQ / 64) : u;
        const int b = uu / (SEQ / 64), c = uu % (SEQ / 64), q0 = c * 64, hh = (isB ? NHA : 0) + wid;
        const size_t hb = (size_t)(b * NHH + hh) * SEQ * 64;
        const bf16_t* kp = a.Kb + hb + r * 64 + 8 * h;
        const bf16_t* vp0 = a.Vt + hb + (size_t)r * SEQ + 4 * h; const bf16_t* vp1 = vp0 + (size_t)32 * SEQ;
        bf16x8 qf[2][4];
#pragma unroll
        for (int qt = 0; qt < 2; ++qt)
#pragma unroll
            for (int kk = 0; kk < 4; ++kk) qf[qt][kk] = *(const bf16x8*)(a.Q + hb + (size_t)(q0 + 32 * qt + r) * 64 + 16 * kk + 8 * h);
        f32x16 ot[2][2];
#pragma unroll
        for (int dt = 0; dt < 2; ++dt)
#pragma unroll
            for (int qt = 0; qt < 2; ++qt)
#pragma unroll
                for (int i = 0; i < 16; ++i) ot[dt][qt][i] = 0.f;
        float linv[2] = {1.f, 1.f};
        if (!isB) {
            float mrun[2] = {-INFINITY, -INFINITY}, lrun[2] = {0.f, 0.f};
            const int klo = q0 - LEFT_CHUNKS * CHUNK < 0 ? 0 : q0 - LEFT_CHUNKS * CHUNK, khi = q0 + 64;
            const float cfar = tbl[wid * 260 + 256];
            bf16x8 kc[4], kn[4], vf[2][2]; load_k(kc, kp, klo);
            for (int k0 = klo; k0 < khi; k0 += 32) {
                load_v(vf, vp0, vp1, k0);
                load_k(kn, kp, k0 + 32 < khi ? k0 + 32 : k0);
#pragma unroll
                for (int qt = 0; qt < 2; ++qt) {
                    bf16x8 pf[2];
                    f32x16 st;
#pragma unroll
                    for (int i = 0; i < 16; ++i) st[i] = 0.f;
#pragma unroll
                    for (int kk = 0; kk < 4; ++kk) st = MFMA32(kc[kk], qf[qt][kk], st);
                    const int dmin = q0 + 32 * qt - k0 - 31;
                    if (dmin >= MAX_REL) {
#pragma unroll
                        for (int i = 0; i < 16; ++i) st[i] += cfar;
                    } else {
                        const int bidx = q0 + 32 * qt + r - k0 - 4 * h + MAX_REL;
#pragma unroll
                        for (int i = 0; i < 16; ++i) { int ix = bidx - ((i & 3) + 8 * (i >> 2)); ix = ix < 0 ? 0 : (ix > 2 * MAX_REL ? 2 * MAX_REL : ix); st[i] += tbl[wid * 260 + ix]; }
                    }
                    float mx = st[0];
#pragma unroll
                    for (int i = 1; i < 16; ++i) mx = fmaxf(mx, st[i]);
                    mx = fmaxf(mx, __shfl_xor(mx, 32));
                    const float mn = fmaxf(mrun[qt], mx), alpha = __builtin_amdgcn_exp2f(mrun[qt] - mn);
                    mrun[qt] = mn;
                    float ps = 0.f;
#pragma unroll
                    for (int i = 0; i < 16; ++i) { st[i] = __builtin_amdgcn_exp2f(st[i] - mn); ps += st[i]; }
                    lrun[qt] = lrun[qt] * alpha + ps;
#pragma unroll
                    for (int i = 0; i < 16; ++i) { ot[0][qt][i] *= alpha; ot[1][qt][i] *= alpha; }
                    pf[0] = pack8(st, 0); pf[1] = pack8(st, 1);
#pragma unroll
                    for (int dt = 0; dt < 2; ++dt)
#pragma unroll
                        for (int s = 0; s < 2; ++s) ot[dt][qt] = MFMA32(vf[dt][s], pf[s], ot[dt][qt]);
                }
#pragma unroll
                for (int kk = 0; kk < 4; ++kk) kc[kk] = kn[kk];
            }
#pragma unroll
            for (int qt = 0; qt < 2; ++qt) { const float lt = lrun[qt] + __shfl_xor(lrun[qt], 32); linv[qt] = 1.f / lt; }
        } else {
            float carry[2] = {1.f, 1.f};
            bf16x8 kc[4], kn[4], vf[2][2]; load_k(kc, kp, q0 + 32);
            for (int k0 = q0 + 32; k0 >= 0; k0 -= 32) {
                load_v(vf, vp0, vp1, k0);
                load_k(kn, kp, k0 >= 32 ? k0 - 32 : k0);
#pragma unroll
                for (int qt = 0; qt < 2; ++qt) {
                    bf16x8 pf[2];
                    f32x16 st;
#pragma unroll
                    for (int i = 0; i < 16; ++i) st[i] = 0.f;
                    const bool none = (k0 > q0 + 32 * qt + 30);
                    if (!none) {
#pragma unroll
                        for (int kk = 0; kk < 4; ++kk) st = MFMA32(kc[kk], qf[qt][kk], st);
                        const bool full = (k0 + 31 < q0 + 32 * qt);
                        const int lim = q0 + 32 * qt + r - k0 - 4 * h;
                        float om[16];
#pragma unroll
                        for (int i = 0; i < 16; ++i) {
                            const float e = __builtin_amdgcn_exp2f(-st[i]); float bta = __builtin_amdgcn_rcpf(1.f + e);
                            if (!full && !(((i & 3) + 8 * (i >> 2)) < lim)) bta = 0.f;
                            st[i] = bta; om[i] = 1.f - bta;
                        }
                        float G[4], Go[4];
#pragma unroll
                        for (int g = 0; g < 4; ++g) { G[g] = (om[4 * g] * om[4 * g + 1]) * (om[4 * g + 2] * om[4 * g + 3]); Go[g] = __shfl_xor(G[g], 32); }
                        float R = carry[qt];
#pragma unroll
                        for (int g = 3; g >= 0; --g) {
                            float run = h == 0 ? R * Go[g] : R;
#pragma unroll
                            for (int uu2 = 3; uu2 >= 0; --uu2) { const float bta = st[4 * g + uu2]; st[4 * g + uu2] = bta * run; run *= om[4 * g + uu2]; }
                            R = R * (G[g] * Go[g]);
                        }
                        carry[qt] = R;
                    }
                    if (!none) {
                        pf[0] = pack8(st, 0); pf[1] = pack8(st, 1);
#pragma unroll
                        for (int dt = 0; dt < 2; ++dt)
#pragma unroll
                            for (int s = 0; s < 2; ++s) ot[dt][qt] = MFMA32(vf[dt][s], pf[s], ot[dt][qt]);
                    }
                }
#pragma unroll
                for (int kk = 0; kk < 4; ++kk) kc[kk] = kn[kk];
                if (__all(carry[0] < SB_EXIT_THR && carry[1] < SB_EXIT_THR)) break;
            }
        }
        float ss[2];
#pragma unroll
        for (int qt = 0; qt < 2; ++qt) {
            float s2 = 0.f;
#pragma unroll
            for (int dt = 0; dt < 2; ++dt)
#pragma unroll
                for (int i = 0; i < 16; ++i) { ot[dt][qt][i] *= linv[qt]; s2 += ot[dt][qt][i] * ot[dt][qt][i]; }
            s2 += __shfl_xor(s2, 32); ss[qt] = s2;
        }
        __syncthreads();
        if (h == 0) { ssq[wid * 64 + r] = ss[0]; ssq[wid * 64 + 32 + r] = ss[1]; }
        __syncthreads();
        const float* gain = isB ? a.gain_b : a.gain_a;
#pragma unroll
        for (int qt = 0; qt < 2; ++qt) {
            float tot = 0.f;
#pragma unroll
            for (int w8 = 0; w8 < 8; ++w8) tot += ssq[w8 * 64 + 32 * qt + r];
            const float rs = rsqrtf(tot * (1.f / 512.f) + RMS_EPS);
            bf16_t* yp = a.y + (size_t)(b * SEQ + q0 + 32 * qt + r) * D_MODEL + (isB ? 512 : 0) + wid * 64;
#pragma unroll
            for (int dt = 0; dt < 2; ++dt)
#pragma unroll
                for (int g = 0; g < 4; ++g) {
                    const int d = 32 * dt + 8 * g + 4 * h; const f32x4 gn = *(const f32x4*)(gain + wid * 64 + d);
                    u32x2 o; o.x = cvt_pk_bf16(ot[dt][qt][4 * g] * rs * gn[0], ot[dt][qt][4 * g + 1] * rs * gn[1]); o.y = cvt_pk_bf16(ot[dt][qt][4 * g + 2] * rs * gn[2], ot[dt][qt][4 * g + 3] * rs * gn[3]);
                    *(u32x2*)(yp + d) = o;
                }
        }
    }
}
__global__ __launch_bounds__(NTHR, 2) void k_attn(P2Args a) { extern __shared__ __attribute__((aligned(16))) char smem[]; phase_attn(a, smem); }
__global__ __launch_bounds__(NTHR, 2) void k_router(P4Args a) { extern __shared__ __attribute__((aligned(16))) char smem[]; phase_router(a, smem); }
__global__ __launch_bounds__(NTHR, 2) void k_moe_gu(P6Args a) { extern __shared__ __attribute__((aligned(16))) char smem[]; phase_moe_gu(a, smem); }
__global__ __launch_bounds__(NTHR, 2) void k_moe_down(P7Args a) { extern __shared__ __attribute__((aligned(16))) char smem[]; phase_moe_down(a, smem); }
__global__ __launch_bounds__(NTHR, 2) void k_combine(P8Args a) { extern __shared__ __attribute__((aligned(16))) char smem[]; phase_combine(a, smem); }
__global__ __launch_bounds__(NTHR, 2) void k_prologue(P0Args a) { extern __shared__ __attribute__((aligned(16))) char smem[]; phase_prologue(a, smem); }
__global__ __launch_bounds__(NTHR, 2) void k_qkv(P1Args a) { extern __shared__ __attribute__((aligned(16))) char smem[]; phase_qkv(a, smem); }
__global__ __launch_bounds__(NTHR, 2) void k_outproj(P3Args a) { extern __shared__ __attribute__((aligned(16))) char smem[]; phase_outproj(a, smem); }


#define XB_TMO      128
#define XB_XCNT(j)  (256  + 64 * (j))
#define XB_XSUB(j)  (1280 + 64 * (j))
#define XB_XGEN(j)  (2304 + 64 * (j))
#define XB_TOP      3328
#define XB_TOPGEN   3392
#define XCD_BAR_WORDS 3456
#define XB_SPIN_CAP (1u << 18)
#define LAS __attribute__((address_space(3)))

__device__ __forceinline__ unsigned xb_ld(unsigned* p)              { return __hip_atomic_load(p, __ATOMIC_RELAXED, __HIP_MEMORY_SCOPE_AGENT); }
__device__ __forceinline__ unsigned xb_add(unsigned* p, unsigned v) { return __hip_atomic_fetch_add(p, v, __ATOMIC_RELAXED, __HIP_MEMORY_SCOPE_AGENT); }
__device__ __forceinline__ unsigned xb_xcc_id() { return (unsigned)__builtin_amdgcn_s_getreg((3 << 11) | 20) & 0xFu; }
#define XB_SPIN(cond, bar) do { unsigned _sp = 0; while (cond) { __builtin_amdgcn_s_sleep(1); \
    if ((++_sp & 255u) == 0u) { if (xb_ld(&(bar)[XB_TMO])) break; if (_sp > XB_SPIN_CAP) { atomicAdd(&(bar)[XB_TMO], 1u); break; } } } } while (0)

struct XcdBarrier {
    unsigned* bar; unsigned x;
    volatile LAS unsigned* st;
};

__device__ __forceinline__ XcdBarrier xcd_barrier_post(unsigned* bar, volatile LAS unsigned* st) {
    XcdBarrier b; b.bar = bar; b.x = xb_xcc_id(); b.st = st;
    if (threadIdx.x == 0) (void)xb_add(&bar[XB_XCNT(b.x)], 1u);
    return b;
}
__device__ __forceinline__ void xcd_barrier_complete(unsigned* bar, unsigned x, unsigned& nloc, unsigned& nx) {
    const unsigned G = gridDim.x * gridDim.y * gridDim.z;
    unsigned sum, cnt, mine, sp = 0u;
    for (;;) {
        sum = 0u; cnt = 0u; mine = 0u;
#pragma unroll
        for (unsigned j = 0; j < 16; ++j) { const unsigned c = xb_ld(&bar[XB_XCNT(j)]); sum += c; cnt += (c > 0u) ? 1u : 0u; mine = (j == x) ? c : mine; }
        if (sum == G) break;
        __builtin_amdgcn_s_sleep(1);
        if ((++sp & 255u) == 0u) { if (xb_ld(&bar[XB_TMO])) break; if (sp > XB_SPIN_CAP) { atomicAdd(&bar[XB_TMO], 1u); break; } }
    }
    nloc = mine > 0u ? mine : 1u; nx = cnt > 0u ? cnt : 1u;
}

__device__ __forceinline__ void xcd_barrier(const XcdBarrier& b) {
    asm volatile("s_waitcnt vmcnt(0)" ::: "memory");
    __syncthreads();
    if (threadIdx.x == 0) {
        unsigned* bar = b.bar;
        __builtin_amdgcn_s_waitcnt(0);
        unsigned nloc = b.st[0], nx = b.st[1];
        if (nloc == 0u) { xcd_barrier_complete(bar, b.x, nloc, nx); b.st[0] = nloc; b.st[1] = nx; }
        const unsigned old = xb_add(&bar[XB_XSUB(b.x)], 1u);
        const unsigned gen = old / nloc;
        if (old + 1u == (gen + 1u) * nloc) {
            __builtin_amdgcn_fence(__ATOMIC_RELEASE, "agent");
            asm volatile("s_waitcnt vmcnt(0)" ::: "memory");
            const unsigned og = xb_add(&bar[XB_TOP], 1u);
            const unsigned tg = og / nx;
            if (og + 1u == (tg + 1u) * nx) xb_add(&bar[XB_TOPGEN], 1u);
            else XB_SPIN(xb_ld(&bar[XB_TOPGEN]) == tg, bar);
            __builtin_amdgcn_fence(__ATOMIC_ACQUIRE, "agent");
            xb_add(&bar[XB_XGEN(b.x)], 1u);
            asm volatile("s_waitcnt vmcnt(0)" ::: "memory");
        } else {
            XB_SPIN(xb_ld(&bar[XB_XGEN(b.x)]) == gen, bar);
            __builtin_amdgcn_fence(__ATOMIC_ACQUIRE, "agent");
            asm volatile("s_waitcnt vmcnt(0)" ::: "memory");
        }
    }
    __syncthreads();
}


struct MegaArgs { P0Args p0; P1Args p1; P2Args p2; P3Args p3; P4Args p4; P6Args p6; P7Args p7; P8Args p8; unsigned* bar; };
__global__ __launch_bounds__(NTHR, 2) void k_mega(MegaArgs a) {
    extern __shared__ __attribute__((aligned(16))) char smem[];
    volatile LAS unsigned* xbw = (volatile LAS unsigned*)(smem + LDS_BYTES - 16);
    if (threadIdx.x == 0) { xbw[0] = 0u; xbw[1] = 0u; xbw[2] = 0u; xbw[3] = 0u; }
    __syncthreads();
    XcdBarrier bar = xcd_barrier_post(a.bar, xbw);
    phase_prologue(a.p0, smem);  xcd_barrier(bar);
    phase_qkv(a.p1, smem);       xcd_barrier(bar);
    phase_attn(a.p2, smem);      xcd_barrier(bar);
    phase_outproj(a.p3, smem);   xcd_barrier(bar);
    phase_router(a.p4, smem);    xcd_barrier(bar);
    phase_moe_gu(a.p6, smem);    xcd_barrier(bar);
    phase_moe_down(a.p7, smem);  xcd_barrier(bar);
    phase_combine(a.p8, smem);
}

extern "C" void kernel_launch(void* const* d_in, const int* in_sizes, int n_in, void* d_out, int out_size, void* d_ws, size_t ws_size, hipStream_t stream) {
    const float* x = (const float*)d_in[0];      const float* w_in = (const float*)d_in[1];   const float* rel_bias = (const float*)d_in[2];
    const float* gain_a = (const float*)d_in[3]; const float* gain_b = (const float*)d_in[4]; const float* w_out = (const float*)d_in[5];
    const float* ln1_g = (const float*)d_in[6];  const float* ln1_b = (const float*)d_in[7];  const float* router_w = (const float*)d_in[8];
    const float* router_bias = (const float*)d_in[9]; const float* w_gate = (const float*)d_in[10]; const float* w_up = (const float*)d_in[11];
    const float* w_down = (const float*)d_in[12]; const float* ws_gate = (const float*)d_in[13]; const float* ws_up = (const float*)d_in[14];
    const float* ws_down = (const float*)d_in[15]; const float* ln2_g = (const float*)d_in[16]; const float* ln2_b = (const float*)d_in[17];
    char* ws = (char*)d_ws; float* out = (float*)d_out;
    int* ctrl = (int*)(ws + OFF_CTRL); int* counts = ctrl + CW_COUNTS; int* starts = ctrl + CW_STARTS;
    bf16_t* X1 = (bf16_t*)(ws + OFF_X1); int* tokl = (int*)(ws + OFF_TOKL); float* gatel = (float*)(ws + OFF_GATEL);
    int* eidx = (int*)(ws + OFF_EIDX); float* gate = (float*)(ws + OFF_GATE); int* slot = (int*)(ws + OFF_SLOT);
    bf16_t* H = (bf16_t*)(ws + OFF_H); bf16_t* Y = (bf16_t*)(ws + OFF_Y);
    bf16_t* Q = (bf16_t*)(ws + OFF_Q); bf16_t* Kb = (bf16_t*)(ws + OFF_K); bf16_t* Vt = (bf16_t*)(ws + OFF_VT);
    bf16_t* yatt = (bf16_t*)(ws + OFF_YATT); bf16_t* r = (bf16_t*)(ws + OFF_R); float* yraw = (float*)(ws + OFF_YRAW); float* scores = (float*)(ws + OFF_SCORES);

    hipMemsetAsync(ctrl, 0, 64 * 1024, stream);
    bf16_t* xb = (bf16_t*)(ws + OFF_XB); float* stats = (float*)(ws + OFF_STATS);
    bf16_t* wt_in = (bf16_t*)(ws + OFF_WTIN); bf16_t* wt_out = (bf16_t*)(ws + OFF_WTOUT); bf16_t* wt_r = (bf16_t*)(ws + OFF_WTR);
    static bool attr_done = false;
    if (!attr_done) {
        hipFuncSetAttribute((const void*)k_mega, hipFuncAttributeMaxDynamicSharedMemorySize, LDS_BYTES);
        attr_done = true;
    }
    MegaArgs m{};
    m.p0 = P0Args{x, w_in, w_out, router_w, xb, wt_in, wt_out, wt_r};
    m.p1 = P1Args{xb, wt_in, Q, Kb, Vt};
    m.p2 = P2Args{Q, Kb, Vt, rel_bias, gain_a, gain_b, yatt};
    m.p3 = P3Args{yatt, wt_out, x, r, stats};
    m.p4 = P4Args{r, stats, ln1_g, ln1_b, X1, wt_r, router_bias, eidx, gate, counts, tokl, gatel, slot};
    m.p6 = P6Args{X1, counts, tokl, w_gate, w_up, ws_gate, ws_up, H};
    m.p7 = P7Args{H, counts, gatel, w_down, ws_down, Y};
    m.p8 = P8Args{X1, Y, slot, counts, ln2_g, ln2_b, out};
    m.bar = (unsigned*)ctrl;
    k_mega<<<GRID, NTHR, LDS_BYTES, stream>>>(m);
}
```

```cpp
#include <hip/hip_runtime.h>
#include <cstdint>
#include <cstdio>

typedef unsigned short bf16_t;

constexpr int D_MODEL = 1024, BATCH = 16, SEQ = 2048, T_TOK = BATCH * SEQ;
constexpr int HEAD_DIM = 64, NHA = 8, NHB = 8, NHH = 16;
constexpr int CHUNK = 64, LEFT_CHUNKS = 8, MAX_REL = 128;
constexpr int N_EXP = 256, TOP_K = 8, N_GROUPS = 8, TOPK_GROUPS = 4, EPG = 32, D_EXP = 256;
constexpr float ROUTED_SCALE = 2.5f, LN_EPS = 1e-5f, RMS_EPS = 1e-6f;
constexpr float DN_ALPHA = 1.189207115002721f;
constexpr float LOG2E = 1.4426950408889634f, LN2 = 0.6931471805599453f;
constexpr float QSCALE = 0.125f * LOG2E;
constexpr int CAP = T_TOK;
constexpr int ROWS_ALL = T_TOK * TOP_K + T_TOK;

__device__ __forceinline__ float bf2f(bf16_t v) { return __uint_as_float(((unsigned)v) << 16); }
__device__ __forceinline__ bf16_t f2bf(float f) { unsigned u = __float_as_uint(f); u += 0x7fffu + ((u >> 16) & 1u); return (bf16_t)(u >> 16); }

constexpr size_t MB = 1024ull * 1024ull;
constexpr size_t OFF_CTRL   = 0;
constexpr size_t OFF_X1     = 1 * MB;
constexpr size_t OFF_TOKL   = OFF_X1 + 64 * MB;
constexpr size_t OFF_GATEL  = OFF_TOKL + 32 * MB;
constexpr size_t OFF_EIDX   = OFF_GATEL + 32 * MB;
constexpr size_t OFF_GATE   = OFF_EIDX + 1 * MB;
constexpr size_t OFF_SLOT   = OFF_GATE + 1 * MB;
constexpr size_t OFF_WDT    = OFF_SLOT + 1 * MB;
constexpr size_t OFF_BIG    = OFF_WDT + 129 * MB;
constexpr size_t OFF_H      = OFF_BIG;
constexpr size_t OFF_Y      = OFF_BIG + 144 * MB;
constexpr size_t OFF_Q      = OFF_BIG;
constexpr size_t OFF_K      = OFF_BIG + 64 * MB;
constexpr size_t OFF_VT     = OFF_BIG + 128 * MB;
constexpr size_t OFF_YATT   = OFF_BIG + 192 * MB;
constexpr size_t OFF_R      = OFF_BIG + 256 * MB;
constexpr size_t OFF_XB     = OFF_BIG + 320 * MB;
constexpr size_t OFF_STATS  = OFF_BIG + 384 * MB;
constexpr size_t OFF_WTIN   = OFF_BIG + 392 * MB;
constexpr size_t OFF_WTOUT  = OFF_BIG + 398 * MB;
constexpr size_t OFF_WTR    = OFF_BIG + 400 * MB;
constexpr size_t OFF_WGUT   = OFF_BIG + 401 * MB;
constexpr size_t WS_NEEDED  = OFF_BIG + 720 * MB;
static_assert(OFF_WGUT + 257 * MB <= WS_NEEDED && WS_NEEDED <= 1024 * MB, "workspace map");
constexpr int CW_COUNTS = 4096;

typedef short bf16x8 __attribute__((ext_vector_type(8)));
typedef float f32x4 __attribute__((ext_vector_type(4)));
typedef float f32x2 __attribute__((ext_vector_type(2)));
typedef float f32x16 __attribute__((ext_vector_type(16)));
typedef unsigned u32x4 __attribute__((ext_vector_type(4)));
typedef unsigned u32x2 __attribute__((ext_vector_type(2)));
#define DI __device__ __forceinline__
constexpr int NTHR = 512, GRID = 256;
DI int tidx() { int t = threadIdx.x; asm volatile("" : "+v"(t)); return t; }
constexpr int LDS_BYTES = 147456;

typedef __bf16 bf16x2_t __attribute__((ext_vector_type(2)));
DI unsigned cvt_pk_bf16(float lo, float hi) { f32x2 v = {lo, hi}; bf16x2_t r = __builtin_convertvector(v, bf16x2_t); return __builtin_bit_cast(unsigned, r); }
DI int vblock() { return (int)((blockIdx.x & 7) * (GRID / 8) + (blockIdx.x >> 3)); }

template <int MT> struct Tile { static constexpr int BM = 32 * MT, A_BYTES = BM * 128, B_BYTES = 256 * 128, STAGE = A_BYTES + B_BYTES; };

template <int MT> struct ALoader {
    const bf16_t* p[MT / 2]; u32x4 v[MT / 2]; int off0;
    DI void init_rows(const bf16_t* A, int lda, int row0) {
        const int tid = tidx(), kc = tid & 7, r = tid >> 3;
#pragma unroll
        for (int i = 0; i < MT / 2; ++i) p[i] = A + (size_t)(row0 + r + 64 * i) * lda + kc * 8;
        off0 = r * 128 + ((kc ^ ((r >> 1) & 7)) << 4);
    }
    DI void init_gather(const bf16_t* A, int lda, const int* rows, int cnt, int m0) {
        const int tid = tidx(), kc = tid & 7, r = tid >> 3;
#pragma unroll
        for (int i = 0; i < MT / 2; ++i) { int rr = m0 + r + 64 * i; rr = rr < cnt ? rr : cnt - 1; const int g = rows ? rows[rr] : rr; p[i] = A + (size_t)g * lda + kc * 8; }
        off0 = r * 128 + ((kc ^ ((r >> 1) & 7)) << 4);
    }
    DI void load(int k0) {
#pragma unroll
        for (int i = 0; i < MT / 2; ++i) v[i] = *(const u32x4*)(p[i] + k0);
    }
    DI void store(char* ldsA) const {
#pragma unroll
        for (int i = 0; i < MT / 2; ++i) *(u32x4*)(ldsA + off0 + i * 8192) = v[i];
    }
};
struct BLoaderBt {
    const bf16_t* p[4]; u32x4 v[4]; int off0;
    DI void init(const bf16_t* Bt, int ldk, int n0) {
        const int tid = tidx(), kc = tid & 7, r = tid >> 3;
#pragma unroll
        for (int i = 0; i < 4; ++i) p[i] = Bt + (size_t)(n0 + r + 64 * i) * ldk + kc * 8;
        off0 = r * 128 + ((kc ^ ((r >> 1) & 7)) << 4);
    }
    DI void load(int k0) {
#pragma unroll
        for (int i = 0; i < 4; ++i) v[i] = *(const u32x4*)(p[i] + k0);
    }
    DI void store(char* ldsB) const {
#pragma unroll
        for (int i = 0; i < 4; ++i) *(u32x4*)(ldsB + off0 + i * 8192) = v[i];
    }
};
template <bool GU> struct BLoaderF32 {
    const float* p[2]; int ldb; f32x2 v[2][8]; int off[2][2];
    DI void init(const float* P0, const float* P1, int ldb_) {
        const int tid = tidx(), l = tid & 63, w = tid >> 6; ldb = ldb_;
        p[0] = P0 + (size_t)(8 * w) * ldb + 2 * l; p[1] = P1 + (size_t)(8 * w) * ldb + 2 * l;
#pragma unroll
        for (int jp = 0; jp < 2; ++jp)
#pragma unroll
            for (int jj = 0; jj < 2; ++jj) { const int c = 2 * l + jj; const int row = GU ? (64 * (c >> 5) + 32 * jp + (c & 31)) : (128 * jp + c); off[jp][jj] = row * 128 + ((w ^ ((row >> 1) & 7)) << 4); }
    }
    DI void load(int k0) {
#pragma unroll
        for (int jp = 0; jp < 2; ++jp)
#pragma unroll
            for (int kk = 0; kk < 8; ++kk) v[jp][kk] = *(const f32x2*)(p[jp] + (size_t)(k0 + kk) * ldb);
    }
    DI void store(char* ldsB) const {
#pragma unroll
        for (int jp = 0; jp < 2; ++jp) {
            u32x4 a, b;
            a.x = cvt_pk_bf16(v[jp][0].x, v[jp][1].x); a.y = cvt_pk_bf16(v[jp][2].x, v[jp][3].x); a.z = cvt_pk_bf16(v[jp][4].x, v[jp][5].x); a.w = cvt_pk_bf16(v[jp][6].x, v[jp][7].x);
            b.x = cvt_pk_bf16(v[jp][0].y, v[jp][1].y); b.y = cvt_pk_bf16(v[jp][2].y, v[jp][3].y); b.z = cvt_pk_bf16(v[jp][4].y, v[jp][5].y); b.w = cvt_pk_bf16(v[jp][6].y, v[jp][7].y);
            *(u32x4*)(ldsB + off[jp][0]) = a; *(u32x4*)(ldsB + off[jp][1]) = b;
        }
    }
};

template <int MT, bool TR, class AL, class BL>
DI void gemm_tile(char* lds, AL& al, BL& bl, int nk, f32x4 (&acc)[MT][4]) {
    typedef Tile<MT> TT;
    const int tid = tidx(), wid = tid >> 6, lane = tid & 63, wr = wid >> 2, wc = wid & 3, fr = lane & 15, fq = lane >> 4;
#pragma unroll
    for (int m = 0; m < MT; ++m)
#pragma unroll
        for (int n = 0; n < 4; ++n) acc[m][n] = (f32x4){0.f, 0.f, 0.f, 0.f};
    int aoff[2], boff[2];
#pragma unroll
    for (int ks = 0; ks < 2; ++ks) { const int ch = (((4 * ks + fq) ^ (fr >> 1)) << 4); aoff[ks] = (16 * MT * wr + fr) * 128 + ch; boff[ks] = TT::A_BYTES + (64 * wc + fr) * 128 + ch; }
    al.load(0); bl.load(0);
    __syncthreads();
    al.store(lds); bl.store(lds + TT::A_BYTES);
    __syncthreads();
    for (int kt = 0; kt < nk; ++kt) {
        char* cur = lds + (kt & 1) * TT::STAGE; char* nxt = lds + ((kt & 1) ^ 1) * TT::STAGE;
        const bool more = kt + 1 < nk;
        if (more) { al.load((kt + 1) * 64); bl.load((kt + 1) * 64); }
#pragma unroll
        for (int ks = 0; ks < 2; ++ks) {
            bf16x8 a[MT], b[4];
#pragma unroll
            for (int m = 0; m < MT; ++m) a[m] = *(const bf16x8*)(cur + aoff[ks] + m * 2048);
#pragma unroll
            for (int n = 0; n < 4; ++n) b[n] = *(const bf16x8*)(cur + boff[ks] + n * 2048);
#pragma unroll
            for (int m = 0; m < MT; ++m)
#pragma unroll
                for (int n = 0; n < 4; ++n)
                    acc[m][n] = TR ? __builtin_amdgcn_mfma_f32_16x16x32_bf16(b[n], a[m], acc[m][n], 0, 0, 0) : __builtin_amdgcn_mfma_f32_16x16x32_bf16(a[m], b[n], acc[m][n], 0, 0, 0);
        }
        if (more) { al.store(nxt); bl.store(nxt + TT::A_BYTES); }
        __syncthreads();
    }
}

#define LAS __attribute__((address_space(3)))
namespace gs {
constexpr int BM = 256, BK = 64, HALF = 128, HTB = HALF * BK * 2, STAGE_BYTES = 8 * HTB;
DI int lds_byte(int r, int c) { const int st = (r >> 4) * 2 + (c >> 5), rr = r & 15, cc = c & 31, ob = rr * 64 + cc * 2; return st * 1024 + (ob ^ (((ob >> 9) & 1) << 5)); }
DI void stage_rc(int b, int& R, int& C) { const int st = b / 1024, sb = b % 1024, swz = sb ^ (((sb >> 9) & 1) << 5); R = (st >> 1) * 16 + swz / 64; C = (st & 1) * 32 + (swz % 64) / 2; }
DI int perm32(int rho) { const int n = rho >> 4, i = rho & 15; return 8 * (i >> 2) + 4 * n + (i & 3); }
template <bool TR, bool PERM, class Sched, class Epi>
DI void gemm_stream(LAS unsigned char* lds, const int K, const Sched& S, const Epi& E) {
    typedef typename Sched::U U;
    const int tid = tidx(), wid = __builtin_amdgcn_readfirstlane(tid >> 6), lane = tid & 63, wr = wid >> 2, wc = wid & 3, fr = lane & 15, fq = lane >> 4;
    const int nt = K / BK;
    int R[2], C[2]; unsigned voffB[2];
#pragma unroll
    for (int i = 0; i < 2; ++i) { stage_rc(tid * 16 + i * 8192, R[i], C[i]); const int Rb = PERM ? ((R[i] & ~31) + perm32(R[i] & 31)) : R[i]; voffB[i] = (unsigned)(Rb * K + C[i]) * 2u; }
    const size_t kstep = (size_t)(BK * 2), hstepB = (size_t)HALF * K * 2;
    const unsigned ldsw = (unsigned)wid * 1024u;
    const int aoff = lds_byte(wr * 64 + fr, fq * 8), boff = lds_byte(wc * 32 + fr, fq * 8);
#define GS_SA(b, h) (((b) * 2 + (h)) * HTB)
#define GS_SB(b, h) ((4 + (b) * 2 + (h)) * HTB)
#define GS_STAGE(bufoff, gbase, voff) do { _Pragma("unroll") for (int _i = 0; _i < 2; ++_i) \
        __builtin_amdgcn_global_load_lds((const unsigned*)((const char*)(gbase) + (voff)[_i]), (LAS unsigned*)(lds + (bufoff) + ldsw + _i * 8192), 16, 0, 0); } while (0)
#define GS_LDA(dst, b, h) do { _Pragma("unroll") for (int m = 0; m < 4; ++m) _Pragma("unroll") for (int k = 0; k < 2; ++k) dst[m][k] = *(const LAS bf16x8*)(lds + GS_SA(b, h) + aoff + m * 2048 + k * 1024); } while (0)
#define GS_LDB(dst, b, h) do { _Pragma("unroll") for (int n = 0; n < 2; ++n) _Pragma("unroll") for (int k = 0; k < 2; ++k) dst[n][k] = *(const LAS bf16x8*)(lds + GS_SB(b, h) + boff + n * 2048 + k * 1024); } while (0)
#define GS_MMA(ai, bj, At, Bt) do { __builtin_amdgcn_s_setprio(1); _Pragma("unroll") for (int m = 0; m < 4; ++m) _Pragma("unroll") for (int n = 0; n < 2; ++n) _Pragma("unroll") for (int k = 0; k < 2; ++k) \
        acc[ai][bj][m][n] = TR ? __builtin_amdgcn_mfma_f32_16x16x32_bf16(Bt[n][k], At[m][k], acc[ai][bj][m][n], 0, 0, 0) : __builtin_amdgcn_mfma_f32_16x16x32_bf16(At[m][k], Bt[n][k], acc[ai][bj][m][n], 0, 0, 0); \
        __builtin_amdgcn_s_setprio(0); } while (0)
#define GS_WAIT_V(n) asm volatile("s_waitcnt vmcnt(" #n ")" ::: "memory")
#define GS_WAIT_L(n) asm volatile("s_waitcnt lgkmcnt(" #n ")" ::: "memory")
#define GS_BAR __builtin_amdgcn_s_barrier()
#define GS_SCHED __builtin_amdgcn_sched_barrier(0)
    U cur, nxt; int ui = 0;
    if (!S.next(0, cur)) return;
    f32x4 acc[2][2][4][2];
#pragma unroll
    for (int a = 0; a < 2; ++a)
#pragma unroll
        for (int b = 0; b < 2; ++b)
#pragma unroll
            for (int m = 0; m < 4; ++m)
#pragma unroll
                for (int n = 0; n < 2; ++n) acc[a][b][m][n] = (f32x4){0.f, 0.f, 0.f, 0.f};
    bf16x8 At[4][2], B0[2][2], B1[2][2];
    unsigned cvo[2][2], nvo[2][2];
    S.a_off(0, cur, R, C, cvo);
    const char* cA = cur.A; const char* cB = cur.B;
    GS_STAGE(GS_SB(0, 0), cB, voffB); GS_STAGE(GS_SB(0, 1), cB + hstepB, voffB); GS_STAGE(GS_SA(0, 0), cA, cvo[0]); GS_STAGE(GS_SA(0, 1), cA, cvo[1]);
    if (wr == 1) GS_BAR;
    GS_WAIT_V(2); GS_BAR;
    GS_STAGE(GS_SB(1, 0), cB + kstep, voffB); GS_STAGE(GS_SA(1, 0), cA + kstep, cvo[0]); GS_STAGE(GS_SB(1, 1), cB + hstepB + kstep, voffB);
    GS_WAIT_V(6); GS_BAR;
    for (;;) {
        const bool has_next = S.next(ui + 1, nxt);
        if (has_next) S.a_off(ui + 1, nxt, R, C, nvo);
        else { nvo[0][0] = cvo[0][0]; nvo[0][1] = cvo[0][1]; nvo[1][0] = cvo[1][0]; nvo[1][1] = cvo[1][1]; }
        const char* nA = has_next ? nxt.A : cA; const char* nB = has_next ? nxt.B : cB;
#pragma unroll 1
        for (int t = 0; t < nt; t += 2) {
            const bool last = (t == nt - 2);
            const char* a1 = cA + (size_t)(t + 1) * kstep;
            const char* a2 = last ? nA : cA + (size_t)(t + 2) * kstep; const char* b2 = last ? nB : cB + (size_t)(t + 2) * kstep;
            const char* a3 = a2 + kstep; const char* b3 = b2 + kstep;
            unsigned v2[2][2];
            v2[0][0] = last ? nvo[0][0] : cvo[0][0]; v2[0][1] = last ? nvo[0][1] : cvo[0][1]; v2[1][0] = last ? nvo[1][0] : cvo[1][0]; v2[1][1] = last ? nvo[1][1] : cvo[1][1];
            GS_LDB(B0, 0, 0); GS_LDB(B1, 0, 1); GS_SCHED; GS_LDA(At, 0, 0); GS_STAGE(GS_SA(1, 1), a1, cvo[1]);
            GS_WAIT_V(8); GS_WAIT_L(0); GS_BAR; GS_MMA(0, 0, At, B0); GS_MMA(0, 1, At, B1); GS_BAR; GS_SCHED;
            GS_LDA(At, 0, 1); GS_STAGE(GS_SB(0, 0), b2, voffB); GS_STAGE(GS_SB(0, 1), b2 + hstepB, voffB); GS_STAGE(GS_SA(0, 0), a2, v2[0]);
            GS_WAIT_V(8); GS_WAIT_L(0); GS_BAR; GS_MMA(1, 0, At, B0); GS_MMA(1, 1, At, B1); GS_BAR; GS_SCHED;
            GS_LDB(B0, 1, 0); GS_LDB(B1, 1, 1); GS_SCHED; GS_LDA(At, 1, 0); GS_STAGE(GS_SA(0, 1), a2, v2[1]);
            GS_WAIT_V(8); GS_WAIT_L(0); GS_BAR; GS_MMA(0, 0, At, B0); GS_MMA(0, 1, At, B1); GS_BAR; GS_SCHED;
            GS_LDA(At, 1, 1); GS_STAGE(GS_SB(1, 0), b3, voffB); GS_STAGE(GS_SB(1, 1), b3 + hstepB, voffB); GS_STAGE(GS_SA(1, 0), a3, v2[0]);
            GS_WAIT_V(8); GS_WAIT_L(0); GS_BAR; GS_MMA(1, 0, At, B0); GS_MMA(1, 1, At, B1); GS_BAR; GS_SCHED;
        }
        if (wr == 0) GS_BAR;
        E(acc, cur, wr, wc, fr, fq);
        if (!has_next) break;
#pragma unroll
        for (int a = 0; a < 2; ++a)
#pragma unroll
            for (int b = 0; b < 2; ++b)
#pragma unroll
                for (int m = 0; m < 4; ++m)
#pragma unroll
                    for (int n = 0; n < 2; ++n) acc[a][b][m][n] = (f32x4){0.f, 0.f, 0.f, 0.f};
        cur = nxt; cA = nA; cB = nB; ++ui;
        cvo[0][0] = nvo[0][0]; cvo[0][1] = nvo[0][1]; cvo[1][0] = nvo[1][0]; cvo[1][1] = nvo[1][1];
        if (wr == 1) GS_BAR;
    }
    GS_WAIT_V(0);
    GS_BAR;
#undef GS_SA
#undef GS_SB
#undef GS_STAGE
#undef GS_LDA
#undef GS_LDB
#undef GS_MMA
#undef GS_WAIT_V
#undef GS_WAIT_L
#undef GS_BAR
#undef GS_SCHED
}
struct DenseU { const char* A; const char* B; int pm, pn; };
struct DenseSched {
    typedef DenseU U;
    const bf16_t* A; const bf16_t* Bt; int K, nunits, first, stride, npn, pn_base, pn_mod0, pn_mod1;
    DI int colmap(int q) const { return pn_base + (q / pn_mod0) * pn_mod1 + (q % pn_mod0); }
    DI bool next(int i, U& u) const {
        const int L = first + i * stride; if (L >= nunits) return false;
        u.pm = L / npn; u.pn = colmap(L % npn);
        u.A = (const char*)A + (size_t)u.pm * BM * K * 2; u.B = (const char*)Bt + (size_t)u.pn * BM * K * 2; return true;
    }
    DI void a_off(int, const U&, const int (&R)[2], const int (&C)[2], unsigned (&vo)[2][2]) const {
#pragma unroll
        for (int h = 0; h < 2; ++h)
#pragma unroll
            for (int i = 0; i < 2; ++i) vo[h][i] = (unsigned)((HALF * h + R[i]) * K + C[i]) * 2u;
    }
};
}

DI void transpose_cvt(const float* W, bf16_t* Wt, int K, int N, int unit, char* lds) {
    float* tile = (float*)lds;
    const int nbn = N / 64, kb = unit / nbn, nb = unit % nbn, tid = tidx();
    __syncthreads();
#pragma unroll
    for (int i = 0; i < 8; ++i) { const int idx = tid + i * 512, r = idx >> 6, c = idx & 63; tile[r * 65 + c] = W[(size_t)(kb * 64 + r) * N + nb * 64 + c]; }
    __syncthreads();
#pragma unroll
    for (int i = 0; i < 8; ++i) { const int idx = tid + i * 512, n = idx >> 6, k = idx & 63; Wt[(size_t)(nb * 64 + n) * K + kb * 64 + k] = f2bf(tile[k * 65 + n]); }
}
struct P0Args { const float* x; const float* w_in; const float* w_out; const float* router_w; bf16_t* xb; bf16_t* wt_in; bf16_t* wt_out; bf16_t* wt_r;
                const float* w_gate; const float* w_up; const float* w_down; const float* ws_gate; const float* ws_up; const float* ws_down; bf16_t* wgut; bf16_t* wdt; };
DI void convert_item(const float* src, int ld, bf16_t* dst, int ldd, int rbase, int rhi, char* lds) {
    float* tile = (float*)lds;
    const int tid = tidx();
    f32x4 v[8];
#pragma unroll
    for (int i = 0; i < 8; ++i) { const int idx = tid + i * 512, k = idx >> 6, n4 = idx & 63; v[i] = *(const f32x4*)(src + (size_t)k * ld + 4 * n4); }
    __syncthreads();
#pragma unroll
    for (int i = 0; i < 8; ++i) { const int idx = tid + i * 512, k = idx >> 6, n4 = idx & 63; float* p = tile + k * 257 + 4 * n4; p[0] = v[i][0]; p[1] = v[i][1]; p[2] = v[i][2]; p[3] = v[i][3]; }
    __syncthreads();
#pragma unroll
    for (int i = 0; i < 4; ++i) {
        const int idx = tid + i * 512, kc = idx & 7, n = idx >> 3; const float* p = tile + (8 * kc) * 257 + n;
        u32x4 o; o.x = cvt_pk_bf16(p[0], p[257]); o.y = cvt_pk_bf16(p[2 * 257], p[3 * 257]); o.z = cvt_pk_bf16(p[4 * 257], p[5 * 257]); o.w = cvt_pk_bf16(p[6 * 257], p[7 * 257]);
        *(u32x4*)(dst + (size_t)(rbase + (n >> 7) * rhi + (n & 127)) * ldd + 8 * kc) = o;
    }
}
constexpr int CV_GU = 257 * 2 * 16, CV_DN = 257 * 16;
DI void convert_moe_item(const P0Args& a, int it, char* lds) {
    if (it < CV_GU) {
        const int e = it / 32, u = (it >> 4) & 1, kt = it & 15;
        const float* W = e < N_EXP ? (u ? a.w_up : a.w_gate) + (size_t)e * D_MODEL * D_EXP : (u ? a.ws_up : a.ws_gate);
        convert_item(W + (size_t)kt * 64 * D_EXP, D_EXP, a.wgut + (size_t)e * 512 * D_MODEL + kt * 64, D_MODEL, 128 * u, 256, lds);
    } else {
        const int j = it - CV_GU, e = j / 16, kt = (j >> 2) & 3, nb = j & 3;
        const float* W = e < N_EXP ? a.w_down + (size_t)e * D_EXP * D_MODEL : a.ws_down;
        convert_item(W + (size_t)kt * 64 * D_MODEL + nb * 256, D_MODEL, a.wdt + (size_t)e * D_MODEL * D_EXP + kt * 64, D_EXP, 256 * nb, 128, lds);
    }
}
DI void phase_prologue(const P0Args& a, char* lds) {
    const int vb = vblock();
    for (size_t i = (size_t)vb * NTHR + tidx(); i < (size_t)T_TOK * D_MODEL / 8; i += (size_t)GRID * NTHR) {
        const f32x4 v0 = *(const f32x4*)(a.x + i * 8), v1 = *(const f32x4*)(a.x + i * 8 + 4);
        u32x4 o; o.x = cvt_pk_bf16(v0[0], v0[1]); o.y = cvt_pk_bf16(v0[2], v0[3]); o.z = cvt_pk_bf16(v1[0], v1[1]); o.w = cvt_pk_bf16(v1[2], v1[3]);
        *(u32x4*)(a.xb + i * 8) = o;
    }
    const int n_in = (1024 / 64) * (3072 / 64), n_out = 16 * 16, n_r = 16 * 4;
    for (int u = vb; u < n_in + n_out + n_r; u += GRID) {
        if (u < n_in) transpose_cvt(a.w_in, a.wt_in, 1024, 3072, u, lds);
        else if (u < n_in + n_out) transpose_cvt(a.w_out, a.wt_out, 1024, 1024, u - n_in, lds);
        else transpose_cvt(a.router_w, a.wt_r, 1024, 256, u - n_in - n_out, lds);
    }
    for (int it = vb; it < CV_GU + CV_DN; it += GRID) convert_moe_item(a, it, lds);
}

struct P1Args { const bf16_t* xb; const bf16_t* wt_in; bf16_t* Q; bf16_t* Kb; bf16_t* Vt; };
struct EpiQK { bf16_t* Q; bf16_t* Kb;
    DI void operator()(const f32x4 (&acc)[2][2][4][2], const gs::DenseU& u, int wr, int wc, int fr, int fq) const {
        const int seg = u.pn >> 1, type = seg % 3, grp = seg / 3; bf16_t* dst = type == 0 ? Q : Kb; const float sc = type == 0 ? QSCALE : 1.f;
#pragma unroll
        for (int ai = 0; ai < 2; ++ai)
#pragma unroll
            for (int m = 0; m < 4; ++m) {
                const int row = u.pm * 256 + 128 * ai + 64 * wr + 16 * m + fr, b = row / SEQ, s = row % SEQ;
#pragma unroll
                for (int bj = 0; bj < 2; ++bj) {
                    const int hh = grp * 8 + 4 * (u.pn & 1) + 2 * bj + (wc >> 1), d0 = 32 * (wc & 1) + 8 * fq;
                    const f32x4 v0 = acc[ai][bj][m][0] * sc, v1 = acc[ai][bj][m][1] * sc;
                    u32x4 o; o.x = cvt_pk_bf16(v0[0], v0[1]); o.y = cvt_pk_bf16(v0[2], v0[3]); o.z = cvt_pk_bf16(v1[0], v1[1]); o.w = cvt_pk_bf16(v1[2], v1[3]);
                    *(u32x4*)(dst + ((size_t)(b * NHH + hh) * SEQ + s) * 64 + d0) = o;
                }
            }
    } };
struct EpiV { bf16_t* Vt;
    DI void operator()(const f32x4 (&acc)[2][2][4][2], const gs::DenseU& u, int wr, int wc, int fr, int fq) const {
        const int grp = (u.pn >> 1) / 3;
#pragma unroll
        for (int ai = 0; ai < 2; ++ai)
#pragma unroll
            for (int m = 0; m < 4; ++m) {
                const int row = u.pm * 256 + 128 * ai + 64 * wr + 16 * m + 4 * fq, b = row / SEQ, s = row % SEQ;
#pragma unroll
                for (int bj = 0; bj < 2; ++bj)
#pragma unroll
                    for (int n = 0; n < 2; ++n) {
                        const int hh = grp * 8 + 4 * (u.pn & 1) + 2 * bj + (wc >> 1), d = 32 * (wc & 1) + 16 * n + fr;
                        const f32x4 v = acc[ai][bj][m][n];
                        u32x2 o; o.x = cvt_pk_bf16(v[0], v[1]); o.y = cvt_pk_bf16(v[2], v[3]);
                        *(u32x2*)(Vt + ((size_t)(b * NHH + hh) * 64 + d) * SEQ + s) = o;
                    }
            }
    } };
DI void phase_qkv(const P1Args& a, LAS unsigned char* lds) {
    { gs::DenseSched S{a.xb, a.wt_in, D_MODEL, (T_TOK / 256) * 8, vblock(), GRID, 8, 0, 4, 6}; EpiQK E{a.Q, a.Kb}; gs::gemm_stream<true, true>(lds, D_MODEL, S, E); }
    { gs::DenseSched S{a.xb, a.wt_in, D_MODEL, (T_TOK / 256) * 4, vblock(), GRID, 4, 4, 2, 6}; EpiV E{a.Vt}; gs::gemm_stream<false, false>(lds, D_MODEL, S, E); }
}

struct P3Args { const bf16_t* y; const bf16_t* wt_out; const float* x; bf16_t* r; float* stats; };
struct EpiOut { const float* x; bf16_t* r; float* stats;
    DI void operator()(const f32x4 (&acc)[2][2][4][2], const gs::DenseU& u, int wr, int wc, int fr, int fq) const {
#pragma unroll
        for (int ai = 0; ai < 2; ++ai)
#pragma unroll
            for (int m = 0; m < 4; ++m) {
                const int row = u.pm * 256 + 128 * ai + 64 * wr + 16 * m + fr;
#pragma unroll
                for (int bj = 0; bj < 2; ++bj) {
                    const int col = u.pn * 256 + 128 * bj + 32 * wc + 8 * fq;
                    const f32x4 x0 = *(const f32x4*)(x + (size_t)row * D_MODEL + col), x1 = *(const f32x4*)(x + (size_t)row * D_MODEL + col + 4);
                    const f32x4 v0 = x0 * DN_ALPHA + acc[ai][bj][m][0], v1 = x1 * DN_ALPHA + acc[ai][bj][m][1];
                    float s = ((v0[0] + v0[1]) + (v0[2] + v0[3])) + ((v1[0] + v1[1]) + (v1[2] + v1[3]));
                    float q = ((v0[0] * v0[0] + v0[1] * v0[1]) + (v0[2] * v0[2] + v0[3] * v0[3])) + ((v1[0] * v1[0] + v1[1] * v1[1]) + (v1[2] * v1[2] + v1[3] * v1[3]));
                    u32x4 o; o.x = cvt_pk_bf16(v0[0], v0[1]); o.y = cvt_pk_bf16(v0[2], v0[3]); o.z = cvt_pk_bf16(v1[0], v1[1]); o.w = cvt_pk_bf16(v1[2], v1[3]);
                    *(u32x4*)(r + (size_t)row * D_MODEL + col) = o;
                    s += __shfl_xor(s, 16); s += __shfl_xor(s, 32); q += __shfl_xor(q, 16); q += __shfl_xor(q, 32);
                    if (fq == 0) *(f32x2*)(stats + ((size_t)row * 32 + u.pn * 8 + bj * 4 + wc) * 2) = (f32x2){s, q};
                }
            }
    } };
DI void phase_outproj(const P3Args& a, LAS unsigned char* lds) {
    gs::DenseSched S{a.y, a.wt_out, D_MODEL, (T_TOK / 256) * 4, vblock(), GRID, 4, 0, 4, 0}; EpiOut E{a.x, a.r, a.stats}; gs::gemm_stream<true, true>(lds, D_MODEL, S, E);
}

constexpr int RS_SC = 289;
constexpr int LDS_HIST = 100 * 1024;
struct P4Args { const bf16_t* r; const float* stats; const float* ln_g; const float* ln_b; bf16_t* x1; const bf16_t* wt_r; const float* rbias;
                int* eidx; float* gate; int* counts; int* tokl; float* gatel; int* slot; };
DI void phase_router(const P4Args& a, char* lds) {
    const int tid = tidx(), wid = tid >> 6, lane = tid & 63, wr = wid >> 2, wc = wid & 3, fr = lane & 15, fq = lane >> 4;
    float* sc = (float*)lds; int* hist = (int*)(lds + LDS_HIST); int* base = hist + 256;
    for (int u = vblock(); u < T_TOK / 128; u += GRID) {
        const int m0 = u * 128;
        for (int i = 0; i < 16; ++i) {
            const int t = m0 + wid * 16 + i;
            f32x2 st = (f32x2){0.f, 0.f};
            if (lane < 32) st = *(const f32x2*)(a.stats + ((size_t)t * 32 + lane) * 2);
            float s = st.x, q = st.y;
#pragma unroll
            for (int o = 1; o <= 16; o <<= 1) { s += __shfl_xor(s, o); q += __shfl_xor(q, o); }
            s = __shfl(s, 0); q = __shfl(q, 0);
            const float mu = s * (1.f / 1024.f), rstd = rsqrtf(q * (1.f / 1024.f) - mu * mu + LN_EPS);
            const u32x4 r0 = *(const u32x4*)(a.r + (size_t)t * D_MODEL + lane * 16), r1 = *(const u32x4*)(a.r + (size_t)t * D_MODEL + lane * 16 + 8);
            float v[16];
#pragma unroll
            for (int j = 0; j < 4; ++j) { v[2 * j] = __uint_as_float(r0[j] << 16); v[2 * j + 1] = __uint_as_float(r0[j] & 0xffff0000u); v[8 + 2 * j] = __uint_as_float(r1[j] << 16); v[8 + 2 * j + 1] = __uint_as_float(r1[j] & 0xffff0000u); }
            u32x4 o0, o1;
#pragma unroll
            for (int j = 0; j < 4; ++j) {
                const f32x4 g = *(const f32x4*)(a.ln_g + lane * 16 + 4 * j), bb = *(const f32x4*)(a.ln_b + lane * 16 + 4 * j);
                const float y0 = (v[4 * j] - mu) * rstd * g[0] + bb[0], y1 = (v[4 * j + 1] - mu) * rstd * g[1] + bb[1], y2 = (v[4 * j + 2] - mu) * rstd * g[2] + bb[2], y3 = (v[4 * j + 3] - mu) * rstd * g[3] + bb[3];
                const unsigned p0 = cvt_pk_bf16(y0, y1), p1 = cvt_pk_bf16(y2, y3);
                if (j < 2) { o0[2 * j] = p0; o0[2 * j + 1] = p1; } else { o1[2 * (j - 2)] = p0; o1[2 * (j - 2) + 1] = p1; }
            }
            *(u32x4*)(a.x1 + (size_t)t * D_MODEL + lane * 16) = o0; *(u32x4*)(a.x1 + (size_t)t * D_MODEL + lane * 16 + 8) = o1;
        }
        if (tid < 256) hist[tid] = 0;
        asm volatile("s_waitcnt vmcnt(0)" ::: "memory");
        __syncthreads();
        ALoader<4> al; al.init_rows(a.x1, D_MODEL, m0);
        BLoaderBt bl; bl.init(a.wt_r, D_MODEL, 0);
        f32x4 acc[4][4];
        gemm_tile<4, true>(lds, al, bl, D_MODEL / 64, acc);
        int my_idx[2], my_rank[2]; float my_gate[2];
#pragma unroll
        for (int p = 0; p < 2; ++p) {
            __syncthreads();
            if (wr == p) {
#pragma unroll
                for (int m = 0; m < 4; ++m)
#pragma unroll
                    for (int n = 0; n < 4; ++n) {
                        const int c0 = 64 * wc + 16 * n + 4 * fq; const f32x4 rb = *(const f32x4*)(a.rbias + c0);
#pragma unroll
                        for (int j = 0; j < 4; ++j) { const int c = c0 + j; sc[(16 * m + fr) * RS_SC + (c >> 5) * 36 + (c & 31)] = 1.f / (1.f + __expf(-acc[m][n][j])) + rb[j]; }
                    }
            }
            __syncthreads();
            const int row = tid >> 3, g = tid & 7, t = m0 + 64 * p + row;
            float sel[32];
#pragma unroll
            for (int i = 0; i < 32; ++i) sel[i] = sc[row * RS_SC + g * 36 + i];
            float m1 = -INFINITY, m2 = -INFINITY;
#pragma unroll
            for (int i = 0; i < 32; ++i) { const float v = sel[i]; m2 = fmaxf(m2, fminf(m1, v)); m1 = fmaxf(m1, v); }
            const float gs = m1 + m2; int rank = 0;
#pragma unroll
            for (int d = 1; d < 8; ++d) { const float o = __shfl_xor(gs, d); const int og = g ^ d; rank += (o > gs || (o == gs && og < g)) ? 1 : 0; }
            const bool en = rank < TOPK_GROUPS;
            float pv = INFINITY; int pi = -1; float myv = 0.f; int myi = 0;
#pragma unroll
            for (int k = 0; k < TOP_K; ++k) {
                float bv = -INFINITY; int bi = 1 << 20;
                if (en) {
#pragma unroll
                    for (int i = 0; i < 32; ++i) { const float v = sel[i]; const int e = g * 32 + i; const bool after = (v < pv) || (v == pv && e > pi); if (after && v > bv) { bv = v; bi = e; } }
                }
#pragma unroll
                for (int d = 1; d < 8; d <<= 1) { const float ov = __shfl_xor(bv, d); const int oi = __shfl_xor(bi, d); if (ov > bv || (ov == bv && oi < bi)) { bv = ov; bi = oi; } }
                pv = bv; pi = bi;
                if (g == k) { myv = bv; myi = bi; }
            }
            const float score = myv - a.rbias[myi];
            float gsum = score;
#pragma unroll
            for (int d = 1; d < 8; d <<= 1) gsum += __shfl_xor(gsum, d);
            const float gt = score / gsum * ROUTED_SCALE;
            a.eidx[t * TOP_K + g] = myi; a.gate[t * TOP_K + g] = gt;
            my_idx[p] = myi; my_gate[p] = gt; my_rank[p] = atomicAdd(&hist[myi], 1);
        }
        __syncthreads();
        if (tid < 256) { const int h = hist[tid]; base[tid] = h > 0 ? atomicAdd(&a.counts[tid], h) : 0; }
        __syncthreads();
#pragma unroll
        for (int p = 0; p < 2; ++p) {
            const int row = tid >> 3, g = tid & 7, t = m0 + 64 * p + row, e = my_idx[p], pos = base[e] + my_rank[p];
            a.tokl[(size_t)e * CAP + pos] = t; a.gatel[(size_t)e * CAP + pos] = my_gate[p]; a.slot[t * TOP_K + g] = e * CAP + pos;
        }
    }
}

constexpr int LDS_ROWTAB = 128 * 1024;
constexpr int LDS_TAB = 140 * 1024;
constexpr int MOE_BM = 256;
DI void build_moe_tab(const int* counts, char* lds) {
    int* tstart = (int*)(lds + LDS_TAB); int* rstart = tstart + 264;
    const int tid = tidx(), lane = tid & 63;
    __syncthreads();
    if (tid < 64) {
        int c[4], tl[4], cs = 0, ts = 0;
#pragma unroll
        for (int i = 0; i < 4; ++i) { c[i] = counts[lane * 4 + i]; tl[i] = (c[i] + MOE_BM - 1) / MOE_BM; cs += c[i]; ts += tl[i]; }
        int ci = cs, ti = ts;
#pragma unroll
        for (int o = 1; o < 64; o <<= 1) { const int n1 = __shfl_up(ci, o), n2 = __shfl_up(ti, o); if (lane >= o) { ci += n1; ti += n2; } }
        int ce = ci - cs, te = ti - ts;
#pragma unroll
        for (int i = 0; i < 4; ++i) { rstart[lane * 4 + i] = ce; tstart[lane * 4 + i] = te; ce += c[i]; te += tl[i]; }
        if (lane == 63) { rstart[256] = ce; tstart[256] = te; rstart[257] = ce + T_TOK; tstart[257] = te + T_TOK / MOE_BM; }
    }
    __syncthreads();
}
DI int find_expert(const int* tstart, int g) {
    int lo = 0, hi = 256;
#pragma unroll 1
    while (lo < hi) { const int mid = (lo + hi + 1) >> 1; if (tstart[mid] <= g) lo = mid; else hi = mid - 1; }
    return lo;
}
struct MoeU { const char* A; const char* B; int e, m0, st, cnt, sub; };

struct P6Args { const bf16_t* x1; const int* counts; const int* tokl; const bf16_t* wgut; bf16_t* H; };
struct GuSched {
    typedef MoeU U;
    const int* tstart; const int* rstart; const int* rowtab; const int* counts; const bf16_t* x1; const bf16_t* wgut; int first, stride, nunits;
    DI bool next(int i, U& u) const {
        const int L = first + i * stride; if (L >= nunits) return false;
        const int g = L >> 1, e = find_expert(tstart, g);
        u.sub = L & 1; u.e = e; u.m0 = (g - tstart[e]) * MOE_BM; u.st = rstart[e]; u.cnt = e < N_EXP ? counts[e] : T_TOK;
        u.A = (const char*)x1; u.B = (const char*)(wgut + ((size_t)e * 512 + 256 * u.sub) * D_MODEL); return true;
    }
    DI void a_off(int i, const U&, const int (&R)[2], const int (&C)[2], unsigned (&vo)[2][2]) const {
#pragma unroll
        for (int h = 0; h < 2; ++h)
#pragma unroll
            for (int p = 0; p < 2; ++p) vo[h][p] = (unsigned)(rowtab[i * 256 + 128 * h + R[p]] * D_MODEL + C[p]) * 2u;
    }
};
struct EpiGU { bf16_t* H;
    DI void operator()(const f32x4 (&acc)[2][2][4][2], const MoeU& u, int wr, int wc, int fr, int fq) const {
#pragma unroll
        for (int ai = 0; ai < 2; ++ai)
#pragma unroll
            for (int m = 0; m < 4; ++m) {
                const int row = u.m0 + 128 * ai + 64 * wr + 16 * m + fr;
                if (row < u.cnt) {
                    float h[8];
#pragma unroll
                    for (int n = 0; n < 2; ++n)
#pragma unroll
                        for (int j = 0; j < 4; ++j) { const float gv = acc[ai][0][m][n][j]; h[4 * n + j] = gv * __builtin_amdgcn_rcpf(1.f + __expf(-gv)) * acc[ai][1][m][n][j]; }
                    u32x4 o; o.x = cvt_pk_bf16(h[0], h[1]); o.y = cvt_pk_bf16(h[2], h[3]); o.z = cvt_pk_bf16(h[4], h[5]); o.w = cvt_pk_bf16(h[6], h[7]);
                    *(u32x4*)(H + (size_t)(u.st + row) * D_EXP + 128 * u.sub + 32 * wc + 8 * fq) = o;
                }
            }
    } };
DI void phase_moe_gu(const P6Args& a, char* smem, LAS unsigned char* lds) {
    build_moe_tab(a.counts, smem);
    const int* tstart = (const int*)(smem + LDS_TAB); const int* rstart = tstart + 264; int* rowtab = (int*)(smem + LDS_ROWTAB);
    const int nunits = tstart[257] * 2, first = vblock();
    const int n_my = first < nunits ? (nunits - first + GRID - 1) / GRID : 0;
    for (int idx = tidx(); idx < n_my * 256; idx += NTHR) {
        const int i = idx >> 8, row = idx & 255, L = first + i * GRID, g = L >> 1, e = find_expert(tstart, g), m0 = (g - tstart[e]) * MOE_BM, cnt = e < N_EXP ? a.counts[e] : T_TOK;
        int rr = m0 + row; rr = rr < cnt ? rr : cnt - 1;
        rowtab[idx] = e < N_EXP ? a.tokl[(size_t)e * CAP + rr] : rr;
    }
    __syncthreads();
    GuSched S{tstart, rstart, rowtab, a.counts, a.x1, a.wgut, first, GRID, nunits}; EpiGU E{a.H};
    gs::gemm_stream<true, true>(lds, D_MODEL, S, E);
}
struct P7Args { const bf16_t* H; const int* counts; const float* gatel; const bf16_t* wdt; bf16_t* Y; };
struct DownSched {
    typedef MoeU U;
    const int* tstart; const int* rstart; const int* counts; const bf16_t* H; const bf16_t* wdt; int first, stride, nunits;
    DI bool next(int i, U& u) const {
        const int L = first + i * stride; if (L >= nunits) return false;
        const int g = L >> 2, e = find_expert(tstart, g);
        u.sub = L & 3; u.e = e; u.m0 = (g - tstart[e]) * MOE_BM; u.st = rstart[e]; u.cnt = e < N_EXP ? counts[e] : T_TOK;
        u.A = (const char*)(H + (size_t)(u.st + u.m0) * D_EXP); u.B = (const char*)(wdt + ((size_t)e * D_MODEL + 256 * u.sub) * D_EXP); return true;
    }
    DI void a_off(int, const U&, const int (&R)[2], const int (&C)[2], unsigned (&vo)[2][2]) const {
#pragma unroll
        for (int h = 0; h < 2; ++h)
#pragma unroll
            for (int p = 0; p < 2; ++p) vo[h][p] = (unsigned)((128 * h + R[p]) * D_EXP + C[p]) * 2u;
    }
};
struct EpiDown { bf16_t* Y; const float* gatel;
    DI void operator()(const f32x4 (&acc)[2][2][4][2], const MoeU& u, int wr, int wc, int fr, int fq) const {
#pragma unroll
        for (int ai = 0; ai < 2; ++ai)
#pragma unroll
            for (int m = 0; m < 4; ++m) {
                const int row = u.m0 + 128 * ai + 64 * wr + 16 * m + fr;
                if (row < u.cnt) {
                    const float gt = u.e < N_EXP ? gatel[(size_t)u.e * CAP + row] : 1.f;
#pragma unroll
                    for (int bj = 0; bj < 2; ++bj) {
                        const f32x4 v0 = acc[ai][bj][m][0] * gt, v1 = acc[ai][bj][m][1] * gt;
                        u32x4 o; o.x = cvt_pk_bf16(v0[0], v0[1]); o.y = cvt_pk_bf16(v0[2], v0[3]); o.z = cvt_pk_bf16(v1[0], v1[1]); o.w = cvt_pk_bf16(v1[2], v1[3]);
                        *(u32x4*)(Y + (size_t)(u.st + row) * D_MODEL + 256 * u.sub + 128 * bj + 32 * wc + 8 * fq) = o;
                    }
                }
            }
    } };
DI void phase_moe_down(const P7Args& a, char* smem, LAS unsigned char* lds) {
    build_moe_tab(a.counts, smem);
    const int* tstart = (const int*)(smem + LDS_TAB); const int* rstart = tstart + 264;
    DownSched S{tstart, rstart, a.counts, a.H, a.wdt, vblock(), GRID, tstart[257] * 4}; EpiDown E{a.Y, a.gatel};
    gs::gemm_stream<true, true>(lds, D_EXP, S, E);
}
struct P8Args { const bf16_t* x1; const bf16_t* Y; const int* slot; const int* counts; const float* ln_g; const float* ln_b; float* out; };
DI void unpack16(const u32x4& a, const u32x4& b, float (&v)[16]) {
#pragma unroll
    for (int j = 0; j < 4; ++j) { v[2 * j] = __uint_as_float(a[j] << 16); v[2 * j + 1] = __uint_as_float(a[j] & 0xffff0000u); v[8 + 2 * j] = __uint_as_float(b[j] << 16); v[8 + 2 * j + 1] = __uint_as_float(b[j] & 0xffff0000u); }
}
DI void phase_combine(const P8Args& a, char* lds) {
    const int tid = tidx(), wid = tid >> 6, lane = tid & 63;
    build_moe_tab(a.counts, lds);
    const int* rstart = (const int*)(lds + LDS_TAB) + 264;
    const int sh0 = rstart[256];
    for (int t = vblock() * 8 + wid; t < T_TOK; t += GRID * 8) {
        float v[16], w[16];
        { const u32x4 p0 = *(const u32x4*)(a.x1 + (size_t)t * D_MODEL + lane * 16), p1 = *(const u32x4*)(a.x1 + (size_t)t * D_MODEL + lane * 16 + 8); unpack16(p0, p1, v); }
#pragma unroll
        for (int i = 0; i < 16; ++i) v[i] *= DN_ALPHA;
        { const bf16_t* yp = a.Y + (size_t)(sh0 + t) * D_MODEL + lane * 16; const u32x4 p0 = *(const u32x4*)yp, p1 = *(const u32x4*)(yp + 8); unpack16(p0, p1, w); }
#pragma unroll
        for (int i = 0; i < 16; ++i) v[i] += w[i];
        int sl = 0; if (lane < TOP_K) sl = a.slot[t * TOP_K + lane];
#pragma unroll
        for (int k = 0; k < TOP_K; ++k) {
            const int s = __shfl(sl, k), e = s / CAP, pos = s % CAP;
            const bf16_t* yp = a.Y + (size_t)(rstart[e] + pos) * D_MODEL + lane * 16; const u32x4 p0 = *(const u32x4*)yp, p1 = *(const u32x4*)(yp + 8); unpack16(p0, p1, w);
#pragma unroll
            for (int i = 0; i < 16; ++i) v[i] += w[i];
        }
        float s = 0.f;
#pragma unroll
        for (int i = 0; i < 16; ++i) s += v[i];
#pragma unroll
        for (int o = 32; o >= 1; o >>= 1) s += __shfl_xor(s, o);
        const float mu = s * (1.f / 1024.f);
        float q = 0.f;
#pragma unroll
        for (int i = 0; i < 16; ++i) { const float d = v[i] - mu; q += d * d; }
#pragma unroll
        for (int o = 32; o >= 1; o >>= 1) q += __shfl_xor(q, o);
        const float rstd = rsqrtf(q * (1.f / 1024.f) + LN_EPS);
#pragma unroll
        for (int j = 0; j < 4; ++j) {
            const f32x4 g = *(const f32x4*)(a.ln_g + lane * 16 + 4 * j), bb = *(const f32x4*)(a.ln_b + lane * 16 + 4 * j);
            f32x4 o; o[0] = (v[4 * j] - mu) * rstd * g[0] + bb[0]; o[1] = (v[4 * j + 1] - mu) * rstd * g[1] + bb[1]; o[2] = (v[4 * j + 2] - mu) * rstd * g[2] + bb[2]; o[3] = (v[4 * j + 3] - mu) * rstd * g[3] + bb[3];
            *(f32x4*)(a.out + (size_t)t * D_MODEL + lane * 16 + 4 * j) = o;
        }
    }
}

#define MFMA32(a, b, c) __builtin_amdgcn_mfma_f32_32x32x16_bf16((a), (b), (c), 0, 0, 0)
constexpr float SB_EXIT_THR = 1e-30f;
struct P2Args { const bf16_t* Q; const bf16_t* Kb; const bf16_t* Vt; const float* rel_bias; const float* gain_a; const float* gain_b; bf16_t* y; };

DI bf16x8 pack8(const f32x16& x, int s) {
    u32x4 p;
    if (s == 0) { p.x = cvt_pk_bf16(x[0], x[1]); p.y = cvt_pk_bf16(x[2], x[3]); p.z = cvt_pk_bf16(x[4], x[5]); p.w = cvt_pk_bf16(x[6], x[7]); }
    else        { p.x = cvt_pk_bf16(x[8], x[9]); p.y = cvt_pk_bf16(x[10], x[11]); p.z = cvt_pk_bf16(x[12], x[13]); p.w = cvt_pk_bf16(x[14], x[15]); }
    return __builtin_bit_cast(bf16x8, p);
}
DI void load_k(bf16x8 (&k)[4], const bf16_t* kp, int k0) {
#pragma unroll
    for (int kk = 0; kk < 4; ++kk) k[kk] = *(const bf16x8*)(kp + (size_t)k0 * 64 + 16 * kk);
}
DI void load_v(bf16x8 (&v)[2][2], const bf16_t* vp0, const bf16_t* vp1, int k0) {
#pragma unroll
    for (int s = 0; s < 2; ++s) {
        const u32x2 a0 = *(const u32x2*)(vp0 + k0 + 16 * s), a1 = *(const u32x2*)(vp0 + k0 + 16 * s + 8);
        const u32x2 b0 = *(const u32x2*)(vp1 + k0 + 16 * s), b1 = *(const u32x2*)(vp1 + k0 + 16 * s + 8);
        v[0][s] = __builtin_bit_cast(bf16x8, (u32x4){a0.x, a0.y, a1.x, a1.y});
        v[1][s] = __builtin_bit_cast(bf16x8, (u32x4){b0.x, b0.y, b1.x, b1.y});
    }
}

DI void phase_attn(const P2Args& a, char* lds) {
    const int tid = tidx(), wid = tid >> 6, lane = tid & 63, r = lane & 31, h = lane >> 5;
    float* tbl = (float*)lds;
    float* ssq = (float*)(lds + 8 * 260 * 4);
    __syncthreads();
    for (int i = tid; i < NHA * 257; i += NTHR) { const int hd = i / 257, j = i % 257; tbl[hd * 260 + j] = a.rel_bias[i] * LOG2E; }
    __syncthreads();
    for (int u = vblock(); u < 2 * BATCH * (SEQ / 64); u += GRID) {
        const bool isB = u >= BATCH * (SEQ / 64); const int uu = isB ? u - BATCH * (SEQ / 64) : u;
        const int b = uu / (SEQ / 64), c = uu % (SEQ / 64), q0 = c * 64, hh = (isB ? NHA : 0) + wid;
        const size_t hb = (size_t)(b * NHH + hh) * SEQ * 64;
        const bf16_t* kp = a.Kb + hb + r * 64 + 8 * h;
        const bf16_t* vp0 = a.Vt + hb + (size_t)r * SEQ + 4 * h; const bf16_t* vp1 = vp0 + (size_t)32 * SEQ;
        bf16x8 qf[2][4];
#pragma unroll
        for (int qt = 0; qt < 2; ++qt)
#pragma unroll
            for (int kk = 0; kk < 4; ++kk) qf[qt][kk] = *(const bf16x8*)(a.Q + hb + (size_t)(q0 + 32 * qt + r) * 64 + 16 * kk + 8 * h);
        f32x16 ot[2][2];
#pragma unroll
        for (int dt = 0; dt < 2; ++dt)
#pragma unroll
            for (int qt = 0; qt < 2; ++qt)
#pragma unroll
                for (int i = 0; i < 16; ++i) ot[dt][qt][i] = 0.f;
        float linv[2] = {1.f, 1.f};
        if (!isB) {
            float mrun[2] = {-INFINITY, -INFINITY}, lrun[2] = {0.f, 0.f};
            const int klo = q0 - LEFT_CHUNKS * CHUNK < 0 ? 0 : q0 - LEFT_CHUNKS * CHUNK, khi = q0 + 64;
            const float cfar = tbl[wid * 260 + 256];
            bf16x8 kc[4], kn[4], vf[2][2]; load_k(kc, kp, klo);
            for (int k0 = klo; k0 < khi; k0 += 32) {
                load_v(vf, vp0, vp1, k0);
                load_k(kn, kp, k0 + 32 < khi ? k0 + 32 : k0);
#pragma unroll
                for (int qt = 0; qt < 2; ++qt) {
                    bf16x8 pf[2];
                    f32x16 st;
#pragma unroll
                    for (int i = 0; i < 16; ++i) st[i] = 0.f;
#pragma unroll
                    for (int kk = 0; kk < 4; ++kk) st = MFMA32(kc[kk], qf[qt][kk], st);
                    const int dmin = q0 + 32 * qt - k0 - 31;
                    if (dmin >= MAX_REL) {
#pragma unroll
                        for (int i = 0; i < 16; ++i) st[i] += cfar;
                    } else {
                        const int bidx = q0 + 32 * qt + r - k0 - 4 * h + MAX_REL;
#pragma unroll
                        for (int i = 0; i < 16; ++i) { int ix = bidx - ((i & 3) + 8 * (i >> 2)); ix = ix < 0 ? 0 : (ix > 2 * MAX_REL ? 2 * MAX_REL : ix); st[i] += tbl[wid * 260 + ix]; }
                    }
                    float mx = st[0];
#pragma unroll
                    for (int i = 1; i < 16; ++i) mx = fmaxf(mx, st[i]);
                    mx = fmaxf(mx, __shfl_xor(mx, 32));
                    const float mn = fmaxf(mrun[qt], mx), alpha = __builtin_amdgcn_exp2f(mrun[qt] - mn);
                    mrun[qt] = mn;
                    float ps = 0.f;
#pragma unroll
                    for (int i = 0; i < 16; ++i) { st[i] = __builtin_amdgcn_exp2f(st[i] - mn); ps += st[i]; }
                    lrun[qt] = lrun[qt] * alpha + ps;
#pragma unroll
                    for (int i = 0; i < 16; ++i) { ot[0][qt][i] *= alpha; ot[1][qt][i] *= alpha; }
                    pf[0] = pack8(st, 0); pf[1] = pack8(st, 1);
#pragma unroll
                    for (int dt = 0; dt < 2; ++dt)
#pragma unroll
                        for (int s = 0; s < 2; ++s) ot[dt][qt] = MFMA32(vf[dt][s], pf[s], ot[dt][qt]);
                }
#pragma unroll
                for (int kk = 0; kk < 4; ++kk) kc[kk] = kn[kk];
            }
#pragma unroll
            for (int qt = 0; qt < 2; ++qt) { const float lt = lrun[qt] + __shfl_xor(lrun[qt], 32); linv[qt] = 1.f / lt; }
        } else {
            float carry[2] = {1.f, 1.f};
            bf16x8 kc[4], kn[4], vf[2][2]; load_k(kc, kp, q0 + 32);
            for (int k0 = q0 + 32; k0 >= 0; k0 -= 32) {
                load_v(vf, vp0, vp1, k0);
                load_k(kn, kp, k0 >= 32 ? k0 - 32 : k0);
#pragma unroll
                for (int qt = 0; qt < 2; ++qt) {
                    bf16x8 pf[2];
                    f32x16 st;
#pragma unroll
                    for (int i = 0; i < 16; ++i) st[i] = 0.f;
                    const bool none = (k0 > q0 + 32 * qt + 30);
                    if (!none) {
#pragma unroll
                        for (int kk = 0; kk < 4; ++kk) st = MFMA32(kc[kk], qf[qt][kk], st);
                        const bool full = (k0 + 31 < q0 + 32 * qt);
                        const int lim = q0 + 32 * qt + r - k0 - 4 * h;
                        float om[16];
#pragma unroll
                        for (int i = 0; i < 16; ++i) {
                            const float e = __builtin_amdgcn_exp2f(-st[i]); float bta = __builtin_amdgcn_rcpf(1.f + e);
                            if (!full && !(((i & 3) + 8 * (i >> 2)) < lim)) bta = 0.f;
                            st[i] = bta; om[i] = 1.f - bta;
                        }
                        float G[4], Go[4];
#pragma unroll
                        for (int g = 0; g < 4; ++g) { G[g] = (om[4 * g] * om[4 * g + 1]) * (om[4 * g + 2] * om[4 * g + 3]); Go[g] = __shfl_xor(G[g], 32); }
                        float R = carry[qt];
#pragma unroll
                        for (int g = 3; g >= 0; --g) {
                            float run = h == 0 ? R * Go[g] : R;
#pragma unroll
                            for (int uu2 = 3; uu2 >= 0; --uu2) { const float bta = st[4 * g + uu2]; st[4 * g + uu2] = bta * run; run *= om[4 * g + uu2]; }
                            R = R * (G[g] * Go[g]);
                        }
                        carry[qt] = R;
                    }
                    if (!none) {
                        pf[0] = pack8(st, 0); pf[1] = pack8(st, 1);
#pragma unroll
                        for (int dt = 0; dt < 2; ++dt)
#pragma unroll
                            for (int s = 0; s < 2; ++s) ot[dt][qt] = MFMA32(vf[dt][s], pf[s], ot[dt][qt]);
                    }
                }
#pragma unroll
                for (int kk = 0; kk < 4; ++kk) kc[kk] = kn[kk];
                if (__all(carry[0] < SB_EXIT_THR && carry[1] < SB_EXIT_THR)) break;
            }
        }
        float ss[2];
#pragma unroll
        for (int qt = 0; qt < 2; ++qt) {
            float s2 = 0.f;
#pragma unroll
            for (int dt = 0; dt < 2; ++dt)
#pragma unroll
                for (int i = 0; i < 16; ++i) { ot[dt][qt][i] *= linv[qt]; s2 += ot[dt][qt][i] * ot[dt][qt][i]; }
            s2 += __shfl_xor(s2, 32); ss[qt] = s2;
        }
        __syncthreads();
        if (h == 0) { ssq[wid * 64 + r] = ss[0]; ssq[wid * 64 + 32 + r] = ss[1]; }
        __syncthreads();
        const float* gain = isB ? a.gain_b : a.gain_a;
#pragma unroll
        for (int qt = 0; qt < 2; ++qt) {
            float tot = 0.f;
#pragma unroll
            for (int w8 = 0; w8 < 8; ++w8) tot += ssq[w8 * 64 + 32 * qt + r];
            const float rs = rsqrtf(tot * (1.f / 512.f) + RMS_EPS);
            bf16_t* yp = a.y + (size_t)(b * SEQ + q0 + 32 * qt + r) * D_MODEL + (isB ? 512 : 0) + wid * 64;
#pragma unroll
            for (int dt = 0; dt < 2; ++dt)
#pragma unroll
                for (int g = 0; g < 4; ++g) {
                    const int d = 32 * dt + 8 * g + 4 * h; const f32x4 gn = *(const f32x4*)(gain + wid * 64 + d);
                    u32x2 o; o.x = cvt_pk_bf16(ot[dt][qt][4 * g] * rs * gn[0], ot[dt][qt][4 * g + 1] * rs * gn[1]); o.y = cvt_pk_bf16(ot[dt][qt][4 * g + 2] * rs * gn[2], ot[dt][qt][4 * g + 3] * rs * gn[3]);
                    *(u32x2*)(yp + d) = o;
                }
        }
    }
}


#define XB_TMO      128
#define XB_XCNT(j)  (256  + 64 * (j))
#define XB_XSUB(j)  (1280 + 64 * (j))
#define XB_XGEN(j)  (2304 + 64 * (j))
#define XB_TOP      3328
#define XB_TOPGEN   3392
#define XCD_BAR_WORDS 3456
#define XB_SPIN_CAP (1u << 18)
#define LAS __attribute__((address_space(3)))

__device__ __forceinline__ unsigned xb_ld(unsigned* p)              { return __hip_atomic_load(p, __ATOMIC_RELAXED, __HIP_MEMORY_SCOPE_AGENT); }
__device__ __forceinline__ unsigned xb_add(unsigned* p, unsigned v) { return __hip_atomic_fetch_add(p, v, __ATOMIC_RELAXED, __HIP_MEMORY_SCOPE_AGENT); }
__device__ __forceinline__ unsigned xb_xcc_id() { return (unsigned)__builtin_amdgcn_s_getreg((3 << 11) | 20) & 0xFu; }
#define XB_SPIN(cond, bar) do { unsigned _sp = 0; while (cond) { __builtin_amdgcn_s_sleep(1); \
    if ((++_sp & 255u) == 0u) { if (xb_ld(&(bar)[XB_TMO])) break; if (_sp > XB_SPIN_CAP) { atomicAdd(&(bar)[XB_TMO], 1u); break; } } } } while (0)

struct XcdBarrier {
    unsigned* bar; unsigned x;
    volatile LAS unsigned* st;
};

__device__ __forceinline__ XcdBarrier xcd_barrier_post(unsigned* bar, volatile LAS unsigned* st) {
    XcdBarrier b; b.bar = bar; b.x = xb_xcc_id(); b.st = st;
    if (threadIdx.x == 0) (void)xb_add(&bar[XB_XCNT(b.x)], 1u);
    return b;
}
__device__ __forceinline__ void xcd_barrier_complete(unsigned* bar, unsigned x, unsigned& nloc, unsigned& nx) {
    const unsigned G = gridDim.x * gridDim.y * gridDim.z;
    unsigned sum, cnt, mine, sp = 0u;
    for (;;) {
        sum = 0u; cnt = 0u; mine = 0u;
#pragma unroll
        for (unsigned j = 0; j < 16; ++j) { const unsigned c = xb_ld(&bar[XB_XCNT(j)]); sum += c; cnt += (c > 0u) ? 1u : 0u; mine = (j == x) ? c : mine; }
        if (sum == G) break;
        __builtin_amdgcn_s_sleep(1);
        if ((++sp & 255u) == 0u) { if (xb_ld(&bar[XB_TMO])) break; if (sp > XB_SPIN_CAP) { atomicAdd(&bar[XB_TMO], 1u); break; } }
    }
    nloc = mine > 0u ? mine : 1u; nx = cnt > 0u ? cnt : 1u;
}

__device__ __forceinline__ void xcd_barrier(const XcdBarrier& b) {
    asm volatile("s_waitcnt vmcnt(0)" ::: "memory");
    __syncthreads();
    if (threadIdx.x == 0) {
        unsigned* bar = b.bar;
        __builtin_amdgcn_s_waitcnt(0);
        unsigned nloc = b.st[0], nx = b.st[1];
        if (nloc == 0u) { xcd_barrier_complete(bar, b.x, nloc, nx); b.st[0] = nloc; b.st[1] = nx; }
        const unsigned old = xb_add(&bar[XB_XSUB(b.x)], 1u);
        const unsigned gen = old / nloc;
        if (old + 1u == (gen + 1u) * nloc) {
            __builtin_amdgcn_fence(__ATOMIC_RELEASE, "agent");
            asm volatile("s_waitcnt vmcnt(0)" ::: "memory");
            const unsigned og = xb_add(&bar[XB_TOP], 1u);
            const unsigned tg = og / nx;
            if (og + 1u == (tg + 1u) * nx) xb_add(&bar[XB_TOPGEN], 1u);
            else XB_SPIN(xb_ld(&bar[XB_TOPGEN]) == tg, bar);
            __builtin_amdgcn_fence(__ATOMIC_ACQUIRE, "agent");
            xb_add(&bar[XB_XGEN(b.x)], 1u);
            asm volatile("s_waitcnt vmcnt(0)" ::: "memory");
        } else {
            XB_SPIN(xb_ld(&bar[XB_XGEN(b.x)]) == gen, bar);
            __builtin_amdgcn_fence(__ATOMIC_ACQUIRE, "agent");
            asm volatile("s_waitcnt vmcnt(0)" ::: "memory");
        }
    }
    __syncthreads();
}


struct MegaArgs { P0Args p0; P1Args p1; P2Args p2; P3Args p3; P4Args p4; P6Args p6; P7Args p7; P8Args p8; unsigned* bar; };
__global__ __launch_bounds__(NTHR, 2) void k_mega(MegaArgs a) {
    extern __shared__ __attribute__((aligned(16))) char smem[];
    volatile LAS unsigned* xbw = (volatile LAS unsigned*)(smem + LDS_BYTES - 16);
    if (threadIdx.x == 0) { xbw[0] = 0u; xbw[1] = 0u; xbw[2] = 0u; xbw[3] = 0u; }
    __syncthreads();
    XcdBarrier bar = xcd_barrier_post(a.bar, xbw);
    LAS unsigned char* L = (LAS unsigned char*)smem;
    phase_prologue(a.p0, smem);     xcd_barrier(bar);
    phase_qkv(a.p1, L);             xcd_barrier(bar);
    phase_attn(a.p2, smem);         xcd_barrier(bar);
    phase_outproj(a.p3, L);         xcd_barrier(bar);
    phase_router(a.p4, smem);       xcd_barrier(bar);
    phase_moe_gu(a.p6, smem, L);    xcd_barrier(bar);
    phase_moe_down(a.p7, smem, L);  xcd_barrier(bar);
    phase_combine(a.p8, smem);
}

extern "C" void kernel_launch(void* const* d_in, const int* in_sizes, int n_in, void* d_out, int out_size, void* d_ws, size_t ws_size, hipStream_t stream) {
    const float* x = (const float*)d_in[0];      const float* w_in = (const float*)d_in[1];   const float* rel_bias = (const float*)d_in[2];
    const float* gain_a = (const float*)d_in[3]; const float* gain_b = (const float*)d_in[4]; const float* w_out = (const float*)d_in[5];
    const float* ln1_g = (const float*)d_in[6];  const float* ln1_b = (const float*)d_in[7];  const float* router_w = (const float*)d_in[8];
    const float* router_bias = (const float*)d_in[9]; const float* w_gate = (const float*)d_in[10]; const float* w_up = (const float*)d_in[11];
    const float* w_down = (const float*)d_in[12]; const float* ws_gate = (const float*)d_in[13]; const float* ws_up = (const float*)d_in[14];
    const float* ws_down = (const float*)d_in[15]; const float* ln2_g = (const float*)d_in[16]; const float* ln2_b = (const float*)d_in[17];
    char* ws = (char*)d_ws; float* out = (float*)d_out;
    int* ctrl = (int*)(ws + OFF_CTRL); int* counts = ctrl + CW_COUNTS;
    bf16_t* X1 = (bf16_t*)(ws + OFF_X1); int* tokl = (int*)(ws + OFF_TOKL); float* gatel = (float*)(ws + OFF_GATEL);
    int* eidx = (int*)(ws + OFF_EIDX); float* gate = (float*)(ws + OFF_GATE); int* slot = (int*)(ws + OFF_SLOT);
    bf16_t* H = (bf16_t*)(ws + OFF_H); bf16_t* Y = (bf16_t*)(ws + OFF_Y);
    bf16_t* Q = (bf16_t*)(ws + OFF_Q); bf16_t* Kb = (bf16_t*)(ws + OFF_K); bf16_t* Vt = (bf16_t*)(ws + OFF_VT);
    bf16_t* yatt = (bf16_t*)(ws + OFF_YATT); bf16_t* r = (bf16_t*)(ws + OFF_R);
    bf16_t* xb = (bf16_t*)(ws + OFF_XB); float* stats = (float*)(ws + OFF_STATS);
    bf16_t* wt_in = (bf16_t*)(ws + OFF_WTIN); bf16_t* wt_out = (bf16_t*)(ws + OFF_WTOUT); bf16_t* wt_r = (bf16_t*)(ws + OFF_WTR);
    bf16_t* wgut = (bf16_t*)(ws + OFF_WGUT); bf16_t* wdt = (bf16_t*)(ws + OFF_WDT);
    if (ws_size < WS_NEEDED) { fprintf(stderr, "kernel_launch: workspace too small (%zu < %zu)\n", ws_size, (size_t)WS_NEEDED); return; }
    hipMemsetAsync(ctrl, 0, 64 * 1024, stream);
    static bool attr_done = false;
    if (!attr_done) {
        hipFuncSetAttribute((const void*)k_mega, hipFuncAttributeMaxDynamicSharedMemorySize, LDS_BYTES);
        attr_done = true;
    }
    MegaArgs m{};
    m.p0 = P0Args{x, w_in, w_out, router_w, xb, wt_in, wt_out, wt_r, w_gate, w_up, w_down, ws_gate, ws_up, ws_down, wgut, wdt};
    m.p1 = P1Args{xb, wt_in, Q, Kb, Vt};
    m.p2 = P2Args{Q, Kb, Vt, rel_bias, gain_a, gain_b, yatt};
    m.p3 = P3Args{yatt, wt_out, x, r, stats};
    m.p4 = P4Args{r, stats, ln1_g, ln1_b, X1, wt_r, router_bias, eidx, gate, counts, tokl, gatel, slot};
    m.p6 = P6Args{X1, counts, tokl, wgut, H};
    m.p7 = P7Args{H, counts, gatel, wdt, Y};
    m.p8 = P8Args{X1, Y, slot, counts, ln2_g, ln2_b, out};
    m.bar = (unsigned*)ctrl;
    k_mega<<<GRID, NTHR, LDS_BYTES, stream>>>(m);
}
```

```cpp
#include <hip/hip_runtime.h>
#include <cstdint>
#include <cstdio>

typedef unsigned short bf16_t;

constexpr int D_MODEL = 1024, BATCH = 16, SEQ = 2048, T_TOK = BATCH * SEQ;
constexpr int HEAD_DIM = 64, NHA = 8, NHB = 8, NHH = 16;
constexpr int CHUNK = 64, LEFT_CHUNKS = 8, MAX_REL = 128;
constexpr int N_EXP = 256, TOP_K = 8, N_GROUPS = 8, TOPK_GROUPS = 4, EPG = 32, D_EXP = 256;
constexpr float ROUTED_SCALE = 2.5f, LN_EPS = 1e-5f, RMS_EPS = 1e-6f;
constexpr float DN_ALPHA = 1.189207115002721f;
constexpr float LOG2E = 1.4426950408889634f, LN2 = 0.6931471805599453f;
constexpr float QSCALE = 0.125f * LOG2E;
constexpr int CAP = T_TOK;
constexpr int ROWS_ALL = T_TOK * TOP_K + T_TOK;

__device__ __forceinline__ float bf2f(bf16_t v) { return __uint_as_float(((unsigned)v) << 16); }
__device__ __forceinline__ bf16_t f2bf(float f) { unsigned u = __float_as_uint(f); u += 0x7fffu + ((u >> 16) & 1u); return (bf16_t)(u >> 16); }

constexpr size_t MB = 1024ull * 1024ull;
constexpr size_t OFF_CTRL   = 0;
constexpr size_t OFF_X1     = 1 * MB;
constexpr size_t OFF_TOKL   = OFF_X1 + 64 * MB;
constexpr size_t OFF_GATEL  = OFF_TOKL + 32 * MB;
constexpr size_t OFF_EIDX   = OFF_GATEL + 32 * MB;
constexpr size_t OFF_GATE   = OFF_EIDX + 1 * MB;
constexpr size_t OFF_SLOT   = OFF_GATE + 1 * MB;
constexpr size_t OFF_WDT    = OFF_SLOT + 1 * MB;
constexpr size_t OFF_BIG    = OFF_WDT + 129 * MB;
constexpr size_t OFF_H      = OFF_BIG;
constexpr size_t OFF_Y      = OFF_BIG + 144 * MB;
constexpr size_t OFF_Q      = OFF_BIG;
constexpr size_t OFF_K      = OFF_BIG + 64 * MB;
constexpr size_t OFF_VT     = OFF_BIG + 128 * MB;
constexpr size_t OFF_YATT   = OFF_BIG + 192 * MB;
constexpr size_t OFF_R      = OFF_BIG + 256 * MB;
constexpr size_t OFF_XB     = OFF_BIG + 320 * MB;
constexpr size_t OFF_STATS  = OFF_BIG + 384 * MB;
constexpr size_t OFF_WTIN   = OFF_BIG + 392 * MB;
constexpr size_t OFF_WTOUT  = OFF_BIG + 398 * MB;
constexpr size_t OFF_WTR    = OFF_BIG + 400 * MB;
constexpr size_t OFF_WGUT   = OFF_BIG + 401 * MB;
constexpr size_t WS_NEEDED  = OFF_BIG + 720 * MB;
static_assert(OFF_WGUT + 257 * MB <= WS_NEEDED && WS_NEEDED <= 1024 * MB, "workspace map");
constexpr int CW_COUNTS = 4096;

typedef short bf16x8 __attribute__((ext_vector_type(8)));
typedef float f32x4 __attribute__((ext_vector_type(4)));
typedef float f32x2 __attribute__((ext_vector_type(2)));
typedef float f32x16 __attribute__((ext_vector_type(16)));
typedef unsigned u32x4 __attribute__((ext_vector_type(4)));
typedef unsigned u32x2 __attribute__((ext_vector_type(2)));
#define DI __device__ __forceinline__
constexpr int NTHR = 512, GRID = 256;
DI int tidx() { int t = threadIdx.x; asm volatile("" : "+v"(t)); return t; }
constexpr int LDS_BYTES = 160 * 1024;

typedef __bf16 bf16x2_t __attribute__((ext_vector_type(2)));
DI unsigned cvt_pk_bf16(float lo, float hi) { f32x2 v = {lo, hi}; bf16x2_t r = __builtin_convertvector(v, bf16x2_t); return __builtin_bit_cast(unsigned, r); }
DI int vblock() { return (int)((blockIdx.x & 7) * (GRID / 8) + (blockIdx.x >> 3)); }

template <int MT> struct Tile { static constexpr int BM = 32 * MT, A_BYTES = BM * 128, B_BYTES = 256 * 128, STAGE = A_BYTES + B_BYTES; };

template <int MT> struct ALoader {
    const bf16_t* p[MT / 2]; u32x4 v[MT / 2]; int off0;
    DI void init_rows(const bf16_t* A, int lda, int row0) {
        const int tid = tidx(), kc = tid & 7, r = tid >> 3;
#pragma unroll
        for (int i = 0; i < MT / 2; ++i) p[i] = A + (size_t)(row0 + r + 64 * i) * lda + kc * 8;
        off0 = r * 128 + ((kc ^ ((r >> 1) & 7)) << 4);
    }
    DI void init_gather(const bf16_t* A, int lda, const int* rows, int cnt, int m0) {
        const int tid = tidx(), kc = tid & 7, r = tid >> 3;
#pragma unroll
        for (int i = 0; i < MT / 2; ++i) { int rr = m0 + r + 64 * i; rr = rr < cnt ? rr : cnt - 1; const int g = rows ? rows[rr] : rr; p[i] = A + (size_t)g * lda + kc * 8; }
        off0 = r * 128 + ((kc ^ ((r >> 1) & 7)) << 4);
    }
    DI void load(int k0) {
#pragma unroll
        for (int i = 0; i < MT / 2; ++i) v[i] = *(const u32x4*)(p[i] + k0);
    }
    DI void store(char* ldsA) const {
#pragma unroll
        for (int i = 0; i < MT / 2; ++i) *(u32x4*)(ldsA + off0 + i * 8192) = v[i];
    }
};
struct BLoaderBt {
    const bf16_t* p[4]; u32x4 v[4]; int off0;
    DI void init(const bf16_t* Bt, int ldk, int n0) {
        const int tid = tidx(), kc = tid & 7, r = tid >> 3;
#pragma unroll
        for (int i = 0; i < 4; ++i) p[i] = Bt + (size_t)(n0 + r + 64 * i) * ldk + kc * 8;
        off0 = r * 128 + ((kc ^ ((r >> 1) & 7)) << 4);
    }
    DI void load(int k0) {
#pragma unroll
        for (int i = 0; i < 4; ++i) v[i] = *(const u32x4*)(p[i] + k0);
    }
    DI void store(char* ldsB) const {
#pragma unroll
        for (int i = 0; i < 4; ++i) *(u32x4*)(ldsB + off0 + i * 8192) = v[i];
    }
};
template <bool GU> struct BLoaderF32 {
    const float* p[2]; int ldb; f32x2 v[2][8]; int off[2][2];
    DI void init(const float* P0, const float* P1, int ldb_) {
        const int tid = tidx(), l = tid & 63, w = tid >> 6; ldb = ldb_;
        p[0] = P0 + (size_t)(8 * w) * ldb + 2 * l; p[1] = P1 + (size_t)(8 * w) * ldb + 2 * l;
#pragma unroll
        for (int jp = 0; jp < 2; ++jp)
#pragma unroll
            for (int jj = 0; jj < 2; ++jj) { const int c = 2 * l + jj; const int row = GU ? (64 * (c >> 5) + 32 * jp + (c & 31)) : (128 * jp + c); off[jp][jj] = row * 128 + ((w ^ ((row >> 1) & 7)) << 4); }
    }
    DI void load(int k0) {
#pragma unroll
        for (int jp = 0; jp < 2; ++jp)
#pragma unroll
            for (int kk = 0; kk < 8; ++kk) v[jp][kk] = *(const f32x2*)(p[jp] + (size_t)(k0 + kk) * ldb);
    }
    DI void store(char* ldsB) const {
#pragma unroll
        for (int jp = 0; jp < 2; ++jp) {
            u32x4 a, b;
            a.x = cvt_pk_bf16(v[jp][0].x, v[jp][1].x); a.y = cvt_pk_bf16(v[jp][2].x, v[jp][3].x); a.z = cvt_pk_bf16(v[jp][4].x, v[jp][5].x); a.w = cvt_pk_bf16(v[jp][6].x, v[jp][7].x);
            b.x = cvt_pk_bf16(v[jp][0].y, v[jp][1].y); b.y = cvt_pk_bf16(v[jp][2].y, v[jp][3].y); b.z = cvt_pk_bf16(v[jp][4].y, v[jp][5].y); b.w = cvt_pk_bf16(v[jp][6].y, v[jp][7].y);
            *(u32x4*)(ldsB + off[jp][0]) = a; *(u32x4*)(ldsB + off[jp][1]) = b;
        }
    }
};

template <int MT, bool TR, class AL, class BL>
DI void gemm_tile(char* lds, AL& al, BL& bl, int nk, f32x4 (&acc)[MT][4]) {
    typedef Tile<MT> TT;
    const int tid = tidx(), wid = tid >> 6, lane = tid & 63, wr = wid >> 2, wc = wid & 3, fr = lane & 15, fq = lane >> 4;
#pragma unroll
    for (int m = 0; m < MT; ++m)
#pragma unroll
        for (int n = 0; n < 4; ++n) acc[m][n] = (f32x4){0.f, 0.f, 0.f, 0.f};
    int aoff[2], boff[2];
#pragma unroll
    for (int ks = 0; ks < 2; ++ks) { const int ch = (((4 * ks + fq) ^ (fr >> 1)) << 4); aoff[ks] = (16 * MT * wr + fr) * 128 + ch; boff[ks] = TT::A_BYTES + (64 * wc + fr) * 128 + ch; }
    al.load(0); bl.load(0);
    __syncthreads();
    al.store(lds); bl.store(lds + TT::A_BYTES);
    __syncthreads();
    for (int kt = 0; kt < nk; ++kt) {
        char* cur = lds + (kt & 1) * TT::STAGE; char* nxt = lds + ((kt & 1) ^ 1) * TT::STAGE;
        const bool more = kt + 1 < nk;
        if (more) { al.load((kt + 1) * 64); bl.load((kt + 1) * 64); }
#pragma unroll
        for (int ks = 0; ks < 2; ++ks) {
            bf16x8 a[MT], b[4];
#pragma unroll
            for (int m = 0; m < MT; ++m) a[m] = *(const bf16x8*)(cur + aoff[ks] + m * 2048);
#pragma unroll
            for (int n = 0; n < 4; ++n) b[n] = *(const bf16x8*)(cur + boff[ks] + n * 2048);
#pragma unroll
            for (int m = 0; m < MT; ++m)
#pragma unroll
                for (int n = 0; n < 4; ++n)
                    acc[m][n] = TR ? __builtin_amdgcn_mfma_f32_16x16x32_bf16(b[n], a[m], acc[m][n], 0, 0, 0) : __builtin_amdgcn_mfma_f32_16x16x32_bf16(a[m], b[n], acc[m][n], 0, 0, 0);
        }
        if (more) { al.store(nxt); bl.store(nxt + TT::A_BYTES); }
        __syncthreads();
    }
}

#define LAS __attribute__((address_space(3)))
namespace gs {
constexpr int BM = 256, BK = 64, HALF = 128, HTB = HALF * BK * 2, STAGE_BYTES = 8 * HTB;
DI int lds_byte(int r, int c) { const int st = (r >> 4) * 2 + (c >> 5), rr = r & 15, cc = c & 31, ob = rr * 64 + cc * 2; return st * 1024 + (ob ^ (((ob >> 9) & 1) << 5)); }
DI void stage_rc(int b, int& R, int& C) { const int st = b / 1024, sb = b % 1024, swz = sb ^ (((sb >> 9) & 1) << 5); R = (st >> 1) * 16 + swz / 64; C = (st & 1) * 32 + (swz % 64) / 2; }
DI int perm32(int rho) { const int n = rho >> 4, i = rho & 15; return 8 * (i >> 2) + 4 * n + (i & 3); }
template <bool TR, bool PERM, class Sched, class Epi>
DI void gemm_stream(LAS unsigned char* lds, const int K, const Sched& S, const Epi& E) {
    typedef typename Sched::U U;
    const int tid = tidx(), wid = __builtin_amdgcn_readfirstlane(tid >> 6), lane = tid & 63, wr = wid >> 2, wc = wid & 3, fr = lane & 15, fq = lane >> 4;
    const int nt = K / BK;
    int R[2], C[2]; unsigned voffB[2];
#pragma unroll
    for (int i = 0; i < 2; ++i) { stage_rc(tid * 16 + i * 8192, R[i], C[i]); const int Rb = PERM ? ((R[i] & ~31) + perm32(R[i] & 31)) : R[i]; voffB[i] = (unsigned)(Rb * K + C[i]) * 2u; }
    const size_t kstep = (size_t)(BK * 2), hstepB = (size_t)HALF * K * 2;
    const unsigned ldsw = (unsigned)wid * 1024u;
    const int aoff = lds_byte(wr * 64 + fr, fq * 8), boff = lds_byte(wc * 32 + fr, fq * 8);
#define GS_SA(b, h) (((b) * 2 + (h)) * HTB)
#define GS_SB(b, h) ((4 + (b) * 2 + (h)) * HTB)
#define GS_STAGE(bufoff, gbase, voff) do { _Pragma("unroll") for (int _i = 0; _i < 2; ++_i) \
        __builtin_amdgcn_global_load_lds((const unsigned*)((const char*)(gbase) + (voff)[_i]), (LAS unsigned*)(lds + (bufoff) + ldsw + _i * 8192), 16, 0, 0); } while (0)
#define GS_LDA(dst, b, h) do { _Pragma("unroll") for (int m = 0; m < 4; ++m) _Pragma("unroll") for (int k = 0; k < 2; ++k) dst[m][k] = *(const LAS bf16x8*)(lds + GS_SA(b, h) + aoff + m * 2048 + k * 1024); } while (0)
#define GS_LDB(dst, b, h) do { _Pragma("unroll") for (int n = 0; n < 2; ++n) _Pragma("unroll") for (int k = 0; k < 2; ++k) dst[n][k] = *(const LAS bf16x8*)(lds + GS_SB(b, h) + boff + n * 2048 + k * 1024); } while (0)
#define GS_MMA(ai, bj, At, Bt) do { __builtin_amdgcn_s_setprio(1); _Pragma("unroll") for (int m = 0; m < 4; ++m) _Pragma("unroll") for (int n = 0; n < 2; ++n) _Pragma("unroll") for (int k = 0; k < 2; ++k) \
        acc[ai][bj][m][n] = TR ? __builtin_amdgcn_mfma_f32_16x16x32_bf16(Bt[n][k], At[m][k], acc[ai][bj][m][n], 0, 0, 0) : __builtin_amdgcn_mfma_f32_16x16x32_bf16(At[m][k], Bt[n][k], acc[ai][bj][m][n], 0, 0, 0); \
        __builtin_amdgcn_s_setprio(0); } while (0)
#define GS_WAIT_V(n) asm volatile("s_waitcnt vmcnt(" #n ")" ::: "memory")
#define GS_WAIT_L(n) asm volatile("s_waitcnt lgkmcnt(" #n ")" ::: "memory")
#define GS_BAR __builtin_amdgcn_s_barrier()
#define GS_SCHED __builtin_amdgcn_sched_barrier(0)
    U cur, nxt; int ui = 0;
    if (!S.next(0, cur)) return;
    f32x4 acc[2][2][4][2];
#pragma unroll
    for (int a = 0; a < 2; ++a)
#pragma unroll
        for (int b = 0; b < 2; ++b)
#pragma unroll
            for (int m = 0; m < 4; ++m)
#pragma unroll
                for (int n = 0; n < 2; ++n) acc[a][b][m][n] = (f32x4){0.f, 0.f, 0.f, 0.f};
    bf16x8 At[4][2], B0[2][2], B1[2][2];
    unsigned cvo[2][2], nvo[2][2];
    S.a_off(0, cur, R, C, cvo);
    const char* cA = cur.A; const char* cB = cur.B;
    GS_STAGE(GS_SB(0, 0), cB, voffB); GS_STAGE(GS_SB(0, 1), cB + hstepB, voffB); GS_STAGE(GS_SA(0, 0), cA, cvo[0]); GS_STAGE(GS_SA(0, 1), cA, cvo[1]);
    if (wr == 1) GS_BAR;
    GS_WAIT_V(2); GS_BAR;
    GS_STAGE(GS_SB(1, 0), cB + kstep, voffB); GS_STAGE(GS_SA(1, 0), cA + kstep, cvo[0]); GS_STAGE(GS_SB(1, 1), cB + hstepB + kstep, voffB);
    GS_WAIT_V(6); GS_BAR;
    for (;;) {
        const bool has_next = S.next(ui + 1, nxt);
        if (has_next) S.a_off(ui + 1, nxt, R, C, nvo);
        else { nvo[0][0] = cvo[0][0]; nvo[0][1] = cvo[0][1]; nvo[1][0] = cvo[1][0]; nvo[1][1] = cvo[1][1]; }
        const char* nA = has_next ? nxt.A : cA; const char* nB = has_next ? nxt.B : cB;
#pragma unroll 1
        for (int t = 0; t < nt; t += 2) {
            const bool last = (t == nt - 2);
            const char* a1 = cA + (size_t)(t + 1) * kstep;
            const char* a2 = last ? nA : cA + (size_t)(t + 2) * kstep; const char* b2 = last ? nB : cB + (size_t)(t + 2) * kstep;
            const char* a3 = a2 + kstep; const char* b3 = b2 + kstep;
            unsigned v2[2][2];
            v2[0][0] = last ? nvo[0][0] : cvo[0][0]; v2[0][1] = last ? nvo[0][1] : cvo[0][1]; v2[1][0] = last ? nvo[1][0] : cvo[1][0]; v2[1][1] = last ? nvo[1][1] : cvo[1][1];
            GS_LDB(B0, 0, 0); GS_LDB(B1, 0, 1); GS_SCHED; GS_LDA(At, 0, 0); GS_STAGE(GS_SA(1, 1), a1, cvo[1]);
            GS_WAIT_V(8); GS_WAIT_L(0); GS_BAR; GS_MMA(0, 0, At, B0); GS_MMA(0, 1, At, B1); GS_BAR; GS_SCHED;
            GS_LDA(At, 0, 1); GS_STAGE(GS_SB(0, 0), b2, voffB); GS_STAGE(GS_SB(0, 1), b2 + hstepB, voffB); GS_STAGE(GS_SA(0, 0), a2, v2[0]);
            GS_WAIT_V(8); GS_WAIT_L(0); GS_BAR; GS_MMA(1, 0, At, B0); GS_MMA(1, 1, At, B1); GS_BAR; GS_SCHED;
            GS_LDB(B0, 1, 0); GS_LDB(B1, 1, 1); GS_SCHED; GS_LDA(At, 1, 0); GS_STAGE(GS_SA(0, 1), a2, v2[1]);
            GS_WAIT_V(8); GS_WAIT_L(0); GS_BAR; GS_MMA(0, 0, At, B0); GS_MMA(0, 1, At, B1); GS_BAR; GS_SCHED;
            GS_LDA(At, 1, 1); GS_STAGE(GS_SB(1, 0), b3, voffB); GS_STAGE(GS_SB(1, 1), b3 + hstepB, voffB); GS_STAGE(GS_SA(1, 0), a3, v2[0]);
            GS_WAIT_V(8); GS_WAIT_L(0); GS_BAR; GS_MMA(1, 0, At, B0); GS_MMA(1, 1, At, B1); GS_BAR; GS_SCHED;
        }
        if (wr == 0) GS_BAR;
        E(acc, cur, wr, wc, fr, fq);
        if (!has_next) break;
#pragma unroll
        for (int a = 0; a < 2; ++a)
#pragma unroll
            for (int b = 0; b < 2; ++b)
#pragma unroll
                for (int m = 0; m < 4; ++m)
#pragma unroll
                    for (int n = 0; n < 2; ++n) acc[a][b][m][n] = (f32x4){0.f, 0.f, 0.f, 0.f};
        cur = nxt; cA = nA; cB = nB; ++ui;
        cvo[0][0] = nvo[0][0]; cvo[0][1] = nvo[0][1]; cvo[1][0] = nvo[1][0]; cvo[1][1] = nvo[1][1];
        if (wr == 1) GS_BAR;
    }
    GS_WAIT_V(0);
    GS_BAR;
#undef GS_SA
#undef GS_SB
#undef GS_STAGE
#undef GS_LDA
#undef GS_LDB
#undef GS_MMA
#undef GS_WAIT_V
#undef GS_WAIT_L
#undef GS_BAR
#undef GS_SCHED
}
struct DenseU { const char* A; const char* B; int pm, pn; };
struct DenseSched {
    typedef DenseU U;
    const bf16_t* A; const bf16_t* Bt; int K, nunits, first, stride, npn, pn_base, pn_mod0, pn_mod1;
    DI int colmap(int q) const { return pn_base + (q / pn_mod0) * pn_mod1 + (q % pn_mod0); }
    DI bool next(int i, U& u) const {
        const int L = first + i * stride; if (L >= nunits) return false;
        u.pm = L / npn; u.pn = colmap(L % npn);
        u.A = (const char*)A + (size_t)u.pm * BM * K * 2; u.B = (const char*)Bt + (size_t)u.pn * BM * K * 2; return true;
    }
    DI void a_off(int, const U&, const int (&R)[2], const int (&C)[2], unsigned (&vo)[2][2]) const {
#pragma unroll
        for (int h = 0; h < 2; ++h)
#pragma unroll
            for (int i = 0; i < 2; ++i) vo[h][i] = (unsigned)((HALF * h + R[i]) * K + C[i]) * 2u;
    }
};
}

DI void transpose_cvt(const float* W, bf16_t* Wt, int K, int N, int unit, char* lds) {
    float* tile = (float*)lds;
    const int nbn = N / 64, kb = unit / nbn, nb = unit % nbn, tid = tidx();
    __syncthreads();
#pragma unroll
    for (int i = 0; i < 8; ++i) { const int idx = tid + i * 512, r = idx >> 6, c = idx & 63; tile[r * 65 + c] = W[(size_t)(kb * 64 + r) * N + nb * 64 + c]; }
    __syncthreads();
#pragma unroll
    for (int i = 0; i < 8; ++i) { const int idx = tid + i * 512, n = idx >> 6, k = idx & 63; Wt[(size_t)(nb * 64 + n) * K + kb * 64 + k] = f2bf(tile[k * 65 + n]); }
}
struct P0Args { const float* x; const float* w_in; const float* w_out; const float* router_w; bf16_t* xb; bf16_t* wt_in; bf16_t* wt_out; bf16_t* wt_r;
                const float* w_gate; const float* w_up; const float* w_down; const float* ws_gate; const float* ws_up; const float* ws_down; bf16_t* wgut; bf16_t* wdt; };
DI void convert_item(const float* src, int ld, bf16_t* dst, int ldd, int rbase, int rhi, char* lds) {
    float* tile = (float*)lds;
    const int tid = tidx();
    f32x4 v[8];
#pragma unroll
    for (int i = 0; i < 8; ++i) { const int idx = tid + i * 512, k = idx >> 6, n4 = idx & 63; v[i] = *(const f32x4*)(src + (size_t)k * ld + 4 * n4); }
    __syncthreads();
#pragma unroll
    for (int i = 0; i < 8; ++i) { const int idx = tid + i * 512, k = idx >> 6, n4 = idx & 63; float* p = tile + k * 257 + 4 * n4; p[0] = v[i][0]; p[1] = v[i][1]; p[2] = v[i][2]; p[3] = v[i][3]; }
    __syncthreads();
#pragma unroll
    for (int i = 0; i < 4; ++i) {
        const int idx = tid + i * 512, kc = idx & 7, n = idx >> 3; const float* p = tile + (8 * kc) * 257 + n;
        u32x4 o; o.x = cvt_pk_bf16(p[0], p[257]); o.y = cvt_pk_bf16(p[2 * 257], p[3 * 257]); o.z = cvt_pk_bf16(p[4 * 257], p[5 * 257]); o.w = cvt_pk_bf16(p[6 * 257], p[7 * 257]);
        *(u32x4*)(dst + (size_t)(rbase + (n >> 7) * rhi + (n & 127)) * ldd + 8 * kc) = o;
    }
}
constexpr int CV_GU = 257 * 2 * 16, CV_DN = 257 * 16;
DI void convert_moe_item(const P0Args& a, int it, char* lds) {
    if (it < CV_GU) {
        const int e = it / 32, u = (it >> 4) & 1, kt = it & 15;
        const float* W = e < N_EXP ? (u ? a.w_up : a.w_gate) + (size_t)e * D_MODEL * D_EXP : (u ? a.ws_up : a.ws_gate);
        convert_item(W + (size_t)kt * 64 * D_EXP, D_EXP, a.wgut + (size_t)e * 512 * D_MODEL + kt * 64, D_MODEL, 128 * u, 256, lds);
    } else {
        const int j = it - CV_GU, e = j / 16, kt = (j >> 2) & 3, nb = j & 3;
        const float* W = e < N_EXP ? a.w_down + (size_t)e * D_EXP * D_MODEL : a.ws_down;
        convert_item(W + (size_t)kt * 64 * D_MODEL + nb * 256, D_MODEL, a.wdt + (size_t)e * D_MODEL * D_EXP + kt * 64, D_EXP, 256 * nb, 128, lds);
    }
}
DI void phase_prologue(const P0Args& a, char* lds) {
    const int vb = vblock();
    for (size_t i = (size_t)vb * NTHR + tidx(); i < (size_t)T_TOK * D_MODEL / 8; i += (size_t)GRID * NTHR) {
        const f32x4 v0 = *(const f32x4*)(a.x + i * 8), v1 = *(const f32x4*)(a.x + i * 8 + 4);
        u32x4 o; o.x = cvt_pk_bf16(v0[0], v0[1]); o.y = cvt_pk_bf16(v0[2], v0[3]); o.z = cvt_pk_bf16(v1[0], v1[1]); o.w = cvt_pk_bf16(v1[2], v1[3]);
        *(u32x4*)(a.xb + i * 8) = o;
    }
    const int n_in = (1024 / 64) * (3072 / 64), n_out = 16 * 16, n_r = 16 * 4;
    for (int u = vb; u < n_in + n_out + n_r; u += GRID) {
        if (u < n_in) transpose_cvt(a.w_in, a.wt_in, 1024, 3072, u, lds);
        else if (u < n_in + n_out) transpose_cvt(a.w_out, a.wt_out, 1024, 1024, u - n_in, lds);
        else transpose_cvt(a.router_w, a.wt_r, 1024, 256, u - n_in - n_out, lds);
    }
}
DI void convert_moe_all(const P0Args& a, char* lds) { for (int it = vblock(); it < CV_GU + CV_DN; it += GRID) convert_moe_item(a, it, lds); }

struct P1Args { const bf16_t* xb; const bf16_t* wt_in; bf16_t* Q; bf16_t* Kb; bf16_t* Vt; };
struct EpiQK { bf16_t* Q; bf16_t* Kb;
    DI void operator()(const f32x4 (&acc)[2][2][4][2], const gs::DenseU& u, int wr, int wc, int fr, int fq) const {
        const int seg = u.pn >> 1, type = seg % 3, grp = seg / 3; bf16_t* dst = type == 0 ? Q : Kb; const float sc = type == 0 ? QSCALE : 1.f;
#pragma unroll
        for (int ai = 0; ai < 2; ++ai)
#pragma unroll
            for (int m = 0; m < 4; ++m) {
                const int row = u.pm * 256 + 128 * ai + 64 * wr + 16 * m + fr, b = row / SEQ, s = row % SEQ;
#pragma unroll
                for (int bj = 0; bj < 2; ++bj) {
                    const int hh = grp * 8 + 4 * (u.pn & 1) + 2 * bj + (wc >> 1), d0 = 32 * (wc & 1) + 8 * fq;
                    const f32x4 v0 = acc[ai][bj][m][0] * sc, v1 = acc[ai][bj][m][1] * sc;
                    u32x4 o; o.x = cvt_pk_bf16(v0[0], v0[1]); o.y = cvt_pk_bf16(v0[2], v0[3]); o.z = cvt_pk_bf16(v1[0], v1[1]); o.w = cvt_pk_bf16(v1[2], v1[3]);
                    *(u32x4*)(dst + ((size_t)(b * NHH + hh) * SEQ + s) * 64 + d0) = o;
                }
            }
    } };
struct EpiV { bf16_t* Vt;
    DI void operator()(const f32x4 (&acc)[2][2][4][2], const gs::DenseU& u, int wr, int wc, int fr, int fq) const {
        const int grp = (u.pn >> 1) / 3;
#pragma unroll
        for (int ai = 0; ai < 2; ++ai)
#pragma unroll
            for (int m = 0; m < 4; ++m) {
                const int row = u.pm * 256 + 128 * ai + 64 * wr + 16 * m + 4 * fq, b = row / SEQ, s = row % SEQ;
#pragma unroll
                for (int bj = 0; bj < 2; ++bj)
#pragma unroll
                    for (int n = 0; n < 2; ++n) {
                        const int hh = grp * 8 + 4 * (u.pn & 1) + 2 * bj + (wc >> 1), d = 32 * (wc & 1) + 16 * n + fr;
                        const f32x4 v = acc[ai][bj][m][n];
                        u32x2 o; o.x = cvt_pk_bf16(v[0], v[1]); o.y = cvt_pk_bf16(v[2], v[3]);
                        *(u32x2*)(Vt + ((size_t)(b * NHH + hh) * 64 + d) * SEQ + s) = o;
                    }
            }
    } };
DI void phase_qkv(const P1Args& a, LAS unsigned char* lds) {
    { gs::DenseSched S{a.xb, a.wt_in, D_MODEL, (T_TOK / 256) * 8, vblock(), GRID, 8, 0, 4, 6}; EpiQK E{a.Q, a.Kb}; gs::gemm_stream<true, true>(lds, D_MODEL, S, E); }
    { gs::DenseSched S{a.xb, a.wt_in, D_MODEL, (T_TOK / 256) * 4, vblock(), GRID, 4, 4, 2, 6}; EpiV E{a.Vt}; gs::gemm_stream<false, false>(lds, D_MODEL, S, E); }
}

struct P3Args { const bf16_t* y; const bf16_t* wt_out; const float* x; bf16_t* r; float* stats; };
struct EpiOut { const float* x; bf16_t* r; float* stats;
    DI void operator()(const f32x4 (&acc)[2][2][4][2], const gs::DenseU& u, int wr, int wc, int fr, int fq) const {
#pragma unroll
        for (int ai = 0; ai < 2; ++ai)
#pragma unroll
            for (int m = 0; m < 4; ++m) {
                const int row = u.pm * 256 + 128 * ai + 64 * wr + 16 * m + fr;
#pragma unroll
                for (int bj = 0; bj < 2; ++bj) {
                    const int col = u.pn * 256 + 128 * bj + 32 * wc + 8 * fq;
                    const f32x4 x0 = *(const f32x4*)(x + (size_t)row * D_MODEL + col), x1 = *(const f32x4*)(x + (size_t)row * D_MODEL + col + 4);
                    const f32x4 v0 = x0 * DN_ALPHA + acc[ai][bj][m][0], v1 = x1 * DN_ALPHA + acc[ai][bj][m][1];
                    float s = ((v0[0] + v0[1]) + (v0[2] + v0[3])) + ((v1[0] + v1[1]) + (v1[2] + v1[3]));
                    float q = ((v0[0] * v0[0] + v0[1] * v0[1]) + (v0[2] * v0[2] + v0[3] * v0[3])) + ((v1[0] * v1[0] + v1[1] * v1[1]) + (v1[2] * v1[2] + v1[3] * v1[3]));
                    u32x4 o; o.x = cvt_pk_bf16(v0[0], v0[1]); o.y = cvt_pk_bf16(v0[2], v0[3]); o.z = cvt_pk_bf16(v1[0], v1[1]); o.w = cvt_pk_bf16(v1[2], v1[3]);
                    *(u32x4*)(r + (size_t)row * D_MODEL + col) = o;
                    s += __shfl_xor(s, 16); s += __shfl_xor(s, 32); q += __shfl_xor(q, 16); q += __shfl_xor(q, 32);
                    if (fq == 0) *(f32x2*)(stats + ((size_t)row * 32 + u.pn * 8 + bj * 4 + wc) * 2) = (f32x2){s, q};
                }
            }
    } };
DI void phase_outproj(const P3Args& a, LAS unsigned char* lds) {
    gs::DenseSched S{a.y, a.wt_out, D_MODEL, (T_TOK / 256) * 4, vblock(), GRID, 4, 0, 4, 0}; EpiOut E{a.x, a.r, a.stats}; gs::gemm_stream<true, true>(lds, D_MODEL, S, E);
}

constexpr int RS_SC = 289;
constexpr int LDS_HIST = 100 * 1024;
struct P4Args { const bf16_t* r; const float* stats; const float* ln_g; const float* ln_b; bf16_t* x1; const bf16_t* wt_r; const float* rbias;
                int* eidx; float* gate; int* counts; int* tokl; float* gatel; int* slot; };
DI void phase_router(const P4Args& a, char* lds) {
    const int tid = tidx(), wid = tid >> 6, lane = tid & 63, wr = wid >> 2, wc = wid & 3, fr = lane & 15, fq = lane >> 4;
    float* sc = (float*)lds; int* hist = (int*)(lds + LDS_HIST); int* base = hist + 256;
    for (int u = vblock(); u < T_TOK / 128; u += GRID) {
        const int m0 = u * 128;
        for (int i = 0; i < 16; ++i) {
            const int t = m0 + wid * 16 + i;
            f32x2 st = (f32x2){0.f, 0.f};
            if (lane < 32) st = *(const f32x2*)(a.stats + ((size_t)t * 32 + lane) * 2);
            float s = st.x, q = st.y;
#pragma unroll
            for (int o = 1; o <= 16; o <<= 1) { s += __shfl_xor(s, o); q += __shfl_xor(q, o); }
            s = __shfl(s, 0); q = __shfl(q, 0);
            const float mu = s * (1.f / 1024.f), rstd = rsqrtf(q * (1.f / 1024.f) - mu * mu + LN_EPS);
            const u32x4 r0 = *(const u32x4*)(a.r + (size_t)t * D_MODEL + lane * 16), r1 = *(const u32x4*)(a.r + (size_t)t * D_MODEL + lane * 16 + 8);
            float v[16];
#pragma unroll
            for (int j = 0; j < 4; ++j) { v[2 * j] = __uint_as_float(r0[j] << 16); v[2 * j + 1] = __uint_as_float(r0[j] & 0xffff0000u); v[8 + 2 * j] = __uint_as_float(r1[j] << 16); v[8 + 2 * j + 1] = __uint_as_float(r1[j] & 0xffff0000u); }
            u32x4 o0, o1;
#pragma unroll
            for (int j = 0; j < 4; ++j) {
                const f32x4 g = *(const f32x4*)(a.ln_g + lane * 16 + 4 * j), bb = *(const f32x4*)(a.ln_b + lane * 16 + 4 * j);
                const float y0 = (v[4 * j] - mu) * rstd * g[0] + bb[0], y1 = (v[4 * j + 1] - mu) * rstd * g[1] + bb[1], y2 = (v[4 * j + 2] - mu) * rstd * g[2] + bb[2], y3 = (v[4 * j + 3] - mu) * rstd * g[3] + bb[3];
                const unsigned p0 = cvt_pk_bf16(y0, y1), p1 = cvt_pk_bf16(y2, y3);
                if (j < 2) { o0[2 * j] = p0; o0[2 * j + 1] = p1; } else { o1[2 * (j - 2)] = p0; o1[2 * (j - 2) + 1] = p1; }
            }
            *(u32x4*)(a.x1 + (size_t)t * D_MODEL + lane * 16) = o0; *(u32x4*)(a.x1 + (size_t)t * D_MODEL + lane * 16 + 8) = o1;
        }
        if (tid < 256) hist[tid] = 0;
        asm volatile("s_waitcnt vmcnt(0)" ::: "memory");
        __syncthreads();
        ALoader<4> al; al.init_rows(a.x1, D_MODEL, m0);
        BLoaderBt bl; bl.init(a.wt_r, D_MODEL, 0);
        f32x4 acc[4][4];
        gemm_tile<4, true>(lds, al, bl, D_MODEL / 64, acc);
        int my_idx[2], my_rank[2]; float my_gate[2];
#pragma unroll
        for (int p = 0; p < 2; ++p) {
            __syncthreads();
            if (wr == p) {
#pragma unroll
                for (int m = 0; m < 4; ++m)
#pragma unroll
                    for (int n = 0; n < 4; ++n) {
                        const int c0 = 64 * wc + 16 * n + 4 * fq; const f32x4 rb = *(const f32x4*)(a.rbias + c0);
#pragma unroll
                        for (int j = 0; j < 4; ++j) { const int c = c0 + j; sc[(16 * m + fr) * RS_SC + (c >> 5) * 36 + (c & 31)] = 1.f / (1.f + __expf(-acc[m][n][j])) + rb[j]; }
                    }
            }
            __syncthreads();
            const int row = tid >> 3, g = tid & 7, t = m0 + 64 * p + row;
            float sel[32];
#pragma unroll
            for (int i = 0; i < 32; ++i) sel[i] = sc[row * RS_SC + g * 36 + i];
            float m1 = -INFINITY, m2 = -INFINITY;
#pragma unroll
            for (int i = 0; i < 32; ++i) { const float v = sel[i]; m2 = fmaxf(m2, fminf(m1, v)); m1 = fmaxf(m1, v); }
            const float gs = m1 + m2; int rank = 0;
#pragma unroll
            for (int d = 1; d < 8; ++d) { const float o = __shfl_xor(gs, d); const int og = g ^ d; rank += (o > gs || (o == gs && og < g)) ? 1 : 0; }
            const bool en = rank < TOPK_GROUPS;
            float pv = INFINITY; int pi = -1; float myv = 0.f; int myi = 0;
#pragma unroll
            for (int k = 0; k < TOP_K; ++k) {
                float bv = -INFINITY; int bi = 1 << 20;
                if (en) {
#pragma unroll
                    for (int i = 0; i < 32; ++i) { const float v = sel[i]; const int e = g * 32 + i; const bool after = (v < pv) || (v == pv && e > pi); if (after && v > bv) { bv = v; bi = e; } }
                }
#pragma unroll
                for (int d = 1; d < 8; d <<= 1) { const float ov = __shfl_xor(bv, d); const int oi = __shfl_xor(bi, d); if (ov > bv || (ov == bv && oi < bi)) { bv = ov; bi = oi; } }
                pv = bv; pi = bi;
                if (g == k) { myv = bv; myi = bi; }
            }
            const float score = myv - a.rbias[myi];
            float gsum = score;
#pragma unroll
            for (int d = 1; d < 8; d <<= 1) gsum += __shfl_xor(gsum, d);
            const float gt = score / gsum * ROUTED_SCALE;
            a.eidx[t * TOP_K + g] = myi; a.gate[t * TOP_K + g] = gt;
            my_idx[p] = myi; my_gate[p] = gt; my_rank[p] = atomicAdd(&hist[myi], 1);
        }
        __syncthreads();
        if (tid < 256) { const int h = hist[tid]; base[tid] = h > 0 ? atomicAdd(&a.counts[tid], h) : 0; }
        __syncthreads();
#pragma unroll
        for (int p = 0; p < 2; ++p) {
            const int row = tid >> 3, g = tid & 7, t = m0 + 64 * p + row, e = my_idx[p], pos = base[e] + my_rank[p];
            a.tokl[(size_t)e * CAP + pos] = t; a.gatel[(size_t)e * CAP + pos] = my_gate[p]; a.slot[t * TOP_K + g] = e * CAP + pos;
        }
    }
}

constexpr int LDS_ROWTAB = 128 * 1024;
constexpr int LDS_GTAB = 139 * 1024;
constexpr int LDS_TAB = 150 * 1024;
constexpr int MOE_BM = 256;
DI void build_moe_tab(const int* counts, char* lds) {
    int* tstart = (int*)(lds + LDS_TAB); int* rstart = tstart + 264; int* cnts = tstart + 528;
    const int tid = tidx(), lane = tid & 63;
    __syncthreads();
    if (tid < 64) {
        int c[4], tl[4], cs = 0, ts = 0;
#pragma unroll
        for (int i = 0; i < 4; ++i) { c[i] = counts[lane * 4 + i]; tl[i] = (c[i] + MOE_BM - 1) / MOE_BM; cs += c[i]; ts += tl[i]; }
        int ci = cs, ti = ts;
#pragma unroll
        for (int o = 1; o < 64; o <<= 1) { const int n1 = __shfl_up(ci, o), n2 = __shfl_up(ti, o); if (lane >= o) { ci += n1; ti += n2; } }
        int ce = ci - cs, te = ti - ts;
#pragma unroll
        for (int i = 0; i < 4; ++i) { rstart[lane * 4 + i] = ce; tstart[lane * 4 + i] = te; cnts[lane * 4 + i] = c[i]; ce += c[i]; te += tl[i]; }
        if (lane == 63) { rstart[256] = ce; tstart[256] = te; cnts[256] = T_TOK; rstart[257] = ce + T_TOK; tstart[257] = te + T_TOK / MOE_BM; }
    }
    __syncthreads();
}
DI int find_expert(const int* tstart, int g) {
    int lo = 0, hi = 256;
#pragma unroll 1
    while (lo < hi) { const int mid = (lo + hi + 1) >> 1; if (tstart[mid] <= g) lo = mid; else hi = mid - 1; }
    return lo;
}
struct MoeU { const char* A; const char* B; int e, m0, st, cnt, sub; };

struct P6Args { const bf16_t* x1; const int* counts; const int* tokl; const float* gatel; const bf16_t* wgut; bf16_t* H; };
struct GuSched {
    typedef MoeU U;
    const int* tstart; const int* rstart; const int* rowtab; const bf16_t* x1; const bf16_t* wgut; int first, stride, nunits;
    DI bool next(int i, U& u) const {
        const int L = first + i * stride; if (L >= nunits) return false;
        const int g = L >> 1, e = find_expert(tstart, g);
        u.sub = L & 1; u.e = i; u.m0 = (g - tstart[e]) * MOE_BM; u.st = rstart[e]; u.cnt = tstart[528 + e];
        u.A = (const char*)x1; u.B = (const char*)(wgut + ((size_t)e * 512 + 256 * u.sub) * D_MODEL); return true;
    }
    DI void a_off(int i, const U&, const int (&R)[2], const int (&C)[2], unsigned (&vo)[2][2]) const {
#pragma unroll
        for (int h = 0; h < 2; ++h)
#pragma unroll
            for (int p = 0; p < 2; ++p) vo[h][p] = (unsigned)(rowtab[i * 256 + 128 * h + R[p]] * D_MODEL + C[p]) * 2u;
    }
};
struct EpiGU { bf16_t* H; const float* gtab;
    DI void operator()(const f32x4 (&acc)[2][2][4][2], const MoeU& u, int wr, int wc, int fr, int fq) const {
#pragma unroll
        for (int ai = 0; ai < 2; ++ai)
#pragma unroll
            for (int m = 0; m < 4; ++m) {
                const int row = u.m0 + 128 * ai + 64 * wr + 16 * m + fr;
                if (row < u.cnt) {
                    const float gt = gtab[u.e * 256 + 128 * ai + 64 * wr + 16 * m + fr];
                    float h[8];
#pragma unroll
                    for (int n = 0; n < 2; ++n)
#pragma unroll
                        for (int j = 0; j < 4; ++j) { const float gv = acc[ai][0][m][n][j]; h[4 * n + j] = gv * __builtin_amdgcn_rcpf(1.f + __expf(-gv)) * acc[ai][1][m][n][j] * gt; }
                    u32x4 o; o.x = cvt_pk_bf16(h[0], h[1]); o.y = cvt_pk_bf16(h[2], h[3]); o.z = cvt_pk_bf16(h[4], h[5]); o.w = cvt_pk_bf16(h[6], h[7]);
                    *(u32x4*)(H + (size_t)(u.st + row) * D_EXP + 128 * u.sub + 32 * wc + 8 * fq) = o;
                }
            }
    } };
DI void phase_moe_gu(const P6Args& a, char* smem, LAS unsigned char* lds) {
    build_moe_tab(a.counts, smem);
    const int* tstart = (const int*)(smem + LDS_TAB); const int* rstart = tstart + 264; int* rowtab = (int*)(smem + LDS_ROWTAB); float* gtab = (float*)(smem + LDS_GTAB);
    const int nunits = tstart[257] * 2, first = vblock();
    const int n_my = first < nunits ? (nunits - first + GRID - 1) / GRID : 0;
    for (int idx = tidx(); idx < n_my * 256; idx += NTHR) {
        const int i = idx >> 8, row = idx & 255, L = first + i * GRID, g = L >> 1, e = find_expert(tstart, g), m0 = (g - tstart[e]) * MOE_BM, cnt = tstart[528 + e];
        int rr = m0 + row; rr = rr < cnt ? rr : cnt - 1;
        rowtab[idx] = e < N_EXP ? a.tokl[(size_t)e * CAP + rr] : rr;
        gtab[idx] = e < N_EXP ? a.gatel[(size_t)e * CAP + rr] : 1.f;
    }
    __syncthreads();
    GuSched S{tstart, rstart, rowtab, a.x1, a.wgut, first, GRID, nunits}; EpiGU E{a.H, gtab};
    gs::gemm_stream<true, true>(lds, D_MODEL, S, E);
}
struct P7Args { const bf16_t* H; const int* counts; const bf16_t* wdt; bf16_t* Y; };
struct DownSched {
    typedef MoeU U;
    const int* tstart; const int* rstart; const bf16_t* H; const bf16_t* wdt; int first, stride, nunits;
    DI bool next(int i, U& u) const {
        const int L = first + i * stride; if (L >= nunits) return false;
        const int g = L >> 2, e = find_expert(tstart, g);
        u.sub = L & 3; u.e = e; u.m0 = (g - tstart[e]) * MOE_BM; u.st = rstart[e]; u.cnt = tstart[528 + e];
        u.A = (const char*)(H + (size_t)(u.st + u.m0) * D_EXP); u.B = (const char*)(wdt + ((size_t)e * D_MODEL + 256 * u.sub) * D_EXP); return true;
    }
    DI void a_off(int, const U&, const int (&R)[2], const int (&C)[2], unsigned (&vo)[2][2]) const {
#pragma unroll
        for (int h = 0; h < 2; ++h)
#pragma unroll
            for (int p = 0; p < 2; ++p) vo[h][p] = (unsigned)((128 * h + R[p]) * D_EXP + C[p]) * 2u;
    }
};
struct EpiDown { bf16_t* Y;
    DI void operator()(const f32x4 (&acc)[2][2][4][2], const MoeU& u, int wr, int wc, int fr, int fq) const {
#pragma unroll
        for (int ai = 0; ai < 2; ++ai)
#pragma unroll
            for (int m = 0; m < 4; ++m) {
                const int row = u.m0 + 128 * ai + 64 * wr + 16 * m + fr;
                if (row < u.cnt) {
#pragma unroll
                    for (int bj = 0; bj < 2; ++bj) {
                        const f32x4 v0 = acc[ai][bj][m][0], v1 = acc[ai][bj][m][1];
                        u32x4 o; o.x = cvt_pk_bf16(v0[0], v0[1]); o.y = cvt_pk_bf16(v0[2], v0[3]); o.z = cvt_pk_bf16(v1[0], v1[1]); o.w = cvt_pk_bf16(v1[2], v1[3]);
                        *(u32x4*)(Y + (size_t)(u.st + row) * D_MODEL + 256 * u.sub + 128 * bj + 32 * wc + 8 * fq) = o;
                    }
                }
            }
    } };
DI void phase_moe_down(const P7Args& a, char* smem, LAS unsigned char* lds) {
    build_moe_tab(a.counts, smem);
    const int* tstart = (const int*)(smem + LDS_TAB); const int* rstart = tstart + 264;
    DownSched S{tstart, rstart, a.H, a.wdt, vblock(), GRID, tstart[257] * 4}; EpiDown E{a.Y};
    gs::gemm_stream<true, true>(lds, D_EXP, S, E);
}
struct P8Args { const bf16_t* x1; const bf16_t* Y; const int* slot; const int* counts; const float* ln_g; const float* ln_b; float* out; };
DI void unpack16(const u32x4& a, const u32x4& b, float (&v)[16]) {
#pragma unroll
    for (int j = 0; j < 4; ++j) { v[2 * j] = __uint_as_float(a[j] << 16); v[2 * j + 1] = __uint_as_float(a[j] & 0xffff0000u); v[8 + 2 * j] = __uint_as_float(b[j] << 16); v[8 + 2 * j + 1] = __uint_as_float(b[j] & 0xffff0000u); }
}
DI void phase_combine(const P8Args& a, char* lds) {
    const int tid = tidx(), wid = tid >> 6, lane = tid & 63;
    build_moe_tab(a.counts, lds);
    const int* rstart = (const int*)(lds + LDS_TAB) + 264;
    const int sh0 = rstart[256];
    for (int t = vblock() * 8 + wid; t < T_TOK; t += GRID * 8) {
        float v[16], w[16];
        { const u32x4 p0 = *(const u32x4*)(a.x1 + (size_t)t * D_MODEL + lane * 16), p1 = *(const u32x4*)(a.x1 + (size_t)t * D_MODEL + lane * 16 + 8); unpack16(p0, p1, v); }
#pragma unroll
        for (int i = 0; i < 16; ++i) v[i] *= DN_ALPHA;
        { const bf16_t* yp = a.Y + (size_t)(sh0 + t) * D_MODEL + lane * 16; const u32x4 p0 = *(const u32x4*)yp, p1 = *(const u32x4*)(yp + 8); unpack16(p0, p1, w); }
#pragma unroll
        for (int i = 0; i < 16; ++i) v[i] += w[i];
        int sl = 0; if (lane < TOP_K) sl = a.slot[t * TOP_K + lane];
#pragma unroll
        for (int k = 0; k < TOP_K; ++k) {
            const int s = __shfl(sl, k), e = s / CAP, pos = s % CAP;
            const bf16_t* yp = a.Y + (size_t)(rstart[e] + pos) * D_MODEL + lane * 16; const u32x4 p0 = *(const u32x4*)yp, p1 = *(const u32x4*)(yp + 8); unpack16(p0, p1, w);
#pragma unroll
            for (int i = 0; i < 16; ++i) v[i] += w[i];
        }
        float s = 0.f;
#pragma unroll
        for (int i = 0; i < 16; ++i) s += v[i];
#pragma unroll
        for (int o = 32; o >= 1; o >>= 1) s += __shfl_xor(s, o);
        const float mu = s * (1.f / 1024.f);
        float q = 0.f;
#pragma unroll
        for (int i = 0; i < 16; ++i) { const float d = v[i] - mu; q += d * d; }
#pragma unroll
        for (int o = 32; o >= 1; o >>= 1) q += __shfl_xor(q, o);
        const float rstd = rsqrtf(q * (1.f / 1024.f) + LN_EPS);
#pragma unroll
        for (int j = 0; j < 4; ++j) {
            const f32x4 g = *(const f32x4*)(a.ln_g + lane * 16 + 4 * j), bb = *(const f32x4*)(a.ln_b + lane * 16 + 4 * j);
            f32x4 o; o[0] = (v[4 * j] - mu) * rstd * g[0] + bb[0]; o[1] = (v[4 * j + 1] - mu) * rstd * g[1] + bb[1]; o[2] = (v[4 * j + 2] - mu) * rstd * g[2] + bb[2]; o[3] = (v[4 * j + 3] - mu) * rstd * g[3] + bb[3];
            *(f32x4*)(a.out + (size_t)t * D_MODEL + lane * 16 + 4 * j) = o;
        }
    }
}

#define MFMA32(a, b, c) __builtin_amdgcn_mfma_f32_32x32x16_bf16((a), (b), (c), 0, 0, 0)
constexpr float SB_EXIT_THR = 1e-30f;
struct P2Args { const bf16_t* Q; const bf16_t* Kb; const bf16_t* Vt; const float* rel_bias; const float* gain_a; const float* gain_b; bf16_t* y; };

DI bf16x8 pack8(const f32x16& x, int s) {
    u32x4 p;
    if (s == 0) { p.x = cvt_pk_bf16(x[0], x[1]); p.y = cvt_pk_bf16(x[2], x[3]); p.z = cvt_pk_bf16(x[4], x[5]); p.w = cvt_pk_bf16(x[6], x[7]); }
    else        { p.x = cvt_pk_bf16(x[8], x[9]); p.y = cvt_pk_bf16(x[10], x[11]); p.z = cvt_pk_bf16(x[12], x[13]); p.w = cvt_pk_bf16(x[14], x[15]); }
    return __builtin_bit_cast(bf16x8, p);
}
DI void load_k(bf16x8 (&k)[4], const bf16_t* kp, int k0) {
#pragma unroll
    for (int kk = 0; kk < 4; ++kk) k[kk] = *(const bf16x8*)(kp + (size_t)k0 * 64 + 16 * kk);
}
DI void load_v(bf16x8 (&v)[2][2], const bf16_t* vp0, const bf16_t* vp1, int k0) {
#pragma unroll
    for (int s = 0; s < 2; ++s) {
        const u32x2 a0 = *(const u32x2*)(vp0 + k0 + 16 * s), a1 = *(const u32x2*)(vp0 + k0 + 16 * s + 8);
        const u32x2 b0 = *(const u32x2*)(vp1 + k0 + 16 * s), b1 = *(const u32x2*)(vp1 + k0 + 16 * s + 8);
        v[0][s] = __builtin_bit_cast(bf16x8, (u32x4){a0.x, a0.y, a1.x, a1.y});
        v[1][s] = __builtin_bit_cast(bf16x8, (u32x4){b0.x, b0.y, b1.x, b1.y});
    }
}

constexpr int LDS_CVT = 16 * 1024;
DI void phase_attn(const P2Args& a, const P0Args& cv, char* lds) {
    const int tid = tidx(), wid = tid >> 6, lane = tid & 63, r = lane & 31, h = lane >> 5;
    float* tbl = (float*)lds;
    float* ssq = (float*)(lds + 8 * 260 * 4);
    __syncthreads();
    for (int i = tid; i < NHA * 257; i += NTHR) { const int hd = i / 257, j = i % 257; tbl[hd * 260 + j] = a.rel_bias[i] * LOG2E; }
    __syncthreads();
    const int cgrp = vblock() % 3;
#pragma unroll 1
    for (int slot = 0; slot < 5; ++slot) {
        if ((cgrp == 0 && slot == 0) || (cgrp == 1 && slot == 2) || (cgrp == 2 && slot == 4)) convert_moe_all(cv, lds + LDS_CVT);
        if (slot == 4) break;
        const int u = vblock() + GRID * (slot >> 1) + 2 * GRID * (slot & 1);
        const bool isB = u >= BATCH * (SEQ / 64); const int uu = isB ? u - BATCH * (SEQ / 64) : u;
        const int b = uu / (SEQ / 64), c = uu % (SEQ / 64), q0 = c * 64, hh = (isB ? NHA : 0) + wid;
        const size_t hb = (size_t)(b * NHH + hh) * SEQ * 64;
        const bf16_t* kp = a.Kb + hb + r * 64 + 8 * h;
        const bf16_t* vp0 = a.Vt + hb + (size_t)r * SEQ + 4 * h; const bf16_t* vp1 = vp0 + (size_t)32 * SEQ;
        bf16x8 qf[2][4];
#pragma unroll
        for (int qt = 0; qt < 2; ++qt)
#pragma unroll
            for (int kk = 0; kk < 4; ++kk) qf[qt][kk] = *(const bf16x8*)(a.Q + hb + (size_t)(q0 + 32 * qt + r) * 64 + 16 * kk + 8 * h);
        f32x16 ot[2][2];
#pragma unroll
        for (int dt = 0; dt < 2; ++dt)
#pragma unroll
            for (int qt = 0; qt < 2; ++qt)
#pragma unroll
                for (int i = 0; i < 16; ++i) ot[dt][qt][i] = 0.f;
        float linv[2] = {1.f, 1.f};
        if (!isB) {
            float mrun[2] = {-INFINITY, -INFINITY}, lrun[2] = {0.f, 0.f};
            const int klo = q0 - LEFT_CHUNKS * CHUNK < 0 ? 0 : q0 - LEFT_CHUNKS * CHUNK, khi = q0 + 64;
            const float cfar = tbl[wid * 260 + 256];
            bf16x8 kc[4], kn[4], vf[2][2]; load_k(kc, kp, klo);
            for (int k0 = klo; k0 < khi; k0 += 32) {
                load_v(vf, vp0, vp1, k0);
                load_k(kn, kp, k0 + 32 < khi ? k0 + 32 : k0);
#pragma unroll
                for (int qt = 0; qt < 2; ++qt) {
                    bf16x8 pf[2];
                    f32x16 st;
#pragma unroll
                    for (int i = 0; i < 16; ++i) st[i] = 0.f;
#pragma unroll
                    for (int kk = 0; kk < 4; ++kk) st = MFMA32(kc[kk], qf[qt][kk], st);
                    const int dmin = q0 + 32 * qt - k0 - 31;
                    if (dmin >= MAX_REL) {
#pragma unroll
                        for (int i = 0; i < 16; ++i) st[i] += cfar;
                    } else {
                        const int bidx = q0 + 32 * qt + r - k0 - 4 * h + MAX_REL;
#pragma unroll
                        for (int i = 0; i < 16; ++i) { int ix = bidx - ((i & 3) + 8 * (i >> 2)); ix = ix < 0 ? 0 : (ix > 2 * MAX_REL ? 2 * MAX_REL : ix); st[i] += tbl[wid * 260 + ix]; }
                    }
                    float mx = st[0];
#pragma unroll
                    for (int i = 1; i < 16; ++i) mx = fmaxf(mx, st[i]);
                    mx = fmaxf(mx, __shfl_xor(mx, 32));
                    const float mn = fmaxf(mrun[qt], mx), alpha = __builtin_amdgcn_exp2f(mrun[qt] - mn);
                    mrun[qt] = mn;
                    float ps = 0.f;
#pragma unroll
                    for (int i = 0; i < 16; ++i) { st[i] = __builtin_amdgcn_exp2f(st[i] - mn); ps += st[i]; }
                    lrun[qt] = lrun[qt] * alpha + ps;
#pragma unroll
                    for (int i = 0; i < 16; ++i) { ot[0][qt][i] *= alpha; ot[1][qt][i] *= alpha; }
                    pf[0] = pack8(st, 0); pf[1] = pack8(st, 1);
#pragma unroll
                    for (int dt = 0; dt < 2; ++dt)
#pragma unroll
                        for (int s = 0; s < 2; ++s) ot[dt][qt] = MFMA32(vf[dt][s], pf[s], ot[dt][qt]);
                }
#pragma unroll
                for (int kk = 0; kk < 4; ++kk) kc[kk] = kn[kk];
            }
#pragma unroll
            for (int qt = 0; qt < 2; ++qt) { const float lt = lrun[qt] + __shfl_xor(lrun[qt], 32); linv[qt] = 1.f / lt; }
        } else {
            float carry[2] = {1.f, 1.f};
            bf16x8 kc[4], kn[4], vf[2][2]; load_k(kc, kp, q0 + 32);
            for (int k0 = q0 + 32; k0 >= 0; k0 -= 32) {
                load_v(vf, vp0, vp1, k0);
                load_k(kn, kp, k0 >= 32 ? k0 - 32 : k0);
#pragma unroll
                for (int qt = 0; qt < 2; ++qt) {
                    bf16x8 pf[2];
                    f32x16 st;
#pragma unroll
                    for (int i = 0; i < 16; ++i) st[i] = 0.f;
                    const bool none = (k0 > q0 + 32 * qt + 30);
                    if (!none) {
#pragma unroll
                        for (int kk = 0; kk < 4; ++kk) st = MFMA32(kc[kk], qf[qt][kk], st);
                        const bool full = (k0 + 31 < q0 + 32 * qt);
                        const int lim = q0 + 32 * qt + r - k0 - 4 * h;
                        float om[16];
#pragma unroll
                        for (int i = 0; i < 16; ++i) {
                            const float e = __builtin_amdgcn_exp2f(-st[i]); float bta = __builtin_amdgcn_rcpf(1.f + e);
                            if (!full && !(((i & 3) + 8 * (i >> 2)) < lim)) bta = 0.f;
                            st[i] = bta; om[i] = 1.f - bta;
                        }
                        float G[4], Go[4];
#pragma unroll
                        for (int g = 0; g < 4; ++g) { G[g] = (om[4 * g] * om[4 * g + 1]) * (om[4 * g + 2] * om[4 * g + 3]); Go[g] = __shfl_xor(G[g], 32); }
                        float R = carry[qt];
#pragma unroll
                        for (int g = 3; g >= 0; --g) {
                            float run = h == 0 ? R * Go[g] : R;
#pragma unroll
                            for (int uu2 = 3; uu2 >= 0; --uu2) { const float bta = st[4 * g + uu2]; st[4 * g + uu2] = bta * run; run *= om[4 * g + uu2]; }
                            R = R * (G[g] * Go[g]);
                        }
                        carry[qt] = R;
                    }
                    if (!none) {
                        pf[0] = pack8(st, 0); pf[1] = pack8(st, 1);
#pragma unroll
                        for (int dt = 0; dt < 2; ++dt)
#pragma unroll
                            for (int s = 0; s < 2; ++s) ot[dt][qt] = MFMA32(vf[dt][s], pf[s], ot[dt][qt]);
                    }
                }
#pragma unroll
                for (int kk = 0; kk < 4; ++kk) kc[kk] = kn[kk];
                if (__all(carry[0] < SB_EXIT_THR && carry[1] < SB_EXIT_THR)) break;
            }
        }
        float ss[2];
#pragma unroll
        for (int qt = 0; qt < 2; ++qt) {
            float s2 = 0.f;
#pragma unroll
            for (int dt = 0; dt < 2; ++dt)
#pragma unroll
                for (int i = 0; i < 16; ++i) { ot[dt][qt][i] *= linv[qt]; s2 += ot[dt][qt][i] * ot[dt][qt][i]; }
            s2 += __shfl_xor(s2, 32); ss[qt] = s2;
        }
        __syncthreads();
        if (h == 0) { ssq[wid * 64 + r] = ss[0]; ssq[wid * 64 + 32 + r] = ss[1]; }
        __syncthreads();
        const float* gain = isB ? a.gain_b : a.gain_a;
#pragma unroll
        for (int qt = 0; qt < 2; ++qt) {
            float tot = 0.f;
#pragma unroll
            for (int w8 = 0; w8 < 8; ++w8) tot += ssq[w8 * 64 + 32 * qt + r];
            const float rs = rsqrtf(tot * (1.f / 512.f) + RMS_EPS);
            bf16_t* yp = a.y + (size_t)(b * SEQ + q0 + 32 * qt + r) * D_MODEL + (isB ? 512 : 0) + wid * 64;
#pragma unroll
            for (int dt = 0; dt < 2; ++dt)
#pragma unroll
                for (int g = 0; g < 4; ++g) {
                    const int d = 32 * dt + 8 * g + 4 * h; const f32x4 gn = *(const f32x4*)(gain + wid * 64 + d);
                    u32x2 o; o.x = cvt_pk_bf16(ot[dt][qt][4 * g] * rs * gn[0], ot[dt][qt][4 * g + 1] * rs * gn[1]); o.y = cvt_pk_bf16(ot[dt][qt][4 * g + 2] * rs * gn[2], ot[dt][qt][4 * g + 3] * rs * gn[3]);
                    *(u32x2*)(yp + d) = o;
                }
        }
    }
}


#define XB_TMO      128
#define XB_XCNT(j)  (256  + 64 * (j))
#define XB_XSUB(j)  (1280 + 64 * (j))
#define XB_XGEN(j)  (2304 + 64 * (j))
#define XB_TOP      3328
#define XB_TOPGEN   3392
#define XCD_BAR_WORDS 3456
#define XB_SPIN_CAP (1u << 18)
#define LAS __attribute__((address_space(3)))

__device__ __forceinline__ unsigned xb_ld(unsigned* p)              { return __hip_atomic_load(p, __ATOMIC_RELAXED, __HIP_MEMORY_SCOPE_AGENT); }
__device__ __forceinline__ unsigned xb_add(unsigned* p, unsigned v) { return __hip_atomic_fetch_add(p, v, __ATOMIC_RELAXED, __HIP_MEMORY_SCOPE_AGENT); }
__device__ __forceinline__ unsigned xb_xcc_id() { return (unsigned)__builtin_amdgcn_s_getreg((3 << 11) | 20) & 0xFu; }
#define XB_SPIN(cond, bar) do { unsigned _sp = 0; while (cond) { __builtin_amdgcn_s_sleep(1); \
    if ((++_sp & 255u) == 0u) { if (xb_ld(&(bar)[XB_TMO])) break; if (_sp > XB_SPIN_CAP) { atomicAdd(&(bar)[XB_TMO], 1u); break; } } } } while (0)

struct XcdBarrier {
    unsigned* bar; unsigned x;
    volatile LAS unsigned* st;
};

__device__ __forceinline__ XcdBarrier xcd_barrier_post(unsigned* bar, volatile LAS unsigned* st) {
    XcdBarrier b; b.bar = bar; b.x = xb_xcc_id(); b.st = st;
    if (threadIdx.x == 0) (void)xb_add(&bar[XB_XCNT(b.x)], 1u);
    return b;
}
__device__ __forceinline__ void xcd_barrier_complete(unsigned* bar, unsigned x, unsigned& nloc, unsigned& nx) {
    const unsigned G = gridDim.x * gridDim.y * gridDim.z;
    unsigned sum, cnt, mine, sp = 0u;
    for (;;) {
        sum = 0u; cnt = 0u; mine = 0u;
#pragma unroll
        for (unsigned j = 0; j < 16; ++j) { const unsigned c = xb_ld(&bar[XB_XCNT(j)]); sum += c; cnt += (c > 0u) ? 1u : 0u; mine = (j == x) ? c : mine; }
        if (sum == G) break;
        __builtin_amdgcn_s_sleep(1);
        if ((++sp & 255u) == 0u) { if (xb_ld(&bar[XB_TMO])) break; if (sp > XB_SPIN_CAP) { atomicAdd(&bar[XB_TMO], 1u); break; } }
    }
    nloc = mine > 0u ? mine : 1u; nx = cnt > 0u ? cnt : 1u;
}

__device__ __forceinline__ void xcd_barrier(const XcdBarrier& b) {
    asm volatile("s_waitcnt vmcnt(0)" ::: "memory");
    __syncthreads();
    if (threadIdx.x == 0) {
        unsigned* bar = b.bar;
        __builtin_amdgcn_s_waitcnt(0);
        unsigned nloc = b.st[0], nx = b.st[1];
        if (nloc == 0u) { xcd_barrier_complete(bar, b.x, nloc, nx); b.st[0] = nloc; b.st[1] = nx; }
        const unsigned old = xb_add(&bar[XB_XSUB(b.x)], 1u);
        const unsigned gen = old / nloc;
        if (old + 1u == (gen + 1u) * nloc) {
            __builtin_amdgcn_fence(__ATOMIC_RELEASE, "agent");
            asm volatile("s_waitcnt vmcnt(0)" ::: "memory");
            const unsigned og = xb_add(&bar[XB_TOP], 1u);
            const unsigned tg = og / nx;
            if (og + 1u == (tg + 1u) * nx) xb_add(&bar[XB_TOPGEN], 1u);
            else XB_SPIN(xb_ld(&bar[XB_TOPGEN]) == tg, bar);
            __builtin_amdgcn_fence(__ATOMIC_ACQUIRE, "agent");
            xb_add(&bar[XB_XGEN(b.x)], 1u);
            asm volatile("s_waitcnt vmcnt(0)" ::: "memory");
        } else {
            XB_SPIN(xb_ld(&bar[XB_XGEN(b.x)]) == gen, bar);
            __builtin_amdgcn_fence(__ATOMIC_ACQUIRE, "agent");
            asm volatile("s_waitcnt vmcnt(0)" ::: "memory");
        }
    }
    __syncthreads();
}


struct MegaArgs { P0Args p0; P1Args p1; P2Args p2; P3Args p3; P4Args p4; P6Args p6; P7Args p7; P8Args p8; unsigned* bar; };
__global__ __launch_bounds__(NTHR, 2) void k_mega(MegaArgs a) {
    extern __shared__ __attribute__((aligned(16))) char smem[];
    volatile LAS unsigned* xbw = (volatile LAS unsigned*)(smem + LDS_BYTES - 16);
    if (threadIdx.x == 0) { xbw[0] = 0u; xbw[1] = 0u; xbw[2] = 0u; xbw[3] = 0u; }
    __syncthreads();
    XcdBarrier bar = xcd_barrier_post(a.bar, xbw);
    LAS unsigned char* L = (LAS unsigned char*)smem;
    phase_prologue(a.p0, smem);     xcd_barrier(bar);
    phase_qkv(a.p1, L);             xcd_barrier(bar);
    phase_attn(a.p2, a.p0, smem);   xcd_barrier(bar);
    phase_outproj(a.p3, L);         xcd_barrier(bar);
    phase_router(a.p4, smem);       xcd_barrier(bar);
    phase_moe_gu(a.p6, smem, L);    xcd_barrier(bar);
    phase_moe_down(a.p7, smem, L);  xcd_barrier(bar);
    phase_combine(a.p8, smem);
}

extern "C" void kernel_launch(void* const* d_in, const int* in_sizes, int n_in, void* d_out, int out_size, void* d_ws, size_t ws_size, hipStream_t stream) {
    const float* x = (const float*)d_in[0];      const float* w_in = (const float*)d_in[1];   const float* rel_bias = (const float*)d_in[2];
    const float* gain_a = (const float*)d_in[3]; const float* gain_b = (const float*)d_in[4]; const float* w_out = (const float*)d_in[5];
    const float* ln1_g = (const float*)d_in[6];  const float* ln1_b = (const float*)d_in[7];  const float* router_w = (const float*)d_in[8];
    const float* router_bias = (const float*)d_in[9]; const float* w_gate = (const float*)d_in[10]; const float* w_up = (const float*)d_in[11];
    const float* w_down = (const float*)d_in[12]; const float* ws_gate = (const float*)d_in[13]; const float* ws_up = (const float*)d_in[14];
    const float* ws_down = (const float*)d_in[15]; const float* ln2_g = (const float*)d_in[16]; const float* ln2_b = (const float*)d_in[17];
    char* ws = (char*)d_ws; float* out = (float*)d_out;
    int* ctrl = (int*)(ws + OFF_CTRL); int* counts = ctrl + CW_COUNTS;
    bf16_t* X1 = (bf16_t*)(ws + OFF_X1); int* tokl = (int*)(ws + OFF_TOKL); float* gatel = (float*)(ws + OFF_GATEL);
    int* eidx = (int*)(ws + OFF_EIDX); float* gate = (float*)(ws + OFF_GATE); int* slot = (int*)(ws + OFF_SLOT);
    bf16_t* H = (bf16_t*)(ws + OFF_H); bf16_t* Y = (bf16_t*)(ws + OFF_Y);
    bf16_t* Q = (bf16_t*)(ws + OFF_Q); bf16_t* Kb = (bf16_t*)(ws + OFF_K); bf16_t* Vt = (bf16_t*)(ws + OFF_VT);
    bf16_t* yatt = (bf16_t*)(ws + OFF_YATT); bf16_t* r = (bf16_t*)(ws + OFF_R);
    bf16_t* xb = (bf16_t*)(ws + OFF_XB); float* stats = (float*)(ws + OFF_STATS);
    bf16_t* wt_in = (bf16_t*)(ws + OFF_WTIN); bf16_t* wt_out = (bf16_t*)(ws + OFF_WTOUT); bf16_t* wt_r = (bf16_t*)(ws + OFF_WTR);
    bf16_t* wgut = (bf16_t*)(ws + OFF_WGUT); bf16_t* wdt = (bf16_t*)(ws + OFF_WDT);
    if (ws_size < WS_NEEDED) { fprintf(stderr, "kernel_launch: workspace too small (%zu < %zu)\n", ws_size, (size_t)WS_NEEDED); return; }
    hipMemsetAsync(ctrl, 0, 64 * 1024, stream);
    static bool attr_done = false;
    if (!attr_done) {
        hipFuncSetAttribute((const void*)k_mega, hipFuncAttributeMaxDynamicSharedMemorySize, LDS_BYTES);
        attr_done = true;
    }
    MegaArgs m{};
    m.p0 = P0Args{x, w_in, w_out, router_w, xb, wt_in, wt_out, wt_r, w_gate, w_up, w_down, ws_gate, ws_up, ws_down, wgut, wdt};
    m.p1 = P1Args{xb, wt_in, Q, Kb, Vt};
    m.p2 = P2Args{Q, Kb, Vt, rel_bias, gain_a, gain_b, yatt};
    m.p3 = P3Args{yatt, wt_out, x, r, stats};
    m.p4 = P4Args{r, stats, ln1_g, ln1_b, X1, wt_r, router_bias, eidx, gate, counts, tokl, gatel, slot};
    m.p6 = P6Args{X1, counts, tokl, gatel, wgut, H};
    m.p7 = P7Args{H, counts, wdt, Y};
    m.p8 = P8Args{X1, Y, slot, counts, ln2_g, ln2_b, out};
    m.bar = (unsigned*)ctrl;
    k_mega<<<GRID, NTHR, LDS_BYTES, stream>>>(m);
}
```

```cpp
#include <hip/hip_runtime.h>
#include <cstdint>
#include <cstdio>

typedef unsigned short bf16_t;

constexpr int D_MODEL = 1024, BATCH = 16, SEQ = 2048, T_TOK = BATCH * SEQ;
constexpr int HEAD_DIM = 64, NHA = 8, NHB = 8, NHH = 16;
constexpr int CHUNK = 64, LEFT_CHUNKS = 8, MAX_REL = 128;
constexpr int N_EXP = 256, TOP_K = 8, N_GROUPS = 8, TOPK_GROUPS = 4, EPG = 32, D_EXP = 256;
constexpr float ROUTED_SCALE = 2.5f, LN_EPS = 1e-5f, RMS_EPS = 1e-6f;
constexpr float DN_ALPHA = 1.189207115002721f;
constexpr float LOG2E = 1.4426950408889634f, LN2 = 0.6931471805599453f;
constexpr float QSCALE = 0.125f * LOG2E;
constexpr int CAP = T_TOK;
constexpr int ROWS_ALL = T_TOK * TOP_K + T_TOK;

__device__ __forceinline__ float bf2f(bf16_t v) { return __uint_as_float(((unsigned)v) << 16); }
__device__ __forceinline__ bf16_t f2bf(float f) { unsigned u = __float_as_uint(f); u += 0x7fffu + ((u >> 16) & 1u); return (bf16_t)(u >> 16); }

constexpr size_t MB = 1024ull * 1024ull;
constexpr size_t OFF_CTRL   = 0;
constexpr size_t OFF_X1     = 1 * MB;
constexpr size_t OFF_TOKL   = OFF_X1 + 64 * MB;
constexpr size_t OFF_GATEL  = OFF_TOKL + 32 * MB;
constexpr size_t OFF_EIDX   = OFF_GATEL + 32 * MB;
constexpr size_t OFF_GATE   = OFF_EIDX + 1 * MB;
constexpr size_t OFF_SLOT   = OFF_GATE + 1 * MB;
constexpr size_t OFF_WDT    = OFF_SLOT + 1 * MB;
constexpr size_t OFF_BIG    = OFF_WDT + 129 * MB;
constexpr size_t OFF_H      = OFF_BIG;
constexpr size_t OFF_Y      = OFF_BIG + 144 * MB;
constexpr size_t OFF_Q      = OFF_BIG;
constexpr size_t OFF_K      = OFF_BIG + 64 * MB;
constexpr size_t OFF_VT     = OFF_BIG + 128 * MB;
constexpr size_t OFF_YATT   = OFF_BIG + 192 * MB;
constexpr size_t OFF_R      = OFF_BIG + 256 * MB;
constexpr size_t OFF_XB     = OFF_BIG + 320 * MB;
constexpr size_t OFF_STATS  = OFF_BIG + 384 * MB;
constexpr size_t OFF_WTIN   = OFF_BIG + 392 * MB;
constexpr size_t OFF_WTOUT  = OFF_BIG + 398 * MB;
constexpr size_t OFF_WTR    = OFF_BIG + 400 * MB;
constexpr size_t OFF_WGUT   = OFF_BIG + 401 * MB;
constexpr size_t WS_NEEDED  = OFF_BIG + 720 * MB;
static_assert(OFF_WGUT + 257 * MB <= WS_NEEDED && WS_NEEDED <= 1024 * MB, "workspace map");
constexpr int CW_COUNTS = 4096;

typedef short bf16x8 __attribute__((ext_vector_type(8)));
typedef float f32x4 __attribute__((ext_vector_type(4)));
typedef float f32x2 __attribute__((ext_vector_type(2)));
typedef float f32x16 __attribute__((ext_vector_type(16)));
typedef unsigned u32x4 __attribute__((ext_vector_type(4)));
typedef unsigned u32x2 __attribute__((ext_vector_type(2)));
#define DI __device__ __forceinline__
constexpr int NTHR = 512, GRID = 256;
DI int tidx() { int t = threadIdx.x; asm volatile("" : "+v"(t)); return t; }
constexpr int LDS_BYTES = 160 * 1024;

typedef __bf16 bf16x2_t __attribute__((ext_vector_type(2)));
DI unsigned cvt_pk_bf16(float lo, float hi) { f32x2 v = {lo, hi}; bf16x2_t r = __builtin_convertvector(v, bf16x2_t); return __builtin_bit_cast(unsigned, r); }
DI int vblock() { return (int)((blockIdx.x & 7) * (GRID / 8) + (blockIdx.x >> 3)); }

template <int MT> struct Tile { static constexpr int BM = 32 * MT, A_BYTES = BM * 128, B_BYTES = 256 * 128, STAGE = A_BYTES + B_BYTES; };

template <int MT> struct ALoader {
    const bf16_t* p[MT / 2]; u32x4 v[MT / 2]; int off0;
    DI void init_rows(const bf16_t* A, int lda, int row0) {
        const int tid = tidx(), kc = tid & 7, r = tid >> 3;
#pragma unroll
        for (int i = 0; i < MT / 2; ++i) p[i] = A + (size_t)(row0 + r + 64 * i) * lda + kc * 8;
        off0 = r * 128 + ((kc ^ ((r >> 1) & 7)) << 4);
    }
    DI void init_gather(const bf16_t* A, int lda, const int* rows, int cnt, int m0) {
        const int tid = tidx(), kc = tid & 7, r = tid >> 3;
#pragma unroll
        for (int i = 0; i < MT / 2; ++i) { int rr = m0 + r + 64 * i; rr = rr < cnt ? rr : cnt - 1; const int g = rows ? rows[rr] : rr; p[i] = A + (size_t)g * lda + kc * 8; }
        off0 = r * 128 + ((kc ^ ((r >> 1) & 7)) << 4);
    }
    DI void load(int k0) {
#pragma unroll
        for (int i = 0; i < MT / 2; ++i) v[i] = *(const u32x4*)(p[i] + k0);
    }
    DI void store(char* ldsA) const {
#pragma unroll
        for (int i = 0; i < MT / 2; ++i) *(u32x4*)(ldsA + off0 + i * 8192) = v[i];
    }
};
struct BLoaderBt {
    const bf16_t* p[4]; u32x4 v[4]; int off0;
    DI void init(const bf16_t* Bt, int ldk, int n0) {
        const int tid = tidx(), kc = tid & 7, r = tid >> 3;
#pragma unroll
        for (int i = 0; i < 4; ++i) p[i] = Bt + (size_t)(n0 + r + 64 * i) * ldk + kc * 8;
        off0 = r * 128 + ((kc ^ ((r >> 1) & 7)) << 4);
    }
    DI void load(int k0) {
#pragma unroll
        for (int i = 0; i < 4; ++i) v[i] = *(const u32x4*)(p[i] + k0);
    }
    DI void store(char* ldsB) const {
#pragma unroll
        for (int i = 0; i < 4; ++i) *(u32x4*)(ldsB + off0 + i * 8192) = v[i];
    }
};
template <bool GU> struct BLoaderF32 {
    const float* p[2]; int ldb; f32x2 v[2][8]; int off[2][2];
    DI void init(const float* P0, const float* P1, int ldb_) {
        const int tid = tidx(), l = tid & 63, w = tid >> 6; ldb = ldb_;
        p[0] = P0 + (size_t)(8 * w) * ldb + 2 * l; p[1] = P1 + (size_t)(8 * w) * ldb + 2 * l;
#pragma unroll
        for (int jp = 0; jp < 2; ++jp)
#pragma unroll
            for (int jj = 0; jj < 2; ++jj) { const int c = 2 * l + jj; const int row = GU ? (64 * (c >> 5) + 32 * jp + (c & 31)) : (128 * jp + c); off[jp][jj] = row * 128 + ((w ^ ((row >> 1) & 7)) << 4); }
    }
    DI void load(int k0) {
#pragma unroll
        for (int jp = 0; jp < 2; ++jp)
#pragma unroll
            for (int kk = 0; kk < 8; ++kk) v[jp][kk] = *(const f32x2*)(p[jp] + (size_t)(k0 + kk) * ldb);
    }
    DI void store(char* ldsB) const {
#pragma unroll
        for (int jp = 0; jp < 2; ++jp) {
            u32x4 a, b;
            a.x = cvt_pk_bf16(v[jp][0].x, v[jp][1].x); a.y = cvt_pk_bf16(v[jp][2].x, v[jp][3].x); a.z = cvt_pk_bf16(v[jp][4].x, v[jp][5].x); a.w = cvt_pk_bf16(v[jp][6].x, v[jp][7].x);
            b.x = cvt_pk_bf16(v[jp][0].y, v[jp][1].y); b.y = cvt_pk_bf16(v[jp][2].y, v[jp][3].y); b.z = cvt_pk_bf16(v[jp][4].y, v[jp][5].y); b.w = cvt_pk_bf16(v[jp][6].y, v[jp][7].y);
            *(u32x4*)(ldsB + off[jp][0]) = a; *(u32x4*)(ldsB + off[jp][1]) = b;
        }
    }
};

template <int MT, bool TR, class AL, class BL>
DI void gemm_tile(char* lds, AL& al, BL& bl, int nk, f32x4 (&acc)[MT][4]) {
    typedef Tile<MT> TT;
    const int tid = tidx(), wid = tid >> 6, lane = tid & 63, wr = wid >> 2, wc = wid & 3, fr = lane & 15, fq = lane >> 4;
#pragma unroll
    for (int m = 0; m < MT; ++m)
#pragma unroll
        for (int n = 0; n < 4; ++n) acc[m][n] = (f32x4){0.f, 0.f, 0.f, 0.f};
    int aoff[2], boff[2];
#pragma unroll
    for (int ks = 0; ks < 2; ++ks) { const int ch = (((4 * ks + fq) ^ (fr >> 1)) << 4); aoff[ks] = (16 * MT * wr + fr) * 128 + ch; boff[ks] = TT::A_BYTES + (64 * wc + fr) * 128 + ch; }
    al.load(0); bl.load(0);
    __syncthreads();
    al.store(lds); bl.store(lds + TT::A_BYTES);
    __syncthreads();
    for (int kt = 0; kt < nk; ++kt) {
        char* cur = lds + (kt & 1) * TT::STAGE; char* nxt = lds + ((kt & 1) ^ 1) * TT::STAGE;
        const bool more = kt + 1 < nk;
        if (more) { al.load((kt + 1) * 64); bl.load((kt + 1) * 64); }
#pragma unroll
        for (int ks = 0; ks < 2; ++ks) {
            bf16x8 a[MT], b[4];
#pragma unroll
            for (int m = 0; m < MT; ++m) a[m] = *(const bf16x8*)(cur + aoff[ks] + m * 2048);
#pragma unroll
            for (int n = 0; n < 4; ++n) b[n] = *(const bf16x8*)(cur + boff[ks] + n * 2048);
#pragma unroll
            for (int m = 0; m < MT; ++m)
#pragma unroll
                for (int n = 0; n < 4; ++n)
                    acc[m][n] = TR ? __builtin_amdgcn_mfma_f32_16x16x32_bf16(b[n], a[m], acc[m][n], 0, 0, 0) : __builtin_amdgcn_mfma_f32_16x16x32_bf16(a[m], b[n], acc[m][n], 0, 0, 0);
        }
        if (more) { al.store(nxt); bl.store(nxt + TT::A_BYTES); }
        __syncthreads();
    }
}

#define LAS __attribute__((address_space(3)))
namespace gs {
constexpr int BM = 256, BK = 64, HALF = 128, HTB = HALF * BK * 2, STAGE_BYTES = 8 * HTB;
DI int lds_byte(int r, int c) { const int st = (r >> 4) * 2 + (c >> 5), rr = r & 15, cc = c & 31, ob = rr * 64 + cc * 2; return st * 1024 + (ob ^ (((ob >> 9) & 1) << 5)); }
DI void stage_rc(int b, int& R, int& C) { const int st = b / 1024, sb = b % 1024, swz = sb ^ (((sb >> 9) & 1) << 5); R = (st >> 1) * 16 + swz / 64; C = (st & 1) * 32 + (swz % 64) / 2; }
DI int perm32(int rho) { const int n = rho >> 4, i = rho & 15; return 8 * (i >> 2) + 4 * n + (i & 3); }
template <bool TR, bool PERM, class Sched, class Epi>
DI void gemm_stream(LAS unsigned char* lds, const int K, const Sched& S, const Epi& E) {
    typedef typename Sched::U U;
    const int tid = tidx(), wid = __builtin_amdgcn_readfirstlane(tid >> 6), lane = tid & 63, wr = wid >> 2, wc = wid & 3, fr = lane & 15, fq = lane >> 4;
    const int nt = K / BK;
    int R[2], C[2]; unsigned voffB[2];
#pragma unroll
    for (int i = 0; i < 2; ++i) { stage_rc(tid * 16 + i * 8192, R[i], C[i]); const int Rb = PERM ? ((R[i] & ~31) + perm32(R[i] & 31)) : R[i]; voffB[i] = (unsigned)(Rb * K + C[i]) * 2u; }
    const size_t kstep = (size_t)(BK * 2), hstepB = (size_t)HALF * K * 2;
    const unsigned ldsw = (unsigned)wid * 1024u;
    const int aoff = lds_byte(wr * 64 + fr, fq * 8), boff = lds_byte(wc * 32 + fr, fq * 8);
#define GS_SA(b, h) (((b) * 2 + (h)) * HTB)
#define GS_SB(b, h) ((4 + (b) * 2 + (h)) * HTB)
#define GS_STAGE(bufoff, gbase, voff) do { _Pragma("unroll") for (int _i = 0; _i < 2; ++_i) \
        __builtin_amdgcn_global_load_lds((const unsigned*)((const char*)(gbase) + (voff)[_i]), (LAS unsigned*)(lds + (bufoff) + ldsw + _i * 8192), 16, 0, 0); } while (0)
#define GS_LDA(dst, b, h) do { _Pragma("unroll") for (int m = 0; m < 4; ++m) _Pragma("unroll") for (int k = 0; k < 2; ++k) dst[m][k] = *(const LAS bf16x8*)(lds + GS_SA(b, h) + aoff + m * 2048 + k * 1024); } while (0)
#define GS_LDB(dst, b, h) do { _Pragma("unroll") for (int n = 0; n < 2; ++n) _Pragma("unroll") for (int k = 0; k < 2; ++k) dst[n][k] = *(const LAS bf16x8*)(lds + GS_SB(b, h) + boff + n * 2048 + k * 1024); } while (0)
#define GS_MMA(ai, bj, At, Bt) do { __builtin_amdgcn_s_setprio(1); _Pragma("unroll") for (int m = 0; m < 4; ++m) _Pragma("unroll") for (int n = 0; n < 2; ++n) _Pragma("unroll") for (int k = 0; k < 2; ++k) \
        acc[ai][bj][m][n] = TR ? __builtin_amdgcn_mfma_f32_16x16x32_bf16(Bt[n][k], At[m][k], acc[ai][bj][m][n], 0, 0, 0) : __builtin_amdgcn_mfma_f32_16x16x32_bf16(At[m][k], Bt[n][k], acc[ai][bj][m][n], 0, 0, 0); \
        __builtin_amdgcn_s_setprio(0); } while (0)
#define GS_WAIT_V(n) asm volatile("s_waitcnt vmcnt(" #n ")" ::: "memory")
#define GS_WAIT_L(n) asm volatile("s_waitcnt lgkmcnt(" #n ")" ::: "memory")
#define GS_BAR __builtin_amdgcn_s_barrier()
#define GS_SCHED __builtin_amdgcn_sched_barrier(0)
    U cur, nxt; int ui = 0;
    if (!S.next(0, cur)) return;
    f32x4 acc[2][2][4][2];
#pragma unroll
    for (int a = 0; a < 2; ++a)
#pragma unroll
        for (int b = 0; b < 2; ++b)
#pragma unroll
            for (int m = 0; m < 4; ++m)
#pragma unroll
                for (int n = 0; n < 2; ++n) acc[a][b][m][n] = (f32x4){0.f, 0.f, 0.f, 0.f};
    bf16x8 At[4][2], B0[2][2], B1[2][2];
    unsigned cvo[2][2], nvo[2][2];
    S.a_off(0, cur, R, C, cvo);
    const char* cA = cur.A; const char* cB = cur.B;
    GS_STAGE(GS_SB(0, 0), cB, voffB); GS_STAGE(GS_SB(0, 1), cB + hstepB, voffB); GS_STAGE(GS_SA(0, 0), cA, cvo[0]); GS_STAGE(GS_SA(0, 1), cA, cvo[1]);
    if (wr == 1) GS_BAR;
    GS_WAIT_V(2); GS_BAR;
    GS_STAGE(GS_SB(1, 0), cB + kstep, voffB); GS_STAGE(GS_SA(1, 0), cA + kstep, cvo[0]); GS_STAGE(GS_SB(1, 1), cB + hstepB + kstep, voffB);
    GS_WAIT_V(6); GS_BAR;
    for (;;) {
        const bool has_next = S.next(ui + 1, nxt);
        if (has_next) S.a_off(ui + 1, nxt, R, C, nvo);
        else { nvo[0][0] = cvo[0][0]; nvo[0][1] = cvo[0][1]; nvo[1][0] = cvo[1][0]; nvo[1][1] = cvo[1][1]; }
        const char* nA = has_next ? nxt.A : cA; const char* nB = has_next ? nxt.B : cB;
#pragma unroll 1
        for (int t = 0; t < nt; t += 2) {
            const bool last = (t == nt - 2);
            const char* a1 = cA + (size_t)(t + 1) * kstep;
            const char* a2 = last ? nA : cA + (size_t)(t + 2) * kstep; const char* b2 = last ? nB : cB + (size_t)(t + 2) * kstep;
            const char* a3 = a2 + kstep; const char* b3 = b2 + kstep;
            unsigned v2[2][2];
            v2[0][0] = last ? nvo[0][0] : cvo[0][0]; v2[0][1] = last ? nvo[0][1] : cvo[0][1]; v2[1][0] = last ? nvo[1][0] : cvo[1][0]; v2[1][1] = last ? nvo[1][1] : cvo[1][1];
            GS_LDB(B0, 0, 0); GS_LDB(B1, 0, 1); GS_SCHED; GS_LDA(At, 0, 0); GS_STAGE(GS_SA(1, 1), a1, cvo[1]);
            GS_WAIT_V(8); GS_WAIT_L(0); GS_BAR; GS_MMA(0, 0, At, B0); GS_MMA(0, 1, At, B1); GS_BAR; GS_SCHED;
            GS_LDA(At, 0, 1); GS_STAGE(GS_SB(0, 0), b2, voffB); GS_STAGE(GS_SB(0, 1), b2 + hstepB, voffB); GS_STAGE(GS_SA(0, 0), a2, v2[0]);
            GS_WAIT_V(8); GS_WAIT_L(0); GS_BAR; GS_MMA(1, 0, At, B0); GS_MMA(1, 1, At, B1); GS_BAR; GS_SCHED;
            GS_LDB(B0, 1, 0); GS_LDB(B1, 1, 1); GS_SCHED; GS_LDA(At, 1, 0); GS_STAGE(GS_SA(0, 1), a2, v2[1]);
            GS_WAIT_V(8); GS_WAIT_L(0); GS_BAR; GS_MMA(0, 0, At, B0); GS_MMA(0, 1, At, B1); GS_BAR; GS_SCHED;
            GS_LDA(At, 1, 1); GS_STAGE(GS_SB(1, 0), b3, voffB); GS_STAGE(GS_SB(1, 1), b3 + hstepB, voffB); GS_STAGE(GS_SA(1, 0), a3, v2[0]);
            GS_WAIT_V(8); GS_WAIT_L(0); GS_BAR; GS_MMA(1, 0, At, B0); GS_MMA(1, 1, At, B1); GS_BAR; GS_SCHED;
        }
        if (wr == 0) GS_BAR;
        E(acc, cur, wr, wc, fr, fq);
        if (!has_next) break;
#pragma unroll
        for (int a = 0; a < 2; ++a)
#pragma unroll
            for (int b = 0; b < 2; ++b)
#pragma unroll
                for (int m = 0; m < 4; ++m)
#pragma unroll
                    for (int n = 0; n < 2; ++n) acc[a][b][m][n] = (f32x4){0.f, 0.f, 0.f, 0.f};
        cur = nxt; cA = nA; cB = nB; ++ui;
        cvo[0][0] = nvo[0][0]; cvo[0][1] = nvo[0][1]; cvo[1][0] = nvo[1][0]; cvo[1][1] = nvo[1][1];
        if (wr == 1) GS_BAR;
    }
    GS_WAIT_V(0);
    GS_BAR;
#undef GS_SA
#undef GS_SB
#undef GS_STAGE
#undef GS_LDA
#undef GS_LDB
#undef GS_MMA
#undef GS_WAIT_V
#undef GS_WAIT_L
#undef GS_BAR
#undef GS_SCHED
}
struct DenseU { const char* A; const char* B; int pm, pn; };
struct DenseSched {
    typedef DenseU U;
    const bf16_t* A; const bf16_t* Bt; int K, nunits, first, stride, npn, pn_base, pn_mod0, pn_mod1;
    DI int colmap(int q) const { return pn_base + (q / pn_mod0) * pn_mod1 + (q % pn_mod0); }
    DI bool next(int i, U& u) const {
        const int L = first + i * stride; if (L >= nunits) return false;
        u.pm = L / npn; u.pn = colmap(L % npn);
        u.A = (const char*)A + (size_t)u.pm * BM * K * 2; u.B = (const char*)Bt + (size_t)u.pn * BM * K * 2; return true;
    }
    DI void a_off(int, const U&, const int (&R)[2], const int (&C)[2], unsigned (&vo)[2][2]) const {
#pragma unroll
        for (int h = 0; h < 2; ++h)
#pragma unroll
            for (int i = 0; i < 2; ++i) vo[h][i] = (unsigned)((HALF * h + R[i]) * K + C[i]) * 2u;
    }
};
}

DI void transpose_cvt(const float* W, bf16_t* Wt, int K, int N, int unit, char* lds) {
    float* tile = (float*)lds;
    const int nbn = N / 64, kb = unit / nbn, nb = unit % nbn, tid = tidx();
    __syncthreads();
#pragma unroll
    for (int i = 0; i < 8; ++i) { const int idx = tid + i * 512, r = idx >> 6, c = idx & 63; tile[r * 65 + c] = W[(size_t)(kb * 64 + r) * N + nb * 64 + c]; }
    __syncthreads();
#pragma unroll
    for (int i = 0; i < 8; ++i) { const int idx = tid + i * 512, n = idx >> 6, k = idx & 63; Wt[(size_t)(nb * 64 + n) * K + kb * 64 + k] = f2bf(tile[k * 65 + n]); }
}
struct P0Args { const float* x; const float* w_in; const float* w_out; const float* router_w; bf16_t* xb; bf16_t* wt_in; bf16_t* wt_out; bf16_t* wt_r;
                const float* w_gate; const float* w_up; const float* w_down; const float* ws_gate; const float* ws_up; const float* ws_down; bf16_t* wgut; bf16_t* wdt; };
constexpr int CV_GU = 257 * 2 * 16, CV_DN = 257 * 16;
struct CvItem { const float* src; bf16_t* dst; int ld, ldd, rbase, rhi; };
DI CvItem cv_item(const P0Args& a, int it) {
    CvItem c;
    if (it < CV_GU) {
        const int e = it / 32, u = (it >> 4) & 1, kt = it & 15;
        const float* W = e < N_EXP ? (u ? a.w_up : a.w_gate) + (size_t)e * D_MODEL * D_EXP : (u ? a.ws_up : a.ws_gate);
        c.src = W + (size_t)kt * 64 * D_EXP; c.ld = D_EXP; c.dst = a.wgut + (size_t)e * 512 * D_MODEL + kt * 64; c.ldd = D_MODEL; c.rbase = 128 * u; c.rhi = 256;
    } else {
        const int j = it - CV_GU, e = j / 16, kt = (j >> 2) & 3, nb = j & 3;
        const float* W = e < N_EXP ? a.w_down + (size_t)e * D_EXP * D_MODEL : a.ws_down;
        c.src = W + (size_t)kt * 64 * D_MODEL + nb * 256; c.ld = D_MODEL; c.dst = a.wdt + (size_t)e * D_MODEL * D_EXP + kt * 64; c.ldd = D_EXP; c.rbase = 256 * nb; c.rhi = 128;
    }
    return c;
}
DI void cv_load(const CvItem& c, f32x4 (&v)[8]) {
    const int tid = tidx();
#pragma unroll
    for (int i = 0; i < 8; ++i) { const int idx = tid + i * 512, k = idx >> 6, n4 = idx & 63; v[i] = __builtin_nontemporal_load((const f32x4*)(c.src + (size_t)k * c.ld + 4 * n4)); }
}
DI void cv_store(const CvItem& c, const f32x4 (&v)[8], char* lds) {
    float* tile = (float*)lds;
    const int tid = tidx();
    __syncthreads();
#pragma unroll
    for (int i = 0; i < 8; ++i) { const int idx = tid + i * 512, k = idx >> 6, n4 = idx & 63; *(f32x4*)(tile + k * 260 + 4 * (n4 ^ ((k >> 3) & 7))) = v[i]; }
    __syncthreads();
#pragma unroll
    for (int i = 0; i < 4; ++i) {
        const int idx = tid + i * 512, kc = idx & 7, n = idx >> 3; const float* p = tile + (8 * kc) * 260 + (n ^ (4 * kc));
        u32x4 o; o.x = cvt_pk_bf16(p[0], p[260]); o.y = cvt_pk_bf16(p[2 * 260], p[3 * 260]); o.z = cvt_pk_bf16(p[4 * 260], p[5 * 260]); o.w = cvt_pk_bf16(p[6 * 260], p[7 * 260]);
        __builtin_nontemporal_store(o, (u32x4*)(c.dst + (size_t)(c.rbase + (n >> 7) * c.rhi + (n & 127)) * c.ldd + 8 * kc));
    }
}
DI void convert_moe_all(const P0Args& a, char* lds) {
    int it = vblock(); if (it >= CV_GU + CV_DN) return;
    CvItem c = cv_item(a, it); f32x4 v[8]; cv_load(c, v);
#pragma unroll 1
    for (;;) {
        const int nit = it + GRID; const bool more = nit < CV_GU + CV_DN;
        CvItem cn = c; f32x4 w[8];
        if (more) { cn = cv_item(a, nit); cv_load(cn, w); }
        cv_store(c, v, lds);
        if (!more) break;
        it = nit; c = cn;
#pragma unroll
        for (int i = 0; i < 8; ++i) v[i] = w[i];
    }
}
DI void phase_prologue(const P0Args& a, char* lds) {
    const int vb = vblock();
    for (size_t i = (size_t)vb * NTHR + tidx(); i < (size_t)T_TOK * D_MODEL / 8; i += (size_t)GRID * NTHR) {
        const f32x4 v0 = *(const f32x4*)(a.x + i * 8), v1 = *(const f32x4*)(a.x + i * 8 + 4);
        u32x4 o; o.x = cvt_pk_bf16(v0[0], v0[1]); o.y = cvt_pk_bf16(v0[2], v0[3]); o.z = cvt_pk_bf16(v1[0], v1[1]); o.w = cvt_pk_bf16(v1[2], v1[3]);
        *(u32x4*)(a.xb + i * 8) = o;
    }
    const int n_in = (1024 / 64) * (3072 / 64), n_out = 16 * 16, n_r = 16 * 4;
    for (int u = vb; u < n_in + n_out + n_r; u += GRID) {
        if (u < n_in) transpose_cvt(a.w_in, a.wt_in, 1024, 3072, u, lds);
        else if (u < n_in + n_out) transpose_cvt(a.w_out, a.wt_out, 1024, 1024, u - n_in, lds);
        else transpose_cvt(a.router_w, a.wt_r, 1024, 256, u - n_in - n_out, lds);
    }
}


struct P1Args { const bf16_t* xb; const bf16_t* wt_in; bf16_t* Q; bf16_t* Kb; bf16_t* Vt; };
struct EpiQK { bf16_t* Q; bf16_t* Kb;
    DI void operator()(const f32x4 (&acc)[2][2][4][2], const gs::DenseU& u, int wr, int wc, int fr, int fq) const {
        const int seg = u.pn >> 1, type = seg % 3, grp = seg / 3; bf16_t* dst = type == 0 ? Q : Kb; const float sc = type == 0 ? QSCALE : 1.f;
#pragma unroll
        for (int ai = 0; ai < 2; ++ai)
#pragma unroll
            for (int m = 0; m < 4; ++m) {
                const int row = u.pm * 256 + 128 * ai + 64 * wr + 16 * m + fr, b = row / SEQ, s = row % SEQ;
#pragma unroll
                for (int bj = 0; bj < 2; ++bj) {
                    const int hh = grp * 8 + 4 * (u.pn & 1) + 2 * bj + (wc >> 1), d0 = 32 * (wc & 1) + 8 * fq;
                    const f32x4 v0 = acc[ai][bj][m][0] * sc, v1 = acc[ai][bj][m][1] * sc;
                    u32x4 o; o.x = cvt_pk_bf16(v0[0], v0[1]); o.y = cvt_pk_bf16(v0[2], v0[3]); o.z = cvt_pk_bf16(v1[0], v1[1]); o.w = cvt_pk_bf16(v1[2], v1[3]);
                    *(u32x4*)(dst + (size_t)(b * NHH + hh) * SEQ * 64 + (s >> 5) * 2048 + ((d0 >> 3) * 32 + (s & 31)) * 8) = o;
                }
            }
    } };
struct EpiV { bf16_t* Vt;
    DI void operator()(const f32x4 (&acc)[2][2][4][2], const gs::DenseU& u, int wr, int wc, int fr, int fq) const {
        const int grp = (u.pn >> 1) / 3;
#pragma unroll
        for (int ai = 0; ai < 2; ++ai)
#pragma unroll
            for (int m = 0; m < 4; ++m) {
                const int row = u.pm * 256 + 128 * ai + 64 * wr + 16 * m + 4 * fq, b = row / SEQ, s = row % SEQ;
#pragma unroll
                for (int bj = 0; bj < 2; ++bj)
#pragma unroll
                    for (int n = 0; n < 2; ++n) {
                        const int hh = grp * 8 + 4 * (u.pn & 1) + 2 * bj + (wc >> 1), d = 32 * (wc & 1) + 16 * n + fr;
                        const f32x4 v = acc[ai][bj][m][n];
                        u32x2 o; o.x = cvt_pk_bf16(v[0], v[1]); o.y = cvt_pk_bf16(v[2], v[3]);
                        { const int kap = s & 31; *(u32x2*)(Vt + (size_t)(b * NHH + hh) * SEQ * 64 + (s >> 5) * 2048 + ((((d >> 5) * 2 + (kap >> 4)) * 2 + ((kap >> 2) & 1)) * 32 + (d & 31)) * 8 + ((kap >> 3) & 1) * 4) = o; }
                    }
            }
    } };
DI void phase_qkv(const P1Args& a, LAS unsigned char* lds) {
    { gs::DenseSched S{a.xb, a.wt_in, D_MODEL, (T_TOK / 256) * 8, vblock(), GRID, 8, 0, 4, 6}; EpiQK E{a.Q, a.Kb}; gs::gemm_stream<true, true>(lds, D_MODEL, S, E); }
    { gs::DenseSched S{a.xb, a.wt_in, D_MODEL, (T_TOK / 256) * 4, vblock(), GRID, 4, 4, 2, 6}; EpiV E{a.Vt}; gs::gemm_stream<false, false>(lds, D_MODEL, S, E); }
}

struct P3Args { const bf16_t* y; const bf16_t* wt_out; const float* x; bf16_t* r; float* stats; };
struct EpiOut { const float* x; bf16_t* r; float* stats;
    DI void operator()(const f32x4 (&acc)[2][2][4][2], const gs::DenseU& u, int wr, int wc, int fr, int fq) const {
#pragma unroll
        for (int ai = 0; ai < 2; ++ai)
#pragma unroll
            for (int m = 0; m < 4; ++m) {
                const int row = u.pm * 256 + 128 * ai + 64 * wr + 16 * m + fr;
#pragma unroll
                for (int bj = 0; bj < 2; ++bj) {
                    const int col = u.pn * 256 + 128 * bj + 32 * wc + 8 * fq;
                    const f32x4 x0 = *(const f32x4*)(x + (size_t)row * D_MODEL + col), x1 = *(const f32x4*)(x + (size_t)row * D_MODEL + col + 4);
                    const f32x4 v0 = x0 * DN_ALPHA + acc[ai][bj][m][0], v1 = x1 * DN_ALPHA + acc[ai][bj][m][1];
                    float s = ((v0[0] + v0[1]) + (v0[2] + v0[3])) + ((v1[0] + v1[1]) + (v1[2] + v1[3]));
                    float q = ((v0[0] * v0[0] + v0[1] * v0[1]) + (v0[2] * v0[2] + v0[3] * v0[3])) + ((v1[0] * v1[0] + v1[1] * v1[1]) + (v1[2] * v1[2] + v1[3] * v1[3]));
                    u32x4 o; o.x = cvt_pk_bf16(v0[0], v0[1]); o.y = cvt_pk_bf16(v0[2], v0[3]); o.z = cvt_pk_bf16(v1[0], v1[1]); o.w = cvt_pk_bf16(v1[2], v1[3]);
                    *(u32x4*)(r + (size_t)row * D_MODEL + col) = o;
                    s += __shfl_xor(s, 16); s += __shfl_xor(s, 32); q += __shfl_xor(q, 16); q += __shfl_xor(q, 32);
                    if (fq == 0) *(f32x2*)(stats + ((size_t)row * 32 + u.pn * 8 + bj * 4 + wc) * 2) = (f32x2){s, q};
                }
            }
    } };
DI void phase_outproj(const P3Args& a, LAS unsigned char* lds) {
    gs::DenseSched S{a.y, a.wt_out, D_MODEL, (T_TOK / 256) * 4, vblock(), GRID, 4, 0, 4, 0}; EpiOut E{a.x, a.r, a.stats}; gs::gemm_stream<true, true>(lds, D_MODEL, S, E);
}

constexpr int RS_SC = 289;
constexpr int LDS_HIST = 100 * 1024;
struct P4Args { const bf16_t* r; const float* stats; const float* ln_g; const float* ln_b; bf16_t* x1; const bf16_t* wt_r; const float* rbias;
                int* eidx; float* gate; int* counts; int* tokl; float* gatel; int* slot; };
DI void phase_router(const P4Args& a, char* lds) {
    const int tid = tidx(), wid = tid >> 6, lane = tid & 63, wr = wid >> 2, wc = wid & 3, fr = lane & 15, fq = lane >> 4;
    float* sc = (float*)lds; int* hist = (int*)(lds + LDS_HIST); int* base = hist + 256;
    for (int u = vblock(); u < T_TOK / 128; u += GRID) {
        const int m0 = u * 128;
        for (int i = 0; i < 16; ++i) {
            const int t = m0 + wid * 16 + i;
            f32x2 st = (f32x2){0.f, 0.f};
            if (lane < 32) st = *(const f32x2*)(a.stats + ((size_t)t * 32 + lane) * 2);
            float s = st.x, q = st.y;
#pragma unroll
            for (int o = 1; o <= 16; o <<= 1) { s += __shfl_xor(s, o); q += __shfl_xor(q, o); }
            s = __shfl(s, 0); q = __shfl(q, 0);
            const float mu = s * (1.f / 1024.f), rstd = rsqrtf(q * (1.f / 1024.f) - mu * mu + LN_EPS);
            const u32x4 r0 = *(const u32x4*)(a.r + (size_t)t * D_MODEL + lane * 16), r1 = *(const u32x4*)(a.r + (size_t)t * D_MODEL + lane * 16 + 8);
            float v[16];
#pragma unroll
            for (int j = 0; j < 4; ++j) { v[2 * j] = __uint_as_float(r0[j] << 16); v[2 * j + 1] = __uint_as_float(r0[j] & 0xffff0000u); v[8 + 2 * j] = __uint_as_float(r1[j] << 16); v[8 + 2 * j + 1] = __uint_as_float(r1[j] & 0xffff0000u); }
            u32x4 o0, o1;
#pragma unroll
            for (int j = 0; j < 4; ++j) {
                const f32x4 g = *(const f32x4*)(a.ln_g + lane * 16 + 4 * j), bb = *(const f32x4*)(a.ln_b + lane * 16 + 4 * j);
                const float y0 = (v[4 * j] - mu) * rstd * g[0] + bb[0], y1 = (v[4 * j + 1] - mu) * rstd * g[1] + bb[1], y2 = (v[4 * j + 2] - mu) * rstd * g[2] + bb[2], y3 = (v[4 * j + 3] - mu) * rstd * g[3] + bb[3];
                const unsigned p0 = cvt_pk_bf16(y0, y1), p1 = cvt_pk_bf16(y2, y3);
                if (j < 2) { o0[2 * j] = p0; o0[2 * j + 1] = p1; } else { o1[2 * (j - 2)] = p0; o1[2 * (j - 2) + 1] = p1; }
            }
            *(u32x4*)(a.x1 + (size_t)t * D_MODEL + lane * 16) = o0; *(u32x4*)(a.x1 + (size_t)t * D_MODEL + lane * 16 + 8) = o1;
        }
        if (tid < 256) hist[tid] = 0;
        asm volatile("s_waitcnt vmcnt(0)" ::: "memory");
        __syncthreads();
        ALoader<4> al; al.init_rows(a.x1, D_MODEL, m0);
        BLoaderBt bl; bl.init(a.wt_r, D_MODEL, 0);
        f32x4 acc[4][4];
        gemm_tile<4, true>(lds, al, bl, D_MODEL / 64, acc);
        int my_idx[2], my_rank[2]; float my_gate[2];
#pragma unroll
        for (int p = 0; p < 2; ++p) {
            __syncthreads();
            if (wr == p) {
#pragma unroll
                for (int m = 0; m < 4; ++m)
#pragma unroll
                    for (int n = 0; n < 4; ++n) {
                        const int c0 = 64 * wc + 16 * n + 4 * fq; const f32x4 rb = *(const f32x4*)(a.rbias + c0);
#pragma unroll
                        for (int j = 0; j < 4; ++j) { const int c = c0 + j; sc[(16 * m + fr) * RS_SC + (c >> 5) * 36 + (c & 31)] = 1.f / (1.f + __expf(-acc[m][n][j])) + rb[j]; }
                    }
            }
            __syncthreads();
            const int row = tid >> 3, g = tid & 7, t = m0 + 64 * p + row;
            float sel[32];
#pragma unroll
            for (int i = 0; i < 32; ++i) sel[i] = sc[row * RS_SC + g * 36 + i];
            float m1 = -INFINITY, m2 = -INFINITY;
#pragma unroll
            for (int i = 0; i < 32; ++i) { const float v = sel[i]; m2 = fmaxf(m2, fminf(m1, v)); m1 = fmaxf(m1, v); }
            const float gs = m1 + m2; int rank = 0;
#pragma unroll
            for (int d = 1; d < 8; ++d) { const float o = __shfl_xor(gs, d); const int og = g ^ d; rank += (o > gs || (o == gs && og < g)) ? 1 : 0; }
            const bool en = rank < TOPK_GROUPS;
            float pv = INFINITY; int pi = -1; float myv = 0.f; int myi = 0;
#pragma unroll
            for (int k = 0; k < TOP_K; ++k) {
                float bv = -INFINITY; int bi = 1 << 20;
                if (en) {
#pragma unroll
                    for (int i = 0; i < 32; ++i) { const float v = sel[i]; const int e = g * 32 + i; const bool after = (v < pv) || (v == pv && e > pi); if (after && v > bv) { bv = v; bi = e; } }
                }
#pragma unroll
                for (int d = 1; d < 8; d <<= 1) { const float ov = __shfl_xor(bv, d); const int oi = __shfl_xor(bi, d); if (ov > bv || (ov == bv && oi < bi)) { bv = ov; bi = oi; } }
                pv = bv; pi = bi;
                if (g == k) { myv = bv; myi = bi; }
            }
            const float score = myv - a.rbias[myi];
            float gsum = score;
#pragma unroll
            for (int d = 1; d < 8; d <<= 1) gsum += __shfl_xor(gsum, d);
            const float gt = score / gsum * ROUTED_SCALE;
            a.eidx[t * TOP_K + g] = myi; a.gate[t * TOP_K + g] = gt;
            my_idx[p] = myi; my_gate[p] = gt; my_rank[p] = atomicAdd(&hist[myi], 1);
        }
        __syncthreads();
        if (tid < 256) { const int h = hist[tid]; base[tid] = h > 0 ? atomicAdd(&a.counts[tid], h) : 0; }
        __syncthreads();
#pragma unroll
        for (int p = 0; p < 2; ++p) {
            const int row = tid >> 3, g = tid & 7, t = m0 + 64 * p + row, e = my_idx[p], pos = base[e] + my_rank[p];
            a.tokl[(size_t)e * CAP + pos] = t; a.gatel[(size_t)e * CAP + pos] = my_gate[p]; a.slot[t * TOP_K + g] = e * CAP + pos;
        }
    }
}

constexpr int LDS_ROWTAB = 128 * 1024;
constexpr int LDS_GTAB = 139 * 1024;
constexpr int LDS_TAB = 150 * 1024;
constexpr int MOE_BM = 256;
DI void build_moe_tab(const int* counts, char* lds) {
    int* tstart = (int*)(lds + LDS_TAB); int* rstart = tstart + 264; int* cnts = tstart + 528;
    const int tid = tidx(), lane = tid & 63;
    __syncthreads();
    if (tid < 64) {
        int c[4], tl[4], cs = 0, ts = 0;
#pragma unroll
        for (int i = 0; i < 4; ++i) { c[i] = counts[lane * 4 + i]; tl[i] = (c[i] + MOE_BM - 1) / MOE_BM; cs += c[i]; ts += tl[i]; }
        int ci = cs, ti = ts;
#pragma unroll
        for (int o = 1; o < 64; o <<= 1) { const int n1 = __shfl_up(ci, o), n2 = __shfl_up(ti, o); if (lane >= o) { ci += n1; ti += n2; } }
        int ce = ci - cs, te = ti - ts;
#pragma unroll
        for (int i = 0; i < 4; ++i) { rstart[lane * 4 + i] = ce; tstart[lane * 4 + i] = te; cnts[lane * 4 + i] = c[i]; ce += c[i]; te += tl[i]; }
        if (lane == 63) { rstart[256] = ce; tstart[256] = te; cnts[256] = T_TOK; rstart[257] = ce + T_TOK; tstart[257] = te + T_TOK / MOE_BM; }
    }
    __syncthreads();
}
DI int find_expert(const int* tstart, int g) {
    int lo = 0, hi = 256;
#pragma unroll 1
    while (lo < hi) { const int mid = (lo + hi + 1) >> 1; if (tstart[mid] <= g) lo = mid; else hi = mid - 1; }
    return lo;
}
struct MoeU { const char* A; const char* B; int e, m0, st, cnt, sub; };

struct P6Args { const bf16_t* x1; const int* counts; const int* tokl; const float* gatel; const bf16_t* wgut; bf16_t* H; };
struct GuSched {
    typedef MoeU U;
    const int* tstart; const int* rstart; const int* rowtab; const bf16_t* x1; const bf16_t* wgut; int first, stride, nunits;
    DI bool next(int i, U& u) const {
        const int L = first + i * stride; if (L >= nunits) return false;
        const int g = L >> 1, e = find_expert(tstart, g);
        u.sub = L & 1; u.e = i; u.m0 = (g - tstart[e]) * MOE_BM; u.st = rstart[e]; u.cnt = tstart[528 + e];
        u.A = (const char*)x1; u.B = (const char*)(wgut + ((size_t)e * 512 + 256 * u.sub) * D_MODEL); return true;
    }
    DI void a_off(int i, const U&, const int (&R)[2], const int (&C)[2], unsigned (&vo)[2][2]) const {
#pragma unroll
        for (int h = 0; h < 2; ++h)
#pragma unroll
            for (int p = 0; p < 2; ++p) vo[h][p] = (unsigned)(rowtab[i * 256 + 128 * h + R[p]] * D_MODEL + C[p]) * 2u;
    }
};
struct EpiGU { bf16_t* H; const float* gtab;
    DI void operator()(const f32x4 (&acc)[2][2][4][2], const MoeU& u, int wr, int wc, int fr, int fq) const {
#pragma unroll
        for (int ai = 0; ai < 2; ++ai)
#pragma unroll
            for (int m = 0; m < 4; ++m) {
                const int row = u.m0 + 128 * ai + 64 * wr + 16 * m + fr;
                if (row < u.cnt) {
                    const float gt = gtab[u.e * 256 + 128 * ai + 64 * wr + 16 * m + fr];
                    float h[8];
#pragma unroll
                    for (int n = 0; n < 2; ++n)
#pragma unroll
                        for (int j = 0; j < 4; ++j) { const float gv = acc[ai][0][m][n][j]; h[4 * n + j] = gv * __builtin_amdgcn_rcpf(1.f + __expf(-gv)) * acc[ai][1][m][n][j] * gt; }
                    u32x4 o; o.x = cvt_pk_bf16(h[0], h[1]); o.y = cvt_pk_bf16(h[2], h[3]); o.z = cvt_pk_bf16(h[4], h[5]); o.w = cvt_pk_bf16(h[6], h[7]);
                    *(u32x4*)(H + (size_t)(u.st + row) * D_EXP + 128 * u.sub + 32 * wc + 8 * fq) = o;
                }
            }
    } };
DI void phase_moe_gu(const P6Args& a, char* smem, LAS unsigned char* lds) {
    build_moe_tab(a.counts, smem);
    const int* tstart = (const int*)(smem + LDS_TAB); const int* rstart = tstart + 264; int* rowtab = (int*)(smem + LDS_ROWTAB); float* gtab = (float*)(smem + LDS_GTAB);
    const int nunits = tstart[257] * 2, first = vblock();
    const int n_my = first < nunits ? (nunits - first + GRID - 1) / GRID : 0;
    for (int idx = tidx(); idx < n_my * 256; idx += NTHR) {
        const int i = idx >> 8, row = idx & 255, L = first + i * GRID, g = L >> 1, e = find_expert(tstart, g), m0 = (g - tstart[e]) * MOE_BM, cnt = tstart[528 + e];
        int rr = m0 + row; rr = rr < cnt ? rr : cnt - 1;
        rowtab[idx] = e < N_EXP ? a.tokl[(size_t)e * CAP + rr] : rr;
        gtab[idx] = e < N_EXP ? a.gatel[(size_t)e * CAP + rr] : 1.f;
    }
    __syncthreads();
    GuSched S{tstart, rstart, rowtab, a.x1, a.wgut, first, GRID, nunits}; EpiGU E{a.H, gtab};
    gs::gemm_stream<true, true>(lds, D_MODEL, S, E);
}
struct P7Args { const bf16_t* H; const int* counts; const bf16_t* wdt; bf16_t* Y; };
struct DownSched {
    typedef MoeU U;
    const int* tstart; const int* rstart; const bf16_t* H; const bf16_t* wdt; int first, stride, nunits;
    DI bool next(int i, U& u) const {
        const int L = first + i * stride; if (L >= nunits) return false;
        const int g = L >> 2, e = find_expert(tstart, g);
        u.sub = L & 3; u.e = e; u.m0 = (g - tstart[e]) * MOE_BM; u.st = rstart[e]; u.cnt = tstart[528 + e];
        u.A = (const char*)(H + (size_t)(u.st + u.m0) * D_EXP); u.B = (const char*)(wdt + ((size_t)e * D_MODEL + 256 * u.sub) * D_EXP); return true;
    }
    DI void a_off(int, const U&, const int (&R)[2], const int (&C)[2], unsigned (&vo)[2][2]) const {
#pragma unroll
        for (int h = 0; h < 2; ++h)
#pragma unroll
            for (int p = 0; p < 2; ++p) vo[h][p] = (unsigned)((128 * h + R[p]) * D_EXP + C[p]) * 2u;
    }
};
struct EpiDown { bf16_t* Y;
    DI void operator()(const f32x4 (&acc)[2][2][4][2], const MoeU& u, int wr, int wc, int fr, int fq) const {
#pragma unroll
        for (int ai = 0; ai < 2; ++ai)
#pragma unroll
            for (int m = 0; m < 4; ++m) {
                const int row = u.m0 + 128 * ai + 64 * wr + 16 * m + fr;
                if (row < u.cnt) {
#pragma unroll
                    for (int bj = 0; bj < 2; ++bj) {
                        const f32x4 v0 = acc[ai][bj][m][0], v1 = acc[ai][bj][m][1];
                        u32x4 o; o.x = cvt_pk_bf16(v0[0], v0[1]); o.y = cvt_pk_bf16(v0[2], v0[3]); o.z = cvt_pk_bf16(v1[0], v1[1]); o.w = cvt_pk_bf16(v1[2], v1[3]);
                        *(u32x4*)(Y + (size_t)(u.st + row) * D_MODEL + 256 * u.sub + 128 * bj + 32 * wc + 8 * fq) = o;
                    }
                }
            }
    } };
DI void phase_moe_down(const P7Args& a, char* smem, LAS unsigned char* lds) {
    build_moe_tab(a.counts, smem);
    const int* tstart = (const int*)(smem + LDS_TAB); const int* rstart = tstart + 264;
    DownSched S{tstart, rstart, a.H, a.wdt, vblock(), GRID, tstart[257] * 4}; EpiDown E{a.Y};
    gs::gemm_stream<true, true>(lds, D_EXP, S, E);
}
struct P8Args { const bf16_t* x1; const bf16_t* Y; const int* slot; const int* counts; const float* ln_g; const float* ln_b; float* out; };
DI void unpack16(const u32x4& a, const u32x4& b, float (&v)[16]) {
#pragma unroll
    for (int j = 0; j < 4; ++j) { v[2 * j] = __uint_as_float(a[j] << 16); v[2 * j + 1] = __uint_as_float(a[j] & 0xffff0000u); v[8 + 2 * j] = __uint_as_float(b[j] << 16); v[8 + 2 * j + 1] = __uint_as_float(b[j] & 0xffff0000u); }
}
DI void phase_combine(const P8Args& a, char* lds) {
    const int tid = tidx(), wid = tid >> 6, lane = tid & 63;
    build_moe_tab(a.counts, lds);
    const int* rstart = (const int*)(lds + LDS_TAB) + 264;
    const int sh0 = rstart[256];
    for (int t = vblock() * 8 + wid; t < T_TOK; t += GRID * 8) {
        float v[16], w[16];
        { const u32x4 p0 = *(const u32x4*)(a.x1 + (size_t)t * D_MODEL + lane * 16), p1 = *(const u32x4*)(a.x1 + (size_t)t * D_MODEL + lane * 16 + 8); unpack16(p0, p1, v); }
#pragma unroll
        for (int i = 0; i < 16; ++i) v[i] *= DN_ALPHA;
        { const bf16_t* yp = a.Y + (size_t)(sh0 + t) * D_MODEL + lane * 16; const u32x4 p0 = *(const u32x4*)yp, p1 = *(const u32x4*)(yp + 8); unpack16(p0, p1, w); }
#pragma unroll
        for (int i = 0; i < 16; ++i) v[i] += w[i];
        int sl = 0; if (lane < TOP_K) sl = a.slot[t * TOP_K + lane];
#pragma unroll
        for (int k = 0; k < TOP_K; ++k) {
            const int s = __shfl(sl, k), e = s / CAP, pos = s % CAP;
            const bf16_t* yp = a.Y + (size_t)(rstart[e] + pos) * D_MODEL + lane * 16; const u32x4 p0 = *(const u32x4*)yp, p1 = *(const u32x4*)(yp + 8); unpack16(p0, p1, w);
#pragma unroll
            for (int i = 0; i < 16; ++i) v[i] += w[i];
        }
        float s = 0.f;
#pragma unroll
        for (int i = 0; i < 16; ++i) s += v[i];
#pragma unroll
        for (int o = 32; o >= 1; o >>= 1) s += __shfl_xor(s, o);
        const float mu = s * (1.f / 1024.f);
        float q = 0.f;
#pragma unroll
        for (int i = 0; i < 16; ++i) { const float d = v[i] - mu; q += d * d; }
#pragma unroll
        for (int o = 32; o >= 1; o >>= 1) q += __shfl_xor(q, o);
        const float rstd = rsqrtf(q * (1.f / 1024.f) + LN_EPS);
#pragma unroll
        for (int j = 0; j < 4; ++j) {
            const f32x4 g = *(const f32x4*)(a.ln_g + lane * 16 + 4 * j), bb = *(const f32x4*)(a.ln_b + lane * 16 + 4 * j);
            f32x4 o; o[0] = (v[4 * j] - mu) * rstd * g[0] + bb[0]; o[1] = (v[4 * j + 1] - mu) * rstd * g[1] + bb[1]; o[2] = (v[4 * j + 2] - mu) * rstd * g[2] + bb[2]; o[3] = (v[4 * j + 3] - mu) * rstd * g[3] + bb[3];
            *(f32x4*)(a.out + (size_t)t * D_MODEL + lane * 16 + 4 * j) = o;
        }
    }
}

#define MFMA32(a, b, c) __builtin_amdgcn_mfma_f32_32x32x16_bf16((a), (b), (c), 0, 0, 0)
constexpr float SB_EXIT_THR = 1e-30f;
struct P2Args { const bf16_t* Q; const bf16_t* Kb; const bf16_t* Vt; const float* rel_bias; const float* gain_a; const float* gain_b; bf16_t* y; };

DI bf16x8 pack8(const f32x16& x, int s) {
    u32x4 p;
    if (s == 0) { p.x = cvt_pk_bf16(x[0], x[1]); p.y = cvt_pk_bf16(x[2], x[3]); p.z = cvt_pk_bf16(x[4], x[5]); p.w = cvt_pk_bf16(x[6], x[7]); }
    else        { p.x = cvt_pk_bf16(x[8], x[9]); p.y = cvt_pk_bf16(x[10], x[11]); p.z = cvt_pk_bf16(x[12], x[13]); p.w = cvt_pk_bf16(x[14], x[15]); }
    return __builtin_bit_cast(bf16x8, p);
}
DI void load_k(bf16x8 (&k)[4], const bf16_t* kp, int k0) {
#pragma unroll
    for (int kk = 0; kk < 4; ++kk) k[kk] = *(const bf16x8*)(kp + (size_t)(k0 >> 5) * 2048 + kk * 512);
}
DI void load_v(bf16x8 (&v)[2][2], const bf16_t* vp, int k0) {
#pragma unroll
    for (int dt = 0; dt < 2; ++dt)
#pragma unroll
        for (int s = 0; s < 2; ++s) v[dt][s] = *(const bf16x8*)(vp + (size_t)(k0 >> 5) * 2048 + (dt * 2 + s) * 512);
}

constexpr int LDS_CVT = 16 * 1024;
DI void phase_attn(const P2Args& a, const P0Args& cv, char* lds) {
    const int tid = tidx(), wid = tid >> 6, lane = tid & 63, r = lane & 31, h = lane >> 5;
    float* tbl = (float*)lds;
    float* ssq = (float*)(lds + 8 * 260 * 4);
    __syncthreads();
    for (int i = tid; i < NHA * 257; i += NTHR) { const int hd = i / 257, j = i % 257; tbl[hd * 260 + j] = a.rel_bias[i] * LOG2E; }
    __syncthreads();
    const int cgrp = vblock() % 3;
#pragma unroll 1
    for (int slot = 0; slot < 5; ++slot) {
        if ((cgrp == 0 && slot == 0) || (cgrp == 1 && slot == 2) || (cgrp == 2 && slot == 4)) convert_moe_all(cv, lds + LDS_CVT);
        if (slot == 4) break;
        const int u = vblock() + GRID * (slot >> 1) + 2 * GRID * (slot & 1);
        const bool isB = u >= BATCH * (SEQ / 64); const int uu = isB ? u - BATCH * (SEQ / 64) : u;
        const int b = uu / (SEQ / 64), c = uu % (SEQ / 64), q0 = c * 64, hh = (isB ? NHA : 0) + wid;
        const size_t hb = (size_t)(b * NHH + hh) * SEQ * 64;
        const bf16_t* kp = a.Kb + hb + lane * 8;
        const bf16_t* vp = a.Vt + hb + lane * 8;
        bf16x8 qf[2][4];
#pragma unroll
        for (int qt = 0; qt < 2; ++qt)
#pragma unroll
            for (int kk = 0; kk < 4; ++kk) qf[qt][kk] = *(const bf16x8*)(a.Q + hb + (size_t)((q0 >> 5) + qt) * 2048 + kk * 512 + lane * 8);
        f32x16 ot[2][2];
#pragma unroll
        for (int dt = 0; dt < 2; ++dt)
#pragma unroll
            for (int qt = 0; qt < 2; ++qt)
#pragma unroll
                for (int i = 0; i < 16; ++i) ot[dt][qt][i] = 0.f;
        float linv[2] = {1.f, 1.f};
        if (!isB) {
            float mrun[2] = {-INFINITY, -INFINITY}, lrun[2] = {0.f, 0.f};
            const int klo = q0 - LEFT_CHUNKS * CHUNK < 0 ? 0 : q0 - LEFT_CHUNKS * CHUNK, khi = q0 + 64;
            const float cfar = tbl[wid * 260 + 256];
            bf16x8 kc[4], kn[4], vf[2][2]; load_k(kc, kp, klo);
            for (int k0 = klo; k0 < khi; k0 += 32) {
                load_v(vf, vp, k0);
                load_k(kn, kp, k0 + 32 < khi ? k0 + 32 : k0);
#pragma unroll
                for (int qt = 0; qt < 2; ++qt) {
                    bf16x8 pf[2];
                    f32x16 st;
#pragma unroll
                    for (int i = 0; i < 16; ++i) st[i] = 0.f;
#pragma unroll
                    for (int kk = 0; kk < 4; ++kk) st = MFMA32(kc[kk], qf[qt][kk], st);
                    const int dmin = q0 + 32 * qt - k0 - 31;
                    if (dmin >= MAX_REL) {
#pragma unroll
                        for (int i = 0; i < 16; ++i) st[i] += cfar;
                    } else {
                        const int bidx = q0 + 32 * qt + r - k0 - 4 * h + MAX_REL;
#pragma unroll
                        for (int i = 0; i < 16; ++i) { int ix = bidx - ((i & 3) + 8 * (i >> 2)); ix = ix < 0 ? 0 : (ix > 2 * MAX_REL ? 2 * MAX_REL : ix); st[i] += tbl[wid * 260 + ix]; }
                    }
                    float mx = st[0];
#pragma unroll
                    for (int i = 1; i < 16; ++i) mx = fmaxf(mx, st[i]);
                    mx = fmaxf(mx, __shfl_xor(mx, 32));
                    const float mn = fmaxf(mrun[qt], mx), alpha = __builtin_amdgcn_exp2f(mrun[qt] - mn);
                    mrun[qt] = mn;
                    float ps = 0.f;
#pragma unroll
                    for (int i = 0; i < 16; ++i) { st[i] = __builtin_amdgcn_exp2f(st[i] - mn); ps += st[i]; }
                    lrun[qt] = lrun[qt] * alpha + ps;
#pragma unroll
                    for (int i = 0; i < 16; ++i) { ot[0][qt][i] *= alpha; ot[1][qt][i] *= alpha; }
                    pf[0] = pack8(st, 0); pf[1] = pack8(st, 1);
#pragma unroll
                    for (int dt = 0; dt < 2; ++dt)
#pragma unroll
                        for (int s = 0; s < 2; ++s) ot[dt][qt] = MFMA32(vf[dt][s], pf[s], ot[dt][qt]);
                }
#pragma unroll
                for (int kk = 0; kk < 4; ++kk) kc[kk] = kn[kk];
            }
#pragma unroll
            for (int qt = 0; qt < 2; ++qt) { const float lt = lrun[qt] + __shfl_xor(lrun[qt], 32); linv[qt] = 1.f / lt; }
        } else {
            float carry[2] = {1.f, 1.f};
            bf16x8 kc[4], kn[4], vf[2][2]; load_k(kc, kp, q0 + 32);
            for (int k0 = q0 + 32; k0 >= 0; k0 -= 32) {
                load_v(vf, vp, k0);
                load_k(kn, kp, k0 >= 32 ? k0 - 32 : k0);
#pragma unroll
                for (int qt = 0; qt < 2; ++qt) {
                    bf16x8 pf[2];
                    f32x16 st;
#pragma unroll
                    for (int i = 0; i < 16; ++i) st[i] = 0.f;
                    const bool none = (k0 > q0 + 32 * qt + 30);
                    if (!none) {
#pragma unroll
                        for (int kk = 0; kk < 4; ++kk) st = MFMA32(kc[kk], qf[qt][kk], st);
                        const bool full = (k0 + 31 < q0 + 32 * qt);
                        const int lim = q0 + 32 * qt + r - k0 - 4 * h;
                        float om[16];
#pragma unroll
                        for (int i = 0; i < 16; ++i) {
                            const float e = __builtin_amdgcn_exp2f(-st[i]); float bta = __builtin_amdgcn_rcpf(1.f + e);
                            if (!full && !(((i & 3) + 8 * (i >> 2)) < lim)) bta = 0.f;
                            st[i] = bta; om[i] = 1.f - bta;
                        }
                        float G[4], Go[4];
#pragma unroll
                        for (int g = 0; g < 4; ++g) { G[g] = (om[4 * g] * om[4 * g + 1]) * (om[4 * g + 2] * om[4 * g + 3]); Go[g] = __shfl_xor(G[g], 32); }
                        float R = carry[qt];
#pragma unroll
                        for (int g = 3; g >= 0; --g) {
                            float run = h == 0 ? R * Go[g] : R;
#pragma unroll
                            for (int uu2 = 3; uu2 >= 0; --uu2) { const float bta = st[4 * g + uu2]; st[4 * g + uu2] = bta * run; run *= om[4 * g + uu2]; }
                            R = R * (G[g] * Go[g]);
                        }
                        carry[qt] = R;
                    }
                    if (!none) {
                        pf[0] = pack8(st, 0); pf[1] = pack8(st, 1);
#pragma unroll
                        for (int dt = 0; dt < 2; ++dt)
#pragma unroll
                            for (int s = 0; s < 2; ++s) ot[dt][qt] = MFMA32(vf[dt][s], pf[s], ot[dt][qt]);
                    }
                }
#pragma unroll
                for (int kk = 0; kk < 4; ++kk) kc[kk] = kn[kk];
                if (__all(carry[0] < SB_EXIT_THR && carry[1] < SB_EXIT_THR)) break;
            }
        }
        float ss[2];
#pragma unroll
        for (int qt = 0; qt < 2; ++qt) {
            float s2 = 0.f;
#pragma unroll
            for (int dt = 0; dt < 2; ++dt)
#pragma unroll
                for (int i = 0; i < 16; ++i) { ot[dt][qt][i] *= linv[qt]; s2 += ot[dt][qt][i] * ot[dt][qt][i]; }
            s2 += __shfl_xor(s2, 32); ss[qt] = s2;
        }
        __syncthreads();
        if (h == 0) { ssq[wid * 64 + r] = ss[0]; ssq[wid * 64 + 32 + r] = ss[1]; }
        __syncthreads();
        const float* gain = isB ? a.gain_b : a.gain_a;
#pragma unroll
        for (int qt = 0; qt < 2; ++qt) {
            float tot = 0.f;
#pragma unroll
            for (int w8 = 0; w8 < 8; ++w8) tot += ssq[w8 * 64 + 32 * qt + r];
            const float rs = rsqrtf(tot * (1.f / 512.f) + RMS_EPS);
            bf16_t* yp = a.y + (size_t)(b * SEQ + q0 + 32 * qt + r) * D_MODEL + (isB ? 512 : 0) + wid * 64;
#pragma unroll
            for (int dt = 0; dt < 2; ++dt)
#pragma unroll
                for (int g = 0; g < 4; ++g) {
                    const int d = 32 * dt + 8 * g + 4 * h; const f32x4 gn = *(const f32x4*)(gain + wid * 64 + d);
                    u32x2 o; o.x = cvt_pk_bf16(ot[dt][qt][4 * g] * rs * gn[0], ot[dt][qt][4 * g + 1] * rs * gn[1]); o.y = cvt_pk_bf16(ot[dt][qt][4 * g + 2] * rs * gn[2], ot[dt][qt][4 * g + 3] * rs * gn[3]);
                    *(u32x2*)(yp + d) = o;
                }
        }
    }
}


#define XB_TMO      128
#define XB_XCNT(j)  (256  + 64 * (j))
#define XB_XSUB(j)  (1280 + 64 * (j))
#define XB_XGEN(j)  (2304 + 64 * (j))
#define XB_TOP      3328
#define XB_TOPGEN   3392
#define XCD_BAR_WORDS 3456
#define XB_SPIN_CAP (1u << 18)
#define LAS __attribute__((address_space(3)))

__device__ __forceinline__ unsigned xb_ld(unsigned* p)              { return __hip_atomic_load(p, __ATOMIC_RELAXED, __HIP_MEMORY_SCOPE_AGENT); }
__device__ __forceinline__ unsigned xb_add(unsigned* p, unsigned v) { return __hip_atomic_fetch_add(p, v, __ATOMIC_RELAXED, __HIP_MEMORY_SCOPE_AGENT); }
__device__ __forceinline__ unsigned xb_xcc_id() { return (unsigned)__builtin_amdgcn_s_getreg((3 << 11) | 20) & 0xFu; }
#define XB_SPIN(cond, bar) do { unsigned _sp = 0; while (cond) { __builtin_amdgcn_s_sleep(1); \
    if ((++_sp & 255u) == 0u) { if (xb_ld(&(bar)[XB_TMO])) break; if (_sp > XB_SPIN_CAP) { atomicAdd(&(bar)[XB_TMO], 1u); break; } } } } while (0)

struct XcdBarrier {
    unsigned* bar; unsigned x;
    volatile LAS unsigned* st;
};

__device__ __forceinline__ XcdBarrier xcd_barrier_post(unsigned* bar, volatile LAS unsigned* st) {
    XcdBarrier b; b.bar = bar; b.x = xb_xcc_id(); b.st = st;
    if (threadIdx.x == 0) (void)xb_add(&bar[XB_XCNT(b.x)], 1u);
    return b;
}
__device__ __forceinline__ void xcd_barrier_complete(unsigned* bar, unsigned x, unsigned& nloc, unsigned& nx) {
    const unsigned G = gridDim.x * gridDim.y * gridDim.z;
    unsigned sum, cnt, mine, sp = 0u;
    for (;;) {
        sum = 0u; cnt = 0u; mine = 0u;
#pragma unroll
        for (unsigned j = 0; j < 16; ++j) { const unsigned c = xb_ld(&bar[XB_XCNT(j)]); sum += c; cnt += (c > 0u) ? 1u : 0u; mine = (j == x) ? c : mine; }
        if (sum == G) break;
        __builtin_amdgcn_s_sleep(1);
        if ((++sp & 255u) == 0u) { if (xb_ld(&bar[XB_TMO])) break; if (sp > XB_SPIN_CAP) { atomicAdd(&bar[XB_TMO], 1u); break; } }
    }
    nloc = mine > 0u ? mine : 1u; nx = cnt > 0u ? cnt : 1u;
}

__device__ __forceinline__ void xcd_barrier(const XcdBarrier& b) {
    asm volatile("s_waitcnt vmcnt(0)" ::: "memory");
    __syncthreads();
    if (threadIdx.x == 0) {
        unsigned* bar = b.bar;
        __builtin_amdgcn_s_waitcnt(0);
        unsigned nloc = b.st[0], nx = b.st[1];
        if (nloc == 0u) { xcd_barrier_complete(bar, b.x, nloc, nx); b.st[0] = nloc; b.st[1] = nx; }
        const unsigned old = xb_add(&bar[XB_XSUB(b.x)], 1u);
        const unsigned gen = old / nloc;
        if (old + 1u == (gen + 1u) * nloc) {
            __builtin_amdgcn_fence(__ATOMIC_RELEASE, "agent");
            asm volatile("s_waitcnt vmcnt(0)" ::: "memory");
            const unsigned og = xb_add(&bar[XB_TOP], 1u);
            const unsigned tg = og / nx;
            if (og + 1u == (tg + 1u) * nx) xb_add(&bar[XB_TOPGEN], 1u);
            else XB_SPIN(xb_ld(&bar[XB_TOPGEN]) == tg, bar);
            __builtin_amdgcn_fence(__ATOMIC_ACQUIRE, "agent");
            xb_add(&bar[XB_XGEN(b.x)], 1u);
            asm volatile("s_waitcnt vmcnt(0)" ::: "memory");
        } else {
            XB_SPIN(xb_ld(&bar[XB_XGEN(b.x)]) == gen, bar);
            __builtin_amdgcn_fence(__ATOMIC_ACQUIRE, "agent");
            asm volatile("s_waitcnt vmcnt(0)" ::: "memory");
        }
    }
    __syncthreads();
}


struct MegaArgs { P0Args p0; P1Args p1; P2Args p2; P3Args p3; P4Args p4; P6Args p6; P7Args p7; P8Args p8; unsigned* bar; };
__global__ __launch_bounds__(NTHR, 2) void k_mega(MegaArgs a) {
    extern __shared__ __attribute__((aligned(16))) char smem[];
    volatile LAS unsigned* xbw = (volatile LAS unsigned*)(smem + LDS_BYTES - 16);
    if (threadIdx.x == 0) { xbw[0] = 0u; xbw[1] = 0u; xbw[2] = 0u; xbw[3] = 0u; }
    __syncthreads();
    XcdBarrier bar = xcd_barrier_post(a.bar, xbw);
    LAS unsigned char* L = (LAS unsigned char*)smem;
    phase_prologue(a.p0, smem);     xcd_barrier(bar);
    phase_qkv(a.p1, L);             xcd_barrier(bar);
    phase_attn(a.p2, a.p0, smem);   xcd_barrier(bar);
    phase_outproj(a.p3, L);         xcd_barrier(bar);
    phase_router(a.p4, smem);       xcd_barrier(bar);
    phase_moe_gu(a.p6, smem, L);    xcd_barrier(bar);
    phase_moe_down(a.p7, smem, L);  xcd_barrier(bar);
    phase_combine(a.p8, smem);
}

extern "C" void kernel_launch(void* const* d_in, const int* in_sizes, int n_in, void* d_out, int out_size, void* d_ws, size_t ws_size, hipStream_t stream) {
    const float* x = (const float*)d_in[0];      const float* w_in = (const float*)d_in[1];   const float* rel_bias = (const float*)d_in[2];
    const float* gain_a = (const float*)d_in[3]; const float* gain_b = (const float*)d_in[4]; const float* w_out = (const float*)d_in[5];
    const float* ln1_g = (const float*)d_in[6];  const float* ln1_b = (const float*)d_in[7];  const float* router_w = (const float*)d_in[8];
    const float* router_bias = (const float*)d_in[9]; const float* w_gate = (const float*)d_in[10]; const float* w_up = (const float*)d_in[11];
    const float* w_down = (const float*)d_in[12]; const float* ws_gate = (const float*)d_in[13]; const float* ws_up = (const float*)d_in[14];
    const float* ws_down = (const float*)d_in[15]; const float* ln2_g = (const float*)d_in[16]; const float* ln2_b = (const float*)d_in[17];
    char* ws = (char*)d_ws; float* out = (float*)d_out;
    int* ctrl = (int*)(ws + OFF_CTRL); int* counts = ctrl + CW_COUNTS;
    bf16_t* X1 = (bf16_t*)(ws + OFF_X1); int* tokl = (int*)(ws + OFF_TOKL); float* gatel = (float*)(ws + OFF_GATEL);
    int* eidx = (int*)(ws + OFF_EIDX); float* gate = (float*)(ws + OFF_GATE); int* slot = (int*)(ws + OFF_SLOT);
    bf16_t* H = (bf16_t*)(ws + OFF_H); bf16_t* Y = (bf16_t*)(ws + OFF_Y);
    bf16_t* Q = (bf16_t*)(ws + OFF_Q); bf16_t* Kb = (bf16_t*)(ws + OFF_K); bf16_t* Vt = (bf16_t*)(ws + OFF_VT);
    bf16_t* yatt = (bf16_t*)(ws + OFF_YATT); bf16_t* r = (bf16_t*)(ws + OFF_R);
    bf16_t* xb = (bf16_t*)(ws + OFF_XB); float* stats = (float*)(ws + OFF_STATS);
    bf16_t* wt_in = (bf16_t*)(ws + OFF_WTIN); bf16_t* wt_out = (bf16_t*)(ws + OFF_WTOUT); bf16_t* wt_r = (bf16_t*)(ws + OFF_WTR);
    bf16_t* wgut = (bf16_t*)(ws + OFF_WGUT); bf16_t* wdt = (bf16_t*)(ws + OFF_WDT);
    if (ws_size < WS_NEEDED) { fprintf(stderr, "kernel_launch: workspace too small (%zu < %zu)\n", ws_size, (size_t)WS_NEEDED); return; }
    hipMemsetAsync(ctrl, 0, 64 * 1024, stream);
    static bool attr_done = false;
    if (!attr_done) {
        hipFuncSetAttribute((const void*)k_mega, hipFuncAttributeMaxDynamicSharedMemorySize, LDS_BYTES);
        attr_done = true;
    }
    MegaArgs m{};
    m.p0 = P0Args{x, w_in, w_out, router_w, xb, wt_in, wt_out, wt_r, w_gate, w_up, w_down, ws_gate, ws_up, ws_down, wgut, wdt};
    m.p1 = P1Args{xb, wt_in, Q, Kb, Vt};
    m.p2 = P2Args{Q, Kb, Vt, rel_bias, gain_a, gain_b, yatt};
    m.p3 = P3Args{yatt, wt_out, x, r, stats};
    m.p4 = P4Args{r, stats, ln1_g, ln1_b, X1, wt_r, router_bias, eidx, gate, counts, tokl, gatel, slot};
    m.p6 = P6Args{X1, counts, tokl, gatel, wgut, H};
    m.p7 = P7Args{H, counts, wdt, Y};
    m.p8 = P8Args{X1, Y, slot, counts, ln2_g, ln2_b, out};
    m.bar = (unsigned*)ctrl;
    k_mega<<<GRID, NTHR, LDS_BYTES, stream>>>(m);
}
```

```cpp
#include <hip/hip_runtime.h>
#include <cstdint>
#include <cstdio>

typedef unsigned short bf16_t;

constexpr int D_MODEL = 1024, BATCH = 16, SEQ = 2048, T_TOK = BATCH * SEQ;
constexpr int HEAD_DIM = 64, NHA = 8, NHB = 8, NHH = 16;
constexpr int CHUNK = 64, LEFT_CHUNKS = 8, MAX_REL = 128;
constexpr int N_EXP = 256, TOP_K = 8, N_GROUPS = 8, TOPK_GROUPS = 4, EPG = 32, D_EXP = 256;
constexpr float ROUTED_SCALE = 2.5f, LN_EPS = 1e-5f, RMS_EPS = 1e-6f;
constexpr float DN_ALPHA = 1.189207115002721f;
constexpr float LOG2E = 1.4426950408889634f, LN2 = 0.6931471805599453f;
constexpr float QSCALE = 0.125f * LOG2E;
constexpr float YSCALE = 64.f;
constexpr int CAP = T_TOK;
constexpr int ROWS_ALL = T_TOK * TOP_K + T_TOK;

__device__ __forceinline__ float bf2f(bf16_t v) { return __uint_as_float(((unsigned)v) << 16); }
__device__ __forceinline__ bf16_t f2bf(float f) { unsigned u = __float_as_uint(f); u += 0x7fffu + ((u >> 16) & 1u); return (bf16_t)(u >> 16); }

constexpr size_t MB = 1024ull * 1024ull;
constexpr size_t OFF_CTRL   = 0;
constexpr size_t OFF_X1     = 1 * MB;
constexpr size_t OFF_TOKL   = OFF_X1 + 64 * MB;
constexpr size_t OFF_GATEL  = OFF_TOKL + 32 * MB;
constexpr size_t OFF_EIDX   = OFF_GATEL + 32 * MB;
constexpr size_t OFF_GATE   = OFF_EIDX + 1 * MB;
constexpr size_t OFF_SLOT   = OFF_GATE + 1 * MB;
constexpr size_t OFF_WDT    = OFF_SLOT + 1 * MB;
constexpr size_t OFF_BIG    = OFF_WDT + 129 * MB;
constexpr size_t OFF_H      = OFF_BIG;
constexpr size_t OFF_Y      = OFF_BIG + 144 * MB;
constexpr size_t OFF_Q      = OFF_BIG;
constexpr size_t OFF_K      = OFF_BIG + 64 * MB;
constexpr size_t OFF_VT     = OFF_BIG + 128 * MB;
constexpr size_t OFF_YATT   = OFF_BIG + 192 * MB;
constexpr size_t OFF_R      = OFF_BIG + 256 * MB;
constexpr size_t OFF_XB     = OFF_BIG + 320 * MB;
constexpr size_t OFF_STATS  = OFF_BIG + 384 * MB;
constexpr size_t OFF_WTIN   = OFF_BIG + 392 * MB;
constexpr size_t OFF_WTOUT  = OFF_BIG + 398 * MB;
constexpr size_t OFF_WTR    = OFF_BIG + 400 * MB;
constexpr size_t OFF_WGUT   = OFF_BIG + 401 * MB;
constexpr size_t WS_NEEDED  = OFF_BIG + 720 * MB;
static_assert(OFF_WGUT + 257 * MB <= WS_NEEDED && WS_NEEDED <= 1024 * MB, "workspace map");
constexpr int CW_COUNTS = 4096;

typedef short bf16x8 __attribute__((ext_vector_type(8)));
typedef float f32x4 __attribute__((ext_vector_type(4)));
typedef float f32x2 __attribute__((ext_vector_type(2)));
typedef float f32x16 __attribute__((ext_vector_type(16)));
typedef unsigned u32x4 __attribute__((ext_vector_type(4)));
typedef unsigned u32x2 __attribute__((ext_vector_type(2)));
#define DI __device__ __forceinline__
constexpr int NTHR = 512, GRID = 256;
DI int tidx() { int t = threadIdx.x; asm volatile("" : "+v"(t)); return t; }
constexpr int LDS_BYTES = 160 * 1024;

typedef __bf16 bf16x2_t __attribute__((ext_vector_type(2)));
DI unsigned cvt_pk_bf16(float lo, float hi) { f32x2 v = {lo, hi}; bf16x2_t r = __builtin_convertvector(v, bf16x2_t); return __builtin_bit_cast(unsigned, r); }
DI int vblock() { return (int)((blockIdx.x & 7) * (GRID / 8) + (blockIdx.x >> 3)); }

template <int MT> struct Tile { static constexpr int BM = 32 * MT, A_BYTES = BM * 128, B_BYTES = 256 * 128, STAGE = A_BYTES + B_BYTES; };

template <int MT> struct ALoader {
    const bf16_t* p[MT / 2]; u32x4 v[MT / 2]; int off0;
    DI void init_rows(const bf16_t* A, int lda, int row0) {
        const int tid = tidx(), kc = tid & 7, r = tid >> 3;
#pragma unroll
        for (int i = 0; i < MT / 2; ++i) p[i] = A + (size_t)(row0 + r + 64 * i) * lda + kc * 8;
        off0 = r * 128 + ((kc ^ ((r >> 1) & 7)) << 4);
    }
    DI void init_gather(const bf16_t* A, int lda, const int* rows, int cnt, int m0) {
        const int tid = tidx(), kc = tid & 7, r = tid >> 3;
#pragma unroll
        for (int i = 0; i < MT / 2; ++i) { int rr = m0 + r + 64 * i; rr = rr < cnt ? rr : cnt - 1; const int g = rows ? rows[rr] : rr; p[i] = A + (size_t)g * lda + kc * 8; }
        off0 = r * 128 + ((kc ^ ((r >> 1) & 7)) << 4);
    }
    DI void load(int k0) {
#pragma unroll
        for (int i = 0; i < MT / 2; ++i) v[i] = *(const u32x4*)(p[i] + k0);
    }
    DI void store(char* ldsA) const {
#pragma unroll
        for (int i = 0; i < MT / 2; ++i) *(u32x4*)(ldsA + off0 + i * 8192) = v[i];
    }
};
struct BLoaderBt {
    const bf16_t* p[4]; u32x4 v[4]; int off0;
    DI void init(const bf16_t* Bt, int ldk, int n0) {
        const int tid = tidx(), kc = tid & 7, r = tid >> 3;
#pragma unroll
        for (int i = 0; i < 4; ++i) p[i] = Bt + (size_t)(n0 + r + 64 * i) * ldk + kc * 8;
        off0 = r * 128 + ((kc ^ ((r >> 1) & 7)) << 4);
    }
    DI void load(int k0) {
#pragma unroll
        for (int i = 0; i < 4; ++i) v[i] = *(const u32x4*)(p[i] + k0);
    }
    DI void store(char* ldsB) const {
#pragma unroll
        for (int i = 0; i < 4; ++i) *(u32x4*)(ldsB + off0 + i * 8192) = v[i];
    }
};
template <bool GU> struct BLoaderF32 {
    const float* p[2]; int ldb; f32x2 v[2][8]; int off[2][2];
    DI void init(const float* P0, const float* P1, int ldb_) {
        const int tid = tidx(), l = tid & 63, w = tid >> 6; ldb = ldb_;
        p[0] = P0 + (size_t)(8 * w) * ldb + 2 * l; p[1] = P1 + (size_t)(8 * w) * ldb + 2 * l;
#pragma unroll
        for (int jp = 0; jp < 2; ++jp)
#pragma unroll
            for (int jj = 0; jj < 2; ++jj) { const int c = 2 * l + jj; const int row = GU ? (64 * (c >> 5) + 32 * jp + (c & 31)) : (128 * jp + c); off[jp][jj] = row * 128 + ((w ^ ((row >> 1) & 7)) << 4); }
    }
    DI void load(int k0) {
#pragma unroll
        for (int jp = 0; jp < 2; ++jp)
#pragma unroll
            for (int kk = 0; kk < 8; ++kk) v[jp][kk] = *(const f32x2*)(p[jp] + (size_t)(k0 + kk) * ldb);
    }
    DI void store(char* ldsB) const {
#pragma unroll
        for (int jp = 0; jp < 2; ++jp) {
            u32x4 a, b;
            a.x = cvt_pk_bf16(v[jp][0].x, v[jp][1].x); a.y = cvt_pk_bf16(v[jp][2].x, v[jp][3].x); a.z = cvt_pk_bf16(v[jp][4].x, v[jp][5].x); a.w = cvt_pk_bf16(v[jp][6].x, v[jp][7].x);
            b.x = cvt_pk_bf16(v[jp][0].y, v[jp][1].y); b.y = cvt_pk_bf16(v[jp][2].y, v[jp][3].y); b.z = cvt_pk_bf16(v[jp][4].y, v[jp][5].y); b.w = cvt_pk_bf16(v[jp][6].y, v[jp][7].y);
            *(u32x4*)(ldsB + off[jp][0]) = a; *(u32x4*)(ldsB + off[jp][1]) = b;
        }
    }
};

template <int MT, bool TR, class AL, class BL>
DI void gemm_tile(char* lds, AL& al, BL& bl, int nk, f32x4 (&acc)[MT][4]) {
    typedef Tile<MT> TT;
    const int tid = tidx(), wid = tid >> 6, lane = tid & 63, wr = wid >> 2, wc = wid & 3, fr = lane & 15, fq = lane >> 4;
#pragma unroll
    for (int m = 0; m < MT; ++m)
#pragma unroll
        for (int n = 0; n < 4; ++n) acc[m][n] = (f32x4){0.f, 0.f, 0.f, 0.f};
    int aoff[2], boff[2];
#pragma unroll
    for (int ks = 0; ks < 2; ++ks) { const int ch = (((4 * ks + fq) ^ (fr >> 1)) << 4); aoff[ks] = (16 * MT * wr + fr) * 128 + ch; boff[ks] = TT::A_BYTES + (64 * wc + fr) * 128 + ch; }
    al.load(0); bl.load(0);
    __syncthreads();
    al.store(lds); bl.store(lds + TT::A_BYTES);
    __syncthreads();
    for (int kt = 0; kt < nk; ++kt) {
        char* cur = lds + (kt & 1) * TT::STAGE; char* nxt = lds + ((kt & 1) ^ 1) * TT::STAGE;
        const bool more = kt + 1 < nk;
        if (more) { al.load((kt + 1) * 64); bl.load((kt + 1) * 64); }
#pragma unroll
        for (int ks = 0; ks < 2; ++ks) {
            bf16x8 a[MT], b[4];
#pragma unroll
            for (int m = 0; m < MT; ++m) a[m] = *(const bf16x8*)(cur + aoff[ks] + m * 2048);
#pragma unroll
            for (int n = 0; n < 4; ++n) b[n] = *(const bf16x8*)(cur + boff[ks] + n * 2048);
#pragma unroll
            for (int m = 0; m < MT; ++m)
#pragma unroll
                for (int n = 0; n < 4; ++n)
                    acc[m][n] = TR ? __builtin_amdgcn_mfma_f32_16x16x32_bf16(b[n], a[m], acc[m][n], 0, 0, 0) : __builtin_amdgcn_mfma_f32_16x16x32_bf16(a[m], b[n], acc[m][n], 0, 0, 0);
        }
        if (more) { al.store(nxt); bl.store(nxt + TT::A_BYTES); }
        __syncthreads();
    }
}

#define LAS __attribute__((address_space(3)))
namespace gs {
constexpr int BM = 256, BK = 64, HALF = 128, HTB = HALF * BK * 2, STAGE_BYTES = 8 * HTB;
DI int lds_byte(int r, int c) { const int st = (r >> 4) * 2 + (c >> 5), rr = r & 15, cc = c & 31, ob = rr * 64 + cc * 2; return st * 1024 + (ob ^ (((ob >> 9) & 1) << 5)); }
DI void stage_rc(int b, int& R, int& C) { const int st = b / 1024, sb = b % 1024, swz = sb ^ (((sb >> 9) & 1) << 5); R = (st >> 1) * 16 + swz / 64; C = (st & 1) * 32 + (swz % 64) / 2; }
DI int perm32(int rho) { const int n = rho >> 4, i = rho & 15; return 8 * (i >> 2) + 4 * n + (i & 3); }
template <bool TR, bool PERM, class Sched, class Epi>
DI void gemm_stream(LAS unsigned char* lds, const int K, const Sched& S, const Epi& E) {
    typedef typename Sched::U U;
    const int tid = tidx(), wid = __builtin_amdgcn_readfirstlane(tid >> 6), lane = tid & 63, wr = wid >> 2, wc = wid & 3, fr = lane & 15, fq = lane >> 4;
    const int nt = K / BK;
    int R[2], C[2]; unsigned voffB[2];
#pragma unroll
    for (int i = 0; i < 2; ++i) { stage_rc(tid * 16 + i * 8192, R[i], C[i]); const int Rb = PERM ? ((R[i] & ~31) + perm32(R[i] & 31)) : R[i]; voffB[i] = (unsigned)(Rb * K + C[i]) * 2u; }
    const size_t kstep = (size_t)(BK * 2), hstepB = (size_t)HALF * K * 2;
    const unsigned ldsw = (unsigned)wid * 1024u;
    const int aoff = lds_byte(wr * 64 + fr, fq * 8), boff = lds_byte(wc * 32 + fr, fq * 8);
#define GS_SA(b, h) (((b) * 2 + (h)) * HTB)
#define GS_SB(b, h) ((4 + (b) * 2 + (h)) * HTB)
#define GS_STAGE(bufoff, gbase, voff) do { _Pragma("unroll") for (int _i = 0; _i < 2; ++_i) \
        __builtin_amdgcn_global_load_lds((const unsigned*)((const char*)(gbase) + (voff)[_i]), (LAS unsigned*)(lds + (bufoff) + ldsw + _i * 8192), 16, 0, 0); } while (0)
#define GS_LDA(dst, b, h) do { _Pragma("unroll") for (int m = 0; m < 4; ++m) _Pragma("unroll") for (int k = 0; k < 2; ++k) dst[m][k] = *(const LAS bf16x8*)(lds + GS_SA(b, h) + aoff + m * 2048 + k * 1024); } while (0)
#define GS_LDB(dst, b, h) do { _Pragma("unroll") for (int n = 0; n < 2; ++n) _Pragma("unroll") for (int k = 0; k < 2; ++k) dst[n][k] = *(const LAS bf16x8*)(lds + GS_SB(b, h) + boff + n * 2048 + k * 1024); } while (0)
#define GS_MMA(ai, bj, At, Bt) do { __builtin_amdgcn_s_setprio(1); _Pragma("unroll") for (int m = 0; m < 4; ++m) _Pragma("unroll") for (int n = 0; n < 2; ++n) _Pragma("unroll") for (int k = 0; k < 2; ++k) \
        acc[ai][bj][m][n] = TR ? __builtin_amdgcn_mfma_f32_16x16x32_bf16(Bt[n][k], At[m][k], acc[ai][bj][m][n], 0, 0, 0) : __builtin_amdgcn_mfma_f32_16x16x32_bf16(At[m][k], Bt[n][k], acc[ai][bj][m][n], 0, 0, 0); \
        __builtin_amdgcn_s_setprio(0); } while (0)
#define GS_WAIT_V(n) asm volatile("s_waitcnt vmcnt(" #n ")" ::: "memory")
#define GS_WAIT_L(n) asm volatile("s_waitcnt lgkmcnt(" #n ")" ::: "memory")
#define GS_BAR __builtin_amdgcn_s_barrier()
#define GS_SCHED __builtin_amdgcn_sched_barrier(0)
    U cur, nxt; int ui = 0;
    if (!S.next(0, cur)) return;
    f32x4 acc[2][2][4][2];
#pragma unroll
    for (int a = 0; a < 2; ++a)
#pragma unroll
        for (int b = 0; b < 2; ++b)
#pragma unroll
            for (int m = 0; m < 4; ++m)
#pragma unroll
                for (int n = 0; n < 2; ++n) acc[a][b][m][n] = (f32x4){0.f, 0.f, 0.f, 0.f};
    bf16x8 At[4][2], B0[2][2], B1[2][2];
    unsigned cvo[2][2], nvo[2][2];
    S.a_off(0, cur, R, C, cvo);
    const char* cA = cur.A; const char* cB = cur.B;
    GS_STAGE(GS_SB(0, 0), cB, voffB); GS_STAGE(GS_SB(0, 1), cB + hstepB, voffB); GS_STAGE(GS_SA(0, 0), cA, cvo[0]); GS_STAGE(GS_SA(0, 1), cA, cvo[1]);
    if (wr == 1) GS_BAR;
    GS_WAIT_V(2); GS_BAR;
    GS_STAGE(GS_SB(1, 0), cB + kstep, voffB); GS_STAGE(GS_SA(1, 0), cA + kstep, cvo[0]); GS_STAGE(GS_SB(1, 1), cB + hstepB + kstep, voffB);
    GS_WAIT_V(6); GS_BAR;
    for (;;) {
        const bool has_next = S.next(ui + 1, nxt);
        if (has_next) S.a_off(ui + 1, nxt, R, C, nvo);
        else { nvo[0][0] = cvo[0][0]; nvo[0][1] = cvo[0][1]; nvo[1][0] = cvo[1][0]; nvo[1][1] = cvo[1][1]; }
        const char* nA = has_next ? nxt.A : cA; const char* nB = has_next ? nxt.B : cB;
#pragma unroll 1
        for (int t = 0; t < nt; t += 2) {
            const bool last = (t == nt - 2);
            const char* a1 = cA + (size_t)(t + 1) * kstep;
            const char* a2 = last ? nA : cA + (size_t)(t + 2) * kstep; const char* b2 = last ? nB : cB + (size_t)(t + 2) * kstep;
            const char* a3 = a2 + kstep; const char* b3 = b2 + kstep;
            unsigned v2[2][2];
            v2[0][0] = last ? nvo[0][0] : cvo[0][0]; v2[0][1] = last ? nvo[0][1] : cvo[0][1]; v2[1][0] = last ? nvo[1][0] : cvo[1][0]; v2[1][1] = last ? nvo[1][1] : cvo[1][1];
            GS_LDB(B0, 0, 0); GS_LDB(B1, 0, 1); GS_SCHED; GS_LDA(At, 0, 0); GS_STAGE(GS_SA(1, 1), a1, cvo[1]);
            GS_WAIT_V(8); GS_WAIT_L(0); GS_BAR; GS_MMA(0, 0, At, B0); GS_MMA(0, 1, At, B1); GS_BAR; GS_SCHED;
            GS_LDA(At, 0, 1); GS_STAGE(GS_SB(0, 0), b2, voffB); GS_STAGE(GS_SB(0, 1), b2 + hstepB, voffB); GS_STAGE(GS_SA(0, 0), a2, v2[0]);
            GS_WAIT_V(8); GS_WAIT_L(0); GS_BAR; GS_MMA(1, 0, At, B0); GS_MMA(1, 1, At, B1); GS_BAR; GS_SCHED;
            GS_LDB(B0, 1, 0); GS_LDB(B1, 1, 1); GS_SCHED; GS_LDA(At, 1, 0); GS_STAGE(GS_SA(0, 1), a2, v2[1]);
            GS_WAIT_V(8); GS_WAIT_L(0); GS_BAR; GS_MMA(0, 0, At, B0); GS_MMA(0, 1, At, B1); GS_BAR; GS_SCHED;
            GS_LDA(At, 1, 1); GS_STAGE(GS_SB(1, 0), b3, voffB); GS_STAGE(GS_SB(1, 1), b3 + hstepB, voffB); GS_STAGE(GS_SA(1, 0), a3, v2[0]);
            GS_WAIT_V(8); GS_WAIT_L(0); GS_BAR; GS_MMA(1, 0, At, B0); GS_MMA(1, 1, At, B1); GS_BAR; GS_SCHED;
        }
        if (wr == 0) GS_BAR;
        E(acc, cur, wr, wc, fr, fq);
        if (!has_next) break;
#pragma unroll
        for (int a = 0; a < 2; ++a)
#pragma unroll
            for (int b = 0; b < 2; ++b)
#pragma unroll
                for (int m = 0; m < 4; ++m)
#pragma unroll
                    for (int n = 0; n < 2; ++n) acc[a][b][m][n] = (f32x4){0.f, 0.f, 0.f, 0.f};
        cur = nxt; cA = nA; cB = nB; ++ui;
        cvo[0][0] = nvo[0][0]; cvo[0][1] = nvo[0][1]; cvo[1][0] = nvo[1][0]; cvo[1][1] = nvo[1][1];
        if (wr == 1) GS_BAR;
    }
    GS_WAIT_V(0);
    GS_BAR;
#undef GS_SA
#undef GS_SB
#undef GS_STAGE
#undef GS_LDA
#undef GS_LDB
#undef GS_MMA
#undef GS_WAIT_V
#undef GS_WAIT_L
#undef GS_BAR
#undef GS_SCHED
}
struct DenseU { const char* A; const char* B; int pm, pn; };
struct DenseSched {
    typedef DenseU U;
    const bf16_t* A; const bf16_t* Bt; int K, nunits, first, stride, npn, pn_base, pn_mod0, pn_mod1;
    DI int colmap(int q) const { return pn_base + (q / pn_mod0) * pn_mod1 + (q % pn_mod0); }
    DI bool next(int i, U& u) const {
        const int L = first + i * stride; if (L >= nunits) return false;
        u.pm = L / npn; u.pn = colmap(L % npn);
        u.A = (const char*)A + (size_t)u.pm * BM * K * 2; u.B = (const char*)Bt + (size_t)u.pn * BM * K * 2; return true;
    }
    DI void a_off(int, const U&, const int (&R)[2], const int (&C)[2], unsigned (&vo)[2][2]) const {
#pragma unroll
        for (int h = 0; h < 2; ++h)
#pragma unroll
            for (int i = 0; i < 2; ++i) vo[h][i] = (unsigned)((HALF * h + R[i]) * K + C[i]) * 2u;
    }
};
}

DI void transpose_cvt(const float* W, bf16_t* Wt, int K, int N, int unit, char* lds) {
    float* tile = (float*)lds;
    const int nbn = N / 64, kb = unit / nbn, nb = unit % nbn, tid = tidx();
    __syncthreads();
#pragma unroll
    for (int i = 0; i < 8; ++i) { const int idx = tid + i * 512, r = idx >> 6, c = idx & 63; tile[r * 65 + c] = W[(size_t)(kb * 64 + r) * N + nb * 64 + c]; }
    __syncthreads();
#pragma unroll
    for (int i = 0; i < 8; ++i) { const int idx = tid + i * 512, n = idx >> 6, k = idx & 63; Wt[(size_t)(nb * 64 + n) * K + kb * 64 + k] = f2bf(tile[k * 65 + n]); }
}
struct P0Args { const float* x; const float* w_in; const float* w_out; const float* router_w; bf16_t* xb; bf16_t* wt_in; bf16_t* wt_out; bf16_t* wt_r;
                const float* w_gate; const float* w_up; const float* w_down; const float* ws_gate; const float* ws_up; const float* ws_down; bf16_t* wgut; bf16_t* wdt; };
constexpr int CV_GU = 257 * 2 * 16, CV_DN = 257 * 16;
struct CvItem { const float* src; bf16_t* dst; int ld, ldd, rbase, rhi; };
DI CvItem cv_item(const P0Args& a, int it) {
    CvItem c;
    if (it < CV_GU) {
        const int e = it / 32, u = (it >> 4) & 1, kt = it & 15;
        const float* W = e < N_EXP ? (u ? a.w_up : a.w_gate) + (size_t)e * D_MODEL * D_EXP : (u ? a.ws_up : a.ws_gate);
        c.src = W + (size_t)kt * 64 * D_EXP; c.ld = D_EXP; c.dst = a.wgut + (size_t)e * 512 * D_MODEL + kt * 64; c.ldd = D_MODEL; c.rbase = 128 * u; c.rhi = 256;
    } else {
        const int j = it - CV_GU, e = j / 16, kt = (j >> 2) & 3, nb = j & 3;
        const float* W = e < N_EXP ? a.w_down + (size_t)e * D_EXP * D_MODEL : a.ws_down;
        c.src = W + (size_t)kt * 64 * D_MODEL + nb * 256; c.ld = D_MODEL; c.dst = a.wdt + (size_t)e * D_MODEL * D_EXP + kt * 64; c.ldd = D_EXP; c.rbase = 256 * nb; c.rhi = 128;
    }
    return c;
}
DI void cv_load(const CvItem& c, f32x4 (&v)[8]) {
    const int tid = tidx();
#pragma unroll
    for (int i = 0; i < 8; ++i) { const int idx = tid + i * 512, k = idx >> 6, n4 = idx & 63; v[i] = __builtin_nontemporal_load((const f32x4*)(c.src + (size_t)k * c.ld + 4 * n4)); }
}
DI void cv_store(const CvItem& c, const f32x4 (&v)[8], char* lds) {
    float* tile = (float*)lds;
    const int tid = tidx();
    __syncthreads();
#pragma unroll
    for (int i = 0; i < 8; ++i) { const int idx = tid + i * 512, k = idx >> 6, n4 = idx & 63; *(f32x4*)(tile + k * 260 + 4 * (n4 ^ ((k >> 3) & 7))) = v[i]; }
    __syncthreads();
#pragma unroll
    for (int i = 0; i < 4; ++i) {
        const int idx = tid + i * 512, kc = idx & 7, n = idx >> 3; const float* p = tile + (8 * kc) * 260 + (n ^ (4 * kc));
        u32x4 o; o.x = cvt_pk_bf16(p[0], p[260]); o.y = cvt_pk_bf16(p[2 * 260], p[3 * 260]); o.z = cvt_pk_bf16(p[4 * 260], p[5 * 260]); o.w = cvt_pk_bf16(p[6 * 260], p[7 * 260]);
        __builtin_nontemporal_store(o, (u32x4*)(c.dst + (size_t)(c.rbase + (n >> 7) * c.rhi + (n & 127)) * c.ldd + 8 * kc));
    }
}
DI void convert_moe_range(const P0Args& a, char* lds, const int lo, const int hi) {
    int it = lo + vblock(); if (it >= hi) return;
    CvItem c = cv_item(a, it); f32x4 v[8]; cv_load(c, v);
#pragma unroll 1
    for (;;) {
        const int nit = it + GRID; const bool more = nit < hi;
        CvItem cn = c; f32x4 w[8];
        if (more) { cn = cv_item(a, nit); cv_load(cn, w); }
        cv_store(c, v, lds);
        if (!more) break;
        it = nit; c = cn;
#pragma unroll
        for (int i = 0; i < 8; ++i) v[i] = w[i];
    }
}
DI void phase_prologue(const P0Args& a, char* lds) {
    const int vb = vblock();
    for (size_t i = (size_t)vb * NTHR + tidx(); i < (size_t)T_TOK * D_MODEL / 8; i += (size_t)GRID * NTHR) {
        const f32x4 v0 = *(const f32x4*)(a.x + i * 8), v1 = *(const f32x4*)(a.x + i * 8 + 4);
        u32x4 o; o.x = cvt_pk_bf16(v0[0], v0[1]); o.y = cvt_pk_bf16(v0[2], v0[3]); o.z = cvt_pk_bf16(v1[0], v1[1]); o.w = cvt_pk_bf16(v1[2], v1[3]);
        *(u32x4*)(a.xb + i * 8) = o;
    }
    const int n_in = (1024 / 64) * (3072 / 64), n_out = 16 * 16, n_r = 16 * 4;
    for (int u = vb; u < n_in + n_out + n_r; u += GRID) {
        if (u < n_in) transpose_cvt(a.w_in, a.wt_in, 1024, 3072, u, lds);
        else if (u < n_in + n_out) transpose_cvt(a.w_out, a.wt_out, 1024, 1024, u - n_in, lds);
        else transpose_cvt(a.router_w, a.wt_r, 1024, 256, u - n_in - n_out, lds);
    }
}


struct P1Args { const bf16_t* xb; const bf16_t* wt_in; bf16_t* Q; bf16_t* Kb; bf16_t* Vt; };
struct EpiQK { bf16_t* Q; bf16_t* Kb;
    DI void operator()(const f32x4 (&acc)[2][2][4][2], const gs::DenseU& u, int wr, int wc, int fr, int fq) const {
        const int seg = u.pn >> 1, type = seg % 3, grp = seg / 3; bf16_t* dst = type == 0 ? Q : Kb; const float sc = type == 0 ? QSCALE : 1.f;
#pragma unroll
        for (int ai = 0; ai < 2; ++ai)
#pragma unroll
            for (int m = 0; m < 4; ++m) {
                const int row = u.pm * 256 + 128 * ai + 64 * wr + 16 * m + fr, b = row / SEQ, s = row % SEQ;
#pragma unroll
                for (int bj = 0; bj < 2; ++bj) {
                    const int hh = grp * 8 + 4 * (u.pn & 1) + 2 * bj + (wc >> 1), d0 = 32 * (wc & 1) + 8 * fq;
                    const f32x4 v0 = acc[ai][bj][m][0] * sc, v1 = acc[ai][bj][m][1] * sc;
                    u32x4 o; o.x = cvt_pk_bf16(v0[0], v0[1]); o.y = cvt_pk_bf16(v0[2], v0[3]); o.z = cvt_pk_bf16(v1[0], v1[1]); o.w = cvt_pk_bf16(v1[2], v1[3]);
                    *(u32x4*)(dst + (size_t)(b * NHH + hh) * SEQ * 64 + (s >> 5) * 2048 + ((d0 >> 3) * 32 + (s & 31)) * 8) = o;
                }
            }
    } };
struct EpiV { bf16_t* Vt;
    DI void operator()(const f32x4 (&acc)[2][2][4][2], const gs::DenseU& u, int wr, int wc, int fr, int fq) const {
        const int grp = (u.pn >> 1) / 3;
#pragma unroll
        for (int ai = 0; ai < 2; ++ai)
#pragma unroll
            for (int m = 0; m < 4; ++m) {
                const int row = u.pm * 256 + 128 * ai + 64 * wr + 16 * m + 4 * fq, b = row / SEQ, s = row % SEQ;
#pragma unroll
                for (int bj = 0; bj < 2; ++bj)
#pragma unroll
                    for (int n = 0; n < 2; ++n) {
                        const int hh = grp * 8 + 4 * (u.pn & 1) + 2 * bj + (wc >> 1), d = 32 * (wc & 1) + 16 * n + fr;
                        const f32x4 v = acc[ai][bj][m][n];
                        u32x2 o; o.x = cvt_pk_bf16(v[0], v[1]); o.y = cvt_pk_bf16(v[2], v[3]);
                        { const int kap = s & 31; *(u32x2*)(Vt + (size_t)(b * NHH + hh) * SEQ * 64 + (s >> 5) * 2048 + ((((d >> 5) * 2 + (kap >> 4)) * 2 + ((kap >> 2) & 1)) * 32 + (d & 31)) * 8 + ((kap >> 3) & 1) * 4) = o; }
                    }
            }
    } };
DI void phase_qkv(const P1Args& a, LAS unsigned char* lds) {
    { gs::DenseSched S{a.xb, a.wt_in, D_MODEL, (T_TOK / 256) * 8, vblock(), GRID, 8, 0, 4, 6}; EpiQK E{a.Q, a.Kb}; gs::gemm_stream<true, true>(lds, D_MODEL, S, E); }
    { gs::DenseSched S{a.xb, a.wt_in, D_MODEL, (T_TOK / 256) * 4, vblock(), GRID, 4, 4, 2, 6}; EpiV E{a.Vt}; gs::gemm_stream<false, false>(lds, D_MODEL, S, E); }
}

struct P3Args { const bf16_t* y; const bf16_t* wt_out; const float* x; bf16_t* r; float* stats; };
struct EpiOut { const float* x; bf16_t* r; float* stats;
    DI void operator()(const f32x4 (&acc)[2][2][4][2], const gs::DenseU& u, int wr, int wc, int fr, int fq) const {
#pragma unroll
        for (int ai = 0; ai < 2; ++ai)
#pragma unroll
            for (int m = 0; m < 4; ++m) {
                const int row = u.pm * 256 + 128 * ai + 64 * wr + 16 * m + fr;
#pragma unroll
                for (int bj = 0; bj < 2; ++bj) {
                    const int col = u.pn * 256 + 128 * bj + 32 * wc + 8 * fq;
                    const f32x4 x0 = *(const f32x4*)(x + (size_t)row * D_MODEL + col), x1 = *(const f32x4*)(x + (size_t)row * D_MODEL + col + 4);
                    const f32x4 v0 = x0 * DN_ALPHA + acc[ai][bj][m][0], v1 = x1 * DN_ALPHA + acc[ai][bj][m][1];
                    float s = ((v0[0] + v0[1]) + (v0[2] + v0[3])) + ((v1[0] + v1[1]) + (v1[2] + v1[3]));
                    float q = ((v0[0] * v0[0] + v0[1] * v0[1]) + (v0[2] * v0[2] + v0[3] * v0[3])) + ((v1[0] * v1[0] + v1[1] * v1[1]) + (v1[2] * v1[2] + v1[3] * v1[3]));
                    u32x4 o; o.x = cvt_pk_bf16(v0[0], v0[1]); o.y = cvt_pk_bf16(v0[2], v0[3]); o.z = cvt_pk_bf16(v1[0], v1[1]); o.w = cvt_pk_bf16(v1[2], v1[3]);
                    *(u32x4*)(r + (size_t)row * D_MODEL + col) = o;
                    s += __shfl_xor(s, 16); s += __shfl_xor(s, 32); q += __shfl_xor(q, 16); q += __shfl_xor(q, 32);
                    if (fq == 0) *(f32x2*)(stats + ((size_t)row * 32 + u.pn * 8 + bj * 4 + wc) * 2) = (f32x2){s, q};
                }
            }
    } };
DI void phase_outproj(const P3Args& a, LAS unsigned char* lds) {
    gs::DenseSched S{a.y, a.wt_out, D_MODEL, (T_TOK / 256) * 4, vblock(), GRID, 4, 0, 4, 0}; EpiOut E{a.x, a.r, a.stats}; gs::gemm_stream<true, true>(lds, D_MODEL, S, E);
}

DI void unpack16(const u32x4& a, const u32x4& b, float (&v)[16]) {
#pragma unroll
    for (int j = 0; j < 4; ++j) { v[2 * j] = __uint_as_float(a[j] << 16); v[2 * j + 1] = __uint_as_float(a[j] & 0xffff0000u); v[8 + 2 * j] = __uint_as_float(b[j] << 16); v[8 + 2 * j + 1] = __uint_as_float(b[j] & 0xffff0000u); }
}
constexpr int RS_SC = 289;
constexpr int LDS_HIST = 100 * 1024;
struct P4Args { const bf16_t* r; const float* stats; const float* ln_g; const float* ln_b; bf16_t* x1; const bf16_t* wt_r; const float* rbias;
                int* eidx; float* gate; int* counts; int* tokl; float* gatel; int* slot; };
DI void phase_router(const P4Args& a, const P0Args& cv, char* lds) {
    const int tid = tidx(), wid = tid >> 6, lane = tid & 63, wr = wid >> 2, wc = wid & 3, fr = lane & 15, fq = lane >> 4;
    float* sc = (float*)lds; int* hist = (int*)(lds + LDS_HIST); int* base = hist + 256;
    for (int u = vblock(); u < T_TOK / 128; u += GRID) {
        const int m0 = u * 128;
        if ((vblock() & 1) == 0) convert_moe_range(cv, lds, CV_GU, CV_GU + CV_DN);
        __syncthreads();
#pragma unroll 1
        for (int i0 = 0; i0 < 16; i0 += 4) {
            f32x2 st[4]; u32x4 r0[4], r1[4];
#pragma unroll
            for (int j4 = 0; j4 < 4; ++j4) {
                const int t = m0 + wid * 16 + i0 + j4;
                st[j4] = (f32x2){0.f, 0.f};
                if (lane < 32) st[j4] = *(const f32x2*)(a.stats + ((size_t)t * 32 + lane) * 2);
                r0[j4] = *(const u32x4*)(a.r + (size_t)t * D_MODEL + lane * 16); r1[j4] = *(const u32x4*)(a.r + (size_t)t * D_MODEL + lane * 16 + 8);
            }
#pragma unroll
            for (int j4 = 0; j4 < 4; ++j4) {
                const int t = m0 + wid * 16 + i0 + j4;
                float s = st[j4].x, q = st[j4].y;
#pragma unroll
                for (int o = 1; o <= 16; o <<= 1) { s += __shfl_xor(s, o); q += __shfl_xor(q, o); }
                s = __shfl(s, 0); q = __shfl(q, 0);
                const float mu = s * (1.f / 1024.f), rstd = rsqrtf(q * (1.f / 1024.f) - mu * mu + LN_EPS);
                float v[16]; unpack16(r0[j4], r1[j4], v);
                u32x4 o0, o1;
#pragma unroll
                for (int j = 0; j < 4; ++j) {
                    const f32x4 g = *(const f32x4*)(a.ln_g + lane * 16 + 4 * j), bb = *(const f32x4*)(a.ln_b + lane * 16 + 4 * j);
                    const float y0 = (v[4 * j] - mu) * rstd * g[0] + bb[0], y1 = (v[4 * j + 1] - mu) * rstd * g[1] + bb[1], y2 = (v[4 * j + 2] - mu) * rstd * g[2] + bb[2], y3 = (v[4 * j + 3] - mu) * rstd * g[3] + bb[3];
                    const unsigned p0 = cvt_pk_bf16(y0, y1), p1 = cvt_pk_bf16(y2, y3);
                    if (j < 2) { o0[2 * j] = p0; o0[2 * j + 1] = p1; } else { o1[2 * (j - 2)] = p0; o1[2 * (j - 2) + 1] = p1; }
                }
                *(u32x4*)(a.x1 + (size_t)t * D_MODEL + lane * 16) = o0; *(u32x4*)(a.x1 + (size_t)t * D_MODEL + lane * 16 + 8) = o1;
            }
        }
        if (tid < 256) hist[tid] = 0;
        asm volatile("s_waitcnt vmcnt(0)" ::: "memory");
        __syncthreads();
        ALoader<4> al; al.init_rows(a.x1, D_MODEL, m0);
        BLoaderBt bl; bl.init(a.wt_r, D_MODEL, 0);
        f32x4 acc[4][4];
        gemm_tile<4, true>(lds, al, bl, D_MODEL / 64, acc);
        int my_idx[2], my_rank[2]; float my_gate[2];
#pragma unroll
        for (int p = 0; p < 2; ++p) {
            __syncthreads();
            if (wr == p) {
#pragma unroll
                for (int m = 0; m < 4; ++m)
#pragma unroll
                    for (int n = 0; n < 4; ++n) {
                        const int c0 = 64 * wc + 16 * n + 4 * fq; const f32x4 rb = *(const f32x4*)(a.rbias + c0);
#pragma unroll
                        for (int j = 0; j < 4; ++j) { const int c = c0 + j; sc[(16 * m + fr) * RS_SC + (c >> 5) * 36 + (c & 31)] = 1.f / (1.f + __expf(-acc[m][n][j])) + rb[j]; }
                    }
            }
            __syncthreads();
            const int row = tid >> 3, g = tid & 7, t = m0 + 64 * p + row;
            float sel[32];
#pragma unroll
            for (int i = 0; i < 32; ++i) sel[i] = sc[row * RS_SC + g * 36 + i];
            float m1 = -INFINITY, m2 = -INFINITY;
#pragma unroll
            for (int i = 0; i < 32; ++i) { const float v = sel[i]; m2 = fmaxf(m2, fminf(m1, v)); m1 = fmaxf(m1, v); }
            const float gs = m1 + m2; int rank = 0;
#pragma unroll
            for (int d = 1; d < 8; ++d) { const float o = __shfl_xor(gs, d); const int og = g ^ d; rank += (o > gs || (o == gs && og < g)) ? 1 : 0; }
            const bool en = rank < TOPK_GROUPS;
            float pv = INFINITY; int pi = -1; float myv = 0.f; int myi = 0;
#pragma unroll
            for (int k = 0; k < TOP_K; ++k) {
                float bv = -INFINITY; int bi = 1 << 20;
                if (en) {
#pragma unroll
                    for (int i = 0; i < 32; ++i) { const float v = sel[i]; const int e = g * 32 + i; const bool after = (v < pv) || (v == pv && e > pi); if (after && v > bv) { bv = v; bi = e; } }
                }
#pragma unroll
                for (int d = 1; d < 8; d <<= 1) { const float ov = __shfl_xor(bv, d); const int oi = __shfl_xor(bi, d); if (ov > bv || (ov == bv && oi < bi)) { bv = ov; bi = oi; } }
                pv = bv; pi = bi;
                if (g == k) { myv = bv; myi = bi; }
            }
            const float score = myv - a.rbias[myi];
            float gsum = score;
#pragma unroll
            for (int d = 1; d < 8; d <<= 1) gsum += __shfl_xor(gsum, d);
            const float gt = score / gsum * ROUTED_SCALE;
            a.eidx[t * TOP_K + g] = myi; a.gate[t * TOP_K + g] = gt;
            my_idx[p] = myi; my_gate[p] = gt; my_rank[p] = atomicAdd(&hist[myi], 1);
        }
        __syncthreads();
        if (tid < 256) { const int h = hist[tid]; base[tid] = h > 0 ? atomicAdd(&a.counts[tid], h) : 0; }
        __syncthreads();
#pragma unroll
        for (int p = 0; p < 2; ++p) {
            const int row = tid >> 3, g = tid & 7, t = m0 + 64 * p + row, e = my_idx[p], pos = base[e] + my_rank[p];
            a.tokl[(size_t)e * CAP + pos] = t; a.gatel[(size_t)e * CAP + pos] = my_gate[p]; a.slot[t * TOP_K + g] = e * CAP + pos;
        }
        if ((vblock() & 1) == 1) convert_moe_range(cv, lds, CV_GU, CV_GU + CV_DN);
    }
}

constexpr int LDS_ROWTAB = 128 * 1024;
constexpr int LDS_GTAB = 139 * 1024;
constexpr int LDS_TAB = 150 * 1024;
constexpr int MOE_BM = 256;
DI void build_moe_tab(const int* counts, char* lds) {
    int* tstart = (int*)(lds + LDS_TAB); int* rstart = tstart + 264; int* cnts = tstart + 528;
    const int tid = tidx(), lane = tid & 63;
    __syncthreads();
    if (tid < 64) {
        int c[4], tl[4], cs = 0, ts = 0;
#pragma unroll
        for (int i = 0; i < 4; ++i) { c[i] = counts[lane * 4 + i]; tl[i] = (c[i] + MOE_BM - 1) / MOE_BM; cs += c[i]; ts += tl[i]; }
        int ci = cs, ti = ts;
#pragma unroll
        for (int o = 1; o < 64; o <<= 1) { const int n1 = __shfl_up(ci, o), n2 = __shfl_up(ti, o); if (lane >= o) { ci += n1; ti += n2; } }
        int ce = ci - cs, te = ti - ts;
#pragma unroll
        for (int i = 0; i < 4; ++i) { rstart[lane * 4 + i] = ce; tstart[lane * 4 + i] = te; cnts[lane * 4 + i] = c[i]; ce += c[i]; te += tl[i]; }
        if (lane == 63) { rstart[256] = ce; tstart[256] = te; cnts[256] = T_TOK; rstart[257] = ce + T_TOK; tstart[257] = te + T_TOK / MOE_BM; }
    }
    __syncthreads();
}
DI int find_expert(const int* tstart, int g) {
    int lo = 0, hi = 256;
#pragma unroll 1
    while (lo < hi) { const int mid = (lo + hi + 1) >> 1; if (tstart[mid] <= g) lo = mid; else hi = mid - 1; }
    return lo;
}
struct MoeU { const char* A; const char* B; int e, m0, st, cnt, sub; };

struct P6Args { const bf16_t* x1; const int* counts; const int* tokl; const float* gatel; const bf16_t* wgut; bf16_t* H; };
struct GuSched {
    typedef MoeU U;
    const int* tstart; const int* rstart; const int* rowtab; const bf16_t* x1; const bf16_t* wgut; int first, stride, nunits;
    DI bool next(int i, U& u) const {
        const int L = first + i * stride; if (L >= nunits) return false;
        const int g = L >> 1, e = find_expert(tstart, g);
        u.sub = L & 1; u.e = i; u.m0 = (g - tstart[e]) * MOE_BM; u.st = rstart[e]; u.cnt = tstart[528 + e];
        u.A = (const char*)x1; u.B = (const char*)(wgut + ((size_t)e * 512 + 256 * u.sub) * D_MODEL); return true;
    }
    DI void a_off(int i, const U&, const int (&R)[2], const int (&C)[2], unsigned (&vo)[2][2]) const {
#pragma unroll
        for (int h = 0; h < 2; ++h)
#pragma unroll
            for (int p = 0; p < 2; ++p) vo[h][p] = (unsigned)(rowtab[i * 256 + 128 * h + R[p]] * D_MODEL + C[p]) * 2u;
    }
};
struct EpiGU { bf16_t* H; const float* gtab;
    DI void operator()(const f32x4 (&acc)[2][2][4][2], const MoeU& u, int wr, int wc, int fr, int fq) const {
#pragma unroll
        for (int ai = 0; ai < 2; ++ai)
#pragma unroll
            for (int m = 0; m < 4; ++m) {
                const int row = u.m0 + 128 * ai + 64 * wr + 16 * m + fr;
                if (row < u.cnt) {
                    const float gt = gtab[u.e * 256 + 128 * ai + 64 * wr + 16 * m + fr];
                    float h[8];
#pragma unroll
                    for (int n = 0; n < 2; ++n)
#pragma unroll
                        for (int j = 0; j < 4; ++j) { const float gv = acc[ai][0][m][n][j]; h[4 * n + j] = gv * __builtin_amdgcn_rcpf(1.f + __expf(-gv)) * acc[ai][1][m][n][j] * gt; }
                    u32x4 o; o.x = cvt_pk_bf16(h[0], h[1]); o.y = cvt_pk_bf16(h[2], h[3]); o.z = cvt_pk_bf16(h[4], h[5]); o.w = cvt_pk_bf16(h[6], h[7]);
                    *(u32x4*)(H + (size_t)(u.st + row) * D_EXP + 128 * u.sub + 32 * wc + 8 * fq) = o;
                }
            }
    } };
DI void phase_moe_gu(const P6Args& a, char* smem, LAS unsigned char* lds) {
    build_moe_tab(a.counts, smem);
    const int* tstart = (const int*)(smem + LDS_TAB); const int* rstart = tstart + 264; int* rowtab = (int*)(smem + LDS_ROWTAB); float* gtab = (float*)(smem + LDS_GTAB);
    const int nunits = tstart[257] * 2, first = vblock();
    const int n_my = first < nunits ? (nunits - first + GRID - 1) / GRID : 0;
    for (int idx = tidx(); idx < n_my * 256; idx += NTHR) {
        const int i = idx >> 8, row = idx & 255, L = first + i * GRID, g = L >> 1, e = find_expert(tstart, g), m0 = (g - tstart[e]) * MOE_BM, cnt = tstart[528 + e];
        int rr = m0 + row; rr = rr < cnt ? rr : cnt - 1;
        rowtab[idx] = e < N_EXP ? a.tokl[(size_t)e * CAP + rr] : rr;
        gtab[idx] = e < N_EXP ? a.gatel[(size_t)e * CAP + rr] : 1.f;
    }
    __syncthreads();
    GuSched S{tstart, rstart, rowtab, a.x1, a.wgut, first, GRID, nunits}; EpiGU E{a.H, gtab};
    gs::gemm_stream<true, true>(lds, D_MODEL, S, E);
}
struct P7Args { const bf16_t* H; const int* counts; const bf16_t* wdt; unsigned char* Y; };
struct DownSched {
    typedef MoeU U;
    const int* tstart; const int* rstart; const bf16_t* H; const bf16_t* wdt; int first, stride, nunits;
    DI bool next(int i, U& u) const {
        const int L = first + i * stride; if (L >= nunits) return false;
        const int g = L >> 2, e = find_expert(tstart, g);
        u.sub = L & 3; u.e = e; u.m0 = (g - tstart[e]) * MOE_BM; u.st = rstart[e]; u.cnt = tstart[528 + e];
        u.A = (const char*)(H + (size_t)(u.st + u.m0) * D_EXP); u.B = (const char*)(wdt + ((size_t)e * D_MODEL + 256 * u.sub) * D_EXP); return true;
    }
    DI void a_off(int, const U&, const int (&R)[2], const int (&C)[2], unsigned (&vo)[2][2]) const {
#pragma unroll
        for (int h = 0; h < 2; ++h)
#pragma unroll
            for (int p = 0; p < 2; ++p) vo[h][p] = (unsigned)((128 * h + R[p]) * D_EXP + C[p]) * 2u;
    }
};
struct EpiDown { unsigned char* Y;
    DI void operator()(const f32x4 (&acc)[2][2][4][2], const MoeU& u, int wr, int wc, int fr, int fq) const {
#pragma unroll
        for (int ai = 0; ai < 2; ++ai)
#pragma unroll
            for (int m = 0; m < 4; ++m) {
                const int row = u.m0 + 128 * ai + 64 * wr + 16 * m + fr;
                if (row < u.cnt) {
#pragma unroll
                    for (int bj = 0; bj < 2; ++bj) {
                        const f32x4 v0 = acc[ai][bj][m][0] * YSCALE, v1 = acc[ai][bj][m][1] * YSCALE;
                        int w0 = 0, w1 = 0;
                        w0 = __builtin_amdgcn_cvt_pk_fp8_f32(v0[0], v0[1], w0, false); w0 = __builtin_amdgcn_cvt_pk_fp8_f32(v0[2], v0[3], w0, true);
                        w1 = __builtin_amdgcn_cvt_pk_fp8_f32(v1[0], v1[1], w1, false); w1 = __builtin_amdgcn_cvt_pk_fp8_f32(v1[2], v1[3], w1, true);
                        *(u32x2*)(Y + (size_t)(u.st + row) * D_MODEL + 256 * u.sub + 128 * bj + 32 * wc + 8 * fq) = (u32x2){(unsigned)w0, (unsigned)w1};
                    }
                }
            }
    } };
DI void phase_moe_down(const P7Args& a, char* smem, LAS unsigned char* lds) {
    build_moe_tab(a.counts, smem);
    const int* tstart = (const int*)(smem + LDS_TAB); const int* rstart = tstart + 264;
    DownSched S{tstart, rstart, a.H, a.wdt, vblock(), GRID, tstart[257] * 4}; EpiDown E{a.Y};
    gs::gemm_stream<true, true>(lds, D_EXP, S, E);
}
struct P8Args { const bf16_t* x1; const unsigned char* Y; const int* slot; const int* counts; const float* ln_g; const float* ln_b; float* out; };
DI void phase_combine(const P8Args& a, char* lds) {
    const int tid = tidx(), wid = tid >> 6, lane = tid & 63;
    build_moe_tab(a.counts, lds);
    const int* rstart = (const int*)(lds + LDS_TAB) + 264;
    const int sh0 = rstart[256];
    for (int t = vblock() * 8 + wid; t < T_TOK; t += GRID * 8) {
        float v[16], w[16];
        { const u32x4 p0 = *(const u32x4*)(a.x1 + (size_t)t * D_MODEL + lane * 16), p1 = *(const u32x4*)(a.x1 + (size_t)t * D_MODEL + lane * 16 + 8); unpack16(p0, p1, v); }
        int sl = 0; if (lane < TOP_K) sl = a.slot[t * TOP_K + lane];
        u32x4 yr[9];
        yr[8] = *(const u32x4*)(a.Y + (size_t)(sh0 + t) * D_MODEL + lane * 16);
#pragma unroll
        for (int k = 0; k < TOP_K; ++k) { const int s = __shfl(sl, k), e = s / CAP, pos = s % CAP; yr[k] = *(const u32x4*)(a.Y + (size_t)(rstart[e] + pos) * D_MODEL + lane * 16); }
#pragma unroll
        for (int i = 0; i < 16; ++i) w[i] = 0.f;
#pragma unroll
        for (int k = 0; k < 9; ++k)
#pragma unroll
            for (int j = 0; j < 4; ++j) { const f32x2 lo = __builtin_amdgcn_cvt_pk_f32_fp8((int)yr[k][j], false), hi = __builtin_amdgcn_cvt_pk_f32_fp8((int)yr[k][j], true); w[4 * j] += lo.x; w[4 * j + 1] += lo.y; w[4 * j + 2] += hi.x; w[4 * j + 3] += hi.y; }
#pragma unroll
        for (int i = 0; i < 16; ++i) v[i] = v[i] * DN_ALPHA + w[i] * (1.f / YSCALE);
        float s = 0.f;
#pragma unroll
        for (int i = 0; i < 16; ++i) s += v[i];
#pragma unroll
        for (int o = 32; o >= 1; o >>= 1) s += __shfl_xor(s, o);
        const float mu = s * (1.f / 1024.f);
        float q = 0.f;
#pragma unroll
        for (int i = 0; i < 16; ++i) { const float d = v[i] - mu; q += d * d; }
#pragma unroll
        for (int o = 32; o >= 1; o >>= 1) q += __shfl_xor(q, o);
        const float rstd = rsqrtf(q * (1.f / 1024.f) + LN_EPS);
#pragma unroll
        for (int j = 0; j < 4; ++j) {
            const f32x4 g = *(const f32x4*)(a.ln_g + lane * 16 + 4 * j), bb = *(const f32x4*)(a.ln_b + lane * 16 + 4 * j);
            f32x4 o; o[0] = (v[4 * j] - mu) * rstd * g[0] + bb[0]; o[1] = (v[4 * j + 1] - mu) * rstd * g[1] + bb[1]; o[2] = (v[4 * j + 2] - mu) * rstd * g[2] + bb[2]; o[3] = (v[4 * j + 3] - mu) * rstd * g[3] + bb[3];
            *(f32x4*)(a.out + (size_t)t * D_MODEL + lane * 16 + 4 * j) = o;
        }
    }
}

#define MFMA32(a, b, c) __builtin_amdgcn_mfma_f32_32x32x16_bf16((a), (b), (c), 0, 0, 0)
constexpr float SB_EXIT_THR = 1e-30f;
struct P2Args { const bf16_t* Q; const bf16_t* Kb; const bf16_t* Vt; const float* rel_bias; const float* gain_a; const float* gain_b; bf16_t* y; };

DI bf16x8 pack8(const f32x16& x, int s) {
    u32x4 p;
    if (s == 0) { p.x = cvt_pk_bf16(x[0], x[1]); p.y = cvt_pk_bf16(x[2], x[3]); p.z = cvt_pk_bf16(x[4], x[5]); p.w = cvt_pk_bf16(x[6], x[7]); }
    else        { p.x = cvt_pk_bf16(x[8], x[9]); p.y = cvt_pk_bf16(x[10], x[11]); p.z = cvt_pk_bf16(x[12], x[13]); p.w = cvt_pk_bf16(x[14], x[15]); }
    return __builtin_bit_cast(bf16x8, p);
}
DI void load_k(bf16x8 (&k)[4], const bf16_t* kp, int k0) {
#pragma unroll
    for (int kk = 0; kk < 4; ++kk) k[kk] = *(const bf16x8*)(kp + (size_t)(k0 >> 5) * 2048 + kk * 512);
}
DI void load_v(bf16x8 (&v)[2][2], const bf16_t* vp, int k0) {
#pragma unroll
    for (int dt = 0; dt < 2; ++dt)
#pragma unroll
        for (int s = 0; s < 2; ++s) v[dt][s] = *(const bf16x8*)(vp + (size_t)(k0 >> 5) * 2048 + (dt * 2 + s) * 512);
}

constexpr int LDS_CVT = 16 * 1024;
DI void phase_attn(const P2Args& a, const P0Args& cv, char* lds) {
    const int tid = tidx(), wid = tid >> 6, lane = tid & 63, r = lane & 31, h = lane >> 5;
    float* tbl = (float*)lds;
    float* ssq = (float*)(lds + 8 * 260 * 4);
    __syncthreads();
    for (int i = tid; i < NHA * 257; i += NTHR) { const int hd = i / 257, j = i % 257; tbl[hd * 260 + j] = a.rel_bias[i] * LOG2E; }
    __syncthreads();
    const int cgrp = vblock() % 3;
#pragma unroll 1
    for (int slot = 0; slot < 5; ++slot) {
        if ((cgrp == 0 && slot == 0) || (cgrp == 1 && slot == 2) || (cgrp == 2 && slot == 4)) convert_moe_range(cv, lds + LDS_CVT, 0, CV_GU);
        if (slot == 4) break;
        const int u = vblock() + GRID * (slot >> 1) + 2 * GRID * (slot & 1);
        const bool isB = u >= BATCH * (SEQ / 64); const int uu = isB ? u - BATCH * (SEQ / 64) : u;
        const int b = uu / (SEQ / 64), c = uu % (SEQ / 64), q0 = c * 64, hh = (isB ? NHA : 0) + wid;
        const size_t hb = (size_t)(b * NHH + hh) * SEQ * 64;
        const bf16_t* kp = a.Kb + hb + lane * 8;
        const bf16_t* vp = a.Vt + hb + lane * 8;
        bf16x8 qf[2][4];
#pragma unroll
        for (int qt = 0; qt < 2; ++qt)
#pragma unroll
            for (int kk = 0; kk < 4; ++kk) qf[qt][kk] = *(const bf16x8*)(a.Q + hb + (size_t)((q0 >> 5) + qt) * 2048 + kk * 512 + lane * 8);
        f32x16 ot[2][2];
#pragma unroll
        for (int dt = 0; dt < 2; ++dt)
#pragma unroll
            for (int qt = 0; qt < 2; ++qt)
#pragma unroll
                for (int i = 0; i < 16; ++i) ot[dt][qt][i] = 0.f;
        float linv[2] = {1.f, 1.f};
        if (!isB) {
            float mrun[2] = {-INFINITY, -INFINITY}, lrun[2] = {0.f, 0.f};
            const int klo = q0 - LEFT_CHUNKS * CHUNK < 0 ? 0 : q0 - LEFT_CHUNKS * CHUNK, khi = q0 + 64;
            const float cfar = tbl[wid * 260 + 256];
            bf16x8 kc[4], kn[4], vf[2][2]; load_k(kc, kp, klo);
            for (int k0 = klo; k0 < khi; k0 += 32) {
                load_v(vf, vp, k0);
                load_k(kn, kp, k0 + 32 < khi ? k0 + 32 : k0);
#pragma unroll
                for (int qt = 0; qt < 2; ++qt) {
                    bf16x8 pf[2];
                    f32x16 st;
#pragma unroll
                    for (int i = 0; i < 16; ++i) st[i] = 0.f;
#pragma unroll
                    for (int kk = 0; kk < 4; ++kk) st = MFMA32(kc[kk], qf[qt][kk], st);
                    const int dmin = q0 + 32 * qt - k0 - 31;
                    if (dmin >= MAX_REL) {
#pragma unroll
                        for (int i = 0; i < 16; ++i) st[i] += cfar;
                    } else {
                        const int bidx = q0 + 32 * qt + r - k0 - 4 * h + MAX_REL;
#pragma unroll
                        for (int i = 0; i < 16; ++i) { int ix = bidx - ((i & 3) + 8 * (i >> 2)); ix = ix < 0 ? 0 : (ix > 2 * MAX_REL ? 2 * MAX_REL : ix); st[i] += tbl[wid * 260 + ix]; }
                    }
                    float mx = st[0];
#pragma unroll
                    for (int i = 1; i < 16; ++i) mx = fmaxf(mx, st[i]);
                    mx = fmaxf(mx, __shfl_xor(mx, 32));
                    const float mn = fmaxf(mrun[qt], mx), alpha = __builtin_amdgcn_exp2f(mrun[qt] - mn);
                    mrun[qt] = mn;
                    float ps = 0.f;
#pragma unroll
                    for (int i = 0; i < 16; ++i) { st[i] = __builtin_amdgcn_exp2f(st[i] - mn); ps += st[i]; }
                    lrun[qt] = lrun[qt] * alpha + ps;
#pragma unroll
                    for (int i = 0; i < 16; ++i) { ot[0][qt][i] *= alpha; ot[1][qt][i] *= alpha; }
                    pf[0] = pack8(st, 0); pf[1] = pack8(st, 1);
#pragma unroll
                    for (int dt = 0; dt < 2; ++dt)
#pragma unroll
                        for (int s = 0; s < 2; ++s) ot[dt][qt] = MFMA32(vf[dt][s], pf[s], ot[dt][qt]);
                }
#pragma unroll
                for (int kk = 0; kk < 4; ++kk) kc[kk] = kn[kk];
            }
#pragma unroll
            for (int qt = 0; qt < 2; ++qt) { const float lt = lrun[qt] + __shfl_xor(lrun[qt], 32); linv[qt] = 1.f / lt; }
        } else {
            float carry[2] = {1.f, 1.f};
            bf16x8 kc[4], kn[4], vf[2][2]; load_k(kc, kp, q0 + 32);
            for (int k0 = q0 + 32; k0 >= 0; k0 -= 32) {
                load_v(vf, vp, k0);
                load_k(kn, kp, k0 >= 32 ? k0 - 32 : k0);
#pragma unroll
                for (int qt = 0; qt < 2; ++qt) {
                    bf16x8 pf[2];
                    f32x16 st;
#pragma unroll
                    for (int i = 0; i < 16; ++i) st[i] = 0.f;
                    const bool none = (k0 > q0 + 32 * qt + 30);
                    if (!none) {
#pragma unroll
                        for (int kk = 0; kk < 4; ++kk) st = MFMA32(kc[kk], qf[qt][kk], st);
                        const bool full = (k0 + 31 < q0 + 32 * qt);
                        const int lim = q0 + 32 * qt + r - k0 - 4 * h;
                        float om[16];
#pragma unroll
                        for (int i = 0; i < 16; ++i) {
                            const float e = __builtin_amdgcn_exp2f(-st[i]); float bta = __builtin_amdgcn_rcpf(1.f + e);
                            if (!full && !(((i & 3) + 8 * (i >> 2)) < lim)) bta = 0.f;
                            st[i] = bta; om[i] = 1.f - bta;
                        }
                        float G[4], Go[4];
#pragma unroll
                        for (int g = 0; g < 4; ++g) { G[g] = (om[4 * g] * om[4 * g + 1]) * (om[4 * g + 2] * om[4 * g + 3]); Go[g] = __shfl_xor(G[g], 32); }
                        float R = carry[qt];
#pragma unroll
                        for (int g = 3; g >= 0; --g) {
                            float run = h == 0 ? R * Go[g] : R;
#pragma unroll
                            for (int uu2 = 3; uu2 >= 0; --uu2) { const float bta = st[4 * g + uu2]; st[4 * g + uu2] = bta * run; run *= om[4 * g + uu2]; }
                            R = R * (G[g] * Go[g]);
                        }
                        carry[qt] = R;
                    }
                    if (!none) {
                        pf[0] = pack8(st, 0); pf[1] = pack8(st, 1);
#pragma unroll
                        for (int dt = 0; dt < 2; ++dt)
#pragma unroll
                            for (int s = 0; s < 2; ++s) ot[dt][qt] = MFMA32(vf[dt][s], pf[s], ot[dt][qt]);
                    }
                }
#pragma unroll
                for (int kk = 0; kk < 4; ++kk) kc[kk] = kn[kk];
                if (__all(carry[0] < SB_EXIT_THR && carry[1] < SB_EXIT_THR)) break;
            }
        }
        float ss[2];
#pragma unroll
        for (int qt = 0; qt < 2; ++qt) {
            float s2 = 0.f;
#pragma unroll
            for (int dt = 0; dt < 2; ++dt)
#pragma unroll
                for (int i = 0; i < 16; ++i) { ot[dt][qt][i] *= linv[qt]; s2 += ot[dt][qt][i] * ot[dt][qt][i]; }
            s2 += __shfl_xor(s2, 32); ss[qt] = s2;
        }
        __syncthreads();
        if (h == 0) { ssq[wid * 64 + r] = ss[0]; ssq[wid * 64 + 32 + r] = ss[1]; }
        __syncthreads();
        const float* gain = isB ? a.gain_b : a.gain_a;
#pragma unroll
        for (int qt = 0; qt < 2; ++qt) {
            float tot = 0.f;
#pragma unroll
            for (int w8 = 0; w8 < 8; ++w8) tot += ssq[w8 * 64 + 32 * qt + r];
            const float rs = rsqrtf(tot * (1.f / 512.f) + RMS_EPS);
            bf16_t* yp = a.y + (size_t)(b * SEQ + q0 + 32 * qt + r) * D_MODEL + (isB ? 512 : 0) + wid * 64;
#pragma unroll
            for (int dt = 0; dt < 2; ++dt)
#pragma unroll
                for (int g = 0; g < 4; ++g) {
                    const int d = 32 * dt + 8 * g + 4 * h; const f32x4 gn = *(const f32x4*)(gain + wid * 64 + d);
                    u32x2 o; o.x = cvt_pk_bf16(ot[dt][qt][4 * g] * rs * gn[0], ot[dt][qt][4 * g + 1] * rs * gn[1]); o.y = cvt_pk_bf16(ot[dt][qt][4 * g + 2] * rs * gn[2], ot[dt][qt][4 * g + 3] * rs * gn[3]);
                    *(u32x2*)(yp + d) = o;
                }
        }
    }
}


#define XB_TMO      128
#define XB_XCNT(j)  (256  + 64 * (j))
#define XB_XSUB(j)  (1280 + 64 * (j))
#define XB_XGEN(j)  (2304 + 64 * (j))
#define XB_TOP      3328
#define XB_TOPGEN   3392
#define XCD_BAR_WORDS 3456
#define XB_SPIN_CAP (1u << 18)
#define LAS __attribute__((address_space(3)))

__device__ __forceinline__ unsigned xb_ld(unsigned* p)              { return __hip_atomic_load(p, __ATOMIC_RELAXED, __HIP_MEMORY_SCOPE_AGENT); }
__device__ __forceinline__ unsigned xb_add(unsigned* p, unsigned v) { return __hip_atomic_fetch_add(p, v, __ATOMIC_RELAXED, __HIP_MEMORY_SCOPE_AGENT); }
__device__ __forceinline__ unsigned xb_xcc_id() { return (unsigned)__builtin_amdgcn_s_getreg((3 << 11) | 20) & 0xFu; }
#define XB_SPIN(cond, bar) do { unsigned _sp = 0; while (cond) { __builtin_amdgcn_s_sleep(1); \
    if ((++_sp & 255u) == 0u) { if (xb_ld(&(bar)[XB_TMO])) break; if (_sp > XB_SPIN_CAP) { atomicAdd(&(bar)[XB_TMO], 1u); break; } } } } while (0)

struct XcdBarrier {
    unsigned* bar; unsigned x;
    volatile LAS unsigned* st;
};

__device__ __forceinline__ XcdBarrier xcd_barrier_post(unsigned* bar, volatile LAS unsigned* st) {
    XcdBarrier b; b.bar = bar; b.x = xb_xcc_id(); b.st = st;
    if (threadIdx.x == 0) (void)xb_add(&bar[XB_XCNT(b.x)], 1u);
    return b;
}
__device__ __forceinline__ void xcd_barrier_complete(unsigned* bar, unsigned x, unsigned& nloc, unsigned& nx) {
    const unsigned G = gridDim.x * gridDim.y * gridDim.z;
    unsigned sum, cnt, mine, sp = 0u;
    for (;;) {
        sum = 0u; cnt = 0u; mine = 0u;
#pragma unroll
        for (unsigned j = 0; j < 16; ++j) { const unsigned c = xb_ld(&bar[XB_XCNT(j)]); sum += c; cnt += (c > 0u) ? 1u : 0u; mine = (j == x) ? c : mine; }
        if (sum == G) break;
        __builtin_amdgcn_s_sleep(1);
        if ((++sp & 255u) == 0u) { if (xb_ld(&bar[XB_TMO])) break; if (sp > XB_SPIN_CAP) { atomicAdd(&bar[XB_TMO], 1u); break; } }
    }
    nloc = mine > 0u ? mine : 1u; nx = cnt > 0u ? cnt : 1u;
}

__device__ __forceinline__ void xcd_barrier(const XcdBarrier& b) {
    asm volatile("s_waitcnt vmcnt(0)" ::: "memory");
    __syncthreads();
    if (threadIdx.x == 0) {
        unsigned* bar = b.bar;
        __builtin_amdgcn_s_waitcnt(0);
        unsigned nloc = b.st[0], nx = b.st[1];
        if (nloc == 0u) { xcd_barrier_complete(bar, b.x, nloc, nx); b.st[0] = nloc; b.st[1] = nx; }
        const unsigned old = xb_add(&bar[XB_XSUB(b.x)], 1u);
        const unsigned gen = old / nloc;
        if (old + 1u == (gen + 1u) * nloc) {
            __builtin_amdgcn_fence(__ATOMIC_RELEASE, "agent");
            asm volatile("s_waitcnt vmcnt(0)" ::: "memory");
            const unsigned og = xb_add(&bar[XB_TOP], 1u);
            const unsigned tg = og / nx;
            if (og + 1u == (tg + 1u) * nx) xb_add(&bar[XB_TOPGEN], 1u);
            else XB_SPIN(xb_ld(&bar[XB_TOPGEN]) == tg, bar);
            __builtin_amdgcn_fence(__ATOMIC_ACQUIRE, "agent");
            xb_add(&bar[XB_XGEN(b.x)], 1u);
            asm volatile("s_waitcnt vmcnt(0)" ::: "memory");
        } else {
            XB_SPIN(xb_ld(&bar[XB_XGEN(b.x)]) == gen, bar);
            __builtin_amdgcn_fence(__ATOMIC_ACQUIRE, "agent");
            asm volatile("s_waitcnt vmcnt(0)" ::: "memory");
        }
    }
    __syncthreads();
}


struct MegaArgs { P0Args p0; P1Args p1; P2Args p2; P3Args p3; P4Args p4; P6Args p6; P7Args p7; P8Args p8; unsigned* bar; };
__global__ __launch_bounds__(NTHR, 2) void k_mega(MegaArgs a) {
    extern __shared__ __attribute__((aligned(16))) char smem[];
    volatile LAS unsigned* xbw = (volatile LAS unsigned*)(smem + LDS_BYTES - 16);
    if (threadIdx.x == 0) { xbw[0] = 0u; xbw[1] = 0u; xbw[2] = 0u; xbw[3] = 0u; }
    __syncthreads();
    XcdBarrier bar = xcd_barrier_post(a.bar, xbw);
    LAS unsigned char* L = (LAS unsigned char*)smem;
    phase_prologue(a.p0, smem);     xcd_barrier(bar);
    phase_qkv(a.p1, L);             xcd_barrier(bar);
    phase_attn(a.p2, a.p0, smem);   xcd_barrier(bar);
    phase_outproj(a.p3, L);         xcd_barrier(bar);
    phase_router(a.p4, a.p0, smem); xcd_barrier(bar);
    phase_moe_gu(a.p6, smem, L);    xcd_barrier(bar);
    phase_moe_down(a.p7, smem, L);  xcd_barrier(bar);
    phase_combine(a.p8, smem);
}

extern "C" void kernel_launch(void* const* d_in, const int* in_sizes, int n_in, void* d_out, int out_size, void* d_ws, size_t ws_size, hipStream_t stream) {
    const float* x = (const float*)d_in[0];      const float* w_in = (const float*)d_in[1];   const float* rel_bias = (const float*)d_in[2];
    const float* gain_a = (const float*)d_in[3]; const float* gain_b = (const float*)d_in[4]; const float* w_out = (const float*)d_in[5];
    const float* ln1_g = (const float*)d_in[6];  const float* ln1_b = (const float*)d_in[7];  const float* router_w = (const float*)d_in[8];
    const float* router_bias = (const float*)d_in[9]; const float* w_gate = (const float*)d_in[10]; const float* w_up = (const float*)d_in[11];
    const float* w_down = (const float*)d_in[12]; const float* ws_gate = (const float*)d_in[13]; const float* ws_up = (const float*)d_in[14];
    const float* ws_down = (const float*)d_in[15]; const float* ln2_g = (const float*)d_in[16]; const float* ln2_b = (const float*)d_in[17];
    char* ws = (char*)d_ws; float* out = (float*)d_out;
    int* ctrl = (int*)(ws + OFF_CTRL); int* counts = ctrl + CW_COUNTS;
    bf16_t* X1 = (bf16_t*)(ws + OFF_X1); int* tokl = (int*)(ws + OFF_TOKL); float* gatel = (float*)(ws + OFF_GATEL);
    int* eidx = (int*)(ws + OFF_EIDX); float* gate = (float*)(ws + OFF_GATE); int* slot = (int*)(ws + OFF_SLOT);
    bf16_t* H = (bf16_t*)(ws + OFF_H); unsigned char* Y = (unsigned char*)(ws + OFF_Y);
    bf16_t* Q = (bf16_t*)(ws + OFF_Q); bf16_t* Kb = (bf16_t*)(ws + OFF_K); bf16_t* Vt = (bf16_t*)(ws + OFF_VT);
    bf16_t* yatt = (bf16_t*)(ws + OFF_YATT); bf16_t* r = (bf16_t*)(ws + OFF_R);
    bf16_t* xb = (bf16_t*)(ws + OFF_XB); float* stats = (float*)(ws + OFF_STATS);
    bf16_t* wt_in = (bf16_t*)(ws + OFF_WTIN); bf16_t* wt_out = (bf16_t*)(ws + OFF_WTOUT); bf16_t* wt_r = (bf16_t*)(ws + OFF_WTR);
    bf16_t* wgut = (bf16_t*)(ws + OFF_WGUT); bf16_t* wdt = (bf16_t*)(ws + OFF_WDT);
    if (ws_size < WS_NEEDED) { fprintf(stderr, "kernel_launch: workspace too small (%zu < %zu)\n", ws_size, (size_t)WS_NEEDED); return; }
    hipMemsetAsync(ctrl, 0, 64 * 1024, stream);
    static bool attr_done = false;
    if (!attr_done) {
        hipFuncSetAttribute((const void*)k_mega, hipFuncAttributeMaxDynamicSharedMemorySize, LDS_BYTES);
        attr_done = true;
    }
    MegaArgs m{};
    m.p0 = P0Args{x, w_in, w_out, router_w, xb, wt_in, wt_out, wt_r, w_gate, w_up, w_down, ws_gate, ws_up, ws_down, wgut, wdt};
    m.p1 = P1Args{xb, wt_in, Q, Kb, Vt};
    m.p2 = P2Args{Q, Kb, Vt, rel_bias, gain_a, gain_b, yatt};
    m.p3 = P3Args{yatt, wt_out, x, r, stats};
    m.p4 = P4Args{r, stats, ln1_g, ln1_b, X1, wt_r, router_bias, eidx, gate, counts, tokl, gatel, slot};
    m.p6 = P6Args{X1, counts, tokl, gatel, wgut, H};
    m.p7 = P7Args{H, counts, wdt, Y};
    m.p8 = P8Args{X1, Y, slot, counts, ln2_g, ln2_b, out};
    m.bar = (unsigned*)ctrl;
    k_mega<<<GRID, NTHR, LDS_BYTES, stream>>>(m);
}
```

```cpp
#include <hip/hip_runtime.h>
#include <cstdint>
#include <cstdio>

typedef unsigned short bf16_t;

constexpr int D_MODEL = 1024, BATCH = 16, SEQ = 2048, T_TOK = BATCH * SEQ;
constexpr int HEAD_DIM = 64, NHA = 8, NHB = 8, NHH = 16;
constexpr int CHUNK = 64, LEFT_CHUNKS = 8, MAX_REL = 128;
constexpr int N_EXP = 256, TOP_K = 8, N_GROUPS = 8, TOPK_GROUPS = 4, EPG = 32, D_EXP = 256;
constexpr float ROUTED_SCALE = 2.5f, LN_EPS = 1e-5f, RMS_EPS = 1e-6f;
constexpr float DN_ALPHA = 1.189207115002721f;
constexpr float LOG2E = 1.4426950408889634f, LN2 = 0.6931471805599453f;
constexpr float QSCALE = 0.125f * LOG2E;
constexpr float YSCALE = 64.f;
constexpr int CAP = T_TOK;
constexpr int ROWS_ALL = T_TOK * TOP_K + T_TOK;

__device__ __forceinline__ float bf2f(bf16_t v) { return __uint_as_float(((unsigned)v) << 16); }
__device__ __forceinline__ bf16_t f2bf(float f) { unsigned u = __float_as_uint(f); u += 0x7fffu + ((u >> 16) & 1u); return (bf16_t)(u >> 16); }

constexpr size_t MB = 1024ull * 1024ull;
constexpr size_t OFF_CTRL   = 0;
constexpr size_t OFF_X1     = 1 * MB;
constexpr size_t OFF_TOKL   = OFF_X1 + 64 * MB;
constexpr size_t OFF_GATEL  = OFF_TOKL + 32 * MB;
constexpr size_t OFF_EIDX   = OFF_GATEL + 32 * MB;
constexpr size_t OFF_GATE   = OFF_EIDX + 1 * MB;
constexpr size_t OFF_SLOT   = OFF_GATE + 1 * MB;
constexpr size_t OFF_WDT    = OFF_SLOT + 1 * MB;
constexpr size_t OFF_BIG    = OFF_WDT + 129 * MB;
constexpr size_t OFF_H      = OFF_BIG;
constexpr size_t OFF_Y      = OFF_BIG + 144 * MB;
constexpr size_t OFF_Q      = OFF_BIG;
constexpr size_t OFF_K      = OFF_BIG + 64 * MB;
constexpr size_t OFF_VT     = OFF_BIG + 128 * MB;
constexpr size_t OFF_YATT   = OFF_BIG + 192 * MB;
constexpr size_t OFF_R      = OFF_BIG + 256 * MB;
constexpr size_t OFF_XB     = OFF_BIG + 320 * MB;
constexpr size_t OFF_STATS  = OFF_BIG + 384 * MB;
constexpr size_t OFF_WTIN   = OFF_BIG + 392 * MB;
constexpr size_t OFF_WTOUT  = OFF_BIG + 398 * MB;
constexpr size_t OFF_WTR    = OFF_BIG + 400 * MB;
constexpr size_t OFF_WGUT   = OFF_BIG + 401 * MB;
constexpr size_t WS_NEEDED  = OFF_BIG + 720 * MB;
static_assert(OFF_WGUT + 257 * MB <= WS_NEEDED && WS_NEEDED <= 1024 * MB, "workspace map");
constexpr int CW_COUNTS = 8192;
constexpr int CSTR = 64;

typedef short bf16x8 __attribute__((ext_vector_type(8)));
typedef float f32x4 __attribute__((ext_vector_type(4)));
typedef float f32x2 __attribute__((ext_vector_type(2)));
typedef float f32x16 __attribute__((ext_vector_type(16)));
typedef unsigned u32x4 __attribute__((ext_vector_type(4)));
typedef unsigned u32x2 __attribute__((ext_vector_type(2)));
#define DI __device__ __forceinline__
constexpr int NTHR = 512, GRID = 256;
DI int tidx() { int t = threadIdx.x; asm volatile("" : "+v"(t)); return t; }
constexpr int LDS_BYTES = 160 * 1024;

typedef __bf16 bf16x2_t __attribute__((ext_vector_type(2)));
DI unsigned cvt_pk_bf16(float lo, float hi) { f32x2 v = {lo, hi}; bf16x2_t r = __builtin_convertvector(v, bf16x2_t); return __builtin_bit_cast(unsigned, r); }
DI int vblock() { return (int)((blockIdx.x & 7) * (GRID / 8) + (blockIdx.x >> 3)); }

template <int MT> struct Tile { static constexpr int BM = 32 * MT, A_BYTES = BM * 128, B_BYTES = 256 * 128, STAGE = A_BYTES + B_BYTES; };

template <int MT> struct ALoader {
    const bf16_t* p[MT / 2]; u32x4 v[MT / 2]; int off0;
    DI void init_rows(const bf16_t* A, int lda, int row0) {
        const int tid = tidx(), kc = tid & 7, r = tid >> 3;
#pragma unroll
        for (int i = 0; i < MT / 2; ++i) p[i] = A + (size_t)(row0 + r + 64 * i) * lda + kc * 8;
        off0 = r * 128 + ((kc ^ ((r >> 1) & 7)) << 4);
    }
    DI void init_gather(const bf16_t* A, int lda, const int* rows, int cnt, int m0) {
        const int tid = tidx(), kc = tid & 7, r = tid >> 3;
#pragma unroll
        for (int i = 0; i < MT / 2; ++i) { int rr = m0 + r + 64 * i; rr = rr < cnt ? rr : cnt - 1; const int g = rows ? rows[rr] : rr; p[i] = A + (size_t)g * lda + kc * 8; }
        off0 = r * 128 + ((kc ^ ((r >> 1) & 7)) << 4);
    }
    DI void load(int k0) {
#pragma unroll
        for (int i = 0; i < MT / 2; ++i) v[i] = *(const u32x4*)(p[i] + k0);
    }
    DI void store(char* ldsA) const {
#pragma unroll
        for (int i = 0; i < MT / 2; ++i) *(u32x4*)(ldsA + off0 + i * 8192) = v[i];
    }
};
struct BLoaderBt {
    const bf16_t* p[4]; u32x4 v[4]; int off0;
    DI void init(const bf16_t* Bt, int ldk, int n0) {
        const int tid = tidx(), kc = tid & 7, r = tid >> 3;
#pragma unroll
        for (int i = 0; i < 4; ++i) p[i] = Bt + (size_t)(n0 + r + 64 * i) * ldk + kc * 8;
        off0 = r * 128 + ((kc ^ ((r >> 1) & 7)) << 4);
    }
    DI void load(int k0) {
#pragma unroll
        for (int i = 0; i < 4; ++i) v[i] = *(const u32x4*)(p[i] + k0);
    }
    DI void store(char* ldsB) const {
#pragma unroll
        for (int i = 0; i < 4; ++i) *(u32x4*)(ldsB + off0 + i * 8192) = v[i];
    }
};
template <bool GU> struct BLoaderF32 {
    const float* p[2]; int ldb; f32x2 v[2][8]; int off[2][2];
    DI void init(const float* P0, const float* P1, int ldb_) {
        const int tid = tidx(), l = tid & 63, w = tid >> 6; ldb = ldb_;
        p[0] = P0 + (size_t)(8 * w) * ldb + 2 * l; p[1] = P1 + (size_t)(8 * w) * ldb + 2 * l;
#pragma unroll
        for (int jp = 0; jp < 2; ++jp)
#pragma unroll
            for (int jj = 0; jj < 2; ++jj) { const int c = 2 * l + jj; const int row = GU ? (64 * (c >> 5) + 32 * jp + (c & 31)) : (128 * jp + c); off[jp][jj] = row * 128 + ((w ^ ((row >> 1) & 7)) << 4); }
    }
    DI void load(int k0) {
#pragma unroll
        for (int jp = 0; jp < 2; ++jp)
#pragma unroll
            for (int kk = 0; kk < 8; ++kk) v[jp][kk] = *(const f32x2*)(p[jp] + (size_t)(k0 + kk) * ldb);
    }
    DI void store(char* ldsB) const {
#pragma unroll
        for (int jp = 0; jp < 2; ++jp) {
            u32x4 a, b;
            a.x = cvt_pk_bf16(v[jp][0].x, v[jp][1].x); a.y = cvt_pk_bf16(v[jp][2].x, v[jp][3].x); a.z = cvt_pk_bf16(v[jp][4].x, v[jp][5].x); a.w = cvt_pk_bf16(v[jp][6].x, v[jp][7].x);
            b.x = cvt_pk_bf16(v[jp][0].y, v[jp][1].y); b.y = cvt_pk_bf16(v[jp][2].y, v[jp][3].y); b.z = cvt_pk_bf16(v[jp][4].y, v[jp][5].y); b.w = cvt_pk_bf16(v[jp][6].y, v[jp][7].y);
            *(u32x4*)(ldsB + off[jp][0]) = a; *(u32x4*)(ldsB + off[jp][1]) = b;
        }
    }
};

template <int MT, bool TR, class AL, class BL>
DI void gemm_tile(char* lds, AL& al, BL& bl, int nk, f32x4 (&acc)[MT][4]) {
    typedef Tile<MT> TT;
    const int tid = tidx(), wid = tid >> 6, lane = tid & 63, wr = wid >> 2, wc = wid & 3, fr = lane & 15, fq = lane >> 4;
#pragma unroll
    for (int m = 0; m < MT; ++m)
#pragma unroll
        for (int n = 0; n < 4; ++n) acc[m][n] = (f32x4){0.f, 0.f, 0.f, 0.f};
    int aoff[2], boff[2];
#pragma unroll
    for (int ks = 0; ks < 2; ++ks) { const int ch = (((4 * ks + fq) ^ (fr >> 1)) << 4); aoff[ks] = (16 * MT * wr + fr) * 128 + ch; boff[ks] = TT::A_BYTES + (64 * wc + fr) * 128 + ch; }
    al.load(0); bl.load(0);
    __syncthreads();
    al.store(lds); bl.store(lds + TT::A_BYTES);
    __syncthreads();
    for (int kt = 0; kt < nk; ++kt) {
        char* cur = lds + (kt & 1) * TT::STAGE; char* nxt = lds + ((kt & 1) ^ 1) * TT::STAGE;
        const bool more = kt + 1 < nk;
        if (more) { al.load((kt + 1) * 64); bl.load((kt + 1) * 64); }
#pragma unroll
        for (int ks = 0; ks < 2; ++ks) {
            bf16x8 a[MT], b[4];
#pragma unroll
            for (int m = 0; m < MT; ++m) a[m] = *(const bf16x8*)(cur + aoff[ks] + m * 2048);
#pragma unroll
            for (int n = 0; n < 4; ++n) b[n] = *(const bf16x8*)(cur + boff[ks] + n * 2048);
#pragma unroll
            for (int m = 0; m < MT; ++m)
#pragma unroll
                for (int n = 0; n < 4; ++n)
                    acc[m][n] = TR ? __builtin_amdgcn_mfma_f32_16x16x32_bf16(b[n], a[m], acc[m][n], 0, 0, 0) : __builtin_amdgcn_mfma_f32_16x16x32_bf16(a[m], b[n], acc[m][n], 0, 0, 0);
        }
        if (more) { al.store(nxt); bl.store(nxt + TT::A_BYTES); }
        __syncthreads();
    }
}

#define LAS __attribute__((address_space(3)))
namespace gs {
constexpr int BM = 256, BK = 64, HALF = 128, HTB = HALF * BK * 2, STAGE_BYTES = 8 * HTB;
DI int lds_byte(int r, int c) { const int st = (r >> 4) * 2 + (c >> 5), rr = r & 15, cc = c & 31, ob = rr * 64 + cc * 2; return st * 1024 + (ob ^ (((ob >> 9) & 1) << 5)); }
DI void stage_rc(int b, int& R, int& C) { const int st = b / 1024, sb = b % 1024, swz = sb ^ (((sb >> 9) & 1) << 5); R = (st >> 1) * 16 + swz / 64; C = (st & 1) * 32 + (swz % 64) / 2; }
DI int perm32(int rho) { const int n = rho >> 4, i = rho & 15; return 8 * (i >> 2) + 4 * n + (i & 3); }
template <bool TR, bool PERM, class Sched, class Epi>
DI void gemm_stream(LAS unsigned char* lds, const int K, const Sched& S, const Epi& E) {
    typedef typename Sched::U U;
    const int tid = tidx(), wid = __builtin_amdgcn_readfirstlane(tid >> 6), lane = tid & 63, wr = wid >> 2, wc = wid & 3, fr = lane & 15, fq = lane >> 4;
    const int nt = K / BK;
    int R[2], C[2]; unsigned voffB[2];
#pragma unroll
    for (int i = 0; i < 2; ++i) { stage_rc(tid * 16 + i * 8192, R[i], C[i]); const int Rb = PERM ? ((R[i] & ~31) + perm32(R[i] & 31)) : R[i]; voffB[i] = (unsigned)(Rb * K + C[i]) * 2u; }
    const size_t kstep = (size_t)(BK * 2), hstepB = (size_t)HALF * K * 2;
    const unsigned ldsw = (unsigned)wid * 1024u;
    const int aoff = lds_byte(wr * 64 + fr, fq * 8), boff = lds_byte(wc * 32 + fr, fq * 8);
#define GS_SA(b, h) (((b) * 2 + (h)) * HTB)
#define GS_SB(b, h) ((4 + (b) * 2 + (h)) * HTB)
#define GS_STAGE(bufoff, gbase, voff) do { _Pragma("unroll") for (int _i = 0; _i < 2; ++_i) \
        __builtin_amdgcn_global_load_lds((const unsigned*)((const char*)(gbase) + (voff)[_i]), (LAS unsigned*)(lds + (bufoff) + ldsw + _i * 8192), 16, 0, 0); } while (0)
#define GS_LDA(dst, b, h) do { _Pragma("unroll") for (int m = 0; m < 4; ++m) _Pragma("unroll") for (int k = 0; k < 2; ++k) dst[m][k] = *(const LAS bf16x8*)(lds + GS_SA(b, h) + aoff + m * 2048 + k * 1024); } while (0)
#define GS_LDB(dst, b, h) do { _Pragma("unroll") for (int n = 0; n < 2; ++n) _Pragma("unroll") for (int k = 0; k < 2; ++k) dst[n][k] = *(const LAS bf16x8*)(lds + GS_SB(b, h) + boff + n * 2048 + k * 1024); } while (0)
#define GS_MMA(ai, bj, At, Bt) do { __builtin_amdgcn_s_setprio(1); _Pragma("unroll") for (int m = 0; m < 4; ++m) _Pragma("unroll") for (int n = 0; n < 2; ++n) _Pragma("unroll") for (int k = 0; k < 2; ++k) \
        acc[ai][bj][m][n] = TR ? __builtin_amdgcn_mfma_f32_16x16x32_bf16(Bt[n][k], At[m][k], acc[ai][bj][m][n], 0, 0, 0) : __builtin_amdgcn_mfma_f32_16x16x32_bf16(At[m][k], Bt[n][k], acc[ai][bj][m][n], 0, 0, 0); \
        __builtin_amdgcn_s_setprio(0); } while (0)
#define GS_WAIT_V(n) asm volatile("s_waitcnt vmcnt(" #n ")" ::: "memory")
#define GS_WAIT_L(n) asm volatile("s_waitcnt lgkmcnt(" #n ")" ::: "memory")
#define GS_BAR __builtin_amdgcn_s_barrier()
#define GS_SCHED __builtin_amdgcn_sched_barrier(0)
    U cur, nxt; int ui = 0;
    if (!S.next(0, cur)) return;
    f32x4 acc[2][2][4][2];
#pragma unroll
    for (int a = 0; a < 2; ++a)
#pragma unroll
        for (int b = 0; b < 2; ++b)
#pragma unroll
            for (int m = 0; m < 4; ++m)
#pragma unroll
                for (int n = 0; n < 2; ++n) acc[a][b][m][n] = (f32x4){0.f, 0.f, 0.f, 0.f};
    bf16x8 At[4][2], B0[2][2], B1[2][2];
    unsigned cvo[2][2], nvo[2][2];
    S.a_off(0, cur, R, C, cvo);
    const char* cA = cur.A; const char* cB = cur.B;
    GS_STAGE(GS_SB(0, 0), cB, voffB); GS_STAGE(GS_SB(0, 1), cB + hstepB, voffB); GS_STAGE(GS_SA(0, 0), cA, cvo[0]); GS_STAGE(GS_SA(0, 1), cA, cvo[1]);
    if (wr == 1) GS_BAR;
    GS_WAIT_V(2); GS_BAR;
    GS_STAGE(GS_SB(1, 0), cB + kstep, voffB); GS_STAGE(GS_SA(1, 0), cA + kstep, cvo[0]); GS_STAGE(GS_SB(1, 1), cB + hstepB + kstep, voffB);
    GS_WAIT_V(6); GS_BAR;
    for (;;) {
        const bool has_next = S.next(ui + 1, nxt);
        if (has_next) S.a_off(ui + 1, nxt, R, C, nvo);
        else { nvo[0][0] = cvo[0][0]; nvo[0][1] = cvo[0][1]; nvo[1][0] = cvo[1][0]; nvo[1][1] = cvo[1][1]; }
        const char* nA = has_next ? nxt.A : cA; const char* nB = has_next ? nxt.B : cB;
#pragma unroll 1
        for (int t = 0; t < nt; t += 2) {
            const bool last = (t == nt - 2);
            const char* a1 = cA + (size_t)(t + 1) * kstep;
            const char* a2 = last ? nA : cA + (size_t)(t + 2) * kstep; const char* b2 = last ? nB : cB + (size_t)(t + 2) * kstep;
            const char* a3 = a2 + kstep; const char* b3 = b2 + kstep;
            unsigned v2[2][2];
            v2[0][0] = last ? nvo[0][0] : cvo[0][0]; v2[0][1] = last ? nvo[0][1] : cvo[0][1]; v2[1][0] = last ? nvo[1][0] : cvo[1][0]; v2[1][1] = last ? nvo[1][1] : cvo[1][1];
            GS_LDB(B0, 0, 0); GS_LDB(B1, 0, 1); GS_SCHED; GS_LDA(At, 0, 0); GS_STAGE(GS_SA(1, 1), a1, cvo[1]);
            GS_WAIT_V(8); GS_WAIT_L(0); GS_BAR; GS_MMA(0, 0, At, B0); GS_MMA(0, 1, At, B1); GS_BAR; GS_SCHED;
            GS_LDA(At, 0, 1); GS_STAGE(GS_SB(0, 0), b2, voffB); GS_STAGE(GS_SB(0, 1), b2 + hstepB, voffB); GS_STAGE(GS_SA(0, 0), a2, v2[0]);
            GS_WAIT_V(8); GS_WAIT_L(0); GS_BAR; GS_MMA(1, 0, At, B0); GS_MMA(1, 1, At, B1); GS_BAR; GS_SCHED;
            GS_LDB(B0, 1, 0); GS_LDB(B1, 1, 1); GS_SCHED; GS_LDA(At, 1, 0); GS_STAGE(GS_SA(0, 1), a2, v2[1]);
            GS_WAIT_V(8); GS_WAIT_L(0); GS_BAR; GS_MMA(0, 0, At, B0); GS_MMA(0, 1, At, B1); GS_BAR; GS_SCHED;
            GS_LDA(At, 1, 1); GS_STAGE(GS_SB(1, 0), b3, voffB); GS_STAGE(GS_SB(1, 1), b3 + hstepB, voffB); GS_STAGE(GS_SA(1, 0), a3, v2[0]);
            GS_WAIT_V(8); GS_WAIT_L(0); GS_BAR; GS_MMA(1, 0, At, B0); GS_MMA(1, 1, At, B1); GS_BAR; GS_SCHED;
        }
        if (wr == 0) GS_BAR;
        E(acc, cur, wr, wc, fr, fq);
        if (!has_next) break;
#pragma unroll
        for (int a = 0; a < 2; ++a)
#pragma unroll
            for (int b = 0; b < 2; ++b)
#pragma unroll
                for (int m = 0; m < 4; ++m)
#pragma unroll
                    for (int n = 0; n < 2; ++n) acc[a][b][m][n] = (f32x4){0.f, 0.f, 0.f, 0.f};
        cur = nxt; cA = nA; cB = nB; ++ui;
        cvo[0][0] = nvo[0][0]; cvo[0][1] = nvo[0][1]; cvo[1][0] = nvo[1][0]; cvo[1][1] = nvo[1][1];
        if (wr == 1) GS_BAR;
    }
    GS_WAIT_V(0);
    GS_BAR;
#undef GS_SA
#undef GS_SB
#undef GS_STAGE
#undef GS_LDA
#undef GS_LDB
#undef GS_MMA
#undef GS_WAIT_V
#undef GS_WAIT_L
#undef GS_BAR
#undef GS_SCHED
}
struct DenseU { const char* A; const char* B; int pm, pn; };
struct DenseSched {
    typedef DenseU U;
    const bf16_t* A; const bf16_t* Bt; int K, nunits, first, stride, npn, pn_base, pn_mod0, pn_mod1;
    DI int colmap(int q) const { return pn_base + (q / pn_mod0) * pn_mod1 + (q % pn_mod0); }
    DI bool next(int i, U& u) const {
        const int L = first + i * stride; if (L >= nunits) return false;
        u.pm = L / npn; u.pn = colmap(L % npn);
        u.A = (const char*)A + (size_t)u.pm * BM * K * 2; u.B = (const char*)Bt + (size_t)u.pn * BM * K * 2; return true;
    }
    DI void a_off(int, const U&, const int (&R)[2], const int (&C)[2], unsigned (&vo)[2][2]) const {
#pragma unroll
        for (int h = 0; h < 2; ++h)
#pragma unroll
            for (int i = 0; i < 2; ++i) vo[h][i] = (unsigned)((HALF * h + R[i]) * K + C[i]) * 2u;
    }
};
}

DI void transpose_cvt(const float* W, bf16_t* Wt, int K, int N, int unit, char* lds) {
    float* tile = (float*)lds;
    const int nbn = N / 64, kb = unit / nbn, nb = unit % nbn, tid = tidx();
    __syncthreads();
#pragma unroll
    for (int i = 0; i < 8; ++i) { const int idx = tid + i * 512, r = idx >> 6, c = idx & 63; tile[r * 65 + c] = W[(size_t)(kb * 64 + r) * N + nb * 64 + c]; }
    __syncthreads();
#pragma unroll
    for (int i = 0; i < 8; ++i) { const int idx = tid + i * 512, n = idx >> 6, k = idx & 63; Wt[(size_t)(nb * 64 + n) * K + kb * 64 + k] = f2bf(tile[k * 65 + n]); }
}
struct P0Args { const float* x; const float* w_in; const float* w_out; const float* router_w; bf16_t* xb; bf16_t* wt_in; bf16_t* wt_out; bf16_t* wt_r;
                const float* w_gate; const float* w_up; const float* w_down; const float* ws_gate; const float* ws_up; const float* ws_down; bf16_t* wgut; bf16_t* wdt; };
constexpr int CV_GU = 257 * 2 * 16, CV_DN = 257 * 16;
struct CvItem { const float* src; bf16_t* dst; int ld, ldd, rbase, rhi; };
DI CvItem cv_item(const P0Args& a, int it) {
    CvItem c;
    if (it < CV_GU) {
        const int e = it / 32, u = (it >> 4) & 1, kt = it & 15;
        const float* W = e < N_EXP ? (u ? a.w_up : a.w_gate) + (size_t)e * D_MODEL * D_EXP : (u ? a.ws_up : a.ws_gate);
        c.src = W + (size_t)kt * 64 * D_EXP; c.ld = D_EXP; c.dst = a.wgut + (size_t)e * 512 * D_MODEL + kt * 64; c.ldd = D_MODEL; c.rbase = 128 * u; c.rhi = 256;
    } else {
        const int j = it - CV_GU, e = j / 16, kt = (j >> 2) & 3, nb = j & 3;
        const float* W = e < N_EXP ? a.w_down + (size_t)e * D_EXP * D_MODEL : a.ws_down;
        c.src = W + (size_t)kt * 64 * D_MODEL + nb * 256; c.ld = D_MODEL; c.dst = a.wdt + (size_t)e * D_MODEL * D_EXP + kt * 64; c.ldd = D_EXP; c.rbase = 256 * nb; c.rhi = 128;
    }
    return c;
}
DI void cv_load(const CvItem& c, f32x4 (&v)[8]) {
    const int tid = tidx();
#pragma unroll
    for (int i = 0; i < 8; ++i) { const int idx = tid + i * 512, k = idx >> 6, n4 = idx & 63; v[i] = __builtin_nontemporal_load((const f32x4*)(c.src + (size_t)k * c.ld + 4 * n4)); }
}
DI void cv_store(const CvItem& c, const f32x4 (&v)[8], char* lds) {
    float* tile = (float*)lds;
    const int tid = tidx();
    __syncthreads();
#pragma unroll
    for (int i = 0; i < 8; ++i) { const int idx = tid + i * 512, k = idx >> 6, n4 = idx & 63; *(f32x4*)(tile + k * 260 + 4 * (n4 ^ ((k >> 3) & 7))) = v[i]; }
    __syncthreads();
#pragma unroll
    for (int i = 0; i < 4; ++i) {
        const int idx = tid + i * 512, kc = idx & 7, n = idx >> 3; const float* p = tile + (8 * kc) * 260 + (n ^ (4 * kc));
        u32x4 o; o.x = cvt_pk_bf16(p[0], p[260]); o.y = cvt_pk_bf16(p[2 * 260], p[3 * 260]); o.z = cvt_pk_bf16(p[4 * 260], p[5 * 260]); o.w = cvt_pk_bf16(p[6 * 260], p[7 * 260]);
        __builtin_nontemporal_store(o, (u32x4*)(c.dst + (size_t)(c.rbase + (n >> 7) * c.rhi + (n & 127)) * c.ldd + 8 * kc));
    }
}
DI void convert_moe_range(const P0Args& a, char* lds, const int lo, const int hi) {
    int it = lo + vblock(); if (it >= hi) return;
    CvItem c = cv_item(a, it); f32x4 v[8]; cv_load(c, v);
#pragma unroll 1
    for (;;) {
        const int nit = it + GRID; const bool more = nit < hi;
        CvItem cn = c; f32x4 w[8];
        if (more) { cn = cv_item(a, nit); cv_load(cn, w); }
        cv_store(c, v, lds);
        if (!more) break;
        it = nit; c = cn;
#pragma unroll
        for (int i = 0; i < 8; ++i) v[i] = w[i];
    }
}
DI void phase_prologue(const P0Args& a, char* lds) {
    const int vb = vblock();
    for (size_t i = (size_t)vb * NTHR + tidx(); i < (size_t)T_TOK * D_MODEL / 8; i += (size_t)GRID * NTHR) {
        const f32x4 v0 = *(const f32x4*)(a.x + i * 8), v1 = *(const f32x4*)(a.x + i * 8 + 4);
        u32x4 o; o.x = cvt_pk_bf16(v0[0], v0[1]); o.y = cvt_pk_bf16(v0[2], v0[3]); o.z = cvt_pk_bf16(v1[0], v1[1]); o.w = cvt_pk_bf16(v1[2], v1[3]);
        *(u32x4*)(a.xb + i * 8) = o;
    }
    const int n_in = (1024 / 64) * (3072 / 64), n_out = 16 * 16, n_r = 16 * 4;
    for (int u = vb; u < n_in + n_out + n_r; u += GRID) {
        if (u < n_in) transpose_cvt(a.w_in, a.wt_in, 1024, 3072, u, lds);
        else if (u < n_in + n_out) transpose_cvt(a.w_out, a.wt_out, 1024, 1024, u - n_in, lds);
        else transpose_cvt(a.router_w, a.wt_r, 1024, 256, u - n_in - n_out, lds);
    }
}


struct P1Args { const bf16_t* xb; const bf16_t* wt_in; bf16_t* Q; bf16_t* Kb; bf16_t* Vt; };
struct EpiQK { bf16_t* Q; bf16_t* Kb;
    DI void operator()(const f32x4 (&acc)[2][2][4][2], const gs::DenseU& u, int wr, int wc, int fr, int fq) const {
        const int seg = u.pn >> 1, type = seg % 3, grp = seg / 3; bf16_t* dst = type == 0 ? Q : Kb; const float sc = type == 0 ? QSCALE : 1.f;
#pragma unroll
        for (int ai = 0; ai < 2; ++ai)
#pragma unroll
            for (int m = 0; m < 4; ++m) {
                const int row = u.pm * 256 + 128 * ai + 64 * wr + 16 * m + fr, b = row / SEQ, s = row % SEQ;
#pragma unroll
                for (int bj = 0; bj < 2; ++bj) {
                    const int hh = grp * 8 + 4 * (u.pn & 1) + 2 * bj + (wc >> 1), d0 = 32 * (wc & 1) + 8 * fq;
                    const f32x4 v0 = acc[ai][bj][m][0] * sc, v1 = acc[ai][bj][m][1] * sc;
                    u32x4 o; o.x = cvt_pk_bf16(v0[0], v0[1]); o.y = cvt_pk_bf16(v0[2], v0[3]); o.z = cvt_pk_bf16(v1[0], v1[1]); o.w = cvt_pk_bf16(v1[2], v1[3]);
                    *(u32x4*)(dst + (size_t)(b * NHH + hh) * SEQ * 64 + (s >> 5) * 2048 + ((d0 >> 3) * 32 + (s & 31)) * 8) = o;
                }
            }
    } };
struct EpiV { bf16_t* Vt;
    DI void operator()(const f32x4 (&acc)[2][2][4][2], const gs::DenseU& u, int wr, int wc, int fr, int fq) const {
        const int grp = (u.pn >> 1) / 3;
#pragma unroll
        for (int ai = 0; ai < 2; ++ai)
#pragma unroll
            for (int m = 0; m < 4; ++m) {
                const int row = u.pm * 256 + 128 * ai + 64 * wr + 16 * m + 4 * fq, b = row / SEQ, s = row % SEQ;
#pragma unroll
                for (int bj = 0; bj < 2; ++bj)
#pragma unroll
                    for (int n = 0; n < 2; ++n) {
                        const int hh = grp * 8 + 4 * (u.pn & 1) + 2 * bj + (wc >> 1), d = 32 * (wc & 1) + 16 * n + fr;
                        const f32x4 v = acc[ai][bj][m][n];
                        u32x2 o; o.x = cvt_pk_bf16(v[0], v[1]); o.y = cvt_pk_bf16(v[2], v[3]);
                        { const int kap = s & 31; *(u32x2*)(Vt + (size_t)(b * NHH + hh) * SEQ * 64 + (s >> 5) * 2048 + ((((d >> 5) * 2 + (kap >> 4)) * 2 + ((kap >> 2) & 1)) * 32 + (d & 31)) * 8 + ((kap >> 3) & 1) * 4) = o; }
                    }
            }
    } };
DI void phase_qkv(const P1Args& a, LAS unsigned char* lds) {
    { gs::DenseSched S{a.xb, a.wt_in, D_MODEL, (T_TOK / 256) * 8, vblock(), GRID, 8, 0, 4, 6}; EpiQK E{a.Q, a.Kb}; gs::gemm_stream<true, true>(lds, D_MODEL, S, E); }
    { gs::DenseSched S{a.xb, a.wt_in, D_MODEL, (T_TOK / 256) * 4, vblock(), GRID, 4, 4, 2, 6}; EpiV E{a.Vt}; gs::gemm_stream<false, false>(lds, D_MODEL, S, E); }
}

struct P3Args { const bf16_t* y; const bf16_t* wt_out; const bf16_t* xb; bf16_t* r; float* stats; };
struct EpiOut { const bf16_t* xb; bf16_t* r; float* stats;
    DI void operator()(const f32x4 (&acc)[2][2][4][2], const gs::DenseU& u, int wr, int wc, int fr, int fq) const {
#pragma unroll
        for (int ai = 0; ai < 2; ++ai)
#pragma unroll
            for (int m = 0; m < 4; ++m) {
                const int row = u.pm * 256 + 128 * ai + 64 * wr + 16 * m + fr;
#pragma unroll
                for (int bj = 0; bj < 2; ++bj) {
                    const int col = u.pn * 256 + 128 * bj + 32 * wc + 8 * fq;
                    const u32x4 xw = *(const u32x4*)(xb + (size_t)row * D_MODEL + col);
                    const f32x4 x0 = (f32x4){__uint_as_float(xw[0] << 16), __uint_as_float(xw[0] & 0xffff0000u), __uint_as_float(xw[1] << 16), __uint_as_float(xw[1] & 0xffff0000u)};
                    const f32x4 x1 = (f32x4){__uint_as_float(xw[2] << 16), __uint_as_float(xw[2] & 0xffff0000u), __uint_as_float(xw[3] << 16), __uint_as_float(xw[3] & 0xffff0000u)};
                    const f32x4 v0 = x0 * DN_ALPHA + acc[ai][bj][m][0], v1 = x1 * DN_ALPHA + acc[ai][bj][m][1];
                    float s = ((v0[0] + v0[1]) + (v0[2] + v0[3])) + ((v1[0] + v1[1]) + (v1[2] + v1[3]));
                    float q = ((v0[0] * v0[0] + v0[1] * v0[1]) + (v0[2] * v0[2] + v0[3] * v0[3])) + ((v1[0] * v1[0] + v1[1] * v1[1]) + (v1[2] * v1[2] + v1[3] * v1[3]));
                    u32x4 o; o.x = cvt_pk_bf16(v0[0], v0[1]); o.y = cvt_pk_bf16(v0[2], v0[3]); o.z = cvt_pk_bf16(v1[0], v1[1]); o.w = cvt_pk_bf16(v1[2], v1[3]);
                    *(u32x4*)(r + (size_t)row * D_MODEL + col) = o;
                    s += __shfl_xor(s, 16); s += __shfl_xor(s, 32); q += __shfl_xor(q, 16); q += __shfl_xor(q, 32);
                    if (fq == 0) *(f32x2*)(stats + ((size_t)row * 32 + u.pn * 8 + bj * 4 + wc) * 2) = (f32x2){s, q};
                }
            }
    } };
DI void phase_outproj(const P3Args& a, LAS unsigned char* lds) {
    gs::DenseSched S{a.y, a.wt_out, D_MODEL, (T_TOK / 256) * 4, vblock(), GRID, 4, 0, 4, 0}; EpiOut E{a.xb, a.r, a.stats}; gs::gemm_stream<true, true>(lds, D_MODEL, S, E);
}

DI void unpack16(const u32x4& a, const u32x4& b, float (&v)[16]) {
#pragma unroll
    for (int j = 0; j < 4; ++j) { v[2 * j] = __uint_as_float(a[j] << 16); v[2 * j + 1] = __uint_as_float(a[j] & 0xffff0000u); v[8 + 2 * j] = __uint_as_float(b[j] << 16); v[8 + 2 * j + 1] = __uint_as_float(b[j] & 0xffff0000u); }
}
constexpr int RS_SC = 289;
constexpr int LDS_HIST = 100 * 1024;
struct P4Args { const bf16_t* r; const float* stats; const float* ln_g; const float* ln_b; bf16_t* x1; const bf16_t* wt_r; const float* rbias;
                int* eidx; float* gate; int* counts; int* tokl; float* gatel; int* slot; };
DI void phase_router(const P4Args& a, const P0Args& cv, char* lds) {
    const int tid = tidx(), wid = tid >> 6, lane = tid & 63, wr = wid >> 2, wc = wid & 3, fr = lane & 15, fq = lane >> 4;
    float* sc = (float*)lds; int* hist = (int*)(lds + LDS_HIST); int* base = hist + 256;
    for (int u = vblock(); u < T_TOK / 128; u += GRID) {
        const int m0 = u * 128;
        if ((vblock() & 1) == 0) convert_moe_range(cv, lds, CV_GU, CV_GU + CV_DN);
        __syncthreads();
#pragma unroll 1
        for (int i0 = 0; i0 < 16; i0 += 4) {
            f32x2 st[4]; u32x4 r0[4], r1[4];
#pragma unroll
            for (int j4 = 0; j4 < 4; ++j4) {
                const int t = m0 + wid * 16 + i0 + j4;
                st[j4] = (f32x2){0.f, 0.f};
                if (lane < 32) st[j4] = *(const f32x2*)(a.stats + ((size_t)t * 32 + lane) * 2);
                r0[j4] = *(const u32x4*)(a.r + (size_t)t * D_MODEL + lane * 16); r1[j4] = *(const u32x4*)(a.r + (size_t)t * D_MODEL + lane * 16 + 8);
            }
#pragma unroll
            for (int j4 = 0; j4 < 4; ++j4) {
                const int t = m0 + wid * 16 + i0 + j4;
                float s = st[j4].x, q = st[j4].y;
#pragma unroll
                for (int o = 1; o <= 16; o <<= 1) { s += __shfl_xor(s, o); q += __shfl_xor(q, o); }
                s = __shfl(s, 0); q = __shfl(q, 0);
                const float mu = s * (1.f / 1024.f), rstd = rsqrtf(q * (1.f / 1024.f) - mu * mu + LN_EPS);
                float v[16]; unpack16(r0[j4], r1[j4], v);
                u32x4 o0, o1;
#pragma unroll
                for (int j = 0; j < 4; ++j) {
                    const f32x4 g = *(const f32x4*)(a.ln_g + lane * 16 + 4 * j), bb = *(const f32x4*)(a.ln_b + lane * 16 + 4 * j);
                    const float y0 = (v[4 * j] - mu) * rstd * g[0] + bb[0], y1 = (v[4 * j + 1] - mu) * rstd * g[1] + bb[1], y2 = (v[4 * j + 2] - mu) * rstd * g[2] + bb[2], y3 = (v[4 * j + 3] - mu) * rstd * g[3] + bb[3];
                    const unsigned p0 = cvt_pk_bf16(y0, y1), p1 = cvt_pk_bf16(y2, y3);
                    if (j < 2) { o0[2 * j] = p0; o0[2 * j + 1] = p1; } else { o1[2 * (j - 2)] = p0; o1[2 * (j - 2) + 1] = p1; }
                }
                *(u32x4*)(a.x1 + (size_t)t * D_MODEL + lane * 16) = o0; *(u32x4*)(a.x1 + (size_t)t * D_MODEL + lane * 16 + 8) = o1;
            }
        }
        if (tid < 256) hist[tid] = 0;
        asm volatile("s_waitcnt vmcnt(0)" ::: "memory");
        __syncthreads();
        ALoader<4> al; al.init_rows(a.x1, D_MODEL, m0);
        BLoaderBt bl; bl.init(a.wt_r, D_MODEL, 0);
        f32x4 acc[4][4];
        gemm_tile<4, true>(lds, al, bl, D_MODEL / 64, acc);
        int my_idx[2], my_rank[2]; float my_gate[2];
#pragma unroll
        for (int p = 0; p < 2; ++p) {
            __syncthreads();
            if (wr == p) {
#pragma unroll
                for (int m = 0; m < 4; ++m)
#pragma unroll
                    for (int n = 0; n < 4; ++n) {
                        const int c0 = 64 * wc + 16 * n + 4 * fq; const f32x4 rb = *(const f32x4*)(a.rbias + c0);
#pragma unroll
                        for (int j = 0; j < 4; ++j) { const int c = c0 + j; sc[(16 * m + fr) * RS_SC + (c >> 5) * 36 + (c & 31)] = 1.f / (1.f + __expf(-acc[m][n][j])) + rb[j]; }
                    }
            }
            __syncthreads();
            const int row = tid >> 3, g = tid & 7, t = m0 + 64 * p + row;
            float sel[32];
#pragma unroll
            for (int i = 0; i < 32; ++i) sel[i] = sc[row * RS_SC + g * 36 + i];
            float m1 = -INFINITY, m2 = -INFINITY;
#pragma unroll
            for (int i = 0; i < 32; ++i) { const float v = sel[i]; m2 = fmaxf(m2, fminf(m1, v)); m1 = fmaxf(m1, v); }
            const float gs = m1 + m2; int rank = 0;
#pragma unroll
            for (int d = 1; d < 8; ++d) { const float o = __shfl_xor(gs, d); const int og = g ^ d; rank += (o > gs || (o == gs && og < g)) ? 1 : 0; }
            const bool en = rank < TOPK_GROUPS;
            float lv = -INFINITY; int li = 1 << 20;
            if (en) {
#pragma unroll
                for (int i = 0; i < 32; ++i) { const float v = sel[i]; if (v > lv) { lv = v; li = g * 32 + i; } }
            }
            float myv = 0.f; int myi = 0;
#pragma unroll
            for (int k = 0; k < TOP_K; ++k) {
                float bv = lv; int bi = li;
#pragma unroll
                for (int d = 1; d < 8; d <<= 1) { const float ov = __shfl_xor(bv, d); const int oi = __shfl_xor(bi, d); if (ov > bv || (ov == bv && oi < bi)) { bv = ov; bi = oi; } }
                if (g == k) { myv = bv; myi = bi; }
                if (k + 1 < TOP_K && (bi >> 5) == g) {
                    lv = -INFINITY; li = 1 << 20;
#pragma unroll
                    for (int i = 0; i < 32; ++i) { if (g * 32 + i == bi) sel[i] = -INFINITY; const float v = sel[i]; if (v > lv) { lv = v; li = g * 32 + i; } }
                }
            }
            const float score = myv - a.rbias[myi];
            float gsum = score;
#pragma unroll
            for (int d = 1; d < 8; d <<= 1) gsum += __shfl_xor(gsum, d);
            const float gt = score / gsum * ROUTED_SCALE;
            a.eidx[t * TOP_K + g] = myi; a.gate[t * TOP_K + g] = gt;
            my_idx[p] = myi; my_gate[p] = gt; my_rank[p] = atomicAdd(&hist[myi], 1);
        }
        __syncthreads();
        if (tid < 256) { const int h = hist[tid]; base[tid] = h > 0 ? atomicAdd(&a.counts[tid * CSTR], h) : 0; }
        __syncthreads();
#pragma unroll
        for (int p = 0; p < 2; ++p) {
            const int row = tid >> 3, g = tid & 7, t = m0 + 64 * p + row, e = my_idx[p], pos = base[e] + my_rank[p];
            a.tokl[(size_t)e * CAP + pos] = t; a.gatel[(size_t)e * CAP + pos] = my_gate[p]; a.slot[t * TOP_K + g] = e * CAP + pos;
        }
        if ((vblock() & 1) == 1) convert_moe_range(cv, lds, CV_GU, CV_GU + CV_DN);
    }
}

constexpr int LDS_ROWTAB = 128 * 1024;
constexpr int LDS_GTAB = 139 * 1024;
constexpr int LDS_TAB = 150 * 1024;
constexpr int MOE_BM = 256;
DI void build_moe_tab(const int* counts, char* lds) {
    int* tstart = (int*)(lds + LDS_TAB); int* rstart = tstart + 264; int* cnts = tstart + 528;
    const int tid = tidx(), lane = tid & 63;
    __syncthreads();
    if (tid < 64) {
        int c[4], tl[4], cs = 0, ts = 0;
#pragma unroll
        for (int i = 0; i < 4; ++i) { c[i] = counts[(lane * 4 + i) * CSTR]; tl[i] = (c[i] + MOE_BM - 1) / MOE_BM; cs += c[i]; ts += tl[i]; }
        int ci = cs, ti = ts;
#pragma unroll
        for (int o = 1; o < 64; o <<= 1) { const int n1 = __shfl_up(ci, o), n2 = __shfl_up(ti, o); if (lane >= o) { ci += n1; ti += n2; } }
        int ce = ci - cs, te = ti - ts;
#pragma unroll
        for (int i = 0; i < 4; ++i) { rstart[lane * 4 + i] = ce; tstart[lane * 4 + i] = te; cnts[lane * 4 + i] = c[i]; ce += c[i]; te += tl[i]; }
        if (lane == 63) { rstart[256] = ce; tstart[256] = te; cnts[256] = T_TOK; rstart[257] = ce + T_TOK; tstart[257] = te + T_TOK / MOE_BM; }
    }
    __syncthreads();
}
DI int find_expert(const int* tstart, int g) {
    int lo = 0, hi = 256;
#pragma unroll 1
    while (lo < hi) { const int mid = (lo + hi + 1) >> 1; if (tstart[mid] <= g) lo = mid; else hi = mid - 1; }
    return lo;
}
struct MoeU { const char* A; const char* B; int e, m0, st, cnt, sub; };

struct P6Args { const bf16_t* x1; const int* counts; const int* tokl; const float* gatel; const bf16_t* wgut; bf16_t* H; };
struct GuSched {
    typedef MoeU U;
    const int* tstart; const int* rstart; const int* rowtab; const bf16_t* x1; const bf16_t* wgut; int first, stride, nunits;
    DI bool next(int i, U& u) const {
        const int L = first + i * stride; if (L >= nunits) return false;
        const int g = L >> 1, e = find_expert(tstart, g);
        u.sub = L & 1; u.e = i; u.m0 = (g - tstart[e]) * MOE_BM; u.st = rstart[e]; u.cnt = tstart[528 + e];
        u.A = (const char*)x1; u.B = (const char*)(wgut + ((size_t)e * 512 + 256 * u.sub) * D_MODEL); return true;
    }
    DI void a_off(int i, const U&, const int (&R)[2], const int (&C)[2], unsigned (&vo)[2][2]) const {
#pragma unroll
        for (int h = 0; h < 2; ++h)
#pragma unroll
            for (int p = 0; p < 2; ++p) vo[h][p] = (unsigned)(rowtab[i * 256 + 128 * h + R[p]] * D_MODEL + C[p]) * 2u;
    }
};
struct EpiGU { bf16_t* H; const float* gtab;
    DI void operator()(const f32x4 (&acc)[2][2][4][2], const MoeU& u, int wr, int wc, int fr, int fq) const {
#pragma unroll
        for (int ai = 0; ai < 2; ++ai)
#pragma unroll
            for (int m = 0; m < 4; ++m) {
                const int row = u.m0 + 128 * ai + 64 * wr + 16 * m + fr;
                if (row < u.cnt) {
                    const float gt = gtab[u.e * 256 + 128 * ai + 64 * wr + 16 * m + fr];
                    float h[8];
#pragma unroll
                    for (int n = 0; n < 2; ++n)
#pragma unroll
                        for (int j = 0; j < 4; ++j) { const float gv = acc[ai][0][m][n][j]; h[4 * n + j] = gv * __builtin_amdgcn_rcpf(1.f + __expf(-gv)) * acc[ai][1][m][n][j] * gt; }
                    u32x4 o; o.x = cvt_pk_bf16(h[0], h[1]); o.y = cvt_pk_bf16(h[2], h[3]); o.z = cvt_pk_bf16(h[4], h[5]); o.w = cvt_pk_bf16(h[6], h[7]);
                    *(u32x4*)(H + (size_t)(u.st + row) * D_EXP + 128 * u.sub + 32 * wc + 8 * fq) = o;
                }
            }
    } };
DI void phase_moe_gu(const P6Args& a, char* smem, LAS unsigned char* lds) {
    build_moe_tab(a.counts, smem);
    const int* tstart = (const int*)(smem + LDS_TAB); const int* rstart = tstart + 264; int* rowtab = (int*)(smem + LDS_ROWTAB); float* gtab = (float*)(smem + LDS_GTAB);
    const int nunits = tstart[257] * 2, first = vblock();
    const int n_my = first < nunits ? (nunits - first + GRID - 1) / GRID : 0;
    for (int idx = tidx(); idx < n_my * 256; idx += NTHR) {
        const int i = idx >> 8, row = idx & 255, L = first + i * GRID, g = L >> 1, e = find_expert(tstart, g), m0 = (g - tstart[e]) * MOE_BM, cnt = tstart[528 + e];
        int rr = m0 + row; rr = rr < cnt ? rr : cnt - 1;
        rowtab[idx] = e < N_EXP ? a.tokl[(size_t)e * CAP + rr] : rr;
        gtab[idx] = e < N_EXP ? a.gatel[(size_t)e * CAP + rr] : 1.f;
    }
    __syncthreads();
    GuSched S{tstart, rstart, rowtab, a.x1, a.wgut, first, GRID, nunits}; EpiGU E{a.H, gtab};
    gs::gemm_stream<true, true>(lds, D_MODEL, S, E);
}
struct P7Args { const bf16_t* H; const int* counts; const bf16_t* wdt; unsigned char* Y; };
struct DownSched {
    typedef MoeU U;
    const int* tstart; const int* rstart; const bf16_t* H; const bf16_t* wdt; int first, stride, nunits;
    DI bool next(int i, U& u) const {
        const int L = first + i * stride; if (L >= nunits) return false;
        const int g = L >> 2, e = find_expert(tstart, g);
        u.sub = L & 3; u.e = e; u.m0 = (g - tstart[e]) * MOE_BM; u.st = rstart[e]; u.cnt = tstart[528 + e];
        u.A = (const char*)(H + (size_t)(u.st + u.m0) * D_EXP); u.B = (const char*)(wdt + ((size_t)e * D_MODEL + 256 * u.sub) * D_EXP); return true;
    }
    DI void a_off(int, const U&, const int (&R)[2], const int (&C)[2], unsigned (&vo)[2][2]) const {
#pragma unroll
        for (int h = 0; h < 2; ++h)
#pragma unroll
            for (int p = 0; p < 2; ++p) vo[h][p] = (unsigned)((128 * h + R[p]) * D_EXP + C[p]) * 2u;
    }
};
struct EpiDown { unsigned char* Y;
    DI void operator()(const f32x4 (&acc)[2][2][4][2], const MoeU& u, int wr, int wc, int fr, int fq) const {
#pragma unroll
        for (int ai = 0; ai < 2; ++ai)
#pragma unroll
            for (int m = 0; m < 4; ++m) {
                const int row = u.m0 + 128 * ai + 64 * wr + 16 * m + fr;
                if (row < u.cnt) {
#pragma unroll
                    for (int bj = 0; bj < 2; ++bj) {
                        const f32x4 v0 = acc[ai][bj][m][0] * YSCALE, v1 = acc[ai][bj][m][1] * YSCALE;
                        int w0 = 0, w1 = 0;
                        w0 = __builtin_amdgcn_cvt_pk_fp8_f32(v0[0], v0[1], w0, false); w0 = __builtin_amdgcn_cvt_pk_fp8_f32(v0[2], v0[3], w0, true);
                        w1 = __builtin_amdgcn_cvt_pk_fp8_f32(v1[0], v1[1], w1, false); w1 = __builtin_amdgcn_cvt_pk_fp8_f32(v1[2], v1[3], w1, true);
                        *(u32x2*)(Y + (size_t)(u.st + row) * D_MODEL + 256 * u.sub + 128 * bj + 32 * wc + 8 * fq) = (u32x2){(unsigned)w0, (unsigned)w1};
                    }
                }
            }
    } };
DI void phase_moe_down(const P7Args& a, char* smem, LAS unsigned char* lds) {
    build_moe_tab(a.counts, smem);
    const int* tstart = (const int*)(smem + LDS_TAB); const int* rstart = tstart + 264;
    DownSched S{tstart, rstart, a.H, a.wdt, vblock(), GRID, tstart[257] * 4}; EpiDown E{a.Y};
    gs::gemm_stream<true, true>(lds, D_EXP, S, E);
}
struct P8Args { const bf16_t* x1; const unsigned char* Y; const int* slot; const int* counts; const float* ln_g; const float* ln_b; float* out; };
DI void phase_combine(const P8Args& a, char* lds) {
    const int tid = tidx(), wid = tid >> 6, lane = tid & 63;
    build_moe_tab(a.counts, lds);
    const int* rstart = (const int*)(lds + LDS_TAB) + 264;
    const int sh0 = rstart[256];
    for (int t = vblock() * 8 + wid; t < T_TOK; t += GRID * 8) {
        float v[16], w[16];
        { const u32x4 p0 = *(const u32x4*)(a.x1 + (size_t)t * D_MODEL + lane * 16), p1 = *(const u32x4*)(a.x1 + (size_t)t * D_MODEL + lane * 16 + 8); unpack16(p0, p1, v); }
        int sl = 0; if (lane < TOP_K) sl = a.slot[t * TOP_K + lane];
        u32x4 yr[9];
        yr[8] = *(const u32x4*)(a.Y + (size_t)(sh0 + t) * D_MODEL + lane * 16);
#pragma unroll
        for (int k = 0; k < TOP_K; ++k) { const int s = __shfl(sl, k), e = s / CAP, pos = s % CAP; yr[k] = *(const u32x4*)(a.Y + (size_t)(rstart[e] + pos) * D_MODEL + lane * 16); }
#pragma unroll
        for (int i = 0; i < 16; ++i) w[i] = 0.f;
#pragma unroll
        for (int k = 0; k < 9; ++k)
#pragma unroll
            for (int j = 0; j < 4; ++j) { const f32x2 lo = __builtin_amdgcn_cvt_pk_f32_fp8((int)yr[k][j], false), hi = __builtin_amdgcn_cvt_pk_f32_fp8((int)yr[k][j], true); w[4 * j] += lo.x; w[4 * j + 1] += lo.y; w[4 * j + 2] += hi.x; w[4 * j + 3] += hi.y; }
#pragma unroll
        for (int i = 0; i < 16; ++i) v[i] = v[i] * DN_ALPHA + w[i] * (1.f / YSCALE);
        float s = 0.f;
#pragma unroll
        for (int i = 0; i < 16; ++i) s += v[i];
#pragma unroll
        for (int o = 32; o >= 1; o >>= 1) s += __shfl_xor(s, o);
        const float mu = s * (1.f / 1024.f);
        float q = 0.f;
#pragma unroll
        for (int i = 0; i < 16; ++i) { const float d = v[i] - mu; q += d * d; }
#pragma unroll
        for (int o = 32; o >= 1; o >>= 1) q += __shfl_xor(q, o);
        const float rstd = rsqrtf(q * (1.f / 1024.f) + LN_EPS);
#pragma unroll
        for (int j = 0; j < 4; ++j) {
            const f32x4 g = *(const f32x4*)(a.ln_g + lane * 16 + 4 * j), bb = *(const f32x4*)(a.ln_b + lane * 16 + 4 * j);
            f32x4 o; o[0] = (v[4 * j] - mu) * rstd * g[0] + bb[0]; o[1] = (v[4 * j + 1] - mu) * rstd * g[1] + bb[1]; o[2] = (v[4 * j + 2] - mu) * rstd * g[2] + bb[2]; o[3] = (v[4 * j + 3] - mu) * rstd * g[3] + bb[3];
            *(f32x4*)(a.out + (size_t)t * D_MODEL + lane * 16 + 4 * j) = o;
        }
    }
}

#define MFMA32(a, b, c) __builtin_amdgcn_mfma_f32_32x32x16_bf16((a), (b), (c), 0, 0, 0)
constexpr float SB_EXIT_THR = 1e-30f;
struct P2Args { const bf16_t* Q; const bf16_t* Kb; const bf16_t* Vt; const float* rel_bias; const float* gain_a; const float* gain_b; bf16_t* y; };

DI bf16x8 pack8(const f32x16& x, int s) {
    u32x4 p;
    if (s == 0) { p.x = cvt_pk_bf16(x[0], x[1]); p.y = cvt_pk_bf16(x[2], x[3]); p.z = cvt_pk_bf16(x[4], x[5]); p.w = cvt_pk_bf16(x[6], x[7]); }
    else        { p.x = cvt_pk_bf16(x[8], x[9]); p.y = cvt_pk_bf16(x[10], x[11]); p.z = cvt_pk_bf16(x[12], x[13]); p.w = cvt_pk_bf16(x[14], x[15]); }
    return __builtin_bit_cast(bf16x8, p);
}
DI void load_k(bf16x8 (&k)[4], const bf16_t* kp, int k0) {
#pragma unroll
    for (int kk = 0; kk < 4; ++kk) k[kk] = *(const bf16x8*)(kp + (size_t)(k0 >> 5) * 2048 + kk * 512);
}
DI void load_v(bf16x8 (&v)[2][2], const bf16_t* vp, int k0) {
#pragma unroll
    for (int dt = 0; dt < 2; ++dt)
#pragma unroll
        for (int s = 0; s < 2; ++s) v[dt][s] = *(const bf16x8*)(vp + (size_t)(k0 >> 5) * 2048 + (dt * 2 + s) * 512);
}

constexpr int LDS_CVT = 16 * 1024;
DI void phase_attn(const P2Args& a, const P0Args& cv, char* lds) {
    const int tid = tidx(), wid = tid >> 6, lane = tid & 63, r = lane & 31, h = lane >> 5;
    float* tbl = (float*)lds;
    float* ssq = (float*)(lds + 8 * 260 * 4);
    __syncthreads();
    for (int i = tid; i < NHA * 257; i += NTHR) { const int hd = i / 257, j = i % 257; tbl[hd * 260 + j] = a.rel_bias[i] * LOG2E; }
    __syncthreads();
    const int cgrp = vblock() % 3;
#pragma unroll 1
    for (int slot = 0; slot < 5; ++slot) {
        if ((cgrp == 0 && slot == 0) || (cgrp == 1 && slot == 2) || (cgrp == 2 && slot == 4)) convert_moe_range(cv, lds + LDS_CVT, 0, CV_GU);
        if (slot == 4) break;
        const int u = vblock() + GRID * (slot >> 1) + 2 * GRID * (slot & 1);
        const bool isB = u >= BATCH * (SEQ / 64); const int uu = isB ? u - BATCH * (SEQ / 64) : u;
        const int b = uu / (SEQ / 64), c = uu % (SEQ / 64), q0 = c * 64, hh = (isB ? NHA : 0) + wid;
        const size_t hb = (size_t)(b * NHH + hh) * SEQ * 64;
        const bf16_t* kp = a.Kb + hb + lane * 8;
        const bf16_t* vp = a.Vt + hb + lane * 8;
        bf16x8 qf[2][4];
#pragma unroll
        for (int qt = 0; qt < 2; ++qt)
#pragma unroll
            for (int kk = 0; kk < 4; ++kk) qf[qt][kk] = *(const bf16x8*)(a.Q + hb + (size_t)((q0 >> 5) + qt) * 2048 + kk * 512 + lane * 8);
        f32x16 ot[2][2];
#pragma unroll
        for (int dt = 0; dt < 2; ++dt)
#pragma unroll
            for (int qt = 0; qt < 2; ++qt)
#pragma unroll
                for (int i = 0; i < 16; ++i) ot[dt][qt][i] = 0.f;
        float linv[2] = {1.f, 1.f};
        if (!isB) {
            float mrun[2] = {-INFINITY, -INFINITY}, lrun[2] = {0.f, 0.f};
            const int klo = q0 - LEFT_CHUNKS * CHUNK < 0 ? 0 : q0 - LEFT_CHUNKS * CHUNK, khi = q0 + 64;
            const float cfar = tbl[wid * 260 + 256];
            bf16x8 kc[4], kn[4], vf[2][2]; load_k(kc, kp, klo);
            for (int k0 = klo; k0 < khi; k0 += 32) {
                load_v(vf, vp, k0);
                load_k(kn, kp, k0 + 32 < khi ? k0 + 32 : k0);
#pragma unroll
                for (int qt = 0; qt < 2; ++qt) {
                    bf16x8 pf[2];
                    f32x16 st;
#pragma unroll
                    for (int i = 0; i < 16; ++i) st[i] = 0.f;
#pragma unroll
                    for (int kk = 0; kk < 4; ++kk) st = MFMA32(kc[kk], qf[qt][kk], st);
                    const int dmin = q0 + 32 * qt - k0 - 31;
                    if (dmin >= MAX_REL) {
#pragma unroll
                        for (int i = 0; i < 16; ++i) st[i] += cfar;
                    } else {
                        const int bidx = q0 + 32 * qt + r - k0 - 4 * h + MAX_REL;
#pragma unroll
                        for (int i = 0; i < 16; ++i) { int ix = bidx - ((i & 3) + 8 * (i >> 2)); ix = ix < 0 ? 0 : (ix > 2 * MAX_REL ? 2 * MAX_REL : ix); st[i] += tbl[wid * 260 + ix]; }
                    }
                    float mx = st[0];
#pragma unroll
                    for (int i = 1; i < 16; ++i) mx = fmaxf(mx, st[i]);
                    mx = fmaxf(mx, __shfl_xor(mx, 32));
                    const float mn = fmaxf(mrun[qt], mx), alpha = __builtin_amdgcn_exp2f(mrun[qt] - mn);
                    mrun[qt] = mn;
                    float ps = 0.f;
#pragma unroll
                    for (int i = 0; i < 16; ++i) { st[i] = __builtin_amdgcn_exp2f(st[i] - mn); ps += st[i]; }
                    lrun[qt] = lrun[qt] * alpha + ps;
#pragma unroll
                    for (int i = 0; i < 16; ++i) { ot[0][qt][i] *= alpha; ot[1][qt][i] *= alpha; }
                    pf[0] = pack8(st, 0); pf[1] = pack8(st, 1);
#pragma unroll
                    for (int dt = 0; dt < 2; ++dt)
#pragma unroll
                        for (int s = 0; s < 2; ++s) ot[dt][qt] = MFMA32(vf[dt][s], pf[s], ot[dt][qt]);
                }
#pragma unroll
                for (int kk = 0; kk < 4; ++kk) kc[kk] = kn[kk];
            }
#pragma unroll
            for (int qt = 0; qt < 2; ++qt) { const float lt = lrun[qt] + __shfl_xor(lrun[qt], 32); linv[qt] = 1.f / lt; }
        } else {
            float carry[2] = {1.f, 1.f};
            bf16x8 kc[4], kn[4], vf[2][2]; load_k(kc, kp, q0 + 32);
            for (int k0 = q0 + 32; k0 >= 0; k0 -= 32) {
                load_v(vf, vp, k0);
                load_k(kn, kp, k0 >= 32 ? k0 - 32 : k0);
#pragma unroll
                for (int qt = 0; qt < 2; ++qt) {
                    bf16x8 pf[2];
                    f32x16 st;
#pragma unroll
                    for (int i = 0; i < 16; ++i) st[i] = 0.f;
                    const bool none = (k0 > q0 + 32 * qt + 30);
                    if (!none) {
#pragma unroll
                        for (int kk = 0; kk < 4; ++kk) st = MFMA32(kc[kk], qf[qt][kk], st);
                        const bool full = (k0 + 31 < q0 + 32 * qt);
                        const int lim = q0 + 32 * qt + r - k0 - 4 * h;
                        float om[16];
#pragma unroll
                        for (int i = 0; i < 16; ++i) {
                            const float e = __builtin_amdgcn_exp2f(-st[i]); float bta = __builtin_amdgcn_rcpf(1.f + e);
                            if (!full && !(((i & 3) + 8 * (i >> 2)) < lim)) bta = 0.f;
                            st[i] = bta; om[i] = 1.f - bta;
                        }
                        float G[4], Go[4];
#pragma unroll
                        for (int g = 0; g < 4; ++g) { G[g] = (om[4 * g] * om[4 * g + 1]) * (om[4 * g + 2] * om[4 * g + 3]); Go[g] = __shfl_xor(G[g], 32); }
                        float R = carry[qt];
#pragma unroll
                        for (int g = 3; g >= 0; --g) {
                            float run = h == 0 ? R * Go[g] : R;
#pragma unroll
                            for (int uu2 = 3; uu2 >= 0; --uu2) { const float bta = st[4 * g + uu2]; st[4 * g + uu2] = bta * run; run *= om[4 * g + uu2]; }
                            R = R * (G[g] * Go[g]);
                        }
                        carry[qt] = R;
                    }
                    if (!none) {
                        pf[0] = pack8(st, 0); pf[1] = pack8(st, 1);
#pragma unroll
                        for (int dt = 0; dt < 2; ++dt)
#pragma unroll
                            for (int s = 0; s < 2; ++s) ot[dt][qt] = MFMA32(vf[dt][s], pf[s], ot[dt][qt]);
                    }
                }
#pragma unroll
                for (int kk = 0; kk < 4; ++kk) kc[kk] = kn[kk];
                if (__all(carry[0] < SB_EXIT_THR && carry[1] < SB_EXIT_THR)) break;
            }
        }
        float ss[2];
#pragma unroll
        for (int qt = 0; qt < 2; ++qt) {
            float s2 = 0.f;
#pragma unroll
            for (int dt = 0; dt < 2; ++dt)
#pragma unroll
                for (int i = 0; i < 16; ++i) { ot[dt][qt][i] *= linv[qt]; s2 += ot[dt][qt][i] * ot[dt][qt][i]; }
            s2 += __shfl_xor(s2, 32); ss[qt] = s2;
        }
        __syncthreads();
        if (h == 0) { ssq[wid * 64 + r] = ss[0]; ssq[wid * 64 + 32 + r] = ss[1]; }
        __syncthreads();
        const float* gain = isB ? a.gain_b : a.gain_a;
#pragma unroll
        for (int qt = 0; qt < 2; ++qt) {
            float tot = 0.f;
#pragma unroll
            for (int w8 = 0; w8 < 8; ++w8) tot += ssq[w8 * 64 + 32 * qt + r];
            const float rs = rsqrtf(tot * (1.f / 512.f) + RMS_EPS);
            bf16_t* yp = a.y + (size_t)(b * SEQ + q0 + 32 * qt + r) * D_MODEL + (isB ? 512 : 0) + wid * 64;
#pragma unroll
            for (int dt = 0; dt < 2; ++dt)
#pragma unroll
                for (int g = 0; g < 4; ++g) {
                    const int d = 32 * dt + 8 * g + 4 * h; const f32x4 gn = *(const f32x4*)(gain + wid * 64 + d);
                    u32x2 o; o.x = cvt_pk_bf16(ot[dt][qt][4 * g] * rs * gn[0], ot[dt][qt][4 * g + 1] * rs * gn[1]); o.y = cvt_pk_bf16(ot[dt][qt][4 * g + 2] * rs * gn[2], ot[dt][qt][4 * g + 3] * rs * gn[3]);
                    *(u32x2*)(yp + d) = o;
                }
        }
    }
}


#define XB_TMO      128
#define XB_XCNT(j)  (256  + 64 * (j))
#define XB_XSUB(j)  (1280 + 64 * (j))
#define XB_XGEN(j)  (2304 + 64 * (j))
#define XB_TOP      3328
#define XB_TOPGEN   3392
#define XCD_BAR_WORDS 3456
#define XB_SPIN_CAP (1u << 18)
#define LAS __attribute__((address_space(3)))

__device__ __forceinline__ unsigned xb_ld(unsigned* p)              { return __hip_atomic_load(p, __ATOMIC_RELAXED, __HIP_MEMORY_SCOPE_AGENT); }
__device__ __forceinline__ unsigned xb_add(unsigned* p, unsigned v) { return __hip_atomic_fetch_add(p, v, __ATOMIC_RELAXED, __HIP_MEMORY_SCOPE_AGENT); }
__device__ __forceinline__ unsigned xb_xcc_id() { return (unsigned)__builtin_amdgcn_s_getreg((3 << 11) | 20) & 0xFu; }
#define XB_SPIN(cond, bar) do { unsigned _sp = 0; while (cond) { __builtin_amdgcn_s_sleep(1); \
    if ((++_sp & 255u) == 0u) { if (xb_ld(&(bar)[XB_TMO])) break; if (_sp > XB_SPIN_CAP) { atomicAdd(&(bar)[XB_TMO], 1u); break; } } } } while (0)

struct XcdBarrier {
    unsigned* bar; unsigned x;
    volatile LAS unsigned* st;
};

__device__ __forceinline__ XcdBarrier xcd_barrier_post(unsigned* bar, volatile LAS unsigned* st) {
    XcdBarrier b; b.bar = bar; b.x = xb_xcc_id(); b.st = st;
    if (threadIdx.x == 0) (void)xb_add(&bar[XB_XCNT(b.x)], 1u);
    return b;
}
__device__ __forceinline__ void xcd_barrier_complete(unsigned* bar, unsigned x, unsigned& nloc, unsigned& nx) {
    const unsigned G = gridDim.x * gridDim.y * gridDim.z;
    unsigned sum, cnt, mine, sp = 0u;
    for (;;) {
        sum = 0u; cnt = 0u; mine = 0u;
#pragma unroll
        for (unsigned j = 0; j < 16; ++j) { const unsigned c = xb_ld(&bar[XB_XCNT(j)]); sum += c; cnt += (c > 0u) ? 1u : 0u; mine = (j == x) ? c : mine; }
        if (sum == G) break;
        __builtin_amdgcn_s_sleep(1);
        if ((++sp & 255u) == 0u) { if (xb_ld(&bar[XB_TMO])) break; if (sp > XB_SPIN_CAP) { atomicAdd(&bar[XB_TMO], 1u); break; } }
    }
    nloc = mine > 0u ? mine : 1u; nx = cnt > 0u ? cnt : 1u;
}

__device__ __forceinline__ void xcd_barrier(const XcdBarrier& b) {
    asm volatile("s_waitcnt vmcnt(0)" ::: "memory");
    __syncthreads();
    if (threadIdx.x == 0) {
        unsigned* bar = b.bar;
        __builtin_amdgcn_s_waitcnt(0);
        unsigned nloc = b.st[0], nx = b.st[1];
        if (nloc == 0u) { xcd_barrier_complete(bar, b.x, nloc, nx); b.st[0] = nloc; b.st[1] = nx; }
        const unsigned old = xb_add(&bar[XB_XSUB(b.x)], 1u);
        const unsigned gen = old / nloc;
        if (old + 1u == (gen + 1u) * nloc) {
            __builtin_amdgcn_fence(__ATOMIC_RELEASE, "agent");
            asm volatile("s_waitcnt vmcnt(0)" ::: "memory");
            const unsigned og = xb_add(&bar[XB_TOP], 1u);
            const unsigned tg = og / nx;
            if (og + 1u == (tg + 1u) * nx) xb_add(&bar[XB_TOPGEN], 1u);
            else XB_SPIN(xb_ld(&bar[XB_TOPGEN]) == tg, bar);
            __builtin_amdgcn_fence(__ATOMIC_ACQUIRE, "agent");
            xb_add(&bar[XB_XGEN(b.x)], 1u);
            asm volatile("s_waitcnt vmcnt(0)" ::: "memory");
        } else {
            XB_SPIN(xb_ld(&bar[XB_XGEN(b.x)]) == gen, bar);
            __builtin_amdgcn_fence(__ATOMIC_ACQUIRE, "agent");
            asm volatile("s_waitcnt vmcnt(0)" ::: "memory");
        }
    }
    __syncthreads();
}


struct MegaArgs { P0Args p0; P1Args p1; P2Args p2; P3Args p3; P4Args p4; P6Args p6; P7Args p7; P8Args p8; unsigned* bar; };
__global__ __launch_bounds__(NTHR, 2) void k_mega(MegaArgs a) {
    extern __shared__ __attribute__((aligned(16))) char smem[];
    volatile LAS unsigned* xbw = (volatile LAS unsigned*)(smem + LDS_BYTES - 16);
    if (threadIdx.x == 0) { xbw[0] = 0u; xbw[1] = 0u; xbw[2] = 0u; xbw[3] = 0u; }
    __syncthreads();
    XcdBarrier bar = xcd_barrier_post(a.bar, xbw);
    LAS unsigned char* L = (LAS unsigned char*)smem;
    phase_prologue(a.p0, smem);     xcd_barrier(bar);
    phase_qkv(a.p1, L);             xcd_barrier(bar);
    phase_attn(a.p2, a.p0, smem);   xcd_barrier(bar);
    phase_outproj(a.p3, L);         xcd_barrier(bar);
    phase_router(a.p4, a.p0, smem); xcd_barrier(bar);
    phase_moe_gu(a.p6, smem, L);    xcd_barrier(bar);
    phase_moe_down(a.p7, smem, L);  xcd_barrier(bar);
    phase_combine(a.p8, smem);
}

extern "C" void kernel_launch(void* const* d_in, const int* in_sizes, int n_in, void* d_out, int out_size, void* d_ws, size_t ws_size, hipStream_t stream) {
    const float* x = (const float*)d_in[0];      const float* w_in = (const float*)d_in[1];   const float* rel_bias = (const float*)d_in[2];
    const float* gain_a = (const float*)d_in[3]; const float* gain_b = (const float*)d_in[4]; const float* w_out = (const float*)d_in[5];
    const float* ln1_g = (const float*)d_in[6];  const float* ln1_b = (const float*)d_in[7];  const float* router_w = (const float*)d_in[8];
    const float* router_bias = (const float*)d_in[9]; const float* w_gate = (const float*)d_in[10]; const float* w_up = (const float*)d_in[11];
    const float* w_down = (const float*)d_in[12]; const float* ws_gate = (const float*)d_in[13]; const float* ws_up = (const float*)d_in[14];
    const float* ws_down = (const float*)d_in[15]; const float* ln2_g = (const float*)d_in[16]; const float* ln2_b = (const float*)d_in[17];
    char* ws = (char*)d_ws; float* out = (float*)d_out;
    int* ctrl = (int*)(ws + OFF_CTRL); int* counts = ctrl + CW_COUNTS;
    bf16_t* X1 = (bf16_t*)(ws + OFF_X1); int* tokl = (int*)(ws + OFF_TOKL); float* gatel = (float*)(ws + OFF_GATEL);
    int* eidx = (int*)(ws + OFF_EIDX); float* gate = (float*)(ws + OFF_GATE); int* slot = (int*)(ws + OFF_SLOT);
    bf16_t* H = (bf16_t*)(ws + OFF_H); unsigned char* Y = (unsigned char*)(ws + OFF_Y);
    bf16_t* Q = (bf16_t*)(ws + OFF_Q); bf16_t* Kb = (bf16_t*)(ws + OFF_K); bf16_t* Vt = (bf16_t*)(ws + OFF_VT);
    bf16_t* yatt = (bf16_t*)(ws + OFF_YATT); bf16_t* r = (bf16_t*)(ws + OFF_R);
    bf16_t* xb = (bf16_t*)(ws + OFF_XB); float* stats = (float*)(ws + OFF_STATS);
    bf16_t* wt_in = (bf16_t*)(ws + OFF_WTIN); bf16_t* wt_out = (bf16_t*)(ws + OFF_WTOUT); bf16_t* wt_r = (bf16_t*)(ws + OFF_WTR);
    bf16_t* wgut = (bf16_t*)(ws + OFF_WGUT); bf16_t* wdt = (bf16_t*)(ws + OFF_WDT);
    if (ws_size < WS_NEEDED) { fprintf(stderr, "kernel_launch: workspace too small (%zu < %zu)\n", ws_size, (size_t)WS_NEEDED); return; }
    hipMemsetAsync(ctrl, 0, 128 * 1024, stream);
    static bool attr_done = false;
    if (!attr_done) {
        hipFuncSetAttribute((const void*)k_mega, hipFuncAttributeMaxDynamicSharedMemorySize, LDS_BYTES);
        attr_done = true;
    }
    MegaArgs m{};
    m.p0 = P0Args{x, w_in, w_out, router_w, xb, wt_in, wt_out, wt_r, w_gate, w_up, w_down, ws_gate, ws_up, ws_down, wgut, wdt};
    m.p1 = P1Args{xb, wt_in, Q, Kb, Vt};
    m.p2 = P2Args{Q, Kb, Vt, rel_bias, gain_a, gain_b, yatt};
    m.p3 = P3Args{yatt, wt_out, xb, r, stats};
    m.p4 = P4Args{r, stats, ln1_g, ln1_b, X1, wt_r, router_bias, eidx, gate, counts, tokl, gatel, slot};
    m.p6 = P6Args{X1, counts, tokl, gatel, wgut, H};
    m.p7 = P7Args{H, counts, wdt, Y};
    m.p8 = P8Args{X1, Y, slot, counts, ln2_g, ln2_b, out};
    m.bar = (unsigned*)ctrl;
    k_mega<<<GRID, NTHR, LDS_BYTES, stream>>>(m);
}
```

```cpp
#include <hip/hip_runtime.h>
#include <cstdint>
#include <cstdio>

typedef unsigned short bf16_t;

constexpr int D_MODEL = 1024, BATCH = 16, SEQ = 2048, T_TOK = BATCH * SEQ;
constexpr int HEAD_DIM = 64, NHA = 8, NHB = 8, NHH = 16;
constexpr int CHUNK = 64, LEFT_CHUNKS = 8, MAX_REL = 128;
constexpr int N_EXP = 256, TOP_K = 8, N_GROUPS = 8, TOPK_GROUPS = 4, EPG = 32, D_EXP = 256;
constexpr float ROUTED_SCALE = 2.5f, LN_EPS = 1e-5f, RMS_EPS = 1e-6f;
constexpr float DN_ALPHA = 1.189207115002721f;
constexpr float LOG2E = 1.4426950408889634f, LN2 = 0.6931471805599453f;
constexpr float QSCALE = 0.125f * LOG2E;
constexpr float WSCALE = 64.f, XSCALE = 16.f, HSCALE = 16.f;
constexpr float YSCALE = 64.f;
constexpr int CAP = T_TOK;
constexpr int ROWS_ALL = T_TOK * TOP_K + T_TOK;

__device__ __forceinline__ float bf2f(bf16_t v) { return __uint_as_float(((unsigned)v) << 16); }
__device__ __forceinline__ bf16_t f2bf(float f) { unsigned u = __float_as_uint(f); u += 0x7fffu + ((u >> 16) & 1u); return (bf16_t)(u >> 16); }

constexpr size_t MB = 1024ull * 1024ull;
constexpr size_t OFF_CTRL   = 0;
constexpr size_t OFF_X1     = 1 * MB;
constexpr size_t OFF_TOKL   = OFF_X1 + 64 * MB;
constexpr size_t OFF_GATEL  = OFF_TOKL + 32 * MB;
constexpr size_t OFF_EIDX   = OFF_GATEL + 32 * MB;
constexpr size_t OFF_GATE   = OFF_EIDX + 1 * MB;
constexpr size_t OFF_SLOT   = OFF_GATE + 1 * MB;
constexpr size_t OFF_WDT    = OFF_SLOT + 1 * MB;
constexpr size_t OFF_X1F8   = OFF_WDT + 72 * MB;
constexpr size_t OFF_BIG    = OFF_WDT + 129 * MB;
constexpr size_t OFF_H      = OFF_BIG;
constexpr size_t OFF_Y      = OFF_BIG + 144 * MB;
constexpr size_t OFF_Q      = OFF_BIG;
constexpr size_t OFF_K      = OFF_BIG + 64 * MB;
constexpr size_t OFF_VT     = OFF_BIG + 128 * MB;
constexpr size_t OFF_YATT   = OFF_BIG + 192 * MB;
constexpr size_t OFF_R      = OFF_BIG + 256 * MB;
constexpr size_t OFF_XB     = OFF_BIG + 320 * MB;
constexpr size_t OFF_STATS  = OFF_BIG + 384 * MB;
constexpr size_t OFF_WTIN   = OFF_BIG + 392 * MB;
constexpr size_t OFF_WTOUT  = OFF_BIG + 398 * MB;
constexpr size_t OFF_WTR    = OFF_BIG + 400 * MB;
constexpr size_t OFF_WGUT   = OFF_BIG + 401 * MB;
constexpr size_t WS_NEEDED  = OFF_BIG + 720 * MB;
static_assert(OFF_WGUT + 257 * MB <= WS_NEEDED && WS_NEEDED <= 1024 * MB, "workspace map");
constexpr int CW_COUNTS = 8192;
constexpr int CSTR = 64;

typedef short bf16x8 __attribute__((ext_vector_type(8)));
typedef float f32x4 __attribute__((ext_vector_type(4)));
typedef float f32x2 __attribute__((ext_vector_type(2)));
typedef float f32x16 __attribute__((ext_vector_type(16)));
typedef unsigned u32x4 __attribute__((ext_vector_type(4)));
typedef unsigned u32x2 __attribute__((ext_vector_type(2)));
#define DI __device__ __forceinline__
constexpr int NTHR = 512, GRID = 256;
DI int tidx() { int t = threadIdx.x; asm volatile("" : "+v"(t)); return t; }
constexpr int LDS_BYTES = 160 * 1024;

typedef __bf16 bf16x2_t __attribute__((ext_vector_type(2)));
DI unsigned cvt_pk_bf16(float lo, float hi) { f32x2 v = {lo, hi}; bf16x2_t r = __builtin_convertvector(v, bf16x2_t); return __builtin_bit_cast(unsigned, r); }
DI float clamp8(float v) { return __builtin_amdgcn_fmed3f(v, -440.f, 440.f); }
DI unsigned pack_fp8x4(float a, float b, float c, float d) { int w = 0; w = __builtin_amdgcn_cvt_pk_fp8_f32(clamp8(a), clamp8(b), w, false); w = __builtin_amdgcn_cvt_pk_fp8_f32(clamp8(c), clamp8(d), w, true); return (unsigned)w; }
DI int vblock() { return (int)((blockIdx.x & 7) * (GRID / 8) + (blockIdx.x >> 3)); }

template <int MT> struct Tile { static constexpr int BM = 32 * MT, A_BYTES = BM * 128, B_BYTES = 256 * 128, STAGE = A_BYTES + B_BYTES; };

template <int MT> struct ALoader {
    const bf16_t* p[MT / 2]; u32x4 v[MT / 2]; int off0;
    DI void init_rows(const bf16_t* A, int lda, int row0) {
        const int tid = tidx(), kc = tid & 7, r = tid >> 3;
#pragma unroll
        for (int i = 0; i < MT / 2; ++i) p[i] = A + (size_t)(row0 + r + 64 * i) * lda + kc * 8;
        off0 = r * 128 + ((kc ^ ((r >> 1) & 7)) << 4);
    }
    DI void init_gather(const bf16_t* A, int lda, const int* rows, int cnt, int m0) {
        const int tid = tidx(), kc = tid & 7, r = tid >> 3;
#pragma unroll
        for (int i = 0; i < MT / 2; ++i) { int rr = m0 + r + 64 * i; rr = rr < cnt ? rr : cnt - 1; const int g = rows ? rows[rr] : rr; p[i] = A + (size_t)g * lda + kc * 8; }
        off0 = r * 128 + ((kc ^ ((r >> 1) & 7)) << 4);
    }
    DI void load(int k0) {
#pragma unroll
        for (int i = 0; i < MT / 2; ++i) v[i] = *(const u32x4*)(p[i] + k0);
    }
    DI void store(char* ldsA) const {
#pragma unroll
        for (int i = 0; i < MT / 2; ++i) *(u32x4*)(ldsA + off0 + i * 8192) = v[i];
    }
};
struct BLoaderBt {
    const bf16_t* p[4]; u32x4 v[4]; int off0;
    DI void init(const bf16_t* Bt, int ldk, int n0) {
        const int tid = tidx(), kc = tid & 7, r = tid >> 3;
#pragma unroll
        for (int i = 0; i < 4; ++i) p[i] = Bt + (size_t)(n0 + r + 64 * i) * ldk + kc * 8;
        off0 = r * 128 + ((kc ^ ((r >> 1) & 7)) << 4);
    }
    DI void load(int k0) {
#pragma unroll
        for (int i = 0; i < 4; ++i) v[i] = *(const u32x4*)(p[i] + k0);
    }
    DI void store(char* ldsB) const {
#pragma unroll
        for (int i = 0; i < 4; ++i) *(u32x4*)(ldsB + off0 + i * 8192) = v[i];
    }
};
template <bool GU> struct BLoaderF32 {
    const float* p[2]; int ldb; f32x2 v[2][8]; int off[2][2];
    DI void init(const float* P0, const float* P1, int ldb_) {
        const int tid = tidx(), l = tid & 63, w = tid >> 6; ldb = ldb_;
        p[0] = P0 + (size_t)(8 * w) * ldb + 2 * l; p[1] = P1 + (size_t)(8 * w) * ldb + 2 * l;
#pragma unroll
        for (int jp = 0; jp < 2; ++jp)
#pragma unroll
            for (int jj = 0; jj < 2; ++jj) { const int c = 2 * l + jj; const int row = GU ? (64 * (c >> 5) + 32 * jp + (c & 31)) : (128 * jp + c); off[jp][jj] = row * 128 + ((w ^ ((row >> 1) & 7)) << 4); }
    }
    DI void load(int k0) {
#pragma unroll
        for (int jp = 0; jp < 2; ++jp)
#pragma unroll
            for (int kk = 0; kk < 8; ++kk) v[jp][kk] = *(const f32x2*)(p[jp] + (size_t)(k0 + kk) * ldb);
    }
    DI void store(char* ldsB) const {
#pragma unroll
        for (int jp = 0; jp < 2; ++jp) {
            u32x4 a, b;
            a.x = cvt_pk_bf16(v[jp][0].x, v[jp][1].x); a.y = cvt_pk_bf16(v[jp][2].x, v[jp][3].x); a.z = cvt_pk_bf16(v[jp][4].x, v[jp][5].x); a.w = cvt_pk_bf16(v[jp][6].x, v[jp][7].x);
            b.x = cvt_pk_bf16(v[jp][0].y, v[jp][1].y); b.y = cvt_pk_bf16(v[jp][2].y, v[jp][3].y); b.z = cvt_pk_bf16(v[jp][4].y, v[jp][5].y); b.w = cvt_pk_bf16(v[jp][6].y, v[jp][7].y);
            *(u32x4*)(ldsB + off[jp][0]) = a; *(u32x4*)(ldsB + off[jp][1]) = b;
        }
    }
};

template <int MT, bool TR, class AL, class BL>
DI void gemm_tile(char* lds, AL& al, BL& bl, int nk, f32x4 (&acc)[MT][4]) {
    typedef Tile<MT> TT;
    const int tid = tidx(), wid = tid >> 6, lane = tid & 63, wr = wid >> 2, wc = wid & 3, fr = lane & 15, fq = lane >> 4;
#pragma unroll
    for (int m = 0; m < MT; ++m)
#pragma unroll
        for (int n = 0; n < 4; ++n) acc[m][n] = (f32x4){0.f, 0.f, 0.f, 0.f};
    int aoff[2], boff[2];
#pragma unroll
    for (int ks = 0; ks < 2; ++ks) { const int ch = (((4 * ks + fq) ^ (fr >> 1)) << 4); aoff[ks] = (16 * MT * wr + fr) * 128 + ch; boff[ks] = TT::A_BYTES + (64 * wc + fr) * 128 + ch; }
    al.load(0); bl.load(0);
    __syncthreads();
    al.store(lds); bl.store(lds + TT::A_BYTES);
    __syncthreads();
    for (int kt = 0; kt < nk; ++kt) {
        char* cur = lds + (kt & 1) * TT::STAGE; char* nxt = lds + ((kt & 1) ^ 1) * TT::STAGE;
        const bool more = kt + 1 < nk;
        if (more) { al.load((kt + 1) * 64); bl.load((kt + 1) * 64); }
#pragma unroll
        for (int ks = 0; ks < 2; ++ks) {
            bf16x8 a[MT], b[4];
#pragma unroll
            for (int m = 0; m < MT; ++m) a[m] = *(const bf16x8*)(cur + aoff[ks] + m * 2048);
#pragma unroll
            for (int n = 0; n < 4; ++n) b[n] = *(const bf16x8*)(cur + boff[ks] + n * 2048);
#pragma unroll
            for (int m = 0; m < MT; ++m)
#pragma unroll
                for (int n = 0; n < 4; ++n)
                    acc[m][n] = TR ? __builtin_amdgcn_mfma_f32_16x16x32_bf16(b[n], a[m], acc[m][n], 0, 0, 0) : __builtin_amdgcn_mfma_f32_16x16x32_bf16(a[m], b[n], acc[m][n], 0, 0, 0);
        }
        if (more) { al.store(nxt); bl.store(nxt + TT::A_BYTES); }
        __syncthreads();
    }
}

#define LAS __attribute__((address_space(3)))
namespace gs {
constexpr int BM = 256, BK = 64, HALF = 128, HTB = HALF * BK * 2, STAGE_BYTES = 8 * HTB;
DI int lds_byte(int r, int c) { const int st = (r >> 4) * 2 + (c >> 5), rr = r & 15, cc = c & 31, ob = rr * 64 + cc * 2; return st * 1024 + (ob ^ (((ob >> 9) & 1) << 5)); }
DI void stage_rc(int b, int& R, int& C) { const int st = b / 1024, sb = b % 1024, swz = sb ^ (((sb >> 9) & 1) << 5); R = (st >> 1) * 16 + swz / 64; C = (st & 1) * 32 + (swz % 64) / 2; }
DI int perm32(int rho) { const int n = rho >> 4, i = rho & 15; return 8 * (i >> 2) + 4 * n + (i & 3); }
typedef long i64x2 __attribute__((ext_vector_type(2)));
DI const char* uni(const char* p) { const unsigned long long v = (unsigned long long)p; const unsigned lo = __builtin_amdgcn_readfirstlane((unsigned)v), hi = __builtin_amdgcn_readfirstlane((unsigned)(v >> 32)); return (const char*)(((unsigned long long)hi << 32) | lo); }
template <bool TR, bool F8>
DI f32x4 mma16(const bf16x8& a, const bf16x8& b, f32x4 c) {
    if (F8) {
        const i64x2 a2 = __builtin_bit_cast(i64x2, a), b2 = __builtin_bit_cast(i64x2, b);
        c = TR ? __builtin_amdgcn_mfma_f32_16x16x32_fp8_fp8(b2[0], a2[0], c, 0, 0, 0) : __builtin_amdgcn_mfma_f32_16x16x32_fp8_fp8(a2[0], b2[0], c, 0, 0, 0);
        return TR ? __builtin_amdgcn_mfma_f32_16x16x32_fp8_fp8(b2[1], a2[1], c, 0, 0, 0) : __builtin_amdgcn_mfma_f32_16x16x32_fp8_fp8(a2[1], b2[1], c, 0, 0, 0);
    }
    return TR ? __builtin_amdgcn_mfma_f32_16x16x32_bf16(b, a, c, 0, 0, 0) : __builtin_amdgcn_mfma_f32_16x16x32_bf16(a, b, c, 0, 0, 0);
}
template <bool TR, bool PERM, bool F8, class Sched, class Epi>
DI void gemm_stream(LAS unsigned char* lds, const int K, const Sched& S, const Epi& E) {
    typedef typename Sched::U U;
    const int tid = tidx(), wid = __builtin_amdgcn_readfirstlane(tid >> 6), lane = tid & 63, wr = wid >> 2, wc = wid & 3, fr = lane & 15, fq = lane >> 4;
    const int nt = K / BK;
    int R[2], C[2]; unsigned voffB[2];
#pragma unroll
    for (int i = 0; i < 2; ++i) { stage_rc(tid * 16 + i * 8192, R[i], C[i]); const int Rb = PERM ? ((R[i] & ~31) + perm32(R[i] & 31)) : R[i]; voffB[i] = (unsigned)(Rb * K + C[i]) * 2u; }
    const size_t kstep = (size_t)(BK * 2), hstepB = (size_t)HALF * K * 2;
    const unsigned ldsw = (unsigned)wid * 1024u;
    const int aoff = lds_byte(wr * 64 + fr, fq * 8), boff = lds_byte(wc * 32 + fr, fq * 8);
#define GS_SA(b, h) (((b) * 2 + (h)) * HTB)
#define GS_SB(b, h) ((4 + (b) * 2 + (h)) * HTB)
#define GS_STAGE(bufoff, gbase, voff) do { _Pragma("unroll") for (int _i = 0; _i < 2; ++_i) \
        __builtin_amdgcn_global_load_lds((const unsigned*)((const char*)(gbase) + (voff)[_i]), (LAS unsigned*)(lds + (bufoff) + ldsw + _i * 8192), 16, 0, 0); } while (0)
#define GS_STAGEB(bufoff, gbase, voff) do { _Pragma("unroll") for (int _i = 0; _i < 2; ++_i) \
        __builtin_amdgcn_global_load_lds((const unsigned*)((const char*)(gbase) + (voff)[_i]), (LAS unsigned*)(lds + (bufoff) + ldsw + _i * 8192), 16, 0, 0); } while (0)
#define GS_LDA(dst, b, h) do { _Pragma("unroll") for (int m = 0; m < 4; ++m) _Pragma("unroll") for (int k = 0; k < 2; ++k) dst[m][k] = *(const LAS bf16x8*)(lds + GS_SA(b, h) + aoff + m * 2048 + k * 1024); } while (0)
#define GS_LDB(dst, b, h) do { _Pragma("unroll") for (int n = 0; n < 2; ++n) _Pragma("unroll") for (int k = 0; k < 2; ++k) dst[n][k] = *(const LAS bf16x8*)(lds + GS_SB(b, h) + boff + n * 2048 + k * 1024); } while (0)
#define GS_MMA(ai, bj, At, Bt) do { __builtin_amdgcn_s_setprio(1); _Pragma("unroll") for (int m = 0; m < 4; ++m) _Pragma("unroll") for (int n = 0; n < 2; ++n) _Pragma("unroll") for (int k = 0; k < 2; ++k) \
        acc[ai][bj][m][n] = mma16<TR, F8>(At[m][k], Bt[n][k], acc[ai][bj][m][n]); \
        __builtin_amdgcn_s_setprio(0); } while (0)
#define GS_WAIT_V(n) asm volatile("s_waitcnt vmcnt(" #n ")" ::: "memory")
#define GS_WAIT_L(n) asm volatile("s_waitcnt lgkmcnt(" #n ")" ::: "memory")
#define GS_BAR __builtin_amdgcn_s_barrier()
#define GS_SCHED __builtin_amdgcn_sched_barrier(0)
    U cur, nxt; int ui = 0;
    if (!S.next(0, cur)) return;
    f32x4 acc[2][2][4][2];
#pragma unroll
    for (int a = 0; a < 2; ++a)
#pragma unroll
        for (int b = 0; b < 2; ++b)
#pragma unroll
            for (int m = 0; m < 4; ++m)
#pragma unroll
                for (int n = 0; n < 2; ++n) acc[a][b][m][n] = (f32x4){0.f, 0.f, 0.f, 0.f};
    bf16x8 At[4][2], B0[2][2], B1[2][2];
    unsigned cvo[2][2], nvo[2][2];
    S.a_off(0, cur, R, C, cvo);
    const char* cA = uni(cur.A); const char* cB = uni(cur.B);
    GS_STAGEB(GS_SB(0, 0), cB, voffB); GS_STAGEB(GS_SB(0, 1), cB + hstepB, voffB); GS_STAGE(GS_SA(0, 0), cA, cvo[0]); GS_STAGE(GS_SA(0, 1), cA, cvo[1]);
    if (wr == 1) GS_BAR;
    GS_WAIT_V(2); GS_BAR;
    GS_STAGEB(GS_SB(1, 0), cB + kstep, voffB); GS_STAGE(GS_SA(1, 0), cA + kstep, cvo[0]); GS_STAGEB(GS_SB(1, 1), cB + hstepB + kstep, voffB);
    GS_WAIT_V(6); GS_BAR;
    for (;;) {
        const bool has_next = S.next(ui + 1, nxt);
        if (has_next) S.a_off(ui + 1, nxt, R, C, nvo);
        else { nvo[0][0] = cvo[0][0]; nvo[0][1] = cvo[0][1]; nvo[1][0] = cvo[1][0]; nvo[1][1] = cvo[1][1]; }
        const char* nA = uni(has_next ? nxt.A : cA); const char* nB = uni(has_next ? nxt.B : cB);
#pragma unroll 1
        for (int t = 0; t < nt; t += 2) {
            const bool last = (t == nt - 2);
            const char* a1 = uni(cA + (size_t)(t + 1) * kstep);
            const char* a2 = uni(last ? nA : cA + (size_t)(t + 2) * kstep); const char* b2 = uni(last ? nB : cB + (size_t)(t + 2) * kstep);
            const char* a3 = uni(a2 + kstep); const char* b3 = uni(b2 + kstep);
            unsigned v2[2][2];
            v2[0][0] = last ? nvo[0][0] : cvo[0][0]; v2[0][1] = last ? nvo[0][1] : cvo[0][1]; v2[1][0] = last ? nvo[1][0] : cvo[1][0]; v2[1][1] = last ? nvo[1][1] : cvo[1][1];
            GS_LDB(B0, 0, 0); GS_LDB(B1, 0, 1); GS_SCHED; GS_LDA(At, 0, 0); GS_STAGE(GS_SA(1, 1), a1, cvo[1]);
            GS_WAIT_V(8); GS_WAIT_L(0); GS_BAR; GS_MMA(0, 0, At, B0); GS_MMA(0, 1, At, B1); GS_BAR; GS_SCHED;
            GS_LDA(At, 0, 1); GS_STAGEB(GS_SB(0, 0), b2, voffB); GS_STAGEB(GS_SB(0, 1), b2 + hstepB, voffB); GS_STAGE(GS_SA(0, 0), a2, v2[0]);
            GS_WAIT_V(8); GS_WAIT_L(0); GS_BAR; GS_MMA(1, 0, At, B0); GS_MMA(1, 1, At, B1); GS_BAR; GS_SCHED;
            GS_LDB(B0, 1, 0); GS_LDB(B1, 1, 1); GS_SCHED; GS_LDA(At, 1, 0); GS_STAGE(GS_SA(0, 1), a2, v2[1]);
            GS_WAIT_V(8); GS_WAIT_L(0); GS_BAR; GS_MMA(0, 0, At, B0); GS_MMA(0, 1, At, B1); GS_BAR; GS_SCHED;
            GS_LDA(At, 1, 1); GS_STAGEB(GS_SB(1, 0), b3, voffB); GS_STAGEB(GS_SB(1, 1), b3 + hstepB, voffB); GS_STAGE(GS_SA(1, 0), a3, v2[0]);
            GS_WAIT_V(8); GS_WAIT_L(0); GS_BAR; GS_MMA(1, 0, At, B0); GS_MMA(1, 1, At, B1); GS_BAR; GS_SCHED;
        }
        if (wr == 0) GS_BAR;
        E(acc, cur, wr, wc, fr, fq);
        if (!has_next) break;
#pragma unroll
        for (int a = 0; a < 2; ++a)
#pragma unroll
            for (int b = 0; b < 2; ++b)
#pragma unroll
                for (int m = 0; m < 4; ++m)
#pragma unroll
                    for (int n = 0; n < 2; ++n) acc[a][b][m][n] = (f32x4){0.f, 0.f, 0.f, 0.f};
        cur = nxt; cA = nA; cB = nB; ++ui;
        cvo[0][0] = nvo[0][0]; cvo[0][1] = nvo[0][1]; cvo[1][0] = nvo[1][0]; cvo[1][1] = nvo[1][1];
        if (wr == 1) GS_BAR;
    }
    GS_WAIT_V(0);
    GS_BAR;
#undef GS_SA
#undef GS_SB
#undef GS_STAGE
#undef GS_STAGEB
#undef GS_LDA
#undef GS_LDB
#undef GS_MMA
#undef GS_WAIT_V
#undef GS_WAIT_L
#undef GS_BAR
#undef GS_SCHED
}
struct DenseU { const char* A; const char* B; int pm, pn; };
struct DenseSched {
    typedef DenseU U;
    const bf16_t* A; const bf16_t* Bt; int K, nunits, first, stride, npn, pn_base, pn_mod0, pn_mod1;
    DI int colmap(int q) const { return pn_base + (q / pn_mod0) * pn_mod1 + (q % pn_mod0); }
    DI bool next(int i, U& u) const {
        const int L = first + i * stride; if (L >= nunits) return false;
        u.pm = L / npn; u.pn = colmap(L % npn);
        u.A = (const char*)A + (size_t)u.pm * BM * K * 2; u.B = (const char*)Bt + (size_t)u.pn * BM * K * 2; return true;
    }
    DI void a_off(int, const U&, const int (&R)[2], const int (&C)[2], unsigned (&vo)[2][2]) const {
#pragma unroll
        for (int h = 0; h < 2; ++h)
#pragma unroll
            for (int i = 0; i < 2; ++i) vo[h][i] = (unsigned)((HALF * h + R[i]) * K + C[i]) * 2u;
    }
};
}

DI void transpose_cvt(const float* W, bf16_t* Wt, int K, int N, int unit, char* lds) {
    float* tile = (float*)lds;
    const int nbn = N / 64, kb = unit / nbn, nb = unit % nbn, tid = tidx();
    __syncthreads();
#pragma unroll
    for (int i = 0; i < 8; ++i) { const int idx = tid + i * 512, r = idx >> 6, c = idx & 63; tile[r * 65 + c] = W[(size_t)(kb * 64 + r) * N + nb * 64 + c]; }
    __syncthreads();
#pragma unroll
    for (int i = 0; i < 8; ++i) { const int idx = tid + i * 512, n = idx >> 6, k = idx & 63; Wt[(size_t)(nb * 64 + n) * K + kb * 64 + k] = f2bf(tile[k * 65 + n]); }
}
struct P0Args { const float* x; const float* w_in; const float* w_out; const float* router_w; bf16_t* xb; bf16_t* wt_in; bf16_t* wt_out; bf16_t* wt_r;
                const float* w_gate; const float* w_up; const float* w_down; const float* ws_gate; const float* ws_up; const float* ws_down; unsigned char* wgut; unsigned char* wdt; };
constexpr int CV_GU = 257 * 2 * 16, CV_DN = 257 * 16;
struct CvItem { const float* src; unsigned char* dst; int ld, ldd, rbase, rhi; };
DI CvItem cv_item(const P0Args& a, int it) {
    CvItem c;
    if (it < CV_GU) {
        const int e = it / 32, u = (it >> 4) & 1, kt = it & 15;
        const float* W = e < N_EXP ? (u ? a.w_up : a.w_gate) + (size_t)e * D_MODEL * D_EXP : (u ? a.ws_up : a.ws_gate);
        c.src = W + (size_t)kt * 64 * D_EXP; c.ld = D_EXP; c.dst = a.wgut + (size_t)e * 512 * D_MODEL + kt * 64; c.ldd = D_MODEL; c.rbase = 128 * u; c.rhi = 256;
    } else {
        const int j = it - CV_GU, e = j / 16, kt = (j >> 2) & 3, nb = j & 3;
        const float* W = e < N_EXP ? a.w_down + (size_t)e * D_EXP * D_MODEL : a.ws_down;
        c.src = W + (size_t)kt * 64 * D_MODEL + nb * 256; c.ld = D_MODEL; c.dst = a.wdt + (size_t)e * D_MODEL * D_EXP + kt * 64; c.ldd = D_EXP; c.rbase = 256 * nb; c.rhi = 128;
    }
    return c;
}
DI void cv_load(const CvItem& c, f32x4 (&v)[8]) {
    const int tid = tidx();
#pragma unroll
    for (int i = 0; i < 8; ++i) { const int idx = tid + i * 512, k = idx >> 6, n4 = idx & 63; v[i] = __builtin_nontemporal_load((const f32x4*)(c.src + (size_t)k * c.ld + 4 * n4)); }
}
DI void cv_store(const CvItem& c, const f32x4 (&v)[8], char* lds) {
    float* tile = (float*)lds;
    const int tid = tidx();
    __syncthreads();
#pragma unroll
    for (int i = 0; i < 8; ++i) { const int idx = tid + i * 512, k = idx >> 6, n4 = idx & 63; *(f32x4*)(tile + k * 260 + 4 * (n4 ^ ((k >> 3) & 7))) = v[i]; }
    __syncthreads();
#pragma unroll
    for (int i = 0; i < 4; ++i) {
        const int idx = tid + i * 512, kc = idx & 7, n = idx >> 3; const float* p = tile + (8 * kc) * 260 + (n ^ (4 * kc));
        const unsigned w0 = pack_fp8x4(p[0] * WSCALE, p[260] * WSCALE, p[2 * 260] * WSCALE, p[3 * 260] * WSCALE), w1 = pack_fp8x4(p[4 * 260] * WSCALE, p[5 * 260] * WSCALE, p[6 * 260] * WSCALE, p[7 * 260] * WSCALE);
        __builtin_nontemporal_store((u32x2){w0, w1}, (u32x2*)(c.dst + (size_t)(c.rbase + (n >> 7) * c.rhi + (n & 127)) * c.ldd + 8 * kc));
    }
}
DI void convert_moe_range(const P0Args& a, char* lds, const int lo, const int hi) {
    int it = lo + vblock(); if (it >= hi) return;
    CvItem c = cv_item(a, it); f32x4 v[8]; cv_load(c, v);
#pragma unroll 1
    for (;;) {
        const int nit = it + GRID; const bool more = nit < hi;
        CvItem cn = c; f32x4 w[8];
        if (more) { cn = cv_item(a, nit); cv_load(cn, w); }
        cv_store(c, v, lds);
        if (!more) break;
        it = nit; c = cn;
#pragma unroll
        for (int i = 0; i < 8; ++i) v[i] = w[i];
    }
}
DI void phase_prologue(const P0Args& a, char* lds) {
    const int vb = vblock();
    for (size_t i = (size_t)vb * NTHR + tidx(); i < (size_t)T_TOK * D_MODEL / 8; i += (size_t)GRID * NTHR) {
        const f32x4 v0 = *(const f32x4*)(a.x + i * 8), v1 = *(const f32x4*)(a.x + i * 8 + 4);
        u32x4 o; o.x = cvt_pk_bf16(v0[0], v0[1]); o.y = cvt_pk_bf16(v0[2], v0[3]); o.z = cvt_pk_bf16(v1[0], v1[1]); o.w = cvt_pk_bf16(v1[2], v1[3]);
        *(u32x4*)(a.xb + i * 8) = o;
    }
    const int n_in = (1024 / 64) * (3072 / 64), n_out = 16 * 16, n_r = 16 * 4;
    for (int u = vb; u < n_in + n_out + n_r; u += GRID) {
        if (u < n_in) transpose_cvt(a.w_in, a.wt_in, 1024, 3072, u, lds);
        else if (u < n_in + n_out) transpose_cvt(a.w_out, a.wt_out, 1024, 1024, u - n_in, lds);
        else transpose_cvt(a.router_w, a.wt_r, 1024, 256, u - n_in - n_out, lds);
    }
}


struct P1Args { const bf16_t* xb; const bf16_t* wt_in; bf16_t* Q; bf16_t* Kb; bf16_t* Vt; };
struct EpiQK { bf16_t* Q; bf16_t* Kb;
    DI void operator()(const f32x4 (&acc)[2][2][4][2], const gs::DenseU& u, int wr, int wc, int fr, int fq) const {
        const int seg = u.pn >> 1, type = seg % 3, grp = seg / 3; bf16_t* dst = type == 0 ? Q : Kb; const float sc = type == 0 ? QSCALE : 1.f;
#pragma unroll
        for (int ai = 0; ai < 2; ++ai)
#pragma unroll
            for (int m = 0; m < 4; ++m) {
                const int row = u.pm * 256 + 128 * ai + 64 * wr + 16 * m + fr, b = row / SEQ, s = row % SEQ;
#pragma unroll
                for (int bj = 0; bj < 2; ++bj) {
                    const int hh = grp * 8 + 4 * (u.pn & 1) + 2 * bj + (wc >> 1), d0 = 32 * (wc & 1) + 8 * fq;
                    const f32x4 v0 = acc[ai][bj][m][0] * sc, v1 = acc[ai][bj][m][1] * sc;
                    u32x4 o; o.x = cvt_pk_bf16(v0[0], v0[1]); o.y = cvt_pk_bf16(v0[2], v0[3]); o.z = cvt_pk_bf16(v1[0], v1[1]); o.w = cvt_pk_bf16(v1[2], v1[3]);
                    *(u32x4*)(dst + (size_t)(b * NHH + hh) * SEQ * 64 + (s >> 5) * 2048 + ((d0 >> 3) * 32 + (s & 31)) * 8) = o;
                }
            }
    } };
struct EpiV { bf16_t* Vt;
    DI void operator()(const f32x4 (&acc)[2][2][4][2], const gs::DenseU& u, int wr, int wc, int fr, int fq) const {
        const int grp = (u.pn >> 1) / 3;
#pragma unroll
        for (int ai = 0; ai < 2; ++ai)
#pragma unroll
            for (int m = 0; m < 4; ++m) {
                const int row = u.pm * 256 + 128 * ai + 64 * wr + 16 * m + 4 * fq, b = row / SEQ, s = row % SEQ;
#pragma unroll
                for (int bj = 0; bj < 2; ++bj)
#pragma unroll
                    for (int n = 0; n < 2; ++n) {
                        const int hh = grp * 8 + 4 * (u.pn & 1) + 2 * bj + (wc >> 1), d = 32 * (wc & 1) + 16 * n + fr;
                        const f32x4 v = acc[ai][bj][m][n];
                        u32x2 o; o.x = cvt_pk_bf16(v[0], v[1]); o.y = cvt_pk_bf16(v[2], v[3]);
                        { const int kap = s & 31; *(u32x2*)(Vt + (size_t)(b * NHH + hh) * SEQ * 64 + (s >> 5) * 2048 + ((((d >> 5) * 2 + (kap >> 4)) * 2 + ((kap >> 2) & 1)) * 32 + (d & 31)) * 8 + ((kap >> 3) & 1) * 4) = o; }
                    }
            }
    } };
DI void phase_qkv(const P1Args& a, LAS unsigned char* lds) {
    { gs::DenseSched S{a.xb, a.wt_in, D_MODEL, (T_TOK / 256) * 8, vblock(), GRID, 8, 0, 4, 6}; EpiQK E{a.Q, a.Kb}; gs::gemm_stream<true, true, false>(lds, D_MODEL, S, E); }
    { gs::DenseSched S{a.xb, a.wt_in, D_MODEL, (T_TOK / 256) * 4, vblock(), GRID, 4, 4, 2, 6}; EpiV E{a.Vt}; gs::gemm_stream<false, false, false>(lds, D_MODEL, S, E); }
}

struct P3Args { const bf16_t* y; const bf16_t* wt_out; const bf16_t* xb; bf16_t* r; float* stats; };
struct EpiOut { const bf16_t* xb; bf16_t* r; float* stats;
    DI void operator()(const f32x4 (&acc)[2][2][4][2], const gs::DenseU& u, int wr, int wc, int fr, int fq) const {
#pragma unroll
        for (int ai = 0; ai < 2; ++ai)
#pragma unroll
            for (int m = 0; m < 4; ++m) {
                const int row = u.pm * 256 + 128 * ai + 64 * wr + 16 * m + fr;
#pragma unroll
                for (int bj = 0; bj < 2; ++bj) {
                    const int col = u.pn * 256 + 128 * bj + 32 * wc + 8 * fq;
                    const u32x4 xw = *(const u32x4*)(xb + (size_t)row * D_MODEL + col);
                    const f32x4 x0 = (f32x4){__uint_as_float(xw[0] << 16), __uint_as_float(xw[0] & 0xffff0000u), __uint_as_float(xw[1] << 16), __uint_as_float(xw[1] & 0xffff0000u)};
                    const f32x4 x1 = (f32x4){__uint_as_float(xw[2] << 16), __uint_as_float(xw[2] & 0xffff0000u), __uint_as_float(xw[3] << 16), __uint_as_float(xw[3] & 0xffff0000u)};
                    const f32x4 v0 = x0 * DN_ALPHA + acc[ai][bj][m][0], v1 = x1 * DN_ALPHA + acc[ai][bj][m][1];
                    float s = ((v0[0] + v0[1]) + (v0[2] + v0[3])) + ((v1[0] + v1[1]) + (v1[2] + v1[3]));
                    float q = ((v0[0] * v0[0] + v0[1] * v0[1]) + (v0[2] * v0[2] + v0[3] * v0[3])) + ((v1[0] * v1[0] + v1[1] * v1[1]) + (v1[2] * v1[2] + v1[3] * v1[3]));
                    u32x4 o; o.x = cvt_pk_bf16(v0[0], v0[1]); o.y = cvt_pk_bf16(v0[2], v0[3]); o.z = cvt_pk_bf16(v1[0], v1[1]); o.w = cvt_pk_bf16(v1[2], v1[3]);
                    *(u32x4*)(r + (size_t)row * D_MODEL + col) = o;
                    s += __shfl_xor(s, 16); s += __shfl_xor(s, 32); q += __shfl_xor(q, 16); q += __shfl_xor(q, 32);
                    if (fq == 0) *(f32x2*)(stats + ((size_t)row * 32 + u.pn * 8 + bj * 4 + wc) * 2) = (f32x2){s, q};
                }
            }
    } };
DI void phase_outproj(const P3Args& a, LAS unsigned char* lds) {
    gs::DenseSched S{a.y, a.wt_out, D_MODEL, (T_TOK / 256) * 4, vblock(), GRID, 4, 0, 4, 0}; EpiOut E{a.xb, a.r, a.stats}; gs::gemm_stream<true, true, false>(lds, D_MODEL, S, E);
}

DI void unpack16(const u32x4& a, const u32x4& b, float (&v)[16]) {
#pragma unroll
    for (int j = 0; j < 4; ++j) { v[2 * j] = __uint_as_float(a[j] << 16); v[2 * j + 1] = __uint_as_float(a[j] & 0xffff0000u); v[8 + 2 * j] = __uint_as_float(b[j] << 16); v[8 + 2 * j + 1] = __uint_as_float(b[j] & 0xffff0000u); }
}
constexpr int RS_SC = 289;
constexpr int LDS_HIST = 100 * 1024;
struct P4Args { const bf16_t* r; const float* stats; const float* ln_g; const float* ln_b; bf16_t* x1; unsigned char* x1f8; const bf16_t* wt_r; const float* rbias;
                int* eidx; float* gate; int* counts; int* tokl; float* gatel; int* slot; };
DI void phase_router(const P4Args& a, const P0Args& cv, char* lds) {
    const int tid = tidx(), wid = tid >> 6, lane = tid & 63, wr = wid >> 2, wc = wid & 3, fr = lane & 15, fq = lane >> 4;
    float* sc = (float*)lds; int* hist = (int*)(lds + LDS_HIST); int* base = hist + 256;
    for (int u = vblock(); u < T_TOK / 128; u += GRID) {
        const int m0 = u * 128;
        if ((vblock() & 1) == 0) convert_moe_range(cv, lds, CV_GU, CV_GU + CV_DN);
        __syncthreads();
#pragma unroll 1
        for (int i0 = 0; i0 < 16; i0 += 4) {
            f32x2 st[4]; u32x4 r0[4], r1[4];
#pragma unroll
            for (int j4 = 0; j4 < 4; ++j4) {
                const int t = m0 + wid * 16 + i0 + j4;
                st[j4] = (f32x2){0.f, 0.f};
                if (lane < 32) st[j4] = *(const f32x2*)(a.stats + ((size_t)t * 32 + lane) * 2);
                r0[j4] = *(const u32x4*)(a.r + (size_t)t * D_MODEL + lane * 16); r1[j4] = *(const u32x4*)(a.r + (size_t)t * D_MODEL + lane * 16 + 8);
            }
#pragma unroll
            for (int j4 = 0; j4 < 4; ++j4) {
                const int t = m0 + wid * 16 + i0 + j4;
                float s = st[j4].x, q = st[j4].y;
#pragma unroll
                for (int o = 1; o <= 16; o <<= 1) { s += __shfl_xor(s, o); q += __shfl_xor(q, o); }
                s = __shfl(s, 0); q = __shfl(q, 0);
                const float mu = s * (1.f / 1024.f), rstd = rsqrtf(q * (1.f / 1024.f) - mu * mu + LN_EPS);
                float v[16]; unpack16(r0[j4], r1[j4], v);
                u32x4 o0, o1, o8;
#pragma unroll
                for (int j = 0; j < 4; ++j) {
                    const f32x4 g = *(const f32x4*)(a.ln_g + lane * 16 + 4 * j), bb = *(const f32x4*)(a.ln_b + lane * 16 + 4 * j);
                    const float y0 = (v[4 * j] - mu) * rstd * g[0] + bb[0], y1 = (v[4 * j + 1] - mu) * rstd * g[1] + bb[1], y2 = (v[4 * j + 2] - mu) * rstd * g[2] + bb[2], y3 = (v[4 * j + 3] - mu) * rstd * g[3] + bb[3];
                    o8[j] = pack_fp8x4(y0 * XSCALE, y1 * XSCALE, y2 * XSCALE, y3 * XSCALE);
                    const unsigned p0 = cvt_pk_bf16(y0, y1), p1 = cvt_pk_bf16(y2, y3);
                    if (j < 2) { o0[2 * j] = p0; o0[2 * j + 1] = p1; } else { o1[2 * (j - 2)] = p0; o1[2 * (j - 2) + 1] = p1; }
                }
                *(u32x4*)(a.x1 + (size_t)t * D_MODEL + lane * 16) = o0; *(u32x4*)(a.x1 + (size_t)t * D_MODEL + lane * 16 + 8) = o1;
                *(u32x4*)(a.x1f8 + (size_t)t * D_MODEL + lane * 16) = o8;
            }
        }
        if (tid < 256) hist[tid] = 0;
        asm volatile("s_waitcnt vmcnt(0)" ::: "memory");
        __syncthreads();
        ALoader<4> al; al.init_rows(a.x1, D_MODEL, m0);
        BLoaderBt bl; bl.init(a.wt_r, D_MODEL, 0);
        f32x4 acc[4][4];
        gemm_tile<4, true>(lds, al, bl, D_MODEL / 64, acc);
        int my_idx[2], my_rank[2]; float my_gate[2];
#pragma unroll
        for (int p = 0; p < 2; ++p) {
            __syncthreads();
            if (wr == p) {
#pragma unroll
                for (int m = 0; m < 4; ++m)
#pragma unroll
                    for (int n = 0; n < 4; ++n) {
                        const int c0 = 64 * wc + 16 * n + 4 * fq; const f32x4 rb = *(const f32x4*)(a.rbias + c0);
#pragma unroll
                        for (int j = 0; j < 4; ++j) { const int c = c0 + j; sc[(16 * m + fr) * RS_SC + (c >> 5) * 36 + (c & 31)] = 1.f / (1.f + __expf(-acc[m][n][j])) + rb[j]; }
                    }
            }
            __syncthreads();
            const int row = tid >> 3, g = tid & 7, t = m0 + 64 * p + row;
            float sel[32];
#pragma unroll
            for (int i = 0; i < 32; ++i) sel[i] = sc[row * RS_SC + g * 36 + i];
            float m1 = -INFINITY, m2 = -INFINITY;
#pragma unroll
            for (int i = 0; i < 32; ++i) { const float v = sel[i]; m2 = fmaxf(m2, fminf(m1, v)); m1 = fmaxf(m1, v); }
            const float gs = m1 + m2; int rank = 0;
#pragma unroll
            for (int d = 1; d < 8; ++d) { const float o = __shfl_xor(gs, d); const int og = g ^ d; rank += (o > gs || (o == gs && og < g)) ? 1 : 0; }
            const bool en = rank < TOPK_GROUPS;
            float lv = -INFINITY; int li = 1 << 20;
            if (en) {
#pragma unroll
                for (int i = 0; i < 32; ++i) { const float v = sel[i]; if (v > lv) { lv = v; li = g * 32 + i; } }
            }
            float myv = 0.f; int myi = 0;
#pragma unroll
            for (int k = 0; k < TOP_K; ++k) {
                float bv = lv; int bi = li;
#pragma unroll
                for (int d = 1; d < 8; d <<= 1) { const float ov = __shfl_xor(bv, d); const int oi = __shfl_xor(bi, d); if (ov > bv || (ov == bv && oi < bi)) { bv = ov; bi = oi; } }
                if (g == k) { myv = bv; myi = bi; }
                if (k + 1 < TOP_K && (bi >> 5) == g) {
                    lv = -INFINITY; li = 1 << 20;
#pragma unroll
                    for (int i = 0; i < 32; ++i) { if (g * 32 + i == bi) sel[i] = -INFINITY; const float v = sel[i]; if (v > lv) { lv = v; li = g * 32 + i; } }
                }
            }
            const float score = myv - a.rbias[myi];
            float gsum = score;
#pragma unroll
            for (int d = 1; d < 8; d <<= 1) gsum += __shfl_xor(gsum, d);
            const float gt = score / gsum * ROUTED_SCALE;
            a.eidx[t * TOP_K + g] = myi; a.gate[t * TOP_K + g] = gt;
            my_idx[p] = myi; my_gate[p] = gt; my_rank[p] = atomicAdd(&hist[myi], 1);
        }
        __syncthreads();
        if (tid < 256) { const int h = hist[tid]; base[tid] = h > 0 ? atomicAdd(&a.counts[tid * CSTR], h) : 0; }
        __syncthreads();
#pragma unroll
        for (int p = 0; p < 2; ++p) {
            const int row = tid >> 3, g = tid & 7, t = m0 + 64 * p + row, e = my_idx[p], pos = base[e] + my_rank[p];
            a.tokl[(size_t)e * CAP + pos] = t; a.gatel[(size_t)e * CAP + pos] = my_gate[p]; a.slot[t * TOP_K + g] = e * CAP + pos;
        }
        if ((vblock() & 1) == 1) convert_moe_range(cv, lds, CV_GU, CV_GU + CV_DN);
    }
}

constexpr int LDS_ROWTAB = 128 * 1024;
constexpr int LDS_GTAB = 139 * 1024;
constexpr int LDS_TAB = 150 * 1024;
constexpr int MOE_BM = 256;
DI void build_moe_tab(const int* counts, char* lds) {
    int* tstart = (int*)(lds + LDS_TAB); int* rstart = tstart + 264; int* cnts = tstart + 528;
    const int tid = tidx(), lane = tid & 63;
    __syncthreads();
    if (tid < 64) {
        int c[4], tl[4], cs = 0, ts = 0;
#pragma unroll
        for (int i = 0; i < 4; ++i) { c[i] = counts[(lane * 4 + i) * CSTR]; tl[i] = (c[i] + MOE_BM - 1) / MOE_BM; cs += c[i]; ts += tl[i]; }
        int ci = cs, ti = ts;
#pragma unroll
        for (int o = 1; o < 64; o <<= 1) { const int n1 = __shfl_up(ci, o), n2 = __shfl_up(ti, o); if (lane >= o) { ci += n1; ti += n2; } }
        int ce = ci - cs, te = ti - ts;
#pragma unroll
        for (int i = 0; i < 4; ++i) { rstart[lane * 4 + i] = ce; tstart[lane * 4 + i] = te; cnts[lane * 4 + i] = c[i]; ce += c[i]; te += tl[i]; }
        if (lane == 63) { rstart[256] = ce; tstart[256] = te; cnts[256] = T_TOK; rstart[257] = ce + T_TOK; tstart[257] = te + T_TOK / MOE_BM; }
    }
    __syncthreads();
}
DI int find_expert(const int* tstart, int g) {
    int lo = 0, hi = 256;
#pragma unroll 1
    while (lo < hi) { const int mid = (lo + hi + 1) >> 1; if (tstart[mid] <= g) lo = mid; else hi = mid - 1; }
    return lo;
}
struct MoeU { const char* A; const char* B; int e, m0, sub, ui; };
typedef const LAS int* ltab_t;
DI int find_expert_l(ltab_t tstart, int g) { int lo = 0, hi = 256;
#pragma unroll 1
    while (lo < hi) { const int mid = (lo + hi + 1) >> 1; if (tstart[mid] <= g) lo = mid; else hi = mid - 1; }
    return lo; }

struct P6Args { const unsigned char* x1; const int* counts; const int* tokl; const float* gatel; const unsigned char* wgut; unsigned char* H; };
struct GuSched {
    typedef MoeU U;
    ltab_t tab; const LAS int* rowtab; const unsigned char* x1; const unsigned char* wgut; int first, stride, nunits;
    DI bool next(int i, U& u) const {
        const int L = first + i * stride; if (L >= nunits) return false;
        const int g = L >> 1, e = find_expert_l(tab, g);
        u.sub = L & 1; u.e = e; u.ui = i; u.m0 = (g - tab[e]) * MOE_BM;
        u.A = (const char*)x1; u.B = (const char*)(wgut + ((size_t)e * 512 + 256 * u.sub) * D_MODEL); return true;
    }
    DI void a_off(int i, const U&, const int (&R)[2], const int (&C)[2], unsigned (&vo)[2][2]) const {
#pragma unroll
        for (int h = 0; h < 2; ++h)
#pragma unroll
            for (int p = 0; p < 2; ++p) vo[h][p] = (unsigned)(rowtab[i * 256 + 128 * h + R[p]] * (D_MODEL / 2) + C[p]) * 2u;
    }
};
struct EpiGU { unsigned char* H; const LAS float* gtab; ltab_t tab;
    DI void operator()(const f32x4 (&acc)[2][2][4][2], const MoeU& u, int wr, int wc, int fr, int fq) const {
        const int st = tab[264 + u.e], cnt = tab[528 + u.e];
#pragma unroll
        for (int ai = 0; ai < 2; ++ai)
#pragma unroll
            for (int m = 0; m < 4; ++m) {
                const int row = u.m0 + 128 * ai + 64 * wr + 16 * m + fr;
                if (row < cnt) {
                    const float gt = gtab[u.ui * 256 + 128 * ai + 64 * wr + 16 * m + fr] * (HSCALE / (XSCALE * WSCALE));
                    float h[8];
#pragma unroll
                    for (int n = 0; n < 2; ++n)
#pragma unroll
                        for (int j = 0; j < 4; ++j) { const float gv = acc[ai][0][m][n][j] * (1.f / (XSCALE * WSCALE)); h[4 * n + j] = gv * __builtin_amdgcn_rcpf(1.f + __expf(-gv)) * acc[ai][1][m][n][j] * gt; }
                    *(u32x2*)(H + (size_t)(st + row) * D_EXP + 128 * u.sub + 32 * wc + 8 * fq) = (u32x2){pack_fp8x4(h[0], h[1], h[2], h[3]), pack_fp8x4(h[4], h[5], h[6], h[7])};
                }
            }
    } };
DI void phase_moe_gu(const P6Args& a, char* smem, LAS unsigned char* lds) {
    build_moe_tab(a.counts, smem);
    const int* tstart = (const int*)(smem + LDS_TAB); const int* rstart = tstart + 264; int* rowtab = (int*)(smem + LDS_ROWTAB); float* gtab = (float*)(smem + LDS_GTAB);
    const int nunits = tstart[257] * 2, first = vblock();
    const int n_my = first < nunits ? (nunits - first + GRID - 1) / GRID : 0;
    for (int idx = tidx(); idx < n_my * 256; idx += NTHR) {
        const int i = idx >> 8, row = idx & 255, L = first + i * GRID, g = L >> 1, e = find_expert(tstart, g), m0 = (g - tstart[e]) * MOE_BM, cnt = tstart[528 + e];
        int rr = m0 + row; rr = rr < cnt ? rr : cnt - 1;
        rowtab[idx] = e < N_EXP ? a.tokl[(size_t)e * CAP + rr] : rr;
        gtab[idx] = e < N_EXP ? a.gatel[(size_t)e * CAP + rr] : 1.f;
    }
    __syncthreads();
    GuSched S{(ltab_t)(lds + LDS_TAB), (const LAS int*)(lds + LDS_ROWTAB), a.x1, a.wgut, first, GRID, nunits}; EpiGU E{a.H, (const LAS float*)(lds + LDS_GTAB), (ltab_t)(lds + LDS_TAB)};
    gs::gemm_stream<true, true, true>(lds, D_MODEL / 2, S, E);
}
struct P7Args { const unsigned char* H; const int* counts; const unsigned char* wdt; unsigned char* Y; };
struct DownSched {
    typedef MoeU U;
    ltab_t tab; const unsigned char* H; const unsigned char* wdt; int first, stride, nunits;
    DI bool next(int i, U& u) const {
        const int L = first + i * stride; if (L >= nunits) return false;
        const int g = L >> 2, e = find_expert_l(tab, g);
        u.sub = L & 3; u.e = e; u.ui = i; u.m0 = (g - tab[e]) * MOE_BM;
        u.A = (const char*)(H + (size_t)(tab[264 + e] + u.m0) * D_EXP); u.B = (const char*)(wdt + ((size_t)e * D_MODEL + 256 * u.sub) * D_EXP); return true;
    }
    DI void a_off(int, const U&, const int (&R)[2], const int (&C)[2], unsigned (&vo)[2][2]) const {
#pragma unroll
        for (int h = 0; h < 2; ++h)
#pragma unroll
            for (int p = 0; p < 2; ++p) vo[h][p] = (unsigned)((128 * h + R[p]) * (D_EXP / 2) + C[p]) * 2u;
    }
};
struct EpiDown { unsigned char* Y; ltab_t tab;
    DI void operator()(const f32x4 (&acc)[2][2][4][2], const MoeU& u, int wr, int wc, int fr, int fq) const {
        const int st = tab[264 + u.e], cnt = tab[528 + u.e];
#pragma unroll
        for (int ai = 0; ai < 2; ++ai)
#pragma unroll
            for (int m = 0; m < 4; ++m) {
                const int row = u.m0 + 128 * ai + 64 * wr + 16 * m + fr;
                if (row < cnt) {
#pragma unroll
                    for (int bj = 0; bj < 2; ++bj) {
                        f32x4 v0 = acc[ai][bj][m][0] * (YSCALE / (HSCALE * WSCALE)), v1 = acc[ai][bj][m][1] * (YSCALE / (HSCALE * WSCALE));
#pragma unroll
                        for (int j = 0; j < 4; ++j) { v0[j] = __builtin_amdgcn_fmed3f(v0[j], -440.f, 440.f); v1[j] = __builtin_amdgcn_fmed3f(v1[j], -440.f, 440.f); }
                        int w0 = 0, w1 = 0;
                        w0 = __builtin_amdgcn_cvt_pk_fp8_f32(v0[0], v0[1], w0, false); w0 = __builtin_amdgcn_cvt_pk_fp8_f32(v0[2], v0[3], w0, true);
                        w1 = __builtin_amdgcn_cvt_pk_fp8_f32(v1[0], v1[1], w1, false); w1 = __builtin_amdgcn_cvt_pk_fp8_f32(v1[2], v1[3], w1, true);
                        *(u32x2*)(Y + (size_t)(st + row) * D_MODEL + 256 * u.sub + 128 * bj + 32 * wc + 8 * fq) = (u32x2){(unsigned)w0, (unsigned)w1};
                    }
                }
            }
    } };
DI void phase_moe_down(const P7Args& a, char* smem, LAS unsigned char* lds) {
    build_moe_tab(a.counts, smem);
    const int* tstart = (const int*)(smem + LDS_TAB); const int* rstart = tstart + 264;
    DownSched S{(ltab_t)(lds + LDS_TAB), a.H, a.wdt, vblock(), GRID, tstart[257] * 4}; EpiDown E{a.Y, (ltab_t)(lds + LDS_TAB)};
    gs::gemm_stream<true, true, true>(lds, D_EXP / 2, S, E);
}
struct P8Args { const bf16_t* x1; const unsigned char* Y; const int* slot; const int* counts; const float* ln_g; const float* ln_b; float* out; };
DI void phase_combine(const P8Args& a, char* lds) {
    const int tid = tidx(), wid = tid >> 6, lane = tid & 63;
    build_moe_tab(a.counts, lds);
    const int* rstart = (const int*)(lds + LDS_TAB) + 264;
    const int sh0 = rstart[256];
    for (int t = vblock() * 8 + wid; t < T_TOK; t += GRID * 8) {
        float v[16], w[16];
        { const u32x4 p0 = *(const u32x4*)(a.x1 + (size_t)t * D_MODEL + lane * 16), p1 = *(const u32x4*)(a.x1 + (size_t)t * D_MODEL + lane * 16 + 8); unpack16(p0, p1, v); }
        int sl = 0; if (lane < TOP_K) sl = a.slot[t * TOP_K + lane];
        u32x4 yr[9];
        yr[8] = *(const u32x4*)(a.Y + (size_t)(sh0 + t) * D_MODEL + lane * 16);
#pragma unroll
        for (int k = 0; k < TOP_K; ++k) { const int s = __shfl(sl, k), e = s / CAP, pos = s % CAP; yr[k] = *(const u32x4*)(a.Y + (size_t)(rstart[e] + pos) * D_MODEL + lane * 16); }
#pragma unroll
        for (int i = 0; i < 16; ++i) w[i] = 0.f;
#pragma unroll
        for (int k = 0; k < 9; ++k)
#pragma unroll
            for (int j = 0; j < 4; ++j) { const f32x2 lo = __builtin_amdgcn_cvt_pk_f32_fp8((int)yr[k][j], false), hi = __builtin_amdgcn_cvt_pk_f32_fp8((int)yr[k][j], true); w[4 * j] += lo.x; w[4 * j + 1] += lo.y; w[4 * j + 2] += hi.x; w[4 * j + 3] += hi.y; }
#pragma unroll
        for (int i = 0; i < 16; ++i) v[i] = v[i] * DN_ALPHA + w[i] * (1.f / YSCALE);
        float s = 0.f;
#pragma unroll
        for (int i = 0; i < 16; ++i) s += v[i];
#pragma unroll
        for (int o = 32; o >= 1; o >>= 1) s += __shfl_xor(s, o);
        const float mu = s * (1.f / 1024.f);
        float q = 0.f;
#pragma unroll
        for (int i = 0; i < 16; ++i) { const float d = v[i] - mu; q += d * d; }
#pragma unroll
        for (int o = 32; o >= 1; o >>= 1) q += __shfl_xor(q, o);
        const float rstd = rsqrtf(q * (1.f / 1024.f) + LN_EPS);
#pragma unroll
        for (int j = 0; j < 4; ++j) {
            const f32x4 g = *(const f32x4*)(a.ln_g + lane * 16 + 4 * j), bb = *(const f32x4*)(a.ln_b + lane * 16 + 4 * j);
            f32x4 o; o[0] = (v[4 * j] - mu) * rstd * g[0] + bb[0]; o[1] = (v[4 * j + 1] - mu) * rstd * g[1] + bb[1]; o[2] = (v[4 * j + 2] - mu) * rstd * g[2] + bb[2]; o[3] = (v[4 * j + 3] - mu) * rstd * g[3] + bb[3];
            *(f32x4*)(a.out + (size_t)t * D_MODEL + lane * 16 + 4 * j) = o;
        }
    }
}

#define MFMA32(a, b, c) __builtin_amdgcn_mfma_f32_32x32x16_bf16((a), (b), (c), 0, 0, 0)
constexpr float SB_EXIT_THR = 1e-30f;
struct P2Args { const bf16_t* Q; const bf16_t* Kb; const bf16_t* Vt; const float* rel_bias; const float* gain_a; const float* gain_b; bf16_t* y; };

DI bf16x8 pack8(const f32x16& x, int s) {
    u32x4 p;
    if (s == 0) { p.x = cvt_pk_bf16(x[0], x[1]); p.y = cvt_pk_bf16(x[2], x[3]); p.z = cvt_pk_bf16(x[4], x[5]); p.w = cvt_pk_bf16(x[6], x[7]); }
    else        { p.x = cvt_pk_bf16(x[8], x[9]); p.y = cvt_pk_bf16(x[10], x[11]); p.z = cvt_pk_bf16(x[12], x[13]); p.w = cvt_pk_bf16(x[14], x[15]); }
    return __builtin_bit_cast(bf16x8, p);
}
DI void load_k(bf16x8 (&k)[4], const bf16_t* kp, int k0) {
#pragma unroll
    for (int kk = 0; kk < 4; ++kk) k[kk] = *(const bf16x8*)(kp + (size_t)(k0 >> 5) * 2048 + kk * 512);
}
DI void load_v(bf16x8 (&v)[2][2], const bf16_t* vp, int k0) {
#pragma unroll
    for (int dt = 0; dt < 2; ++dt)
#pragma unroll
        for (int s = 0; s < 2; ++s) v[dt][s] = *(const bf16x8*)(vp + (size_t)(k0 >> 5) * 2048 + (dt * 2 + s) * 512);
}

constexpr int LDS_CVT = 16 * 1024;
DI void phase_attn(const P2Args& a, const P0Args& cv, char* lds) {
    const int tid = tidx(), wid = tid >> 6, lane = tid & 63, r = lane & 31, h = lane >> 5;
    float* tbl = (float*)lds;
    float* ssq = (float*)(lds + 8 * 260 * 4);
    __syncthreads();
    for (int i = tid; i < NHA * 257; i += NTHR) { const int hd = i / 257, j = i % 257; tbl[hd * 260 + j] = a.rel_bias[i] * LOG2E; }
    __syncthreads();
    const int cgrp = vblock() % 3;
#pragma unroll 1
    for (int slot = 0; slot < 5; ++slot) {
        if ((cgrp == 0 && slot == 0) || (cgrp == 1 && slot == 2) || (cgrp == 2 && slot == 4)) convert_moe_range(cv, lds + LDS_CVT, 0, CV_GU);
        if (slot == 4) break;
        const int u = vblock() + GRID * (slot >> 1) + 2 * GRID * (slot & 1);
        const bool isB = u >= BATCH * (SEQ / 64); const int uu = isB ? u - BATCH * (SEQ / 64) : u;
        const int b = uu / (SEQ / 64), c = uu % (SEQ / 64), q0 = c * 64, hh = (isB ? NHA : 0) + wid;
        const size_t hb = (size_t)(b * NHH + hh) * SEQ * 64;
        const bf16_t* kp = a.Kb + hb + lane * 8;
        const bf16_t* vp = a.Vt + hb + lane * 8;
        bf16x8 qf[2][4];
#pragma unroll
        for (int qt = 0; qt < 2; ++qt)
#pragma unroll
            for (int kk = 0; kk < 4; ++kk) qf[qt][kk] = *(const bf16x8*)(a.Q + hb + (size_t)((q0 >> 5) + qt) * 2048 + kk * 512 + lane * 8);
        f32x16 ot[2][2];
#pragma unroll
        for (int dt = 0; dt < 2; ++dt)
#pragma unroll
            for (int qt = 0; qt < 2; ++qt)
#pragma unroll
                for (int i = 0; i < 16; ++i) ot[dt][qt][i] = 0.f;
        float linv[2] = {1.f, 1.f};
        if (!isB) {
            float mrun[2] = {-INFINITY, -INFINITY}, lrun[2] = {0.f, 0.f};
            const int klo = q0 - LEFT_CHUNKS * CHUNK < 0 ? 0 : q0 - LEFT_CHUNKS * CHUNK, khi = q0 + 64;
            const float cfar = tbl[wid * 260 + 256];
            bf16x8 kc[4], kn[4], vf[2][2]; load_k(kc, kp, klo);
            for (int k0 = klo; k0 < khi; k0 += 32) {
                load_v(vf, vp, k0);
                load_k(kn, kp, k0 + 32 < khi ? k0 + 32 : k0);
#pragma unroll
                for (int qt = 0; qt < 2; ++qt) {
                    bf16x8 pf[2];
                    f32x16 st;
#pragma unroll
                    for (int i = 0; i < 16; ++i) st[i] = 0.f;
#pragma unroll
                    for (int kk = 0; kk < 4; ++kk) st = MFMA32(kc[kk], qf[qt][kk], st);
                    const int dmin = q0 + 32 * qt - k0 - 31;
                    if (dmin >= MAX_REL) {
#pragma unroll
                        for (int i = 0; i < 16; ++i) st[i] += cfar;
                    } else {
                        const int bidx = q0 + 32 * qt + r - k0 - 4 * h + MAX_REL;
#pragma unroll
                        for (int i = 0; i < 16; ++i) { int ix = bidx - ((i & 3) + 8 * (i >> 2)); ix = ix < 0 ? 0 : (ix > 2 * MAX_REL ? 2 * MAX_REL : ix); st[i] += tbl[wid * 260 + ix]; }
                    }
                    float mx = st[0];
#pragma unroll
                    for (int i = 1; i < 16; ++i) mx = fmaxf(mx, st[i]);
                    mx = fmaxf(mx, __shfl_xor(mx, 32));
                    const float mn = fmaxf(mrun[qt], mx), alpha = __builtin_amdgcn_exp2f(mrun[qt] - mn);
                    mrun[qt] = mn;
                    float ps = 0.f;
#pragma unroll
                    for (int i = 0; i < 16; ++i) { st[i] = __builtin_amdgcn_exp2f(st[i] - mn); ps += st[i]; }
                    lrun[qt] = lrun[qt] * alpha + ps;
#pragma unroll
                    for (int i = 0; i < 16; ++i) { ot[0][qt][i] *= alpha; ot[1][qt][i] *= alpha; }
                    pf[0] = pack8(st, 0); pf[1] = pack8(st, 1);
#pragma unroll
                    for (int dt = 0; dt < 2; ++dt)
#pragma unroll
                        for (int s = 0; s < 2; ++s) ot[dt][qt] = MFMA32(vf[dt][s], pf[s], ot[dt][qt]);
                }
#pragma unroll
                for (int kk = 0; kk < 4; ++kk) kc[kk] = kn[kk];
            }
#pragma unroll
            for (int qt = 0; qt < 2; ++qt) { const float lt = lrun[qt] + __shfl_xor(lrun[qt], 32); linv[qt] = 1.f / lt; }
        } else {
            float carry[2] = {1.f, 1.f};
            bf16x8 kc[4], kn[4], vf[2][2]; load_k(kc, kp, q0 + 32);
            for (int k0 = q0 + 32; k0 >= 0; k0 -= 32) {
                load_v(vf, vp, k0);
                load_k(kn, kp, k0 >= 32 ? k0 - 32 : k0);
#pragma unroll
                for (int qt = 0; qt < 2; ++qt) {
                    bf16x8 pf[2];
                    f32x16 st;
#pragma unroll
                    for (int i = 0; i < 16; ++i) st[i] = 0.f;
                    const bool none = (k0 > q0 + 32 * qt + 30);
                    if (!none) {
#pragma unroll
                        for (int kk = 0; kk < 4; ++kk) st = MFMA32(kc[kk], qf[qt][kk], st);
                        const bool full = (k0 + 31 < q0 + 32 * qt);
                        const int lim = q0 + 32 * qt + r - k0 - 4 * h;
                        float om[16];
#pragma unroll
                        for (int i = 0; i < 16; ++i) {
                            const float e = __builtin_amdgcn_exp2f(-st[i]); float bta = __builtin_amdgcn_rcpf(1.f + e);
                            if (!full && !(((i & 3) + 8 * (i >> 2)) < lim)) bta = 0.f;
                            st[i] = bta; om[i] = 1.f - bta;
                        }
                        float G[4], Go[4];
#pragma unroll
                        for (int g = 0; g < 4; ++g) { G[g] = (om[4 * g] * om[4 * g + 1]) * (om[4 * g + 2] * om[4 * g + 3]); Go[g] = __shfl_xor(G[g], 32); }
                        float R = carry[qt];
#pragma unroll
                        for (int g = 3; g >= 0; --g) {
                            float run = h == 0 ? R * Go[g] : R;
#pragma unroll
                            for (int uu2 = 3; uu2 >= 0; --uu2) { const float bta = st[4 * g + uu2]; st[4 * g + uu2] = bta * run; run *= om[4 * g + uu2]; }
                            R = R * (G[g] * Go[g]);
                        }
                        carry[qt] = R;
                    }
                    if (!none) {
                        pf[0] = pack8(st, 0); pf[1] = pack8(st, 1);
#pragma unroll
                        for (int dt = 0; dt < 2; ++dt)
#pragma unroll
                            for (int s = 0; s < 2; ++s) ot[dt][qt] = MFMA32(vf[dt][s], pf[s], ot[dt][qt]);
                    }
                }
#pragma unroll
                for (int kk = 0; kk < 4; ++kk) kc[kk] = kn[kk];
                if (__all(carry[0] < SB_EXIT_THR && carry[1] < SB_EXIT_THR)) break;
            }
        }
        float ss[2];
#pragma unroll
        for (int qt = 0; qt < 2; ++qt) {
            float s2 = 0.f;
#pragma unroll
            for (int dt = 0; dt < 2; ++dt)
#pragma unroll
                for (int i = 0; i < 16; ++i) { ot[dt][qt][i] *= linv[qt]; s2 += ot[dt][qt][i] * ot[dt][qt][i]; }
            s2 += __shfl_xor(s2, 32); ss[qt] = s2;
        }
        __syncthreads();
        if (h == 0) { ssq[wid * 64 + r] = ss[0]; ssq[wid * 64 + 32 + r] = ss[1]; }
        __syncthreads();
        const float* gain = isB ? a.gain_b : a.gain_a;
#pragma unroll
        for (int qt = 0; qt < 2; ++qt) {
            float tot = 0.f;
#pragma unroll
            for (int w8 = 0; w8 < 8; ++w8) tot += ssq[w8 * 64 + 32 * qt + r];
            const float rs = rsqrtf(tot * (1.f / 512.f) + RMS_EPS);
            bf16_t* yp = a.y + (size_t)(b * SEQ + q0 + 32 * qt + r) * D_MODEL + (isB ? 512 : 0) + wid * 64;
#pragma unroll
            for (int dt = 0; dt < 2; ++dt)
#pragma unroll
                for (int g = 0; g < 4; ++g) {
                    const int d = 32 * dt + 8 * g + 4 * h; const f32x4 gn = *(const f32x4*)(gain + wid * 64 + d);
                    u32x2 o; o.x = cvt_pk_bf16(ot[dt][qt][4 * g] * rs * gn[0], ot[dt][qt][4 * g + 1] * rs * gn[1]); o.y = cvt_pk_bf16(ot[dt][qt][4 * g + 2] * rs * gn[2], ot[dt][qt][4 * g + 3] * rs * gn[3]);
                    *(u32x2*)(yp + d) = o;
                }
        }
    }
}


#define XB_TMO      128
#define XB_XCNT(j)  (256  + 64 * (j))
#define XB_XSUB(j)  (1280 + 64 * (j))
#define XB_XGEN(j)  (2304 + 64 * (j))
#define XB_TOP      3328
#define XB_TOPGEN   3392
#define XCD_BAR_WORDS 3456
#define XB_SPIN_CAP (1u << 18)
#define LAS __attribute__((address_space(3)))

__device__ __forceinline__ unsigned xb_ld(unsigned* p)              { return __hip_atomic_load(p, __ATOMIC_RELAXED, __HIP_MEMORY_SCOPE_AGENT); }
__device__ __forceinline__ unsigned xb_add(unsigned* p, unsigned v) { return __hip_atomic_fetch_add(p, v, __ATOMIC_RELAXED, __HIP_MEMORY_SCOPE_AGENT); }
__device__ __forceinline__ unsigned xb_xcc_id() { return (unsigned)__builtin_amdgcn_s_getreg((3 << 11) | 20) & 0xFu; }
#define XB_SPIN(cond, bar) do { unsigned _sp = 0; while (cond) { __builtin_amdgcn_s_sleep(1); \
    if ((++_sp & 255u) == 0u) { if (xb_ld(&(bar)[XB_TMO])) break; if (_sp > XB_SPIN_CAP) { atomicAdd(&(bar)[XB_TMO], 1u); break; } } } } while (0)

struct XcdBarrier {
    unsigned* bar; unsigned x;
    volatile LAS unsigned* st;
};

__device__ __forceinline__ XcdBarrier xcd_barrier_post(unsigned* bar, volatile LAS unsigned* st) {
    XcdBarrier b; b.bar = bar; b.x = xb_xcc_id(); b.st = st;
    if (threadIdx.x == 0) (void)xb_add(&bar[XB_XCNT(b.x)], 1u);
    return b;
}
__device__ __forceinline__ void xcd_barrier_complete(unsigned* bar, unsigned x, unsigned& nloc, unsigned& nx) {
    const unsigned G = gridDim.x * gridDim.y * gridDim.z;
    unsigned sum, cnt, mine, sp = 0u;
    for (;;) {
        sum = 0u; cnt = 0u; mine = 0u;
#pragma unroll
        for (unsigned j = 0; j < 16; ++j) { const unsigned c = xb_ld(&bar[XB_XCNT(j)]); sum += c; cnt += (c > 0u) ? 1u : 0u; mine = (j == x) ? c : mine; }
        if (sum == G) break;
        __builtin_amdgcn_s_sleep(1);
        if ((++sp & 255u) == 0u) { if (xb_ld(&bar[XB_TMO])) break; if (sp > XB_SPIN_CAP) { atomicAdd(&bar[XB_TMO], 1u); break; } }
    }
    nloc = mine > 0u ? mine : 1u; nx = cnt > 0u ? cnt : 1u;
}

__device__ __forceinline__ void xcd_barrier(const XcdBarrier& b) {
    asm volatile("s_waitcnt vmcnt(0)" ::: "memory");
    __syncthreads();
    if (threadIdx.x == 0) {
        unsigned* bar = b.bar;
        __builtin_amdgcn_s_waitcnt(0);
        unsigned nloc = b.st[0], nx = b.st[1];
        if (nloc == 0u) { xcd_barrier_complete(bar, b.x, nloc, nx); b.st[0] = nloc; b.st[1] = nx; }
        const unsigned old = xb_add(&bar[XB_XSUB(b.x)], 1u);
        const unsigned gen = old / nloc;
        if (old + 1u == (gen + 1u) * nloc) {
            __builtin_amdgcn_fence(__ATOMIC_RELEASE, "agent");
            asm volatile("s_waitcnt vmcnt(0)" ::: "memory");
            const unsigned og = xb_add(&bar[XB_TOP], 1u);
            const unsigned tg = og / nx;
            if (og + 1u == (tg + 1u) * nx) xb_add(&bar[XB_TOPGEN], 1u);
            else XB_SPIN(xb_ld(&bar[XB_TOPGEN]) == tg, bar);
            __builtin_amdgcn_fence(__ATOMIC_ACQUIRE, "agent");
            xb_add(&bar[XB_XGEN(b.x)], 1u);
            asm volatile("s_waitcnt vmcnt(0)" ::: "memory");
        } else {
            XB_SPIN(xb_ld(&bar[XB_XGEN(b.x)]) == gen, bar);
            __builtin_amdgcn_fence(__ATOMIC_ACQUIRE, "agent");
            asm volatile("s_waitcnt vmcnt(0)" ::: "memory");
        }
    }
    __syncthreads();
}


struct MegaArgs { P0Args p0; P1Args p1; P2Args p2; P3Args p3; P4Args p4; P6Args p6; P7Args p7; P8Args p8; unsigned* bar; };
__global__ __launch_bounds__(NTHR, 2) void k_mega(MegaArgs a) {
    extern __shared__ __attribute__((aligned(16))) char smem[];
    volatile LAS unsigned* xbw = (volatile LAS unsigned*)(smem + LDS_BYTES - 16);
    if (threadIdx.x == 0) { xbw[0] = 0u; xbw[1] = 0u; xbw[2] = 0u; xbw[3] = 0u; }
    __syncthreads();
    XcdBarrier bar = xcd_barrier_post(a.bar, xbw);
    LAS unsigned char* L = (LAS unsigned char*)smem;
    phase_prologue(a.p0, smem);     xcd_barrier(bar);
    phase_qkv(a.p1, L);             xcd_barrier(bar);
    phase_attn(a.p2, a.p0, smem);   xcd_barrier(bar);
    phase_outproj(a.p3, L);         xcd_barrier(bar);
    phase_router(a.p4, a.p0, smem); xcd_barrier(bar);
    phase_moe_gu(a.p6, smem, L);    xcd_barrier(bar);
    phase_moe_down(a.p7, smem, L);  xcd_barrier(bar);
    phase_combine(a.p8, smem);
}

extern "C" void kernel_launch(void* const* d_in, const int* in_sizes, int n_in, void* d_out, int out_size, void* d_ws, size_t ws_size, hipStream_t stream) {
    const float* x = (const float*)d_in[0];      const float* w_in = (const float*)d_in[1];   const float* rel_bias = (const float*)d_in[2];
    const float* gain_a = (const float*)d_in[3]; const float* gain_b = (const float*)d_in[4]; const float* w_out = (const float*)d_in[5];
    const float* ln1_g = (const float*)d_in[6];  const float* ln1_b = (const float*)d_in[7];  const float* router_w = (const float*)d_in[8];
    const float* router_bias = (const float*)d_in[9]; const float* w_gate = (const float*)d_in[10]; const float* w_up = (const float*)d_in[11];
    const float* w_down = (const float*)d_in[12]; const float* ws_gate = (const float*)d_in[13]; const float* ws_up = (const float*)d_in[14];
    const float* ws_down = (const float*)d_in[15]; const float* ln2_g = (const float*)d_in[16]; const float* ln2_b = (const float*)d_in[17];
    char* ws = (char*)d_ws; float* out = (float*)d_out;
    int* ctrl = (int*)(ws + OFF_CTRL); int* counts = ctrl + CW_COUNTS;
    bf16_t* X1 = (bf16_t*)(ws + OFF_X1); int* tokl = (int*)(ws + OFF_TOKL); float* gatel = (float*)(ws + OFF_GATEL);
    int* eidx = (int*)(ws + OFF_EIDX); float* gate = (float*)(ws + OFF_GATE); int* slot = (int*)(ws + OFF_SLOT);
    unsigned char* H = (unsigned char*)(ws + OFF_H); unsigned char* Y = (unsigned char*)(ws + OFF_Y); unsigned char* x1f8 = (unsigned char*)(ws + OFF_X1F8);
    bf16_t* Q = (bf16_t*)(ws + OFF_Q); bf16_t* Kb = (bf16_t*)(ws + OFF_K); bf16_t* Vt = (bf16_t*)(ws + OFF_VT);
    bf16_t* yatt = (bf16_t*)(ws + OFF_YATT); bf16_t* r = (bf16_t*)(ws + OFF_R);
    bf16_t* xb = (bf16_t*)(ws + OFF_XB); float* stats = (float*)(ws + OFF_STATS);
    bf16_t* wt_in = (bf16_t*)(ws + OFF_WTIN); bf16_t* wt_out = (bf16_t*)(ws + OFF_WTOUT); bf16_t* wt_r = (bf16_t*)(ws + OFF_WTR);
    unsigned char* wgut = (unsigned char*)(ws + OFF_WGUT); unsigned char* wdt = (unsigned char*)(ws + OFF_WDT);
    if (ws_size < WS_NEEDED) { fprintf(stderr, "kernel_launch: workspace too small (%zu < %zu)\n", ws_size, (size_t)WS_NEEDED); return; }
    hipMemsetAsync(ctrl, 0, 128 * 1024, stream);
    static bool attr_done = false;
    if (!attr_done) {
        hipFuncSetAttribute((const void*)k_mega, hipFuncAttributeMaxDynamicSharedMemorySize, LDS_BYTES);
        attr_done = true;
    }
    MegaArgs m{};
    m.p0 = P0Args{x, w_in, w_out, router_w, xb, wt_in, wt_out, wt_r, w_gate, w_up, w_down, ws_gate, ws_up, ws_down, wgut, wdt};
    m.p1 = P1Args{xb, wt_in, Q, Kb, Vt};
    m.p2 = P2Args{Q, Kb, Vt, rel_bias, gain_a, gain_b, yatt};
    m.p3 = P3Args{yatt, wt_out, xb, r, stats};
    m.p4 = P4Args{r, stats, ln1_g, ln1_b, X1, x1f8, wt_r, router_bias, eidx, gate, counts, tokl, gatel, slot};
    m.p6 = P6Args{x1f8, counts, tokl, gatel, wgut, H};
    m.p7 = P7Args{H, counts, wdt, Y};
    m.p8 = P8Args{X1, Y, slot, counts, ln2_g, ln2_b, out};
    m.bar = (unsigned*)ctrl;
    k_mega<<<GRID, NTHR, LDS_BYTES, stream>>>(m);
}
```

```cpp
#include <hip/hip_runtime.h>
#include <cstdint>
#include <cstdio>

typedef unsigned short bf16_t;

constexpr int D_MODEL = 1024, BATCH = 16, SEQ = 2048, T_TOK = BATCH * SEQ;
constexpr int HEAD_DIM = 64, NHA = 8, NHB = 8, NHH = 16;
constexpr int CHUNK = 64, LEFT_CHUNKS = 8, MAX_REL = 128;
constexpr int N_EXP = 256, TOP_K = 8, N_GROUPS = 8, TOPK_GROUPS = 4, EPG = 32, D_EXP = 256;
constexpr float ROUTED_SCALE = 2.5f, LN_EPS = 1e-5f, RMS_EPS = 1e-6f;
constexpr float DN_ALPHA = 1.189207115002721f;
constexpr float LOG2E = 1.4426950408889634f, LN2 = 0.6931471805599453f;
constexpr float QSCALE = 0.125f * LOG2E;
constexpr float WSCALE = 64.f, XSCALE = 16.f, HSCALE = 16.f;
constexpr float YSCALE = 64.f;
constexpr int CAP = T_TOK;
constexpr int ROWS_ALL = T_TOK * TOP_K + T_TOK;

__device__ __forceinline__ float bf2f(bf16_t v) { return __uint_as_float(((unsigned)v) << 16); }
__device__ __forceinline__ bf16_t f2bf(float f) { unsigned u = __float_as_uint(f); u += 0x7fffu + ((u >> 16) & 1u); return (bf16_t)(u >> 16); }

constexpr size_t MB = 1024ull * 1024ull;
constexpr size_t OFF_CTRL   = 0;
constexpr size_t OFF_X1     = 1 * MB;
constexpr size_t OFF_TOKL   = OFF_X1 + 64 * MB;
constexpr size_t OFF_GATEL  = OFF_TOKL + 32 * MB;
constexpr size_t OFF_EIDX   = OFF_GATEL + 32 * MB;
constexpr size_t OFF_GATE   = OFF_EIDX + 1 * MB;
constexpr size_t OFF_SLOT   = OFF_GATE + 1 * MB;
constexpr size_t OFF_WDT    = OFF_SLOT + 1 * MB;
constexpr size_t OFF_X1F8   = OFF_WDT + 72 * MB;
constexpr size_t OFF_BIG    = OFF_WDT + 129 * MB;
constexpr size_t OFF_H      = OFF_BIG;
constexpr size_t OFF_Y      = OFF_BIG + 144 * MB;
constexpr size_t OFF_Q      = OFF_BIG;
constexpr size_t OFF_K      = OFF_BIG + 64 * MB;
constexpr size_t OFF_VT     = OFF_BIG + 128 * MB;
constexpr size_t OFF_YATT   = OFF_BIG + 192 * MB;
constexpr size_t OFF_R      = OFF_BIG + 256 * MB;
constexpr size_t OFF_XB     = OFF_BIG + 320 * MB;
constexpr size_t OFF_STATS  = OFF_BIG + 384 * MB;
constexpr size_t OFF_WTIN   = OFF_BIG + 392 * MB;
constexpr size_t OFF_WTOUT  = OFF_BIG + 398 * MB;
constexpr size_t OFF_WTR    = OFF_BIG + 400 * MB;
constexpr size_t OFF_WGUT   = OFF_BIG + 401 * MB;
constexpr size_t WS_NEEDED  = OFF_BIG + 720 * MB;
static_assert(OFF_WGUT + 257 * MB <= WS_NEEDED && WS_NEEDED <= 1024 * MB, "workspace map");
constexpr int CW_COUNTS = 8192;
constexpr int CSTR = 64;

typedef short bf16x8 __attribute__((ext_vector_type(8)));
typedef float f32x4 __attribute__((ext_vector_type(4)));
typedef float f32x2 __attribute__((ext_vector_type(2)));
typedef float f32x16 __attribute__((ext_vector_type(16)));
typedef unsigned u32x4 __attribute__((ext_vector_type(4)));
typedef unsigned u32x2 __attribute__((ext_vector_type(2)));
#define DI __device__ __forceinline__
constexpr int NTHR = 512, GRID = 256;
DI int tidx() { int t = threadIdx.x; asm volatile("" : "+v"(t)); return t; }
constexpr int LDS_BYTES = 160 * 1024;

typedef __bf16 bf16x2_t __attribute__((ext_vector_type(2)));
DI unsigned cvt_pk_bf16(float lo, float hi) { f32x2 v = {lo, hi}; bf16x2_t r = __builtin_convertvector(v, bf16x2_t); return __builtin_bit_cast(unsigned, r); }
DI float clamp8(float v) { return __builtin_amdgcn_fmed3f(v, -440.f, 440.f); }
DI unsigned pack_fp8x4(float a, float b, float c, float d) { int w = 0; w = __builtin_amdgcn_cvt_pk_fp8_f32(clamp8(a), clamp8(b), w, false); w = __builtin_amdgcn_cvt_pk_fp8_f32(clamp8(c), clamp8(d), w, true); return (unsigned)w; }
DI int vblock() { return (int)((blockIdx.x & 7) * (GRID / 8) + (blockIdx.x >> 3)); }

template <int MT> struct Tile { static constexpr int BM = 32 * MT, A_BYTES = BM * 128, B_BYTES = 256 * 128, STAGE = A_BYTES + B_BYTES; };

template <int MT> struct ALoader {
    const bf16_t* p[MT / 2]; u32x4 v[MT / 2]; int off0;
    DI void init_rows(const bf16_t* A, int lda, int row0) {
        const int tid = tidx(), kc = tid & 7, r = tid >> 3;
#pragma unroll
        for (int i = 0; i < MT / 2; ++i) p[i] = A + (size_t)(row0 + r + 64 * i) * lda + kc * 8;
        off0 = r * 128 + ((kc ^ ((r >> 1) & 7)) << 4);
    }
    DI void init_gather(const bf16_t* A, int lda, const int* rows, int cnt, int m0) {
        const int tid = tidx(), kc = tid & 7, r = tid >> 3;
#pragma unroll
        for (int i = 0; i < MT / 2; ++i) { int rr = m0 + r + 64 * i; rr = rr < cnt ? rr : cnt - 1; const int g = rows ? rows[rr] : rr; p[i] = A + (size_t)g * lda + kc * 8; }
        off0 = r * 128 + ((kc ^ ((r >> 1) & 7)) << 4);
    }
    DI void load(int k0) {
#pragma unroll
        for (int i = 0; i < MT / 2; ++i) v[i] = *(const u32x4*)(p[i] + k0);
    }
    DI void store(char* ldsA) const {
#pragma unroll
        for (int i = 0; i < MT / 2; ++i) *(u32x4*)(ldsA + off0 + i * 8192) = v[i];
    }
};
struct BLoaderBt {
    const bf16_t* p[4]; u32x4 v[4]; int off0;
    DI void init(const bf16_t* Bt, int ldk, int n0) {
        const int tid = tidx(), kc = tid & 7, r = tid >> 3;
#pragma unroll
        for (int i = 0; i < 4; ++i) p[i] = Bt + (size_t)(n0 + r + 64 * i) * ldk + kc * 8;
        off0 = r * 128 + ((kc ^ ((r >> 1) & 7)) << 4);
    }
    DI void load(int k0) {
#pragma unroll
        for (int i = 0; i < 4; ++i) v[i] = *(const u32x4*)(p[i] + k0);
    }
    DI void store(char* ldsB) const {
#pragma unroll
        for (int i = 0; i < 4; ++i) *(u32x4*)(ldsB + off0 + i * 8192) = v[i];
    }
};
template <bool GU> struct BLoaderF32 {
    const float* p[2]; int ldb; f32x2 v[2][8]; int off[2][2];
    DI void init(const float* P0, const float* P1, int ldb_) {
        const int tid = tidx(), l = tid & 63, w = tid >> 6; ldb = ldb_;
        p[0] = P0 + (size_t)(8 * w) * ldb + 2 * l; p[1] = P1 + (size_t)(8 * w) * ldb + 2 * l;
#pragma unroll
        for (int jp = 0; jp < 2; ++jp)
#pragma unroll
            for (int jj = 0; jj < 2; ++jj) { const int c = 2 * l + jj; const int row = GU ? (64 * (c >> 5) + 32 * jp + (c & 31)) : (128 * jp + c); off[jp][jj] = row * 128 + ((w ^ ((row >> 1) & 7)) << 4); }
    }
    DI void load(int k0) {
#pragma unroll
        for (int jp = 0; jp < 2; ++jp)
#pragma unroll
            for (int kk = 0; kk < 8; ++kk) v[jp][kk] = *(const f32x2*)(p[jp] + (size_t)(k0 + kk) * ldb);
    }
    DI void store(char* ldsB) const {
#pragma unroll
        for (int jp = 0; jp < 2; ++jp) {
            u32x4 a, b;
            a.x = cvt_pk_bf16(v[jp][0].x, v[jp][1].x); a.y = cvt_pk_bf16(v[jp][2].x, v[jp][3].x); a.z = cvt_pk_bf16(v[jp][4].x, v[jp][5].x); a.w = cvt_pk_bf16(v[jp][6].x, v[jp][7].x);
            b.x = cvt_pk_bf16(v[jp][0].y, v[jp][1].y); b.y = cvt_pk_bf16(v[jp][2].y, v[jp][3].y); b.z = cvt_pk_bf16(v[jp][4].y, v[jp][5].y); b.w = cvt_pk_bf16(v[jp][6].y, v[jp][7].y);
            *(u32x4*)(ldsB + off[jp][0]) = a; *(u32x4*)(ldsB + off[jp][1]) = b;
        }
    }
};

template <int MT, bool TR, class AL, class BL>
DI void gemm_tile(char* lds, AL& al, BL& bl, int nk, f32x4 (&acc)[MT][4]) {
    typedef Tile<MT> TT;
    const int tid = tidx(), wid = tid >> 6, lane = tid & 63, wr = wid >> 2, wc = wid & 3, fr = lane & 15, fq = lane >> 4;
#pragma unroll
    for (int m = 0; m < MT; ++m)
#pragma unroll
        for (int n = 0; n < 4; ++n) acc[m][n] = (f32x4){0.f, 0.f, 0.f, 0.f};
    int aoff[2], boff[2];
#pragma unroll
    for (int ks = 0; ks < 2; ++ks) { const int ch = (((4 * ks + fq) ^ (fr >> 1)) << 4); aoff[ks] = (16 * MT * wr + fr) * 128 + ch; boff[ks] = TT::A_BYTES + (64 * wc + fr) * 128 + ch; }
    al.load(0); bl.load(0);
    __syncthreads();
    al.store(lds); bl.store(lds + TT::A_BYTES);
    __syncthreads();
    for (int kt = 0; kt < nk; ++kt) {
        char* cur = lds + (kt & 1) * TT::STAGE; char* nxt = lds + ((kt & 1) ^ 1) * TT::STAGE;
        const bool more = kt + 1 < nk;
        if (more) { al.load((kt + 1) * 64); bl.load((kt + 1) * 64); }
#pragma unroll
        for (int ks = 0; ks < 2; ++ks) {
            bf16x8 a[MT], b[4];
#pragma unroll
            for (int m = 0; m < MT; ++m) a[m] = *(const bf16x8*)(cur + aoff[ks] + m * 2048);
#pragma unroll
            for (int n = 0; n < 4; ++n) b[n] = *(const bf16x8*)(cur + boff[ks] + n * 2048);
#pragma unroll
            for (int m = 0; m < MT; ++m)
#pragma unroll
                for (int n = 0; n < 4; ++n)
                    acc[m][n] = TR ? __builtin_amdgcn_mfma_f32_16x16x32_bf16(b[n], a[m], acc[m][n], 0, 0, 0) : __builtin_amdgcn_mfma_f32_16x16x32_bf16(a[m], b[n], acc[m][n], 0, 0, 0);
        }
        if (more) { al.store(nxt); bl.store(nxt + TT::A_BYTES); }
        __syncthreads();
    }
}

#define LAS __attribute__((address_space(3)))
namespace gs {
constexpr int BM = 256, BK = 64, HALF = 128, HTB = HALF * BK * 2, STAGE_BYTES = 8 * HTB;
DI int lds_byte(int r, int c) { const int st = (r >> 4) * 2 + (c >> 5), rr = r & 15, cc = c & 31, ob = rr * 64 + cc * 2; return st * 1024 + (ob ^ (((ob >> 9) & 1) << 5)); }
DI void stage_rc(int b, int& R, int& C) { const int st = b / 1024, sb = b % 1024, swz = sb ^ (((sb >> 9) & 1) << 5); R = (st >> 1) * 16 + swz / 64; C = (st & 1) * 32 + (swz % 64) / 2; }
DI int perm32(int rho) { const int n = rho >> 4, i = rho & 15; return 8 * (i >> 2) + 4 * n + (i & 3); }
typedef long i64x2 __attribute__((ext_vector_type(2)));
DI const char* uni(const char* p) { const unsigned long long v = (unsigned long long)p; const unsigned lo = __builtin_amdgcn_readfirstlane((unsigned)v), hi = __builtin_amdgcn_readfirstlane((unsigned)(v >> 32)); return (const char*)(((unsigned long long)hi << 32) | lo); }
template <bool TR, bool F8>
DI f32x4 mma16(const bf16x8& a, const bf16x8& b, f32x4 c) {
    if (F8) {
        const i64x2 a2 = __builtin_bit_cast(i64x2, a), b2 = __builtin_bit_cast(i64x2, b);
        c = TR ? __builtin_amdgcn_mfma_f32_16x16x32_fp8_fp8(b2[0], a2[0], c, 0, 0, 0) : __builtin_amdgcn_mfma_f32_16x16x32_fp8_fp8(a2[0], b2[0], c, 0, 0, 0);
        return TR ? __builtin_amdgcn_mfma_f32_16x16x32_fp8_fp8(b2[1], a2[1], c, 0, 0, 0) : __builtin_amdgcn_mfma_f32_16x16x32_fp8_fp8(a2[1], b2[1], c, 0, 0, 0);
    }
    return TR ? __builtin_amdgcn_mfma_f32_16x16x32_bf16(b, a, c, 0, 0, 0) : __builtin_amdgcn_mfma_f32_16x16x32_bf16(a, b, c, 0, 0, 0);
}
typedef int i32x8 __attribute__((ext_vector_type(8)));
typedef short bf16x16 __attribute__((ext_vector_type(16)));
template <bool TR>
DI f32x4 mma128(const bf16x16& a, const bf16x16& b, f32x4 c) {
    const i32x8 av = __builtin_bit_cast(i32x8, a), bv = __builtin_bit_cast(i32x8, b);
    return TR ? __builtin_amdgcn_mfma_scale_f32_16x16x128_f8f6f4(bv, av, c, 0, 0, 0, 0x7F7F7F7F, 0, 0x7F7F7F7F) : __builtin_amdgcn_mfma_scale_f32_16x16x128_f8f6f4(av, bv, c, 0, 0, 0, 0x7F7F7F7F, 0, 0x7F7F7F7F);
}
DI bf16x8 frag_lo(const bf16x16& v) { return __builtin_shufflevector(v, v, 0, 1, 2, 3, 4, 5, 6, 7); }
DI bf16x8 frag_hi(const bf16x16& v) { return __builtin_shufflevector(v, v, 8, 9, 10, 11, 12, 13, 14, 15); }
template <bool TR, bool PERM, int F8, class Sched, class Epi>
DI void gemm_stream(LAS unsigned char* lds, const int K, const Sched& S, const Epi& E) {
    typedef typename Sched::U U;
    const int tid = tidx(), wid = __builtin_amdgcn_readfirstlane(tid >> 6), lane = tid & 63, wr = wid >> 2, wc = wid & 3, fr = lane & 15, fq = lane >> 4;
    const int nt = K / BK;
    int R[2], C[2]; unsigned voffB[2];
#pragma unroll
    for (int i = 0; i < 2; ++i) { stage_rc(tid * 16 + i * 8192, R[i], C[i]); const int Rb = PERM ? ((R[i] & ~31) + perm32(R[i] & 31)) : R[i]; voffB[i] = (unsigned)(Rb * K + C[i]) * 2u; }
    const size_t kstep = (size_t)(BK * 2), hstepB = (size_t)HALF * K * 2;
    const unsigned ldsw = (unsigned)wid * 1024u;
    const int aoff = lds_byte(wr * 64 + fr, fq * 8), boff = lds_byte(wc * 32 + fr, fq * 8);
#define GS_SA(b, h) (((b) * 2 + (h)) * HTB)
#define GS_SB(b, h) ((4 + (b) * 2 + (h)) * HTB)
#define GS_STAGE(bufoff, gbase, uix, h) do { _Pragma("unroll") for (int _i = 0; _i < 2; ++_i) \
        __builtin_amdgcn_global_load_lds((const unsigned*)((const char*)(gbase) + S.a_voff(uix, h, R[_i], C[_i])), (LAS unsigned*)(lds + (bufoff) + ldsw + _i * 8192), 16, 0, 0); } while (0)
#define GS_STAGEB(bufoff, gbase, voff) do { _Pragma("unroll") for (int _i = 0; _i < 2; ++_i) \
        __builtin_amdgcn_global_load_lds((const unsigned*)((const char*)(gbase) + (voff)[_i]), (LAS unsigned*)(lds + (bufoff) + ldsw + _i * 8192), 16, 0, 0); } while (0)
#define GS_LD32(base) __builtin_shufflevector(*(const LAS bf16x8*)(base), *(const LAS bf16x8*)((base) + 1024), 0, 1, 2, 3, 4, 5, 6, 7, 8, 9, 10, 11, 12, 13, 14, 15)
#define GS_LDA(dst, b, h) do { _Pragma("unroll") for (int m = 0; m < 4; ++m) dst[m] = GS_LD32(lds + GS_SA(b, h) + aoff + m * 2048); } while (0)
#define GS_LDB(dst, b, h) do { _Pragma("unroll") for (int n = 0; n < 2; ++n) dst[n] = GS_LD32(lds + GS_SB(b, h) + boff + n * 2048); } while (0)
#define GS_MMA(ai, bj, At, Bt) do { __builtin_amdgcn_s_setprio(1); _Pragma("unroll") for (int m = 0; m < 4; ++m) _Pragma("unroll") for (int n = 0; n < 2; ++n) { \
        if (F8 == 2) acc[ai][bj][m][n] = mma128<TR>(At[m], Bt[n], acc[ai][bj][m][n]); \
        else { acc[ai][bj][m][n] = mma16<TR, F8 == 1>(frag_lo(At[m]), frag_lo(Bt[n]), acc[ai][bj][m][n]); acc[ai][bj][m][n] = mma16<TR, F8 == 1>(frag_hi(At[m]), frag_hi(Bt[n]), acc[ai][bj][m][n]); } } \
        __builtin_amdgcn_s_setprio(0); } while (0)
#define GS_WAIT_V(n) asm volatile("s_waitcnt vmcnt(" #n ")" ::: "memory")
#define GS_WAIT_L(n) asm volatile("s_waitcnt lgkmcnt(" #n ")" ::: "memory")
#define GS_BAR __builtin_amdgcn_s_barrier()
#define GS_SCHED __builtin_amdgcn_sched_barrier(0)
    U cur, nxt; int ui = 0;
    if (!S.next(0, cur)) return;
    f32x4 acc[2][2][4][2];
#pragma unroll
    for (int a = 0; a < 2; ++a)
#pragma unroll
        for (int b = 0; b < 2; ++b)
#pragma unroll
            for (int m = 0; m < 4; ++m)
#pragma unroll
                for (int n = 0; n < 2; ++n) acc[a][b][m][n] = (f32x4){0.f, 0.f, 0.f, 0.f};
    bf16x16 At[4], B0[2], B1[2];
    const char* cA = uni(cur.A); const char* cB = uni(cur.B);
    GS_STAGEB(GS_SB(0, 0), cB, voffB); GS_STAGEB(GS_SB(0, 1), cB + hstepB, voffB); GS_STAGE(GS_SA(0, 0), cA, 0, 0); GS_STAGE(GS_SA(0, 1), cA, 0, 1);
    if (wr == 1) GS_BAR;
    GS_WAIT_V(2); GS_BAR;
    GS_STAGEB(GS_SB(1, 0), cB + kstep, voffB); GS_STAGE(GS_SA(1, 0), cA + kstep, 0, 0); GS_STAGEB(GS_SB(1, 1), cB + hstepB + kstep, voffB);
    GS_WAIT_V(6); GS_BAR;
    for (;;) {
        const bool has_next = S.next(ui + 1, nxt);
        const int nui = has_next ? ui + 1 : ui;
        const char* nA = uni(has_next ? nxt.A : cA); const char* nB = uni(has_next ? nxt.B : cB);
#pragma unroll 1
        for (int t = 0; t < nt; t += 2) {
            const bool last = (t == nt - 2);
            const char* a1 = uni(cA + (size_t)(t + 1) * kstep);
            const char* a2 = uni(last ? nA : cA + (size_t)(t + 2) * kstep); const char* b2 = uni(last ? nB : cB + (size_t)(t + 2) * kstep);
            const char* a3 = uni(a2 + kstep); const char* b3 = uni(b2 + kstep);
            const int u2 = last ? nui : ui;
            GS_LDB(B0, 0, 0); GS_LDB(B1, 0, 1); GS_SCHED; GS_LDA(At, 0, 0); GS_STAGE(GS_SA(1, 1), a1, ui, 1);
            GS_WAIT_V(8); GS_WAIT_L(0); GS_BAR; GS_MMA(0, 0, At, B0); GS_MMA(0, 1, At, B1); GS_BAR; GS_SCHED;
            GS_LDA(At, 0, 1); GS_STAGEB(GS_SB(0, 0), b2, voffB); GS_STAGEB(GS_SB(0, 1), b2 + hstepB, voffB); GS_STAGE(GS_SA(0, 0), a2, u2, 0);
            GS_WAIT_V(8); GS_WAIT_L(0); GS_BAR; GS_MMA(1, 0, At, B0); GS_MMA(1, 1, At, B1); GS_BAR; GS_SCHED;
            GS_LDB(B0, 1, 0); GS_LDB(B1, 1, 1); GS_SCHED; GS_LDA(At, 1, 0); GS_STAGE(GS_SA(0, 1), a2, u2, 1);
            GS_WAIT_V(8); GS_WAIT_L(0); GS_BAR; GS_MMA(0, 0, At, B0); GS_MMA(0, 1, At, B1); GS_BAR; GS_SCHED;
            GS_LDA(At, 1, 1); GS_STAGEB(GS_SB(1, 0), b3, voffB); GS_STAGEB(GS_SB(1, 1), b3 + hstepB, voffB); GS_STAGE(GS_SA(1, 0), a3, u2, 0);
            GS_WAIT_V(8); GS_WAIT_L(0); GS_BAR; GS_MMA(1, 0, At, B0); GS_MMA(1, 1, At, B1); GS_BAR; GS_SCHED;
        }
        if (wr == 0) GS_BAR;
        E(acc, cur, wr, wc, fr, fq);
        if (!has_next) break;
#pragma unroll
        for (int a = 0; a < 2; ++a)
#pragma unroll
            for (int b = 0; b < 2; ++b)
#pragma unroll
                for (int m = 0; m < 4; ++m)
#pragma unroll
                    for (int n = 0; n < 2; ++n) acc[a][b][m][n] = (f32x4){0.f, 0.f, 0.f, 0.f};
        cur = nxt; cA = nA; cB = nB; ++ui;
        if (wr == 1) GS_BAR;
    }
    GS_WAIT_V(0);
    GS_BAR;
#undef GS_SA
#undef GS_SB
#undef GS_STAGE
#undef GS_STAGEB
#undef GS_LDA
#undef GS_LD32
#undef GS_LDB
#undef GS_MMA
#undef GS_WAIT_V
#undef GS_WAIT_L
#undef GS_BAR
#undef GS_SCHED
}
struct DenseU { const char* A; const char* B; int pm, pn; };
struct DenseSched {
    typedef DenseU U;
    const bf16_t* A; const bf16_t* Bt; int K, nunits, first, stride, npn, pn_base, pn_mod0, pn_mod1;
    DI int colmap(int q) const { return pn_base + (q / pn_mod0) * pn_mod1 + (q % pn_mod0); }
    DI bool next(int i, U& u) const {
        const int L = first + i * stride; if (L >= nunits) return false;
        u.pm = L / npn; u.pn = colmap(L % npn);
        u.A = (const char*)A + (size_t)u.pm * BM * K * 2; u.B = (const char*)Bt + (size_t)u.pn * BM * K * 2; return true;
    }
    DI unsigned a_voff(int, int h, int R, int C) const { return (unsigned)((HALF * h + R) * K + C) * 2u; }
};
}

DI void transpose_cvt(const float* W, bf16_t* Wt, int K, int N, int unit, char* lds) {
    float* tile = (float*)lds;
    const int nbn = N / 64, kb = unit / nbn, nb = unit % nbn, tid = tidx();
    __syncthreads();
#pragma unroll
    for (int i = 0; i < 8; ++i) { const int idx = tid + i * 512, r = idx >> 6, c = idx & 63; tile[r * 65 + c] = W[(size_t)(kb * 64 + r) * N + nb * 64 + c]; }
    __syncthreads();
#pragma unroll
    for (int i = 0; i < 8; ++i) { const int idx = tid + i * 512, n = idx >> 6, k = idx & 63; Wt[(size_t)(nb * 64 + n) * K + kb * 64 + k] = f2bf(tile[k * 65 + n]); }
}
struct P0Args { const float* x; const float* w_in; const float* w_out; const float* router_w; bf16_t* xb; bf16_t* wt_in; bf16_t* wt_out; bf16_t* wt_r;
                const float* w_gate; const float* w_up; const float* w_down; const float* ws_gate; const float* ws_up; const float* ws_down; unsigned char* wgut; unsigned char* wdt; };
constexpr int CV_GU = 257 * 2 * 16, CV_DN = 257 * 16;
struct CvItem { const float* src; unsigned char* dst; int ld, ldd, rbase, rhi; };
DI CvItem cv_item(const P0Args& a, int it) {
    CvItem c;
    if (it < CV_GU) {
        const int e = it / 32, u = (it >> 4) & 1, kt = it & 15;
        const float* W = e < N_EXP ? (u ? a.w_up : a.w_gate) + (size_t)e * D_MODEL * D_EXP : (u ? a.ws_up : a.ws_gate);
        c.src = W + (size_t)kt * 64 * D_EXP; c.ld = D_EXP; c.dst = a.wgut + (size_t)e * 512 * D_MODEL + kt * 64; c.ldd = D_MODEL; c.rbase = 128 * u; c.rhi = 256;
    } else {
        const int j = it - CV_GU, e = j / 16, kt = (j >> 2) & 3, nb = j & 3;
        const float* W = e < N_EXP ? a.w_down + (size_t)e * D_EXP * D_MODEL : a.ws_down;
        c.src = W + (size_t)kt * 64 * D_MODEL + nb * 256; c.ld = D_MODEL; c.dst = a.wdt + (size_t)e * D_MODEL * D_EXP + kt * 64; c.ldd = D_EXP; c.rbase = 256 * nb; c.rhi = 128;
    }
    return c;
}
DI void cv_load(const CvItem& c, f32x4 (&v)[8]) {
    const int tid = tidx();
#pragma unroll
    for (int i = 0; i < 8; ++i) { const int idx = tid + i * 512, k = idx >> 6, n4 = idx & 63; v[i] = __builtin_nontemporal_load((const f32x4*)(c.src + (size_t)k * c.ld + 4 * n4)); }
}
DI void cv_store(const CvItem& c, const f32x4 (&v)[8], char* lds) {
    float* tile = (float*)lds;
    const int tid = tidx();
    __syncthreads();
#pragma unroll
    for (int i = 0; i < 8; ++i) { const int idx = tid + i * 512, k = idx >> 6, n4 = idx & 63; *(f32x4*)(tile + k * 260 + 4 * (n4 ^ ((k >> 3) & 7))) = v[i]; }
    __syncthreads();
#pragma unroll
    for (int i = 0; i < 4; ++i) {
        const int idx = tid + i * 512, kc = idx & 7, n = idx >> 3; const float* p = tile + (8 * kc) * 260 + (n ^ (4 * kc));
        const unsigned w0 = pack_fp8x4(p[0] * WSCALE, p[260] * WSCALE, p[2 * 260] * WSCALE, p[3 * 260] * WSCALE), w1 = pack_fp8x4(p[4 * 260] * WSCALE, p[5 * 260] * WSCALE, p[6 * 260] * WSCALE, p[7 * 260] * WSCALE);
        __builtin_nontemporal_store((u32x2){w0, w1}, (u32x2*)(c.dst + (size_t)(c.rbase + (n >> 7) * c.rhi + (n & 127)) * c.ldd + 8 * kc));
    }
}
DI void convert_moe_range(const P0Args& a, char* lds, const int lo, const int hi) {
    int it = lo + vblock(); if (it >= hi) return;
    CvItem c = cv_item(a, it); f32x4 v[8]; cv_load(c, v);
#pragma unroll 1
    for (;;) {
        const int nit = it + GRID; const bool more = nit < hi;
        CvItem cn = c; f32x4 w[8];
        if (more) { cn = cv_item(a, nit); cv_load(cn, w); }
        cv_store(c, v, lds);
        if (!more) break;
        it = nit; c = cn;
#pragma unroll
        for (int i = 0; i < 8; ++i) v[i] = w[i];
    }
}
DI void phase_prologue(const P0Args& a, char* lds) {
    const int vb = vblock();
    for (size_t i = (size_t)vb * NTHR + tidx(); i < (size_t)T_TOK * D_MODEL / 8; i += (size_t)GRID * NTHR) {
        const f32x4 v0 = *(const f32x4*)(a.x + i * 8), v1 = *(const f32x4*)(a.x + i * 8 + 4);
        u32x4 o; o.x = cvt_pk_bf16(v0[0], v0[1]); o.y = cvt_pk_bf16(v0[2], v0[3]); o.z = cvt_pk_bf16(v1[0], v1[1]); o.w = cvt_pk_bf16(v1[2], v1[3]);
        *(u32x4*)(a.xb + i * 8) = o;
    }
    const int n_in = (1024 / 64) * (3072 / 64), n_out = 16 * 16, n_r = 16 * 4;
    for (int u = vb; u < n_in + n_out + n_r; u += GRID) {
        if (u < n_in) transpose_cvt(a.w_in, a.wt_in, 1024, 3072, u, lds);
        else if (u < n_in + n_out) transpose_cvt(a.w_out, a.wt_out, 1024, 1024, u - n_in, lds);
        else transpose_cvt(a.router_w, a.wt_r, 1024, 256, u - n_in - n_out, lds);
    }
}


struct P1Args { const bf16_t* xb; const bf16_t* wt_in; bf16_t* Q; bf16_t* Kb; bf16_t* Vt; };
struct EpiQK { bf16_t* Q; bf16_t* Kb;
    DI void operator()(const f32x4 (&acc)[2][2][4][2], const gs::DenseU& u, int wr, int wc, int fr, int fq) const {
        const int seg = u.pn >> 1, type = seg % 3, grp = seg / 3; bf16_t* dst = type == 0 ? Q : Kb; const float sc = type == 0 ? QSCALE : 1.f;
#pragma unroll
        for (int ai = 0; ai < 2; ++ai)
#pragma unroll
            for (int m = 0; m < 4; ++m) {
                const int row = u.pm * 256 + 128 * ai + 64 * wr + 16 * m + fr, b = row / SEQ, s = row % SEQ;
#pragma unroll
                for (int bj = 0; bj < 2; ++bj) {
                    const int hh = grp * 8 + 4 * (u.pn & 1) + 2 * bj + (wc >> 1), d0 = 32 * (wc & 1) + 8 * fq;
                    const f32x4 v0 = acc[ai][bj][m][0] * sc, v1 = acc[ai][bj][m][1] * sc;
                    u32x4 o; o.x = cvt_pk_bf16(v0[0], v0[1]); o.y = cvt_pk_bf16(v0[2], v0[3]); o.z = cvt_pk_bf16(v1[0], v1[1]); o.w = cvt_pk_bf16(v1[2], v1[3]);
                    *(u32x4*)(dst + (size_t)(b * NHH + hh) * SEQ * 64 + (s >> 5) * 2048 + ((d0 >> 3) * 32 + (s & 31)) * 8) = o;
                }
            }
    } };
struct EpiV { bf16_t* Vt;
    DI void operator()(const f32x4 (&acc)[2][2][4][2], const gs::DenseU& u, int wr, int wc, int fr, int fq) const {
        const int grp = (u.pn >> 1) / 3;
#pragma unroll
        for (int ai = 0; ai < 2; ++ai)
#pragma unroll
            for (int m = 0; m < 4; ++m) {
                const int row = u.pm * 256 + 128 * ai + 64 * wr + 16 * m + 4 * fq, b = row / SEQ, s = row % SEQ;
#pragma unroll
                for (int bj = 0; bj < 2; ++bj)
#pragma unroll
                    for (int n = 0; n < 2; ++n) {
                        const int hh = grp * 8 + 4 * (u.pn & 1) + 2 * bj + (wc >> 1), d = 32 * (wc & 1) + 16 * n + fr;
                        const f32x4 v = acc[ai][bj][m][n];
                        u32x2 o; o.x = cvt_pk_bf16(v[0], v[1]); o.y = cvt_pk_bf16(v[2], v[3]);
                        { const int kap = s & 31; *(u32x2*)(Vt + (size_t)(b * NHH + hh) * SEQ * 64 + (s >> 5) * 2048 + ((((d >> 5) * 2 + (kap >> 4)) * 2 + ((kap >> 2) & 1)) * 32 + (d & 31)) * 8 + ((kap >> 3) & 1) * 4) = o; }
                    }
            }
    } };
DI void phase_qkv(const P1Args& a, LAS unsigned char* lds) {
    { gs::DenseSched S{a.xb, a.wt_in, D_MODEL, (T_TOK / 256) * 8, vblock(), GRID, 8, 0, 4, 6}; EpiQK E{a.Q, a.Kb}; gs::gemm_stream<true, true, 0>(lds, D_MODEL, S, E); }
    { gs::DenseSched S{a.xb, a.wt_in, D_MODEL, (T_TOK / 256) * 4, vblock(), GRID, 4, 4, 2, 6}; EpiV E{a.Vt}; gs::gemm_stream<false, false, 0>(lds, D_MODEL, S, E); }
}

struct P3Args { const bf16_t* y; const bf16_t* wt_out; const bf16_t* xb; bf16_t* r; float* stats; };
struct EpiOut { const bf16_t* xb; bf16_t* r; float* stats;
    DI void operator()(const f32x4 (&acc)[2][2][4][2], const gs::DenseU& u, int wr, int wc, int fr, int fq) const {
#pragma unroll
        for (int ai = 0; ai < 2; ++ai)
#pragma unroll
            for (int m = 0; m < 4; ++m) {
                const int row = u.pm * 256 + 128 * ai + 64 * wr + 16 * m + fr;
#pragma unroll
                for (int bj = 0; bj < 2; ++bj) {
                    const int col = u.pn * 256 + 128 * bj + 32 * wc + 8 * fq;
                    const u32x4 xw = *(const u32x4*)(xb + (size_t)row * D_MODEL + col);
                    const f32x4 x0 = (f32x4){__uint_as_float(xw[0] << 16), __uint_as_float(xw[0] & 0xffff0000u), __uint_as_float(xw[1] << 16), __uint_as_float(xw[1] & 0xffff0000u)};
                    const f32x4 x1 = (f32x4){__uint_as_float(xw[2] << 16), __uint_as_float(xw[2] & 0xffff0000u), __uint_as_float(xw[3] << 16), __uint_as_float(xw[3] & 0xffff0000u)};
                    const f32x4 v0 = x0 * DN_ALPHA + acc[ai][bj][m][0], v1 = x1 * DN_ALPHA + acc[ai][bj][m][1];
                    float s = ((v0[0] + v0[1]) + (v0[2] + v0[3])) + ((v1[0] + v1[1]) + (v1[2] + v1[3]));
                    float q = ((v0[0] * v0[0] + v0[1] * v0[1]) + (v0[2] * v0[2] + v0[3] * v0[3])) + ((v1[0] * v1[0] + v1[1] * v1[1]) + (v1[2] * v1[2] + v1[3] * v1[3]));
                    u32x4 o; o.x = cvt_pk_bf16(v0[0], v0[1]); o.y = cvt_pk_bf16(v0[2], v0[3]); o.z = cvt_pk_bf16(v1[0], v1[1]); o.w = cvt_pk_bf16(v1[2], v1[3]);
                    *(u32x4*)(r + (size_t)row * D_MODEL + col) = o;
                    s += __shfl_xor(s, 16); s += __shfl_xor(s, 32); q += __shfl_xor(q, 16); q += __shfl_xor(q, 32);
                    if (fq == 0) *(f32x2*)(stats + ((size_t)row * 32 + u.pn * 8 + bj * 4 + wc) * 2) = (f32x2){s, q};
                }
            }
    } };
DI void phase_outproj(const P3Args& a, LAS unsigned char* lds) {
    gs::DenseSched S{a.y, a.wt_out, D_MODEL, (T_TOK / 256) * 4, vblock(), GRID, 4, 0, 4, 0}; EpiOut E{a.xb, a.r, a.stats}; gs::gemm_stream<true, true, 0>(lds, D_MODEL, S, E);
}

DI void unpack16(const u32x4& a, const u32x4& b, float (&v)[16]) {
#pragma unroll
    for (int j = 0; j < 4; ++j) { v[2 * j] = __uint_as_float(a[j] << 16); v[2 * j + 1] = __uint_as_float(a[j] & 0xffff0000u); v[8 + 2 * j] = __uint_as_float(b[j] << 16); v[8 + 2 * j + 1] = __uint_as_float(b[j] & 0xffff0000u); }
}
constexpr int RS_SC = 289;
constexpr int LDS_HIST = 100 * 1024;
struct P4Args { const bf16_t* r; const float* stats; const float* ln_g; const float* ln_b; bf16_t* x1; unsigned char* x1f8; const bf16_t* wt_r; const float* rbias;
                int* eidx; float* gate; int* counts; int* tokl; float* gatel; int* slot; };
DI void phase_router(const P4Args& a, const P0Args& cv, char* lds) {
    const int tid = tidx(), wid = tid >> 6, lane = tid & 63, wr = wid >> 2, wc = wid & 3, fr = lane & 15, fq = lane >> 4;
    float* sc = (float*)lds; int* hist = (int*)(lds + LDS_HIST); int* base = hist + 256;
    for (int u = vblock(); u < T_TOK / 128; u += GRID) {
        const int m0 = u * 128;
        if ((vblock() & 1) == 0) convert_moe_range(cv, lds, CV_GU, CV_GU + CV_DN);
        __syncthreads();
#pragma unroll 1
        for (int i0 = 0; i0 < 16; i0 += 4) {
            f32x2 st[4]; u32x4 r0[4], r1[4];
#pragma unroll
            for (int j4 = 0; j4 < 4; ++j4) {
                const int t = m0 + wid * 16 + i0 + j4;
                st[j4] = (f32x2){0.f, 0.f};
                if (lane < 32) st[j4] = *(const f32x2*)(a.stats + ((size_t)t * 32 + lane) * 2);
                r0[j4] = *(const u32x4*)(a.r + (size_t)t * D_MODEL + lane * 16); r1[j4] = *(const u32x4*)(a.r + (size_t)t * D_MODEL + lane * 16 + 8);
            }
#pragma unroll
            for (int j4 = 0; j4 < 4; ++j4) {
                const int t = m0 + wid * 16 + i0 + j4;
                float s = st[j4].x, q = st[j4].y;
#pragma unroll
                for (int o = 1; o <= 16; o <<= 1) { s += __shfl_xor(s, o); q += __shfl_xor(q, o); }
                s = __shfl(s, 0); q = __shfl(q, 0);
                const float mu = s * (1.f / 1024.f), rstd = rsqrtf(q * (1.f / 1024.f) - mu * mu + LN_EPS);
                float v[16]; unpack16(r0[j4], r1[j4], v);
                u32x4 o0, o1, o8;
#pragma unroll
                for (int j = 0; j < 4; ++j) {
                    const f32x4 g = *(const f32x4*)(a.ln_g + lane * 16 + 4 * j), bb = *(const f32x4*)(a.ln_b + lane * 16 + 4 * j);
                    const float y0 = (v[4 * j] - mu) * rstd * g[0] + bb[0], y1 = (v[4 * j + 1] - mu) * rstd * g[1] + bb[1], y2 = (v[4 * j + 2] - mu) * rstd * g[2] + bb[2], y3 = (v[4 * j + 3] - mu) * rstd * g[3] + bb[3];
                    o8[j] = pack_fp8x4(y0 * XSCALE, y1 * XSCALE, y2 * XSCALE, y3 * XSCALE);
                    const unsigned p0 = cvt_pk_bf16(y0, y1), p1 = cvt_pk_bf16(y2, y3);
                    if (j < 2) { o0[2 * j] = p0; o0[2 * j + 1] = p1; } else { o1[2 * (j - 2)] = p0; o1[2 * (j - 2) + 1] = p1; }
                }
                *(u32x4*)(a.x1 + (size_t)t * D_MODEL + lane * 16) = o0; *(u32x4*)(a.x1 + (size_t)t * D_MODEL + lane * 16 + 8) = o1;
                *(u32x4*)(a.x1f8 + (size_t)t * D_MODEL + lane * 16) = o8;
            }
        }
        if (tid < 256) hist[tid] = 0;
        asm volatile("s_waitcnt vmcnt(0)" ::: "memory");
        __syncthreads();
        ALoader<4> al; al.init_rows(a.x1, D_MODEL, m0);
        BLoaderBt bl; bl.init(a.wt_r, D_MODEL, 0);
        f32x4 acc[4][4];
        gemm_tile<4, true>(lds, al, bl, D_MODEL / 64, acc);
        int my_idx[2], my_rank[2]; float my_gate[2];
#pragma unroll
        for (int p = 0; p < 2; ++p) {
            __syncthreads();
            if (wr == p) {
#pragma unroll
                for (int m = 0; m < 4; ++m)
#pragma unroll
                    for (int n = 0; n < 4; ++n) {
                        const int c0 = 64 * wc + 16 * n + 4 * fq; const f32x4 rb = *(const f32x4*)(a.rbias + c0);
#pragma unroll
                        for (int j = 0; j < 4; ++j) { const int c = c0 + j; sc[(16 * m + fr) * RS_SC + (c >> 5) * 36 + (c & 31)] = 1.f / (1.f + __expf(-acc[m][n][j])) + rb[j]; }
                    }
            }
            __syncthreads();
            const int row = tid >> 3, g = tid & 7, t = m0 + 64 * p + row;
            float sel[32];
#pragma unroll
            for (int i = 0; i < 32; ++i) sel[i] = sc[row * RS_SC + g * 36 + i];
            float m1 = -INFINITY, m2 = -INFINITY;
#pragma unroll
            for (int i = 0; i < 32; ++i) { const float v = sel[i]; m2 = fmaxf(m2, fminf(m1, v)); m1 = fmaxf(m1, v); }
            const float gs = m1 + m2; int rank = 0;
#pragma unroll
            for (int d = 1; d < 8; ++d) { const float o = __shfl_xor(gs, d); const int og = g ^ d; rank += (o > gs || (o == gs && og < g)) ? 1 : 0; }
            const bool en = rank < TOPK_GROUPS;
            float lv = -INFINITY; int li = 1 << 20;
            if (en) {
#pragma unroll
                for (int i = 0; i < 32; ++i) { const float v = sel[i]; if (v > lv) { lv = v; li = g * 32 + i; } }
            }
            float myv = 0.f; int myi = 0;
#pragma unroll
            for (int k = 0; k < TOP_K; ++k) {
                float bv = lv; int bi = li;
#pragma unroll
                for (int d = 1; d < 8; d <<= 1) { const float ov = __shfl_xor(bv, d); const int oi = __shfl_xor(bi, d); if (ov > bv || (ov == bv && oi < bi)) { bv = ov; bi = oi; } }
                if (g == k) { myv = bv; myi = bi; }
                if (k + 1 < TOP_K && (bi >> 5) == g) {
                    lv = -INFINITY; li = 1 << 20;
#pragma unroll
                    for (int i = 0; i < 32; ++i) { if (g * 32 + i == bi) sel[i] = -INFINITY; const float v = sel[i]; if (v > lv) { lv = v; li = g * 32 + i; } }
                }
            }
            const float score = myv - a.rbias[myi];
            float gsum = score;
#pragma unroll
            for (int d = 1; d < 8; d <<= 1) gsum += __shfl_xor(gsum, d);
            const float gt = score / gsum * ROUTED_SCALE;
            a.eidx[t * TOP_K + g] = myi; a.gate[t * TOP_K + g] = gt;
            my_idx[p] = myi; my_gate[p] = gt; my_rank[p] = atomicAdd(&hist[myi], 1);
        }
        __syncthreads();
        if (tid < 256) { const int h = hist[tid]; base[tid] = h > 0 ? atomicAdd(&a.counts[tid * CSTR], h) : 0; }
        __syncthreads();
#pragma unroll
        for (int p = 0; p < 2; ++p) {
            const int row = tid >> 3, g = tid & 7, t = m0 + 64 * p + row, e = my_idx[p], pos = base[e] + my_rank[p];
            a.tokl[(size_t)e * CAP + pos] = t; a.gatel[(size_t)e * CAP + pos] = my_gate[p]; a.slot[t * TOP_K + g] = e * CAP + pos;
        }
        if ((vblock() & 1) == 1) convert_moe_range(cv, lds, CV_GU, CV_GU + CV_DN);
    }
}

constexpr int LDS_ROWTAB = 128 * 1024;
constexpr int LDS_GTAB = 139 * 1024;
constexpr int LDS_TAB = 150 * 1024;
constexpr int MOE_BM = 256;
DI void build_moe_tab(const int* counts, char* lds) {
    int* tstart = (int*)(lds + LDS_TAB); int* rstart = tstart + 264; int* cnts = tstart + 528;
    const int tid = tidx(), lane = tid & 63;
    __syncthreads();
    if (tid < 64) {
        int c[4], tl[4], cs = 0, ts = 0;
#pragma unroll
        for (int i = 0; i < 4; ++i) { c[i] = counts[(lane * 4 + i) * CSTR]; tl[i] = (c[i] + MOE_BM - 1) / MOE_BM; cs += c[i]; ts += tl[i]; }
        int ci = cs, ti = ts;
#pragma unroll
        for (int o = 1; o < 64; o <<= 1) { const int n1 = __shfl_up(ci, o), n2 = __shfl_up(ti, o); if (lane >= o) { ci += n1; ti += n2; } }
        int ce = ci - cs, te = ti - ts;
#pragma unroll
        for (int i = 0; i < 4; ++i) { rstart[lane * 4 + i] = ce; tstart[lane * 4 + i] = te; cnts[lane * 4 + i] = c[i]; ce += c[i]; te += tl[i]; }
        if (lane == 63) { rstart[256] = ce; tstart[256] = te; cnts[256] = T_TOK; rstart[257] = ce + T_TOK; tstart[257] = te + T_TOK / MOE_BM; }
    }
    __syncthreads();
}
DI int find_expert(const int* tstart, int g) {
    int lo = 0, hi = 256;
#pragma unroll 1
    while (lo < hi) { const int mid = (lo + hi + 1) >> 1; if (tstart[mid] <= g) lo = mid; else hi = mid - 1; }
    return lo;
}
struct MoeU { const char* A; const char* B; int e, m0, sub, ui; };
typedef const LAS int* ltab_t;
DI int find_expert_l(ltab_t tstart, int g) { int lo = 0, hi = 256;
#pragma unroll 1
    while (lo < hi) { const int mid = (lo + hi + 1) >> 1; if (tstart[mid] <= g) lo = mid; else hi = mid - 1; }
    return lo; }

struct P6Args { const unsigned char* x1; const int* counts; const int* tokl; const float* gatel; const unsigned char* wgut; unsigned char* H; };
struct GuSched {
    typedef MoeU U;
    ltab_t tab; const LAS int* rowtab; const unsigned char* x1; const unsigned char* wgut; int first, stride, nunits;
    DI bool next(int i, U& u) const {
        const int L = first + i * stride; if (L >= nunits) return false;
        const int g = L >> 1, e = find_expert_l(tab, g);
        u.sub = L & 1; u.e = e; u.ui = i; u.m0 = (g - tab[e]) * MOE_BM;
        u.A = (const char*)x1; u.B = (const char*)(wgut + ((size_t)e * 512 + 256 * u.sub) * D_MODEL); return true;
    }
    DI unsigned a_voff(int i, int h, int R, int C) const { return (unsigned)(rowtab[i * 256 + 128 * h + R] * (D_MODEL / 2) + C) * 2u; }
};
struct EpiGU { unsigned char* H; const LAS float* gtab; ltab_t tab;
    DI void operator()(const f32x4 (&acc)[2][2][4][2], const MoeU& u, int wr, int wc, int fr, int fq) const {
        const int st = tab[264 + u.e], cnt = tab[528 + u.e];
#pragma unroll
        for (int ai = 0; ai < 2; ++ai)
#pragma unroll
            for (int m = 0; m < 4; ++m) {
                const int row = u.m0 + 128 * ai + 64 * wr + 16 * m + fr;
                if (row < cnt) {
                    const float gt = gtab[u.ui * 256 + 128 * ai + 64 * wr + 16 * m + fr] * (HSCALE / (XSCALE * WSCALE));
                    float h[8];
#pragma unroll
                    for (int n = 0; n < 2; ++n)
#pragma unroll
                        for (int j = 0; j < 4; ++j) { const float gv = acc[ai][0][m][n][j] * (1.f / (XSCALE * WSCALE)); h[4 * n + j] = gv * __builtin_amdgcn_rcpf(1.f + __expf(-gv)) * acc[ai][1][m][n][j] * gt; }
                    *(u32x2*)(H + (size_t)(st + row) * D_EXP + 128 * u.sub + 32 * wc + 8 * fq) = (u32x2){pack_fp8x4(h[0], h[1], h[2], h[3]), pack_fp8x4(h[4], h[5], h[6], h[7])};
                }
            }
    } };
DI void phase_moe_gu(const P6Args& a, char* smem, LAS unsigned char* lds) {
    build_moe_tab(a.counts, smem);
    const int* tstart = (const int*)(smem + LDS_TAB); const int* rstart = tstart + 264; int* rowtab = (int*)(smem + LDS_ROWTAB); float* gtab = (float*)(smem + LDS_GTAB);
    const int nunits = tstart[257] * 2, first = vblock();
    const int n_my = first < nunits ? (nunits - first + GRID - 1) / GRID : 0;
    for (int idx = tidx(); idx < n_my * 256; idx += NTHR) {
        const int i = idx >> 8, row = idx & 255, L = first + i * GRID, g = L >> 1, e = find_expert(tstart, g), m0 = (g - tstart[e]) * MOE_BM, cnt = tstart[528 + e];
        int rr = m0 + row; rr = rr < cnt ? rr : cnt - 1;
        rowtab[idx] = e < N_EXP ? a.tokl[(size_t)e * CAP + rr] : rr;
        gtab[idx] = e < N_EXP ? a.gatel[(size_t)e * CAP + rr] : 1.f;
    }
    __syncthreads();
    GuSched S{(ltab_t)(lds + LDS_TAB), (const LAS int*)(lds + LDS_ROWTAB), a.x1, a.wgut, first, GRID, nunits}; EpiGU E{a.H, (const LAS float*)(lds + LDS_GTAB), (ltab_t)(lds + LDS_TAB)};
    gs::gemm_stream<true, true, 1>(lds, D_MODEL / 2, S, E);
}
struct P7Args { const unsigned char* H; const int* counts; const unsigned char* wdt; unsigned char* Y; };
struct DownSched {
    typedef MoeU U;
    ltab_t tab; const unsigned char* H; const unsigned char* wdt; int first, stride, nunits;
    DI bool next(int i, U& u) const {
        const int L = first + i * stride; if (L >= nunits) return false;
        const int g = L >> 2, e = find_expert_l(tab, g);
        u.sub = L & 3; u.e = e; u.ui = i; u.m0 = (g - tab[e]) * MOE_BM;
        u.A = (const char*)(H + (size_t)(tab[264 + e] + u.m0) * D_EXP); u.B = (const char*)(wdt + ((size_t)e * D_MODEL + 256 * u.sub) * D_EXP); return true;
    }
    DI unsigned a_voff(int, int h, int R, int C) const { return (unsigned)((128 * h + R) * (D_EXP / 2) + C) * 2u; }
};
struct EpiDown { unsigned char* Y; ltab_t tab;
    DI void operator()(const f32x4 (&acc)[2][2][4][2], const MoeU& u, int wr, int wc, int fr, int fq) const {
        const int st = tab[264 + u.e], cnt = tab[528 + u.e];
#pragma unroll
        for (int ai = 0; ai < 2; ++ai)
#pragma unroll
            for (int m = 0; m < 4; ++m) {
                const int row = u.m0 + 128 * ai + 64 * wr + 16 * m + fr;
                if (row < cnt) {
#pragma unroll
                    for (int bj = 0; bj < 2; ++bj) {
                        f32x4 v0 = acc[ai][bj][m][0] * (YSCALE / (HSCALE * WSCALE)), v1 = acc[ai][bj][m][1] * (YSCALE / (HSCALE * WSCALE));
#pragma unroll
                        for (int j = 0; j < 4; ++j) { v0[j] = __builtin_amdgcn_fmed3f(v0[j], -440.f, 440.f); v1[j] = __builtin_amdgcn_fmed3f(v1[j], -440.f, 440.f); }
                        int w0 = 0, w1 = 0;
                        w0 = __builtin_amdgcn_cvt_pk_fp8_f32(v0[0], v0[1], w0, false); w0 = __builtin_amdgcn_cvt_pk_fp8_f32(v0[2], v0[3], w0, true);
                        w1 = __builtin_amdgcn_cvt_pk_fp8_f32(v1[0], v1[1], w1, false); w1 = __builtin_amdgcn_cvt_pk_fp8_f32(v1[2], v1[3], w1, true);
                        *(u32x2*)(Y + (size_t)(st + row) * D_MODEL + 256 * u.sub + 128 * bj + 32 * wc + 8 * fq) = (u32x2){(unsigned)w0, (unsigned)w1};
                    }
                }
            }
    } };
DI void phase_moe_down(const P7Args& a, char* smem, LAS unsigned char* lds) {
    build_moe_tab(a.counts, smem);
    const int* tstart = (const int*)(smem + LDS_TAB); const int* rstart = tstart + 264;
    DownSched S{(ltab_t)(lds + LDS_TAB), a.H, a.wdt, vblock(), GRID, tstart[257] * 4}; EpiDown E{a.Y, (ltab_t)(lds + LDS_TAB)};
    gs::gemm_stream<true, true, 2>(lds, D_EXP / 2, S, E);
}
struct P8Args { const bf16_t* x1; const unsigned char* Y; const int* slot; const int* counts; const float* ln_g; const float* ln_b; float* out; };
DI void phase_combine(const P8Args& a, char* lds) {
    const int tid = tidx(), wid = tid >> 6, lane = tid & 63;
    build_moe_tab(a.counts, lds);
    const int* rstart = (const int*)(lds + LDS_TAB) + 264;
    const int sh0 = rstart[256];
    for (int t = vblock() * 8 + wid; t < T_TOK; t += GRID * 8) {
        float v[16], w[16];
        { const u32x4 p0 = *(const u32x4*)(a.x1 + (size_t)t * D_MODEL + lane * 16), p1 = *(const u32x4*)(a.x1 + (size_t)t * D_MODEL + lane * 16 + 8); unpack16(p0, p1, v); }
        int sl = 0; if (lane < TOP_K) sl = a.slot[t * TOP_K + lane];
        u32x4 yr[9];
        yr[8] = *(const u32x4*)(a.Y + (size_t)(sh0 + t) * D_MODEL + lane * 16);
#pragma unroll
        for (int k = 0; k < TOP_K; ++k) { const int s = __shfl(sl, k), e = s / CAP, pos = s % CAP; yr[k] = *(const u32x4*)(a.Y + (size_t)(rstart[e] + pos) * D_MODEL + lane * 16); }
#pragma unroll
        for (int i = 0; i < 16; ++i) w[i] = 0.f;
#pragma unroll
        for (int k = 0; k < 9; ++k)
#pragma unroll
            for (int j = 0; j < 4; ++j) { const f32x2 lo = __builtin_amdgcn_cvt_pk_f32_fp8((int)yr[k][j], false), hi = __builtin_amdgcn_cvt_pk_f32_fp8((int)yr[k][j], true); w[4 * j] += lo.x; w[4 * j + 1] += lo.y; w[4 * j + 2] += hi.x; w[4 * j + 3] += hi.y; }
#pragma unroll
        for (int i = 0; i < 16; ++i) v[i] = v[i] * DN_ALPHA + w[i] * (1.f / YSCALE);
        float s = 0.f;
#pragma unroll
        for (int i = 0; i < 16; ++i) s += v[i];
#pragma unroll
        for (int o = 32; o >= 1; o >>= 1) s += __shfl_xor(s, o);
        const float mu = s * (1.f / 1024.f);
        float q = 0.f;
#pragma unroll
        for (int i = 0; i < 16; ++i) { const float d = v[i] - mu; q += d * d; }
#pragma unroll
        for (int o = 32; o >= 1; o >>= 1) q += __shfl_xor(q, o);
        const float rstd = rsqrtf(q * (1.f / 1024.f) + LN_EPS);
#pragma unroll
        for (int j = 0; j < 4; ++j) {
            const f32x4 g = *(const f32x4*)(a.ln_g + lane * 16 + 4 * j), bb = *(const f32x4*)(a.ln_b + lane * 16 + 4 * j);
            f32x4 o; o[0] = (v[4 * j] - mu) * rstd * g[0] + bb[0]; o[1] = (v[4 * j + 1] - mu) * rstd * g[1] + bb[1]; o[2] = (v[4 * j + 2] - mu) * rstd * g[2] + bb[2]; o[3] = (v[4 * j + 3] - mu) * rstd * g[3] + bb[3];
            *(f32x4*)(a.out + (size_t)t * D_MODEL + lane * 16 + 4 * j) = o;
        }
    }
}

#define MFMA32(a, b, c) __builtin_amdgcn_mfma_f32_32x32x16_bf16((a), (b), (c), 0, 0, 0)
constexpr float SB_EXIT_THR = 1e-30f;
struct P2Args { const bf16_t* Q; const bf16_t* Kb; const bf16_t* Vt; const float* rel_bias; const float* gain_a; const float* gain_b; bf16_t* y; };

DI bf16x8 pack8(const f32x16& x, int s) {
    u32x4 p;
    if (s == 0) { p.x = cvt_pk_bf16(x[0], x[1]); p.y = cvt_pk_bf16(x[2], x[3]); p.z = cvt_pk_bf16(x[4], x[5]); p.w = cvt_pk_bf16(x[6], x[7]); }
    else        { p.x = cvt_pk_bf16(x[8], x[9]); p.y = cvt_pk_bf16(x[10], x[11]); p.z = cvt_pk_bf16(x[12], x[13]); p.w = cvt_pk_bf16(x[14], x[15]); }
    return __builtin_bit_cast(bf16x8, p);
}
DI void load_k(bf16x8 (&k)[4], const bf16_t* kp, int k0) {
#pragma unroll
    for (int kk = 0; kk < 4; ++kk) k[kk] = *(const bf16x8*)(kp + (size_t)(k0 >> 5) * 2048 + kk * 512);
}
DI void load_v(bf16x8 (&v)[2][2], const bf16_t* vp, int k0) {
#pragma unroll
    for (int dt = 0; dt < 2; ++dt)
#pragma unroll
        for (int s = 0; s < 2; ++s) v[dt][s] = *(const bf16x8*)(vp + (size_t)(k0 >> 5) * 2048 + (dt * 2 + s) * 512);
}

constexpr int LDS_CVT = 16 * 1024;
DI void phase_attn(const P2Args& a, const P0Args& cv, char* lds) {
    const int tid = tidx(), wid = tid >> 6, lane = tid & 63, r = lane & 31, h = lane >> 5;
    float* tbl = (float*)lds;
    float* ssq = (float*)(lds + 8 * 260 * 4);
    __syncthreads();
    for (int i = tid; i < NHA * 257; i += NTHR) { const int hd = i / 257, j = i % 257; tbl[hd * 260 + j] = a.rel_bias[i] * LOG2E; }
    __syncthreads();
    const int cgrp = vblock() % 3;
#pragma unroll 1
    for (int slot = 0; slot < 5; ++slot) {
        if ((cgrp == 0 && slot == 0) || (cgrp == 1 && slot == 2) || (cgrp == 2 && slot == 4)) convert_moe_range(cv, lds + LDS_CVT, 0, CV_GU);
        if (slot == 4) break;
        const int u = vblock() + GRID * (slot >> 1) + 2 * GRID * (slot & 1);
        const bool isB = u >= BATCH * (SEQ / 64); const int uu = isB ? u - BATCH * (SEQ / 64) : u;
        const int b = uu / (SEQ / 64), c = uu % (SEQ / 64), q0 = c * 64, hh = (isB ? NHA : 0) + wid;
        const size_t hb = (size_t)(b * NHH + hh) * SEQ * 64;
        const bf16_t* kp = a.Kb + hb + lane * 8;
        const bf16_t* vp = a.Vt + hb + lane * 8;
        bf16x8 qf[2][4];
#pragma unroll
        for (int qt = 0; qt < 2; ++qt)
#pragma unroll
            for (int kk = 0; kk < 4; ++kk) qf[qt][kk] = *(const bf16x8*)(a.Q + hb + (size_t)((q0 >> 5) + qt) * 2048 + kk * 512 + lane * 8);
        f32x16 ot[2][2];
#pragma unroll
        for (int dt = 0; dt < 2; ++dt)
#pragma unroll
            for (int qt = 0; qt < 2; ++qt)
#pragma unroll
                for (int i = 0; i < 16; ++i) ot[dt][qt][i] = 0.f;
        float linv[2] = {1.f, 1.f};
        if (!isB) {
            float mrun[2] = {-INFINITY, -INFINITY}, lrun[2] = {0.f, 0.f};
            const int klo = q0 - LEFT_CHUNKS * CHUNK < 0 ? 0 : q0 - LEFT_CHUNKS * CHUNK, khi = q0 + 64;
            const float cfar = tbl[wid * 260 + 256];
            bf16x8 kc[4], kn[4], vf[2][2]; load_k(kc, kp, klo);
            for (int k0 = klo; k0 < khi; k0 += 32) {
                load_v(vf, vp, k0);
                load_k(kn, kp, k0 + 32 < khi ? k0 + 32 : k0);
#pragma unroll
                for (int qt = 0; qt < 2; ++qt) {
                    bf16x8 pf[2];
                    f32x16 st;
#pragma unroll
                    for (int i = 0; i < 16; ++i) st[i] = 0.f;
#pragma unroll
                    for (int kk = 0; kk < 4; ++kk) st = MFMA32(kc[kk], qf[qt][kk], st);
                    const int dmin = q0 + 32 * qt - k0 - 31;
                    if (dmin >= MAX_REL) {
#pragma unroll
                        for (int i = 0; i < 16; ++i) st[i] += cfar;
                    } else {
                        const int bidx = q0 + 32 * qt + r - k0 - 4 * h + MAX_REL;
#pragma unroll
                        for (int i = 0; i < 16; ++i) { int ix = bidx - ((i & 3) + 8 * (i >> 2)); ix = ix < 0 ? 0 : (ix > 2 * MAX_REL ? 2 * MAX_REL : ix); st[i] += tbl[wid * 260 + ix]; }
                    }
                    float mx = st[0];
#pragma unroll
                    for (int i = 1; i < 16; ++i) mx = fmaxf(mx, st[i]);
                    mx = fmaxf(mx, __shfl_xor(mx, 32));
                    const float mn = fmaxf(mrun[qt], mx), alpha = __builtin_amdgcn_exp2f(mrun[qt] - mn);
                    mrun[qt] = mn;
                    float ps = 0.f;
#pragma unroll
                    for (int i = 0; i < 16; ++i) { st[i] = __builtin_amdgcn_exp2f(st[i] - mn); ps += st[i]; }
                    lrun[qt] = lrun[qt] * alpha + ps;
#pragma unroll
                    for (int i = 0; i < 16; ++i) { ot[0][qt][i] *= alpha; ot[1][qt][i] *= alpha; }
                    pf[0] = pack8(st, 0); pf[1] = pack8(st, 1);
#pragma unroll
                    for (int dt = 0; dt < 2; ++dt)
#pragma unroll
                        for (int s = 0; s < 2; ++s) ot[dt][qt] = MFMA32(vf[dt][s], pf[s], ot[dt][qt]);
                }
#pragma unroll
                for (int kk = 0; kk < 4; ++kk) kc[kk] = kn[kk];
            }
#pragma unroll
            for (int qt = 0; qt < 2; ++qt) { const float lt = lrun[qt] + __shfl_xor(lrun[qt], 32); linv[qt] = 1.f / lt; }
        } else {
            float carry[2] = {1.f, 1.f};
            bf16x8 kc[4], kn[4], vf[2][2]; load_k(kc, kp, q0 + 32);
            for (int k0 = q0 + 32; k0 >= 0; k0 -= 32) {
                load_v(vf, vp, k0);
                load_k(kn, kp, k0 >= 32 ? k0 - 32 : k0);
#pragma unroll
                for (int qt = 0; qt < 2; ++qt) {
                    bf16x8 pf[2];
                    f32x16 st;
#pragma unroll
                    for (int i = 0; i < 16; ++i) st[i] = 0.f;
                    const bool none = (k0 > q0 + 32 * qt + 30);
                    if (!none) {
#pragma unroll
                        for (int kk = 0; kk < 4; ++kk) st = MFMA32(kc[kk], qf[qt][kk], st);
                        const bool full = (k0 + 31 < q0 + 32 * qt);
                        const int lim = q0 + 32 * qt + r - k0 - 4 * h;
                        float om[16];
#pragma unroll
                        for (int i = 0; i < 16; ++i) {
                            const float e = __builtin_amdgcn_exp2f(-st[i]); float bta = __builtin_amdgcn_rcpf(1.f + e);
                            if (!full && !(((i & 3) + 8 * (i >> 2)) < lim)) bta = 0.f;
                            st[i] = bta; om[i] = 1.f - bta;
                        }
                        float G[4], Go[4];
#pragma unroll
                        for (int g = 0; g < 4; ++g) { G[g] = (om[4 * g] * om[4 * g + 1]) * (om[4 * g + 2] * om[4 * g + 3]); Go[g] = __shfl_xor(G[g], 32); }
                        float R = carry[qt];
#pragma unroll
                        for (int g = 3; g >= 0; --g) {
                            float run = h == 0 ? R * Go[g] : R;
#pragma unroll
                            for (int uu2 = 3; uu2 >= 0; --uu2) { const float bta = st[4 * g + uu2]; st[4 * g + uu2] = bta * run; run *= om[4 * g + uu2]; }
                            R = R * (G[g] * Go[g]);
                        }
                        carry[qt] = R;
                    }
                    if (!none) {
                        pf[0] = pack8(st, 0); pf[1] = pack8(st, 1);
#pragma unroll
                        for (int dt = 0; dt < 2; ++dt)
#pragma unroll
                            for (int s = 0; s < 2; ++s) ot[dt][qt] = MFMA32(vf[dt][s], pf[s], ot[dt][qt]);
                    }
                }
#pragma unroll
                for (int kk = 0; kk < 4; ++kk) kc[kk] = kn[kk];
                if (__all(carry[0] < SB_EXIT_THR && carry[1] < SB_EXIT_THR)) break;
            }
        }
        float ss[2];
#pragma unroll
        for (int qt = 0; qt < 2; ++qt) {
            float s2 = 0.f;
#pragma unroll
            for (int dt = 0; dt < 2; ++dt)
#pragma unroll
                for (int i = 0; i < 16; ++i) { ot[dt][qt][i] *= linv[qt]; s2 += ot[dt][qt][i] * ot[dt][qt][i]; }
            s2 += __shfl_xor(s2, 32); ss[qt] = s2;
        }
        __syncthreads();
        if (h == 0) { ssq[wid * 64 + r] = ss[0]; ssq[wid * 64 + 32 + r] = ss[1]; }
        __syncthreads();
        const float* gain = isB ? a.gain_b : a.gain_a;
#pragma unroll
        for (int qt = 0; qt < 2; ++qt) {
            float tot = 0.f;
#pragma unroll
            for (int w8 = 0; w8 < 8; ++w8) tot += ssq[w8 * 64 + 32 * qt + r];
            const float rs = rsqrtf(tot * (1.f / 512.f) + RMS_EPS);
            bf16_t* yp = a.y + (size_t)(b * SEQ + q0 + 32 * qt + r) * D_MODEL + (isB ? 512 : 0) + wid * 64;
#pragma unroll
            for (int dt = 0; dt < 2; ++dt)
#pragma unroll
                for (int g = 0; g < 4; ++g) {
                    const int d = 32 * dt + 8 * g + 4 * h; const f32x4 gn = *(const f32x4*)(gain + wid * 64 + d);
                    u32x2 o; o.x = cvt_pk_bf16(ot[dt][qt][4 * g] * rs * gn[0], ot[dt][qt][4 * g + 1] * rs * gn[1]); o.y = cvt_pk_bf16(ot[dt][qt][4 * g + 2] * rs * gn[2], ot[dt][qt][4 * g + 3] * rs * gn[3]);
                    *(u32x2*)(yp + d) = o;
                }
        }
    }
}


#define XB_TMO      128
#define XB_XCNT(j)  (256  + 64 * (j))
#define XB_XSUB(j)  (1280 + 64 * (j))
#define XB_XGEN(j)  (2304 + 64 * (j))
#define XB_TOP      3328
#define XB_TOPGEN   3392
#define XCD_BAR_WORDS 3456
#define XB_SPIN_CAP (1u << 18)
#define LAS __attribute__((address_space(3)))

__device__ __forceinline__ unsigned xb_ld(unsigned* p)              { return __hip_atomic_load(p, __ATOMIC_RELAXED, __HIP_MEMORY_SCOPE_AGENT); }
__device__ __forceinline__ unsigned xb_add(unsigned* p, unsigned v) { return __hip_atomic_fetch_add(p, v, __ATOMIC_RELAXED, __HIP_MEMORY_SCOPE_AGENT); }
__device__ __forceinline__ unsigned xb_xcc_id() { return (unsigned)__builtin_amdgcn_s_getreg((3 << 11) | 20) & 0xFu; }
#define XB_SPIN(cond, bar) do { unsigned _sp = 0; while (cond) { __builtin_amdgcn_s_sleep(1); \
    if ((++_sp & 255u) == 0u) { if (xb_ld(&(bar)[XB_TMO])) break; if (_sp > XB_SPIN_CAP) { atomicAdd(&(bar)[XB_TMO], 1u); break; } } } } while (0)

struct XcdBarrier {
    unsigned* bar; unsigned x;
    volatile LAS unsigned* st;
};

__device__ __forceinline__ XcdBarrier xcd_barrier_post(unsigned* bar, volatile LAS unsigned* st) {
    XcdBarrier b; b.bar = bar; b.x = xb_xcc_id(); b.st = st;
    if (threadIdx.x == 0) (void)xb_add(&bar[XB_XCNT(b.x)], 1u);
    return b;
}
__device__ __forceinline__ void xcd_barrier_complete(unsigned* bar, unsigned x, unsigned& nloc, unsigned& nx) {
    const unsigned G = gridDim.x * gridDim.y * gridDim.z;
    unsigned sum, cnt, mine, sp = 0u;
    for (;;) {
        sum = 0u; cnt = 0u; mine = 0u;
#pragma unroll
        for (unsigned j = 0; j < 16; ++j) { const unsigned c = xb_ld(&bar[XB_XCNT(j)]); sum += c; cnt += (c > 0u) ? 1u : 0u; mine = (j == x) ? c : mine; }
        if (sum == G) break;
        __builtin_amdgcn_s_sleep(1);
        if ((++sp & 255u) == 0u) { if (xb_ld(&bar[XB_TMO])) break; if (sp > XB_SPIN_CAP) { atomicAdd(&bar[XB_TMO], 1u); break; } }
    }
    nloc = mine > 0u ? mine : 1u; nx = cnt > 0u ? cnt : 1u;
}

__device__ __forceinline__ void xcd_barrier(const XcdBarrier& b) {
    asm volatile("s_waitcnt vmcnt(0)" ::: "memory");
    __syncthreads();
    if (threadIdx.x == 0) {
        unsigned* bar = b.bar;
        __builtin_amdgcn_s_waitcnt(0);
        unsigned nloc = b.st[0], nx = b.st[1];
        if (nloc == 0u) { xcd_barrier_complete(bar, b.x, nloc, nx); b.st[0] = nloc; b.st[1] = nx; }
        const unsigned old = xb_add(&bar[XB_XSUB(b.x)], 1u);
        const unsigned gen = old / nloc;
        if (old + 1u == (gen + 1u) * nloc) {
            __builtin_amdgcn_fence(__ATOMIC_RELEASE, "agent");
            asm volatile("s_waitcnt vmcnt(0)" ::: "memory");
            const unsigned og = xb_add(&bar[XB_TOP], 1u);
            const unsigned tg = og / nx;
            if (og + 1u == (tg + 1u) * nx) xb_add(&bar[XB_TOPGEN], 1u);
            else XB_SPIN(xb_ld(&bar[XB_TOPGEN]) == tg, bar);
            __builtin_amdgcn_fence(__ATOMIC_ACQUIRE, "agent");
            xb_add(&bar[XB_XGEN(b.x)], 1u);
            asm volatile("s_waitcnt vmcnt(0)" ::: "memory");
        } else {
            XB_SPIN(xb_ld(&bar[XB_XGEN(b.x)]) == gen, bar);
            __builtin_amdgcn_fence(__ATOMIC_ACQUIRE, "agent");
            asm volatile("s_waitcnt vmcnt(0)" ::: "memory");
        }
    }
    __syncthreads();
}


struct MegaArgs { P0Args p0; P1Args p1; P2Args p2; P3Args p3; P4Args p4; P6Args p6; P7Args p7; P8Args p8; unsigned* bar; };
__global__ __launch_bounds__(NTHR, 2) void k_mega(MegaArgs a) {
    extern __shared__ __attribute__((aligned(16))) char smem[];
    volatile LAS unsigned* xbw = (volatile LAS unsigned*)(smem + LDS_BYTES - 16);
    if (threadIdx.x == 0) { xbw[0] = 0u; xbw[1] = 0u; xbw[2] = 0u; xbw[3] = 0u; }
    __syncthreads();
    XcdBarrier bar = xcd_barrier_post(a.bar, xbw);
    LAS unsigned char* L = (LAS unsigned char*)smem;
    phase_prologue(a.p0, smem);     xcd_barrier(bar);
    phase_qkv(a.p1, L);             xcd_barrier(bar);
    phase_attn(a.p2, a.p0, smem);   xcd_barrier(bar);
    phase_outproj(a.p3, L);         xcd_barrier(bar);
    phase_router(a.p4, a.p0, smem); xcd_barrier(bar);
    phase_moe_gu(a.p6, smem, L);    xcd_barrier(bar);
    phase_moe_down(a.p7, smem, L);  xcd_barrier(bar);
    phase_combine(a.p8, smem);
}

extern "C" void kernel_launch(void* const* d_in, const int* in_sizes, int n_in, void* d_out, int out_size, void* d_ws, size_t ws_size, hipStream_t stream) {
    const float* x = (const float*)d_in[0];      const float* w_in = (const float*)d_in[1];   const float* rel_bias = (const float*)d_in[2];
    const float* gain_a = (const float*)d_in[3]; const float* gain_b = (const float*)d_in[4]; const float* w_out = (const float*)d_in[5];
    const float* ln1_g = (const float*)d_in[6];  const float* ln1_b = (const float*)d_in[7];  const float* router_w = (const float*)d_in[8];
    const float* router_bias = (const float*)d_in[9]; const float* w_gate = (const float*)d_in[10]; const float* w_up = (const float*)d_in[11];
    const float* w_down = (const float*)d_in[12]; const float* ws_gate = (const float*)d_in[13]; const float* ws_up = (const float*)d_in[14];
    const float* ws_down = (const float*)d_in[15]; const float* ln2_g = (const float*)d_in[16]; const float* ln2_b = (const float*)d_in[17];
    char* ws = (char*)d_ws; float* out = (float*)d_out;
    int* ctrl = (int*)(ws + OFF_CTRL); int* counts = ctrl + CW_COUNTS;
    bf16_t* X1 = (bf16_t*)(ws + OFF_X1); int* tokl = (int*)(ws + OFF_TOKL); float* gatel = (float*)(ws + OFF_GATEL);
    int* eidx = (int*)(ws + OFF_EIDX); float* gate = (float*)(ws + OFF_GATE); int* slot = (int*)(ws + OFF_SLOT);
    unsigned char* H = (unsigned char*)(ws + OFF_H); unsigned char* Y = (unsigned char*)(ws + OFF_Y); unsigned char* x1f8 = (unsigned char*)(ws + OFF_X1F8);
    bf16_t* Q = (bf16_t*)(ws + OFF_Q); bf16_t* Kb = (bf16_t*)(ws + OFF_K); bf16_t* Vt = (bf16_t*)(ws + OFF_VT);
    bf16_t* yatt = (bf16_t*)(ws + OFF_YATT); bf16_t* r = (bf16_t*)(ws + OFF_R);
    bf16_t* xb = (bf16_t*)(ws + OFF_XB); float* stats = (float*)(ws + OFF_STATS);
    bf16_t* wt_in = (bf16_t*)(ws + OFF_WTIN); bf16_t* wt_out = (bf16_t*)(ws + OFF_WTOUT); bf16_t* wt_r = (bf16_t*)(ws + OFF_WTR);
    unsigned char* wgut = (unsigned char*)(ws + OFF_WGUT); unsigned char* wdt = (unsigned char*)(ws + OFF_WDT);
    if (ws_size < WS_NEEDED) { fprintf(stderr, "kernel_launch: workspace too small (%zu < %zu)\n", ws_size, (size_t)WS_NEEDED); return; }
    hipMemsetAsync(ctrl, 0, 128 * 1024, stream);
    static bool attr_done = false;
    if (!attr_done) {
        hipFuncSetAttribute((const void*)k_mega, hipFuncAttributeMaxDynamicSharedMemorySize, LDS_BYTES);
        attr_done = true;
    }
    MegaArgs m{};
    m.p0 = P0Args{x, w_in, w_out, router_w, xb, wt_in, wt_out, wt_r, w_gate, w_up, w_down, ws_gate, ws_up, ws_down, wgut, wdt};
    m.p1 = P1Args{xb, wt_in, Q, Kb, Vt};
    m.p2 = P2Args{Q, Kb, Vt, rel_bias, gain_a, gain_b, yatt};
    m.p3 = P3Args{yatt, wt_out, xb, r, stats};
    m.p4 = P4Args{r, stats, ln1_g, ln1_b, X1, x1f8, wt_r, router_bias, eidx, gate, counts, tokl, gatel, slot};
    m.p6 = P6Args{x1f8, counts, tokl, gatel, wgut, H};
    m.p7 = P7Args{H, counts, wdt, Y};
    m.p8 = P8Args{X1, Y, slot, counts, ln2_g, ln2_b, out};
    m.bar = (unsigned*)ctrl;
    k_mega<<<GRID, NTHR, LDS_BYTES, stream>>>(m);
}
```

```cpp
#include <hip/hip_runtime.h>
#include <cstdint>
#include <cstdio>

typedef unsigned short bf16_t;

constexpr int D_MODEL = 1024, BATCH = 16, SEQ = 2048, T_TOK = BATCH * SEQ;
constexpr int HEAD_DIM = 64, NHA = 8, NHB = 8, NHH = 16;
constexpr int CHUNK = 64, LEFT_CHUNKS = 8, MAX_REL = 128;
constexpr int N_EXP = 256, TOP_K = 8, N_GROUPS = 8, TOPK_GROUPS = 4, EPG = 32, D_EXP = 256;
constexpr float ROUTED_SCALE = 2.5f, LN_EPS = 1e-5f, RMS_EPS = 1e-6f;
constexpr float DN_ALPHA = 1.189207115002721f;
constexpr float LOG2E = 1.4426950408889634f, LN2 = 0.6931471805599453f;
constexpr float QSCALE = 0.125f * LOG2E;
constexpr float WSCALE = 64.f, XSCALE = 16.f, HSCALE = 16.f;
constexpr float YSCALE = 64.f;
constexpr int CAP = T_TOK;
constexpr int ROWS_ALL = T_TOK * TOP_K + T_TOK;

__device__ __forceinline__ float bf2f(bf16_t v) { return __uint_as_float(((unsigned)v) << 16); }
__device__ __forceinline__ bf16_t f2bf(float f) { unsigned u = __float_as_uint(f); u += 0x7fffu + ((u >> 16) & 1u); return (bf16_t)(u >> 16); }

constexpr size_t MB = 1024ull * 1024ull;
constexpr size_t OFF_CTRL   = 0;
constexpr size_t OFF_X1     = 1 * MB;
constexpr size_t OFF_TOKL   = OFF_X1 + 64 * MB;
constexpr size_t OFF_GATEL  = OFF_TOKL + 32 * MB;
constexpr size_t OFF_EIDX   = OFF_GATEL + 32 * MB;
constexpr size_t OFF_GATE   = OFF_EIDX + 1 * MB;
constexpr size_t OFF_SLOT   = OFF_GATE + 1 * MB;
constexpr size_t OFF_WDT    = OFF_SLOT + 1 * MB;
constexpr size_t OFF_X1F8   = OFF_WDT + 72 * MB;
constexpr size_t OFF_BIG    = OFF_WDT + 129 * MB;
constexpr size_t OFF_H      = OFF_BIG;
constexpr size_t OFF_Y      = OFF_BIG + 144 * MB;
constexpr size_t OFF_Q      = OFF_BIG;
constexpr size_t OFF_K      = OFF_BIG + 64 * MB;
constexpr size_t OFF_VT     = OFF_BIG + 128 * MB;
constexpr size_t OFF_YATT   = OFF_BIG + 192 * MB;
constexpr size_t OFF_R      = OFF_BIG + 256 * MB;
constexpr size_t OFF_XB     = OFF_BIG + 320 * MB;
constexpr size_t OFF_STATS  = OFF_BIG + 384 * MB;
constexpr size_t OFF_WTIN   = OFF_BIG + 392 * MB;
constexpr size_t OFF_WTOUT  = OFF_BIG + 398 * MB;
constexpr size_t OFF_WTR    = OFF_BIG + 400 * MB;
constexpr size_t OFF_WGUT   = OFF_BIG + 401 * MB;
constexpr size_t WS_NEEDED  = OFF_BIG + 720 * MB;
static_assert(OFF_WGUT + 257 * MB <= WS_NEEDED && WS_NEEDED <= 1024 * MB, "workspace map");
constexpr int CW_COUNTS = 8192;
constexpr int CSTR = 64;

typedef short bf16x8 __attribute__((ext_vector_type(8)));
typedef float f32x4 __attribute__((ext_vector_type(4)));
typedef float f32x2 __attribute__((ext_vector_type(2)));
typedef float f32x16 __attribute__((ext_vector_type(16)));
typedef unsigned u32x4 __attribute__((ext_vector_type(4)));
typedef unsigned u32x2 __attribute__((ext_vector_type(2)));
#define DI __device__ __forceinline__
constexpr int NTHR = 512, GRID = 256;
DI int tidx() { int t = threadIdx.x; asm volatile("" : "+v"(t)); return t; }
constexpr int LDS_BYTES = 160 * 1024;

typedef __bf16 bf16x2_t __attribute__((ext_vector_type(2)));
DI unsigned cvt_pk_bf16(float lo, float hi) { f32x2 v = {lo, hi}; bf16x2_t r = __builtin_convertvector(v, bf16x2_t); return __builtin_bit_cast(unsigned, r); }
DI float clamp8(float v) { return __builtin_amdgcn_fmed3f(v, -440.f, 440.f); }
DI unsigned pack_fp8x4(float a, float b, float c, float d) { int w = 0; w = __builtin_amdgcn_cvt_pk_fp8_f32(clamp8(a), clamp8(b), w, false); w = __builtin_amdgcn_cvt_pk_fp8_f32(clamp8(c), clamp8(d), w, true); return (unsigned)w; }
DI int vblock() { return (int)((blockIdx.x & 7) * (GRID / 8) + (blockIdx.x >> 3)); }

template <int MT> struct Tile { static constexpr int BM = 32 * MT, A_BYTES = BM * 128, B_BYTES = 256 * 128, STAGE = A_BYTES + B_BYTES; };

template <int MT> struct ALoader {
    const bf16_t* p[MT / 2]; u32x4 v[MT / 2]; int off0;
    DI void init_rows(const bf16_t* A, int lda, int row0) {
        const int tid = tidx(), kc = tid & 7, r = tid >> 3;
#pragma unroll
        for (int i = 0; i < MT / 2; ++i) p[i] = A + (size_t)(row0 + r + 64 * i) * lda + kc * 8;
        off0 = r * 128 + ((kc ^ ((r >> 1) & 7)) << 4);
    }
    DI void init_gather(const bf16_t* A, int lda, const int* rows, int cnt, int m0) {
        const int tid = tidx(), kc = tid & 7, r = tid >> 3;
#pragma unroll
        for (int i = 0; i < MT / 2; ++i) { int rr = m0 + r + 64 * i; rr = rr < cnt ? rr : cnt - 1; const int g = rows ? rows[rr] : rr; p[i] = A + (size_t)g * lda + kc * 8; }
        off0 = r * 128 + ((kc ^ ((r >> 1) & 7)) << 4);
    }
    DI void load(int k0) {
#pragma unroll
        for (int i = 0; i < MT / 2; ++i) v[i] = *(const u32x4*)(p[i] + k0);
    }
    DI void store(char* ldsA) const {
#pragma unroll
        for (int i = 0; i < MT / 2; ++i) *(u32x4*)(ldsA + off0 + i * 8192) = v[i];
    }
};
struct BLoaderBt {
    const bf16_t* p[4]; u32x4 v[4]; int off0;
    DI void init(const bf16_t* Bt, int ldk, int n0) {
        const int tid = tidx(), kc = tid & 7, r = tid >> 3;
#pragma unroll
        for (int i = 0; i < 4; ++i) p[i] = Bt + (size_t)(n0 + r + 64 * i) * ldk + kc * 8;
        off0 = r * 128 + ((kc ^ ((r >> 1) & 7)) << 4);
    }
    DI void load(int k0) {
#pragma unroll
        for (int i = 0; i < 4; ++i) v[i] = *(const u32x4*)(p[i] + k0);
    }
    DI void store(char* ldsB) const {
#pragma unroll
        for (int i = 0; i < 4; ++i) *(u32x4*)(ldsB + off0 + i * 8192) = v[i];
    }
};
template <int MT, bool TR, class AL, class BL>
DI void gemm_tile(char* lds, AL& al, BL& bl, int nk, f32x4 (&acc)[MT][4]) {
    typedef Tile<MT> TT;
    const int tid = tidx(), wid = tid >> 6, lane = tid & 63, wr = wid >> 2, wc = wid & 3, fr = lane & 15, fq = lane >> 4;
#pragma unroll
    for (int m = 0; m < MT; ++m)
#pragma unroll
        for (int n = 0; n < 4; ++n) acc[m][n] = (f32x4){0.f, 0.f, 0.f, 0.f};
    int aoff[2], boff[2];
#pragma unroll
    for (int ks = 0; ks < 2; ++ks) { const int ch = (((4 * ks + fq) ^ (fr >> 1)) << 4); aoff[ks] = (16 * MT * wr + fr) * 128 + ch; boff[ks] = TT::A_BYTES + (64 * wc + fr) * 128 + ch; }
    al.load(0); bl.load(0);
    __syncthreads();
    al.store(lds); bl.store(lds + TT::A_BYTES);
    __syncthreads();
    for (int kt = 0; kt < nk; ++kt) {
        char* cur = lds + (kt & 1) * TT::STAGE; char* nxt = lds + ((kt & 1) ^ 1) * TT::STAGE;
        const bool more = kt + 1 < nk;
        if (more) { al.load((kt + 1) * 64); bl.load((kt + 1) * 64); }
#pragma unroll
        for (int ks = 0; ks < 2; ++ks) {
            bf16x8 a[MT], b[4];
#pragma unroll
            for (int m = 0; m < MT; ++m) a[m] = *(const bf16x8*)(cur + aoff[ks] + m * 2048);
#pragma unroll
            for (int n = 0; n < 4; ++n) b[n] = *(const bf16x8*)(cur + boff[ks] + n * 2048);
#pragma unroll
            for (int m = 0; m < MT; ++m)
#pragma unroll
                for (int n = 0; n < 4; ++n)
                    acc[m][n] = TR ? __builtin_amdgcn_mfma_f32_16x16x32_bf16(b[n], a[m], acc[m][n], 0, 0, 0) : __builtin_amdgcn_mfma_f32_16x16x32_bf16(a[m], b[n], acc[m][n], 0, 0, 0);
        }
        if (more) { al.store(nxt); bl.store(nxt + TT::A_BYTES); }
        __syncthreads();
    }
}

#define LAS __attribute__((address_space(3)))
namespace gs {
constexpr int BM = 256, BK = 64, HALF = 128, HTB = HALF * BK * 2, STAGE_BYTES = 8 * HTB;
DI int lds_byte(int r, int c) { const int st = (r >> 4) * 2 + (c >> 5), rr = r & 15, cc = c & 31, ob = rr * 64 + cc * 2; return st * 1024 + (ob ^ (((ob >> 9) & 1) << 5)); }
DI void stage_rc(int b, int& R, int& C) { const int st = b / 1024, sb = b % 1024, swz = sb ^ (((sb >> 9) & 1) << 5); R = (st >> 1) * 16 + swz / 64; C = (st & 1) * 32 + (swz % 64) / 2; }
DI int perm32(int rho) { const int n = rho >> 4, i = rho & 15; return 8 * (i >> 2) + 4 * n + (i & 3); }
typedef long i64x2 __attribute__((ext_vector_type(2)));
DI const char* uni(const char* p) { const unsigned long long v = (unsigned long long)p; const unsigned lo = __builtin_amdgcn_readfirstlane((unsigned)v), hi = __builtin_amdgcn_readfirstlane((unsigned)(v >> 32)); return (const char*)(((unsigned long long)hi << 32) | lo); }
template <bool TR, bool F8>
DI f32x4 mma16(const bf16x8& a, const bf16x8& b, f32x4 c) {
    if (F8) {
        const i64x2 a2 = __builtin_bit_cast(i64x2, a), b2 = __builtin_bit_cast(i64x2, b);
        c = TR ? __builtin_amdgcn_mfma_f32_16x16x32_fp8_fp8(b2[0], a2[0], c, 0, 0, 0) : __builtin_amdgcn_mfma_f32_16x16x32_fp8_fp8(a2[0], b2[0], c, 0, 0, 0);
        return TR ? __builtin_amdgcn_mfma_f32_16x16x32_fp8_fp8(b2[1], a2[1], c, 0, 0, 0) : __builtin_amdgcn_mfma_f32_16x16x32_fp8_fp8(a2[1], b2[1], c, 0, 0, 0);
    }
    return TR ? __builtin_amdgcn_mfma_f32_16x16x32_bf16(b, a, c, 0, 0, 0) : __builtin_amdgcn_mfma_f32_16x16x32_bf16(a, b, c, 0, 0, 0);
}
typedef int i32x8 __attribute__((ext_vector_type(8)));
typedef short bf16x16 __attribute__((ext_vector_type(16)));
template <bool TR>
DI f32x4 mma128(const bf16x16& a, const bf16x16& b, f32x4 c) {
    const i32x8 av = __builtin_bit_cast(i32x8, a), bv = __builtin_bit_cast(i32x8, b);
    return TR ? __builtin_amdgcn_mfma_scale_f32_16x16x128_f8f6f4(bv, av, c, 0, 0, 0, 0x7F7F7F7F, 0, 0x7F7F7F7F) : __builtin_amdgcn_mfma_scale_f32_16x16x128_f8f6f4(av, bv, c, 0, 0, 0, 0x7F7F7F7F, 0, 0x7F7F7F7F);
}
DI bf16x8 frag_lo(const bf16x16& v) { return __builtin_shufflevector(v, v, 0, 1, 2, 3, 4, 5, 6, 7); }
DI bf16x8 frag_hi(const bf16x16& v) { return __builtin_shufflevector(v, v, 8, 9, 10, 11, 12, 13, 14, 15); }
template <bool TR, bool PERM, int F8, class Sched, class Epi>
DI void gemm_stream(LAS unsigned char* lds, const int K, const Sched& S, const Epi& E) {
    typedef typename Sched::U U;
    const int tid = tidx(), wid = __builtin_amdgcn_readfirstlane(tid >> 6), lane = tid & 63, wr = wid >> 2, wc = wid & 3, fr = lane & 15, fq = lane >> 4;
    const int nt = K / BK;
    int R[2], C[2]; unsigned voffB[2];
#pragma unroll
    for (int i = 0; i < 2; ++i) { stage_rc(tid * 16 + i * 8192, R[i], C[i]); const int Rb = PERM ? ((R[i] & ~31) + perm32(R[i] & 31)) : R[i]; voffB[i] = (unsigned)(Rb * K + C[i]) * 2u; }
    const size_t kstep = (size_t)(BK * 2), hstepB = (size_t)HALF * K * 2;
    const unsigned ldsw = (unsigned)wid * 1024u;
    const int aoff = lds_byte(wr * 64 + fr, fq * 8), boff = lds_byte(wc * 32 + fr, fq * 8);
#define GS_SA(b, h) (((b) * 2 + (h)) * HTB)
#define GS_SB(b, h) ((4 + (b) * 2 + (h)) * HTB)
#define GS_STAGE(bufoff, gbase, uix, h) do { _Pragma("unroll") for (int _i = 0; _i < 2; ++_i) \
        __builtin_amdgcn_global_load_lds((const unsigned*)((const char*)(gbase) + S.a_voff(uix, h, R[_i], C[_i])), (LAS unsigned*)(lds + (bufoff) + ldsw + _i * 8192), 16, 0, 0); } while (0)
#define GS_STAGEB(bufoff, gbase, voff) do { _Pragma("unroll") for (int _i = 0; _i < 2; ++_i) \
        __builtin_amdgcn_global_load_lds((const unsigned*)((const char*)(gbase) + (voff)[_i]), (LAS unsigned*)(lds + (bufoff) + ldsw + _i * 8192), 16, 0, 0); } while (0)
#define GS_LD32(base) __builtin_shufflevector(*(const LAS bf16x8*)(base), *(const LAS bf16x8*)((base) + 1024), 0, 1, 2, 3, 4, 5, 6, 7, 8, 9, 10, 11, 12, 13, 14, 15)
#define GS_LDA(dst, b, h) do { _Pragma("unroll") for (int m = 0; m < 4; ++m) dst[m] = GS_LD32(lds + GS_SA(b, h) + aoff + m * 2048); } while (0)
#define GS_LDB(dst, b, h) do { _Pragma("unroll") for (int n = 0; n < 2; ++n) dst[n] = GS_LD32(lds + GS_SB(b, h) + boff + n * 2048); } while (0)
#define GS_MMA(ai, bj, At, Bt) do { __builtin_amdgcn_s_setprio(1); _Pragma("unroll") for (int m = 0; m < 4; ++m) _Pragma("unroll") for (int n = 0; n < 2; ++n) { \
        if (F8 == 2) acc[ai][bj][m][n] = mma128<TR>(At[m], Bt[n], acc[ai][bj][m][n]); \
        else { acc[ai][bj][m][n] = mma16<TR, F8 == 1>(frag_lo(At[m]), frag_lo(Bt[n]), acc[ai][bj][m][n]); acc[ai][bj][m][n] = mma16<TR, F8 == 1>(frag_hi(At[m]), frag_hi(Bt[n]), acc[ai][bj][m][n]); } } \
        __builtin_amdgcn_s_setprio(0); } while (0)
#define GS_WAIT_V(n) asm volatile("s_waitcnt vmcnt(" #n ")" ::: "memory")
#define GS_WAIT_L(n) asm volatile("s_waitcnt lgkmcnt(" #n ")" ::: "memory")
#define GS_BAR __builtin_amdgcn_s_barrier()
#define GS_SCHED __builtin_amdgcn_sched_barrier(0)
    U cur, nxt; int ui = 0;
    if (!S.next(0, cur)) return;
    f32x4 acc[2][2][4][2];
#pragma unroll
    for (int a = 0; a < 2; ++a)
#pragma unroll
        for (int b = 0; b < 2; ++b)
#pragma unroll
            for (int m = 0; m < 4; ++m)
#pragma unroll
                for (int n = 0; n < 2; ++n) acc[a][b][m][n] = (f32x4){0.f, 0.f, 0.f, 0.f};
    bf16x16 At[4], B0[2], B1[2];
    const char* cA = uni(cur.A); const char* cB = uni(cur.B);
    GS_STAGEB(GS_SB(0, 0), cB, voffB); GS_STAGEB(GS_SB(0, 1), cB + hstepB, voffB); GS_STAGE(GS_SA(0, 0), cA, 0, 0); GS_STAGE(GS_SA(0, 1), cA, 0, 1);
    if (wr == 1) GS_BAR;
    GS_WAIT_V(2); GS_BAR;
    GS_STAGEB(GS_SB(1, 0), cB + kstep, voffB); GS_STAGE(GS_SA(1, 0), cA + kstep, 0, 0); GS_STAGEB(GS_SB(1, 1), cB + hstepB + kstep, voffB);
    GS_WAIT_V(6); GS_BAR;
    for (;;) {
        const bool has_next = S.next(ui + 1, nxt);
        const int nui = has_next ? ui + 1 : ui;
        const char* nA = uni(has_next ? nxt.A : cA); const char* nB = uni(has_next ? nxt.B : cB);
#pragma unroll 1
        for (int t = 0; t < nt; t += 2) {
            const bool last = (t == nt - 2);
            const char* a1 = uni(cA + (size_t)(t + 1) * kstep);
            const char* a2 = uni(last ? nA : cA + (size_t)(t + 2) * kstep); const char* b2 = uni(last ? nB : cB + (size_t)(t + 2) * kstep);
            const char* a3 = uni(a2 + kstep); const char* b3 = uni(b2 + kstep);
            const int u2 = last ? nui : ui;
            GS_LDB(B0, 0, 0); GS_LDB(B1, 0, 1); GS_SCHED; GS_LDA(At, 0, 0); GS_STAGE(GS_SA(1, 1), a1, ui, 1);
            GS_WAIT_V(8); GS_WAIT_L(0); GS_BAR; GS_MMA(0, 0, At, B0); GS_MMA(0, 1, At, B1); GS_BAR; GS_SCHED;
            GS_LDA(At, 0, 1); GS_STAGEB(GS_SB(0, 0), b2, voffB); GS_STAGEB(GS_SB(0, 1), b2 + hstepB, voffB); GS_STAGE(GS_SA(0, 0), a2, u2, 0);
            GS_WAIT_V(8); GS_WAIT_L(0); GS_BAR; GS_MMA(1, 0, At, B0); GS_MMA(1, 1, At, B1); GS_BAR; GS_SCHED;
            GS_LDB(B0, 1, 0); GS_LDB(B1, 1, 1); GS_SCHED; GS_LDA(At, 1, 0); GS_STAGE(GS_SA(0, 1), a2, u2, 1);
            GS_WAIT_V(8); GS_WAIT_L(0); GS_BAR; GS_MMA(0, 0, At, B0); GS_MMA(0, 1, At, B1); GS_BAR; GS_SCHED;
            GS_LDA(At, 1, 1); GS_STAGEB(GS_SB(1, 0), b3, voffB); GS_STAGEB(GS_SB(1, 1), b3 + hstepB, voffB); GS_STAGE(GS_SA(1, 0), a3, u2, 0);
            GS_WAIT_V(8); GS_WAIT_L(0); GS_BAR; GS_MMA(1, 0, At, B0); GS_MMA(1, 1, At, B1); GS_BAR; GS_SCHED;
        }
        if (wr == 0) GS_BAR;
        E(acc, cur, wr, wc, fr, fq);
        if (!has_next) break;
#pragma unroll
        for (int a = 0; a < 2; ++a)
#pragma unroll
            for (int b = 0; b < 2; ++b)
#pragma unroll
                for (int m = 0; m < 4; ++m)
#pragma unroll
                    for (int n = 0; n < 2; ++n) acc[a][b][m][n] = (f32x4){0.f, 0.f, 0.f, 0.f};
        cur = nxt; cA = nA; cB = nB; ++ui;
        if (wr == 1) GS_BAR;
    }
    GS_WAIT_V(0);
    GS_BAR;
#undef GS_SA
#undef GS_SB
#undef GS_STAGE
#undef GS_STAGEB
#undef GS_LDA
#undef GS_LD32
#undef GS_LDB
#undef GS_MMA
#undef GS_WAIT_V
#undef GS_WAIT_L
#undef GS_BAR
#undef GS_SCHED
}
struct DenseU { const char* A; const char* B; int pm, pn; };
struct DenseSched {
    typedef DenseU U;
    const bf16_t* A; const bf16_t* Bt; int K, nunits, first, stride, npn, pn_base, pn_mod0, pn_mod1;
    DI int colmap(int q) const { return pn_base + (q / pn_mod0) * pn_mod1 + (q % pn_mod0); }
    DI bool next(int i, U& u) const {
        const int L = first + i * stride; if (L >= nunits) return false;
        u.pm = L / npn; u.pn = colmap(L % npn);
        u.A = (const char*)A + (size_t)u.pm * BM * K * 2; u.B = (const char*)Bt + (size_t)u.pn * BM * K * 2; return true;
    }
    DI unsigned a_voff(int, int h, int R, int C) const { return (unsigned)((HALF * h + R) * K + C) * 2u; }
};
}

DI void transpose_cvt(const float* W, bf16_t* Wt, int K, int N, int unit, char* lds) {
    float* tile = (float*)lds;
    const int nbn = N / 64, kb = unit / nbn, nb = unit % nbn, tid = tidx();
    __syncthreads();
#pragma unroll
    for (int i = 0; i < 8; ++i) { const int idx = tid + i * 512, r = idx >> 6, c = idx & 63; tile[r * 65 + c] = W[(size_t)(kb * 64 + r) * N + nb * 64 + c]; }
    __syncthreads();
#pragma unroll
    for (int i = 0; i < 8; ++i) { const int idx = tid + i * 512, n = idx >> 6, k = idx & 63; Wt[(size_t)(nb * 64 + n) * K + kb * 64 + k] = f2bf(tile[k * 65 + n]); }
}
struct P0Args { const float* x; const float* w_in; const float* w_out; const float* router_w; bf16_t* xb; bf16_t* wt_in; bf16_t* wt_out; bf16_t* wt_r;
                const float* w_gate; const float* w_up; const float* w_down; const float* ws_gate; const float* ws_up; const float* ws_down; unsigned char* wgut; unsigned char* wdt; };
constexpr int CV_GU = 257 * 2 * 16, CV_DN = 257 * 16;
struct CvItem { const float* src; unsigned char* dst; int ld, ldd, rbase, rhi; };
DI CvItem cv_item(const P0Args& a, int it) {
    CvItem c;
    if (it < CV_GU) {
        const int e = it / 32, u = (it >> 4) & 1, kt = it & 15;
        const float* W = e < N_EXP ? (u ? a.w_up : a.w_gate) + (size_t)e * D_MODEL * D_EXP : (u ? a.ws_up : a.ws_gate);
        c.src = W + (size_t)kt * 64 * D_EXP; c.ld = D_EXP; c.dst = a.wgut + (size_t)e * 512 * D_MODEL + kt * 64; c.ldd = D_MODEL; c.rbase = 128 * u; c.rhi = 256;
    } else {
        const int j = it - CV_GU, e = j / 16, kt = (j >> 2) & 3, nb = j & 3;
        const float* W = e < N_EXP ? a.w_down + (size_t)e * D_EXP * D_MODEL : a.ws_down;
        c.src = W + (size_t)kt * 64 * D_MODEL + nb * 256; c.ld = D_MODEL; c.dst = a.wdt + (size_t)e * D_MODEL * D_EXP + kt * 64; c.ldd = D_EXP; c.rbase = 256 * nb; c.rhi = 128;
    }
    return c;
}
DI void cv_load(const CvItem& c, f32x4 (&v)[8]) {
    const int tid = tidx();
#pragma unroll
    for (int i = 0; i < 8; ++i) { const int idx = tid + i * 512, k = idx >> 6, n4 = idx & 63; v[i] = __builtin_nontemporal_load((const f32x4*)(c.src + (size_t)k * c.ld + 4 * n4)); }
}
DI void cv_store(const CvItem& c, const f32x4 (&v)[8], char* lds) {
    float* tile = (float*)lds;
    const int tid = tidx();
    __syncthreads();
#pragma unroll
    for (int i = 0; i < 8; ++i) { const int idx = tid + i * 512, k = idx >> 6, n4 = idx & 63; *(f32x4*)(tile + k * 260 + 4 * (n4 ^ ((k >> 3) & 7))) = v[i]; }
    __syncthreads();
#pragma unroll
    for (int i = 0; i < 4; ++i) {
        const int idx = tid + i * 512, kc = idx & 7, n = idx >> 3; const float* p = tile + (8 * kc) * 260 + (n ^ (4 * kc));
        const unsigned w0 = pack_fp8x4(p[0] * WSCALE, p[260] * WSCALE, p[2 * 260] * WSCALE, p[3 * 260] * WSCALE), w1 = pack_fp8x4(p[4 * 260] * WSCALE, p[5 * 260] * WSCALE, p[6 * 260] * WSCALE, p[7 * 260] * WSCALE);
        __builtin_nontemporal_store((u32x2){w0, w1}, (u32x2*)(c.dst + (size_t)(c.rbase + (n >> 7) * c.rhi + (n & 127)) * c.ldd + 8 * kc));
    }
}
DI void convert_moe_range(const P0Args& a, char* lds, const int lo, const int hi) {
    int it = lo + vblock(); if (it >= hi) return;
    CvItem c = cv_item(a, it); f32x4 v[8]; cv_load(c, v);
#pragma unroll 1
    for (;;) {
        const int nit = it + GRID; const bool more = nit < hi;
        CvItem cn = c; f32x4 w[8];
        if (more) { cn = cv_item(a, nit); cv_load(cn, w); }
        cv_store(c, v, lds);
        if (!more) break;
        it = nit; c = cn;
#pragma unroll
        for (int i = 0; i < 8; ++i) v[i] = w[i];
    }
}
DI void phase_prologue(const P0Args& a, char* lds) {
    const int vb = vblock();
    for (size_t i = (size_t)vb * NTHR + tidx(); i < (size_t)T_TOK * D_MODEL / 8; i += (size_t)GRID * NTHR) {
        const f32x4 v0 = *(const f32x4*)(a.x + i * 8), v1 = *(const f32x4*)(a.x + i * 8 + 4);
        u32x4 o; o.x = cvt_pk_bf16(v0[0], v0[1]); o.y = cvt_pk_bf16(v0[2], v0[3]); o.z = cvt_pk_bf16(v1[0], v1[1]); o.w = cvt_pk_bf16(v1[2], v1[3]);
        *(u32x4*)(a.xb + i * 8) = o;
    }
    const int n_in = (1024 / 64) * (3072 / 64), n_out = 16 * 16, n_r = 16 * 4;
    for (int u = vb; u < n_in + n_out + n_r; u += GRID) {
        if (u < n_in) transpose_cvt(a.w_in, a.wt_in, 1024, 3072, u, lds);
        else if (u < n_in + n_out) transpose_cvt(a.w_out, a.wt_out, 1024, 1024, u - n_in, lds);
        else transpose_cvt(a.router_w, a.wt_r, 1024, 256, u - n_in - n_out, lds);
    }
}


struct P1Args { const bf16_t* xb; const bf16_t* wt_in; bf16_t* Q; bf16_t* Kb; bf16_t* Vt; };
struct EpiQK { bf16_t* Q; bf16_t* Kb;
    DI void operator()(const f32x4 (&acc)[2][2][4][2], const gs::DenseU& u, int wr, int wc, int fr, int fq) const {
        const int seg = u.pn >> 1, type = seg % 3, grp = seg / 3; bf16_t* dst = type == 0 ? Q : Kb; const float sc = type == 0 ? QSCALE : 1.f;
#pragma unroll
        for (int ai = 0; ai < 2; ++ai)
#pragma unroll
            for (int m = 0; m < 4; ++m) {
                const int row = u.pm * 256 + 128 * ai + 64 * wr + 16 * m + fr, b = row / SEQ, s = row % SEQ;
#pragma unroll
                for (int bj = 0; bj < 2; ++bj) {
                    const int hh = grp * 8 + 4 * (u.pn & 1) + 2 * bj + (wc >> 1), d0 = 32 * (wc & 1) + 8 * fq;
                    const f32x4 v0 = acc[ai][bj][m][0] * sc, v1 = acc[ai][bj][m][1] * sc;
                    u32x4 o; o.x = cvt_pk_bf16(v0[0], v0[1]); o.y = cvt_pk_bf16(v0[2], v0[3]); o.z = cvt_pk_bf16(v1[0], v1[1]); o.w = cvt_pk_bf16(v1[2], v1[3]);
                    *(u32x4*)(dst + (size_t)(b * NHH + hh) * SEQ * 64 + (s >> 5) * 2048 + ((d0 >> 3) * 32 + (s & 31)) * 8) = o;
                }
            }
    } };
struct EpiV { bf16_t* Vt;
    DI void operator()(const f32x4 (&acc)[2][2][4][2], const gs::DenseU& u, int wr, int wc, int fr, int fq) const {
        const int grp = (u.pn >> 1) / 3;
#pragma unroll
        for (int ai = 0; ai < 2; ++ai)
#pragma unroll
            for (int m = 0; m < 4; ++m) {
                const int row = u.pm * 256 + 128 * ai + 64 * wr + 16 * m + 4 * fq, b = row / SEQ, s = row % SEQ;
#pragma unroll
                for (int bj = 0; bj < 2; ++bj)
#pragma unroll
                    for (int n = 0; n < 2; ++n) {
                        const int hh = grp * 8 + 4 * (u.pn & 1) + 2 * bj + (wc >> 1), d = 32 * (wc & 1) + 16 * n + fr;
                        const f32x4 v = acc[ai][bj][m][n];
                        u32x2 o; o.x = cvt_pk_bf16(v[0], v[1]); o.y = cvt_pk_bf16(v[2], v[3]);
                        { const int kap = s & 31; *(u32x2*)(Vt + (size_t)(b * NHH + hh) * SEQ * 64 + (s >> 5) * 2048 + ((((d >> 5) * 2 + (kap >> 4)) * 2 + ((kap >> 2) & 1)) * 32 + (d & 31)) * 8 + ((kap >> 3) & 1) * 4) = o; }
                    }
            }
    } };
DI void phase_qkv(const P1Args& a, LAS unsigned char* lds) {
    { gs::DenseSched S{a.xb, a.wt_in, D_MODEL, (T_TOK / 256) * 8, vblock(), GRID, 8, 0, 4, 6}; EpiQK E{a.Q, a.Kb}; gs::gemm_stream<true, true, 0>(lds, D_MODEL, S, E); }
    { gs::DenseSched S{a.xb, a.wt_in, D_MODEL, (T_TOK / 256) * 4, vblock(), GRID, 4, 4, 2, 6}; EpiV E{a.Vt}; gs::gemm_stream<false, false, 0>(lds, D_MODEL, S, E); }
}

struct P3Args { const bf16_t* y; const bf16_t* wt_out; const bf16_t* xb; bf16_t* r; float* stats; };
struct EpiOut { const bf16_t* xb; bf16_t* r; float* stats;
    DI void operator()(const f32x4 (&acc)[2][2][4][2], const gs::DenseU& u, int wr, int wc, int fr, int fq) const {
#pragma unroll
        for (int ai = 0; ai < 2; ++ai) {
            u32x4 xw[4][2];
#pragma unroll
            for (int m = 0; m < 4; ++m)
#pragma unroll
                for (int bj = 0; bj < 2; ++bj) xw[m][bj] = *(const u32x4*)(xb + (size_t)(u.pm * 256 + 128 * ai + 64 * wr + 16 * m + fr) * D_MODEL + u.pn * 256 + 128 * bj + 32 * wc + 8 * fq);
#pragma unroll
            for (int m = 0; m < 4; ++m) {
                const int row = u.pm * 256 + 128 * ai + 64 * wr + 16 * m + fr;
#pragma unroll
                for (int bj = 0; bj < 2; ++bj) {
                    const int col = u.pn * 256 + 128 * bj + 32 * wc + 8 * fq;
                    const u32x4 w = xw[m][bj];
                    const f32x4 x0 = (f32x4){__uint_as_float(w[0] << 16), __uint_as_float(w[0] & 0xffff0000u), __uint_as_float(w[1] << 16), __uint_as_float(w[1] & 0xffff0000u)};
                    const f32x4 x1 = (f32x4){__uint_as_float(w[2] << 16), __uint_as_float(w[2] & 0xffff0000u), __uint_as_float(w[3] << 16), __uint_as_float(w[3] & 0xffff0000u)};
                    const f32x4 v0 = x0 * DN_ALPHA + acc[ai][bj][m][0], v1 = x1 * DN_ALPHA + acc[ai][bj][m][1];
                    float s = ((v0[0] + v0[1]) + (v0[2] + v0[3])) + ((v1[0] + v1[1]) + (v1[2] + v1[3]));
                    float q = ((v0[0] * v0[0] + v0[1] * v0[1]) + (v0[2] * v0[2] + v0[3] * v0[3])) + ((v1[0] * v1[0] + v1[1] * v1[1]) + (v1[2] * v1[2] + v1[3] * v1[3]));
                    u32x4 o; o.x = cvt_pk_bf16(v0[0], v0[1]); o.y = cvt_pk_bf16(v0[2], v0[3]); o.z = cvt_pk_bf16(v1[0], v1[1]); o.w = cvt_pk_bf16(v1[2], v1[3]);
                    *(u32x4*)(r + (size_t)row * D_MODEL + col) = o;
                    s += __shfl_xor(s, 16); s += __shfl_xor(s, 32); q += __shfl_xor(q, 16); q += __shfl_xor(q, 32);
                    if (fq == 0) *(f32x2*)(stats + ((size_t)row * 32 + u.pn * 8 + bj * 4 + wc) * 2) = (f32x2){s, q};
                }
            }
        }
    } };
DI void phase_outproj(const P3Args& a, LAS unsigned char* lds) {
    gs::DenseSched S{a.y, a.wt_out, D_MODEL, (T_TOK / 256) * 4, vblock(), GRID, 4, 0, 4, 0}; EpiOut E{a.xb, a.r, a.stats}; gs::gemm_stream<true, true, 0>(lds, D_MODEL, S, E);
}

DI void unpack16(const u32x4& a, const u32x4& b, float (&v)[16]) {
#pragma unroll
    for (int j = 0; j < 4; ++j) { v[2 * j] = __uint_as_float(a[j] << 16); v[2 * j + 1] = __uint_as_float(a[j] & 0xffff0000u); v[8 + 2 * j] = __uint_as_float(b[j] << 16); v[8 + 2 * j + 1] = __uint_as_float(b[j] & 0xffff0000u); }
}
constexpr int RS_SC = 289;
constexpr int LDS_HIST = 100 * 1024;
struct P4Args { const bf16_t* r; const float* stats; const float* ln_g; const float* ln_b; bf16_t* x1; unsigned char* x1f8; const bf16_t* wt_r; const float* rbias;
                int* eidx; float* gate; int* counts; int* tokl; float* gatel; int* slot; };
DI void phase_router(const P4Args& a, const P0Args& cv, char* lds) {
    const int tid = tidx(), wid = tid >> 6, lane = tid & 63, wr = wid >> 2, wc = wid & 3, fr = lane & 15, fq = lane >> 4;
    float* sc = (float*)lds; int* hist = (int*)(lds + LDS_HIST); int* base = hist + 256;
    for (int u = vblock(); u < T_TOK / 128; u += GRID) {
        const int m0 = u * 128;
        if ((vblock() & 1) == 0) convert_moe_range(cv, lds, CV_GU, CV_GU + CV_DN);
        __syncthreads();
#pragma unroll 1
        for (int i0 = 0; i0 < 16; i0 += 4) {
            f32x2 st[4]; u32x4 r0[4], r1[4];
#pragma unroll
            for (int j4 = 0; j4 < 4; ++j4) {
                const int t = m0 + wid * 16 + i0 + j4;
                st[j4] = (f32x2){0.f, 0.f};
                if (lane < 32) st[j4] = *(const f32x2*)(a.stats + ((size_t)t * 32 + lane) * 2);
                r0[j4] = *(const u32x4*)(a.r + (size_t)t * D_MODEL + lane * 16); r1[j4] = *(const u32x4*)(a.r + (size_t)t * D_MODEL + lane * 16 + 8);
            }
#pragma unroll
            for (int j4 = 0; j4 < 4; ++j4) {
                const int t = m0 + wid * 16 + i0 + j4;
                float s = st[j4].x, q = st[j4].y;
#pragma unroll
                for (int o = 1; o <= 16; o <<= 1) { s += __shfl_xor(s, o); q += __shfl_xor(q, o); }
                s = __shfl(s, 0); q = __shfl(q, 0);
                const float mu = s * (1.f / 1024.f), rstd = rsqrtf(q * (1.f / 1024.f) - mu * mu + LN_EPS);
                float v[16]; unpack16(r0[j4], r1[j4], v);
                u32x4 o0, o1, o8;
#pragma unroll
                for (int j = 0; j < 4; ++j) {
                    const f32x4 g = *(const f32x4*)(a.ln_g + lane * 16 + 4 * j), bb = *(const f32x4*)(a.ln_b + lane * 16 + 4 * j);
                    const float y0 = (v[4 * j] - mu) * rstd * g[0] + bb[0], y1 = (v[4 * j + 1] - mu) * rstd * g[1] + bb[1], y2 = (v[4 * j + 2] - mu) * rstd * g[2] + bb[2], y3 = (v[4 * j + 3] - mu) * rstd * g[3] + bb[3];
                    o8[j] = pack_fp8x4(y0 * XSCALE, y1 * XSCALE, y2 * XSCALE, y3 * XSCALE);
                    const unsigned p0 = cvt_pk_bf16(y0, y1), p1 = cvt_pk_bf16(y2, y3);
                    if (j < 2) { o0[2 * j] = p0; o0[2 * j + 1] = p1; } else { o1[2 * (j - 2)] = p0; o1[2 * (j - 2) + 1] = p1; }
                }
                *(u32x4*)(a.x1 + (size_t)t * D_MODEL + lane * 16) = o0; *(u32x4*)(a.x1 + (size_t)t * D_MODEL + lane * 16 + 8) = o1;
                *(u32x4*)(a.x1f8 + (size_t)t * D_MODEL + lane * 16) = o8;
            }
        }
        if (tid < 256) hist[tid] = 0;
        asm volatile("s_waitcnt vmcnt(0)" ::: "memory");
        __syncthreads();
        ALoader<4> al; al.init_rows(a.x1, D_MODEL, m0);
        BLoaderBt bl; bl.init(a.wt_r, D_MODEL, 0);
        f32x4 acc[4][4];
        gemm_tile<4, true>(lds, al, bl, D_MODEL / 64, acc);
        int my_idx[2], my_rank[2]; float my_gate[2];
#pragma unroll
        for (int p = 0; p < 2; ++p) {
            __syncthreads();
            if (wr == p) {
#pragma unroll
                for (int m = 0; m < 4; ++m)
#pragma unroll
                    for (int n = 0; n < 4; ++n) {
                        const int c0 = 64 * wc + 16 * n + 4 * fq; const f32x4 rb = *(const f32x4*)(a.rbias + c0);
#pragma unroll
                        for (int j = 0; j < 4; ++j) { const int c = c0 + j; sc[(16 * m + fr) * RS_SC + (c >> 5) * 36 + (c & 31)] = 1.f / (1.f + __expf(-acc[m][n][j])) + rb[j]; }
                    }
            }
            __syncthreads();
            const int row = tid >> 3, g = tid & 7, t = m0 + 64 * p + row;
            float sel[32];
#pragma unroll
            for (int i = 0; i < 32; ++i) sel[i] = sc[row * RS_SC + g * 36 + i];
            float m1 = -INFINITY, m2 = -INFINITY;
#pragma unroll
            for (int i = 0; i < 32; ++i) { const float v = sel[i]; m2 = fmaxf(m2, fminf(m1, v)); m1 = fmaxf(m1, v); }
            const float gs = m1 + m2; int rank = 0;
#pragma unroll
            for (int d = 1; d < 8; ++d) { const float o = __shfl_xor(gs, d); const int og = g ^ d; rank += (o > gs || (o == gs && og < g)) ? 1 : 0; }
            const bool en = rank < TOPK_GROUPS;
            float lv = -INFINITY; int li = 1 << 20;
            if (en) {
#pragma unroll
                for (int i = 0; i < 32; ++i) { const float v = sel[i]; if (v > lv) { lv = v; li = g * 32 + i; } }
            }
            float myv = 0.f; int myi = 0;
#pragma unroll
            for (int k = 0; k < TOP_K; ++k) {
                float bv = lv; int bi = li;
#pragma unroll
                for (int d = 1; d < 8; d <<= 1) { const float ov = __shfl_xor(bv, d); const int oi = __shfl_xor(bi, d); if (ov > bv || (ov == bv && oi < bi)) { bv = ov; bi = oi; } }
                if (g == k) { myv = bv; myi = bi; }
                if (k + 1 < TOP_K && (bi >> 5) == g) {
                    lv = -INFINITY; li = 1 << 20;
#pragma unroll
                    for (int i = 0; i < 32; ++i) { if (g * 32 + i == bi) sel[i] = -INFINITY; const float v = sel[i]; if (v > lv) { lv = v; li = g * 32 + i; } }
                }
            }
            const float score = myv - a.rbias[myi];
            float gsum = score;
#pragma unroll
            for (int d = 1; d < 8; d <<= 1) gsum += __shfl_xor(gsum, d);
            const float gt = score / gsum * ROUTED_SCALE;
            a.eidx[t * TOP_K + g] = myi; a.gate[t * TOP_K + g] = gt;
            my_idx[p] = myi; my_gate[p] = gt; my_rank[p] = atomicAdd(&hist[myi], 1);
        }
        __syncthreads();
        if (tid < 256) { const int h = hist[tid]; base[tid] = h > 0 ? atomicAdd(&a.counts[tid * CSTR], h) : 0; }
        __syncthreads();
#pragma unroll
        for (int p = 0; p < 2; ++p) {
            const int row = tid >> 3, g = tid & 7, t = m0 + 64 * p + row, e = my_idx[p], pos = base[e] + my_rank[p];
            a.tokl[(size_t)e * CAP + pos] = t; a.gatel[(size_t)e * CAP + pos] = my_gate[p]; a.slot[t * TOP_K + g] = e * CAP + pos;
        }
        if ((vblock() & 1) == 1) convert_moe_range(cv, lds, CV_GU, CV_GU + CV_DN);
    }
}

constexpr int LDS_ROWTAB = 128 * 1024;
constexpr int LDS_GTAB = 139 * 1024;
constexpr int LDS_TAB = 150 * 1024;
constexpr int MOE_BM = 256;
DI void build_moe_tab(const int* counts, char* lds) {
    int* tstart = (int*)(lds + LDS_TAB); int* rstart = tstart + 264; int* cnts = tstart + 528;
    const int tid = tidx(), lane = tid & 63;
    __syncthreads();
    if (tid < 64) {
        int c[4], tl[4], cs = 0, ts = 0;
#pragma unroll
        for (int i = 0; i < 4; ++i) { c[i] = counts[(lane * 4 + i) * CSTR]; tl[i] = (c[i] + MOE_BM - 1) / MOE_BM; cs += c[i]; ts += tl[i]; }
        int ci = cs, ti = ts;
#pragma unroll
        for (int o = 1; o < 64; o <<= 1) { const int n1 = __shfl_up(ci, o), n2 = __shfl_up(ti, o); if (lane >= o) { ci += n1; ti += n2; } }
        int ce = ci - cs, te = ti - ts;
#pragma unroll
        for (int i = 0; i < 4; ++i) { rstart[lane * 4 + i] = ce; tstart[lane * 4 + i] = te; cnts[lane * 4 + i] = c[i]; ce += c[i]; te += tl[i]; }
        if (lane == 63) { rstart[256] = ce; tstart[256] = te; cnts[256] = T_TOK; rstart[257] = ce + T_TOK; tstart[257] = te + T_TOK / MOE_BM; }
    }
    __syncthreads();
}
DI int find_expert(const int* tstart, int g) {
    int lo = 0, hi = 256;
#pragma unroll 1
    while (lo < hi) { const int mid = (lo + hi + 1) >> 1; if (tstart[mid] <= g) lo = mid; else hi = mid - 1; }
    return lo;
}
struct MoeU { const char* A; const char* B; int e, m0, sub, ui; };
typedef const LAS int* ltab_t;
DI int find_expert_l(ltab_t tstart, int g) { int lo = 0, hi = 256;
#pragma unroll 1
    while (lo < hi) { const int mid = (lo + hi + 1) >> 1; if (tstart[mid] <= g) lo = mid; else hi = mid - 1; }
    return lo; }

struct P6Args { const unsigned char* x1; const int* counts; const int* tokl; const float* gatel; const unsigned char* wgut; unsigned char* H; };
struct GuSched {
    typedef MoeU U;
    ltab_t tab; const LAS int* rowtab; const unsigned char* x1; const unsigned char* wgut; int first, stride, nunits;
    DI bool next(int i, U& u) const {
        const int L = first + i * stride; if (L >= nunits) return false;
        const int g = L >> 1, e = find_expert_l(tab, g);
        u.sub = L & 1; u.e = e; u.ui = i; u.m0 = (g - tab[e]) * MOE_BM;
        u.A = (const char*)x1; u.B = (const char*)(wgut + ((size_t)e * 512 + 256 * u.sub) * D_MODEL); return true;
    }
    DI unsigned a_voff(int i, int h, int R, int C) const { return (unsigned)(rowtab[i * 256 + 128 * h + R] * (D_MODEL / 2) + C) * 2u; }
};
struct EpiGU { unsigned char* H; const LAS float* gtab; ltab_t tab;
    DI void operator()(const f32x4 (&acc)[2][2][4][2], const MoeU& u, int wr, int wc, int fr, int fq) const {
        const int st = tab[264 + u.e], cnt = tab[528 + u.e];
#pragma unroll
        for (int ai = 0; ai < 2; ++ai)
#pragma unroll
            for (int m = 0; m < 4; ++m) {
                const int row = u.m0 + 128 * ai + 64 * wr + 16 * m + fr;
                if (row < cnt) {
                    const float gt = gtab[u.ui * 256 + 128 * ai + 64 * wr + 16 * m + fr] * (HSCALE / (XSCALE * WSCALE));
                    float h[8];
#pragma unroll
                    for (int n = 0; n < 2; ++n)
#pragma unroll
                        for (int j = 0; j < 4; ++j) { const float gv = acc[ai][0][m][n][j] * (1.f / (XSCALE * WSCALE)); h[4 * n + j] = gv * __builtin_amdgcn_rcpf(1.f + __expf(-gv)) * acc[ai][1][m][n][j] * gt; }
                    *(u32x2*)(H + (size_t)(st + row) * D_EXP + 128 * u.sub + 32 * wc + 8 * fq) = (u32x2){pack_fp8x4(h[0], h[1], h[2], h[3]), pack_fp8x4(h[4], h[5], h[6], h[7])};
                }
            }
    } };
DI void phase_moe_gu(const P6Args& a, char* smem, LAS unsigned char* lds) {
    build_moe_tab(a.counts, smem);
    const int* tstart = (const int*)(smem + LDS_TAB); const int* rstart = tstart + 264; int* rowtab = (int*)(smem + LDS_ROWTAB); float* gtab = (float*)(smem + LDS_GTAB);
    const int nunits = tstart[257] * 2, first = vblock();
    const int n_my = first < nunits ? (nunits - first + GRID - 1) / GRID : 0;
    for (int idx = tidx(); idx < n_my * 256; idx += NTHR) {
        const int i = idx >> 8, row = idx & 255, L = first + i * GRID, g = L >> 1, e = find_expert(tstart, g), m0 = (g - tstart[e]) * MOE_BM, cnt = tstart[528 + e];
        int rr = m0 + row; rr = rr < cnt ? rr : cnt - 1;
        rowtab[idx] = e < N_EXP ? a.tokl[(size_t)e * CAP + rr] : rr;
        gtab[idx] = e < N_EXP ? a.gatel[(size_t)e * CAP + rr] : 1.f;
    }
    __syncthreads();
    GuSched S{(ltab_t)(lds + LDS_TAB), (const LAS int*)(lds + LDS_ROWTAB), a.x1, a.wgut, first, GRID, nunits}; EpiGU E{a.H, (const LAS float*)(lds + LDS_GTAB), (ltab_t)(lds + LDS_TAB)};
    gs::gemm_stream<true, true, 1>(lds, D_MODEL / 2, S, E);
}
struct P7Args { const unsigned char* H; const int* counts; const unsigned char* wdt; unsigned char* Y; };
struct DownSched {
    typedef MoeU U;
    ltab_t tab; const unsigned char* H; const unsigned char* wdt; int first, stride, nunits;
    DI bool next(int i, U& u) const {
        const int L = first + i * stride; if (L >= nunits) return false;
        const int g = L >> 2, e = find_expert_l(tab, g);
        u.sub = L & 3; u.e = e; u.ui = i; u.m0 = (g - tab[e]) * MOE_BM;
        u.A = (const char*)(H + (size_t)(tab[264 + e] + u.m0) * D_EXP); u.B = (const char*)(wdt + ((size_t)e * D_MODEL + 256 * u.sub) * D_EXP); return true;
    }
    DI unsigned a_voff(int, int h, int R, int C) const { return (unsigned)((128 * h + R) * (D_EXP / 2) + C) * 2u; }
};
struct EpiDown { unsigned char* Y; ltab_t tab;
    DI void operator()(const f32x4 (&acc)[2][2][4][2], const MoeU& u, int wr, int wc, int fr, int fq) const {
        const int st = tab[264 + u.e], cnt = tab[528 + u.e];
#pragma unroll
        for (int ai = 0; ai < 2; ++ai)
#pragma unroll
            for (int m = 0; m < 4; ++m) {
                const int row = u.m0 + 128 * ai + 64 * wr + 16 * m + fr;
                if (row < cnt) {
#pragma unroll
                    for (int bj = 0; bj < 2; ++bj) {
                        f32x4 v0 = acc[ai][bj][m][0] * (YSCALE / (HSCALE * WSCALE)), v1 = acc[ai][bj][m][1] * (YSCALE / (HSCALE * WSCALE));
#pragma unroll
                        for (int j = 0; j < 4; ++j) { v0[j] = __builtin_amdgcn_fmed3f(v0[j], -440.f, 440.f); v1[j] = __builtin_amdgcn_fmed3f(v1[j], -440.f, 440.f); }
                        int w0 = 0, w1 = 0;
                        w0 = __builtin_amdgcn_cvt_pk_fp8_f32(v0[0], v0[1], w0, false); w0 = __builtin_amdgcn_cvt_pk_fp8_f32(v0[2], v0[3], w0, true);
                        w1 = __builtin_amdgcn_cvt_pk_fp8_f32(v1[0], v1[1], w1, false); w1 = __builtin_amdgcn_cvt_pk_fp8_f32(v1[2], v1[3], w1, true);
                        *(u32x2*)(Y + (size_t)(st + row) * D_MODEL + 256 * u.sub + 128 * bj + 32 * wc + 8 * fq) = (u32x2){(unsigned)w0, (unsigned)w1};
                    }
                }
            }
    } };
DI void phase_moe_down(const P7Args& a, char* smem, LAS unsigned char* lds) {
    build_moe_tab(a.counts, smem);
    const int* tstart = (const int*)(smem + LDS_TAB); const int* rstart = tstart + 264;
    DownSched S{(ltab_t)(lds + LDS_TAB), a.H, a.wdt, vblock(), GRID, tstart[257] * 4}; EpiDown E{a.Y, (ltab_t)(lds + LDS_TAB)};
    gs::gemm_stream<true, true, 2>(lds, D_EXP / 2, S, E);
}
struct P8Args { const bf16_t* x1; const unsigned char* Y; const int* slot; const int* counts; const float* ln_g; const float* ln_b; float* out; };
DI void phase_combine(const P8Args& a, char* lds) {
    const int tid = tidx(), wid = tid >> 6, lane = tid & 63;
    build_moe_tab(a.counts, lds);
    const int* rstart = (const int*)(lds + LDS_TAB) + 264;
    const int sh0 = rstart[256];
    for (int t = vblock() * 8 + wid; t < T_TOK; t += GRID * 8) {
        float v[16], w[16];
        { const u32x4 p0 = *(const u32x4*)(a.x1 + (size_t)t * D_MODEL + lane * 16), p1 = *(const u32x4*)(a.x1 + (size_t)t * D_MODEL + lane * 16 + 8); unpack16(p0, p1, v); }
        int sl = 0; if (lane < TOP_K) sl = a.slot[t * TOP_K + lane];
        u32x4 yr[9];
        yr[8] = *(const u32x4*)(a.Y + (size_t)(sh0 + t) * D_MODEL + lane * 16);
#pragma unroll
        for (int k = 0; k < TOP_K; ++k) { const int s = __shfl(sl, k), e = s / CAP, pos = s % CAP; yr[k] = *(const u32x4*)(a.Y + (size_t)(rstart[e] + pos) * D_MODEL + lane * 16); }
#pragma unroll
        for (int i = 0; i < 16; ++i) w[i] = 0.f;
#pragma unroll
        for (int k = 0; k < 9; ++k)
#pragma unroll
            for (int j = 0; j < 4; ++j) { const f32x2 lo = __builtin_amdgcn_cvt_pk_f32_fp8((int)yr[k][j], false), hi = __builtin_amdgcn_cvt_pk_f32_fp8((int)yr[k][j], true); w[4 * j] += lo.x; w[4 * j + 1] += lo.y; w[4 * j + 2] += hi.x; w[4 * j + 3] += hi.y; }
#pragma unroll
        for (int i = 0; i < 16; ++i) v[i] = v[i] * DN_ALPHA + w[i] * (1.f / YSCALE);
        float s = 0.f;
#pragma unroll
        for (int i = 0; i < 16; ++i) s += v[i];
#pragma unroll
        for (int o = 32; o >= 1; o >>= 1) s += __shfl_xor(s, o);
        const float mu = s * (1.f / 1024.f);
        float q = 0.f;
#pragma unroll
        for (int i = 0; i < 16; ++i) { const float d = v[i] - mu; q += d * d; }
#pragma unroll
        for (int o = 32; o >= 1; o >>= 1) q += __shfl_xor(q, o);
        const float rstd = rsqrtf(q * (1.f / 1024.f) + LN_EPS);
#pragma unroll
        for (int j = 0; j < 4; ++j) {
            const f32x4 g = *(const f32x4*)(a.ln_g + lane * 16 + 4 * j), bb = *(const f32x4*)(a.ln_b + lane * 16 + 4 * j);
            f32x4 o; o[0] = (v[4 * j] - mu) * rstd * g[0] + bb[0]; o[1] = (v[4 * j + 1] - mu) * rstd * g[1] + bb[1]; o[2] = (v[4 * j + 2] - mu) * rstd * g[2] + bb[2]; o[3] = (v[4 * j + 3] - mu) * rstd * g[3] + bb[3];
            *(f32x4*)(a.out + (size_t)t * D_MODEL + lane * 16 + 4 * j) = o;
        }
    }
}

#define MFMA32(a, b, c) __builtin_amdgcn_mfma_f32_32x32x16_bf16((a), (b), (c), 0, 0, 0)
constexpr float SB_EXIT_THR = 1e-30f;
struct P2Args { const bf16_t* Q; const bf16_t* Kb; const bf16_t* Vt; const float* rel_bias; const float* gain_a; const float* gain_b; bf16_t* y; };

DI bf16x8 pack8(const f32x16& x, int s) {
    u32x4 p;
    if (s == 0) { p.x = cvt_pk_bf16(x[0], x[1]); p.y = cvt_pk_bf16(x[2], x[3]); p.z = cvt_pk_bf16(x[4], x[5]); p.w = cvt_pk_bf16(x[6], x[7]); }
    else        { p.x = cvt_pk_bf16(x[8], x[9]); p.y = cvt_pk_bf16(x[10], x[11]); p.z = cvt_pk_bf16(x[12], x[13]); p.w = cvt_pk_bf16(x[14], x[15]); }
    return __builtin_bit_cast(bf16x8, p);
}
DI void load_k(bf16x8 (&k)[4], const bf16_t* kp, int k0) {
#pragma unroll
    for (int kk = 0; kk < 4; ++kk) k[kk] = *(const bf16x8*)(kp + (size_t)(k0 >> 5) * 2048 + kk * 512);
}
DI void load_v(bf16x8 (&v)[2][2], const bf16_t* vp, int k0) {
#pragma unroll
    for (int dt = 0; dt < 2; ++dt)
#pragma unroll
        for (int s = 0; s < 2; ++s) v[dt][s] = *(const bf16x8*)(vp + (size_t)(k0 >> 5) * 2048 + (dt * 2 + s) * 512);
}

constexpr int LDS_CVT = 16 * 1024;
DI void phase_attn(const P2Args& a, const P0Args& cv, char* lds) {
    const int tid = tidx(), wid = tid >> 6, lane = tid & 63, r = lane & 31, h = lane >> 5;
    float* tbl = (float*)lds;
    float* ssq = (float*)(lds + 8 * 260 * 4);
    __syncthreads();
    for (int i = tid; i < NHA * 257; i += NTHR) { const int hd = i / 257, j = i % 257; tbl[hd * 260 + j] = a.rel_bias[i] * LOG2E; }
    __syncthreads();
    const int cgrp = vblock() % 3;
#pragma unroll 1
    for (int slot = 0; slot < 5; ++slot) {
        if ((cgrp == 0 && slot == 0) || (cgrp == 1 && slot == 2) || (cgrp == 2 && slot == 4)) convert_moe_range(cv, lds + LDS_CVT, 0, CV_GU);
        if (slot == 4) break;
        const int u = vblock() + GRID * (slot >> 1) + 2 * GRID * (slot & 1);
        const bool isB = u >= BATCH * (SEQ / 64); const int uu = isB ? u - BATCH * (SEQ / 64) : u;
        const int b = uu / (SEQ / 64), c = uu % (SEQ / 64), q0 = c * 64, hh = (isB ? NHA : 0) + wid;
        const size_t hb = (size_t)(b * NHH + hh) * SEQ * 64;
        const bf16_t* kp = a.Kb + hb + lane * 8;
        const bf16_t* vp = a.Vt + hb + lane * 8;
        bf16x8 qf[2][4];
#pragma unroll
        for (int qt = 0; qt < 2; ++qt)
#pragma unroll
            for (int kk = 0; kk < 4; ++kk) qf[qt][kk] = *(const bf16x8*)(a.Q + hb + (size_t)((q0 >> 5) + qt) * 2048 + kk * 512 + lane * 8);
        f32x16 ot[2][2];
#pragma unroll
        for (int dt = 0; dt < 2; ++dt)
#pragma unroll
            for (int qt = 0; qt < 2; ++qt)
#pragma unroll
                for (int i = 0; i < 16; ++i) ot[dt][qt][i] = 0.f;
        float linv[2] = {1.f, 1.f};
        if (!isB) {
            float mrun[2] = {-INFINITY, -INFINITY}, lrun[2] = {0.f, 0.f};
            const int klo = q0 - LEFT_CHUNKS * CHUNK < 0 ? 0 : q0 - LEFT_CHUNKS * CHUNK, khi = q0 + 64;
            const float cfar = tbl[wid * 260 + 256];
            bf16x8 kc[4], kn[4], vf[2][2]; load_k(kc, kp, klo);
            for (int k0 = klo; k0 < khi; k0 += 32) {
                load_v(vf, vp, k0);
                load_k(kn, kp, k0 + 32 < khi ? k0 + 32 : k0);
#pragma unroll
                for (int qt = 0; qt < 2; ++qt) {
                    bf16x8 pf[2];
                    f32x16 st;
#pragma unroll
                    for (int i = 0; i < 16; ++i) st[i] = 0.f;
#pragma unroll
                    for (int kk = 0; kk < 4; ++kk) st = MFMA32(kc[kk], qf[qt][kk], st);
                    const int dmin = q0 + 32 * qt - k0 - 31;
                    if (dmin >= MAX_REL) {
#pragma unroll
                        for (int i = 0; i < 16; ++i) st[i] += cfar;
                    } else {
                        const int bidx = q0 + 32 * qt + r - k0 - 4 * h + MAX_REL;
#pragma unroll
                        for (int i = 0; i < 16; ++i) { int ix = bidx - ((i & 3) + 8 * (i >> 2)); ix = ix < 0 ? 0 : (ix > 2 * MAX_REL ? 2 * MAX_REL : ix); st[i] += tbl[wid * 260 + ix]; }
                    }
                    float mx = st[0];
#pragma unroll
                    for (int i = 1; i < 16; ++i) mx = fmaxf(mx, st[i]);
                    mx = fmaxf(mx, __shfl_xor(mx, 32));
                    const float mn = fmaxf(mrun[qt], mx), alpha = __builtin_amdgcn_exp2f(mrun[qt] - mn);
                    mrun[qt] = mn;
                    float ps = 0.f;
#pragma unroll
                    for (int i = 0; i < 16; ++i) { st[i] = __builtin_amdgcn_exp2f(st[i] - mn); ps += st[i]; }
                    lrun[qt] = lrun[qt] * alpha + ps;
#pragma unroll
                    for (int i = 0; i < 16; ++i) { ot[0][qt][i] *= alpha; ot[1][qt][i] *= alpha; }
                    pf[0] = pack8(st, 0); pf[1] = pack8(st, 1);
#pragma unroll
                    for (int dt = 0; dt < 2; ++dt)
#pragma unroll
                        for (int s = 0; s < 2; ++s) ot[dt][qt] = MFMA32(vf[dt][s], pf[s], ot[dt][qt]);
                }
#pragma unroll
                for (int kk = 0; kk < 4; ++kk) kc[kk] = kn[kk];
            }
#pragma unroll
            for (int qt = 0; qt < 2; ++qt) { const float lt = lrun[qt] + __shfl_xor(lrun[qt], 32); linv[qt] = 1.f / lt; }
        } else {
            float carry[2] = {1.f, 1.f};
            bf16x8 kc[4], kn[4], vf[2][2]; load_k(kc, kp, q0 + 32);
            for (int k0 = q0 + 32; k0 >= 0; k0 -= 32) {
                load_v(vf, vp, k0);
                load_k(kn, kp, k0 >= 32 ? k0 - 32 : k0);
#pragma unroll
                for (int qt = 0; qt < 2; ++qt) {
                    bf16x8 pf[2];
                    f32x16 st;
#pragma unroll
                    for (int i = 0; i < 16; ++i) st[i] = 0.f;
                    const bool none = (k0 > q0 + 32 * qt + 30);
                    if (!none) {
#pragma unroll
                        for (int kk = 0; kk < 4; ++kk) st = MFMA32(kc[kk], qf[qt][kk], st);
                        const bool full = (k0 + 31 < q0 + 32 * qt);
                        const int lim = q0 + 32 * qt + r - k0 - 4 * h;
                        float om[16];
#pragma unroll
                        for (int i = 0; i < 16; ++i) {
                            const float e = __builtin_amdgcn_exp2f(-st[i]); float bta = __builtin_amdgcn_rcpf(1.f + e);
                            if (!full && !(((i & 3) + 8 * (i >> 2)) < lim)) bta = 0.f;
                            st[i] = bta; om[i] = 1.f - bta;
                        }
                        float G[4], Go[4];
#pragma unroll
                        for (int g = 0; g < 4; ++g) { G[g] = (om[4 * g] * om[4 * g + 1]) * (om[4 * g + 2] * om[4 * g + 3]); Go[g] = __shfl_xor(G[g], 32); }
                        float R = carry[qt];
#pragma unroll
                        for (int g = 3; g >= 0; --g) {
                            float run = h == 0 ? R * Go[g] : R;
#pragma unroll
                            for (int uu2 = 3; uu2 >= 0; --uu2) { const float bta = st[4 * g + uu2]; st[4 * g + uu2] = bta * run; run *= om[4 * g + uu2]; }
                            R = R * (G[g] * Go[g]);
                        }
                        carry[qt] = R;
                    }
                    if (!none) {
                        pf[0] = pack8(st, 0); pf[1] = pack8(st, 1);
#pragma unroll
                        for (int dt = 0; dt < 2; ++dt)
#pragma unroll
                            for (int s = 0; s < 2; ++s) ot[dt][qt] = MFMA32(vf[dt][s], pf[s], ot[dt][qt]);
                    }
                }
#pragma unroll
                for (int kk = 0; kk < 4; ++kk) kc[kk] = kn[kk];
                if (__all(carry[0] < SB_EXIT_THR && carry[1] < SB_EXIT_THR)) break;
            }
        }
        float ss[2];
#pragma unroll
        for (int qt = 0; qt < 2; ++qt) {
            float s2 = 0.f;
#pragma unroll
            for (int dt = 0; dt < 2; ++dt)
#pragma unroll
                for (int i = 0; i < 16; ++i) { ot[dt][qt][i] *= linv[qt]; s2 += ot[dt][qt][i] * ot[dt][qt][i]; }
            s2 += __shfl_xor(s2, 32); ss[qt] = s2;
        }
        __syncthreads();
        if (h == 0) { ssq[wid * 64 + r] = ss[0]; ssq[wid * 64 + 32 + r] = ss[1]; }
        __syncthreads();
        const float* gain = isB ? a.gain_b : a.gain_a;
#pragma unroll
        for (int qt = 0; qt < 2; ++qt) {
            float tot = 0.f;
#pragma unroll
            for (int w8 = 0; w8 < 8; ++w8) tot += ssq[w8 * 64 + 32 * qt + r];
            const float rs = rsqrtf(tot * (1.f / 512.f) + RMS_EPS);
            bf16_t* yp = a.y + (size_t)(b * SEQ + q0 + 32 * qt + r) * D_MODEL + (isB ? 512 : 0) + wid * 64;
#pragma unroll
            for (int dt = 0; dt < 2; ++dt)
#pragma unroll
                for (int g = 0; g < 4; ++g) {
                    const int d = 32 * dt + 8 * g + 4 * h; const f32x4 gn = *(const f32x4*)(gain + wid * 64 + d);
                    u32x2 o; o.x = cvt_pk_bf16(ot[dt][qt][4 * g] * rs * gn[0], ot[dt][qt][4 * g + 1] * rs * gn[1]); o.y = cvt_pk_bf16(ot[dt][qt][4 * g + 2] * rs * gn[2], ot[dt][qt][4 * g + 3] * rs * gn[3]);
                    *(u32x2*)(yp + d) = o;
                }
        }
    }
}


#define XB_TMO      128
#define XB_XCNT(j)  (256  + 64 * (j))
#define XB_XSUB(j)  (1280 + 64 * (j))
#define XB_XGEN(j)  (2304 + 64 * (j))
#define XB_TOP      3328
#define XB_TOPGEN   3392
#define XCD_BAR_WORDS 3456
#define XB_SPIN_CAP (1u << 18)
#define LAS __attribute__((address_space(3)))

__device__ __forceinline__ unsigned xb_ld(unsigned* p)              { return __hip_atomic_load(p, __ATOMIC_RELAXED, __HIP_MEMORY_SCOPE_AGENT); }
__device__ __forceinline__ unsigned xb_add(unsigned* p, unsigned v) { return __hip_atomic_fetch_add(p, v, __ATOMIC_RELAXED, __HIP_MEMORY_SCOPE_AGENT); }
__device__ __forceinline__ unsigned xb_xcc_id() { return (unsigned)__builtin_amdgcn_s_getreg((3 << 11) | 20) & 0xFu; }
#define XB_SPIN(cond, bar) do { unsigned _sp = 0; while (cond) { __builtin_amdgcn_s_sleep(1); \
    if ((++_sp & 255u) == 0u) { if (xb_ld(&(bar)[XB_TMO])) break; if (_sp > XB_SPIN_CAP) { atomicAdd(&(bar)[XB_TMO], 1u); break; } } } } while (0)

struct XcdBarrier {
    unsigned* bar; unsigned x;
    volatile LAS unsigned* st;
};

__device__ __forceinline__ XcdBarrier xcd_barrier_post(unsigned* bar, volatile LAS unsigned* st) {
    XcdBarrier b; b.bar = bar; b.x = xb_xcc_id(); b.st = st;
    if (threadIdx.x == 0) (void)xb_add(&bar[XB_XCNT(b.x)], 1u);
    return b;
}
__device__ __forceinline__ void xcd_barrier_complete(unsigned* bar, unsigned x, unsigned& nloc, unsigned& nx) {
    const unsigned G = gridDim.x * gridDim.y * gridDim.z;
    unsigned sum, cnt, mine, sp = 0u;
    for (;;) {
        sum = 0u; cnt = 0u; mine = 0u;
#pragma unroll
        for (unsigned j = 0; j < 16; ++j) { const unsigned c = xb_ld(&bar[XB_XCNT(j)]); sum += c; cnt += (c > 0u) ? 1u : 0u; mine = (j == x) ? c : mine; }
        if (sum == G) break;
        __builtin_amdgcn_s_sleep(1);
        if ((++sp & 255u) == 0u) { if (xb_ld(&bar[XB_TMO])) break; if (sp > XB_SPIN_CAP) { atomicAdd(&bar[XB_TMO], 1u); break; } }
    }
    nloc = mine > 0u ? mine : 1u; nx = cnt > 0u ? cnt : 1u;
}

__device__ __forceinline__ void xcd_barrier(const XcdBarrier& b) {
    asm volatile("s_waitcnt vmcnt(0)" ::: "memory");
    __syncthreads();
    if (threadIdx.x == 0) {
        unsigned* bar = b.bar;
        __builtin_amdgcn_s_waitcnt(0);
        unsigned nloc = b.st[0], nx = b.st[1];
        if (nloc == 0u) { xcd_barrier_complete(bar, b.x, nloc, nx); b.st[0] = nloc; b.st[1] = nx; }
        const unsigned old = xb_add(&bar[XB_XSUB(b.x)], 1u);
        const unsigned gen = old / nloc;
        if (old + 1u == (gen + 1u) * nloc) {
            __builtin_amdgcn_fence(__ATOMIC_RELEASE, "agent");
            asm volatile("s_waitcnt vmcnt(0)" ::: "memory");
            const unsigned og = xb_add(&bar[XB_TOP], 1u);
            const unsigned tg = og / nx;
            if (og + 1u == (tg + 1u) * nx) xb_add(&bar[XB_TOPGEN], 1u);
            else XB_SPIN(xb_ld(&bar[XB_TOPGEN]) == tg, bar);
            __builtin_amdgcn_fence(__ATOMIC_ACQUIRE, "agent");
            xb_add(&bar[XB_XGEN(b.x)], 1u);
            asm volatile("s_waitcnt vmcnt(0)" ::: "memory");
        } else {
            XB_SPIN(xb_ld(&bar[XB_XGEN(b.x)]) == gen, bar);
            __builtin_amdgcn_fence(__ATOMIC_ACQUIRE, "agent");
            asm volatile("s_waitcnt vmcnt(0)" ::: "memory");
        }
    }
    __syncthreads();
}


struct MegaArgs { P0Args p0; P1Args p1; P2Args p2; P3Args p3; P4Args p4; P6Args p6; P7Args p7; P8Args p8; unsigned* bar; };
__global__ __launch_bounds__(NTHR, 2) void k_mega(MegaArgs a) {
    extern __shared__ __attribute__((aligned(16))) char smem[];
    volatile LAS unsigned* xbw = (volatile LAS unsigned*)(smem + LDS_BYTES - 16);
    if (threadIdx.x == 0) { xbw[0] = 0u; xbw[1] = 0u; xbw[2] = 0u; xbw[3] = 0u; }
    __syncthreads();
    XcdBarrier bar = xcd_barrier_post(a.bar, xbw);
    LAS unsigned char* L = (LAS unsigned char*)smem;
    phase_prologue(a.p0, smem);     xcd_barrier(bar);
    phase_qkv(a.p1, L);             xcd_barrier(bar);
    phase_attn(a.p2, a.p0, smem);   xcd_barrier(bar);
    phase_outproj(a.p3, L);         xcd_barrier(bar);
    phase_router(a.p4, a.p0, smem); xcd_barrier(bar);
    phase_moe_gu(a.p6, smem, L);    xcd_barrier(bar);
    phase_moe_down(a.p7, smem, L);  xcd_barrier(bar);
    phase_combine(a.p8, smem);
}

extern "C" void kernel_launch(void* const* d_in, const int* in_sizes, int n_in, void* d_out, int out_size, void* d_ws, size_t ws_size, hipStream_t stream) {
    const float* x = (const float*)d_in[0];      const float* w_in = (const float*)d_in[1];   const float* rel_bias = (const float*)d_in[2];
    const float* gain_a = (const float*)d_in[3]; const float* gain_b = (const float*)d_in[4]; const float* w_out = (const float*)d_in[5];
    const float* ln1_g = (const float*)d_in[6];  const float* ln1_b = (const float*)d_in[7];  const float* router_w = (const float*)d_in[8];
    const float* router_bias = (const float*)d_in[9]; const float* w_gate = (const float*)d_in[10]; const float* w_up = (const float*)d_in[11];
    const float* w_down = (const float*)d_in[12]; const float* ws_gate = (const float*)d_in[13]; const float* ws_up = (const float*)d_in[14];
    const float* ws_down = (const float*)d_in[15]; const float* ln2_g = (const float*)d_in[16]; const float* ln2_b = (const float*)d_in[17];
    char* ws = (char*)d_ws; float* out = (float*)d_out;
    int* ctrl = (int*)(ws + OFF_CTRL); int* counts = ctrl + CW_COUNTS;
    bf16_t* X1 = (bf16_t*)(ws + OFF_X1); int* tokl = (int*)(ws + OFF_TOKL); float* gatel = (float*)(ws + OFF_GATEL);
    int* eidx = (int*)(ws + OFF_EIDX); float* gate = (float*)(ws + OFF_GATE); int* slot = (int*)(ws + OFF_SLOT);
    unsigned char* H = (unsigned char*)(ws + OFF_H); unsigned char* Y = (unsigned char*)(ws + OFF_Y); unsigned char* x1f8 = (unsigned char*)(ws + OFF_X1F8);
    bf16_t* Q = (bf16_t*)(ws + OFF_Q); bf16_t* Kb = (bf16_t*)(ws + OFF_K); bf16_t* Vt = (bf16_t*)(ws + OFF_VT);
    bf16_t* yatt = (bf16_t*)(ws + OFF_YATT); bf16_t* r = (bf16_t*)(ws + OFF_R);
    bf16_t* xb = (bf16_t*)(ws + OFF_XB); float* stats = (float*)(ws + OFF_STATS);
    bf16_t* wt_in = (bf16_t*)(ws + OFF_WTIN); bf16_t* wt_out = (bf16_t*)(ws + OFF_WTOUT); bf16_t* wt_r = (bf16_t*)(ws + OFF_WTR);
    unsigned char* wgut = (unsigned char*)(ws + OFF_WGUT); unsigned char* wdt = (unsigned char*)(ws + OFF_WDT);
    if (ws_size < WS_NEEDED) { fprintf(stderr, "kernel_launch: workspace too small (%zu < %zu)\n", ws_size, (size_t)WS_NEEDED); return; }
    hipMemsetAsync(ctrl, 0, 128 * 1024, stream);
    static bool attr_done = false;
    if (!attr_done) {
        hipFuncSetAttribute((const void*)k_mega, hipFuncAttributeMaxDynamicSharedMemorySize, LDS_BYTES);
        attr_done = true;
    }
    MegaArgs m{};
    m.p0 = P0Args{x, w_in, w_out, router_w, xb, wt_in, wt_out, wt_r, w_gate, w_up, w_down, ws_gate, ws_up, ws_down, wgut, wdt};
    m.p1 = P1Args{xb, wt_in, Q, Kb, Vt};
    m.p2 = P2Args{Q, Kb, Vt, rel_bias, gain_a, gain_b, yatt};
    m.p3 = P3Args{yatt, wt_out, xb, r, stats};
    m.p4 = P4Args{r, stats, ln1_g, ln1_b, X1, x1f8, wt_r, router_bias, eidx, gate, counts, tokl, gatel, slot};
    m.p6 = P6Args{x1f8, counts, tokl, gatel, wgut, H};
    m.p7 = P7Args{H, counts, wdt, Y};
    m.p8 = P8Args{X1, Y, slot, counts, ln2_g, ln2_b, out};
    m.bar = (unsigned*)ctrl;
    k_mega<<<GRID, NTHR, LDS_BYTES, stream>>>(m);
}
```

```cpp
#include <hip/hip_runtime.h>
#include <cstdint>
#include <cstdio>

typedef unsigned short bf16_t;

constexpr int D_MODEL = 1024, BATCH = 16, SEQ = 2048, T_TOK = BATCH * SEQ;
constexpr int HEAD_DIM = 64, NHA = 8, NHB = 8, NHH = 16;
constexpr int CHUNK = 64, LEFT_CHUNKS = 8, MAX_REL = 128;
constexpr int N_EXP = 256, TOP_K = 8, N_GROUPS = 8, TOPK_GROUPS = 4, EPG = 32, D_EXP = 256;
constexpr float ROUTED_SCALE = 2.5f, LN_EPS = 1e-5f, RMS_EPS = 1e-6f;
constexpr float DN_ALPHA = 1.189207115002721f;
constexpr float LOG2E = 1.4426950408889634f, LN2 = 0.6931471805599453f;
constexpr float QSCALE = 0.125f * LOG2E;
constexpr float WSCALE = 64.f, XSCALE = 16.f, HSCALE = 16.f;
constexpr float YSCALE = 64.f;
constexpr int CAP = T_TOK;
constexpr int ROWS_ALL = T_TOK * TOP_K + T_TOK;

__device__ __forceinline__ float bf2f(bf16_t v) { return __uint_as_float(((unsigned)v) << 16); }
__device__ __forceinline__ bf16_t f2bf(float f) { unsigned u = __float_as_uint(f); u += 0x7fffu + ((u >> 16) & 1u); return (bf16_t)(u >> 16); }

constexpr size_t MB = 1024ull * 1024ull;
constexpr size_t OFF_CTRL   = 0;
constexpr size_t OFF_X1     = 1 * MB;
constexpr size_t OFF_TOKL   = OFF_X1 + 64 * MB;
constexpr size_t OFF_GATEL  = OFF_TOKL + 32 * MB;
constexpr size_t OFF_EIDX   = OFF_GATEL + 32 * MB;
constexpr size_t OFF_GATE   = OFF_EIDX + 1 * MB;
constexpr size_t OFF_SLOT   = OFF_GATE + 1 * MB;
constexpr size_t OFF_WDT    = OFF_SLOT + 1 * MB;
constexpr size_t OFF_X1F8   = OFF_WDT + 72 * MB;
constexpr size_t OFF_BIG    = OFF_WDT + 129 * MB;
constexpr size_t OFF_H      = OFF_BIG;
constexpr size_t OFF_Y      = OFF_BIG + 144 * MB;
constexpr size_t OFF_Q      = OFF_BIG;
constexpr size_t OFF_K      = OFF_BIG + 64 * MB;
constexpr size_t OFF_VT     = OFF_BIG + 128 * MB;
constexpr size_t OFF_YATT   = OFF_BIG + 192 * MB;
constexpr size_t OFF_R      = OFF_BIG + 256 * MB;
constexpr size_t OFF_XB     = OFF_BIG + 320 * MB;
constexpr size_t OFF_STATS  = OFF_BIG + 384 * MB;
constexpr size_t OFF_WTIN   = OFF_BIG + 392 * MB;
constexpr size_t OFF_WTOUT  = OFF_BIG + 398 * MB;
constexpr size_t OFF_WTR    = OFF_BIG + 400 * MB;
constexpr size_t OFF_WGUT   = OFF_BIG + 401 * MB;
constexpr size_t WS_NEEDED  = OFF_BIG + 720 * MB;
static_assert(OFF_WGUT + 257 * MB <= WS_NEEDED && WS_NEEDED <= 1024 * MB, "workspace map");
constexpr int CW_COUNTS = 8192;
constexpr int CSTR = 64;

typedef short bf16x8 __attribute__((ext_vector_type(8)));
typedef float f32x4 __attribute__((ext_vector_type(4)));
typedef float f32x2 __attribute__((ext_vector_type(2)));
typedef float f32x16 __attribute__((ext_vector_type(16)));
typedef unsigned u32x4 __attribute__((ext_vector_type(4)));
typedef unsigned u32x2 __attribute__((ext_vector_type(2)));
#define DI __device__ __forceinline__
constexpr int NTHR = 512, GRID = 256;
DI int tidx() { int t = threadIdx.x; asm volatile("" : "+v"(t)); return t; }
constexpr int LDS_BYTES = 160 * 1024;

typedef __bf16 bf16x2_t __attribute__((ext_vector_type(2)));
DI unsigned cvt_pk_bf16(float lo, float hi) { f32x2 v = {lo, hi}; bf16x2_t r = __builtin_convertvector(v, bf16x2_t); return __builtin_bit_cast(unsigned, r); }
DI float clamp8(float v) { return __builtin_amdgcn_fmed3f(v, -440.f, 440.f); }
DI unsigned pack_fp8x4(float a, float b, float c, float d) { int w = 0; w = __builtin_amdgcn_cvt_pk_fp8_f32(clamp8(a), clamp8(b), w, false); w = __builtin_amdgcn_cvt_pk_fp8_f32(clamp8(c), clamp8(d), w, true); return (unsigned)w; }
DI int vblock() { return (int)((blockIdx.x & 7) * (GRID / 8) + (blockIdx.x >> 3)); }

template <int MT> struct Tile { static constexpr int BM = 32 * MT, A_BYTES = BM * 128, B_BYTES = 256 * 128, STAGE = A_BYTES + B_BYTES; };

template <int MT> struct ALoader {
    const bf16_t* p[MT / 2]; u32x4 v[MT / 2]; int off0;
    DI void init_rows(const bf16_t* A, int lda, int row0) {
        const int tid = tidx(), kc = tid & 7, r = tid >> 3;
#pragma unroll
        for (int i = 0; i < MT / 2; ++i) p[i] = A + (size_t)(row0 + r + 64 * i) * lda + kc * 8;
        off0 = r * 128 + ((kc ^ ((r >> 1) & 7)) << 4);
    }
    DI void init_gather(const bf16_t* A, int lda, const int* rows, int cnt, int m0) {
        const int tid = tidx(), kc = tid & 7, r = tid >> 3;
#pragma unroll
        for (int i = 0; i < MT / 2; ++i) { int rr = m0 + r + 64 * i; rr = rr < cnt ? rr : cnt - 1; const int g = rows ? rows[rr] : rr; p[i] = A + (size_t)g * lda + kc * 8; }
        off0 = r * 128 + ((kc ^ ((r >> 1) & 7)) << 4);
    }
    DI void load(int k0) {
#pragma unroll
        for (int i = 0; i < MT / 2; ++i) v[i] = *(const u32x4*)(p[i] + k0);
    }
    DI void store(char* ldsA) const {
#pragma unroll
        for (int i = 0; i < MT / 2; ++i) *(u32x4*)(ldsA + off0 + i * 8192) = v[i];
    }
};
struct BLoaderBt {
    const bf16_t* p[4]; u32x4 v[4]; int off0;
    DI void init(const bf16_t* Bt, int ldk, int n0) {
        const int tid = tidx(), kc = tid & 7, r = tid >> 3;
#pragma unroll
        for (int i = 0; i < 4; ++i) p[i] = Bt + (size_t)(n0 + r + 64 * i) * ldk + kc * 8;
        off0 = r * 128 + ((kc ^ ((r >> 1) & 7)) << 4);
    }
    DI void load(int k0) {
#pragma unroll
        for (int i = 0; i < 4; ++i) v[i] = *(const u32x4*)(p[i] + k0);
    }
    DI void store(char* ldsB) const {
#pragma unroll
        for (int i = 0; i < 4; ++i) *(u32x4*)(ldsB + off0 + i * 8192) = v[i];
    }
};
template <int MT, bool TR, class AL, class BL>
DI void gemm_tile(char* lds, AL& al, BL& bl, int nk, f32x4 (&acc)[MT][4]) {
    typedef Tile<MT> TT;
    const int tid = tidx(), wid = tid >> 6, lane = tid & 63, wr = wid >> 2, wc = wid & 3, fr = lane & 15, fq = lane >> 4;
#pragma unroll
    for (int m = 0; m < MT; ++m)
#pragma unroll
        for (int n = 0; n < 4; ++n) acc[m][n] = (f32x4){0.f, 0.f, 0.f, 0.f};
    int aoff[2], boff[2];
#pragma unroll
    for (int ks = 0; ks < 2; ++ks) { const int ch = (((4 * ks + fq) ^ (fr >> 1)) << 4); aoff[ks] = (16 * MT * wr + fr) * 128 + ch; boff[ks] = TT::A_BYTES + (64 * wc + fr) * 128 + ch; }
    al.load(0); bl.load(0);
    __syncthreads();
    al.store(lds); bl.store(lds + TT::A_BYTES);
    __syncthreads();
    for (int kt = 0; kt < nk; ++kt) {
        char* cur = lds + (kt & 1) * TT::STAGE; char* nxt = lds + ((kt & 1) ^ 1) * TT::STAGE;
        const bool more = kt + 1 < nk;
        if (more) { al.load((kt + 1) * 64); bl.load((kt + 1) * 64); }
#pragma unroll
        for (int ks = 0; ks < 2; ++ks) {
            bf16x8 a[MT], b[4];
#pragma unroll
            for (int m = 0; m < MT; ++m) a[m] = *(const bf16x8*)(cur + aoff[ks] + m * 2048);
#pragma unroll
            for (int n = 0; n < 4; ++n) b[n] = *(const bf16x8*)(cur + boff[ks] + n * 2048);
#pragma unroll
            for (int m = 0; m < MT; ++m)
#pragma unroll
                for (int n = 0; n < 4; ++n)
                    acc[m][n] = TR ? __builtin_amdgcn_mfma_f32_16x16x32_bf16(b[n], a[m], acc[m][n], 0, 0, 0) : __builtin_amdgcn_mfma_f32_16x16x32_bf16(a[m], b[n], acc[m][n], 0, 0, 0);
        }
        if (more) { al.store(nxt); bl.store(nxt + TT::A_BYTES); }
        __syncthreads();
    }
}

#define LAS __attribute__((address_space(3)))
namespace gs {
constexpr int BM = 256, BK = 64, HALF = 128, HTB = HALF * BK * 2, STAGE_BYTES = 8 * HTB;
DI int lds_byte(int r, int c) { const int st = (r >> 4) * 2 + (c >> 5), rr = r & 15, cc = c & 31, ob = rr * 64 + cc * 2; return st * 1024 + (ob ^ (((ob >> 9) & 1) << 5)); }
DI void stage_rc(int b, int& R, int& C) { const int st = b / 1024, sb = b % 1024, swz = sb ^ (((sb >> 9) & 1) << 5); R = (st >> 1) * 16 + swz / 64; C = (st & 1) * 32 + (swz % 64) / 2; }
DI int perm32(int rho) { const int n = rho >> 4, i = rho & 15; return 8 * (i >> 2) + 4 * n + (i & 3); }
typedef long i64x2 __attribute__((ext_vector_type(2)));
DI const char* uni(const char* p) { const unsigned long long v = (unsigned long long)p; const unsigned lo = __builtin_amdgcn_readfirstlane((unsigned)v), hi = __builtin_amdgcn_readfirstlane((unsigned)(v >> 32)); return (const char*)(((unsigned long long)hi << 32) | lo); }
template <bool TR, bool F8>
DI f32x4 mma16(const bf16x8& a, const bf16x8& b, f32x4 c) {
    if (F8) {
        const i64x2 a2 = __builtin_bit_cast(i64x2, a), b2 = __builtin_bit_cast(i64x2, b);
        c = TR ? __builtin_amdgcn_mfma_f32_16x16x32_fp8_fp8(b2[0], a2[0], c, 0, 0, 0) : __builtin_amdgcn_mfma_f32_16x16x32_fp8_fp8(a2[0], b2[0], c, 0, 0, 0);
        return TR ? __builtin_amdgcn_mfma_f32_16x16x32_fp8_fp8(b2[1], a2[1], c, 0, 0, 0) : __builtin_amdgcn_mfma_f32_16x16x32_fp8_fp8(a2[1], b2[1], c, 0, 0, 0);
    }
    return TR ? __builtin_amdgcn_mfma_f32_16x16x32_bf16(b, a, c, 0, 0, 0) : __builtin_amdgcn_mfma_f32_16x16x32_bf16(a, b, c, 0, 0, 0);
}
typedef int i32x8 __attribute__((ext_vector_type(8)));
typedef short bf16x16 __attribute__((ext_vector_type(16)));
template <bool TR>
DI f32x4 mma128(const bf16x16& a, const bf16x16& b, f32x4 c) {
    const i32x8 av = __builtin_bit_cast(i32x8, a), bv = __builtin_bit_cast(i32x8, b);
    const int one = 0x7F7F7F7F;
    if (TR) asm volatile("v_mfma_scale_f32_16x16x128_f8f6f4 %0, %1, %2, %0, %3, %3 op_sel_hi:[0,0,0]" : "+v"(c) : "v"(bv), "v"(av), "v"(one));
    else    asm volatile("v_mfma_scale_f32_16x16x128_f8f6f4 %0, %1, %2, %0, %3, %3 op_sel_hi:[0,0,0]" : "+v"(c) : "v"(av), "v"(bv), "v"(one));
    return c;
}
DI bf16x8 frag_lo(const bf16x16& v) { return __builtin_shufflevector(v, v, 0, 1, 2, 3, 4, 5, 6, 7); }
DI bf16x8 frag_hi(const bf16x16& v) { return __builtin_shufflevector(v, v, 8, 9, 10, 11, 12, 13, 14, 15); }
template <bool TR, bool PERM, int F8, class Sched, class Epi>
DI void gemm_stream(LAS unsigned char* lds, const int K, const Sched& S, const Epi& E) {
    typedef typename Sched::U U;
    const int tid = tidx(), wid = __builtin_amdgcn_readfirstlane(tid >> 6), lane = tid & 63, wr = wid >> 2, wc = wid & 3, fr = lane & 15, fq = lane >> 4;
    const int nt = K / BK;
    int R[2], C[2]; unsigned voffB[2];
#pragma unroll
    for (int i = 0; i < 2; ++i) { stage_rc(tid * 16 + i * 8192, R[i], C[i]); const int Rb = PERM ? ((R[i] & ~31) + perm32(R[i] & 31)) : R[i]; voffB[i] = (unsigned)(Rb * K + C[i]) * 2u; }
    const size_t kstep = (size_t)(BK * 2), hstepB = (size_t)HALF * K * 2;
    const unsigned ldsw = (unsigned)wid * 1024u;
    const int aoff = lds_byte(wr * 64 + fr, fq * 8), boff = lds_byte(wc * 32 + fr, fq * 8);
#define GS_SA(b, h) (((b) * 2 + (h)) * HTB)
#define GS_SB(b, h) ((4 + (b) * 2 + (h)) * HTB)
#define GS_STAGE(bufoff, gbase, uix, h) do { _Pragma("unroll") for (int _i = 0; _i < 2; ++_i) \
        __builtin_amdgcn_global_load_lds((const unsigned*)((const char*)(gbase) + S.a_voff(uix, h, R[_i], C[_i])), (LAS unsigned*)(lds + (bufoff) + ldsw + _i * 8192), 16, 0, 0); } while (0)
#define GS_STAGEB(bufoff, gbase, voff) do { _Pragma("unroll") for (int _i = 0; _i < 2; ++_i) \
        __builtin_amdgcn_global_load_lds((const unsigned*)((const char*)(gbase) + (voff)[_i]), (LAS unsigned*)(lds + (bufoff) + ldsw + _i * 8192), 16, 0, 0); } while (0)
#define GS_LD32(base) __builtin_shufflevector(*(const LAS bf16x8*)(base), *(const LAS bf16x8*)((base) + 1024), 0, 1, 2, 3, 4, 5, 6, 7, 8, 9, 10, 11, 12, 13, 14, 15)
#define GS_LDA(dst, b, h) do { _Pragma("unroll") for (int m = 0; m < 4; ++m) dst[m] = GS_LD32(lds + GS_SA(b, h) + aoff + m * 2048); } while (0)
#define GS_LDB(dst, b, h) do { _Pragma("unroll") for (int n = 0; n < 2; ++n) dst[n] = GS_LD32(lds + GS_SB(b, h) + boff + n * 2048); } while (0)
#define GS_MMA(ai, bj, At, Bt) do { __builtin_amdgcn_s_setprio(1); _Pragma("unroll") for (int m = 0; m < 4; ++m) _Pragma("unroll") for (int n = 0; n < 2; ++n) { \
        if (F8 == 2) acc[ai][bj][m][n] = mma128<TR>(At[m], Bt[n], acc[ai][bj][m][n]); \
        else { acc[ai][bj][m][n] = mma16<TR, F8 == 1>(frag_lo(At[m]), frag_lo(Bt[n]), acc[ai][bj][m][n]); acc[ai][bj][m][n] = mma16<TR, F8 == 1>(frag_hi(At[m]), frag_hi(Bt[n]), acc[ai][bj][m][n]); } } \
        __builtin_amdgcn_s_setprio(0); } while (0)
#define GS_WAIT_V(n) asm volatile("s_waitcnt vmcnt(" #n ")" ::: "memory")
#define GS_WAIT_L(n) asm volatile("s_waitcnt lgkmcnt(" #n ")" ::: "memory")
#define GS_BAR __builtin_amdgcn_s_barrier()
#define GS_SCHED __builtin_amdgcn_sched_barrier(0)
    U cur, nxt; int ui = 0;
    if (!S.next(0, cur)) return;
    f32x4 acc[2][2][4][2];
#pragma unroll
    for (int a = 0; a < 2; ++a)
#pragma unroll
        for (int b = 0; b < 2; ++b)
#pragma unroll
            for (int m = 0; m < 4; ++m)
#pragma unroll
                for (int n = 0; n < 2; ++n) acc[a][b][m][n] = (f32x4){0.f, 0.f, 0.f, 0.f};
    bf16x16 At[4], B0[2], B1[2];
    const char* cA = uni(cur.A); const char* cB = uni(cur.B);
    GS_STAGEB(GS_SB(0, 0), cB, voffB); GS_STAGEB(GS_SB(0, 1), cB + hstepB, voffB); GS_STAGE(GS_SA(0, 0), cA, 0, 0); GS_STAGE(GS_SA(0, 1), cA, 0, 1);
    if (wr == 1) GS_BAR;
    GS_WAIT_V(2); GS_BAR;
    GS_STAGEB(GS_SB(1, 0), cB + kstep, voffB); GS_STAGE(GS_SA(1, 0), cA + kstep, 0, 0); GS_STAGEB(GS_SB(1, 1), cB + hstepB + kstep, voffB);
    GS_WAIT_V(6); GS_BAR;
    for (;;) {
        const bool has_next = S.next(ui + 1, nxt);
        const int nui = has_next ? ui + 1 : ui;
        const char* nA = uni(has_next ? nxt.A : cA); const char* nB = uni(has_next ? nxt.B : cB);
#pragma unroll 1
        for (int t = 0; t < nt; t += 2) {
            const bool last = (t == nt - 2);
            const char* a1 = uni(cA + (size_t)(t + 1) * kstep);
            const char* a2 = uni(last ? nA : cA + (size_t)(t + 2) * kstep); const char* b2 = uni(last ? nB : cB + (size_t)(t + 2) * kstep);
            const char* a3 = uni(a2 + kstep); const char* b3 = uni(b2 + kstep);
            const int u2 = last ? nui : ui;
            GS_LDB(B0, 0, 0); GS_LDB(B1, 0, 1); GS_SCHED; GS_LDA(At, 0, 0); GS_STAGE(GS_SA(1, 1), a1, ui, 1);
            GS_WAIT_V(8); GS_WAIT_L(0); GS_BAR; GS_MMA(0, 0, At, B0); GS_MMA(0, 1, At, B1); GS_BAR; GS_SCHED;
            GS_LDA(At, 0, 1); GS_STAGEB(GS_SB(0, 0), b2, voffB); GS_STAGEB(GS_SB(0, 1), b2 + hstepB, voffB); GS_STAGE(GS_SA(0, 0), a2, u2, 0);
            GS_WAIT_V(8); GS_WAIT_L(0); GS_BAR; GS_MMA(1, 0, At, B0); GS_MMA(1, 1, At, B1); GS_BAR; GS_SCHED;
            GS_LDB(B0, 1, 0); GS_LDB(B1, 1, 1); GS_SCHED; GS_LDA(At, 1, 0); GS_STAGE(GS_SA(0, 1), a2, u2, 1);
            GS_WAIT_V(8); GS_WAIT_L(0); GS_BAR; GS_MMA(0, 0, At, B0); GS_MMA(0, 1, At, B1); GS_BAR; GS_SCHED;
            GS_LDA(At, 1, 1); GS_STAGEB(GS_SB(1, 0), b3, voffB); GS_STAGEB(GS_SB(1, 1), b3 + hstepB, voffB); GS_STAGE(GS_SA(1, 0), a3, u2, 0);
            GS_WAIT_V(8); GS_WAIT_L(0); GS_BAR; GS_MMA(1, 0, At, B0); GS_MMA(1, 1, At, B1); GS_BAR; GS_SCHED;
        }
        if (wr == 0) GS_BAR;
        if (F8 == 2) asm volatile("s_nop 15\n\ts_nop 15\n\ts_nop 15\n\ts_nop 15\n\ts_nop 15\n\ts_nop 15" ::: "memory");
        E(acc, cur, wr, wc, fr, fq);
        if (!has_next) break;
#pragma unroll
        for (int a = 0; a < 2; ++a)
#pragma unroll
            for (int b = 0; b < 2; ++b)
#pragma unroll
                for (int m = 0; m < 4; ++m)
#pragma unroll
                    for (int n = 0; n < 2; ++n) acc[a][b][m][n] = (f32x4){0.f, 0.f, 0.f, 0.f};
        cur = nxt; cA = nA; cB = nB; ++ui;
        if (wr == 1) GS_BAR;
    }
    GS_WAIT_V(0);
    GS_BAR;
#undef GS_SA
#undef GS_SB
#undef GS_STAGE
#undef GS_STAGEB
#undef GS_LDA
#undef GS_LD32
#undef GS_LDB
#undef GS_MMA
#undef GS_WAIT_V
#undef GS_WAIT_L
#undef GS_BAR
#undef GS_SCHED
}
struct DenseU { const char* A; const char* B; int pm, pn; };
struct DenseSched {
    typedef DenseU U;
    const bf16_t* A; const bf16_t* Bt; int K, nunits, first, stride, npn, pn_base, pn_mod0, pn_mod1;
    DI int colmap(int q) const { return pn_base + (q / pn_mod0) * pn_mod1 + (q % pn_mod0); }
    DI bool next(int i, U& u) const {
        const int L = first + i * stride; if (L >= nunits) return false;
        u.pm = L / npn; u.pn = colmap(L % npn);
        u.A = (const char*)A + (size_t)u.pm * BM * K * 2; u.B = (const char*)Bt + (size_t)u.pn * BM * K * 2; return true;
    }
    DI unsigned a_voff(int, int h, int R, int C) const { return (unsigned)((HALF * h + R) * K + C) * 2u; }
};
}

DI void transpose_cvt(const float* W, bf16_t* Wt, int K, int N, int unit, char* lds) {
    float* tile = (float*)lds;
    const int nbn = N / 64, kb = unit / nbn, nb = unit % nbn, tid = tidx();
    __syncthreads();
#pragma unroll
    for (int i = 0; i < 8; ++i) { const int idx = tid + i * 512, r = idx >> 6, c = idx & 63; tile[r * 65 + c] = W[(size_t)(kb * 64 + r) * N + nb * 64 + c]; }
    __syncthreads();
#pragma unroll
    for (int i = 0; i < 8; ++i) { const int idx = tid + i * 512, n = idx >> 6, k = idx & 63; Wt[(size_t)(nb * 64 + n) * K + kb * 64 + k] = f2bf(tile[k * 65 + n]); }
}
struct P0Args { const float* x; const float* w_in; const float* w_out; const float* router_w; bf16_t* xb; bf16_t* wt_in; bf16_t* wt_out; bf16_t* wt_r;
                const float* w_gate; const float* w_up; const float* w_down; const float* ws_gate; const float* ws_up; const float* ws_down; unsigned char* wgut; unsigned char* wdt; };
constexpr int CV_GU = 257 * 2 * 16, CV_DN = 257 * 16;
struct CvItem { const float* src; unsigned char* dst; int ld, ldd, rbase, rhi; };
DI CvItem cv_item(const P0Args& a, int it) {
    CvItem c;
    if (it < CV_GU) {
        const int e = it / 32, u = (it >> 4) & 1, kt = it & 15;
        const float* W = e < N_EXP ? (u ? a.w_up : a.w_gate) + (size_t)e * D_MODEL * D_EXP : (u ? a.ws_up : a.ws_gate);
        c.src = W + (size_t)kt * 64 * D_EXP; c.ld = D_EXP; c.dst = a.wgut + (size_t)e * 512 * D_MODEL + kt * 64; c.ldd = D_MODEL; c.rbase = 128 * u; c.rhi = 256;
    } else {
        const int j = it - CV_GU, e = j / 16, kt = (j >> 2) & 3, nb = j & 3;
        const float* W = e < N_EXP ? a.w_down + (size_t)e * D_EXP * D_MODEL : a.ws_down;
        c.src = W + (size_t)kt * 64 * D_MODEL + nb * 256; c.ld = D_MODEL; c.dst = a.wdt + (size_t)e * D_MODEL * D_EXP + kt * 64; c.ldd = D_EXP; c.rbase = 256 * nb; c.rhi = 128;
    }
    return c;
}
DI void cv_load(const CvItem& c, f32x4 (&v)[8]) {
    const int tid = tidx();
#pragma unroll
    for (int i = 0; i < 8; ++i) { const int idx = tid + i * 512, k = idx >> 6, n4 = idx & 63; v[i] = __builtin_nontemporal_load((const f32x4*)(c.src + (size_t)k * c.ld + 4 * n4)); }
}
DI void cv_store(const CvItem& c, const f32x4 (&v)[8], char* lds) {
    float* tile = (float*)lds;
    const int tid = tidx();
    __syncthreads();
#pragma unroll
    for (int i = 0; i < 8; ++i) { const int idx = tid + i * 512, k = idx >> 6, n4 = idx & 63; *(f32x4*)(tile + k * 260 + 4 * (n4 ^ ((k >> 3) & 7))) = v[i]; }
    __syncthreads();
#pragma unroll
    for (int i = 0; i < 4; ++i) {
        const int idx = tid + i * 512, kc = idx & 7, n = idx >> 3; const float* p = tile + (8 * kc) * 260 + (n ^ (4 * kc));
        const unsigned w0 = pack_fp8x4(p[0] * WSCALE, p[260] * WSCALE, p[2 * 260] * WSCALE, p[3 * 260] * WSCALE), w1 = pack_fp8x4(p[4 * 260] * WSCALE, p[5 * 260] * WSCALE, p[6 * 260] * WSCALE, p[7 * 260] * WSCALE);
        __builtin_nontemporal_store((u32x2){w0, w1}, (u32x2*)(c.dst + (size_t)(c.rbase + (n >> 7) * c.rhi + (n & 127)) * c.ldd + 8 * kc));
    }
}
DI void convert_moe_range(const P0Args& a, char* lds, const int lo, const int hi) {
    int it = lo + vblock(); if (it >= hi) return;
    CvItem c = cv_item(a, it); f32x4 v[8]; cv_load(c, v);
#pragma unroll 1
    for (;;) {
        const int nit = it + GRID; const bool more = nit < hi;
        CvItem cn = c; f32x4 w[8];
        if (more) { cn = cv_item(a, nit); cv_load(cn, w); }
        cv_store(c, v, lds);
        if (!more) break;
        it = nit; c = cn;
#pragma unroll
        for (int i = 0; i < 8; ++i) v[i] = w[i];
    }
}
DI void phase_prologue(const P0Args& a, char* lds) {
    const int vb = vblock();
    for (size_t i = (size_t)vb * NTHR + tidx(); i < (size_t)T_TOK * D_MODEL / 8; i += (size_t)GRID * NTHR) {
        const f32x4 v0 = *(const f32x4*)(a.x + i * 8), v1 = *(const f32x4*)(a.x + i * 8 + 4);
        u32x4 o; o.x = cvt_pk_bf16(v0[0], v0[1]); o.y = cvt_pk_bf16(v0[2], v0[3]); o.z = cvt_pk_bf16(v1[0], v1[1]); o.w = cvt_pk_bf16(v1[2], v1[3]);
        *(u32x4*)(a.xb + i * 8) = o;
    }
    const int n_in = (1024 / 64) * (3072 / 64), n_out = 16 * 16, n_r = 16 * 4;
    for (int u = vb; u < n_in + n_out + n_r; u += GRID) {
        if (u < n_in) transpose_cvt(a.w_in, a.wt_in, 1024, 3072, u, lds);
        else if (u < n_in + n_out) transpose_cvt(a.w_out, a.wt_out, 1024, 1024, u - n_in, lds);
        else transpose_cvt(a.router_w, a.wt_r, 1024, 256, u - n_in - n_out, lds);
    }
}


struct P1Args { const bf16_t* xb; const bf16_t* wt_in; bf16_t* Q; bf16_t* Kb; bf16_t* Vt; };
struct EpiQK { bf16_t* Q; bf16_t* Kb;
    DI void operator()(const f32x4 (&acc)[2][2][4][2], const gs::DenseU& u, int wr, int wc, int fr, int fq) const {
        const int seg = u.pn >> 1, type = seg % 3, grp = seg / 3; bf16_t* dst = type == 0 ? Q : Kb; const float sc = type == 0 ? QSCALE : 1.f;
#pragma unroll
        for (int ai = 0; ai < 2; ++ai)
#pragma unroll
            for (int m = 0; m < 4; ++m) {
                const int row = u.pm * 256 + 128 * ai + 64 * wr + 16 * m + fr, b = row / SEQ, s = row % SEQ;
#pragma unroll
                for (int bj = 0; bj < 2; ++bj) {
                    const int hh = grp * 8 + 4 * (u.pn & 1) + 2 * bj + (wc >> 1), d0 = 32 * (wc & 1) + 8 * fq;
                    const f32x4 v0 = acc[ai][bj][m][0] * sc, v1 = acc[ai][bj][m][1] * sc;
                    u32x4 o; o.x = cvt_pk_bf16(v0[0], v0[1]); o.y = cvt_pk_bf16(v0[2], v0[3]); o.z = cvt_pk_bf16(v1[0], v1[1]); o.w = cvt_pk_bf16(v1[2], v1[3]);
                    *(u32x4*)(dst + (size_t)(b * NHH + hh) * SEQ * 64 + (s >> 5) * 2048 + ((d0 >> 3) * 32 + (s & 31)) * 8) = o;
                }
            }
    } };
struct EpiV { bf16_t* Vt;
    DI void operator()(const f32x4 (&acc)[2][2][4][2], const gs::DenseU& u, int wr, int wc, int fr, int fq) const {
        const int grp = (u.pn >> 1) / 3;
#pragma unroll
        for (int ai = 0; ai < 2; ++ai)
#pragma unroll
            for (int m = 0; m < 4; ++m) {
                const int row = u.pm * 256 + 128 * ai + 64 * wr + 16 * m + 4 * fq, b = row / SEQ, s = row % SEQ;
#pragma unroll
                for (int bj = 0; bj < 2; ++bj)
#pragma unroll
                    for (int n = 0; n < 2; ++n) {
                        const int hh = grp * 8 + 4 * (u.pn & 1) + 2 * bj + (wc >> 1), d = 32 * (wc & 1) + 16 * n + fr;
                        const f32x4 v = acc[ai][bj][m][n];
                        u32x2 o; o.x = cvt_pk_bf16(v[0], v[1]); o.y = cvt_pk_bf16(v[2], v[3]);
                        { const int kap = s & 31; *(u32x2*)(Vt + (size_t)(b * NHH + hh) * SEQ * 64 + (s >> 5) * 2048 + ((((d >> 5) * 2 + (kap >> 4)) * 2 + ((kap >> 2) & 1)) * 32 + (d & 31)) * 8 + ((kap >> 3) & 1) * 4) = o; }
                    }
            }
    } };
DI void phase_qkv(const P1Args& a, LAS unsigned char* lds) {
    { gs::DenseSched S{a.xb, a.wt_in, D_MODEL, (T_TOK / 256) * 8, vblock(), GRID, 8, 0, 4, 6}; EpiQK E{a.Q, a.Kb}; gs::gemm_stream<true, true, 0>(lds, D_MODEL, S, E); }
    { gs::DenseSched S{a.xb, a.wt_in, D_MODEL, (T_TOK / 256) * 4, vblock(), GRID, 4, 4, 2, 6}; EpiV E{a.Vt}; gs::gemm_stream<false, false, 0>(lds, D_MODEL, S, E); }
}

struct P3Args { const bf16_t* y; const bf16_t* wt_out; const bf16_t* xb; bf16_t* r; float* stats; };
struct EpiOut { const bf16_t* xb; bf16_t* r; float* stats;
    DI void operator()(const f32x4 (&acc)[2][2][4][2], const gs::DenseU& u, int wr, int wc, int fr, int fq) const {
#pragma unroll
        for (int ai = 0; ai < 2; ++ai) {
            u32x4 xw[4][2];
#pragma unroll
            for (int m = 0; m < 4; ++m)
#pragma unroll
                for (int bj = 0; bj < 2; ++bj) xw[m][bj] = *(const u32x4*)(xb + (size_t)(u.pm * 256 + 128 * ai + 64 * wr + 16 * m + fr) * D_MODEL + u.pn * 256 + 128 * bj + 32 * wc + 8 * fq);
#pragma unroll
            for (int m = 0; m < 4; ++m) {
                const int row = u.pm * 256 + 128 * ai + 64 * wr + 16 * m + fr;
#pragma unroll
                for (int bj = 0; bj < 2; ++bj) {
                    const int col = u.pn * 256 + 128 * bj + 32 * wc + 8 * fq;
                    const u32x4 w = xw[m][bj];
                    const f32x4 x0 = (f32x4){__uint_as_float(w[0] << 16), __uint_as_float(w[0] & 0xffff0000u), __uint_as_float(w[1] << 16), __uint_as_float(w[1] & 0xffff0000u)};
                    const f32x4 x1 = (f32x4){__uint_as_float(w[2] << 16), __uint_as_float(w[2] & 0xffff0000u), __uint_as_float(w[3] << 16), __uint_as_float(w[3] & 0xffff0000u)};
                    const f32x4 v0 = x0 * DN_ALPHA + acc[ai][bj][m][0], v1 = x1 * DN_ALPHA + acc[ai][bj][m][1];
                    float s = ((v0[0] + v0[1]) + (v0[2] + v0[3])) + ((v1[0] + v1[1]) + (v1[2] + v1[3]));
                    float q = ((v0[0] * v0[0] + v0[1] * v0[1]) + (v0[2] * v0[2] + v0[3] * v0[3])) + ((v1[0] * v1[0] + v1[1] * v1[1]) + (v1[2] * v1[2] + v1[3] * v1[3]));
                    u32x4 o; o.x = cvt_pk_bf16(v0[0], v0[1]); o.y = cvt_pk_bf16(v0[2], v0[3]); o.z = cvt_pk_bf16(v1[0], v1[1]); o.w = cvt_pk_bf16(v1[2], v1[3]);
                    *(u32x4*)(r + (size_t)row * D_MODEL + col) = o;
                    s += __shfl_xor(s, 16); s += __shfl_xor(s, 32); q += __shfl_xor(q, 16); q += __shfl_xor(q, 32);
                    if (fq == 0) *(f32x2*)(stats + ((size_t)row * 32 + u.pn * 8 + bj * 4 + wc) * 2) = (f32x2){s, q};
                }
            }
        }
    } };
DI void phase_outproj(const P3Args& a, LAS unsigned char* lds) {
    gs::DenseSched S{a.y, a.wt_out, D_MODEL, (T_TOK / 256) * 4, vblock(), GRID, 4, 0, 4, 0}; EpiOut E{a.xb, a.r, a.stats}; gs::gemm_stream<true, true, 0>(lds, D_MODEL, S, E);
}

DI void unpack16(const u32x4& a, const u32x4& b, float (&v)[16]) {
#pragma unroll
    for (int j = 0; j < 4; ++j) { v[2 * j] = __uint_as_float(a[j] << 16); v[2 * j + 1] = __uint_as_float(a[j] & 0xffff0000u); v[8 + 2 * j] = __uint_as_float(b[j] << 16); v[8 + 2 * j + 1] = __uint_as_float(b[j] & 0xffff0000u); }
}
constexpr int RS_SC = 289;
constexpr int LDS_HIST = 100 * 1024;
struct P4Args { const bf16_t* r; const float* stats; const float* ln_g; const float* ln_b; bf16_t* x1; unsigned char* x1f8; const bf16_t* wt_r; const float* rbias;
                int* eidx; float* gate; int* counts; int* tokl; float* gatel; int* slot; };
DI void phase_router(const P4Args& a, const P0Args& cv, char* lds) {
    const int tid = tidx(), wid = tid >> 6, lane = tid & 63, wr = wid >> 2, wc = wid & 3, fr = lane & 15, fq = lane >> 4;
    float* sc = (float*)lds; int* hist = (int*)(lds + LDS_HIST); int* base = hist + 256;
    for (int u = vblock(); u < T_TOK / 128; u += GRID) {
        const int m0 = u * 128;
        if ((vblock() & 1) == 0) convert_moe_range(cv, lds, CV_GU, CV_GU + CV_DN);
        __syncthreads();
#pragma unroll 1
        for (int i0 = 0; i0 < 16; i0 += 4) {
            f32x2 st[4]; u32x4 r0[4], r1[4];
#pragma unroll
            for (int j4 = 0; j4 < 4; ++j4) {
                const int t = m0 + wid * 16 + i0 + j4;
                st[j4] = (f32x2){0.f, 0.f};
                if (lane < 32) st[j4] = *(const f32x2*)(a.stats + ((size_t)t * 32 + lane) * 2);
                r0[j4] = *(const u32x4*)(a.r + (size_t)t * D_MODEL + lane * 16); r1[j4] = *(const u32x4*)(a.r + (size_t)t * D_MODEL + lane * 16 + 8);
            }
#pragma unroll
            for (int j4 = 0; j4 < 4; ++j4) {
                const int t = m0 + wid * 16 + i0 + j4;
                float s = st[j4].x, q = st[j4].y;
#pragma unroll
                for (int o = 1; o <= 16; o <<= 1) { s += __shfl_xor(s, o); q += __shfl_xor(q, o); }
                s = __shfl(s, 0); q = __shfl(q, 0);
                const float mu = s * (1.f / 1024.f), rstd = rsqrtf(q * (1.f / 1024.f) - mu * mu + LN_EPS);
                float v[16]; unpack16(r0[j4], r1[j4], v);
                u32x4 o0, o1, o8;
#pragma unroll
                for (int j = 0; j < 4; ++j) {
                    const f32x4 g = *(const f32x4*)(a.ln_g + lane * 16 + 4 * j), bb = *(const f32x4*)(a.ln_b + lane * 16 + 4 * j);
                    const float y0 = (v[4 * j] - mu) * rstd * g[0] + bb[0], y1 = (v[4 * j + 1] - mu) * rstd * g[1] + bb[1], y2 = (v[4 * j + 2] - mu) * rstd * g[2] + bb[2], y3 = (v[4 * j + 3] - mu) * rstd * g[3] + bb[3];
                    o8[j] = pack_fp8x4(y0 * XSCALE, y1 * XSCALE, y2 * XSCALE, y3 * XSCALE);
                    const unsigned p0 = cvt_pk_bf16(y0, y1), p1 = cvt_pk_bf16(y2, y3);
                    if (j < 2) { o0[2 * j] = p0; o0[2 * j + 1] = p1; } else { o1[2 * (j - 2)] = p0; o1[2 * (j - 2) + 1] = p1; }
                }
                *(u32x4*)(a.x1 + (size_t)t * D_MODEL + lane * 16) = o0; *(u32x4*)(a.x1 + (size_t)t * D_MODEL + lane * 16 + 8) = o1;
                *(u32x4*)(a.x1f8 + (size_t)t * D_MODEL + lane * 16) = o8;
            }
        }
        if (tid < 256) hist[tid] = 0;
        asm volatile("s_waitcnt vmcnt(0)" ::: "memory");
        __syncthreads();
        ALoader<4> al; al.init_rows(a.x1, D_MODEL, m0);
        BLoaderBt bl; bl.init(a.wt_r, D_MODEL, 0);
        f32x4 acc[4][4];
        gemm_tile<4, true>(lds, al, bl, D_MODEL / 64, acc);
        int my_idx[2], my_rank[2]; float my_gate[2];
#pragma unroll
        for (int p = 0; p < 2; ++p) {
            __syncthreads();
            if (wr == p) {
#pragma unroll
                for (int m = 0; m < 4; ++m)
#pragma unroll
                    for (int n = 0; n < 4; ++n) {
                        const int c0 = 64 * wc + 16 * n + 4 * fq; const f32x4 rb = *(const f32x4*)(a.rbias + c0);
#pragma unroll
                        for (int j = 0; j < 4; ++j) { const int c = c0 + j; sc[(16 * m + fr) * RS_SC + (c >> 5) * 36 + (c & 31)] = 1.f / (1.f + __expf(-acc[m][n][j])) + rb[j]; }
                    }
            }
            __syncthreads();
            const int row = tid >> 3, g = tid & 7, t = m0 + 64 * p + row;
            float sel[32];
#pragma unroll
            for (int i = 0; i < 32; ++i) sel[i] = sc[row * RS_SC + g * 36 + i];
            float m1 = -INFINITY, m2 = -INFINITY;
#pragma unroll
            for (int i = 0; i < 32; ++i) { const float v = sel[i]; m2 = fmaxf(m2, fminf(m1, v)); m1 = fmaxf(m1, v); }
            const float gs = m1 + m2; int rank = 0;
#pragma unroll
            for (int d = 1; d < 8; ++d) { const float o = __shfl_xor(gs, d); const int og = g ^ d; rank += (o > gs || (o == gs && og < g)) ? 1 : 0; }
            const bool en = rank < TOPK_GROUPS;
            float lv = -INFINITY; int li = 1 << 20;
            if (en) {
#pragma unroll
                for (int i = 0; i < 32; ++i) { const float v = sel[i]; if (v > lv) { lv = v; li = g * 32 + i; } }
            }
            float myv = 0.f; int myi = 0;
#pragma unroll
            for (int k = 0; k < TOP_K; ++k) {
                float bv = lv; int bi = li;
#pragma unroll
                for (int d = 1; d < 8; d <<= 1) { const float ov = __shfl_xor(bv, d); const int oi = __shfl_xor(bi, d); if (ov > bv || (ov == bv && oi < bi)) { bv = ov; bi = oi; } }
                if (g == k) { myv = bv; myi = bi; }
                if (k + 1 < TOP_K && (bi >> 5) == g) {
                    lv = -INFINITY; li = 1 << 20;
#pragma unroll
                    for (int i = 0; i < 32; ++i) { if (g * 32 + i == bi) sel[i] = -INFINITY; const float v = sel[i]; if (v > lv) { lv = v; li = g * 32 + i; } }
                }
            }
            const float score = myv - a.rbias[myi];
            float gsum = score;
#pragma unroll
            for (int d = 1; d < 8; d <<= 1) gsum += __shfl_xor(gsum, d);
            const float gt = score / gsum * ROUTED_SCALE;
            a.eidx[t * TOP_K + g] = myi; a.gate[t * TOP_K + g] = gt;
            my_idx[p] = myi; my_gate[p] = gt; my_rank[p] = atomicAdd(&hist[myi], 1);
        }
        __syncthreads();
        if (tid < 256) { const int h = hist[tid]; base[tid] = h > 0 ? atomicAdd(&a.counts[tid * CSTR], h) : 0; }
        __syncthreads();
#pragma unroll
        for (int p = 0; p < 2; ++p) {
            const int row = tid >> 3, g = tid & 7, t = m0 + 64 * p + row, e = my_idx[p], pos = base[e] + my_rank[p];
            a.tokl[(size_t)e * CAP + pos] = t; a.gatel[(size_t)e * CAP + pos] = my_gate[p]; a.slot[t * TOP_K + g] = e * CAP + pos;
        }
        if ((vblock() & 1) == 1) convert_moe_range(cv, lds, CV_GU, CV_GU + CV_DN);
    }
}

constexpr int LDS_ROWTAB = 128 * 1024;
constexpr int LDS_GTAB = 139 * 1024;
constexpr int LDS_TAB = 150 * 1024;
constexpr int MOE_BM = 256;
DI void build_moe_tab(const int* counts, char* lds) {
    int* tstart = (int*)(lds + LDS_TAB); int* rstart = tstart + 264; int* cnts = tstart + 528;
    const int tid = tidx(), lane = tid & 63;
    __syncthreads();
    if (tid < 64) {
        int c[4], tl[4], cs = 0, ts = 0;
#pragma unroll
        for (int i = 0; i < 4; ++i) { c[i] = counts[(lane * 4 + i) * CSTR]; tl[i] = (c[i] + MOE_BM - 1) / MOE_BM; cs += c[i]; ts += tl[i]; }
        int ci = cs, ti = ts;
#pragma unroll
        for (int o = 1; o < 64; o <<= 1) { const int n1 = __shfl_up(ci, o), n2 = __shfl_up(ti, o); if (lane >= o) { ci += n1; ti += n2; } }
        int ce = ci - cs, te = ti - ts;
#pragma unroll
        for (int i = 0; i < 4; ++i) { rstart[lane * 4 + i] = ce; tstart[lane * 4 + i] = te; cnts[lane * 4 + i] = c[i]; ce += c[i]; te += tl[i]; }
        if (lane == 63) { rstart[256] = ce; tstart[256] = te; cnts[256] = T_TOK; rstart[257] = ce + T_TOK; tstart[257] = te + T_TOK / MOE_BM; }
    }
    __syncthreads();
}
DI int find_expert(const int* tstart, int g) {
    int lo = 0, hi = 256;
#pragma unroll 1
    while (lo < hi) { const int mid = (lo + hi + 1) >> 1; if (tstart[mid] <= g) lo = mid; else hi = mid - 1; }
    return lo;
}
struct MoeU { const char* A; const char* B; int e, m0, sub, ui; };
typedef const LAS int* ltab_t;
DI int find_expert_l(ltab_t tstart, int g) { int lo = 0, hi = 256;
#pragma unroll 1
    while (lo < hi) { const int mid = (lo + hi + 1) >> 1; if (tstart[mid] <= g) lo = mid; else hi = mid - 1; }
    return lo; }

struct P6Args { const unsigned char* x1; const int* counts; const int* tokl; const float* gatel; const unsigned char* wgut; unsigned char* H; };
struct GuSched {
    typedef MoeU U;
    ltab_t tab; const LAS int* rowtab; const unsigned char* x1; const unsigned char* wgut; int first, stride, nunits;
    DI bool next(int i, U& u) const {
        const int L = first + i * stride; if (L >= nunits) return false;
        const int g = L >> 1, e = find_expert_l(tab, g);
        u.sub = L & 1; u.e = e; u.ui = i; u.m0 = (g - tab[e]) * MOE_BM;
        u.A = (const char*)x1; u.B = (const char*)(wgut + ((size_t)e * 512 + 256 * u.sub) * D_MODEL); return true;
    }
    DI unsigned a_voff(int i, int h, int R, int C) const { return (unsigned)(rowtab[i * 256 + 128 * h + R] * (D_MODEL / 2) + C) * 2u; }
};
struct EpiGU { unsigned char* H; const LAS float* gtab; ltab_t tab;
    DI void operator()(const f32x4 (&acc)[2][2][4][2], const MoeU& u, int wr, int wc, int fr, int fq) const {
        const int st = tab[264 + u.e], cnt = tab[528 + u.e];
#pragma unroll
        for (int ai = 0; ai < 2; ++ai)
#pragma unroll
            for (int m = 0; m < 4; ++m) {
                const int row = u.m0 + 128 * ai + 64 * wr + 16 * m + fr;
                if (row < cnt) {
                    const float gt = gtab[u.ui * 256 + 128 * ai + 64 * wr + 16 * m + fr] * (HSCALE / (XSCALE * WSCALE));
                    float h[8];
#pragma unroll
                    for (int n = 0; n < 2; ++n)
#pragma unroll
                        for (int j = 0; j < 4; ++j) { const float gv = acc[ai][0][m][n][j] * (1.f / (XSCALE * WSCALE)); h[4 * n + j] = gv * __builtin_amdgcn_rcpf(1.f + __expf(-gv)) * acc[ai][1][m][n][j] * gt; }
                    *(u32x2*)(H + (size_t)(st + row) * D_EXP + 128 * u.sub + 32 * wc + 8 * fq) = (u32x2){pack_fp8x4(h[0], h[1], h[2], h[3]), pack_fp8x4(h[4], h[5], h[6], h[7])};
                }
            }
    } };
DI void phase_moe_gu(const P6Args& a, char* smem, LAS unsigned char* lds) {
    build_moe_tab(a.counts, smem);
    const int* tstart = (const int*)(smem + LDS_TAB); const int* rstart = tstart + 264; int* rowtab = (int*)(smem + LDS_ROWTAB); float* gtab = (float*)(smem + LDS_GTAB);
    const int nunits = tstart[257] * 2, first = vblock();
    const int n_my = first < nunits ? (nunits - first + GRID - 1) / GRID : 0;
    for (int idx = tidx(); idx < n_my * 256; idx += NTHR) {
        const int i = idx >> 8, row = idx & 255, L = first + i * GRID, g = L >> 1, e = find_expert(tstart, g), m0 = (g - tstart[e]) * MOE_BM, cnt = tstart[528 + e];
        int rr = m0 + row; rr = rr < cnt ? rr : cnt - 1;
        rowtab[idx] = e < N_EXP ? a.tokl[(size_t)e * CAP + rr] : rr;
        gtab[idx] = e < N_EXP ? a.gatel[(size_t)e * CAP + rr] : 1.f;
    }
    __syncthreads();
    GuSched S{(ltab_t)(lds + LDS_TAB), (const LAS int*)(lds + LDS_ROWTAB), a.x1, a.wgut, first, GRID, nunits}; EpiGU E{a.H, (const LAS float*)(lds + LDS_GTAB), (ltab_t)(lds + LDS_TAB)};
    gs::gemm_stream<true, true, 2>(lds, D_MODEL / 2, S, E);
}
struct P7Args { const unsigned char* H; const int* counts; const unsigned char* wdt; unsigned char* Y; };
struct DownSched {
    typedef MoeU U;
    ltab_t tab; const unsigned char* H; const unsigned char* wdt; int first, stride, nunits;
    DI bool next(int i, U& u) const {
        const int L = first + i * stride; if (L >= nunits) return false;
        const int g = L >> 2, e = find_expert_l(tab, g);
        u.sub = L & 3; u.e = e; u.ui = i; u.m0 = (g - tab[e]) * MOE_BM;
        u.A = (const char*)(H + (size_t)(tab[264 + e] + u.m0) * D_EXP); u.B = (const char*)(wdt + ((size_t)e * D_MODEL + 256 * u.sub) * D_EXP); return true;
    }
    DI unsigned a_voff(int, int h, int R, int C) const { return (unsigned)((128 * h + R) * (D_EXP / 2) + C) * 2u; }
};
struct EpiDown { unsigned char* Y; ltab_t tab;
    DI void operator()(const f32x4 (&acc)[2][2][4][2], const MoeU& u, int wr, int wc, int fr, int fq) const {
        const int st = tab[264 + u.e], cnt = tab[528 + u.e];
#pragma unroll
        for (int ai = 0; ai < 2; ++ai)
#pragma unroll
            for (int m = 0; m < 4; ++m) {
                const int row = u.m0 + 128 * ai + 64 * wr + 16 * m + fr;
                if (row < cnt) {
#pragma unroll
                    for (int bj = 0; bj < 2; ++bj) {
                        f32x4 v0 = acc[ai][bj][m][0] * (YSCALE / (HSCALE * WSCALE)), v1 = acc[ai][bj][m][1] * (YSCALE / (HSCALE * WSCALE));
#pragma unroll
                        for (int j = 0; j < 4; ++j) { v0[j] = __builtin_amdgcn_fmed3f(v0[j], -440.f, 440.f); v1[j] = __builtin_amdgcn_fmed3f(v1[j], -440.f, 440.f); }
                        int w0 = 0, w1 = 0;
                        w0 = __builtin_amdgcn_cvt_pk_fp8_f32(v0[0], v0[1], w0, false); w0 = __builtin_amdgcn_cvt_pk_fp8_f32(v0[2], v0[3], w0, true);
                        w1 = __builtin_amdgcn_cvt_pk_fp8_f32(v1[0], v1[1], w1, false); w1 = __builtin_amdgcn_cvt_pk_fp8_f32(v1[2], v1[3], w1, true);
                        *(u32x2*)(Y + (size_t)(st + row) * D_MODEL + 256 * u.sub + 128 * bj + 32 * wc + 8 * fq) = (u32x2){(unsigned)w0, (unsigned)w1};
                    }
                }
            }
    } };
DI void phase_moe_down(const P7Args& a, char* smem, LAS unsigned char* lds) {
    build_moe_tab(a.counts, smem);
    const int* tstart = (const int*)(smem + LDS_TAB); const int* rstart = tstart + 264;
    DownSched S{(ltab_t)(lds + LDS_TAB), a.H, a.wdt, vblock(), GRID, tstart[257] * 4}; EpiDown E{a.Y, (ltab_t)(lds + LDS_TAB)};
    gs::gemm_stream<true, true, 2>(lds, D_EXP / 2, S, E);
}
struct P8Args { const bf16_t* x1; const unsigned char* Y; const int* slot; const int* counts; const float* ln_g; const float* ln_b; float* out; };
DI void phase_combine(const P8Args& a, char* lds) {
    const int tid = tidx(), wid = tid >> 6, lane = tid & 63;
    build_moe_tab(a.counts, lds);
    const int* rstart = (const int*)(lds + LDS_TAB) + 264;
    const int sh0 = rstart[256];
    for (int t = vblock() * 8 + wid; t < T_TOK; t += GRID * 8) {
        float v[16], w[16];
        { const u32x4 p0 = *(const u32x4*)(a.x1 + (size_t)t * D_MODEL + lane * 16), p1 = *(const u32x4*)(a.x1 + (size_t)t * D_MODEL + lane * 16 + 8); unpack16(p0, p1, v); }
        int sl = 0; if (lane < TOP_K) sl = a.slot[t * TOP_K + lane];
        u32x4 yr[9];
        yr[8] = *(const u32x4*)(a.Y + (size_t)(sh0 + t) * D_MODEL + lane * 16);
#pragma unroll
        for (int k = 0; k < TOP_K; ++k) { const int s = __shfl(sl, k), e = s / CAP, pos = s % CAP; yr[k] = *(const u32x4*)(a.Y + (size_t)(rstart[e] + pos) * D_MODEL + lane * 16); }
#pragma unroll
        for (int i = 0; i < 16; ++i) w[i] = 0.f;
#pragma unroll
        for (int k = 0; k < 9; ++k)
#pragma unroll
            for (int j = 0; j < 4; ++j) { const f32x2 lo = __builtin_amdgcn_cvt_pk_f32_fp8((int)yr[k][j], false), hi = __builtin_amdgcn_cvt_pk_f32_fp8((int)yr[k][j], true); w[4 * j] += lo.x; w[4 * j + 1] += lo.y; w[4 * j + 2] += hi.x; w[4 * j + 3] += hi.y; }
#pragma unroll
        for (int i = 0; i < 16; ++i) v[i] = v[i] * DN_ALPHA + w[i] * (1.f / YSCALE);
        float s = 0.f;
#pragma unroll
        for (int i = 0; i < 16; ++i) s += v[i];
#pragma unroll
        for (int o = 32; o >= 1; o >>= 1) s += __shfl_xor(s, o);
        const float mu = s * (1.f / 1024.f);
        float q = 0.f;
#pragma unroll
        for (int i = 0; i < 16; ++i) { const float d = v[i] - mu; q += d * d; }
#pragma unroll
        for (int o = 32; o >= 1; o >>= 1) q += __shfl_xor(q, o);
        const float rstd = rsqrtf(q * (1.f / 1024.f) + LN_EPS);
#pragma unroll
        for (int j = 0; j < 4; ++j) {
            const f32x4 g = *(const f32x4*)(a.ln_g + lane * 16 + 4 * j), bb = *(const f32x4*)(a.ln_b + lane * 16 + 4 * j);
            f32x4 o; o[0] = (v[4 * j] - mu) * rstd * g[0] + bb[0]; o[1] = (v[4 * j + 1] - mu) * rstd * g[1] + bb[1]; o[2] = (v[4 * j + 2] - mu) * rstd * g[2] + bb[2]; o[3] = (v[4 * j + 3] - mu) * rstd * g[3] + bb[3];
            *(f32x4*)(a.out + (size_t)t * D_MODEL + lane * 16 + 4 * j) = o;
        }
    }
}

#define MFMA32(a, b, c) __builtin_amdgcn_mfma_f32_32x32x16_bf16((a), (b), (c), 0, 0, 0)
constexpr float SB_EXIT_THR = 1e-30f;
struct P2Args { const bf16_t* Q; const bf16_t* Kb; const bf16_t* Vt; const float* rel_bias; const float* gain_a; const float* gain_b; bf16_t* y; };

DI bf16x8 pack8(const f32x16& x, int s) {
    u32x4 p;
    if (s == 0) { p.x = cvt_pk_bf16(x[0], x[1]); p.y = cvt_pk_bf16(x[2], x[3]); p.z = cvt_pk_bf16(x[4], x[5]); p.w = cvt_pk_bf16(x[6], x[7]); }
    else        { p.x = cvt_pk_bf16(x[8], x[9]); p.y = cvt_pk_bf16(x[10], x[11]); p.z = cvt_pk_bf16(x[12], x[13]); p.w = cvt_pk_bf16(x[14], x[15]); }
    return __builtin_bit_cast(bf16x8, p);
}
DI void load_k(bf16x8 (&k)[4], const bf16_t* kp, int k0) {
#pragma unroll
    for (int kk = 0; kk < 4; ++kk) k[kk] = *(const bf16x8*)(kp + (size_t)(k0 >> 5) * 2048 + kk * 512);
}
DI void load_v(bf16x8 (&v)[2][2], const bf16_t* vp, int k0) {
#pragma unroll
    for (int dt = 0; dt < 2; ++dt)
#pragma unroll
        for (int s = 0; s < 2; ++s) v[dt][s] = *(const bf16x8*)(vp + (size_t)(k0 >> 5) * 2048 + (dt * 2 + s) * 512);
}

constexpr int LDS_CVT = 16 * 1024;
DI void phase_attn(const P2Args& a, const P0Args& cv, char* lds) {
    const int tid = tidx(), wid = tid >> 6, lane = tid & 63, r = lane & 31, h = lane >> 5;
    float* tbl = (float*)lds;
    float* ssq = (float*)(lds + 8 * 260 * 4);
    __syncthreads();
    for (int i = tid; i < NHA * 257; i += NTHR) { const int hd = i / 257, j = i % 257; tbl[hd * 260 + j] = a.rel_bias[i] * LOG2E; }
    __syncthreads();
    const int cgrp = vblock() % 3;
#pragma unroll 1
    for (int slot = 0; slot < 5; ++slot) {
        if ((cgrp == 0 && slot == 0) || (cgrp == 1 && slot == 2) || (cgrp == 2 && slot == 4)) convert_moe_range(cv, lds + LDS_CVT, 0, CV_GU);
        if (slot == 4) break;
        const int u = vblock() + GRID * (slot >> 1) + 2 * GRID * (slot & 1);
        const bool isB = u >= BATCH * (SEQ / 64); const int uu = isB ? u - BATCH * (SEQ / 64) : u;
        const int b = uu / (SEQ / 64), c = uu % (SEQ / 64), q0 = c * 64, hh = (isB ? NHA : 0) + wid;
        const size_t hb = (size_t)(b * NHH + hh) * SEQ * 64;
        const bf16_t* kp = a.Kb + hb + lane * 8;
        const bf16_t* vp = a.Vt + hb + lane * 8;
        bf16x8 qf[2][4];
#pragma unroll
        for (int qt = 0; qt < 2; ++qt)
#pragma unroll
            for (int kk = 0; kk < 4; ++kk) qf[qt][kk] = *(const bf16x8*)(a.Q + hb + (size_t)((q0 >> 5) + qt) * 2048 + kk * 512 + lane * 8);
        f32x16 ot[2][2];
#pragma unroll
        for (int dt = 0; dt < 2; ++dt)
#pragma unroll
            for (int qt = 0; qt < 2; ++qt)
#pragma unroll
                for (int i = 0; i < 16; ++i) ot[dt][qt][i] = 0.f;
        float linv[2] = {1.f, 1.f};
        if (!isB) {
            float mrun[2] = {-INFINITY, -INFINITY}, lrun[2] = {0.f, 0.f};
            const int klo = q0 - LEFT_CHUNKS * CHUNK < 0 ? 0 : q0 - LEFT_CHUNKS * CHUNK, khi = q0 + 64;
            const float cfar = tbl[wid * 260 + 256];
            bf16x8 kc[4], kn[4], vf[2][2]; load_k(kc, kp, klo);
            for (int k0 = klo; k0 < khi; k0 += 32) {
                load_v(vf, vp, k0);
                load_k(kn, kp, k0 + 32 < khi ? k0 + 32 : k0);
#pragma unroll
                for (int qt = 0; qt < 2; ++qt) {
                    bf16x8 pf[2];
                    f32x16 st;
#pragma unroll
                    for (int i = 0; i < 16; ++i) st[i] = 0.f;
#pragma unroll
                    for (int kk = 0; kk < 4; ++kk) st = MFMA32(kc[kk], qf[qt][kk], st);
                    const int dmin = q0 + 32 * qt - k0 - 31;
                    if (dmin >= MAX_REL) {
#pragma unroll
                        for (int i = 0; i < 16; ++i) st[i] += cfar;
                    } else {
                        const int bidx = q0 + 32 * qt + r - k0 - 4 * h + MAX_REL;
#pragma unroll
                        for (int i = 0; i < 16; ++i) { int ix = bidx - ((i & 3) + 8 * (i >> 2)); ix = ix < 0 ? 0 : (ix > 2 * MAX_REL ? 2 * MAX_REL : ix); st[i] += tbl[wid * 260 + ix]; }
                    }
                    float mx = st[0];
#pragma unroll
                    for (int i = 1; i < 16; ++i) mx = fmaxf(mx, st[i]);
                    mx = fmaxf(mx, __shfl_xor(mx, 32));
                    const float mn = fmaxf(mrun[qt], mx), alpha = __builtin_amdgcn_exp2f(mrun[qt] - mn);
                    mrun[qt] = mn;
                    float ps = 0.f;
#pragma unroll
                    for (int i = 0; i < 16; ++i) { st[i] = __builtin_amdgcn_exp2f(st[i] - mn); ps += st[i]; }
                    lrun[qt] = lrun[qt] * alpha + ps;
#pragma unroll
                    for (int i = 0; i < 16; ++i) { ot[0][qt][i] *= alpha; ot[1][qt][i] *= alpha; }
                    pf[0] = pack8(st, 0); pf[1] = pack8(st, 1);
#pragma unroll
                    for (int dt = 0; dt < 2; ++dt)
#pragma unroll
                        for (int s = 0; s < 2; ++s) ot[dt][qt] = MFMA32(vf[dt][s], pf[s], ot[dt][qt]);
                }
#pragma unroll
                for (int kk = 0; kk < 4; ++kk) kc[kk] = kn[kk];
            }
#pragma unroll
            for (int qt = 0; qt < 2; ++qt) { const float lt = lrun[qt] + __shfl_xor(lrun[qt], 32); linv[qt] = 1.f / lt; }
        } else {
            float carry[2] = {1.f, 1.f};
            bf16x8 kc[4], kn[4], vf[2][2]; load_k(kc, kp, q0 + 32);
            for (int k0 = q0 + 32; k0 >= 0; k0 -= 32) {
                load_v(vf, vp, k0);
                load_k(kn, kp, k0 >= 32 ? k0 - 32 : k0);
#pragma unroll
                for (int qt = 0; qt < 2; ++qt) {
                    bf16x8 pf[2];
                    f32x16 st;
#pragma unroll
                    for (int i = 0; i < 16; ++i) st[i] = 0.f;
                    const bool none = (k0 > q0 + 32 * qt + 30);
                    if (!none) {
#pragma unroll
                        for (int kk = 0; kk < 4; ++kk) st = MFMA32(kc[kk], qf[qt][kk], st);
                        const bool full = (k0 + 31 < q0 + 32 * qt);
                        const int lim = q0 + 32 * qt + r - k0 - 4 * h;
                        float om[16];
#pragma unroll
                        for (int i = 0; i < 16; ++i) {
                            const float e = __builtin_amdgcn_exp2f(-st[i]); float bta = __builtin_amdgcn_rcpf(1.f + e);
                            if (!full && !(((i & 3) + 8 * (i >> 2)) < lim)) bta = 0.f;
                            st[i] = bta; om[i] = 1.f - bta;
                        }
                        float G[4], Go[4];
#pragma unroll
                        for (int g = 0; g < 4; ++g) { G[g] = (om[4 * g] * om[4 * g + 1]) * (om[4 * g + 2] * om[4 * g + 3]); Go[g] = __shfl_xor(G[g], 32); }
                        float R = carry[qt];
#pragma unroll
                        for (int g = 3; g >= 0; --g) {
                            float run = h == 0 ? R * Go[g] : R;
#pragma unroll
                            for (int uu2 = 3; uu2 >= 0; --uu2) { const float bta = st[4 * g + uu2]; st[4 * g + uu2] = bta * run; run *= om[4 * g + uu2]; }
                            R = R * (G[g] * Go[g]);
                        }
                        carry[qt] = R;
                    }
                    if (!none) {
                        pf[0] = pack8(st, 0); pf[1] = pack8(st, 1);
#pragma unroll
                        for (int dt = 0; dt < 2; ++dt)
#pragma unroll
                            for (int s = 0; s < 2; ++s) ot[dt][qt] = MFMA32(vf[dt][s], pf[s], ot[dt][qt]);
                    }
                }
#pragma unroll
                for (int kk = 0; kk < 4; ++kk) kc[kk] = kn[kk];
                if (__all(carry[0] < SB_EXIT_THR && carry[1] < SB_EXIT_THR)) break;
            }
        }
        float ss[2];
#pragma unroll
        for (int qt = 0; qt < 2; ++qt) {
            float s2 = 0.f;
#pragma unroll
            for (int dt = 0; dt < 2; ++dt)
#pragma unroll
                for (int i = 0; i < 16; ++i) { ot[dt][qt][i] *= linv[qt]; s2 += ot[dt][qt][i] * ot[dt][qt][i]; }
            s2 += __shfl_xor(s2, 32); ss[qt] = s2;
        }
        __syncthreads();
        if (h == 0) { ssq[wid * 64 + r] = ss[0]; ssq[wid * 64 + 32 + r] = ss[1]; }
        __syncthreads();
        const float* gain = isB ? a.gain_b : a.gain_a;
#pragma unroll
        for (int qt = 0; qt < 2; ++qt) {
            float tot = 0.f;
#pragma unroll
            for (int w8 = 0; w8 < 8; ++w8) tot += ssq[w8 * 64 + 32 * qt + r];
            const float rs = rsqrtf(tot * (1.f / 512.f) + RMS_EPS);
            bf16_t* yp = a.y + (size_t)(b * SEQ + q0 + 32 * qt + r) * D_MODEL + (isB ? 512 : 0) + wid * 64;
#pragma unroll
            for (int dt = 0; dt < 2; ++dt)
#pragma unroll
                for (int g = 0; g < 4; ++g) {
                    const int d = 32 * dt + 8 * g + 4 * h; const f32x4 gn = *(const f32x4*)(gain + wid * 64 + d);
                    u32x2 o; o.x = cvt_pk_bf16(ot[dt][qt][4 * g] * rs * gn[0], ot[dt][qt][4 * g + 1] * rs * gn[1]); o.y = cvt_pk_bf16(ot[dt][qt][4 * g + 2] * rs * gn[2], ot[dt][qt][4 * g + 3] * rs * gn[3]);
                    *(u32x2*)(yp + d) = o;
                }
        }
    }
}


#define XB_TMO      128
#define XB_XCNT(j)  (256  + 64 * (j))
#define XB_XSUB(j)  (1280 + 64 * (j))
#define XB_XGEN(j)  (2304 + 64 * (j))
#define XB_TOP      3328
#define XB_TOPGEN   3392
#define XCD_BAR_WORDS 3456
#define XB_SPIN_CAP (1u << 18)
#define LAS __attribute__((address_space(3)))

__device__ __forceinline__ unsigned xb_ld(unsigned* p)              { return __hip_atomic_load(p, __ATOMIC_RELAXED, __HIP_MEMORY_SCOPE_AGENT); }
__device__ __forceinline__ unsigned xb_add(unsigned* p, unsigned v) { return __hip_atomic_fetch_add(p, v, __ATOMIC_RELAXED, __HIP_MEMORY_SCOPE_AGENT); }
__device__ __forceinline__ unsigned xb_xcc_id() { return (unsigned)__builtin_amdgcn_s_getreg((3 << 11) | 20) & 0xFu; }
#define XB_SPIN(cond, bar) do { unsigned _sp = 0; while (cond) { __builtin_amdgcn_s_sleep(1); \
    if ((++_sp & 255u) == 0u) { if (xb_ld(&(bar)[XB_TMO])) break; if (_sp > XB_SPIN_CAP) { atomicAdd(&(bar)[XB_TMO], 1u); break; } } } } while (0)

struct XcdBarrier {
    unsigned* bar; unsigned x;
    volatile LAS unsigned* st;
};

__device__ __forceinline__ XcdBarrier xcd_barrier_post(unsigned* bar, volatile LAS unsigned* st) {
    XcdBarrier b; b.bar = bar; b.x = xb_xcc_id(); b.st = st;
    if (threadIdx.x == 0) (void)xb_add(&bar[XB_XCNT(b.x)], 1u);
    return b;
}
__device__ __forceinline__ void xcd_barrier_complete(unsigned* bar, unsigned x, unsigned& nloc, unsigned& nx) {
    const unsigned G = gridDim.x * gridDim.y * gridDim.z;
    unsigned sum, cnt, mine, sp = 0u;
    for (;;) {
        sum = 0u; cnt = 0u; mine = 0u;
#pragma unroll
        for (unsigned j = 0; j < 16; ++j) { const unsigned c = xb_ld(&bar[XB_XCNT(j)]); sum += c; cnt += (c > 0u) ? 1u : 0u; mine = (j == x) ? c : mine; }
        if (sum == G) break;
        __builtin_amdgcn_s_sleep(1);
        if ((++sp & 255u) == 0u) { if (xb_ld(&bar[XB_TMO])) break; if (sp > XB_SPIN_CAP) { atomicAdd(&bar[XB_TMO], 1u); break; } }
    }
    nloc = mine > 0u ? mine : 1u; nx = cnt > 0u ? cnt : 1u;
}

__device__ __forceinline__ void xcd_barrier(const XcdBarrier& b) {
    asm volatile("s_waitcnt vmcnt(0)" ::: "memory");
    __syncthreads();
    if (threadIdx.x == 0) {
        unsigned* bar = b.bar;
        __builtin_amdgcn_s_waitcnt(0);
        unsigned nloc = b.st[0], nx = b.st[1];
        if (nloc == 0u) { xcd_barrier_complete(bar, b.x, nloc, nx); b.st[0] = nloc; b.st[1] = nx; }
        const unsigned old = xb_add(&bar[XB_XSUB(b.x)], 1u);
        const unsigned gen = old / nloc;
        if (old + 1u == (gen + 1u) * nloc) {
            __builtin_amdgcn_fence(__ATOMIC_RELEASE, "agent");
            asm volatile("s_waitcnt vmcnt(0)" ::: "memory");
            const unsigned og = xb_add(&bar[XB_TOP], 1u);
            const unsigned tg = og / nx;
            if (og + 1u == (tg + 1u) * nx) xb_add(&bar[XB_TOPGEN], 1u);
            else XB_SPIN(xb_ld(&bar[XB_TOPGEN]) == tg, bar);
            __builtin_amdgcn_fence(__ATOMIC_ACQUIRE, "agent");
            xb_add(&bar[XB_XGEN(b.x)], 1u);
            asm volatile("s_waitcnt vmcnt(0)" ::: "memory");
        } else {
            XB_SPIN(xb_ld(&bar[XB_XGEN(b.x)]) == gen, bar);
            __builtin_amdgcn_fence(__ATOMIC_ACQUIRE, "agent");
            asm volatile("s_waitcnt vmcnt(0)" ::: "memory");
        }
    }
    __syncthreads();
}


struct MegaArgs { P0Args p0; P1Args p1; P2Args p2; P3Args p3; P4Args p4; P6Args p6; P7Args p7; P8Args p8; unsigned* bar; };
__global__ __launch_bounds__(NTHR, 2) void k_mega(MegaArgs a) {
    extern __shared__ __attribute__((aligned(16))) char smem[];
    volatile LAS unsigned* xbw = (volatile LAS unsigned*)(smem + LDS_BYTES - 16);
    if (threadIdx.x == 0) { xbw[0] = 0u; xbw[1] = 0u; xbw[2] = 0u; xbw[3] = 0u; }
    __syncthreads();
    XcdBarrier bar = xcd_barrier_post(a.bar, xbw);
    LAS unsigned char* L = (LAS unsigned char*)smem;
    phase_prologue(a.p0, smem);     xcd_barrier(bar);
    phase_qkv(a.p1, L);             xcd_barrier(bar);
    phase_attn(a.p2, a.p0, smem);   xcd_barrier(bar);
    phase_outproj(a.p3, L);         xcd_barrier(bar);
    phase_router(a.p4, a.p0, smem); xcd_barrier(bar);
    phase_moe_gu(a.p6, smem, L);    xcd_barrier(bar);
    phase_moe_down(a.p7, smem, L);  xcd_barrier(bar);
    phase_combine(a.p8, smem);
}

extern "C" void kernel_launch(void* const* d_in, const int* in_sizes, int n_in, void* d_out, int out_size, void* d_ws, size_t ws_size, hipStream_t stream) {
    const float* x = (const float*)d_in[0];      const float* w_in = (const float*)d_in[1];   const float* rel_bias = (const float*)d_in[2];
    const float* gain_a = (const float*)d_in[3]; const float* gain_b = (const float*)d_in[4]; const float* w_out = (const float*)d_in[5];
    const float* ln1_g = (const float*)d_in[6];  const float* ln1_b = (const float*)d_in[7];  const float* router_w = (const float*)d_in[8];
    const float* router_bias = (const float*)d_in[9]; const float* w_gate = (const float*)d_in[10]; const float* w_up = (const float*)d_in[11];
    const float* w_down = (const float*)d_in[12]; const float* ws_gate = (const float*)d_in[13]; const float* ws_up = (const float*)d_in[14];
    const float* ws_down = (const float*)d_in[15]; const float* ln2_g = (const float*)d_in[16]; const float* ln2_b = (const float*)d_in[17];
    char* ws = (char*)d_ws; float* out = (float*)d_out;
    int* ctrl = (int*)(ws + OFF_CTRL); int* counts = ctrl + CW_COUNTS;
    bf16_t* X1 = (bf16_t*)(ws + OFF_X1); int* tokl = (int*)(ws + OFF_TOKL); float* gatel = (float*)(ws + OFF_GATEL);
    int* eidx = (int*)(ws + OFF_EIDX); float* gate = (float*)(ws + OFF_GATE); int* slot = (int*)(ws + OFF_SLOT);
    unsigned char* H = (unsigned char*)(ws + OFF_H); unsigned char* Y = (unsigned char*)(ws + OFF_Y); unsigned char* x1f8 = (unsigned char*)(ws + OFF_X1F8);
    bf16_t* Q = (bf16_t*)(ws + OFF_Q); bf16_t* Kb = (bf16_t*)(ws + OFF_K); bf16_t* Vt = (bf16_t*)(ws + OFF_VT);
    bf16_t* yatt = (bf16_t*)(ws + OFF_YATT); bf16_t* r = (bf16_t*)(ws + OFF_R);
    bf16_t* xb = (bf16_t*)(ws + OFF_XB); float* stats = (float*)(ws + OFF_STATS);
    bf16_t* wt_in = (bf16_t*)(ws + OFF_WTIN); bf16_t* wt_out = (bf16_t*)(ws + OFF_WTOUT); bf16_t* wt_r = (bf16_t*)(ws + OFF_WTR);
    unsigned char* wgut = (unsigned char*)(ws + OFF_WGUT); unsigned char* wdt = (unsigned char*)(ws + OFF_WDT);
    if (ws_size < WS_NEEDED) { fprintf(stderr, "kernel_launch: workspace too small (%zu < %zu)\n", ws_size, (size_t)WS_NEEDED); return; }
    hipMemsetAsync(ctrl, 0, 128 * 1024, stream);
    static bool attr_done = false;
    if (!attr_done) {
        hipFuncSetAttribute((const void*)k_mega, hipFuncAttributeMaxDynamicSharedMemorySize, LDS_BYTES);
        attr_done = true;
    }
    MegaArgs m{};
    m.p0 = P0Args{x, w_in, w_out, router_w, xb, wt_in, wt_out, wt_r, w_gate, w_up, w_down, ws_gate, ws_up, ws_down, wgut, wdt};
    m.p1 = P1Args{xb, wt_in, Q, Kb, Vt};
    m.p2 = P2Args{Q, Kb, Vt, rel_bias, gain_a, gain_b, yatt};
    m.p3 = P3Args{yatt, wt_out, xb, r, stats};
    m.p4 = P4Args{r, stats, ln1_g, ln1_b, X1, x1f8, wt_r, router_bias, eidx, gate, counts, tokl, gatel, slot};
    m.p6 = P6Args{x1f8, counts, tokl, gatel, wgut, H};
    m.p7 = P7Args{H, counts, wdt, Y};
    m.p8 = P8Args{X1, Y, slot, counts, ln2_g, ln2_b, out};
    m.bar = (unsigned*)ctrl;
    k_mega<<<GRID, NTHR, LDS_BYTES, stream>>>(m);
}
```

```cpp
#include <hip/hip_runtime.h>
#include <cstdint>
#include <cstdio>

typedef unsigned short bf16_t;

constexpr int D_MODEL = 1024, BATCH = 16, SEQ = 2048, T_TOK = BATCH * SEQ;
constexpr int HEAD_DIM = 64, NHA = 8, NHB = 8, NHH = 16;
constexpr int CHUNK = 64, LEFT_CHUNKS = 8, MAX_REL = 128;
constexpr int N_EXP = 256, TOP_K = 8, N_GROUPS = 8, TOPK_GROUPS = 4, EPG = 32, D_EXP = 256;
constexpr float ROUTED_SCALE = 2.5f, LN_EPS = 1e-5f, RMS_EPS = 1e-6f;
constexpr float DN_ALPHA = 1.189207115002721f;
constexpr float LOG2E = 1.4426950408889634f, LN2 = 0.6931471805599453f;
constexpr float QSCALE = 0.125f * LOG2E;
constexpr float WSCALE = 64.f, XSCALE = 16.f, HSCALE = 16.f;
constexpr float YSCALE = 64.f;
constexpr int CAP = T_TOK;
constexpr int ROWS_ALL = T_TOK * TOP_K + T_TOK;

__device__ __forceinline__ float bf2f(bf16_t v) { return __uint_as_float(((unsigned)v) << 16); }
__device__ __forceinline__ bf16_t f2bf(float f) { unsigned u = __float_as_uint(f); u += 0x7fffu + ((u >> 16) & 1u); return (bf16_t)(u >> 16); }

constexpr size_t MB = 1024ull * 1024ull;
constexpr size_t OFF_CTRL   = 0;
constexpr size_t OFF_X1     = 1 * MB;
constexpr size_t OFF_TOKL   = OFF_X1 + 64 * MB;
constexpr size_t OFF_GATEL  = OFF_TOKL + 32 * MB;
constexpr size_t OFF_EIDX   = OFF_GATEL + 32 * MB;
constexpr size_t OFF_GATE   = OFF_EIDX + 1 * MB;
constexpr size_t OFF_SLOT   = OFF_GATE + 1 * MB;
constexpr size_t OFF_WDT    = OFF_SLOT + 1 * MB;
constexpr size_t OFF_X1F8   = OFF_WDT + 72 * MB;
constexpr size_t OFF_BIG    = OFF_WDT + 129 * MB;
constexpr size_t OFF_H      = OFF_BIG;
constexpr size_t OFF_Y      = OFF_BIG + 144 * MB;
constexpr size_t OFF_Q      = OFF_BIG;
constexpr size_t OFF_K      = OFF_BIG + 64 * MB;
constexpr size_t OFF_VT     = OFF_BIG + 128 * MB;
constexpr size_t OFF_YATT   = OFF_BIG + 192 * MB;
constexpr size_t OFF_R      = OFF_BIG + 256 * MB;
constexpr size_t OFF_XB     = OFF_BIG + 320 * MB;
constexpr size_t OFF_STATS  = OFF_BIG + 384 * MB;
constexpr size_t OFF_WTIN   = OFF_BIG + 392 * MB;
constexpr size_t OFF_WTOUT  = OFF_BIG + 398 * MB;
constexpr size_t OFF_WTR    = OFF_BIG + 400 * MB;
constexpr size_t OFF_WGUT   = OFF_BIG + 401 * MB;
constexpr size_t WS_NEEDED  = OFF_BIG + 720 * MB;
static_assert(OFF_WGUT + 257 * MB <= WS_NEEDED && WS_NEEDED <= 1024 * MB, "workspace map");
constexpr int CW_COUNTS = 8192;
constexpr int CSTR = 64;

typedef short bf16x8 __attribute__((ext_vector_type(8)));
typedef float f32x4 __attribute__((ext_vector_type(4)));
typedef float f32x2 __attribute__((ext_vector_type(2)));
typedef float f32x16 __attribute__((ext_vector_type(16)));
typedef unsigned u32x4 __attribute__((ext_vector_type(4)));
typedef unsigned u32x2 __attribute__((ext_vector_type(2)));
#define DI __device__ __forceinline__
constexpr int NTHR = 512, GRID = 256;
DI int tidx() { int t = threadIdx.x; asm volatile("" : "+v"(t)); return t; }
constexpr int LDS_BYTES = 160 * 1024;

typedef __bf16 bf16x2_t __attribute__((ext_vector_type(2)));
DI unsigned cvt_pk_bf16(float lo, float hi) { f32x2 v = {lo, hi}; bf16x2_t r = __builtin_convertvector(v, bf16x2_t); return __builtin_bit_cast(unsigned, r); }
DI float clamp8(float v) { return __builtin_amdgcn_fmed3f(v, -440.f, 440.f); }
DI unsigned pack_fp8x4(float a, float b, float c, float d) { int w = 0; w = __builtin_amdgcn_cvt_pk_fp8_f32(clamp8(a), clamp8(b), w, false); w = __builtin_amdgcn_cvt_pk_fp8_f32(clamp8(c), clamp8(d), w, true); return (unsigned)w; }
DI int vblock() { return (int)((blockIdx.x & 7) * (GRID / 8) + (blockIdx.x >> 3)); }

template <int MT> struct Tile { static constexpr int BM = 32 * MT, A_BYTES = BM * 128, B_BYTES = 256 * 128, STAGE = A_BYTES + B_BYTES; };

template <int MT> struct ALoader {
    const bf16_t* p[MT / 2]; u32x4 v[MT / 2]; int off0;
    DI void init_rows(const bf16_t* A, int lda, int row0) {
        const int tid = tidx(), kc = tid & 7, r = tid >> 3;
#pragma unroll
        for (int i = 0; i < MT / 2; ++i) p[i] = A + (size_t)(row0 + r + 64 * i) * lda + kc * 8;
        off0 = r * 128 + ((kc ^ ((r >> 1) & 7)) << 4);
    }
    DI void init_gather(const bf16_t* A, int lda, const int* rows, int cnt, int m0) {
        const int tid = tidx(), kc = tid & 7, r = tid >> 3;
#pragma unroll
        for (int i = 0; i < MT / 2; ++i) { int rr = m0 + r + 64 * i; rr = rr < cnt ? rr : cnt - 1; const int g = rows ? rows[rr] : rr; p[i] = A + (size_t)g * lda + kc * 8; }
        off0 = r * 128 + ((kc ^ ((r >> 1) & 7)) << 4);
    }
    DI void load(int k0) {
#pragma unroll
        for (int i = 0; i < MT / 2; ++i) v[i] = *(const u32x4*)(p[i] + k0);
    }
    DI void store(char* ldsA) const {
#pragma unroll
        for (int i = 0; i < MT / 2; ++i) *(u32x4*)(ldsA + off0 + i * 8192) = v[i];
    }
};
struct BLoaderBt {
    const bf16_t* p[4]; u32x4 v[4]; int off0;
    DI void init(const bf16_t* Bt, int ldk, int n0) {
        const int tid = tidx(), kc = tid & 7, r = tid >> 3;
#pragma unroll
        for (int i = 0; i < 4; ++i) p[i] = Bt + (size_t)(n0 + r + 64 * i) * ldk + kc * 8;
        off0 = r * 128 + ((kc ^ ((r >> 1) & 7)) << 4);
    }
    DI void load(int k0) {
#pragma unroll
        for (int i = 0; i < 4; ++i) v[i] = *(const u32x4*)(p[i] + k0);
    }
    DI void store(char* ldsB) const {
#pragma unroll
        for (int i = 0; i < 4; ++i) *(u32x4*)(ldsB + off0 + i * 8192) = v[i];
    }
};
template <int MT, bool TR, class AL, class BL>
DI void gemm_tile(char* lds, AL& al, BL& bl, int nk, f32x4 (&acc)[MT][4]) {
    typedef Tile<MT> TT;
    const int tid = tidx(), wid = tid >> 6, lane = tid & 63, wr = wid >> 2, wc = wid & 3, fr = lane & 15, fq = lane >> 4;
#pragma unroll
    for (int m = 0; m < MT; ++m)
#pragma unroll
        for (int n = 0; n < 4; ++n) acc[m][n] = (f32x4){0.f, 0.f, 0.f, 0.f};
    int aoff[2], boff[2];
#pragma unroll
    for (int ks = 0; ks < 2; ++ks) { const int ch = (((4 * ks + fq) ^ (fr >> 1)) << 4); aoff[ks] = (16 * MT * wr + fr) * 128 + ch; boff[ks] = TT::A_BYTES + (64 * wc + fr) * 128 + ch; }
    al.load(0); bl.load(0);
    __syncthreads();
    al.store(lds); bl.store(lds + TT::A_BYTES);
    __syncthreads();
    for (int kt = 0; kt < nk; ++kt) {
        char* cur = lds + (kt & 1) * TT::STAGE; char* nxt = lds + ((kt & 1) ^ 1) * TT::STAGE;
        const bool more = kt + 1 < nk;
        if (more) { al.load((kt + 1) * 64); bl.load((kt + 1) * 64); }
#pragma unroll
        for (int ks = 0; ks < 2; ++ks) {
            bf16x8 a[MT], b[4];
#pragma unroll
            for (int m = 0; m < MT; ++m) a[m] = *(const bf16x8*)(cur + aoff[ks] + m * 2048);
#pragma unroll
            for (int n = 0; n < 4; ++n) b[n] = *(const bf16x8*)(cur + boff[ks] + n * 2048);
#pragma unroll
            for (int m = 0; m < MT; ++m)
#pragma unroll
                for (int n = 0; n < 4; ++n)
                    acc[m][n] = TR ? __builtin_amdgcn_mfma_f32_16x16x32_bf16(b[n], a[m], acc[m][n], 0, 0, 0) : __builtin_amdgcn_mfma_f32_16x16x32_bf16(a[m], b[n], acc[m][n], 0, 0, 0);
        }
        if (more) { al.store(nxt); bl.store(nxt + TT::A_BYTES); }
        __syncthreads();
    }
}

#define LAS __attribute__((address_space(3)))
namespace gs {
constexpr int BM = 256, BK = 64, HALF = 128, HTB = HALF * BK * 2, STAGE_BYTES = 8 * HTB;
DI int lds_byte(int r, int c) { const int st = (r >> 4) * 2 + (c >> 5), rr = r & 15, cc = c & 31, ob = rr * 64 + cc * 2; return st * 1024 + (ob ^ (((ob >> 9) & 1) << 5)); }
DI void stage_rc(int b, int& R, int& C) { const int st = b / 1024, sb = b % 1024, swz = sb ^ (((sb >> 9) & 1) << 5); R = (st >> 1) * 16 + swz / 64; C = (st & 1) * 32 + (swz % 64) / 2; }
DI int perm32(int rho) { const int n = rho >> 4, i = rho & 15; return 8 * (i >> 2) + 4 * n + (i & 3); }
typedef long i64x2 __attribute__((ext_vector_type(2)));
DI const char* uni(const char* p) { const unsigned long long v = (unsigned long long)p; const unsigned lo = __builtin_amdgcn_readfirstlane((unsigned)v), hi = __builtin_amdgcn_readfirstlane((unsigned)(v >> 32)); return (const char*)(((unsigned long long)hi << 32) | lo); }
template <bool TR, bool F8>
DI f32x4 mma16(const bf16x8& a, const bf16x8& b, f32x4 c) {
    if (F8) {
        const i64x2 a2 = __builtin_bit_cast(i64x2, a), b2 = __builtin_bit_cast(i64x2, b);
        c = TR ? __builtin_amdgcn_mfma_f32_16x16x32_fp8_fp8(b2[0], a2[0], c, 0, 0, 0) : __builtin_amdgcn_mfma_f32_16x16x32_fp8_fp8(a2[0], b2[0], c, 0, 0, 0);
        return TR ? __builtin_amdgcn_mfma_f32_16x16x32_fp8_fp8(b2[1], a2[1], c, 0, 0, 0) : __builtin_amdgcn_mfma_f32_16x16x32_fp8_fp8(a2[1], b2[1], c, 0, 0, 0);
    }
    return TR ? __builtin_amdgcn_mfma_f32_16x16x32_bf16(b, a, c, 0, 0, 0) : __builtin_amdgcn_mfma_f32_16x16x32_bf16(a, b, c, 0, 0, 0);
}
typedef int i32x8 __attribute__((ext_vector_type(8)));
typedef short bf16x16 __attribute__((ext_vector_type(16)));
template <bool TR>
DI f32x4 mma128(const bf16x16& a, const bf16x16& b, f32x4 c) {
    const i32x8 av = __builtin_bit_cast(i32x8, a), bv = __builtin_bit_cast(i32x8, b);
    const int one = 0x7F7F7F7F;
    if (TR) asm volatile("v_mfma_scale_f32_16x16x128_f8f6f4 %0, %1, %2, %0, %3, %3 op_sel_hi:[0,0,0]" : "+v"(c) : "v"(bv), "v"(av), "v"(one));
    else    asm volatile("v_mfma_scale_f32_16x16x128_f8f6f4 %0, %1, %2, %0, %3, %3 op_sel_hi:[0,0,0]" : "+v"(c) : "v"(av), "v"(bv), "v"(one));
    return c;
}
DI bf16x8 frag_lo(const bf16x16& v) { return __builtin_shufflevector(v, v, 0, 1, 2, 3, 4, 5, 6, 7); }
DI bf16x8 frag_hi(const bf16x16& v) { return __builtin_shufflevector(v, v, 8, 9, 10, 11, 12, 13, 14, 15); }
template <bool TR, bool PERM, int F8, class Sched, class Epi>
DI void gemm_stream(LAS unsigned char* lds, const int K, const Sched& S, const Epi& E) {
    typedef typename Sched::U U;
    const int tid = tidx(), wid = __builtin_amdgcn_readfirstlane(tid >> 6), lane = tid & 63, wr = wid >> 2, wc = wid & 3, fr = lane & 15, fq = lane >> 4;
    const int nt = K / BK;
    int R[2], C[2]; unsigned voffB[2];
#pragma unroll
    for (int i = 0; i < 2; ++i) { stage_rc(tid * 16 + i * 8192, R[i], C[i]); const int Rb = PERM ? ((R[i] & ~31) + perm32(R[i] & 31)) : R[i]; voffB[i] = (unsigned)(Rb * K + C[i]) * 2u; }
    const size_t kstep = (size_t)(BK * 2), hstepB = (size_t)HALF * K * 2;
    const unsigned ldsw = (unsigned)wid * 1024u;
    const int aoff = lds_byte(wr * 64 + fr, fq * 8), boff = lds_byte(wc * 32 + fr, fq * 8);
#define GS_SA(b, h) (((b) * 2 + (h)) * HTB)
#define GS_SB(b, h) ((4 + (b) * 2 + (h)) * HTB)
#define GS_STAGE(bufoff, gbase, uix, h) do { _Pragma("unroll") for (int _i = 0; _i < 2; ++_i) \
        __builtin_amdgcn_global_load_lds((const unsigned*)((const char*)(gbase) + S.a_voff(uix, h, R[_i], C[_i])), (LAS unsigned*)(lds + (bufoff) + ldsw + _i * 8192), 16, 0, 0); } while (0)
#define GS_STAGEB(bufoff, gbase, voff) do { _Pragma("unroll") for (int _i = 0; _i < 2; ++_i) \
        __builtin_amdgcn_global_load_lds((const unsigned*)((const char*)(gbase) + (voff)[_i]), (LAS unsigned*)(lds + (bufoff) + ldsw + _i * 8192), 16, 0, 0); } while (0)
#define GS_LD32(base) __builtin_shufflevector(*(const LAS bf16x8*)(base), *(const LAS bf16x8*)((base) + 1024), 0, 1, 2, 3, 4, 5, 6, 7, 8, 9, 10, 11, 12, 13, 14, 15)
#define GS_LDA(dst, b, h) do { _Pragma("unroll") for (int m = 0; m < 4; ++m) dst[m] = GS_LD32(lds + GS_SA(b, h) + aoff + m * 2048); } while (0)
#define GS_LDB(dst, b, h) do { _Pragma("unroll") for (int n = 0; n < 2; ++n) dst[n] = GS_LD32(lds + GS_SB(b, h) + boff + n * 2048); } while (0)
#define GS_MMA(ai, bj, At, Bt) do { __builtin_amdgcn_s_setprio(1); _Pragma("unroll") for (int m = 0; m < 4; ++m) _Pragma("unroll") for (int n = 0; n < 2; ++n) { \
        if (F8 == 2) acc[ai][bj][m][n] = mma128<TR>(At[m], Bt[n], acc[ai][bj][m][n]); \
        else { acc[ai][bj][m][n] = mma16<TR, F8 == 1>(frag_lo(At[m]), frag_lo(Bt[n]), acc[ai][bj][m][n]); acc[ai][bj][m][n] = mma16<TR, F8 == 1>(frag_hi(At[m]), frag_hi(Bt[n]), acc[ai][bj][m][n]); } } \
        __builtin_amdgcn_s_setprio(0); } while (0)
#define GS_WAIT_V(n) asm volatile("s_waitcnt vmcnt(" #n ")" ::: "memory")
#define GS_WAIT_L(n) asm volatile("s_waitcnt lgkmcnt(" #n ")" ::: "memory")
#define GS_BAR __builtin_amdgcn_s_barrier()
#define GS_SCHED __builtin_amdgcn_sched_barrier(0)
    U cur, nxt; int ui = 0;
    if (!S.next(0, cur)) return;
    f32x4 acc[2][2][4][2];
#pragma unroll
    for (int a = 0; a < 2; ++a)
#pragma unroll
        for (int b = 0; b < 2; ++b)
#pragma unroll
            for (int m = 0; m < 4; ++m)
#pragma unroll
                for (int n = 0; n < 2; ++n) acc[a][b][m][n] = (f32x4){0.f, 0.f, 0.f, 0.f};
    bf16x16 At[4], B0[2], B1[2];
    const char* cA = uni(cur.A); const char* cB = uni(cur.B);
    GS_STAGEB(GS_SB(0, 0), cB, voffB); GS_STAGEB(GS_SB(0, 1), cB + hstepB, voffB); GS_STAGE(GS_SA(0, 0), cA, 0, 0); GS_STAGE(GS_SA(0, 1), cA, 0, 1);
    if (wr == 1) GS_BAR;
    GS_WAIT_V(2); GS_BAR;
    GS_STAGEB(GS_SB(1, 0), cB + kstep, voffB); GS_STAGE(GS_SA(1, 0), cA + kstep, 0, 0); GS_STAGEB(GS_SB(1, 1), cB + hstepB + kstep, voffB);
    GS_WAIT_V(6); GS_BAR;
    for (;;) {
        const bool has_next = S.next(ui + 1, nxt);
        const int nui = has_next ? ui + 1 : ui;
        const char* nA = uni(has_next ? nxt.A : cA); const char* nB = uni(has_next ? nxt.B : cB);
#pragma unroll 1
        for (int t = 0; t < nt; t += 2) {
            const bool last = (t == nt - 2);
            const char* a1 = uni(cA + (size_t)(t + 1) * kstep);
            const char* a2 = uni(last ? nA : cA + (size_t)(t + 2) * kstep); const char* b2 = uni(last ? nB : cB + (size_t)(t + 2) * kstep);
            const char* a3 = uni(a2 + kstep); const char* b3 = uni(b2 + kstep);
            const int u2 = last ? nui : ui;
            GS_LDB(B0, 0, 0); GS_LDB(B1, 0, 1); GS_SCHED; GS_LDA(At, 0, 0); GS_STAGE(GS_SA(1, 1), a1, ui, 1);
            GS_WAIT_V(8); GS_WAIT_L(0); GS_BAR; GS_MMA(0, 0, At, B0); GS_MMA(0, 1, At, B1); GS_BAR; GS_SCHED;
            GS_LDA(At, 0, 1); GS_STAGEB(GS_SB(0, 0), b2, voffB); GS_STAGEB(GS_SB(0, 1), b2 + hstepB, voffB); GS_STAGE(GS_SA(0, 0), a2, u2, 0);
            GS_WAIT_V(8); GS_WAIT_L(0); GS_BAR; GS_MMA(1, 0, At, B0); GS_MMA(1, 1, At, B1); GS_BAR; GS_SCHED;
            GS_LDB(B0, 1, 0); GS_LDB(B1, 1, 1); GS_SCHED; GS_LDA(At, 1, 0); GS_STAGE(GS_SA(0, 1), a2, u2, 1);
            GS_WAIT_V(8); GS_WAIT_L(0); GS_BAR; GS_MMA(0, 0, At, B0); GS_MMA(0, 1, At, B1); GS_BAR; GS_SCHED;
            GS_LDA(At, 1, 1); GS_STAGEB(GS_SB(1, 0), b3, voffB); GS_STAGEB(GS_SB(1, 1), b3 + hstepB, voffB); GS_STAGE(GS_SA(1, 0), a3, u2, 0);
            GS_WAIT_V(8); GS_WAIT_L(0); GS_BAR; GS_MMA(1, 0, At, B0); GS_MMA(1, 1, At, B1); GS_BAR; GS_SCHED;
        }
        if (wr == 0) GS_BAR;
        if (F8 == 2) asm volatile("s_nop 15\n\ts_nop 15\n\ts_nop 15\n\ts_nop 15\n\ts_nop 15\n\ts_nop 15" ::: "memory");
        E(acc, cur, wr, wc, fr, fq);
        if (!has_next) break;
#pragma unroll
        for (int a = 0; a < 2; ++a)
#pragma unroll
            for (int b = 0; b < 2; ++b)
#pragma unroll
                for (int m = 0; m < 4; ++m)
#pragma unroll
                    for (int n = 0; n < 2; ++n) acc[a][b][m][n] = (f32x4){0.f, 0.f, 0.f, 0.f};
        cur = nxt; cA = nA; cB = nB; ++ui;
        if (wr == 1) GS_BAR;
    }
    GS_WAIT_V(0);
    GS_BAR;
#undef GS_SA
#undef GS_SB
#undef GS_STAGE
#undef GS_STAGEB
#undef GS_LDA
#undef GS_LD32
#undef GS_LDB
#undef GS_MMA
#undef GS_WAIT_V
#undef GS_WAIT_L
#undef GS_BAR
#undef GS_SCHED
}
struct DenseU { const char* A; const char* B; int pm, pn; };
struct DenseSched {
    typedef DenseU U;
    const bf16_t* A; const bf16_t* Bt; int K, nunits, first, stride, npn, pn_base, pn_mod0, pn_mod1;
    DI int colmap(int q) const { return pn_base + (q / pn_mod0) * pn_mod1 + (q % pn_mod0); }
    DI bool next(int i, U& u) const {
        const int L = first + i * stride; if (L >= nunits) return false;
        u.pm = L / npn; u.pn = colmap(L % npn);
        u.A = (const char*)A + (size_t)u.pm * BM * K * 2; u.B = (const char*)Bt + (size_t)u.pn * BM * K * 2; return true;
    }
    DI unsigned a_voff(int, int h, int R, int C) const { return (unsigned)((HALF * h + R) * K + C) * 2u; }
};
}

DI void transpose_cvt(const float* W, bf16_t* Wt, int K, int N, int unit, char* lds) {
    float* tile = (float*)lds;
    const int nbn = N / 64, kb = unit / nbn, nb = unit % nbn, tid = tidx();
    __syncthreads();
#pragma unroll
    for (int i = 0; i < 8; ++i) { const int idx = tid + i * 512, r = idx >> 6, c = idx & 63; tile[r * 65 + c] = W[(size_t)(kb * 64 + r) * N + nb * 64 + c]; }
    __syncthreads();
#pragma unroll
    for (int i = 0; i < 8; ++i) { const int idx = tid + i * 512, n = idx >> 6, k = idx & 63; Wt[(size_t)(nb * 64 + n) * K + kb * 64 + k] = f2bf(tile[k * 65 + n]); }
}
struct P0Args { const float* x; const float* w_in; const float* w_out; const float* router_w; bf16_t* xb; bf16_t* wt_in; bf16_t* wt_out; bf16_t* wt_r;
                const float* w_gate; const float* w_up; const float* w_down; const float* ws_gate; const float* ws_up; const float* ws_down; unsigned char* wgut; unsigned char* wdt; };
constexpr int CV_GU = 257 * 2 * 16, CV_DN = 257 * 16;
struct CvItem { const float* src; unsigned char* dst; int ld, ldd, rbase, rhi; };
DI CvItem cv_item(const P0Args& a, int it) {
    CvItem c;
    if (it < CV_GU) {
        const int e = it / 32, u = (it >> 4) & 1, kt = it & 15;
        const float* W = e < N_EXP ? (u ? a.w_up : a.w_gate) + (size_t)e * D_MODEL * D_EXP : (u ? a.ws_up : a.ws_gate);
        c.src = W + (size_t)kt * 64 * D_EXP; c.ld = D_EXP; c.dst = a.wgut + (size_t)e * 512 * D_MODEL + kt * 64; c.ldd = D_MODEL; c.rbase = 128 * u; c.rhi = 256;
    } else {
        const int j = it - CV_GU, e = j / 16, kt = (j >> 2) & 3, nb = j & 3;
        const float* W = e < N_EXP ? a.w_down + (size_t)e * D_EXP * D_MODEL : a.ws_down;
        c.src = W + (size_t)kt * 64 * D_MODEL + nb * 256; c.ld = D_MODEL; c.dst = a.wdt + (size_t)e * D_MODEL * D_EXP + kt * 64; c.ldd = D_EXP; c.rbase = 256 * nb; c.rhi = 128;
    }
    return c;
}
DI void cv_load(const CvItem& c, f32x4 (&v)[8]) {
    const int tid = tidx();
#pragma unroll
    for (int i = 0; i < 8; ++i) { const int idx = tid + i * 512, k = idx >> 6, n4 = idx & 63; v[i] = __builtin_nontemporal_load((const f32x4*)(c.src + (size_t)k * c.ld + 4 * n4)); }
}
DI void cv_store(const CvItem& c, const f32x4 (&v)[8], char* lds) {
    float* tile = (float*)lds;
    const int tid = tidx();
    __syncthreads();
#pragma unroll
    for (int i = 0; i < 8; ++i) { const int idx = tid + i * 512, k = idx >> 6, n4 = idx & 63; *(f32x4*)(tile + k * 260 + 4 * (n4 ^ ((k >> 3) & 7))) = v[i]; }
    __syncthreads();
#pragma unroll
    for (int i = 0; i < 4; ++i) {
        const int idx = tid + i * 512, kc = idx & 7, n = idx >> 3; const float* p = tile + (8 * kc) * 260 + (n ^ (4 * kc));
        const unsigned w0 = pack_fp8x4(p[0] * WSCALE, p[260] * WSCALE, p[2 * 260] * WSCALE, p[3 * 260] * WSCALE), w1 = pack_fp8x4(p[4 * 260] * WSCALE, p[5 * 260] * WSCALE, p[6 * 260] * WSCALE, p[7 * 260] * WSCALE);
        __builtin_nontemporal_store((u32x2){w0, w1}, (u32x2*)(c.dst + (size_t)(c.rbase + (n >> 7) * c.rhi + (n & 127)) * c.ldd + 8 * kc));
    }
}
DI void convert_moe_range(const P0Args& a, char* lds, const int lo, const int hi) {
    int it = lo + vblock(); if (it >= hi) return;
    CvItem c = cv_item(a, it); f32x4 v[8]; cv_load(c, v);
#pragma unroll 1
    for (;;) {
        const int nit = it + GRID; const bool more = nit < hi;
        CvItem cn = c; f32x4 w[8];
        if (more) { cn = cv_item(a, nit); cv_load(cn, w); }
        cv_store(c, v, lds);
        if (!more) break;
        it = nit; c = cn;
#pragma unroll
        for (int i = 0; i < 8; ++i) v[i] = w[i];
    }
}
DI void phase_prologue(const P0Args& a, char* lds) {
    const int vb = vblock();
    for (size_t i = (size_t)vb * NTHR + tidx(); i < (size_t)T_TOK * D_MODEL / 8; i += (size_t)GRID * NTHR) {
        const f32x4 v0 = *(const f32x4*)(a.x + i * 8), v1 = *(const f32x4*)(a.x + i * 8 + 4);
        u32x4 o; o.x = cvt_pk_bf16(v0[0], v0[1]); o.y = cvt_pk_bf16(v0[2], v0[3]); o.z = cvt_pk_bf16(v1[0], v1[1]); o.w = cvt_pk_bf16(v1[2], v1[3]);
        *(u32x4*)(a.xb + i * 8) = o;
    }
    const int n_in = (1024 / 64) * (3072 / 64), n_out = 16 * 16, n_r = 16 * 4;
    for (int u = vb; u < n_in + n_out + n_r; u += GRID) {
        if (u < n_in) transpose_cvt(a.w_in, a.wt_in, 1024, 3072, u, lds);
        else if (u < n_in + n_out) transpose_cvt(a.w_out, a.wt_out, 1024, 1024, u - n_in, lds);
        else transpose_cvt(a.router_w, a.wt_r, 1024, 256, u - n_in - n_out, lds);
    }
}


struct P1Args { const bf16_t* xb; const bf16_t* wt_in; bf16_t* Q; bf16_t* Kb; bf16_t* Vt; };
struct EpiQK { bf16_t* Q; bf16_t* Kb;
    DI void operator()(const f32x4 (&acc)[2][2][4][2], const gs::DenseU& u, int wr, int wc, int fr, int fq) const {
        const int seg = u.pn >> 1, type = seg % 3, grp = seg / 3; bf16_t* dst = type == 0 ? Q : Kb; const float sc = type == 0 ? QSCALE : 1.f;
#pragma unroll
        for (int ai = 0; ai < 2; ++ai)
#pragma unroll
            for (int m = 0; m < 4; ++m) {
                const int row = u.pm * 256 + 128 * ai + 64 * wr + 16 * m + fr, b = row / SEQ, s = row % SEQ;
#pragma unroll
                for (int bj = 0; bj < 2; ++bj) {
                    const int hh = grp * 8 + 4 * (u.pn & 1) + 2 * bj + (wc >> 1), d0 = 32 * (wc & 1) + 8 * fq;
                    const f32x4 v0 = acc[ai][bj][m][0] * sc, v1 = acc[ai][bj][m][1] * sc;
                    u32x4 o; o.x = cvt_pk_bf16(v0[0], v0[1]); o.y = cvt_pk_bf16(v0[2], v0[3]); o.z = cvt_pk_bf16(v1[0], v1[1]); o.w = cvt_pk_bf16(v1[2], v1[3]);
                    *(u32x4*)(dst + (size_t)(b * NHH + hh) * SEQ * 64 + (s >> 5) * 2048 + ((d0 >> 3) * 32 + (s & 31)) * 8) = o;
                }
            }
    } };
struct EpiV { bf16_t* Vt;
    DI void operator()(const f32x4 (&acc)[2][2][4][2], const gs::DenseU& u, int wr, int wc, int fr, int fq) const {
        const int grp = (u.pn >> 1) / 3;
#pragma unroll
        for (int ai = 0; ai < 2; ++ai)
#pragma unroll
            for (int m = 0; m < 4; ++m) {
                const int row = u.pm * 256 + 128 * ai + 64 * wr + 16 * m + 4 * fq, b = row / SEQ, s = row % SEQ;
#pragma unroll
                for (int bj = 0; bj < 2; ++bj)
#pragma unroll
                    for (int n = 0; n < 2; ++n) {
                        const int hh = grp * 8 + 4 * (u.pn & 1) + 2 * bj + (wc >> 1), d = 32 * (wc & 1) + 16 * n + fr;
                        const f32x4 v = acc[ai][bj][m][n];
                        u32x2 o; o.x = cvt_pk_bf16(v[0], v[1]); o.y = cvt_pk_bf16(v[2], v[3]);
                        { const int kap = s & 31; *(u32x2*)(Vt + (size_t)(b * NHH + hh) * SEQ * 64 + (s >> 5) * 2048 + ((((d >> 5) * 2 + (kap >> 4)) * 2 + ((kap >> 2) & 1)) * 32 + (d & 31)) * 8 + ((kap >> 3) & 1) * 4) = o; }
                    }
            }
    } };
DI void phase_qkv(const P1Args& a, LAS unsigned char* lds) {
    { gs::DenseSched S{a.xb, a.wt_in, D_MODEL, (T_TOK / 256) * 8, vblock(), GRID, 8, 0, 4, 6}; EpiQK E{a.Q, a.Kb}; gs::gemm_stream<true, true, 0>(lds, D_MODEL, S, E); }
    { gs::DenseSched S{a.xb, a.wt_in, D_MODEL, (T_TOK / 256) * 4, vblock(), GRID, 4, 4, 2, 6}; EpiV E{a.Vt}; gs::gemm_stream<false, false, 0>(lds, D_MODEL, S, E); }
}

struct P3Args { const bf16_t* y; const bf16_t* wt_out; const bf16_t* xb; bf16_t* r; float* stats; };
struct EpiOut { const bf16_t* xb; bf16_t* r; float* stats;
    DI void operator()(const f32x4 (&acc)[2][2][4][2], const gs::DenseU& u, int wr, int wc, int fr, int fq) const {
#pragma unroll
        for (int ai = 0; ai < 2; ++ai) {
            u32x4 xw[4][2];
#pragma unroll
            for (int m = 0; m < 4; ++m)
#pragma unroll
                for (int bj = 0; bj < 2; ++bj) xw[m][bj] = *(const u32x4*)(xb + (size_t)(u.pm * 256 + 128 * ai + 64 * wr + 16 * m + fr) * D_MODEL + u.pn * 256 + 128 * bj + 32 * wc + 8 * fq);
#pragma unroll
            for (int m = 0; m < 4; ++m) {
                const int row = u.pm * 256 + 128 * ai + 64 * wr + 16 * m + fr;
#pragma unroll
                for (int bj = 0; bj < 2; ++bj) {
                    const int col = u.pn * 256 + 128 * bj + 32 * wc + 8 * fq;
                    const u32x4 w = xw[m][bj];
                    const f32x4 x0 = (f32x4){__uint_as_float(w[0] << 16), __uint_as_float(w[0] & 0xffff0000u), __uint_as_float(w[1] << 16), __uint_as_float(w[1] & 0xffff0000u)};
                    const f32x4 x1 = (f32x4){__uint_as_float(w[2] << 16), __uint_as_float(w[2] & 0xffff0000u), __uint_as_float(w[3] << 16), __uint_as_float(w[3] & 0xffff0000u)};
                    const f32x4 v0 = x0 * DN_ALPHA + acc[ai][bj][m][0], v1 = x1 * DN_ALPHA + acc[ai][bj][m][1];
                    float s = ((v0[0] + v0[1]) + (v0[2] + v0[3])) + ((v1[0] + v1[1]) + (v1[2] + v1[3]));
                    float q = ((v0[0] * v0[0] + v0[1] * v0[1]) + (v0[2] * v0[2] + v0[3] * v0[3])) + ((v1[0] * v1[0] + v1[1] * v1[1]) + (v1[2] * v1[2] + v1[3] * v1[3]));
                    u32x4 o; o.x = cvt_pk_bf16(v0[0], v0[1]); o.y = cvt_pk_bf16(v0[2], v0[3]); o.z = cvt_pk_bf16(v1[0], v1[1]); o.w = cvt_pk_bf16(v1[2], v1[3]);
                    *(u32x4*)(r + (size_t)row * D_MODEL + col) = o;
                    s += __shfl_xor(s, 16); s += __shfl_xor(s, 32); q += __shfl_xor(q, 16); q += __shfl_xor(q, 32);
                    if (fq == 0) *(f32x2*)(stats + ((size_t)row * 32 + u.pn * 8 + bj * 4 + wc) * 2) = (f32x2){s, q};
                }
            }
        }
    } };
DI void phase_outproj(const P3Args& a, LAS unsigned char* lds) {
    gs::DenseSched S{a.y, a.wt_out, D_MODEL, (T_TOK / 256) * 4, vblock(), GRID, 4, 0, 4, 0}; EpiOut E{a.xb, a.r, a.stats}; gs::gemm_stream<true, true, 0>(lds, D_MODEL, S, E);
}

DI void unpack16(const u32x4& a, const u32x4& b, float (&v)[16]) {
#pragma unroll
    for (int j = 0; j < 4; ++j) { v[2 * j] = __uint_as_float(a[j] << 16); v[2 * j + 1] = __uint_as_float(a[j] & 0xffff0000u); v[8 + 2 * j] = __uint_as_float(b[j] << 16); v[8 + 2 * j + 1] = __uint_as_float(b[j] & 0xffff0000u); }
}
constexpr int RS_SC = 289;
constexpr int LDS_HIST = 100 * 1024;
struct P4Args { const bf16_t* r; const float* stats; const float* ln_g; const float* ln_b; bf16_t* x1; unsigned char* x1f8; const bf16_t* wt_r; const float* rbias;
                int* eidx; float* gate; int* counts; int* tokl; float* gatel; int* slot; };
DI void phase_router(const P4Args& a, const P0Args& cv, char* lds) {
    const int tid = tidx(), wid = tid >> 6, lane = tid & 63, wr = wid >> 2, wc = wid & 3, fr = lane & 15, fq = lane >> 4;
    float* sc = (float*)lds; int* hist = (int*)(lds + LDS_HIST); int* base = hist + 256;
    for (int u = vblock(); u < T_TOK / 128; u += GRID) {
        const int m0 = u * 128;
        if ((vblock() & 1) == 0) convert_moe_range(cv, lds, CV_GU, CV_GU + CV_DN);
        __syncthreads();
#pragma unroll 1
        for (int i0 = 0; i0 < 16; i0 += 4) {
            f32x2 st[4]; u32x4 r0[4], r1[4];
#pragma unroll
            for (int j4 = 0; j4 < 4; ++j4) {
                const int t = m0 + wid * 16 + i0 + j4;
                st[j4] = (f32x2){0.f, 0.f};
                if (lane < 32) st[j4] = *(const f32x2*)(a.stats + ((size_t)t * 32 + lane) * 2);
                r0[j4] = *(const u32x4*)(a.r + (size_t)t * D_MODEL + lane * 16); r1[j4] = *(const u32x4*)(a.r + (size_t)t * D_MODEL + lane * 16 + 8);
            }
#pragma unroll
            for (int j4 = 0; j4 < 4; ++j4) {
                const int t = m0 + wid * 16 + i0 + j4;
                float s = st[j4].x, q = st[j4].y;
#pragma unroll
                for (int o = 1; o <= 16; o <<= 1) { s += __shfl_xor(s, o); q += __shfl_xor(q, o); }
                s = __shfl(s, 0); q = __shfl(q, 0);
                const float mu = s * (1.f / 1024.f), rstd = rsqrtf(q * (1.f / 1024.f) - mu * mu + LN_EPS);
                float v[16]; unpack16(r0[j4], r1[j4], v);
                u32x4 o0, o1, o8;
#pragma unroll
                for (int j = 0; j < 4; ++j) {
                    const f32x4 g = *(const f32x4*)(a.ln_g + lane * 16 + 4 * j), bb = *(const f32x4*)(a.ln_b + lane * 16 + 4 * j);
                    const float y0 = (v[4 * j] - mu) * rstd * g[0] + bb[0], y1 = (v[4 * j + 1] - mu) * rstd * g[1] + bb[1], y2 = (v[4 * j + 2] - mu) * rstd * g[2] + bb[2], y3 = (v[4 * j + 3] - mu) * rstd * g[3] + bb[3];
                    o8[j] = pack_fp8x4(y0 * XSCALE, y1 * XSCALE, y2 * XSCALE, y3 * XSCALE);
                    const unsigned p0 = cvt_pk_bf16(y0, y1), p1 = cvt_pk_bf16(y2, y3);
                    if (j < 2) { o0[2 * j] = p0; o0[2 * j + 1] = p1; } else { o1[2 * (j - 2)] = p0; o1[2 * (j - 2) + 1] = p1; }
                }
                *(u32x4*)(a.x1 + (size_t)t * D_MODEL + lane * 16) = o0; *(u32x4*)(a.x1 + (size_t)t * D_MODEL + lane * 16 + 8) = o1;
                *(u32x4*)(a.x1f8 + (size_t)t * D_MODEL + lane * 16) = o8;
            }
        }
        if (tid < 256) hist[tid] = 0;
        asm volatile("s_waitcnt vmcnt(0)" ::: "memory");
        __syncthreads();
        ALoader<4> al; al.init_rows(a.x1, D_MODEL, m0);
        BLoaderBt bl; bl.init(a.wt_r, D_MODEL, 0);
        f32x4 acc[4][4];
        gemm_tile<4, true>(lds, al, bl, D_MODEL / 64, acc);
        int my_idx[2], my_rank[2]; float my_gate[2];
#pragma unroll
        for (int p = 0; p < 2; ++p) {
            __syncthreads();
            if (wr == p) {
#pragma unroll
                for (int m = 0; m < 4; ++m)
#pragma unroll
                    for (int n = 0; n < 4; ++n) {
                        const int c0 = 64 * wc + 16 * n + 4 * fq; const f32x4 rb = *(const f32x4*)(a.rbias + c0);
#pragma unroll
                        for (int j = 0; j < 4; ++j) { const int c = c0 + j; sc[(16 * m + fr) * RS_SC + (c >> 5) * 36 + (c & 31)] = 1.f / (1.f + __expf(-acc[m][n][j])) + rb[j]; }
                    }
            }
            __syncthreads();
            const int row = tid >> 3, g = tid & 7, t = m0 + 64 * p + row;
            float sel[32];
#pragma unroll
            for (int i = 0; i < 32; ++i) sel[i] = sc[row * RS_SC + g * 36 + i];
            float m1 = -INFINITY, m2 = -INFINITY;
#pragma unroll
            for (int i = 0; i < 32; ++i) { const float v = sel[i]; m2 = fmaxf(m2, fminf(m1, v)); m1 = fmaxf(m1, v); }
            const float gs = m1 + m2; int rank = 0;
#pragma unroll
            for (int d = 1; d < 8; ++d) { const float o = __shfl_xor(gs, d); const int og = g ^ d; rank += (o > gs || (o == gs && og < g)) ? 1 : 0; }
            const bool en = rank < TOPK_GROUPS;
            float lv = -INFINITY; int li = 1 << 20;
            if (en) {
#pragma unroll
                for (int i = 0; i < 32; ++i) { const float v = sel[i]; if (v > lv) { lv = v; li = g * 32 + i; } }
            }
            float myv = 0.f; int myi = 0;
#pragma unroll
            for (int k = 0; k < TOP_K; ++k) {
                float bv = lv; int bi = li;
#pragma unroll
                for (int d = 1; d < 8; d <<= 1) { const float ov = __shfl_xor(bv, d); const int oi = __shfl_xor(bi, d); if (ov > bv || (ov == bv && oi < bi)) { bv = ov; bi = oi; } }
                if (g == k) { myv = bv; myi = bi; }
                if (k + 1 < TOP_K && (bi >> 5) == g) {
                    lv = -INFINITY; li = 1 << 20;
#pragma unroll
                    for (int i = 0; i < 32; ++i) { if (g * 32 + i == bi) sel[i] = -INFINITY; const float v = sel[i]; if (v > lv) { lv = v; li = g * 32 + i; } }
                }
            }
            const float score = myv - a.rbias[myi];
            float gsum = score;
#pragma unroll
            for (int d = 1; d < 8; d <<= 1) gsum += __shfl_xor(gsum, d);
            const float gt = score / gsum * ROUTED_SCALE;
            a.eidx[t * TOP_K + g] = myi; a.gate[t * TOP_K + g] = gt;
            my_idx[p] = myi; my_gate[p] = gt; my_rank[p] = atomicAdd(&hist[myi], 1);
        }
        __syncthreads();
        if (tid < 256) { const int h = hist[tid]; base[tid] = h > 0 ? atomicAdd(&a.counts[tid * CSTR], h) : 0; }
        __syncthreads();
#pragma unroll
        for (int p = 0; p < 2; ++p) {
            const int row = tid >> 3, g = tid & 7, t = m0 + 64 * p + row, e = my_idx[p], pos = base[e] + my_rank[p];
            a.tokl[(size_t)e * CAP + pos] = t; a.gatel[(size_t)e * CAP + pos] = my_gate[p]; a.slot[t * TOP_K + g] = e * CAP + pos;
        }
        if ((vblock() & 1) == 1) convert_moe_range(cv, lds, CV_GU, CV_GU + CV_DN);
    }
}

constexpr int LDS_ROWTAB = 128 * 1024;
constexpr int LDS_GTAB = 139 * 1024;
constexpr int LDS_TAB = 150 * 1024;
constexpr int MOE_BM = 256;
DI void build_moe_tab(const int* counts, char* lds) {
    int* tstart = (int*)(lds + LDS_TAB); int* rstart = tstart + 264; int* cnts = tstart + 528;
    const int tid = tidx(), lane = tid & 63;
    __syncthreads();
    if (tid < 64) {
        int c[4], tl[4], cs = 0, ts = 0;
#pragma unroll
        for (int i = 0; i < 4; ++i) { c[i] = counts[(lane * 4 + i) * CSTR]; tl[i] = (c[i] + MOE_BM - 1) / MOE_BM; cs += c[i]; ts += tl[i]; }
        int ci = cs, ti = ts;
#pragma unroll
        for (int o = 1; o < 64; o <<= 1) { const int n1 = __shfl_up(ci, o), n2 = __shfl_up(ti, o); if (lane >= o) { ci += n1; ti += n2; } }
        int ce = ci - cs, te = ti - ts;
#pragma unroll
        for (int i = 0; i < 4; ++i) { rstart[lane * 4 + i] = ce; tstart[lane * 4 + i] = te; cnts[lane * 4 + i] = c[i]; ce += c[i]; te += tl[i]; }
        if (lane == 63) { rstart[256] = ce; tstart[256] = te; cnts[256] = T_TOK; rstart[257] = ce + T_TOK; tstart[257] = te + T_TOK / MOE_BM; }
    }
    __syncthreads();
}
DI int find_expert(const int* tstart, int g) {
    int lo = 0, hi = 256;
#pragma unroll 1
    while (lo < hi) { const int mid = (lo + hi + 1) >> 1; if (tstart[mid] <= g) lo = mid; else hi = mid - 1; }
    return lo;
}
struct MoeU { const char* A; const char* B; int e, m0, sub, ui; };
typedef const LAS int* ltab_t;
DI int find_expert_l(ltab_t tstart, int g) { int lo = 0, hi = 256;
#pragma unroll 1
    while (lo < hi) { const int mid = (lo + hi + 1) >> 1; if (tstart[mid] <= g) lo = mid; else hi = mid - 1; }
    return lo; }

struct P6Args { const unsigned char* x1; const int* counts; const int* tokl; const float* gatel; const unsigned char* wgut; unsigned char* H; };
struct GuSched {
    typedef MoeU U;
    ltab_t tab; const LAS int* rowtab; const unsigned char* x1; const unsigned char* wgut; int first, stride, nunits;
    DI bool next(int i, U& u) const {
        const int L = first + i * stride; if (L >= nunits) return false;
        const int g = L >> 1, e = find_expert_l(tab, g);
        u.sub = L & 1; u.e = e; u.ui = i; u.m0 = (g - tab[e]) * MOE_BM;
        u.A = (const char*)x1; u.B = (const char*)(wgut + ((size_t)e * 512 + 256 * u.sub) * D_MODEL); return true;
    }
    DI unsigned a_voff(int i, int h, int R, int C) const { return (unsigned)(rowtab[i * 256 + 128 * h + R] * (D_MODEL / 2) + C) * 2u; }
};
struct EpiGU { unsigned char* H; const LAS float* gtab; ltab_t tab;
    DI void operator()(const f32x4 (&acc)[2][2][4][2], const MoeU& u, int wr, int wc, int fr, int fq) const {
        const int st = tab[264 + u.e], cnt = tab[528 + u.e];
#pragma unroll
        for (int ai = 0; ai < 2; ++ai)
#pragma unroll
            for (int m = 0; m < 4; ++m) {
                const int row = u.m0 + 128 * ai + 64 * wr + 16 * m + fr;
                if (row < cnt) {
                    const float gt = gtab[u.ui * 256 + 128 * ai + 64 * wr + 16 * m + fr] * (HSCALE / (XSCALE * WSCALE));
                    float h[8];
#pragma unroll
                    for (int n = 0; n < 2; ++n)
#pragma unroll
                        for (int j = 0; j < 4; ++j) { const float gv = acc[ai][0][m][n][j] * (1.f / (XSCALE * WSCALE)); h[4 * n + j] = gv * __builtin_amdgcn_rcpf(1.f + __expf(-gv)) * acc[ai][1][m][n][j] * gt; }
                    *(u32x2*)(H + (size_t)(st + row) * D_EXP + 128 * u.sub + 32 * wc + 8 * fq) = (u32x2){pack_fp8x4(h[0], h[1], h[2], h[3]), pack_fp8x4(h[4], h[5], h[6], h[7])};
                }
            }
    } };
DI void phase_moe_gu(const P6Args& a, char* smem, LAS unsigned char* lds) {
    build_moe_tab(a.counts, smem);
    const int* tstart = (const int*)(smem + LDS_TAB); const int* rstart = tstart + 264; int* rowtab = (int*)(smem + LDS_ROWTAB); float* gtab = (float*)(smem + LDS_GTAB);
    const int nunits = tstart[257] * 2, first = vblock();
    const int n_my = first < nunits ? (nunits - first + GRID - 1) / GRID : 0;
    for (int idx = tidx(); idx < n_my * 256; idx += NTHR) {
        const int i = idx >> 8, row = idx & 255, L = first + i * GRID, g = L >> 1, e = find_expert(tstart, g), m0 = (g - tstart[e]) * MOE_BM, cnt = tstart[528 + e];
        int rr = m0 + row; rr = rr < cnt ? rr : cnt - 1;
        rowtab[idx] = e < N_EXP ? a.tokl[(size_t)e * CAP + rr] : rr;
        gtab[idx] = e < N_EXP ? a.gatel[(size_t)e * CAP + rr] : 1.f;
    }
    __syncthreads();
    GuSched S{(ltab_t)(lds + LDS_TAB), (const LAS int*)(lds + LDS_ROWTAB), a.x1, a.wgut, first, GRID, nunits}; EpiGU E{a.H, (const LAS float*)(lds + LDS_GTAB), (ltab_t)(lds + LDS_TAB)};
    gs::gemm_stream<true, true, 2>(lds, D_MODEL / 2, S, E);
}
struct P7Args { const unsigned char* H; const int* counts; const unsigned char* wdt; unsigned char* Y; };
struct DownSched {
    typedef MoeU U;
    ltab_t tab; const unsigned char* H; const unsigned char* wdt; int first, stride, nunits;
    DI bool next(int i, U& u) const {
        const int L = first + i * stride; if (L >= nunits) return false;
        const int g = L >> 2, e = find_expert_l(tab, g);
        u.sub = L & 3; u.e = e; u.ui = i; u.m0 = (g - tab[e]) * MOE_BM;
        u.A = (const char*)(H + (size_t)(tab[264 + e] + u.m0) * D_EXP); u.B = (const char*)(wdt + ((size_t)e * D_MODEL + 256 * u.sub) * D_EXP); return true;
    }
    DI unsigned a_voff(int, int h, int R, int C) const { return (unsigned)((128 * h + R) * (D_EXP / 2) + C) * 2u; }
};
struct EpiDown { unsigned char* Y; ltab_t tab;
    DI void operator()(const f32x4 (&acc)[2][2][4][2], const MoeU& u, int wr, int wc, int fr, int fq) const {
        const int st = tab[264 + u.e], cnt = tab[528 + u.e];
#pragma unroll
        for (int ai = 0; ai < 2; ++ai)
#pragma unroll
            for (int m = 0; m < 4; ++m) {
                const int row = u.m0 + 128 * ai + 64 * wr + 16 * m + fr;
                if (row < cnt) {
                    u32x4 o;
#pragma unroll
                    for (int bj = 0; bj < 2; ++bj) {
                        const f32x4 v0 = acc[ai][bj][m][0] * (YSCALE / (HSCALE * WSCALE)), v1 = acc[ai][bj][m][1] * (YSCALE / (HSCALE * WSCALE));
                        o[2 * bj] = pack_fp8x4(v0[0], v0[1], v0[2], v0[3]); o[2 * bj + 1] = pack_fp8x4(v1[0], v1[1], v1[2], v1[3]);
                    }
                    *(u32x4*)(Y + (size_t)(st + row) * D_MODEL + 256 * u.sub + 64 * wc + 16 * fq) = o;
                }
            }
    } };
DI void phase_moe_down(const P7Args& a, char* smem, LAS unsigned char* lds) {
    build_moe_tab(a.counts, smem);
    const int* tstart = (const int*)(smem + LDS_TAB); const int* rstart = tstart + 264;
    DownSched S{(ltab_t)(lds + LDS_TAB), a.H, a.wdt, vblock(), GRID, tstart[257] * 4}; EpiDown E{a.Y, (ltab_t)(lds + LDS_TAB)};
    gs::gemm_stream<true, true, 2>(lds, D_EXP / 2, S, E);
}
struct P8Args { const bf16_t* x1; const unsigned char* Y; const int* slot; const int* counts; const float* ln_g; const float* ln_b; float* out; };
DI void phase_combine(const P8Args& a, char* lds) {
    const int tid = tidx(), wid = tid >> 6, lane = tid & 63;
    build_moe_tab(a.counts, lds);
    const int* rstart = (const int*)(lds + LDS_TAB) + 264;
    const int sh0 = rstart[256];
    const int c0 = 256 * (lane >> 4) + 32 * ((lane >> 2) & 3) + 8 * (lane & 3);
    for (int t = vblock() * 8 + wid; t < T_TOK; t += GRID * 8) {
        float v[16], w[16];
        { const u32x4 p0 = *(const u32x4*)(a.x1 + (size_t)t * D_MODEL + c0), p1 = *(const u32x4*)(a.x1 + (size_t)t * D_MODEL + c0 + 128); unpack16(p0, p1, v); }
        int sl = 0; if (lane < TOP_K) sl = a.slot[t * TOP_K + lane];
        u32x4 yr[9];
        yr[8] = *(const u32x4*)(a.Y + (size_t)(sh0 + t) * D_MODEL + lane * 16);
#pragma unroll
        for (int k = 0; k < TOP_K; ++k) { const int s = __shfl(sl, k), e = s / CAP, pos = s % CAP; yr[k] = *(const u32x4*)(a.Y + (size_t)(rstart[e] + pos) * D_MODEL + lane * 16); }
#pragma unroll
        for (int i = 0; i < 16; ++i) w[i] = 0.f;
#pragma unroll
        for (int k = 0; k < 9; ++k)
#pragma unroll
            for (int j = 0; j < 4; ++j) { const f32x2 lo = __builtin_amdgcn_cvt_pk_f32_fp8((int)yr[k][j], false), hi = __builtin_amdgcn_cvt_pk_f32_fp8((int)yr[k][j], true); w[4 * j] += lo.x; w[4 * j + 1] += lo.y; w[4 * j + 2] += hi.x; w[4 * j + 3] += hi.y; }
#pragma unroll
        for (int i = 0; i < 16; ++i) v[i] = v[i] * DN_ALPHA + w[i] * (1.f / YSCALE);
        float s = 0.f;
#pragma unroll
        for (int i = 0; i < 16; ++i) s += v[i];
#pragma unroll
        for (int o = 32; o >= 1; o >>= 1) s += __shfl_xor(s, o);
        const float mu = s * (1.f / 1024.f);
        float q = 0.f;
#pragma unroll
        for (int i = 0; i < 16; ++i) { const float d = v[i] - mu; q += d * d; }
#pragma unroll
        for (int o = 32; o >= 1; o >>= 1) q += __shfl_xor(q, o);
        const float rstd = rsqrtf(q * (1.f / 1024.f) + LN_EPS);
#pragma unroll
        for (int j = 0; j < 4; ++j) {
            const int col = c0 + 128 * (j >> 1) + 4 * (j & 1);
            const f32x4 g = *(const f32x4*)(a.ln_g + col), bb = *(const f32x4*)(a.ln_b + col);
            f32x4 o; o[0] = (v[4 * j] - mu) * rstd * g[0] + bb[0]; o[1] = (v[4 * j + 1] - mu) * rstd * g[1] + bb[1]; o[2] = (v[4 * j + 2] - mu) * rstd * g[2] + bb[2]; o[3] = (v[4 * j + 3] - mu) * rstd * g[3] + bb[3];
            *(f32x4*)(a.out + (size_t)t * D_MODEL + col) = o;
        }
    }
}
#define MFMA32(a, b, c) __builtin_amdgcn_mfma_f32_32x32x16_bf16((a), (b), (c), 0, 0, 0)
constexpr float SB_EXIT_THR = 1e-30f;
struct P2Args { const bf16_t* Q; const bf16_t* Kb; const bf16_t* Vt; const float* rel_bias; const float* gain_a; const float* gain_b; bf16_t* y; };

DI bf16x8 pack8(const f32x16& x, int s) {
    u32x4 p;
    if (s == 0) { p.x = cvt_pk_bf16(x[0], x[1]); p.y = cvt_pk_bf16(x[2], x[3]); p.z = cvt_pk_bf16(x[4], x[5]); p.w = cvt_pk_bf16(x[6], x[7]); }
    else        { p.x = cvt_pk_bf16(x[8], x[9]); p.y = cvt_pk_bf16(x[10], x[11]); p.z = cvt_pk_bf16(x[12], x[13]); p.w = cvt_pk_bf16(x[14], x[15]); }
    return __builtin_bit_cast(bf16x8, p);
}
DI void load_k(bf16x8 (&k)[4], const bf16_t* kp, int k0) {
#pragma unroll
    for (int kk = 0; kk < 4; ++kk) k[kk] = *(const bf16x8*)(kp + (size_t)(k0 >> 5) * 2048 + kk * 512);
}
DI void load_v(bf16x8 (&v)[2][2], const bf16_t* vp, int k0) {
#pragma unroll
    for (int dt = 0; dt < 2; ++dt)
#pragma unroll
        for (int s = 0; s < 2; ++s) v[dt][s] = *(const bf16x8*)(vp + (size_t)(k0 >> 5) * 2048 + (dt * 2 + s) * 512);
}

constexpr int LDS_CVT = 16 * 1024;
DI void phase_attn(const P2Args& a, const P0Args& cv, char* lds) {
    const int tid = tidx(), wid = tid >> 6, lane = tid & 63, r = lane & 31, h = lane >> 5;
    float* tbl = (float*)lds;
    float* ssq = (float*)(lds + 8 * 260 * 4);
    __syncthreads();
    for (int i = tid; i < NHA * 257; i += NTHR) { const int hd = i / 257, j = i % 257; tbl[hd * 260 + j] = a.rel_bias[i] * LOG2E; }
    __syncthreads();
    const int cgrp = vblock() % 3;
#pragma unroll 1
    for (int slot = 0; slot < 5; ++slot) {
        if ((cgrp == 0 && slot == 0) || (cgrp == 1 && slot == 2) || (cgrp == 2 && slot == 4)) convert_moe_range(cv, lds + LDS_CVT, 0, CV_GU);
        if (slot == 4) break;
        const int u = vblock() + GRID * (slot >> 1) + 2 * GRID * (slot & 1);
        const bool isB = u >= BATCH * (SEQ / 64); const int uu = isB ? u - BATCH * (SEQ / 64) : u;
        const int b = uu / (SEQ / 64), c = uu % (SEQ / 64), q0 = c * 64, hh = (isB ? NHA : 0) + wid;
        const size_t hb = (size_t)(b * NHH + hh) * SEQ * 64;
        const bf16_t* kp = a.Kb + hb + lane * 8;
        const bf16_t* vp = a.Vt + hb + lane * 8;
        bf16x8 qf[2][4];
#pragma unroll
        for (int qt = 0; qt < 2; ++qt)
#pragma unroll
            for (int kk = 0; kk < 4; ++kk) qf[qt][kk] = *(const bf16x8*)(a.Q + hb + (size_t)((q0 >> 5) + qt) * 2048 + kk * 512 + lane * 8);
        f32x16 ot[2][2];
#pragma unroll
        for (int dt = 0; dt < 2; ++dt)
#pragma unroll
            for (int qt = 0; qt < 2; ++qt)
#pragma unroll
                for (int i = 0; i < 16; ++i) ot[dt][qt][i] = 0.f;
        float linv[2] = {1.f, 1.f};
        if (!isB) {
            float mrun[2] = {-INFINITY, -INFINITY}, lrun[2] = {0.f, 0.f};
            const int klo = q0 - LEFT_CHUNKS * CHUNK < 0 ? 0 : q0 - LEFT_CHUNKS * CHUNK, khi = q0 + 64;
            const float cfar = tbl[wid * 260 + 256];
            bf16x8 kc[4], kn[4], vf[2][2]; load_k(kc, kp, klo);
            for (int k0 = klo; k0 < khi; k0 += 32) {
                load_v(vf, vp, k0);
                load_k(kn, kp, k0 + 32 < khi ? k0 + 32 : k0);
#pragma unroll
                for (int qt = 0; qt < 2; ++qt) {
                    bf16x8 pf[2];
                    f32x16 st;
#pragma unroll
                    for (int i = 0; i < 16; ++i) st[i] = 0.f;
#pragma unroll
                    for (int kk = 0; kk < 4; ++kk) st = MFMA32(kc[kk], qf[qt][kk], st);
                    const int dmin = q0 + 32 * qt - k0 - 31;
                    if (dmin >= MAX_REL) {
#pragma unroll
                        for (int i = 0; i < 16; ++i) st[i] += cfar;
                    } else {
                        const int bidx = q0 + 32 * qt + r - k0 - 4 * h + MAX_REL;
#pragma unroll
                        for (int i = 0; i < 16; ++i) { int ix = bidx - ((i & 3) + 8 * (i >> 2)); ix = ix < 0 ? 0 : (ix > 2 * MAX_REL ? 2 * MAX_REL : ix); st[i] += tbl[wid * 260 + ix]; }
                    }
                    float mx = st[0];
#pragma unroll
                    for (int i = 1; i < 16; ++i) mx = fmaxf(mx, st[i]);
                    mx = fmaxf(mx, __shfl_xor(mx, 32));
                    const float mn = fmaxf(mrun[qt], mx), alpha = __builtin_amdgcn_exp2f(mrun[qt] - mn);
                    mrun[qt] = mn;
                    float ps = 0.f;
#pragma unroll
                    for (int i = 0; i < 16; ++i) { st[i] = __builtin_amdgcn_exp2f(st[i] - mn); ps += st[i]; }
                    lrun[qt] = lrun[qt] * alpha + ps;
#pragma unroll
                    for (int i = 0; i < 16; ++i) { ot[0][qt][i] *= alpha; ot[1][qt][i] *= alpha; }
                    pf[0] = pack8(st, 0); pf[1] = pack8(st, 1);
#pragma unroll
                    for (int dt = 0; dt < 2; ++dt)
#pragma unroll
                        for (int s = 0; s < 2; ++s) ot[dt][qt] = MFMA32(vf[dt][s], pf[s], ot[dt][qt]);
                }
#pragma unroll
                for (int kk = 0; kk < 4; ++kk) kc[kk] = kn[kk];
            }
#pragma unroll
            for (int qt = 0; qt < 2; ++qt) { const float lt = lrun[qt] + __shfl_xor(lrun[qt], 32); linv[qt] = 1.f / lt; }
        } else {
            float carry[2] = {1.f, 1.f};
            bf16x8 kc[4], kn[4], vf[2][2]; load_k(kc, kp, q0 + 32);
            for (int k0 = q0 + 32; k0 >= 0; k0 -= 32) {
                load_v(vf, vp, k0);
                load_k(kn, kp, k0 >= 32 ? k0 - 32 : k0);
#pragma unroll
                for (int qt = 0; qt < 2; ++qt) {
                    bf16x8 pf[2];
                    f32x16 st;
#pragma unroll
                    for (int i = 0; i < 16; ++i) st[i] = 0.f;
                    const bool none = (k0 > q0 + 32 * qt + 30);
                    if (!none) {
#pragma unroll
                        for (int kk = 0; kk < 4; ++kk) st = MFMA32(kc[kk], qf[qt][kk], st);
                        const bool full = (k0 + 31 < q0 + 32 * qt);
                        const int lim = q0 + 32 * qt + r - k0 - 4 * h;
                        float om[16];
#pragma unroll
                        for (int i = 0; i < 16; ++i) {
                            const float e = __builtin_amdgcn_exp2f(-st[i]); float bta = __builtin_amdgcn_rcpf(1.f + e);
                            if (!full && !(((i & 3) + 8 * (i >> 2)) < lim)) bta = 0.f;
                            st[i] = bta; om[i] = 1.f - bta;
                        }
                        float G[4], Go[4];
#pragma unroll
                        for (int g = 0; g < 4; ++g) { G[g] = (om[4 * g] * om[4 * g + 1]) * (om[4 * g + 2] * om[4 * g + 3]); Go[g] = __shfl_xor(G[g], 32); }
                        float R = carry[qt];
#pragma unroll
                        for (int g = 3; g >= 0; --g) {
                            float run = h == 0 ? R * Go[g] : R;
#pragma unroll
                            for (int uu2 = 3; uu2 >= 0; --uu2) { const float bta = st[4 * g + uu2]; st[4 * g + uu2] = bta * run; run *= om[4 * g + uu2]; }
                            R = R * (G[g] * Go[g]);
                        }
                        carry[qt] = R;
                    }
                    if (!none) {
                        pf[0] = pack8(st, 0); pf[1] = pack8(st, 1);
#pragma unroll
                        for (int dt = 0; dt < 2; ++dt)
#pragma unroll
                            for (int s = 0; s < 2; ++s) ot[dt][qt] = MFMA32(vf[dt][s], pf[s], ot[dt][qt]);
                    }
                }
#pragma unroll
                for (int kk = 0; kk < 4; ++kk) kc[kk] = kn[kk];
                if (__all(carry[0] < SB_EXIT_THR && carry[1] < SB_EXIT_THR)) break;
            }
        }
        float ss[2];
#pragma unroll
        for (int qt = 0; qt < 2; ++qt) {
            float s2 = 0.f;
#pragma unroll
            for (int dt = 0; dt < 2; ++dt)
#pragma unroll
                for (int i = 0; i < 16; ++i) { ot[dt][qt][i] *= linv[qt]; s2 += ot[dt][qt][i] * ot[dt][qt][i]; }
            s2 += __shfl_xor(s2, 32); ss[qt] = s2;
        }
        __syncthreads();
        if (h == 0) { ssq[wid * 64 + r] = ss[0]; ssq[wid * 64 + 32 + r] = ss[1]; }
        __syncthreads();
        const float* gain = isB ? a.gain_b : a.gain_a;
#pragma unroll
        for (int qt = 0; qt < 2; ++qt) {
            float tot = 0.f;
#pragma unroll
            for (int w8 = 0; w8 < 8; ++w8) tot += ssq[w8 * 64 + 32 * qt + r];
            const float rs = rsqrtf(tot * (1.f / 512.f) + RMS_EPS);
            bf16_t* yp = a.y + (size_t)(b * SEQ + q0 + 32 * qt + r) * D_MODEL + (isB ? 512 : 0) + wid * 64;
#pragma unroll
            for (int dt = 0; dt < 2; ++dt)
#pragma unroll
                for (int g = 0; g < 4; ++g) {
                    const int d = 32 * dt + 8 * g + 4 * h; const f32x4 gn = *(const f32x4*)(gain + wid * 64 + d);
                    u32x2 o; o.x = cvt_pk_bf16(ot[dt][qt][4 * g] * rs * gn[0], ot[dt][qt][4 * g + 1] * rs * gn[1]); o.y = cvt_pk_bf16(ot[dt][qt][4 * g + 2] * rs * gn[2], ot[dt][qt][4 * g + 3] * rs * gn[3]);
                    *(u32x2*)(yp + d) = o;
                }
        }
    }
}


#define XB_TMO      128
#define XB_XCNT(j)  (256  + 64 * (j))
#define XB_XSUB(j)  (1280 + 64 * (j))
#define XB_XGEN(j)  (2304 + 64 * (j))
#define XB_TOP      3328
#define XB_TOPGEN   3392
#define XCD_BAR_WORDS 3456
#define XB_SPIN_CAP (1u << 18)
#define LAS __attribute__((address_space(3)))

__device__ __forceinline__ unsigned xb_ld(unsigned* p)              { return __hip_atomic_load(p, __ATOMIC_RELAXED, __HIP_MEMORY_SCOPE_AGENT); }
__device__ __forceinline__ unsigned xb_add(unsigned* p, unsigned v) { return __hip_atomic_fetch_add(p, v, __ATOMIC_RELAXED, __HIP_MEMORY_SCOPE_AGENT); }
__device__ __forceinline__ unsigned xb_xcc_id() { return (unsigned)__builtin_amdgcn_s_getreg((3 << 11) | 20) & 0xFu; }
#define XB_SPIN(cond, bar) do { unsigned _sp = 0; while (cond) { __builtin_amdgcn_s_sleep(1); \
    if ((++_sp & 255u) == 0u) { if (xb_ld(&(bar)[XB_TMO])) break; if (_sp > XB_SPIN_CAP) { atomicAdd(&(bar)[XB_TMO], 1u); break; } } } } while (0)

struct XcdBarrier {
    unsigned* bar; unsigned x;
    volatile LAS unsigned* st;
};

__device__ __forceinline__ XcdBarrier xcd_barrier_post(unsigned* bar, volatile LAS unsigned* st) {
    XcdBarrier b; b.bar = bar; b.x = xb_xcc_id(); b.st = st;
    if (threadIdx.x == 0) (void)xb_add(&bar[XB_XCNT(b.x)], 1u);
    return b;
}
__device__ __forceinline__ void xcd_barrier_complete(unsigned* bar, unsigned x, unsigned& nloc, unsigned& nx) {
    const unsigned G = gridDim.x * gridDim.y * gridDim.z;
    unsigned sum, cnt, mine, sp = 0u;
    for (;;) {
        sum = 0u; cnt = 0u; mine = 0u;
#pragma unroll
        for (unsigned j = 0; j < 16; ++j) { const unsigned c = xb_ld(&bar[XB_XCNT(j)]); sum += c; cnt += (c > 0u) ? 1u : 0u; mine = (j == x) ? c : mine; }
        if (sum == G) break;
        __builtin_amdgcn_s_sleep(1);
        if ((++sp & 255u) == 0u) { if (xb_ld(&bar[XB_TMO])) break; if (sp > XB_SPIN_CAP) { atomicAdd(&bar[XB_TMO], 1u); break; } }
    }
    nloc = mine > 0u ? mine : 1u; nx = cnt > 0u ? cnt : 1u;
}

__device__ __forceinline__ void xcd_barrier(const XcdBarrier& b) {
    asm volatile("s_waitcnt vmcnt(0)" ::: "memory");
    __syncthreads();
    if (threadIdx.x == 0) {
        unsigned* bar = b.bar;
        __builtin_amdgcn_s_waitcnt(0);
        unsigned nloc = b.st[0], nx = b.st[1];
        if (nloc == 0u) { xcd_barrier_complete(bar, b.x, nloc, nx); b.st[0] = nloc; b.st[1] = nx; }
        const unsigned old = xb_add(&bar[XB_XSUB(b.x)], 1u);
        const unsigned gen = old / nloc;
        if (old + 1u == (gen + 1u) * nloc) {
            __builtin_amdgcn_fence(__ATOMIC_RELEASE, "agent");
            asm volatile("s_waitcnt vmcnt(0)" ::: "memory");
            const unsigned og = xb_add(&bar[XB_TOP], 1u);
            const unsigned tg = og / nx;
            if (og + 1u == (tg + 1u) * nx) xb_add(&bar[XB_TOPGEN], 1u);
            else XB_SPIN(xb_ld(&bar[XB_TOPGEN]) == tg, bar);
            __builtin_amdgcn_fence(__ATOMIC_ACQUIRE, "agent");
            xb_add(&bar[XB_XGEN(b.x)], 1u);
            asm volatile("s_waitcnt vmcnt(0)" ::: "memory");
        } else {
            XB_SPIN(xb_ld(&bar[XB_XGEN(b.x)]) == gen, bar);
            __builtin_amdgcn_fence(__ATOMIC_ACQUIRE, "agent");
            asm volatile("s_waitcnt vmcnt(0)" ::: "memory");
        }
    }
    __syncthreads();
}


struct MegaArgs { P0Args p0; P1Args p1; P2Args p2; P3Args p3; P4Args p4; P6Args p6; P7Args p7; P8Args p8; unsigned* bar; };
__global__ __launch_bounds__(NTHR, 2) void k_mega(MegaArgs a) {
    extern __shared__ __attribute__((aligned(16))) char smem[];
    volatile LAS unsigned* xbw = (volatile LAS unsigned*)(smem + LDS_BYTES - 16);
    if (threadIdx.x == 0) { xbw[0] = 0u; xbw[1] = 0u; xbw[2] = 0u; xbw[3] = 0u; }
    __syncthreads();
    XcdBarrier bar = xcd_barrier_post(a.bar, xbw);
    LAS unsigned char* L = (LAS unsigned char*)smem;
    phase_prologue(a.p0, smem);     xcd_barrier(bar);
    phase_qkv(a.p1, L);             xcd_barrier(bar);
    phase_attn(a.p2, a.p0, smem);   xcd_barrier(bar);
    phase_outproj(a.p3, L);         xcd_barrier(bar);
    phase_router(a.p4, a.p0, smem); xcd_barrier(bar);
    phase_moe_gu(a.p6, smem, L);    xcd_barrier(bar);
    phase_moe_down(a.p7, smem, L);  xcd_barrier(bar);
    phase_combine(a.p8, smem);
}

extern "C" void kernel_launch(void* const* d_in, const int* in_sizes, int n_in, void* d_out, int out_size, void* d_ws, size_t ws_size, hipStream_t stream) {
    const float* x = (const float*)d_in[0];      const float* w_in = (const float*)d_in[1];   const float* rel_bias = (const float*)d_in[2];
    const float* gain_a = (const float*)d_in[3]; const float* gain_b = (const float*)d_in[4]; const float* w_out = (const float*)d_in[5];
    const float* ln1_g = (const float*)d_in[6];  const float* ln1_b = (const float*)d_in[7];  const float* router_w = (const float*)d_in[8];
    const float* router_bias = (const float*)d_in[9]; const float* w_gate = (const float*)d_in[10]; const float* w_up = (const float*)d_in[11];
    const float* w_down = (const float*)d_in[12]; const float* ws_gate = (const float*)d_in[13]; const float* ws_up = (const float*)d_in[14];
    const float* ws_down = (const float*)d_in[15]; const float* ln2_g = (const float*)d_in[16]; const float* ln2_b = (const float*)d_in[17];
    char* ws = (char*)d_ws; float* out = (float*)d_out;
    int* ctrl = (int*)(ws + OFF_CTRL); int* counts = ctrl + CW_COUNTS;
    bf16_t* X1 = (bf16_t*)(ws + OFF_X1); int* tokl = (int*)(ws + OFF_TOKL); float* gatel = (float*)(ws + OFF_GATEL);
    int* eidx = (int*)(ws + OFF_EIDX); float* gate = (float*)(ws + OFF_GATE); int* slot = (int*)(ws + OFF_SLOT);
    unsigned char* H = (unsigned char*)(ws + OFF_H); unsigned char* Y = (unsigned char*)(ws + OFF_Y); unsigned char* x1f8 = (unsigned char*)(ws + OFF_X1F8);
    bf16_t* Q = (bf16_t*)(ws + OFF_Q); bf16_t* Kb = (bf16_t*)(ws + OFF_K); bf16_t* Vt = (bf16_t*)(ws + OFF_VT);
    bf16_t* yatt = (bf16_t*)(ws + OFF_YATT); bf16_t* r = (bf16_t*)(ws + OFF_R);
    bf16_t* xb = (bf16_t*)(ws + OFF_XB); float* stats = (float*)(ws + OFF_STATS);
    bf16_t* wt_in = (bf16_t*)(ws + OFF_WTIN); bf16_t* wt_out = (bf16_t*)(ws + OFF_WTOUT); bf16_t* wt_r = (bf16_t*)(ws + OFF_WTR);
    unsigned char* wgut = (unsigned char*)(ws + OFF_WGUT); unsigned char* wdt = (unsigned char*)(ws + OFF_WDT);
    if (ws_size < WS_NEEDED) { fprintf(stderr, "kernel_launch: workspace too small (%zu < %zu)\n", ws_size, (size_t)WS_NEEDED); return; }
    hipMemsetAsync(ctrl, 0, 128 * 1024, stream);
    static bool attr_done = false;
    if (!attr_done) {
        hipFuncSetAttribute((const void*)k_mega, hipFuncAttributeMaxDynamicSharedMemorySize, LDS_BYTES);
        attr_done = true;
    }
    MegaArgs m{};
    m.p0 = P0Args{x, w_in, w_out, router_w, xb, wt_in, wt_out, wt_r, w_gate, w_up, w_down, ws_gate, ws_up, ws_down, wgut, wdt};
    m.p1 = P1Args{xb, wt_in, Q, Kb, Vt};
    m.p2 = P2Args{Q, Kb, Vt, rel_bias, gain_a, gain_b, yatt};
    m.p3 = P3Args{yatt, wt_out, xb, r, stats};
    m.p4 = P4Args{r, stats, ln1_g, ln1_b, X1, x1f8, wt_r, router_bias, eidx, gate, counts, tokl, gatel, slot};
    m.p6 = P6Args{x1f8, counts, tokl, gatel, wgut, H};
    m.p7 = P7Args{H, counts, wdt, Y};
    m.p8 = P8Args{X1, Y, slot, counts, ln2_g, ln2_b, out};
    m.bar = (unsigned*)ctrl;
    k_mega<<<GRID, NTHR, LDS_BYTES, stream>>>(m);
}
```

```cpp
#include <hip/hip_runtime.h>
#include <cstdint>
#include <cstdio>

typedef unsigned short bf16_t;

constexpr int D_MODEL = 1024, BATCH = 16, SEQ = 2048, T_TOK = BATCH * SEQ;
constexpr int HEAD_DIM = 64, NHA = 8, NHB = 8, NHH = 16;
constexpr int CHUNK = 64, LEFT_CHUNKS = 8, MAX_REL = 128;
constexpr int N_EXP = 256, TOP_K = 8, N_GROUPS = 8, TOPK_GROUPS = 4, EPG = 32, D_EXP = 256;
constexpr float ROUTED_SCALE = 2.5f, LN_EPS = 1e-5f, RMS_EPS = 1e-6f;
constexpr float DN_ALPHA = 1.189207115002721f;
constexpr float LOG2E = 1.4426950408889634f, LN2 = 0.6931471805599453f;
constexpr float QSCALE = 0.125f * LOG2E;
constexpr float WSCALE = 64.f, XSCALE = 16.f, HSCALE = 16.f;
constexpr float YSCALE = 64.f;
constexpr int CAP = T_TOK;
constexpr int ROWS_ALL = T_TOK * TOP_K + T_TOK;

__device__ __forceinline__ float bf2f(bf16_t v) { return __uint_as_float(((unsigned)v) << 16); }
__device__ __forceinline__ bf16_t f2bf(float f) { unsigned u = __float_as_uint(f); u += 0x7fffu + ((u >> 16) & 1u); return (bf16_t)(u >> 16); }

constexpr size_t MB = 1024ull * 1024ull;
constexpr size_t OFF_CTRL   = 0;
constexpr size_t OFF_X1     = 1 * MB;
constexpr size_t OFF_TOKL   = OFF_X1 + 64 * MB;
constexpr size_t OFF_GATEL  = OFF_TOKL + 32 * MB;
constexpr size_t OFF_EIDX   = OFF_GATEL + 32 * MB;
constexpr size_t OFF_GATE   = OFF_EIDX + 1 * MB;
constexpr size_t OFF_SLOT   = OFF_GATE + 1 * MB;
constexpr size_t OFF_WDT    = OFF_SLOT + 1 * MB;
constexpr size_t OFF_X1F8   = OFF_WDT + 72 * MB;
constexpr size_t OFF_BIG    = OFF_WDT + 129 * MB;
constexpr size_t OFF_H      = OFF_BIG;
constexpr size_t OFF_Y      = OFF_BIG + 144 * MB;
constexpr size_t OFF_Q      = OFF_BIG;
constexpr size_t OFF_K      = OFF_BIG + 64 * MB;
constexpr size_t OFF_VT     = OFF_BIG + 128 * MB;
constexpr size_t OFF_YATT   = OFF_BIG + 192 * MB;
constexpr size_t OFF_R      = OFF_BIG + 256 * MB;
constexpr size_t OFF_XB     = OFF_BIG + 320 * MB;
constexpr size_t OFF_STATS  = OFF_BIG + 384 * MB;
constexpr size_t OFF_WTIN   = OFF_BIG + 392 * MB;
constexpr size_t OFF_WTOUT  = OFF_BIG + 398 * MB;
constexpr size_t OFF_WTR    = OFF_BIG + 400 * MB;
constexpr size_t OFF_WGUT   = OFF_BIG + 401 * MB;
constexpr size_t WS_NEEDED  = OFF_BIG + 720 * MB;
static_assert(OFF_WGUT + 257 * MB <= WS_NEEDED && WS_NEEDED <= 1024 * MB, "workspace map");
constexpr int CW_COUNTS = 8192;
constexpr int CSTR = 64;

typedef short bf16x8 __attribute__((ext_vector_type(8)));
typedef float f32x4 __attribute__((ext_vector_type(4)));
typedef float f32x2 __attribute__((ext_vector_type(2)));
typedef float f32x16 __attribute__((ext_vector_type(16)));
typedef unsigned u32x4 __attribute__((ext_vector_type(4)));
typedef unsigned u32x2 __attribute__((ext_vector_type(2)));
#define DI __device__ __forceinline__
constexpr int NTHR = 512, GRID = 256;
DI int tidx() { int t = threadIdx.x; asm volatile("" : "+v"(t)); return t; }
constexpr int LDS_BYTES = 160 * 1024;

typedef __bf16 bf16x2_t __attribute__((ext_vector_type(2)));
DI unsigned cvt_pk_bf16(float lo, float hi) { f32x2 v = {lo, hi}; bf16x2_t r = __builtin_convertvector(v, bf16x2_t); return __builtin_bit_cast(unsigned, r); }
DI float clamp8(float v) { return __builtin_amdgcn_fmed3f(v, -440.f, 440.f); }
DI unsigned pack_fp8x4(float a, float b, float c, float d) { int w = 0; w = __builtin_amdgcn_cvt_pk_fp8_f32(clamp8(a), clamp8(b), w, false); w = __builtin_amdgcn_cvt_pk_fp8_f32(clamp8(c), clamp8(d), w, true); return (unsigned)w; }
DI int vblock() { return (int)((blockIdx.x & 7) * (GRID / 8) + (blockIdx.x >> 3)); }

template <int MT> struct Tile { static constexpr int BM = 32 * MT, A_BYTES = BM * 128, B_BYTES = 256 * 128, STAGE = A_BYTES + B_BYTES; };

template <int MT> struct ALoader {
    const bf16_t* p[MT / 2]; u32x4 v[MT / 2]; int off0;
    DI void init_rows(const bf16_t* A, int lda, int row0) {
        const int tid = tidx(), kc = tid & 7, r = tid >> 3;
#pragma unroll
        for (int i = 0; i < MT / 2; ++i) p[i] = A + (size_t)(row0 + r + 64 * i) * lda + kc * 8;
        off0 = r * 128 + ((kc ^ ((r >> 1) & 7)) << 4);
    }
    DI void init_gather(const bf16_t* A, int lda, const int* rows, int cnt, int m0) {
        const int tid = tidx(), kc = tid & 7, r = tid >> 3;
#pragma unroll
        for (int i = 0; i < MT / 2; ++i) { int rr = m0 + r + 64 * i; rr = rr < cnt ? rr : cnt - 1; const int g = rows ? rows[rr] : rr; p[i] = A + (size_t)g * lda + kc * 8; }
        off0 = r * 128 + ((kc ^ ((r >> 1) & 7)) << 4);
    }
    DI void load(int k0) {
#pragma unroll
        for (int i = 0; i < MT / 2; ++i) v[i] = *(const u32x4*)(p[i] + k0);
    }
    DI void store(char* ldsA) const {
#pragma unroll
        for (int i = 0; i < MT / 2; ++i) *(u32x4*)(ldsA + off0 + i * 8192) = v[i];
    }
};
struct BLoaderBt {
    const bf16_t* p[4]; u32x4 v[4]; int off0;
    DI void init(const bf16_t* Bt, int ldk, int n0) {
        const int tid = tidx(), kc = tid & 7, r = tid >> 3;
#pragma unroll
        for (int i = 0; i < 4; ++i) p[i] = Bt + (size_t)(n0 + r + 64 * i) * ldk + kc * 8;
        off0 = r * 128 + ((kc ^ ((r >> 1) & 7)) << 4);
    }
    DI void load(int k0) {
#pragma unroll
        for (int i = 0; i < 4; ++i) v[i] = *(const u32x4*)(p[i] + k0);
    }
    DI void store(char* ldsB) const {
#pragma unroll
        for (int i = 0; i < 4; ++i) *(u32x4*)(ldsB + off0 + i * 8192) = v[i];
    }
};
template <int MT, bool TR, class AL, class BL>
DI void gemm_tile(char* lds, AL& al, BL& bl, int nk, f32x4 (&acc)[MT][4]) {
    typedef Tile<MT> TT;
    const int tid = tidx(), wid = tid >> 6, lane = tid & 63, wr = wid >> 2, wc = wid & 3, fr = lane & 15, fq = lane >> 4;
#pragma unroll
    for (int m = 0; m < MT; ++m)
#pragma unroll
        for (int n = 0; n < 4; ++n) acc[m][n] = (f32x4){0.f, 0.f, 0.f, 0.f};
    int aoff[2], boff[2];
#pragma unroll
    for (int ks = 0; ks < 2; ++ks) { const int ch = (((4 * ks + fq) ^ (fr >> 1)) << 4); aoff[ks] = (16 * MT * wr + fr) * 128 + ch; boff[ks] = TT::A_BYTES + (64 * wc + fr) * 128 + ch; }
    al.load(0); bl.load(0);
    __syncthreads();
    al.store(lds); bl.store(lds + TT::A_BYTES);
    __syncthreads();
    for (int kt = 0; kt < nk; ++kt) {
        char* cur = lds + (kt & 1) * TT::STAGE; char* nxt = lds + ((kt & 1) ^ 1) * TT::STAGE;
        const bool more = kt + 1 < nk;
        if (more) { al.load((kt + 1) * 64); bl.load((kt + 1) * 64); }
#pragma unroll
        for (int ks = 0; ks < 2; ++ks) {
            bf16x8 a[MT], b[4];
#pragma unroll
            for (int m = 0; m < MT; ++m) a[m] = *(const bf16x8*)(cur + aoff[ks] + m * 2048);
#pragma unroll
            for (int n = 0; n < 4; ++n) b[n] = *(const bf16x8*)(cur + boff[ks] + n * 2048);
#pragma unroll
            for (int m = 0; m < MT; ++m)
#pragma unroll
                for (int n = 0; n < 4; ++n)
                    acc[m][n] = TR ? __builtin_amdgcn_mfma_f32_16x16x32_bf16(b[n], a[m], acc[m][n], 0, 0, 0) : __builtin_amdgcn_mfma_f32_16x16x32_bf16(a[m], b[n], acc[m][n], 0, 0, 0);
        }
        if (more) { al.store(nxt); bl.store(nxt + TT::A_BYTES); }
        __syncthreads();
    }
}

#define LAS __attribute__((address_space(3)))
namespace gs {
constexpr int BM = 256, BK = 64, HALF = 128, HTB = HALF * BK * 2, STAGE_BYTES = 8 * HTB;
DI int lds_byte(int r, int c) { const int st = (r >> 4) * 2 + (c >> 5), rr = r & 15, cc = c & 31, ob = rr * 64 + cc * 2; return st * 1024 + (ob ^ (((ob >> 9) & 1) << 5)); }
DI void stage_rc(int b, int& R, int& C) { const int st = b / 1024, sb = b % 1024, swz = sb ^ (((sb >> 9) & 1) << 5); R = (st >> 1) * 16 + swz / 64; C = (st & 1) * 32 + (swz % 64) / 2; }
DI int perm32(int rho) { const int n = rho >> 4, i = rho & 15; return 8 * (i >> 2) + 4 * n + (i & 3); }
typedef long i64x2 __attribute__((ext_vector_type(2)));
DI const char* uni(const char* p) { const unsigned long long v = (unsigned long long)p; const unsigned lo = __builtin_amdgcn_readfirstlane((unsigned)v), hi = __builtin_amdgcn_readfirstlane((unsigned)(v >> 32)); return (const char*)(((unsigned long long)hi << 32) | lo); }
template <bool TR, bool F8>
DI f32x4 mma16(const bf16x8& a, const bf16x8& b, f32x4 c) {
    if (F8) {
        const i64x2 a2 = __builtin_bit_cast(i64x2, a), b2 = __builtin_bit_cast(i64x2, b);
        c = TR ? __builtin_amdgcn_mfma_f32_16x16x32_fp8_fp8(b2[0], a2[0], c, 0, 0, 0) : __builtin_amdgcn_mfma_f32_16x16x32_fp8_fp8(a2[0], b2[0], c, 0, 0, 0);
        return TR ? __builtin_amdgcn_mfma_f32_16x16x32_fp8_fp8(b2[1], a2[1], c, 0, 0, 0) : __builtin_amdgcn_mfma_f32_16x16x32_fp8_fp8(a2[1], b2[1], c, 0, 0, 0);
    }
    return TR ? __builtin_amdgcn_mfma_f32_16x16x32_bf16(b, a, c, 0, 0, 0) : __builtin_amdgcn_mfma_f32_16x16x32_bf16(a, b, c, 0, 0, 0);
}
typedef int i32x8 __attribute__((ext_vector_type(8)));
typedef short bf16x16 __attribute__((ext_vector_type(16)));
template <bool TR>
DI f32x4 mma128(const bf16x16& a, const bf16x16& b, f32x4 c) {
    const i32x8 av = __builtin_bit_cast(i32x8, a), bv = __builtin_bit_cast(i32x8, b);
    const int one = 0x7F7F7F7F;
    if (TR) asm volatile("v_mfma_scale_f32_16x16x128_f8f6f4 %0, %1, %2, %0, %3, %3 op_sel_hi:[0,0,0]" : "+v"(c) : "v"(bv), "v"(av), "v"(one));
    else    asm volatile("v_mfma_scale_f32_16x16x128_f8f6f4 %0, %1, %2, %0, %3, %3 op_sel_hi:[0,0,0]" : "+v"(c) : "v"(av), "v"(bv), "v"(one));
    return c;
}
DI bf16x8 frag_lo(const bf16x16& v) { return __builtin_shufflevector(v, v, 0, 1, 2, 3, 4, 5, 6, 7); }
DI bf16x8 frag_hi(const bf16x16& v) { return __builtin_shufflevector(v, v, 8, 9, 10, 11, 12, 13, 14, 15); }
template <bool TR, bool PERM, int F8, class Sched, class Epi>
DI void gemm_stream(LAS unsigned char* lds, const int K, const Sched& S, const Epi& E) {
    typedef typename Sched::U U;
    const int tid = tidx(), wid = __builtin_amdgcn_readfirstlane(tid >> 6), lane = tid & 63, wr = wid >> 2, wc = wid & 3, fr = lane & 15, fq = lane >> 4;
    const int nt = K / BK;
    int R[2], C[2]; unsigned voffB[2];
#pragma unroll
    for (int i = 0; i < 2; ++i) { stage_rc(tid * 16 + i * 8192, R[i], C[i]); const int Rb = PERM ? ((R[i] & ~31) + perm32(R[i] & 31)) : R[i]; voffB[i] = (unsigned)(Rb * K + C[i]) * 2u; }
    const size_t kstep = (size_t)(BK * 2), hstepB = (size_t)HALF * K * 2;
    const unsigned ldsw = (unsigned)wid * 1024u;
    const int aoff = lds_byte(wr * 64 + fr, fq * 8), boff = lds_byte(wc * 32 + fr, fq * 8);
#define GS_SA(b, h) (((b) * 2 + (h)) * HTB)
#define GS_SB(b, h) ((4 + (b) * 2 + (h)) * HTB)
#define GS_STAGE(bufoff, gbase, uix, h) do { _Pragma("unroll") for (int _i = 0; _i < 2; ++_i) \
        __builtin_amdgcn_global_load_lds((const unsigned*)((const char*)(gbase) + S.a_voff(uix, h, R[_i], C[_i])), (LAS unsigned*)(lds + (bufoff) + ldsw + _i * 8192), 16, 0, 0); } while (0)
#define GS_STAGEB(bufoff, gbase, voff) do { _Pragma("unroll") for (int _i = 0; _i < 2; ++_i) \
        __builtin_amdgcn_global_load_lds((const unsigned*)((const char*)(gbase) + (voff)[_i]), (LAS unsigned*)(lds + (bufoff) + ldsw + _i * 8192), 16, 0, 0); } while (0)
#define GS_LD32(base) __builtin_shufflevector(*(const LAS bf16x8*)(base), *(const LAS bf16x8*)((base) + 1024), 0, 1, 2, 3, 4, 5, 6, 7, 8, 9, 10, 11, 12, 13, 14, 15)
#define GS_LDA(dst, b, h) do { _Pragma("unroll") for (int m = 0; m < 4; ++m) dst[m] = GS_LD32(lds + GS_SA(b, h) + aoff + m * 2048); } while (0)
#define GS_LDB(dst, b, h) do { _Pragma("unroll") for (int n = 0; n < 2; ++n) dst[n] = GS_LD32(lds + GS_SB(b, h) + boff + n * 2048); } while (0)
#define GS_MMA(ai, bj, At, Bt) do { __builtin_amdgcn_s_setprio(1); _Pragma("unroll") for (int m = 0; m < 4; ++m) _Pragma("unroll") for (int n = 0; n < 2; ++n) { \
        if (F8 == 2) acc[ai][bj][m][n] = mma128<TR>(At[m], Bt[n], acc[ai][bj][m][n]); \
        else { acc[ai][bj][m][n] = mma16<TR, F8 == 1>(frag_lo(At[m]), frag_lo(Bt[n]), acc[ai][bj][m][n]); acc[ai][bj][m][n] = mma16<TR, F8 == 1>(frag_hi(At[m]), frag_hi(Bt[n]), acc[ai][bj][m][n]); } } \
        __builtin_amdgcn_s_setprio(0); } while (0)
#define GS_WAIT_V(n) asm volatile("s_waitcnt vmcnt(" #n ")" ::: "memory")
#define GS_WAIT_L(n) asm volatile("s_waitcnt lgkmcnt(" #n ")" ::: "memory")
#define GS_BAR __builtin_amdgcn_s_barrier()
#define GS_SCHED __builtin_amdgcn_sched_barrier(0)
    U cur, nxt; int ui = 0;
    if (!S.next(0, cur)) return;
    f32x4 acc[2][2][4][2];
#pragma unroll
    for (int a = 0; a < 2; ++a)
#pragma unroll
        for (int b = 0; b < 2; ++b)
#pragma unroll
            for (int m = 0; m < 4; ++m)
#pragma unroll
                for (int n = 0; n < 2; ++n) acc[a][b][m][n] = (f32x4){0.f, 0.f, 0.f, 0.f};
    bf16x16 At[4], B0[2], B1[2];
    const char* cA = uni(cur.A); const char* cB = uni(cur.B);
    GS_STAGEB(GS_SB(0, 0), cB, voffB); GS_STAGEB(GS_SB(0, 1), cB + hstepB, voffB); GS_STAGE(GS_SA(0, 0), cA, 0, 0); GS_STAGE(GS_SA(0, 1), cA, 0, 1);
    if (wr == 1) GS_BAR;
    GS_WAIT_V(2); GS_BAR;
    GS_STAGEB(GS_SB(1, 0), cB + kstep, voffB); GS_STAGE(GS_SA(1, 0), cA + kstep, 0, 0); GS_STAGEB(GS_SB(1, 1), cB + hstepB + kstep, voffB);
    GS_WAIT_V(6); GS_BAR;
    for (;;) {
        const bool has_next = S.next(ui + 1, nxt);
        const int nui = has_next ? ui + 1 : ui;
        const char* nA = uni(has_next ? nxt.A : cA); const char* nB = uni(has_next ? nxt.B : cB);
#pragma unroll 1
        for (int t = 0; t < nt; t += 2) {
            const bool last = (t == nt - 2);
            const char* a1 = uni(cA + (size_t)(t + 1) * kstep);
            const char* a2 = uni(last ? nA : cA + (size_t)(t + 2) * kstep); const char* b2 = uni(last ? nB : cB + (size_t)(t + 2) * kstep);
            const char* a3 = uni(a2 + kstep); const char* b3 = uni(b2 + kstep);
            const int u2 = last ? nui : ui;
            GS_LDB(B0, 0, 0); GS_LDB(B1, 0, 1); GS_SCHED; GS_LDA(At, 0, 0); GS_STAGE(GS_SA(1, 1), a1, ui, 1);
            GS_WAIT_V(8); GS_WAIT_L(0); GS_BAR; GS_MMA(0, 0, At, B0); GS_MMA(0, 1, At, B1); GS_BAR; GS_SCHED;
            GS_LDA(At, 0, 1); GS_STAGEB(GS_SB(0, 0), b2, voffB); GS_STAGEB(GS_SB(0, 1), b2 + hstepB, voffB); GS_STAGE(GS_SA(0, 0), a2, u2, 0);
            GS_WAIT_V(8); GS_WAIT_L(0); GS_BAR; GS_MMA(1, 0, At, B0); GS_MMA(1, 1, At, B1); GS_BAR; GS_SCHED;
            GS_LDB(B0, 1, 0); GS_LDB(B1, 1, 1); GS_SCHED; GS_LDA(At, 1, 0); GS_STAGE(GS_SA(0, 1), a2, u2, 1);
            GS_WAIT_V(8); GS_WAIT_L(0); GS_BAR; GS_MMA(0, 0, At, B0); GS_MMA(0, 1, At, B1); GS_BAR; GS_SCHED;
            GS_LDA(At, 1, 1); GS_STAGEB(GS_SB(1, 0), b3, voffB); GS_STAGEB(GS_SB(1, 1), b3 + hstepB, voffB); GS_STAGE(GS_SA(1, 0), a3, u2, 0);
            GS_WAIT_V(8); GS_WAIT_L(0); GS_BAR; GS_MMA(1, 0, At, B0); GS_MMA(1, 1, At, B1); GS_BAR; GS_SCHED;
        }
        if (wr == 0) GS_BAR;
        if (F8 == 2) asm volatile("s_nop 15\n\ts_nop 15\n\ts_nop 15\n\ts_nop 15\n\ts_nop 15\n\ts_nop 15" ::: "memory");
        E(acc, cur, wr, wc, fr, fq);
        if (!has_next) break;
#pragma unroll
        for (int a = 0; a < 2; ++a)
#pragma unroll
            for (int b = 0; b < 2; ++b)
#pragma unroll
                for (int m = 0; m < 4; ++m)
#pragma unroll
                    for (int n = 0; n < 2; ++n) acc[a][b][m][n] = (f32x4){0.f, 0.f, 0.f, 0.f};
        cur = nxt; cA = nA; cB = nB; ++ui;
        if (wr == 1) GS_BAR;
    }
    GS_WAIT_V(0);
    GS_BAR;
#undef GS_SA
#undef GS_SB
#undef GS_STAGE
#undef GS_STAGEB
#undef GS_LDA
#undef GS_LD32
#undef GS_LDB
#undef GS_MMA
#undef GS_WAIT_V
#undef GS_WAIT_L
#undef GS_BAR
#undef GS_SCHED
}
struct DenseU { const char* A; const char* B; int pm, pn; };
struct DenseSched {
    typedef DenseU U;
    const bf16_t* A; const bf16_t* Bt; int K, nunits, first, stride, npn, pn_base, pn_mod0, pn_mod1;
    DI int colmap(int q) const { return pn_base + (q / pn_mod0) * pn_mod1 + (q % pn_mod0); }
    DI bool next(int i, U& u) const {
        const int L = first + i * stride; if (L >= nunits) return false;
        u.pm = L / npn; u.pn = colmap(L % npn);
        u.A = (const char*)A + (size_t)u.pm * BM * K * 2; u.B = (const char*)Bt + (size_t)u.pn * BM * K * 2; return true;
    }
    DI unsigned a_voff(int, int h, int R, int C) const { return (unsigned)((HALF * h + R) * K + C) * 2u; }
};
}

DI void transpose_cvt(const float* W, bf16_t* Wt, int K, int N, int unit, char* lds) {
    float* tile = (float*)lds;
    const int nbn = N / 64, kb = unit / nbn, nb = unit % nbn, tid = tidx();
    __syncthreads();
#pragma unroll
    for (int i = 0; i < 8; ++i) { const int idx = tid + i * 512, r = idx >> 6, c = idx & 63; tile[r * 65 + c] = W[(size_t)(kb * 64 + r) * N + nb * 64 + c]; }
    __syncthreads();
#pragma unroll
    for (int i = 0; i < 8; ++i) { const int idx = tid + i * 512, n = idx >> 6, k = idx & 63; Wt[(size_t)(nb * 64 + n) * K + kb * 64 + k] = f2bf(tile[k * 65 + n]); }
}
struct P0Args { const float* x; const float* w_in; const float* w_out; const float* router_w; bf16_t* xb; bf16_t* wt_in; bf16_t* wt_out; bf16_t* wt_r;
                const float* w_gate; const float* w_up; const float* w_down; const float* ws_gate; const float* ws_up; const float* ws_down; unsigned char* wgut; unsigned char* wdt; };
constexpr int CV_GU = 257 * 2 * 16, CV_DN = 257 * 16;
struct CvItem { const float* src; unsigned char* dst; int ld, ldd, rbase, rhi; };
DI CvItem cv_item(const P0Args& a, int it) {
    CvItem c;
    if (it < CV_GU) {
        const int e = it / 32, u = (it >> 4) & 1, kt = it & 15;
        const float* W = e < N_EXP ? (u ? a.w_up : a.w_gate) + (size_t)e * D_MODEL * D_EXP : (u ? a.ws_up : a.ws_gate);
        c.src = W + (size_t)kt * 64 * D_EXP; c.ld = D_EXP; c.dst = a.wgut + (size_t)e * 512 * D_MODEL + kt * 64; c.ldd = D_MODEL; c.rbase = 128 * u; c.rhi = 256;
    } else {
        const int j = it - CV_GU, e = j / 16, kt = (j >> 2) & 3, nb = j & 3;
        const float* W = e < N_EXP ? a.w_down + (size_t)e * D_EXP * D_MODEL : a.ws_down;
        c.src = W + (size_t)kt * 64 * D_MODEL + nb * 256; c.ld = D_MODEL; c.dst = a.wdt + (size_t)e * D_MODEL * D_EXP + kt * 64; c.ldd = D_EXP; c.rbase = 256 * nb; c.rhi = 128;
    }
    return c;
}
DI void cv_load(const CvItem& c, f32x4 (&v)[8]) {
    const int tid = tidx();
#pragma unroll
    for (int i = 0; i < 8; ++i) { const int idx = tid + i * 512, k = idx >> 6, n4 = idx & 63; v[i] = __builtin_nontemporal_load((const f32x4*)(c.src + (size_t)k * c.ld + 4 * n4)); }
}
DI void cv_store(const CvItem& c, const f32x4 (&v)[8], char* lds) {
    float* tile = (float*)lds;
    const int tid = tidx();
    __syncthreads();
#pragma unroll
    for (int i = 0; i < 8; ++i) { const int idx = tid + i * 512, k = idx >> 6, n4 = idx & 63; *(f32x4*)(tile + k * 260 + 4 * (n4 ^ ((k >> 3) & 7))) = v[i]; }
    __syncthreads();
#pragma unroll
    for (int i = 0; i < 4; ++i) {
        const int idx = tid + i * 512, kc = idx & 7, n = idx >> 3; const float* p = tile + (8 * kc) * 260 + (n ^ (4 * kc));
        const unsigned w0 = pack_fp8x4(p[0] * WSCALE, p[260] * WSCALE, p[2 * 260] * WSCALE, p[3 * 260] * WSCALE), w1 = pack_fp8x4(p[4 * 260] * WSCALE, p[5 * 260] * WSCALE, p[6 * 260] * WSCALE, p[7 * 260] * WSCALE);
        __builtin_nontemporal_store((u32x2){w0, w1}, (u32x2*)(c.dst + (size_t)(c.rbase + (n >> 7) * c.rhi + (n & 127)) * c.ldd + 8 * kc));
    }
}
DI void convert_moe_range(const P0Args& a, char* lds, const int lo, const int hi) {
    int it = lo + vblock(); if (it >= hi) return;
    CvItem c = cv_item(a, it); f32x4 v[8]; cv_load(c, v);
#pragma unroll 1
    for (;;) {
        const int nit = it + GRID; const bool more = nit < hi;
        CvItem cn = c; f32x4 w[8];
        if (more) { cn = cv_item(a, nit); cv_load(cn, w); }
        cv_store(c, v, lds);
        if (!more) break;
        it = nit; c = cn;
#pragma unroll
        for (int i = 0; i < 8; ++i) v[i] = w[i];
    }
}
DI void phase_prologue(const P0Args& a, char* lds) {
    const int vb = vblock();
    for (size_t i = (size_t)vb * NTHR + tidx(); i < (size_t)T_TOK * D_MODEL / 8; i += (size_t)GRID * NTHR) {
        const f32x4 v0 = *(const f32x4*)(a.x + i * 8), v1 = *(const f32x4*)(a.x + i * 8 + 4);
        u32x4 o; o.x = cvt_pk_bf16(v0[0], v0[1]); o.y = cvt_pk_bf16(v0[2], v0[3]); o.z = cvt_pk_bf16(v1[0], v1[1]); o.w = cvt_pk_bf16(v1[2], v1[3]);
        *(u32x4*)(a.xb + i * 8) = o;
    }
    const int n_in = (1024 / 64) * (3072 / 64), n_out = 16 * 16, n_r = 16 * 4;
    for (int u = vb; u < n_in + n_out + n_r; u += GRID) {
        if (u < n_in) transpose_cvt(a.w_in, a.wt_in, 1024, 3072, u, lds);
        else if (u < n_in + n_out) transpose_cvt(a.w_out, a.wt_out, 1024, 1024, u - n_in, lds);
        else transpose_cvt(a.router_w, a.wt_r, 1024, 256, u - n_in - n_out, lds);
    }
}


struct P1Args { const bf16_t* xb; const bf16_t* wt_in; bf16_t* Q; bf16_t* Kb; bf16_t* Vt; };
struct EpiQK { bf16_t* Q; bf16_t* Kb;
    DI void operator()(const f32x4 (&acc)[2][2][4][2], const gs::DenseU& u, int wr, int wc, int fr, int fq) const {
        const int seg = u.pn >> 1, type = seg % 3, grp = seg / 3; bf16_t* dst = type == 0 ? Q : Kb; const float sc = type == 0 ? QSCALE : 1.f;
#pragma unroll
        for (int ai = 0; ai < 2; ++ai)
#pragma unroll
            for (int m = 0; m < 4; ++m) {
                const int row = u.pm * 256 + 128 * ai + 64 * wr + 16 * m + fr, b = row / SEQ, s = row % SEQ;
#pragma unroll
                for (int bj = 0; bj < 2; ++bj) {
                    const int hh = grp * 8 + 4 * (u.pn & 1) + 2 * bj + (wc >> 1), d0 = 32 * (wc & 1) + 8 * fq;
                    const f32x4 v0 = acc[ai][bj][m][0] * sc, v1 = acc[ai][bj][m][1] * sc;
                    u32x4 o; o.x = cvt_pk_bf16(v0[0], v0[1]); o.y = cvt_pk_bf16(v0[2], v0[3]); o.z = cvt_pk_bf16(v1[0], v1[1]); o.w = cvt_pk_bf16(v1[2], v1[3]);
                    *(u32x4*)(dst + (size_t)(b * NHH + hh) * SEQ * 64 + (s >> 5) * 2048 + ((d0 >> 3) * 32 + (s & 31)) * 8) = o;
                }
            }
    } };
struct EpiV { bf16_t* Vt;
    DI void operator()(const f32x4 (&acc)[2][2][4][2], const gs::DenseU& u, int wr, int wc, int fr, int fq) const {
        const int grp = (u.pn >> 1) / 3;
#pragma unroll
        for (int ai = 0; ai < 2; ++ai)
#pragma unroll
            for (int m = 0; m < 4; ++m) {
                const int row = u.pm * 256 + 128 * ai + 64 * wr + 16 * m + 4 * fq, b = row / SEQ, s = row % SEQ;
#pragma unroll
                for (int bj = 0; bj < 2; ++bj)
#pragma unroll
                    for (int n = 0; n < 2; ++n) {
                        const int hh = grp * 8 + 4 * (u.pn & 1) + 2 * bj + (wc >> 1), d = 32 * (wc & 1) + 16 * n + fr;
                        const f32x4 v = acc[ai][bj][m][n];
                        u32x2 o; o.x = cvt_pk_bf16(v[0], v[1]); o.y = cvt_pk_bf16(v[2], v[3]);
                        { const int kap = s & 31; *(u32x2*)(Vt + (size_t)(b * NHH + hh) * SEQ * 64 + (s >> 5) * 2048 + ((((d >> 5) * 2 + (kap >> 4)) * 2 + ((kap >> 2) & 1)) * 32 + (d & 31)) * 8 + ((kap >> 3) & 1) * 4) = o; }
                    }
            }
    } };
DI void phase_qkv(const P1Args& a, LAS unsigned char* lds) {
    { gs::DenseSched S{a.xb, a.wt_in, D_MODEL, (T_TOK / 256) * 8, vblock(), GRID, 8, 0, 4, 6}; EpiQK E{a.Q, a.Kb}; gs::gemm_stream<true, true, 0>(lds, D_MODEL, S, E); }
    { gs::DenseSched S{a.xb, a.wt_in, D_MODEL, (T_TOK / 256) * 4, vblock(), GRID, 4, 4, 2, 6}; EpiV E{a.Vt}; gs::gemm_stream<false, false, 0>(lds, D_MODEL, S, E); }
}

struct P3Args { const bf16_t* y; const bf16_t* wt_out; const bf16_t* xb; bf16_t* r; float* stats; };
struct EpiOut { const bf16_t* xb; bf16_t* r; float* stats;
    DI void operator()(const f32x4 (&acc)[2][2][4][2], const gs::DenseU& u, int wr, int wc, int fr, int fq) const {
#pragma unroll
        for (int ai = 0; ai < 2; ++ai) {
            u32x4 xw[4][2];
#pragma unroll
            for (int m = 0; m < 4; ++m)
#pragma unroll
                for (int bj = 0; bj < 2; ++bj) xw[m][bj] = *(const u32x4*)(xb + (size_t)(u.pm * 256 + 128 * ai + 64 * wr + 16 * m + fr) * D_MODEL + u.pn * 256 + 128 * bj + 32 * wc + 8 * fq);
#pragma unroll
            for (int m = 0; m < 4; ++m) {
                const int row = u.pm * 256 + 128 * ai + 64 * wr + 16 * m + fr;
#pragma unroll
                for (int bj = 0; bj < 2; ++bj) {
                    const int col = u.pn * 256 + 128 * bj + 32 * wc + 8 * fq;
                    const u32x4 w = xw[m][bj];
                    const f32x4 x0 = (f32x4){__uint_as_float(w[0] << 16), __uint_as_float(w[0] & 0xffff0000u), __uint_as_float(w[1] << 16), __uint_as_float(w[1] & 0xffff0000u)};
                    const f32x4 x1 = (f32x4){__uint_as_float(w[2] << 16), __uint_as_float(w[2] & 0xffff0000u), __uint_as_float(w[3] << 16), __uint_as_float(w[3] & 0xffff0000u)};
                    const f32x4 v0 = x0 * DN_ALPHA + acc[ai][bj][m][0], v1 = x1 * DN_ALPHA + acc[ai][bj][m][1];
                    float s = ((v0[0] + v0[1]) + (v0[2] + v0[3])) + ((v1[0] + v1[1]) + (v1[2] + v1[3]));
                    float q = ((v0[0] * v0[0] + v0[1] * v0[1]) + (v0[2] * v0[2] + v0[3] * v0[3])) + ((v1[0] * v1[0] + v1[1] * v1[1]) + (v1[2] * v1[2] + v1[3] * v1[3]));
                    u32x4 o; o.x = cvt_pk_bf16(v0[0], v0[1]); o.y = cvt_pk_bf16(v0[2], v0[3]); o.z = cvt_pk_bf16(v1[0], v1[1]); o.w = cvt_pk_bf16(v1[2], v1[3]);
                    *(u32x4*)(r + (size_t)row * D_MODEL + col) = o;
                    s += __shfl_xor(s, 16); s += __shfl_xor(s, 32); q += __shfl_xor(q, 16); q += __shfl_xor(q, 32);
                    if (fq == 0) *(f32x2*)(stats + ((size_t)row * 32 + u.pn * 8 + bj * 4 + wc) * 2) = (f32x2){s, q};
                }
            }
        }
    } };
DI void phase_outproj(const P3Args& a, LAS unsigned char* lds) {
    gs::DenseSched S{a.y, a.wt_out, D_MODEL, (T_TOK / 256) * 4, vblock(), GRID, 4, 0, 4, 0}; EpiOut E{a.xb, a.r, a.stats}; gs::gemm_stream<true, true, 0>(lds, D_MODEL, S, E);
}

DI void unpack16(const u32x4& a, const u32x4& b, float (&v)[16]) {
#pragma unroll
    for (int j = 0; j < 4; ++j) { v[2 * j] = __uint_as_float(a[j] << 16); v[2 * j + 1] = __uint_as_float(a[j] & 0xffff0000u); v[8 + 2 * j] = __uint_as_float(b[j] << 16); v[8 + 2 * j + 1] = __uint_as_float(b[j] & 0xffff0000u); }
}
constexpr int RS_SC = 289;
constexpr int LDS_HIST = 100 * 1024;
struct P4Args { const bf16_t* r; const float* stats; const float* ln_g; const float* ln_b; bf16_t* x1; unsigned char* x1f8; const bf16_t* wt_r; const float* rbias;
                int* eidx; float* gate; int* counts; int* tokl; float* gatel; int* slot; };
DI void phase_router(const P4Args& a, const P0Args& cv, char* lds) {
    const int tid = tidx(), wid = tid >> 6, lane = tid & 63, wr = wid >> 2, wc = wid & 3, fr = lane & 15, fq = lane >> 4;
    float* sc = (float*)lds; int* hist = (int*)(lds + LDS_HIST); int* base = hist + 256;
    for (int u = vblock(); u < T_TOK / 128; u += GRID) {
        const int m0 = u * 128;
        if ((vblock() & 1) == 0) convert_moe_range(cv, lds, CV_GU, CV_GU + CV_DN);
        __syncthreads();
#pragma unroll 1
        for (int i0 = 0; i0 < 16; i0 += 4) {
            f32x2 st[4]; u32x4 r0[4], r1[4];
#pragma unroll
            for (int j4 = 0; j4 < 4; ++j4) {
                const int t = m0 + wid * 16 + i0 + j4;
                st[j4] = (f32x2){0.f, 0.f};
                if (lane < 32) st[j4] = *(const f32x2*)(a.stats + ((size_t)t * 32 + lane) * 2);
                r0[j4] = *(const u32x4*)(a.r + (size_t)t * D_MODEL + lane * 16); r1[j4] = *(const u32x4*)(a.r + (size_t)t * D_MODEL + lane * 16 + 8);
            }
#pragma unroll
            for (int j4 = 0; j4 < 4; ++j4) {
                const int t = m0 + wid * 16 + i0 + j4;
                float s = st[j4].x, q = st[j4].y;
#pragma unroll
                for (int o = 1; o <= 16; o <<= 1) { s += __shfl_xor(s, o); q += __shfl_xor(q, o); }
                s = __shfl(s, 0); q = __shfl(q, 0);
                const float mu = s * (1.f / 1024.f), rstd = rsqrtf(q * (1.f / 1024.f) - mu * mu + LN_EPS);
                float v[16]; unpack16(r0[j4], r1[j4], v);
                u32x4 o0, o1, o8;
#pragma unroll
                for (int j = 0; j < 4; ++j) {
                    const f32x4 g = *(const f32x4*)(a.ln_g + lane * 16 + 4 * j), bb = *(const f32x4*)(a.ln_b + lane * 16 + 4 * j);
                    const float y0 = (v[4 * j] - mu) * rstd * g[0] + bb[0], y1 = (v[4 * j + 1] - mu) * rstd * g[1] + bb[1], y2 = (v[4 * j + 2] - mu) * rstd * g[2] + bb[2], y3 = (v[4 * j + 3] - mu) * rstd * g[3] + bb[3];
                    o8[j] = pack_fp8x4(y0 * XSCALE, y1 * XSCALE, y2 * XSCALE, y3 * XSCALE);
                    const unsigned p0 = cvt_pk_bf16(y0, y1), p1 = cvt_pk_bf16(y2, y3);
                    if (j < 2) { o0[2 * j] = p0; o0[2 * j + 1] = p1; } else { o1[2 * (j - 2)] = p0; o1[2 * (j - 2) + 1] = p1; }
                }
                *(u32x4*)(a.x1 + (size_t)t * D_MODEL + lane * 16) = o0; *(u32x4*)(a.x1 + (size_t)t * D_MODEL + lane * 16 + 8) = o1;
                *(u32x4*)(a.x1f8 + (size_t)t * D_MODEL + lane * 16) = o8;
            }
        }
        if (tid < 256) hist[tid] = 0;
        asm volatile("s_waitcnt vmcnt(0)" ::: "memory");
        __syncthreads();
        ALoader<4> al; al.init_rows(a.x1, D_MODEL, m0);
        BLoaderBt bl; bl.init(a.wt_r, D_MODEL, 0);
        f32x4 acc[4][4];
        gemm_tile<4, true>(lds, al, bl, D_MODEL / 64, acc);
        int my_idx[2], my_rank[2]; float my_gate[2];
#pragma unroll
        for (int p = 0; p < 2; ++p) {
            __syncthreads();
            if (wr == p) {
#pragma unroll
                for (int m = 0; m < 4; ++m)
#pragma unroll
                    for (int n = 0; n < 4; ++n) {
                        const int c0 = 64 * wc + 16 * n + 4 * fq; const f32x4 rb = *(const f32x4*)(a.rbias + c0);
#pragma unroll
                        for (int j = 0; j < 4; ++j) { const int c = c0 + j; sc[(16 * m + fr) * RS_SC + (c >> 5) * 36 + (c & 31)] = 1.f / (1.f + __expf(-acc[m][n][j])) + rb[j]; }
                    }
            }
            __syncthreads();
            const int row = tid >> 3, g = tid & 7, t = m0 + 64 * p + row;
            float sel[32];
#pragma unroll
            for (int i = 0; i < 32; ++i) sel[i] = sc[row * RS_SC + g * 36 + i];
            float m1 = -INFINITY, m2 = -INFINITY;
#pragma unroll
            for (int i = 0; i < 32; ++i) { const float v = sel[i]; m2 = fmaxf(m2, fminf(m1, v)); m1 = fmaxf(m1, v); }
            const float gs = m1 + m2; int rank = 0;
#pragma unroll
            for (int d = 1; d < 8; ++d) { const float o = __shfl_xor(gs, d); const int og = g ^ d; rank += (o > gs || (o == gs && og < g)) ? 1 : 0; }
            const bool en = rank < TOPK_GROUPS;
            float lv = -INFINITY; int li = 1 << 20;
            if (en) {
#pragma unroll
                for (int i = 0; i < 32; ++i) { const float v = sel[i]; if (v > lv) { lv = v; li = g * 32 + i; } }
            }
            float myv = 0.f; int myi = 0;
#pragma unroll
            for (int k = 0; k < TOP_K; ++k) {
                float bv = lv; int bi = li;
#pragma unroll
                for (int d = 1; d < 8; d <<= 1) { const float ov = __shfl_xor(bv, d); const int oi = __shfl_xor(bi, d); if (ov > bv || (ov == bv && oi < bi)) { bv = ov; bi = oi; } }
                if (g == k) { myv = bv; myi = bi; }
                if (k + 1 < TOP_K && (bi >> 5) == g) {
                    lv = -INFINITY; li = 1 << 20;
#pragma unroll
                    for (int i = 0; i < 32; ++i) { if (g * 32 + i == bi) sel[i] = -INFINITY; const float v = sel[i]; if (v > lv) { lv = v; li = g * 32 + i; } }
                }
            }
            const float score = myv - a.rbias[myi];
            float gsum = score;
#pragma unroll
            for (int d = 1; d < 8; d <<= 1) gsum += __shfl_xor(gsum, d);
            const float gt = score / gsum * ROUTED_SCALE;
            a.eidx[t * TOP_K + g] = myi; a.gate[t * TOP_K + g] = gt;
            my_idx[p] = myi; my_gate[p] = gt; my_rank[p] = atomicAdd(&hist[myi], 1);
        }
        __syncthreads();
        if (tid < 256) { const int h = hist[tid]; base[tid] = h > 0 ? atomicAdd(&a.counts[tid * CSTR], h) : 0; }
        __syncthreads();
#pragma unroll
        for (int p = 0; p < 2; ++p) {
            const int row = tid >> 3, g = tid & 7, t = m0 + 64 * p + row, e = my_idx[p], pos = base[e] + my_rank[p];
            a.tokl[(size_t)e * CAP + pos] = t; a.gatel[(size_t)e * CAP + pos] = my_gate[p]; a.slot[t * TOP_K + g] = e * CAP + pos;
        }
        if ((vblock() & 1) == 1) convert_moe_range(cv, lds, CV_GU, CV_GU + CV_DN);
    }
}

constexpr int LDS_ROWTAB = 128 * 1024;
constexpr int LDS_GTAB = 139 * 1024;
constexpr int LDS_TAB = 150 * 1024;
constexpr int LDS_UTAB = 154 * 1024;
constexpr int MOE_BM = 256;
DI void build_moe_tab(const int* counts, char* lds) {
    int* tstart = (int*)(lds + LDS_TAB); int* rstart = tstart + 264; int* cnts = tstart + 528;
    const int tid = tidx(), lane = tid & 63;
    __syncthreads();
    if (tid < 64) {
        int c[4], tl[4], cs = 0, ts = 0;
#pragma unroll
        for (int i = 0; i < 4; ++i) { c[i] = counts[(lane * 4 + i) * CSTR]; tl[i] = (c[i] + MOE_BM - 1) / MOE_BM; cs += c[i]; ts += tl[i]; }
        int ci = cs, ti = ts;
#pragma unroll
        for (int o = 1; o < 64; o <<= 1) { const int n1 = __shfl_up(ci, o), n2 = __shfl_up(ti, o); if (lane >= o) { ci += n1; ti += n2; } }
        int ce = ci - cs, te = ti - ts;
#pragma unroll
        for (int i = 0; i < 4; ++i) { rstart[lane * 4 + i] = ce; tstart[lane * 4 + i] = te; cnts[lane * 4 + i] = c[i]; ce += c[i]; te += tl[i]; }
        if (lane == 63) { rstart[256] = ce; tstart[256] = te; cnts[256] = T_TOK; rstart[257] = ce + T_TOK; tstart[257] = te + T_TOK / MOE_BM; }
    }
    __syncthreads();
}
DI int find_expert(const int* tstart, int g) {
    int lo = 0, hi = 256;
#pragma unroll 1
    while (lo < hi) { const int mid = (lo + hi + 1) >> 1; if (tstart[mid] <= g) lo = mid; else hi = mid - 1; }
    return lo;
}
struct MoeU { const char* A; const char* B; int e, m0, sub, ui; };
typedef const LAS int* ltab_t;
DI int find_expert_l(ltab_t tstart, int g) { int lo = 0, hi = 256;
#pragma unroll 1
    while (lo < hi) { const int mid = (lo + hi + 1) >> 1; if (tstart[mid] <= g) lo = mid; else hi = mid - 1; }
    return lo; }

struct P6Args { const unsigned char* x1; const int* counts; const int* tokl; const float* gatel; const unsigned char* wgut; unsigned char* H; };
struct GuSched {
    typedef MoeU U;
    ltab_t tab; const LAS int* rowtab; const LAS int* utab; const unsigned char* x1; const unsigned char* wgut; int first, stride, nunits;
    DI bool next(int i, U& u) const {
        const int L = first + i * stride; if (L >= nunits) return false;
        const int g = L >> 1, e = utab[i];
        u.sub = L & 1; u.e = e; u.ui = i; u.m0 = (g - tab[e]) * MOE_BM;
        u.A = (const char*)x1; u.B = (const char*)(wgut + ((size_t)e * 512 + 256 * u.sub) * D_MODEL); return true;
    }
    DI unsigned a_voff(int i, int h, int R, int C) const { return (unsigned)(rowtab[i * 256 + 128 * h + R] * (D_MODEL / 2) + C) * 2u; }
};
struct EpiGU { unsigned char* H; const LAS float* gtab; ltab_t tab;
    DI void operator()(const f32x4 (&acc)[2][2][4][2], const MoeU& u, int wr, int wc, int fr, int fq) const {
        const int st = tab[264 + u.e], cnt = tab[528 + u.e];
#pragma unroll
        for (int ai = 0; ai < 2; ++ai)
#pragma unroll
            for (int m = 0; m < 4; ++m) {
                const int row = u.m0 + 128 * ai + 64 * wr + 16 * m + fr;
                if (row < cnt) {
                    const float gt = gtab[u.ui * 256 + 128 * ai + 64 * wr + 16 * m + fr] * (HSCALE / (XSCALE * WSCALE));
                    float h[8];
#pragma unroll
                    for (int n = 0; n < 2; ++n)
#pragma unroll
                        for (int j = 0; j < 4; ++j) { const float gv = acc[ai][0][m][n][j] * (1.f / (XSCALE * WSCALE)); h[4 * n + j] = gv * __builtin_amdgcn_rcpf(1.f + __expf(-gv)) * acc[ai][1][m][n][j] * gt; }
                    *(u32x2*)(H + (size_t)(st + row) * D_EXP + 128 * u.sub + 32 * wc + 8 * fq) = (u32x2){pack_fp8x4(h[0], h[1], h[2], h[3]), pack_fp8x4(h[4], h[5], h[6], h[7])};
                }
            }
    } };
DI void phase_moe_gu(const P6Args& a, char* smem, LAS unsigned char* lds) {
    build_moe_tab(a.counts, smem);
    const int* tstart = (const int*)(smem + LDS_TAB); const int* rstart = tstart + 264; int* rowtab = (int*)(smem + LDS_ROWTAB); float* gtab = (float*)(smem + LDS_GTAB);
    const int nunits = tstart[257] * 2, first = vblock();
    const int n_my = first < nunits ? (nunits - first + GRID - 1) / GRID : 0;
    for (int idx = tidx(); idx < n_my * 256; idx += NTHR) {
        const int i = idx >> 8, row = idx & 255, L = first + i * GRID, g = L >> 1, e = find_expert(tstart, g), m0 = (g - tstart[e]) * MOE_BM, cnt = tstart[528 + e];
        int rr = m0 + row; rr = rr < cnt ? rr : cnt - 1;
        rowtab[idx] = e < N_EXP ? a.tokl[(size_t)e * CAP + rr] : rr;
        gtab[idx] = e < N_EXP ? a.gatel[(size_t)e * CAP + rr] : 1.f;
    }
    if (tidx() < 32 && tidx() < n_my) ((int*)(smem + LDS_UTAB))[tidx()] = find_expert(tstart, (first + tidx() * GRID) >> 1);
    __syncthreads();
    GuSched S{(ltab_t)(lds + LDS_TAB), (const LAS int*)(lds + LDS_ROWTAB), (const LAS int*)(lds + LDS_UTAB), a.x1, a.wgut, first, GRID, nunits}; EpiGU E{a.H, (const LAS float*)(lds + LDS_GTAB), (ltab_t)(lds + LDS_TAB)};
    gs::gemm_stream<true, true, 2>(lds, D_MODEL / 2, S, E);
}
struct P7Args { const unsigned char* H; const int* counts; const unsigned char* wdt; unsigned char* Y; };
struct DownSched {
    typedef MoeU U;
    ltab_t tab; const LAS int* utab; const unsigned char* H; const unsigned char* wdt; int first, stride, nunits;
    DI bool next(int i, U& u) const {
        const int L = first + i * stride; if (L >= nunits) return false;
        const int g = L >> 2, e = utab[i];
        u.sub = L & 3; u.e = e; u.ui = i; u.m0 = (g - tab[e]) * MOE_BM;
        u.A = (const char*)(H + (size_t)(tab[264 + e] + u.m0) * D_EXP); u.B = (const char*)(wdt + ((size_t)e * D_MODEL + 256 * u.sub) * D_EXP); return true;
    }
    DI unsigned a_voff(int, int h, int R, int C) const { return (unsigned)((128 * h + R) * (D_EXP / 2) + C) * 2u; }
};
struct EpiDown { unsigned char* Y; ltab_t tab;
    DI void operator()(const f32x4 (&acc)[2][2][4][2], const MoeU& u, int wr, int wc, int fr, int fq) const {
        const int st = tab[264 + u.e], cnt = tab[528 + u.e];
#pragma unroll
        for (int ai = 0; ai < 2; ++ai)
#pragma unroll
            for (int m = 0; m < 4; ++m) {
                const int row = u.m0 + 128 * ai + 64 * wr + 16 * m + fr;
                if (row < cnt) {
                    u32x4 o;
#pragma unroll
                    for (int bj = 0; bj < 2; ++bj) {
                        const f32x4 v0 = acc[ai][bj][m][0] * (YSCALE / (HSCALE * WSCALE)), v1 = acc[ai][bj][m][1] * (YSCALE / (HSCALE * WSCALE));
                        o[2 * bj] = pack_fp8x4(v0[0], v0[1], v0[2], v0[3]); o[2 * bj + 1] = pack_fp8x4(v1[0], v1[1], v1[2], v1[3]);
                    }
                    *(u32x4*)(Y + (size_t)(st + row) * D_MODEL + 256 * u.sub + 64 * wc + 16 * fq) = o;
                }
            }
    } };
DI void phase_moe_down(const P7Args& a, char* smem, LAS unsigned char* lds) {
    build_moe_tab(a.counts, smem);
    const int* tstart = (const int*)(smem + LDS_TAB); const int* rstart = tstart + 264;
    { const int nun = tstart[257] * 4, i = tidx(); if (i < 32 && vblock() + i * GRID < nun) ((int*)(smem + LDS_UTAB))[i] = find_expert(tstart, (vblock() + i * GRID) >> 2); }
    __syncthreads();
    DownSched S{(ltab_t)(lds + LDS_TAB), (const LAS int*)(lds + LDS_UTAB), a.H, a.wdt, vblock(), GRID, tstart[257] * 4}; EpiDown E{a.Y, (ltab_t)(lds + LDS_TAB)};
    gs::gemm_stream<true, true, 2>(lds, D_EXP / 2, S, E);
}
struct P8Args { const bf16_t* x1; const unsigned char* Y; const int* slot; const int* counts; const float* ln_g; const float* ln_b; float* out; };
DI void phase_combine(const P8Args& a, char* lds) {
    const int tid = tidx(), wid = tid >> 6, lane = tid & 63;
    build_moe_tab(a.counts, lds);
    const int* rstart = (const int*)(lds + LDS_TAB) + 264;
    const int sh0 = rstart[256];
    const int c0 = 256 * (lane >> 4) + 32 * ((lane >> 2) & 3) + 8 * (lane & 3);
    for (int t = vblock() * 8 + wid; t < T_TOK; t += GRID * 8) {
        float v[16], w[16];
        { const u32x4 p0 = *(const u32x4*)(a.x1 + (size_t)t * D_MODEL + c0), p1 = *(const u32x4*)(a.x1 + (size_t)t * D_MODEL + c0 + 128); unpack16(p0, p1, v); }
        int sl = 0; if (lane < TOP_K) sl = a.slot[t * TOP_K + lane];
        u32x4 yr[9];
        yr[8] = *(const u32x4*)(a.Y + (size_t)(sh0 + t) * D_MODEL + lane * 16);
#pragma unroll
        for (int k = 0; k < TOP_K; ++k) { const int s = __shfl(sl, k), e = s / CAP, pos = s % CAP; yr[k] = *(const u32x4*)(a.Y + (size_t)(rstart[e] + pos) * D_MODEL + lane * 16); }
#pragma unroll
        for (int i = 0; i < 16; ++i) w[i] = 0.f;
#pragma unroll
        for (int k = 0; k < 9; ++k)
#pragma unroll
            for (int j = 0; j < 4; ++j) { const f32x2 lo = __builtin_amdgcn_cvt_pk_f32_fp8((int)yr[k][j], false), hi = __builtin_amdgcn_cvt_pk_f32_fp8((int)yr[k][j], true); w[4 * j] += lo.x; w[4 * j + 1] += lo.y; w[4 * j + 2] += hi.x; w[4 * j + 3] += hi.y; }
#pragma unroll
        for (int i = 0; i < 16; ++i) v[i] = v[i] * DN_ALPHA + w[i] * (1.f / YSCALE);
        float s = 0.f;
#pragma unroll
        for (int i = 0; i < 16; ++i) s += v[i];
#pragma unroll
        for (int o = 32; o >= 1; o >>= 1) s += __shfl_xor(s, o);
        const float mu = s * (1.f / 1024.f);
        float q = 0.f;
#pragma unroll
        for (int i = 0; i < 16; ++i) { const float d = v[i] - mu; q += d * d; }
#pragma unroll
        for (int o = 32; o >= 1; o >>= 1) q += __shfl_xor(q, o);
        const float rstd = rsqrtf(q * (1.f / 1024.f) + LN_EPS);
#pragma unroll
        for (int j = 0; j < 4; ++j) {
            const int col = c0 + 128 * (j >> 1) + 4 * (j & 1);
            const f32x4 g = *(const f32x4*)(a.ln_g + col), bb = *(const f32x4*)(a.ln_b + col);
            f32x4 o; o[0] = (v[4 * j] - mu) * rstd * g[0] + bb[0]; o[1] = (v[4 * j + 1] - mu) * rstd * g[1] + bb[1]; o[2] = (v[4 * j + 2] - mu) * rstd * g[2] + bb[2]; o[3] = (v[4 * j + 3] - mu) * rstd * g[3] + bb[3];
            *(f32x4*)(a.out + (size_t)t * D_MODEL + col) = o;
        }
    }
}
#define MFMA32(a, b, c) __builtin_amdgcn_mfma_f32_32x32x16_bf16((a), (b), (c), 0, 0, 0)
constexpr float SB_EXIT_THR = 1e-30f;
struct P2Args { const bf16_t* Q; const bf16_t* Kb; const bf16_t* Vt; const float* rel_bias; const float* gain_a; const float* gain_b; bf16_t* y; };

DI bf16x8 pack8(const f32x16& x, int s) {
    u32x4 p;
    if (s == 0) { p.x = cvt_pk_bf16(x[0], x[1]); p.y = cvt_pk_bf16(x[2], x[3]); p.z = cvt_pk_bf16(x[4], x[5]); p.w = cvt_pk_bf16(x[6], x[7]); }
    else        { p.x = cvt_pk_bf16(x[8], x[9]); p.y = cvt_pk_bf16(x[10], x[11]); p.z = cvt_pk_bf16(x[12], x[13]); p.w = cvt_pk_bf16(x[14], x[15]); }
    return __builtin_bit_cast(bf16x8, p);
}
DI void load_k(bf16x8 (&k)[4], const bf16_t* kp, int k0) {
#pragma unroll
    for (int kk = 0; kk < 4; ++kk) k[kk] = *(const bf16x8*)(kp + (size_t)(k0 >> 5) * 2048 + kk * 512);
}
DI void load_v(bf16x8 (&v)[2][2], const bf16_t* vp, int k0) {
#pragma unroll
    for (int dt = 0; dt < 2; ++dt)
#pragma unroll
        for (int s = 0; s < 2; ++s) v[dt][s] = *(const bf16x8*)(vp + (size_t)(k0 >> 5) * 2048 + (dt * 2 + s) * 512);
}

constexpr int LDS_CVT = 16 * 1024;
DI void phase_attn(const P2Args& a, const P0Args& cv, char* lds) {
    const int tid = tidx(), wid = tid >> 6, lane = tid & 63, r = lane & 31, h = lane >> 5;
    float* tbl = (float*)lds;
    float* ssq = (float*)(lds + 8 * 260 * 4);
    __syncthreads();
    for (int i = tid; i < NHA * 257; i += NTHR) { const int hd = i / 257, j = i % 257; tbl[hd * 260 + j] = a.rel_bias[i] * LOG2E; }
    __syncthreads();
    const int cgrp = vblock() % 3;
#pragma unroll 1
    for (int slot = 0; slot < 5; ++slot) {
        if ((cgrp == 0 && slot == 0) || (cgrp == 1 && slot == 2) || (cgrp == 2 && slot == 4)) convert_moe_range(cv, lds + LDS_CVT, 0, CV_GU);
        if (slot == 4) break;
        const int u = vblock() + GRID * (slot >> 1) + 2 * GRID * (slot & 1);
        const bool isB = u >= BATCH * (SEQ / 64); const int uu = isB ? u - BATCH * (SEQ / 64) : u;
        const int b = uu / (SEQ / 64), c = uu % (SEQ / 64), q0 = c * 64, hh = (isB ? NHA : 0) + wid;
        const size_t hb = (size_t)(b * NHH + hh) * SEQ * 64;
        const bf16_t* kp = a.Kb + hb + lane * 8;
        const bf16_t* vp = a.Vt + hb + lane * 8;
        bf16x8 qf[2][4];
#pragma unroll
        for (int qt = 0; qt < 2; ++qt)
#pragma unroll
            for (int kk = 0; kk < 4; ++kk) qf[qt][kk] = *(const bf16x8*)(a.Q + hb + (size_t)((q0 >> 5) + qt) * 2048 + kk * 512 + lane * 8);
        f32x16 ot[2][2];
#pragma unroll
        for (int dt = 0; dt < 2; ++dt)
#pragma unroll
            for (int qt = 0; qt < 2; ++qt)
#pragma unroll
                for (int i = 0; i < 16; ++i) ot[dt][qt][i] = 0.f;
        float linv[2] = {1.f, 1.f};
        if (!isB) {
            float mrun[2] = {-INFINITY, -INFINITY}, lrun[2] = {0.f, 0.f};
            const int klo = q0 - LEFT_CHUNKS * CHUNK < 0 ? 0 : q0 - LEFT_CHUNKS * CHUNK, khi = q0 + 64;
            const float cfar = tbl[wid * 260 + 256];
            bf16x8 kc[4], kn[4], vf[2][2]; load_k(kc, kp, klo);
            for (int k0 = klo; k0 < khi; k0 += 32) {
                load_v(vf, vp, k0);
                load_k(kn, kp, k0 + 32 < khi ? k0 + 32 : k0);
#pragma unroll
                for (int qt = 0; qt < 2; ++qt) {
                    bf16x8 pf[2];
                    f32x16 st;
#pragma unroll
                    for (int i = 0; i < 16; ++i) st[i] = 0.f;
#pragma unroll
                    for (int kk = 0; kk < 4; ++kk) st = MFMA32(kc[kk], qf[qt][kk], st);
                    const int dmin = q0 + 32 * qt - k0 - 31;
                    if (dmin >= MAX_REL) {
#pragma unroll
                        for (int i = 0; i < 16; ++i) st[i] += cfar;
                    } else {
                        const int bidx = q0 + 32 * qt + r - k0 - 4 * h + MAX_REL;
#pragma unroll
                        for (int i = 0; i < 16; ++i) { int ix = bidx - ((i & 3) + 8 * (i >> 2)); ix = ix < 0 ? 0 : (ix > 2 * MAX_REL ? 2 * MAX_REL : ix); st[i] += tbl[wid * 260 + ix]; }
                    }
                    float mx = st[0];
#pragma unroll
                    for (int i = 1; i < 16; ++i) mx = fmaxf(mx, st[i]);
                    mx = fmaxf(mx, __shfl_xor(mx, 32));
                    const float mn = fmaxf(mrun[qt], mx), alpha = __builtin_amdgcn_exp2f(mrun[qt] - mn);
                    mrun[qt] = mn;
                    float ps = 0.f;
#pragma unroll
                    for (int i = 0; i < 16; ++i) { st[i] = __builtin_amdgcn_exp2f(st[i] - mn); ps += st[i]; }
                    lrun[qt] = lrun[qt] * alpha + ps;
#pragma unroll
                    for (int i = 0; i < 16; ++i) { ot[0][qt][i] *= alpha; ot[1][qt][i] *= alpha; }
                    pf[0] = pack8(st, 0); pf[1] = pack8(st, 1);
#pragma unroll
                    for (int dt = 0; dt < 2; ++dt)
#pragma unroll
                        for (int s = 0; s < 2; ++s) ot[dt][qt] = MFMA32(vf[dt][s], pf[s], ot[dt][qt]);
                }
#pragma unroll
                for (int kk = 0; kk < 4; ++kk) kc[kk] = kn[kk];
            }
#pragma unroll
            for (int qt = 0; qt < 2; ++qt) { const float lt = lrun[qt] + __shfl_xor(lrun[qt], 32); linv[qt] = 1.f / lt; }
        } else {
            float carry[2] = {1.f, 1.f};
            bf16x8 kc[4], kn[4], vf[2][2]; load_k(kc, kp, q0 + 32);
            for (int k0 = q0 + 32; k0 >= 0; k0 -= 32) {
                load_v(vf, vp, k0);
                load_k(kn, kp, k0 >= 32 ? k0 - 32 : k0);
#pragma unroll
                for (int qt = 0; qt < 2; ++qt) {
                    bf16x8 pf[2];
                    f32x16 st;
#pragma unroll
                    for (int i = 0; i < 16; ++i) st[i] = 0.f;
                    const bool none = (k0 > q0 + 32 * qt + 30);
                    if (!none) {
#pragma unroll
                        for (int kk = 0; kk < 4; ++kk) st = MFMA32(kc[kk], qf[qt][kk], st);
                        const bool full = (k0 + 31 < q0 + 32 * qt);
                        const int lim = q0 + 32 * qt + r - k0 - 4 * h;
                        float om[16];
#pragma unroll
                        for (int i = 0; i < 16; ++i) {
                            const float e = __builtin_amdgcn_exp2f(-st[i]); float bta = __builtin_amdgcn_rcpf(1.f + e);
                            if (!full && !(((i & 3) + 8 * (i >> 2)) < lim)) bta = 0.f;
                            st[i] = bta; om[i] = 1.f - bta;
                        }
                        float G[4], Go[4];
#pragma unroll
                        for (int g = 0; g < 4; ++g) { G[g] = (om[4 * g] * om[4 * g + 1]) * (om[4 * g + 2] * om[4 * g + 3]); Go[g] = __shfl_xor(G[g], 32); }
                        float R = carry[qt];
#pragma unroll
                        for (int g = 3; g >= 0; --g) {
                            float run = h == 0 ? R * Go[g] : R;
#pragma unroll
                            for (int uu2 = 3; uu2 >= 0; --uu2) { const float bta = st[4 * g + uu2]; st[4 * g + uu2] = bta * run; run *= om[4 * g + uu2]; }
                            R = R * (G[g] * Go[g]);
                        }
                        carry[qt] = R;
                    }
                    if (!none) {
                        pf[0] = pack8(st, 0); pf[1] = pack8(st, 1);
#pragma unroll
                        for (int dt = 0; dt < 2; ++dt)
#pragma unroll
                            for (int s = 0; s < 2; ++s) ot[dt][qt] = MFMA32(vf[dt][s], pf[s], ot[dt][qt]);
                    }
                }
#pragma unroll
                for (int kk = 0; kk < 4; ++kk) kc[kk] = kn[kk];
                if (__all(carry[0] < SB_EXIT_THR && carry[1] < SB_EXIT_THR)) break;
            }
        }
        float ss[2];
#pragma unroll
        for (int qt = 0; qt < 2; ++qt) {
            float s2 = 0.f;
#pragma unroll
            for (int dt = 0; dt < 2; ++dt)
#pragma unroll
                for (int i = 0; i < 16; ++i) { ot[dt][qt][i] *= linv[qt]; s2 += ot[dt][qt][i] * ot[dt][qt][i]; }
            s2 += __shfl_xor(s2, 32); ss[qt] = s2;
        }
        __syncthreads();
        if (h == 0) { ssq[wid * 64 + r] = ss[0]; ssq[wid * 64 + 32 + r] = ss[1]; }
        __syncthreads();
        const float* gain = isB ? a.gain_b : a.gain_a;
#pragma unroll
        for (int qt = 0; qt < 2; ++qt) {
            float tot = 0.f;
#pragma unroll
            for (int w8 = 0; w8 < 8; ++w8) tot += ssq[w8 * 64 + 32 * qt + r];
            const float rs = rsqrtf(tot * (1.f / 512.f) + RMS_EPS);
            bf16_t* yp = a.y + (size_t)(b * SEQ + q0 + 32 * qt + r) * D_MODEL + (isB ? 512 : 0) + wid * 64;
#pragma unroll
            for (int dt = 0; dt < 2; ++dt)
#pragma unroll
                for (int g = 0; g < 4; ++g) {
                    const int d = 32 * dt + 8 * g + 4 * h; const f32x4 gn = *(const f32x4*)(gain + wid * 64 + d);
                    u32x2 o; o.x = cvt_pk_bf16(ot[dt][qt][4 * g] * rs * gn[0], ot[dt][qt][4 * g + 1] * rs * gn[1]); o.y = cvt_pk_bf16(ot[dt][qt][4 * g + 2] * rs * gn[2], ot[dt][qt][4 * g + 3] * rs * gn[3]);
                    *(u32x2*)(yp + d) = o;
                }
        }
    }
}


#define XB_TMO      128
#define XB_XCNT(j)  (256  + 64 * (j))
#define XB_XSUB(j)  (1280 + 64 * (j))
#define XB_XGEN(j)  (2304 + 64 * (j))
#define XB_TOP      3328
#define XB_TOPGEN   3392
#define XCD_BAR_WORDS 3456
#define XB_SPIN_CAP (1u << 18)
#define LAS __attribute__((address_space(3)))

__device__ __forceinline__ unsigned xb_ld(unsigned* p)              { return __hip_atomic_load(p, __ATOMIC_RELAXED, __HIP_MEMORY_SCOPE_AGENT); }
__device__ __forceinline__ unsigned xb_add(unsigned* p, unsigned v) { return __hip_atomic_fetch_add(p, v, __ATOMIC_RELAXED, __HIP_MEMORY_SCOPE_AGENT); }
__device__ __forceinline__ unsigned xb_xcc_id() { return (unsigned)__builtin_amdgcn_s_getreg((3 << 11) | 20) & 0xFu; }
#define XB_SPIN(cond, bar) do { unsigned _sp = 0; while (cond) { __builtin_amdgcn_s_sleep(1); \
    if ((++_sp & 255u) == 0u) { if (xb_ld(&(bar)[XB_TMO])) break; if (_sp > XB_SPIN_CAP) { atomicAdd(&(bar)[XB_TMO], 1u); break; } } } } while (0)

struct XcdBarrier {
    unsigned* bar; unsigned x;
    volatile LAS unsigned* st;
};

__device__ __forceinline__ XcdBarrier xcd_barrier_post(unsigned* bar, volatile LAS unsigned* st) {
    XcdBarrier b; b.bar = bar; b.x = xb_xcc_id(); b.st = st;
    if (threadIdx.x == 0) (void)xb_add(&bar[XB_XCNT(b.x)], 1u);
    return b;
}
__device__ __forceinline__ void xcd_barrier_complete(unsigned* bar, unsigned x, unsigned& nloc, unsigned& nx) {
    const unsigned G = gridDim.x * gridDim.y * gridDim.z;
    unsigned sum, cnt, mine, sp = 0u;
    for (;;) {
        sum = 0u; cnt = 0u; mine = 0u;
#pragma unroll
        for (unsigned j = 0; j < 16; ++j) { const unsigned c = xb_ld(&bar[XB_XCNT(j)]); sum += c; cnt += (c > 0u) ? 1u : 0u; mine = (j == x) ? c : mine; }
        if (sum == G) break;
        __builtin_amdgcn_s_sleep(1);
        if ((++sp & 255u) == 0u) { if (xb_ld(&bar[XB_TMO])) break; if (sp > XB_SPIN_CAP) { atomicAdd(&bar[XB_TMO], 1u); break; } }
    }
    nloc = mine > 0u ? mine : 1u; nx = cnt > 0u ? cnt : 1u;
}

__device__ __forceinline__ void xcd_barrier(const XcdBarrier& b) {
    asm volatile("s_waitcnt vmcnt(0)" ::: "memory");
    __syncthreads();
    if (threadIdx.x == 0) {
        unsigned* bar = b.bar;
        __builtin_amdgcn_s_waitcnt(0);
        unsigned nloc = b.st[0], nx = b.st[1];
        if (nloc == 0u) { xcd_barrier_complete(bar, b.x, nloc, nx); b.st[0] = nloc; b.st[1] = nx; }
        const unsigned old = xb_add(&bar[XB_XSUB(b.x)], 1u);
        const unsigned gen = old / nloc;
        if (old + 1u == (gen + 1u) * nloc) {
            __builtin_amdgcn_fence(__ATOMIC_RELEASE, "agent");
            asm volatile("s_waitcnt vmcnt(0)" ::: "memory");
            const unsigned og = xb_add(&bar[XB_TOP], 1u);
            const unsigned tg = og / nx;
            if (og + 1u == (tg + 1u) * nx) xb_add(&bar[XB_TOPGEN], 1u);
            else XB_SPIN(xb_ld(&bar[XB_TOPGEN]) == tg, bar);
            __builtin_amdgcn_fence(__ATOMIC_ACQUIRE, "agent");
            xb_add(&bar[XB_XGEN(b.x)], 1u);
            asm volatile("s_waitcnt vmcnt(0)" ::: "memory");
        } else {
            XB_SPIN(xb_ld(&bar[XB_XGEN(b.x)]) == gen, bar);
            __builtin_amdgcn_fence(__ATOMIC_ACQUIRE, "agent");
            asm volatile("s_waitcnt vmcnt(0)" ::: "memory");
        }
    }
    __syncthreads();
}


struct MegaArgs { P0Args p0; P1Args p1; P2Args p2; P3Args p3; P4Args p4; P6Args p6; P7Args p7; P8Args p8; unsigned* bar; };
__global__ __launch_bounds__(NTHR, 2) void k_mega(MegaArgs a) {
    extern __shared__ __attribute__((aligned(16))) char smem[];
    volatile LAS unsigned* xbw = (volatile LAS unsigned*)(smem + LDS_BYTES - 16);
    if (threadIdx.x == 0) { xbw[0] = 0u; xbw[1] = 0u; xbw[2] = 0u; xbw[3] = 0u; }
    __syncthreads();
    XcdBarrier bar = xcd_barrier_post(a.bar, xbw);
    LAS unsigned char* L = (LAS unsigned char*)smem;
    phase_prologue(a.p0, smem);     xcd_barrier(bar);
    phase_qkv(a.p1, L);             xcd_barrier(bar);
    phase_attn(a.p2, a.p0, smem);   xcd_barrier(bar);
    phase_outproj(a.p3, L);         xcd_barrier(bar);
    phase_router(a.p4, a.p0, smem); xcd_barrier(bar);
    phase_moe_gu(a.p6, smem, L);    xcd_barrier(bar);
    phase_moe_down(a.p7, smem, L);  xcd_barrier(bar);
    phase_combine(a.p8, smem);
}

extern "C" void kernel_launch(void* const* d_in, const int* in_sizes, int n_in, void* d_out, int out_size, void* d_ws, size_t ws_size, hipStream_t stream) {
    const float* x = (const float*)d_in[0];      const float* w_in = (const float*)d_in[1];   const float* rel_bias = (const float*)d_in[2];
    const float* gain_a = (const float*)d_in[3]; const float* gain_b = (const float*)d_in[4]; const float* w_out = (const float*)d_in[5];
    const float* ln1_g = (const float*)d_in[6];  const float* ln1_b = (const float*)d_in[7];  const float* router_w = (const float*)d_in[8];
    const float* router_bias = (const float*)d_in[9]; const float* w_gate = (const float*)d_in[10]; const float* w_up = (const float*)d_in[11];
    const float* w_down = (const float*)d_in[12]; const float* ws_gate = (const float*)d_in[13]; const float* ws_up = (const float*)d_in[14];
    const float* ws_down = (const float*)d_in[15]; const float* ln2_g = (const float*)d_in[16]; const float* ln2_b = (const float*)d_in[17];
    char* ws = (char*)d_ws; float* out = (float*)d_out;
    int* ctrl = (int*)(ws + OFF_CTRL); int* counts = ctrl + CW_COUNTS;
    bf16_t* X1 = (bf16_t*)(ws + OFF_X1); int* tokl = (int*)(ws + OFF_TOKL); float* gatel = (float*)(ws + OFF_GATEL);
    int* eidx = (int*)(ws + OFF_EIDX); float* gate = (float*)(ws + OFF_GATE); int* slot = (int*)(ws + OFF_SLOT);
    unsigned char* H = (unsigned char*)(ws + OFF_H); unsigned char* Y = (unsigned char*)(ws + OFF_Y); unsigned char* x1f8 = (unsigned char*)(ws + OFF_X1F8);
    bf16_t* Q = (bf16_t*)(ws + OFF_Q); bf16_t* Kb = (bf16_t*)(ws + OFF_K); bf16_t* Vt = (bf16_t*)(ws + OFF_VT);
    bf16_t* yatt = (bf16_t*)(ws + OFF_YATT); bf16_t* r = (bf16_t*)(ws + OFF_R);
    bf16_t* xb = (bf16_t*)(ws + OFF_XB); float* stats = (float*)(ws + OFF_STATS);
    bf16_t* wt_in = (bf16_t*)(ws + OFF_WTIN); bf16_t* wt_out = (bf16_t*)(ws + OFF_WTOUT); bf16_t* wt_r = (bf16_t*)(ws + OFF_WTR);
    unsigned char* wgut = (unsigned char*)(ws + OFF_WGUT); unsigned char* wdt = (unsigned char*)(ws + OFF_WDT);
    if (ws_size < WS_NEEDED) { fprintf(stderr, "kernel_launch: workspace too small (%zu < %zu)\n", ws_size, (size_t)WS_NEEDED); return; }
    hipMemsetAsync(ctrl, 0, 128 * 1024, stream);
    static bool attr_done = false;
    if (!attr_done) {
        hipFuncSetAttribute((const void*)k_mega, hipFuncAttributeMaxDynamicSharedMemorySize, LDS_BYTES);
        attr_done = true;
    }
    MegaArgs m{};
    m.p0 = P0Args{x, w_in, w_out, router_w, xb, wt_in, wt_out, wt_r, w_gate, w_up, w_down, ws_gate, ws_up, ws_down, wgut, wdt};
    m.p1 = P1Args{xb, wt_in, Q, Kb, Vt};
    m.p2 = P2Args{Q, Kb, Vt, rel_bias, gain_a, gain_b, yatt};
    m.p3 = P3Args{yatt, wt_out, xb, r, stats};
    m.p4 = P4Args{r, stats, ln1_g, ln1_b, X1, x1f8, wt_r, router_bias, eidx, gate, counts, tokl, gatel, slot};
    m.p6 = P6Args{x1f8, counts, tokl, gatel, wgut, H};
    m.p7 = P7Args{H, counts, wdt, Y};
    m.p8 = P8Args{X1, Y, slot, counts, ln2_g, ln2_b, out};
    m.bar = (unsigned*)ctrl;
    k_mega<<<GRID, NTHR, LDS_BYTES, stream>>>(m);
}
```

```cpp
#include <hip/hip_runtime.h>
#include <cstdint>
#include <cstdio>

typedef unsigned short bf16_t;

constexpr int D_MODEL = 1024, BATCH = 16, SEQ = 2048, T_TOK = BATCH * SEQ;
constexpr int HEAD_DIM = 64, NHA = 8, NHB = 8, NHH = 16;
constexpr int CHUNK = 64, LEFT_CHUNKS = 8, MAX_REL = 128;
constexpr int N_EXP = 256, TOP_K = 8, N_GROUPS = 8, TOPK_GROUPS = 4, EPG = 32, D_EXP = 256;
constexpr float ROUTED_SCALE = 2.5f, LN_EPS = 1e-5f, RMS_EPS = 1e-6f;
constexpr float DN_ALPHA = 1.189207115002721f;
constexpr float LOG2E = 1.4426950408889634f, LN2 = 0.6931471805599453f;
constexpr float QSCALE = 0.125f * LOG2E;
constexpr float WSCALE = 64.f, XSCALE = 16.f, HSCALE = 16.f;
constexpr float YSCALE = 64.f;
constexpr int CAP = T_TOK;
constexpr int ROWS_ALL = T_TOK * TOP_K + T_TOK;

__device__ __forceinline__ float bf2f(bf16_t v) { return __uint_as_float(((unsigned)v) << 16); }
__device__ __forceinline__ bf16_t f2bf(float f) { unsigned u = __float_as_uint(f); u += 0x7fffu + ((u >> 16) & 1u); return (bf16_t)(u >> 16); }

constexpr size_t MB = 1024ull * 1024ull;
constexpr size_t OFF_CTRL   = 0;
constexpr size_t OFF_X1     = 1 * MB;
constexpr size_t OFF_TOKL   = OFF_X1 + 64 * MB;
constexpr size_t OFF_GATEL  = OFF_TOKL + 32 * MB;
constexpr size_t OFF_EIDX   = OFF_GATEL + 32 * MB;
constexpr size_t OFF_GATE   = OFF_EIDX + 1 * MB;
constexpr size_t OFF_SLOT   = OFF_GATE + 1 * MB;
constexpr size_t OFF_WDT    = OFF_SLOT + 1 * MB;
constexpr size_t OFF_X1F8   = OFF_WDT + 72 * MB;
constexpr size_t OFF_BIG    = OFF_WDT + 129 * MB;
constexpr size_t OFF_H      = OFF_BIG;
constexpr size_t OFF_Y      = OFF_BIG + 144 * MB;
constexpr size_t OFF_Q      = OFF_BIG;
constexpr size_t OFF_K      = OFF_BIG + 64 * MB;
constexpr size_t OFF_VT     = OFF_BIG + 128 * MB;
constexpr size_t OFF_YATT   = OFF_BIG + 192 * MB;
constexpr size_t OFF_R      = OFF_BIG + 256 * MB;
constexpr size_t OFF_XB     = OFF_BIG + 320 * MB;
constexpr size_t OFF_STATS  = OFF_BIG + 384 * MB;
constexpr size_t OFF_WTIN   = OFF_BIG + 392 * MB;
constexpr size_t OFF_WTOUT  = OFF_BIG + 398 * MB;
constexpr size_t OFF_WTR    = OFF_BIG + 400 * MB;
constexpr size_t OFF_WGUT   = OFF_BIG + 401 * MB;
constexpr size_t WS_NEEDED  = OFF_BIG + 720 * MB;
static_assert(OFF_WGUT + 257 * MB <= WS_NEEDED && WS_NEEDED <= 1024 * MB, "workspace map");
constexpr int CW_COUNTS = 8192;
constexpr int CSTR = 64;

typedef short bf16x8 __attribute__((ext_vector_type(8)));
typedef float f32x4 __attribute__((ext_vector_type(4)));
typedef float f32x2 __attribute__((ext_vector_type(2)));
typedef float f32x16 __attribute__((ext_vector_type(16)));
typedef unsigned u32x4 __attribute__((ext_vector_type(4)));
typedef unsigned u32x2 __attribute__((ext_vector_type(2)));
#define DI __device__ __forceinline__
constexpr int NTHR = 512, GRID = 256;
DI int tidx() { int t = threadIdx.x; asm volatile("" : "+v"(t)); return t; }
constexpr int LDS_BYTES = 160 * 1024;

typedef __bf16 bf16x2_t __attribute__((ext_vector_type(2)));
DI unsigned cvt_pk_bf16(float lo, float hi) { f32x2 v = {lo, hi}; bf16x2_t r = __builtin_convertvector(v, bf16x2_t); return __builtin_bit_cast(unsigned, r); }
DI float clamp8(float v) { return __builtin_amdgcn_fmed3f(v, -440.f, 440.f); }
DI unsigned pack_fp8x4(float a, float b, float c, float d) { int w = 0; w = __builtin_amdgcn_cvt_pk_fp8_f32(clamp8(a), clamp8(b), w, false); w = __builtin_amdgcn_cvt_pk_fp8_f32(clamp8(c), clamp8(d), w, true); return (unsigned)w; }
DI int vblock() { return (int)((blockIdx.x & 7) * (GRID / 8) + (blockIdx.x >> 3)); }

template <int MT> struct Tile { static constexpr int BM = 32 * MT, A_BYTES = BM * 128, B_BYTES = 256 * 128, STAGE = A_BYTES + B_BYTES; };

template <int MT> struct ALoader {
    const bf16_t* p[MT / 2]; u32x4 v[MT / 2]; int off0;
    DI void init_rows(const bf16_t* A, int lda, int row0) {
        const int tid = tidx(), kc = tid & 7, r = tid >> 3;
#pragma unroll
        for (int i = 0; i < MT / 2; ++i) p[i] = A + (size_t)(row0 + r + 64 * i) * lda + kc * 8;
        off0 = r * 128 + ((kc ^ ((r >> 1) & 7)) << 4);
    }
    DI void init_gather(const bf16_t* A, int lda, const int* rows, int cnt, int m0) {
        const int tid = tidx(), kc = tid & 7, r = tid >> 3;
#pragma unroll
        for (int i = 0; i < MT / 2; ++i) { int rr = m0 + r + 64 * i; rr = rr < cnt ? rr : cnt - 1; const int g = rows ? rows[rr] : rr; p[i] = A + (size_t)g * lda + kc * 8; }
        off0 = r * 128 + ((kc ^ ((r >> 1) & 7)) << 4);
    }
    DI void load(int k0) {
#pragma unroll
        for (int i = 0; i < MT / 2; ++i) v[i] = *(const u32x4*)(p[i] + k0);
    }
    DI void store(char* ldsA) const {
#pragma unroll
        for (int i = 0; i < MT / 2; ++i) *(u32x4*)(ldsA + off0 + i * 8192) = v[i];
    }
};
struct BLoaderBt {
    const bf16_t* p[4]; u32x4 v[4]; int off0;
    DI void init(const bf16_t* Bt, int ldk, int n0) {
        const int tid = tidx(), kc = tid & 7, r = tid >> 3;
#pragma unroll
        for (int i = 0; i < 4; ++i) p[i] = Bt + (size_t)(n0 + r + 64 * i) * ldk + kc * 8;
        off0 = r * 128 + ((kc ^ ((r >> 1) & 7)) << 4);
    }
    DI void load(int k0) {
#pragma unroll
        for (int i = 0; i < 4; ++i) v[i] = *(const u32x4*)(p[i] + k0);
    }
    DI void store(char* ldsB) const {
#pragma unroll
        for (int i = 0; i < 4; ++i) *(u32x4*)(ldsB + off0 + i * 8192) = v[i];
    }
};
template <int MT, bool TR, class AL, class BL>
DI void gemm_tile(char* lds, AL& al, BL& bl, int nk, f32x4 (&acc)[MT][4]) {
    typedef Tile<MT> TT;
    const int tid = tidx(), wid = tid >> 6, lane = tid & 63, wr = wid >> 2, wc = wid & 3, fr = lane & 15, fq = lane >> 4;
#pragma unroll
    for (int m = 0; m < MT; ++m)
#pragma unroll
        for (int n = 0; n < 4; ++n) acc[m][n] = (f32x4){0.f, 0.f, 0.f, 0.f};
    int aoff[2], boff[2];
#pragma unroll
    for (int ks = 0; ks < 2; ++ks) { const int ch = (((4 * ks + fq) ^ (fr >> 1)) << 4); aoff[ks] = (16 * MT * wr + fr) * 128 + ch; boff[ks] = TT::A_BYTES + (64 * wc + fr) * 128 + ch; }
    al.load(0); bl.load(0);
    __syncthreads();
    al.store(lds); bl.store(lds + TT::A_BYTES);
    __syncthreads();
    for (int kt = 0; kt < nk; ++kt) {
        char* cur = lds + (kt & 1) * TT::STAGE; char* nxt = lds + ((kt & 1) ^ 1) * TT::STAGE;
        const bool more = kt + 1 < nk;
        if (more) { al.load((kt + 1) * 64); bl.load((kt + 1) * 64); }
#pragma unroll
        for (int ks = 0; ks < 2; ++ks) {
            bf16x8 a[MT], b[4];
#pragma unroll
            for (int m = 0; m < MT; ++m) a[m] = *(const bf16x8*)(cur + aoff[ks] + m * 2048);
#pragma unroll
            for (int n = 0; n < 4; ++n) b[n] = *(const bf16x8*)(cur + boff[ks] + n * 2048);
#pragma unroll
            for (int m = 0; m < MT; ++m)
#pragma unroll
                for (int n = 0; n < 4; ++n)
                    acc[m][n] = TR ? __builtin_amdgcn_mfma_f32_16x16x32_bf16(b[n], a[m], acc[m][n], 0, 0, 0) : __builtin_amdgcn_mfma_f32_16x16x32_bf16(a[m], b[n], acc[m][n], 0, 0, 0);
        }
        if (more) { al.store(nxt); bl.store(nxt + TT::A_BYTES); }
        __syncthreads();
    }
}

#define LAS __attribute__((address_space(3)))
namespace gs {
constexpr int BM = 256, BK = 64, HALF = 128, HTB = HALF * BK * 2, STAGE_BYTES = 8 * HTB;
DI int lds_byte(int r, int c) { const int st = (r >> 4) * 2 + (c >> 5), rr = r & 15, cc = c & 31, ob = rr * 64 + cc * 2; return st * 1024 + (ob ^ (((ob >> 9) & 1) << 5)); }
DI void stage_rc(int b, int& R, int& C) { const int st = b / 1024, sb = b % 1024, swz = sb ^ (((sb >> 9) & 1) << 5); R = (st >> 1) * 16 + swz / 64; C = (st & 1) * 32 + (swz % 64) / 2; }
DI int perm32(int rho) { const int n = rho >> 4, i = rho & 15; return 8 * (i >> 2) + 4 * n + (i & 3); }
typedef long i64x2 __attribute__((ext_vector_type(2)));
DI const char* uni(const char* p) { const unsigned long long v = (unsigned long long)p; const unsigned lo = __builtin_amdgcn_readfirstlane((unsigned)v), hi = __builtin_amdgcn_readfirstlane((unsigned)(v >> 32)); return (const char*)(((unsigned long long)hi << 32) | lo); }
template <bool TR, bool F8>
DI f32x4 mma16(const bf16x8& a, const bf16x8& b, f32x4 c) {
    if (F8) {
        const i64x2 a2 = __builtin_bit_cast(i64x2, a), b2 = __builtin_bit_cast(i64x2, b);
        c = TR ? __builtin_amdgcn_mfma_f32_16x16x32_fp8_fp8(b2[0], a2[0], c, 0, 0, 0) : __builtin_amdgcn_mfma_f32_16x16x32_fp8_fp8(a2[0], b2[0], c, 0, 0, 0);
        return TR ? __builtin_amdgcn_mfma_f32_16x16x32_fp8_fp8(b2[1], a2[1], c, 0, 0, 0) : __builtin_amdgcn_mfma_f32_16x16x32_fp8_fp8(a2[1], b2[1], c, 0, 0, 0);
    }
    return TR ? __builtin_amdgcn_mfma_f32_16x16x32_bf16(b, a, c, 0, 0, 0) : __builtin_amdgcn_mfma_f32_16x16x32_bf16(a, b, c, 0, 0, 0);
}
typedef int i32x8 __attribute__((ext_vector_type(8)));
typedef short bf16x16 __attribute__((ext_vector_type(16)));
template <bool TR>
DI f32x4 mma128(const bf16x16& a, const bf16x16& b, f32x4 c) {
    const i32x8 av = __builtin_bit_cast(i32x8, a), bv = __builtin_bit_cast(i32x8, b);
    const int one = 0x7F7F7F7F;
    if (TR) asm volatile("v_mfma_scale_f32_16x16x128_f8f6f4 %0, %1, %2, %0, %3, %3 op_sel_hi:[0,0,0]" : "+v"(c) : "v"(bv), "v"(av), "v"(one));
    else    asm volatile("v_mfma_scale_f32_16x16x128_f8f6f4 %0, %1, %2, %0, %3, %3 op_sel_hi:[0,0,0]" : "+v"(c) : "v"(av), "v"(bv), "v"(one));
    return c;
}
DI bf16x8 frag_lo(const bf16x16& v) { return __builtin_shufflevector(v, v, 0, 1, 2, 3, 4, 5, 6, 7); }
DI bf16x8 frag_hi(const bf16x16& v) { return __builtin_shufflevector(v, v, 8, 9, 10, 11, 12, 13, 14, 15); }
template <bool TR, bool PERM, int F8, class Sched, class Epi>
DI void gemm_stream(LAS unsigned char* lds, const int K, const Sched& S, const Epi& E) {
    typedef typename Sched::U U;
    const int tid = tidx(), wid = __builtin_amdgcn_readfirstlane(tid >> 6), lane = tid & 63, wr = wid >> 2, wc = wid & 3, fr = lane & 15, fq = lane >> 4;
    const int nt = K / BK;
    int R[2], C[2]; unsigned voffB[2];
#pragma unroll
    for (int i = 0; i < 2; ++i) { stage_rc(tid * 16 + i * 8192, R[i], C[i]); const int Rb = PERM ? ((R[i] & ~31) + perm32(R[i] & 31)) : R[i]; voffB[i] = (unsigned)(Rb * K + C[i]) * 2u; }
    const size_t kstep = (size_t)(BK * 2), hstepB = (size_t)HALF * K * 2;
    const unsigned ldsw = (unsigned)wid * 1024u;
    const int aoff = lds_byte(wr * 64 + fr, fq * 8), boff = lds_byte(wc * 32 + fr, fq * 8);
#define GS_SA(b, h) (((b) * 2 + (h)) * HTB)
#define GS_SB(b, h) ((4 + (b) * 2 + (h)) * HTB)
#define GS_STAGE(bufoff, gbase, uix, h) do { _Pragma("unroll") for (int _i = 0; _i < 2; ++_i) \
        __builtin_amdgcn_global_load_lds((const unsigned*)((const char*)(gbase) + S.a_voff(uix, h, R[_i], C[_i])), (LAS unsigned*)(lds + (bufoff) + ldsw + _i * 8192), 16, 0, 0); } while (0)
#define GS_STAGEB(bufoff, gbase, voff) do { _Pragma("unroll") for (int _i = 0; _i < 2; ++_i) \
        __builtin_amdgcn_global_load_lds((const unsigned*)((const char*)(gbase) + (voff)[_i]), (LAS unsigned*)(lds + (bufoff) + ldsw + _i * 8192), 16, 0, 0); } while (0)
#define GS_LD32(base) __builtin_shufflevector(*(const LAS bf16x8*)(base), *(const LAS bf16x8*)((base) + 1024), 0, 1, 2, 3, 4, 5, 6, 7, 8, 9, 10, 11, 12, 13, 14, 15)
#define GS_LDA(dst, b, h) do { _Pragma("unroll") for (int m = 0; m < 4; ++m) dst[m] = GS_LD32(lds + GS_SA(b, h) + aoff + m * 2048); } while (0)
#define GS_LDB(dst, b, h) do { _Pragma("unroll") for (int n = 0; n < 2; ++n) dst[n] = GS_LD32(lds + GS_SB(b, h) + boff + n * 2048); } while (0)
#define GS_MMA(ai, bj, At, Bt) do { __builtin_amdgcn_s_setprio(1); _Pragma("unroll") for (int m = 0; m < 4; ++m) _Pragma("unroll") for (int n = 0; n < 2; ++n) { \
        if (F8 == 2) acc[ai][bj][m][n] = mma128<TR>(At[m], Bt[n], acc[ai][bj][m][n]); \
        else { acc[ai][bj][m][n] = mma16<TR, F8 == 1>(frag_lo(At[m]), frag_lo(Bt[n]), acc[ai][bj][m][n]); acc[ai][bj][m][n] = mma16<TR, F8 == 1>(frag_hi(At[m]), frag_hi(Bt[n]), acc[ai][bj][m][n]); } } \
        __builtin_amdgcn_s_setprio(0); } while (0)
#define GS_WAIT_V(n) asm volatile("s_waitcnt vmcnt(" #n ")" ::: "memory")
#define GS_WAIT_L(n) asm volatile("s_waitcnt lgkmcnt(" #n ")" ::: "memory")
#define GS_BAR __builtin_amdgcn_s_barrier()
#define GS_SCHED __builtin_amdgcn_sched_barrier(0)
    U cur, nxt; int ui = 0;
    if (!S.next(0, cur)) return;
    f32x4 acc[2][2][4][2];
#pragma unroll
    for (int a = 0; a < 2; ++a)
#pragma unroll
        for (int b = 0; b < 2; ++b)
#pragma unroll
            for (int m = 0; m < 4; ++m)
#pragma unroll
                for (int n = 0; n < 2; ++n) acc[a][b][m][n] = (f32x4){0.f, 0.f, 0.f, 0.f};
    bf16x16 At[4], B0[2], B1[2];
    const char* cA = uni(cur.A); const char* cB = uni(cur.B);
    GS_STAGEB(GS_SB(0, 0), cB, voffB); GS_STAGEB(GS_SB(0, 1), cB + hstepB, voffB); GS_STAGE(GS_SA(0, 0), cA, 0, 0); GS_STAGE(GS_SA(0, 1), cA, 0, 1);
    if (wr == 1) GS_BAR;
    GS_WAIT_V(2); GS_BAR;
    GS_STAGEB(GS_SB(1, 0), cB + kstep, voffB); GS_STAGE(GS_SA(1, 0), cA + kstep, 0, 0); GS_STAGEB(GS_SB(1, 1), cB + hstepB + kstep, voffB);
    GS_WAIT_V(6); GS_BAR;
    for (;;) {
        const bool has_next = S.next(ui + 1, nxt);
        const int nui = has_next ? ui + 1 : ui;
        const char* nA = uni(has_next ? nxt.A : cA); const char* nB = uni(has_next ? nxt.B : cB);
#pragma unroll 1
        for (int t = 0; t < nt; t += 2) {
            const bool last = (t == nt - 2);
            const char* a1 = uni(cA + (size_t)(t + 1) * kstep);
            const char* a2 = uni(last ? nA : cA + (size_t)(t + 2) * kstep); const char* b2 = uni(last ? nB : cB + (size_t)(t + 2) * kstep);
            const char* a3 = uni(a2 + kstep); const char* b3 = uni(b2 + kstep);
            const int u2 = last ? nui : ui;
            GS_LDB(B0, 0, 0); GS_LDB(B1, 0, 1); GS_SCHED; GS_LDA(At, 0, 0); GS_STAGE(GS_SA(1, 1), a1, ui, 1);
            GS_WAIT_V(8); GS_WAIT_L(0); GS_BAR; GS_MMA(0, 0, At, B0); GS_MMA(0, 1, At, B1); GS_BAR; GS_SCHED;
            GS_LDA(At, 0, 1); GS_STAGEB(GS_SB(0, 0), b2, voffB); GS_STAGEB(GS_SB(0, 1), b2 + hstepB, voffB); GS_STAGE(GS_SA(0, 0), a2, u2, 0);
            GS_WAIT_V(8); GS_WAIT_L(0); GS_BAR; GS_MMA(1, 0, At, B0); GS_MMA(1, 1, At, B1); GS_BAR; GS_SCHED;
            GS_LDB(B0, 1, 0); GS_LDB(B1, 1, 1); GS_SCHED; GS_LDA(At, 1, 0); GS_STAGE(GS_SA(0, 1), a2, u2, 1);
            GS_WAIT_V(8); GS_WAIT_L(0); GS_BAR; GS_MMA(0, 0, At, B0); GS_MMA(0, 1, At, B1); GS_BAR; GS_SCHED;
            GS_LDA(At, 1, 1); GS_STAGEB(GS_SB(1, 0), b3, voffB); GS_STAGEB(GS_SB(1, 1), b3 + hstepB, voffB); GS_STAGE(GS_SA(1, 0), a3, u2, 0);
            GS_WAIT_V(8); GS_WAIT_L(0); GS_BAR; GS_MMA(1, 0, At, B0); GS_MMA(1, 1, At, B1); GS_BAR; GS_SCHED;
        }
        if (wr == 0) GS_BAR;
        if (F8 == 2) asm volatile("s_nop 15\n\ts_nop 15\n\ts_nop 15\n\ts_nop 15\n\ts_nop 15\n\ts_nop 15" ::: "memory");
        E(acc, cur, wr, wc, fr, fq);
        if (!has_next) break;
#pragma unroll
        for (int a = 0; a < 2; ++a)
#pragma unroll
            for (int b = 0; b < 2; ++b)
#pragma unroll
                for (int m = 0; m < 4; ++m)
#pragma unroll
                    for (int n = 0; n < 2; ++n) acc[a][b][m][n] = (f32x4){0.f, 0.f, 0.f, 0.f};
        cur = nxt; cA = nA; cB = nB; ++ui;
        if (wr == 1) GS_BAR;
    }
    GS_WAIT_V(0);
    GS_BAR;
#undef GS_SA
#undef GS_SB
#undef GS_STAGE
#undef GS_STAGEB
#undef GS_LDA
#undef GS_LD32
#undef GS_LDB
#undef GS_MMA
#undef GS_WAIT_V
#undef GS_WAIT_L
#undef GS_BAR
#undef GS_SCHED
}
struct DenseU { const char* A; const char* B; int pm, pn; };
struct DenseSched {
    typedef DenseU U;
    const bf16_t* A; const bf16_t* Bt; int K, nunits, first, stride, npn, pn_base, pn_mod0, pn_mod1;
    DI int colmap(int q) const { return pn_base + (q / pn_mod0) * pn_mod1 + (q % pn_mod0); }
    DI bool next(int i, U& u) const {
        const int L = first + i * stride; if (L >= nunits) return false;
        u.pm = L / npn; u.pn = colmap(L % npn);
        u.A = (const char*)A + (size_t)u.pm * BM * K * 2; u.B = (const char*)Bt + (size_t)u.pn * BM * K * 2; return true;
    }
    DI unsigned a_voff(int, int h, int R, int C) const { return (unsigned)((HALF * h + R) * K + C) * 2u; }
};
}

DI void transpose_cvt(const float* W, bf16_t* Wt, int K, int N, int unit, char* lds) {
    float* tile = (float*)lds;
    const int nbn = N / 64, kb = unit / nbn, nb = unit % nbn, tid = tidx();
    __syncthreads();
#pragma unroll
    for (int i = 0; i < 8; ++i) { const int idx = tid + i * 512, r = idx >> 6, c = idx & 63; tile[r * 65 + c] = W[(size_t)(kb * 64 + r) * N + nb * 64 + c]; }
    __syncthreads();
#pragma unroll
    for (int i = 0; i < 8; ++i) { const int idx = tid + i * 512, n = idx >> 6, k = idx & 63; Wt[(size_t)(nb * 64 + n) * K + kb * 64 + k] = f2bf(tile[k * 65 + n]); }
}
struct P0Args { const float* x; const float* w_in; const float* w_out; const float* router_w; bf16_t* xb; bf16_t* wt_in; bf16_t* wt_out; bf16_t* wt_r;
                const float* w_gate; const float* w_up; const float* w_down; const float* ws_gate; const float* ws_up; const float* ws_down; unsigned char* wgut; unsigned char* wdt; };
constexpr int CV_GU = 257 * 2 * 16, CV_DN = 257 * 16;
struct CvItem { const float* src; unsigned char* dst; int ld, ldd, rbase, rhi; };
DI CvItem cv_item(const P0Args& a, int it) {
    CvItem c;
    if (it < CV_GU) {
        const int e = it / 32, u = (it >> 4) & 1, kt = it & 15;
        const float* W = e < N_EXP ? (u ? a.w_up : a.w_gate) + (size_t)e * D_MODEL * D_EXP : (u ? a.ws_up : a.ws_gate);
        c.src = W + (size_t)kt * 64 * D_EXP; c.ld = D_EXP; c.dst = a.wgut + (size_t)e * 512 * D_MODEL + kt * 64; c.ldd = D_MODEL; c.rbase = 128 * u; c.rhi = 256;
    } else {
        const int j = it - CV_GU, e = j / 16, kt = (j >> 2) & 3, nb = j & 3;
        const float* W = e < N_EXP ? a.w_down + (size_t)e * D_EXP * D_MODEL : a.ws_down;
        c.src = W + (size_t)kt * 64 * D_MODEL + nb * 256; c.ld = D_MODEL; c.dst = a.wdt + (size_t)e * D_MODEL * D_EXP + kt * 64; c.ldd = D_EXP; c.rbase = 256 * nb; c.rhi = 128;
    }
    return c;
}
DI void cv_load(const CvItem& c, f32x4 (&v)[8]) {
    const int tid = tidx();
#pragma unroll
    for (int i = 0; i < 8; ++i) { const int idx = tid + i * 512, k = idx >> 6, n4 = idx & 63; v[i] = __builtin_nontemporal_load((const f32x4*)(c.src + (size_t)k * c.ld + 4 * n4)); }
}
DI void cv_store(const CvItem& c, const f32x4 (&v)[8], char* lds) {
    float* tile = (float*)lds;
    const int tid = tidx();
    __syncthreads();
#pragma unroll
    for (int i = 0; i < 8; ++i) { const int idx = tid + i * 512, k = idx >> 6, n4 = idx & 63; *(f32x4*)(tile + k * 260 + 4 * (n4 ^ ((k >> 3) & 7))) = v[i]; }
    __syncthreads();
#pragma unroll
    for (int i = 0; i < 4; ++i) {
        const int idx = tid + i * 512, kc = idx & 7, n = idx >> 3; const float* p = tile + (8 * kc) * 260 + (n ^ (4 * kc));
        const unsigned w0 = pack_fp8x4(p[0] * WSCALE, p[260] * WSCALE, p[2 * 260] * WSCALE, p[3 * 260] * WSCALE), w1 = pack_fp8x4(p[4 * 260] * WSCALE, p[5 * 260] * WSCALE, p[6 * 260] * WSCALE, p[7 * 260] * WSCALE);
        __builtin_nontemporal_store((u32x2){w0, w1}, (u32x2*)(c.dst + (size_t)(c.rbase + (n >> 7) * c.rhi + (n & 127)) * c.ldd + 8 * kc));
    }
}
DI void convert_moe_range(const P0Args& a, char* lds, const int lo, const int hi) {
    int it = lo + vblock(); if (it >= hi) return;
    CvItem c = cv_item(a, it); f32x4 v[8]; cv_load(c, v);
#pragma unroll 1
    for (;;) {
        const int nit = it + GRID; const bool more = nit < hi;
        CvItem cn = c; f32x4 w[8];
        if (more) { cn = cv_item(a, nit); cv_load(cn, w); }
        cv_store(c, v, lds);
        if (!more) break;
        it = nit; c = cn;
#pragma unroll
        for (int i = 0; i < 8; ++i) v[i] = w[i];
    }
}
DI void phase_prologue(const P0Args& a, char* lds) {
    const int vb = vblock();
    for (size_t i = (size_t)vb * NTHR + tidx(); i < (size_t)T_TOK * D_MODEL / 8; i += (size_t)GRID * NTHR) {
        const f32x4 v0 = *(const f32x4*)(a.x + i * 8), v1 = *(const f32x4*)(a.x + i * 8 + 4);
        u32x4 o; o.x = cvt_pk_bf16(v0[0], v0[1]); o.y = cvt_pk_bf16(v0[2], v0[3]); o.z = cvt_pk_bf16(v1[0], v1[1]); o.w = cvt_pk_bf16(v1[2], v1[3]);
        *(u32x4*)(a.xb + i * 8) = o;
    }
    const int n_in = (1024 / 64) * (3072 / 64), n_out = 16 * 16, n_r = 16 * 4;
    for (int u = vb; u < n_in + n_out + n_r; u += GRID) {
        if (u < n_in) transpose_cvt(a.w_in, a.wt_in, 1024, 3072, u, lds);
        else if (u < n_in + n_out) transpose_cvt(a.w_out, a.wt_out, 1024, 1024, u - n_in, lds);
        else transpose_cvt(a.router_w, a.wt_r, 1024, 256, u - n_in - n_out, lds);
    }
}


struct P1Args { const bf16_t* xb; const bf16_t* wt_in; bf16_t* Q; bf16_t* Kb; bf16_t* Vt; };
struct EpiQK { bf16_t* Q; bf16_t* Kb;
    DI void operator()(const f32x4 (&acc)[2][2][4][2], const gs::DenseU& u, int wr, int wc, int fr, int fq) const {
        const int seg = u.pn >> 1, type = seg % 3, grp = seg / 3; bf16_t* dst = type == 0 ? Q : Kb; const float sc = type == 0 ? QSCALE : 1.f;
#pragma unroll
        for (int ai = 0; ai < 2; ++ai)
#pragma unroll
            for (int m = 0; m < 4; ++m) {
                const int row = u.pm * 256 + 128 * ai + 64 * wr + 16 * m + fr, b = row / SEQ, s = row % SEQ;
#pragma unroll
                for (int bj = 0; bj < 2; ++bj) {
                    const int hh = grp * 8 + 4 * (u.pn & 1) + 2 * bj + (wc >> 1), d0 = 32 * (wc & 1) + 8 * fq;
                    const f32x4 v0 = acc[ai][bj][m][0] * sc, v1 = acc[ai][bj][m][1] * sc;
                    u32x4 o; o.x = cvt_pk_bf16(v0[0], v0[1]); o.y = cvt_pk_bf16(v0[2], v0[3]); o.z = cvt_pk_bf16(v1[0], v1[1]); o.w = cvt_pk_bf16(v1[2], v1[3]);
                    *(u32x4*)(dst + (size_t)(b * NHH + hh) * SEQ * 64 + (s >> 5) * 2048 + ((d0 >> 3) * 32 + (s & 31)) * 8) = o;
                }
            }
    } };
struct EpiV { bf16_t* Vt;
    DI void operator()(const f32x4 (&acc)[2][2][4][2], const gs::DenseU& u, int wr, int wc, int fr, int fq) const {
        const int grp = (u.pn >> 1) / 3;
#pragma unroll
        for (int ai = 0; ai < 2; ++ai)
#pragma unroll
            for (int m = 0; m < 4; ++m) {
                const int row = u.pm * 256 + 128 * ai + 64 * wr + 16 * m + 4 * fq, b = row / SEQ, s = row % SEQ;
#pragma unroll
                for (int bj = 0; bj < 2; ++bj)
#pragma unroll
                    for (int n = 0; n < 2; ++n) {
                        const int hh = grp * 8 + 4 * (u.pn & 1) + 2 * bj + (wc >> 1), d = 32 * (wc & 1) + 16 * n + fr;
                        const f32x4 v = acc[ai][bj][m][n];
                        u32x2 o; o.x = cvt_pk_bf16(v[0], v[1]); o.y = cvt_pk_bf16(v[2], v[3]);
                        { const int kap = s & 31; *(u32x2*)(Vt + (size_t)(b * NHH + hh) * SEQ * 64 + (s >> 5) * 2048 + ((((d >> 5) * 2 + (kap >> 4)) * 2 + ((kap >> 2) & 1)) * 32 + (d & 31)) * 8 + ((kap >> 3) & 1) * 4) = o; }
                    }
            }
    } };
DI void phase_qkv(const P1Args& a, LAS unsigned char* lds) {
    { gs::DenseSched S{a.xb, a.wt_in, D_MODEL, (T_TOK / 256) * 8, vblock(), GRID, 8, 0, 4, 6}; EpiQK E{a.Q, a.Kb}; gs::gemm_stream<true, true, 0>(lds, D_MODEL, S, E); }
    { gs::DenseSched S{a.xb, a.wt_in, D_MODEL, (T_TOK / 256) * 4, vblock(), GRID, 4, 4, 2, 6}; EpiV E{a.Vt}; gs::gemm_stream<false, false, 0>(lds, D_MODEL, S, E); }
}

struct P3Args { const bf16_t* y; const bf16_t* wt_out; const bf16_t* xb; bf16_t* r; float* stats; };
struct EpiOut { const bf16_t* xb; bf16_t* r; float* stats;
    DI void operator()(const f32x4 (&acc)[2][2][4][2], const gs::DenseU& u, int wr, int wc, int fr, int fq) const {
#pragma unroll
        for (int ai = 0; ai < 2; ++ai) {
            u32x4 xw[4][2];
#pragma unroll
            for (int m = 0; m < 4; ++m)
#pragma unroll
                for (int bj = 0; bj < 2; ++bj) xw[m][bj] = *(const u32x4*)(xb + (size_t)(u.pm * 256 + 128 * ai + 64 * wr + 16 * m + fr) * D_MODEL + u.pn * 256 + 128 * bj + 32 * wc + 8 * fq);
#pragma unroll
            for (int m = 0; m < 4; ++m) {
                const int row = u.pm * 256 + 128 * ai + 64 * wr + 16 * m + fr;
#pragma unroll
                for (int bj = 0; bj < 2; ++bj) {
                    const int col = u.pn * 256 + 128 * bj + 32 * wc + 8 * fq;
                    const u32x4 w = xw[m][bj];
                    const f32x4 x0 = (f32x4){__uint_as_float(w[0] << 16), __uint_as_float(w[0] & 0xffff0000u), __uint_as_float(w[1] << 16), __uint_as_float(w[1] & 0xffff0000u)};
                    const f32x4 x1 = (f32x4){__uint_as_float(w[2] << 16), __uint_as_float(w[2] & 0xffff0000u), __uint_as_float(w[3] << 16), __uint_as_float(w[3] & 0xffff0000u)};
                    const f32x4 v0 = x0 * DN_ALPHA + acc[ai][bj][m][0], v1 = x1 * DN_ALPHA + acc[ai][bj][m][1];
                    float s = ((v0[0] + v0[1]) + (v0[2] + v0[3])) + ((v1[0] + v1[1]) + (v1[2] + v1[3]));
                    float q = ((v0[0] * v0[0] + v0[1] * v0[1]) + (v0[2] * v0[2] + v0[3] * v0[3])) + ((v1[0] * v1[0] + v1[1] * v1[1]) + (v1[2] * v1[2] + v1[3] * v1[3]));
                    u32x4 o; o.x = cvt_pk_bf16(v0[0], v0[1]); o.y = cvt_pk_bf16(v0[2], v0[3]); o.z = cvt_pk_bf16(v1[0], v1[1]); o.w = cvt_pk_bf16(v1[2], v1[3]);
                    *(u32x4*)(r + (size_t)row * D_MODEL + col) = o;
                    s += __shfl_xor(s, 16); s += __shfl_xor(s, 32); q += __shfl_xor(q, 16); q += __shfl_xor(q, 32);
                    if (fq == 0) *(f32x2*)(stats + ((size_t)row * 32 + u.pn * 8 + bj * 4 + wc) * 2) = (f32x2){s, q};
                }
            }
        }
    } };
DI void phase_outproj(const P3Args& a, LAS unsigned char* lds) {
    gs::DenseSched S{a.y, a.wt_out, D_MODEL, (T_TOK / 256) * 4, vblock(), GRID, 4, 0, 4, 0}; EpiOut E{a.xb, a.r, a.stats}; gs::gemm_stream<true, true, 0>(lds, D_MODEL, S, E);
}

DI void unpack16(const u32x4& a, const u32x4& b, float (&v)[16]) {
#pragma unroll
    for (int j = 0; j < 4; ++j) { v[2 * j] = __uint_as_float(a[j] << 16); v[2 * j + 1] = __uint_as_float(a[j] & 0xffff0000u); v[8 + 2 * j] = __uint_as_float(b[j] << 16); v[8 + 2 * j + 1] = __uint_as_float(b[j] & 0xffff0000u); }
}
constexpr int RS_SC = 289;
constexpr int LDS_HIST = 100 * 1024;
struct P4Args { const bf16_t* r; const float* stats; const float* ln_g; const float* ln_b; bf16_t* x1; unsigned char* x1f8; const bf16_t* wt_r; const float* rbias;
                int* eidx; float* gate; int* counts; int* tokl; float* gatel; int* slot; };
DI void phase_router(const P4Args& a, const P0Args& cv, char* lds) {
    const int tid = tidx(), wid = tid >> 6, lane = tid & 63, wr = wid >> 2, wc = wid & 3, fr = lane & 15, fq = lane >> 4;
    float* sc = (float*)lds; int* hist = (int*)(lds + LDS_HIST); int* base = hist + 256;
    for (int u = vblock(); u < T_TOK / 128; u += GRID) {
        const int m0 = u * 128;
        if ((vblock() & 1) == 0) convert_moe_range(cv, lds, CV_GU, CV_GU + CV_DN);
        __syncthreads();
#pragma unroll 1
        for (int i0 = 0; i0 < 16; i0 += 4) {
            f32x2 st[4]; u32x4 r0[4], r1[4];
#pragma unroll
            for (int j4 = 0; j4 < 4; ++j4) {
                const int t = m0 + wid * 16 + i0 + j4;
                st[j4] = (f32x2){0.f, 0.f};
                if (lane < 32) st[j4] = *(const f32x2*)(a.stats + ((size_t)t * 32 + lane) * 2);
                r0[j4] = *(const u32x4*)(a.r + (size_t)t * D_MODEL + lane * 16); r1[j4] = *(const u32x4*)(a.r + (size_t)t * D_MODEL + lane * 16 + 8);
            }
#pragma unroll
            for (int j4 = 0; j4 < 4; ++j4) {
                const int t = m0 + wid * 16 + i0 + j4;
                float s = st[j4].x, q = st[j4].y;
#pragma unroll
                for (int o = 1; o <= 16; o <<= 1) { s += __shfl_xor(s, o); q += __shfl_xor(q, o); }
                s = __shfl(s, 0); q = __shfl(q, 0);
                const float mu = s * (1.f / 1024.f), rstd = rsqrtf(q * (1.f / 1024.f) - mu * mu + LN_EPS);
                float v[16]; unpack16(r0[j4], r1[j4], v);
                u32x4 o0, o1, o8;
#pragma unroll
                for (int j = 0; j < 4; ++j) {
                    const f32x4 g = *(const f32x4*)(a.ln_g + lane * 16 + 4 * j), bb = *(const f32x4*)(a.ln_b + lane * 16 + 4 * j);
                    const float y0 = (v[4 * j] - mu) * rstd * g[0] + bb[0], y1 = (v[4 * j + 1] - mu) * rstd * g[1] + bb[1], y2 = (v[4 * j + 2] - mu) * rstd * g[2] + bb[2], y3 = (v[4 * j + 3] - mu) * rstd * g[3] + bb[3];
                    o8[j] = pack_fp8x4(y0 * XSCALE, y1 * XSCALE, y2 * XSCALE, y3 * XSCALE);
                    const unsigned p0 = cvt_pk_bf16(y0, y1), p1 = cvt_pk_bf16(y2, y3);
                    if (j < 2) { o0[2 * j] = p0; o0[2 * j + 1] = p1; } else { o1[2 * (j - 2)] = p0; o1[2 * (j - 2) + 1] = p1; }
                }
                *(u32x4*)(a.x1 + (size_t)t * D_MODEL + lane * 16) = o0; *(u32x4*)(a.x1 + (size_t)t * D_MODEL + lane * 16 + 8) = o1;
                *(u32x4*)(a.x1f8 + (size_t)t * D_MODEL + lane * 16) = o8;
            }
        }
        if (tid < 256) hist[tid] = 0;
        asm volatile("s_waitcnt vmcnt(0)" ::: "memory");
        __syncthreads();
        ALoader<4> al; al.init_rows(a.x1, D_MODEL, m0);
        BLoaderBt bl; bl.init(a.wt_r, D_MODEL, 0);
        f32x4 acc[4][4];
        gemm_tile<4, true>(lds, al, bl, D_MODEL / 64, acc);
        int my_idx[2], my_rank[2]; float my_gate[2];
#pragma unroll
        for (int p = 0; p < 2; ++p) {
            __syncthreads();
            if (wr == p) {
#pragma unroll
                for (int m = 0; m < 4; ++m)
#pragma unroll
                    for (int n = 0; n < 4; ++n) {
                        const int c0 = 64 * wc + 16 * n + 4 * fq; const f32x4 rb = *(const f32x4*)(a.rbias + c0);
#pragma unroll
                        for (int j = 0; j < 4; ++j) { const int c = c0 + j; sc[(16 * m + fr) * RS_SC + (c >> 5) * 36 + (c & 31)] = 1.f / (1.f + __expf(-acc[m][n][j])) + rb[j]; }
                    }
            }
            __syncthreads();
            const int row = tid >> 3, g = tid & 7, t = m0 + 64 * p + row;
            float sel[32];
#pragma unroll
            for (int i = 0; i < 32; ++i) sel[i] = sc[row * RS_SC + g * 36 + i];
            float m1 = -INFINITY, m2 = -INFINITY;
#pragma unroll
            for (int i = 0; i < 32; ++i) { const float v = sel[i]; m2 = fmaxf(m2, fminf(m1, v)); m1 = fmaxf(m1, v); }
            const float gs = m1 + m2; int rank = 0;
#pragma unroll
            for (int d = 1; d < 8; ++d) { const float o = __shfl_xor(gs, d); const int og = g ^ d; rank += (o > gs || (o == gs && og < g)) ? 1 : 0; }
            const bool en = rank < TOPK_GROUPS;
            float lv = -INFINITY; int li = 1 << 20;
            if (en) {
#pragma unroll
                for (int i = 0; i < 32; ++i) { const float v = sel[i]; if (v > lv) { lv = v; li = g * 32 + i; } }
            }
            float myv = 0.f; int myi = 0;
#pragma unroll
            for (int k = 0; k < TOP_K; ++k) {
                float bv = lv; int bi = li;
#pragma unroll
                for (int d = 1; d < 8; d <<= 1) { const float ov = __shfl_xor(bv, d); const int oi = __shfl_xor(bi, d); if (ov > bv || (ov == bv && oi < bi)) { bv = ov; bi = oi; } }
                if (g == k) { myv = bv; myi = bi; }
                if (k + 1 < TOP_K && (bi >> 5) == g) {
                    lv = -INFINITY; li = 1 << 20;
#pragma unroll
                    for (int i = 0; i < 32; ++i) { if (g * 32 + i == bi) sel[i] = -INFINITY; const float v = sel[i]; if (v > lv) { lv = v; li = g * 32 + i; } }
                }
            }
            const float score = myv - a.rbias[myi];
            float gsum = score;
#pragma unroll
            for (int d = 1; d < 8; d <<= 1) gsum += __shfl_xor(gsum, d);
            const float gt = score / gsum * ROUTED_SCALE;
            a.eidx[t * TOP_K + g] = myi; a.gate[t * TOP_K + g] = gt;
            my_idx[p] = myi; my_gate[p] = gt; my_rank[p] = atomicAdd(&hist[myi], 1);
        }
        __syncthreads();
        if (tid < 256) { const int h = hist[tid]; base[tid] = h > 0 ? atomicAdd(&a.counts[tid * CSTR], h) : 0; }
        __syncthreads();
#pragma unroll
        for (int p = 0; p < 2; ++p) {
            const int row = tid >> 3, g = tid & 7, t = m0 + 64 * p + row, e = my_idx[p], pos = base[e] + my_rank[p];
            a.tokl[(size_t)e * CAP + pos] = t; a.gatel[(size_t)e * CAP + pos] = my_gate[p]; a.slot[t * TOP_K + g] = e * CAP + pos;
        }
        if ((vblock() & 1) == 1) convert_moe_range(cv, lds, CV_GU, CV_GU + CV_DN);
    }
}

constexpr int LDS_ROWTAB = 128 * 1024;
constexpr int LDS_GTAB = 139 * 1024;
constexpr int LDS_TAB = 150 * 1024;
constexpr int LDS_UTAB = 154 * 1024;
constexpr int MOE_BM = 256;
DI void build_moe_tab(const int* counts, char* lds) {
    int* tstart = (int*)(lds + LDS_TAB); int* rstart = tstart + 264; int* cnts = tstart + 528;
    const int tid = tidx(), lane = tid & 63;
    __syncthreads();
    if (tid < 64) {
        int c[4], tl[4], cs = 0, ts = 0;
#pragma unroll
        for (int i = 0; i < 4; ++i) { c[i] = counts[(lane * 4 + i) * CSTR]; tl[i] = (c[i] + MOE_BM - 1) / MOE_BM; cs += c[i]; ts += tl[i]; }
        int ci = cs, ti = ts;
#pragma unroll
        for (int o = 1; o < 64; o <<= 1) { const int n1 = __shfl_up(ci, o), n2 = __shfl_up(ti, o); if (lane >= o) { ci += n1; ti += n2; } }
        int ce = ci - cs, te = ti - ts;
#pragma unroll
        for (int i = 0; i < 4; ++i) { rstart[lane * 4 + i] = ce; tstart[lane * 4 + i] = te; cnts[lane * 4 + i] = c[i]; ce += c[i]; te += tl[i]; }
        if (lane == 63) { rstart[256] = ce; tstart[256] = te; cnts[256] = T_TOK; rstart[257] = ce + T_TOK; tstart[257] = te + T_TOK / MOE_BM; }
    }
    __syncthreads();
}
DI int find_expert(const int* tstart, int g) {
    int lo = 0, hi = 256;
#pragma unroll 1
    while (lo < hi) { const int mid = (lo + hi + 1) >> 1; if (tstart[mid] <= g) lo = mid; else hi = mid - 1; }
    return lo;
}
struct MoeU { const char* A; const char* B; int e, m0, sub, ui; };
typedef const LAS int* ltab_t;
DI int find_expert_l(ltab_t tstart, int g) { int lo = 0, hi = 256;
#pragma unroll 1
    while (lo < hi) { const int mid = (lo + hi + 1) >> 1; if (tstart[mid] <= g) lo = mid; else hi = mid - 1; }
    return lo; }

struct P6Args { const unsigned char* x1; const int* counts; const int* tokl; const float* gatel; const unsigned char* wgut; unsigned char* H; };
struct GuSched {
    typedef MoeU U;
    ltab_t tab; const LAS int* rowtab; const LAS int* utab; const unsigned char* x1; const unsigned char* wgut; int first, stride, nunits;
    DI bool next(int i, U& u) const {
        const int L = first + i * stride; if (L >= nunits) return false;
        const int g = L >> 1, e = utab[i];
        u.sub = L & 1; u.e = e; u.ui = i; u.m0 = (g - tab[e]) * MOE_BM;
        u.A = (const char*)x1; u.B = (const char*)(wgut + ((size_t)e * 512 + 256 * u.sub) * D_MODEL); return true;
    }
    DI unsigned a_voff(int i, int h, int R, int C) const { return (unsigned)(rowtab[i * 256 + 128 * h + R] * (D_MODEL / 2) + C) * 2u; }
};
struct EpiGU { unsigned char* H; const LAS float* gtab; ltab_t tab;
    DI void operator()(const f32x4 (&acc)[2][2][4][2], const MoeU& u, int wr, int wc, int fr, int fq) const {
        const int st = tab[264 + u.e], cnt = tab[528 + u.e];
#pragma unroll
        for (int ai = 0; ai < 2; ++ai)
#pragma unroll
            for (int m = 0; m < 4; ++m) {
                const int row = u.m0 + 128 * ai + 64 * wr + 16 * m + fr;
                if (row < cnt) {
                    const float gt = gtab[u.ui * 256 + 128 * ai + 64 * wr + 16 * m + fr] * (HSCALE / (XSCALE * WSCALE));
                    float h[8];
#pragma unroll
                    for (int n = 0; n < 2; ++n)
#pragma unroll
                        for (int j = 0; j < 4; ++j) { const float gv = acc[ai][0][m][n][j] * (1.f / (XSCALE * WSCALE)); h[4 * n + j] = gv * __builtin_amdgcn_rcpf(1.f + __expf(-gv)) * acc[ai][1][m][n][j] * gt; }
                    *(u32x2*)(H + (size_t)(st + row) * D_EXP + 128 * u.sub + 32 * wc + 8 * fq) = (u32x2){pack_fp8x4(h[0], h[1], h[2], h[3]), pack_fp8x4(h[4], h[5], h[6], h[7])};
                }
            }
    } };
DI void phase_moe_gu(const P6Args& a, char* smem, LAS unsigned char* lds) {
    build_moe_tab(a.counts, smem);
    const int* tstart = (const int*)(smem + LDS_TAB); const int* rstart = tstart + 264; int* rowtab = (int*)(smem + LDS_ROWTAB); float* gtab = (float*)(smem + LDS_GTAB);
    const int nunits = tstart[257] * 2, first = vblock();
    const int n_my = first < nunits ? (nunits - first + GRID - 1) / GRID : 0;
    for (int idx = tidx(); idx < n_my * 256; idx += NTHR) {
        const int i = idx >> 8, row = idx & 255, L = first + i * GRID, g = L >> 1, e = find_expert(tstart, g), m0 = (g - tstart[e]) * MOE_BM, cnt = tstart[528 + e];
        int rr = m0 + row; rr = rr < cnt ? rr : cnt - 1;
        rowtab[idx] = e < N_EXP ? a.tokl[(size_t)e * CAP + rr] : rr;
        gtab[idx] = e < N_EXP ? a.gatel[(size_t)e * CAP + rr] : 1.f;
    }
    if (tidx() < 32 && tidx() < n_my) ((int*)(smem + LDS_UTAB))[tidx()] = find_expert(tstart, (first + tidx() * GRID) >> 1);
    __syncthreads();
    GuSched S{(ltab_t)(lds + LDS_TAB), (const LAS int*)(lds + LDS_ROWTAB), (const LAS int*)(lds + LDS_UTAB), a.x1, a.wgut, first, GRID, nunits}; EpiGU E{a.H, (const LAS float*)(lds + LDS_GTAB), (ltab_t)(lds + LDS_TAB)};
    gs::gemm_stream<true, true, 2>(lds, D_MODEL / 2, S, E);
}
struct P7Args { const unsigned char* H; const int* counts; const unsigned char* wdt; unsigned char* Y; };
struct DownSched {
    typedef MoeU U;
    ltab_t tab; const LAS int* utab; const unsigned char* H; const unsigned char* wdt; int first, stride, nunits;
    DI bool next(int i, U& u) const {
        const int L = first + i * stride; if (L >= nunits) return false;
        const int g = L >> 2, e = utab[i];
        u.sub = L & 3; u.e = e; u.ui = i; u.m0 = (g - tab[e]) * MOE_BM;
        u.A = (const char*)(H + (size_t)(tab[264 + e] + u.m0) * D_EXP); u.B = (const char*)(wdt + ((size_t)e * D_MODEL + 256 * u.sub) * D_EXP); return true;
    }
    DI unsigned a_voff(int, int h, int R, int C) const { return (unsigned)((128 * h + R) * (D_EXP / 2) + C) * 2u; }
};
struct EpiDown { unsigned char* Y; ltab_t tab;
    DI void operator()(const f32x4 (&acc)[2][2][4][2], const MoeU& u, int wr, int wc, int fr, int fq) const {
        const int st = tab[264 + u.e], cnt = tab[528 + u.e];
#pragma unroll
        for (int ai = 0; ai < 2; ++ai)
#pragma unroll
            for (int m = 0; m < 4; ++m) {
                const int row = u.m0 + 128 * ai + 64 * wr + 16 * m + fr;
                if (row < cnt) {
                    u32x4 o;
#pragma unroll
                    for (int bj = 0; bj < 2; ++bj) {
                        const f32x4 v0 = acc[ai][bj][m][0] * (YSCALE / (HSCALE * WSCALE)), v1 = acc[ai][bj][m][1] * (YSCALE / (HSCALE * WSCALE));
                        o[2 * bj] = pack_fp8x4(v0[0], v0[1], v0[2], v0[3]); o[2 * bj + 1] = pack_fp8x4(v1[0], v1[1], v1[2], v1[3]);
                    }
                    *(u32x4*)(Y + (size_t)(st + row) * D_MODEL + 256 * u.sub + 64 * wc + 16 * fq) = o;
                }
            }
    } };
DI void phase_moe_down(const P7Args& a, char* smem, LAS unsigned char* lds) {
    build_moe_tab(a.counts, smem);
    const int* tstart = (const int*)(smem + LDS_TAB); const int* rstart = tstart + 264;
    { const int nun = tstart[257] * 4, i = tidx(); if (i < 32 && vblock() + i * GRID < nun) ((int*)(smem + LDS_UTAB))[i] = find_expert(tstart, (vblock() + i * GRID) >> 2); }
    __syncthreads();
    DownSched S{(ltab_t)(lds + LDS_TAB), (const LAS int*)(lds + LDS_UTAB), a.H, a.wdt, vblock(), GRID, tstart[257] * 4}; EpiDown E{a.Y, (ltab_t)(lds + LDS_TAB)};
    gs::gemm_stream<true, true, 2>(lds, D_EXP / 2, S, E);
}
struct P8Args { const bf16_t* x1; const unsigned char* Y; const int* slot; const int* counts; const float* ln_g; const float* ln_b; float* out; };
DI void phase_combine(const P8Args& a, char* lds) {
    const int tid = tidx(), wid = tid >> 6, lane = tid & 63;
    build_moe_tab(a.counts, lds);
    const int* rstart = (const int*)(lds + LDS_TAB) + 264;
    const int sh0 = rstart[256];
    const int c0 = 256 * (lane >> 4) + 32 * ((lane >> 2) & 3) + 8 * (lane & 3);
    for (int t = vblock() * 8 + wid; t < T_TOK; t += GRID * 8) {
        float v[16], w[16];
        { const u32x4 p0 = *(const u32x4*)(a.x1 + (size_t)t * D_MODEL + c0), p1 = *(const u32x4*)(a.x1 + (size_t)t * D_MODEL + c0 + 128); unpack16(p0, p1, v); }
        int sl = 0; if (lane < TOP_K) sl = a.slot[t * TOP_K + lane];
        u32x4 yr[9];
        yr[8] = *(const u32x4*)(a.Y + (size_t)(sh0 + t) * D_MODEL + lane * 16);
#pragma unroll
        for (int k = 0; k < TOP_K; ++k) { const int s = __shfl(sl, k), e = s / CAP, pos = s % CAP; yr[k] = *(const u32x4*)(a.Y + (size_t)(rstart[e] + pos) * D_MODEL + lane * 16); }
#pragma unroll
        for (int i = 0; i < 16; ++i) w[i] = 0.f;
#pragma unroll
        for (int k = 0; k < 9; ++k)
#pragma unroll
            for (int j = 0; j < 4; ++j) { const f32x2 lo = __builtin_amdgcn_cvt_pk_f32_fp8((int)yr[k][j], false), hi = __builtin_amdgcn_cvt_pk_f32_fp8((int)yr[k][j], true); w[4 * j] += lo.x; w[4 * j + 1] += lo.y; w[4 * j + 2] += hi.x; w[4 * j + 3] += hi.y; }
#pragma unroll
        for (int i = 0; i < 16; ++i) v[i] = v[i] * DN_ALPHA + w[i] * (1.f / YSCALE);
        float s = 0.f;
#pragma unroll
        for (int i = 0; i < 16; ++i) s += v[i];
#pragma unroll
        for (int o = 32; o >= 1; o >>= 1) s += __shfl_xor(s, o);
        const float mu = s * (1.f / 1024.f);
        float q = 0.f;
#pragma unroll
        for (int i = 0; i < 16; ++i) { const float d = v[i] - mu; q += d * d; }
#pragma unroll
        for (int o = 32; o >= 1; o >>= 1) q += __shfl_xor(q, o);
        const float rstd = rsqrtf(q * (1.f / 1024.f) + LN_EPS);
#pragma unroll
        for (int j = 0; j < 4; ++j) {
            const int col = c0 + 128 * (j >> 1) + 4 * (j & 1);
            const f32x4 g = *(const f32x4*)(a.ln_g + col), bb = *(const f32x4*)(a.ln_b + col);
            f32x4 o; o[0] = (v[4 * j] - mu) * rstd * g[0] + bb[0]; o[1] = (v[4 * j + 1] - mu) * rstd * g[1] + bb[1]; o[2] = (v[4 * j + 2] - mu) * rstd * g[2] + bb[2]; o[3] = (v[4 * j + 3] - mu) * rstd * g[3] + bb[3];
            *(f32x4*)(a.out + (size_t)t * D_MODEL + col) = o;
        }
    }
}
#define MFMA32(a, b, c) __builtin_amdgcn_mfma_f32_32x32x16_bf16((a), (b), (c), 0, 0, 0)
constexpr float SB_EXIT_THR = 1e-30f;
struct P2Args { const bf16_t* Q; const bf16_t* Kb; const bf16_t* Vt; const float* rel_bias; const float* gain_a; const float* gain_b; bf16_t* y; };

DI bf16x8 pack8(const f32x16& x, int s) {
    u32x4 p;
    if (s == 0) { p.x = cvt_pk_bf16(x[0], x[1]); p.y = cvt_pk_bf16(x[2], x[3]); p.z = cvt_pk_bf16(x[4], x[5]); p.w = cvt_pk_bf16(x[6], x[7]); }
    else        { p.x = cvt_pk_bf16(x[8], x[9]); p.y = cvt_pk_bf16(x[10], x[11]); p.z = cvt_pk_bf16(x[12], x[13]); p.w = cvt_pk_bf16(x[14], x[15]); }
    return __builtin_bit_cast(bf16x8, p);
}
DI void load_k(bf16x8 (&k)[4], const bf16_t* kp, int k0) {
#pragma unroll
    for (int kk = 0; kk < 4; ++kk) k[kk] = *(const bf16x8*)(kp + (size_t)(k0 >> 5) * 2048 + kk * 512);
}
DI void load_v(bf16x8 (&v)[2][2], const bf16_t* vp, int k0) {
#pragma unroll
    for (int dt = 0; dt < 2; ++dt)
#pragma unroll
        for (int s = 0; s < 2; ++s) v[dt][s] = *(const bf16x8*)(vp + (size_t)(k0 >> 5) * 2048 + (dt * 2 + s) * 512);
}

constexpr int LDS_CVT = 16 * 1024;
DI void phase_attn(const P2Args& a, const P0Args& cv, char* lds) {
    const int tid = tidx(), wid = tid >> 6, lane = tid & 63, r = lane & 31, h = lane >> 5;
    float* tbl = (float*)lds;
    float* ssq = (float*)(lds + 8 * 260 * 4);
    __syncthreads();
    for (int i = tid; i < NHA * 257; i += NTHR) { const int hd = i / 257, j = i % 257; tbl[hd * 260 + j] = a.rel_bias[i] * LOG2E; }
    __syncthreads();
    const int cgrp = vblock() % 3;
#pragma unroll 1
    for (int slot = 0; slot < 5; ++slot) {
        if ((cgrp == 0 && slot == 0) || (cgrp == 1 && slot == 2) || (cgrp == 2 && slot == 4)) convert_moe_range(cv, lds + LDS_CVT, 0, CV_GU);
        if (slot == 4) break;
        const int u = vblock() + GRID * (slot >> 1) + 2 * GRID * (slot & 1);
        const bool isB = u >= BATCH * (SEQ / 64); const int uu = isB ? u - BATCH * (SEQ / 64) : u;
        const int b = uu / (SEQ / 64), c = uu % (SEQ / 64), q0 = c * 64, hh = (isB ? NHA : 0) + wid;
        const size_t hb = (size_t)(b * NHH + hh) * SEQ * 64;
        const bf16_t* kp = a.Kb + hb + lane * 8;
        const bf16_t* vp = a.Vt + hb + lane * 8;
        bf16x8 qf[2][4];
#pragma unroll
        for (int qt = 0; qt < 2; ++qt)
#pragma unroll
            for (int kk = 0; kk < 4; ++kk) qf[qt][kk] = *(const bf16x8*)(a.Q + hb + (size_t)((q0 >> 5) + qt) * 2048 + kk * 512 + lane * 8);
        f32x16 ot[2][2];
#pragma unroll
        for (int dt = 0; dt < 2; ++dt)
#pragma unroll
            for (int qt = 0; qt < 2; ++qt)
#pragma unroll
                for (int i = 0; i < 16; ++i) ot[dt][qt][i] = 0.f;
        float linv[2] = {1.f, 1.f};
        if (!isB) {
            float mrun[2] = {-INFINITY, -INFINITY}, lrun[2] = {0.f, 0.f};
            const int klo = q0 - LEFT_CHUNKS * CHUNK < 0 ? 0 : q0 - LEFT_CHUNKS * CHUNK, khi = q0 + 64;
            const float cfar = tbl[wid * 260 + 256];
            bf16x8 kc[4], kn[4], vf[2][2]; load_k(kc, kp, klo);
            for (int k0 = klo; k0 < khi; k0 += 32) {
                load_v(vf, vp, k0);
                load_k(kn, kp, k0 + 32 < khi ? k0 + 32 : k0);
#pragma unroll
                for (int qt = 0; qt < 2; ++qt) {
                    bf16x8 pf[2];
                    f32x16 st;
#pragma unroll
                    for (int i = 0; i < 16; ++i) st[i] = 0.f;
#pragma unroll
                    for (int kk = 0; kk < 4; ++kk) st = MFMA32(kc[kk], qf[qt][kk], st);
                    const int dmin = q0 + 32 * qt - k0 - 31;
                    float boff = 0.f;
                    if (dmin >= MAX_REL) boff = cfar;
                    else {
                        const int bidx = q0 + 32 * qt + r - k0 - 4 * h + MAX_REL;
#pragma unroll
                        for (int i = 0; i < 16; ++i) { int ix = bidx - ((i & 3) + 8 * (i >> 2)); ix = ix < 0 ? 0 : (ix > 2 * MAX_REL ? 2 * MAX_REL : ix); st[i] += tbl[wid * 260 + ix]; }
                    }
                    float mx = st[0];
#pragma unroll
                    for (int i = 1; i < 16; ++i) mx = fmaxf(mx, st[i]);
                    mx = fmaxf(mx, __shfl_xor(mx, 32)) + boff;
                    const float mo = mrun[qt], mn = fmaxf(mo, mx);
                    mrun[qt] = mn;
                    const float eo = boff - mn;
                    float ps = 0.f;
#pragma unroll
                    for (int i = 0; i < 16; ++i) { st[i] = __builtin_amdgcn_exp2f(st[i] + eo); ps += st[i]; }
                    if (__all(mn == mo)) lrun[qt] += ps;
                    else {
                        const float alpha = __builtin_amdgcn_exp2f(mo - mn);
                        lrun[qt] = lrun[qt] * alpha + ps;
#pragma unroll
                        for (int i = 0; i < 16; ++i) { ot[0][qt][i] *= alpha; ot[1][qt][i] *= alpha; }
                    }
                    pf[0] = pack8(st, 0); pf[1] = pack8(st, 1);
#pragma unroll
                    for (int dt = 0; dt < 2; ++dt)
#pragma unroll
                        for (int s = 0; s < 2; ++s) ot[dt][qt] = MFMA32(vf[dt][s], pf[s], ot[dt][qt]);
                }
#pragma unroll
                for (int kk = 0; kk < 4; ++kk) kc[kk] = kn[kk];
            }
#pragma unroll
            for (int qt = 0; qt < 2; ++qt) { const float lt = lrun[qt] + __shfl_xor(lrun[qt], 32); linv[qt] = 1.f / lt; }
        } else {
            float carry[2] = {1.f, 1.f};
            bf16x8 kc[4], kn[4], vf[2][2]; load_k(kc, kp, q0 + 32);
            for (int k0 = q0 + 32; k0 >= 0; k0 -= 32) {
                load_v(vf, vp, k0);
                load_k(kn, kp, k0 >= 32 ? k0 - 32 : k0);
#pragma unroll
                for (int qt = 0; qt < 2; ++qt) {
                    bf16x8 pf[2];
                    f32x16 st;
#pragma unroll
                    for (int i = 0; i < 16; ++i) st[i] = 0.f;
                    const bool none = (k0 > q0 + 32 * qt + 30);
                    if (!none) {
#pragma unroll
                        for (int kk = 0; kk < 4; ++kk) st = MFMA32(kc[kk], qf[qt][kk], st);
                        const bool full = (k0 + 31 < q0 + 32 * qt);
                        const int lim = q0 + 32 * qt + r - k0 - 4 * h;
                        float om[16];
#pragma unroll
                        for (int i = 0; i < 16; ++i) {
                            const float e = __builtin_amdgcn_exp2f(-st[i]); float bta = __builtin_amdgcn_rcpf(1.f + e);
                            if (!full && !(((i & 3) + 8 * (i >> 2)) < lim)) bta = 0.f;
                            st[i] = bta; om[i] = 1.f - bta;
                        }
                        float G[4], Go[4];
#pragma unroll
                        for (int g = 0; g < 4; ++g) { G[g] = (om[4 * g] * om[4 * g + 1]) * (om[4 * g + 2] * om[4 * g + 3]); Go[g] = __shfl_xor(G[g], 32); }
                        float R = carry[qt];
#pragma unroll
                        for (int g = 3; g >= 0; --g) {
                            float run = h == 0 ? R * Go[g] : R;
#pragma unroll
                            for (int uu2 = 3; uu2 >= 0; --uu2) { const float bta = st[4 * g + uu2]; st[4 * g + uu2] = bta * run; run *= om[4 * g + uu2]; }
                            R = R * (G[g] * Go[g]);
                        }
                        carry[qt] = R;
                    }
                    if (!none) {
                        pf[0] = pack8(st, 0); pf[1] = pack8(st, 1);
#pragma unroll
                        for (int dt = 0; dt < 2; ++dt)
#pragma unroll
                            for (int s = 0; s < 2; ++s) ot[dt][qt] = MFMA32(vf[dt][s], pf[s], ot[dt][qt]);
                    }
                }
#pragma unroll
                for (int kk = 0; kk < 4; ++kk) kc[kk] = kn[kk];
                if (__all(carry[0] < SB_EXIT_THR && carry[1] < SB_EXIT_THR)) break;
            }
        }
        float ss[2];
#pragma unroll
        for (int qt = 0; qt < 2; ++qt) {
            float s2 = 0.f;
#pragma unroll
            for (int dt = 0; dt < 2; ++dt)
#pragma unroll
                for (int i = 0; i < 16; ++i) { ot[dt][qt][i] *= linv[qt]; s2 += ot[dt][qt][i] * ot[dt][qt][i]; }
            s2 += __shfl_xor(s2, 32); ss[qt] = s2;
        }
        __syncthreads();
        if (h == 0) { ssq[wid * 64 + r] = ss[0]; ssq[wid * 64 + 32 + r] = ss[1]; }
        __syncthreads();
        const float* gain = isB ? a.gain_b : a.gain_a;
#pragma unroll
        for (int qt = 0; qt < 2; ++qt) {
            float tot = 0.f;
#pragma unroll
            for (int w8 = 0; w8 < 8; ++w8) tot += ssq[w8 * 64 + 32 * qt + r];
            const float rs = rsqrtf(tot * (1.f / 512.f) + RMS_EPS);
            char* yst = lds + LDS_CVT + wid * (64 * 136);
#pragma unroll
            for (int dt = 0; dt < 2; ++dt)
#pragma unroll
                for (int g = 0; g < 4; ++g) {
                    const int d = 32 * dt + 8 * g + 4 * h; const f32x4 gn = *(const f32x4*)(gain + wid * 64 + d);
                    u32x2 o; o.x = cvt_pk_bf16(ot[dt][qt][4 * g] * rs * gn[0], ot[dt][qt][4 * g + 1] * rs * gn[1]); o.y = cvt_pk_bf16(ot[dt][qt][4 * g + 2] * rs * gn[2], ot[dt][qt][4 * g + 3] * rs * gn[3]);
                    *(u32x2*)(yst + (32 * qt + r) * 136 + d * 2) = o;
                }
        }
        {
            char* yst = lds + LDS_CVT + wid * (64 * 136);
            bf16_t* yb = a.y + (size_t)(b * SEQ + q0) * D_MODEL + (isB ? 512 : 0) + wid * 64;
#pragma unroll
            for (int j = 0; j < 8; ++j) {
                const int tok = (lane >> 3) + 8 * j, ch = lane & 7;
                const u32x2 lo = *(const u32x2*)(yst + tok * 136 + ch * 16), hi = *(const u32x2*)(yst + tok * 136 + ch * 16 + 8);
                *(u32x4*)(yb + (size_t)tok * D_MODEL + ch * 8) = (u32x4){lo.x, lo.y, hi.x, hi.y};
            }
        }
    }
}


#define XB_TMO      128
#define XB_XCNT(j)  (256  + 64 * (j))
#define XB_XSUB(j)  (1280 + 64 * (j))
#define XB_XGEN(j)  (2304 + 64 * (j))
#define XB_TOP      3328
#define XB_TOPGEN   3392
#define XCD_BAR_WORDS 3456
#define XB_SPIN_CAP (1u << 18)
#define LAS __attribute__((address_space(3)))

__device__ __forceinline__ unsigned xb_ld(unsigned* p)              { return __hip_atomic_load(p, __ATOMIC_RELAXED, __HIP_MEMORY_SCOPE_AGENT); }
__device__ __forceinline__ unsigned xb_add(unsigned* p, unsigned v) { return __hip_atomic_fetch_add(p, v, __ATOMIC_RELAXED, __HIP_MEMORY_SCOPE_AGENT); }
__device__ __forceinline__ unsigned xb_xcc_id() { return (unsigned)__builtin_amdgcn_s_getreg((3 << 11) | 20) & 0xFu; }
#define XB_SPIN(cond, bar) do { unsigned _sp = 0; while (cond) { __builtin_amdgcn_s_sleep(1); \
    if ((++_sp & 255u) == 0u) { if (xb_ld(&(bar)[XB_TMO])) break; if (_sp > XB_SPIN_CAP) { atomicAdd(&(bar)[XB_TMO], 1u); break; } } } } while (0)

struct XcdBarrier {
    unsigned* bar; unsigned x;
    volatile LAS unsigned* st;
};

__device__ __forceinline__ XcdBarrier xcd_barrier_post(unsigned* bar, volatile LAS unsigned* st) {
    XcdBarrier b; b.bar = bar; b.x = xb_xcc_id(); b.st = st;
    if (threadIdx.x == 0) (void)xb_add(&bar[XB_XCNT(b.x)], 1u);
    return b;
}
__device__ __forceinline__ void xcd_barrier_complete(unsigned* bar, unsigned x, unsigned& nloc, unsigned& nx) {
    const unsigned G = gridDim.x * gridDim.y * gridDim.z;
    unsigned sum, cnt, mine, sp = 0u;
    for (;;) {
        sum = 0u; cnt = 0u; mine = 0u;
#pragma unroll
        for (unsigned j = 0; j < 16; ++j) { const unsigned c = xb_ld(&bar[XB_XCNT(j)]); sum += c; cnt += (c > 0u) ? 1u : 0u; mine = (j == x) ? c : mine; }
        if (sum == G) break;
        __builtin_amdgcn_s_sleep(1);
        if ((++sp & 255u) == 0u) { if (xb_ld(&bar[XB_TMO])) break; if (sp > XB_SPIN_CAP) { atomicAdd(&bar[XB_TMO], 1u); break; } }
    }
    nloc = mine > 0u ? mine : 1u; nx = cnt > 0u ? cnt : 1u;
}

__device__ __forceinline__ void xcd_barrier(const XcdBarrier& b) {
    asm volatile("s_waitcnt vmcnt(0)" ::: "memory");
    __syncthreads();
    if (threadIdx.x == 0) {
        unsigned* bar = b.bar;
        __builtin_amdgcn_s_waitcnt(0);
        unsigned nloc = b.st[0], nx = b.st[1];
        if (nloc == 0u) { xcd_barrier_complete(bar, b.x, nloc, nx); b.st[0] = nloc; b.st[1] = nx; }
        const unsigned old = xb_add(&bar[XB_XSUB(b.x)], 1u);
        const unsigned gen = old / nloc;
        if (old + 1u == (gen + 1u) * nloc) {
            __builtin_amdgcn_fence(__ATOMIC_RELEASE, "agent");
            asm volatile("s_waitcnt vmcnt(0)" ::: "memory");
            const unsigned og = xb_add(&bar[XB_TOP], 1u);
            const unsigned tg = og / nx;
            if (og + 1u == (tg + 1u) * nx) xb_add(&bar[XB_TOPGEN], 1u);
            else XB_SPIN(xb_ld(&bar[XB_TOPGEN]) == tg, bar);
            __builtin_amdgcn_fence(__ATOMIC_ACQUIRE, "agent");
            xb_add(&bar[XB_XGEN(b.x)], 1u);
            asm volatile("s_waitcnt vmcnt(0)" ::: "memory");
        } else {
            XB_SPIN(xb_ld(&bar[XB_XGEN(b.x)]) == gen, bar);
            __builtin_amdgcn_fence(__ATOMIC_ACQUIRE, "agent");
            asm volatile("s_waitcnt vmcnt(0)" ::: "memory");
        }
    }
    __syncthreads();
}


struct MegaArgs { P0Args p0; P1Args p1; P2Args p2; P3Args p3; P4Args p4; P6Args p6; P7Args p7; P8Args p8; unsigned* bar; };
__global__ __launch_bounds__(NTHR, 2) void k_mega(MegaArgs a) {
    extern __shared__ __attribute__((aligned(16))) char smem[];
    volatile LAS unsigned* xbw = (volatile LAS unsigned*)(smem + LDS_BYTES - 16);
    if (threadIdx.x == 0) { xbw[0] = 0u; xbw[1] = 0u; xbw[2] = 0u; xbw[3] = 0u; }
    __syncthreads();
    XcdBarrier bar = xcd_barrier_post(a.bar, xbw);
    LAS unsigned char* L = (LAS unsigned char*)smem;
    phase_prologue(a.p0, smem);     xcd_barrier(bar);
    phase_qkv(a.p1, L);             xcd_barrier(bar);
    phase_attn(a.p2, a.p0, smem);   xcd_barrier(bar);
    phase_outproj(a.p3, L);         xcd_barrier(bar);
    phase_router(a.p4, a.p0, smem); xcd_barrier(bar);
    phase_moe_gu(a.p6, smem, L);    xcd_barrier(bar);
    phase_moe_down(a.p7, smem, L);  xcd_barrier(bar);
    phase_combine(a.p8, smem);
}

extern "C" void kernel_launch(void* const* d_in, const int* in_sizes, int n_in, void* d_out, int out_size, void* d_ws, size_t ws_size, hipStream_t stream) {
    const float* x = (const float*)d_in[0];      const float* w_in = (const float*)d_in[1];   const float* rel_bias = (const float*)d_in[2];
    const float* gain_a = (const float*)d_in[3]; const float* gain_b = (const float*)d_in[4]; const float* w_out = (const float*)d_in[5];
    const float* ln1_g = (const float*)d_in[6];  const float* ln1_b = (const float*)d_in[7];  const float* router_w = (const float*)d_in[8];
    const float* router_bias = (const float*)d_in[9]; const float* w_gate = (const float*)d_in[10]; const float* w_up = (const float*)d_in[11];
    const float* w_down = (const float*)d_in[12]; const float* ws_gate = (const float*)d_in[13]; const float* ws_up = (const float*)d_in[14];
    const float* ws_down = (const float*)d_in[15]; const float* ln2_g = (const float*)d_in[16]; const float* ln2_b = (const float*)d_in[17];
    char* ws = (char*)d_ws; float* out = (float*)d_out;
    int* ctrl = (int*)(ws + OFF_CTRL); int* counts = ctrl + CW_COUNTS;
    bf16_t* X1 = (bf16_t*)(ws + OFF_X1); int* tokl = (int*)(ws + OFF_TOKL); float* gatel = (float*)(ws + OFF_GATEL);
    int* eidx = (int*)(ws + OFF_EIDX); float* gate = (float*)(ws + OFF_GATE); int* slot = (int*)(ws + OFF_SLOT);
    unsigned char* H = (unsigned char*)(ws + OFF_H); unsigned char* Y = (unsigned char*)(ws + OFF_Y); unsigned char* x1f8 = (unsigned char*)(ws + OFF_X1F8);
    bf16_t* Q = (bf16_t*)(ws + OFF_Q); bf16_t* Kb = (bf16_t*)(ws + OFF_K); bf16_t* Vt = (bf16_t*)(ws + OFF_VT);
    bf16_t* yatt = (bf16_t*)(ws + OFF_YATT); bf16_t* r = (bf16_t*)(ws + OFF_R);
    bf16_t* xb = (bf16_t*)(ws + OFF_XB); float* stats = (float*)(ws + OFF_STATS);
    bf16_t* wt_in = (bf16_t*)(ws + OFF_WTIN); bf16_t* wt_out = (bf16_t*)(ws + OFF_WTOUT); bf16_t* wt_r = (bf16_t*)(ws + OFF_WTR);
    unsigned char* wgut = (unsigned char*)(ws + OFF_WGUT); unsigned char* wdt = (unsigned char*)(ws + OFF_WDT);
    if (ws_size < WS_NEEDED) { fprintf(stderr, "kernel_launch: workspace too small (%zu < %zu)\n", ws_size, (size_t)WS_NEEDED); return; }
    hipMemsetAsync(ctrl, 0, 128 * 1024, stream);
    static bool attr_done = false;
    if (!attr_done) {
        hipFuncSetAttribute((const void*)k_mega, hipFuncAttributeMaxDynamicSharedMemorySize, LDS_BYTES);
        attr_done = true;
    }
    MegaArgs m{};
    m.p0 = P0Args{x, w_in, w_out, router_w, xb, wt_in, wt_out, wt_r, w_gate, w_up, w_down, ws_gate, ws_up, ws_down, wgut, wdt};
    m.p1 = P1Args{xb, wt_in, Q, Kb, Vt};
    m.p2 = P2Args{Q, Kb, Vt, rel_bias, gain_a, gain_b, yatt};
    m.p3 = P3Args{yatt, wt_out, xb, r, stats};
    m.p4 = P4Args{r, stats, ln1_g, ln1_b, X1, x1f8, wt_r, router_bias, eidx, gate, counts, tokl, gatel, slot};
    m.p6 = P6Args{x1f8, counts, tokl, gatel, wgut, H};
    m.p7 = P7Args{H, counts, wdt, Y};
    m.p8 = P8Args{X1, Y, slot, counts, ln2_g, ln2_b, out};
    m.bar = (unsigned*)ctrl;
    k_mega<<<GRID, NTHR, LDS_BYTES, stream>>>(m);
}
```

```cpp
#include <hip/hip_runtime.h>
#include <cstdint>
#include <cstdio>

typedef unsigned short bf16_t;

constexpr int D_MODEL = 1024, BATCH = 16, SEQ = 2048, T_TOK = BATCH * SEQ;
constexpr int HEAD_DIM = 64, NHA = 8, NHB = 8, NHH = 16;
constexpr int CHUNK = 64, LEFT_CHUNKS = 8, MAX_REL = 128;
constexpr int N_EXP = 256, TOP_K = 8, N_GROUPS = 8, TOPK_GROUPS = 4, EPG = 32, D_EXP = 256;
constexpr float ROUTED_SCALE = 2.5f, LN_EPS = 1e-5f, RMS_EPS = 1e-6f;
constexpr float DN_ALPHA = 1.189207115002721f;
constexpr float LOG2E = 1.4426950408889634f, LN2 = 0.6931471805599453f;
constexpr float QSCALE = 0.125f * LOG2E;
constexpr float WSCALE = 64.f, XSCALE = 16.f, HSCALE = 16.f;
constexpr float YSCALE = 64.f;
constexpr int CAP = T_TOK;
constexpr int ROWS_ALL = T_TOK * TOP_K + T_TOK;

__device__ __forceinline__ float bf2f(bf16_t v) { return __uint_as_float(((unsigned)v) << 16); }
__device__ __forceinline__ bf16_t f2bf(float f) { unsigned u = __float_as_uint(f); u += 0x7fffu + ((u >> 16) & 1u); return (bf16_t)(u >> 16); }

constexpr size_t MB = 1024ull * 1024ull;
constexpr size_t OFF_CTRL   = 0;
constexpr size_t OFF_X1     = 1 * MB;
constexpr size_t OFF_TOKL   = OFF_X1 + 64 * MB;
constexpr size_t OFF_GATEL  = OFF_TOKL + 32 * MB;
constexpr size_t OFF_EIDX   = OFF_GATEL + 32 * MB;
constexpr size_t OFF_GATE   = OFF_EIDX + 1 * MB;
constexpr size_t OFF_SLOT   = OFF_GATE + 1 * MB;
constexpr size_t OFF_WDT    = OFF_SLOT + 1 * MB;
constexpr size_t OFF_X1F8   = OFF_WDT + 72 * MB;
constexpr size_t OFF_BIG    = OFF_WDT + 129 * MB;
constexpr size_t OFF_H      = OFF_BIG;
constexpr size_t OFF_Y      = OFF_BIG + 144 * MB;
constexpr size_t OFF_Q      = OFF_BIG;
constexpr size_t OFF_K      = OFF_BIG + 64 * MB;
constexpr size_t OFF_VT     = OFF_BIG + 128 * MB;
constexpr size_t OFF_YATT   = OFF_BIG + 192 * MB;
constexpr size_t OFF_R      = OFF_BIG + 256 * MB;
constexpr size_t OFF_XB     = OFF_BIG + 320 * MB;
constexpr size_t OFF_STATS  = OFF_BIG + 384 * MB;
constexpr size_t OFF_WTIN   = OFF_BIG + 392 * MB;
constexpr size_t OFF_WTOUT  = OFF_BIG + 398 * MB;
constexpr size_t OFF_WTR    = OFF_BIG + 400 * MB;
constexpr size_t OFF_WGUT   = OFF_BIG + 401 * MB;
constexpr size_t WS_NEEDED  = OFF_BIG + 720 * MB;
static_assert(OFF_WGUT + 257 * MB <= WS_NEEDED && WS_NEEDED <= 1024 * MB, "workspace map");
constexpr int CW_COUNTS = 8192;
constexpr int CSTR = 64;

typedef short bf16x8 __attribute__((ext_vector_type(8)));
typedef float f32x4 __attribute__((ext_vector_type(4)));
typedef float f32x2 __attribute__((ext_vector_type(2)));
typedef float f32x16 __attribute__((ext_vector_type(16)));
typedef unsigned u32x4 __attribute__((ext_vector_type(4)));
typedef unsigned u32x2 __attribute__((ext_vector_type(2)));
#define DI __device__ __forceinline__
constexpr int NTHR = 512, GRID = 256;
DI int tidx() { int t = threadIdx.x; asm volatile("" : "+v"(t)); return t; }
constexpr int LDS_BYTES = 160 * 1024;

typedef __bf16 bf16x2_t __attribute__((ext_vector_type(2)));
DI unsigned cvt_pk_bf16(float lo, float hi) { f32x2 v = {lo, hi}; bf16x2_t r = __builtin_convertvector(v, bf16x2_t); return __builtin_bit_cast(unsigned, r); }
DI float clamp8(float v) { return __builtin_amdgcn_fmed3f(v, -440.f, 440.f); }
DI unsigned pack_fp8x4(float a, float b, float c, float d) { int w = 0; w = __builtin_amdgcn_cvt_pk_fp8_f32(clamp8(a), clamp8(b), w, false); w = __builtin_amdgcn_cvt_pk_fp8_f32(clamp8(c), clamp8(d), w, true); return (unsigned)w; }
DI int vblock() { return (int)((blockIdx.x & 7) * (GRID / 8) + (blockIdx.x >> 3)); }

template <int MT> struct Tile { static constexpr int BM = 32 * MT, A_BYTES = BM * 128, B_BYTES = 256 * 128, STAGE = A_BYTES + B_BYTES; };

template <int MT> struct ALoader {
    const bf16_t* p[MT / 2]; u32x4 v[MT / 2]; int off0;
    DI void init_rows(const bf16_t* A, int lda, int row0) {
        const int tid = tidx(), kc = tid & 7, r = tid >> 3;
#pragma unroll
        for (int i = 0; i < MT / 2; ++i) p[i] = A + (size_t)(row0 + r + 64 * i) * lda + kc * 8;
        off0 = r * 128 + ((kc ^ ((r >> 1) & 7)) << 4);
    }
    DI void init_gather(const bf16_t* A, int lda, const int* rows, int cnt, int m0) {
        const int tid = tidx(), kc = tid & 7, r = tid >> 3;
#pragma unroll
        for (int i = 0; i < MT / 2; ++i) { int rr = m0 + r + 64 * i; rr = rr < cnt ? rr : cnt - 1; const int g = rows ? rows[rr] : rr; p[i] = A + (size_t)g * lda + kc * 8; }
        off0 = r * 128 + ((kc ^ ((r >> 1) & 7)) << 4);
    }
    DI void load(int k0) {
#pragma unroll
        for (int i = 0; i < MT / 2; ++i) v[i] = *(const u32x4*)(p[i] + k0);
    }
    DI void store(char* ldsA) const {
#pragma unroll
        for (int i = 0; i < MT / 2; ++i) *(u32x4*)(ldsA + off0 + i * 8192) = v[i];
    }
};
struct BLoaderBt {
    const bf16_t* p[4]; u32x4 v[4]; int off0;
    DI void init(const bf16_t* Bt, int ldk, int n0) {
        const int tid = tidx(), kc = tid & 7, r = tid >> 3;
#pragma unroll
        for (int i = 0; i < 4; ++i) p[i] = Bt + (size_t)(n0 + r + 64 * i) * ldk + kc * 8;
        off0 = r * 128 + ((kc ^ ((r >> 1) & 7)) << 4);
    }
    DI void load(int k0) {
#pragma unroll
        for (int i = 0; i < 4; ++i) v[i] = *(const u32x4*)(p[i] + k0);
    }
    DI void store(char* ldsB) const {
#pragma unroll
        for (int i = 0; i < 4; ++i) *(u32x4*)(ldsB + off0 + i * 8192) = v[i];
    }
};
template <int MT, bool TR, class AL, class BL>
DI void gemm_tile(char* lds, AL& al, BL& bl, int nk, f32x4 (&acc)[MT][4]) {
    typedef Tile<MT> TT;
    const int tid = tidx(), wid = tid >> 6, lane = tid & 63, wr = wid >> 2, wc = wid & 3, fr = lane & 15, fq = lane >> 4;
#pragma unroll
    for (int m = 0; m < MT; ++m)
#pragma unroll
        for (int n = 0; n < 4; ++n) acc[m][n] = (f32x4){0.f, 0.f, 0.f, 0.f};
    int aoff[2], boff[2];
#pragma unroll
    for (int ks = 0; ks < 2; ++ks) { const int ch = (((4 * ks + fq) ^ (fr >> 1)) << 4); aoff[ks] = (16 * MT * wr + fr) * 128 + ch; boff[ks] = TT::A_BYTES + (64 * wc + fr) * 128 + ch; }
    al.load(0); bl.load(0);
    __syncthreads();
    al.store(lds); bl.store(lds + TT::A_BYTES);
    __syncthreads();
    for (int kt = 0; kt < nk; ++kt) {
        char* cur = lds + (kt & 1) * TT::STAGE; char* nxt = lds + ((kt & 1) ^ 1) * TT::STAGE;
        const bool more = kt + 1 < nk;
        if (more) { al.load((kt + 1) * 64); bl.load((kt + 1) * 64); }
#pragma unroll
        for (int ks = 0; ks < 2; ++ks) {
            bf16x8 a[MT], b[4];
#pragma unroll
            for (int m = 0; m < MT; ++m) a[m] = *(const bf16x8*)(cur + aoff[ks] + m * 2048);
#pragma unroll
            for (int n = 0; n < 4; ++n) b[n] = *(const bf16x8*)(cur + boff[ks] + n * 2048);
#pragma unroll
            for (int m = 0; m < MT; ++m)
#pragma unroll
                for (int n = 0; n < 4; ++n)
                    acc[m][n] = TR ? __builtin_amdgcn_mfma_f32_16x16x32_bf16(b[n], a[m], acc[m][n], 0, 0, 0) : __builtin_amdgcn_mfma_f32_16x16x32_bf16(a[m], b[n], acc[m][n], 0, 0, 0);
        }
        if (more) { al.store(nxt); bl.store(nxt + TT::A_BYTES); }
        __syncthreads();
    }
}

#define LAS __attribute__((address_space(3)))
namespace gs {
constexpr int BM = 256, BK = 64, HALF = 128, HTB = HALF * BK * 2, STAGE_BYTES = 8 * HTB;
DI int lds_byte(int r, int c) { const int st = (r >> 4) * 2 + (c >> 5), rr = r & 15, cc = c & 31, ob = rr * 64 + cc * 2; return st * 1024 + (ob ^ (((ob >> 9) & 1) << 5)); }
DI void stage_rc(int b, int& R, int& C) { const int st = b / 1024, sb = b % 1024, swz = sb ^ (((sb >> 9) & 1) << 5); R = (st >> 1) * 16 + swz / 64; C = (st & 1) * 32 + (swz % 64) / 2; }
DI int perm32(int rho) { const int n = rho >> 4, i = rho & 15; return 8 * (i >> 2) + 4 * n + (i & 3); }
typedef long i64x2 __attribute__((ext_vector_type(2)));
DI const char* uni(const char* p) { const unsigned long long v = (unsigned long long)p; const unsigned lo = __builtin_amdgcn_readfirstlane((unsigned)v), hi = __builtin_amdgcn_readfirstlane((unsigned)(v >> 32)); return (const char*)(((unsigned long long)hi << 32) | lo); }
template <bool TR, bool F8>
DI f32x4 mma16(const bf16x8& a, const bf16x8& b, f32x4 c) {
    if (F8) {
        const i64x2 a2 = __builtin_bit_cast(i64x2, a), b2 = __builtin_bit_cast(i64x2, b);
        c = TR ? __builtin_amdgcn_mfma_f32_16x16x32_fp8_fp8(b2[0], a2[0], c, 0, 0, 0) : __builtin_amdgcn_mfma_f32_16x16x32_fp8_fp8(a2[0], b2[0], c, 0, 0, 0);
        return TR ? __builtin_amdgcn_mfma_f32_16x16x32_fp8_fp8(b2[1], a2[1], c, 0, 0, 0) : __builtin_amdgcn_mfma_f32_16x16x32_fp8_fp8(a2[1], b2[1], c, 0, 0, 0);
    }
    return TR ? __builtin_amdgcn_mfma_f32_16x16x32_bf16(b, a, c, 0, 0, 0) : __builtin_amdgcn_mfma_f32_16x16x32_bf16(a, b, c, 0, 0, 0);
}
typedef int i32x8 __attribute__((ext_vector_type(8)));
typedef short bf16x16 __attribute__((ext_vector_type(16)));
template <bool TR>
DI f32x4 mma128(const bf16x16& a, const bf16x16& b, f32x4 c) {
    const i32x8 av = __builtin_bit_cast(i32x8, a), bv = __builtin_bit_cast(i32x8, b);
    const int one = 0x7F7F7F7F;
    if (TR) asm volatile("v_mfma_scale_f32_16x16x128_f8f6f4 %0, %1, %2, %0, %3, %3 op_sel_hi:[0,0,0]" : "+v"(c) : "v"(bv), "v"(av), "v"(one));
    else    asm volatile("v_mfma_scale_f32_16x16x128_f8f6f4 %0, %1, %2, %0, %3, %3 op_sel_hi:[0,0,0]" : "+v"(c) : "v"(av), "v"(bv), "v"(one));
    return c;
}
DI bf16x8 frag_lo(const bf16x16& v) { return __builtin_shufflevector(v, v, 0, 1, 2, 3, 4, 5, 6, 7); }
DI bf16x8 frag_hi(const bf16x16& v) { return __builtin_shufflevector(v, v, 8, 9, 10, 11, 12, 13, 14, 15); }
template <bool TR, bool PERM, int F8, class Sched, class Epi>
DI void gemm_stream(LAS unsigned char* lds, const int K, const Sched& S, const Epi& E) {
    typedef typename Sched::U U;
    const int tid = tidx(), wid = __builtin_amdgcn_readfirstlane(tid >> 6), lane = tid & 63, wr = wid >> 2, wc = wid & 3, fr = lane & 15, fq = lane >> 4;
    const int nt = K / BK;
    int R[2], C[2]; unsigned voffB[2];
#pragma unroll
    for (int i = 0; i < 2; ++i) { stage_rc(tid * 16 + i * 8192, R[i], C[i]); const int Rb = PERM ? ((R[i] & ~31) + perm32(R[i] & 31)) : R[i]; voffB[i] = (unsigned)(Rb * K + C[i]) * 2u; }
    const size_t kstep = (size_t)(BK * 2), hstepB = (size_t)HALF * K * 2;
    const unsigned ldsw = (unsigned)wid * 1024u;
    const int aoff = lds_byte(wr * 64 + fr, fq * 8), boff = lds_byte(wc * 32 + fr, fq * 8);
#define GS_SA(b, h) (((b) * 2 + (h)) * HTB)
#define GS_SB(b, h) ((4 + (b) * 2 + (h)) * HTB)
#define GS_STAGE(bufoff, gbase, uix, h) do { _Pragma("unroll") for (int _i = 0; _i < 2; ++_i) \
        __builtin_amdgcn_global_load_lds((const unsigned*)((const char*)(gbase) + S.a_voff(uix, h, R[_i], C[_i])), (LAS unsigned*)(lds + (bufoff) + ldsw + _i * 8192), 16, 0, 0); } while (0)
#define GS_STAGEB(bufoff, gbase, voff) do { _Pragma("unroll") for (int _i = 0; _i < 2; ++_i) \
        __builtin_amdgcn_global_load_lds((const unsigned*)((const char*)(gbase) + (voff)[_i]), (LAS unsigned*)(lds + (bufoff) + ldsw + _i * 8192), 16, 0, 0); } while (0)
#define GS_LD32(base) __builtin_shufflevector(*(const LAS bf16x8*)(base), *(const LAS bf16x8*)((base) + 1024), 0, 1, 2, 3, 4, 5, 6, 7, 8, 9, 10, 11, 12, 13, 14, 15)
#define GS_LDA(dst, b, h) do { _Pragma("unroll") for (int m = 0; m < 4; ++m) dst[m] = GS_LD32(lds + GS_SA(b, h) + aoff + m * 2048); } while (0)
#define GS_LDB(dst, b, h) do { _Pragma("unroll") for (int n = 0; n < 2; ++n) dst[n] = GS_LD32(lds + GS_SB(b, h) + boff + n * 2048); } while (0)
#define GS_MMA(ai, bj, At, Bt) do { __builtin_amdgcn_s_setprio(1); _Pragma("unroll") for (int m = 0; m < 4; ++m) _Pragma("unroll") for (int n = 0; n < 2; ++n) { \
        if (F8 == 2) acc[ai][bj][m][n] = mma128<TR>(At[m], Bt[n], acc[ai][bj][m][n]); \
        else { acc[ai][bj][m][n] = mma16<TR, F8 == 1>(frag_lo(At[m]), frag_lo(Bt[n]), acc[ai][bj][m][n]); acc[ai][bj][m][n] = mma16<TR, F8 == 1>(frag_hi(At[m]), frag_hi(Bt[n]), acc[ai][bj][m][n]); } } \
        __builtin_amdgcn_s_setprio(0); } while (0)
#define GS_WAIT_V(n) asm volatile("s_waitcnt vmcnt(" #n ")" ::: "memory")
#define GS_WAIT_L(n) asm volatile("s_waitcnt lgkmcnt(" #n ")" ::: "memory")
#define GS_BAR __builtin_amdgcn_s_barrier()
#define GS_SCHED __builtin_amdgcn_sched_barrier(0)
    U cur, nxt; int ui = 0;
    if (!S.next(0, cur)) return;
    f32x4 acc[2][2][4][2];
#pragma unroll
    for (int a = 0; a < 2; ++a)
#pragma unroll
        for (int b = 0; b < 2; ++b)
#pragma unroll
            for (int m = 0; m < 4; ++m)
#pragma unroll
                for (int n = 0; n < 2; ++n) acc[a][b][m][n] = (f32x4){0.f, 0.f, 0.f, 0.f};
    bf16x16 At[4], B0[2], B1[2];
    const char* cA = uni(cur.A); const char* cB = uni(cur.B);
    GS_STAGEB(GS_SB(0, 0), cB, voffB); GS_STAGEB(GS_SB(0, 1), cB + hstepB, voffB); GS_STAGE(GS_SA(0, 0), cA, 0, 0); GS_STAGE(GS_SA(0, 1), cA, 0, 1);
    if (wr == 1) GS_BAR;
    GS_WAIT_V(2); GS_BAR;
    GS_STAGEB(GS_SB(1, 0), cB + kstep, voffB); GS_STAGE(GS_SA(1, 0), cA + kstep, 0, 0); GS_STAGEB(GS_SB(1, 1), cB + hstepB + kstep, voffB);
    GS_WAIT_V(6); GS_BAR;
    for (;;) {
        const bool has_next = S.next(ui + 1, nxt);
        const int nui = has_next ? ui + 1 : ui;
        const char* nA = uni(has_next ? nxt.A : cA); const char* nB = uni(has_next ? nxt.B : cB);
#pragma unroll 1
        for (int t = 0; t < nt; t += 2) {
            const bool last = (t == nt - 2);
            const char* a1 = uni(cA + (size_t)(t + 1) * kstep);
            const char* a2 = uni(last ? nA : cA + (size_t)(t + 2) * kstep); const char* b2 = uni(last ? nB : cB + (size_t)(t + 2) * kstep);
            const char* a3 = uni(a2 + kstep); const char* b3 = uni(b2 + kstep);
            const int u2 = last ? nui : ui;
            GS_LDB(B0, 0, 0); GS_LDB(B1, 0, 1); GS_SCHED; GS_LDA(At, 0, 0); GS_STAGE(GS_SA(1, 1), a1, ui, 1);
            GS_WAIT_V(8); GS_WAIT_L(0); GS_BAR; GS_MMA(0, 0, At, B0); GS_MMA(0, 1, At, B1); GS_BAR; GS_SCHED;
            GS_LDA(At, 0, 1); GS_STAGEB(GS_SB(0, 0), b2, voffB); GS_STAGEB(GS_SB(0, 1), b2 + hstepB, voffB); GS_STAGE(GS_SA(0, 0), a2, u2, 0);
            GS_WAIT_V(8); GS_WAIT_L(0); GS_BAR; GS_MMA(1, 0, At, B0); GS_MMA(1, 1, At, B1); GS_BAR; GS_SCHED;
            GS_LDB(B0, 1, 0); GS_LDB(B1, 1, 1); GS_SCHED; GS_LDA(At, 1, 0); GS_STAGE(GS_SA(0, 1), a2, u2, 1);
            GS_WAIT_V(8); GS_WAIT_L(0); GS_BAR; GS_MMA(0, 0, At, B0); GS_MMA(0, 1, At, B1); GS_BAR; GS_SCHED;
            GS_LDA(At, 1, 1); GS_STAGEB(GS_SB(1, 0), b3, voffB); GS_STAGEB(GS_SB(1, 1), b3 + hstepB, voffB); GS_STAGE(GS_SA(1, 0), a3, u2, 0);
            GS_WAIT_V(8); GS_WAIT_L(0); GS_BAR; GS_MMA(1, 0, At, B0); GS_MMA(1, 1, At, B1); GS_BAR; GS_SCHED;
        }
        if (wr == 0) GS_BAR;
        if (F8 == 2) asm volatile("s_nop 15\n\ts_nop 15\n\ts_nop 15\n\ts_nop 15\n\ts_nop 15\n\ts_nop 15" ::: "memory");
        E(acc, cur, wr, wc, fr, fq);
        if (!has_next) break;
#pragma unroll
        for (int a = 0; a < 2; ++a)
#pragma unroll
            for (int b = 0; b < 2; ++b)
#pragma unroll
                for (int m = 0; m < 4; ++m)
#pragma unroll
                    for (int n = 0; n < 2; ++n) acc[a][b][m][n] = (f32x4){0.f, 0.f, 0.f, 0.f};
        cur = nxt; cA = nA; cB = nB; ++ui;
        if (wr == 1) GS_BAR;
    }
    GS_WAIT_V(0);
    GS_BAR;
#undef GS_SA
#undef GS_SB
#undef GS_STAGE
#undef GS_STAGEB
#undef GS_LDA
#undef GS_LD32
#undef GS_LDB
#undef GS_MMA
#undef GS_WAIT_V
#undef GS_WAIT_L
#undef GS_BAR
#undef GS_SCHED
}
struct DenseU { const char* A; const char* B; int pm, pn; };
struct DenseSched {
    typedef DenseU U;
    const bf16_t* A; const bf16_t* Bt; int K, nunits, first, stride, npn, pn_base, pn_mod0, pn_mod1;
    DI int colmap(int q) const { return pn_base + (q / pn_mod0) * pn_mod1 + (q % pn_mod0); }
    DI bool next(int i, U& u) const {
        const int L = first + i * stride; if (L >= nunits) return false;
        u.pm = L / npn; u.pn = colmap(L % npn);
        u.A = (const char*)A + (size_t)u.pm * BM * K * 2; u.B = (const char*)Bt + (size_t)u.pn * BM * K * 2; return true;
    }
    DI unsigned a_voff(int, int h, int R, int C) const { return (unsigned)((HALF * h + R) * K + C) * 2u; }
};
}

DI void transpose_cvt(const float* W, bf16_t* Wt, int K, int N, int unit, char* lds) {
    float* tile = (float*)lds;
    const int nbn = N / 64, kb = unit / nbn, nb = unit % nbn, tid = tidx();
    __syncthreads();
#pragma unroll
    for (int i = 0; i < 8; ++i) { const int idx = tid + i * 512, r = idx >> 6, c = idx & 63; tile[r * 65 + c] = W[(size_t)(kb * 64 + r) * N + nb * 64 + c]; }
    __syncthreads();
#pragma unroll
    for (int i = 0; i < 8; ++i) { const int idx = tid + i * 512, n = idx >> 6, k = idx & 63; Wt[(size_t)(nb * 64 + n) * K + kb * 64 + k] = f2bf(tile[k * 65 + n]); }
}
struct P0Args { const float* x; const float* w_in; const float* w_out; const float* router_w; bf16_t* xb; bf16_t* wt_in; bf16_t* wt_out; bf16_t* wt_r;
                const float* w_gate; const float* w_up; const float* w_down; const float* ws_gate; const float* ws_up; const float* ws_down; unsigned char* wgut; unsigned char* wdt; };
constexpr int CV_GU = 257 * 2 * 16, CV_DN = 257 * 16;
struct CvItem { const float* src; unsigned char* dst; int ld, ldd, rbase, rhi; };
DI CvItem cv_item(const P0Args& a, int it) {
    CvItem c;
    if (it < CV_GU) {
        const int e = it / 32, u = (it >> 4) & 1, kt = it & 15;
        const float* W = e < N_EXP ? (u ? a.w_up : a.w_gate) + (size_t)e * D_MODEL * D_EXP : (u ? a.ws_up : a.ws_gate);
        c.src = W + (size_t)kt * 64 * D_EXP; c.ld = D_EXP; c.dst = a.wgut + (size_t)e * 512 * D_MODEL + kt * 64; c.ldd = D_MODEL; c.rbase = 128 * u; c.rhi = 256;
    } else {
        const int j = it - CV_GU, e = j / 16, kt = (j >> 2) & 3, nb = j & 3;
        const float* W = e < N_EXP ? a.w_down + (size_t)e * D_EXP * D_MODEL : a.ws_down;
        c.src = W + (size_t)kt * 64 * D_MODEL + nb * 256; c.ld = D_MODEL; c.dst = a.wdt + (size_t)e * D_MODEL * D_EXP + kt * 64; c.ldd = D_EXP; c.rbase = 256 * nb; c.rhi = 128;
    }
    return c;
}
constexpr int CV_TILE_BYTES = 64 * 260 * 4;
DI void cv_dma_nt(const char* sbase, unsigned voff, unsigned lds_dst) {
    unsigned keep;
    asm volatile("s_mov_b32 %0, m0\n\ts_mov_b32 m0, %3\n\ts_nop 0\n\tglobal_load_lds_dwordx4 %1, %2 nt\n\ts_mov_b32 m0, %0" : "=&s"(keep) : "v"(voff), "s"(sbase), "s"(lds_dst) : "memory");
}
DI const char* uni64(const void* p) { const unsigned long long v = (unsigned long long)p; const unsigned lo = __builtin_amdgcn_readfirstlane((unsigned)v), hi = __builtin_amdgcn_readfirstlane((unsigned)(v >> 32)); return (const char*)(((unsigned long long)hi << 32) | lo); }
DI void cv_issue(const CvItem& c, LAS unsigned char* tile) {
    const int tid = tidx(), w = __builtin_amdgcn_readfirstlane(tid >> 6), l = tid & 63;
    const char* sb = uni64(c.src); const unsigned tb = (unsigned)__builtin_amdgcn_readfirstlane((unsigned)(size_t)tile);
#pragma unroll
    for (int i = 0; i < 8; ++i) { const int k = 8 * w + i; cv_dma_nt(sb, (unsigned)(k * c.ld + 4 * (l ^ w)) * 4u, tb + (unsigned)(k * 1040)); }
}
DI void lds_barrier() { asm volatile("s_waitcnt lgkmcnt(0)" ::: "memory"); __builtin_amdgcn_s_barrier(); asm volatile("" ::: "memory"); }
DI void cv_emit(const CvItem& c, const char* lds) {
    const float* tile = (const float*)lds;
    const int tid = tidx();
#pragma unroll
    for (int i = 0; i < 4; ++i) {
        const int idx = tid + i * 512, kc = idx & 7, n = idx >> 3; const float* p = tile + (8 * kc) * 260 + (n ^ (4 * kc));
        const unsigned w0 = pack_fp8x4(p[0] * WSCALE, p[260] * WSCALE, p[2 * 260] * WSCALE, p[3 * 260] * WSCALE), w1 = pack_fp8x4(p[4 * 260] * WSCALE, p[5 * 260] * WSCALE, p[6 * 260] * WSCALE, p[7 * 260] * WSCALE);
        __builtin_nontemporal_store((u32x2){w0, w1}, (u32x2*)(c.dst + (size_t)(c.rbase + (n >> 7) * c.rhi + (n & 127)) * c.ldd + 8 * kc));
    }
}
DI void convert_moe_range(const P0Args& a, char* lds, const int lo, const int hi) {
    int it = lo + vblock(); if (it >= hi) return;
    __syncthreads();
    LAS unsigned char* t0 = (LAS unsigned char*)lds; LAS unsigned char* t1 = t0 + CV_TILE_BYTES;
    CvItem c = cv_item(a, it); cv_issue(c, t0);
    int pp = 0;
#pragma unroll 1
    for (;;) {
        const int nit = it + GRID; const bool more = nit < hi;
        CvItem cn = c;
        if (more) { cn = cv_item(a, nit); cv_issue(cn, pp ? t0 : t1); }
        if (more) asm volatile("s_waitcnt vmcnt(8)" ::: "memory"); else asm volatile("s_waitcnt vmcnt(0)" ::: "memory");
        lds_barrier();
        cv_emit(c, lds + (pp ? CV_TILE_BYTES : 0));
        lds_barrier();
        if (!more) break;
        it = nit; c = cn; pp ^= 1;
    }
    asm volatile("s_waitcnt vmcnt(0)" ::: "memory");
    __syncthreads();
}
DI void phase_prologue(const P0Args& a, char* lds) {
    const int vb = vblock();
    for (size_t i = (size_t)vb * NTHR + tidx(); i < (size_t)T_TOK * D_MODEL / 8; i += (size_t)GRID * NTHR) {
        const f32x4 v0 = *(const f32x4*)(a.x + i * 8), v1 = *(const f32x4*)(a.x + i * 8 + 4);
        u32x4 o; o.x = cvt_pk_bf16(v0[0], v0[1]); o.y = cvt_pk_bf16(v0[2], v0[3]); o.z = cvt_pk_bf16(v1[0], v1[1]); o.w = cvt_pk_bf16(v1[2], v1[3]);
        *(u32x4*)(a.xb + i * 8) = o;
    }
    const int n_in = (1024 / 64) * (3072 / 64), n_out = 16 * 16, n_r = 16 * 4;
    for (int u = vb; u < n_in + n_out + n_r; u += GRID) {
        if (u < n_in) transpose_cvt(a.w_in, a.wt_in, 1024, 3072, u, lds);
        else if (u < n_in + n_out) transpose_cvt(a.w_out, a.wt_out, 1024, 1024, u - n_in, lds);
        else transpose_cvt(a.router_w, a.wt_r, 1024, 256, u - n_in - n_out, lds);
    }
}


struct P1Args { const bf16_t* xb; const bf16_t* wt_in; bf16_t* Q; bf16_t* Kb; bf16_t* Vt; };
struct EpiQK { bf16_t* Q; bf16_t* Kb;
    DI void operator()(const f32x4 (&acc)[2][2][4][2], const gs::DenseU& u, int wr, int wc, int fr, int fq) const {
        const int seg = u.pn >> 1, type = seg % 3, grp = seg / 3; bf16_t* dst = type == 0 ? Q : Kb; const float sc = type == 0 ? QSCALE : 1.f;
#pragma unroll
        for (int ai = 0; ai < 2; ++ai)
#pragma unroll
            for (int m = 0; m < 4; ++m) {
                const int row = u.pm * 256 + 128 * ai + 64 * wr + 16 * m + fr, b = row / SEQ, s = row % SEQ;
#pragma unroll
                for (int bj = 0; bj < 2; ++bj) {
                    const int hh = grp * 8 + 4 * (u.pn & 1) + 2 * bj + (wc >> 1), d0 = 32 * (wc & 1) + 8 * fq;
                    const f32x4 v0 = acc[ai][bj][m][0] * sc, v1 = acc[ai][bj][m][1] * sc;
                    u32x4 o; o.x = cvt_pk_bf16(v0[0], v0[1]); o.y = cvt_pk_bf16(v0[2], v0[3]); o.z = cvt_pk_bf16(v1[0], v1[1]); o.w = cvt_pk_bf16(v1[2], v1[3]);
                    *(u32x4*)(dst + (size_t)(b * NHH + hh) * SEQ * 64 + (s >> 5) * 2048 + ((d0 >> 3) * 32 + (s & 31)) * 8) = o;
                }
            }
    } };
struct EpiV { bf16_t* Vt;
    DI void operator()(const f32x4 (&acc)[2][2][4][2], const gs::DenseU& u, int wr, int wc, int fr, int fq) const {
        const int grp = (u.pn >> 1) / 3;
#pragma unroll
        for (int ai = 0; ai < 2; ++ai)
#pragma unroll
            for (int m = 0; m < 4; ++m) {
                const int row = u.pm * 256 + 128 * ai + 64 * wr + 16 * m + 4 * fq, b = row / SEQ, s = row % SEQ;
#pragma unroll
                for (int bj = 0; bj < 2; ++bj)
#pragma unroll
                    for (int n = 0; n < 2; ++n) {
                        const int hh = grp * 8 + 4 * (u.pn & 1) + 2 * bj + (wc >> 1), d = 32 * (wc & 1) + 16 * n + fr;
                        const f32x4 v = acc[ai][bj][m][n];
                        u32x2 o; o.x = cvt_pk_bf16(v[0], v[1]); o.y = cvt_pk_bf16(v[2], v[3]);
                        { const int kap = s & 31; *(u32x2*)(Vt + (size_t)(b * NHH + hh) * SEQ * 64 + (s >> 5) * 2048 + ((((d >> 5) * 2 + (kap >> 4)) * 2 + ((kap >> 2) & 1)) * 32 + (d & 31)) * 8 + ((kap >> 3) & 1) * 4) = o; }
                    }
            }
    } };
DI void phase_qkv(const P1Args& a, LAS unsigned char* lds) {
    { gs::DenseSched S{a.xb, a.wt_in, D_MODEL, (T_TOK / 256) * 8, vblock(), GRID, 8, 0, 4, 6}; EpiQK E{a.Q, a.Kb}; gs::gemm_stream<true, true, 0>(lds, D_MODEL, S, E); }
    { gs::DenseSched S{a.xb, a.wt_in, D_MODEL, (T_TOK / 256) * 4, vblock(), GRID, 4, 4, 2, 6}; EpiV E{a.Vt}; gs::gemm_stream<false, false, 0>(lds, D_MODEL, S, E); }
}

struct P3Args { const bf16_t* y; const bf16_t* wt_out; const bf16_t* xb; bf16_t* r; float* stats; };
struct EpiOut { const bf16_t* xb; bf16_t* r; float* stats;
    DI void operator()(const f32x4 (&acc)[2][2][4][2], const gs::DenseU& u, int wr, int wc, int fr, int fq) const {
#pragma unroll
        for (int ai = 0; ai < 2; ++ai) {
            u32x4 xw[4][2];
#pragma unroll
            for (int m = 0; m < 4; ++m)
#pragma unroll
                for (int bj = 0; bj < 2; ++bj) xw[m][bj] = *(const u32x4*)(xb + (size_t)(u.pm * 256 + 128 * ai + 64 * wr + 16 * m + fr) * D_MODEL + u.pn * 256 + 128 * bj + 32 * wc + 8 * fq);
#pragma unroll
            for (int m = 0; m < 4; ++m) {
                const int row = u.pm * 256 + 128 * ai + 64 * wr + 16 * m + fr;
#pragma unroll
                for (int bj = 0; bj < 2; ++bj) {
                    const int col = u.pn * 256 + 128 * bj + 32 * wc + 8 * fq;
                    const u32x4 w = xw[m][bj];
                    const f32x4 x0 = (f32x4){__uint_as_float(w[0] << 16), __uint_as_float(w[0] & 0xffff0000u), __uint_as_float(w[1] << 16), __uint_as_float(w[1] & 0xffff0000u)};
                    const f32x4 x1 = (f32x4){__uint_as_float(w[2] << 16), __uint_as_float(w[2] & 0xffff0000u), __uint_as_float(w[3] << 16), __uint_as_float(w[3] & 0xffff0000u)};
                    const f32x4 v0 = x0 * DN_ALPHA + acc[ai][bj][m][0], v1 = x1 * DN_ALPHA + acc[ai][bj][m][1];
                    float s = ((v0[0] + v0[1]) + (v0[2] + v0[3])) + ((v1[0] + v1[1]) + (v1[2] + v1[3]));
                    float q = ((v0[0] * v0[0] + v0[1] * v0[1]) + (v0[2] * v0[2] + v0[3] * v0[3])) + ((v1[0] * v1[0] + v1[1] * v1[1]) + (v1[2] * v1[2] + v1[3] * v1[3]));
                    u32x4 o; o.x = cvt_pk_bf16(v0[0], v0[1]); o.y = cvt_pk_bf16(v0[2], v0[3]); o.z = cvt_pk_bf16(v1[0], v1[1]); o.w = cvt_pk_bf16(v1[2], v1[3]);
                    *(u32x4*)(r + (size_t)row * D_MODEL + col) = o;
                    s += __shfl_xor(s, 16); s += __shfl_xor(s, 32); q += __shfl_xor(q, 16); q += __shfl_xor(q, 32);
                    if (fq == 0) *(f32x2*)(stats + ((size_t)row * 32 + u.pn * 8 + bj * 4 + wc) * 2) = (f32x2){s, q};
                }
            }
        }
    } };
DI void phase_outproj(const P3Args& a, LAS unsigned char* lds) {
    gs::DenseSched S{a.y, a.wt_out, D_MODEL, (T_TOK / 256) * 4, vblock(), GRID, 4, 0, 4, 0}; EpiOut E{a.xb, a.r, a.stats}; gs::gemm_stream<true, true, 0>(lds, D_MODEL, S, E);
}

DI void unpack16(const u32x4& a, const u32x4& b, float (&v)[16]) {
#pragma unroll
    for (int j = 0; j < 4; ++j) { v[2 * j] = __uint_as_float(a[j] << 16); v[2 * j + 1] = __uint_as_float(a[j] & 0xffff0000u); v[8 + 2 * j] = __uint_as_float(b[j] << 16); v[8 + 2 * j + 1] = __uint_as_float(b[j] & 0xffff0000u); }
}
constexpr int RS_SC = 289;
constexpr int LDS_HIST = 100 * 1024;
struct P4Args { const bf16_t* r; const float* stats; const float* ln_g; const float* ln_b; bf16_t* x1; unsigned char* x1f8; const bf16_t* wt_r; const float* rbias;
                int* eidx; float* gate; int* counts; int* tokl; float* gatel; int* slot; };
DI void phase_router(const P4Args& a, const P0Args& cv, char* lds) {
    const int tid = tidx(), wid = tid >> 6, lane = tid & 63, wr = wid >> 2, wc = wid & 3, fr = lane & 15, fq = lane >> 4;
    float* sc = (float*)lds; int* hist = (int*)(lds + LDS_HIST); int* base = hist + 256;
    for (int u = vblock(); u < T_TOK / 128; u += GRID) {
        const int m0 = u * 128;
        if ((vblock() & 1) == 0) convert_moe_range(cv, lds, CV_GU, CV_GU + CV_DN);
        __syncthreads();
#pragma unroll 1
        for (int i0 = 0; i0 < 16; i0 += 4) {
            f32x2 st[4]; u32x4 r0[4], r1[4];
#pragma unroll
            for (int j4 = 0; j4 < 4; ++j4) {
                const int t = m0 + wid * 16 + i0 + j4;
                st[j4] = (f32x2){0.f, 0.f};
                if (lane < 32) st[j4] = *(const f32x2*)(a.stats + ((size_t)t * 32 + lane) * 2);
                r0[j4] = *(const u32x4*)(a.r + (size_t)t * D_MODEL + lane * 16); r1[j4] = *(const u32x4*)(a.r + (size_t)t * D_MODEL + lane * 16 + 8);
            }
#pragma unroll
            for (int j4 = 0; j4 < 4; ++j4) {
                const int t = m0 + wid * 16 + i0 + j4;
                float s = st[j4].x, q = st[j4].y;
#pragma unroll
                for (int o = 1; o <= 16; o <<= 1) { s += __shfl_xor(s, o); q += __shfl_xor(q, o); }
                s = __shfl(s, 0); q = __shfl(q, 0);
                const float mu = s * (1.f / 1024.f), rstd = rsqrtf(q * (1.f / 1024.f) - mu * mu + LN_EPS);
                float v[16]; unpack16(r0[j4], r1[j4], v);
                u32x4 o0, o1, o8;
#pragma unroll
                for (int j = 0; j < 4; ++j) {
                    const f32x4 g = *(const f32x4*)(a.ln_g + lane * 16 + 4 * j), bb = *(const f32x4*)(a.ln_b + lane * 16 + 4 * j);
                    const float y0 = (v[4 * j] - mu) * rstd * g[0] + bb[0], y1 = (v[4 * j + 1] - mu) * rstd * g[1] + bb[1], y2 = (v[4 * j + 2] - mu) * rstd * g[2] + bb[2], y3 = (v[4 * j + 3] - mu) * rstd * g[3] + bb[3];
                    o8[j] = pack_fp8x4(y0 * XSCALE, y1 * XSCALE, y2 * XSCALE, y3 * XSCALE);
                    const unsigned p0 = cvt_pk_bf16(y0, y1), p1 = cvt_pk_bf16(y2, y3);
                    if (j < 2) { o0[2 * j] = p0; o0[2 * j + 1] = p1; } else { o1[2 * (j - 2)] = p0; o1[2 * (j - 2) + 1] = p1; }
                }
                *(u32x4*)(a.x1 + (size_t)t * D_MODEL + lane * 16) = o0; *(u32x4*)(a.x1 + (size_t)t * D_MODEL + lane * 16 + 8) = o1;
                *(u32x4*)(a.x1f8 + (size_t)t * D_MODEL + lane * 16) = o8;
            }
        }
        if (tid < 256) hist[tid] = 0;
        asm volatile("s_waitcnt vmcnt(0)" ::: "memory");
        __syncthreads();
        ALoader<4> al; al.init_rows(a.x1, D_MODEL, m0);
        BLoaderBt bl; bl.init(a.wt_r, D_MODEL, 0);
        f32x4 acc[4][4];
        gemm_tile<4, true>(lds, al, bl, D_MODEL / 64, acc);
        int my_idx[2], my_rank[2]; float my_gate[2];
#pragma unroll
        for (int p = 0; p < 2; ++p) {
            __syncthreads();
            if (wr == p) {
#pragma unroll
                for (int m = 0; m < 4; ++m)
#pragma unroll
                    for (int n = 0; n < 4; ++n) {
                        const int c0 = 64 * wc + 16 * n + 4 * fq; const f32x4 rb = *(const f32x4*)(a.rbias + c0);
#pragma unroll
                        for (int j = 0; j < 4; ++j) { const int c = c0 + j; sc[(16 * m + fr) * RS_SC + (c >> 5) * 36 + (c & 31)] = 1.f / (1.f + __expf(-acc[m][n][j])) + rb[j]; }
                    }
            }
            __syncthreads();
            const int row = tid >> 3, g = tid & 7, t = m0 + 64 * p + row;
            float sel[32];
#pragma unroll
            for (int i = 0; i < 32; ++i) sel[i] = sc[row * RS_SC + g * 36 + i];
            float m1 = -INFINITY, m2 = -INFINITY;
#pragma unroll
            for (int i = 0; i < 32; ++i) { const float v = sel[i]; m2 = fmaxf(m2, fminf(m1, v)); m1 = fmaxf(m1, v); }
            const float gs = m1 + m2; int rank = 0;
#pragma unroll
            for (int d = 1; d < 8; ++d) { const float o = __shfl_xor(gs, d); const int og = g ^ d; rank += (o > gs || (o == gs && og < g)) ? 1 : 0; }
            const bool en = rank < TOPK_GROUPS;
            float lv = -INFINITY; int li = 1 << 20;
            if (en) {
#pragma unroll
                for (int i = 0; i < 32; ++i) { const float v = sel[i]; if (v > lv) { lv = v; li = g * 32 + i; } }
            }
            float myv = 0.f; int myi = 0;
#pragma unroll
            for (int k = 0; k < TOP_K; ++k) {
                float bv = lv; int bi = li;
#pragma unroll
                for (int d = 1; d < 8; d <<= 1) { const float ov = __shfl_xor(bv, d); const int oi = __shfl_xor(bi, d); if (ov > bv || (ov == bv && oi < bi)) { bv = ov; bi = oi; } }
                if (g == k) { myv = bv; myi = bi; }
                if (k + 1 < TOP_K && (bi >> 5) == g) {
                    lv = -INFINITY; li = 1 << 20;
#pragma unroll
                    for (int i = 0; i < 32; ++i) { if (g * 32 + i == bi) sel[i] = -INFINITY; const float v = sel[i]; if (v > lv) { lv = v; li = g * 32 + i; } }
                }
            }
            const float score = myv - a.rbias[myi];
            float gsum = score;
#pragma unroll
            for (int d = 1; d < 8; d <<= 1) gsum += __shfl_xor(gsum, d);
            const float gt = score / gsum * ROUTED_SCALE;
            a.eidx[t * TOP_K + g] = myi; a.gate[t * TOP_K + g] = gt;
            my_idx[p] = myi; my_gate[p] = gt; my_rank[p] = atomicAdd(&hist[myi], 1);
        }
        __syncthreads();
        if (tid < 256) { const int h = hist[tid]; base[tid] = h > 0 ? atomicAdd(&a.counts[tid * CSTR], h) : 0; }
        __syncthreads();
#pragma unroll
        for (int p = 0; p < 2; ++p) {
            const int row = tid >> 3, g = tid & 7, t = m0 + 64 * p + row, e = my_idx[p], pos = base[e] + my_rank[p];
            a.tokl[(size_t)e * CAP + pos] = t; a.gatel[(size_t)e * CAP + pos] = my_gate[p]; a.slot[t * TOP_K + g] = e * CAP + pos;
        }
        if ((vblock() & 1) == 1) convert_moe_range(cv, lds, CV_GU, CV_GU + CV_DN);
    }
}

constexpr int LDS_ROWTAB = 128 * 1024;
constexpr int LDS_GTAB = 139 * 1024;
constexpr int LDS_TAB = 150 * 1024;
constexpr int LDS_UTAB = 154 * 1024;
constexpr int MOE_BM = 256;
DI void build_moe_tab(const int* counts, char* lds) {
    int* tstart = (int*)(lds + LDS_TAB); int* rstart = tstart + 264; int* cnts = tstart + 528;
    const int tid = tidx(), lane = tid & 63;
    __syncthreads();
    if (tid < 64) {
        int c[4], tl[4], cs = 0, ts = 0;
#pragma unroll
        for (int i = 0; i < 4; ++i) { c[i] = counts[(lane * 4 + i) * CSTR]; tl[i] = (c[i] + MOE_BM - 1) / MOE_BM; cs += c[i]; ts += tl[i]; }
        int ci = cs, ti = ts;
#pragma unroll
        for (int o = 1; o < 64; o <<= 1) { const int n1 = __shfl_up(ci, o), n2 = __shfl_up(ti, o); if (lane >= o) { ci += n1; ti += n2; } }
        int ce = ci - cs, te = ti - ts;
#pragma unroll
        for (int i = 0; i < 4; ++i) { rstart[lane * 4 + i] = ce; tstart[lane * 4 + i] = te; cnts[lane * 4 + i] = c[i]; ce += c[i]; te += tl[i]; }
        if (lane == 63) { rstart[256] = ce; tstart[256] = te; cnts[256] = T_TOK; rstart[257] = ce + T_TOK; tstart[257] = te + T_TOK / MOE_BM; }
    }
    __syncthreads();
}
DI int find_expert(const int* tstart, int g) {
    int lo = 0, hi = 256;
#pragma unroll 1
    while (lo < hi) { const int mid = (lo + hi + 1) >> 1; if (tstart[mid] <= g) lo = mid; else hi = mid - 1; }
    return lo;
}
struct MoeU { const char* A; const char* B; int e, m0, sub, ui; };
typedef const LAS int* ltab_t;
DI int find_expert_l(ltab_t tstart, int g) { int lo = 0, hi = 256;
#pragma unroll 1
    while (lo < hi) { const int mid = (lo + hi + 1) >> 1; if (tstart[mid] <= g) lo = mid; else hi = mid - 1; }
    return lo; }

struct P6Args { const unsigned char* x1; const int* counts; const int* tokl; const float* gatel; const unsigned char* wgut; unsigned char* H; };
struct GuSched {
    typedef MoeU U;
    ltab_t tab; const LAS int* rowtab; const LAS int* utab; const unsigned char* x1; const unsigned char* wgut; int first, stride, nunits;
    DI bool next(int i, U& u) const {
        const int L = first + i * stride; if (L >= nunits) return false;
        const int g = L >> 1, e = utab[i];
        u.sub = L & 1; u.e = e; u.ui = i; u.m0 = (g - tab[e]) * MOE_BM;
        u.A = (const char*)x1; u.B = (const char*)(wgut + ((size_t)e * 512 + 256 * u.sub) * D_MODEL); return true;
    }
    DI unsigned a_voff(int i, int h, int R, int C) const { return (unsigned)(rowtab[i * 256 + 128 * h + R] * (D_MODEL / 2) + C) * 2u; }
};
struct EpiGU { unsigned char* H; const LAS float* gtab; ltab_t tab;
    DI void operator()(const f32x4 (&acc)[2][2][4][2], const MoeU& u, int wr, int wc, int fr, int fq) const {
        const int st = tab[264 + u.e], cnt = tab[528 + u.e];
#pragma unroll
        for (int ai = 0; ai < 2; ++ai)
#pragma unroll
            for (int m = 0; m < 4; ++m) {
                const int row = u.m0 + 128 * ai + 64 * wr + 16 * m + fr;
                if (row < cnt) {
                    const float gt = gtab[u.ui * 256 + 128 * ai + 64 * wr + 16 * m + fr] * (HSCALE / (XSCALE * WSCALE));
                    float h[8];
#pragma unroll
                    for (int n = 0; n < 2; ++n)
#pragma unroll
                        for (int j = 0; j < 4; ++j) { const float gv = acc[ai][0][m][n][j] * (1.f / (XSCALE * WSCALE)); h[4 * n + j] = gv * __builtin_amdgcn_rcpf(1.f + __expf(-gv)) * acc[ai][1][m][n][j] * gt; }
                    *(u32x2*)(H + (size_t)(st + row) * D_EXP + 128 * u.sub + 32 * wc + 8 * fq) = (u32x2){pack_fp8x4(h[0], h[1], h[2], h[3]), pack_fp8x4(h[4], h[5], h[6], h[7])};
                }
            }
    } };
DI void phase_moe_gu(const P6Args& a, char* smem, LAS unsigned char* lds) {
    build_moe_tab(a.counts, smem);
    const int* tstart = (const int*)(smem + LDS_TAB); const int* rstart = tstart + 264; int* rowtab = (int*)(smem + LDS_ROWTAB); float* gtab = (float*)(smem + LDS_GTAB);
    const int nunits = tstart[257] * 2, first = vblock();
    const int n_my = first < nunits ? (nunits - first + GRID - 1) / GRID : 0;
    for (int idx = tidx(); idx < n_my * 256; idx += NTHR) {
        const int i = idx >> 8, row = idx & 255, L = first + i * GRID, g = L >> 1, e = find_expert(tstart, g), m0 = (g - tstart[e]) * MOE_BM, cnt = tstart[528 + e];
        int rr = m0 + row; rr = rr < cnt ? rr : cnt - 1;
        rowtab[idx] = e < N_EXP ? a.tokl[(size_t)e * CAP + rr] : rr;
        gtab[idx] = e < N_EXP ? a.gatel[(size_t)e * CAP + rr] : 1.f;
    }
    if (tidx() < 32 && tidx() < n_my) ((int*)(smem + LDS_UTAB))[tidx()] = find_expert(tstart, (first + tidx() * GRID) >> 1);
    __syncthreads();
    GuSched S{(ltab_t)(lds + LDS_TAB), (const LAS int*)(lds + LDS_ROWTAB), (const LAS int*)(lds + LDS_UTAB), a.x1, a.wgut, first, GRID, nunits}; EpiGU E{a.H, (const LAS float*)(lds + LDS_GTAB), (ltab_t)(lds + LDS_TAB)};
    gs::gemm_stream<true, true, 2>(lds, D_MODEL / 2, S, E);
}
struct P7Args { const unsigned char* H; const int* counts; const unsigned char* wdt; unsigned char* Y; };
struct DownSched {
    typedef MoeU U;
    ltab_t tab; const LAS int* utab; const unsigned char* H; const unsigned char* wdt; int first, stride, nunits;
    DI bool next(int i, U& u) const {
        const int L = first + i * stride; if (L >= nunits) return false;
        const int g = L >> 2, e = utab[i];
        u.sub = L & 3; u.e = e; u.ui = i; u.m0 = (g - tab[e]) * MOE_BM;
        u.A = (const char*)(H + (size_t)(tab[264 + e] + u.m0) * D_EXP); u.B = (const char*)(wdt + ((size_t)e * D_MODEL + 256 * u.sub) * D_EXP); return true;
    }
    DI unsigned a_voff(int, int h, int R, int C) const { return (unsigned)((128 * h + R) * (D_EXP / 2) + C) * 2u; }
};
struct EpiDown { unsigned char* Y; ltab_t tab;
    DI void operator()(const f32x4 (&acc)[2][2][4][2], const MoeU& u, int wr, int wc, int fr, int fq) const {
        const int st = tab[264 + u.e], cnt = tab[528 + u.e];
#pragma unroll
        for (int ai = 0; ai < 2; ++ai)
#pragma unroll
            for (int m = 0; m < 4; ++m) {
                const int row = u.m0 + 128 * ai + 64 * wr + 16 * m + fr;
                if (row < cnt) {
                    u32x4 o;
#pragma unroll
                    for (int bj = 0; bj < 2; ++bj) {
                        const f32x4 v0 = acc[ai][bj][m][0] * (YSCALE / (HSCALE * WSCALE)), v1 = acc[ai][bj][m][1] * (YSCALE / (HSCALE * WSCALE));
                        o[2 * bj] = pack_fp8x4(v0[0], v0[1], v0[2], v0[3]); o[2 * bj + 1] = pack_fp8x4(v1[0], v1[1], v1[2], v1[3]);
                    }
                    *(u32x4*)(Y + (size_t)(st + row) * D_MODEL + 256 * u.sub + 64 * wc + 16 * fq) = o;
                }
            }
    } };
DI void phase_moe_down(const P7Args& a, char* smem, LAS unsigned char* lds) {
    build_moe_tab(a.counts, smem);
    const int* tstart = (const int*)(smem + LDS_TAB); const int* rstart = tstart + 264;
    { const int nun = tstart[257] * 4, i = tidx(); if (i < 32 && vblock() + i * GRID < nun) ((int*)(smem + LDS_UTAB))[i] = find_expert(tstart, (vblock() + i * GRID) >> 2); }
    __syncthreads();
    DownSched S{(ltab_t)(lds + LDS_TAB), (const LAS int*)(lds + LDS_UTAB), a.H, a.wdt, vblock(), GRID, tstart[257] * 4}; EpiDown E{a.Y, (ltab_t)(lds + LDS_TAB)};
    gs::gemm_stream<true, true, 2>(lds, D_EXP / 2, S, E);
}
struct P8Args { const bf16_t* x1; const unsigned char* Y; const int* slot; const int* counts; const float* ln_g; const float* ln_b; float* out; };
DI void phase_combine(const P8Args& a, char* lds) {
    const int tid = tidx(), wid = tid >> 6, lane = tid & 63;
    build_moe_tab(a.counts, lds);
    const int* rstart = (const int*)(lds + LDS_TAB) + 264;
    const int sh0 = rstart[256];
    const int c0 = 256 * (lane >> 4) + 32 * ((lane >> 2) & 3) + 8 * (lane & 3);
    for (int t = vblock() * 8 + wid; t < T_TOK; t += GRID * 8) {
        float v[16], w[16];
        { const u32x4 p0 = *(const u32x4*)(a.x1 + (size_t)t * D_MODEL + c0), p1 = *(const u32x4*)(a.x1 + (size_t)t * D_MODEL + c0 + 128); unpack16(p0, p1, v); }
        int sl = 0; if (lane < TOP_K) sl = a.slot[t * TOP_K + lane];
        u32x4 yr[9];
        yr[8] = *(const u32x4*)(a.Y + (size_t)(sh0 + t) * D_MODEL + lane * 16);
#pragma unroll
        for (int k = 0; k < TOP_K; ++k) { const int s = __shfl(sl, k), e = s / CAP, pos = s % CAP; yr[k] = *(const u32x4*)(a.Y + (size_t)(rstart[e] + pos) * D_MODEL + lane * 16); }
#pragma unroll
        for (int i = 0; i < 16; ++i) w[i] = 0.f;
#pragma unroll
        for (int k = 0; k < 9; ++k)
#pragma unroll
            for (int j = 0; j < 4; ++j) { const f32x2 lo = __builtin_amdgcn_cvt_pk_f32_fp8((int)yr[k][j], false), hi = __builtin_amdgcn_cvt_pk_f32_fp8((int)yr[k][j], true); w[4 * j] += lo.x; w[4 * j + 1] += lo.y; w[4 * j + 2] += hi.x; w[4 * j + 3] += hi.y; }
#pragma unroll
        for (int i = 0; i < 16; ++i) v[i] = v[i] * DN_ALPHA + w[i] * (1.f / YSCALE);
        float s = 0.f;
#pragma unroll
        for (int i = 0; i < 16; ++i) s += v[i];
#pragma unroll
        for (int o = 32; o >= 1; o >>= 1) s += __shfl_xor(s, o);
        const float mu = s * (1.f / 1024.f);
        float q = 0.f;
#pragma unroll
        for (int i = 0; i < 16; ++i) { const float d = v[i] - mu; q += d * d; }
#pragma unroll
        for (int o = 32; o >= 1; o >>= 1) q += __shfl_xor(q, o);
        const float rstd = rsqrtf(q * (1.f / 1024.f) + LN_EPS);
#pragma unroll
        for (int j = 0; j < 4; ++j) {
            const int col = c0 + 128 * (j >> 1) + 4 * (j & 1);
            const f32x4 g = *(const f32x4*)(a.ln_g + col), bb = *(const f32x4*)(a.ln_b + col);
            f32x4 o; o[0] = (v[4 * j] - mu) * rstd * g[0] + bb[0]; o[1] = (v[4 * j + 1] - mu) * rstd * g[1] + bb[1]; o[2] = (v[4 * j + 2] - mu) * rstd * g[2] + bb[2]; o[3] = (v[4 * j + 3] - mu) * rstd * g[3] + bb[3];
            *(f32x4*)(a.out + (size_t)t * D_MODEL + col) = o;
        }
    }
}
#define MFMA32(a, b, c) __builtin_amdgcn_mfma_f32_32x32x16_bf16((a), (b), (c), 0, 0, 0)
constexpr float SB_EXIT_THR = 1e-30f;
struct P2Args { const bf16_t* Q; const bf16_t* Kb; const bf16_t* Vt; const float* rel_bias; const float* gain_a; const float* gain_b; bf16_t* y; };

DI bf16x8 pack8(const f32x16& x, int s) {
    u32x4 p;
    if (s == 0) { p.x = cvt_pk_bf16(x[0], x[1]); p.y = cvt_pk_bf16(x[2], x[3]); p.z = cvt_pk_bf16(x[4], x[5]); p.w = cvt_pk_bf16(x[6], x[7]); }
    else        { p.x = cvt_pk_bf16(x[8], x[9]); p.y = cvt_pk_bf16(x[10], x[11]); p.z = cvt_pk_bf16(x[12], x[13]); p.w = cvt_pk_bf16(x[14], x[15]); }
    return __builtin_bit_cast(bf16x8, p);
}
DI void load_k(bf16x8 (&k)[4], const bf16_t* kp, int k0) {
#pragma unroll
    for (int kk = 0; kk < 4; ++kk) k[kk] = *(const bf16x8*)(kp + (size_t)(k0 >> 5) * 2048 + kk * 512);
}
DI void load_v(bf16x8 (&v)[2][2], const bf16_t* vp, int k0) {
#pragma unroll
    for (int dt = 0; dt < 2; ++dt)
#pragma unroll
        for (int s = 0; s < 2; ++s) v[dt][s] = *(const bf16x8*)(vp + (size_t)(k0 >> 5) * 2048 + (dt * 2 + s) * 512);
}

constexpr int LDS_CVT = 16 * 1024;
DI void phase_attn(const P2Args& a, const P0Args& cv, char* lds) {
    const int tid = tidx(), wid = tid >> 6, lane = tid & 63, r = lane & 31, h = lane >> 5;
    float* tbl = (float*)lds;
    float* ssq = (float*)(lds + 8 * 260 * 4);
    __syncthreads();
    for (int i = tid; i < NHA * 257; i += NTHR) { const int hd = i / 257, j = i % 257; tbl[hd * 260 + j] = a.rel_bias[i] * LOG2E; }
    __syncthreads();
    const int cgrp = vblock() % 3;
#pragma unroll 1
    for (int slot = 0; slot < 5; ++slot) {
        if ((cgrp == 0 && slot == 0) || (cgrp == 1 && slot == 2) || (cgrp == 2 && slot == 4)) convert_moe_range(cv, lds + LDS_CVT, 0, CV_GU);
        if (slot == 4) break;
        const int u = vblock() + GRID * (slot >> 1) + 2 * GRID * (slot & 1);
        const bool isB = u >= BATCH * (SEQ / 64); const int uu = isB ? u - BATCH * (SEQ / 64) : u;
        const int b = uu / (SEQ / 64), c = uu % (SEQ / 64), q0 = c * 64, hh = (isB ? NHA : 0) + wid;
        const size_t hb = (size_t)(b * NHH + hh) * SEQ * 64;
        const bf16_t* kp = a.Kb + hb + lane * 8;
        const bf16_t* vp = a.Vt + hb + lane * 8;
        bf16x8 qf[2][4];
#pragma unroll
        for (int qt = 0; qt < 2; ++qt)
#pragma unroll
            for (int kk = 0; kk < 4; ++kk) qf[qt][kk] = *(const bf16x8*)(a.Q + hb + (size_t)((q0 >> 5) + qt) * 2048 + kk * 512 + lane * 8);
        f32x16 ot[2][2];
#pragma unroll
        for (int dt = 0; dt < 2; ++dt)
#pragma unroll
            for (int qt = 0; qt < 2; ++qt)
#pragma unroll
                for (int i = 0; i < 16; ++i) ot[dt][qt][i] = 0.f;
        float linv[2] = {1.f, 1.f};
        if (!isB) {
            float mrun[2] = {-INFINITY, -INFINITY}, lrun[2] = {0.f, 0.f};
            const int klo = q0 - LEFT_CHUNKS * CHUNK < 0 ? 0 : q0 - LEFT_CHUNKS * CHUNK, khi = q0 + 64;
            const float cfar = tbl[wid * 260 + 256];
            bf16x8 kc[4], kn[4], vf[2][2]; load_k(kc, kp, klo);
            for (int k0 = klo; k0 < khi; k0 += 32) {
                load_v(vf, vp, k0);
                load_k(kn, kp, k0 + 32 < khi ? k0 + 32 : k0);
#pragma unroll
                for (int qt = 0; qt < 2; ++qt) {
                    bf16x8 pf[2];
                    f32x16 st;
#pragma unroll
                    for (int i = 0; i < 16; ++i) st[i] = 0.f;
#pragma unroll
                    for (int kk = 0; kk < 4; ++kk) st = MFMA32(kc[kk], qf[qt][kk], st);
                    const int dmin = q0 + 32 * qt - k0 - 31;
                    float boff = 0.f;
                    if (dmin >= MAX_REL) boff = cfar;
                    else {
                        const int bidx = q0 + 32 * qt + r - k0 - 4 * h + MAX_REL;
#pragma unroll
                        for (int i = 0; i < 16; ++i) { int ix = bidx - ((i & 3) + 8 * (i >> 2)); ix = ix < 0 ? 0 : (ix > 2 * MAX_REL ? 2 * MAX_REL : ix); st[i] += tbl[wid * 260 + ix]; }
                    }
                    float mx = st[0];
#pragma unroll
                    for (int i = 1; i < 16; ++i) mx = fmaxf(mx, st[i]);
                    mx = fmaxf(mx, __shfl_xor(mx, 32)) + boff;
                    const float mo = mrun[qt], mn = fmaxf(mo, mx);
                    mrun[qt] = mn;
                    const float eo = boff - mn;
                    float ps = 0.f;
#pragma unroll
                    for (int i = 0; i < 16; ++i) { st[i] = __builtin_amdgcn_exp2f(st[i] + eo); ps += st[i]; }
                    if (__all(mn == mo)) lrun[qt] += ps;
                    else {
                        const float alpha = __builtin_amdgcn_exp2f(mo - mn);
                        lrun[qt] = lrun[qt] * alpha + ps;
#pragma unroll
                        for (int i = 0; i < 16; ++i) { ot[0][qt][i] *= alpha; ot[1][qt][i] *= alpha; }
                    }
                    pf[0] = pack8(st, 0); pf[1] = pack8(st, 1);
#pragma unroll
                    for (int dt = 0; dt < 2; ++dt)
#pragma unroll
                        for (int s = 0; s < 2; ++s) ot[dt][qt] = MFMA32(vf[dt][s], pf[s], ot[dt][qt]);
                }
#pragma unroll
                for (int kk = 0; kk < 4; ++kk) kc[kk] = kn[kk];
            }
#pragma unroll
            for (int qt = 0; qt < 2; ++qt) { const float lt = lrun[qt] + __shfl_xor(lrun[qt], 32); linv[qt] = 1.f / lt; }
        } else {
            float carry[2] = {1.f, 1.f};
            bf16x8 kc[4], kn[4], vf[2][2]; load_k(kc, kp, q0 + 32);
            for (int k0 = q0 + 32; k0 >= 0; k0 -= 32) {
                load_v(vf, vp, k0);
                load_k(kn, kp, k0 >= 32 ? k0 - 32 : k0);
#pragma unroll
                for (int qt = 0; qt < 2; ++qt) {
                    bf16x8 pf[2];
                    f32x16 st;
#pragma unroll
                    for (int i = 0; i < 16; ++i) st[i] = 0.f;
                    const bool none = (k0 > q0 + 32 * qt + 30);
                    if (!none) {
#pragma unroll
                        for (int kk = 0; kk < 4; ++kk) st = MFMA32(kc[kk], qf[qt][kk], st);
                        const bool full = (k0 + 31 < q0 + 32 * qt);
                        const int lim = q0 + 32 * qt + r - k0 - 4 * h;
                        float om[16];
#pragma unroll
                        for (int i = 0; i < 16; ++i) {
                            const float e = __builtin_amdgcn_exp2f(-st[i]); float bta = __builtin_amdgcn_rcpf(1.f + e);
                            if (!full && !(((i & 3) + 8 * (i >> 2)) < lim)) bta = 0.f;
                            st[i] = bta; om[i] = 1.f - bta;
                        }
                        float G[4], Go[4];
#pragma unroll
                        for (int g = 0; g < 4; ++g) { G[g] = (om[4 * g] * om[4 * g + 1]) * (om[4 * g + 2] * om[4 * g + 3]); Go[g] = __shfl_xor(G[g], 32); }
                        float R = carry[qt];
#pragma unroll
                        for (int g = 3; g >= 0; --g) {
                            float run = h == 0 ? R * Go[g] : R;
#pragma unroll
                            for (int uu2 = 3; uu2 >= 0; --uu2) { const float bta = st[4 * g + uu2]; st[4 * g + uu2] = bta * run; run *= om[4 * g + uu2]; }
                            R = R * (G[g] * Go[g]);
                        }
                        carry[qt] = R;
                    }
                    if (!none) {
                        pf[0] = pack8(st, 0); pf[1] = pack8(st, 1);
#pragma unroll
                        for (int dt = 0; dt < 2; ++dt)
#pragma unroll
                            for (int s = 0; s < 2; ++s) ot[dt][qt] = MFMA32(vf[dt][s], pf[s], ot[dt][qt]);
                    }
                }
#pragma unroll
                for (int kk = 0; kk < 4; ++kk) kc[kk] = kn[kk];
                if (__all(carry[0] < SB_EXIT_THR && carry[1] < SB_EXIT_THR)) break;
            }
        }
        float ss[2];
#pragma unroll
        for (int qt = 0; qt < 2; ++qt) {
            float s2 = 0.f;
#pragma unroll
            for (int dt = 0; dt < 2; ++dt)
#pragma unroll
                for (int i = 0; i < 16; ++i) { ot[dt][qt][i] *= linv[qt]; s2 += ot[dt][qt][i] * ot[dt][qt][i]; }
            s2 += __shfl_xor(s2, 32); ss[qt] = s2;
        }
        __syncthreads();
        if (h == 0) { ssq[wid * 64 + r] = ss[0]; ssq[wid * 64 + 32 + r] = ss[1]; }
        __syncthreads();
        const float* gain = isB ? a.gain_b : a.gain_a;
#pragma unroll
        for (int qt = 0; qt < 2; ++qt) {
            float tot = 0.f;
#pragma unroll
            for (int w8 = 0; w8 < 8; ++w8) tot += ssq[w8 * 64 + 32 * qt + r];
            const float rs = rsqrtf(tot * (1.f / 512.f) + RMS_EPS);
            char* yst = lds + LDS_CVT + wid * (64 * 136);
#pragma unroll
            for (int dt = 0; dt < 2; ++dt)
#pragma unroll
                for (int g = 0; g < 4; ++g) {
                    const int d = 32 * dt + 8 * g + 4 * h; const f32x4 gn = *(const f32x4*)(gain + wid * 64 + d);
                    u32x2 o; o.x = cvt_pk_bf16(ot[dt][qt][4 * g] * rs * gn[0], ot[dt][qt][4 * g + 1] * rs * gn[1]); o.y = cvt_pk_bf16(ot[dt][qt][4 * g + 2] * rs * gn[2], ot[dt][qt][4 * g + 3] * rs * gn[3]);
                    *(u32x2*)(yst + (32 * qt + r) * 136 + d * 2) = o;
                }
        }
        {
            char* yst = lds + LDS_CVT + wid * (64 * 136);
            bf16_t* yb = a.y + (size_t)(b * SEQ + q0) * D_MODEL + (isB ? 512 : 0) + wid * 64;
#pragma unroll
            for (int j = 0; j < 8; ++j) {
                const int tok = (lane >> 3) + 8 * j, ch = lane & 7;
                const u32x2 lo = *(const u32x2*)(yst + tok * 136 + ch * 16), hi = *(const u32x2*)(yst + tok * 136 + ch * 16 + 8);
                *(u32x4*)(yb + (size_t)tok * D_MODEL + ch * 8) = (u32x4){lo.x, lo.y, hi.x, hi.y};
            }
        }
    }
}


#define XB_TMO      128
#define XB_XCNT(j)  (256  + 64 * (j))
#define XB_XSUB(j)  (1280 + 64 * (j))
#define XB_XGEN(j)  (2304 + 64 * (j))
#define XB_TOP      3328
#define XB_TOPGEN   3392
#define XCD_BAR_WORDS 3456
#define XB_SPIN_CAP (1u << 18)
#define LAS __attribute__((address_space(3)))

__device__ __forceinline__ unsigned xb_ld(unsigned* p)              { return __hip_atomic_load(p, __ATOMIC_RELAXED, __HIP_MEMORY_SCOPE_AGENT); }
__device__ __forceinline__ unsigned xb_add(unsigned* p, unsigned v) { return __hip_atomic_fetch_add(p, v, __ATOMIC_RELAXED, __HIP_MEMORY_SCOPE_AGENT); }
__device__ __forceinline__ unsigned xb_xcc_id() { return (unsigned)__builtin_amdgcn_s_getreg((3 << 11) | 20) & 0xFu; }
#define XB_SPIN(cond, bar) do { unsigned _sp = 0; while (cond) { __builtin_amdgcn_s_sleep(1); \
    if ((++_sp & 255u) == 0u) { if (xb_ld(&(bar)[XB_TMO])) break; if (_sp > XB_SPIN_CAP) { atomicAdd(&(bar)[XB_TMO], 1u); break; } } } } while (0)

struct XcdBarrier {
    unsigned* bar; unsigned x;
    volatile LAS unsigned* st;
};

__device__ __forceinline__ XcdBarrier xcd_barrier_post(unsigned* bar, volatile LAS unsigned* st) {
    XcdBarrier b; b.bar = bar; b.x = xb_xcc_id(); b.st = st;
    if (threadIdx.x == 0) (void)xb_add(&bar[XB_XCNT(b.x)], 1u);
    return b;
}
__device__ __forceinline__ void xcd_barrier_complete(unsigned* bar, unsigned x, unsigned& nloc, unsigned& nx) {
    const unsigned G = gridDim.x * gridDim.y * gridDim.z;
    unsigned sum, cnt, mine, sp = 0u;
    for (;;) {
        sum = 0u; cnt = 0u; mine = 0u;
#pragma unroll
        for (unsigned j = 0; j < 16; ++j) { const unsigned c = xb_ld(&bar[XB_XCNT(j)]); sum += c; cnt += (c > 0u) ? 1u : 0u; mine = (j == x) ? c : mine; }
        if (sum == G) break;
        __builtin_amdgcn_s_sleep(1);
        if ((++sp & 255u) == 0u) { if (xb_ld(&bar[XB_TMO])) break; if (sp > XB_SPIN_CAP) { atomicAdd(&bar[XB_TMO], 1u); break; } }
    }
    nloc = mine > 0u ? mine : 1u; nx = cnt > 0u ? cnt : 1u;
}

__device__ __forceinline__ void xcd_barrier(const XcdBarrier& b) {
    asm volatile("s_waitcnt vmcnt(0)" ::: "memory");
    __syncthreads();
    if (threadIdx.x == 0) {
        unsigned* bar = b.bar;
        __builtin_amdgcn_s_waitcnt(0);
        unsigned nloc = b.st[0], nx = b.st[1];
        if (nloc == 0u) { xcd_barrier_complete(bar, b.x, nloc, nx); b.st[0] = nloc; b.st[1] = nx; }
        const unsigned old = xb_add(&bar[XB_XSUB(b.x)], 1u);
        const unsigned gen = old / nloc;
        if (old + 1u == (gen + 1u) * nloc) {
            __builtin_amdgcn_fence(__ATOMIC_RELEASE, "agent");
            asm volatile("s_waitcnt vmcnt(0)" ::: "memory");
            const unsigned og = xb_add(&bar[XB_TOP], 1u);
            const unsigned tg = og / nx;
            if (og + 1u == (tg + 1u) * nx) xb_add(&bar[XB_TOPGEN], 1u);
            else XB_SPIN(xb_ld(&bar[XB_TOPGEN]) == tg, bar);
            __builtin_amdgcn_fence(__ATOMIC_ACQUIRE, "agent");
            xb_add(&bar[XB_XGEN(b.x)], 1u);
            asm volatile("s_waitcnt vmcnt(0)" ::: "memory");
        } else {
            XB_SPIN(xb_ld(&bar[XB_XGEN(b.x)]) == gen, bar);
            __builtin_amdgcn_fence(__ATOMIC_ACQUIRE, "agent");
            asm volatile("s_waitcnt vmcnt(0)" ::: "memory");
        }
    }
    __syncthreads();
}


struct MegaArgs { P0Args p0; P1Args p1; P2Args p2; P3Args p3; P4Args p4; P6Args p6; P7Args p7; P8Args p8; unsigned* bar; };
__global__ __launch_bounds__(NTHR, 2) void k_mega(MegaArgs a) {
    extern __shared__ __attribute__((aligned(16))) char smem[];
    volatile LAS unsigned* xbw = (volatile LAS unsigned*)(smem + LDS_BYTES - 16);
    if (threadIdx.x == 0) { xbw[0] = 0u; xbw[1] = 0u; xbw[2] = 0u; xbw[3] = 0u; }
    __syncthreads();
    XcdBarrier bar = xcd_barrier_post(a.bar, xbw);
    LAS unsigned char* L = (LAS unsigned char*)smem;
    phase_prologue(a.p0, smem);     xcd_barrier(bar);
    phase_qkv(a.p1, L);             xcd_barrier(bar);
    phase_attn(a.p2, a.p0, smem);   xcd_barrier(bar);
    phase_outproj(a.p3, L);         xcd_barrier(bar);
    phase_router(a.p4, a.p0, smem); xcd_barrier(bar);
    phase_moe_gu(a.p6, smem, L);    xcd_barrier(bar);
    phase_moe_down(a.p7, smem, L);  xcd_barrier(bar);
    phase_combine(a.p8, smem);
}

extern "C" void kernel_launch(void* const* d_in, const int* in_sizes, int n_in, void* d_out, int out_size, void* d_ws, size_t ws_size, hipStream_t stream) {
    const float* x = (const float*)d_in[0];      const float* w_in = (const float*)d_in[1];   const float* rel_bias = (const float*)d_in[2];
    const float* gain_a = (const float*)d_in[3]; const float* gain_b = (const float*)d_in[4]; const float* w_out = (const float*)d_in[5];
    const float* ln1_g = (const float*)d_in[6];  const float* ln1_b = (const float*)d_in[7];  const float* router_w = (const float*)d_in[8];
    const float* router_bias = (const float*)d_in[9]; const float* w_gate = (const float*)d_in[10]; const float* w_up = (const float*)d_in[11];
    const float* w_down = (const float*)d_in[12]; const float* ws_gate = (const float*)d_in[13]; const float* ws_up = (const float*)d_in[14];
    const float* ws_down = (const float*)d_in[15]; const float* ln2_g = (const float*)d_in[16]; const float* ln2_b = (const float*)d_in[17];
    char* ws = (char*)d_ws; float* out = (float*)d_out;
    int* ctrl = (int*)(ws + OFF_CTRL); int* counts = ctrl + CW_COUNTS;
    bf16_t* X1 = (bf16_t*)(ws + OFF_X1); int* tokl = (int*)(ws + OFF_TOKL); float* gatel = (float*)(ws + OFF_GATEL);
    int* eidx = (int*)(ws + OFF_EIDX); float* gate = (float*)(ws + OFF_GATE); int* slot = (int*)(ws + OFF_SLOT);
    unsigned char* H = (unsigned char*)(ws + OFF_H); unsigned char* Y = (unsigned char*)(ws + OFF_Y); unsigned char* x1f8 = (unsigned char*)(ws + OFF_X1F8);
    bf16_t* Q = (bf16_t*)(ws + OFF_Q); bf16_t* Kb = (bf16_t*)(ws + OFF_K); bf16_t* Vt = (bf16_t*)(ws + OFF_VT);
    bf16_t* yatt = (bf16_t*)(ws + OFF_YATT); bf16_t* r = (bf16_t*)(ws + OFF_R);
    bf16_t* xb = (bf16_t*)(ws + OFF_XB); float* stats = (float*)(ws + OFF_STATS);
    bf16_t* wt_in = (bf16_t*)(ws + OFF_WTIN); bf16_t* wt_out = (bf16_t*)(ws + OFF_WTOUT); bf16_t* wt_r = (bf16_t*)(ws + OFF_WTR);
    unsigned char* wgut = (unsigned char*)(ws + OFF_WGUT); unsigned char* wdt = (unsigned char*)(ws + OFF_WDT);
    if (ws_size < WS_NEEDED) { fprintf(stderr, "kernel_launch: workspace too small (%zu < %zu)\n", ws_size, (size_t)WS_NEEDED); return; }
    hipMemsetAsync(ctrl, 0, 128 * 1024, stream);
    static bool attr_done = false;
    if (!attr_done) {
        hipFuncSetAttribute((const void*)k_mega, hipFuncAttributeMaxDynamicSharedMemorySize, LDS_BYTES);
        attr_done = true;
    }
    MegaArgs m{};
    m.p0 = P0Args{x, w_in, w_out, router_w, xb, wt_in, wt_out, wt_r, w_gate, w_up, w_down, ws_gate, ws_up, ws_down, wgut, wdt};
    m.p1 = P1Args{xb, wt_in, Q, Kb, Vt};
    m.p2 = P2Args{Q, Kb, Vt, rel_bias, gain_a, gain_b, yatt};
    m.p3 = P3Args{yatt, wt_out, xb, r, stats};
    m.p4 = P4Args{r, stats, ln1_g, ln1_b, X1, x1f8, wt_r, router_bias, eidx, gate, counts, tokl, gatel, slot};
    m.p6 = P6Args{x1f8, counts, tokl, gatel, wgut, H};
    m.p7 = P7Args{H, counts, wdt, Y};
    m.p8 = P8Args{X1, Y, slot, counts, ln2_g, ln2_b, out};
    m.bar = (unsigned*)ctrl;
    k_mega<<<GRID, NTHR, LDS_BYTES, stream>>>(m);
}
```

```cpp
#include <hip/hip_runtime.h>
#include <cstdint>
#include <cstdio>

typedef unsigned short bf16_t;

constexpr int D_MODEL = 1024, BATCH = 16, SEQ = 2048, T_TOK = BATCH * SEQ;
constexpr int HEAD_DIM = 64, NHA = 8, NHB = 8, NHH = 16;
constexpr int CHUNK = 64, LEFT_CHUNKS = 8, MAX_REL = 128;
constexpr int N_EXP = 256, TOP_K = 8, N_GROUPS = 8, TOPK_GROUPS = 4, EPG = 32, D_EXP = 256;
constexpr float ROUTED_SCALE = 2.5f, LN_EPS = 1e-5f, RMS_EPS = 1e-6f;
constexpr float DN_ALPHA = 1.189207115002721f;
constexpr float LOG2E = 1.4426950408889634f, LN2 = 0.6931471805599453f;
constexpr float QSCALE = 0.125f * LOG2E;
constexpr float WSCALE = 64.f, XSCALE = 16.f, HSCALE = 16.f;
constexpr float YSCALE = 64.f;
constexpr int CAP = T_TOK;
constexpr int ROWS_ALL = T_TOK * TOP_K + T_TOK;

__device__ __forceinline__ float bf2f(bf16_t v) { return __uint_as_float(((unsigned)v) << 16); }
__device__ __forceinline__ bf16_t f2bf(float f) { unsigned u = __float_as_uint(f); u += 0x7fffu + ((u >> 16) & 1u); return (bf16_t)(u >> 16); }

constexpr size_t MB = 1024ull * 1024ull;
constexpr size_t OFF_CTRL   = 0;
constexpr size_t OFF_X1     = 1 * MB;
constexpr size_t OFF_TOKL   = OFF_X1 + 64 * MB;
constexpr size_t OFF_GATEL  = OFF_TOKL + 32 * MB;
constexpr size_t OFF_EIDX   = OFF_GATEL + 32 * MB;
constexpr size_t OFF_GATE   = OFF_EIDX + 1 * MB;
constexpr size_t OFF_SLOT   = OFF_GATE + 1 * MB;
constexpr size_t OFF_WDT    = OFF_SLOT + 1 * MB;
constexpr size_t OFF_X1F8   = OFF_WDT + 72 * MB;
constexpr size_t OFF_BIG    = OFF_WDT + 129 * MB;
constexpr size_t OFF_H      = OFF_BIG;
constexpr size_t OFF_Y      = OFF_BIG + 144 * MB;
constexpr size_t OFF_Q      = OFF_BIG;
constexpr size_t OFF_K      = OFF_BIG + 64 * MB;
constexpr size_t OFF_VT     = OFF_BIG + 128 * MB;
constexpr size_t OFF_YATT   = OFF_BIG + 192 * MB;
constexpr size_t OFF_R      = OFF_BIG + 256 * MB;
constexpr size_t OFF_XB     = OFF_BIG + 320 * MB;
constexpr size_t OFF_STATS  = OFF_BIG + 384 * MB;
constexpr size_t OFF_WTIN   = OFF_BIG + 392 * MB;
constexpr size_t OFF_WTOUT  = OFF_BIG + 398 * MB;
constexpr size_t OFF_WTR    = OFF_BIG + 400 * MB;
constexpr size_t OFF_WGUT   = OFF_BIG + 401 * MB;
constexpr size_t WS_NEEDED  = OFF_BIG + 720 * MB;
static_assert(OFF_WGUT + 257 * MB <= WS_NEEDED && WS_NEEDED <= 1024 * MB, "workspace map");
constexpr int CW_COUNTS = 8192;
constexpr int CSTR = 64;

typedef short bf16x8 __attribute__((ext_vector_type(8)));
typedef float f32x4 __attribute__((ext_vector_type(4)));
typedef float f32x2 __attribute__((ext_vector_type(2)));
typedef float f32x16 __attribute__((ext_vector_type(16)));
typedef unsigned u32x4 __attribute__((ext_vector_type(4)));
typedef unsigned u32x2 __attribute__((ext_vector_type(2)));
#define DI __device__ __forceinline__
constexpr int NTHR = 512, GRID = 256;
DI int tidx() { int t = threadIdx.x; asm volatile("" : "+v"(t)); return t; }
constexpr int LDS_BYTES = 160 * 1024;

typedef __bf16 bf16x2_t __attribute__((ext_vector_type(2)));
DI unsigned cvt_pk_bf16(float lo, float hi) { f32x2 v = {lo, hi}; bf16x2_t r = __builtin_convertvector(v, bf16x2_t); return __builtin_bit_cast(unsigned, r); }
DI float clamp8(float v) { return __builtin_amdgcn_fmed3f(v, -440.f, 440.f); }
DI unsigned pack_fp8x4(float a, float b, float c, float d) { int w = 0; w = __builtin_amdgcn_cvt_pk_fp8_f32(clamp8(a), clamp8(b), w, false); w = __builtin_amdgcn_cvt_pk_fp8_f32(clamp8(c), clamp8(d), w, true); return (unsigned)w; }
DI int vblock() { return (int)((blockIdx.x & 7) * (GRID / 8) + (blockIdx.x >> 3)); }

template <int MT> struct Tile { static constexpr int BM = 32 * MT, A_BYTES = BM * 128, B_BYTES = 256 * 128, STAGE = A_BYTES + B_BYTES; };

template <int MT> struct ALoader {
    const bf16_t* p[MT / 2]; u32x4 v[MT / 2]; int off0;
    DI void init_rows(const bf16_t* A, int lda, int row0) {
        const int tid = tidx(), kc = tid & 7, r = tid >> 3;
#pragma unroll
        for (int i = 0; i < MT / 2; ++i) p[i] = A + (size_t)(row0 + r + 64 * i) * lda + kc * 8;
        off0 = r * 128 + ((kc ^ ((r >> 1) & 7)) << 4);
    }
    DI void init_gather(const bf16_t* A, int lda, const int* rows, int cnt, int m0) {
        const int tid = tidx(), kc = tid & 7, r = tid >> 3;
#pragma unroll
        for (int i = 0; i < MT / 2; ++i) { int rr = m0 + r + 64 * i; rr = rr < cnt ? rr : cnt - 1; const int g = rows ? rows[rr] : rr; p[i] = A + (size_t)g * lda + kc * 8; }
        off0 = r * 128 + ((kc ^ ((r >> 1) & 7)) << 4);
    }
    DI void load(int k0) {
#pragma unroll
        for (int i = 0; i < MT / 2; ++i) v[i] = *(const u32x4*)(p[i] + k0);
    }
    DI void store(char* ldsA) const {
#pragma unroll
        for (int i = 0; i < MT / 2; ++i) *(u32x4*)(ldsA + off0 + i * 8192) = v[i];
    }
};
struct BLoaderBt {
    const bf16_t* p[4]; u32x4 v[4]; int off0;
    DI void init(const bf16_t* Bt, int ldk, int n0) {
        const int tid = tidx(), kc = tid & 7, r = tid >> 3;
#pragma unroll
        for (int i = 0; i < 4; ++i) p[i] = Bt + (size_t)(n0 + r + 64 * i) * ldk + kc * 8;
        off0 = r * 128 + ((kc ^ ((r >> 1) & 7)) << 4);
    }
    DI void load(int k0) {
#pragma unroll
        for (int i = 0; i < 4; ++i) v[i] = *(const u32x4*)(p[i] + k0);
    }
    DI void store(char* ldsB) const {
#pragma unroll
        for (int i = 0; i < 4; ++i) *(u32x4*)(ldsB + off0 + i * 8192) = v[i];
    }
};
template <int MT, bool TR, class AL, class BL>
DI void gemm_tile(char* lds, AL& al, BL& bl, int nk, f32x4 (&acc)[MT][4]) {
    typedef Tile<MT> TT;
    const int tid = tidx(), wid = tid >> 6, lane = tid & 63, wr = wid >> 2, wc = wid & 3, fr = lane & 15, fq = lane >> 4;
#pragma unroll
    for (int m = 0; m < MT; ++m)
#pragma unroll
        for (int n = 0; n < 4; ++n) acc[m][n] = (f32x4){0.f, 0.f, 0.f, 0.f};
    int aoff[2], boff[2];
#pragma unroll
    for (int ks = 0; ks < 2; ++ks) { const int ch = (((4 * ks + fq) ^ (fr >> 1)) << 4); aoff[ks] = (16 * MT * wr + fr) * 128 + ch; boff[ks] = TT::A_BYTES + (64 * wc + fr) * 128 + ch; }
    al.load(0); bl.load(0);
    __syncthreads();
    al.store(lds); bl.store(lds + TT::A_BYTES);
    __syncthreads();
    for (int kt = 0; kt < nk; ++kt) {
        char* cur = lds + (kt & 1) * TT::STAGE; char* nxt = lds + ((kt & 1) ^ 1) * TT::STAGE;
        const bool more = kt + 1 < nk;
        if (more) { al.load((kt + 1) * 64); bl.load((kt + 1) * 64); }
#pragma unroll
        for (int ks = 0; ks < 2; ++ks) {
            bf16x8 a[MT], b[4];
#pragma unroll
            for (int m = 0; m < MT; ++m) a[m] = *(const bf16x8*)(cur + aoff[ks] + m * 2048);
#pragma unroll
            for (int n = 0; n < 4; ++n) b[n] = *(const bf16x8*)(cur + boff[ks] + n * 2048);
#pragma unroll
            for (int m = 0; m < MT; ++m)
#pragma unroll
                for (int n = 0; n < 4; ++n)
                    acc[m][n] = TR ? __builtin_amdgcn_mfma_f32_16x16x32_bf16(b[n], a[m], acc[m][n], 0, 0, 0) : __builtin_amdgcn_mfma_f32_16x16x32_bf16(a[m], b[n], acc[m][n], 0, 0, 0);
        }
        if (more) { al.store(nxt); bl.store(nxt + TT::A_BYTES); }
        __syncthreads();
    }
}

#define LAS __attribute__((address_space(3)))
namespace gs {
constexpr int BM = 256, BK = 64, HALF = 128, HTB = HALF * BK * 2, STAGE_BYTES = 8 * HTB;
DI int lds_byte(int r, int c) { const int st = (r >> 4) * 2 + (c >> 5), rr = r & 15, cc = c & 31, ob = rr * 64 + cc * 2; return st * 1024 + (ob ^ (((ob >> 9) & 1) << 5)); }
DI void stage_rc(int b, int& R, int& C) { const int st = b / 1024, sb = b % 1024, swz = sb ^ (((sb >> 9) & 1) << 5); R = (st >> 1) * 16 + swz / 64; C = (st & 1) * 32 + (swz % 64) / 2; }
DI int perm32(int rho) { const int n = rho >> 4, i = rho & 15; return 8 * (i >> 2) + 4 * n + (i & 3); }
typedef long i64x2 __attribute__((ext_vector_type(2)));
DI const char* uni(const char* p) { const unsigned long long v = (unsigned long long)p; const unsigned lo = __builtin_amdgcn_readfirstlane((unsigned)v), hi = __builtin_amdgcn_readfirstlane((unsigned)(v >> 32)); return (const char*)(((unsigned long long)hi << 32) | lo); }
template <bool TR, bool F8>
DI f32x4 mma16(const bf16x8& a, const bf16x8& b, f32x4 c) {
    if (F8) {
        const i64x2 a2 = __builtin_bit_cast(i64x2, a), b2 = __builtin_bit_cast(i64x2, b);
        c = TR ? __builtin_amdgcn_mfma_f32_16x16x32_fp8_fp8(b2[0], a2[0], c, 0, 0, 0) : __builtin_amdgcn_mfma_f32_16x16x32_fp8_fp8(a2[0], b2[0], c, 0, 0, 0);
        return TR ? __builtin_amdgcn_mfma_f32_16x16x32_fp8_fp8(b2[1], a2[1], c, 0, 0, 0) : __builtin_amdgcn_mfma_f32_16x16x32_fp8_fp8(a2[1], b2[1], c, 0, 0, 0);
    }
    return TR ? __builtin_amdgcn_mfma_f32_16x16x32_bf16(b, a, c, 0, 0, 0) : __builtin_amdgcn_mfma_f32_16x16x32_bf16(a, b, c, 0, 0, 0);
}
typedef int i32x8 __attribute__((ext_vector_type(8)));
typedef short bf16x16 __attribute__((ext_vector_type(16)));
template <bool TR>
DI f32x4 mma128(const bf16x16& a, const bf16x16& b, f32x4 c) {
    const i32x8 av = __builtin_bit_cast(i32x8, a), bv = __builtin_bit_cast(i32x8, b);
    const int one = 0x7F7F7F7F;
    if (TR) asm volatile("v_mfma_scale_f32_16x16x128_f8f6f4 %0, %1, %2, %0, %3, %3 op_sel_hi:[0,0,0]" : "+v"(c) : "v"(bv), "v"(av), "v"(one));
    else    asm volatile("v_mfma_scale_f32_16x16x128_f8f6f4 %0, %1, %2, %0, %3, %3 op_sel_hi:[0,0,0]" : "+v"(c) : "v"(av), "v"(bv), "v"(one));
    return c;
}
DI bf16x8 frag_lo(const bf16x16& v) { return __builtin_shufflevector(v, v, 0, 1, 2, 3, 4, 5, 6, 7); }
DI bf16x8 frag_hi(const bf16x16& v) { return __builtin_shufflevector(v, v, 8, 9, 10, 11, 12, 13, 14, 15); }
template <bool TR, bool PERM, int F8, class Sched, class Epi>
DI void gemm_stream(LAS unsigned char* lds, const int K, const Sched& S, const Epi& E) {
    typedef typename Sched::U U;
    const int tid = tidx(), wid = __builtin_amdgcn_readfirstlane(tid >> 6), lane = tid & 63, wr = wid >> 2, wc = wid & 3, fr = lane & 15, fq = lane >> 4;
    const int nt = K / BK;
    int R[2], C[2]; unsigned voffB[2];
#pragma unroll
    for (int i = 0; i < 2; ++i) { stage_rc(tid * 16 + i * 8192, R[i], C[i]); const int Rb = PERM ? ((R[i] & ~31) + perm32(R[i] & 31)) : R[i]; voffB[i] = (unsigned)(Rb * K + C[i]) * 2u; }
    const size_t kstep = (size_t)(BK * 2), hstepB = (size_t)HALF * K * 2;
    const unsigned ldsw = (unsigned)wid * 1024u;
    const int aoff = lds_byte(wr * 64 + fr, fq * 8), boff = lds_byte(wc * 32 + fr, fq * 8);
#define GS_SA(b, h) (((b) * 2 + (h)) * HTB)
#define GS_SB(b, h) ((4 + (b) * 2 + (h)) * HTB)
#define GS_STAGE(bufoff, gbase, uix, h) do { _Pragma("unroll") for (int _i = 0; _i < 2; ++_i) \
        __builtin_amdgcn_global_load_lds((const unsigned*)((const char*)(gbase) + S.a_voff(uix, h, R[_i], C[_i])), (LAS unsigned*)(lds + (bufoff) + ldsw + _i * 8192), 16, 0, 0); } while (0)
#define GS_STAGEB(bufoff, gbase, voff) do { _Pragma("unroll") for (int _i = 0; _i < 2; ++_i) \
        __builtin_amdgcn_global_load_lds((const unsigned*)((const char*)(gbase) + (voff)[_i]), (LAS unsigned*)(lds + (bufoff) + ldsw + _i * 8192), 16, 0, 0); } while (0)
#define GS_LD32(base) __builtin_shufflevector(*(const LAS bf16x8*)(base), *(const LAS bf16x8*)((base) + 1024), 0, 1, 2, 3, 4, 5, 6, 7, 8, 9, 10, 11, 12, 13, 14, 15)
#define GS_LDA(dst, b, h) do { _Pragma("unroll") for (int m = 0; m < 4; ++m) dst[m] = GS_LD32(lds + GS_SA(b, h) + aoff + m * 2048); } while (0)
#define GS_LDB(dst, b, h) do { _Pragma("unroll") for (int n = 0; n < 2; ++n) dst[n] = GS_LD32(lds + GS_SB(b, h) + boff + n * 2048); } while (0)
#define GS_MMA(ai, bj, At, Bt) do { __builtin_amdgcn_s_setprio(1); _Pragma("unroll") for (int m = 0; m < 4; ++m) _Pragma("unroll") for (int n = 0; n < 2; ++n) { \
        if (F8 == 2) acc[ai][bj][m][n] = mma128<TR>(At[m], Bt[n], acc[ai][bj][m][n]); \
        else { acc[ai][bj][m][n] = mma16<TR, F8 == 1>(frag_lo(At[m]), frag_lo(Bt[n]), acc[ai][bj][m][n]); acc[ai][bj][m][n] = mma16<TR, F8 == 1>(frag_hi(At[m]), frag_hi(Bt[n]), acc[ai][bj][m][n]); } } \
        __builtin_amdgcn_s_setprio(0); } while (0)
#define GS_WAIT_V(n) asm volatile("s_waitcnt vmcnt(" #n ")" ::: "memory")
#define GS_WAIT_L(n) asm volatile("s_waitcnt lgkmcnt(" #n ")" ::: "memory")
#define GS_BAR __builtin_amdgcn_s_barrier()
#define GS_SCHED __builtin_amdgcn_sched_barrier(0)
    U cur, nxt; int ui = 0;
    if (!S.next(0, cur)) return;
    f32x4 acc[2][2][4][2];
#pragma unroll
    for (int a = 0; a < 2; ++a)
#pragma unroll
        for (int b = 0; b < 2; ++b)
#pragma unroll
            for (int m = 0; m < 4; ++m)
#pragma unroll
                for (int n = 0; n < 2; ++n) acc[a][b][m][n] = (f32x4){0.f, 0.f, 0.f, 0.f};
    bf16x16 At[4], B0[2], B1[2];
    const char* cA = uni(cur.A); const char* cB = uni(cur.B);
    GS_STAGEB(GS_SB(0, 0), cB, voffB); GS_STAGEB(GS_SB(0, 1), cB + hstepB, voffB); GS_STAGE(GS_SA(0, 0), cA, 0, 0); GS_STAGE(GS_SA(0, 1), cA, 0, 1);
    if (wr == 1) GS_BAR;
    GS_WAIT_V(2); GS_BAR;
    GS_STAGEB(GS_SB(1, 0), cB + kstep, voffB); GS_STAGE(GS_SA(1, 0), cA + kstep, 0, 0); GS_STAGEB(GS_SB(1, 1), cB + hstepB + kstep, voffB);
    GS_WAIT_V(6); GS_BAR;
    for (;;) {
        const bool has_next = S.next(ui + 1, nxt);
        const int nui = has_next ? ui + 1 : ui;
        const char* nA = uni(has_next ? nxt.A : cA); const char* nB = uni(has_next ? nxt.B : cB);
#pragma unroll 1
        for (int t = 0; t < nt; t += 2) {
            const bool last = (t == nt - 2);
            const char* a1 = uni(cA + (size_t)(t + 1) * kstep);
            const char* a2 = uni(last ? nA : cA + (size_t)(t + 2) * kstep); const char* b2 = uni(last ? nB : cB + (size_t)(t + 2) * kstep);
            const char* a3 = uni(a2 + kstep); const char* b3 = uni(b2 + kstep);
            const int u2 = last ? nui : ui;
            GS_LDB(B0, 0, 0); GS_LDB(B1, 0, 1); GS_SCHED; GS_LDA(At, 0, 0); GS_STAGE(GS_SA(1, 1), a1, ui, 1);
            GS_WAIT_V(8); GS_WAIT_L(0); GS_BAR; GS_MMA(0, 0, At, B0); GS_MMA(0, 1, At, B1); GS_BAR; GS_SCHED;
            GS_LDA(At, 0, 1); GS_STAGEB(GS_SB(0, 0), b2, voffB); GS_STAGEB(GS_SB(0, 1), b2 + hstepB, voffB); GS_STAGE(GS_SA(0, 0), a2, u2, 0);
            GS_WAIT_V(8); GS_WAIT_L(0); GS_BAR; GS_MMA(1, 0, At, B0); GS_MMA(1, 1, At, B1); GS_BAR; GS_SCHED;
            GS_LDB(B0, 1, 0); GS_LDB(B1, 1, 1); GS_SCHED; GS_LDA(At, 1, 0); GS_STAGE(GS_SA(0, 1), a2, u2, 1);
            GS_WAIT_V(8); GS_WAIT_L(0); GS_BAR; GS_MMA(0, 0, At, B0); GS_MMA(0, 1, At, B1); GS_BAR; GS_SCHED;
            GS_LDA(At, 1, 1); GS_STAGEB(GS_SB(1, 0), b3, voffB); GS_STAGEB(GS_SB(1, 1), b3 + hstepB, voffB); GS_STAGE(GS_SA(1, 0), a3, u2, 0);
            GS_WAIT_V(8); GS_WAIT_L(0); GS_BAR; GS_MMA(1, 0, At, B0); GS_MMA(1, 1, At, B1); GS_BAR; GS_SCHED;
        }
        if (wr == 0) GS_BAR;
        if (F8 == 2) asm volatile("s_nop 15\n\ts_nop 15\n\ts_nop 15\n\ts_nop 15\n\ts_nop 15\n\ts_nop 15" ::: "memory");
        E(acc, cur, wr, wc, fr, fq);
        if (!has_next) break;
#pragma unroll
        for (int a = 0; a < 2; ++a)
#pragma unroll
            for (int b = 0; b < 2; ++b)
#pragma unroll
                for (int m = 0; m < 4; ++m)
#pragma unroll
                    for (int n = 0; n < 2; ++n) acc[a][b][m][n] = (f32x4){0.f, 0.f, 0.f, 0.f};
        cur = nxt; cA = nA; cB = nB; ++ui;
        if (wr == 1) GS_BAR;
    }
    GS_WAIT_V(0);
    GS_BAR;
#undef GS_SA
#undef GS_SB
#undef GS_STAGE
#undef GS_STAGEB
#undef GS_LDA
#undef GS_LD32
#undef GS_LDB
#undef GS_MMA
#undef GS_WAIT_V
#undef GS_WAIT_L
#undef GS_BAR
#undef GS_SCHED
}
struct DenseU { const char* A; const char* B; int pm, pn; };
struct DenseSched {
    typedef DenseU U;
    const bf16_t* A; const bf16_t* Bt; int K, nunits, first, stride, npn, pn_base, pn_mod0, pn_mod1;
    DI int colmap(int q) const { return pn_base + (q / pn_mod0) * pn_mod1 + (q % pn_mod0); }
    DI bool next(int i, U& u) const {
        const int L = first + i * stride; if (L >= nunits) return false;
        u.pm = L / npn; u.pn = colmap(L % npn);
        u.A = (const char*)A + (size_t)u.pm * BM * K * 2; u.B = (const char*)Bt + (size_t)u.pn * BM * K * 2; return true;
    }
    DI unsigned a_voff(int, int h, int R, int C) const { return (unsigned)((HALF * h + R) * K + C) * 2u; }
};
}

DI void transpose_cvt(const float* W, bf16_t* Wt, int K, int N, int unit, char* lds) {
    float* tile = (float*)lds;
    const int nbn = N / 64, kb = unit / nbn, nb = unit % nbn, tid = tidx();
    __syncthreads();
#pragma unroll
    for (int i = 0; i < 8; ++i) { const int idx = tid + i * 512, r = idx >> 6, c = idx & 63; tile[r * 65 + c] = W[(size_t)(kb * 64 + r) * N + nb * 64 + c]; }
    __syncthreads();
#pragma unroll
    for (int i = 0; i < 8; ++i) { const int idx = tid + i * 512, n = idx >> 6, k = idx & 63; Wt[(size_t)(nb * 64 + n) * K + kb * 64 + k] = f2bf(tile[k * 65 + n]); }
}
struct P0Args { const float* x; const float* w_in; const float* w_out; const float* router_w; bf16_t* xb; bf16_t* wt_in; bf16_t* wt_out; bf16_t* wt_r;
                const float* w_gate; const float* w_up; const float* w_down; const float* ws_gate; const float* ws_up; const float* ws_down; unsigned char* wgut; unsigned char* wdt; };
constexpr int CV_GU = 257 * 2 * 16, CV_DN = 257 * 16;
struct CvItem { const float* src; unsigned char* dst; int ld, ldd, rbase, rhi; };
DI CvItem cv_item(const P0Args& a, int it) {
    CvItem c;
    if (it < CV_GU) {
        const int e = it / 32, u = (it >> 4) & 1, kt = it & 15;
        const float* W = e < N_EXP ? (u ? a.w_up : a.w_gate) + (size_t)e * D_MODEL * D_EXP : (u ? a.ws_up : a.ws_gate);
        c.src = W + (size_t)kt * 64 * D_EXP; c.ld = D_EXP; c.dst = a.wgut + (size_t)e * 512 * D_MODEL + kt * 64; c.ldd = D_MODEL; c.rbase = 128 * u; c.rhi = 256;
    } else {
        const int j = it - CV_GU, e = j / 16, kt = (j >> 2) & 3, nb = j & 3;
        const float* W = e < N_EXP ? a.w_down + (size_t)e * D_EXP * D_MODEL : a.ws_down;
        c.src = W + (size_t)kt * 64 * D_MODEL + nb * 256; c.ld = D_MODEL; c.dst = a.wdt + (size_t)e * D_MODEL * D_EXP + kt * 64; c.ldd = D_EXP; c.rbase = 256 * nb; c.rhi = 128;
    }
    return c;
}
constexpr int CV_TILE_BYTES = 64 * 260 * 4;
DI void cv_dma_nt(const char* sbase, unsigned voff, unsigned lds_dst) {
    unsigned keep;
    asm volatile("s_mov_b32 %0, m0\n\ts_mov_b32 m0, %3\n\ts_nop 0\n\tglobal_load_lds_dwordx4 %1, %2 nt\n\ts_mov_b32 m0, %0" : "=&s"(keep) : "v"(voff), "s"(sbase), "s"(lds_dst) : "memory");
}
DI const char* uni64(const void* p) { const unsigned long long v = (unsigned long long)p; const unsigned lo = __builtin_amdgcn_readfirstlane((unsigned)v), hi = __builtin_amdgcn_readfirstlane((unsigned)(v >> 32)); return (const char*)(((unsigned long long)hi << 32) | lo); }
DI void cv_issue(const CvItem& c, LAS unsigned char* tile) {
    const int tid = tidx(), w = __builtin_amdgcn_readfirstlane(tid >> 6), l = tid & 63;
    const char* sb = uni64(c.src); const unsigned tb = (unsigned)__builtin_amdgcn_readfirstlane((unsigned)(size_t)tile);
#pragma unroll
    for (int i = 0; i < 8; ++i) { const int k = 8 * w + i; cv_dma_nt(sb, (unsigned)(k * c.ld + 4 * (l ^ w)) * 4u, tb + (unsigned)(k * 1040)); }
}
DI void lds_barrier() { asm volatile("s_waitcnt lgkmcnt(0)" ::: "memory"); __builtin_amdgcn_s_barrier(); asm volatile("" ::: "memory"); }
DI void cv_emit(const CvItem& c, const char* lds) {
    const float* tile = (const float*)lds;
    const int tid = tidx();
#pragma unroll
    for (int i = 0; i < 4; ++i) {
        const int idx = tid + i * 512, kc = idx & 7, n = idx >> 3; const float* p = tile + (8 * kc) * 260 + (n ^ (4 * kc));
        const unsigned w0 = pack_fp8x4(p[0] * WSCALE, p[260] * WSCALE, p[2 * 260] * WSCALE, p[3 * 260] * WSCALE), w1 = pack_fp8x4(p[4 * 260] * WSCALE, p[5 * 260] * WSCALE, p[6 * 260] * WSCALE, p[7 * 260] * WSCALE);
        __builtin_nontemporal_store((u32x2){w0, w1}, (u32x2*)(c.dst + (size_t)(c.rbase + (n >> 7) * c.rhi + (n & 127)) * c.ldd + 8 * kc));
    }
}
DI void convert_moe_range(const P0Args& a, char* lds, const int lo, const int hi) {
    int it = lo + vblock(); if (it >= hi) return;
    __syncthreads();
    LAS unsigned char* t0 = (LAS unsigned char*)lds; LAS unsigned char* t1 = t0 + CV_TILE_BYTES;
    CvItem c = cv_item(a, it); cv_issue(c, t0);
    int pp = 0;
#pragma unroll 1
    for (;;) {
        const int nit = it + GRID; const bool more = nit < hi;
        CvItem cn = c;
        if (more) { cn = cv_item(a, nit); cv_issue(cn, pp ? t0 : t1); }
        if (more) asm volatile("s_waitcnt vmcnt(8)" ::: "memory"); else asm volatile("s_waitcnt vmcnt(0)" ::: "memory");
        lds_barrier();
        cv_emit(c, lds + (pp ? CV_TILE_BYTES : 0));
        lds_barrier();
        if (!more) break;
        it = nit; c = cn; pp ^= 1;
    }
    asm volatile("s_waitcnt vmcnt(0)" ::: "memory");
    __syncthreads();
}
DI void phase_prologue(const P0Args& a, char* lds) {
    const int vb = vblock();
    for (size_t i = (size_t)vb * NTHR + tidx(); i < (size_t)T_TOK * D_MODEL / 8; i += (size_t)GRID * NTHR) {
        const f32x4 v0 = *(const f32x4*)(a.x + i * 8), v1 = *(const f32x4*)(a.x + i * 8 + 4);
        u32x4 o; o.x = cvt_pk_bf16(v0[0], v0[1]); o.y = cvt_pk_bf16(v0[2], v0[3]); o.z = cvt_pk_bf16(v1[0], v1[1]); o.w = cvt_pk_bf16(v1[2], v1[3]);
        *(u32x4*)(a.xb + i * 8) = o;
    }
    const int n_in = (1024 / 64) * (3072 / 64), n_out = 16 * 16, n_r = 16 * 4;
    for (int u = vb; u < n_in + n_out + n_r; u += GRID) {
        if (u < n_in) transpose_cvt(a.w_in, a.wt_in, 1024, 3072, u, lds);
        else if (u < n_in + n_out) transpose_cvt(a.w_out, a.wt_out, 1024, 1024, u - n_in, lds);
        else transpose_cvt(a.router_w, a.wt_r, 1024, 256, u - n_in - n_out, lds);
    }
}


struct P1Args { const bf16_t* xb; const bf16_t* wt_in; bf16_t* Q; bf16_t* Kb; bf16_t* Vt; };
struct EpiQK { bf16_t* Q; bf16_t* Kb;
    DI void operator()(const f32x4 (&acc)[2][2][4][2], const gs::DenseU& u, int wr, int wc, int fr, int fq) const {
        const int seg = u.pn >> 1, type = seg % 3, grp = seg / 3; bf16_t* dst = type == 0 ? Q : Kb; const float sc = type == 0 ? QSCALE : 1.f;
#pragma unroll
        for (int ai = 0; ai < 2; ++ai)
#pragma unroll
            for (int m = 0; m < 4; ++m) {
                const int row = u.pm * 256 + 128 * ai + 64 * wr + 16 * m + fr, b = row / SEQ, s = row % SEQ;
#pragma unroll
                for (int bj = 0; bj < 2; ++bj) {
                    const int hh = grp * 8 + 4 * (u.pn & 1) + 2 * bj + (wc >> 1), d0 = 32 * (wc & 1) + 8 * fq;
                    const f32x4 v0 = acc[ai][bj][m][0] * sc, v1 = acc[ai][bj][m][1] * sc;
                    u32x4 o; o.x = cvt_pk_bf16(v0[0], v0[1]); o.y = cvt_pk_bf16(v0[2], v0[3]); o.z = cvt_pk_bf16(v1[0], v1[1]); o.w = cvt_pk_bf16(v1[2], v1[3]);
                    *(u32x4*)(dst + (size_t)(b * NHH + hh) * SEQ * 64 + (s >> 5) * 2048 + ((d0 >> 3) * 32 + (s & 31)) * 8) = o;
                }
            }
    } };
struct EpiV { bf16_t* Vt;
    DI void operator()(const f32x4 (&acc)[2][2][4][2], const gs::DenseU& u, int wr, int wc, int fr, int fq) const {
        const int grp = (u.pn >> 1) / 3;
#pragma unroll
        for (int ai = 0; ai < 2; ++ai)
#pragma unroll
            for (int m = 0; m < 4; ++m) {
                const int row = u.pm * 256 + 128 * ai + 64 * wr + 16 * m + 4 * fq, b = row / SEQ, s = row % SEQ;
#pragma unroll
                for (int bj = 0; bj < 2; ++bj)
#pragma unroll
                    for (int n = 0; n < 2; ++n) {
                        const int hh = grp * 8 + 4 * (u.pn & 1) + 2 * bj + (wc >> 1), d = 32 * (wc & 1) + 16 * n + fr;
                        const f32x4 v = acc[ai][bj][m][n];
                        u32x2 o; o.x = cvt_pk_bf16(v[0], v[1]); o.y = cvt_pk_bf16(v[2], v[3]);
                        { const int kap = s & 31; *(u32x2*)(Vt + (size_t)(b * NHH + hh) * SEQ * 64 + (s >> 5) * 2048 + ((((d >> 5) * 2 + (kap >> 4)) * 2 + ((kap >> 2) & 1)) * 32 + (d & 31)) * 8 + ((kap >> 3) & 1) * 4) = o; }
                    }
            }
    } };
DI void phase_qkv(const P1Args& a, LAS unsigned char* lds) {
    { gs::DenseSched S{a.xb, a.wt_in, D_MODEL, (T_TOK / 256) * 8, vblock(), GRID, 8, 0, 4, 6}; EpiQK E{a.Q, a.Kb}; gs::gemm_stream<true, true, 0>(lds, D_MODEL, S, E); }
    { gs::DenseSched S{a.xb, a.wt_in, D_MODEL, (T_TOK / 256) * 4, vblock(), GRID, 4, 4, 2, 6}; EpiV E{a.Vt}; gs::gemm_stream<false, false, 0>(lds, D_MODEL, S, E); }
}

struct P3Args { const bf16_t* y; const bf16_t* wt_out; const bf16_t* xb; bf16_t* r; float* stats; };
struct EpiOut { const bf16_t* xb; bf16_t* r; float* stats;
    DI void operator()(const f32x4 (&acc)[2][2][4][2], const gs::DenseU& u, int wr, int wc, int fr, int fq) const {
#pragma unroll
        for (int ai = 0; ai < 2; ++ai) {
            u32x4 xw[4][2];
#pragma unroll
            for (int m = 0; m < 4; ++m)
#pragma unroll
                for (int bj = 0; bj < 2; ++bj) xw[m][bj] = *(const u32x4*)(xb + (size_t)(u.pm * 256 + 128 * ai + 64 * wr + 16 * m + fr) * D_MODEL + u.pn * 256 + 128 * bj + 32 * wc + 8 * fq);
#pragma unroll
            for (int m = 0; m < 4; ++m) {
                const int row = u.pm * 256 + 128 * ai + 64 * wr + 16 * m + fr;
#pragma unroll
                for (int bj = 0; bj < 2; ++bj) {
                    const int col = u.pn * 256 + 128 * bj + 32 * wc + 8 * fq;
                    const u32x4 w = xw[m][bj];
                    const f32x4 x0 = (f32x4){__uint_as_float(w[0] << 16), __uint_as_float(w[0] & 0xffff0000u), __uint_as_float(w[1] << 16), __uint_as_float(w[1] & 0xffff0000u)};
                    const f32x4 x1 = (f32x4){__uint_as_float(w[2] << 16), __uint_as_float(w[2] & 0xffff0000u), __uint_as_float(w[3] << 16), __uint_as_float(w[3] & 0xffff0000u)};
                    const f32x4 v0 = x0 * DN_ALPHA + acc[ai][bj][m][0], v1 = x1 * DN_ALPHA + acc[ai][bj][m][1];
                    float s = ((v0[0] + v0[1]) + (v0[2] + v0[3])) + ((v1[0] + v1[1]) + (v1[2] + v1[3]));
                    float q = ((v0[0] * v0[0] + v0[1] * v0[1]) + (v0[2] * v0[2] + v0[3] * v0[3])) + ((v1[0] * v1[0] + v1[1] * v1[1]) + (v1[2] * v1[2] + v1[3] * v1[3]));
                    u32x4 o; o.x = cvt_pk_bf16(v0[0], v0[1]); o.y = cvt_pk_bf16(v0[2], v0[3]); o.z = cvt_pk_bf16(v1[0], v1[1]); o.w = cvt_pk_bf16(v1[2], v1[3]);
                    *(u32x4*)(r + (size_t)row * D_MODEL + col) = o;
                    s += __shfl_xor(s, 16); s += __shfl_xor(s, 32); q += __shfl_xor(q, 16); q += __shfl_xor(q, 32);
                    if (fq == 0) *(f32x2*)(stats + ((size_t)row * 32 + u.pn * 8 + bj * 4 + wc) * 2) = (f32x2){s, q};
                }
            }
        }
    } };
DI void phase_outproj(const P3Args& a, LAS unsigned char* lds) {
    gs::DenseSched S{a.y, a.wt_out, D_MODEL, (T_TOK / 256) * 4, vblock(), GRID, 4, 0, 4, 0}; EpiOut E{a.xb, a.r, a.stats}; gs::gemm_stream<true, true, 0>(lds, D_MODEL, S, E);
}

DI void unpack16(const u32x4& a, const u32x4& b, float (&v)[16]) {
#pragma unroll
    for (int j = 0; j < 4; ++j) { v[2 * j] = __uint_as_float(a[j] << 16); v[2 * j + 1] = __uint_as_float(a[j] & 0xffff0000u); v[8 + 2 * j] = __uint_as_float(b[j] << 16); v[8 + 2 * j + 1] = __uint_as_float(b[j] & 0xffff0000u); }
}
constexpr int RS_SC = 289;
constexpr int LDS_HIST = 100 * 1024;
struct P4Args { const bf16_t* r; const float* stats; const float* ln_g; const float* ln_b; bf16_t* x1; unsigned char* x1f8; const bf16_t* wt_r; const float* rbias;
                int* eidx; float* gate; int* counts; int* tokl; float* gatel; int* slot; };
DI void phase_router(const P4Args& a, const P0Args& cv, char* lds) {
    const int tid = tidx(), wid = tid >> 6, lane = tid & 63, wr = wid >> 2, wc = wid & 3, fr = lane & 15, fq = lane >> 4;
    float* sc = (float*)lds; int* hist = (int*)(lds + LDS_HIST); int* base = hist + 256;
    for (int u = vblock(); u < T_TOK / 128; u += GRID) {
        const int m0 = u * 128;
        if ((vblock() & 1) == 0) convert_moe_range(cv, lds, CV_GU, CV_GU + CV_DN);
        __syncthreads();
#pragma unroll 1
        for (int i0 = 0; i0 < 16; i0 += 4) {
            f32x2 st[4]; u32x4 r0[4], r1[4];
#pragma unroll
            for (int j4 = 0; j4 < 4; ++j4) {
                const int t = m0 + wid * 16 + i0 + j4;
                st[j4] = (f32x2){0.f, 0.f};
                if (lane < 32) st[j4] = *(const f32x2*)(a.stats + ((size_t)t * 32 + lane) * 2);
                r0[j4] = *(const u32x4*)(a.r + (size_t)t * D_MODEL + lane * 16); r1[j4] = *(const u32x4*)(a.r + (size_t)t * D_MODEL + lane * 16 + 8);
            }
#pragma unroll
            for (int j4 = 0; j4 < 4; ++j4) {
                const int t = m0 + wid * 16 + i0 + j4;
                float s = st[j4].x, q = st[j4].y;
#pragma unroll
                for (int o = 1; o <= 16; o <<= 1) { s += __shfl_xor(s, o); q += __shfl_xor(q, o); }
                s = __shfl(s, 0); q = __shfl(q, 0);
                const float mu = s * (1.f / 1024.f), rstd = rsqrtf(q * (1.f / 1024.f) - mu * mu + LN_EPS);
                float v[16]; unpack16(r0[j4], r1[j4], v);
                u32x4 o0, o1, o8;
#pragma unroll
                for (int j = 0; j < 4; ++j) {
                    const f32x4 g = *(const f32x4*)(a.ln_g + lane * 16 + 4 * j), bb = *(const f32x4*)(a.ln_b + lane * 16 + 4 * j);
                    const float y0 = (v[4 * j] - mu) * rstd * g[0] + bb[0], y1 = (v[4 * j + 1] - mu) * rstd * g[1] + bb[1], y2 = (v[4 * j + 2] - mu) * rstd * g[2] + bb[2], y3 = (v[4 * j + 3] - mu) * rstd * g[3] + bb[3];
                    o8[j] = pack_fp8x4(y0 * XSCALE, y1 * XSCALE, y2 * XSCALE, y3 * XSCALE);
                    const unsigned p0 = cvt_pk_bf16(y0, y1), p1 = cvt_pk_bf16(y2, y3);
                    if (j < 2) { o0[2 * j] = p0; o0[2 * j + 1] = p1; } else { o1[2 * (j - 2)] = p0; o1[2 * (j - 2) + 1] = p1; }
                }
                *(u32x4*)(a.x1 + (size_t)t * D_MODEL + lane * 16) = o0; *(u32x4*)(a.x1 + (size_t)t * D_MODEL + lane * 16 + 8) = o1;
                *(u32x4*)(a.x1f8 + (size_t)t * D_MODEL + lane * 16) = o8;
            }
        }
        if (tid < 256) hist[tid] = 0;
        asm volatile("s_waitcnt vmcnt(0)" ::: "memory");
        __syncthreads();
        ALoader<4> al; al.init_rows(a.x1, D_MODEL, m0);
        BLoaderBt bl; bl.init(a.wt_r, D_MODEL, 0);
        f32x4 acc[4][4];
        gemm_tile<4, true>(lds, al, bl, D_MODEL / 64, acc);
        int my_idx[2], my_rank[2]; float my_gate[2];
#pragma unroll
        for (int p = 0; p < 2; ++p) {
            __syncthreads();
            if (wr == p) {
#pragma unroll
                for (int m = 0; m < 4; ++m)
#pragma unroll
                    for (int n = 0; n < 4; ++n) {
                        const int c0 = 64 * wc + 16 * n + 4 * fq; const f32x4 rb = *(const f32x4*)(a.rbias + c0);
#pragma unroll
                        for (int j = 0; j < 4; ++j) { const int c = c0 + j; sc[(16 * m + fr) * RS_SC + (c >> 5) * 36 + (c & 31)] = 1.f / (1.f + __expf(-acc[m][n][j])) + rb[j]; }
                    }
            }
            __syncthreads();
            const int row = tid >> 3, g = tid & 7, t = m0 + 64 * p + row;
            float sel[32];
#pragma unroll
            for (int i = 0; i < 32; ++i) sel[i] = sc[row * RS_SC + g * 36 + i];
            float m1 = -INFINITY, m2 = -INFINITY;
#pragma unroll
            for (int i = 0; i < 32; ++i) { const float v = sel[i]; m2 = fmaxf(m2, fminf(m1, v)); m1 = fmaxf(m1, v); }
            const float gs = m1 + m2; int rank = 0;
#pragma unroll
            for (int d = 1; d < 8; ++d) { const float o = __shfl_xor(gs, d); const int og = g ^ d; rank += (o > gs || (o == gs && og < g)) ? 1 : 0; }
            const bool en = rank < TOPK_GROUPS;
            float lv = -INFINITY; int li = 1 << 20;
            if (en) {
#pragma unroll
                for (int i = 0; i < 32; ++i) { const float v = sel[i]; if (v > lv) { lv = v; li = g * 32 + i; } }
            }
            float myv = 0.f; int myi = 0;
#pragma unroll
            for (int k = 0; k < TOP_K; ++k) {
                float bv = lv; int bi = li;
#pragma unroll
                for (int d = 1; d < 8; d <<= 1) { const float ov = __shfl_xor(bv, d); const int oi = __shfl_xor(bi, d); if (ov > bv || (ov == bv && oi < bi)) { bv = ov; bi = oi; } }
                if (g == k) { myv = bv; myi = bi; }
                if (k + 1 < TOP_K && (bi >> 5) == g) {
                    lv = -INFINITY; li = 1 << 20;
#pragma unroll
                    for (int i = 0; i < 32; ++i) { if (g * 32 + i == bi) sel[i] = -INFINITY; const float v = sel[i]; if (v > lv) { lv = v; li = g * 32 + i; } }
                }
            }
            const float score = myv - a.rbias[myi];
            float gsum = score;
#pragma unroll
            for (int d = 1; d < 8; d <<= 1) gsum += __shfl_xor(gsum, d);
            const float gt = score / gsum * ROUTED_SCALE;
            a.eidx[t * TOP_K + g] = myi; a.gate[t * TOP_K + g] = gt;
            my_idx[p] = myi; my_gate[p] = gt; my_rank[p] = atomicAdd(&hist[myi], 1);
        }
        __syncthreads();
        if (tid < 256) { const int h = hist[tid]; base[tid] = h > 0 ? atomicAdd(&a.counts[tid * CSTR], h) : 0; }
        __syncthreads();
#pragma unroll
        for (int p = 0; p < 2; ++p) {
            const int row = tid >> 3, g = tid & 7, t = m0 + 64 * p + row, e = my_idx[p], pos = base[e] + my_rank[p];
            a.tokl[(size_t)e * CAP + pos] = t; a.gatel[(size_t)e * CAP + pos] = my_gate[p]; a.slot[t * TOP_K + g] = e * CAP + pos;
        }
        if ((vblock() & 1) == 1) convert_moe_range(cv, lds, CV_GU, CV_GU + CV_DN);
    }
}

constexpr int LDS_ROWTAB = 128 * 1024;
constexpr int LDS_GTAB = 139 * 1024;
constexpr int LDS_TAB = 150 * 1024;
constexpr int LDS_UTAB = 154 * 1024;
constexpr int MOE_BM = 256;
DI void build_moe_tab(const int* counts, char* lds) {
    int* tstart = (int*)(lds + LDS_TAB); int* rstart = tstart + 264; int* cnts = tstart + 528;
    const int tid = tidx(), lane = tid & 63;
    __syncthreads();
    if (tid < 64) {
        int c[4], tl[4], cs = 0, ts = 0;
#pragma unroll
        for (int i = 0; i < 4; ++i) { c[i] = counts[(lane * 4 + i) * CSTR]; tl[i] = (c[i] + MOE_BM - 1) / MOE_BM; cs += c[i]; ts += tl[i]; }
        int ci = cs, ti = ts;
#pragma unroll
        for (int o = 1; o < 64; o <<= 1) { const int n1 = __shfl_up(ci, o), n2 = __shfl_up(ti, o); if (lane >= o) { ci += n1; ti += n2; } }
        int ce = ci - cs, te = ti - ts;
#pragma unroll
        for (int i = 0; i < 4; ++i) { rstart[lane * 4 + i] = ce; tstart[lane * 4 + i] = te; cnts[lane * 4 + i] = c[i]; ce += c[i]; te += tl[i]; }
        if (lane == 63) { rstart[256] = ce; tstart[256] = te; cnts[256] = T_TOK; rstart[257] = ce + T_TOK; tstart[257] = te + T_TOK / MOE_BM; }
    }
    __syncthreads();
}
DI int find_expert(const int* tstart, int g) {
    int lo = 0, hi = 256;
#pragma unroll 1
    while (lo < hi) { const int mid = (lo + hi + 1) >> 1; if (tstart[mid] <= g) lo = mid; else hi = mid - 1; }
    return lo;
}
struct MoeU { const char* A; const char* B; int e, m0, sub, ui; };
typedef const LAS int* ltab_t;
DI int find_expert_l(ltab_t tstart, int g) { int lo = 0, hi = 256;
#pragma unroll 1
    while (lo < hi) { const int mid = (lo + hi + 1) >> 1; if (tstart[mid] <= g) lo = mid; else hi = mid - 1; }
    return lo; }

struct P6Args { const unsigned char* x1; const int* counts; const int* tokl; const float* gatel; const unsigned char* wgut; unsigned char* H; };
struct GuSched {
    typedef MoeU U;
    ltab_t tab; const LAS int* rowtab; const LAS int* utab; const unsigned char* x1; const unsigned char* wgut; int first, stride, nunits;
    DI bool next(int i, U& u) const {
        const int L = first + i * stride; if (L >= nunits) return false;
        const int g = L >> 1, e = utab[i];
        u.sub = L & 1; u.e = e; u.ui = i; u.m0 = (g - tab[e]) * MOE_BM;
        u.A = (const char*)x1; u.B = (const char*)(wgut + ((size_t)e * 512 + 256 * u.sub) * D_MODEL); return true;
    }
    DI unsigned a_voff(int i, int h, int R, int C) const { return (unsigned)(rowtab[i * 256 + 128 * h + R] * (D_MODEL / 2) + C) * 2u; }
};
struct EpiGU { unsigned char* H; const LAS float* gtab; ltab_t tab;
    DI void operator()(const f32x4 (&acc)[2][2][4][2], const MoeU& u, int wr, int wc, int fr, int fq) const {
        const int st = tab[264 + u.e], cnt = tab[528 + u.e];
#pragma unroll
        for (int ai = 0; ai < 2; ++ai)
#pragma unroll
            for (int m = 0; m < 4; ++m) {
                const int row = u.m0 + 128 * ai + 64 * wr + 16 * m + fr;
                if (row < cnt) {
                    const float gt = gtab[u.ui * 256 + 128 * ai + 64 * wr + 16 * m + fr] * (HSCALE / (XSCALE * WSCALE));
                    float h[8];
#pragma unroll
                    for (int n = 0; n < 2; ++n)
#pragma unroll
                        for (int j = 0; j < 4; ++j) { const float gv = acc[ai][0][m][n][j] * (1.f / (XSCALE * WSCALE)); h[4 * n + j] = gv * __builtin_amdgcn_rcpf(1.f + __expf(-gv)) * acc[ai][1][m][n][j] * gt; }
                    *(u32x2*)(H + (size_t)(st + row) * D_EXP + 128 * u.sub + 32 * wc + 8 * fq) = (u32x2){pack_fp8x4(h[0], h[1], h[2], h[3]), pack_fp8x4(h[4], h[5], h[6], h[7])};
                }
            }
    } };
DI void phase_moe_gu(const P6Args& a, char* smem, LAS unsigned char* lds) {
    build_moe_tab(a.counts, smem);
    const int* tstart = (const int*)(smem + LDS_TAB); const int* rstart = tstart + 264; int* rowtab = (int*)(smem + LDS_ROWTAB); float* gtab = (float*)(smem + LDS_GTAB);
    const int nunits = tstart[257] * 2, first = vblock();
    const int n_my = first < nunits ? (nunits - first + GRID - 1) / GRID : 0;
    for (int idx = tidx(); idx < n_my * 256; idx += NTHR) {
        const int i = idx >> 8, row = idx & 255, L = first + i * GRID, g = L >> 1, e = find_expert(tstart, g), m0 = (g - tstart[e]) * MOE_BM, cnt = tstart[528 + e];
        int rr = m0 + row; rr = rr < cnt ? rr : cnt - 1;
        rowtab[idx] = e < N_EXP ? a.tokl[(size_t)e * CAP + rr] : rr;
        gtab[idx] = e < N_EXP ? a.gatel[(size_t)e * CAP + rr] : 1.f;
    }
    if (tidx() < 32 && tidx() < n_my) ((int*)(smem + LDS_UTAB))[tidx()] = find_expert(tstart, (first + tidx() * GRID) >> 1);
    __syncthreads();
    GuSched S{(ltab_t)(lds + LDS_TAB), (const LAS int*)(lds + LDS_ROWTAB), (const LAS int*)(lds + LDS_UTAB), a.x1, a.wgut, first, GRID, nunits}; EpiGU E{a.H, (const LAS float*)(lds + LDS_GTAB), (ltab_t)(lds + LDS_TAB)};
    gs::gemm_stream<true, true, 2>(lds, D_MODEL / 2, S, E);
}
struct P7Args { const unsigned char* H; const int* counts; const unsigned char* wdt; unsigned char* Y; };
struct DownSched {
    typedef MoeU U;
    ltab_t tab; const LAS int* utab; const unsigned char* H; const unsigned char* wdt; int first, stride, nunits;
    DI bool next(int i, U& u) const {
        const int L = first + i * stride; if (L >= nunits) return false;
        const int g = L >> 2, e = utab[i];
        u.sub = L & 3; u.e = e; u.ui = i; u.m0 = (g - tab[e]) * MOE_BM;
        u.A = (const char*)(H + (size_t)(tab[264 + e] + u.m0) * D_EXP); u.B = (const char*)(wdt + ((size_t)e * D_MODEL + 256 * u.sub) * D_EXP); return true;
    }
    DI unsigned a_voff(int, int h, int R, int C) const { return (unsigned)((128 * h + R) * (D_EXP / 2) + C) * 2u; }
};
struct EpiDown { unsigned char* Y; ltab_t tab;
    DI void operator()(const f32x4 (&acc)[2][2][4][2], const MoeU& u, int wr, int wc, int fr, int fq) const {
        const int st = tab[264 + u.e], cnt = tab[528 + u.e];
#pragma unroll
        for (int ai = 0; ai < 2; ++ai)
#pragma unroll
            for (int m = 0; m < 4; ++m) {
                const int row = u.m0 + 128 * ai + 64 * wr + 16 * m + fr;
                if (row < cnt) {
                    u32x4 o;
#pragma unroll
                    for (int bj = 0; bj < 2; ++bj) {
                        const f32x4 v0 = acc[ai][bj][m][0] * (YSCALE / (HSCALE * WSCALE)), v1 = acc[ai][bj][m][1] * (YSCALE / (HSCALE * WSCALE));
                        o[2 * bj] = pack_fp8x4(v0[0], v0[1], v0[2], v0[3]); o[2 * bj + 1] = pack_fp8x4(v1[0], v1[1], v1[2], v1[3]);
                    }
                    *(u32x4*)(Y + (size_t)(st + row) * D_MODEL + 256 * u.sub + 64 * wc + 16 * fq) = o;
                }
            }
    } };
DI void phase_moe_down(const P7Args& a, char* smem, LAS unsigned char* lds) {
    build_moe_tab(a.counts, smem);
    const int* tstart = (const int*)(smem + LDS_TAB); const int* rstart = tstart + 264;
    { const int nun = tstart[257] * 4, i = tidx(); if (i < 32 && vblock() + i * GRID < nun) ((int*)(smem + LDS_UTAB))[i] = find_expert(tstart, (vblock() + i * GRID) >> 2); }
    __syncthreads();
    DownSched S{(ltab_t)(lds + LDS_TAB), (const LAS int*)(lds + LDS_UTAB), a.H, a.wdt, vblock(), GRID, tstart[257] * 4}; EpiDown E{a.Y, (ltab_t)(lds + LDS_TAB)};
    gs::gemm_stream<true, true, 2>(lds, D_EXP / 2, S, E);
}
struct P8Args { const bf16_t* x1; const unsigned char* Y; const int* slot; const int* counts; const float* ln_g; const float* ln_b; float* out; };
DI void phase_combine(const P8Args& a, char* lds) {
    const int tid = tidx(), wid = tid >> 6, lane = tid & 63;
    build_moe_tab(a.counts, lds);
    const int* rstart = (const int*)(lds + LDS_TAB) + 264;
    const int sh0 = rstart[256];
    const int c0 = 256 * (lane >> 4) + 32 * ((lane >> 2) & 3) + 8 * (lane & 3);
    for (int t = vblock() * 8 + wid; t < T_TOK; t += GRID * 8) {
        float v[16], w[16];
        { const u32x4 p0 = *(const u32x4*)(a.x1 + (size_t)t * D_MODEL + c0), p1 = *(const u32x4*)(a.x1 + (size_t)t * D_MODEL + c0 + 128); unpack16(p0, p1, v); }
        int sl = 0; if (lane < TOP_K) sl = a.slot[t * TOP_K + lane];
        u32x4 yr[9];
        yr[8] = *(const u32x4*)(a.Y + (size_t)(sh0 + t) * D_MODEL + lane * 16);
#pragma unroll
        for (int k = 0; k < TOP_K; ++k) { const int s = __shfl(sl, k), e = s / CAP, pos = s % CAP; yr[k] = *(const u32x4*)(a.Y + (size_t)(rstart[e] + pos) * D_MODEL + lane * 16); }
#pragma unroll
        for (int i = 0; i < 16; ++i) w[i] = 0.f;
#pragma unroll
        for (int k = 0; k < 9; ++k)
#pragma unroll
            for (int j = 0; j < 4; ++j) { const f32x2 lo = __builtin_amdgcn_cvt_pk_f32_fp8((int)yr[k][j], false), hi = __builtin_amdgcn_cvt_pk_f32_fp8((int)yr[k][j], true); w[4 * j] += lo.x; w[4 * j + 1] += lo.y; w[4 * j + 2] += hi.x; w[4 * j + 3] += hi.y; }
#pragma unroll
        for (int i = 0; i < 16; ++i) v[i] = v[i] * DN_ALPHA + w[i] * (1.f / YSCALE);
        float s = 0.f;
#pragma unroll
        for (int i = 0; i < 16; ++i) s += v[i];
#pragma unroll
        for (int o = 32; o >= 1; o >>= 1) s += __shfl_xor(s, o);
        const float mu = s * (1.f / 1024.f);
        float q = 0.f;
#pragma unroll
        for (int i = 0; i < 16; ++i) { const float d = v[i] - mu; q += d * d; }
#pragma unroll
        for (int o = 32; o >= 1; o >>= 1) q += __shfl_xor(q, o);
        const float rstd = rsqrtf(q * (1.f / 1024.f) + LN_EPS);
#pragma unroll
        for (int j = 0; j < 4; ++j) {
            const int col = c0 + 128 * (j >> 1) + 4 * (j & 1);
            const f32x4 g = *(const f32x4*)(a.ln_g + col), bb = *(const f32x4*)(a.ln_b + col);
            f32x4 o; o[0] = (v[4 * j] - mu) * rstd * g[0] + bb[0]; o[1] = (v[4 * j + 1] - mu) * rstd * g[1] + bb[1]; o[2] = (v[4 * j + 2] - mu) * rstd * g[2] + bb[2]; o[3] = (v[4 * j + 3] - mu) * rstd * g[3] + bb[3];
            *(f32x4*)(a.out + (size_t)t * D_MODEL + col) = o;
        }
    }
}
#define MFMA32(a, b, c) __builtin_amdgcn_mfma_f32_32x32x16_bf16((a), (b), (c), 0, 0, 0)
constexpr float SB_EXIT_THR = 1e-30f;
struct P2Args { const bf16_t* Q; const bf16_t* Kb; const bf16_t* Vt; const float* rel_bias; const float* gain_a; const float* gain_b; bf16_t* y; };

DI bf16x8 pack8(const f32x16& x, int s) {
    u32x4 p;
    if (s == 0) { p.x = cvt_pk_bf16(x[0], x[1]); p.y = cvt_pk_bf16(x[2], x[3]); p.z = cvt_pk_bf16(x[4], x[5]); p.w = cvt_pk_bf16(x[6], x[7]); }
    else        { p.x = cvt_pk_bf16(x[8], x[9]); p.y = cvt_pk_bf16(x[10], x[11]); p.z = cvt_pk_bf16(x[12], x[13]); p.w = cvt_pk_bf16(x[14], x[15]); }
    return __builtin_bit_cast(bf16x8, p);
}
DI void load_k(bf16x8 (&k)[4], const bf16_t* kp, int k0) {
#pragma unroll
    for (int kk = 0; kk < 4; ++kk) k[kk] = *(const bf16x8*)(kp + (size_t)(k0 >> 5) * 2048 + kk * 512);
}
DI void load_v(bf16x8 (&v)[2][2], const bf16_t* vp, int k0) {
#pragma unroll
    for (int dt = 0; dt < 2; ++dt)
#pragma unroll
        for (int s = 0; s < 2; ++s) v[dt][s] = *(const bf16x8*)(vp + (size_t)(k0 >> 5) * 2048 + (dt * 2 + s) * 512);
}

constexpr int LDS_CVT = 16 * 1024;
DI void phase_attn(const P2Args& a, const P0Args& cv, char* lds) {
    const int tid = tidx(), wid = tid >> 6, lane = tid & 63, r = lane & 31, h = lane >> 5;
    float* tbl = (float*)lds;
    float* ssq = (float*)(lds + 8 * 260 * 4);
    __syncthreads();
    for (int i = tid; i < NHA * 257; i += NTHR) { const int hd = i / 257, j = i % 257; tbl[hd * 260 + j] = a.rel_bias[i] * LOG2E; }
    __syncthreads();
    const int cgrp = vblock() % 2;
#pragma unroll 1
    for (int slot = 0; slot < 5; ++slot) {
        if ((cgrp == 0 && slot == 0) || (cgrp == 1 && slot == 4)) convert_moe_range(cv, lds + LDS_CVT, 0, CV_GU);
        if (slot == 4) break;
        const int u = vblock() + GRID * (slot >> 1) + 2 * GRID * (slot & 1);
        const bool isB = u >= BATCH * (SEQ / 64); const int uu = isB ? u - BATCH * (SEQ / 64) : u;
        const int b = uu / (SEQ / 64), c = uu % (SEQ / 64), q0 = c * 64, hh = (isB ? NHA : 0) + wid;
        const size_t hb = (size_t)(b * NHH + hh) * SEQ * 64;
        const bf16_t* kp = a.Kb + hb + lane * 8;
        const bf16_t* vp = a.Vt + hb + lane * 8;
        bf16x8 qf[2][4];
#pragma unroll
        for (int qt = 0; qt < 2; ++qt)
#pragma unroll
            for (int kk = 0; kk < 4; ++kk) qf[qt][kk] = *(const bf16x8*)(a.Q + hb + (size_t)((q0 >> 5) + qt) * 2048 + kk * 512 + lane * 8);
        f32x16 ot[2][2];
#pragma unroll
        for (int dt = 0; dt < 2; ++dt)
#pragma unroll
            for (int qt = 0; qt < 2; ++qt)
#pragma unroll
                for (int i = 0; i < 16; ++i) ot[dt][qt][i] = 0.f;
        float linv[2] = {1.f, 1.f};
        if (!isB) {
            float mrun[2] = {-INFINITY, -INFINITY}, lrun[2] = {0.f, 0.f};
            const int klo = q0 - LEFT_CHUNKS * CHUNK < 0 ? 0 : q0 - LEFT_CHUNKS * CHUNK, khi = q0 + 64;
            const float cfar = tbl[wid * 260 + 256];
            bf16x8 kc[4], kn[4], vf[2][2]; load_k(kc, kp, klo);
            for (int k0 = klo; k0 < khi; k0 += 32) {
                load_v(vf, vp, k0);
                load_k(kn, kp, k0 + 32 < khi ? k0 + 32 : k0);
#pragma unroll
                for (int qt = 0; qt < 2; ++qt) {
                    bf16x8 pf[2];
                    f32x16 st;
#pragma unroll
                    for (int i = 0; i < 16; ++i) st[i] = 0.f;
#pragma unroll
                    for (int kk = 0; kk < 4; ++kk) st = MFMA32(kc[kk], qf[qt][kk], st);
                    const int dmin = q0 + 32 * qt - k0 - 31;
                    float boff = 0.f;
                    if (dmin >= MAX_REL) boff = cfar;
                    else {
                        const int bidx = q0 + 32 * qt + r - k0 - 4 * h + MAX_REL;
#pragma unroll
                        for (int i = 0; i < 16; ++i) { int ix = bidx - ((i & 3) + 8 * (i >> 2)); ix = ix < 0 ? 0 : (ix > 2 * MAX_REL ? 2 * MAX_REL : ix); st[i] += tbl[wid * 260 + ix]; }
                    }
                    float mx = st[0];
#pragma unroll
                    for (int i = 1; i < 16; ++i) mx = fmaxf(mx, st[i]);
                    mx = fmaxf(mx, __shfl_xor(mx, 32)) + boff;
                    const float mo = mrun[qt], mn = fmaxf(mo, mx);
                    mrun[qt] = mn;
                    const float eo = boff - mn;
                    float ps = 0.f;
#pragma unroll
                    for (int i = 0; i < 16; ++i) { st[i] = __builtin_amdgcn_exp2f(st[i] + eo); ps += st[i]; }
                    if (__all(mn == mo)) lrun[qt] += ps;
                    else {
                        const float alpha = __builtin_amdgcn_exp2f(mo - mn);
                        lrun[qt] = lrun[qt] * alpha + ps;
#pragma unroll
                        for (int i = 0; i < 16; ++i) { ot[0][qt][i] *= alpha; ot[1][qt][i] *= alpha; }
                    }
                    pf[0] = pack8(st, 0); pf[1] = pack8(st, 1);
#pragma unroll
                    for (int dt = 0; dt < 2; ++dt)
#pragma unroll
                        for (int s = 0; s < 2; ++s) ot[dt][qt] = MFMA32(vf[dt][s], pf[s], ot[dt][qt]);
                }
#pragma unroll
                for (int kk = 0; kk < 4; ++kk) kc[kk] = kn[kk];
            }
#pragma unroll
            for (int qt = 0; qt < 2; ++qt) { const float lt = lrun[qt] + __shfl_xor(lrun[qt], 32); linv[qt] = 1.f / lt; }
        } else {
            float carry[2] = {1.f, 1.f};
            bf16x8 kc[4], kn[4], vf[2][2]; load_k(kc, kp, q0 + 32);
            for (int k0 = q0 + 32; k0 >= 0; k0 -= 32) {
                load_v(vf, vp, k0);
                load_k(kn, kp, k0 >= 32 ? k0 - 32 : k0);
#pragma unroll
                for (int qt = 0; qt < 2; ++qt) {
                    bf16x8 pf[2];
                    f32x16 st;
#pragma unroll
                    for (int i = 0; i < 16; ++i) st[i] = 0.f;
                    const bool none = (k0 > q0 + 32 * qt + 30);
                    if (!none) {
#pragma unroll
                        for (int kk = 0; kk < 4; ++kk) st = MFMA32(kc[kk], qf[qt][kk], st);
                        const bool full = (k0 + 31 < q0 + 32 * qt);
                        const int lim = q0 + 32 * qt + r - k0 - 4 * h;
                        float om[16];
#pragma unroll
                        for (int i = 0; i < 16; ++i) {
                            const float e = __builtin_amdgcn_exp2f(-st[i]); float bta = __builtin_amdgcn_rcpf(1.f + e);
                            if (!full && !(((i & 3) + 8 * (i >> 2)) < lim)) bta = 0.f;
                            st[i] = bta; om[i] = 1.f - bta;
                        }
                        float G[4], Go[4];
#pragma unroll
                        for (int g = 0; g < 4; ++g) { G[g] = (om[4 * g] * om[4 * g + 1]) * (om[4 * g + 2] * om[4 * g + 3]); Go[g] = __shfl_xor(G[g], 32); }
                        float R = carry[qt];
#pragma unroll
                        for (int g = 3; g >= 0; --g) {
                            float run = h == 0 ? R * Go[g] : R;
#pragma unroll
                            for (int uu2 = 3; uu2 >= 0; --uu2) { const float bta = st[4 * g + uu2]; st[4 * g + uu2] = bta * run; run *= om[4 * g + uu2]; }
                            R = R * (G[g] * Go[g]);
                        }
                        carry[qt] = R;
                    }
                    if (!none) {
                        pf[0] = pack8(st, 0); pf[1] = pack8(st, 1);
#pragma unroll
                        for (int dt = 0; dt < 2; ++dt)
#pragma unroll
                            for (int s = 0; s < 2; ++s) ot[dt][qt] = MFMA32(vf[dt][s], pf[s], ot[dt][qt]);
                    }
                }
#pragma unroll
                for (int kk = 0; kk < 4; ++kk) kc[kk] = kn[kk];
                if (__all(carry[0] < SB_EXIT_THR && carry[1] < SB_EXIT_THR)) break;
            }
        }
        float ss[2];
#pragma unroll
        for (int qt = 0; qt < 2; ++qt) {
            float s2 = 0.f;
#pragma unroll
            for (int dt = 0; dt < 2; ++dt)
#pragma unroll
                for (int i = 0; i < 16; ++i) { ot[dt][qt][i] *= linv[qt]; s2 += ot[dt][qt][i] * ot[dt][qt][i]; }
            s2 += __shfl_xor(s2, 32); ss[qt] = s2;
        }
        __syncthreads();
        if (h == 0) { ssq[wid * 64 + r] = ss[0]; ssq[wid * 64 + 32 + r] = ss[1]; }
        __syncthreads();
        const float* gain = isB ? a.gain_b : a.gain_a;
#pragma unroll
        for (int qt = 0; qt < 2; ++qt) {
            float tot = 0.f;
#pragma unroll
            for (int w8 = 0; w8 < 8; ++w8) tot += ssq[w8 * 64 + 32 * qt + r];
            const float rs = rsqrtf(tot * (1.f / 512.f) + RMS_EPS);
            char* yst = lds + LDS_CVT + wid * (64 * 136);
#pragma unroll
            for (int dt = 0; dt < 2; ++dt)
#pragma unroll
                for (int g = 0; g < 4; ++g) {
                    const int d = 32 * dt + 8 * g + 4 * h; const f32x4 gn = *(const f32x4*)(gain + wid * 64 + d);
                    u32x2 o; o.x = cvt_pk_bf16(ot[dt][qt][4 * g] * rs * gn[0], ot[dt][qt][4 * g + 1] * rs * gn[1]); o.y = cvt_pk_bf16(ot[dt][qt][4 * g + 2] * rs * gn[2], ot[dt][qt][4 * g + 3] * rs * gn[3]);
                    *(u32x2*)(yst + (32 * qt + r) * 136 + d * 2) = o;
                }
        }
        {
            char* yst = lds + LDS_CVT + wid * (64 * 136);
            bf16_t* yb = a.y + (size_t)(b * SEQ + q0) * D_MODEL + (isB ? 512 : 0) + wid * 64;
#pragma unroll
            for (int j = 0; j < 8; ++j) {
                const int tok = (lane >> 3) + 8 * j, ch = lane & 7;
                const u32x2 lo = *(const u32x2*)(yst + tok * 136 + ch * 16), hi = *(const u32x2*)(yst + tok * 136 + ch * 16 + 8);
                *(u32x4*)(yb + (size_t)tok * D_MODEL + ch * 8) = (u32x4){lo.x, lo.y, hi.x, hi.y};
            }
        }
    }
}


#define XB_TMO      128
#define XB_XCNT(j)  (256  + 64 * (j))
#define XB_XSUB(j)  (1280 + 64 * (j))
#define XB_XGEN(j)  (2304 + 64 * (j))
#define XB_TOP      3328
#define XB_TOPGEN   3392
#define XCD_BAR_WORDS 3456
#define XB_SPIN_CAP (1u << 18)
#define LAS __attribute__((address_space(3)))

__device__ __forceinline__ unsigned xb_ld(unsigned* p)              { return __hip_atomic_load(p, __ATOMIC_RELAXED, __HIP_MEMORY_SCOPE_AGENT); }
__device__ __forceinline__ unsigned xb_add(unsigned* p, unsigned v) { return __hip_atomic_fetch_add(p, v, __ATOMIC_RELAXED, __HIP_MEMORY_SCOPE_AGENT); }
__device__ __forceinline__ unsigned xb_xcc_id() { return (unsigned)__builtin_amdgcn_s_getreg((3 << 11) | 20) & 0xFu; }
#define XB_SPIN(cond, bar) do { unsigned _sp = 0; while (cond) { __builtin_amdgcn_s_sleep(1); \
    if ((++_sp & 255u) == 0u) { if (xb_ld(&(bar)[XB_TMO])) break; if (_sp > XB_SPIN_CAP) { atomicAdd(&(bar)[XB_TMO], 1u); break; } } } } while (0)

struct XcdBarrier {
    unsigned* bar; unsigned x;
    volatile LAS unsigned* st;
};

__device__ __forceinline__ XcdBarrier xcd_barrier_post(unsigned* bar, volatile LAS unsigned* st) {
    XcdBarrier b; b.bar = bar; b.x = xb_xcc_id(); b.st = st;
    if (threadIdx.x == 0) (void)xb_add(&bar[XB_XCNT(b.x)], 1u);
    return b;
}
__device__ __forceinline__ void xcd_barrier_complete(unsigned* bar, unsigned x, unsigned& nloc, unsigned& nx) {
    const unsigned G = gridDim.x * gridDim.y * gridDim.z;
    unsigned sum, cnt, mine, sp = 0u;
    for (;;) {
        sum = 0u; cnt = 0u; mine = 0u;
#pragma unroll
        for (unsigned j = 0; j < 16; ++j) { const unsigned c = xb_ld(&bar[XB_XCNT(j)]); sum += c; cnt += (c > 0u) ? 1u : 0u; mine = (j == x) ? c : mine; }
        if (sum == G) break;
        __builtin_amdgcn_s_sleep(1);
        if ((++sp & 255u) == 0u) { if (xb_ld(&bar[XB_TMO])) break; if (sp > XB_SPIN_CAP) { atomicAdd(&bar[XB_TMO], 1u); break; } }
    }
    nloc = mine > 0u ? mine : 1u; nx = cnt > 0u ? cnt : 1u;
}

__device__ __forceinline__ void xcd_barrier(const XcdBarrier& b) {
    asm volatile("s_waitcnt vmcnt(0)" ::: "memory");
    __syncthreads();
    if (threadIdx.x == 0) {
        unsigned* bar = b.bar;
        __builtin_amdgcn_s_waitcnt(0);
        unsigned nloc = b.st[0], nx = b.st[1];
        if (nloc == 0u) { xcd_barrier_complete(bar, b.x, nloc, nx); b.st[0] = nloc; b.st[1] = nx; }
        const unsigned old = xb_add(&bar[XB_XSUB(b.x)], 1u);
        const unsigned gen = old / nloc;
        if (old + 1u == (gen + 1u) * nloc) {
            __builtin_amdgcn_fence(__ATOMIC_RELEASE, "agent");
            asm volatile("s_waitcnt vmcnt(0)" ::: "memory");
            const unsigned og = xb_add(&bar[XB_TOP], 1u);
            const unsigned tg = og / nx;
            if (og + 1u == (tg + 1u) * nx) xb_add(&bar[XB_TOPGEN], 1u);
            else XB_SPIN(xb_ld(&bar[XB_TOPGEN]) == tg, bar);
            __builtin_amdgcn_fence(__ATOMIC_ACQUIRE, "agent");
            xb_add(&bar[XB_XGEN(b.x)], 1u);
            asm volatile("s_waitcnt vmcnt(0)" ::: "memory");
        } else {
            XB_SPIN(xb_ld(&bar[XB_XGEN(b.x)]) == gen, bar);
            __builtin_amdgcn_fence(__ATOMIC_ACQUIRE, "agent");
            asm volatile("s_waitcnt vmcnt(0)" ::: "memory");
        }
    }
    __syncthreads();
}


struct MegaArgs { P0Args p0; P1Args p1; P2Args p2; P3Args p3; P4Args p4; P6Args p6; P7Args p7; P8Args p8; unsigned* bar; };
__global__ __launch_bounds__(NTHR, 2) void k_mega(MegaArgs a) {
    extern __shared__ __attribute__((aligned(16))) char smem[];
    volatile LAS unsigned* xbw = (volatile LAS unsigned*)(smem + LDS_BYTES - 16);
    if (threadIdx.x == 0) { xbw[0] = 0u; xbw[1] = 0u; xbw[2] = 0u; xbw[3] = 0u; }
    __syncthreads();
    XcdBarrier bar = xcd_barrier_post(a.bar, xbw);
    LAS unsigned char* L = (LAS unsigned char*)smem;
    phase_prologue(a.p0, smem);     xcd_barrier(bar);
    phase_qkv(a.p1, L);             xcd_barrier(bar);
    phase_attn(a.p2, a.p0, smem);   xcd_barrier(bar);
    phase_outproj(a.p3, L);         xcd_barrier(bar);
    phase_router(a.p4, a.p0, smem); xcd_barrier(bar);
    phase_moe_gu(a.p6, smem, L);    xcd_barrier(bar);
    phase_moe_down(a.p7, smem, L);  xcd_barrier(bar);
    phase_combine(a.p8, smem);
}

extern "C" void kernel_launch(void* const* d_in, const int* in_sizes, int n_in, void* d_out, int out_size, void* d_ws, size_t ws_size, hipStream_t stream) {
    const float* x = (const float*)d_in[0];      const float* w_in = (const float*)d_in[1];   const float* rel_bias = (const float*)d_in[2];
    const float* gain_a = (const float*)d_in[3]; const float* gain_b = (const float*)d_in[4]; const float* w_out = (const float*)d_in[5];
    const float* ln1_g = (const float*)d_in[6];  const float* ln1_b = (const float*)d_in[7];  const float* router_w = (const float*)d_in[8];
    const float* router_bias = (const float*)d_in[9]; const float* w_gate = (const float*)d_in[10]; const float* w_up = (const float*)d_in[11];
    const float* w_down = (const float*)d_in[12]; const float* ws_gate = (const float*)d_in[13]; const float* ws_up = (const float*)d_in[14];
    const float* ws_down = (const float*)d_in[15]; const float* ln2_g = (const float*)d_in[16]; const float* ln2_b = (const float*)d_in[17];
    char* ws = (char*)d_ws; float* out = (float*)d_out;
    int* ctrl = (int*)(ws + OFF_CTRL); int* counts = ctrl + CW_COUNTS;
    bf16_t* X1 = (bf16_t*)(ws + OFF_X1); int* tokl = (int*)(ws + OFF_TOKL); float* gatel = (float*)(ws + OFF_GATEL);
    int* eidx = (int*)(ws + OFF_EIDX); float* gate = (float*)(ws + OFF_GATE); int* slot = (int*)(ws + OFF_SLOT);
    unsigned char* H = (unsigned char*)(ws + OFF_H); unsigned char* Y = (unsigned char*)(ws + OFF_Y); unsigned char* x1f8 = (unsigned char*)(ws + OFF_X1F8);
    bf16_t* Q = (bf16_t*)(ws + OFF_Q); bf16_t* Kb = (bf16_t*)(ws + OFF_K); bf16_t* Vt = (bf16_t*)(ws + OFF_VT);
    bf16_t* yatt = (bf16_t*)(ws + OFF_YATT); bf16_t* r = (bf16_t*)(ws + OFF_R);
    bf16_t* xb = (bf16_t*)(ws + OFF_XB); float* stats = (float*)(ws + OFF_STATS);
    bf16_t* wt_in = (bf16_t*)(ws + OFF_WTIN); bf16_t* wt_out = (bf16_t*)(ws + OFF_WTOUT); bf16_t* wt_r = (bf16_t*)(ws + OFF_WTR);
    unsigned char* wgut = (unsigned char*)(ws + OFF_WGUT); unsigned char* wdt = (unsigned char*)(ws + OFF_WDT);
    if (ws_size < WS_NEEDED) { fprintf(stderr, "kernel_launch: workspace too small (%zu < %zu)\n", ws_size, (size_t)WS_NEEDED); return; }
    hipMemsetAsync(ctrl, 0, 128 * 1024, stream);
    static bool attr_done = false;
    if (!attr_done) {
        hipFuncSetAttribute((const void*)k_mega, hipFuncAttributeMaxDynamicSharedMemorySize, LDS_BYTES);
        attr_done = true;
    }
    MegaArgs m{};
    m.p0 = P0Args{x, w_in, w_out, router_w, xb, wt_in, wt_out, wt_r, w_gate, w_up, w_down, ws_gate, ws_up, ws_down, wgut, wdt};
    m.p1 = P1Args{xb, wt_in, Q, Kb, Vt};
    m.p2 = P2Args{Q, Kb, Vt, rel_bias, gain_a, gain_b, yatt};
    m.p3 = P3Args{yatt, wt_out, xb, r, stats};
    m.p4 = P4Args{r, stats, ln1_g, ln1_b, X1, x1f8, wt_r, router_bias, eidx, gate, counts, tokl, gatel, slot};
    m.p6 = P6Args{x1f8, counts, tokl, gatel, wgut, H};
    m.p7 = P7Args{H, counts, wdt, Y};
    m.p8 = P8Args{X1, Y, slot, counts, ln2_g, ln2_b, out};
    m.bar = (unsigned*)ctrl;
    k_mega<<<GRID, NTHR, LDS_BYTES, stream>>>(m);
}
```

```cpp
#include <hip/hip_runtime.h>
#include <cstdint>
#include <cstdio>

typedef unsigned short bf16_t;

constexpr int D_MODEL = 1024, BATCH = 16, SEQ = 2048, T_TOK = BATCH * SEQ;
constexpr int HEAD_DIM = 64, NHA = 8, NHB = 8, NHH = 16;
constexpr int CHUNK = 64, LEFT_CHUNKS = 8, MAX_REL = 128;
constexpr int N_EXP = 256, TOP_K = 8, N_GROUPS = 8, TOPK_GROUPS = 4, EPG = 32, D_EXP = 256;
constexpr float ROUTED_SCALE = 2.5f, LN_EPS = 1e-5f, RMS_EPS = 1e-6f;
constexpr float DN_ALPHA = 1.189207115002721f;
constexpr float LOG2E = 1.4426950408889634f, LN2 = 0.6931471805599453f;
constexpr float QSCALE = 0.125f * LOG2E;
constexpr float WSCALE = 64.f, XSCALE = 16.f, HSCALE = 16.f;
constexpr float YSCALE = 64.f;
constexpr int CAP = T_TOK;
constexpr int ROWS_ALL = T_TOK * TOP_K + T_TOK;

__device__ __forceinline__ float bf2f(bf16_t v) { return __uint_as_float(((unsigned)v) << 16); }
__device__ __forceinline__ bf16_t f2bf(float f) { unsigned u = __float_as_uint(f); u += 0x7fffu + ((u >> 16) & 1u); return (bf16_t)(u >> 16); }

constexpr size_t MB = 1024ull * 1024ull;
constexpr size_t OFF_CTRL   = 0;
constexpr size_t OFF_X1     = 1 * MB;
constexpr size_t OFF_TOKL   = OFF_X1 + 64 * MB;
constexpr size_t OFF_GATEL  = OFF_TOKL + 32 * MB;
constexpr size_t OFF_EIDX   = OFF_GATEL + 32 * MB;
constexpr size_t OFF_GATE   = OFF_EIDX + 1 * MB;
constexpr size_t OFF_SLOT   = OFF_GATE + 1 * MB;
constexpr size_t OFF_WDT    = OFF_SLOT + 1 * MB;
constexpr size_t OFF_X1F8   = OFF_WDT + 72 * MB;
constexpr size_t OFF_BIG    = OFF_WDT + 129 * MB;
constexpr size_t OFF_H      = OFF_BIG;
constexpr size_t OFF_Y      = OFF_BIG + 144 * MB;
constexpr size_t OFF_Q      = OFF_BIG;
constexpr size_t OFF_K      = OFF_BIG + 64 * MB;
constexpr size_t OFF_VT     = OFF_BIG + 128 * MB;
constexpr size_t OFF_YATT   = OFF_BIG + 192 * MB;
constexpr size_t OFF_R      = OFF_BIG + 256 * MB;
constexpr size_t OFF_XB     = OFF_BIG + 320 * MB;
constexpr size_t OFF_STATS  = OFF_BIG + 384 * MB;
constexpr size_t OFF_WTIN   = OFF_BIG + 392 * MB;
constexpr size_t OFF_WTOUT  = OFF_BIG + 398 * MB;
constexpr size_t OFF_WTR    = OFF_BIG + 400 * MB;
constexpr size_t OFF_WGUT   = OFF_BIG + 401 * MB;
constexpr size_t WS_NEEDED  = OFF_BIG + 720 * MB;
static_assert(OFF_WGUT + 257 * MB <= WS_NEEDED && WS_NEEDED <= 1024 * MB, "workspace map");
constexpr int CW_COUNTS = 8192;
constexpr int CSTR = 64;

typedef short bf16x8 __attribute__((ext_vector_type(8)));
typedef float f32x4 __attribute__((ext_vector_type(4)));
typedef float f32x2 __attribute__((ext_vector_type(2)));
typedef float f32x16 __attribute__((ext_vector_type(16)));
typedef unsigned u32x4 __attribute__((ext_vector_type(4)));
typedef unsigned u32x2 __attribute__((ext_vector_type(2)));
#define DI __device__ __forceinline__
constexpr int NTHR = 512, GRID = 256;
DI int tidx() { int t = threadIdx.x; asm volatile("" : "+v"(t)); return t; }
constexpr int LDS_BYTES = 160 * 1024;

typedef __bf16 bf16x2_t __attribute__((ext_vector_type(2)));
DI unsigned cvt_pk_bf16(float lo, float hi) { f32x2 v = {lo, hi}; bf16x2_t r = __builtin_convertvector(v, bf16x2_t); return __builtin_bit_cast(unsigned, r); }
DI float clamp8(float v) { return __builtin_amdgcn_fmed3f(v, -440.f, 440.f); }
DI unsigned pack_fp8x4(float a, float b, float c, float d) { int w = 0; w = __builtin_amdgcn_cvt_pk_fp8_f32(clamp8(a), clamp8(b), w, false); w = __builtin_amdgcn_cvt_pk_fp8_f32(clamp8(c), clamp8(d), w, true); return (unsigned)w; }
DI int vblock() { return (int)((blockIdx.x & 7) * (GRID / 8) + (blockIdx.x >> 3)); }

template <int MT> struct Tile { static constexpr int BM = 32 * MT, A_BYTES = BM * 128, B_BYTES = 256 * 128, STAGE = A_BYTES + B_BYTES; };

template <int MT> struct ALoader {
    const bf16_t* p[MT / 2]; u32x4 v[MT / 2]; int off0;
    DI void init_rows(const bf16_t* A, int lda, int row0) {
        const int tid = tidx(), kc = tid & 7, r = tid >> 3;
#pragma unroll
        for (int i = 0; i < MT / 2; ++i) p[i] = A + (size_t)(row0 + r + 64 * i) * lda + kc * 8;
        off0 = r * 128 + ((kc ^ ((r >> 1) & 7)) << 4);
    }
    DI void init_gather(const bf16_t* A, int lda, const int* rows, int cnt, int m0) {
        const int tid = tidx(), kc = tid & 7, r = tid >> 3;
#pragma unroll
        for (int i = 0; i < MT / 2; ++i) { int rr = m0 + r + 64 * i; rr = rr < cnt ? rr : cnt - 1; const int g = rows ? rows[rr] : rr; p[i] = A + (size_t)g * lda + kc * 8; }
        off0 = r * 128 + ((kc ^ ((r >> 1) & 7)) << 4);
    }
    DI void load(int k0) {
#pragma unroll
        for (int i = 0; i < MT / 2; ++i) v[i] = *(const u32x4*)(p[i] + k0);
    }
    DI void store(char* ldsA) const {
#pragma unroll
        for (int i = 0; i < MT / 2; ++i) *(u32x4*)(ldsA + off0 + i * 8192) = v[i];
    }
};
struct BLoaderBt {
    const bf16_t* p[4]; u32x4 v[4]; int off0;
    DI void init(const bf16_t* Bt, int ldk, int n0) {
        const int tid = tidx(), kc = tid & 7, r = tid >> 3;
#pragma unroll
        for (int i = 0; i < 4; ++i) p[i] = Bt + (size_t)(n0 + r + 64 * i) * ldk + kc * 8;
        off0 = r * 128 + ((kc ^ ((r >> 1) & 7)) << 4);
    }
    DI void load(int k0) {
#pragma unroll
        for (int i = 0; i < 4; ++i) v[i] = *(const u32x4*)(p[i] + k0);
    }
    DI void store(char* ldsB) const {
#pragma unroll
        for (int i = 0; i < 4; ++i) *(u32x4*)(ldsB + off0 + i * 8192) = v[i];
    }
};
template <int MT, bool TR, class AL, class BL>
DI void gemm_tile(char* lds, AL& al, BL& bl, int nk, f32x4 (&acc)[MT][4]) {
    typedef Tile<MT> TT;
    const int tid = tidx(), wid = tid >> 6, lane = tid & 63, wr = wid >> 2, wc = wid & 3, fr = lane & 15, fq = lane >> 4;
#pragma unroll
    for (int m = 0; m < MT; ++m)
#pragma unroll
        for (int n = 0; n < 4; ++n) acc[m][n] = (f32x4){0.f, 0.f, 0.f, 0.f};
    int aoff[2], boff[2];
#pragma unroll
    for (int ks = 0; ks < 2; ++ks) { const int ch = (((4 * ks + fq) ^ (fr >> 1)) << 4); aoff[ks] = (16 * MT * wr + fr) * 128 + ch; boff[ks] = TT::A_BYTES + (64 * wc + fr) * 128 + ch; }
    al.load(0); bl.load(0);
    __syncthreads();
    al.store(lds); bl.store(lds + TT::A_BYTES);
    __syncthreads();
    for (int kt = 0; kt < nk; ++kt) {
        char* cur = lds + (kt & 1) * TT::STAGE; char* nxt = lds + ((kt & 1) ^ 1) * TT::STAGE;
        const bool more = kt + 1 < nk;
        if (more) { al.load((kt + 1) * 64); bl.load((kt + 1) * 64); }
#pragma unroll
        for (int ks = 0; ks < 2; ++ks) {
            bf16x8 a[MT], b[4];
#pragma unroll
            for (int m = 0; m < MT; ++m) a[m] = *(const bf16x8*)(cur + aoff[ks] + m * 2048);
#pragma unroll
            for (int n = 0; n < 4; ++n) b[n] = *(const bf16x8*)(cur + boff[ks] + n * 2048);
#pragma unroll
            for (int m = 0; m < MT; ++m)
#pragma unroll
                for (int n = 0; n < 4; ++n)
                    acc[m][n] = TR ? __builtin_amdgcn_mfma_f32_16x16x32_bf16(b[n], a[m], acc[m][n], 0, 0, 0) : __builtin_amdgcn_mfma_f32_16x16x32_bf16(a[m], b[n], acc[m][n], 0, 0, 0);
        }
        if (more) { al.store(nxt); bl.store(nxt + TT::A_BYTES); }
        __syncthreads();
    }
}

#define LAS __attribute__((address_space(3)))
namespace gs {
constexpr int BM = 256, BK = 64, HALF = 128, HTB = HALF * BK * 2, STAGE_BYTES = 8 * HTB;
DI int lds_byte(int r, int c) { const int st = (r >> 4) * 2 + (c >> 5), rr = r & 15, cc = c & 31, ob = rr * 64 + cc * 2; return st * 1024 + (ob ^ (((ob >> 9) & 1) << 5)); }
DI void stage_rc(int b, int& R, int& C) { const int st = b / 1024, sb = b % 1024, swz = sb ^ (((sb >> 9) & 1) << 5); R = (st >> 1) * 16 + swz / 64; C = (st & 1) * 32 + (swz % 64) / 2; }
DI int perm32(int rho) { const int n = rho >> 4, i = rho & 15; return 8 * (i >> 2) + 4 * n + (i & 3); }
typedef long i64x2 __attribute__((ext_vector_type(2)));
DI const char* uni(const char* p) { const unsigned long long v = (unsigned long long)p; const unsigned lo = __builtin_amdgcn_readfirstlane((unsigned)v), hi = __builtin_amdgcn_readfirstlane((unsigned)(v >> 32)); return (const char*)(((unsigned long long)hi << 32) | lo); }
template <bool TR, bool F8>
DI f32x4 mma16(const bf16x8& a, const bf16x8& b, f32x4 c) {
    if (F8) {
        const i64x2 a2 = __builtin_bit_cast(i64x2, a), b2 = __builtin_bit_cast(i64x2, b);
        c = TR ? __builtin_amdgcn_mfma_f32_16x16x32_fp8_fp8(b2[0], a2[0], c, 0, 0, 0) : __builtin_amdgcn_mfma_f32_16x16x32_fp8_fp8(a2[0], b2[0], c, 0, 0, 0);
        return TR ? __builtin_amdgcn_mfma_f32_16x16x32_fp8_fp8(b2[1], a2[1], c, 0, 0, 0) : __builtin_amdgcn_mfma_f32_16x16x32_fp8_fp8(a2[1], b2[1], c, 0, 0, 0);
    }
    return TR ? __builtin_amdgcn_mfma_f32_16x16x32_bf16(b, a, c, 0, 0, 0) : __builtin_amdgcn_mfma_f32_16x16x32_bf16(a, b, c, 0, 0, 0);
}
typedef int i32x8 __attribute__((ext_vector_type(8)));
typedef short bf16x16 __attribute__((ext_vector_type(16)));
template <bool TR>
DI f32x4 mma128(const bf16x16& a, const bf16x16& b, f32x4 c) {
    const i32x8 av = __builtin_bit_cast(i32x8, a), bv = __builtin_bit_cast(i32x8, b);
    const int one = 0x7F7F7F7F;
    if (TR) asm volatile("v_mfma_scale_f32_16x16x128_f8f6f4 %0, %1, %2, %0, %3, %3 op_sel_hi:[0,0,0]" : "+v"(c) : "v"(bv), "v"(av), "v"(one));
    else    asm volatile("v_mfma_scale_f32_16x16x128_f8f6f4 %0, %1, %2, %0, %3, %3 op_sel_hi:[0,0,0]" : "+v"(c) : "v"(av), "v"(bv), "v"(one));
    return c;
}
DI bf16x8 frag_lo(const bf16x16& v) { return __builtin_shufflevector(v, v, 0, 1, 2, 3, 4, 5, 6, 7); }
DI bf16x8 frag_hi(const bf16x16& v) { return __builtin_shufflevector(v, v, 8, 9, 10, 11, 12, 13, 14, 15); }
template <bool TR, bool PERM, int F8, class Sched, class Epi>
DI void gemm_stream(LAS unsigned char* lds, const int K, const Sched& S, const Epi& E) {
    typedef typename Sched::U U;
    const int tid = tidx(), wid = __builtin_amdgcn_readfirstlane(tid >> 6), lane = tid & 63, wr = wid >> 2, wc = wid & 3, fr = lane & 15, fq = lane >> 4;
    const int nt = K / BK;
    int R[2], C[2]; unsigned voffB[2];
#pragma unroll
    for (int i = 0; i < 2; ++i) { stage_rc(tid * 16 + i * 8192, R[i], C[i]); const int Rb = PERM ? ((R[i] & ~31) + perm32(R[i] & 31)) : R[i]; voffB[i] = (unsigned)(Rb * K + C[i]) * 2u; }
    const size_t kstep = (size_t)(BK * 2), hstepB = (size_t)HALF * K * 2;
    const unsigned ldsw = (unsigned)wid * 1024u;
    const int aoff = lds_byte(wr * 64 + fr, fq * 8), boff = lds_byte(wc * 32 + fr, fq * 8);
#define GS_SA(b, h) (((b) * 2 + (h)) * HTB)
#define GS_SB(b, h) ((4 + (b) * 2 + (h)) * HTB)
#define GS_STAGE(bufoff, gbase, uix, h) do { _Pragma("unroll") for (int _i = 0; _i < 2; ++_i) \
        __builtin_amdgcn_global_load_lds((const unsigned*)((const char*)(gbase) + S.a_voff(uix, h, R[_i], C[_i])), (LAS unsigned*)(lds + (bufoff) + ldsw + _i * 8192), 16, 0, 0); } while (0)
#define GS_STAGEB(bufoff, gbase, voff) do { _Pragma("unroll") for (int _i = 0; _i < 2; ++_i) \
        __builtin_amdgcn_global_load_lds((const unsigned*)((const char*)(gbase) + (voff)[_i]), (LAS unsigned*)(lds + (bufoff) + ldsw + _i * 8192), 16, 0, 0); } while (0)
#define GS_LD32(base) __builtin_shufflevector(*(const LAS bf16x8*)(base), *(const LAS bf16x8*)((base) + 1024), 0, 1, 2, 3, 4, 5, 6, 7, 8, 9, 10, 11, 12, 13, 14, 15)
#define GS_LDA(dst, b, h) do { _Pragma("unroll") for (int m = 0; m < 4; ++m) dst[m] = GS_LD32(lds + GS_SA(b, h) + aoff + m * 2048); } while (0)
#define GS_LDB(dst, b, h) do { _Pragma("unroll") for (int n = 0; n < 2; ++n) dst[n] = GS_LD32(lds + GS_SB(b, h) + boff + n * 2048); } while (0)
#define GS_MMA(ai, bj, At, Bt) do { __builtin_amdgcn_s_setprio(1); _Pragma("unroll") for (int m = 0; m < 4; ++m) _Pragma("unroll") for (int n = 0; n < 2; ++n) { \
        if (F8 == 2) acc[ai][bj][m][n] = mma128<TR>(At[m], Bt[n], acc[ai][bj][m][n]); \
        else { acc[ai][bj][m][n] = mma16<TR, F8 == 1>(frag_lo(At[m]), frag_lo(Bt[n]), acc[ai][bj][m][n]); acc[ai][bj][m][n] = mma16<TR, F8 == 1>(frag_hi(At[m]), frag_hi(Bt[n]), acc[ai][bj][m][n]); } } \
        __builtin_amdgcn_s_setprio(0); } while (0)
#define GS_WAIT_V(n) asm volatile("s_waitcnt vmcnt(" #n ")" ::: "memory")
#define GS_WAIT_L(n) asm volatile("s_waitcnt lgkmcnt(" #n ")" ::: "memory")
#define GS_BAR __builtin_amdgcn_s_barrier()
#define GS_SCHED __builtin_amdgcn_sched_barrier(0)
    U cur, nxt; int ui = 0;
    if (!S.next(0, cur)) return;
    f32x4 acc[2][2][4][2];
#pragma unroll
    for (int a = 0; a < 2; ++a)
#pragma unroll
        for (int b = 0; b < 2; ++b)
#pragma unroll
            for (int m = 0; m < 4; ++m)
#pragma unroll
                for (int n = 0; n < 2; ++n) acc[a][b][m][n] = (f32x4){0.f, 0.f, 0.f, 0.f};
    bf16x16 At[4], B0[2], B1[2];
    const char* cA = uni(cur.A); const char* cB = uni(cur.B);
    GS_STAGEB(GS_SB(0, 0), cB, voffB); GS_STAGEB(GS_SB(0, 1), cB + hstepB, voffB); GS_STAGE(GS_SA(0, 0), cA, 0, 0); GS_STAGE(GS_SA(0, 1), cA, 0, 1);
    if (wr == 1) GS_BAR;
    GS_WAIT_V(2); GS_BAR;
    GS_STAGEB(GS_SB(1, 0), cB + kstep, voffB); GS_STAGE(GS_SA(1, 0), cA + kstep, 0, 0); GS_STAGEB(GS_SB(1, 1), cB + hstepB + kstep, voffB);
    GS_WAIT_V(6); GS_BAR;
    for (;;) {
        const bool has_next = S.next(ui + 1, nxt);
        const int nui = has_next ? ui + 1 : ui;
        const char* nA = uni(has_next ? nxt.A : cA); const char* nB = uni(has_next ? nxt.B : cB);
#pragma unroll 1
        for (int t = 0; t < nt; t += 2) {
            const bool last = (t == nt - 2);
            const char* a1 = uni(cA + (size_t)(t + 1) * kstep);
            const char* a2 = uni(last ? nA : cA + (size_t)(t + 2) * kstep); const char* b2 = uni(last ? nB : cB + (size_t)(t + 2) * kstep);
            const char* a3 = uni(a2 + kstep); const char* b3 = uni(b2 + kstep);
            const int u2 = last ? nui : ui;
            GS_LDB(B0, 0, 0); GS_LDB(B1, 0, 1); GS_SCHED; GS_LDA(At, 0, 0); GS_STAGE(GS_SA(1, 1), a1, ui, 1);
            GS_WAIT_V(8); GS_WAIT_L(0); GS_BAR; GS_MMA(0, 0, At, B0); GS_MMA(0, 1, At, B1); GS_BAR; GS_SCHED;
            GS_LDA(At, 0, 1); GS_STAGEB(GS_SB(0, 0), b2, voffB); GS_STAGEB(GS_SB(0, 1), b2 + hstepB, voffB); GS_STAGE(GS_SA(0, 0), a2, u2, 0);
            GS_WAIT_V(8); GS_WAIT_L(0); GS_BAR; GS_MMA(1, 0, At, B0); GS_MMA(1, 1, At, B1); GS_BAR; GS_SCHED;
            GS_LDB(B0, 1, 0); GS_LDB(B1, 1, 1); GS_SCHED; GS_LDA(At, 1, 0); GS_STAGE(GS_SA(0, 1), a2, u2, 1);
            GS_WAIT_V(8); GS_WAIT_L(0); GS_BAR; GS_MMA(0, 0, At, B0); GS_MMA(0, 1, At, B1); GS_BAR; GS_SCHED;
            GS_LDA(At, 1, 1); GS_STAGEB(GS_SB(1, 0), b3, voffB); GS_STAGEB(GS_SB(1, 1), b3 + hstepB, voffB); GS_STAGE(GS_SA(1, 0), a3, u2, 0);
            GS_WAIT_V(8); GS_WAIT_L(0); GS_BAR; GS_MMA(1, 0, At, B0); GS_MMA(1, 1, At, B1); GS_BAR; GS_SCHED;
        }
        if (wr == 0) GS_BAR;
        if (F8 == 2) asm volatile("s_nop 15\n\ts_nop 15\n\ts_nop 15\n\ts_nop 15\n\ts_nop 15\n\ts_nop 15" ::: "memory");
        E(acc, cur, wr, wc, fr, fq);
        if (!has_next) break;
#pragma unroll
        for (int a = 0; a < 2; ++a)
#pragma unroll
            for (int b = 0; b < 2; ++b)
#pragma unroll
                for (int m = 0; m < 4; ++m)
#pragma unroll
                    for (int n = 0; n < 2; ++n) acc[a][b][m][n] = (f32x4){0.f, 0.f, 0.f, 0.f};
        cur = nxt; cA = nA; cB = nB; ++ui;
        if (wr == 1) GS_BAR;
    }
    GS_WAIT_V(0);
    GS_BAR;
#undef GS_SA
#undef GS_SB
#undef GS_STAGE
#undef GS_STAGEB
#undef GS_LDA
#undef GS_LD32
#undef GS_LDB
#undef GS_MMA
#undef GS_WAIT_V
#undef GS_WAIT_L
#undef GS_BAR
#undef GS_SCHED
}
struct DenseU { const char* A; const char* B; int pm, pn; };
struct DenseSched {
    typedef DenseU U;
    const bf16_t* A; const bf16_t* Bt; int K, nunits, first, stride, npn, pn_base, pn_mod0, pn_mod1;
    DI int colmap(int q) const { return pn_base + (q / pn_mod0) * pn_mod1 + (q % pn_mod0); }
    DI bool next(int i, U& u) const {
        const int L = first + i * stride; if (L >= nunits) return false;
        u.pm = L / npn; u.pn = colmap(L % npn);
        u.A = (const char*)A + (size_t)u.pm * BM * K * 2; u.B = (const char*)Bt + (size_t)u.pn * BM * K * 2; return true;
    }
    DI unsigned a_voff(int, int h, int R, int C) const { return (unsigned)((HALF * h + R) * K + C) * 2u; }
};
}

DI void transpose_cvt(const float* W, bf16_t* Wt, int K, int N, int unit, char* lds) {
    float* tile = (float*)lds;
    const int nbn = N / 64, kb = unit / nbn, nb = unit % nbn, tid = tidx();
    __syncthreads();
#pragma unroll
    for (int i = 0; i < 8; ++i) { const int idx = tid + i * 512, r = idx >> 6, c = idx & 63; tile[r * 65 + c] = W[(size_t)(kb * 64 + r) * N + nb * 64 + c]; }
    __syncthreads();
#pragma unroll
    for (int i = 0; i < 8; ++i) { const int idx = tid + i * 512, n = idx >> 6, k = idx & 63; Wt[(size_t)(nb * 64 + n) * K + kb * 64 + k] = f2bf(tile[k * 65 + n]); }
}
struct P0Args { const float* x; const float* w_in; const float* w_out; const float* router_w; bf16_t* xb; bf16_t* wt_in; bf16_t* wt_out; bf16_t* wt_r;
                const float* w_gate; const float* w_up; const float* w_down; const float* ws_gate; const float* ws_up; const float* ws_down; unsigned char* wgut; unsigned char* wdt; };
constexpr int CV_GU = 257 * 2 * 16, CV_DN = 257 * 16;
struct CvItem { const float* src; unsigned char* dst; int ld, ldd, rbase, rhi; };
DI CvItem cv_item(const P0Args& a, int it) {
    CvItem c;
    if (it < CV_GU) {
        const int e = it / 32, u = (it >> 4) & 1, kt = it & 15;
        const float* W = e < N_EXP ? (u ? a.w_up : a.w_gate) + (size_t)e * D_MODEL * D_EXP : (u ? a.ws_up : a.ws_gate);
        c.src = W + (size_t)kt * 64 * D_EXP; c.ld = D_EXP; c.dst = a.wgut + (size_t)e * 512 * D_MODEL + kt * 64; c.ldd = D_MODEL; c.rbase = 128 * u; c.rhi = 256;
    } else {
        const int j = it - CV_GU, e = j / 16, kt = (j >> 2) & 3, nb = j & 3;
        const float* W = e < N_EXP ? a.w_down + (size_t)e * D_EXP * D_MODEL : a.ws_down;
        c.src = W + (size_t)kt * 64 * D_MODEL + nb * 256; c.ld = D_MODEL; c.dst = a.wdt + (size_t)e * D_MODEL * D_EXP + kt * 64; c.ldd = D_EXP; c.rbase = 256 * nb; c.rhi = 128;
    }
    return c;
}
constexpr int CV_TILE_BYTES = 64 * 260 * 4;
DI void cv_dma_nt(const char* sbase, unsigned voff, unsigned lds_dst) {
    unsigned keep;
    asm volatile("s_mov_b32 %0, m0\n\ts_mov_b32 m0, %3\n\ts_nop 0\n\tglobal_load_lds_dwordx4 %1, %2 nt\n\ts_mov_b32 m0, %0" : "=&s"(keep) : "v"(voff), "s"(sbase), "s"(lds_dst) : "memory");
}
DI const char* uni64(const void* p) { const unsigned long long v = (unsigned long long)p; const unsigned lo = __builtin_amdgcn_readfirstlane((unsigned)v), hi = __builtin_amdgcn_readfirstlane((unsigned)(v >> 32)); return (const char*)(((unsigned long long)hi << 32) | lo); }
DI void cv_issue(const CvItem& c, LAS unsigned char* tile) {
    const int tid = tidx(), w = __builtin_amdgcn_readfirstlane(tid >> 6), l = tid & 63;
    const char* sb = uni64(c.src); const unsigned tb = (unsigned)__builtin_amdgcn_readfirstlane((unsigned)(size_t)tile);
#pragma unroll
    for (int i = 0; i < 8; ++i) { const int k = 8 * w + i; cv_dma_nt(sb, (unsigned)(k * c.ld + 4 * (l ^ w)) * 4u, tb + (unsigned)(k * 1040)); }
}
DI void lds_barrier() { asm volatile("s_waitcnt lgkmcnt(0)" ::: "memory"); __builtin_amdgcn_s_barrier(); asm volatile("" ::: "memory"); }
DI void cv_emit(const CvItem& c, const char* lds) {
    const float* tile = (const float*)lds;
    const int tid = tidx();
#pragma unroll
    for (int i = 0; i < 4; ++i) {
        const int idx = tid + i * 512, kc = idx & 7, n = idx >> 3; const float* p = tile + (8 * kc) * 260 + (n ^ (4 * kc));
        const unsigned w0 = pack_fp8x4(p[0] * WSCALE, p[260] * WSCALE, p[2 * 260] * WSCALE, p[3 * 260] * WSCALE), w1 = pack_fp8x4(p[4 * 260] * WSCALE, p[5 * 260] * WSCALE, p[6 * 260] * WSCALE, p[7 * 260] * WSCALE);
        __builtin_nontemporal_store((u32x2){w0, w1}, (u32x2*)(c.dst + (size_t)(c.rbase + (n >> 7) * c.rhi + (n & 127)) * c.ldd + 8 * kc));
    }
}
DI void convert_moe_range(const P0Args& a, char* lds, const int lo, const int hi) {
    int it = lo + vblock(); if (it >= hi) return;
    __syncthreads();
    LAS unsigned char* t0 = (LAS unsigned char*)lds; LAS unsigned char* t1 = t0 + CV_TILE_BYTES;
    CvItem c = cv_item(a, it); cv_issue(c, t0);
    int pp = 0;
#pragma unroll 1
    for (;;) {
        const int nit = it + GRID; const bool more = nit < hi;
        CvItem cn = c;
        if (more) { cn = cv_item(a, nit); cv_issue(cn, pp ? t0 : t1); }
        if (more) asm volatile("s_waitcnt vmcnt(8)" ::: "memory"); else asm volatile("s_waitcnt vmcnt(0)" ::: "memory");
        lds_barrier();
        cv_emit(c, lds + (pp ? CV_TILE_BYTES : 0));
        lds_barrier();
        if (!more) break;
        it = nit; c = cn; pp ^= 1;
    }
    asm volatile("s_waitcnt vmcnt(0)" ::: "memory");
    __syncthreads();
}
DI void phase_prologue(const P0Args& a, char* lds) {
    const int vb = vblock();
    for (size_t i = (size_t)vb * NTHR + tidx(); i < (size_t)T_TOK * D_MODEL / 8; i += (size_t)GRID * NTHR) {
        const f32x4 v0 = *(const f32x4*)(a.x + i * 8), v1 = *(const f32x4*)(a.x + i * 8 + 4);
        u32x4 o; o.x = cvt_pk_bf16(v0[0], v0[1]); o.y = cvt_pk_bf16(v0[2], v0[3]); o.z = cvt_pk_bf16(v1[0], v1[1]); o.w = cvt_pk_bf16(v1[2], v1[3]);
        *(u32x4*)(a.xb + i * 8) = o;
    }
    const int n_in = (1024 / 64) * (3072 / 64), n_out = 16 * 16, n_r = 16 * 4;
    for (int u = vb; u < n_in + n_out + n_r; u += GRID) {
        if (u < n_in) transpose_cvt(a.w_in, a.wt_in, 1024, 3072, u, lds);
        else if (u < n_in + n_out) transpose_cvt(a.w_out, a.wt_out, 1024, 1024, u - n_in, lds);
        else transpose_cvt(a.router_w, a.wt_r, 1024, 256, u - n_in - n_out, lds);
    }
}


struct P1Args { const bf16_t* xb; const bf16_t* wt_in; bf16_t* Q; bf16_t* Kb; bf16_t* Vt; };
struct EpiQK { bf16_t* Q; bf16_t* Kb;
    DI void operator()(const f32x4 (&acc)[2][2][4][2], const gs::DenseU& u, int wr, int wc, int fr, int fq) const {
        const int seg = u.pn >> 1, type = seg % 3, grp = seg / 3; bf16_t* dst = type == 0 ? Q : Kb; const float sc = type == 0 ? QSCALE : 1.f;
#pragma unroll
        for (int ai = 0; ai < 2; ++ai)
#pragma unroll
            for (int m = 0; m < 4; ++m) {
                const int row = u.pm * 256 + 128 * ai + 64 * wr + 16 * m + fr, b = row / SEQ, s = row % SEQ;
#pragma unroll
                for (int bj = 0; bj < 2; ++bj) {
                    const int hh = grp * 8 + 4 * (u.pn & 1) + 2 * bj + (wc >> 1), d0 = 32 * (wc & 1) + 8 * fq;
                    const f32x4 v0 = acc[ai][bj][m][0] * sc, v1 = acc[ai][bj][m][1] * sc;
                    u32x4 o; o.x = cvt_pk_bf16(v0[0], v0[1]); o.y = cvt_pk_bf16(v0[2], v0[3]); o.z = cvt_pk_bf16(v1[0], v1[1]); o.w = cvt_pk_bf16(v1[2], v1[3]);
                    *(u32x4*)(dst + (size_t)(b * NHH + hh) * SEQ * 64 + (s >> 5) * 2048 + ((d0 >> 3) * 32 + (s & 31)) * 8) = o;
                }
            }
    } };
struct EpiV { bf16_t* Vt;
    DI void operator()(const f32x4 (&acc)[2][2][4][2], const gs::DenseU& u, int wr, int wc, int fr, int fq) const {
        const int grp = (u.pn >> 1) / 3;
#pragma unroll
        for (int ai = 0; ai < 2; ++ai)
#pragma unroll
            for (int m = 0; m < 4; ++m) {
                const int row = u.pm * 256 + 128 * ai + 64 * wr + 16 * m + 4 * fq, b = row / SEQ, s = row % SEQ;
#pragma unroll
                for (int bj = 0; bj < 2; ++bj)
#pragma unroll
                    for (int n = 0; n < 2; ++n) {
                        const int hh = grp * 8 + 4 * (u.pn & 1) + 2 * bj + (wc >> 1), d = 32 * (wc & 1) + 16 * n + fr;
                        const f32x4 v = acc[ai][bj][m][n];
                        u32x2 o; o.x = cvt_pk_bf16(v[0], v[1]); o.y = cvt_pk_bf16(v[2], v[3]);
                        { const int kap = s & 31; *(u32x2*)(Vt + (size_t)(b * NHH + hh) * SEQ * 64 + (s >> 5) * 2048 + ((((d >> 5) * 2 + (kap >> 4)) * 2 + ((kap >> 2) & 1)) * 32 + (d & 31)) * 8 + ((kap >> 3) & 1) * 4) = o; }
                    }
            }
    } };
DI void phase_qkv(const P1Args& a, LAS unsigned char* lds) {
    { gs::DenseSched S{a.xb, a.wt_in, D_MODEL, (T_TOK / 256) * 8, vblock(), GRID, 8, 0, 4, 6}; EpiQK E{a.Q, a.Kb}; gs::gemm_stream<true, true, 0>(lds, D_MODEL, S, E); }
    { gs::DenseSched S{a.xb, a.wt_in, D_MODEL, (T_TOK / 256) * 4, vblock(), GRID, 4, 4, 2, 6}; EpiV E{a.Vt}; gs::gemm_stream<false, false, 0>(lds, D_MODEL, S, E); }
}

struct P3Args { const bf16_t* y; const bf16_t* wt_out; const bf16_t* xb; bf16_t* r; float* stats; };
struct EpiOut { const bf16_t* xb; bf16_t* r; float* stats;
    DI void operator()(const f32x4 (&acc)[2][2][4][2], const gs::DenseU& u, int wr, int wc, int fr, int fq) const {
#pragma unroll
        for (int ai = 0; ai < 2; ++ai) {
            u32x4 xw[4][2];
#pragma unroll
            for (int m = 0; m < 4; ++m)
#pragma unroll
                for (int bj = 0; bj < 2; ++bj) xw[m][bj] = *(const u32x4*)(xb + (size_t)(u.pm * 256 + 128 * ai + 64 * wr + 16 * m + fr) * D_MODEL + u.pn * 256 + 128 * bj + 32 * wc + 8 * fq);
#pragma unroll
            for (int m = 0; m < 4; ++m) {
                const int row = u.pm * 256 + 128 * ai + 64 * wr + 16 * m + fr;
#pragma unroll
                for (int bj = 0; bj < 2; ++bj) {
                    const int col = u.pn * 256 + 128 * bj + 32 * wc + 8 * fq;
                    const u32x4 w = xw[m][bj];
                    const f32x4 x0 = (f32x4){__uint_as_float(w[0] << 16), __uint_as_float(w[0] & 0xffff0000u), __uint_as_float(w[1] << 16), __uint_as_float(w[1] & 0xffff0000u)};
                    const f32x4 x1 = (f32x4){__uint_as_float(w[2] << 16), __uint_as_float(w[2] & 0xffff0000u), __uint_as_float(w[3] << 16), __uint_as_float(w[3] & 0xffff0000u)};
                    const f32x4 v0 = x0 * DN_ALPHA + acc[ai][bj][m][0], v1 = x1 * DN_ALPHA + acc[ai][bj][m][1];
                    float s = ((v0[0] + v0[1]) + (v0[2] + v0[3])) + ((v1[0] + v1[1]) + (v1[2] + v1[3]));
                    float q = ((v0[0] * v0[0] + v0[1] * v0[1]) + (v0[2] * v0[2] + v0[3] * v0[3])) + ((v1[0] * v1[0] + v1[1] * v1[1]) + (v1[2] * v1[2] + v1[3] * v1[3]));
                    u32x4 o; o.x = cvt_pk_bf16(v0[0], v0[1]); o.y = cvt_pk_bf16(v0[2], v0[3]); o.z = cvt_pk_bf16(v1[0], v1[1]); o.w = cvt_pk_bf16(v1[2], v1[3]);
                    *(u32x4*)(r + (size_t)row * D_MODEL + col) = o;
                    s += __shfl_xor(s, 16); s += __shfl_xor(s, 32); q += __shfl_xor(q, 16); q += __shfl_xor(q, 32);
                    if (fq == 0) *(f32x2*)(stats + ((size_t)row * 32 + u.pn * 8 + bj * 4 + wc) * 2) = (f32x2){s, q};
                }
            }
        }
    } };
DI void phase_outproj(const P3Args& a, LAS unsigned char* lds) {
    gs::DenseSched S{a.y, a.wt_out, D_MODEL, (T_TOK / 256) * 4, vblock(), GRID, 4, 0, 4, 0}; EpiOut E{a.xb, a.r, a.stats}; gs::gemm_stream<true, true, 0>(lds, D_MODEL, S, E);
}

DI void unpack16(const u32x4& a, const u32x4& b, float (&v)[16]) {
#pragma unroll
    for (int j = 0; j < 4; ++j) { v[2 * j] = __uint_as_float(a[j] << 16); v[2 * j + 1] = __uint_as_float(a[j] & 0xffff0000u); v[8 + 2 * j] = __uint_as_float(b[j] << 16); v[8 + 2 * j + 1] = __uint_as_float(b[j] & 0xffff0000u); }
}
constexpr int RS_SC = 289;
constexpr int LDS_HIST = 100 * 1024;
struct P4Args { const bf16_t* r; const float* stats; const float* ln_g; const float* ln_b; bf16_t* x1; unsigned char* x1f8; const bf16_t* wt_r; const float* rbias;
                int* eidx; float* gate; int* counts; int* tokl; float* gatel; int* slot; };
DI void phase_router(const P4Args& a, const P0Args& cv, char* lds) {
    const int tid = tidx(), wid = tid >> 6, lane = tid & 63, wr = wid >> 2, wc = wid & 3, fr = lane & 15, fq = lane >> 4;
    float* sc = (float*)lds; int* hist = (int*)(lds + LDS_HIST); int* base = hist + 256;
    for (int u = vblock(); u < T_TOK / 128; u += GRID) {
        const int m0 = u * 128;
        if ((vblock() & 1) == 0) convert_moe_range(cv, lds, CV_GU, CV_GU + CV_DN);
        __syncthreads();
#pragma unroll 1
        for (int i0 = 0; i0 < 16; i0 += 4) {
            f32x2 st[4]; u32x4 r0[4], r1[4];
#pragma unroll
            for (int j4 = 0; j4 < 4; ++j4) {
                const int t = m0 + wid * 16 + i0 + j4;
                st[j4] = (f32x2){0.f, 0.f};
                if (lane < 32) st[j4] = *(const f32x2*)(a.stats + ((size_t)t * 32 + lane) * 2);
                r0[j4] = *(const u32x4*)(a.r + (size_t)t * D_MODEL + lane * 16); r1[j4] = *(const u32x4*)(a.r + (size_t)t * D_MODEL + lane * 16 + 8);
            }
#pragma unroll
            for (int j4 = 0; j4 < 4; ++j4) {
                const int t = m0 + wid * 16 + i0 + j4;
                float s = st[j4].x, q = st[j4].y;
#pragma unroll
                for (int o = 1; o <= 16; o <<= 1) { s += __shfl_xor(s, o); q += __shfl_xor(q, o); }
                s = __shfl(s, 0); q = __shfl(q, 0);
                const float mu = s * (1.f / 1024.f), rstd = rsqrtf(q * (1.f / 1024.f) - mu * mu + LN_EPS);
                float v[16]; unpack16(r0[j4], r1[j4], v);
                u32x4 o0, o1, o8;
#pragma unroll
                for (int j = 0; j < 4; ++j) {
                    const f32x4 g = *(const f32x4*)(a.ln_g + lane * 16 + 4 * j), bb = *(const f32x4*)(a.ln_b + lane * 16 + 4 * j);
                    const float y0 = (v[4 * j] - mu) * rstd * g[0] + bb[0], y1 = (v[4 * j + 1] - mu) * rstd * g[1] + bb[1], y2 = (v[4 * j + 2] - mu) * rstd * g[2] + bb[2], y3 = (v[4 * j + 3] - mu) * rstd * g[3] + bb[3];
                    o8[j] = pack_fp8x4(y0 * XSCALE, y1 * XSCALE, y2 * XSCALE, y3 * XSCALE);
                    const unsigned p0 = cvt_pk_bf16(y0, y1), p1 = cvt_pk_bf16(y2, y3);
                    if (j < 2) { o0[2 * j] = p0; o0[2 * j + 1] = p1; } else { o1[2 * (j - 2)] = p0; o1[2 * (j - 2) + 1] = p1; }
                }
                *(u32x4*)(a.x1 + (size_t)t * D_MODEL + lane * 16) = o0; *(u32x4*)(a.x1 + (size_t)t * D_MODEL + lane * 16 + 8) = o1;
                *(u32x4*)(a.x1f8 + (size_t)t * D_MODEL + lane * 16) = o8;
            }
        }
        if (tid < 256) hist[tid] = 0;
        asm volatile("s_waitcnt vmcnt(0)" ::: "memory");
        __syncthreads();
        ALoader<4> al; al.init_rows(a.x1, D_MODEL, m0);
        BLoaderBt bl; bl.init(a.wt_r, D_MODEL, 0);
        f32x4 acc[4][4];
        gemm_tile<4, true>(lds, al, bl, D_MODEL / 64, acc);
        int my_idx[2], my_rank[2]; float my_gate[2];
#pragma unroll
        for (int p = 0; p < 2; ++p) {
            __syncthreads();
            if (wr == p) {
#pragma unroll
                for (int m = 0; m < 4; ++m)
#pragma unroll
                    for (int n = 0; n < 4; ++n) {
                        const int c0 = 64 * wc + 16 * n + 4 * fq; const f32x4 rb = *(const f32x4*)(a.rbias + c0);
#pragma unroll
                        for (int j = 0; j < 4; ++j) { const int c = c0 + j; sc[(16 * m + fr) * RS_SC + (c >> 5) * 36 + (c & 31)] = 1.f / (1.f + __expf(-acc[m][n][j])) + rb[j]; }
                    }
            }
            __syncthreads();
            const int row = tid >> 3, g = tid & 7, t = m0 + 64 * p + row;
            float sel[32];
#pragma unroll
            for (int i = 0; i < 32; ++i) sel[i] = sc[row * RS_SC + g * 36 + i];
            float m1 = -INFINITY, m2 = -INFINITY;
#pragma unroll
            for (int i = 0; i < 32; ++i) { const float v = sel[i]; m2 = fmaxf(m2, fminf(m1, v)); m1 = fmaxf(m1, v); }
            const float gs = m1 + m2; int rank = 0;
#pragma unroll
            for (int d = 1; d < 8; ++d) { const float o = __shfl_xor(gs, d); const int og = g ^ d; rank += (o > gs || (o == gs && og < g)) ? 1 : 0; }
            const bool en = rank < TOPK_GROUPS;
            float lv = -INFINITY; int li = 1 << 20;
            if (en) {
#pragma unroll
                for (int i = 0; i < 32; ++i) { const float v = sel[i]; if (v > lv) { lv = v; li = g * 32 + i; } }
            }
            float myv = 0.f; int myi = 0;
#pragma unroll
            for (int k = 0; k < TOP_K; ++k) {
                float bv = lv; int bi = li;
#pragma unroll
                for (int d = 1; d < 8; d <<= 1) { const float ov = __shfl_xor(bv, d); const int oi = __shfl_xor(bi, d); if (ov > bv || (ov == bv && oi < bi)) { bv = ov; bi = oi; } }
                if (g == k) { myv = bv; myi = bi; }
                if (k + 1 < TOP_K && (bi >> 5) == g) {
                    lv = -INFINITY; li = 1 << 20;
#pragma unroll
                    for (int i = 0; i < 32; ++i) { if (g * 32 + i == bi) sel[i] = -INFINITY; const float v = sel[i]; if (v > lv) { lv = v; li = g * 32 + i; } }
                }
            }
            const float score = myv - a.rbias[myi];
            float gsum = score;
#pragma unroll
            for (int d = 1; d < 8; d <<= 1) gsum += __shfl_xor(gsum, d);
            const float gt = score / gsum * ROUTED_SCALE;
            a.eidx[t * TOP_K + g] = myi; a.gate[t * TOP_K + g] = gt;
            my_idx[p] = myi; my_gate[p] = gt; my_rank[p] = atomicAdd(&hist[myi], 1);
        }
        __syncthreads();
        if (tid < 256) { const int h = hist[tid]; base[tid] = h > 0 ? atomicAdd(&a.counts[tid * CSTR], h) : 0; }
        __syncthreads();
#pragma unroll
        for (int p = 0; p < 2; ++p) {
            const int row = tid >> 3, g = tid & 7, t = m0 + 64 * p + row, e = my_idx[p], pos = base[e] + my_rank[p];
            a.tokl[(size_t)e * CAP + pos] = t; a.gatel[(size_t)e * CAP + pos] = my_gate[p]; a.slot[t * TOP_K + g] = e * CAP + pos;
        }
        if ((vblock() & 1) == 1) convert_moe_range(cv, lds, CV_GU, CV_GU + CV_DN);
    }
}

constexpr int LDS_ROWTAB = 128 * 1024;
constexpr int LDS_GTAB = 139 * 1024;
constexpr int LDS_TAB = 150 * 1024;
constexpr int LDS_UTAB = 154 * 1024;
constexpr int MOE_BM = 256;
DI void build_moe_tab(const int* counts, char* lds) {
    int* tstart = (int*)(lds + LDS_TAB); int* rstart = tstart + 264; int* cnts = tstart + 528;
    const int tid = tidx(), lane = tid & 63;
    __syncthreads();
    if (tid < 64) {
        int c[4], tl[4], cs = 0, ts = 0;
#pragma unroll
        for (int i = 0; i < 4; ++i) { c[i] = counts[(lane * 4 + i) * CSTR]; tl[i] = (c[i] + MOE_BM - 1) / MOE_BM; cs += c[i]; ts += tl[i]; }
        int ci = cs, ti = ts;
#pragma unroll
        for (int o = 1; o < 64; o <<= 1) { const int n1 = __shfl_up(ci, o), n2 = __shfl_up(ti, o); if (lane >= o) { ci += n1; ti += n2; } }
        int ce = ci - cs, te = ti - ts;
#pragma unroll
        for (int i = 0; i < 4; ++i) { rstart[lane * 4 + i] = ce; tstart[lane * 4 + i] = te; cnts[lane * 4 + i] = c[i]; ce += c[i]; te += tl[i]; }
        if (lane == 63) { rstart[256] = ce; tstart[256] = te; cnts[256] = T_TOK; rstart[257] = ce + T_TOK; tstart[257] = te + T_TOK / MOE_BM; }
    }
    __syncthreads();
}
DI int find_expert(const int* tstart, int g) {
    int lo = 0, hi = 256;
#pragma unroll 1
    while (lo < hi) { const int mid = (lo + hi + 1) >> 1; if (tstart[mid] <= g) lo = mid; else hi = mid - 1; }
    return lo;
}
struct MoeU { const char* A; const char* B; int e, m0, sub, ui; };
typedef const LAS int* ltab_t;
DI int find_expert_l(ltab_t tstart, int g) { int lo = 0, hi = 256;
#pragma unroll 1
    while (lo < hi) { const int mid = (lo + hi + 1) >> 1; if (tstart[mid] <= g) lo = mid; else hi = mid - 1; }
    return lo; }

struct P6Args { const unsigned char* x1; const int* counts; const int* tokl; const float* gatel; const unsigned char* wgut; unsigned char* H; };
struct GuSched {
    typedef MoeU U;
    ltab_t tab; const LAS int* rowtab; const LAS int* utab; const unsigned char* x1; const unsigned char* wgut; int first, stride, nunits;
    DI bool next(int i, U& u) const {
        const int L = first + i * stride; if (L >= nunits) return false;
        const int g = L >> 1, e = utab[i];
        u.sub = L & 1; u.e = e; u.ui = i; u.m0 = (g - tab[e]) * MOE_BM;
        u.A = (const char*)x1; u.B = (const char*)(wgut + ((size_t)e * 512 + 256 * u.sub) * D_MODEL); return true;
    }
    DI unsigned a_voff(int i, int h, int R, int C) const { return (unsigned)(rowtab[i * 256 + 128 * h + R] * (D_MODEL / 2) + C) * 2u; }
};
struct EpiGU { unsigned char* H; const LAS float* gtab; ltab_t tab;
    DI void operator()(const f32x4 (&acc)[2][2][4][2], const MoeU& u, int wr, int wc, int fr, int fq) const {
        const int st = tab[264 + u.e], cnt = tab[528 + u.e];
#pragma unroll
        for (int ai = 0; ai < 2; ++ai)
#pragma unroll
            for (int m = 0; m < 4; ++m) {
                const int row = u.m0 + 128 * ai + 64 * wr + 16 * m + fr;
                if (row < cnt) {
                    const float gt = gtab[u.ui * 256 + 128 * ai + 64 * wr + 16 * m + fr] * (HSCALE / (XSCALE * WSCALE));
                    float h[8];
#pragma unroll
                    for (int n = 0; n < 2; ++n)
#pragma unroll
                        for (int j = 0; j < 4; ++j) { const float gv = acc[ai][0][m][n][j] * (1.f / (XSCALE * WSCALE)); h[4 * n + j] = gv * __builtin_amdgcn_rcpf(1.f + __expf(-gv)) * acc[ai][1][m][n][j] * gt; }
                    *(u32x2*)(H + (size_t)(st + row) * D_EXP + 128 * u.sub + 32 * wc + 8 * fq) = (u32x2){pack_fp8x4(h[0], h[1], h[2], h[3]), pack_fp8x4(h[4], h[5], h[6], h[7])};
                }
            }
    } };
DI void phase_moe_gu(const P6Args& a, char* smem, LAS unsigned char* lds) {
    build_moe_tab(a.counts, smem);
    const int* tstart = (const int*)(smem + LDS_TAB); const int* rstart = tstart + 264; int* rowtab = (int*)(smem + LDS_ROWTAB); float* gtab = (float*)(smem + LDS_GTAB);
    const int nunits = tstart[257] * 2, first = vblock();
    const int n_my = first < nunits ? (nunits - first + GRID - 1) / GRID : 0;
    for (int idx = tidx(); idx < n_my * 256; idx += NTHR) {
        const int i = idx >> 8, row = idx & 255, L = first + i * GRID, g = L >> 1, e = find_expert(tstart, g), m0 = (g - tstart[e]) * MOE_BM, cnt = tstart[528 + e];
        int rr = m0 + row; rr = rr < cnt ? rr : cnt - 1;
        rowtab[idx] = e < N_EXP ? a.tokl[(size_t)e * CAP + rr] : rr;
        gtab[idx] = e < N_EXP ? a.gatel[(size_t)e * CAP + rr] : 1.f;
    }
    if (tidx() < 32 && tidx() < n_my) ((int*)(smem + LDS_UTAB))[tidx()] = find_expert(tstart, (first + tidx() * GRID) >> 1);
    __syncthreads();
    GuSched S{(ltab_t)(lds + LDS_TAB), (const LAS int*)(lds + LDS_ROWTAB), (const LAS int*)(lds + LDS_UTAB), a.x1, a.wgut, first, GRID, nunits}; EpiGU E{a.H, (const LAS float*)(lds + LDS_GTAB), (ltab_t)(lds + LDS_TAB)};
    gs::gemm_stream<true, true, 2>(lds, D_MODEL / 2, S, E);
}
struct P7Args { const unsigned char* H; const int* counts; const unsigned char* wdt; unsigned char* Y; };
struct DownSched {
    typedef MoeU U;
    ltab_t tab; const LAS int* utab; const unsigned char* H; const unsigned char* wdt; int first, stride, nunits;
    DI bool next(int i, U& u) const {
        const int L = first + i * stride; if (L >= nunits) return false;
        const int g = L >> 2, e = utab[i];
        u.sub = L & 3; u.e = e; u.ui = i; u.m0 = (g - tab[e]) * MOE_BM;
        u.A = (const char*)(H + (size_t)(tab[264 + e] + u.m0) * D_EXP); u.B = (const char*)(wdt + ((size_t)e * D_MODEL + 256 * u.sub) * D_EXP); return true;
    }
    DI unsigned a_voff(int, int h, int R, int C) const { return (unsigned)((128 * h + R) * (D_EXP / 2) + C) * 2u; }
};
struct EpiDown { unsigned char* Y; ltab_t tab;
    DI void operator()(const f32x4 (&acc)[2][2][4][2], const MoeU& u, int wr, int wc, int fr, int fq) const {
        const int st = tab[264 + u.e], cnt = tab[528 + u.e];
#pragma unroll
        for (int ai = 0; ai < 2; ++ai)
#pragma unroll
            for (int m = 0; m < 4; ++m) {
                const int row = u.m0 + 128 * ai + 64 * wr + 16 * m + fr;
                if (row < cnt) {
                    u32x4 o;
#pragma unroll
                    for (int bj = 0; bj < 2; ++bj) {
                        const f32x4 v0 = acc[ai][bj][m][0] * (YSCALE / (HSCALE * WSCALE)), v1 = acc[ai][bj][m][1] * (YSCALE / (HSCALE * WSCALE));
                        o[2 * bj] = pack_fp8x4(v0[0], v0[1], v0[2], v0[3]); o[2 * bj + 1] = pack_fp8x4(v1[0], v1[1], v1[2], v1[3]);
                    }
                    *(u32x4*)(Y + (size_t)(st + row) * D_MODEL + 256 * u.sub + 64 * wc + 16 * fq) = o;
                }
            }
    } };
DI void phase_moe_down(const P7Args& a, char* smem, LAS unsigned char* lds) {
    const int* tstart = (const int*)(smem + LDS_TAB); const int* rstart = tstart + 264;
    { const int nun = tstart[257] * 4, i = tidx(); if (i < 32 && vblock() + i * GRID < nun) ((int*)(smem + LDS_UTAB))[i] = find_expert(tstart, (vblock() + i * GRID) >> 2); }
    __syncthreads();
    DownSched S{(ltab_t)(lds + LDS_TAB), (const LAS int*)(lds + LDS_UTAB), a.H, a.wdt, vblock(), GRID, tstart[257] * 4}; EpiDown E{a.Y, (ltab_t)(lds + LDS_TAB)};
    gs::gemm_stream<true, true, 2>(lds, D_EXP / 2, S, E);
}
struct P8Args { const bf16_t* x1; const unsigned char* Y; const int* slot; const int* counts; const float* ln_g; const float* ln_b; float* out; };
DI void phase_combine(const P8Args& a, char* lds) {
    const int tid = tidx(), wid = tid >> 6, lane = tid & 63;
    const int* rstart = (const int*)(lds + LDS_TAB) + 264;
    const int sh0 = rstart[256];
    const int c0 = 256 * (lane >> 4) + 32 * ((lane >> 2) & 3) + 8 * (lane & 3);
    for (int t = vblock() * 8 + wid; t < T_TOK; t += GRID * 8) {
        float v[16], w[16];
        { const u32x4 p0 = *(const u32x4*)(a.x1 + (size_t)t * D_MODEL + c0), p1 = *(const u32x4*)(a.x1 + (size_t)t * D_MODEL + c0 + 128); unpack16(p0, p1, v); }
        int sl = 0; if (lane < TOP_K) sl = a.slot[t * TOP_K + lane];
        u32x4 yr[9];
        yr[8] = *(const u32x4*)(a.Y + (size_t)(sh0 + t) * D_MODEL + lane * 16);
#pragma unroll
        for (int k = 0; k < TOP_K; ++k) { const int s = __shfl(sl, k), e = s / CAP, pos = s % CAP; yr[k] = *(const u32x4*)(a.Y + (size_t)(rstart[e] + pos) * D_MODEL + lane * 16); }
#pragma unroll
        for (int i = 0; i < 16; ++i) w[i] = 0.f;
#pragma unroll
        for (int k = 0; k < 9; ++k)
#pragma unroll
            for (int j = 0; j < 4; ++j) { const f32x2 lo = __builtin_amdgcn_cvt_pk_f32_fp8((int)yr[k][j], false), hi = __builtin_amdgcn_cvt_pk_f32_fp8((int)yr[k][j], true); w[4 * j] += lo.x; w[4 * j + 1] += lo.y; w[4 * j + 2] += hi.x; w[4 * j + 3] += hi.y; }
#pragma unroll
        for (int i = 0; i < 16; ++i) v[i] = v[i] * DN_ALPHA + w[i] * (1.f / YSCALE);
        float s = 0.f;
#pragma unroll
        for (int i = 0; i < 16; ++i) s += v[i];
#pragma unroll
        for (int o = 32; o >= 1; o >>= 1) s += __shfl_xor(s, o);
        const float mu = s * (1.f / 1024.f);
        float q = 0.f;
#pragma unroll
        for (int i = 0; i < 16; ++i) { const float d = v[i] - mu; q += d * d; }
#pragma unroll
        for (int o = 32; o >= 1; o >>= 1) q += __shfl_xor(q, o);
        const float rstd = rsqrtf(q * (1.f / 1024.f) + LN_EPS);
#pragma unroll
        for (int j = 0; j < 4; ++j) {
            const int col = c0 + 128 * (j >> 1) + 4 * (j & 1);
            const f32x4 g = *(const f32x4*)(a.ln_g + col), bb = *(const f32x4*)(a.ln_b + col);
            f32x4 o; o[0] = (v[4 * j] - mu) * rstd * g[0] + bb[0]; o[1] = (v[4 * j + 1] - mu) * rstd * g[1] + bb[1]; o[2] = (v[4 * j + 2] - mu) * rstd * g[2] + bb[2]; o[3] = (v[4 * j + 3] - mu) * rstd * g[3] + bb[3];
            *(f32x4*)(a.out + (size_t)t * D_MODEL + col) = o;
        }
    }
}
#define MFMA32(a, b, c) __builtin_amdgcn_mfma_f32_32x32x16_bf16((a), (b), (c), 0, 0, 0)
constexpr float SB_EXIT_THR = 1e-30f;
struct P2Args { const bf16_t* Q; const bf16_t* Kb; const bf16_t* Vt; const float* rel_bias; const float* gain_a; const float* gain_b; bf16_t* y; };

DI bf16x8 pack8(const f32x16& x, int s) {
    u32x4 p;
    if (s == 0) { p.x = cvt_pk_bf16(x[0], x[1]); p.y = cvt_pk_bf16(x[2], x[3]); p.z = cvt_pk_bf16(x[4], x[5]); p.w = cvt_pk_bf16(x[6], x[7]); }
    else        { p.x = cvt_pk_bf16(x[8], x[9]); p.y = cvt_pk_bf16(x[10], x[11]); p.z = cvt_pk_bf16(x[12], x[13]); p.w = cvt_pk_bf16(x[14], x[15]); }
    return __builtin_bit_cast(bf16x8, p);
}
DI void load_k(bf16x8 (&k)[4], const bf16_t* kp, int k0) {
#pragma unroll
    for (int kk = 0; kk < 4; ++kk) k[kk] = *(const bf16x8*)(kp + (size_t)(k0 >> 5) * 2048 + kk * 512);
}
DI void load_v(bf16x8 (&v)[2][2], const bf16_t* vp, int k0) {
#pragma unroll
    for (int dt = 0; dt < 2; ++dt)
#pragma unroll
        for (int s = 0; s < 2; ++s) v[dt][s] = *(const bf16x8*)(vp + (size_t)(k0 >> 5) * 2048 + (dt * 2 + s) * 512);
}

constexpr int LDS_CVT = 16 * 1024;
DI void phase_attn(const P2Args& a, const P0Args& cv, char* lds) {
    const int tid = tidx(), wid = tid >> 6, lane = tid & 63, r = lane & 31, h = lane >> 5;
    float* tbl = (float*)lds;
    float* ssq = (float*)(lds + 8 * 260 * 4);
    __syncthreads();
    for (int i = tid; i < NHA * 257; i += NTHR) { const int hd = i / 257, j = i % 257; tbl[hd * 260 + j] = a.rel_bias[i] * LOG2E; }
    __syncthreads();
    const int cgrp = vblock() % 2;
#pragma unroll 1
    for (int slot = 0; slot < 5; ++slot) {
        if ((cgrp == 0 && slot == 0) || (cgrp == 1 && slot == 4)) convert_moe_range(cv, lds + LDS_CVT, 0, CV_GU);
        if (slot == 4) break;
        const int u = vblock() + GRID * (slot >> 1) + 2 * GRID * (slot & 1);
        const bool isB = u >= BATCH * (SEQ / 64); const int uu = isB ? u - BATCH * (SEQ / 64) : u;
        const int b = uu / (SEQ / 64), c = uu % (SEQ / 64), q0 = c * 64, hh = (isB ? NHA : 0) + wid;
        const size_t hb = (size_t)(b * NHH + hh) * SEQ * 64;
        const bf16_t* kp = a.Kb + hb + lane * 8;
        const bf16_t* vp = a.Vt + hb + lane * 8;
        bf16x8 qf[2][4];
#pragma unroll
        for (int qt = 0; qt < 2; ++qt)
#pragma unroll
            for (int kk = 0; kk < 4; ++kk) qf[qt][kk] = *(const bf16x8*)(a.Q + hb + (size_t)((q0 >> 5) + qt) * 2048 + kk * 512 + lane * 8);
        f32x16 ot[2][2];
#pragma unroll
        for (int dt = 0; dt < 2; ++dt)
#pragma unroll
            for (int qt = 0; qt < 2; ++qt)
#pragma unroll
                for (int i = 0; i < 16; ++i) ot[dt][qt][i] = 0.f;
        float linv[2] = {1.f, 1.f};
        if (!isB) {
            float mrun[2] = {-INFINITY, -INFINITY}, lrun[2] = {0.f, 0.f};
            const int klo = q0 - LEFT_CHUNKS * CHUNK < 0 ? 0 : q0 - LEFT_CHUNKS * CHUNK, khi = q0 + 64;
            const float cfar = tbl[wid * 260 + 256];
            bf16x8 kc[4], kn[4], vf[2][2]; load_k(kc, kp, klo);
            for (int k0 = klo; k0 < khi; k0 += 32) {
                load_v(vf, vp, k0);
                load_k(kn, kp, k0 + 32 < khi ? k0 + 32 : k0);
#pragma unroll
                for (int qt = 0; qt < 2; ++qt) {
                    bf16x8 pf[2];
                    f32x16 st;
#pragma unroll
                    for (int i = 0; i < 16; ++i) st[i] = 0.f;
#pragma unroll
                    for (int kk = 0; kk < 4; ++kk) st = MFMA32(kc[kk], qf[qt][kk], st);
                    const int dmin = q0 + 32 * qt - k0 - 31;
                    float boff = 0.f;
                    if (dmin >= MAX_REL) boff = cfar;
                    else {
                        const int bidx = q0 + 32 * qt + r - k0 - 4 * h + MAX_REL;
#pragma unroll
                        for (int i = 0; i < 16; ++i) { int ix = bidx - ((i & 3) + 8 * (i >> 2)); ix = ix < 0 ? 0 : (ix > 2 * MAX_REL ? 2 * MAX_REL : ix); st[i] += tbl[wid * 260 + ix]; }
                    }
                    float mx = st[0];
#pragma unroll
                    for (int i = 1; i < 16; ++i) mx = fmaxf(mx, st[i]);
                    mx = fmaxf(mx, __shfl_xor(mx, 32)) + boff;
                    const float mo = mrun[qt], mn = fmaxf(mo, mx);
                    mrun[qt] = mn;
                    const float eo = boff - mn;
                    float ps = 0.f;
#pragma unroll
                    for (int i = 0; i < 16; ++i) { st[i] = __builtin_amdgcn_exp2f(st[i] + eo); ps += st[i]; }
                    if (__all(mn == mo)) lrun[qt] += ps;
                    else {
                        const float alpha = __builtin_amdgcn_exp2f(mo - mn);
                        lrun[qt] = lrun[qt] * alpha + ps;
#pragma unroll
                        for (int i = 0; i < 16; ++i) { ot[0][qt][i] *= alpha; ot[1][qt][i] *= alpha; }
                    }
                    pf[0] = pack8(st, 0); pf[1] = pack8(st, 1);
#pragma unroll
                    for (int dt = 0; dt < 2; ++dt)
#pragma unroll
                        for (int s = 0; s < 2; ++s) ot[dt][qt] = MFMA32(vf[dt][s], pf[s], ot[dt][qt]);
                }
#pragma unroll
                for (int kk = 0; kk < 4; ++kk) kc[kk] = kn[kk];
            }
#pragma unroll
            for (int qt = 0; qt < 2; ++qt) { const float lt = lrun[qt] + __shfl_xor(lrun[qt], 32); linv[qt] = 1.f / lt; }
        } else {
            float carry[2] = {1.f, 1.f};
            bf16x8 kc[4], kn[4], vf[2][2]; load_k(kc, kp, q0 + 32);
            for (int k0 = q0 + 32; k0 >= 0; k0 -= 32) {
                load_v(vf, vp, k0);
                load_k(kn, kp, k0 >= 32 ? k0 - 32 : k0);
#pragma unroll
                for (int qt = 0; qt < 2; ++qt) {
                    bf16x8 pf[2];
                    f32x16 st;
#pragma unroll
                    for (int i = 0; i < 16; ++i) st[i] = 0.f;
                    const bool none = (k0 > q0 + 32 * qt + 30);
                    if (!none) {
#pragma unroll
                        for (int kk = 0; kk < 4; ++kk) st = MFMA32(kc[kk], qf[qt][kk], st);
                        const bool full = (k0 + 31 < q0 + 32 * qt);
                        const int lim = q0 + 32 * qt + r - k0 - 4 * h;
                        float om[16];
#pragma unroll
                        for (int i = 0; i < 16; ++i) {
                            const float e = __builtin_amdgcn_exp2f(-st[i]); float bta = __builtin_amdgcn_rcpf(1.f + e);
                            if (!full && !(((i & 3) + 8 * (i >> 2)) < lim)) bta = 0.f;
                            st[i] = bta; om[i] = 1.f - bta;
                        }
                        float G[4], Go[4];
#pragma unroll
                        for (int g = 0; g < 4; ++g) { G[g] = (om[4 * g] * om[4 * g + 1]) * (om[4 * g + 2] * om[4 * g + 3]); Go[g] = __shfl_xor(G[g], 32); }
                        float R = carry[qt];
#pragma unroll
                        for (int g = 3; g >= 0; --g) {
                            float run = h == 0 ? R * Go[g] : R;
#pragma unroll
                            for (int uu2 = 3; uu2 >= 0; --uu2) { const float bta = st[4 * g + uu2]; st[4 * g + uu2] = bta * run; run *= om[4 * g + uu2]; }
                            R = R * (G[g] * Go[g]);
                        }
                        carry[qt] = R;
                    }
                    if (!none) {
                        pf[0] = pack8(st, 0); pf[1] = pack8(st, 1);
#pragma unroll
                        for (int dt = 0; dt < 2; ++dt)
#pragma unroll
                            for (int s = 0; s < 2; ++s) ot[dt][qt] = MFMA32(vf[dt][s], pf[s], ot[dt][qt]);
                    }
                }
#pragma unroll
                for (int kk = 0; kk < 4; ++kk) kc[kk] = kn[kk];
                if (__all(carry[0] < SB_EXIT_THR && carry[1] < SB_EXIT_THR)) break;
            }
        }
        float ss[2];
#pragma unroll
        for (int qt = 0; qt < 2; ++qt) {
            float s2 = 0.f;
#pragma unroll
            for (int dt = 0; dt < 2; ++dt)
#pragma unroll
                for (int i = 0; i < 16; ++i) { ot[dt][qt][i] *= linv[qt]; s2 += ot[dt][qt][i] * ot[dt][qt][i]; }
            s2 += __shfl_xor(s2, 32); ss[qt] = s2;
        }
        __syncthreads();
        if (h == 0) { ssq[wid * 64 + r] = ss[0]; ssq[wid * 64 + 32 + r] = ss[1]; }
        __syncthreads();
        const float* gain = isB ? a.gain_b : a.gain_a;
#pragma unroll
        for (int qt = 0; qt < 2; ++qt) {
            float tot = 0.f;
#pragma unroll
            for (int w8 = 0; w8 < 8; ++w8) tot += ssq[w8 * 64 + 32 * qt + r];
            const float rs = rsqrtf(tot * (1.f / 512.f) + RMS_EPS);
            char* yst = lds + LDS_CVT + wid * (64 * 136);
#pragma unroll
            for (int dt = 0; dt < 2; ++dt)
#pragma unroll
                for (int g = 0; g < 4; ++g) {
                    const int d = 32 * dt + 8 * g + 4 * h; const f32x4 gn = *(const f32x4*)(gain + wid * 64 + d);
                    u32x2 o; o.x = cvt_pk_bf16(ot[dt][qt][4 * g] * rs * gn[0], ot[dt][qt][4 * g + 1] * rs * gn[1]); o.y = cvt_pk_bf16(ot[dt][qt][4 * g + 2] * rs * gn[2], ot[dt][qt][4 * g + 3] * rs * gn[3]);
                    *(u32x2*)(yst + (32 * qt + r) * 136 + d * 2) = o;
                }
        }
        {
            char* yst = lds + LDS_CVT + wid * (64 * 136);
            bf16_t* yb = a.y + (size_t)(b * SEQ + q0) * D_MODEL + (isB ? 512 : 0) + wid * 64;
#pragma unroll
            for (int j = 0; j < 8; ++j) {
                const int tok = (lane >> 3) + 8 * j, ch = lane & 7;
                const u32x2 lo = *(const u32x2*)(yst + tok * 136 + ch * 16), hi = *(const u32x2*)(yst + tok * 136 + ch * 16 + 8);
                *(u32x4*)(yb + (size_t)tok * D_MODEL + ch * 8) = (u32x4){lo.x, lo.y, hi.x, hi.y};
            }
        }
    }
}


#define XB_TMO      128
#define XB_XCNT(j)  (256  + 64 * (j))
#define XB_XSUB(j)  (1280 + 64 * (j))
#define XB_XGEN(j)  (2304 + 64 * (j))
#define XB_TOP      3328
#define XB_TOPGEN   3392
#define XCD_BAR_WORDS 3456
#define XB_SPIN_CAP (1u << 18)
#define LAS __attribute__((address_space(3)))

__device__ __forceinline__ unsigned xb_ld(unsigned* p)              { return __hip_atomic_load(p, __ATOMIC_RELAXED, __HIP_MEMORY_SCOPE_AGENT); }
__device__ __forceinline__ unsigned xb_add(unsigned* p, unsigned v) { return __hip_atomic_fetch_add(p, v, __ATOMIC_RELAXED, __HIP_MEMORY_SCOPE_AGENT); }
__device__ __forceinline__ unsigned xb_xcc_id() { return (unsigned)__builtin_amdgcn_s_getreg((3 << 11) | 20) & 0xFu; }
#define XB_SPIN(cond, bar) do { unsigned _sp = 0; while (cond) { __builtin_amdgcn_s_sleep(1); \
    if ((++_sp & 255u) == 0u) { if (xb_ld(&(bar)[XB_TMO])) break; if (_sp > XB_SPIN_CAP) { atomicAdd(&(bar)[XB_TMO], 1u); break; } } } } while (0)

struct XcdBarrier {
    unsigned* bar; unsigned x;
    volatile LAS unsigned* st;
};

__device__ __forceinline__ XcdBarrier xcd_barrier_post(unsigned* bar, volatile LAS unsigned* st) {
    XcdBarrier b; b.bar = bar; b.x = xb_xcc_id(); b.st = st;
    if (threadIdx.x == 0) (void)xb_add(&bar[XB_XCNT(b.x)], 1u);
    return b;
}
__device__ __forceinline__ void xcd_barrier_complete(unsigned* bar, unsigned x, unsigned& nloc, unsigned& nx) {
    const unsigned G = gridDim.x * gridDim.y * gridDim.z;
    unsigned sum, cnt, mine, sp = 0u;
    for (;;) {
        sum = 0u; cnt = 0u; mine = 0u;
#pragma unroll
        for (unsigned j = 0; j < 16; ++j) { const unsigned c = xb_ld(&bar[XB_XCNT(j)]); sum += c; cnt += (c > 0u) ? 1u : 0u; mine = (j == x) ? c : mine; }
        if (sum == G) break;
        __builtin_amdgcn_s_sleep(1);
        if ((++sp & 255u) == 0u) { if (xb_ld(&bar[XB_TMO])) break; if (sp > XB_SPIN_CAP) { atomicAdd(&bar[XB_TMO], 1u); break; } }
    }
    nloc = mine > 0u ? mine : 1u; nx = cnt > 0u ? cnt : 1u;
}

__device__ __forceinline__ void xcd_barrier(const XcdBarrier& b) {
    asm volatile("s_waitcnt vmcnt(0)" ::: "memory");
    __syncthreads();
    if (threadIdx.x == 0) {
        unsigned* bar = b.bar;
        __builtin_amdgcn_s_waitcnt(0);
        unsigned nloc = b.st[0], nx = b.st[1];
        if (nloc == 0u) { xcd_barrier_complete(bar, b.x, nloc, nx); b.st[0] = nloc; b.st[1] = nx; }
        const unsigned old = xb_add(&bar[XB_XSUB(b.x)], 1u);
        const unsigned gen = old / nloc;
        if (old + 1u == (gen + 1u) * nloc) {
            __builtin_amdgcn_fence(__ATOMIC_RELEASE, "agent");
            asm volatile("s_waitcnt vmcnt(0)" ::: "memory");
            const unsigned og = xb_add(&bar[XB_TOP], 1u);
            const unsigned tg = og / nx;
            if (og + 1u == (tg + 1u) * nx) xb_add(&bar[XB_TOPGEN], 1u);
            else XB_SPIN(xb_ld(&bar[XB_TOPGEN]) == tg, bar);
            __builtin_amdgcn_fence(__ATOMIC_ACQUIRE, "agent");
            xb_add(&bar[XB_XGEN(b.x)], 1u);
            asm volatile("s_waitcnt vmcnt(0)" ::: "memory");
        } else {
            XB_SPIN(xb_ld(&bar[XB_XGEN(b.x)]) == gen, bar);
            __builtin_amdgcn_fence(__ATOMIC_ACQUIRE, "agent");
            asm volatile("s_waitcnt vmcnt(0)" ::: "memory");
        }
    }
    __syncthreads();
}


struct MegaArgs { P0Args p0; P1Args p1; P2Args p2; P3Args p3; P4Args p4; P6Args p6; P7Args p7; P8Args p8; unsigned* bar; };
__global__ __launch_bounds__(NTHR, 2) void k_mega(MegaArgs a) {
    extern __shared__ __attribute__((aligned(16))) char smem[];
    volatile LAS unsigned* xbw = (volatile LAS unsigned*)(smem + LDS_BYTES - 16);
    if (threadIdx.x == 0) { xbw[0] = 0u; xbw[1] = 0u; xbw[2] = 0u; xbw[3] = 0u; }
    __syncthreads();
    XcdBarrier bar = xcd_barrier_post(a.bar, xbw);
    LAS unsigned char* L = (LAS unsigned char*)smem;
    phase_prologue(a.p0, smem);     xcd_barrier(bar);
    phase_qkv(a.p1, L);             xcd_barrier(bar);
    phase_attn(a.p2, a.p0, smem);   xcd_barrier(bar);
    phase_outproj(a.p3, L);         xcd_barrier(bar);
    phase_router(a.p4, a.p0, smem); xcd_barrier(bar);
    phase_moe_gu(a.p6, smem, L);    xcd_barrier(bar);
    phase_moe_down(a.p7, smem, L);  xcd_barrier(bar);
    phase_combine(a.p8, smem);
}

extern "C" void kernel_launch(void* const* d_in, const int* in_sizes, int n_in, void* d_out, int out_size, void* d_ws, size_t ws_size, hipStream_t stream) {
    const float* x = (const float*)d_in[0];      const float* w_in = (const float*)d_in[1];   const float* rel_bias = (const float*)d_in[2];
    const float* gain_a = (const float*)d_in[3]; const float* gain_b = (const float*)d_in[4]; const float* w_out = (const float*)d_in[5];
    const float* ln1_g = (const float*)d_in[6];  const float* ln1_b = (const float*)d_in[7];  const float* router_w = (const float*)d_in[8];
    const float* router_bias = (const float*)d_in[9]; const float* w_gate = (const float*)d_in[10]; const float* w_up = (const float*)d_in[11];
    const float* w_down = (const float*)d_in[12]; const float* ws_gate = (const float*)d_in[13]; const float* ws_up = (const float*)d_in[14];
    const float* ws_down = (const float*)d_in[15]; const float* ln2_g = (const float*)d_in[16]; const float* ln2_b = (const float*)d_in[17];
    char* ws = (char*)d_ws; float* out = (float*)d_out;
    int* ctrl = (int*)(ws + OFF_CTRL); int* counts = ctrl + CW_COUNTS;
    bf16_t* X1 = (bf16_t*)(ws + OFF_X1); int* tokl = (int*)(ws + OFF_TOKL); float* gatel = (float*)(ws + OFF_GATEL);
    int* eidx = (int*)(ws + OFF_EIDX); float* gate = (float*)(ws + OFF_GATE); int* slot = (int*)(ws + OFF_SLOT);
    unsigned char* H = (unsigned char*)(ws + OFF_H); unsigned char* Y = (unsigned char*)(ws + OFF_Y); unsigned char* x1f8 = (unsigned char*)(ws + OFF_X1F8);
    bf16_t* Q = (bf16_t*)(ws + OFF_Q); bf16_t* Kb = (bf16_t*)(ws + OFF_K); bf16_t* Vt = (bf16_t*)(ws + OFF_VT);
    bf16_t* yatt = (bf16_t*)(ws + OFF_YATT); bf16_t* r = (bf16_t*)(ws + OFF_R);
    bf16_t* xb = (bf16_t*)(ws + OFF_XB); float* stats = (float*)(ws + OFF_STATS);
    bf16_t* wt_in = (bf16_t*)(ws + OFF_WTIN); bf16_t* wt_out = (bf16_t*)(ws + OFF_WTOUT); bf16_t* wt_r = (bf16_t*)(ws + OFF_WTR);
    unsigned char* wgut = (unsigned char*)(ws + OFF_WGUT); unsigned char* wdt = (unsigned char*)(ws + OFF_WDT);
    if (ws_size < WS_NEEDED) { fprintf(stderr, "kernel_launch: workspace too small (%zu < %zu)\n", ws_size, (size_t)WS_NEEDED); return; }
    hipMemsetAsync(ctrl, 0, 128 * 1024, stream);
    static bool attr_done = false;
    if (!attr_done) {
        hipFuncSetAttribute((const void*)k_mega, hipFuncAttributeMaxDynamicSharedMemorySize, LDS_BYTES);
        attr_done = true;
    }
    MegaArgs m{};
    m.p0 = P0Args{x, w_in, w_out, router_w, xb, wt_in, wt_out, wt_r, w_gate, w_up, w_down, ws_gate, ws_up, ws_down, wgut, wdt};
    m.p1 = P1Args{xb, wt_in, Q, Kb, Vt};
    m.p2 = P2Args{Q, Kb, Vt, rel_bias, gain_a, gain_b, yatt};
    m.p3 = P3Args{yatt, wt_out, xb, r, stats};
    m.p4 = P4Args{r, stats, ln1_g, ln1_b, X1, x1f8, wt_r, router_bias, eidx, gate, counts, tokl, gatel, slot};
    m.p6 = P6Args{x1f8, counts, tokl, gatel, wgut, H};
    m.p7 = P7Args{H, counts, wdt, Y};
    m.p8 = P8Args{X1, Y, slot, counts, ln2_g, ln2_b, out};
    m.bar = (unsigned*)ctrl;
    k_mega<<<GRID, NTHR, LDS_BYTES, stream>>>(m);
}
```

```cpp
#include <hip/hip_runtime.h>
#include <cstdint>
#include <cstdio>

typedef unsigned short bf16_t;

constexpr int D_MODEL = 1024, BATCH = 16, SEQ = 2048, T_TOK = BATCH * SEQ;
constexpr int HEAD_DIM = 64, NHA = 8, NHB = 8, NHH = 16;
constexpr int CHUNK = 64, LEFT_CHUNKS = 8, MAX_REL = 128;
constexpr int N_EXP = 256, TOP_K = 8, N_GROUPS = 8, TOPK_GROUPS = 4, EPG = 32, D_EXP = 256;
constexpr float ROUTED_SCALE = 2.5f, LN_EPS = 1e-5f, RMS_EPS = 1e-6f;
constexpr float DN_ALPHA = 1.189207115002721f;
constexpr float LOG2E = 1.4426950408889634f, LN2 = 0.6931471805599453f;
constexpr float QSCALE = 0.125f * LOG2E;
constexpr float WSCALE = 64.f, XSCALE = 16.f, HSCALE = 16.f;
constexpr float YSCALE = 64.f;
constexpr int CAP = T_TOK;
constexpr int ROWS_ALL = T_TOK * TOP_K + T_TOK;

__device__ __forceinline__ float bf2f(bf16_t v) { return __uint_as_float(((unsigned)v) << 16); }
__device__ __forceinline__ bf16_t f2bf(float f) { unsigned u = __float_as_uint(f); u += 0x7fffu + ((u >> 16) & 1u); return (bf16_t)(u >> 16); }

constexpr size_t MB = 1024ull * 1024ull;
constexpr size_t OFF_CTRL   = 0;
constexpr size_t OFF_X1     = 1 * MB;
constexpr size_t OFF_TOKL   = OFF_X1 + 64 * MB;
constexpr size_t OFF_GATEL  = OFF_TOKL + 32 * MB;
constexpr size_t OFF_EIDX   = OFF_GATEL + 32 * MB;
constexpr size_t OFF_GATE   = OFF_EIDX + 1 * MB;
constexpr size_t OFF_SLOT   = OFF_GATE + 1 * MB;
constexpr size_t OFF_WDT    = OFF_SLOT + 1 * MB;
constexpr size_t OFF_X1F8   = OFF_WDT + 72 * MB;
constexpr size_t OFF_BIG    = OFF_WDT + 129 * MB;
constexpr size_t OFF_H      = OFF_BIG;
constexpr size_t OFF_Y      = OFF_BIG + 144 * MB;
constexpr size_t OFF_Q      = OFF_BIG;
constexpr size_t OFF_K      = OFF_BIG + 64 * MB;
constexpr size_t OFF_VT     = OFF_BIG + 128 * MB;
constexpr size_t OFF_YATT   = OFF_BIG + 192 * MB;
constexpr size_t OFF_R      = OFF_BIG + 256 * MB;
constexpr size_t OFF_XB     = OFF_BIG + 320 * MB;
constexpr size_t OFF_STATS  = OFF_BIG + 384 * MB;
constexpr size_t OFF_WTIN   = OFF_BIG + 392 * MB;
constexpr size_t OFF_WTOUT  = OFF_BIG + 398 * MB;
constexpr size_t OFF_WTR    = OFF_BIG + 400 * MB;
constexpr size_t OFF_WGUT   = OFF_BIG + 401 * MB;
constexpr size_t WS_NEEDED  = OFF_BIG + 720 * MB;
static_assert(OFF_WGUT + 257 * MB <= WS_NEEDED && WS_NEEDED <= 1024 * MB, "workspace map");
constexpr int CW_COUNTS = 8192;
constexpr int CSTR = 64;

typedef short bf16x8 __attribute__((ext_vector_type(8)));
typedef float f32x4 __attribute__((ext_vector_type(4)));
typedef float f32x2 __attribute__((ext_vector_type(2)));
typedef float f32x16 __attribute__((ext_vector_type(16)));
typedef unsigned u32x4 __attribute__((ext_vector_type(4)));
typedef unsigned u32x2 __attribute__((ext_vector_type(2)));
#define DI __device__ __forceinline__
constexpr int NTHR = 512, GRID = 256;
DI int tidx() { int t = threadIdx.x; asm volatile("" : "+v"(t)); return t; }
constexpr int LDS_BYTES = 160 * 1024;

typedef __bf16 bf16x2_t __attribute__((ext_vector_type(2)));
DI unsigned cvt_pk_bf16(float lo, float hi) { f32x2 v = {lo, hi}; bf16x2_t r = __builtin_convertvector(v, bf16x2_t); return __builtin_bit_cast(unsigned, r); }
DI float clamp8(float v) { return __builtin_amdgcn_fmed3f(v, -440.f, 440.f); }
DI unsigned pack_fp8x4(float a, float b, float c, float d) { int w = 0; w = __builtin_amdgcn_cvt_pk_fp8_f32(clamp8(a), clamp8(b), w, false); w = __builtin_amdgcn_cvt_pk_fp8_f32(clamp8(c), clamp8(d), w, true); return (unsigned)w; }
DI int vblock() { return (int)((blockIdx.x & 7) * (GRID / 8) + (blockIdx.x >> 3)); }

template <int MT> struct Tile { static constexpr int BM = 32 * MT, A_BYTES = BM * 128, B_BYTES = 256 * 128, STAGE = A_BYTES + B_BYTES; };

template <int MT> struct ALoader {
    const bf16_t* p[MT / 2]; u32x4 v[MT / 2]; int off0;
    DI void init_rows(const bf16_t* A, int lda, int row0) {
        const int tid = tidx(), kc = tid & 7, r = tid >> 3;
#pragma unroll
        for (int i = 0; i < MT / 2; ++i) p[i] = A + (size_t)(row0 + r + 64 * i) * lda + kc * 8;
        off0 = r * 128 + ((kc ^ ((r >> 1) & 7)) << 4);
    }
    DI void init_gather(const bf16_t* A, int lda, const int* rows, int cnt, int m0) {
        const int tid = tidx(), kc = tid & 7, r = tid >> 3;
#pragma unroll
        for (int i = 0; i < MT / 2; ++i) { int rr = m0 + r + 64 * i; rr = rr < cnt ? rr : cnt - 1; const int g = rows ? rows[rr] : rr; p[i] = A + (size_t)g * lda + kc * 8; }
        off0 = r * 128 + ((kc ^ ((r >> 1) & 7)) << 4);
    }
    DI void load(int k0) {
#pragma unroll
        for (int i = 0; i < MT / 2; ++i) v[i] = *(const u32x4*)(p[i] + k0);
    }
    DI void store(char* ldsA) const {
#pragma unroll
        for (int i = 0; i < MT / 2; ++i) *(u32x4*)(ldsA + off0 + i * 8192) = v[i];
    }
};
struct BLoaderBt {
    const bf16_t* p[4]; u32x4 v[4]; int off0;
    DI void init(const bf16_t* Bt, int ldk, int n0) {
        const int tid = tidx(), kc = tid & 7, r = tid >> 3;
#pragma unroll
        for (int i = 0; i < 4; ++i) p[i] = Bt + (size_t)(n0 + r + 64 * i) * ldk + kc * 8;
        off0 = r * 128 + ((kc ^ ((r >> 1) & 7)) << 4);
    }
    DI void load(int k0) {
#pragma unroll
        for (int i = 0; i < 4; ++i) v[i] = *(const u32x4*)(p[i] + k0);
    }
    DI void store(char* ldsB) const {
#pragma unroll
        for (int i = 0; i < 4; ++i) *(u32x4*)(ldsB + off0 + i * 8192) = v[i];
    }
};
template <int MT, bool TR, class AL, class BL>
DI void gemm_tile(char* lds, AL& al, BL& bl, int nk, f32x4 (&acc)[MT][4]) {
    typedef Tile<MT> TT;
    const int tid = tidx(), wid = tid >> 6, lane = tid & 63, wr = wid >> 2, wc = wid & 3, fr = lane & 15, fq = lane >> 4;
#pragma unroll
    for (int m = 0; m < MT; ++m)
#pragma unroll
        for (int n = 0; n < 4; ++n) acc[m][n] = (f32x4){0.f, 0.f, 0.f, 0.f};
    int aoff[2], boff[2];
#pragma unroll
    for (int ks = 0; ks < 2; ++ks) { const int ch = (((4 * ks + fq) ^ (fr >> 1)) << 4); aoff[ks] = (16 * MT * wr + fr) * 128 + ch; boff[ks] = TT::A_BYTES + (64 * wc + fr) * 128 + ch; }
    al.load(0); bl.load(0);
    __syncthreads();
    al.store(lds); bl.store(lds + TT::A_BYTES);
    __syncthreads();
    for (int kt = 0; kt < nk; ++kt) {
        char* cur = lds + (kt & 1) * TT::STAGE; char* nxt = lds + ((kt & 1) ^ 1) * TT::STAGE;
        const bool more = kt + 1 < nk;
        if (more) { al.load((kt + 1) * 64); bl.load((kt + 1) * 64); }
#pragma unroll
        for (int ks = 0; ks < 2; ++ks) {
            bf16x8 a[MT], b[4];
#pragma unroll
            for (int m = 0; m < MT; ++m) a[m] = *(const bf16x8*)(cur + aoff[ks] + m * 2048);
#pragma unroll
            for (int n = 0; n < 4; ++n) b[n] = *(const bf16x8*)(cur + boff[ks] + n * 2048);
#pragma unroll
            for (int m = 0; m < MT; ++m)
#pragma unroll
                for (int n = 0; n < 4; ++n)
                    acc[m][n] = TR ? __builtin_amdgcn_mfma_f32_16x16x32_bf16(b[n], a[m], acc[m][n], 0, 0, 0) : __builtin_amdgcn_mfma_f32_16x16x32_bf16(a[m], b[n], acc[m][n], 0, 0, 0);
        }
        if (more) { al.store(nxt); bl.store(nxt + TT::A_BYTES); }
        __syncthreads();
    }
}

#define LAS __attribute__((address_space(3)))
namespace gs {
constexpr int BM = 256, BK = 64, HALF = 128, HTB = HALF * BK * 2, STAGE_BYTES = 8 * HTB;
DI int lds_byte(int r, int c) { const int st = (r >> 4) * 2 + (c >> 5), rr = r & 15, cc = c & 31, ob = rr * 64 + cc * 2; return st * 1024 + (ob ^ (((ob >> 9) & 1) << 5)); }
DI void stage_rc(int b, int& R, int& C) { const int st = b / 1024, sb = b % 1024, swz = sb ^ (((sb >> 9) & 1) << 5); R = (st >> 1) * 16 + swz / 64; C = (st & 1) * 32 + (swz % 64) / 2; }
DI int perm32(int rho) { const int n = rho >> 4, i = rho & 15; return 8 * (i >> 2) + 4 * n + (i & 3); }
typedef long i64x2 __attribute__((ext_vector_type(2)));
DI const char* uni(const char* p) { const unsigned long long v = (unsigned long long)p; const unsigned lo = __builtin_amdgcn_readfirstlane((unsigned)v), hi = __builtin_amdgcn_readfirstlane((unsigned)(v >> 32)); return (const char*)(((unsigned long long)hi << 32) | lo); }
template <bool TR, bool F8>
DI f32x4 mma16(const bf16x8& a, const bf16x8& b, f32x4 c) {
    if (F8) {
        const i64x2 a2 = __builtin_bit_cast(i64x2, a), b2 = __builtin_bit_cast(i64x2, b);
        c = TR ? __builtin_amdgcn_mfma_f32_16x16x32_fp8_fp8(b2[0], a2[0], c, 0, 0, 0) : __builtin_amdgcn_mfma_f32_16x16x32_fp8_fp8(a2[0], b2[0], c, 0, 0, 0);
        return TR ? __builtin_amdgcn_mfma_f32_16x16x32_fp8_fp8(b2[1], a2[1], c, 0, 0, 0) : __builtin_amdgcn_mfma_f32_16x16x32_fp8_fp8(a2[1], b2[1], c, 0, 0, 0);
    }
    return TR ? __builtin_amdgcn_mfma_f32_16x16x32_bf16(b, a, c, 0, 0, 0) : __builtin_amdgcn_mfma_f32_16x16x32_bf16(a, b, c, 0, 0, 0);
}
typedef int i32x8 __attribute__((ext_vector_type(8)));
typedef short bf16x16 __attribute__((ext_vector_type(16)));
template <bool TR>
DI f32x4 mma128(const bf16x16& a, const bf16x16& b, f32x4 c) {
    const i32x8 av = __builtin_bit_cast(i32x8, a), bv = __builtin_bit_cast(i32x8, b);
    const int one = 0x7F7F7F7F;
    if (TR) asm volatile("v_mfma_scale_f32_16x16x128_f8f6f4 %0, %1, %2, %0, %3, %3 op_sel_hi:[0,0,0]" : "+v"(c) : "v"(bv), "v"(av), "v"(one));
    else    asm volatile("v_mfma_scale_f32_16x16x128_f8f6f4 %0, %1, %2, %0, %3, %3 op_sel_hi:[0,0,0]" : "+v"(c) : "v"(av), "v"(bv), "v"(one));
    return c;
}
DI bf16x8 frag_lo(const bf16x16& v) { return __builtin_shufflevector(v, v, 0, 1, 2, 3, 4, 5, 6, 7); }
DI bf16x8 frag_hi(const bf16x16& v) { return __builtin_shufflevector(v, v, 8, 9, 10, 11, 12, 13, 14, 15); }
template <bool TR, bool PERM, int F8, class Sched, class Epi>
DI void gemm_stream(LAS unsigned char* lds, const int K, const Sched& S, const Epi& E) {
    typedef typename Sched::U U;
    const int tid = tidx(), wid = __builtin_amdgcn_readfirstlane(tid >> 6), lane = tid & 63, wr = wid >> 2, wc = wid & 3, fr = lane & 15, fq = lane >> 4;
    const int nt = K / BK;
    int R[2], C[2]; unsigned voffB[2];
#pragma unroll
    for (int i = 0; i < 2; ++i) { stage_rc(tid * 16 + i * 8192, R[i], C[i]); const int Rb = PERM ? ((R[i] & ~31) + perm32(R[i] & 31)) : R[i]; voffB[i] = (unsigned)(Rb * K + C[i]) * 2u; }
    const size_t kstep = (size_t)(BK * 2), hstepB = (size_t)HALF * K * 2;
    const unsigned ldsw = (unsigned)wid * 1024u;
    const int aoff = lds_byte(wr * 64 + fr, fq * 8), boff = lds_byte(wc * 32 + fr, fq * 8);
#define GS_SA(b, h) (((b) * 2 + (h)) * HTB)
#define GS_SB(b, h) ((4 + (b) * 2 + (h)) * HTB)
#define GS_STAGE(bufoff, gbase, uix, h) do { _Pragma("unroll") for (int _i = 0; _i < 2; ++_i) \
        __builtin_amdgcn_global_load_lds((const unsigned*)((const char*)(gbase) + S.a_voff(uix, h, R[_i], C[_i])), (LAS unsigned*)(lds + (bufoff) + ldsw + _i * 8192), 16, 0, 0); } while (0)
#define GS_STAGEB(bufoff, gbase, voff) do { _Pragma("unroll") for (int _i = 0; _i < 2; ++_i) \
        __builtin_amdgcn_global_load_lds((const unsigned*)((const char*)(gbase) + (voff)[_i]), (LAS unsigned*)(lds + (bufoff) + ldsw + _i * 8192), 16, 0, 0); } while (0)
#define GS_LD32(base) __builtin_shufflevector(*(const LAS bf16x8*)(base), *(const LAS bf16x8*)((base) + 1024), 0, 1, 2, 3, 4, 5, 6, 7, 8, 9, 10, 11, 12, 13, 14, 15)
#define GS_LDA(dst, b, h) do { _Pragma("unroll") for (int m = 0; m < 4; ++m) dst[m] = GS_LD32(lds + GS_SA(b, h) + aoff + m * 2048); } while (0)
#define GS_LDB(dst, b, h) do { _Pragma("unroll") for (int n = 0; n < 2; ++n) dst[n] = GS_LD32(lds + GS_SB(b, h) + boff + n * 2048); } while (0)
#define GS_MMA(ai, bj, At, Bt) do { __builtin_amdgcn_s_setprio(1); _Pragma("unroll") for (int m = 0; m < 4; ++m) _Pragma("unroll") for (int n = 0; n < 2; ++n) { \
        if (F8 == 2) acc[ai][bj][m][n] = mma128<TR>(At[m], Bt[n], acc[ai][bj][m][n]); \
        else { acc[ai][bj][m][n] = mma16<TR, F8 == 1>(frag_lo(At[m]), frag_lo(Bt[n]), acc[ai][bj][m][n]); acc[ai][bj][m][n] = mma16<TR, F8 == 1>(frag_hi(At[m]), frag_hi(Bt[n]), acc[ai][bj][m][n]); } } \
        __builtin_amdgcn_s_setprio(0); } while (0)
#define GS_WAIT_V(n) asm volatile("s_waitcnt vmcnt(" #n ")" ::: "memory")
#define GS_WAIT_L(n) asm volatile("s_waitcnt lgkmcnt(" #n ")" ::: "memory")
#define GS_BAR __builtin_amdgcn_s_barrier()
#define GS_SCHED __builtin_amdgcn_sched_barrier(0)
    U cur, nxt; int ui = 0;
    if (!S.next(0, cur)) return;
    f32x4 acc[2][2][4][2];
#pragma unroll
    for (int a = 0; a < 2; ++a)
#pragma unroll
        for (int b = 0; b < 2; ++b)
#pragma unroll
            for (int m = 0; m < 4; ++m)
#pragma unroll
                for (int n = 0; n < 2; ++n) acc[a][b][m][n] = (f32x4){0.f, 0.f, 0.f, 0.f};
    bf16x16 At[4], B0[2], B1[2];
    const char* cA = uni(cur.A); const char* cB = uni(cur.B);
    GS_STAGEB(GS_SB(0, 0), cB, voffB); GS_STAGEB(GS_SB(0, 1), cB + hstepB, voffB); GS_STAGE(GS_SA(0, 0), cA, 0, 0); GS_STAGE(GS_SA(0, 1), cA, 0, 1);
    if (wr == 1) GS_BAR;
    GS_WAIT_V(2); GS_BAR;
    GS_STAGEB(GS_SB(1, 0), cB + kstep, voffB); GS_STAGE(GS_SA(1, 0), cA + kstep, 0, 0); GS_STAGEB(GS_SB(1, 1), cB + hstepB + kstep, voffB);
    GS_WAIT_V(6); GS_BAR;
    for (;;) {
        const bool has_next = S.next(ui + 1, nxt);
        const int nui = has_next ? ui + 1 : ui;
        const char* nA = uni(has_next ? nxt.A : cA); const char* nB = uni(has_next ? nxt.B : cB);
#pragma unroll 1
        for (int t = 0; t < nt; t += 2) {
            const bool last = (t == nt - 2);
            const char* a1 = uni(cA + (size_t)(t + 1) * kstep);
            const char* a2 = uni(last ? nA : cA + (size_t)(t + 2) * kstep); const char* b2 = uni(last ? nB : cB + (size_t)(t + 2) * kstep);
            const char* a3 = uni(a2 + kstep); const char* b3 = uni(b2 + kstep);
            const int u2 = last ? nui : ui;
            GS_LDB(B0, 0, 0); GS_LDB(B1, 0, 1); GS_SCHED; GS_LDA(At, 0, 0); GS_STAGE(GS_SA(1, 1), a1, ui, 1);
            GS_WAIT_V(8); GS_WAIT_L(0); GS_BAR; GS_MMA(0, 0, At, B0); GS_MMA(0, 1, At, B1); GS_BAR; GS_SCHED;
            GS_LDA(At, 0, 1); GS_STAGEB(GS_SB(0, 0), b2, voffB); GS_STAGEB(GS_SB(0, 1), b2 + hstepB, voffB); GS_STAGE(GS_SA(0, 0), a2, u2, 0);
            GS_WAIT_V(8); GS_WAIT_L(0); GS_BAR; GS_MMA(1, 0, At, B0); GS_MMA(1, 1, At, B1); GS_BAR; GS_SCHED;
            GS_LDB(B0, 1, 0); GS_LDB(B1, 1, 1); GS_SCHED; GS_LDA(At, 1, 0); GS_STAGE(GS_SA(0, 1), a2, u2, 1);
            GS_WAIT_V(8); GS_WAIT_L(0); GS_BAR; GS_MMA(0, 0, At, B0); GS_MMA(0, 1, At, B1); GS_BAR; GS_SCHED;
            GS_LDA(At, 1, 1); GS_STAGEB(GS_SB(1, 0), b3, voffB); GS_STAGEB(GS_SB(1, 1), b3 + hstepB, voffB); GS_STAGE(GS_SA(1, 0), a3, u2, 0);
            GS_WAIT_V(8); GS_WAIT_L(0); GS_BAR; GS_MMA(1, 0, At, B0); GS_MMA(1, 1, At, B1); GS_BAR; GS_SCHED;
        }
        if (wr == 0) GS_BAR;
        if (F8 == 2) asm volatile("s_nop 15\n\ts_nop 15\n\ts_nop 15\n\ts_nop 15\n\ts_nop 15\n\ts_nop 15" ::: "memory");
        E(acc, cur, wr, wc, fr, fq);
        if (!has_next) break;
#pragma unroll
        for (int a = 0; a < 2; ++a)
#pragma unroll
            for (int b = 0; b < 2; ++b)
#pragma unroll
                for (int m = 0; m < 4; ++m)
#pragma unroll
                    for (int n = 0; n < 2; ++n) acc[a][b][m][n] = (f32x4){0.f, 0.f, 0.f, 0.f};
        cur = nxt; cA = nA; cB = nB; ++ui;
        if (wr == 1) GS_BAR;
    }
    GS_WAIT_V(0);
    GS_BAR;
#undef GS_SA
#undef GS_SB
#undef GS_STAGE
#undef GS_STAGEB
#undef GS_LDA
#undef GS_LD32
#undef GS_LDB
#undef GS_MMA
#undef GS_WAIT_V
#undef GS_WAIT_L
#undef GS_BAR
#undef GS_SCHED
}
struct DenseU { const char* A; const char* B; int pm, pn; };
struct DenseSched {
    typedef DenseU U;
    const bf16_t* A; const bf16_t* Bt; int K, nunits, first, stride, npn, pn_base, pn_mod0, pn_mod1;
    DI int colmap(int q) const { return pn_base + (q / pn_mod0) * pn_mod1 + (q % pn_mod0); }
    DI bool next(int i, U& u) const {
        const int L = first + i * stride; if (L >= nunits) return false;
        u.pm = L / npn; u.pn = colmap(L % npn);
        u.A = (const char*)A + (size_t)u.pm * BM * K * 2; u.B = (const char*)Bt + (size_t)u.pn * BM * K * 2; return true;
    }
    DI unsigned a_voff(int, int h, int R, int C) const { return (unsigned)((HALF * h + R) * K + C) * 2u; }
};
}

DI void transpose_cvt(const float* W, bf16_t* Wt, int K, int N, int unit, char* lds) {
    float* tile = (float*)lds;
    const int nbn = N / 64, kb = unit / nbn, nb = unit % nbn, tid = tidx();
    __syncthreads();
#pragma unroll
    for (int i = 0; i < 8; ++i) { const int idx = tid + i * 512, r = idx >> 6, c = idx & 63; tile[r * 65 + c] = W[(size_t)(kb * 64 + r) * N + nb * 64 + c]; }
    __syncthreads();
#pragma unroll
    for (int i = 0; i < 8; ++i) { const int idx = tid + i * 512, n = idx >> 6, k = idx & 63; Wt[(size_t)(nb * 64 + n) * K + kb * 64 + k] = f2bf(tile[k * 65 + n]); }
}
struct P0Args { const float* x; const float* w_in; const float* w_out; const float* router_w; bf16_t* xb; bf16_t* wt_in; bf16_t* wt_out; bf16_t* wt_r;
                const float* w_gate; const float* w_up; const float* w_down; const float* ws_gate; const float* ws_up; const float* ws_down; unsigned char* wgut; unsigned char* wdt; };
constexpr int CV_GU = 257 * 2 * 16, CV_DN = 257 * 16;
struct CvItem { const float* src; unsigned char* dst; int ld, ldd, rbase, rhi; };
DI CvItem cv_item(const P0Args& a, int it) {
    CvItem c;
    if (it < CV_GU) {
        const int e = it / 32, u = (it >> 4) & 1, kt = it & 15;
        const float* W = e < N_EXP ? (u ? a.w_up : a.w_gate) + (size_t)e * D_MODEL * D_EXP : (u ? a.ws_up : a.ws_gate);
        c.src = W + (size_t)kt * 64 * D_EXP; c.ld = D_EXP; c.dst = a.wgut + (size_t)e * 512 * D_MODEL + kt * 64; c.ldd = D_MODEL; c.rbase = 128 * u; c.rhi = 256;
    } else {
        const int j = it - CV_GU, e = j / 16, kt = (j >> 2) & 3, nb = j & 3;
        const float* W = e < N_EXP ? a.w_down + (size_t)e * D_EXP * D_MODEL : a.ws_down;
        c.src = W + (size_t)kt * 64 * D_MODEL + nb * 256; c.ld = D_MODEL; c.dst = a.wdt + (size_t)e * D_MODEL * D_EXP + kt * 64; c.ldd = D_EXP; c.rbase = 256 * nb; c.rhi = 128;
    }
    return c;
}
constexpr int CV_TILE_BYTES = 64 * 260 * 4;
DI void cv_dma_nt(const char* sbase, unsigned voff, unsigned lds_dst) {
    unsigned keep;
    asm volatile("s_mov_b32 %0, m0\n\ts_mov_b32 m0, %3\n\ts_nop 0\n\tglobal_load_lds_dwordx4 %1, %2 nt\n\ts_mov_b32 m0, %0" : "=&s"(keep) : "v"(voff), "s"(sbase), "s"(lds_dst) : "memory");
}
DI const char* uni64(const void* p) { const unsigned long long v = (unsigned long long)p; const unsigned lo = __builtin_amdgcn_readfirstlane((unsigned)v), hi = __builtin_amdgcn_readfirstlane((unsigned)(v >> 32)); return (const char*)(((unsigned long long)hi << 32) | lo); }
DI void cv_issue(const CvItem& c, LAS unsigned char* tile) {
    const int tid = tidx(), w = __builtin_amdgcn_readfirstlane(tid >> 6), l = tid & 63;
    const char* sb = uni64(c.src); const unsigned tb = (unsigned)__builtin_amdgcn_readfirstlane((unsigned)(size_t)tile);
#pragma unroll
    for (int i = 0; i < 8; ++i) { const int k = 8 * w + i; cv_dma_nt(sb, (unsigned)(k * c.ld + 4 * (l ^ w)) * 4u, tb + (unsigned)(k * 1040)); }
}
DI void lds_barrier() { asm volatile("s_waitcnt lgkmcnt(0)" ::: "memory"); __builtin_amdgcn_s_barrier(); asm volatile("" ::: "memory"); }
DI void cv_emit(const CvItem& c, const char* lds) {
    const float* tile = (const float*)lds;
    const int tid = tidx();
#pragma unroll
    for (int i = 0; i < 4; ++i) {
        const int idx = tid + i * 512, kc = idx & 7, n = idx >> 3; const float* p = tile + (8 * kc) * 260 + (n ^ (4 * kc));
        const unsigned w0 = pack_fp8x4(p[0] * WSCALE, p[260] * WSCALE, p[2 * 260] * WSCALE, p[3 * 260] * WSCALE), w1 = pack_fp8x4(p[4 * 260] * WSCALE, p[5 * 260] * WSCALE, p[6 * 260] * WSCALE, p[7 * 260] * WSCALE);
        __builtin_nontemporal_store((u32x2){w0, w1}, (u32x2*)(c.dst + (size_t)(c.rbase + (n >> 7) * c.rhi + (n & 127)) * c.ldd + 8 * kc));
    }
}
DI void convert_moe_range(const P0Args& a, char* lds, const int lo, const int hi) {
    int it = lo + vblock(); if (it >= hi) return;
    __syncthreads();
    LAS unsigned char* t0 = (LAS unsigned char*)lds; LAS unsigned char* t1 = t0 + CV_TILE_BYTES;
    CvItem c = cv_item(a, it); cv_issue(c, t0);
    int pp = 0;
#pragma unroll 1
    for (;;) {
        const int nit = it + GRID; const bool more = nit < hi;
        CvItem cn = c;
        if (more) { cn = cv_item(a, nit); cv_issue(cn, pp ? t0 : t1); }
        if (more) asm volatile("s_waitcnt vmcnt(8)" ::: "memory"); else asm volatile("s_waitcnt vmcnt(0)" ::: "memory");
        lds_barrier();
        cv_emit(c, lds + (pp ? CV_TILE_BYTES : 0));
        lds_barrier();
        if (!more) break;
        it = nit; c = cn; pp ^= 1;
    }
    asm volatile("s_waitcnt vmcnt(0)" ::: "memory");
    __syncthreads();
}
DI void phase_prologue(const P0Args& a, char* lds) {
    const int vb = vblock();
    for (size_t i = (size_t)vb * NTHR + tidx(); i < (size_t)T_TOK * D_MODEL / 8; i += (size_t)GRID * NTHR) {
        const f32x4 v0 = *(const f32x4*)(a.x + i * 8), v1 = *(const f32x4*)(a.x + i * 8 + 4);
        u32x4 o; o.x = cvt_pk_bf16(v0[0], v0[1]); o.y = cvt_pk_bf16(v0[2], v0[3]); o.z = cvt_pk_bf16(v1[0], v1[1]); o.w = cvt_pk_bf16(v1[2], v1[3]);
        *(u32x4*)(a.xb + i * 8) = o;
    }
    const int n_in = (1024 / 64) * (3072 / 64), n_out = 16 * 16, n_r = 16 * 4;
    for (int u = vb; u < n_in + n_out + n_r; u += GRID) {
        if (u < n_in) transpose_cvt(a.w_in, a.wt_in, 1024, 3072, u, lds);
        else if (u < n_in + n_out) transpose_cvt(a.w_out, a.wt_out, 1024, 1024, u - n_in, lds);
        else transpose_cvt(a.router_w, a.wt_r, 1024, 256, u - n_in - n_out, lds);
    }
}


struct P1Args { const bf16_t* xb; const bf16_t* wt_in; bf16_t* Q; bf16_t* Kb; bf16_t* Vt; };
struct EpiQK { bf16_t* Q; bf16_t* Kb;
    DI void operator()(const f32x4 (&acc)[2][2][4][2], const gs::DenseU& u, int wr, int wc, int fr, int fq) const {
        const int seg = u.pn >> 1, type = seg % 3, grp = seg / 3; bf16_t* dst = type == 0 ? Q : Kb; const float sc = type == 0 ? QSCALE : 1.f;
#pragma unroll
        for (int ai = 0; ai < 2; ++ai)
#pragma unroll
            for (int m = 0; m < 4; ++m) {
                const int row = u.pm * 256 + 128 * ai + 64 * wr + 16 * m + fr, b = row / SEQ, s = row % SEQ;
#pragma unroll
                for (int bj = 0; bj < 2; ++bj) {
                    const int hh = grp * 8 + 4 * (u.pn & 1) + 2 * bj + (wc >> 1), d0 = 32 * (wc & 1) + 8 * fq;
                    const f32x4 v0 = acc[ai][bj][m][0] * sc, v1 = acc[ai][bj][m][1] * sc;
                    u32x4 o; o.x = cvt_pk_bf16(v0[0], v0[1]); o.y = cvt_pk_bf16(v0[2], v0[3]); o.z = cvt_pk_bf16(v1[0], v1[1]); o.w = cvt_pk_bf16(v1[2], v1[3]);
                    *(u32x4*)(dst + (size_t)(b * NHH + hh) * SEQ * 64 + (s >> 5) * 2048 + ((d0 >> 3) * 32 + (s & 31)) * 8) = o;
                }
            }
    } };
struct EpiV { bf16_t* Vt;
    DI void operator()(const f32x4 (&acc)[2][2][4][2], const gs::DenseU& u, int wr, int wc, int fr, int fq) const {
        const int grp = (u.pn >> 1) / 3;
#pragma unroll
        for (int ai = 0; ai < 2; ++ai)
#pragma unroll
            for (int m = 0; m < 4; ++m) {
                const int row = u.pm * 256 + 128 * ai + 64 * wr + 16 * m + 4 * fq, b = row / SEQ, s = row % SEQ;
#pragma unroll
                for (int bj = 0; bj < 2; ++bj)
#pragma unroll
                    for (int n = 0; n < 2; ++n) {
                        const int hh = grp * 8 + 4 * (u.pn & 1) + 2 * bj + (wc >> 1), d = 32 * (wc & 1) + 16 * n + fr;
                        const f32x4 v = acc[ai][bj][m][n];
                        u32x2 o; o.x = cvt_pk_bf16(v[0], v[1]); o.y = cvt_pk_bf16(v[2], v[3]);
                        { const int kap = s & 31; *(u32x2*)(Vt + (size_t)(b * NHH + hh) * SEQ * 64 + (s >> 5) * 2048 + ((((d >> 5) * 2 + (kap >> 4)) * 2 + ((kap >> 2) & 1)) * 32 + (d & 31)) * 8 + ((kap >> 3) & 1) * 4) = o; }
                    }
            }
    } };
DI void phase_qkv(const P1Args& a, LAS unsigned char* lds) {
    { gs::DenseSched S{a.xb, a.wt_in, D_MODEL, (T_TOK / 256) * 8, vblock(), GRID, 8, 0, 4, 6}; EpiQK E{a.Q, a.Kb}; gs::gemm_stream<true, true, 0>(lds, D_MODEL, S, E); }
    { gs::DenseSched S{a.xb, a.wt_in, D_MODEL, (T_TOK / 256) * 4, vblock(), GRID, 4, 4, 2, 6}; EpiV E{a.Vt}; gs::gemm_stream<false, false, 0>(lds, D_MODEL, S, E); }
}

struct P3Args { const bf16_t* y; const bf16_t* wt_out; const bf16_t* xb; bf16_t* r; float* stats; };
struct EpiOut { const bf16_t* xb; bf16_t* r; float* stats;
    DI void operator()(const f32x4 (&acc)[2][2][4][2], const gs::DenseU& u, int wr, int wc, int fr, int fq) const {
#pragma unroll
        for (int ai = 0; ai < 2; ++ai) {
            u32x4 xw[4][2];
#pragma unroll
            for (int m = 0; m < 4; ++m)
#pragma unroll
                for (int bj = 0; bj < 2; ++bj) xw[m][bj] = *(const u32x4*)(xb + (size_t)(u.pm * 256 + 128 * ai + 64 * wr + 16 * m + fr) * D_MODEL + u.pn * 256 + 128 * bj + 32 * wc + 8 * fq);
#pragma unroll
            for (int m = 0; m < 4; ++m) {
                const int row = u.pm * 256 + 128 * ai + 64 * wr + 16 * m + fr;
#pragma unroll
                for (int bj = 0; bj < 2; ++bj) {
                    const int col = u.pn * 256 + 128 * bj + 32 * wc + 8 * fq;
                    const u32x4 w = xw[m][bj];
                    const f32x4 x0 = (f32x4){__uint_as_float(w[0] << 16), __uint_as_float(w[0] & 0xffff0000u), __uint_as_float(w[1] << 16), __uint_as_float(w[1] & 0xffff0000u)};
                    const f32x4 x1 = (f32x4){__uint_as_float(w[2] << 16), __uint_as_float(w[2] & 0xffff0000u), __uint_as_float(w[3] << 16), __uint_as_float(w[3] & 0xffff0000u)};
                    const f32x4 v0 = x0 * DN_ALPHA + acc[ai][bj][m][0], v1 = x1 * DN_ALPHA + acc[ai][bj][m][1];
                    float s = ((v0[0] + v0[1]) + (v0[2] + v0[3])) + ((v1[0] + v1[1]) + (v1[2] + v1[3]));
                    float q = ((v0[0] * v0[0] + v0[1] * v0[1]) + (v0[2] * v0[2] + v0[3] * v0[3])) + ((v1[0] * v1[0] + v1[1] * v1[1]) + (v1[2] * v1[2] + v1[3] * v1[3]));
                    u32x4 o; o.x = cvt_pk_bf16(v0[0], v0[1]); o.y = cvt_pk_bf16(v0[2], v0[3]); o.z = cvt_pk_bf16(v1[0], v1[1]); o.w = cvt_pk_bf16(v1[2], v1[3]);
                    *(u32x4*)(r + (size_t)row * D_MODEL + col) = o;
                    s += __shfl_xor(s, 16); s += __shfl_xor(s, 32); q += __shfl_xor(q, 16); q += __shfl_xor(q, 32);
                    if (fq == 0) *(f32x2*)(stats + ((size_t)row * 32 + u.pn * 8 + bj * 4 + wc) * 2) = (f32x2){s, q};
                }
            }
        }
    } };
DI void phase_outproj(const P3Args& a, LAS unsigned char* lds) {
    gs::DenseSched S{a.y, a.wt_out, D_MODEL, (T_TOK / 256) * 4, vblock(), GRID, 4, 0, 4, 0}; EpiOut E{a.xb, a.r, a.stats}; gs::gemm_stream<true, true, 0>(lds, D_MODEL, S, E);
}

DI void unpack16(const u32x4& a, const u32x4& b, float (&v)[16]) {
#pragma unroll
    for (int j = 0; j < 4; ++j) { v[2 * j] = __uint_as_float(a[j] << 16); v[2 * j + 1] = __uint_as_float(a[j] & 0xffff0000u); v[8 + 2 * j] = __uint_as_float(b[j] << 16); v[8 + 2 * j + 1] = __uint_as_float(b[j] & 0xffff0000u); }
}
DI void dma16_plain(const char* sbase, unsigned voff, unsigned lds_dst) {
    unsigned keep;
    asm volatile("s_mov_b32 %0, m0\n\ts_mov_b32 m0, %3\n\ts_nop 0\n\tglobal_load_lds_dwordx4 %1, %2\n\ts_mov_b32 m0, %0" : "=&s"(keep) : "v"(voff), "s"(sbase), "s"(lds_dst) : "memory");
}
DI void router_gemm(char* lds, const bf16_t* A, const bf16_t* Bt, f32x4 (&acc)[4][4]) {
    constexpr int STAGE = 16384 + 32768, NK = D_MODEL / 64;
    const int tid = tidx(), wid = __builtin_amdgcn_readfirstlane(tid >> 6), lane = tid & 63, wr = wid >> 2, wc = wid & 3, fr = lane & 15, fq = lane >> 4;
#pragma unroll
    for (int m = 0; m < 4; ++m)
#pragma unroll
        for (int n = 0; n < 4; ++n) acc[m][n] = (f32x4){0.f, 0.f, 0.f, 0.f};
    int aoff[2], boff[2];
#pragma unroll
    for (int ks = 0; ks < 2; ++ks) { const int ch = (((4 * ks + fq) ^ (fr >> 1)) << 4); aoff[ks] = (64 * wr + fr) * 128 + ch; boff[ks] = 16384 + (64 * wc + fr) * 128 + ch; }
    unsigned voA[2], voB[4];
#pragma unroll
    for (int i = 0; i < 2; ++i) { const int row = 8 * (2 * wid + i) + (lane >> 3), kc = (lane & 7) ^ ((row >> 1) & 7); voA[i] = (unsigned)(row * D_MODEL + kc * 8) * 2u; }
#pragma unroll
    for (int i = 0; i < 4; ++i) { const int row = 8 * (4 * wid + i) + (lane >> 3), kc = (lane & 7) ^ ((row >> 1) & 7); voB[i] = (unsigned)(row * D_MODEL + kc * 8) * 2u; }
    const unsigned lb = (unsigned)__builtin_amdgcn_readfirstlane((unsigned)(size_t)(LAS unsigned char*)lds);
    const char* ab = uni64(A); const char* bb = uni64(Bt);
#define RG_ISSUE(kt) do { const unsigned sb_ = lb + (unsigned)(((kt) % 3) * STAGE); const char* a_ = ab + (size_t)(kt) * 128; const char* b_ = bb + (size_t)(kt) * 128; \
        _Pragma("unroll") for (int i_ = 0; i_ < 2; ++i_) dma16_plain(a_, voA[i_], sb_ + (unsigned)((2 * wid + i_) * 1024)); \
        _Pragma("unroll") for (int i_ = 0; i_ < 4; ++i_) dma16_plain(b_, voB[i_], sb_ + 16384u + (unsigned)((4 * wid + i_) * 1024)); } while (0)
    __syncthreads();
    RG_ISSUE(0); RG_ISSUE(1);
#pragma unroll 1
    for (int kt = 0; kt < NK; ++kt) {
        if (kt + 1 < NK) asm volatile("s_waitcnt vmcnt(6)" ::: "memory"); else asm volatile("s_waitcnt vmcnt(0)" ::: "memory");
        asm volatile("s_waitcnt lgkmcnt(0)" ::: "memory"); __builtin_amdgcn_s_barrier(); asm volatile("" ::: "memory");
        if (kt + 2 < NK) RG_ISSUE(kt + 2);
        const char* cur = lds + (kt % 3) * STAGE;
#pragma unroll
        for (int ks = 0; ks < 2; ++ks) {
            bf16x8 a[4], b[4];
#pragma unroll
            for (int m = 0; m < 4; ++m) a[m] = *(const bf16x8*)(cur + aoff[ks] + m * 2048);
#pragma unroll
            for (int n = 0; n < 4; ++n) b[n] = *(const bf16x8*)(cur + boff[ks] + n * 2048);
#pragma unroll
            for (int m = 0; m < 4; ++m)
#pragma unroll
                for (int n = 0; n < 4; ++n) acc[m][n] = __builtin_amdgcn_mfma_f32_16x16x32_bf16(b[n], a[m], acc[m][n], 0, 0, 0);
        }
    }
#undef RG_ISSUE
    __syncthreads();
}
constexpr int RS_SC = 289;
constexpr int LDS_HIST = 100 * 1024;
struct P4Args { const bf16_t* r; const float* stats; const float* ln_g; const float* ln_b; bf16_t* x1; unsigned char* x1f8; const bf16_t* wt_r; const float* rbias;
                int* eidx; float* gate; int* counts; int* tokl; float* gatel; int* slot; };
DI void phase_router(const P4Args& a, const P0Args& cv, char* lds) {
    const int tid = tidx(), wid = tid >> 6, lane = tid & 63, wr = wid >> 2, wc = wid & 3, fr = lane & 15, fq = lane >> 4;
    float* sc = (float*)lds; int* hist = (int*)(lds + LDS_HIST); int* base = hist + 256;
    for (int u = vblock(); u < T_TOK / 128; u += GRID) {
        const int m0 = u * 128;
        if ((vblock() & 1) == 0) convert_moe_range(cv, lds, CV_GU, CV_GU + CV_DN);
        __syncthreads();
#pragma unroll 1
        for (int i0 = 0; i0 < 16; i0 += 4) {
            f32x2 st[4]; u32x4 r0[4], r1[4];
#pragma unroll
            for (int j4 = 0; j4 < 4; ++j4) {
                const int t = m0 + wid * 16 + i0 + j4;
                st[j4] = (f32x2){0.f, 0.f};
                if (lane < 32) st[j4] = *(const f32x2*)(a.stats + ((size_t)t * 32 + lane) * 2);
                r0[j4] = *(const u32x4*)(a.r + (size_t)t * D_MODEL + lane * 16); r1[j4] = *(const u32x4*)(a.r + (size_t)t * D_MODEL + lane * 16 + 8);
            }
#pragma unroll
            for (int j4 = 0; j4 < 4; ++j4) {
                const int t = m0 + wid * 16 + i0 + j4;
                float s = st[j4].x, q = st[j4].y;
#pragma unroll
                for (int o = 1; o <= 16; o <<= 1) { s += __shfl_xor(s, o); q += __shfl_xor(q, o); }
                s = __shfl(s, 0); q = __shfl(q, 0);
                const float mu = s * (1.f / 1024.f), rstd = rsqrtf(q * (1.f / 1024.f) - mu * mu + LN_EPS);
                float v[16]; unpack16(r0[j4], r1[j4], v);
                u32x4 o0, o1, o8;
#pragma unroll
                for (int j = 0; j < 4; ++j) {
                    const f32x4 g = *(const f32x4*)(a.ln_g + lane * 16 + 4 * j), bb = *(const f32x4*)(a.ln_b + lane * 16 + 4 * j);
                    const float y0 = (v[4 * j] - mu) * rstd * g[0] + bb[0], y1 = (v[4 * j + 1] - mu) * rstd * g[1] + bb[1], y2 = (v[4 * j + 2] - mu) * rstd * g[2] + bb[2], y3 = (v[4 * j + 3] - mu) * rstd * g[3] + bb[3];
                    o8[j] = pack_fp8x4(y0 * XSCALE, y1 * XSCALE, y2 * XSCALE, y3 * XSCALE);
                    const unsigned p0 = cvt_pk_bf16(y0, y1), p1 = cvt_pk_bf16(y2, y3);
                    if (j < 2) { o0[2 * j] = p0; o0[2 * j + 1] = p1; } else { o1[2 * (j - 2)] = p0; o1[2 * (j - 2) + 1] = p1; }
                }
                *(u32x4*)(a.x1 + (size_t)t * D_MODEL + lane * 16) = o0; *(u32x4*)(a.x1 + (size_t)t * D_MODEL + lane * 16 + 8) = o1;
                *(u32x4*)(a.x1f8 + (size_t)t * D_MODEL + lane * 16) = o8;
            }
        }
        asm volatile("s_waitcnt vmcnt(0)" ::: "memory");
        __syncthreads();
        f32x4 acc[4][4];
        router_gemm(lds, a.x1 + (size_t)m0 * D_MODEL, a.wt_r, acc);
        if (tid < 256) hist[tid] = 0;
        int my_idx[2], my_rank[2]; float my_gate[2];
#pragma unroll
        for (int p = 0; p < 2; ++p) {
            __syncthreads();
            if (wr == p) {
#pragma unroll
                for (int m = 0; m < 4; ++m)
#pragma unroll
                    for (int n = 0; n < 4; ++n) {
                        const int c0 = 64 * wc + 16 * n + 4 * fq; const f32x4 rb = *(const f32x4*)(a.rbias + c0);
#pragma unroll
                        for (int j = 0; j < 4; ++j) { const int c = c0 + j; sc[(16 * m + fr) * RS_SC + (c >> 5) * 36 + (c & 31)] = 1.f / (1.f + __expf(-acc[m][n][j])) + rb[j]; }
                    }
            }
            __syncthreads();
            const int row = tid >> 3, g = tid & 7, t = m0 + 64 * p + row;
            float sel[32];
#pragma unroll
            for (int i = 0; i < 32; ++i) sel[i] = sc[row * RS_SC + g * 36 + i];
            float m1 = -INFINITY, m2 = -INFINITY;
#pragma unroll
            for (int i = 0; i < 32; ++i) { const float v = sel[i]; m2 = fmaxf(m2, fminf(m1, v)); m1 = fmaxf(m1, v); }
            const float gs = m1 + m2; int rank = 0;
#pragma unroll
            for (int d = 1; d < 8; ++d) { const float o = __shfl_xor(gs, d); const int og = g ^ d; rank += (o > gs || (o == gs && og < g)) ? 1 : 0; }
            const bool en = rank < TOPK_GROUPS;
            float lv = -INFINITY; int li = 1 << 20;
            if (en) {
#pragma unroll
                for (int i = 0; i < 32; ++i) { const float v = sel[i]; if (v > lv) { lv = v; li = g * 32 + i; } }
            }
            float myv = 0.f; int myi = 0;
#pragma unroll
            for (int k = 0; k < TOP_K; ++k) {
                float bv = lv; int bi = li;
#pragma unroll
                for (int d = 1; d < 8; d <<= 1) { const float ov = __shfl_xor(bv, d); const int oi = __shfl_xor(bi, d); if (ov > bv || (ov == bv && oi < bi)) { bv = ov; bi = oi; } }
                if (g == k) { myv = bv; myi = bi; }
                if (k + 1 < TOP_K && (bi >> 5) == g) {
                    lv = -INFINITY; li = 1 << 20;
#pragma unroll
                    for (int i = 0; i < 32; ++i) { if (g * 32 + i == bi) sel[i] = -INFINITY; const float v = sel[i]; if (v > lv) { lv = v; li = g * 32 + i; } }
                }
            }
            const float score = myv - a.rbias[myi];
            float gsum = score;
#pragma unroll
            for (int d = 1; d < 8; d <<= 1) gsum += __shfl_xor(gsum, d);
            const float gt = score / gsum * ROUTED_SCALE;
            a.eidx[t * TOP_K + g] = myi; a.gate[t * TOP_K + g] = gt;
            my_idx[p] = myi; my_gate[p] = gt; my_rank[p] = atomicAdd(&hist[myi], 1);
        }
        __syncthreads();
        if (tid < 256) { const int h = hist[tid]; base[tid] = h > 0 ? atomicAdd(&a.counts[tid * CSTR], h) : 0; }
        __syncthreads();
#pragma unroll
        for (int p = 0; p < 2; ++p) {
            const int row = tid >> 3, g = tid & 7, t = m0 + 64 * p + row, e = my_idx[p], pos = base[e] + my_rank[p];
            a.tokl[(size_t)e * CAP + pos] = t; a.gatel[(size_t)e * CAP + pos] = my_gate[p]; a.slot[t * TOP_K + g] = e * CAP + pos;
        }
        if ((vblock() & 1) == 1) convert_moe_range(cv, lds, CV_GU, CV_GU + CV_DN);
    }
}

constexpr int LDS_ROWTAB = 128 * 1024;
constexpr int LDS_GTAB = 139 * 1024;
constexpr int LDS_TAB = 150 * 1024;
constexpr int LDS_UTAB = 154 * 1024;
constexpr int MOE_BM = 256;
DI void build_moe_tab(const int* counts, char* lds) {
    int* tstart = (int*)(lds + LDS_TAB); int* rstart = tstart + 264; int* cnts = tstart + 528;
    const int tid = tidx(), lane = tid & 63;
    __syncthreads();
    if (tid < 64) {
        int c[4], tl[4], cs = 0, ts = 0;
#pragma unroll
        for (int i = 0; i < 4; ++i) { c[i] = counts[(lane * 4 + i) * CSTR]; tl[i] = (c[i] + MOE_BM - 1) / MOE_BM; cs += c[i]; ts += tl[i]; }
        int ci = cs, ti = ts;
#pragma unroll
        for (int o = 1; o < 64; o <<= 1) { const int n1 = __shfl_up(ci, o), n2 = __shfl_up(ti, o); if (lane >= o) { ci += n1; ti += n2; } }
        int ce = ci - cs, te = ti - ts;
#pragma unroll
        for (int i = 0; i < 4; ++i) { rstart[lane * 4 + i] = ce; tstart[lane * 4 + i] = te; cnts[lane * 4 + i] = c[i]; ce += c[i]; te += tl[i]; }
        if (lane == 63) { rstart[256] = ce; tstart[256] = te; cnts[256] = T_TOK; rstart[257] = ce + T_TOK; tstart[257] = te + T_TOK / MOE_BM; }
    }
    __syncthreads();
}
DI int find_expert(const int* tstart, int g) {
    int lo = 0, hi = 256;
#pragma unroll 1
    while (lo < hi) { const int mid = (lo + hi + 1) >> 1; if (tstart[mid] <= g) lo = mid; else hi = mid - 1; }
    return lo;
}
struct MoeU { const char* A; const char* B; int e, m0, sub, ui; };
typedef const LAS int* ltab_t;
DI int find_expert_l(ltab_t tstart, int g) { int lo = 0, hi = 256;
#pragma unroll 1
    while (lo < hi) { const int mid = (lo + hi + 1) >> 1; if (tstart[mid] <= g) lo = mid; else hi = mid - 1; }
    return lo; }

struct P6Args { const unsigned char* x1; const int* counts; const int* tokl; const float* gatel; const unsigned char* wgut; unsigned char* H; };
struct GuSched {
    typedef MoeU U;
    ltab_t tab; const LAS int* rowtab; const LAS int* utab; const unsigned char* x1; const unsigned char* wgut; int first, stride, nunits;
    DI bool next(int i, U& u) const {
        const int L = first + i * stride; if (L >= nunits) return false;
        const int g = L >> 1, e = utab[i];
        u.sub = L & 1; u.e = e; u.ui = i; u.m0 = (g - tab[e]) * MOE_BM;
        u.A = (const char*)x1; u.B = (const char*)(wgut + ((size_t)e * 512 + 256 * u.sub) * D_MODEL); return true;
    }
    DI unsigned a_voff(int i, int h, int R, int C) const { return (unsigned)(rowtab[i * 256 + 128 * h + R] * (D_MODEL / 2) + C) * 2u; }
};
struct EpiGU { unsigned char* H; const LAS float* gtab; ltab_t tab;
    DI void operator()(const f32x4 (&acc)[2][2][4][2], const MoeU& u, int wr, int wc, int fr, int fq) const {
        const int st = tab[264 + u.e], cnt = tab[528 + u.e];
#pragma unroll
        for (int ai = 0; ai < 2; ++ai)
#pragma unroll
            for (int m = 0; m < 4; ++m) {
                const int row = u.m0 + 128 * ai + 64 * wr + 16 * m + fr;
                if (row < cnt) {
                    const float gt = gtab[u.ui * 256 + 128 * ai + 64 * wr + 16 * m + fr] * (HSCALE / (XSCALE * WSCALE));
                    float h[8];
#pragma unroll
                    for (int n = 0; n < 2; ++n)
#pragma unroll
                        for (int j = 0; j < 4; ++j) { const float gv = acc[ai][0][m][n][j] * (1.f / (XSCALE * WSCALE)); h[4 * n + j] = gv * __builtin_amdgcn_rcpf(1.f + __expf(-gv)) * acc[ai][1][m][n][j] * gt; }
                    *(u32x2*)(H + (size_t)(st + row) * D_EXP + 128 * u.sub + 32 * wc + 8 * fq) = (u32x2){pack_fp8x4(h[0], h[1], h[2], h[3]), pack_fp8x4(h[4], h[5], h[6], h[7])};
                }
            }
    } };
DI void phase_moe_gu(const P6Args& a, char* smem, LAS unsigned char* lds) {
    build_moe_tab(a.counts, smem);
    const int* tstart = (const int*)(smem + LDS_TAB); const int* rstart = tstart + 264; int* rowtab = (int*)(smem + LDS_ROWTAB); float* gtab = (float*)(smem + LDS_GTAB);
    const int nunits = tstart[257] * 2, first = vblock();
    const int n_my = first < nunits ? (nunits - first + GRID - 1) / GRID : 0;
    for (int idx = tidx(); idx < n_my * 256; idx += NTHR) {
        const int i = idx >> 8, row = idx & 255, L = first + i * GRID, g = L >> 1, e = find_expert(tstart, g), m0 = (g - tstart[e]) * MOE_BM, cnt = tstart[528 + e];
        int rr = m0 + row; rr = rr < cnt ? rr : cnt - 1;
        rowtab[idx] = e < N_EXP ? a.tokl[(size_t)e * CAP + rr] : rr;
        gtab[idx] = e < N_EXP ? a.gatel[(size_t)e * CAP + rr] : 1.f;
    }
    if (tidx() < 32 && tidx() < n_my) ((int*)(smem + LDS_UTAB))[tidx()] = find_expert(tstart, (first + tidx() * GRID) >> 1);
    __syncthreads();
    GuSched S{(ltab_t)(lds + LDS_TAB), (const LAS int*)(lds + LDS_ROWTAB), (const LAS int*)(lds + LDS_UTAB), a.x1, a.wgut, first, GRID, nunits}; EpiGU E{a.H, (const LAS float*)(lds + LDS_GTAB), (ltab_t)(lds + LDS_TAB)};
    gs::gemm_stream<true, true, 2>(lds, D_MODEL / 2, S, E);
}
struct P7Args { const unsigned char* H; const int* counts; const unsigned char* wdt; unsigned char* Y; };
struct DownSched {
    typedef MoeU U;
    ltab_t tab; const LAS int* utab; const unsigned char* H; const unsigned char* wdt; int first, stride, nunits;
    DI bool next(int i, U& u) const {
        const int L = first + i * stride; if (L >= nunits) return false;
        const int g = L >> 2, e = utab[i];
        u.sub = L & 3; u.e = e; u.ui = i; u.m0 = (g - tab[e]) * MOE_BM;
        u.A = (const char*)(H + (size_t)(tab[264 + e] + u.m0) * D_EXP); u.B = (const char*)(wdt + ((size_t)e * D_MODEL + 256 * u.sub) * D_EXP); return true;
    }
    DI unsigned a_voff(int, int h, int R, int C) const { return (unsigned)((128 * h + R) * (D_EXP / 2) + C) * 2u; }
};
struct EpiDown { unsigned char* Y; ltab_t tab;
    DI void operator()(const f32x4 (&acc)[2][2][4][2], const MoeU& u, int wr, int wc, int fr, int fq) const {
        const int st = tab[264 + u.e], cnt = tab[528 + u.e];
#pragma unroll
        for (int ai = 0; ai < 2; ++ai)
#pragma unroll
            for (int m = 0; m < 4; ++m) {
                const int row = u.m0 + 128 * ai + 64 * wr + 16 * m + fr;
                if (row < cnt) {
                    u32x4 o;
#pragma unroll
                    for (int bj = 0; bj < 2; ++bj) {
                        const f32x4 v0 = acc[ai][bj][m][0] * (YSCALE / (HSCALE * WSCALE)), v1 = acc[ai][bj][m][1] * (YSCALE / (HSCALE * WSCALE));
                        o[2 * bj] = pack_fp8x4(v0[0], v0[1], v0[2], v0[3]); o[2 * bj + 1] = pack_fp8x4(v1[0], v1[1], v1[2], v1[3]);
                    }
                    *(u32x4*)(Y + (size_t)(st + row) * D_MODEL + 256 * u.sub + 64 * wc + 16 * fq) = o;
                }
            }
    } };
DI void phase_moe_down(const P7Args& a, char* smem, LAS unsigned char* lds) {
    const int* tstart = (const int*)(smem + LDS_TAB); const int* rstart = tstart + 264;
    { const int nun = tstart[257] * 4, i = tidx(); if (i < 32 && vblock() + i * GRID < nun) ((int*)(smem + LDS_UTAB))[i] = find_expert(tstart, (vblock() + i * GRID) >> 2); }
    __syncthreads();
    DownSched S{(ltab_t)(lds + LDS_TAB), (const LAS int*)(lds + LDS_UTAB), a.H, a.wdt, vblock(), GRID, tstart[257] * 4}; EpiDown E{a.Y, (ltab_t)(lds + LDS_TAB)};
    gs::gemm_stream<true, true, 2>(lds, D_EXP / 2, S, E);
}
struct P8Args { const bf16_t* x1; const unsigned char* Y; const int* slot; const int* counts; const float* ln_g; const float* ln_b; float* out; };
DI void phase_combine(const P8Args& a, char* lds) {
    const int tid = tidx(), wid = tid >> 6, lane = tid & 63;
    const int* rstart = (const int*)(lds + LDS_TAB) + 264;
    const int sh0 = rstart[256];
    const int c0 = 256 * (lane >> 4) + 32 * ((lane >> 2) & 3) + 8 * (lane & 3);
    for (int t = vblock() * 8 + wid; t < T_TOK; t += GRID * 8) {
        float v[16], w[16];
        { const u32x4 p0 = *(const u32x4*)(a.x1 + (size_t)t * D_MODEL + c0), p1 = *(const u32x4*)(a.x1 + (size_t)t * D_MODEL + c0 + 128); unpack16(p0, p1, v); }
        int sl = 0; if (lane < TOP_K) sl = a.slot[t * TOP_K + lane];
        u32x4 yr[9];
        yr[8] = *(const u32x4*)(a.Y + (size_t)(sh0 + t) * D_MODEL + lane * 16);
#pragma unroll
        for (int k = 0; k < TOP_K; ++k) { const int s = __shfl(sl, k), e = s / CAP, pos = s % CAP; yr[k] = *(const u32x4*)(a.Y + (size_t)(rstart[e] + pos) * D_MODEL + lane * 16); }
#pragma unroll
        for (int i = 0; i < 16; ++i) w[i] = 0.f;
#pragma unroll
        for (int k = 0; k < 9; ++k)
#pragma unroll
            for (int j = 0; j < 4; ++j) { const f32x2 lo = __builtin_amdgcn_cvt_pk_f32_fp8((int)yr[k][j], false), hi = __builtin_amdgcn_cvt_pk_f32_fp8((int)yr[k][j], true); w[4 * j] += lo.x; w[4 * j + 1] += lo.y; w[4 * j + 2] += hi.x; w[4 * j + 3] += hi.y; }
#pragma unroll
        for (int i = 0; i < 16; ++i) v[i] = v[i] * DN_ALPHA + w[i] * (1.f / YSCALE);
        float s = 0.f;
#pragma unroll
        for (int i = 0; i < 16; ++i) s += v[i];
#pragma unroll
        for (int o = 32; o >= 1; o >>= 1) s += __shfl_xor(s, o);
        const float mu = s * (1.f / 1024.f);
        float q = 0.f;
#pragma unroll
        for (int i = 0; i < 16; ++i) { const float d = v[i] - mu; q += d * d; }
#pragma unroll
        for (int o = 32; o >= 1; o >>= 1) q += __shfl_xor(q, o);
        const float rstd = rsqrtf(q * (1.f / 1024.f) + LN_EPS);
#pragma unroll
        for (int j = 0; j < 4; ++j) {
            const int col = c0 + 128 * (j >> 1) + 4 * (j & 1);
            const f32x4 g = *(const f32x4*)(a.ln_g + col), bb = *(const f32x4*)(a.ln_b + col);
            f32x4 o; o[0] = (v[4 * j] - mu) * rstd * g[0] + bb[0]; o[1] = (v[4 * j + 1] - mu) * rstd * g[1] + bb[1]; o[2] = (v[4 * j + 2] - mu) * rstd * g[2] + bb[2]; o[3] = (v[4 * j + 3] - mu) * rstd * g[3] + bb[3];
            *(f32x4*)(a.out + (size_t)t * D_MODEL + col) = o;
        }
    }
}
#define MFMA32(a, b, c) __builtin_amdgcn_mfma_f32_32x32x16_bf16((a), (b), (c), 0, 0, 0)
constexpr float SB_EXIT_THR = 1e-30f;
struct P2Args { const bf16_t* Q; const bf16_t* Kb; const bf16_t* Vt; const float* rel_bias; const float* gain_a; const float* gain_b; bf16_t* y; };

DI bf16x8 pack8(const f32x16& x, int s) {
    u32x4 p;
    if (s == 0) { p.x = cvt_pk_bf16(x[0], x[1]); p.y = cvt_pk_bf16(x[2], x[3]); p.z = cvt_pk_bf16(x[4], x[5]); p.w = cvt_pk_bf16(x[6], x[7]); }
    else        { p.x = cvt_pk_bf16(x[8], x[9]); p.y = cvt_pk_bf16(x[10], x[11]); p.z = cvt_pk_bf16(x[12], x[13]); p.w = cvt_pk_bf16(x[14], x[15]); }
    return __builtin_bit_cast(bf16x8, p);
}
DI void load_k(bf16x8 (&k)[4], const bf16_t* kp, int k0) {
#pragma unroll
    for (int kk = 0; kk < 4; ++kk) k[kk] = *(const bf16x8*)(kp + (size_t)(k0 >> 5) * 2048 + kk * 512);
}
DI void load_v(bf16x8 (&v)[2][2], const bf16_t* vp, int k0) {
#pragma unroll
    for (int dt = 0; dt < 2; ++dt)
#pragma unroll
        for (int s = 0; s < 2; ++s) v[dt][s] = *(const bf16x8*)(vp + (size_t)(k0 >> 5) * 2048 + (dt * 2 + s) * 512);
}

constexpr int LDS_CVT = 16 * 1024;
DI void phase_attn(const P2Args& a, const P0Args& cv, char* lds) {
    const int tid = tidx(), wid = tid >> 6, lane = tid & 63, r = lane & 31, h = lane >> 5;
    float* tbl = (float*)lds;
    float* ssq = (float*)(lds + 8 * 260 * 4);
    __syncthreads();
    for (int i = tid; i < NHA * 257; i += NTHR) { const int hd = i / 257, j = i % 257; tbl[hd * 260 + j] = a.rel_bias[i] * LOG2E; }
    __syncthreads();
    const int cgrp = vblock() % 2;
#pragma unroll 1
    for (int slot = 0; slot < 5; ++slot) {
        if ((cgrp == 0 && slot == 0) || (cgrp == 1 && slot == 4)) convert_moe_range(cv, lds + LDS_CVT, 0, CV_GU);
        if (slot == 4) break;
        const int u = vblock() + GRID * (slot >> 1) + 2 * GRID * (slot & 1);
        const bool isB = u >= BATCH * (SEQ / 64); const int uu = isB ? u - BATCH * (SEQ / 64) : u;
        const int b = uu / (SEQ / 64), c = uu % (SEQ / 64), q0 = c * 64, hh = (isB ? NHA : 0) + wid;
        const size_t hb = (size_t)(b * NHH + hh) * SEQ * 64;
        const bf16_t* kp = a.Kb + hb + lane * 8;
        const bf16_t* vp = a.Vt + hb + lane * 8;
        bf16x8 qf[2][4];
#pragma unroll
        for (int qt = 0; qt < 2; ++qt)
#pragma unroll
            for (int kk = 0; kk < 4; ++kk) qf[qt][kk] = *(const bf16x8*)(a.Q + hb + (size_t)((q0 >> 5) + qt) * 2048 + kk * 512 + lane * 8);
        f32x16 ot[2][2];
#pragma unroll
        for (int dt = 0; dt < 2; ++dt)
#pragma unroll
            for (int qt = 0; qt < 2; ++qt)
#pragma unroll
                for (int i = 0; i < 16; ++i) ot[dt][qt][i] = 0.f;
        float linv[2] = {1.f, 1.f};
        if (!isB) {
            float mrun[2] = {-INFINITY, -INFINITY}, lrun[2] = {0.f, 0.f};
            const int klo = q0 - LEFT_CHUNKS * CHUNK < 0 ? 0 : q0 - LEFT_CHUNKS * CHUNK, khi = q0 + 64;
            const float cfar = tbl[wid * 260 + 256];
            bf16x8 kc[4], kn[4], vf[2][2]; load_k(kc, kp, klo);
            for (int k0 = klo; k0 < khi; k0 += 32) {
                load_v(vf, vp, k0);
                load_k(kn, kp, k0 + 32 < khi ? k0 + 32 : k0);
#pragma unroll
                for (int qt = 0; qt < 2; ++qt) {
                    bf16x8 pf[2];
                    f32x16 st;
#pragma unroll
                    for (int i = 0; i < 16; ++i) st[i] = 0.f;
#pragma unroll
                    for (int kk = 0; kk < 4; ++kk) st = MFMA32(kc[kk], qf[qt][kk], st);
                    const int dmin = q0 + 32 * qt - k0 - 31;
                    float boff = 0.f;
                    if (dmin >= MAX_REL) boff = cfar;
                    else {
                        const int bidx = q0 + 32 * qt + r - k0 - 4 * h + MAX_REL;
#pragma unroll
                        for (int i = 0; i < 16; ++i) { int ix = bidx - ((i & 3) + 8 * (i >> 2)); ix = ix < 0 ? 0 : (ix > 2 * MAX_REL ? 2 * MAX_REL : ix); st[i] += tbl[wid * 260 + ix]; }
                    }
                    float mx = st[0];
#pragma unroll
                    for (int i = 1; i < 16; ++i) mx = fmaxf(mx, st[i]);
                    mx = fmaxf(mx, __shfl_xor(mx, 32)) + boff;
                    const float mo = mrun[qt], mn = fmaxf(mo, mx);
                    mrun[qt] = mn;
                    const float eo = boff - mn;
                    float ps = 0.f;
#pragma unroll
                    for (int i = 0; i < 16; ++i) { st[i] = __builtin_amdgcn_exp2f(st[i] + eo); ps += st[i]; }
                    if (__all(mn == mo)) lrun[qt] += ps;
                    else {
                        const float alpha = __builtin_amdgcn_exp2f(mo - mn);
                        lrun[qt] = lrun[qt] * alpha + ps;
#pragma unroll
                        for (int i = 0; i < 16; ++i) { ot[0][qt][i] *= alpha; ot[1][qt][i] *= alpha; }
                    }
                    pf[0] = pack8(st, 0); pf[1] = pack8(st, 1);
#pragma unroll
                    for (int dt = 0; dt < 2; ++dt)
#pragma unroll
                        for (int s = 0; s < 2; ++s) ot[dt][qt] = MFMA32(vf[dt][s], pf[s], ot[dt][qt]);
                }
#pragma unroll
                for (int kk = 0; kk < 4; ++kk) kc[kk] = kn[kk];
            }
#pragma unroll
            for (int qt = 0; qt < 2; ++qt) { const float lt = lrun[qt] + __shfl_xor(lrun[qt], 32); linv[qt] = 1.f / lt; }
        } else {
            float carry[2] = {1.f, 1.f};
            bf16x8 kc[4], kn[4], vf[2][2]; load_k(kc, kp, q0 + 32);
            for (int k0 = q0 + 32; k0 >= 0; k0 -= 32) {
                load_v(vf, vp, k0);
                load_k(kn, kp, k0 >= 32 ? k0 - 32 : k0);
#pragma unroll
                for (int qt = 0; qt < 2; ++qt) {
                    bf16x8 pf[2];
                    f32x16 st;
#pragma unroll
                    for (int i = 0; i < 16; ++i) st[i] = 0.f;
                    const bool none = (k0 > q0 + 32 * qt + 30);
                    if (!none) {
#pragma unroll
                        for (int kk = 0; kk < 4; ++kk) st = MFMA32(kc[kk], qf[qt][kk], st);
                        const bool full = (k0 + 31 < q0 + 32 * qt);
                        const int lim = q0 + 32 * qt + r - k0 - 4 * h;
                        float om[16];
#pragma unroll
                        for (int i = 0; i < 16; ++i) {
                            const float e = __builtin_amdgcn_exp2f(-st[i]); float bta = __builtin_amdgcn_rcpf(1.f + e);
                            if (!full && !(((i & 3) + 8 * (i >> 2)) < lim)) bta = 0.f;
                            st[i] = bta; om[i] = 1.f - bta;
                        }
                        float G[4], Go[4];
#pragma unroll
                        for (int g = 0; g < 4; ++g) { G[g] = (om[4 * g] * om[4 * g + 1]) * (om[4 * g + 2] * om[4 * g + 3]); Go[g] = __shfl_xor(G[g], 32); }
                        float R = carry[qt];
#pragma unroll
                        for (int g = 3; g >= 0; --g) {
                            float run = h == 0 ? R * Go[g] : R;
#pragma unroll
                            for (int uu2 = 3; uu2 >= 0; --uu2) { const float bta = st[4 * g + uu2]; st[4 * g + uu2] = bta * run; run *= om[4 * g + uu2]; }
                            R = R * (G[g] * Go[g]);
                        }
                        carry[qt] = R;
                    }
                    if (!none) {
                        pf[0] = pack8(st, 0); pf[1] = pack8(st, 1);
#pragma unroll
                        for (int dt = 0; dt < 2; ++dt)
#pragma unroll
                            for (int s = 0; s < 2; ++s) ot[dt][qt] = MFMA32(vf[dt][s], pf[s], ot[dt][qt]);
                    }
                }
#pragma unroll
                for (int kk = 0; kk < 4; ++kk) kc[kk] = kn[kk];
                if (__all(carry[0] < SB_EXIT_THR && carry[1] < SB_EXIT_THR)) break;
            }
        }
        float ss[2];
#pragma unroll
        for (int qt = 0; qt < 2; ++qt) {
            float s2 = 0.f;
#pragma unroll
            for (int dt = 0; dt < 2; ++dt)
#pragma unroll
                for (int i = 0; i < 16; ++i) { ot[dt][qt][i] *= linv[qt]; s2 += ot[dt][qt][i] * ot[dt][qt][i]; }
            s2 += __shfl_xor(s2, 32); ss[qt] = s2;
        }
        __syncthreads();
        if (h == 0) { ssq[wid * 64 + r] = ss[0]; ssq[wid * 64 + 32 + r] = ss[1]; }
        __syncthreads();
        const float* gain = isB ? a.gain_b : a.gain_a;
#pragma unroll
        for (int qt = 0; qt < 2; ++qt) {
            float tot = 0.f;
#pragma unroll
            for (int w8 = 0; w8 < 8; ++w8) tot += ssq[w8 * 64 + 32 * qt + r];
            const float rs = rsqrtf(tot * (1.f / 512.f) + RMS_EPS);
            char* yst = lds + LDS_CVT + wid * (64 * 136);
#pragma unroll
            for (int dt = 0; dt < 2; ++dt)
#pragma unroll
                for (int g = 0; g < 4; ++g) {
                    const int d = 32 * dt + 8 * g + 4 * h; const f32x4 gn = *(const f32x4*)(gain + wid * 64 + d);
                    u32x2 o; o.x = cvt_pk_bf16(ot[dt][qt][4 * g] * rs * gn[0], ot[dt][qt][4 * g + 1] * rs * gn[1]); o.y = cvt_pk_bf16(ot[dt][qt][4 * g + 2] * rs * gn[2], ot[dt][qt][4 * g + 3] * rs * gn[3]);
                    *(u32x2*)(yst + (32 * qt + r) * 136 + d * 2) = o;
                }
        }
        {
            char* yst = lds + LDS_CVT + wid * (64 * 136);
            bf16_t* yb = a.y + (size_t)(b * SEQ + q0) * D_MODEL + (isB ? 512 : 0) + wid * 64;
#pragma unroll
            for (int j = 0; j < 8; ++j) {
                const int tok = (lane >> 3) + 8 * j, ch = lane & 7;
                const u32x2 lo = *(const u32x2*)(yst + tok * 136 + ch * 16), hi = *(const u32x2*)(yst + tok * 136 + ch * 16 + 8);
                *(u32x4*)(yb + (size_t)tok * D_MODEL + ch * 8) = (u32x4){lo.x, lo.y, hi.x, hi.y};
            }
        }
    }
}


#define XB_TMO      128
#define XB_XCNT(j)  (256  + 64 * (j))
#define XB_XSUB(j)  (1280 + 64 * (j))
#define XB_XGEN(j)  (2304 + 64 * (j))
#define XB_TOP      3328
#define XB_TOPGEN   3392
#define XCD_BAR_WORDS 3456
#define XB_SPIN_CAP (1u << 18)
#define LAS __attribute__((address_space(3)))

__device__ __forceinline__ unsigned xb_ld(unsigned* p)              { return __hip_atomic_load(p, __ATOMIC_RELAXED, __HIP_MEMORY_SCOPE_AGENT); }
__device__ __forceinline__ unsigned xb_add(unsigned* p, unsigned v) { return __hip_atomic_fetch_add(p, v, __ATOMIC_RELAXED, __HIP_MEMORY_SCOPE_AGENT); }
__device__ __forceinline__ unsigned xb_xcc_id() { return (unsigned)__builtin_amdgcn_s_getreg((3 << 11) | 20) & 0xFu; }
#define XB_SPIN(cond, bar) do { unsigned _sp = 0; while (cond) { __builtin_amdgcn_s_sleep(1); \
    if ((++_sp & 255u) == 0u) { if (xb_ld(&(bar)[XB_TMO])) break; if (_sp > XB_SPIN_CAP) { atomicAdd(&(bar)[XB_TMO], 1u); break; } } } } while (0)

struct XcdBarrier {
    unsigned* bar; unsigned x;
    volatile LAS unsigned* st;
};

__device__ __forceinline__ XcdBarrier xcd_barrier_post(unsigned* bar, volatile LAS unsigned* st) {
    XcdBarrier b; b.bar = bar; b.x = xb_xcc_id(); b.st = st;
    if (threadIdx.x == 0) (void)xb_add(&bar[XB_XCNT(b.x)], 1u);
    return b;
}
__device__ __forceinline__ void xcd_barrier_complete(unsigned* bar, unsigned x, unsigned& nloc, unsigned& nx) {
    const unsigned G = gridDim.x * gridDim.y * gridDim.z;
    unsigned sum, cnt, mine, sp = 0u;
    for (;;) {
        sum = 0u; cnt = 0u; mine = 0u;
#pragma unroll
        for (unsigned j = 0; j < 16; ++j) { const unsigned c = xb_ld(&bar[XB_XCNT(j)]); sum += c; cnt += (c > 0u) ? 1u : 0u; mine = (j == x) ? c : mine; }
        if (sum == G) break;
        __builtin_amdgcn_s_sleep(1);
        if ((++sp & 255u) == 0u) { if (xb_ld(&bar[XB_TMO])) break; if (sp > XB_SPIN_CAP) { atomicAdd(&bar[XB_TMO], 1u); break; } }
    }
    nloc = mine > 0u ? mine : 1u; nx = cnt > 0u ? cnt : 1u;
}

__device__ __forceinline__ void xcd_barrier(const XcdBarrier& b) {
    asm volatile("s_waitcnt vmcnt(0)" ::: "memory");
    __syncthreads();
    if (threadIdx.x == 0) {
        unsigned* bar = b.bar;
        __builtin_amdgcn_s_waitcnt(0);
        unsigned nloc = b.st[0], nx = b.st[1];
        if (nloc == 0u) { xcd_barrier_complete(bar, b.x, nloc, nx); b.st[0] = nloc; b.st[1] = nx; }
        const unsigned old = xb_add(&bar[XB_XSUB(b.x)], 1u);
        const unsigned gen = old / nloc;
        if (old + 1u == (gen + 1u) * nloc) {
            __builtin_amdgcn_fence(__ATOMIC_RELEASE, "agent");
            asm volatile("s_waitcnt vmcnt(0)" ::: "memory");
            const unsigned og = xb_add(&bar[XB_TOP], 1u);
            const unsigned tg = og / nx;
            if (og + 1u == (tg + 1u) * nx) xb_add(&bar[XB_TOPGEN], 1u);
            else XB_SPIN(xb_ld(&bar[XB_TOPGEN]) == tg, bar);
            __builtin_amdgcn_fence(__ATOMIC_ACQUIRE, "agent");
            xb_add(&bar[XB_XGEN(b.x)], 1u);
            asm volatile("s_waitcnt vmcnt(0)" ::: "memory");
        } else {
            XB_SPIN(xb_ld(&bar[XB_XGEN(b.x)]) == gen, bar);
            __builtin_amdgcn_fence(__ATOMIC_ACQUIRE, "agent");
            asm volatile("s_waitcnt vmcnt(0)" ::: "memory");
        }
    }
    __syncthreads();
}


struct MegaArgs { P0Args p0; P1Args p1; P2Args p2; P3Args p3; P4Args p4; P6Args p6; P7Args p7; P8Args p8; unsigned* bar; };
__global__ __launch_bounds__(NTHR, 2) void k_mega(MegaArgs a) {
    extern __shared__ __attribute__((aligned(16))) char smem[];
    volatile LAS unsigned* xbw = (volatile LAS unsigned*)(smem + LDS_BYTES - 16);
    if (threadIdx.x == 0) { xbw[0] = 0u; xbw[1] = 0u; xbw[2] = 0u; xbw[3] = 0u; }
    __syncthreads();
    XcdBarrier bar = xcd_barrier_post(a.bar, xbw);
    LAS unsigned char* L = (LAS unsigned char*)smem;
    phase_prologue(a.p0, smem);     xcd_barrier(bar);
    phase_qkv(a.p1, L);             xcd_barrier(bar);
    phase_attn(a.p2, a.p0, smem);   xcd_barrier(bar);
    phase_outproj(a.p3, L);         xcd_barrier(bar);
    phase_router(a.p4, a.p0, smem); xcd_barrier(bar);
    phase_moe_gu(a.p6, smem, L);    xcd_barrier(bar);
    phase_moe_down(a.p7, smem, L);  xcd_barrier(bar);
    phase_combine(a.p8, smem);
}

extern "C" void kernel_launch(void* const* d_in, const int* in_sizes, int n_in, void* d_out, int out_size, void* d_ws, size_t ws_size, hipStream_t stream) {
    const float* x = (const float*)d_in[0];      const float* w_in = (const float*)d_in[1];   const float* rel_bias = (const float*)d_in[2];
    const float* gain_a = (const float*)d_in[3]; const float* gain_b = (const float*)d_in[4]; const float* w_out = (const float*)d_in[5];
    const float* ln1_g = (const float*)d_in[6];  const float* ln1_b = (const float*)d_in[7];  const float* router_w = (const float*)d_in[8];
    const float* router_bias = (const float*)d_in[9]; const float* w_gate = (const float*)d_in[10]; const float* w_up = (const float*)d_in[11];
    const float* w_down = (const float*)d_in[12]; const float* ws_gate = (const float*)d_in[13]; const float* ws_up = (const float*)d_in[14];
    const float* ws_down = (const float*)d_in[15]; const float* ln2_g = (const float*)d_in[16]; const float* ln2_b = (const float*)d_in[17];
    char* ws = (char*)d_ws; float* out = (float*)d_out;
    int* ctrl = (int*)(ws + OFF_CTRL); int* counts = ctrl + CW_COUNTS;
    bf16_t* X1 = (bf16_t*)(ws + OFF_X1); int* tokl = (int*)(ws + OFF_TOKL); float* gatel = (float*)(ws + OFF_GATEL);
    int* eidx = (int*)(ws + OFF_EIDX); float* gate = (float*)(ws + OFF_GATE); int* slot = (int*)(ws + OFF_SLOT);
    unsigned char* H = (unsigned char*)(ws + OFF_H); unsigned char* Y = (unsigned char*)(ws + OFF_Y); unsigned char* x1f8 = (unsigned char*)(ws + OFF_X1F8);
    bf16_t* Q = (bf16_t*)(ws + OFF_Q); bf16_t* Kb = (bf16_t*)(ws + OFF_K); bf16_t* Vt = (bf16_t*)(ws + OFF_VT);
    bf16_t* yatt = (bf16_t*)(ws + OFF_YATT); bf16_t* r = (bf16_t*)(ws + OFF_R);
    bf16_t* xb = (bf16_t*)(ws + OFF_XB); float* stats = (float*)(ws + OFF_STATS);
    bf16_t* wt_in = (bf16_t*)(ws + OFF_WTIN); bf16_t* wt_out = (bf16_t*)(ws + OFF_WTOUT); bf16_t* wt_r = (bf16_t*)(ws + OFF_WTR);
    unsigned char* wgut = (unsigned char*)(ws + OFF_WGUT); unsigned char* wdt = (unsigned char*)(ws + OFF_WDT);
    if (ws_size < WS_NEEDED) { fprintf(stderr, "kernel_launch: workspace too small (%zu < %zu)\n", ws_size, (size_t)WS_NEEDED); return; }
    hipMemsetAsync(ctrl, 0, 128 * 1024, stream);
    static bool attr_done = false;
    if (!attr_done) {
        hipFuncSetAttribute((const void*)k_mega, hipFuncAttributeMaxDynamicSharedMemorySize, LDS_BYTES);
        attr_done = true;
    }
    MegaArgs m{};
    m.p0 = P0Args{x, w_in, w_out, router_w, xb, wt_in, wt_out, wt_r, w_gate, w_up, w_down, ws_gate, ws_up, ws_down, wgut, wdt};
    m.p1 = P1Args{xb, wt_in, Q, Kb, Vt};
    m.p2 = P2Args{Q, Kb, Vt, rel_bias, gain_a, gain_b, yatt};
    m.p3 = P3Args{yatt, wt_out, xb, r, stats};
    m.p4 = P4Args{r, stats, ln1_g, ln1_b, X1, x1f8, wt_r, router_bias, eidx, gate, counts, tokl, gatel, slot};
    m.p6 = P6Args{x1f8, counts, tokl, gatel, wgut, H};
    m.p7 = P7Args{H, counts, wdt, Y};
    m.p8 = P8Args{X1, Y, slot, counts, ln2_g, ln2_b, out};
    m.bar = (unsigned*)ctrl;
    k_mega<<<GRID, NTHR, LDS_BYTES, stream>>>(m);
}
```

```cpp
#include <hip/hip_runtime.h>
#include <cstdint>
#include <cstdio>

typedef unsigned short bf16_t;

constexpr int D_MODEL = 1024, BATCH = 16, SEQ = 2048, T_TOK = BATCH * SEQ;
constexpr int HEAD_DIM = 64, NHA = 8, NHB = 8, NHH = 16;
constexpr int CHUNK = 64, LEFT_CHUNKS = 8, MAX_REL = 128;
constexpr int N_EXP = 256, TOP_K = 8, N_GROUPS = 8, TOPK_GROUPS = 4, EPG = 32, D_EXP = 256;
constexpr float ROUTED_SCALE = 2.5f, LN_EPS = 1e-5f, RMS_EPS = 1e-6f;
constexpr float DN_ALPHA = 1.189207115002721f;
constexpr float LOG2E = 1.4426950408889634f, LN2 = 0.6931471805599453f;
constexpr float QSCALE = 0.125f * LOG2E;
constexpr float WSCALE = 64.f, XSCALE = 16.f, HSCALE = 16.f;
constexpr float YSCALE = 64.f;
constexpr int CAP = T_TOK;
constexpr int ROWS_ALL = T_TOK * TOP_K + T_TOK;

__device__ __forceinline__ float bf2f(bf16_t v) { return __uint_as_float(((unsigned)v) << 16); }
__device__ __forceinline__ bf16_t f2bf(float f) { unsigned u = __float_as_uint(f); u += 0x7fffu + ((u >> 16) & 1u); return (bf16_t)(u >> 16); }

constexpr size_t MB = 1024ull * 1024ull;
constexpr size_t OFF_CTRL   = 0;
constexpr size_t OFF_X1     = 1 * MB;
constexpr size_t OFF_TOKL   = OFF_X1 + 64 * MB;
constexpr size_t OFF_GATEL  = OFF_TOKL + 32 * MB;
constexpr size_t OFF_EIDX   = OFF_GATEL + 32 * MB;
constexpr size_t OFF_GATE   = OFF_EIDX + 1 * MB;
constexpr size_t OFF_SLOT   = OFF_GATE + 1 * MB;
constexpr size_t OFF_WDT    = OFF_SLOT + 1 * MB;
constexpr size_t OFF_X1F8   = OFF_WDT + 72 * MB;
constexpr size_t OFF_BIG    = OFF_WDT + 129 * MB;
constexpr size_t OFF_H      = OFF_BIG;
constexpr size_t OFF_Y      = OFF_BIG + 144 * MB;
constexpr size_t OFF_Q      = OFF_BIG;
constexpr size_t OFF_K      = OFF_BIG + 64 * MB;
constexpr size_t OFF_VT     = OFF_BIG + 128 * MB;
constexpr size_t OFF_YATT   = OFF_BIG + 192 * MB;
constexpr size_t OFF_R      = OFF_BIG + 256 * MB;
constexpr size_t OFF_XB     = OFF_BIG + 320 * MB;
constexpr size_t OFF_STATS  = OFF_BIG + 384 * MB;
constexpr size_t OFF_WTIN   = OFF_BIG + 392 * MB;
constexpr size_t OFF_WTOUT  = OFF_BIG + 398 * MB;
constexpr size_t OFF_WTR    = OFF_BIG + 400 * MB;
constexpr size_t OFF_WGUT   = OFF_BIG + 401 * MB;
constexpr size_t WS_NEEDED  = OFF_BIG + 720 * MB;
static_assert(OFF_WGUT + 257 * MB <= WS_NEEDED && WS_NEEDED <= 1024 * MB, "workspace map");
constexpr int CW_COUNTS = 8192;
constexpr int CSTR = 64;

typedef short bf16x8 __attribute__((ext_vector_type(8)));
typedef float f32x4 __attribute__((ext_vector_type(4)));
typedef float f32x2 __attribute__((ext_vector_type(2)));
typedef float f32x16 __attribute__((ext_vector_type(16)));
typedef unsigned u32x4 __attribute__((ext_vector_type(4)));
typedef unsigned u32x2 __attribute__((ext_vector_type(2)));
#define DI __device__ __forceinline__
constexpr int NTHR = 512, GRID = 256;
DI int tidx() { int t = threadIdx.x; asm volatile("" : "+v"(t)); return t; }
constexpr int LDS_BYTES = 160 * 1024;

typedef __bf16 bf16x2_t __attribute__((ext_vector_type(2)));
DI unsigned cvt_pk_bf16(float lo, float hi) { f32x2 v = {lo, hi}; bf16x2_t r = __builtin_convertvector(v, bf16x2_t); return __builtin_bit_cast(unsigned, r); }
DI unsigned pack_fp8x4(float a, float b, float c, float d) { int w = 0; w = __builtin_amdgcn_cvt_pk_fp8_f32(a, b, w, false); w = __builtin_amdgcn_cvt_pk_fp8_f32(c, d, w, true); return (unsigned)w; }
DI int vblock() { return (int)((blockIdx.x & 7) * (GRID / 8) + (blockIdx.x >> 3)); }

template <int MT> struct Tile { static constexpr int BM = 32 * MT, A_BYTES = BM * 128, B_BYTES = 256 * 128, STAGE = A_BYTES + B_BYTES; };

template <int MT> struct ALoader {
    const bf16_t* p[MT / 2]; u32x4 v[MT / 2]; int off0;
    DI void init_rows(const bf16_t* A, int lda, int row0) {
        const int tid = tidx(), kc = tid & 7, r = tid >> 3;
#pragma unroll
        for (int i = 0; i < MT / 2; ++i) p[i] = A + (size_t)(row0 + r + 64 * i) * lda + kc * 8;
        off0 = r * 128 + ((kc ^ ((r >> 1) & 7)) << 4);
    }
    DI void init_gather(const bf16_t* A, int lda, const int* rows, int cnt, int m0) {
        const int tid = tidx(), kc = tid & 7, r = tid >> 3;
#pragma unroll
        for (int i = 0; i < MT / 2; ++i) { int rr = m0 + r + 64 * i; rr = rr < cnt ? rr : cnt - 1; const int g = rows ? rows[rr] : rr; p[i] = A + (size_t)g * lda + kc * 8; }
        off0 = r * 128 + ((kc ^ ((r >> 1) & 7)) << 4);
    }
    DI void load(int k0) {
#pragma unroll
        for (int i = 0; i < MT / 2; ++i) v[i] = *(const u32x4*)(p[i] + k0);
    }
    DI void store(char* ldsA) const {
#pragma unroll
        for (int i = 0; i < MT / 2; ++i) *(u32x4*)(ldsA + off0 + i * 8192) = v[i];
    }
};
struct BLoaderBt {
    const bf16_t* p[4]; u32x4 v[4]; int off0;
    DI void init(const bf16_t* Bt, int ldk, int n0) {
        const int tid = tidx(), kc = tid & 7, r = tid >> 3;
#pragma unroll
        for (int i = 0; i < 4; ++i) p[i] = Bt + (size_t)(n0 + r + 64 * i) * ldk + kc * 8;
        off0 = r * 128 + ((kc ^ ((r >> 1) & 7)) << 4);
    }
    DI void load(int k0) {
#pragma unroll
        for (int i = 0; i < 4; ++i) v[i] = *(const u32x4*)(p[i] + k0);
    }
    DI void store(char* ldsB) const {
#pragma unroll
        for (int i = 0; i < 4; ++i) *(u32x4*)(ldsB + off0 + i * 8192) = v[i];
    }
};
template <int MT, bool TR, class AL, class BL>
DI void gemm_tile(char* lds, AL& al, BL& bl, int nk, f32x4 (&acc)[MT][4]) {
    typedef Tile<MT> TT;
    const int tid = tidx(), wid = tid >> 6, lane = tid & 63, wr = wid >> 2, wc = wid & 3, fr = lane & 15, fq = lane >> 4;
#pragma unroll
    for (int m = 0; m < MT; ++m)
#pragma unroll
        for (int n = 0; n < 4; ++n) acc[m][n] = (f32x4){0.f, 0.f, 0.f, 0.f};
    int aoff[2], boff[2];
#pragma unroll
    for (int ks = 0; ks < 2; ++ks) { const int ch = (((4 * ks + fq) ^ (fr >> 1)) << 4); aoff[ks] = (16 * MT * wr + fr) * 128 + ch; boff[ks] = TT::A_BYTES + (64 * wc + fr) * 128 + ch; }
    al.load(0); bl.load(0);
    __syncthreads();
    al.store(lds); bl.store(lds + TT::A_BYTES);
    __syncthreads();
    for (int kt = 0; kt < nk; ++kt) {
        char* cur = lds + (kt & 1) * TT::STAGE; char* nxt = lds + ((kt & 1) ^ 1) * TT::STAGE;
        const bool more = kt + 1 < nk;
        if (more) { al.load((kt + 1) * 64); bl.load((kt + 1) * 64); }
#pragma unroll
        for (int ks = 0; ks < 2; ++ks) {
            bf16x8 a[MT], b[4];
#pragma unroll
            for (int m = 0; m < MT; ++m) a[m] = *(const bf16x8*)(cur + aoff[ks] + m * 2048);
#pragma unroll
            for (int n = 0; n < 4; ++n) b[n] = *(const bf16x8*)(cur + boff[ks] + n * 2048);
#pragma unroll
            for (int m = 0; m < MT; ++m)
#pragma unroll
                for (int n = 0; n < 4; ++n)
                    acc[m][n] = TR ? __builtin_amdgcn_mfma_f32_16x16x32_bf16(b[n], a[m], acc[m][n], 0, 0, 0) : __builtin_amdgcn_mfma_f32_16x16x32_bf16(a[m], b[n], acc[m][n], 0, 0, 0);
        }
        if (more) { al.store(nxt); bl.store(nxt + TT::A_BYTES); }
        __syncthreads();
    }
}

#define LAS __attribute__((address_space(3)))
namespace gs {
constexpr int BM = 256, BK = 64, HALF = 128, HTB = HALF * BK * 2, STAGE_BYTES = 8 * HTB;
DI int lds_byte(int r, int c) { const int st = (r >> 4) * 2 + (c >> 5), rr = r & 15, cc = c & 31, ob = rr * 64 + cc * 2; return st * 1024 + (ob ^ (((ob >> 9) & 1) << 5)); }
DI void stage_rc(int b, int& R, int& C) { const int st = b / 1024, sb = b % 1024, swz = sb ^ (((sb >> 9) & 1) << 5); R = (st >> 1) * 16 + swz / 64; C = (st & 1) * 32 + (swz % 64) / 2; }
DI int perm32(int rho) { const int n = rho >> 4, i = rho & 15; return 8 * (i >> 2) + 4 * n + (i & 3); }
typedef long i64x2 __attribute__((ext_vector_type(2)));
DI const char* uni(const char* p) { const unsigned long long v = (unsigned long long)p; const unsigned lo = __builtin_amdgcn_readfirstlane((unsigned)v), hi = __builtin_amdgcn_readfirstlane((unsigned)(v >> 32)); return (const char*)(((unsigned long long)hi << 32) | lo); }
template <bool TR, bool F8>
DI f32x4 mma16(const bf16x8& a, const bf16x8& b, f32x4 c) {
    if (F8) {
        const i64x2 a2 = __builtin_bit_cast(i64x2, a), b2 = __builtin_bit_cast(i64x2, b);
        c = TR ? __builtin_amdgcn_mfma_f32_16x16x32_fp8_fp8(b2[0], a2[0], c, 0, 0, 0) : __builtin_amdgcn_mfma_f32_16x16x32_fp8_fp8(a2[0], b2[0], c, 0, 0, 0);
        return TR ? __builtin_amdgcn_mfma_f32_16x16x32_fp8_fp8(b2[1], a2[1], c, 0, 0, 0) : __builtin_amdgcn_mfma_f32_16x16x32_fp8_fp8(a2[1], b2[1], c, 0, 0, 0);
    }
    return TR ? __builtin_amdgcn_mfma_f32_16x16x32_bf16(b, a, c, 0, 0, 0) : __builtin_amdgcn_mfma_f32_16x16x32_bf16(a, b, c, 0, 0, 0);
}
typedef int i32x8 __attribute__((ext_vector_type(8)));
typedef short bf16x16 __attribute__((ext_vector_type(16)));
template <bool TR, int SC>
DI f32x4 mma128(const bf16x16& a, const bf16x16& b, f32x4 c) {
    const i32x8 av = __builtin_bit_cast(i32x8, a), bv = __builtin_bit_cast(i32x8, b);
    const int one = SC;
    if (TR) asm volatile("v_mfma_scale_f32_16x16x128_f8f6f4 %0, %1, %2, %0, %3, %3 op_sel_hi:[0,0,0]" : "+v"(c) : "v"(bv), "v"(av), "v"(one));
    else    asm volatile("v_mfma_scale_f32_16x16x128_f8f6f4 %0, %1, %2, %0, %3, %3 op_sel_hi:[0,0,0]" : "+v"(c) : "v"(av), "v"(bv), "v"(one));
    return c;
}
DI bf16x8 frag_lo(const bf16x16& v) { return __builtin_shufflevector(v, v, 0, 1, 2, 3, 4, 5, 6, 7); }
DI bf16x8 frag_hi(const bf16x16& v) { return __builtin_shufflevector(v, v, 8, 9, 10, 11, 12, 13, 14, 15); }
template <bool TR, bool PERM, int F8, class Sched, class Epi>
DI void gemm_stream(LAS unsigned char* lds, const int K, const Sched& S, const Epi& E) {
    typedef typename Sched::U U;
    const int tid = tidx(), wid = __builtin_amdgcn_readfirstlane(tid >> 6), lane = tid & 63, wr = wid >> 2, wc = wid & 3, fr = lane & 15, fq = lane >> 4;
    const int nt = K / BK;
    int R[2], C[2]; unsigned voffB[2];
#pragma unroll
    for (int i = 0; i < 2; ++i) { stage_rc(tid * 16 + i * 8192, R[i], C[i]); const int Rb = PERM ? ((R[i] & ~31) + perm32(R[i] & 31)) : R[i]; voffB[i] = (unsigned)(Rb * K + C[i]) * 2u; }
    const size_t kstep = (size_t)(BK * 2), hstepB = (size_t)HALF * K * 2;
    const unsigned ldsw = (unsigned)wid * 1024u;
    const int aoff = lds_byte(wr * 64 + fr, fq * 8), boff = lds_byte(wc * 32 + fr, fq * 8);
#define GS_SA(b, h) (((b) * 2 + (h)) * HTB)
#define GS_SB(b, h) ((4 + (b) * 2 + (h)) * HTB)
#define GS_STAGE(bufoff, gbase, uix, h) do { _Pragma("unroll") for (int _i = 0; _i < 2; ++_i) \
        __builtin_amdgcn_global_load_lds((const unsigned*)((const char*)(gbase) + S.a_voff(uix, h, R[_i], C[_i])), (LAS unsigned*)(lds + (bufoff) + ldsw + _i * 8192), 16, 0, 0); } while (0)
#define GS_STAGEB(bufoff, gbase, voff) do { _Pragma("unroll") for (int _i = 0; _i < 2; ++_i) \
        __builtin_amdgcn_global_load_lds((const unsigned*)((const char*)(gbase) + (voff)[_i]), (LAS unsigned*)(lds + (bufoff) + ldsw + _i * 8192), 16, 0, 0); } while (0)
#define GS_LD32(base) __builtin_shufflevector(*(const LAS bf16x8*)(base), *(const LAS bf16x8*)((base) + 1024), 0, 1, 2, 3, 4, 5, 6, 7, 8, 9, 10, 11, 12, 13, 14, 15)
#define GS_LDA(dst, b, h) do { _Pragma("unroll") for (int m = 0; m < 4; ++m) dst[m] = GS_LD32(lds + GS_SA(b, h) + aoff + m * 2048); } while (0)
#define GS_LDB(dst, b, h) do { _Pragma("unroll") for (int n = 0; n < 2; ++n) dst[n] = GS_LD32(lds + GS_SB(b, h) + boff + n * 2048); } while (0)
#define GS_MMA(ai, bj, At, Bt) do { __builtin_amdgcn_s_setprio(1); _Pragma("unroll") for (int m = 0; m < 4; ++m) _Pragma("unroll") for (int n = 0; n < 2; ++n) { \
        if (F8 == 2) acc[ai][bj][m][n] = mma128<TR, Epi::MXS>(At[m], Bt[n], acc[ai][bj][m][n]); \
        else { acc[ai][bj][m][n] = mma16<TR, F8 == 1>(frag_lo(At[m]), frag_lo(Bt[n]), acc[ai][bj][m][n]); acc[ai][bj][m][n] = mma16<TR, F8 == 1>(frag_hi(At[m]), frag_hi(Bt[n]), acc[ai][bj][m][n]); } } \
        __builtin_amdgcn_s_setprio(0); } while (0)
#define GS_WAIT_V(n) asm volatile("s_waitcnt vmcnt(" #n ")" ::: "memory")
#define GS_WAIT_L(n) asm volatile("s_waitcnt lgkmcnt(" #n ")" ::: "memory")
#define GS_BAR __builtin_amdgcn_s_barrier()
#define GS_SCHED __builtin_amdgcn_sched_barrier(0)
    U cur, nxt; int ui = 0;
    if (!S.next(0, cur)) return;
    f32x4 acc[2][2][4][2];
#pragma unroll
    for (int a = 0; a < 2; ++a)
#pragma unroll
        for (int b = 0; b < 2; ++b)
#pragma unroll
            for (int m = 0; m < 4; ++m)
#pragma unroll
                for (int n = 0; n < 2; ++n) acc[a][b][m][n] = (f32x4){0.f, 0.f, 0.f, 0.f};
    bf16x16 At[4], B0[2], B1[2];
    const char* cA = uni(cur.A); const char* cB = uni(cur.B);
    GS_STAGEB(GS_SB(0, 0), cB, voffB); GS_STAGEB(GS_SB(0, 1), cB + hstepB, voffB); GS_STAGE(GS_SA(0, 0), cA, 0, 0); GS_STAGE(GS_SA(0, 1), cA, 0, 1);
    if (wr == 1) GS_BAR;
    GS_WAIT_V(2); GS_BAR;
    GS_STAGEB(GS_SB(1, 0), cB + kstep, voffB); GS_STAGE(GS_SA(1, 0), cA + kstep, 0, 0); GS_STAGEB(GS_SB(1, 1), cB + hstepB + kstep, voffB);
    GS_WAIT_V(6); GS_BAR;
    for (;;) {
        const bool has_next = S.next(ui + 1, nxt);
        const int nui = has_next ? ui + 1 : ui;
        const char* nA = uni(has_next ? nxt.A : cA); const char* nB = uni(has_next ? nxt.B : cB);
#pragma unroll 1
        for (int t = 0; t < nt; t += 2) {
            const bool last = (t == nt - 2);
            const char* a1 = uni(cA + (size_t)(t + 1) * kstep);
            const char* a2 = uni(last ? nA : cA + (size_t)(t + 2) * kstep); const char* b2 = uni(last ? nB : cB + (size_t)(t + 2) * kstep);
            const char* a3 = uni(a2 + kstep); const char* b3 = uni(b2 + kstep);
            const int u2 = last ? nui : ui;
            GS_LDB(B0, 0, 0); GS_LDB(B1, 0, 1); GS_SCHED; GS_LDA(At, 0, 0); GS_STAGE(GS_SA(1, 1), a1, ui, 1);
            GS_WAIT_V(8); GS_WAIT_L(0); GS_BAR; GS_MMA(0, 0, At, B0); GS_MMA(0, 1, At, B1); GS_BAR; GS_SCHED;
            GS_LDA(At, 0, 1); GS_STAGEB(GS_SB(0, 0), b2, voffB); GS_STAGEB(GS_SB(0, 1), b2 + hstepB, voffB); GS_STAGE(GS_SA(0, 0), a2, u2, 0);
            GS_WAIT_V(8); GS_WAIT_L(0); GS_BAR; GS_MMA(1, 0, At, B0); GS_MMA(1, 1, At, B1); GS_BAR; GS_SCHED;
            GS_LDB(B0, 1, 0); GS_LDB(B1, 1, 1); GS_SCHED; GS_LDA(At, 1, 0); GS_STAGE(GS_SA(0, 1), a2, u2, 1);
            GS_WAIT_V(8); GS_WAIT_L(0); GS_BAR; GS_MMA(0, 0, At, B0); GS_MMA(0, 1, At, B1); GS_BAR; GS_SCHED;
            GS_LDA(At, 1, 1); GS_STAGEB(GS_SB(1, 0), b3, voffB); GS_STAGEB(GS_SB(1, 1), b3 + hstepB, voffB); GS_STAGE(GS_SA(1, 0), a3, u2, 0);
            GS_WAIT_V(8); GS_WAIT_L(0); GS_BAR; GS_MMA(1, 0, At, B0); GS_MMA(1, 1, At, B1); GS_BAR; GS_SCHED;
        }
        if (wr == 0) GS_BAR;
        if (F8 == 2) asm volatile("s_nop 15\n\ts_nop 15\n\ts_nop 15\n\ts_nop 15\n\ts_nop 15\n\ts_nop 15" ::: "memory");
        E(acc, cur, wr, wc, fr, fq);
        if (!has_next) break;
#pragma unroll
        for (int a = 0; a < 2; ++a)
#pragma unroll
            for (int b = 0; b < 2; ++b)
#pragma unroll
                for (int m = 0; m < 4; ++m)
#pragma unroll
                    for (int n = 0; n < 2; ++n) acc[a][b][m][n] = (f32x4){0.f, 0.f, 0.f, 0.f};
        cur = nxt; cA = nA; cB = nB; ++ui;
        if (wr == 1) GS_BAR;
    }
    GS_WAIT_V(0);
    GS_BAR;
#undef GS_SA
#undef GS_SB
#undef GS_STAGE
#undef GS_STAGEB
#undef GS_LDA
#undef GS_LD32
#undef GS_LDB
#undef GS_MMA
#undef GS_WAIT_V
#undef GS_WAIT_L
#undef GS_BAR
#undef GS_SCHED
}
struct DenseU { const char* A; const char* B; int pm, pn; };
struct DenseSched {
    typedef DenseU U;
    const bf16_t* A; const bf16_t* Bt; int K, nunits, first, stride, npn, pn_base, pn_mod0, pn_mod1;
    DI int colmap(int q) const { return pn_base + (q / pn_mod0) * pn_mod1 + (q % pn_mod0); }
    DI bool next(int i, U& u) const {
        const int L = first + i * stride; if (L >= nunits) return false;
        u.pm = L / npn; u.pn = colmap(L % npn);
        u.A = (const char*)A + (size_t)u.pm * BM * K * 2; u.B = (const char*)Bt + (size_t)u.pn * BM * K * 2; return true;
    }
    DI unsigned a_voff(int, int h, int R, int C) const { return (unsigned)((HALF * h + R) * K + C) * 2u; }
};
}

DI void transpose_cvt(const float* W, bf16_t* Wt, int K, int N, int unit, char* lds) {
    float* tile = (float*)lds;
    const int nbn = N / 64, kb = unit / nbn, nb = unit % nbn, tid = tidx();
    __syncthreads();
#pragma unroll
    for (int i = 0; i < 8; ++i) { const int idx = tid + i * 512, r = idx >> 6, c = idx & 63; tile[r * 65 + c] = W[(size_t)(kb * 64 + r) * N + nb * 64 + c]; }
    __syncthreads();
#pragma unroll
    for (int i = 0; i < 8; ++i) { const int idx = tid + i * 512, n = idx >> 6, k = idx & 63; Wt[(size_t)(nb * 64 + n) * K + kb * 64 + k] = f2bf(tile[k * 65 + n]); }
}
struct P0Args { const float* x; const float* w_in; const float* w_out; const float* router_w; bf16_t* xb; bf16_t* wt_in; bf16_t* wt_out; bf16_t* wt_r;
                const float* w_gate; const float* w_up; const float* w_down; const float* ws_gate; const float* ws_up; const float* ws_down; unsigned char* wgut; unsigned char* wdt; };
constexpr int CV_GU = 257 * 2 * 16, CV_DN = 257 * 16;
struct CvItem { const float* src; unsigned char* dst; int ld, ldd, rbase, rhi; };
DI CvItem cv_item(const P0Args& a, int it) {
    CvItem c;
    if (it < CV_GU) {
        const int e = it / 32, u = (it >> 4) & 1, kt = it & 15;
        const float* W = e < N_EXP ? (u ? a.w_up : a.w_gate) + (size_t)e * D_MODEL * D_EXP : (u ? a.ws_up : a.ws_gate);
        c.src = W + (size_t)kt * 64 * D_EXP; c.ld = D_EXP; c.dst = a.wgut + (size_t)e * 512 * D_MODEL + kt * 64; c.ldd = D_MODEL; c.rbase = 128 * u; c.rhi = 256;
    } else {
        const int j = it - CV_GU, e = j / 16, kt = (j >> 2) & 3, nb = j & 3;
        const float* W = e < N_EXP ? a.w_down + (size_t)e * D_EXP * D_MODEL : a.ws_down;
        c.src = W + (size_t)kt * 64 * D_MODEL + nb * 256; c.ld = D_MODEL; c.dst = a.wdt + (size_t)e * D_MODEL * D_EXP + kt * 64; c.ldd = D_EXP; c.rbase = 256 * nb; c.rhi = 128;
    }
    return c;
}
constexpr int CV_TILE_BYTES = 64 * 260 * 4;
DI void cv_dma_nt(const char* sbase, unsigned voff, unsigned lds_dst) {
    unsigned keep;
    asm volatile("s_mov_b32 %0, m0\n\ts_mov_b32 m0, %3\n\ts_nop 0\n\tglobal_load_lds_dwordx4 %1, %2 nt\n\ts_mov_b32 m0, %0" : "=&s"(keep) : "v"(voff), "s"(sbase), "s"(lds_dst) : "memory");
}
DI const char* uni64(const void* p) { const unsigned long long v = (unsigned long long)p; const unsigned lo = __builtin_amdgcn_readfirstlane((unsigned)v), hi = __builtin_amdgcn_readfirstlane((unsigned)(v >> 32)); return (const char*)(((unsigned long long)hi << 32) | lo); }
DI void cv_issue(const CvItem& c, LAS unsigned char* tile) {
    const int tid = tidx(), w = __builtin_amdgcn_readfirstlane(tid >> 6), l = tid & 63;
    const char* sb = uni64(c.src); const unsigned tb = (unsigned)__builtin_amdgcn_readfirstlane((unsigned)(size_t)tile);
#pragma unroll
    for (int i = 0; i < 8; ++i) { const int k = 8 * w + i; cv_dma_nt(sb, (unsigned)(k * c.ld + 4 * (l ^ w)) * 4u, tb + (unsigned)(k * 1040)); }
}
DI void lds_barrier() { asm volatile("s_waitcnt lgkmcnt(0)" ::: "memory"); __builtin_amdgcn_s_barrier(); asm volatile("" ::: "memory"); }
DI void cv_emit(const CvItem& c, const char* lds) {
    const float* tile = (const float*)lds;
    const int tid = tidx();
#pragma unroll
    for (int i = 0; i < 4; ++i) {
        const int idx = tid + i * 512, kc = idx & 7, n = idx >> 3; const float* p = tile + (8 * kc) * 260 + (n ^ (4 * kc));
        const unsigned w0 = pack_fp8x4(p[0] * WSCALE, p[260] * WSCALE, p[2 * 260] * WSCALE, p[3 * 260] * WSCALE), w1 = pack_fp8x4(p[4 * 260] * WSCALE, p[5 * 260] * WSCALE, p[6 * 260] * WSCALE, p[7 * 260] * WSCALE);
        __builtin_nontemporal_store((u32x2){w0, w1}, (u32x2*)(c.dst + (size_t)(c.rbase + (n >> 7) * c.rhi + (n & 127)) * c.ldd + 8 * kc));
    }
}
DI void convert_moe_range(const P0Args& a, char* lds, const int lo, const int hi) {
    int it = lo + vblock(); if (it >= hi) return;
    __syncthreads();
    LAS unsigned char* t0 = (LAS unsigned char*)lds; LAS unsigned char* t1 = t0 + CV_TILE_BYTES;
    CvItem c = cv_item(a, it); cv_issue(c, t0);
    int pp = 0;
#pragma unroll 1
    for (;;) {
        const int nit = it + GRID; const bool more = nit < hi;
        CvItem cn = c;
        if (more) { cn = cv_item(a, nit); cv_issue(cn, pp ? t0 : t1); }
        if (more) asm volatile("s_waitcnt vmcnt(8)" ::: "memory"); else asm volatile("s_waitcnt vmcnt(0)" ::: "memory");
        lds_barrier();
        cv_emit(c, lds + (pp ? CV_TILE_BYTES : 0));
        lds_barrier();
        if (!more) break;
        it = nit; c = cn; pp ^= 1;
    }
    asm volatile("s_waitcnt vmcnt(0)" ::: "memory");
    __syncthreads();
}
DI void phase_prologue(const P0Args& a, char* lds) {
    const int vb = vblock();
    for (size_t i = (size_t)vb * NTHR + tidx(); i < (size_t)T_TOK * D_MODEL / 8; i += (size_t)GRID * NTHR) {
        const f32x4 v0 = *(const f32x4*)(a.x + i * 8), v1 = *(const f32x4*)(a.x + i * 8 + 4);
        u32x4 o; o.x = cvt_pk_bf16(v0[0], v0[1]); o.y = cvt_pk_bf16(v0[2], v0[3]); o.z = cvt_pk_bf16(v1[0], v1[1]); o.w = cvt_pk_bf16(v1[2], v1[3]);
        *(u32x4*)(a.xb + i * 8) = o;
    }
    const int n_in = (1024 / 64) * (3072 / 64), n_out = 16 * 16, n_r = 16 * 4;
    for (int u = vb; u < n_in + n_out + n_r; u += GRID) {
        if (u < n_in) transpose_cvt(a.w_in, a.wt_in, 1024, 3072, u, lds);
        else if (u < n_in + n_out) transpose_cvt(a.w_out, a.wt_out, 1024, 1024, u - n_in, lds);
        else transpose_cvt(a.router_w, a.wt_r, 1024, 256, u - n_in - n_out, lds);
    }
}


struct P1Args { const bf16_t* xb; const bf16_t* wt_in; bf16_t* Q; bf16_t* Kb; bf16_t* Vt; };
struct EpiQK { bf16_t* Q; bf16_t* Kb; static constexpr int MXS = 0x7F7F7F7F;
    DI void operator()(const f32x4 (&acc)[2][2][4][2], const gs::DenseU& u, int wr, int wc, int fr, int fq) const {
        const int seg = u.pn >> 1, type = seg % 3, grp = seg / 3; bf16_t* dst = type == 0 ? Q : Kb; const float sc = type == 0 ? QSCALE : 1.f;
#pragma unroll
        for (int ai = 0; ai < 2; ++ai)
#pragma unroll
            for (int m = 0; m < 4; ++m) {
                const int row = u.pm * 256 + 128 * ai + 64 * wr + 16 * m + fr, b = row / SEQ, s = row % SEQ;
#pragma unroll
                for (int bj = 0; bj < 2; ++bj) {
                    const int hh = grp * 8 + 4 * (u.pn & 1) + 2 * bj + (wc >> 1), d0 = 32 * (wc & 1) + 8 * fq;
                    const f32x4 v0 = acc[ai][bj][m][0] * sc, v1 = acc[ai][bj][m][1] * sc;
                    u32x4 o; o.x = cvt_pk_bf16(v0[0], v0[1]); o.y = cvt_pk_bf16(v0[2], v0[3]); o.z = cvt_pk_bf16(v1[0], v1[1]); o.w = cvt_pk_bf16(v1[2], v1[3]);
                    *(u32x4*)(dst + (size_t)(b * NHH + hh) * SEQ * 64 + (s >> 5) * 2048 + ((d0 >> 3) * 32 + (s & 31)) * 8) = o;
                }
            }
    } };
struct EpiV { bf16_t* Vt; static constexpr int MXS = 0x7F7F7F7F;
    DI void operator()(const f32x4 (&acc)[2][2][4][2], const gs::DenseU& u, int wr, int wc, int fr, int fq) const {
        const int grp = (u.pn >> 1) / 3;
#pragma unroll
        for (int ai = 0; ai < 2; ++ai)
#pragma unroll
            for (int m = 0; m < 4; ++m) {
                const int row = u.pm * 256 + 128 * ai + 64 * wr + 16 * m + 4 * fq, b = row / SEQ, s = row % SEQ;
#pragma unroll
                for (int bj = 0; bj < 2; ++bj)
#pragma unroll
                    for (int n = 0; n < 2; ++n) {
                        const int hh = grp * 8 + 4 * (u.pn & 1) + 2 * bj + (wc >> 1), d = 32 * (wc & 1) + 16 * n + fr;
                        const f32x4 v = acc[ai][bj][m][n];
                        u32x2 o; o.x = cvt_pk_bf16(v[0], v[1]); o.y = cvt_pk_bf16(v[2], v[3]);
                        { const int kap = s & 31; *(u32x2*)(Vt + (size_t)(b * NHH + hh) * SEQ * 64 + (s >> 5) * 2048 + ((((d >> 5) * 2 + (kap >> 4)) * 2 + ((kap >> 2) & 1)) * 32 + (d & 31)) * 8 + ((kap >> 3) & 1) * 4) = o; }
                    }
            }
    } };
DI void phase_qkv(const P1Args& a, LAS unsigned char* lds) {
    { gs::DenseSched S{a.xb, a.wt_in, D_MODEL, (T_TOK / 256) * 8, vblock(), GRID, 8, 0, 4, 6}; EpiQK E{a.Q, a.Kb}; gs::gemm_stream<true, true, 0>(lds, D_MODEL, S, E); }
    { gs::DenseSched S{a.xb, a.wt_in, D_MODEL, (T_TOK / 256) * 4, vblock(), GRID, 4, 4, 2, 6}; EpiV E{a.Vt}; gs::gemm_stream<false, false, 0>(lds, D_MODEL, S, E); }
}

struct P3Args { const bf16_t* y; const bf16_t* wt_out; const bf16_t* xb; bf16_t* r; float* stats; };
struct EpiOut { const bf16_t* xb; bf16_t* r; float* stats; static constexpr int MXS = 0x7F7F7F7F;
    DI void operator()(const f32x4 (&acc)[2][2][4][2], const gs::DenseU& u, int wr, int wc, int fr, int fq) const {
#pragma unroll
        for (int ai = 0; ai < 2; ++ai) {
            u32x4 xw[4][2];
#pragma unroll
            for (int m = 0; m < 4; ++m)
#pragma unroll
                for (int bj = 0; bj < 2; ++bj) xw[m][bj] = *(const u32x4*)(xb + (size_t)(u.pm * 256 + 128 * ai + 64 * wr + 16 * m + fr) * D_MODEL + u.pn * 256 + 128 * bj + 32 * wc + 8 * fq);
#pragma unroll
            for (int m = 0; m < 4; ++m) {
                const int row = u.pm * 256 + 128 * ai + 64 * wr + 16 * m + fr;
#pragma unroll
                for (int bj = 0; bj < 2; ++bj) {
                    const int col = u.pn * 256 + 128 * bj + 32 * wc + 8 * fq;
                    const u32x4 w = xw[m][bj];
                    const f32x4 x0 = (f32x4){__uint_as_float(w[0] << 16), __uint_as_float(w[0] & 0xffff0000u), __uint_as_float(w[1] << 16), __uint_as_float(w[1] & 0xffff0000u)};
                    const f32x4 x1 = (f32x4){__uint_as_float(w[2] << 16), __uint_as_float(w[2] & 0xffff0000u), __uint_as_float(w[3] << 16), __uint_as_float(w[3] & 0xffff0000u)};
                    const f32x4 v0 = x0 * DN_ALPHA + acc[ai][bj][m][0], v1 = x1 * DN_ALPHA + acc[ai][bj][m][1];
                    float s = ((v0[0] + v0[1]) + (v0[2] + v0[3])) + ((v1[0] + v1[1]) + (v1[2] + v1[3]));
                    float q = ((v0[0] * v0[0] + v0[1] * v0[1]) + (v0[2] * v0[2] + v0[3] * v0[3])) + ((v1[0] * v1[0] + v1[1] * v1[1]) + (v1[2] * v1[2] + v1[3] * v1[3]));
                    u32x4 o; o.x = cvt_pk_bf16(v0[0], v0[1]); o.y = cvt_pk_bf16(v0[2], v0[3]); o.z = cvt_pk_bf16(v1[0], v1[1]); o.w = cvt_pk_bf16(v1[2], v1[3]);
                    *(u32x4*)(r + (size_t)row * D_MODEL + col) = o;
                    s += __shfl_xor(s, 16); s += __shfl_xor(s, 32); q += __shfl_xor(q, 16); q += __shfl_xor(q, 32);
                    if (fq == 0) *(f32x2*)(stats + ((size_t)row * 32 + u.pn * 8 + bj * 4 + wc) * 2) = (f32x2){s, q};
                }
            }
        }
    } };
DI void phase_outproj(const P3Args& a, LAS unsigned char* lds) {
    gs::DenseSched S{a.y, a.wt_out, D_MODEL, (T_TOK / 256) * 4, vblock(), GRID, 4, 0, 4, 0}; EpiOut E{a.xb, a.r, a.stats}; gs::gemm_stream<true, true, 0>(lds, D_MODEL, S, E);
}

DI void unpack16(const u32x4& a, const u32x4& b, float (&v)[16]) {
#pragma unroll
    for (int j = 0; j < 4; ++j) { v[2 * j] = __uint_as_float(a[j] << 16); v[2 * j + 1] = __uint_as_float(a[j] & 0xffff0000u); v[8 + 2 * j] = __uint_as_float(b[j] << 16); v[8 + 2 * j + 1] = __uint_as_float(b[j] & 0xffff0000u); }
}
DI void dma16_plain(const char* sbase, unsigned voff, unsigned lds_dst) {
    unsigned keep;
    asm volatile("s_mov_b32 %0, m0\n\ts_mov_b32 m0, %3\n\ts_nop 0\n\tglobal_load_lds_dwordx4 %1, %2\n\ts_mov_b32 m0, %0" : "=&s"(keep) : "v"(voff), "s"(sbase), "s"(lds_dst) : "memory");
}
DI void router_gemm(char* lds, const bf16_t* A, const bf16_t* Bt, f32x4 (&acc)[4][4]) {
    constexpr int STAGE = 16384 + 32768, NK = D_MODEL / 64;
    const int tid = tidx(), wid = __builtin_amdgcn_readfirstlane(tid >> 6), lane = tid & 63, wr = wid >> 2, wc = wid & 3, fr = lane & 15, fq = lane >> 4;
#pragma unroll
    for (int m = 0; m < 4; ++m)
#pragma unroll
        for (int n = 0; n < 4; ++n) acc[m][n] = (f32x4){0.f, 0.f, 0.f, 0.f};
    int aoff[2], boff[2];
#pragma unroll
    for (int ks = 0; ks < 2; ++ks) { const int ch = (((4 * ks + fq) ^ (fr >> 1)) << 4); aoff[ks] = (64 * wr + fr) * 128 + ch; boff[ks] = 16384 + (64 * wc + fr) * 128 + ch; }
    unsigned voA[2], voB[4];
#pragma unroll
    for (int i = 0; i < 2; ++i) { const int row = 8 * (2 * wid + i) + (lane >> 3), kc = (lane & 7) ^ ((row >> 1) & 7); voA[i] = (unsigned)(row * D_MODEL + kc * 8) * 2u; }
#pragma unroll
    for (int i = 0; i < 4; ++i) { const int row = 8 * (4 * wid + i) + (lane >> 3), kc = (lane & 7) ^ ((row >> 1) & 7); voB[i] = (unsigned)(row * D_MODEL + kc * 8) * 2u; }
    const unsigned lb = (unsigned)__builtin_amdgcn_readfirstlane((unsigned)(size_t)(LAS unsigned char*)lds);
    const char* ab = uni64(A); const char* bb = uni64(Bt);
#define RG_ISSUE(kt) do { const unsigned sb_ = lb + (unsigned)(((kt) % 3) * STAGE); const char* a_ = ab + (size_t)(kt) * 128; const char* b_ = bb + (size_t)(kt) * 128; \
        _Pragma("unroll") for (int i_ = 0; i_ < 2; ++i_) dma16_plain(a_, voA[i_], sb_ + (unsigned)((2 * wid + i_) * 1024)); \
        _Pragma("unroll") for (int i_ = 0; i_ < 4; ++i_) dma16_plain(b_, voB[i_], sb_ + 16384u + (unsigned)((4 * wid + i_) * 1024)); } while (0)
    __syncthreads();
    RG_ISSUE(0); RG_ISSUE(1);
#pragma unroll 1
    for (int kt = 0; kt < NK; ++kt) {
        if (kt + 1 < NK) asm volatile("s_waitcnt vmcnt(6)" ::: "memory"); else asm volatile("s_waitcnt vmcnt(0)" ::: "memory");
        asm volatile("s_waitcnt lgkmcnt(0)" ::: "memory"); __builtin_amdgcn_s_barrier(); asm volatile("" ::: "memory");
        if (kt + 2 < NK) RG_ISSUE(kt + 2);
        const char* cur = lds + (kt % 3) * STAGE;
#pragma unroll
        for (int ks = 0; ks < 2; ++ks) {
            bf16x8 a[4], b[4];
#pragma unroll
            for (int m = 0; m < 4; ++m) a[m] = *(const bf16x8*)(cur + aoff[ks] + m * 2048);
#pragma unroll
            for (int n = 0; n < 4; ++n) b[n] = *(const bf16x8*)(cur + boff[ks] + n * 2048);
#pragma unroll
            for (int m = 0; m < 4; ++m)
#pragma unroll
                for (int n = 0; n < 4; ++n) acc[m][n] = __builtin_amdgcn_mfma_f32_16x16x32_bf16(b[n], a[m], acc[m][n], 0, 0, 0);
        }
    }
#undef RG_ISSUE
    __syncthreads();
}
constexpr int RS_SC = 289;
constexpr int LDS_HIST = 100 * 1024;
struct P4Args { const bf16_t* r; const float* stats; const float* ln_g; const float* ln_b; bf16_t* x1; unsigned char* x1f8; const bf16_t* wt_r; const float* rbias;
                int* eidx; float* gate; int* counts; int* tokl; float* gatel; int* slot; };
DI void phase_router(const P4Args& a, const P0Args& cv, char* lds) {
    const int tid = tidx(), wid = tid >> 6, lane = tid & 63, wr = wid >> 2, wc = wid & 3, fr = lane & 15, fq = lane >> 4;
    float* sc = (float*)lds; int* hist = (int*)(lds + LDS_HIST); int* base = hist + 256;
    for (int u = vblock(); u < T_TOK / 128; u += GRID) {
        const int m0 = u * 128;
        if ((vblock() & 1) == 0) convert_moe_range(cv, lds, CV_GU, CV_GU + CV_DN);
        __syncthreads();
#pragma unroll 1
        for (int i0 = 0; i0 < 16; i0 += 4) {
            f32x2 st[4]; u32x4 r0[4], r1[4];
#pragma unroll
            for (int j4 = 0; j4 < 4; ++j4) {
                const int t = m0 + wid * 16 + i0 + j4;
                st[j4] = (f32x2){0.f, 0.f};
                if (lane < 32) st[j4] = *(const f32x2*)(a.stats + ((size_t)t * 32 + lane) * 2);
                r0[j4] = *(const u32x4*)(a.r + (size_t)t * D_MODEL + lane * 16); r1[j4] = *(const u32x4*)(a.r + (size_t)t * D_MODEL + lane * 16 + 8);
            }
#pragma unroll
            for (int j4 = 0; j4 < 4; ++j4) {
                const int t = m0 + wid * 16 + i0 + j4;
                float s = st[j4].x, q = st[j4].y;
#pragma unroll
                for (int o = 1; o <= 16; o <<= 1) { s += __shfl_xor(s, o); q += __shfl_xor(q, o); }
                s = __shfl(s, 0); q = __shfl(q, 0);
                const float mu = s * (1.f / 1024.f), rstd = rsqrtf(q * (1.f / 1024.f) - mu * mu + LN_EPS);
                float v[16]; unpack16(r0[j4], r1[j4], v);
                u32x4 o0, o1, o8;
#pragma unroll
                for (int j = 0; j < 4; ++j) {
                    const f32x4 g = *(const f32x4*)(a.ln_g + lane * 16 + 4 * j), bb = *(const f32x4*)(a.ln_b + lane * 16 + 4 * j);
                    const float y0 = (v[4 * j] - mu) * rstd * g[0] + bb[0], y1 = (v[4 * j + 1] - mu) * rstd * g[1] + bb[1], y2 = (v[4 * j + 2] - mu) * rstd * g[2] + bb[2], y3 = (v[4 * j + 3] - mu) * rstd * g[3] + bb[3];
                    o8[j] = pack_fp8x4(y0 * XSCALE, y1 * XSCALE, y2 * XSCALE, y3 * XSCALE);
                    const unsigned p0 = cvt_pk_bf16(y0, y1), p1 = cvt_pk_bf16(y2, y3);
                    if (j < 2) { o0[2 * j] = p0; o0[2 * j + 1] = p1; } else { o1[2 * (j - 2)] = p0; o1[2 * (j - 2) + 1] = p1; }
                }
                *(u32x4*)(a.x1 + (size_t)t * D_MODEL + lane * 16) = o0; *(u32x4*)(a.x1 + (size_t)t * D_MODEL + lane * 16 + 8) = o1;
                *(u32x4*)(a.x1f8 + (size_t)t * D_MODEL + lane * 16) = o8;
            }
        }
        asm volatile("s_waitcnt vmcnt(0)" ::: "memory");
        __syncthreads();
        f32x4 acc[4][4];
        router_gemm(lds, a.x1 + (size_t)m0 * D_MODEL, a.wt_r, acc);
        if (tid < 256) hist[tid] = 0;
        int my_idx[2], my_rank[2]; float my_gate[2];
#pragma unroll
        for (int p = 0; p < 2; ++p) {
            __syncthreads();
            if (wr == p) {
#pragma unroll
                for (int m = 0; m < 4; ++m)
#pragma unroll
                    for (int n = 0; n < 4; ++n) {
                        const int c0 = 64 * wc + 16 * n + 4 * fq; const f32x4 rb = *(const f32x4*)(a.rbias + c0);
#pragma unroll
                        for (int j = 0; j < 4; ++j) { const int c = c0 + j; sc[(16 * m + fr) * RS_SC + (c >> 5) * 36 + (c & 31)] = 1.f / (1.f + __expf(-acc[m][n][j])) + rb[j]; }
                    }
            }
            __syncthreads();
            const int row = tid >> 3, g = tid & 7, t = m0 + 64 * p + row;
            float sel[32];
#pragma unroll
            for (int i = 0; i < 32; ++i) sel[i] = sc[row * RS_SC + g * 36 + i];
            float m1 = -INFINITY, m2 = -INFINITY;
#pragma unroll
            for (int i = 0; i < 32; ++i) { const float v = sel[i]; m2 = fmaxf(m2, fminf(m1, v)); m1 = fmaxf(m1, v); }
            const float gs = m1 + m2; int rank = 0;
#pragma unroll
            for (int d = 1; d < 8; ++d) { const float o = __shfl_xor(gs, d); const int og = g ^ d; rank += (o > gs || (o == gs && og < g)) ? 1 : 0; }
            const bool en = rank < TOPK_GROUPS;
            float lv = -INFINITY; int li = 1 << 20;
            if (en) {
#pragma unroll
                for (int i = 0; i < 32; ++i) { const float v = sel[i]; if (v > lv) { lv = v; li = g * 32 + i; } }
            }
            float myv = 0.f; int myi = 0;
#pragma unroll
            for (int k = 0; k < TOP_K; ++k) {
                float bv = lv; int bi = li;
#pragma unroll
                for (int d = 1; d < 8; d <<= 1) { const float ov = __shfl_xor(bv, d); const int oi = __shfl_xor(bi, d); if (ov > bv || (ov == bv && oi < bi)) { bv = ov; bi = oi; } }
                if (g == k) { myv = bv; myi = bi; }
                if (k + 1 < TOP_K && (bi >> 5) == g) {
                    lv = -INFINITY; li = 1 << 20;
#pragma unroll
                    for (int i = 0; i < 32; ++i) { if (g * 32 + i == bi) sel[i] = -INFINITY; const float v = sel[i]; if (v > lv) { lv = v; li = g * 32 + i; } }
                }
            }
            const float score = myv - a.rbias[myi];
            float gsum = score;
#pragma unroll
            for (int d = 1; d < 8; d <<= 1) gsum += __shfl_xor(gsum, d);
            const float gt = score / gsum * ROUTED_SCALE;
            a.eidx[t * TOP_K + g] = myi; a.gate[t * TOP_K + g] = gt;
            my_idx[p] = myi; my_gate[p] = gt; my_rank[p] = atomicAdd(&hist[myi], 1);
        }
        __syncthreads();
        if (tid < 256) { const int h = hist[tid]; base[tid] = h > 0 ? atomicAdd(&a.counts[tid * CSTR], h) : 0; }
        __syncthreads();
#pragma unroll
        for (int p = 0; p < 2; ++p) {
            const int row = tid >> 3, g = tid & 7, t = m0 + 64 * p + row, e = my_idx[p], pos = base[e] + my_rank[p];
            a.tokl[(size_t)e * CAP + pos] = t; a.gatel[(size_t)e * CAP + pos] = my_gate[p]; a.slot[t * TOP_K + g] = e * CAP + pos;
        }
        if ((vblock() & 1) == 1) convert_moe_range(cv, lds, CV_GU, CV_GU + CV_DN);
    }
}

constexpr int LDS_ROWTAB = 128 * 1024;
constexpr int LDS_GTAB = 139 * 1024;
constexpr int LDS_TAB = 150 * 1024;
constexpr int LDS_UTAB = 154 * 1024;
constexpr int MOE_BM = 256;
DI void build_moe_tab(const int* counts, char* lds) {
    int* tstart = (int*)(lds + LDS_TAB); int* rstart = tstart + 264; int* cnts = tstart + 528;
    const int tid = tidx(), lane = tid & 63;
    __syncthreads();
    if (tid < 64) {
        int c[4], tl[4], cs = 0, ts = 0;
#pragma unroll
        for (int i = 0; i < 4; ++i) { c[i] = counts[(lane * 4 + i) * CSTR]; tl[i] = (c[i] + MOE_BM - 1) / MOE_BM; cs += c[i]; ts += tl[i]; }
        int ci = cs, ti = ts;
#pragma unroll
        for (int o = 1; o < 64; o <<= 1) { const int n1 = __shfl_up(ci, o), n2 = __shfl_up(ti, o); if (lane >= o) { ci += n1; ti += n2; } }
        int ce = ci - cs, te = ti - ts;
#pragma unroll
        for (int i = 0; i < 4; ++i) { rstart[lane * 4 + i] = ce; tstart[lane * 4 + i] = te; cnts[lane * 4 + i] = c[i]; ce += c[i]; te += tl[i]; }
        if (lane == 63) { rstart[256] = ce; tstart[256] = te; cnts[256] = T_TOK; rstart[257] = ce + T_TOK; tstart[257] = te + T_TOK / MOE_BM; }
    }
    __syncthreads();
}
DI int find_expert(const int* tstart, int g) {
    int lo = 0, hi = 256;
#pragma unroll 1
    while (lo < hi) { const int mid = (lo + hi + 1) >> 1; if (tstart[mid] <= g) lo = mid; else hi = mid - 1; }
    return lo;
}
struct MoeU { const char* A; const char* B; int e, m0, sub, ui; };
typedef const LAS int* ltab_t;
DI int find_expert_l(ltab_t tstart, int g) { int lo = 0, hi = 256;
#pragma unroll 1
    while (lo < hi) { const int mid = (lo + hi + 1) >> 1; if (tstart[mid] <= g) lo = mid; else hi = mid - 1; }
    return lo; }

struct P6Args { const unsigned char* x1; const int* counts; const int* tokl; const float* gatel; const unsigned char* wgut; unsigned char* H; };
struct GuSched {
    typedef MoeU U;
    ltab_t tab; const LAS int* rowtab; const LAS int* utab; const unsigned char* x1; const unsigned char* wgut; int first, stride, nunits;
    DI bool next(int i, U& u) const {
        const int L = first + i * stride; if (L >= nunits) return false;
        const int g = L >> 1, e = utab[i];
        u.sub = L & 1; u.e = e; u.ui = i; u.m0 = (g - tab[e]) * MOE_BM;
        u.A = (const char*)x1; u.B = (const char*)(wgut + ((size_t)e * 512 + 256 * u.sub) * D_MODEL); return true;
    }
    DI unsigned a_voff(int i, int h, int R, int C) const { return (unsigned)(rowtab[i * 256 + 128 * h + R] * (D_MODEL / 2) + C) * 2u; }
};
struct EpiGU { unsigned char* H; const LAS float* gtab; ltab_t tab; static constexpr int MXS = 0x7A7A7A7A;
    DI void operator()(const f32x4 (&acc)[2][2][4][2], const MoeU& u, int wr, int wc, int fr, int fq) const {
        const int st = tab[264 + u.e], cnt = tab[528 + u.e];
#pragma unroll
        for (int ai = 0; ai < 2; ++ai)
#pragma unroll
            for (int m = 0; m < 4; ++m) {
                const int row = u.m0 + 128 * ai + 64 * wr + 16 * m + fr;
                if (row < cnt) {
                    const float gt = gtab[u.ui * 256 + 128 * ai + 64 * wr + 16 * m + fr] * HSCALE;
                    float h[8];
#pragma unroll
                    for (int n = 0; n < 2; ++n)
#pragma unroll
                        for (int j = 0; j < 4; ++j) { const float gv = acc[ai][0][m][n][j]; h[4 * n + j] = gv * __builtin_amdgcn_rcpf(1.f + __expf(-gv)) * acc[ai][1][m][n][j] * gt; }
                    *(u32x2*)(H + (size_t)(st + row) * D_EXP + 128 * u.sub + 32 * wc + 8 * fq) = (u32x2){pack_fp8x4(h[0], h[1], h[2], h[3]), pack_fp8x4(h[4], h[5], h[6], h[7])};
                }
            }
    } };
DI void phase_moe_gu(const P6Args& a, char* smem, LAS unsigned char* lds) {
    build_moe_tab(a.counts, smem);
    const int* tstart = (const int*)(smem + LDS_TAB); const int* rstart = tstart + 264; int* rowtab = (int*)(smem + LDS_ROWTAB); float* gtab = (float*)(smem + LDS_GTAB);
    const int nunits = tstart[257] * 2, first = vblock();
    const int n_my = first < nunits ? (nunits - first + GRID - 1) / GRID : 0;
    for (int idx = tidx(); idx < n_my * 256; idx += NTHR) {
        const int i = idx >> 8, row = idx & 255, L = first + i * GRID, g = L >> 1, e = find_expert(tstart, g), m0 = (g - tstart[e]) * MOE_BM, cnt = tstart[528 + e];
        int rr = m0 + row; rr = rr < cnt ? rr : cnt - 1;
        rowtab[idx] = e < N_EXP ? a.tokl[(size_t)e * CAP + rr] : rr;
        gtab[idx] = e < N_EXP ? a.gatel[(size_t)e * CAP + rr] : 1.f;
    }
    if (tidx() < 32 && tidx() < n_my) ((int*)(smem + LDS_UTAB))[tidx()] = find_expert(tstart, (first + tidx() * GRID) >> 1);
    __syncthreads();
    GuSched S{(ltab_t)(lds + LDS_TAB), (const LAS int*)(lds + LDS_ROWTAB), (const LAS int*)(lds + LDS_UTAB), a.x1, a.wgut, first, GRID, nunits}; EpiGU E{a.H, (const LAS float*)(lds + LDS_GTAB), (ltab_t)(lds + LDS_TAB)};
    gs::gemm_stream<true, true, 2>(lds, D_MODEL / 2, S, E);
}
struct P7Args { const unsigned char* H; const int* counts; const unsigned char* wdt; unsigned char* Y; };
struct DownSched {
    typedef MoeU U;
    ltab_t tab; const LAS int* utab; const unsigned char* H; const unsigned char* wdt; int first, stride, nunits;
    DI bool next(int i, U& u) const {
        const int L = first + i * stride; if (L >= nunits) return false;
        const int g = L >> 2, e = utab[i];
        u.sub = L & 3; u.e = e; u.ui = i; u.m0 = (g - tab[e]) * MOE_BM;
        u.A = (const char*)(H + (size_t)(tab[264 + e] + u.m0) * D_EXP); u.B = (const char*)(wdt + ((size_t)e * D_MODEL + 256 * u.sub) * D_EXP); return true;
    }
    DI unsigned a_voff(int, int h, int R, int C) const { return (unsigned)((128 * h + R) * (D_EXP / 2) + C) * 2u; }
};
struct EpiDown { unsigned char* Y; ltab_t tab; static constexpr int MXS = 0x7D7D7D7D;
    DI void operator()(const f32x4 (&acc)[2][2][4][2], const MoeU& u, int wr, int wc, int fr, int fq) const {
        const int st = tab[264 + u.e], cnt = tab[528 + u.e];
#pragma unroll
        for (int ai = 0; ai < 2; ++ai)
#pragma unroll
            for (int m = 0; m < 4; ++m) {
                const int row = u.m0 + 128 * ai + 64 * wr + 16 * m + fr;
                if (row < cnt) {
                    u32x4 o;
#pragma unroll
                    for (int bj = 0; bj < 2; ++bj) {
                        const f32x4 v0 = acc[ai][bj][m][0], v1 = acc[ai][bj][m][1];
                        o[2 * bj] = pack_fp8x4(v0[0], v0[1], v0[2], v0[3]); o[2 * bj + 1] = pack_fp8x4(v1[0], v1[1], v1[2], v1[3]);
                    }
                    *(u32x4*)(Y + (size_t)(st + row) * D_MODEL + 256 * u.sub + 64 * wc + 16 * fq) = o;
                }
            }
    } };
DI void phase_moe_down(const P7Args& a, char* smem, LAS unsigned char* lds) {
    const int* tstart = (const int*)(smem + LDS_TAB); const int* rstart = tstart + 264;
    { const int nun = tstart[257] * 4, i = tidx(); if (i < 32 && vblock() + i * GRID < nun) ((int*)(smem + LDS_UTAB))[i] = find_expert(tstart, (vblock() + i * GRID) >> 2); }
    __syncthreads();
    DownSched S{(ltab_t)(lds + LDS_TAB), (const LAS int*)(lds + LDS_UTAB), a.H, a.wdt, vblock(), GRID, tstart[257] * 4}; EpiDown E{a.Y, (ltab_t)(lds + LDS_TAB)};
    gs::gemm_stream<true, true, 2>(lds, D_EXP / 2, S, E);
}
struct P8Args { const bf16_t* x1; const unsigned char* Y; const int* slot; const int* counts; const float* ln_g; const float* ln_b; float* out; };
DI void phase_combine(const P8Args& a, char* lds) {
    const int tid = tidx(), wid = tid >> 6, lane = tid & 63;
    const int* rstart = (const int*)(lds + LDS_TAB) + 264;
    const int sh0 = rstart[256];
    const int c0 = 256 * (lane >> 4) + 32 * ((lane >> 2) & 3) + 8 * (lane & 3);
    for (int t = vblock() * 8 + wid; t < T_TOK; t += GRID * 8) {
        float v[16], w[16];
        { const u32x4 p0 = *(const u32x4*)(a.x1 + (size_t)t * D_MODEL + c0), p1 = *(const u32x4*)(a.x1 + (size_t)t * D_MODEL + c0 + 128); unpack16(p0, p1, v); }
        int sl = 0; if (lane < TOP_K) sl = a.slot[t * TOP_K + lane];
        u32x4 yr[9];
        yr[8] = *(const u32x4*)(a.Y + (size_t)(sh0 + t) * D_MODEL + lane * 16);
#pragma unroll
        for (int k = 0; k < TOP_K; ++k) { const int s = __shfl(sl, k), e = s / CAP, pos = s % CAP; yr[k] = *(const u32x4*)(a.Y + (size_t)(rstart[e] + pos) * D_MODEL + lane * 16); }
#pragma unroll
        for (int i = 0; i < 16; ++i) w[i] = 0.f;
#pragma unroll
        for (int k = 0; k < 9; ++k)
#pragma unroll
            for (int j = 0; j < 4; ++j) { const f32x2 lo = __builtin_amdgcn_cvt_pk_f32_fp8((int)yr[k][j], false), hi = __builtin_amdgcn_cvt_pk_f32_fp8((int)yr[k][j], true); w[4 * j] += lo.x; w[4 * j + 1] += lo.y; w[4 * j + 2] += hi.x; w[4 * j + 3] += hi.y; }
#pragma unroll
        for (int i = 0; i < 16; ++i) v[i] = v[i] * DN_ALPHA + w[i] * (1.f / YSCALE);
        float s = 0.f;
#pragma unroll
        for (int i = 0; i < 16; ++i) s += v[i];
#pragma unroll
        for (int o = 32; o >= 1; o >>= 1) s += __shfl_xor(s, o);
        const float mu = s * (1.f / 1024.f);
        float q = 0.f;
#pragma unroll
        for (int i = 0; i < 16; ++i) { const float d = v[i] - mu; q += d * d; }
#pragma unroll
        for (int o = 32; o >= 1; o >>= 1) q += __shfl_xor(q, o);
        const float rstd = rsqrtf(q * (1.f / 1024.f) + LN_EPS);
#pragma unroll
        for (int j = 0; j < 4; ++j) {
            const int col = c0 + 128 * (j >> 1) + 4 * (j & 1);
            const f32x4 g = *(const f32x4*)(a.ln_g + col), bb = *(const f32x4*)(a.ln_b + col);
            f32x4 o; o[0] = (v[4 * j] - mu) * rstd * g[0] + bb[0]; o[1] = (v[4 * j + 1] - mu) * rstd * g[1] + bb[1]; o[2] = (v[4 * j + 2] - mu) * rstd * g[2] + bb[2]; o[3] = (v[4 * j + 3] - mu) * rstd * g[3] + bb[3];
            *(f32x4*)(a.out + (size_t)t * D_MODEL + col) = o;
        }
    }
}
#define MFMA32(a, b, c) __builtin_amdgcn_mfma_f32_32x32x16_bf16((a), (b), (c), 0, 0, 0)
constexpr float SB_EXIT_THR = 1e-30f;
struct P2Args { const bf16_t* Q; const bf16_t* Kb; const bf16_t* Vt; const float* rel_bias; const float* gain_a; const float* gain_b; bf16_t* y; };

DI bf16x8 pack8(const f32x16& x, int s) {
    u32x4 p;
    if (s == 0) { p.x = cvt_pk_bf16(x[0], x[1]); p.y = cvt_pk_bf16(x[2], x[3]); p.z = cvt_pk_bf16(x[4], x[5]); p.w = cvt_pk_bf16(x[6], x[7]); }
    else        { p.x = cvt_pk_bf16(x[8], x[9]); p.y = cvt_pk_bf16(x[10], x[11]); p.z = cvt_pk_bf16(x[12], x[13]); p.w = cvt_pk_bf16(x[14], x[15]); }
    return __builtin_bit_cast(bf16x8, p);
}
DI void load_k(bf16x8 (&k)[4], const bf16_t* kp, int k0) {
#pragma unroll
    for (int kk = 0; kk < 4; ++kk) k[kk] = *(const bf16x8*)(kp + (size_t)(k0 >> 5) * 2048 + kk * 512);
}
DI void load_v(bf16x8 (&v)[2][2], const bf16_t* vp, int k0) {
#pragma unroll
    for (int dt = 0; dt < 2; ++dt)
#pragma unroll
        for (int s = 0; s < 2; ++s) v[dt][s] = *(const bf16x8*)(vp + (size_t)(k0 >> 5) * 2048 + (dt * 2 + s) * 512);
}

constexpr int LDS_CVT = 16 * 1024;
DI void phase_attn(const P2Args& a, const P0Args& cv, char* lds) {
    const int tid = tidx(), wid = tid >> 6, lane = tid & 63, r = lane & 31, h = lane >> 5;
    float* tbl = (float*)lds;
    float* ssq = (float*)(lds + 8 * 260 * 4);
    __syncthreads();
    for (int i = tid; i < NHA * 257; i += NTHR) { const int hd = i / 257, j = i % 257; tbl[hd * 260 + j] = a.rel_bias[i] * LOG2E; }
    __syncthreads();
    const int cgrp = vblock() % 2;
#pragma unroll 1
    for (int slot = 0; slot < 5; ++slot) {
        if ((cgrp == 0 && slot == 0) || (cgrp == 1 && slot == 4)) convert_moe_range(cv, lds + LDS_CVT, 0, CV_GU);
        if (slot == 4) break;
        const int u = vblock() + GRID * (slot >> 1) + 2 * GRID * (slot & 1);
        const bool isB = u >= BATCH * (SEQ / 64); const int uu = isB ? u - BATCH * (SEQ / 64) : u;
        const int b = uu / (SEQ / 64), c = uu % (SEQ / 64), q0 = c * 64, hh = (isB ? NHA : 0) + wid;
        const size_t hb = (size_t)(b * NHH + hh) * SEQ * 64;
        const bf16_t* kp = a.Kb + hb + lane * 8;
        const bf16_t* vp = a.Vt + hb + lane * 8;
        bf16x8 qf[2][4];
#pragma unroll
        for (int qt = 0; qt < 2; ++qt)
#pragma unroll
            for (int kk = 0; kk < 4; ++kk) qf[qt][kk] = *(const bf16x8*)(a.Q + hb + (size_t)((q0 >> 5) + qt) * 2048 + kk * 512 + lane * 8);
        f32x16 ot[2][2];
#pragma unroll
        for (int dt = 0; dt < 2; ++dt)
#pragma unroll
            for (int qt = 0; qt < 2; ++qt)
#pragma unroll
                for (int i = 0; i < 16; ++i) ot[dt][qt][i] = 0.f;
        float linv[2] = {1.f, 1.f};
        if (!isB) {
            float mrun[2] = {-INFINITY, -INFINITY}, lrun[2] = {0.f, 0.f};
            const int klo = q0 - LEFT_CHUNKS * CHUNK < 0 ? 0 : q0 - LEFT_CHUNKS * CHUNK, khi = q0 + 64;
            const float cfar = tbl[wid * 260 + 256];
            bf16x8 kc[4], kn[4], vf[2][2]; load_k(kc, kp, klo);
            for (int k0 = klo; k0 < khi; k0 += 32) {
                load_v(vf, vp, k0);
                load_k(kn, kp, k0 + 32 < khi ? k0 + 32 : k0);
#pragma unroll
                for (int qt = 0; qt < 2; ++qt) {
                    bf16x8 pf[2];
                    f32x16 st;
#pragma unroll
                    for (int i = 0; i < 16; ++i) st[i] = 0.f;
#pragma unroll
                    for (int kk = 0; kk < 4; ++kk) st = MFMA32(kc[kk], qf[qt][kk], st);
                    const int dmin = q0 + 32 * qt - k0 - 31;
                    float boff = 0.f;
                    if (dmin >= MAX_REL) boff = cfar;
                    else {
                        const int bidx = q0 + 32 * qt + r - k0 - 4 * h + MAX_REL;
#pragma unroll
                        for (int i = 0; i < 16; ++i) { int ix = bidx - ((i & 3) + 8 * (i >> 2)); ix = ix < 0 ? 0 : (ix > 2 * MAX_REL ? 2 * MAX_REL : ix); st[i] += tbl[wid * 260 + ix]; }
                    }
                    float mx = st[0];
#pragma unroll
                    for (int i = 1; i < 16; ++i) mx = fmaxf(mx, st[i]);
                    mx = fmaxf(mx, __shfl_xor(mx, 32)) + boff;
                    const float mo = mrun[qt], mn = fmaxf(mo, mx);
                    mrun[qt] = mn;
                    const float eo = boff - mn;
                    float ps = 0.f;
#pragma unroll
                    for (int i = 0; i < 16; ++i) { st[i] = __builtin_amdgcn_exp2f(st[i] + eo); ps += st[i]; }
                    if (__all(mn == mo)) lrun[qt] += ps;
                    else {
                        const float alpha = __builtin_amdgcn_exp2f(mo - mn);
                        lrun[qt] = lrun[qt] * alpha + ps;
#pragma unroll
                        for (int i = 0; i < 16; ++i) { ot[0][qt][i] *= alpha; ot[1][qt][i] *= alpha; }
                    }
                    pf[0] = pack8(st, 0); pf[1] = pack8(st, 1);
#pragma unroll
                    for (int dt = 0; dt < 2; ++dt)
#pragma unroll
                        for (int s = 0; s < 2; ++s) ot[dt][qt] = MFMA32(vf[dt][s], pf[s], ot[dt][qt]);
                }
#pragma unroll
                for (int kk = 0; kk < 4; ++kk) kc[kk] = kn[kk];
            }
#pragma unroll
            for (int qt = 0; qt < 2; ++qt) { const float lt = lrun[qt] + __shfl_xor(lrun[qt], 32); linv[qt] = 1.f / lt; }
        } else {
            float carry[2] = {1.f, 1.f};
            bf16x8 kc[4], kn[4], vf[2][2]; load_k(kc, kp, q0 + 32);
            for (int k0 = q0 + 32; k0 >= 0; k0 -= 32) {
                load_v(vf, vp, k0);
                load_k(kn, kp, k0 >= 32 ? k0 - 32 : k0);
#pragma unroll
                for (int qt = 0; qt < 2; ++qt) {
                    bf16x8 pf[2];
                    f32x16 st;
#pragma unroll
                    for (int i = 0; i < 16; ++i) st[i] = 0.f;
                    const bool none = (k0 > q0 + 32 * qt + 30);
                    if (!none) {
#pragma unroll
                        for (int kk = 0; kk < 4; ++kk) st = MFMA32(kc[kk], qf[qt][kk], st);
                        const bool full = (k0 + 31 < q0 + 32 * qt);
                        const int lim = q0 + 32 * qt + r - k0 - 4 * h;
                        float om[16];
#pragma unroll
                        for (int i = 0; i < 16; ++i) {
                            const float e = __builtin_amdgcn_exp2f(-st[i]); float bta = __builtin_amdgcn_rcpf(1.f + e);
                            if (!full && !(((i & 3) + 8 * (i >> 2)) < lim)) bta = 0.f;
                            st[i] = bta; om[i] = 1.f - bta;
                        }
                        float G[4], Go[4];
#pragma unroll
                        for (int g = 0; g < 4; ++g) { G[g] = (om[4 * g] * om[4 * g + 1]) * (om[4 * g + 2] * om[4 * g + 3]); Go[g] = __shfl_xor(G[g], 32); }
                        float R = carry[qt];
#pragma unroll
                        for (int g = 3; g >= 0; --g) {
                            float run = h == 0 ? R * Go[g] : R;
#pragma unroll
                            for (int uu2 = 3; uu2 >= 0; --uu2) { const float bta = st[4 * g + uu2]; st[4 * g + uu2] = bta * run; run *= om[4 * g + uu2]; }
                            R = R * (G[g] * Go[g]);
                        }
                        carry[qt] = R;
                    }
                    if (!none) {
                        pf[0] = pack8(st, 0); pf[1] = pack8(st, 1);
#pragma unroll
                        for (int dt = 0; dt < 2; ++dt)
#pragma unroll
                            for (int s = 0; s < 2; ++s) ot[dt][qt] = MFMA32(vf[dt][s], pf[s], ot[dt][qt]);
                    }
                }
#pragma unroll
                for (int kk = 0; kk < 4; ++kk) kc[kk] = kn[kk];
                if (__all(carry[0] < SB_EXIT_THR && carry[1] < SB_EXIT_THR)) break;
            }
        }
        float ss[2];
#pragma unroll
        for (int qt = 0; qt < 2; ++qt) {
            float s2 = 0.f;
#pragma unroll
            for (int dt = 0; dt < 2; ++dt)
#pragma unroll
                for (int i = 0; i < 16; ++i) { ot[dt][qt][i] *= linv[qt]; s2 += ot[dt][qt][i] * ot[dt][qt][i]; }
            s2 += __shfl_xor(s2, 32); ss[qt] = s2;
        }
        __syncthreads();
        if (h == 0) { ssq[wid * 64 + r] = ss[0]; ssq[wid * 64 + 32 + r] = ss[1]; }
        __syncthreads();
        const float* gain = isB ? a.gain_b : a.gain_a;
#pragma unroll
        for (int qt = 0; qt < 2; ++qt) {
            float tot = 0.f;
#pragma unroll
            for (int w8 = 0; w8 < 8; ++w8) tot += ssq[w8 * 64 + 32 * qt + r];
            const float rs = rsqrtf(tot * (1.f / 512.f) + RMS_EPS);
            char* yst = lds + LDS_CVT + wid * (64 * 136);
#pragma unroll
            for (int dt = 0; dt < 2; ++dt)
#pragma unroll
                for (int g = 0; g < 4; ++g) {
                    const int d = 32 * dt + 8 * g + 4 * h; const f32x4 gn = *(const f32x4*)(gain + wid * 64 + d);
                    u32x2 o; o.x = cvt_pk_bf16(ot[dt][qt][4 * g] * rs * gn[0], ot[dt][qt][4 * g + 1] * rs * gn[1]); o.y = cvt_pk_bf16(ot[dt][qt][4 * g + 2] * rs * gn[2], ot[dt][qt][4 * g + 3] * rs * gn[3]);
                    *(u32x2*)(yst + (32 * qt + r) * 136 + d * 2) = o;
                }
        }
        {
            char* yst = lds + LDS_CVT + wid * (64 * 136);
            bf16_t* yb = a.y + (size_t)(b * SEQ + q0) * D_MODEL + (isB ? 512 : 0) + wid * 64;
#pragma unroll
            for (int j = 0; j < 8; ++j) {
                const int tok = (lane >> 3) + 8 * j, ch = lane & 7;
                const u32x2 lo = *(const u32x2*)(yst + tok * 136 + ch * 16), hi = *(const u32x2*)(yst + tok * 136 + ch * 16 + 8);
                *(u32x4*)(yb + (size_t)tok * D_MODEL + ch * 8) = (u32x4){lo.x, lo.y, hi.x, hi.y};
            }
        }
    }
}


#define XB_TMO      128
#define XB_XCNT(j)  (256  + 64 * (j))
#define XB_XSUB(j)  (1280 + 64 * (j))
#define XB_XGEN(j)  (2304 + 64 * (j))
#define XB_TOP      3328
#define XB_TOPGEN   3392
#define XCD_BAR_WORDS 3456
#define XB_SPIN_CAP (1u << 18)
#define LAS __attribute__((address_space(3)))

__device__ __forceinline__ unsigned xb_ld(unsigned* p)              { return __hip_atomic_load(p, __ATOMIC_RELAXED, __HIP_MEMORY_SCOPE_AGENT); }
__device__ __forceinline__ unsigned xb_add(unsigned* p, unsigned v) { return __hip_atomic_fetch_add(p, v, __ATOMIC_RELAXED, __HIP_MEMORY_SCOPE_AGENT); }
__device__ __forceinline__ unsigned xb_xcc_id() { return (unsigned)__builtin_amdgcn_s_getreg((3 << 11) | 20) & 0xFu; }
#define XB_SPIN(cond, bar) do { unsigned _sp = 0; while (cond) { __builtin_amdgcn_s_sleep(1); \
    if ((++_sp & 255u) == 0u) { if (xb_ld(&(bar)[XB_TMO])) break; if (_sp > XB_SPIN_CAP) { atomicAdd(&(bar)[XB_TMO], 1u); break; } } } } while (0)

struct XcdBarrier {
    unsigned* bar; unsigned x;
    volatile LAS unsigned* st;
};

__device__ __forceinline__ XcdBarrier xcd_barrier_post(unsigned* bar, volatile LAS unsigned* st) {
    XcdBarrier b; b.bar = bar; b.x = xb_xcc_id(); b.st = st;
    if (threadIdx.x == 0) (void)xb_add(&bar[XB_XCNT(b.x)], 1u);
    return b;
}
__device__ __forceinline__ void xcd_barrier_complete(unsigned* bar, unsigned x, unsigned& nloc, unsigned& nx) {
    const unsigned G = gridDim.x * gridDim.y * gridDim.z;
    unsigned sum, cnt, mine, sp = 0u;
    for (;;) {
        sum = 0u; cnt = 0u; mine = 0u;
#pragma unroll
        for (unsigned j = 0; j < 16; ++j) { const unsigned c = xb_ld(&bar[XB_XCNT(j)]); sum += c; cnt += (c > 0u) ? 1u : 0u; mine = (j == x) ? c : mine; }
        if (sum == G) break;
        __builtin_amdgcn_s_sleep(1);
        if ((++sp & 255u) == 0u) { if (xb_ld(&bar[XB_TMO])) break; if (sp > XB_SPIN_CAP) { atomicAdd(&bar[XB_TMO], 1u); break; } }
    }
    nloc = mine > 0u ? mine : 1u; nx = cnt > 0u ? cnt : 1u;
}

__device__ __forceinline__ void xcd_barrier(const XcdBarrier& b) {
    asm volatile("s_waitcnt vmcnt(0)" ::: "memory");
    __syncthreads();
    if (threadIdx.x == 0) {
        unsigned* bar = b.bar;
        __builtin_amdgcn_s_waitcnt(0);
        unsigned nloc = b.st[0], nx = b.st[1];
        if (nloc == 0u) { xcd_barrier_complete(bar, b.x, nloc, nx); b.st[0] = nloc; b.st[1] = nx; }
        const unsigned old = xb_add(&bar[XB_XSUB(b.x)], 1u);
        const unsigned gen = old / nloc;
        if (old + 1u == (gen + 1u) * nloc) {
            __builtin_amdgcn_fence(__ATOMIC_RELEASE, "agent");
            asm volatile("s_waitcnt vmcnt(0)" ::: "memory");
            const unsigned og = xb_add(&bar[XB_TOP], 1u);
            const unsigned tg = og / nx;
            if (og + 1u == (tg + 1u) * nx) xb_add(&bar[XB_TOPGEN], 1u);
            else XB_SPIN(xb_ld(&bar[XB_TOPGEN]) == tg, bar);
            __builtin_amdgcn_fence(__ATOMIC_ACQUIRE, "agent");
            xb_add(&bar[XB_XGEN(b.x)], 1u);
            asm volatile("s_waitcnt vmcnt(0)" ::: "memory");
        } else {
            XB_SPIN(xb_ld(&bar[XB_XGEN(b.x)]) == gen, bar);
            __builtin_amdgcn_fence(__ATOMIC_ACQUIRE, "agent");
            asm volatile("s_waitcnt vmcnt(0)" ::: "memory");
        }
    }
    __syncthreads();
}


struct MegaArgs { P0Args p0; P1Args p1; P2Args p2; P3Args p3; P4Args p4; P6Args p6; P7Args p7; P8Args p8; unsigned* bar; };
__global__ __launch_bounds__(NTHR, 2) void k_mega(MegaArgs a) {
    extern __shared__ __attribute__((aligned(16))) char smem[];
    asm volatile("s_setreg_imm32_b32 hwreg(HW_REG_MODE, 23, 1), 1");
    volatile LAS unsigned* xbw = (volatile LAS unsigned*)(smem + LDS_BYTES - 16);
    if (threadIdx.x == 0) { xbw[0] = 0u; xbw[1] = 0u; xbw[2] = 0u; xbw[3] = 0u; }
    __syncthreads();
    XcdBarrier bar = xcd_barrier_post(a.bar, xbw);
    LAS unsigned char* L = (LAS unsigned char*)smem;
    phase_prologue(a.p0, smem);     xcd_barrier(bar);
    phase_qkv(a.p1, L);             xcd_barrier(bar);
    phase_attn(a.p2, a.p0, smem);   xcd_barrier(bar);
    phase_outproj(a.p3, L);         xcd_barrier(bar);
    phase_router(a.p4, a.p0, smem); xcd_barrier(bar);
    phase_moe_gu(a.p6, smem, L);    xcd_barrier(bar);
    phase_moe_down(a.p7, smem, L);  xcd_barrier(bar);
    phase_combine(a.p8, smem);
}

extern "C" void kernel_launch(void* const* d_in, const int* in_sizes, int n_in, void* d_out, int out_size, void* d_ws, size_t ws_size, hipStream_t stream) {
    const float* x = (const float*)d_in[0];      const float* w_in = (const float*)d_in[1];   const float* rel_bias = (const float*)d_in[2];
    const float* gain_a = (const float*)d_in[3]; const float* gain_b = (const float*)d_in[4]; const float* w_out = (const float*)d_in[5];
    const float* ln1_g = (const float*)d_in[6];  const float* ln1_b = (const float*)d_in[7];  const float* router_w = (const float*)d_in[8];
    const float* router_bias = (const float*)d_in[9]; const float* w_gate = (const float*)d_in[10]; const float* w_up = (const float*)d_in[11];
    const float* w_down = (const float*)d_in[12]; const float* ws_gate = (const float*)d_in[13]; const float* ws_up = (const float*)d_in[14];
    const float* ws_down = (const float*)d_in[15]; const float* ln2_g = (const float*)d_in[16]; const float* ln2_b = (const float*)d_in[17];
    char* ws = (char*)d_ws; float* out = (float*)d_out;
    int* ctrl = (int*)(ws + OFF_CTRL); int* counts = ctrl + CW_COUNTS;
    bf16_t* X1 = (bf16_t*)(ws + OFF_X1); int* tokl = (int*)(ws + OFF_TOKL); float* gatel = (float*)(ws + OFF_GATEL);
    int* eidx = (int*)(ws + OFF_EIDX); float* gate = (float*)(ws + OFF_GATE); int* slot = (int*)(ws + OFF_SLOT);
    unsigned char* H = (unsigned char*)(ws + OFF_H); unsigned char* Y = (unsigned char*)(ws + OFF_Y); unsigned char* x1f8 = (unsigned char*)(ws + OFF_X1F8);
    bf16_t* Q = (bf16_t*)(ws + OFF_Q); bf16_t* Kb = (bf16_t*)(ws + OFF_K); bf16_t* Vt = (bf16_t*)(ws + OFF_VT);
    bf16_t* yatt = (bf16_t*)(ws + OFF_YATT); bf16_t* r = (bf16_t*)(ws + OFF_R);
    bf16_t* xb = (bf16_t*)(ws + OFF_XB); float* stats = (float*)(ws + OFF_STATS);
    bf16_t* wt_in = (bf16_t*)(ws + OFF_WTIN); bf16_t* wt_out = (bf16_t*)(ws + OFF_WTOUT); bf16_t* wt_r = (bf16_t*)(ws + OFF_WTR);
    unsigned char* wgut = (unsigned char*)(ws + OFF_WGUT); unsigned char* wdt = (unsigned char*)(ws + OFF_WDT);
    if (ws_size < WS_NEEDED) { fprintf(stderr, "kernel_launch: workspace too small (%zu < %zu)\n", ws_size, (size_t)WS_NEEDED); return; }
    hipMemsetAsync(ctrl, 0, 128 * 1024, stream);
    static bool attr_done = false;
    if (!attr_done) {
        hipFuncSetAttribute((const void*)k_mega, hipFuncAttributeMaxDynamicSharedMemorySize, LDS_BYTES);
        attr_done = true;
    }
    MegaArgs m{};
    m.p0 = P0Args{x, w_in, w_out, router_w, xb, wt_in, wt_out, wt_r, w_gate, w_up, w_down, ws_gate, ws_up, ws_down, wgut, wdt};
    m.p1 = P1Args{xb, wt_in, Q, Kb, Vt};
    m.p2 = P2Args{Q, Kb, Vt, rel_bias, gain_a, gain_b, yatt};
    m.p3 = P3Args{yatt, wt_out, xb, r, stats};
    m.p4 = P4Args{r, stats, ln1_g, ln1_b, X1, x1f8, wt_r, router_bias, eidx, gate, counts, tokl, gatel, slot};
    m.p6 = P6Args{x1f8, counts, tokl, gatel, wgut, H};
    m.p7 = P7Args{H, counts, wdt, Y};
    m.p8 = P8Args{X1, Y, slot, counts, ln2_g, ln2_b, out};
    m.bar = (unsigned*)ctrl;
    k_mega<<<GRID, NTHR, LDS_BYTES, stream>>>(m);
}
```

```cpp
#include <hip/hip_runtime.h>
#include <cstdint>
#include <cstdio>

typedef unsigned short bf16_t;

constexpr int D_MODEL = 1024, BATCH = 16, SEQ = 2048, T_TOK = BATCH * SEQ;
constexpr int HEAD_DIM = 64, NHA = 8, NHB = 8, NHH = 16;
constexpr int CHUNK = 64, LEFT_CHUNKS = 8, MAX_REL = 128;
constexpr int N_EXP = 256, TOP_K = 8, N_GROUPS = 8, TOPK_GROUPS = 4, EPG = 32, D_EXP = 256;
constexpr float ROUTED_SCALE = 2.5f, LN_EPS = 1e-5f, RMS_EPS = 1e-6f;
constexpr float DN_ALPHA = 1.189207115002721f;
constexpr float LOG2E = 1.4426950408889634f, LN2 = 0.6931471805599453f;
constexpr float QSCALE = 0.125f * LOG2E;
constexpr float WSCALE = 64.f, XSCALE = 16.f, HSCALE = 16.f;
constexpr float YSCALE = 64.f;
constexpr int CAP = T_TOK;
constexpr int ROWS_ALL = T_TOK * TOP_K + T_TOK;

__device__ __forceinline__ float bf2f(bf16_t v) { return __uint_as_float(((unsigned)v) << 16); }
__device__ __forceinline__ bf16_t f2bf(float f) { unsigned u = __float_as_uint(f); u += 0x7fffu + ((u >> 16) & 1u); return (bf16_t)(u >> 16); }

constexpr size_t MB = 1024ull * 1024ull;
constexpr size_t OFF_CTRL   = 0;
constexpr size_t OFF_X1     = 1 * MB;
constexpr size_t OFF_TOKL   = OFF_X1 + 64 * MB;
constexpr size_t OFF_GATEL  = OFF_TOKL + 32 * MB;
constexpr size_t OFF_EIDX   = OFF_GATEL + 32 * MB;
constexpr size_t OFF_GATE   = OFF_EIDX + 1 * MB;
constexpr size_t OFF_SLOT   = OFF_GATE + 1 * MB;
constexpr size_t OFF_WDT    = OFF_SLOT + 1 * MB;
constexpr size_t OFF_X1F8   = OFF_WDT + 72 * MB;
constexpr size_t OFF_BIG    = OFF_WDT + 129 * MB;
constexpr size_t OFF_H      = OFF_BIG;
constexpr size_t OFF_Y      = OFF_BIG + 144 * MB;
constexpr size_t OFF_Q      = OFF_BIG;
constexpr size_t OFF_K      = OFF_BIG + 64 * MB;
constexpr size_t OFF_VT     = OFF_BIG + 128 * MB;
constexpr size_t OFF_YATT   = OFF_BIG + 192 * MB;
constexpr size_t OFF_R      = OFF_BIG + 256 * MB;
constexpr size_t OFF_XB     = OFF_BIG + 320 * MB;
constexpr size_t OFF_STATS  = OFF_BIG + 384 * MB;
constexpr size_t OFF_WTIN   = OFF_BIG + 392 * MB;
constexpr size_t OFF_WTOUT  = OFF_BIG + 398 * MB;
constexpr size_t OFF_WTR    = OFF_BIG + 400 * MB;
constexpr size_t OFF_WGUT   = OFF_BIG + 401 * MB;
constexpr size_t WS_NEEDED  = OFF_BIG + 720 * MB;
static_assert(OFF_WGUT + 257 * MB <= WS_NEEDED && WS_NEEDED <= 1024 * MB, "workspace map");
constexpr int CW_COUNTS = 8192;
constexpr int CSTR = 64;

typedef short bf16x8 __attribute__((ext_vector_type(8)));
typedef float f32x4 __attribute__((ext_vector_type(4)));
typedef float f32x2 __attribute__((ext_vector_type(2)));
typedef float f32x16 __attribute__((ext_vector_type(16)));
typedef unsigned u32x4 __attribute__((ext_vector_type(4)));
typedef unsigned u32x2 __attribute__((ext_vector_type(2)));
#define DI __device__ __forceinline__
constexpr int NTHR = 512, GRID = 256;
DI int tidx() { int t = threadIdx.x; asm volatile("" : "+v"(t)); return t; }
constexpr int LDS_BYTES = 160 * 1024;

typedef __bf16 bf16x2_t __attribute__((ext_vector_type(2)));
DI unsigned cvt_pk_bf16(float lo, float hi) { f32x2 v = {lo, hi}; bf16x2_t r = __builtin_convertvector(v, bf16x2_t); return __builtin_bit_cast(unsigned, r); }
DI unsigned pack_fp8x4(float a, float b, float c, float d) { int w = 0; w = __builtin_amdgcn_cvt_pk_fp8_f32(a, b, w, false); w = __builtin_amdgcn_cvt_pk_fp8_f32(c, d, w, true); return (unsigned)w; }
DI int vblock() { return (int)((blockIdx.x & 7) * (GRID / 8) + (blockIdx.x >> 3)); }

template <int MT> struct Tile { static constexpr int BM = 32 * MT, A_BYTES = BM * 128, B_BYTES = 256 * 128, STAGE = A_BYTES + B_BYTES; };

template <int MT> struct ALoader {
    const bf16_t* p[MT / 2]; u32x4 v[MT / 2]; int off0;
    DI void init_rows(const bf16_t* A, int lda, int row0) {
        const int tid = tidx(), kc = tid & 7, r = tid >> 3;
#pragma unroll
        for (int i = 0; i < MT / 2; ++i) p[i] = A + (size_t)(row0 + r + 64 * i) * lda + kc * 8;
        off0 = r * 128 + ((kc ^ ((r >> 1) & 7)) << 4);
    }
    DI void init_gather(const bf16_t* A, int lda, const int* rows, int cnt, int m0) {
        const int tid = tidx(), kc = tid & 7, r = tid >> 3;
#pragma unroll
        for (int i = 0; i < MT / 2; ++i) { int rr = m0 + r + 64 * i; rr = rr < cnt ? rr : cnt - 1; const int g = rows ? rows[rr] : rr; p[i] = A + (size_t)g * lda + kc * 8; }
        off0 = r * 128 + ((kc ^ ((r >> 1) & 7)) << 4);
    }
    DI void load(int k0) {
#pragma unroll
        for (int i = 0; i < MT / 2; ++i) v[i] = *(const u32x4*)(p[i] + k0);
    }
    DI void store(char* ldsA) const {
#pragma unroll
        for (int i = 0; i < MT / 2; ++i) *(u32x4*)(ldsA + off0 + i * 8192) = v[i];
    }
};
struct BLoaderBt {
    const bf16_t* p[4]; u32x4 v[4]; int off0;
    DI void init(const bf16_t* Bt, int ldk, int n0) {
        const int tid = tidx(), kc = tid & 7, r = tid >> 3;
#pragma unroll
        for (int i = 0; i < 4; ++i) p[i] = Bt + (size_t)(n0 + r + 64 * i) * ldk + kc * 8;
        off0 = r * 128 + ((kc ^ ((r >> 1) & 7)) << 4);
    }
    DI void load(int k0) {
#pragma unroll
        for (int i = 0; i < 4; ++i) v[i] = *(const u32x4*)(p[i] + k0);
    }
    DI void store(char* ldsB) const {
#pragma unroll
        for (int i = 0; i < 4; ++i) *(u32x4*)(ldsB + off0 + i * 8192) = v[i];
    }
};
template <int MT, bool TR, class AL, class BL>
DI void gemm_tile(char* lds, AL& al, BL& bl, int nk, f32x4 (&acc)[MT][4]) {
    typedef Tile<MT> TT;
    const int tid = tidx(), wid = tid >> 6, lane = tid & 63, wr = wid >> 2, wc = wid & 3, fr = lane & 15, fq = lane >> 4;
#pragma unroll
    for (int m = 0; m < MT; ++m)
#pragma unroll
        for (int n = 0; n < 4; ++n) acc[m][n] = (f32x4){0.f, 0.f, 0.f, 0.f};
    int aoff[2], boff[2];
#pragma unroll
    for (int ks = 0; ks < 2; ++ks) { const int ch = (((4 * ks + fq) ^ (fr >> 1)) << 4); aoff[ks] = (16 * MT * wr + fr) * 128 + ch; boff[ks] = TT::A_BYTES + (64 * wc + fr) * 128 + ch; }
    al.load(0); bl.load(0);
    __syncthreads();
    al.store(lds); bl.store(lds + TT::A_BYTES);
    __syncthreads();
    for (int kt = 0; kt < nk; ++kt) {
        char* cur = lds + (kt & 1) * TT::STAGE; char* nxt = lds + ((kt & 1) ^ 1) * TT::STAGE;
        const bool more = kt + 1 < nk;
        if (more) { al.load((kt + 1) * 64); bl.load((kt + 1) * 64); }
#pragma unroll
        for (int ks = 0; ks < 2; ++ks) {
            bf16x8 a[MT], b[4];
#pragma unroll
            for (int m = 0; m < MT; ++m) a[m] = *(const bf16x8*)(cur + aoff[ks] + m * 2048);
#pragma unroll
            for (int n = 0; n < 4; ++n) b[n] = *(const bf16x8*)(cur + boff[ks] + n * 2048);
#pragma unroll
            for (int m = 0; m < MT; ++m)
#pragma unroll
                for (int n = 0; n < 4; ++n)
                    acc[m][n] = TR ? __builtin_amdgcn_mfma_f32_16x16x32_bf16(b[n], a[m], acc[m][n], 0, 0, 0) : __builtin_amdgcn_mfma_f32_16x16x32_bf16(a[m], b[n], acc[m][n], 0, 0, 0);
        }
        if (more) { al.store(nxt); bl.store(nxt + TT::A_BYTES); }
        __syncthreads();
    }
}

#define LAS __attribute__((address_space(3)))
namespace gs {
constexpr int BM = 256, BK = 64, HALF = 128, HTB = HALF * BK * 2, STAGE_BYTES = 8 * HTB;
DI int lds_byte(int r, int c) { const int st = (r >> 4) * 2 + (c >> 5), rr = r & 15, cc = c & 31, ob = rr * 64 + cc * 2; return st * 1024 + (ob ^ (((ob >> 9) & 1) << 5)); }
DI void stage_rc(int b, int& R, int& C) { const int st = b / 1024, sb = b % 1024, swz = sb ^ (((sb >> 9) & 1) << 5); R = (st >> 1) * 16 + swz / 64; C = (st & 1) * 32 + (swz % 64) / 2; }
DI int perm32(int rho) { const int n = rho >> 4, i = rho & 15; return 8 * (i >> 2) + 4 * n + (i & 3); }
typedef long i64x2 __attribute__((ext_vector_type(2)));
DI const char* uni(const char* p) { const unsigned long long v = (unsigned long long)p; const unsigned lo = __builtin_amdgcn_readfirstlane((unsigned)v), hi = __builtin_amdgcn_readfirstlane((unsigned)(v >> 32)); return (const char*)(((unsigned long long)hi << 32) | lo); }
template <bool TR, bool F8>
DI f32x4 mma16(const bf16x8& a, const bf16x8& b, f32x4 c) {
    if (F8) {
        const i64x2 a2 = __builtin_bit_cast(i64x2, a), b2 = __builtin_bit_cast(i64x2, b);
        c = TR ? __builtin_amdgcn_mfma_f32_16x16x32_fp8_fp8(b2[0], a2[0], c, 0, 0, 0) : __builtin_amdgcn_mfma_f32_16x16x32_fp8_fp8(a2[0], b2[0], c, 0, 0, 0);
        return TR ? __builtin_amdgcn_mfma_f32_16x16x32_fp8_fp8(b2[1], a2[1], c, 0, 0, 0) : __builtin_amdgcn_mfma_f32_16x16x32_fp8_fp8(a2[1], b2[1], c, 0, 0, 0);
    }
    return TR ? __builtin_amdgcn_mfma_f32_16x16x32_bf16(b, a, c, 0, 0, 0) : __builtin_amdgcn_mfma_f32_16x16x32_bf16(a, b, c, 0, 0, 0);
}
typedef int i32x8 __attribute__((ext_vector_type(8)));
typedef short bf16x16 __attribute__((ext_vector_type(16)));
template <bool TR, int SC>
DI f32x4 mma128(const bf16x16& a, const bf16x16& b, f32x4 c) {
    const i32x8 av = __builtin_bit_cast(i32x8, a), bv = __builtin_bit_cast(i32x8, b);
    const int one = SC;
    if (TR) asm volatile("v_mfma_scale_f32_16x16x128_f8f6f4 %0, %1, %2, %0, %3, %3 op_sel_hi:[0,0,0]" : "+v"(c) : "v"(bv), "v"(av), "v"(one));
    else    asm volatile("v_mfma_scale_f32_16x16x128_f8f6f4 %0, %1, %2, %0, %3, %3 op_sel_hi:[0,0,0]" : "+v"(c) : "v"(av), "v"(bv), "v"(one));
    return c;
}
DI bf16x8 frag_lo(const bf16x16& v) { return __builtin_shufflevector(v, v, 0, 1, 2, 3, 4, 5, 6, 7); }
DI bf16x8 frag_hi(const bf16x16& v) { return __builtin_shufflevector(v, v, 8, 9, 10, 11, 12, 13, 14, 15); }
template <bool TR, bool PERM, int F8, class Sched, class Epi>
DI void gemm_stream(LAS unsigned char* lds, const int K, const Sched& S, const Epi& E) {
    typedef typename Sched::U U;
    const int tid = tidx(), wid = __builtin_amdgcn_readfirstlane(tid >> 6), lane = tid & 63, wr = wid >> 2, wc = wid & 3, fr = lane & 15, fq = lane >> 4;
    const int nt = K / BK;
    int R[2], C[2]; unsigned voffB[2];
#pragma unroll
    for (int i = 0; i < 2; ++i) { stage_rc(tid * 16 + i * 8192, R[i], C[i]); const int Rb = PERM ? ((R[i] & ~31) + perm32(R[i] & 31)) : R[i]; voffB[i] = (unsigned)(Rb * K + C[i]) * 2u; }
    const size_t kstep = (size_t)(BK * 2), hstepB = (size_t)HALF * K * 2;
    const unsigned ldsw = (unsigned)wid * 1024u;
    const int aoff = lds_byte(wr * 64 + fr, fq * 8), boff = lds_byte(wc * 32 + fr, fq * 8);
#define GS_SA(b, h) (((b) * 2 + (h)) * HTB)
#define GS_SB(b, h) ((4 + (b) * 2 + (h)) * HTB)
#define GS_STAGE(bufoff, gbase, uix, h) do { _Pragma("unroll") for (int _i = 0; _i < 2; ++_i) \
        __builtin_amdgcn_global_load_lds((const unsigned*)((const char*)(gbase) + S.a_voff(uix, h, R[_i], C[_i])), (LAS unsigned*)(lds + (bufoff) + ldsw + _i * 8192), 16, 0, 0); } while (0)
#define GS_STAGEB(bufoff, gbase, voff) do { _Pragma("unroll") for (int _i = 0; _i < 2; ++_i) \
        __builtin_amdgcn_global_load_lds((const unsigned*)((const char*)(gbase) + (voff)[_i]), (LAS unsigned*)(lds + (bufoff) + ldsw + _i * 8192), 16, 0, 0); } while (0)
#define GS_LD32(base) __builtin_shufflevector(*(const LAS bf16x8*)(base), *(const LAS bf16x8*)((base) + 1024), 0, 1, 2, 3, 4, 5, 6, 7, 8, 9, 10, 11, 12, 13, 14, 15)
#define GS_LDA(dst, b, h) do { _Pragma("unroll") for (int m = 0; m < 4; ++m) dst[m] = GS_LD32(lds + GS_SA(b, h) + aoff + m * 2048); } while (0)
#define GS_LDB(dst, b, h) do { _Pragma("unroll") for (int n = 0; n < 2; ++n) dst[n] = GS_LD32(lds + GS_SB(b, h) + boff + n * 2048); } while (0)
#define GS_MMA(ai, bj, At, Bt) do { __builtin_amdgcn_s_setprio(1); _Pragma("unroll") for (int m = 0; m < 4; ++m) _Pragma("unroll") for (int n = 0; n < 2; ++n) { \
        if (F8 == 2) acc[ai][bj][m][n] = mma128<TR, Epi::MXS>(At[m], Bt[n], acc[ai][bj][m][n]); \
        else { acc[ai][bj][m][n] = mma16<TR, F8 == 1>(frag_lo(At[m]), frag_lo(Bt[n]), acc[ai][bj][m][n]); acc[ai][bj][m][n] = mma16<TR, F8 == 1>(frag_hi(At[m]), frag_hi(Bt[n]), acc[ai][bj][m][n]); } } \
        __builtin_amdgcn_s_setprio(0); } while (0)
#define GS_WAIT_V(n) asm volatile("s_waitcnt vmcnt(" #n ")" ::: "memory")
#define GS_WAIT_L(n) asm volatile("s_waitcnt lgkmcnt(" #n ")" ::: "memory")
#define GS_BAR __builtin_amdgcn_s_barrier()
#define GS_SCHED __builtin_amdgcn_sched_barrier(0)
    U cur, nxt; int ui = 0;
    if (!S.next(0, cur)) return;
    f32x4 acc[2][2][4][2];
#pragma unroll
    for (int a = 0; a < 2; ++a)
#pragma unroll
        for (int b = 0; b < 2; ++b)
#pragma unroll
            for (int m = 0; m < 4; ++m)
#pragma unroll
                for (int n = 0; n < 2; ++n) acc[a][b][m][n] = (f32x4){0.f, 0.f, 0.f, 0.f};
    bf16x16 At[4], B0[2], B1[2];
    const char* cA = uni(cur.A); const char* cB = uni(cur.B);
    GS_STAGEB(GS_SB(0, 0), cB, voffB); GS_STAGEB(GS_SB(0, 1), cB + hstepB, voffB); GS_STAGE(GS_SA(0, 0), cA, 0, 0); GS_STAGE(GS_SA(0, 1), cA, 0, 1);
    if (wr == 1) GS_BAR;
    GS_WAIT_V(2); GS_BAR;
    GS_STAGEB(GS_SB(1, 0), cB + kstep, voffB); GS_STAGE(GS_SA(1, 0), cA + kstep, 0, 0); GS_STAGEB(GS_SB(1, 1), cB + hstepB + kstep, voffB);
    GS_WAIT_V(6); GS_BAR;
    for (;;) {
        const bool has_next = S.next(ui + 1, nxt);
        const int nui = has_next ? ui + 1 : ui;
        const char* nA = uni(has_next ? nxt.A : cA); const char* nB = uni(has_next ? nxt.B : cB);
#pragma unroll 1
        for (int t = 0; t < nt; t += 2) {
            const bool last = (t == nt - 2);
            const char* a1 = uni(cA + (size_t)(t + 1) * kstep);
            const char* a2 = uni(last ? nA : cA + (size_t)(t + 2) * kstep); const char* b2 = uni(last ? nB : cB + (size_t)(t + 2) * kstep);
            const char* a3 = uni(a2 + kstep); const char* b3 = uni(b2 + kstep);
            const int u2 = last ? nui : ui;
            GS_LDB(B0, 0, 0); GS_LDB(B1, 0, 1); GS_SCHED; GS_LDA(At, 0, 0); GS_STAGE(GS_SA(1, 1), a1, ui, 1);
            GS_WAIT_V(8); GS_WAIT_L(0); GS_BAR; GS_MMA(0, 0, At, B0); GS_MMA(0, 1, At, B1); GS_BAR; GS_SCHED;
            GS_LDA(At, 0, 1); GS_STAGEB(GS_SB(0, 0), b2, voffB); GS_STAGEB(GS_SB(0, 1), b2 + hstepB, voffB); GS_STAGE(GS_SA(0, 0), a2, u2, 0);
            GS_WAIT_V(8); GS_WAIT_L(0); GS_BAR; GS_MMA(1, 0, At, B0); GS_MMA(1, 1, At, B1); GS_BAR; GS_SCHED;
            GS_LDB(B0, 1, 0); GS_LDB(B1, 1, 1); GS_SCHED; GS_LDA(At, 1, 0); GS_STAGE(GS_SA(0, 1), a2, u2, 1);
            GS_WAIT_V(8); GS_WAIT_L(0); GS_BAR; GS_MMA(0, 0, At, B0); GS_MMA(0, 1, At, B1); GS_BAR; GS_SCHED;
            GS_LDA(At, 1, 1); GS_STAGEB(GS_SB(1, 0), b3, voffB); GS_STAGEB(GS_SB(1, 1), b3 + hstepB, voffB); GS_STAGE(GS_SA(1, 0), a3, u2, 0);
            GS_WAIT_V(8); GS_WAIT_L(0); GS_BAR; GS_MMA(1, 0, At, B0); GS_MMA(1, 1, At, B1); GS_BAR; GS_SCHED;
        }
        if (wr == 0) GS_BAR;
        if (F8 == 2) asm volatile("s_nop 15\n\ts_nop 15\n\ts_nop 15\n\ts_nop 15\n\ts_nop 15\n\ts_nop 15" ::: "memory");
        E(acc, cur, wr, wc, fr, fq);
        if (!has_next) break;
#pragma unroll
        for (int a = 0; a < 2; ++a)
#pragma unroll
            for (int b = 0; b < 2; ++b)
#pragma unroll
                for (int m = 0; m < 4; ++m)
#pragma unroll
                    for (int n = 0; n < 2; ++n) acc[a][b][m][n] = (f32x4){0.f, 0.f, 0.f, 0.f};
        cur = nxt; cA = nA; cB = nB; ++ui;
        if (wr == 1) GS_BAR;
    }
    GS_WAIT_V(0);
    GS_BAR;
#undef GS_SA
#undef GS_SB
#undef GS_STAGE
#undef GS_STAGEB
#undef GS_LDA
#undef GS_LD32
#undef GS_LDB
#undef GS_MMA
#undef GS_WAIT_V
#undef GS_WAIT_L
#undef GS_BAR
#undef GS_SCHED
}
struct DenseU { const char* A; const char* B; int pm, pn; };
struct DenseSched {
    typedef DenseU U;
    const bf16_t* A; const bf16_t* Bt; int K, nunits, first, stride, npn, pn_base, pn_mod0, pn_mod1;
    DI int colmap(int q) const { return pn_base + (q / pn_mod0) * pn_mod1 + (q % pn_mod0); }
    DI bool next(int i, U& u) const {
        const int L = first + i * stride; if (L >= nunits) return false;
        u.pm = L / npn; u.pn = colmap(L % npn);
        u.A = (const char*)A + (size_t)u.pm * BM * K * 2; u.B = (const char*)Bt + (size_t)u.pn * BM * K * 2; return true;
    }
    DI unsigned a_voff(int, int h, int R, int C) const { return (unsigned)((HALF * h + R) * K + C) * 2u; }
};
}

DI void transpose_cvt(const float* W, bf16_t* Wt, int K, int N, int unit, char* lds) {
    float* tile = (float*)lds;
    const int nbn = N / 64, kb = unit / nbn, nb = unit % nbn, tid = tidx();
    __syncthreads();
#pragma unroll
    for (int i = 0; i < 8; ++i) { const int idx = tid + i * 512, r = idx >> 6, c = idx & 63; tile[r * 65 + c] = W[(size_t)(kb * 64 + r) * N + nb * 64 + c]; }
    __syncthreads();
#pragma unroll
    for (int i = 0; i < 8; ++i) { const int idx = tid + i * 512, n = idx >> 6, k = idx & 63; Wt[(size_t)(nb * 64 + n) * K + kb * 64 + k] = f2bf(tile[k * 65 + n]); }
}
struct P0Args { const float* x; const float* w_in; const float* w_out; const float* router_w; bf16_t* xb; bf16_t* wt_in; bf16_t* wt_out; bf16_t* wt_r;
                const float* w_gate; const float* w_up; const float* w_down; const float* ws_gate; const float* ws_up; const float* ws_down; unsigned char* wgut; unsigned char* wdt; };
constexpr int CV_GU = 257 * 2 * 16, CV_DN = 257 * 16;
struct CvItem { const float* src; unsigned char* dst; int ld, ldd, rbase, rhi; };
DI CvItem cv_item(const P0Args& a, int it) {
    CvItem c;
    if (it < CV_GU) {
        const int e = it / 32, u = (it >> 4) & 1, kt = it & 15;
        const float* W = e < N_EXP ? (u ? a.w_up : a.w_gate) + (size_t)e * D_MODEL * D_EXP : (u ? a.ws_up : a.ws_gate);
        c.src = W + (size_t)kt * 64 * D_EXP; c.ld = D_EXP; c.dst = a.wgut + (size_t)e * 512 * D_MODEL + kt * 64; c.ldd = D_MODEL; c.rbase = 128 * u; c.rhi = 256;
    } else {
        const int j = it - CV_GU, e = j / 16, kt = (j >> 2) & 3, nb = j & 3;
        const float* W = e < N_EXP ? a.w_down + (size_t)e * D_EXP * D_MODEL : a.ws_down;
        c.src = W + (size_t)kt * 64 * D_MODEL + nb * 256; c.ld = D_MODEL; c.dst = a.wdt + (size_t)e * D_MODEL * D_EXP + kt * 64; c.ldd = D_EXP; c.rbase = 256 * nb; c.rhi = 128;
    }
    return c;
}
constexpr int CV_TILE_BYTES = 64 * 260 * 4;
DI void cv_dma_nt(const char* sbase, unsigned voff, unsigned lds_dst) {
    unsigned keep;
    asm volatile("s_mov_b32 %0, m0\n\ts_mov_b32 m0, %3\n\ts_nop 0\n\tglobal_load_lds_dwordx4 %1, %2 nt\n\ts_mov_b32 m0, %0" : "=&s"(keep) : "v"(voff), "s"(sbase), "s"(lds_dst) : "memory");
}
DI const char* uni64(const void* p) { const unsigned long long v = (unsigned long long)p; const unsigned lo = __builtin_amdgcn_readfirstlane((unsigned)v), hi = __builtin_amdgcn_readfirstlane((unsigned)(v >> 32)); return (const char*)(((unsigned long long)hi << 32) | lo); }
DI void cv_issue(const CvItem& c, LAS unsigned char* tile) {
    const int tid = tidx(), w = __builtin_amdgcn_readfirstlane(tid >> 6), l = tid & 63;
    const char* sb = uni64(c.src); const unsigned tb = (unsigned)__builtin_amdgcn_readfirstlane((unsigned)(size_t)tile);
#pragma unroll
    for (int i = 0; i < 8; ++i) { const int k = 8 * w + i; cv_dma_nt(sb, (unsigned)(k * c.ld + 4 * (l ^ w)) * 4u, tb + (unsigned)(k * 1040)); }
}
DI void lds_barrier() { asm volatile("s_waitcnt lgkmcnt(0)" ::: "memory"); __builtin_amdgcn_s_barrier(); asm volatile("" ::: "memory"); }
DI void cv_emit(const CvItem& c, const char* lds) {
    const float* tile = (const float*)lds;
    const int tid = tidx();
#pragma unroll
    for (int i = 0; i < 4; ++i) {
        const int idx = tid + i * 512, kc = idx & 7, n = idx >> 3; const float* p = tile + (8 * kc) * 260 + (n ^ (4 * kc));
        const unsigned w0 = pack_fp8x4(p[0] * WSCALE, p[260] * WSCALE, p[2 * 260] * WSCALE, p[3 * 260] * WSCALE), w1 = pack_fp8x4(p[4 * 260] * WSCALE, p[5 * 260] * WSCALE, p[6 * 260] * WSCALE, p[7 * 260] * WSCALE);
        __builtin_nontemporal_store((u32x2){w0, w1}, (u32x2*)(c.dst + (size_t)(c.rbase + (n >> 7) * c.rhi + (n & 127)) * c.ldd + 8 * kc));
    }
}
DI void convert_moe_range(const P0Args& a, char* lds, const int lo, const int hi) {
    int it = lo + vblock(); if (it >= hi) return;
    __syncthreads();
    LAS unsigned char* t0 = (LAS unsigned char*)lds; LAS unsigned char* t1 = t0 + CV_TILE_BYTES;
    CvItem c = cv_item(a, it); cv_issue(c, t0);
    int pp = 0;
#pragma unroll 1
    for (;;) {
        const int nit = it + GRID; const bool more = nit < hi;
        CvItem cn = c;
        if (more) { cn = cv_item(a, nit); cv_issue(cn, pp ? t0 : t1); }
        if (more) asm volatile("s_waitcnt vmcnt(8)" ::: "memory"); else asm volatile("s_waitcnt vmcnt(0)" ::: "memory");
        lds_barrier();
        cv_emit(c, lds + (pp ? CV_TILE_BYTES : 0));
        lds_barrier();
        if (!more) break;
        it = nit; c = cn; pp ^= 1;
    }
    asm volatile("s_waitcnt vmcnt(0)" ::: "memory");
    __syncthreads();
}
DI void phase_prologue(const P0Args& a, char* lds) {
    const int vb = vblock();
    for (size_t i = (size_t)vb * NTHR + tidx(); i < (size_t)T_TOK * D_MODEL / 8; i += (size_t)GRID * NTHR) {
        const f32x4 v0 = *(const f32x4*)(a.x + i * 8), v1 = *(const f32x4*)(a.x + i * 8 + 4);
        u32x4 o; o.x = cvt_pk_bf16(v0[0], v0[1]); o.y = cvt_pk_bf16(v0[2], v0[3]); o.z = cvt_pk_bf16(v1[0], v1[1]); o.w = cvt_pk_bf16(v1[2], v1[3]);
        *(u32x4*)(a.xb + i * 8) = o;
    }
    const int n_in = (1024 / 64) * (3072 / 64), n_out = 16 * 16, n_r = 16 * 4;
    for (int u = vb; u < n_in + n_out + n_r; u += GRID) {
        if (u < n_in) transpose_cvt(a.w_in, a.wt_in, 1024, 3072, u, lds);
        else if (u < n_in + n_out) transpose_cvt(a.w_out, a.wt_out, 1024, 1024, u - n_in, lds);
        else transpose_cvt(a.router_w, a.wt_r, 1024, 256, u - n_in - n_out, lds);
    }
}


struct P1Args { const bf16_t* xb; const bf16_t* wt_in; bf16_t* Q; bf16_t* Kb; bf16_t* Vt; };
struct EpiQK { bf16_t* Q; bf16_t* Kb; static constexpr int MXS = 0x7F7F7F7F;
    DI void operator()(const f32x4 (&acc)[2][2][4][2], const gs::DenseU& u, int wr, int wc, int fr, int fq) const {
        const int seg = u.pn >> 1, type = seg % 3, grp = seg / 3; bf16_t* dst = type == 0 ? Q : Kb; const float sc = type == 0 ? QSCALE : 1.f;
#pragma unroll
        for (int ai = 0; ai < 2; ++ai)
#pragma unroll
            for (int m = 0; m < 4; ++m) {
                const int row = u.pm * 256 + 128 * ai + 64 * wr + 16 * m + fr, b = row / SEQ, s = row % SEQ;
#pragma unroll
                for (int bj = 0; bj < 2; ++bj) {
                    const int hh = grp * 8 + 4 * (u.pn & 1) + 2 * bj + (wc >> 1), d0 = 32 * (wc & 1) + 8 * fq;
                    const f32x4 v0 = acc[ai][bj][m][0] * sc, v1 = acc[ai][bj][m][1] * sc;
                    u32x4 o; o.x = cvt_pk_bf16(v0[0], v0[1]); o.y = cvt_pk_bf16(v0[2], v0[3]); o.z = cvt_pk_bf16(v1[0], v1[1]); o.w = cvt_pk_bf16(v1[2], v1[3]);
                    *(u32x4*)(dst + (size_t)(b * NHH + hh) * SEQ * 64 + (s >> 5) * 2048 + ((d0 >> 3) * 32 + (s & 31)) * 8) = o;
                }
            }
    } };
struct EpiV { bf16_t* Vt; static constexpr int MXS = 0x7F7F7F7F;
    DI void operator()(const f32x4 (&acc)[2][2][4][2], const gs::DenseU& u, int wr, int wc, int fr, int fq) const {
        const int grp = (u.pn >> 1) / 3;
#pragma unroll
        for (int ai = 0; ai < 2; ++ai)
#pragma unroll
            for (int m = 0; m < 4; ++m) {
                const int row = u.pm * 256 + 128 * ai + 64 * wr + 16 * m + 4 * fq, b = row / SEQ, s = row % SEQ;
#pragma unroll
                for (int bj = 0; bj < 2; ++bj)
#pragma unroll
                    for (int n = 0; n < 2; ++n) {
                        const int hh = grp * 8 + 4 * (u.pn & 1) + 2 * bj + (wc >> 1), d = 32 * (wc & 1) + 16 * n + fr;
                        const f32x4 v = acc[ai][bj][m][n];
                        u32x2 o; o.x = cvt_pk_bf16(v[0], v[1]); o.y = cvt_pk_bf16(v[2], v[3]);
                        { const int kap = s & 31; *(u32x2*)(Vt + (size_t)(b * NHH + hh) * SEQ * 64 + (s >> 5) * 2048 + ((((d >> 5) * 2 + (kap >> 4)) * 2 + ((kap >> 2) & 1)) * 32 + (d & 31)) * 8 + ((kap >> 3) & 1) * 4) = o; }
                    }
            }
    } };
DI void phase_qkv(const P1Args& a, LAS unsigned char* lds) {
    { gs::DenseSched S{a.xb, a.wt_in, D_MODEL, (T_TOK / 256) * 8, vblock(), GRID, 8, 0, 4, 6}; EpiQK E{a.Q, a.Kb}; gs::gemm_stream<true, true, 0>(lds, D_MODEL, S, E); }
    { gs::DenseSched S{a.xb, a.wt_in, D_MODEL, (T_TOK / 256) * 4, vblock(), GRID, 4, 4, 2, 6}; EpiV E{a.Vt}; gs::gemm_stream<false, false, 0>(lds, D_MODEL, S, E); }
}

struct P3Args { const bf16_t* y; const bf16_t* wt_out; const bf16_t* xb; bf16_t* r; float* stats; };
struct EpiOut { const bf16_t* xb; bf16_t* r; float* stats; static constexpr int MXS = 0x7F7F7F7F;
    DI void operator()(const f32x4 (&acc)[2][2][4][2], const gs::DenseU& u, int wr, int wc, int fr, int fq) const {
#pragma unroll
        for (int ai = 0; ai < 2; ++ai) {
            u32x4 xw[4][2];
#pragma unroll
            for (int m = 0; m < 4; ++m)
#pragma unroll
                for (int bj = 0; bj < 2; ++bj) xw[m][bj] = *(const u32x4*)(xb + (size_t)(u.pm * 256 + 128 * ai + 64 * wr + 16 * m + fr) * D_MODEL + u.pn * 256 + 128 * bj + 32 * wc + 8 * fq);
#pragma unroll
            for (int m = 0; m < 4; ++m) {
                const int row = u.pm * 256 + 128 * ai + 64 * wr + 16 * m + fr;
#pragma unroll
                for (int bj = 0; bj < 2; ++bj) {
                    const int col = u.pn * 256 + 128 * bj + 32 * wc + 8 * fq;
                    const u32x4 w = xw[m][bj];
                    const f32x4 x0 = (f32x4){__uint_as_float(w[0] << 16), __uint_as_float(w[0] & 0xffff0000u), __uint_as_float(w[1] << 16), __uint_as_float(w[1] & 0xffff0000u)};
                    const f32x4 x1 = (f32x4){__uint_as_float(w[2] << 16), __uint_as_float(w[2] & 0xffff0000u), __uint_as_float(w[3] << 16), __uint_as_float(w[3] & 0xffff0000u)};
                    const f32x4 v0 = x0 * DN_ALPHA + acc[ai][bj][m][0], v1 = x1 * DN_ALPHA + acc[ai][bj][m][1];
                    float s = ((v0[0] + v0[1]) + (v0[2] + v0[3])) + ((v1[0] + v1[1]) + (v1[2] + v1[3]));
                    float q = ((v0[0] * v0[0] + v0[1] * v0[1]) + (v0[2] * v0[2] + v0[3] * v0[3])) + ((v1[0] * v1[0] + v1[1] * v1[1]) + (v1[2] * v1[2] + v1[3] * v1[3]));
                    u32x4 o; o.x = cvt_pk_bf16(v0[0], v0[1]); o.y = cvt_pk_bf16(v0[2], v0[3]); o.z = cvt_pk_bf16(v1[0], v1[1]); o.w = cvt_pk_bf16(v1[2], v1[3]);
                    *(u32x4*)(r + (size_t)row * D_MODEL + col) = o;
                    s += __shfl_xor(s, 16); s += __shfl_xor(s, 32); q += __shfl_xor(q, 16); q += __shfl_xor(q, 32);
                    if (fq == 0) *(f32x2*)(stats + ((size_t)row * 32 + u.pn * 8 + bj * 4 + wc) * 2) = (f32x2){s, q};
                }
            }
        }
    } };
DI void phase_outproj(const P3Args& a, LAS unsigned char* lds) {
    gs::DenseSched S{a.y, a.wt_out, D_MODEL, (T_TOK / 256) * 4, vblock(), GRID, 4, 0, 4, 0}; EpiOut E{a.xb, a.r, a.stats}; gs::gemm_stream<true, true, 0>(lds, D_MODEL, S, E);
}

DI void unpack16(const u32x4& a, const u32x4& b, float (&v)[16]) {
#pragma unroll
    for (int j = 0; j < 4; ++j) { v[2 * j] = __uint_as_float(a[j] << 16); v[2 * j + 1] = __uint_as_float(a[j] & 0xffff0000u); v[8 + 2 * j] = __uint_as_float(b[j] << 16); v[8 + 2 * j + 1] = __uint_as_float(b[j] & 0xffff0000u); }
}
DI void dma16_plain(const char* sbase, unsigned voff, unsigned lds_dst) {
    unsigned keep;
    asm volatile("s_mov_b32 %0, m0\n\ts_mov_b32 m0, %3\n\ts_nop 0\n\tglobal_load_lds_dwordx4 %1, %2\n\ts_mov_b32 m0, %0" : "=&s"(keep) : "v"(voff), "s"(sbase), "s"(lds_dst) : "memory");
}
DI void router_gemm(char* lds, const bf16_t* A, const bf16_t* Bt, f32x4 (&acc)[4][4]) {
    constexpr int STAGE = 16384 + 32768, NK = D_MODEL / 64;
    const int tid = tidx(), wid = __builtin_amdgcn_readfirstlane(tid >> 6), lane = tid & 63, wr = wid >> 2, wc = wid & 3, fr = lane & 15, fq = lane >> 4;
#pragma unroll
    for (int m = 0; m < 4; ++m)
#pragma unroll
        for (int n = 0; n < 4; ++n) acc[m][n] = (f32x4){0.f, 0.f, 0.f, 0.f};
    int aoff[2], boff[2];
#pragma unroll
    for (int ks = 0; ks < 2; ++ks) { const int ch = (((4 * ks + fq) ^ (fr >> 1)) << 4); aoff[ks] = (64 * wr + fr) * 128 + ch; boff[ks] = 16384 + (64 * wc + fr) * 128 + ch; }
    unsigned voA[2], voB[4];
#pragma unroll
    for (int i = 0; i < 2; ++i) { const int row = 8 * (2 * wid + i) + (lane >> 3), kc = (lane & 7) ^ ((row >> 1) & 7); voA[i] = (unsigned)(row * D_MODEL + kc * 8) * 2u; }
#pragma unroll
    for (int i = 0; i < 4; ++i) { const int row = 8 * (4 * wid + i) + (lane >> 3), kc = (lane & 7) ^ ((row >> 1) & 7); voB[i] = (unsigned)(row * D_MODEL + kc * 8) * 2u; }
    const unsigned lb = (unsigned)__builtin_amdgcn_readfirstlane((unsigned)(size_t)(LAS unsigned char*)lds);
    const char* ab = uni64(A); const char* bb = uni64(Bt);
#define RG_ISSUE(kt) do { const unsigned sb_ = lb + (unsigned)(((kt) % 3) * STAGE); const char* a_ = ab + (size_t)(kt) * 128; const char* b_ = bb + (size_t)(kt) * 128; \
        _Pragma("unroll") for (int i_ = 0; i_ < 2; ++i_) dma16_plain(a_, voA[i_], sb_ + (unsigned)((2 * wid + i_) * 1024)); \
        _Pragma("unroll") for (int i_ = 0; i_ < 4; ++i_) dma16_plain(b_, voB[i_], sb_ + 16384u + (unsigned)((4 * wid + i_) * 1024)); } while (0)
    __syncthreads();
    RG_ISSUE(0); RG_ISSUE(1);
#pragma unroll 1
    for (int kt = 0; kt < NK; ++kt) {
        if (kt + 1 < NK) asm volatile("s_waitcnt vmcnt(6)" ::: "memory"); else asm volatile("s_waitcnt vmcnt(0)" ::: "memory");
        asm volatile("s_waitcnt lgkmcnt(0)" ::: "memory"); __builtin_amdgcn_s_barrier(); asm volatile("" ::: "memory");
        if (kt + 2 < NK) RG_ISSUE(kt + 2);
        const char* cur = lds + (kt % 3) * STAGE;
#pragma unroll
        for (int ks = 0; ks < 2; ++ks) {
            bf16x8 a[4], b[4];
#pragma unroll
            for (int m = 0; m < 4; ++m) a[m] = *(const bf16x8*)(cur + aoff[ks] + m * 2048);
#pragma unroll
            for (int n = 0; n < 4; ++n) b[n] = *(const bf16x8*)(cur + boff[ks] + n * 2048);
#pragma unroll
            for (int m = 0; m < 4; ++m)
#pragma unroll
                for (int n = 0; n < 4; ++n) acc[m][n] = __builtin_amdgcn_mfma_f32_16x16x32_bf16(b[n], a[m], acc[m][n], 0, 0, 0);
        }
    }
#undef RG_ISSUE
    __syncthreads();
}
constexpr int RS_SC = 289;
constexpr int LDS_HIST = 100 * 1024;
struct P4Args { const bf16_t* r; const float* stats; const float* ln_g; const float* ln_b; bf16_t* x1; unsigned char* x1f8; const bf16_t* wt_r; const float* rbias;
                int* eidx; float* gate; int* counts; int* tokl; float* gatel; int* slot; };
DI void phase_router(const P4Args& a, const P0Args& cv, char* lds) {
    const int tid = tidx(), wid = tid >> 6, lane = tid & 63, wr = wid >> 2, wc = wid & 3, fr = lane & 15, fq = lane >> 4;
    float* sc = (float*)lds; int* hist = (int*)(lds + LDS_HIST); int* base = hist + 256;
    for (int u = vblock(); u < T_TOK / 128; u += GRID) {
        const int m0 = u * 128;
        if ((vblock() & 1) == 0) convert_moe_range(cv, lds, CV_GU, CV_GU + CV_DN);
        __syncthreads();
#pragma unroll 1
        for (int i0 = 0; i0 < 16; i0 += 4) {
            f32x2 st[4]; u32x4 r0[4], r1[4];
#pragma unroll
            for (int j4 = 0; j4 < 4; ++j4) {
                const int t = m0 + wid * 16 + i0 + j4;
                st[j4] = (f32x2){0.f, 0.f};
                if (lane < 32) st[j4] = *(const f32x2*)(a.stats + ((size_t)t * 32 + lane) * 2);
                r0[j4] = *(const u32x4*)(a.r + (size_t)t * D_MODEL + lane * 16); r1[j4] = *(const u32x4*)(a.r + (size_t)t * D_MODEL + lane * 16 + 8);
            }
#pragma unroll
            for (int j4 = 0; j4 < 4; ++j4) {
                const int t = m0 + wid * 16 + i0 + j4;
                float s = st[j4].x, q = st[j4].y;
#pragma unroll
                for (int o = 1; o <= 16; o <<= 1) { s += __shfl_xor(s, o); q += __shfl_xor(q, o); }
                s = __shfl(s, 0); q = __shfl(q, 0);
                const float mu = s * (1.f / 1024.f), rstd = rsqrtf(q * (1.f / 1024.f) - mu * mu + LN_EPS);
                float v[16]; unpack16(r0[j4], r1[j4], v);
                u32x4 o0, o1, o8;
#pragma unroll
                for (int j = 0; j < 4; ++j) {
                    const f32x4 g = *(const f32x4*)(a.ln_g + lane * 16 + 4 * j), bb = *(const f32x4*)(a.ln_b + lane * 16 + 4 * j);
                    const float y0 = (v[4 * j] - mu) * rstd * g[0] + bb[0], y1 = (v[4 * j + 1] - mu) * rstd * g[1] + bb[1], y2 = (v[4 * j + 2] - mu) * rstd * g[2] + bb[2], y3 = (v[4 * j + 3] - mu) * rstd * g[3] + bb[3];
                    o8[j] = pack_fp8x4(y0 * XSCALE, y1 * XSCALE, y2 * XSCALE, y3 * XSCALE);
                    const unsigned p0 = cvt_pk_bf16(y0, y1), p1 = cvt_pk_bf16(y2, y3);
                    if (j < 2) { o0[2 * j] = p0; o0[2 * j + 1] = p1; } else { o1[2 * (j - 2)] = p0; o1[2 * (j - 2) + 1] = p1; }
                }
                *(u32x4*)(a.x1 + (size_t)t * D_MODEL + lane * 16) = o0; *(u32x4*)(a.x1 + (size_t)t * D_MODEL + lane * 16 + 8) = o1;
                *(u32x4*)(a.x1f8 + (size_t)t * D_MODEL + lane * 16) = o8;
            }
        }
        asm volatile("s_waitcnt vmcnt(0)" ::: "memory");
        __syncthreads();
        f32x4 acc[4][4];
        router_gemm(lds, a.x1 + (size_t)m0 * D_MODEL, a.wt_r, acc);
        if (tid < 256) hist[tid] = 0;
        int my_idx[2], my_rank[2]; float my_gate[2];
#pragma unroll
        for (int p = 0; p < 2; ++p) {
            __syncthreads();
            if (wr == p) {
#pragma unroll
                for (int m = 0; m < 4; ++m)
#pragma unroll
                    for (int n = 0; n < 4; ++n) {
                        const int c0 = 64 * wc + 16 * n + 4 * fq; const f32x4 rb = *(const f32x4*)(a.rbias + c0);
#pragma unroll
                        for (int j = 0; j < 4; ++j) { const int c = c0 + j; sc[(16 * m + fr) * RS_SC + (c >> 5) * 36 + (c & 31)] = 1.f / (1.f + __expf(-acc[m][n][j])) + rb[j]; }
                    }
            }
            __syncthreads();
            const int row = tid >> 3, g = tid & 7, t = m0 + 64 * p + row;
            float sel[32];
#pragma unroll
            for (int i = 0; i < 32; ++i) sel[i] = sc[row * RS_SC + g * 36 + i];
            float m1 = -INFINITY, m2 = -INFINITY;
#pragma unroll
            for (int i = 0; i < 32; ++i) { const float v = sel[i]; m2 = fmaxf(m2, fminf(m1, v)); m1 = fmaxf(m1, v); }
            const float gs = m1 + m2; int rank = 0;
#pragma unroll
            for (int d = 1; d < 8; ++d) { const float o = __shfl_xor(gs, d); const int og = g ^ d; rank += (o > gs || (o == gs && og < g)) ? 1 : 0; }
            const bool en = rank < TOPK_GROUPS;
            float lv = -INFINITY; int li = 1 << 20;
            if (en) {
#pragma unroll
                for (int i = 0; i < 32; ++i) { const float v = sel[i]; if (v > lv) { lv = v; li = g * 32 + i; } }
            }
            float myv = 0.f; int myi = 0;
#pragma unroll
            for (int k = 0; k < TOP_K; ++k) {
                float bv = lv; int bi = li;
#pragma unroll
                for (int d = 1; d < 8; d <<= 1) { const float ov = __shfl_xor(bv, d); const int oi = __shfl_xor(bi, d); if (ov > bv || (ov == bv && oi < bi)) { bv = ov; bi = oi; } }
                if (g == k) { myv = bv; myi = bi; }
                if (k + 1 < TOP_K && (bi >> 5) == g) {
                    lv = -INFINITY; li = 1 << 20;
#pragma unroll
                    for (int i = 0; i < 32; ++i) { if (g * 32 + i == bi) sel[i] = -INFINITY; const float v = sel[i]; if (v > lv) { lv = v; li = g * 32 + i; } }
                }
            }
            const float score = myv - a.rbias[myi];
            float gsum = score;
#pragma unroll
            for (int d = 1; d < 8; d <<= 1) gsum += __shfl_xor(gsum, d);
            const float gt = score / gsum * ROUTED_SCALE;
            a.eidx[t * TOP_K + g] = myi; a.gate[t * TOP_K + g] = gt;
            my_idx[p] = myi; my_gate[p] = gt; my_rank[p] = atomicAdd(&hist[myi], 1);
        }
        __syncthreads();
        if (tid < 256) { const int h = hist[tid]; base[tid] = h > 0 ? atomicAdd(&a.counts[tid * CSTR], h) : 0; }
        __syncthreads();
#pragma unroll
        for (int p = 0; p < 2; ++p) {
            const int row = tid >> 3, g = tid & 7, t = m0 + 64 * p + row, e = my_idx[p], pos = base[e] + my_rank[p];
            a.tokl[(size_t)e * CAP + pos] = t; a.gatel[(size_t)e * CAP + pos] = my_gate[p]; a.slot[t * TOP_K + g] = e * CAP + pos;
        }
        if ((vblock() & 1) == 1) convert_moe_range(cv, lds, CV_GU, CV_GU + CV_DN);
    }
}

constexpr int LDS_ROWTAB = 128 * 1024;
constexpr int LDS_GTAB = 139 * 1024;
constexpr int LDS_TAB = 150 * 1024;
constexpr int LDS_UTAB = 154 * 1024;
constexpr int MOE_BM = 256;
DI void build_moe_tab(const int* counts, char* lds) {
    int* tstart = (int*)(lds + LDS_TAB); int* rstart = tstart + 264; int* cnts = tstart + 528;
    const int tid = tidx(), lane = tid & 63;
    __syncthreads();
    if (tid < 64) {
        int c[4], tl[4], cs = 0, ts = 0;
#pragma unroll
        for (int i = 0; i < 4; ++i) { c[i] = counts[(lane * 4 + i) * CSTR]; tl[i] = (c[i] + MOE_BM - 1) / MOE_BM; cs += c[i]; ts += tl[i]; }
        int ci = cs, ti = ts;
#pragma unroll
        for (int o = 1; o < 64; o <<= 1) { const int n1 = __shfl_up(ci, o), n2 = __shfl_up(ti, o); if (lane >= o) { ci += n1; ti += n2; } }
        int ce = ci - cs, te = ti - ts;
#pragma unroll
        for (int i = 0; i < 4; ++i) { rstart[lane * 4 + i] = ce; tstart[lane * 4 + i] = te; cnts[lane * 4 + i] = c[i]; ce += c[i]; te += tl[i]; }
        if (lane == 63) { rstart[256] = ce; tstart[256] = te; cnts[256] = T_TOK; rstart[257] = ce + T_TOK; tstart[257] = te + T_TOK / MOE_BM; }
    }
    __syncthreads();
}
DI int find_expert(const int* tstart, int g) {
    int lo = 0, hi = 256;
#pragma unroll 1
    while (lo < hi) { const int mid = (lo + hi + 1) >> 1; if (tstart[mid] <= g) lo = mid; else hi = mid - 1; }
    return lo;
}
struct MoeU { const char* A; const char* B; int e, m0, sub, ui; };
typedef const LAS int* ltab_t;
DI int find_expert_l(ltab_t tstart, int g) { int lo = 0, hi = 256;
#pragma unroll 1
    while (lo < hi) { const int mid = (lo + hi + 1) >> 1; if (tstart[mid] <= g) lo = mid; else hi = mid - 1; }
    return lo; }

struct P6Args { const unsigned char* x1; const int* counts; const int* tokl; const float* gatel; const unsigned char* wgut; unsigned char* H; };
struct GuSched {
    typedef MoeU U;
    ltab_t tab; const LAS int* rowtab; const LAS int* utab; const unsigned char* x1; const unsigned char* wgut; int first, stride, nunits;
    DI bool next(int i, U& u) const {
        const int L = first + i * stride; if (L >= nunits) return false;
        const int g = L >> 1, e = utab[i];
        u.sub = L & 1; u.e = e; u.ui = i; u.m0 = (g - tab[e]) * MOE_BM;
        u.A = (const char*)x1; u.B = (const char*)(wgut + ((size_t)e * 512 + 256 * u.sub) * D_MODEL); return true;
    }
    DI unsigned a_voff(int i, int h, int R, int C) const { return (unsigned)(rowtab[i * 256 + 128 * h + R] * (D_MODEL / 2) + C) * 2u; }
};
struct EpiGU { unsigned char* H; const LAS float* gtab; ltab_t tab; static constexpr int MXS = 0x7A7A7A7A;
    DI void operator()(const f32x4 (&acc)[2][2][4][2], const MoeU& u, int wr, int wc, int fr, int fq) const {
        const int st = tab[264 + u.e], cnt = tab[528 + u.e];
#pragma unroll
        for (int ai = 0; ai < 2; ++ai)
#pragma unroll
            for (int m = 0; m < 4; ++m) {
                const int row = u.m0 + 128 * ai + 64 * wr + 16 * m + fr;
                if (row < cnt) {
                    const float gt = gtab[u.ui * 256 + 128 * ai + 64 * wr + 16 * m + fr] * HSCALE;
                    float h[8];
#pragma unroll
                    for (int n = 0; n < 2; ++n)
#pragma unroll
                        for (int j = 0; j < 4; ++j) { const float gv = acc[ai][0][m][n][j]; h[4 * n + j] = gv * __builtin_amdgcn_rcpf(1.f + __expf(-gv)) * acc[ai][1][m][n][j] * gt; }
                    *(u32x2*)(H + (size_t)(st + row) * D_EXP + 128 * u.sub + 32 * wc + 8 * fq) = (u32x2){pack_fp8x4(h[0], h[1], h[2], h[3]), pack_fp8x4(h[4], h[5], h[6], h[7])};
                }
            }
    } };
DI void phase_moe_gu(const P6Args& a, char* smem, LAS unsigned char* lds) {
    build_moe_tab(a.counts, smem);
    const int* tstart = (const int*)(smem + LDS_TAB); const int* rstart = tstart + 264; int* rowtab = (int*)(smem + LDS_ROWTAB); float* gtab = (float*)(smem + LDS_GTAB);
    const int nunits = tstart[257] * 2, first = vblock();
    const int n_my = first < nunits ? (nunits - first + GRID - 1) / GRID : 0;
    for (int idx = tidx(); idx < n_my * 256; idx += NTHR) {
        const int i = idx >> 8, row = idx & 255, L = first + i * GRID, g = L >> 1, e = find_expert(tstart, g), m0 = (g - tstart[e]) * MOE_BM, cnt = tstart[528 + e];
        int rr = m0 + row; rr = rr < cnt ? rr : cnt - 1;
        rowtab[idx] = e < N_EXP ? a.tokl[(size_t)e * CAP + rr] : rr;
        gtab[idx] = e < N_EXP ? a.gatel[(size_t)e * CAP + rr] : 1.f;
    }
    if (tidx() < 32 && tidx() < n_my) ((int*)(smem + LDS_UTAB))[tidx()] = find_expert(tstart, (first + tidx() * GRID) >> 1);
    __syncthreads();
    GuSched S{(ltab_t)(lds + LDS_TAB), (const LAS int*)(lds + LDS_ROWTAB), (const LAS int*)(lds + LDS_UTAB), a.x1, a.wgut, first, GRID, nunits}; EpiGU E{a.H, (const LAS float*)(lds + LDS_GTAB), (ltab_t)(lds + LDS_TAB)};
    gs::gemm_stream<true, true, 2>(lds, D_MODEL / 2, S, E);
}
struct P7Args { const unsigned char* H; const int* counts; const unsigned char* wdt; unsigned char* Y; };
struct DownSched {
    typedef MoeU U;
    ltab_t tab; const LAS int* utab; const unsigned char* H; const unsigned char* wdt; int first, stride, nunits;
    DI bool next(int i, U& u) const {
        const int L = first + i * stride; if (L >= nunits) return false;
        const int g = L >> 2, e = utab[i];
        u.sub = L & 3; u.e = e; u.ui = i; u.m0 = (g - tab[e]) * MOE_BM;
        u.A = (const char*)(H + (size_t)(tab[264 + e] + u.m0) * D_EXP); u.B = (const char*)(wdt + ((size_t)e * D_MODEL + 256 * u.sub) * D_EXP); return true;
    }
    DI unsigned a_voff(int, int h, int R, int C) const { return (unsigned)((128 * h + R) * (D_EXP / 2) + C) * 2u; }
};
struct EpiDown { unsigned char* Y; ltab_t tab; static constexpr int MXS = 0x7D7D7D7D;
    DI void operator()(const f32x4 (&acc)[2][2][4][2], const MoeU& u, int wr, int wc, int fr, int fq) const {
        const int st = tab[264 + u.e], cnt = tab[528 + u.e];
#pragma unroll
        for (int ai = 0; ai < 2; ++ai)
#pragma unroll
            for (int m = 0; m < 4; ++m) {
                const int row = u.m0 + 128 * ai + 64 * wr + 16 * m + fr;
                if (row < cnt) {
                    u32x4 o;
#pragma unroll
                    for (int bj = 0; bj < 2; ++bj) {
                        const f32x4 v0 = acc[ai][bj][m][0], v1 = acc[ai][bj][m][1];
                        o[2 * bj] = pack_fp8x4(v0[0], v0[1], v0[2], v0[3]); o[2 * bj + 1] = pack_fp8x4(v1[0], v1[1], v1[2], v1[3]);
                    }
                    __builtin_nontemporal_store(o, (u32x4*)(Y + (size_t)(st + row) * D_MODEL + 256 * u.sub + 64 * wc + 16 * fq));
                }
            }
    } };
DI void phase_moe_down(const P7Args& a, char* smem, LAS unsigned char* lds) {
    const int* tstart = (const int*)(smem + LDS_TAB); const int* rstart = tstart + 264;
    { const int nun = tstart[257] * 4, i = tidx(); if (i < 32 && vblock() + i * GRID < nun) ((int*)(smem + LDS_UTAB))[i] = find_expert(tstart, (vblock() + i * GRID) >> 2); }
    __syncthreads();
    DownSched S{(ltab_t)(lds + LDS_TAB), (const LAS int*)(lds + LDS_UTAB), a.H, a.wdt, vblock(), GRID, tstart[257] * 4}; EpiDown E{a.Y, (ltab_t)(lds + LDS_TAB)};
    gs::gemm_stream<true, true, 2>(lds, D_EXP / 2, S, E);
}
struct P8Args { const bf16_t* x1; const unsigned char* Y; const int* slot; const int* counts; const float* ln_g; const float* ln_b; float* out; };
DI void phase_combine(const P8Args& a, char* lds) {
    const int tid = tidx(), wid = tid >> 6, lane = tid & 63;
    const int* rstart = (const int*)(lds + LDS_TAB) + 264;
    const int sh0 = rstart[256];
    const int c0 = 256 * (lane >> 4) + 32 * ((lane >> 2) & 3) + 8 * (lane & 3);
    for (int t = vblock() * 8 + wid; t < T_TOK; t += GRID * 8) {
        float v[16], w[16];
        { const u32x4 p0 = *(const u32x4*)(a.x1 + (size_t)t * D_MODEL + c0), p1 = *(const u32x4*)(a.x1 + (size_t)t * D_MODEL + c0 + 128); unpack16(p0, p1, v); }
        int sl = 0; if (lane < TOP_K) sl = a.slot[t * TOP_K + lane];
        u32x4 yr[9];
        yr[8] = *(const u32x4*)(a.Y + (size_t)(sh0 + t) * D_MODEL + lane * 16);
#pragma unroll
        for (int k = 0; k < TOP_K; ++k) { const int s = __shfl(sl, k), e = s / CAP, pos = s % CAP; yr[k] = *(const u32x4*)(a.Y + (size_t)(rstart[e] + pos) * D_MODEL + lane * 16); }
#pragma unroll
        for (int i = 0; i < 16; ++i) w[i] = 0.f;
#pragma unroll
        for (int k = 0; k < 9; ++k)
#pragma unroll
            for (int j = 0; j < 4; ++j) { const f32x2 lo = __builtin_amdgcn_cvt_pk_f32_fp8((int)yr[k][j], false), hi = __builtin_amdgcn_cvt_pk_f32_fp8((int)yr[k][j], true); w[4 * j] += lo.x; w[4 * j + 1] += lo.y; w[4 * j + 2] += hi.x; w[4 * j + 3] += hi.y; }
#pragma unroll
        for (int i = 0; i < 16; ++i) v[i] = v[i] * DN_ALPHA + w[i] * (1.f / YSCALE);
        float s = 0.f;
#pragma unroll
        for (int i = 0; i < 16; ++i) s += v[i];
#pragma unroll
        for (int o = 32; o >= 1; o >>= 1) s += __shfl_xor(s, o);
        const float mu = s * (1.f / 1024.f);
        float q = 0.f;
#pragma unroll
        for (int i = 0; i < 16; ++i) { const float d = v[i] - mu; q += d * d; }
#pragma unroll
        for (int o = 32; o >= 1; o >>= 1) q += __shfl_xor(q, o);
        const float rstd = rsqrtf(q * (1.f / 1024.f) + LN_EPS);
#pragma unroll
        for (int j = 0; j < 4; ++j) {
            const int col = c0 + 128 * (j >> 1) + 4 * (j & 1);
            const f32x4 g = *(const f32x4*)(a.ln_g + col), bb = *(const f32x4*)(a.ln_b + col);
            f32x4 o; o[0] = (v[4 * j] - mu) * rstd * g[0] + bb[0]; o[1] = (v[4 * j + 1] - mu) * rstd * g[1] + bb[1]; o[2] = (v[4 * j + 2] - mu) * rstd * g[2] + bb[2]; o[3] = (v[4 * j + 3] - mu) * rstd * g[3] + bb[3];
            *(f32x4*)(a.out + (size_t)t * D_MODEL + col) = o;
        }
    }
}
#define MFMA32(a, b, c) __builtin_amdgcn_mfma_f32_32x32x16_bf16((a), (b), (c), 0, 0, 0)
constexpr float SB_EXIT_THR = 1e-30f;
struct P2Args { const bf16_t* Q; const bf16_t* Kb; const bf16_t* Vt; const float* rel_bias; const float* gain_a; const float* gain_b; bf16_t* y; };

DI bf16x8 pack8(const f32x16& x, int s) {
    u32x4 p;
    if (s == 0) { p.x = cvt_pk_bf16(x[0], x[1]); p.y = cvt_pk_bf16(x[2], x[3]); p.z = cvt_pk_bf16(x[4], x[5]); p.w = cvt_pk_bf16(x[6], x[7]); }
    else        { p.x = cvt_pk_bf16(x[8], x[9]); p.y = cvt_pk_bf16(x[10], x[11]); p.z = cvt_pk_bf16(x[12], x[13]); p.w = cvt_pk_bf16(x[14], x[15]); }
    return __builtin_bit_cast(bf16x8, p);
}
DI void load_k(bf16x8 (&k)[4], const bf16_t* kp, int k0) {
#pragma unroll
    for (int kk = 0; kk < 4; ++kk) k[kk] = *(const bf16x8*)(kp + (size_t)(k0 >> 5) * 2048 + kk * 512);
}
DI void load_v(bf16x8 (&v)[2][2], const bf16_t* vp, int k0) {
#pragma unroll
    for (int dt = 0; dt < 2; ++dt)
#pragma unroll
        for (int s = 0; s < 2; ++s) v[dt][s] = *(const bf16x8*)(vp + (size_t)(k0 >> 5) * 2048 + (dt * 2 + s) * 512);
}

constexpr int LDS_CVT = 16 * 1024;
DI void phase_attn(const P2Args& a, const P0Args& cv, char* lds) {
    const int tid = tidx(), wid = tid >> 6, lane = tid & 63, r = lane & 31, h = lane >> 5;
    float* tbl = (float*)lds;
    float* ssq = (float*)(lds + 8 * 260 * 4);
    __syncthreads();
    for (int i = tid; i < NHA * 257; i += NTHR) { const int hd = i / 257, j = i % 257; tbl[hd * 260 + j] = a.rel_bias[i] * LOG2E; }
    __syncthreads();
    const int cgrp = vblock() % 2;
#pragma unroll 1
    for (int slot = 0; slot < 5; ++slot) {
        if ((cgrp == 0 && slot == 0) || (cgrp == 1 && slot == 4)) convert_moe_range(cv, lds + LDS_CVT, 0, CV_GU);
        if (slot == 4) break;
        const int u = vblock() + GRID * (slot >> 1) + 2 * GRID * (slot & 1);
        const bool isB = u >= BATCH * (SEQ / 64); const int uu = isB ? u - BATCH * (SEQ / 64) : u;
        const int b = uu / (SEQ / 64), c = uu % (SEQ / 64), q0 = c * 64, hh = (isB ? NHA : 0) + wid;
        const size_t hb = (size_t)(b * NHH + hh) * SEQ * 64;
        const bf16_t* kp = a.Kb + hb + lane * 8;
        const bf16_t* vp = a.Vt + hb + lane * 8;
        bf16x8 qf[2][4];
#pragma unroll
        for (int qt = 0; qt < 2; ++qt)
#pragma unroll
            for (int kk = 0; kk < 4; ++kk) qf[qt][kk] = *(const bf16x8*)(a.Q + hb + (size_t)((q0 >> 5) + qt) * 2048 + kk * 512 + lane * 8);
        f32x16 ot[2][2];
#pragma unroll
        for (int dt = 0; dt < 2; ++dt)
#pragma unroll
            for (int qt = 0; qt < 2; ++qt)
#pragma unroll
                for (int i = 0; i < 16; ++i) ot[dt][qt][i] = 0.f;
        float linv[2] = {1.f, 1.f};
        if (!isB) {
            float mrun[2] = {-INFINITY, -INFINITY}, lrun[2] = {0.f, 0.f};
            const int klo = q0 - LEFT_CHUNKS * CHUNK < 0 ? 0 : q0 - LEFT_CHUNKS * CHUNK, khi = q0 + 64;
            const float cfar = tbl[wid * 260 + 256];
            bf16x8 kc[4], kn[4], vf[2][2]; load_k(kc, kp, klo);
            for (int k0 = klo; k0 < khi; k0 += 32) {
                load_v(vf, vp, k0);
                load_k(kn, kp, k0 + 32 < khi ? k0 + 32 : k0);
#pragma unroll
                for (int qt = 0; qt < 2; ++qt) {
                    bf16x8 pf[2];
                    f32x16 st;
#pragma unroll
                    for (int i = 0; i < 16; ++i) st[i] = 0.f;
#pragma unroll
                    for (int kk = 0; kk < 4; ++kk) st = MFMA32(kc[kk], qf[qt][kk], st);
                    const int dmin = q0 + 32 * qt - k0 - 31;
                    float boff = 0.f;
                    if (dmin >= MAX_REL) boff = cfar;
                    else {
                        const int bidx = q0 + 32 * qt + r - k0 - 4 * h + MAX_REL;
#pragma unroll
                        for (int i = 0; i < 16; ++i) { int ix = bidx - ((i & 3) + 8 * (i >> 2)); ix = ix < 0 ? 0 : (ix > 2 * MAX_REL ? 2 * MAX_REL : ix); st[i] += tbl[wid * 260 + ix]; }
                    }
                    float mx = st[0];
#pragma unroll
                    for (int i = 1; i < 16; ++i) mx = fmaxf(mx, st[i]);
                    mx = fmaxf(mx, __shfl_xor(mx, 32)) + boff;
                    const float mo = mrun[qt], mn = fmaxf(mo, mx);
                    mrun[qt] = mn;
                    const float eo = boff - mn;
                    float ps = 0.f;
#pragma unroll
                    for (int i = 0; i < 16; ++i) { st[i] = __builtin_amdgcn_exp2f(st[i] + eo); ps += st[i]; }
                    if (__all(mn == mo)) lrun[qt] += ps;
                    else {
                        const float alpha = __builtin_amdgcn_exp2f(mo - mn);
                        lrun[qt] = lrun[qt] * alpha + ps;
#pragma unroll
                        for (int i = 0; i < 16; ++i) { ot[0][qt][i] *= alpha; ot[1][qt][i] *= alpha; }
                    }
                    pf[0] = pack8(st, 0); pf[1] = pack8(st, 1);
#pragma unroll
                    for (int dt = 0; dt < 2; ++dt)
#pragma unroll
                        for (int s = 0; s < 2; ++s) ot[dt][qt] = MFMA32(vf[dt][s], pf[s], ot[dt][qt]);
                }
#pragma unroll
                for (int kk = 0; kk < 4; ++kk) kc[kk] = kn[kk];
            }
#pragma unroll
            for (int qt = 0; qt < 2; ++qt) { const float lt = lrun[qt] + __shfl_xor(lrun[qt], 32); linv[qt] = 1.f / lt; }
        } else {
            float carry[2] = {1.f, 1.f};
            bf16x8 kc[4], kn[4], vf[2][2]; load_k(kc, kp, q0 + 32);
            for (int k0 = q0 + 32; k0 >= 0; k0 -= 32) {
                load_v(vf, vp, k0);
                load_k(kn, kp, k0 >= 32 ? k0 - 32 : k0);
#pragma unroll
                for (int qt = 0; qt < 2; ++qt) {
                    bf16x8 pf[2];
                    f32x16 st;
#pragma unroll
                    for (int i = 0; i < 16; ++i) st[i] = 0.f;
                    const bool none = (k0 > q0 + 32 * qt + 30);
                    if (!none) {
#pragma unroll
                        for (int kk = 0; kk < 4; ++kk) st = MFMA32(kc[kk], qf[qt][kk], st);
                        const bool full = (k0 + 31 < q0 + 32 * qt);
                        const int lim = q0 + 32 * qt + r - k0 - 4 * h;
                        float om[16];
#pragma unroll
                        for (int i = 0; i < 16; ++i) {
                            const float e = __builtin_amdgcn_exp2f(-st[i]); float bta = __builtin_amdgcn_rcpf(1.f + e);
                            if (!full && !(((i & 3) + 8 * (i >> 2)) < lim)) bta = 0.f;
                            st[i] = bta; om[i] = 1.f - bta;
                        }
                        float G[4], Go[4];
#pragma unroll
                        for (int g = 0; g < 4; ++g) { G[g] = (om[4 * g] * om[4 * g + 1]) * (om[4 * g + 2] * om[4 * g + 3]); Go[g] = __shfl_xor(G[g], 32); }
                        float R = carry[qt];
#pragma unroll
                        for (int g = 3; g >= 0; --g) {
                            float run = h == 0 ? R * Go[g] : R;
#pragma unroll
                            for (int uu2 = 3; uu2 >= 0; --uu2) { const float bta = st[4 * g + uu2]; st[4 * g + uu2] = bta * run; run *= om[4 * g + uu2]; }
                            R = R * (G[g] * Go[g]);
                        }
                        carry[qt] = R;
                    }
                    if (!none) {
                        pf[0] = pack8(st, 0); pf[1] = pack8(st, 1);
#pragma unroll
                        for (int dt = 0; dt < 2; ++dt)
#pragma unroll
                            for (int s = 0; s < 2; ++s) ot[dt][qt] = MFMA32(vf[dt][s], pf[s], ot[dt][qt]);
                    }
                }
#pragma unroll
                for (int kk = 0; kk < 4; ++kk) kc[kk] = kn[kk];
                if (__all(carry[0] < SB_EXIT_THR && carry[1] < SB_EXIT_THR)) break;
            }
        }
        float ss[2];
#pragma unroll
        for (int qt = 0; qt < 2; ++qt) {
            float s2 = 0.f;
#pragma unroll
            for (int dt = 0; dt < 2; ++dt)
#pragma unroll
                for (int i = 0; i < 16; ++i) { ot[dt][qt][i] *= linv[qt]; s2 += ot[dt][qt][i] * ot[dt][qt][i]; }
            s2 += __shfl_xor(s2, 32); ss[qt] = s2;
        }
        __syncthreads();
        if (h == 0) { ssq[wid * 64 + r] = ss[0]; ssq[wid * 64 + 32 + r] = ss[1]; }
        __syncthreads();
        const float* gain = isB ? a.gain_b : a.gain_a;
#pragma unroll
        for (int qt = 0; qt < 2; ++qt) {
            float tot = 0.f;
#pragma unroll
            for (int w8 = 0; w8 < 8; ++w8) tot += ssq[w8 * 64 + 32 * qt + r];
            const float rs = rsqrtf(tot * (1.f / 512.f) + RMS_EPS);
            char* yst = lds + LDS_CVT + wid * (64 * 136);
#pragma unroll
            for (int dt = 0; dt < 2; ++dt)
#pragma unroll
                for (int g = 0; g < 4; ++g) {
                    const int d = 32 * dt + 8 * g + 4 * h; const f32x4 gn = *(const f32x4*)(gain + wid * 64 + d);
                    u32x2 o; o.x = cvt_pk_bf16(ot[dt][qt][4 * g] * rs * gn[0], ot[dt][qt][4 * g + 1] * rs * gn[1]); o.y = cvt_pk_bf16(ot[dt][qt][4 * g + 2] * rs * gn[2], ot[dt][qt][4 * g + 3] * rs * gn[3]);
                    *(u32x2*)(yst + (32 * qt + r) * 136 + d * 2) = o;
                }
        }
        {
            char* yst = lds + LDS_CVT + wid * (64 * 136);
            bf16_t* yb = a.y + (size_t)(b * SEQ + q0) * D_MODEL + (isB ? 512 : 0) + wid * 64;
#pragma unroll
            for (int j = 0; j < 8; ++j) {
                const int tok = (lane >> 3) + 8 * j, ch = lane & 7;
                const u32x2 lo = *(const u32x2*)(yst + tok * 136 + ch * 16), hi = *(const u32x2*)(yst + tok * 136 + ch * 16 + 8);
                *(u32x4*)(yb + (size_t)tok * D_MODEL + ch * 8) = (u32x4){lo.x, lo.y, hi.x, hi.y};
            }
        }
    }
}


#define XB_TMO      128
#define XB_XCNT(j)  (256  + 64 * (j))
#define XB_XSUB(j)  (1280 + 64 * (j))
#define XB_XGEN(j)  (2304 + 64 * (j))
#define XB_TOP      3328
#define XB_TOPGEN   3392
#define XCD_BAR_WORDS 3456
#define XB_SPIN_CAP (1u << 18)
#define LAS __attribute__((address_space(3)))

__device__ __forceinline__ unsigned xb_ld(unsigned* p)              { return __hip_atomic_load(p, __ATOMIC_RELAXED, __HIP_MEMORY_SCOPE_AGENT); }
__device__ __forceinline__ unsigned xb_add(unsigned* p, unsigned v) { return __hip_atomic_fetch_add(p, v, __ATOMIC_RELAXED, __HIP_MEMORY_SCOPE_AGENT); }
__device__ __forceinline__ unsigned xb_xcc_id() { return (unsigned)__builtin_amdgcn_s_getreg((3 << 11) | 20) & 0xFu; }
#define XB_SPIN(cond, bar) do { unsigned _sp = 0; while (cond) { __builtin_amdgcn_s_sleep(1); \
    if ((++_sp & 255u) == 0u) { if (xb_ld(&(bar)[XB_TMO])) break; if (_sp > XB_SPIN_CAP) { atomicAdd(&(bar)[XB_TMO], 1u); break; } } } } while (0)

struct XcdBarrier {
    unsigned* bar; unsigned x;
    volatile LAS unsigned* st;
};

__device__ __forceinline__ XcdBarrier xcd_barrier_post(unsigned* bar, volatile LAS unsigned* st) {
    XcdBarrier b; b.bar = bar; b.x = xb_xcc_id(); b.st = st;
    if (threadIdx.x == 0) (void)xb_add(&bar[XB_XCNT(b.x)], 1u);
    return b;
}
__device__ __forceinline__ void xcd_barrier_complete(unsigned* bar, unsigned x, unsigned& nloc, unsigned& nx) {
    const unsigned G = gridDim.x * gridDim.y * gridDim.z;
    unsigned sum, cnt, mine, sp = 0u;
    for (;;) {
        sum = 0u; cnt = 0u; mine = 0u;
#pragma unroll
        for (unsigned j = 0; j < 16; ++j) { const unsigned c = xb_ld(&bar[XB_XCNT(j)]); sum += c; cnt += (c > 0u) ? 1u : 0u; mine = (j == x) ? c : mine; }
        if (sum == G) break;
        __builtin_amdgcn_s_sleep(1);
        if ((++sp & 255u) == 0u) { if (xb_ld(&bar[XB_TMO])) break; if (sp > XB_SPIN_CAP) { atomicAdd(&bar[XB_TMO], 1u); break; } }
    }
    nloc = mine > 0u ? mine : 1u; nx = cnt > 0u ? cnt : 1u;
}

__device__ __forceinline__ void xcd_barrier(const XcdBarrier& b) {
    asm volatile("s_waitcnt vmcnt(0)" ::: "memory");
    __syncthreads();
    if (threadIdx.x == 0) {
        unsigned* bar = b.bar;
        __builtin_amdgcn_s_waitcnt(0);
        unsigned nloc = b.st[0], nx = b.st[1];
        if (nloc == 0u) { xcd_barrier_complete(bar, b.x, nloc, nx); b.st[0] = nloc; b.st[1] = nx; }
        const unsigned old = xb_add(&bar[XB_XSUB(b.x)], 1u);
        const unsigned gen = old / nloc;
        if (old + 1u == (gen + 1u) * nloc) {
            __builtin_amdgcn_fence(__ATOMIC_RELEASE, "agent");
            asm volatile("s_waitcnt vmcnt(0)" ::: "memory");
            const unsigned og = xb_add(&bar[XB_TOP], 1u);
            const unsigned tg = og / nx;
            if (og + 1u == (tg + 1u) * nx) xb_add(&bar[XB_TOPGEN], 1u);
            else XB_SPIN(xb_ld(&bar[XB_TOPGEN]) == tg, bar);
            __builtin_amdgcn_fence(__ATOMIC_ACQUIRE, "agent");
            xb_add(&bar[XB_XGEN(b.x)], 1u);
            asm volatile("s_waitcnt vmcnt(0)" ::: "memory");
        } else {
            XB_SPIN(xb_ld(&bar[XB_XGEN(b.x)]) == gen, bar);
            __builtin_amdgcn_fence(__ATOMIC_ACQUIRE, "agent");
            asm volatile("s_waitcnt vmcnt(0)" ::: "memory");
        }
    }
    __syncthreads();
}


struct MegaArgs { P0Args p0; P1Args p1; P2Args p2; P3Args p3; P4Args p4; P6Args p6; P7Args p7; P8Args p8; unsigned* bar; };
__global__ __launch_bounds__(NTHR, 2) void k_mega(MegaArgs a) {
    extern __shared__ __attribute__((aligned(16))) char smem[];
    asm volatile("s_setreg_imm32_b32 hwreg(HW_REG_MODE, 23, 1), 1");
    volatile LAS unsigned* xbw = (volatile LAS unsigned*)(smem + LDS_BYTES - 16);
    if (threadIdx.x == 0) { xbw[0] = 0u; xbw[1] = 0u; xbw[2] = 0u; xbw[3] = 0u; }
    __syncthreads();
    XcdBarrier bar = xcd_barrier_post(a.bar, xbw);
    LAS unsigned char* L = (LAS unsigned char*)smem;
    phase_prologue(a.p0, smem);     xcd_barrier(bar);
    phase_qkv(a.p1, L);             xcd_barrier(bar);
    phase_attn(a.p2, a.p0, smem);   xcd_barrier(bar);
    phase_outproj(a.p3, L);         xcd_barrier(bar);
    phase_router(a.p4, a.p0, smem); xcd_barrier(bar);
    phase_moe_gu(a.p6, smem, L);    xcd_barrier(bar);
    phase_moe_down(a.p7, smem, L);  xcd_barrier(bar);
    phase_combine(a.p8, smem);
}

extern "C" void kernel_launch(void* const* d_in, const int* in_sizes, int n_in, void* d_out, int out_size, void* d_ws, size_t ws_size, hipStream_t stream) {
    const float* x = (const float*)d_in[0];      const float* w_in = (const float*)d_in[1];   const float* rel_bias = (const float*)d_in[2];
    const float* gain_a = (const float*)d_in[3]; const float* gain_b = (const float*)d_in[4]; const float* w_out = (const float*)d_in[5];
    const float* ln1_g = (const float*)d_in[6];  const float* ln1_b = (const float*)d_in[7];  const float* router_w = (const float*)d_in[8];
    const float* router_bias = (const float*)d_in[9]; const float* w_gate = (const float*)d_in[10]; const float* w_up = (const float*)d_in[11];
    const float* w_down = (const float*)d_in[12]; const float* ws_gate = (const float*)d_in[13]; const float* ws_up = (const float*)d_in[14];
    const float* ws_down = (const float*)d_in[15]; const float* ln2_g = (const float*)d_in[16]; const float* ln2_b = (const float*)d_in[17];
    char* ws = (char*)d_ws; float* out = (float*)d_out;
    int* ctrl = (int*)(ws + OFF_CTRL); int* counts = ctrl + CW_COUNTS;
    bf16_t* X1 = (bf16_t*)(ws + OFF_X1); int* tokl = (int*)(ws + OFF_TOKL); float* gatel = (float*)(ws + OFF_GATEL);
    int* eidx = (int*)(ws + OFF_EIDX); float* gate = (float*)(ws + OFF_GATE); int* slot = (int*)(ws + OFF_SLOT);
    unsigned char* H = (unsigned char*)(ws + OFF_H); unsigned char* Y = (unsigned char*)(ws + OFF_Y); unsigned char* x1f8 = (unsigned char*)(ws + OFF_X1F8);
    bf16_t* Q = (bf16_t*)(ws + OFF_Q); bf16_t* Kb = (bf16_t*)(ws + OFF_K); bf16_t* Vt = (bf16_t*)(ws + OFF_VT);
    bf16_t* yatt = (bf16_t*)(ws + OFF_YATT); bf16_t* r = (bf16_t*)(ws + OFF_R);
    bf16_t* xb = (bf16_t*)(ws + OFF_XB); float* stats = (float*)(ws + OFF_STATS);
    bf16_t* wt_in = (bf16_t*)(ws + OFF_WTIN); bf16_t* wt_out = (bf16_t*)(ws + OFF_WTOUT); bf16_t* wt_r = (bf16_t*)(ws + OFF_WTR);
    unsigned char* wgut = (unsigned char*)(ws + OFF_WGUT); unsigned char* wdt = (unsigned char*)(ws + OFF_WDT);
    if (ws_size < WS_NEEDED) { fprintf(stderr, "kernel_launch: workspace too small (%zu < %zu)\n", ws_size, (size_t)WS_NEEDED); return; }
    hipMemsetAsync(ctrl, 0, 128 * 1024, stream);
    static bool attr_done = false;
    if (!attr_done) {
        hipFuncSetAttribute((const void*)k_mega, hipFuncAttributeMaxDynamicSharedMemorySize, LDS_BYTES);
        attr_done = true;
    }
    MegaArgs m{};
    m.p0 = P0Args{x, w_in, w_out, router_w, xb, wt_in, wt_out, wt_r, w_gate, w_up, w_down, ws_gate, ws_up, ws_down, wgut, wdt};
    m.p1 = P1Args{xb, wt_in, Q, Kb, Vt};
    m.p2 = P2Args{Q, Kb, Vt, rel_bias, gain_a, gain_b, yatt};
    m.p3 = P3Args{yatt, wt_out, xb, r, stats};
    m.p4 = P4Args{r, stats, ln1_g, ln1_b, X1, x1f8, wt_r, router_bias, eidx, gate, counts, tokl, gatel, slot};
    m.p6 = P6Args{x1f8, counts, tokl, gatel, wgut, H};
    m.p7 = P7Args{H, counts, wdt, Y};
    m.p8 = P8Args{X1, Y, slot, counts, ln2_g, ln2_b, out};
    m.bar = (unsigned*)ctrl;
    k_mega<<<GRID, NTHR, LDS_BYTES, stream>>>(m);
}
```

```cpp
#include <hip/hip_runtime.h>
#include <cstdint>
#include <cstdio>

typedef unsigned short bf16_t;

constexpr int D_MODEL = 1024, BATCH = 16, SEQ = 2048, T_TOK = BATCH * SEQ;
constexpr int HEAD_DIM = 64, NHA = 8, NHB = 8, NHH = 16;
constexpr int CHUNK = 64, LEFT_CHUNKS = 8, MAX_REL = 128;
constexpr int N_EXP = 256, TOP_K = 8, N_GROUPS = 8, TOPK_GROUPS = 4, EPG = 32, D_EXP = 256;
constexpr float ROUTED_SCALE = 2.5f, LN_EPS = 1e-5f, RMS_EPS = 1e-6f;
constexpr float DN_ALPHA = 1.189207115002721f;
constexpr float LOG2E = 1.4426950408889634f, LN2 = 0.6931471805599453f;
constexpr float QSCALE = 0.125f * LOG2E;
constexpr float WSCALE = 64.f, XSCALE = 16.f, HSCALE = 16.f;
constexpr float YSCALE = 64.f;
constexpr int CAP = T_TOK;
constexpr int ROWS_ALL = T_TOK * TOP_K + T_TOK;

__device__ __forceinline__ float bf2f(bf16_t v) { return __uint_as_float(((unsigned)v) << 16); }
__device__ __forceinline__ bf16_t f2bf(float f) { unsigned u = __float_as_uint(f); u += 0x7fffu + ((u >> 16) & 1u); return (bf16_t)(u >> 16); }

constexpr size_t MB = 1024ull * 1024ull;
constexpr size_t OFF_CTRL   = 0;
constexpr size_t OFF_X1     = 1 * MB;
constexpr size_t OFF_TOKL   = OFF_X1 + 64 * MB;
constexpr size_t OFF_GATEL  = OFF_TOKL + 32 * MB;
constexpr size_t OFF_EIDX   = OFF_GATEL + 32 * MB;
constexpr size_t OFF_GATE   = OFF_EIDX + 1 * MB;
constexpr size_t OFF_SLOT   = OFF_GATE + 1 * MB;
constexpr size_t OFF_WDT    = OFF_SLOT + 1 * MB;
constexpr size_t OFF_X1F8   = OFF_WDT + 72 * MB;
constexpr size_t OFF_BIG    = OFF_WDT + 129 * MB;
constexpr size_t OFF_H      = OFF_BIG;
constexpr size_t OFF_Y      = OFF_BIG + 144 * MB;
constexpr size_t OFF_Q      = OFF_BIG;
constexpr size_t OFF_K      = OFF_BIG + 64 * MB;
constexpr size_t OFF_VT     = OFF_BIG + 128 * MB;
constexpr size_t OFF_YATT   = OFF_BIG + 192 * MB;
constexpr size_t OFF_R      = OFF_BIG + 256 * MB;
constexpr size_t OFF_XB     = OFF_BIG + 320 * MB;
constexpr size_t OFF_WTIN   = OFF_BIG + 392 * MB;
constexpr size_t OFF_WTOUT  = OFF_BIG + 398 * MB;
constexpr size_t OFF_WTR    = OFF_BIG + 400 * MB;
constexpr size_t OFF_WGUT   = OFF_BIG + 401 * MB;
constexpr size_t WS_NEEDED  = OFF_BIG + 720 * MB;
static_assert(OFF_WGUT + 257 * MB <= WS_NEEDED && WS_NEEDED <= 1024 * MB, "workspace map");
constexpr int CW_COUNTS = 8192;
constexpr int CSTR = 64;

typedef short bf16x8 __attribute__((ext_vector_type(8)));
typedef float f32x4 __attribute__((ext_vector_type(4)));
typedef float f32x2 __attribute__((ext_vector_type(2)));
typedef float f32x16 __attribute__((ext_vector_type(16)));
typedef unsigned u32x4 __attribute__((ext_vector_type(4)));
typedef unsigned u32x2 __attribute__((ext_vector_type(2)));
#define DI __device__ __forceinline__
constexpr int NTHR = 512, GRID = 256;
DI int tidx() { int t = threadIdx.x; asm volatile("" : "+v"(t)); return t; }
constexpr int LDS_BYTES = 160 * 1024;

typedef __bf16 bf16x2_t __attribute__((ext_vector_type(2)));
DI unsigned cvt_pk_bf16(float lo, float hi) { f32x2 v = {lo, hi}; bf16x2_t r = __builtin_convertvector(v, bf16x2_t); return __builtin_bit_cast(unsigned, r); }
DI unsigned pack_fp8x4(float a, float b, float c, float d) { int w = 0; w = __builtin_amdgcn_cvt_pk_fp8_f32(a, b, w, false); w = __builtin_amdgcn_cvt_pk_fp8_f32(c, d, w, true); return (unsigned)w; }
DI int vblock() { return (int)((blockIdx.x & 7) * (GRID / 8) + (blockIdx.x >> 3)); }

template <int MT> struct Tile { static constexpr int BM = 32 * MT, A_BYTES = BM * 128, B_BYTES = 256 * 128, STAGE = A_BYTES + B_BYTES; };

template <int MT> struct ALoader {
    const bf16_t* p[MT / 2]; u32x4 v[MT / 2]; int off0;
    DI void init_rows(const bf16_t* A, int lda, int row0) {
        const int tid = tidx(), kc = tid & 7, r = tid >> 3;
#pragma unroll
        for (int i = 0; i < MT / 2; ++i) p[i] = A + (size_t)(row0 + r + 64 * i) * lda + kc * 8;
        off0 = r * 128 + ((kc ^ ((r >> 1) & 7)) << 4);
    }
    DI void init_gather(const bf16_t* A, int lda, const int* rows, int cnt, int m0) {
        const int tid = tidx(), kc = tid & 7, r = tid >> 3;
#pragma unroll
        for (int i = 0; i < MT / 2; ++i) { int rr = m0 + r + 64 * i; rr = rr < cnt ? rr : cnt - 1; const int g = rows ? rows[rr] : rr; p[i] = A + (size_t)g * lda + kc * 8; }
        off0 = r * 128 + ((kc ^ ((r >> 1) & 7)) << 4);
    }
    DI void load(int k0) {
#pragma unroll
        for (int i = 0; i < MT / 2; ++i) v[i] = *(const u32x4*)(p[i] + k0);
    }
    DI void store(char* ldsA) const {
#pragma unroll
        for (int i = 0; i < MT / 2; ++i) *(u32x4*)(ldsA + off0 + i * 8192) = v[i];
    }
};
struct BLoaderBt {
    const bf16_t* p[4]; u32x4 v[4]; int off0;
    DI void init(const bf16_t* Bt, int ldk, int n0) {
        const int tid = tidx(), kc = tid & 7, r = tid >> 3;
#pragma unroll
        for (int i = 0; i < 4; ++i) p[i] = Bt + (size_t)(n0 + r + 64 * i) * ldk + kc * 8;
        off0 = r * 128 + ((kc ^ ((r >> 1) & 7)) << 4);
    }
    DI void load(int k0) {
#pragma unroll
        for (int i = 0; i < 4; ++i) v[i] = *(const u32x4*)(p[i] + k0);
    }
    DI void store(char* ldsB) const {
#pragma unroll
        for (int i = 0; i < 4; ++i) *(u32x4*)(ldsB + off0 + i * 8192) = v[i];
    }
};
template <int MT, bool TR, class AL, class BL>
DI void gemm_tile(char* lds, AL& al, BL& bl, int nk, f32x4 (&acc)[MT][4]) {
    typedef Tile<MT> TT;
    const int tid = tidx(), wid = tid >> 6, lane = tid & 63, wr = wid >> 2, wc = wid & 3, fr = lane & 15, fq = lane >> 4;
#pragma unroll
    for (int m = 0; m < MT; ++m)
#pragma unroll
        for (int n = 0; n < 4; ++n) acc[m][n] = (f32x4){0.f, 0.f, 0.f, 0.f};
    int aoff[2], boff[2];
#pragma unroll
    for (int ks = 0; ks < 2; ++ks) { const int ch = (((4 * ks + fq) ^ (fr >> 1)) << 4); aoff[ks] = (16 * MT * wr + fr) * 128 + ch; boff[ks] = TT::A_BYTES + (64 * wc + fr) * 128 + ch; }
    al.load(0); bl.load(0);
    __syncthreads();
    al.store(lds); bl.store(lds + TT::A_BYTES);
    __syncthreads();
    for (int kt = 0; kt < nk; ++kt) {
        char* cur = lds + (kt & 1) * TT::STAGE; char* nxt = lds + ((kt & 1) ^ 1) * TT::STAGE;
        const bool more = kt + 1 < nk;
        if (more) { al.load((kt + 1) * 64); bl.load((kt + 1) * 64); }
#pragma unroll
        for (int ks = 0; ks < 2; ++ks) {
            bf16x8 a[MT], b[4];
#pragma unroll
            for (int m = 0; m < MT; ++m) a[m] = *(const bf16x8*)(cur + aoff[ks] + m * 2048);
#pragma unroll
            for (int n = 0; n < 4; ++n) b[n] = *(const bf16x8*)(cur + boff[ks] + n * 2048);
#pragma unroll
            for (int m = 0; m < MT; ++m)
#pragma unroll
                for (int n = 0; n < 4; ++n)
                    acc[m][n] = TR ? __builtin_amdgcn_mfma_f32_16x16x32_bf16(b[n], a[m], acc[m][n], 0, 0, 0) : __builtin_amdgcn_mfma_f32_16x16x32_bf16(a[m], b[n], acc[m][n], 0, 0, 0);
        }
        if (more) { al.store(nxt); bl.store(nxt + TT::A_BYTES); }
        __syncthreads();
    }
}

#define LAS __attribute__((address_space(3)))
namespace gs {
constexpr int BM = 256, BK = 64, HALF = 128, HTB = HALF * BK * 2, STAGE_BYTES = 8 * HTB;
DI int lds_byte(int r, int c) { const int st = (r >> 4) * 2 + (c >> 5), rr = r & 15, cc = c & 31, ob = rr * 64 + cc * 2; return st * 1024 + (ob ^ (((ob >> 9) & 1) << 5)); }
DI void stage_rc(int b, int& R, int& C) { const int st = b / 1024, sb = b % 1024, swz = sb ^ (((sb >> 9) & 1) << 5); R = (st >> 1) * 16 + swz / 64; C = (st & 1) * 32 + (swz % 64) / 2; }
DI int perm32(int rho) { const int n = rho >> 4, i = rho & 15; return 8 * (i >> 2) + 4 * n + (i & 3); }
typedef long i64x2 __attribute__((ext_vector_type(2)));
DI const char* uni(const char* p) { const unsigned long long v = (unsigned long long)p; const unsigned lo = __builtin_amdgcn_readfirstlane((unsigned)v), hi = __builtin_amdgcn_readfirstlane((unsigned)(v >> 32)); return (const char*)(((unsigned long long)hi << 32) | lo); }
template <bool TR, bool F8>
DI f32x4 mma16(const bf16x8& a, const bf16x8& b, f32x4 c) {
    if (F8) {
        const i64x2 a2 = __builtin_bit_cast(i64x2, a), b2 = __builtin_bit_cast(i64x2, b);
        c = TR ? __builtin_amdgcn_mfma_f32_16x16x32_fp8_fp8(b2[0], a2[0], c, 0, 0, 0) : __builtin_amdgcn_mfma_f32_16x16x32_fp8_fp8(a2[0], b2[0], c, 0, 0, 0);
        return TR ? __builtin_amdgcn_mfma_f32_16x16x32_fp8_fp8(b2[1], a2[1], c, 0, 0, 0) : __builtin_amdgcn_mfma_f32_16x16x32_fp8_fp8(a2[1], b2[1], c, 0, 0, 0);
    }
    return TR ? __builtin_amdgcn_mfma_f32_16x16x32_bf16(b, a, c, 0, 0, 0) : __builtin_amdgcn_mfma_f32_16x16x32_bf16(a, b, c, 0, 0, 0);
}
typedef int i32x8 __attribute__((ext_vector_type(8)));
typedef short bf16x16 __attribute__((ext_vector_type(16)));
template <bool TR, int SC>
DI f32x4 mma128(const bf16x16& a, const bf16x16& b, f32x4 c) {
    const i32x8 av = __builtin_bit_cast(i32x8, a), bv = __builtin_bit_cast(i32x8, b);
    const int one = SC;
    if (TR) asm volatile("v_mfma_scale_f32_16x16x128_f8f6f4 %0, %1, %2, %0, %3, %3 op_sel_hi:[0,0,0]" : "+v"(c) : "v"(bv), "v"(av), "v"(one));
    else    asm volatile("v_mfma_scale_f32_16x16x128_f8f6f4 %0, %1, %2, %0, %3, %3 op_sel_hi:[0,0,0]" : "+v"(c) : "v"(av), "v"(bv), "v"(one));
    return c;
}
template <bool TR, int SC>
DI f32x4 mma128z(const bf16x16& a, const bf16x16& b) {
    const i32x8 av = __builtin_bit_cast(i32x8, a), bv = __builtin_bit_cast(i32x8, b);
    const int one = SC; f32x4 c;
    if (TR) asm volatile("v_mfma_scale_f32_16x16x128_f8f6f4 %0, %1, %2, 0, %3, %3 op_sel_hi:[0,0,0]" : "=&v"(c) : "v"(bv), "v"(av), "v"(one));
    else    asm volatile("v_mfma_scale_f32_16x16x128_f8f6f4 %0, %1, %2, 0, %3, %3 op_sel_hi:[0,0,0]" : "=&v"(c) : "v"(av), "v"(bv), "v"(one));
    return c;
}
DI bf16x8 frag_lo(const bf16x16& v) { return __builtin_shufflevector(v, v, 0, 1, 2, 3, 4, 5, 6, 7); }
DI bf16x8 frag_hi(const bf16x16& v) { return __builtin_shufflevector(v, v, 8, 9, 10, 11, 12, 13, 14, 15); }
template <int N> DI void wait_vm() { asm volatile("s_waitcnt vmcnt(%0)" :: "n"(N) : "memory"); }
template <bool TR, bool PERM, int F8, bool SPLIT, class Sched, class Epi>
DI void gemm_stream(LAS unsigned char* lds, const int K, const Sched& S, const Epi& E) {
    typedef typename Sched::U U;
    const int tid = tidx(), wid = __builtin_amdgcn_readfirstlane(tid >> 6), lane = tid & 63, wr = wid >> 2, wc = wid & 3, fr = lane & 15, fq = lane >> 4;
    const int nt = K / BK;
    constexpr int NJ = SPLIT ? 4 : 2, JSTEP = SPLIT ? 4096 : 8192;
    const bool dma = !SPLIT || wr == 0;
    int R[NJ], C[NJ]; unsigned voffB[NJ], voffA[NJ];
#pragma unroll
    for (int i = 0; i < NJ; ++i) { stage_rc((SPLIT ? wc * 1024 + lane * 16 : tid * 16) + i * JSTEP, R[i], C[i]); const int Rb = PERM ? ((R[i] & ~31) + perm32(R[i] & 31)) : R[i]; voffB[i] = (unsigned)(Rb * K + C[i]) * 2u;
                                   voffA[i] = SPLIT ? S.a_voff(0, 0, R[i], C[i]) : 0u; }
    const unsigned hstepA = (unsigned)HALF * K * 2;
    const size_t kstep = (size_t)(BK * 2), hstepB = (size_t)HALF * K * 2;
    const unsigned ldsw = (unsigned)(SPLIT ? wc : wid) * 1024u;
    const int aoff = lds_byte(wr * 64 + fr, fq * 8), boff = lds_byte(wc * 32 + fr, fq * 8);
#define GS_SA(b, h) (((b) * 2 + (h)) * HTB)
#define GS_SB(b, h) ((4 + (b) * 2 + (h)) * HTB)
#define GS_STAGE(bufoff, gbase, uix, h) do { if (dma) { _Pragma("unroll") for (int _i = 0; _i < NJ; ++_i) \
        __builtin_amdgcn_global_load_lds((const unsigned*)((const char*)(gbase) + (SPLIT ? voffA[_i] + (h) * hstepA : S.a_voff(uix, h, R[_i], C[_i]))), (LAS unsigned*)(lds + (bufoff) + ldsw + _i * JSTEP), 16, 0, 0); } } while (0)
#define GS_STAGEB(bufoff, gbase, voff) do { if (dma) { _Pragma("unroll") for (int _i = 0; _i < NJ; ++_i) \
        __builtin_amdgcn_global_load_lds((const unsigned*)((const char*)(gbase) + (voff)[_i]), (LAS unsigned*)(lds + (bufoff) + ldsw + _i * JSTEP), 16, 0, 0); } } while (0)
#define GS_LD32(base) __builtin_shufflevector(*(const LAS bf16x8*)(base), *(const LAS bf16x8*)((base) + 1024), 0, 1, 2, 3, 4, 5, 6, 7, 8, 9, 10, 11, 12, 13, 14, 15)
#define GS_LDA(dst, b, h) do { _Pragma("unroll") for (int m = 0; m < 4; ++m) dst[m] = GS_LD32(lds + GS_SA(b, h) + aoff + m * 2048); } while (0)
#define GS_LDB(dst, b, h) do { _Pragma("unroll") for (int n = 0; n < 2; ++n) dst[n] = GS_LD32(lds + GS_SB(b, h) + boff + n * 2048); } while (0)
#define GS_MMA(ai, bj, At, Bt) do { __builtin_amdgcn_s_setprio(1); _Pragma("unroll") for (int m = 0; m < 4; ++m) _Pragma("unroll") for (int n = 0; n < 2; ++n) { \
        if (F8 == 2) acc[ai][bj][m][n] = mma128<TR, Epi::MXS>(At[m], Bt[n], acc[ai][bj][m][n]); \
        else { acc[ai][bj][m][n] = mma16<TR, F8 == 1>(frag_lo(At[m]), frag_lo(Bt[n]), acc[ai][bj][m][n]); acc[ai][bj][m][n] = mma16<TR, F8 == 1>(frag_hi(At[m]), frag_hi(Bt[n]), acc[ai][bj][m][n]); } } \
        __builtin_amdgcn_s_setprio(0); } while (0)
#define GS_MMAZ(ai, bj, At, Bt) do { __builtin_amdgcn_s_setprio(1); _Pragma("unroll") for (int m = 0; m < 4; ++m) _Pragma("unroll") for (int n = 0; n < 2; ++n) { \
        if (F8 == 2) acc[ai][bj][m][n] = mma128z<TR, Epi::MXS>(At[m], Bt[n]); \
        else { acc[ai][bj][m][n] = mma16<TR, F8 == 1>(frag_lo(At[m]), frag_lo(Bt[n]), (f32x4){0.f, 0.f, 0.f, 0.f}); acc[ai][bj][m][n] = mma16<TR, F8 == 1>(frag_hi(At[m]), frag_hi(Bt[n]), acc[ai][bj][m][n]); } } \
        __builtin_amdgcn_s_setprio(0); } while (0)
#define GS_WAIT_V(n) do { if (SPLIT) { if (wr == 0) wait_vm<2 * (n)>(); } else wait_vm<(n)>(); } while (0)
#define GS_WAIT_L(n) asm volatile("s_waitcnt lgkmcnt(" #n ")" ::: "memory")
#define GS_BAR __builtin_amdgcn_s_barrier()
#define GS_SCHED __builtin_amdgcn_sched_barrier(0)
    U cur, nxt; int ui = 0;
    if (!S.next(0, cur)) return;
    f32x4 acc[2][2][4][2];
    u32x4 dq[6]; unsigned dbase = 0u; int dnv = 0;
    bf16x16 At[4], B0[2], B1[2];
    const char* cA = uni(cur.A); const char* cB = uni(cur.B);
    GS_STAGEB(GS_SB(0, 0), cB, voffB); GS_STAGEB(GS_SB(0, 1), cB + hstepB, voffB); GS_STAGE(GS_SA(0, 0), cA, 0, 0); GS_STAGE(GS_SA(0, 1), cA, 0, 1);
    if (wr == 1) GS_BAR;
    GS_WAIT_V(2); GS_BAR;
    GS_STAGEB(GS_SB(1, 0), cB + kstep, voffB); GS_STAGE(GS_SA(1, 0), cA + kstep, 0, 0); GS_STAGEB(GS_SB(1, 1), cB + hstepB + kstep, voffB);
    GS_WAIT_V(6); GS_BAR;
    for (;;) {
        const bool has_next = S.next(ui + 1, nxt);
        const int nui = has_next ? ui + 1 : ui;
        const char* nA = uni(has_next ? nxt.A : cA); const char* nB = uni(has_next ? nxt.B : cB);
#define GS_TRIP(T, MM, W0, DEF) do { \
            const bool last = ((T) == nt - 2); \
            const char* a1 = uni(cA + (size_t)((T) + 1) * kstep); \
            const char* a2 = uni(last ? nA : cA + (size_t)((T) + 2) * kstep); const char* b2 = uni(last ? nB : cB + (size_t)((T) + 2) * kstep); \
            const char* a3 = uni(a2 + kstep); const char* b3 = uni(b2 + kstep); \
            const int u2 = last ? nui : ui; \
              \
            GS_LDB(B0, 0, 0); GS_LDB(B1, 0, 1); GS_SCHED; GS_LDA(At, 0, 0); if (W0) GS_STAGE(GS_SA(1, 1), a1, ui, 1);     \
            if (W0) GS_WAIT_V(8); GS_WAIT_L(0); GS_BAR; MM(0, 0, At, B0); MM(0, 1, At, B1); DEF(0); GS_BAR; GS_SCHED; \
              \
            GS_LDA(At, 0, 1); GS_STAGEB(GS_SB(0, 0), b2, voffB); GS_STAGEB(GS_SB(0, 1), b2 + hstepB, voffB); GS_STAGE(GS_SA(0, 0), a2, u2, 0); \
            GS_WAIT_V(8); GS_WAIT_L(0); GS_BAR; MM(1, 0, At, B0); MM(1, 1, At, B1); DEF(1); GS_BAR; GS_SCHED; \
              \
            GS_LDB(B0, 1, 0); GS_LDB(B1, 1, 1); GS_SCHED; GS_LDA(At, 1, 0); GS_STAGE(GS_SA(0, 1), a2, u2, 1); \
            GS_WAIT_V(8); GS_WAIT_L(0); GS_BAR; GS_MMA(0, 0, At, B0); GS_MMA(0, 1, At, B1); DEF(2); GS_BAR; GS_SCHED; \
              \
            GS_LDA(At, 1, 1); GS_STAGEB(GS_SB(1, 0), b3, voffB); GS_STAGEB(GS_SB(1, 1), b3 + hstepB, voffB); GS_STAGE(GS_SA(1, 0), a3, u2, 0); \
            GS_WAIT_V(8); GS_WAIT_L(0); GS_BAR; GS_MMA(1, 0, At, B0); GS_MMA(1, 1, At, B1); DEF(3); GS_BAR; GS_SCHED; } while (0)
#define GS_DEF(k) do { if constexpr (SPLIT) { if ((k) < 3 && wr == 1 && ui > 0) { E.store1(dq[2 * (k)], dbase, dnv, 2 * (k) + 2); E.store1(dq[2 * (k) + 1], dbase, dnv, 2 * (k) + 3); } } } while (0)
#define GS_NODEF(k) do { } while (0)
        GS_TRIP(0, GS_MMAZ, ui == 0, GS_DEF);
#pragma unroll 1
        for (int t = 2; t < nt; t += 2) GS_TRIP(t, GS_MMA, true, GS_NODEF);
#undef GS_TRIP
#undef GS_DEF
#undef GS_NODEF
        if (has_next) GS_STAGE(GS_SA(1, 1), uni(nA + kstep), nui, 1);
        if (wr == 0) GS_BAR;
        if (F8 == 2) asm volatile("s_nop 15\n\ts_nop 15\n\ts_nop 15\n\ts_nop 15\n\ts_nop 15\n\ts_nop 15" ::: "memory");
        if constexpr (SPLIT) {
            if (wr == 1) E.pack(acc, cur, wr, wc, fr, fq, dq, dbase, dnv);
            else { GS_WAIT_V(8); E(acc, cur, wr, wc, fr, fq); }
        } else {
            GS_WAIT_V(8);
            E(acc, cur, wr, wc, fr, fq);
        }
        if (!has_next) break;
        cur = nxt; cA = nA; cB = nB; ++ui;
        if (wr == 1) GS_BAR;
    }
    if constexpr (SPLIT) { if (wr == 1) {
#pragma unroll
        for (int k = 0; k < 6; ++k) E.store1(dq[k], dbase, dnv, k + 2); } }
    GS_WAIT_V(0);
    GS_BAR;
#undef GS_SA
#undef GS_SB
#undef GS_STAGE
#undef GS_STAGEB
#undef GS_LDA
#undef GS_LD32
#undef GS_LDB
#undef GS_MMA
#undef GS_MMAZ
#undef GS_WAIT_V
#undef GS_WAIT_L
#undef GS_BAR
#undef GS_SCHED
}
struct DenseU { const char* A; const char* B; int pm, pn; };
struct DenseSched {
    typedef DenseU U;
    const bf16_t* A; const bf16_t* Bt; int K, nunits, first, stride, npn, pn_base, pn_mod0, pn_mod1;
    DI int colmap(int q) const { return pn_base + (q / pn_mod0) * pn_mod1 + (q % pn_mod0); }
    DI bool next(int i, U& u) const {
        const int L = first + i * stride; if (L >= nunits) return false;
        u.pm = L / npn; u.pn = colmap(L % npn);
        u.A = (const char*)A + (size_t)u.pm * BM * K * 2; u.B = (const char*)Bt + (size_t)u.pn * BM * K * 2; return true;
    }
    DI unsigned a_voff(int, int h, int R, int C) const { return (unsigned)((HALF * h + R) * K + C) * 2u; }
};
}

DI void transpose_cvt(const float* W, bf16_t* Wt, int K, int N, int unit, char* lds) {
    float* tile = (float*)lds;
    const int nbn = N / 64, kb = unit / nbn, nb = unit % nbn, tid = tidx();
    __syncthreads();
#pragma unroll
    for (int i = 0; i < 8; ++i) { const int idx = tid + i * 512, r = idx >> 6, c = idx & 63; tile[r * 65 + c] = W[(size_t)(kb * 64 + r) * N + nb * 64 + c]; }
    __syncthreads();
#pragma unroll
    for (int i = 0; i < 8; ++i) { const int idx = tid + i * 512, n = idx >> 6, k = idx & 63; Wt[(size_t)(nb * 64 + n) * K + kb * 64 + k] = f2bf(tile[k * 65 + n]); }
}
struct P0Args { const float* x; const float* w_in; const float* w_out; const float* router_w; bf16_t* xb; bf16_t* wt_in; bf16_t* wt_out; bf16_t* wt_r;
                const float* w_gate; const float* w_up; const float* w_down; const float* ws_gate; const float* ws_up; const float* ws_down; unsigned char* wgut; unsigned char* wdt; };
constexpr int CV_GU = 257 * 2 * 16, CV_DN = 257 * 16;
struct CvItem { const float* src; unsigned char* dst; int ld, ldd, rbase, rhi; };
DI CvItem cv_item(const P0Args& a, int it) {
    CvItem c;
    if (it < CV_GU) {
        const int e = it / 32, u = (it >> 4) & 1, kt = it & 15;
        const float* W = e < N_EXP ? (u ? a.w_up : a.w_gate) + (size_t)e * D_MODEL * D_EXP : (u ? a.ws_up : a.ws_gate);
        c.src = W + (size_t)kt * 64 * D_EXP; c.ld = D_EXP; c.dst = a.wgut + (size_t)e * 512 * D_MODEL + kt * 64; c.ldd = D_MODEL; c.rbase = 128 * u; c.rhi = 256;
    } else {
        const int j = it - CV_GU, e = j / 16, kt = (j >> 2) & 3, nb = j & 3;
        const float* W = e < N_EXP ? a.w_down + (size_t)e * D_EXP * D_MODEL : a.ws_down;
        c.src = W + (size_t)kt * 64 * D_MODEL + nb * 256; c.ld = D_MODEL; c.dst = a.wdt + (size_t)e * D_MODEL * D_EXP + kt * 64; c.ldd = D_EXP; c.rbase = 256 * nb; c.rhi = 128;
    }
    return c;
}
constexpr int CV_TILE_BYTES = 64 * 260 * 4;
DI void cv_dma_nt(const char* sbase, unsigned voff, unsigned lds_dst) {
    unsigned keep;
    asm volatile("s_mov_b32 %0, m0\n\ts_mov_b32 m0, %3\n\ts_nop 0\n\tglobal_load_lds_dwordx4 %1, %2 nt\n\ts_mov_b32 m0, %0" : "=&s"(keep) : "v"(voff), "s"(sbase), "s"(lds_dst) : "memory");
}
DI const char* uni64(const void* p) { const unsigned long long v = (unsigned long long)p; const unsigned lo = __builtin_amdgcn_readfirstlane((unsigned)v), hi = __builtin_amdgcn_readfirstlane((unsigned)(v >> 32)); return (const char*)(((unsigned long long)hi << 32) | lo); }
DI void cv_issue(const CvItem& c, LAS unsigned char* tile) {
    const int tid = tidx(), w = __builtin_amdgcn_readfirstlane(tid >> 6), l = tid & 63;
    const char* sb = uni64(c.src); const unsigned tb = (unsigned)__builtin_amdgcn_readfirstlane((unsigned)(size_t)tile);
#pragma unroll
    for (int i = 0; i < 8; ++i) { const int k = 8 * w + i; cv_dma_nt(sb, (unsigned)(k * c.ld + 4 * (l ^ w)) * 4u, tb + (unsigned)(k * 1040)); }
}
DI void lds_barrier() { asm volatile("s_waitcnt lgkmcnt(0)" ::: "memory"); __builtin_amdgcn_s_barrier(); asm volatile("" ::: "memory"); }
DI void cv_emit(const CvItem& c, const char* lds) {
    const float* tile = (const float*)lds;
    const int tid = tidx();
#pragma unroll
    for (int i = 0; i < 4; ++i) {
        const int idx = tid + i * 512, kc = idx & 7, n = idx >> 3; const float* p = tile + (8 * kc) * 260 + (n ^ (4 * kc));
        const unsigned w0 = pack_fp8x4(p[0] * WSCALE, p[260] * WSCALE, p[2 * 260] * WSCALE, p[3 * 260] * WSCALE), w1 = pack_fp8x4(p[4 * 260] * WSCALE, p[5 * 260] * WSCALE, p[6 * 260] * WSCALE, p[7 * 260] * WSCALE);
        __builtin_nontemporal_store((u32x2){w0, w1}, (u32x2*)(c.dst + (size_t)(c.rbase + (n >> 7) * c.rhi + (n & 127)) * c.ldd + 8 * kc));
    }
}
DI void convert_moe_range(const P0Args& a, char* lds, const int lo, const int hi) {
    int it = lo + vblock(); if (it >= hi) return;
    __syncthreads();
    LAS unsigned char* t0 = (LAS unsigned char*)lds; LAS unsigned char* t1 = t0 + CV_TILE_BYTES;
    CvItem c = cv_item(a, it); cv_issue(c, t0);
    int pp = 0;
#pragma unroll 1
    for (;;) {
        const int nit = it + GRID; const bool more = nit < hi;
        CvItem cn = c;
        if (more) { cn = cv_item(a, nit); cv_issue(cn, pp ? t0 : t1); }
        if (more) asm volatile("s_waitcnt vmcnt(8)" ::: "memory"); else asm volatile("s_waitcnt vmcnt(0)" ::: "memory");
        lds_barrier();
        cv_emit(c, lds + (pp ? CV_TILE_BYTES : 0));
        lds_barrier();
        if (!more) break;
        it = nit; c = cn; pp ^= 1;
    }
    asm volatile("s_waitcnt vmcnt(0)" ::: "memory");
    __syncthreads();
}
DI void phase_prologue(const P0Args& a, char* lds) {
    const int vb = vblock();
    for (size_t i = (size_t)vb * NTHR + tidx(); i < (size_t)T_TOK * D_MODEL / 8; i += (size_t)GRID * NTHR) {
        const f32x4 v0 = *(const f32x4*)(a.x + i * 8), v1 = *(const f32x4*)(a.x + i * 8 + 4);
        u32x4 o; o.x = cvt_pk_bf16(v0[0], v0[1]); o.y = cvt_pk_bf16(v0[2], v0[3]); o.z = cvt_pk_bf16(v1[0], v1[1]); o.w = cvt_pk_bf16(v1[2], v1[3]);
        *(u32x4*)(a.xb + i * 8) = o;
    }
    const int n_in = (1024 / 64) * (3072 / 64), n_out = 16 * 16, n_r = 16 * 4;
    for (int u = vb; u < n_in + n_out + n_r; u += GRID) {
        if (u < n_in) transpose_cvt(a.w_in, a.wt_in, 1024, 3072, u, lds);
        else if (u < n_in + n_out) transpose_cvt(a.w_out, a.wt_out, 1024, 1024, u - n_in, lds);
        else transpose_cvt(a.router_w, a.wt_r, 1024, 256, u - n_in - n_out, lds);
    }
}


struct P1Args { const bf16_t* xb; const bf16_t* wt_in; bf16_t* Q; bf16_t* Kb; bf16_t* Vt; };
struct EpiQK { bf16_t* Q; bf16_t* Kb; static constexpr int MXS = 0x7F7F7F7F;
    DI void operator()(const f32x4 (&acc)[2][2][4][2], const gs::DenseU& u, int wr, int wc, int fr, int fq) const {
        const int seg = u.pn >> 1, type = seg % 3, grp = seg / 3; bf16_t* dst = type == 0 ? Q : Kb; const float sc = type == 0 ? QSCALE : 1.f;
#pragma unroll
        for (int ai = 0; ai < 2; ++ai)
#pragma unroll
            for (int m = 0; m < 4; ++m) {
                const int row = u.pm * 256 + 128 * ai + 64 * wr + 16 * m + fr, b = row / SEQ, s = row % SEQ;
#pragma unroll
                for (int bj = 0; bj < 2; ++bj) {
                    const int hh = grp * 8 + 4 * (u.pn & 1) + 2 * bj + (wc >> 1), d0 = 32 * (wc & 1) + 8 * fq;
                    const f32x4 v0 = acc[ai][bj][m][0] * sc, v1 = acc[ai][bj][m][1] * sc;
                    u32x4 o; o.x = cvt_pk_bf16(v0[0], v0[1]); o.y = cvt_pk_bf16(v0[2], v0[3]); o.z = cvt_pk_bf16(v1[0], v1[1]); o.w = cvt_pk_bf16(v1[2], v1[3]);
                    *(u32x4*)(dst + (size_t)(b * NHH + hh) * SEQ * 64 + (s >> 5) * 2048 + ((d0 >> 3) * 32 + (s & 31)) * 8) = o;
                }
            }
    } };
struct EpiV { bf16_t* Vt; static constexpr int MXS = 0x7F7F7F7F;
    DI void operator()(const f32x4 (&acc)[2][2][4][2], const gs::DenseU& u, int wr, int wc, int fr, int fq) const {
        const int grp = (u.pn >> 1) / 3;
#pragma unroll
        for (int ai = 0; ai < 2; ++ai)
#pragma unroll
            for (int m = 0; m < 4; ++m) {
                const int row = u.pm * 256 + 128 * ai + 64 * wr + 16 * m + 4 * fq, b = row / SEQ, s = row % SEQ;
#pragma unroll
                for (int bj = 0; bj < 2; ++bj)
#pragma unroll
                    for (int n = 0; n < 2; ++n) {
                        const int hh = grp * 8 + 4 * (u.pn & 1) + 2 * bj + (wc >> 1), d = 32 * (wc & 1) + 16 * n + fr;
                        const f32x4 v = acc[ai][bj][m][n];
                        u32x2 o; o.x = cvt_pk_bf16(v[0], v[1]); o.y = cvt_pk_bf16(v[2], v[3]);
                        { const int kap = s & 31; *(u32x2*)(Vt + (size_t)(b * NHH + hh) * SEQ * 64 + (s >> 5) * 2048 + ((((d >> 5) * 2 + (kap >> 4)) * 2 + ((kap >> 2) & 1)) * 32 + (d & 31)) * 8 + ((kap >> 3) & 1) * 4) = o; }
                    }
            }
    } };
DI void phase_qkv(const P1Args& a, LAS unsigned char* lds) {
    { gs::DenseSched S{a.xb, a.wt_in, D_MODEL, (T_TOK / 256) * 8, vblock(), GRID, 8, 0, 4, 6}; EpiQK E{a.Q, a.Kb}; gs::gemm_stream<true, true, 0, false>(lds, D_MODEL, S, E); }
    { gs::DenseSched S{a.xb, a.wt_in, D_MODEL, (T_TOK / 256) * 4, vblock(), GRID, 4, 4, 2, 6}; EpiV E{a.Vt}; gs::gemm_stream<false, false, 0, false>(lds, D_MODEL, S, E); }
}

struct P3Args { const bf16_t* y; const bf16_t* wt_out; bf16_t* r; };
struct EpiOut { bf16_t* r; static constexpr int MXS = 0x7F7F7F7F;
    DI void operator()(const f32x4 (&acc)[2][2][4][2], const gs::DenseU& u, int wr, int wc, int fr, int fq) const {
#pragma unroll
        for (int ai = 0; ai < 2; ++ai)
#pragma unroll
            for (int m = 0; m < 4; ++m) {
                const int row = u.pm * 256 + 128 * ai + 64 * wr + 16 * m + fr;
#pragma unroll
                for (int bj = 0; bj < 2; ++bj) {
                    const int col = u.pn * 256 + 128 * bj + 32 * wc + 8 * fq;
                    const f32x4 v0 = acc[ai][bj][m][0], v1 = acc[ai][bj][m][1];
                    u32x4 o; o.x = cvt_pk_bf16(v0[0], v0[1]); o.y = cvt_pk_bf16(v0[2], v0[3]); o.z = cvt_pk_bf16(v1[0], v1[1]); o.w = cvt_pk_bf16(v1[2], v1[3]);
                    *(u32x4*)(r + (size_t)row * D_MODEL + col) = o;
                }
            }
    } };
DI void phase_outproj(const P3Args& a, LAS unsigned char* lds) {
    gs::DenseSched S{a.y, a.wt_out, D_MODEL, (T_TOK / 256) * 4, vblock(), GRID, 4, 0, 4, 0}; EpiOut E{a.r}; gs::gemm_stream<true, true, 0, false>(lds, D_MODEL, S, E);
}

DI void unpack16(const u32x4& a, const u32x4& b, float (&v)[16]) {
#pragma unroll
    for (int j = 0; j < 4; ++j) { v[2 * j] = __uint_as_float(a[j] << 16); v[2 * j + 1] = __uint_as_float(a[j] & 0xffff0000u); v[8 + 2 * j] = __uint_as_float(b[j] << 16); v[8 + 2 * j + 1] = __uint_as_float(b[j] & 0xffff0000u); }
}
DI void dma16_plain(const char* sbase, unsigned voff, unsigned lds_dst) {
    unsigned keep;
    asm volatile("s_mov_b32 %0, m0\n\ts_mov_b32 m0, %3\n\ts_nop 0\n\tglobal_load_lds_dwordx4 %1, %2\n\ts_mov_b32 m0, %0" : "=&s"(keep) : "v"(voff), "s"(sbase), "s"(lds_dst) : "memory");
}
DI void router_gemm(char* lds, const bf16_t* A, const bf16_t* Bt, f32x4 (&acc)[4][4]) {
    constexpr int STAGE = 16384 + 32768, NK = D_MODEL / 64;
    const int tid = tidx(), wid = __builtin_amdgcn_readfirstlane(tid >> 6), lane = tid & 63, wr = wid >> 2, wc = wid & 3, fr = lane & 15, fq = lane >> 4;
#pragma unroll
    for (int m = 0; m < 4; ++m)
#pragma unroll
        for (int n = 0; n < 4; ++n) acc[m][n] = (f32x4){0.f, 0.f, 0.f, 0.f};
    int aoff[2], boff[2];
#pragma unroll
    for (int ks = 0; ks < 2; ++ks) { const int ch = (((4 * ks + fq) ^ (fr >> 1)) << 4); aoff[ks] = (64 * wr + fr) * 128 + ch; boff[ks] = 16384 + (64 * wc + fr) * 128 + ch; }
    unsigned voA[2], voB[4];
#pragma unroll
    for (int i = 0; i < 2; ++i) { const int row = 8 * (2 * wid + i) + (lane >> 3), kc = (lane & 7) ^ ((row >> 1) & 7); voA[i] = (unsigned)(row * D_MODEL + kc * 8) * 2u; }
#pragma unroll
    for (int i = 0; i < 4; ++i) { const int row = 8 * (4 * wid + i) + (lane >> 3), kc = (lane & 7) ^ ((row >> 1) & 7); voB[i] = (unsigned)(row * D_MODEL + kc * 8) * 2u; }
    const unsigned lb = (unsigned)__builtin_amdgcn_readfirstlane((unsigned)(size_t)(LAS unsigned char*)lds);
    const char* ab = uni64(A); const char* bb = uni64(Bt);
#define RG_ISSUE(kt) do { const unsigned sb_ = lb + (unsigned)(((kt) % 3) * STAGE); const char* a_ = ab + (size_t)(kt) * 128; const char* b_ = bb + (size_t)(kt) * 128; \
        _Pragma("unroll") for (int i_ = 0; i_ < 2; ++i_) dma16_plain(a_, voA[i_], sb_ + (unsigned)((2 * wid + i_) * 1024)); \
        _Pragma("unroll") for (int i_ = 0; i_ < 4; ++i_) dma16_plain(b_, voB[i_], sb_ + 16384u + (unsigned)((4 * wid + i_) * 1024)); } while (0)
    __syncthreads();
    RG_ISSUE(0); RG_ISSUE(1);
#pragma unroll 1
    for (int kt = 0; kt < NK; ++kt) {
        if (kt + 1 < NK) asm volatile("s_waitcnt vmcnt(6)" ::: "memory"); else asm volatile("s_waitcnt vmcnt(0)" ::: "memory");
        asm volatile("s_waitcnt lgkmcnt(0)" ::: "memory"); __builtin_amdgcn_s_barrier(); asm volatile("" ::: "memory");
        if (kt + 2 < NK) RG_ISSUE(kt + 2);
        const char* cur = lds + (kt % 3) * STAGE;
#pragma unroll
        for (int ks = 0; ks < 2; ++ks) {
            bf16x8 a[4], b[4];
#pragma unroll
            for (int m = 0; m < 4; ++m) a[m] = *(const bf16x8*)(cur + aoff[ks] + m * 2048);
#pragma unroll
            for (int n = 0; n < 4; ++n) b[n] = *(const bf16x8*)(cur + boff[ks] + n * 2048);
#pragma unroll
            for (int m = 0; m < 4; ++m)
#pragma unroll
                for (int n = 0; n < 4; ++n) acc[m][n] = __builtin_amdgcn_mfma_f32_16x16x32_bf16(b[n], a[m], acc[m][n], 0, 0, 0);
        }
    }
#undef RG_ISSUE
    __syncthreads();
}
constexpr int RS_SC = 289;
constexpr int LDS_HIST = 100 * 1024;
struct P4Args { const bf16_t* r; const bf16_t* xb; const float* ln_g; const float* ln_b; bf16_t* x1; unsigned char* x1f8; const bf16_t* wt_r; const float* rbias;
                int* eidx; float* gate; int* counts; int* tokl; float* gatel; int* slot; };
DI void phase_router(const P4Args& a, const P0Args& cv, char* lds) {
    const int tid = tidx(), wid = tid >> 6, lane = tid & 63, wr = wid >> 2, wc = wid & 3, fr = lane & 15, fq = lane >> 4;
    float* sc = (float*)lds; int* hist = (int*)(lds + LDS_HIST); int* base = hist + 256;
    for (int u = vblock(); u < T_TOK / 128; u += GRID) {
        const int m0 = u * 128;
        if ((vblock() & 1) == 0) convert_moe_range(cv, lds, CV_GU, CV_GU + CV_DN);
        __syncthreads();
#pragma unroll 1
        for (int i0 = 0; i0 < 16; i0 += 4) {
            u32x4 r0[4], r1[4], x0[4], x1w[4];
#pragma unroll
            for (int j4 = 0; j4 < 4; ++j4) {
                const int t = m0 + wid * 16 + i0 + j4;
                r0[j4] = *(const u32x4*)(a.r + (size_t)t * D_MODEL + lane * 16); r1[j4] = *(const u32x4*)(a.r + (size_t)t * D_MODEL + lane * 16 + 8);
                x0[j4] = *(const u32x4*)(a.xb + (size_t)t * D_MODEL + lane * 16); x1w[j4] = *(const u32x4*)(a.xb + (size_t)t * D_MODEL + lane * 16 + 8);
            }
#pragma unroll
            for (int j4 = 0; j4 < 4; ++j4) {
                const int t = m0 + wid * 16 + i0 + j4;
                float v[16], xv[16]; unpack16(r0[j4], r1[j4], v); unpack16(x0[j4], x1w[j4], xv);
                float s = 0.f;
#pragma unroll
                for (int i = 0; i < 16; ++i) { v[i] = xv[i] * DN_ALPHA + v[i]; s += v[i]; }
#pragma unroll
                for (int o = 1; o <= 32; o <<= 1) s += __shfl_xor(s, o);
                const float mu = s * (1.f / 1024.f);
                float q = 0.f;
#pragma unroll
                for (int i = 0; i < 16; ++i) { const float d = v[i] - mu; q += d * d; }
#pragma unroll
                for (int o = 1; o <= 32; o <<= 1) q += __shfl_xor(q, o);
                const float rstd = rsqrtf(q * (1.f / 1024.f) + LN_EPS);
                u32x4 o0, o1, o8;
#pragma unroll
                for (int j = 0; j < 4; ++j) {
                    const f32x4 g = *(const f32x4*)(a.ln_g + lane * 16 + 4 * j), bb = *(const f32x4*)(a.ln_b + lane * 16 + 4 * j);
                    const float y0 = (v[4 * j] - mu) * rstd * g[0] + bb[0], y1 = (v[4 * j + 1] - mu) * rstd * g[1] + bb[1], y2 = (v[4 * j + 2] - mu) * rstd * g[2] + bb[2], y3 = (v[4 * j + 3] - mu) * rstd * g[3] + bb[3];
                    o8[j] = pack_fp8x4(y0 * XSCALE, y1 * XSCALE, y2 * XSCALE, y3 * XSCALE);
                    const unsigned p0 = cvt_pk_bf16(y0, y1), p1 = cvt_pk_bf16(y2, y3);
                    if (j < 2) { o0[2 * j] = p0; o0[2 * j + 1] = p1; } else { o1[2 * (j - 2)] = p0; o1[2 * (j - 2) + 1] = p1; }
                }
                *(u32x4*)(a.x1 + (size_t)t * D_MODEL + lane * 16) = o0; *(u32x4*)(a.x1 + (size_t)t * D_MODEL + lane * 16 + 8) = o1;
                *(u32x4*)(a.x1f8 + (size_t)t * D_MODEL + lane * 16) = o8;
            }
        }
        asm volatile("s_waitcnt vmcnt(0)" ::: "memory");
        __syncthreads();
        f32x4 acc[4][4];
        router_gemm(lds, a.x1 + (size_t)m0 * D_MODEL, a.wt_r, acc);
        if (tid < 256) hist[tid] = 0;
        int my_idx[2], my_rank[2]; float my_gate[2];
#pragma unroll
        for (int p = 0; p < 2; ++p) {
            __syncthreads();
            if (wr == p) {
#pragma unroll
                for (int m = 0; m < 4; ++m)
#pragma unroll
                    for (int n = 0; n < 4; ++n) {
                        const int c0 = 64 * wc + 16 * n + 4 * fq; const f32x4 rb = *(const f32x4*)(a.rbias + c0);
#pragma unroll
                        for (int j = 0; j < 4; ++j) { const int c = c0 + j; sc[(16 * m + fr) * RS_SC + (c >> 5) * 36 + (c & 31)] = 1.f / (1.f + __expf(-acc[m][n][j])) + rb[j]; }
                    }
            }
            __syncthreads();
            const int row = tid >> 3, g = tid & 7, t = m0 + 64 * p + row;
            float sel[32];
#pragma unroll
            for (int i = 0; i < 32; ++i) sel[i] = sc[row * RS_SC + g * 36 + i];
            float m1 = -INFINITY, m2 = -INFINITY;
#pragma unroll
            for (int i = 0; i < 32; ++i) { const float v = sel[i]; m2 = fmaxf(m2, fminf(m1, v)); m1 = fmaxf(m1, v); }
            const float gs = m1 + m2; int rank = 0;
#pragma unroll
            for (int d = 1; d < 8; ++d) { const float o = __shfl_xor(gs, d); const int og = g ^ d; rank += (o > gs || (o == gs && og < g)) ? 1 : 0; }
            const bool en = rank < TOPK_GROUPS;
            float lv = -INFINITY; int li = 1 << 20;
            if (en) {
#pragma unroll
                for (int i = 0; i < 32; ++i) { const float v = sel[i]; if (v > lv) { lv = v; li = g * 32 + i; } }
            }
            float myv = 0.f; int myi = 0;
#pragma unroll
            for (int k = 0; k < TOP_K; ++k) {
                float bv = lv; int bi = li;
#pragma unroll
                for (int d = 1; d < 8; d <<= 1) { const float ov = __shfl_xor(bv, d); const int oi = __shfl_xor(bi, d); if (ov > bv || (ov == bv && oi < bi)) { bv = ov; bi = oi; } }
                if (g == k) { myv = bv; myi = bi; }
                if (k + 1 < TOP_K && (bi >> 5) == g) {
                    lv = -INFINITY; li = 1 << 20;
#pragma unroll
                    for (int i = 0; i < 32; ++i) { if (g * 32 + i == bi) sel[i] = -INFINITY; const float v = sel[i]; if (v > lv) { lv = v; li = g * 32 + i; } }
                }
            }
            const float score = myv - a.rbias[myi];
            float gsum = score;
#pragma unroll
            for (int d = 1; d < 8; d <<= 1) gsum += __shfl_xor(gsum, d);
            const float gt = score / gsum * ROUTED_SCALE;
            a.eidx[t * TOP_K + g] = myi; a.gate[t * TOP_K + g] = gt;
            my_idx[p] = myi; my_gate[p] = gt; my_rank[p] = atomicAdd(&hist[myi], 1);
        }
        __syncthreads();
        if (tid < 256) { const int h = hist[tid]; base[tid] = h > 0 ? atomicAdd(&a.counts[tid * CSTR], h) : 0; }
        __syncthreads();
#pragma unroll
        for (int p = 0; p < 2; ++p) {
            const int row = tid >> 3, g = tid & 7, t = m0 + 64 * p + row, e = my_idx[p], pos = base[e] + my_rank[p];
            a.tokl[(size_t)e * CAP + pos] = t; a.gatel[(size_t)e * CAP + pos] = my_gate[p]; a.slot[t * TOP_K + g] = e * CAP + pos;
        }
        if ((vblock() & 1) == 1) convert_moe_range(cv, lds, CV_GU, CV_GU + CV_DN);
    }
}

constexpr int LDS_ROWTAB = 128 * 1024;
constexpr int LDS_GTAB = 139 * 1024;
constexpr int LDS_TAB = 150 * 1024;
constexpr int LDS_UTAB = 154 * 1024;
constexpr int MOE_BM = 256;
DI void build_moe_tab(const int* counts, char* lds) {
    int* tstart = (int*)(lds + LDS_TAB); int* rstart = tstart + 264; int* cnts = tstart + 528;
    const int tid = tidx(), lane = tid & 63;
    __syncthreads();
    if (tid < 64) {
        int c[4], tl[4], cs = 0, ts = 0;
#pragma unroll
        for (int i = 0; i < 4; ++i) { c[i] = counts[(lane * 4 + i) * CSTR]; tl[i] = (c[i] + MOE_BM - 1) / MOE_BM; cs += c[i]; ts += tl[i]; }
        int ci = cs, ti = ts;
#pragma unroll
        for (int o = 1; o < 64; o <<= 1) { const int n1 = __shfl_up(ci, o), n2 = __shfl_up(ti, o); if (lane >= o) { ci += n1; ti += n2; } }
        int ce = ci - cs, te = ti - ts;
#pragma unroll
        for (int i = 0; i < 4; ++i) { rstart[lane * 4 + i] = ce; tstart[lane * 4 + i] = te; cnts[lane * 4 + i] = c[i]; ce += c[i]; te += tl[i]; }
        if (lane == 63) { rstart[256] = ce; tstart[256] = te; cnts[256] = T_TOK; rstart[257] = ce + T_TOK; tstart[257] = te + T_TOK / MOE_BM; }
    }
    __syncthreads();
}
DI int find_expert(const int* tstart, int g) {
    int lo = 0, hi = 256;
#pragma unroll 1
    while (lo < hi) { const int mid = (lo + hi + 1) >> 1; if (tstart[mid] <= g) lo = mid; else hi = mid - 1; }
    return lo;
}
struct MoeU { const char* A; const char* B; int e, m0, sub, ui; };
typedef const LAS int* ltab_t;
DI int find_expert_l(ltab_t tstart, int g) { int lo = 0, hi = 256;
#pragma unroll 1
    while (lo < hi) { const int mid = (lo + hi + 1) >> 1; if (tstart[mid] <= g) lo = mid; else hi = mid - 1; }
    return lo; }

struct P6Args { const unsigned char* x1; const int* counts; const int* tokl; const float* gatel; const unsigned char* wgut; unsigned char* H; };
struct GuSched {
    typedef MoeU U;
    ltab_t tab; const LAS int* rowtab; const LAS int* utab; const unsigned char* x1; const unsigned char* wgut; int first, stride, nunits;
    DI bool next(int i, U& u) const {
        const int L = first + i * stride; if (L >= nunits) return false;
        const int g = L >> 1, e = utab[i];
        u.sub = L & 1; u.e = e; u.ui = i; u.m0 = (g - tab[e]) * MOE_BM;
        u.A = (const char*)x1; u.B = (const char*)(wgut + ((size_t)e * 512 + 256 * u.sub) * D_MODEL); return true;
    }
    DI unsigned a_voff(int i, int h, int R, int C) const { return (unsigned)(rowtab[i * 256 + 128 * h + R] * (D_MODEL / 2) + C) * 2u; }
};
struct EpiGU { unsigned char* H; const LAS float* gtab; ltab_t tab; static constexpr int MXS = 0x7A7A7A7A;
    DI void operator()(const f32x4 (&acc)[2][2][4][2], const MoeU& u, int wr, int wc, int fr, int fq) const {
        const int st = tab[264 + u.e], cnt = tab[528 + u.e];
#pragma unroll
        for (int ai = 0; ai < 2; ++ai)
#pragma unroll
            for (int m = 0; m < 4; ++m) {
                const int row = u.m0 + 128 * ai + 64 * wr + 16 * m + fr;
                if (row < cnt) {
                    const float gt = gtab[u.ui * 256 + 128 * ai + 64 * wr + 16 * m + fr] * HSCALE;
                    float h[8];
#pragma unroll
                    for (int n = 0; n < 2; ++n)
#pragma unroll
                        for (int j = 0; j < 4; ++j) { const float gv = acc[ai][0][m][n][j]; h[4 * n + j] = gv * __builtin_amdgcn_rcpf(1.f + __expf(-gv)) * acc[ai][1][m][n][j] * gt; }
                    *(u32x2*)(H + (size_t)(st + row) * D_EXP + 128 * u.sub + 32 * wc + 8 * fq) = (u32x2){pack_fp8x4(h[0], h[1], h[2], h[3]), pack_fp8x4(h[4], h[5], h[6], h[7])};
                }
            }
    } };
DI void phase_moe_gu(const P6Args& a, char* smem, LAS unsigned char* lds) {
    build_moe_tab(a.counts, smem);
    const int* tstart = (const int*)(smem + LDS_TAB); const int* rstart = tstart + 264; int* rowtab = (int*)(smem + LDS_ROWTAB); float* gtab = (float*)(smem + LDS_GTAB);
    const int nunits = tstart[257] * 2, first = vblock();
    const int n_my = first < nunits ? (nunits - first + GRID - 1) / GRID : 0;
    for (int idx = tidx(); idx < n_my * 256; idx += NTHR) {
        const int i = idx >> 8, row = idx & 255, L = first + i * GRID, g = L >> 1, e = find_expert(tstart, g), m0 = (g - tstart[e]) * MOE_BM, cnt = tstart[528 + e];
        int rr = m0 + row; rr = rr < cnt ? rr : cnt - 1;
        rowtab[idx] = e < N_EXP ? a.tokl[(size_t)e * CAP + rr] : rr;
        gtab[idx] = e < N_EXP ? a.gatel[(size_t)e * CAP + rr] : 1.f;
    }
    if (tidx() < 32 && tidx() < n_my) ((int*)(smem + LDS_UTAB))[tidx()] = find_expert(tstart, (first + tidx() * GRID) >> 1);
    __syncthreads();
    GuSched S{(ltab_t)(lds + LDS_TAB), (const LAS int*)(lds + LDS_ROWTAB), (const LAS int*)(lds + LDS_UTAB), a.x1, a.wgut, first, GRID, nunits}; EpiGU E{a.H, (const LAS float*)(lds + LDS_GTAB), (ltab_t)(lds + LDS_TAB)};
    gs::gemm_stream<true, true, 2, false>(lds, D_MODEL / 2, S, E);
}
struct P7Args { const unsigned char* H; const int* counts; const unsigned char* wdt; unsigned char* Y; };
struct DownSched {
    typedef MoeU U;
    ltab_t tab; const LAS int* utab; const unsigned char* H; const unsigned char* wdt; int first, stride, nunits;
    DI bool next(int i, U& u) const {
        const int L = first + i * stride; if (L >= nunits) return false;
        const int g = L >> 2, e = utab[i];
        u.sub = L & 3; u.e = e; u.ui = i; u.m0 = (g - tab[e]) * MOE_BM;
        u.A = (const char*)(H + (size_t)(tab[264 + e] + u.m0) * D_EXP); u.B = (const char*)(wdt + ((size_t)e * D_MODEL + 256 * u.sub) * D_EXP); return true;
    }
    DI unsigned a_voff(int, int h, int R, int C) const { return (unsigned)((128 * h + R) * (D_EXP / 2) + C) * 2u; }
};
struct EpiDown { unsigned char* Y; ltab_t tab; static constexpr int MXS = 0x7D7D7D7D;
    DI void operator()(const f32x4 (&acc)[2][2][4][2], const MoeU& u, int wr, int wc, int fr, int fq) const {
        const int st = tab[264 + u.e], cnt = tab[528 + u.e];
#pragma unroll
        for (int ai = 0; ai < 2; ++ai)
#pragma unroll
            for (int m = 0; m < 4; ++m) {
                const int row = u.m0 + 128 * ai + 64 * wr + 16 * m + fr;
                if (row < cnt) {
                    u32x4 o;
#pragma unroll
                    for (int bj = 0; bj < 2; ++bj) {
                        const f32x4 v0 = acc[ai][bj][m][0], v1 = acc[ai][bj][m][1];
                        o[2 * bj] = pack_fp8x4(v0[0], v0[1], v0[2], v0[3]); o[2 * bj + 1] = pack_fp8x4(v1[0], v1[1], v1[2], v1[3]);
                    }
                    *(u32x4*)(Y + (size_t)(st + row) * D_MODEL + 256 * u.sub + 64 * wc + 16 * fq) = o;
                }
            }
    }
    DI void pack(const f32x4 (&acc)[2][2][4][2], const MoeU& u, int wr, int wc, int fr, int fq, u32x4 (&o)[6], unsigned& base, int& nv) const {
        const int st = tab[264 + u.e], cnt = tab[528 + u.e], row0 = u.m0 + 64 * wr + fr;
        nv = cnt - row0;
        base = (unsigned)(st + row0) * D_MODEL + 256 * u.sub + 64 * wc + 16 * fq;
#pragma unroll
        for (int ai = 0; ai < 2; ++ai)
#pragma unroll
            for (int m = 0; m < 4; ++m) {
                u32x4 w;
#pragma unroll
                for (int bj = 0; bj < 2; ++bj) {
                    const f32x4 v0 = acc[ai][bj][m][0], v1 = acc[ai][bj][m][1];
                    w[2 * bj] = pack_fp8x4(v0[0], v0[1], v0[2], v0[3]); w[2 * bj + 1] = pack_fp8x4(v1[0], v1[1], v1[2], v1[3]);
                }
                if (4 * ai + m < 2) store1(w, base, nv, 4 * ai + m); else o[4 * ai + m - 2] = w;
            }
    }
    DI void store1(const u32x4& v, unsigned base, int nv, int k) const { const int ro = 128 * (k >> 2) + 16 * (k & 3); if (ro < nv) *(u32x4*)(Y + (size_t)(base + (unsigned)ro * D_MODEL)) = v; }
};
DI void phase_moe_down(const P7Args& a, char* smem, LAS unsigned char* lds) {
    const int* tstart = (const int*)(smem + LDS_TAB); const int* rstart = tstart + 264;
    { const int nun = tstart[257] * 4, i = tidx(); if (i < 32 && vblock() + i * GRID < nun) ((int*)(smem + LDS_UTAB))[i] = find_expert(tstart, (vblock() + i * GRID) >> 2); }
    __syncthreads();
    DownSched S{(ltab_t)(lds + LDS_TAB), (const LAS int*)(lds + LDS_UTAB), a.H, a.wdt, vblock(), GRID, tstart[257] * 4}; EpiDown E{a.Y, (ltab_t)(lds + LDS_TAB)};
    gs::gemm_stream<true, true, 2, true>(lds, D_EXP / 2, S, E);
}
struct P8Args { const bf16_t* x1; const unsigned char* Y; const int* slot; const int* counts; const float* ln_g; const float* ln_b; float* out; };
DI void phase_combine(const P8Args& a, char* lds) {
    const int tid = tidx(), wid = tid >> 6, lane = tid & 63;
    const int* rstart = (const int*)(lds + LDS_TAB) + 264;
    const int sh0 = rstart[256];
    const int c0 = 256 * (lane >> 4) + 32 * ((lane >> 2) & 3) + 8 * (lane & 3);
    for (int t = vblock() * 8 + wid; t < T_TOK; t += GRID * 8) {
        float v[16], w[16];
        { const u32x4 p0 = *(const u32x4*)(a.x1 + (size_t)t * D_MODEL + c0), p1 = *(const u32x4*)(a.x1 + (size_t)t * D_MODEL + c0 + 128); unpack16(p0, p1, v); }
        int sl = 0; if (lane < TOP_K) sl = a.slot[t * TOP_K + lane];
        u32x4 yr[9];
        yr[8] = *(const u32x4*)(a.Y + (size_t)(sh0 + t) * D_MODEL + lane * 16);
#pragma unroll
        for (int k = 0; k < TOP_K; ++k) { const int s = __shfl(sl, k), e = s / CAP, pos = s % CAP; yr[k] = *(const u32x4*)(a.Y + (size_t)(rstart[e] + pos) * D_MODEL + lane * 16); }
#pragma unroll
        for (int i = 0; i < 16; ++i) w[i] = 0.f;
#pragma unroll
        for (int k = 0; k < 9; ++k)
#pragma unroll
            for (int j = 0; j < 4; ++j) { const f32x2 lo = __builtin_amdgcn_cvt_pk_f32_fp8((int)yr[k][j], false), hi = __builtin_amdgcn_cvt_pk_f32_fp8((int)yr[k][j], true); w[4 * j] += lo.x; w[4 * j + 1] += lo.y; w[4 * j + 2] += hi.x; w[4 * j + 3] += hi.y; }
#pragma unroll
        for (int i = 0; i < 16; ++i) v[i] = v[i] * DN_ALPHA + w[i] * (1.f / YSCALE);
        float s = 0.f;
#pragma unroll
        for (int i = 0; i < 16; ++i) s += v[i];
#pragma unroll
        for (int o = 32; o >= 1; o >>= 1) s += __shfl_xor(s, o);
        const float mu = s * (1.f / 1024.f);
        float q = 0.f;
#pragma unroll
        for (int i = 0; i < 16; ++i) { const float d = v[i] - mu; q += d * d; }
#pragma unroll
        for (int o = 32; o >= 1; o >>= 1) q += __shfl_xor(q, o);
        const float rstd = rsqrtf(q * (1.f / 1024.f) + LN_EPS);
#pragma unroll
        for (int j = 0; j < 4; ++j) {
            const int col = c0 + 128 * (j >> 1) + 4 * (j & 1);
            const f32x4 g = *(const f32x4*)(a.ln_g + col), bb = *(const f32x4*)(a.ln_b + col);
            f32x4 o; o[0] = (v[4 * j] - mu) * rstd * g[0] + bb[0]; o[1] = (v[4 * j + 1] - mu) * rstd * g[1] + bb[1]; o[2] = (v[4 * j + 2] - mu) * rstd * g[2] + bb[2]; o[3] = (v[4 * j + 3] - mu) * rstd * g[3] + bb[3];
            *(f32x4*)(a.out + (size_t)t * D_MODEL + col) = o;
        }
    }
}
#define MFMA32(a, b, c) __builtin_amdgcn_mfma_f32_32x32x16_bf16((a), (b), (c), 0, 0, 0)
constexpr float SB_EXIT_THR = 1e-30f;
struct P2Args { const bf16_t* Q; const bf16_t* Kb; const bf16_t* Vt; const float* rel_bias; const float* gain_a; const float* gain_b; bf16_t* y; };

DI bf16x8 pack8(const f32x16& x, int s) {
    u32x4 p;
    if (s == 0) { p.x = cvt_pk_bf16(x[0], x[1]); p.y = cvt_pk_bf16(x[2], x[3]); p.z = cvt_pk_bf16(x[4], x[5]); p.w = cvt_pk_bf16(x[6], x[7]); }
    else        { p.x = cvt_pk_bf16(x[8], x[9]); p.y = cvt_pk_bf16(x[10], x[11]); p.z = cvt_pk_bf16(x[12], x[13]); p.w = cvt_pk_bf16(x[14], x[15]); }
    return __builtin_bit_cast(bf16x8, p);
}
DI void load_k(bf16x8 (&k)[4], const bf16_t* kp, int k0) {
#pragma unroll
    for (int kk = 0; kk < 4; ++kk) k[kk] = *(const bf16x8*)(kp + (size_t)(k0 >> 5) * 2048 + kk * 512);
}
DI void load_v(bf16x8 (&v)[2][2], const bf16_t* vp, int k0) {
#pragma unroll
    for (int dt = 0; dt < 2; ++dt)
#pragma unroll
        for (int s = 0; s < 2; ++s) v[dt][s] = *(const bf16x8*)(vp + (size_t)(k0 >> 5) * 2048 + (dt * 2 + s) * 512);
}

constexpr int LDS_CVT = 16 * 1024;
DI void phase_attn(const P2Args& a, const P0Args& cv, char* lds) {
    const int tid = tidx(), wid = tid >> 6, lane = tid & 63, r = lane & 31, h = lane >> 5;
    float* tbl = (float*)lds;
    float* ssq = (float*)(lds + 8 * 260 * 4);
    __syncthreads();
    for (int i = tid; i < NHA * 257; i += NTHR) { const int hd = i / 257, j = i % 257; tbl[hd * 260 + j] = a.rel_bias[i] * LOG2E; }
    __syncthreads();
    const int cgrp = vblock() % 2;
#pragma unroll 1
    for (int slot = 0; slot < 5; ++slot) {
        if ((cgrp == 0 && slot == 0) || (cgrp == 1 && slot == 4)) convert_moe_range(cv, lds + LDS_CVT, 0, CV_GU);
        if (slot == 4) break;
        const int u = vblock() + GRID * (slot >> 1) + 2 * GRID * (slot & 1);
        const bool isB = u >= BATCH * (SEQ / 64); const int uu = isB ? u - BATCH * (SEQ / 64) : u;
        const int b = uu / (SEQ / 64), c = uu % (SEQ / 64), q0 = c * 64, hh = (isB ? NHA : 0) + wid;
        const size_t hb = (size_t)(b * NHH + hh) * SEQ * 64;
        const bf16_t* kp = a.Kb + hb + lane * 8;
        const bf16_t* vp = a.Vt + hb + lane * 8;
        bf16x8 qf[2][4];
#pragma unroll
        for (int qt = 0; qt < 2; ++qt)
#pragma unroll
            for (int kk = 0; kk < 4; ++kk) qf[qt][kk] = *(const bf16x8*)(a.Q + hb + (size_t)((q0 >> 5) + qt) * 2048 + kk * 512 + lane * 8);
        f32x16 ot[2][2];
#pragma unroll
        for (int dt = 0; dt < 2; ++dt)
#pragma unroll
            for (int qt = 0; qt < 2; ++qt)
#pragma unroll
                for (int i = 0; i < 16; ++i) ot[dt][qt][i] = 0.f;
        float linv[2] = {1.f, 1.f};
        if (!isB) {
            float mrun[2] = {-INFINITY, -INFINITY}, lrun[2] = {0.f, 0.f};
            const int klo = q0 - LEFT_CHUNKS * CHUNK < 0 ? 0 : q0 - LEFT_CHUNKS * CHUNK, khi = q0 + 64;
            const float cfar = tbl[wid * 260 + 256];
            bf16x8 kc[4], kn[4], vf[2][2]; load_k(kc, kp, klo);
            for (int k0 = klo; k0 < khi; k0 += 32) {
                load_v(vf, vp, k0);
                load_k(kn, kp, k0 + 32 < khi ? k0 + 32 : k0);
#pragma unroll
                for (int qt = 0; qt < 2; ++qt) {
                    bf16x8 pf[2];
                    f32x16 st;
#pragma unroll
                    for (int i = 0; i < 16; ++i) st[i] = 0.f;
#pragma unroll
                    for (int kk = 0; kk < 4; ++kk) st = MFMA32(kc[kk], qf[qt][kk], st);
                    const int dmin = q0 + 32 * qt - k0 - 31;
                    float boff = 0.f;
                    if (dmin >= MAX_REL) boff = cfar;
                    else {
                        const int bidx = q0 + 32 * qt + r - k0 - 4 * h + MAX_REL;
#pragma unroll
                        for (int i = 0; i < 16; ++i) { int ix = bidx - ((i & 3) + 8 * (i >> 2)); ix = ix < 0 ? 0 : (ix > 2 * MAX_REL ? 2 * MAX_REL : ix); st[i] += tbl[wid * 260 + ix]; }
                    }
                    float mx = st[0];
#pragma unroll
                    for (int i = 1; i < 16; ++i) mx = fmaxf(mx, st[i]);
                    mx = fmaxf(mx, __shfl_xor(mx, 32)) + boff;
                    const float mo = mrun[qt], mn = fmaxf(mo, mx);
                    mrun[qt] = mn;
                    const float eo = boff - mn;
                    float ps = 0.f;
#pragma unroll
                    for (int i = 0; i < 16; ++i) { st[i] = __builtin_amdgcn_exp2f(st[i] + eo); ps += st[i]; }
                    if (__all(mn == mo)) lrun[qt] += ps;
                    else {
                        const float alpha = __builtin_amdgcn_exp2f(mo - mn);
                        lrun[qt] = lrun[qt] * alpha + ps;
#pragma unroll
                        for (int i = 0; i < 16; ++i) { ot[0][qt][i] *= alpha; ot[1][qt][i] *= alpha; }
                    }
                    pf[0] = pack8(st, 0); pf[1] = pack8(st, 1);
#pragma unroll
                    for (int dt = 0; dt < 2; ++dt)
#pragma unroll
                        for (int s = 0; s < 2; ++s) ot[dt][qt] = MFMA32(vf[dt][s], pf[s], ot[dt][qt]);
                }
#pragma unroll
                for (int kk = 0; kk < 4; ++kk) kc[kk] = kn[kk];
            }
#pragma unroll
            for (int qt = 0; qt < 2; ++qt) { const float lt = lrun[qt] + __shfl_xor(lrun[qt], 32); linv[qt] = 1.f / lt; }
        } else {
            float carry[2] = {1.f, 1.f};
            bf16x8 kc[4], kn[4], vf[2][2]; load_k(kc, kp, q0 + 32);
            for (int k0 = q0 + 32; k0 >= 0; k0 -= 32) {
                load_v(vf, vp, k0);
                load_k(kn, kp, k0 >= 32 ? k0 - 32 : k0);
#pragma unroll
                for (int qt = 0; qt < 2; ++qt) {
                    bf16x8 pf[2];
                    f32x16 st;
#pragma unroll
                    for (int i = 0; i < 16; ++i) st[i] = 0.f;
                    const bool none = (k0 > q0 + 32 * qt + 30);
                    if (!none) {
#pragma unroll
                        for (int kk = 0; kk < 4; ++kk) st = MFMA32(kc[kk], qf[qt][kk], st);
                        const bool full = (k0 + 31 < q0 + 32 * qt);
                        const int lim = q0 + 32 * qt + r - k0 - 4 * h;
                        float om[16];
#pragma unroll
                        for (int i = 0; i < 16; ++i) {
                            const float e = __builtin_amdgcn_exp2f(-st[i]); float bta = __builtin_amdgcn_rcpf(1.f + e);
                            if (!full && !(((i & 3) + 8 * (i >> 2)) < lim)) bta = 0.f;
                            st[i] = bta; om[i] = 1.f - bta;
                        }
                        float G[4], Go[4];
#pragma unroll
                        for (int g = 0; g < 4; ++g) { G[g] = (om[4 * g] * om[4 * g + 1]) * (om[4 * g + 2] * om[4 * g + 3]); Go[g] = __shfl_xor(G[g], 32); }
                        float R = carry[qt];
#pragma unroll
                        for (int g = 3; g >= 0; --g) {
                            float run = h == 0 ? R * Go[g] : R;
#pragma unroll
                            for (int uu2 = 3; uu2 >= 0; --uu2) { const float bta = st[4 * g + uu2]; st[4 * g + uu2] = bta * run; run *= om[4 * g + uu2]; }
                            R = R * (G[g] * Go[g]);
                        }
                        carry[qt] = R;
                    }
                    if (!none) {
                        pf[0] = pack8(st, 0); pf[1] = pack8(st, 1);
#pragma unroll
                        for (int dt = 0; dt < 2; ++dt)
#pragma unroll
                            for (int s = 0; s < 2; ++s) ot[dt][qt] = MFMA32(vf[dt][s], pf[s], ot[dt][qt]);
                    }
                }
#pragma unroll
                for (int kk = 0; kk < 4; ++kk) kc[kk] = kn[kk];
                if (__all(carry[0] < SB_EXIT_THR && carry[1] < SB_EXIT_THR)) break;
            }
        }
        float ss[2];
#pragma unroll
        for (int qt = 0; qt < 2; ++qt) {
            float s2 = 0.f;
#pragma unroll
            for (int dt = 0; dt < 2; ++dt)
#pragma unroll
                for (int i = 0; i < 16; ++i) { ot[dt][qt][i] *= linv[qt]; s2 += ot[dt][qt][i] * ot[dt][qt][i]; }
            s2 += __shfl_xor(s2, 32); ss[qt] = s2;
        }
        __syncthreads();
        if (h == 0) { ssq[wid * 64 + r] = ss[0]; ssq[wid * 64 + 32 + r] = ss[1]; }
        __syncthreads();
        const float* gain = isB ? a.gain_b : a.gain_a;
#pragma unroll
        for (int qt = 0; qt < 2; ++qt) {
            float tot = 0.f;
#pragma unroll
            for (int w8 = 0; w8 < 8; ++w8) tot += ssq[w8 * 64 + 32 * qt + r];
            const float rs = rsqrtf(tot * (1.f / 512.f) + RMS_EPS);
            char* yst = lds + LDS_CVT + wid * (64 * 136);
#pragma unroll
            for (int dt = 0; dt < 2; ++dt)
#pragma unroll
                for (int g = 0; g < 4; ++g) {
                    const int d = 32 * dt + 8 * g + 4 * h; const f32x4 gn = *(const f32x4*)(gain + wid * 64 + d);
                    u32x2 o; o.x = cvt_pk_bf16(ot[dt][qt][4 * g] * rs * gn[0], ot[dt][qt][4 * g + 1] * rs * gn[1]); o.y = cvt_pk_bf16(ot[dt][qt][4 * g + 2] * rs * gn[2], ot[dt][qt][4 * g + 3] * rs * gn[3]);
                    *(u32x2*)(yst + (32 * qt + r) * 136 + d * 2) = o;
                }
        }
        {
            char* yst = lds + LDS_CVT + wid * (64 * 136);
            bf16_t* yb = a.y + (size_t)(b * SEQ + q0) * D_MODEL + (isB ? 512 : 0) + wid * 64;
#pragma unroll
            for (int j = 0; j < 8; ++j) {
                const int tok = (lane >> 3) + 8 * j, ch = lane & 7;
                const u32x2 lo = *(const u32x2*)(yst + tok * 136 + ch * 16), hi = *(const u32x2*)(yst + tok * 136 + ch * 16 + 8);
                *(u32x4*)(yb + (size_t)tok * D_MODEL + ch * 8) = (u32x4){lo.x, lo.y, hi.x, hi.y};
            }
        }
    }
}


#define XB_TMO      128
#define XB_XCNT(j)  (256  + 64 * (j))
#define XB_XSUB(j)  (1280 + 64 * (j))
#define XB_XGEN(j)  (2304 + 64 * (j))
#define XB_TOP      3328
#define XB_TOPGEN   3392
#define XCD_BAR_WORDS 3456
#define XB_SPIN_CAP (1u << 18)
#define LAS __attribute__((address_space(3)))

__device__ __forceinline__ unsigned xb_ld(unsigned* p)              { return __hip_atomic_load(p, __ATOMIC_RELAXED, __HIP_MEMORY_SCOPE_AGENT); }
__device__ __forceinline__ unsigned xb_add(unsigned* p, unsigned v) { return __hip_atomic_fetch_add(p, v, __ATOMIC_RELAXED, __HIP_MEMORY_SCOPE_AGENT); }
__device__ __forceinline__ unsigned xb_xcc_id() { return (unsigned)__builtin_amdgcn_s_getreg((3 << 11) | 20) & 0xFu; }
#define XB_SPIN(cond, bar) do { unsigned _sp = 0; while (cond) { __builtin_amdgcn_s_sleep(1); \
    if ((++_sp & 255u) == 0u) { if (xb_ld(&(bar)[XB_TMO])) break; if (_sp > XB_SPIN_CAP) { atomicAdd(&(bar)[XB_TMO], 1u); break; } } } } while (0)

struct XcdBarrier {
    unsigned* bar; unsigned x;
    volatile LAS unsigned* st;
};

__device__ __forceinline__ XcdBarrier xcd_barrier_post(unsigned* bar, volatile LAS unsigned* st) {
    XcdBarrier b; b.bar = bar; b.x = xb_xcc_id(); b.st = st;
    if (threadIdx.x == 0) (void)xb_add(&bar[XB_XCNT(b.x)], 1u);
    return b;
}
__device__ __forceinline__ void xcd_barrier_complete(unsigned* bar, unsigned x, unsigned& nloc, unsigned& nx) {
    const unsigned G = gridDim.x * gridDim.y * gridDim.z;
    unsigned sum, cnt, mine, sp = 0u;
    for (;;) {
        sum = 0u; cnt = 0u; mine = 0u;
#pragma unroll
        for (unsigned j = 0; j < 16; ++j) { const unsigned c = xb_ld(&bar[XB_XCNT(j)]); sum += c; cnt += (c > 0u) ? 1u : 0u; mine = (j == x) ? c : mine; }
        if (sum == G) break;
        __builtin_amdgcn_s_sleep(1);
        if ((++sp & 255u) == 0u) { if (xb_ld(&bar[XB_TMO])) break; if (sp > XB_SPIN_CAP) { atomicAdd(&bar[XB_TMO], 1u); break; } }
    }
    nloc = mine > 0u ? mine : 1u; nx = cnt > 0u ? cnt : 1u;
}

__device__ __forceinline__ void xcd_barrier(const XcdBarrier& b) {
    asm volatile("s_waitcnt vmcnt(0)" ::: "memory");
    __syncthreads();
    if (threadIdx.x == 0) {
        unsigned* bar = b.bar;
        __builtin_amdgcn_s_waitcnt(0);
        unsigned nloc = b.st[0], nx = b.st[1];
        if (nloc == 0u) { xcd_barrier_complete(bar, b.x, nloc, nx); b.st[0] = nloc; b.st[1] = nx; }
        const unsigned old = xb_add(&bar[XB_XSUB(b.x)], 1u);
        const unsigned gen = old / nloc;
        if (old + 1u == (gen + 1u) * nloc) {
            __builtin_amdgcn_fence(__ATOMIC_RELEASE, "agent");
            asm volatile("s_waitcnt vmcnt(0)" ::: "memory");
            const unsigned og = xb_add(&bar[XB_TOP], 1u);
            const unsigned tg = og / nx;
            if (og + 1u == (tg + 1u) * nx) xb_add(&bar[XB_TOPGEN], 1u);
            else XB_SPIN(xb_ld(&bar[XB_TOPGEN]) == tg, bar);
            __builtin_amdgcn_fence(__ATOMIC_ACQUIRE, "agent");
            xb_add(&bar[XB_XGEN(b.x)], 1u);
            asm volatile("s_waitcnt vmcnt(0)" ::: "memory");
        } else {
            XB_SPIN(xb_ld(&bar[XB_XGEN(b.x)]) == gen, bar);
            __builtin_amdgcn_fence(__ATOMIC_ACQUIRE, "agent");
            asm volatile("s_waitcnt vmcnt(0)" ::: "memory");
        }
    }
    __syncthreads();
}


struct MegaArgs { P0Args p0; P1Args p1; P2Args p2; P3Args p3; P4Args p4; P6Args p6; P7Args p7; P8Args p8; unsigned* bar; };
__global__ __launch_bounds__(NTHR, 2) void k_mega(MegaArgs a) {
    extern __shared__ __attribute__((aligned(16))) char smem[];
    asm volatile("s_setreg_imm32_b32 hwreg(HW_REG_MODE, 23, 1), 1");
    volatile LAS unsigned* xbw = (volatile LAS unsigned*)(smem + LDS_BYTES - 16);
    if (threadIdx.x == 0) { xbw[0] = 0u; xbw[1] = 0u; xbw[2] = 0u; xbw[3] = 0u; }
    __syncthreads();
    XcdBarrier bar = xcd_barrier_post(a.bar, xbw);
    LAS unsigned char* L = (LAS unsigned char*)smem;
    phase_prologue(a.p0, smem);     xcd_barrier(bar);
    phase_qkv(a.p1, L);             xcd_barrier(bar);
    phase_attn(a.p2, a.p0, smem);   xcd_barrier(bar);
    phase_outproj(a.p3, L);         xcd_barrier(bar);
    phase_router(a.p4, a.p0, smem); xcd_barrier(bar);
    phase_moe_gu(a.p6, smem, L);    xcd_barrier(bar);
    phase_moe_down(a.p7, smem, L);  xcd_barrier(bar);
    phase_combine(a.p8, smem);
}

extern "C" void kernel_launch(void* const* d_in, const int* in_sizes, int n_in, void* d_out, int out_size, void* d_ws, size_t ws_size, hipStream_t stream) {
    const float* x = (const float*)d_in[0];      const float* w_in = (const float*)d_in[1];   const float* rel_bias = (const float*)d_in[2];
    const float* gain_a = (const float*)d_in[3]; const float* gain_b = (const float*)d_in[4]; const float* w_out = (const float*)d_in[5];
    const float* ln1_g = (const float*)d_in[6];  const float* ln1_b = (const float*)d_in[7];  const float* router_w = (const float*)d_in[8];
    const float* router_bias = (const float*)d_in[9]; const float* w_gate = (const float*)d_in[10]; const float* w_up = (const float*)d_in[11];
    const float* w_down = (const float*)d_in[12]; const float* ws_gate = (const float*)d_in[13]; const float* ws_up = (const float*)d_in[14];
    const float* ws_down = (const float*)d_in[15]; const float* ln2_g = (const float*)d_in[16]; const float* ln2_b = (const float*)d_in[17];
    char* ws = (char*)d_ws; float* out = (float*)d_out;
    int* ctrl = (int*)(ws + OFF_CTRL); int* counts = ctrl + CW_COUNTS;
    bf16_t* X1 = (bf16_t*)(ws + OFF_X1); int* tokl = (int*)(ws + OFF_TOKL); float* gatel = (float*)(ws + OFF_GATEL);
    int* eidx = (int*)(ws + OFF_EIDX); float* gate = (float*)(ws + OFF_GATE); int* slot = (int*)(ws + OFF_SLOT);
    unsigned char* H = (unsigned char*)(ws + OFF_H); unsigned char* Y = (unsigned char*)(ws + OFF_Y); unsigned char* x1f8 = (unsigned char*)(ws + OFF_X1F8);
    bf16_t* Q = (bf16_t*)(ws + OFF_Q); bf16_t* Kb = (bf16_t*)(ws + OFF_K); bf16_t* Vt = (bf16_t*)(ws + OFF_VT);
    bf16_t* yatt = (bf16_t*)(ws + OFF_YATT); bf16_t* r = (bf16_t*)(ws + OFF_R);
    bf16_t* xb = (bf16_t*)(ws + OFF_XB);
    bf16_t* wt_in = (bf16_t*)(ws + OFF_WTIN); bf16_t* wt_out = (bf16_t*)(ws + OFF_WTOUT); bf16_t* wt_r = (bf16_t*)(ws + OFF_WTR);
    unsigned char* wgut = (unsigned char*)(ws + OFF_WGUT); unsigned char* wdt = (unsigned char*)(ws + OFF_WDT);
    if (ws_size < WS_NEEDED) { fprintf(stderr, "kernel_launch: workspace too small (%zu < %zu)\n", ws_size, (size_t)WS_NEEDED); return; }
    hipMemsetAsync(ctrl, 0, 128 * 1024, stream);
    static bool attr_done = false;
    if (!attr_done) {
        hipFuncSetAttribute((const void*)k_mega, hipFuncAttributeMaxDynamicSharedMemorySize, LDS_BYTES);
        attr_done = true;
    }
    MegaArgs m{};
    m.p0 = P0Args{x, w_in, w_out, router_w, xb, wt_in, wt_out, wt_r, w_gate, w_up, w_down, ws_gate, ws_up, ws_down, wgut, wdt};
    m.p1 = P1Args{xb, wt_in, Q, Kb, Vt};
    m.p2 = P2Args{Q, Kb, Vt, rel_bias, gain_a, gain_b, yatt};
    m.p3 = P3Args{yatt, wt_out, r};
    m.p4 = P4Args{r, xb, ln1_g, ln1_b, X1, x1f8, wt_r, router_bias, eidx, gate, counts, tokl, gatel, slot};
    m.p6 = P6Args{x1f8, counts, tokl, gatel, wgut, H};
    m.p7 = P7Args{H, counts, wdt, Y};
    m.p8 = P8Args{X1, Y, slot, counts, ln2_g, ln2_b, out};
    m.bar = (unsigned*)ctrl;
    k_mega<<<GRID, NTHR, LDS_BYTES, stream>>>(m);
}
```

```cpp
#include <hip/hip_runtime.h>
#include <cstdint>
#include <cstdio>

typedef unsigned short bf16_t;

constexpr int D_MODEL = 1024, BATCH = 16, SEQ = 2048, T_TOK = BATCH * SEQ;
constexpr int HEAD_DIM = 64, NHA = 8, NHB = 8, NHH = 16;
constexpr int CHUNK = 64, LEFT_CHUNKS = 8, MAX_REL = 128;
constexpr int N_EXP = 256, TOP_K = 8, N_GROUPS = 8, TOPK_GROUPS = 4, EPG = 32, D_EXP = 256;
constexpr float ROUTED_SCALE = 2.5f, LN_EPS = 1e-5f, RMS_EPS = 1e-6f;
constexpr float DN_ALPHA = 1.189207115002721f;
constexpr float LOG2E = 1.4426950408889634f, LN2 = 0.6931471805599453f;
constexpr float QSCALE = 0.125f * LOG2E;
constexpr float WSCALE = 64.f, XSCALE = 16.f, HSCALE = 16.f;
constexpr float YSCALE = 64.f;
constexpr int CAP = T_TOK;
constexpr int ROWS_ALL = T_TOK * TOP_K + T_TOK;

__device__ __forceinline__ float bf2f(bf16_t v) { return __uint_as_float(((unsigned)v) << 16); }
__device__ __forceinline__ bf16_t f2bf(float f) { unsigned u = __float_as_uint(f); u += 0x7fffu + ((u >> 16) & 1u); return (bf16_t)(u >> 16); }

constexpr size_t MB = 1024ull * 1024ull;
constexpr size_t OFF_CTRL   = 0;
constexpr size_t OFF_X1     = 1 * MB;
constexpr size_t OFF_TOKL   = OFF_X1 + 64 * MB;
constexpr size_t OFF_GATEL  = OFF_TOKL + 32 * MB;
constexpr size_t OFF_EIDX   = OFF_GATEL + 32 * MB;
constexpr size_t OFF_GATE   = OFF_EIDX + 1 * MB;
constexpr size_t OFF_SLOT   = OFF_GATE + 1 * MB;
constexpr size_t OFF_WDT    = OFF_SLOT + 1 * MB;
constexpr size_t OFF_X1F8   = OFF_WDT + 72 * MB;
constexpr size_t OFF_BIG    = OFF_WDT + 129 * MB;
constexpr size_t OFF_H      = OFF_BIG;
constexpr size_t OFF_Y      = OFF_BIG + 144 * MB;
constexpr size_t OFF_Q      = OFF_BIG;
constexpr size_t OFF_K      = OFF_BIG + 64 * MB;
constexpr size_t OFF_VT     = OFF_BIG + 128 * MB;
constexpr size_t OFF_YATT   = OFF_BIG + 192 * MB;
constexpr size_t OFF_R      = OFF_BIG + 256 * MB;
constexpr size_t OFF_XB     = OFF_BIG + 320 * MB;
constexpr size_t OFF_WTIN   = OFF_BIG + 392 * MB;
constexpr size_t OFF_WTOUT  = OFF_BIG + 398 * MB;
constexpr size_t OFF_WTR    = OFF_BIG + 400 * MB;
constexpr size_t OFF_WGUT   = OFF_BIG + 401 * MB;
constexpr size_t WS_NEEDED  = OFF_BIG + 720 * MB;
static_assert(OFF_WGUT + 257 * MB <= WS_NEEDED && WS_NEEDED <= 1024 * MB, "workspace map");
constexpr int CW_COUNTS = 8192;
constexpr int CSTR = 64;

typedef short bf16x8 __attribute__((ext_vector_type(8)));
typedef float f32x4 __attribute__((ext_vector_type(4)));
typedef float f32x2 __attribute__((ext_vector_type(2)));
typedef float f32x16 __attribute__((ext_vector_type(16)));
typedef unsigned u32x4 __attribute__((ext_vector_type(4)));
typedef unsigned u32x2 __attribute__((ext_vector_type(2)));
#define DI __device__ __forceinline__
constexpr int NTHR = 512, GRID = 256;
DI int tidx() { int t = threadIdx.x; asm volatile("" : "+v"(t)); return t; }
constexpr int LDS_BYTES = 160 * 1024;

typedef __bf16 bf16x2_t __attribute__((ext_vector_type(2)));
DI unsigned cvt_pk_bf16(float lo, float hi) { f32x2 v = {lo, hi}; bf16x2_t r = __builtin_convertvector(v, bf16x2_t); return __builtin_bit_cast(unsigned, r); }
DI unsigned pack_fp8x4(float a, float b, float c, float d) { int w = 0; w = __builtin_amdgcn_cvt_pk_fp8_f32(a, b, w, false); w = __builtin_amdgcn_cvt_pk_fp8_f32(c, d, w, true); return (unsigned)w; }
DI int vblock() { return (int)((blockIdx.x & 7) * (GRID / 8) + (blockIdx.x >> 3)); }

template <int MT> struct Tile { static constexpr int BM = 32 * MT, A_BYTES = BM * 128, B_BYTES = 256 * 128, STAGE = A_BYTES + B_BYTES; };

template <int MT> struct ALoader {
    const bf16_t* p[MT / 2]; u32x4 v[MT / 2]; int off0;
    DI void init_rows(const bf16_t* A, int lda, int row0) {
        const int tid = tidx(), kc = tid & 7, r = tid >> 3;
#pragma unroll
        for (int i = 0; i < MT / 2; ++i) p[i] = A + (size_t)(row0 + r + 64 * i) * lda + kc * 8;
        off0 = r * 128 + ((kc ^ ((r >> 1) & 7)) << 4);
    }
    DI void init_gather(const bf16_t* A, int lda, const int* rows, int cnt, int m0) {
        const int tid = tidx(), kc = tid & 7, r = tid >> 3;
#pragma unroll
        for (int i = 0; i < MT / 2; ++i) { int rr = m0 + r + 64 * i; rr = rr < cnt ? rr : cnt - 1; const int g = rows ? rows[rr] : rr; p[i] = A + (size_t)g * lda + kc * 8; }
        off0 = r * 128 + ((kc ^ ((r >> 1) & 7)) << 4);
    }
    DI void load(int k0) {
#pragma unroll
        for (int i = 0; i < MT / 2; ++i) v[i] = *(const u32x4*)(p[i] + k0);
    }
    DI void store(char* ldsA) const {
#pragma unroll
        for (int i = 0; i < MT / 2; ++i) *(u32x4*)(ldsA + off0 + i * 8192) = v[i];
    }
};
struct BLoaderBt {
    const bf16_t* p[4]; u32x4 v[4]; int off0;
    DI void init(const bf16_t* Bt, int ldk, int n0) {
        const int tid = tidx(), kc = tid & 7, r = tid >> 3;
#pragma unroll
        for (int i = 0; i < 4; ++i) p[i] = Bt + (size_t)(n0 + r + 64 * i) * ldk + kc * 8;
        off0 = r * 128 + ((kc ^ ((r >> 1) & 7)) << 4);
    }
    DI void load(int k0) {
#pragma unroll
        for (int i = 0; i < 4; ++i) v[i] = *(const u32x4*)(p[i] + k0);
    }
    DI void store(char* ldsB) const {
#pragma unroll
        for (int i = 0; i < 4; ++i) *(u32x4*)(ldsB + off0 + i * 8192) = v[i];
    }
};
template <int MT, bool TR, class AL, class BL>
DI void gemm_tile(char* lds, AL& al, BL& bl, int nk, f32x4 (&acc)[MT][4]) {
    typedef Tile<MT> TT;
    const int tid = tidx(), wid = tid >> 6, lane = tid & 63, wr = wid >> 2, wc = wid & 3, fr = lane & 15, fq = lane >> 4;
#pragma unroll
    for (int m = 0; m < MT; ++m)
#pragma unroll
        for (int n = 0; n < 4; ++n) acc[m][n] = (f32x4){0.f, 0.f, 0.f, 0.f};
    int aoff[2], boff[2];
#pragma unroll
    for (int ks = 0; ks < 2; ++ks) { const int ch = (((4 * ks + fq) ^ (fr >> 1)) << 4); aoff[ks] = (16 * MT * wr + fr) * 128 + ch; boff[ks] = TT::A_BYTES + (64 * wc + fr) * 128 + ch; }
    al.load(0); bl.load(0);
    __syncthreads();
    al.store(lds); bl.store(lds + TT::A_BYTES);
    __syncthreads();
    for (int kt = 0; kt < nk; ++kt) {
        char* cur = lds + (kt & 1) * TT::STAGE; char* nxt = lds + ((kt & 1) ^ 1) * TT::STAGE;
        const bool more = kt + 1 < nk;
        if (more) { al.load((kt + 1) * 64); bl.load((kt + 1) * 64); }
#pragma unroll
        for (int ks = 0; ks < 2; ++ks) {
            bf16x8 a[MT], b[4];
#pragma unroll
            for (int m = 0; m < MT; ++m) a[m] = *(const bf16x8*)(cur + aoff[ks] + m * 2048);
#pragma unroll
            for (int n = 0; n < 4; ++n) b[n] = *(const bf16x8*)(cur + boff[ks] + n * 2048);
#pragma unroll
            for (int m = 0; m < MT; ++m)
#pragma unroll
                for (int n = 0; n < 4; ++n)
                    acc[m][n] = TR ? __builtin_amdgcn_mfma_f32_16x16x32_bf16(b[n], a[m], acc[m][n], 0, 0, 0) : __builtin_amdgcn_mfma_f32_16x16x32_bf16(a[m], b[n], acc[m][n], 0, 0, 0);
        }
        if (more) { al.store(nxt); bl.store(nxt + TT::A_BYTES); }
        __syncthreads();
    }
}

#define LAS __attribute__((address_space(3)))
namespace gs {
constexpr int BM = 256, BK = 64, HALF = 128, HTB = HALF * BK * 2, STAGE_BYTES = 8 * HTB;
DI int lds_byte(int r, int c) { const int st = (r >> 4) * 2 + (c >> 5), rr = r & 15, cc = c & 31, ob = rr * 64 + cc * 2; return st * 1024 + (ob ^ (((ob >> 9) & 1) << 5)); }
DI void stage_rc(int b, int& R, int& C) { const int st = b / 1024, sb = b % 1024, swz = sb ^ (((sb >> 9) & 1) << 5); R = (st >> 1) * 16 + swz / 64; C = (st & 1) * 32 + (swz % 64) / 2; }
DI int perm32(int rho) { const int n = rho >> 4, i = rho & 15; return 8 * (i >> 2) + 4 * n + (i & 3); }
typedef long i64x2 __attribute__((ext_vector_type(2)));
DI const char* uni(const char* p) { const unsigned long long v = (unsigned long long)p; const unsigned lo = __builtin_amdgcn_readfirstlane((unsigned)v), hi = __builtin_amdgcn_readfirstlane((unsigned)(v >> 32)); return (const char*)(((unsigned long long)hi << 32) | lo); }
template <bool TR, bool F8>
DI f32x4 mma16(const bf16x8& a, const bf16x8& b, f32x4 c) {
    if (F8) {
        const i64x2 a2 = __builtin_bit_cast(i64x2, a), b2 = __builtin_bit_cast(i64x2, b);
        c = TR ? __builtin_amdgcn_mfma_f32_16x16x32_fp8_fp8(b2[0], a2[0], c, 0, 0, 0) : __builtin_amdgcn_mfma_f32_16x16x32_fp8_fp8(a2[0], b2[0], c, 0, 0, 0);
        return TR ? __builtin_amdgcn_mfma_f32_16x16x32_fp8_fp8(b2[1], a2[1], c, 0, 0, 0) : __builtin_amdgcn_mfma_f32_16x16x32_fp8_fp8(a2[1], b2[1], c, 0, 0, 0);
    }
    return TR ? __builtin_amdgcn_mfma_f32_16x16x32_bf16(b, a, c, 0, 0, 0) : __builtin_amdgcn_mfma_f32_16x16x32_bf16(a, b, c, 0, 0, 0);
}
typedef int i32x8 __attribute__((ext_vector_type(8)));
typedef short bf16x16 __attribute__((ext_vector_type(16)));
template <bool TR, int SC>
DI f32x4 mma128(const bf16x16& a, const bf16x16& b, f32x4 c) {
    const i32x8 av = __builtin_bit_cast(i32x8, a), bv = __builtin_bit_cast(i32x8, b);
    const int one = SC;
    if (TR) asm volatile("v_mfma_scale_f32_16x16x128_f8f6f4 %0, %1, %2, %0, %3, %3 op_sel_hi:[0,0,0]" : "+v"(c) : "v"(bv), "v"(av), "v"(one));
    else    asm volatile("v_mfma_scale_f32_16x16x128_f8f6f4 %0, %1, %2, %0, %3, %3 op_sel_hi:[0,0,0]" : "+v"(c) : "v"(av), "v"(bv), "v"(one));
    return c;
}
template <bool TR, int SC>
DI f32x4 mma128z(const bf16x16& a, const bf16x16& b) {
    const i32x8 av = __builtin_bit_cast(i32x8, a), bv = __builtin_bit_cast(i32x8, b);
    const int one = SC; f32x4 c;
    if (TR) asm volatile("v_mfma_scale_f32_16x16x128_f8f6f4 %0, %1, %2, 0, %3, %3 op_sel_hi:[0,0,0]" : "=&v"(c) : "v"(bv), "v"(av), "v"(one));
    else    asm volatile("v_mfma_scale_f32_16x16x128_f8f6f4 %0, %1, %2, 0, %3, %3 op_sel_hi:[0,0,0]" : "=&v"(c) : "v"(av), "v"(bv), "v"(one));
    return c;
}
DI bf16x8 frag_lo(const bf16x16& v) { return __builtin_shufflevector(v, v, 0, 1, 2, 3, 4, 5, 6, 7); }
DI bf16x8 frag_hi(const bf16x16& v) { return __builtin_shufflevector(v, v, 8, 9, 10, 11, 12, 13, 14, 15); }
template <int N> DI void wait_vm() { asm volatile("s_waitcnt vmcnt(%0)" :: "n"(N) : "memory"); }
template <bool TR, bool PERM, int F8, bool SPLIT, class Sched, class Epi>
DI void gemm_stream(LAS unsigned char* lds, const int K, const Sched& S, const Epi& E) {
    typedef typename Sched::U U;
    const int tid = tidx(), wid = __builtin_amdgcn_readfirstlane(tid >> 6), lane = tid & 63, wr = wid >> 2, wc = wid & 3, fr = lane & 15, fq = lane >> 4;
    const int nt = K / BK;
    constexpr int NJ = SPLIT ? 4 : 2, JSTEP = SPLIT ? 4096 : 8192;
    const bool dma = !SPLIT || wr == 0;
    int R[NJ], C[NJ]; unsigned voffB[NJ], voffA[NJ];
#pragma unroll
    for (int i = 0; i < NJ; ++i) { stage_rc((SPLIT ? wc * 1024 + lane * 16 : tid * 16) + i * JSTEP, R[i], C[i]); const int Rb = PERM ? ((R[i] & ~31) + perm32(R[i] & 31)) : R[i]; voffB[i] = (unsigned)(Rb * K + C[i]) * 2u;
                                   voffA[i] = SPLIT ? S.a_voff(0, 0, R[i], C[i]) : 0u; }
    const unsigned hstepA = (unsigned)HALF * K * 2;
    const size_t kstep = (size_t)(BK * 2), hstepB = (size_t)HALF * K * 2;
    const unsigned ldsw = (unsigned)(SPLIT ? wc : wid) * 1024u;
    const int aoff = lds_byte(wr * 64 + fr, fq * 8), boff = lds_byte(wc * 32 + fr, fq * 8);
#define GS_SA(b, h) (((b) * 2 + (h)) * HTB)
#define GS_SB(b, h) ((4 + (b) * 2 + (h)) * HTB)
#define GS_STAGE(bufoff, gbase, uix, h) do { if (dma) { _Pragma("unroll") for (int _i = 0; _i < NJ; ++_i) \
        __builtin_amdgcn_global_load_lds((const unsigned*)((const char*)(gbase) + (SPLIT ? voffA[_i] + (h) * hstepA : S.a_voff(uix, h, R[_i], C[_i]))), (LAS unsigned*)(lds + (bufoff) + ldsw + _i * JSTEP), 16, 0, 0); } } while (0)
#define GS_STAGEB(bufoff, gbase, voff) do { if (dma) { _Pragma("unroll") for (int _i = 0; _i < NJ; ++_i) \
        __builtin_amdgcn_global_load_lds((const unsigned*)((const char*)(gbase) + (voff)[_i]), (LAS unsigned*)(lds + (bufoff) + ldsw + _i * JSTEP), 16, 0, 0); } } while (0)
#define GS_LD32(base) __builtin_shufflevector(*(const LAS bf16x8*)(base), *(const LAS bf16x8*)((base) + 1024), 0, 1, 2, 3, 4, 5, 6, 7, 8, 9, 10, 11, 12, 13, 14, 15)
#define GS_LDA(dst, b, h) do { _Pragma("unroll") for (int m = 0; m < 4; ++m) dst[m] = GS_LD32(lds + GS_SA(b, h) + aoff + m * 2048); } while (0)
#define GS_LDB(dst, b, h) do { _Pragma("unroll") for (int n = 0; n < 2; ++n) dst[n] = GS_LD32(lds + GS_SB(b, h) + boff + n * 2048); } while (0)
#define GS_MMA(ai, bj, At, Bt) do { __builtin_amdgcn_s_setprio(1); _Pragma("unroll") for (int m = 0; m < 4; ++m) _Pragma("unroll") for (int n = 0; n < 2; ++n) { \
        if (F8 == 2) acc[ai][bj][m][n] = mma128<TR, Epi::MXS>(At[m], Bt[n], acc[ai][bj][m][n]); \
        else { acc[ai][bj][m][n] = mma16<TR, F8 == 1>(frag_lo(At[m]), frag_lo(Bt[n]), acc[ai][bj][m][n]); acc[ai][bj][m][n] = mma16<TR, F8 == 1>(frag_hi(At[m]), frag_hi(Bt[n]), acc[ai][bj][m][n]); } } \
        __builtin_amdgcn_s_setprio(0); } while (0)
#define GS_MMAZ(ai, bj, At, Bt) do { __builtin_amdgcn_s_setprio(1); _Pragma("unroll") for (int m = 0; m < 4; ++m) _Pragma("unroll") for (int n = 0; n < 2; ++n) { \
        if (F8 == 2) acc[ai][bj][m][n] = mma128z<TR, Epi::MXS>(At[m], Bt[n]); \
        else { acc[ai][bj][m][n] = mma16<TR, F8 == 1>(frag_lo(At[m]), frag_lo(Bt[n]), (f32x4){0.f, 0.f, 0.f, 0.f}); acc[ai][bj][m][n] = mma16<TR, F8 == 1>(frag_hi(At[m]), frag_hi(Bt[n]), acc[ai][bj][m][n]); } } \
        __builtin_amdgcn_s_setprio(0); } while (0)
#define GS_WAIT_V(n) do { if (SPLIT) { if (wr == 0) wait_vm<2 * (n)>(); } else wait_vm<(n)>(); } while (0)
#define GS_WAIT_L(n) asm volatile("s_waitcnt lgkmcnt(" #n ")" ::: "memory")
#define GS_BAR __builtin_amdgcn_s_barrier()
#define GS_SCHED __builtin_amdgcn_sched_barrier(0)
    U cur, nxt; int ui = 0;
    if (!S.next(0, cur)) return;
    f32x4 acc[2][2][4][2];
    u32x4 dq[6]; unsigned dbase = 0u; int dnv = 0;
    bf16x16 At[4], B0[2], B1[2];
    const char* cA = uni(cur.A); const char* cB = uni(cur.B);
    GS_STAGEB(GS_SB(0, 0), cB, voffB); GS_STAGEB(GS_SB(0, 1), cB + hstepB, voffB); GS_STAGE(GS_SA(0, 0), cA, 0, 0); GS_STAGE(GS_SA(0, 1), cA, 0, 1);
    if (wr == 1) GS_BAR;
    GS_WAIT_V(2); GS_BAR;
    GS_STAGEB(GS_SB(1, 0), cB + kstep, voffB); GS_STAGE(GS_SA(1, 0), cA + kstep, 0, 0); GS_STAGEB(GS_SB(1, 1), cB + hstepB + kstep, voffB);
    GS_WAIT_V(6); GS_BAR;
    for (;;) {
        const bool has_next = S.next(ui + 1, nxt);
        const int nui = has_next ? ui + 1 : ui;
        const char* nA = uni(has_next ? nxt.A : cA); const char* nB = uni(has_next ? nxt.B : cB);
#define GS_TRIP(T, MM, W0, DEF) do { \
            const bool last = ((T) == nt - 2); \
            const char* a1 = uni(cA + (size_t)((T) + 1) * kstep); \
            const char* a2 = uni(last ? nA : cA + (size_t)((T) + 2) * kstep); const char* b2 = uni(last ? nB : cB + (size_t)((T) + 2) * kstep); \
            const char* a3 = uni(a2 + kstep); const char* b3 = uni(b2 + kstep); \
            const int u2 = last ? nui : ui; \
              \
            GS_LDB(B0, 0, 0); GS_LDB(B1, 0, 1); GS_SCHED; GS_LDA(At, 0, 0); GS_STAGE(GS_SA(1, 1), a1, ui, 1); \
            if (W0) GS_WAIT_V(8); GS_WAIT_L(0); GS_BAR; MM(0, 0, At, B0); MM(0, 1, At, B1); DEF(0); GS_BAR; GS_SCHED; \
              \
            GS_LDA(At, 0, 1); GS_STAGEB(GS_SB(0, 0), b2, voffB); GS_STAGEB(GS_SB(0, 1), b2 + hstepB, voffB); GS_STAGE(GS_SA(0, 0), a2, u2, 0); \
            GS_WAIT_V(8); GS_WAIT_L(0); GS_BAR; MM(1, 0, At, B0); MM(1, 1, At, B1); DEF(1); GS_BAR; GS_SCHED; \
              \
            GS_LDB(B0, 1, 0); GS_LDB(B1, 1, 1); GS_SCHED; GS_LDA(At, 1, 0); GS_STAGE(GS_SA(0, 1), a2, u2, 1); \
            GS_WAIT_V(8); GS_WAIT_L(0); GS_BAR; GS_MMA(0, 0, At, B0); GS_MMA(0, 1, At, B1); DEF(2); GS_BAR; GS_SCHED; \
              \
            GS_LDA(At, 1, 1); GS_STAGEB(GS_SB(1, 0), b3, voffB); GS_STAGEB(GS_SB(1, 1), b3 + hstepB, voffB); GS_STAGE(GS_SA(1, 0), a3, u2, 0); \
            GS_WAIT_V(8); GS_WAIT_L(0); GS_BAR; GS_MMA(1, 0, At, B0); GS_MMA(1, 1, At, B1); DEF(3); GS_BAR; GS_SCHED; } while (0)
#define GS_DEF(k) do { if constexpr (SPLIT) { if ((k) < 3 && wr == 1 && ui > 0) { E.store1(dq[2 * (k)], dbase, dnv, 2 * (k) + 2); E.store1(dq[2 * (k) + 1], dbase, dnv, 2 * (k) + 3); } } } while (0)
#define GS_NODEF(k) do { } while (0)
        GS_TRIP(0, GS_MMAZ, ui == 0, GS_DEF);
#pragma unroll 1
        for (int t = 2; t < nt; t += 2) GS_TRIP(t, GS_MMA, true, GS_NODEF);
#undef GS_TRIP
#undef GS_DEF
#undef GS_NODEF
        if (wr == 0) GS_BAR;
        if (F8 == 2) asm volatile("s_nop 15\n\ts_nop 15\n\ts_nop 15\n\ts_nop 15\n\ts_nop 15\n\ts_nop 15" ::: "memory");
        if constexpr (SPLIT) {
            if (wr == 1) E.pack(acc, cur, wr, wc, fr, fq, dq, dbase, dnv);
            else { GS_WAIT_V(6); E(acc, cur, wr, wc, fr, fq); }
        } else {
            GS_WAIT_V(6);
            E(acc, cur, wr, wc, fr, fq);
        }
        if (!has_next) break;
        cur = nxt; cA = nA; cB = nB; ++ui;
        if (wr == 1) GS_BAR;
    }
    if constexpr (SPLIT) { if (wr == 1) {
#pragma unroll
        for (int k = 0; k < 6; ++k) E.store1(dq[k], dbase, dnv, k + 2); } }
    GS_WAIT_V(0);
    GS_BAR;
#undef GS_SA
#undef GS_SB
#undef GS_STAGE
#undef GS_STAGEB
#undef GS_LDA
#undef GS_LD32
#undef GS_LDB
#undef GS_MMA
#undef GS_MMAZ
#undef GS_WAIT_V
#undef GS_WAIT_L
#undef GS_BAR
#undef GS_SCHED
}
struct DenseU { const char* A; const char* B; int pm, pn; };
struct DenseSched {
    typedef DenseU U;
    const bf16_t* A; const bf16_t* Bt; int K, nunits, first, stride, npn, pn_base, pn_mod0, pn_mod1;
    DI int colmap(int q) const { return pn_base + (q / pn_mod0) * pn_mod1 + (q % pn_mod0); }
    DI bool next(int i, U& u) const {
        const int L = first + i * stride; if (L >= nunits) return false;
        u.pm = L / npn; u.pn = colmap(L % npn);
        u.A = (const char*)A + (size_t)u.pm * BM * K * 2; u.B = (const char*)Bt + (size_t)u.pn * BM * K * 2; return true;
    }
    DI unsigned a_voff(int, int h, int R, int C) const { return (unsigned)((HALF * h + R) * K + C) * 2u; }
};
}

DI void transpose_cvt(const float* W, bf16_t* Wt, int K, int N, int unit, char* lds) {
    float* tile = (float*)lds;
    const int nbn = N / 64, kb = unit / nbn, nb = unit % nbn, tid = tidx();
    __syncthreads();
#pragma unroll
    for (int i = 0; i < 8; ++i) { const int idx = tid + i * 512, r = idx >> 6, c = idx & 63; tile[r * 65 + c] = W[(size_t)(kb * 64 + r) * N + nb * 64 + c]; }
    __syncthreads();
#pragma unroll
    for (int i = 0; i < 8; ++i) { const int idx = tid + i * 512, n = idx >> 6, k = idx & 63; Wt[(size_t)(nb * 64 + n) * K + kb * 64 + k] = f2bf(tile[k * 65 + n]); }
}
struct P0Args { const float* x; const float* w_in; const float* w_out; const float* router_w; bf16_t* xb; bf16_t* wt_in; bf16_t* wt_out; bf16_t* wt_r;
                const float* w_gate; const float* w_up; const float* w_down; const float* ws_gate; const float* ws_up; const float* ws_down; unsigned char* wgut; unsigned char* wdt; };
constexpr int CV_GU = 257 * 2 * 16, CV_DN = 257 * 16;
struct CvItem { const float* src; unsigned char* dst; int ld, ldd, rbase, rhi; };
DI CvItem cv_item(const P0Args& a, int it) {
    CvItem c;
    if (it < CV_GU) {
        const int e = it / 32, u = (it >> 4) & 1, kt = it & 15;
        const float* W = e < N_EXP ? (u ? a.w_up : a.w_gate) + (size_t)e * D_MODEL * D_EXP : (u ? a.ws_up : a.ws_gate);
        c.src = W + (size_t)kt * 64 * D_EXP; c.ld = D_EXP; c.dst = a.wgut + (size_t)e * 512 * D_MODEL + kt * 64; c.ldd = D_MODEL; c.rbase = 128 * u; c.rhi = 256;
    } else {
        const int j = it - CV_GU, e = j / 16, kt = (j >> 2) & 3, nb = j & 3;
        const float* W = e < N_EXP ? a.w_down + (size_t)e * D_EXP * D_MODEL : a.ws_down;
        c.src = W + (size_t)kt * 64 * D_MODEL + nb * 256; c.ld = D_MODEL; c.dst = a.wdt + (size_t)e * D_MODEL * D_EXP + kt * 64; c.ldd = D_EXP; c.rbase = 256 * nb; c.rhi = 128;
    }
    return c;
}
constexpr int CV_TILE_BYTES = 64 * 260 * 4;
DI void cv_dma_nt(const char* sbase, unsigned voff, unsigned lds_dst) {
    unsigned keep;
    asm volatile("s_mov_b32 %0, m0\n\ts_mov_b32 m0, %3\n\ts_nop 0\n\tglobal_load_lds_dwordx4 %1, %2 nt\n\ts_mov_b32 m0, %0" : "=&s"(keep) : "v"(voff), "s"(sbase), "s"(lds_dst) : "memory");
}
DI const char* uni64(const void* p) { const unsigned long long v = (unsigned long long)p; const unsigned lo = __builtin_amdgcn_readfirstlane((unsigned)v), hi = __builtin_amdgcn_readfirstlane((unsigned)(v >> 32)); return (const char*)(((unsigned long long)hi << 32) | lo); }
DI void cv_issue(const CvItem& c, LAS unsigned char* tile) {
    const int tid = tidx(), w = __builtin_amdgcn_readfirstlane(tid >> 6), l = tid & 63;
    const char* sb = uni64(c.src); const unsigned tb = (unsigned)__builtin_amdgcn_readfirstlane((unsigned)(size_t)tile);
#pragma unroll
    for (int i = 0; i < 8; ++i) { const int k = 8 * w + i; cv_dma_nt(sb, (unsigned)(k * c.ld + 4 * (l ^ w)) * 4u, tb + (unsigned)(k * 1040)); }
}
DI void lds_barrier() { asm volatile("s_waitcnt lgkmcnt(0)" ::: "memory"); __builtin_amdgcn_s_barrier(); asm volatile("" ::: "memory"); }
DI void cv_emit(const CvItem& c, const char* lds) {
    const float* tile = (const float*)lds;
    const int tid = tidx();
#pragma unroll
    for (int i = 0; i < 4; ++i) {
        const int idx = tid + i * 512, kc = idx & 7, n = idx >> 3; const float* p = tile + (8 * kc) * 260 + (n ^ (4 * kc));
        const unsigned w0 = pack_fp8x4(p[0] * WSCALE, p[260] * WSCALE, p[2 * 260] * WSCALE, p[3 * 260] * WSCALE), w1 = pack_fp8x4(p[4 * 260] * WSCALE, p[5 * 260] * WSCALE, p[6 * 260] * WSCALE, p[7 * 260] * WSCALE);
        __builtin_nontemporal_store((u32x2){w0, w1}, (u32x2*)(c.dst + (size_t)(c.rbase + (n >> 7) * c.rhi + (n & 127)) * c.ldd + 8 * kc));
    }
}
DI void convert_moe_range(const P0Args& a, char* lds, const int lo, const int hi) {
    int it = lo + vblock(); if (it >= hi) return;
    __syncthreads();
    LAS unsigned char* t0 = (LAS unsigned char*)lds; LAS unsigned char* t1 = t0 + CV_TILE_BYTES;
    CvItem c = cv_item(a, it); cv_issue(c, t0);
    int pp = 0;
#pragma unroll 1
    for (;;) {
        const int nit = it + GRID; const bool more = nit < hi;
        CvItem cn = c;
        if (more) { cn = cv_item(a, nit); cv_issue(cn, pp ? t0 : t1); }
        if (more) asm volatile("s_waitcnt vmcnt(8)" ::: "memory"); else asm volatile("s_waitcnt vmcnt(0)" ::: "memory");
        lds_barrier();
        cv_emit(c, lds + (pp ? CV_TILE_BYTES : 0));
        lds_barrier();
        if (!more) break;
        it = nit; c = cn; pp ^= 1;
    }
    asm volatile("s_waitcnt vmcnt(0)" ::: "memory");
    __syncthreads();
}
DI void phase_prologue(const P0Args& a, char* lds) {
    const int vb = vblock();
    for (size_t i = (size_t)vb * NTHR + tidx(); i < (size_t)T_TOK * D_MODEL / 8; i += (size_t)GRID * NTHR) {
        const f32x4 v0 = *(const f32x4*)(a.x + i * 8), v1 = *(const f32x4*)(a.x + i * 8 + 4);
        u32x4 o; o.x = cvt_pk_bf16(v0[0], v0[1]); o.y = cvt_pk_bf16(v0[2], v0[3]); o.z = cvt_pk_bf16(v1[0], v1[1]); o.w = cvt_pk_bf16(v1[2], v1[3]);
        *(u32x4*)(a.xb + i * 8) = o;
    }
    const int n_in = (1024 / 64) * (3072 / 64), n_out = 16 * 16, n_r = 16 * 4;
    for (int u = vb; u < n_in + n_out + n_r; u += GRID) {
        if (u < n_in) transpose_cvt(a.w_in, a.wt_in, 1024, 3072, u, lds);
        else if (u < n_in + n_out) transpose_cvt(a.w_out, a.wt_out, 1024, 1024, u - n_in, lds);
        else transpose_cvt(a.router_w, a.wt_r, 1024, 256, u - n_in - n_out, lds);
    }
}


struct P1Args { const bf16_t* xb; const bf16_t* wt_in; bf16_t* Q; bf16_t* Kb; bf16_t* Vt; };
struct EpiQK { bf16_t* Q; bf16_t* Kb; static constexpr int MXS = 0x7F7F7F7F;
    DI void operator()(const f32x4 (&acc)[2][2][4][2], const gs::DenseU& u, int wr, int wc, int fr, int fq) const {
        const int seg = u.pn >> 1, type = seg % 3, grp = seg / 3; bf16_t* dst = type == 0 ? Q : Kb; const float sc = type == 0 ? QSCALE : 1.f;
#pragma unroll
        for (int ai = 0; ai < 2; ++ai)
#pragma unroll
            for (int m = 0; m < 4; ++m) {
                const int row = u.pm * 256 + 128 * ai + 64 * wr + 16 * m + fr, b = row / SEQ, s = row % SEQ;
#pragma unroll
                for (int bj = 0; bj < 2; ++bj) {
                    const int hh = grp * 8 + 4 * (u.pn & 1) + 2 * bj + (wc >> 1), d0 = 32 * (wc & 1) + 8 * fq;
                    const f32x4 v0 = acc[ai][bj][m][0] * sc, v1 = acc[ai][bj][m][1] * sc;
                    u32x4 o; o.x = cvt_pk_bf16(v0[0], v0[1]); o.y = cvt_pk_bf16(v0[2], v0[3]); o.z = cvt_pk_bf16(v1[0], v1[1]); o.w = cvt_pk_bf16(v1[2], v1[3]);
                    *(u32x4*)(dst + (size_t)(b * NHH + hh) * SEQ * 64 + (s >> 5) * 2048 + ((d0 >> 3) * 32 + (s & 31)) * 8) = o;
                }
            }
    } };
struct EpiV { bf16_t* Vt; static constexpr int MXS = 0x7F7F7F7F;
    DI void operator()(const f32x4 (&acc)[2][2][4][2], const gs::DenseU& u, int wr, int wc, int fr, int fq) const {
        const int grp = (u.pn >> 1) / 3;
#pragma unroll
        for (int ai = 0; ai < 2; ++ai)
#pragma unroll
            for (int m = 0; m < 4; ++m) {
                const int row = u.pm * 256 + 128 * ai + 64 * wr + 16 * m + 4 * fq, b = row / SEQ, s = row % SEQ;
#pragma unroll
                for (int bj = 0; bj < 2; ++bj)
#pragma unroll
                    for (int n = 0; n < 2; ++n) {
                        const int hh = grp * 8 + 4 * (u.pn & 1) + 2 * bj + (wc >> 1), d = 32 * (wc & 1) + 16 * n + fr;
                        const f32x4 v = acc[ai][bj][m][n];
                        u32x2 o; o.x = cvt_pk_bf16(v[0], v[1]); o.y = cvt_pk_bf16(v[2], v[3]);
                        { const int kap = s & 31; *(u32x2*)(Vt + (size_t)(b * NHH + hh) * SEQ * 64 + (s >> 5) * 2048 + ((((d >> 5) * 2 + (kap >> 4)) * 2 + ((kap >> 2) & 1)) * 32 + (d & 31)) * 8 + ((kap >> 3) & 1) * 4) = o; }
                    }
            }
    } };
DI void phase_qkv(const P1Args& a, LAS unsigned char* lds) {
    { gs::DenseSched S{a.xb, a.wt_in, D_MODEL, (T_TOK / 256) * 8, vblock(), GRID, 8, 0, 4, 6}; EpiQK E{a.Q, a.Kb}; gs::gemm_stream<true, true, 0, false>(lds, D_MODEL, S, E); }
    { gs::DenseSched S{a.xb, a.wt_in, D_MODEL, (T_TOK / 256) * 4, vblock(), GRID, 4, 4, 2, 6}; EpiV E{a.Vt}; gs::gemm_stream<false, false, 0, false>(lds, D_MODEL, S, E); }
}

struct P3Args { const bf16_t* y; const bf16_t* wt_out; bf16_t* r; };
struct EpiOut { bf16_t* r; static constexpr int MXS = 0x7F7F7F7F;
    DI void operator()(const f32x4 (&acc)[2][2][4][2], const gs::DenseU& u, int wr, int wc, int fr, int fq) const {
#pragma unroll
        for (int ai = 0; ai < 2; ++ai)
#pragma unroll
            for (int m = 0; m < 4; ++m) {
                const int row = u.pm * 256 + 128 * ai + 64 * wr + 16 * m + fr;
#pragma unroll
                for (int bj = 0; bj < 2; ++bj) {
                    const int col = u.pn * 256 + 128 * bj + 32 * wc + 8 * fq;
                    const f32x4 v0 = acc[ai][bj][m][0], v1 = acc[ai][bj][m][1];
                    u32x4 o; o.x = cvt_pk_bf16(v0[0], v0[1]); o.y = cvt_pk_bf16(v0[2], v0[3]); o.z = cvt_pk_bf16(v1[0], v1[1]); o.w = cvt_pk_bf16(v1[2], v1[3]);
                    *(u32x4*)(r + (size_t)row * D_MODEL + col) = o;
                }
            }
    } };
DI void phase_outproj(const P3Args& a, LAS unsigned char* lds) {
    gs::DenseSched S{a.y, a.wt_out, D_MODEL, (T_TOK / 256) * 4, vblock(), GRID, 4, 0, 4, 0}; EpiOut E{a.r}; gs::gemm_stream<true, true, 0, false>(lds, D_MODEL, S, E);
}

DI void unpack16(const u32x4& a, const u32x4& b, float (&v)[16]) {
#pragma unroll
    for (int j = 0; j < 4; ++j) { v[2 * j] = __uint_as_float(a[j] << 16); v[2 * j + 1] = __uint_as_float(a[j] & 0xffff0000u); v[8 + 2 * j] = __uint_as_float(b[j] << 16); v[8 + 2 * j + 1] = __uint_as_float(b[j] & 0xffff0000u); }
}
DI void dma16_plain(const char* sbase, unsigned voff, unsigned lds_dst) {
    unsigned keep;
    asm volatile("s_mov_b32 %0, m0\n\ts_mov_b32 m0, %3\n\ts_nop 0\n\tglobal_load_lds_dwordx4 %1, %2\n\ts_mov_b32 m0, %0" : "=&s"(keep) : "v"(voff), "s"(sbase), "s"(lds_dst) : "memory");
}
DI void router_gemm(char* lds, const bf16_t* A, const bf16_t* Bt, f32x4 (&acc)[4][4]) {
    constexpr int STAGE = 16384 + 32768, NK = D_MODEL / 64;
    const int tid = tidx(), wid = __builtin_amdgcn_readfirstlane(tid >> 6), lane = tid & 63, wr = wid >> 2, wc = wid & 3, fr = lane & 15, fq = lane >> 4;
#pragma unroll
    for (int m = 0; m < 4; ++m)
#pragma unroll
        for (int n = 0; n < 4; ++n) acc[m][n] = (f32x4){0.f, 0.f, 0.f, 0.f};
    int aoff[2], boff[2];
#pragma unroll
    for (int ks = 0; ks < 2; ++ks) { const int ch = (((4 * ks + fq) ^ (fr >> 1)) << 4); aoff[ks] = (64 * wr + fr) * 128 + ch; boff[ks] = 16384 + (64 * wc + fr) * 128 + ch; }
    unsigned voA[2], voB[4];
#pragma unroll
    for (int i = 0; i < 2; ++i) { const int row = 8 * (2 * wid + i) + (lane >> 3), kc = (lane & 7) ^ ((row >> 1) & 7); voA[i] = (unsigned)(row * D_MODEL + kc * 8) * 2u; }
#pragma unroll
    for (int i = 0; i < 4; ++i) { const int row = 8 * (4 * wid + i) + (lane >> 3), kc = (lane & 7) ^ ((row >> 1) & 7); voB[i] = (unsigned)(row * D_MODEL + kc * 8) * 2u; }
    const unsigned lb = (unsigned)__builtin_amdgcn_readfirstlane((unsigned)(size_t)(LAS unsigned char*)lds);
    const char* ab = uni64(A); const char* bb = uni64(Bt);
#define RG_ISSUE(kt) do { const unsigned sb_ = lb + (unsigned)(((kt) % 3) * STAGE); const char* a_ = ab + (size_t)(kt) * 128; const char* b_ = bb + (size_t)(kt) * 128; \
        _Pragma("unroll") for (int i_ = 0; i_ < 2; ++i_) dma16_plain(a_, voA[i_], sb_ + (unsigned)((2 * wid + i_) * 1024)); \
        _Pragma("unroll") for (int i_ = 0; i_ < 4; ++i_) dma16_plain(b_, voB[i_], sb_ + 16384u + (unsigned)((4 * wid + i_) * 1024)); } while (0)
    __syncthreads();
    RG_ISSUE(0); RG_ISSUE(1);
#pragma unroll 1
    for (int kt = 0; kt < NK; ++kt) {
        if (kt + 1 < NK) asm volatile("s_waitcnt vmcnt(6)" ::: "memory"); else asm volatile("s_waitcnt vmcnt(0)" ::: "memory");
        asm volatile("s_waitcnt lgkmcnt(0)" ::: "memory"); __builtin_amdgcn_s_barrier(); asm volatile("" ::: "memory");
        if (kt + 2 < NK) RG_ISSUE(kt + 2);
        const char* cur = lds + (kt % 3) * STAGE;
#pragma unroll
        for (int ks = 0; ks < 2; ++ks) {
            bf16x8 a[4], b[4];
#pragma unroll
            for (int m = 0; m < 4; ++m) a[m] = *(const bf16x8*)(cur + aoff[ks] + m * 2048);
#pragma unroll
            for (int n = 0; n < 4; ++n) b[n] = *(const bf16x8*)(cur + boff[ks] + n * 2048);
#pragma unroll
            for (int m = 0; m < 4; ++m)
#pragma unroll
                for (int n = 0; n < 4; ++n) acc[m][n] = __builtin_amdgcn_mfma_f32_16x16x32_bf16(b[n], a[m], acc[m][n], 0, 0, 0);
        }
    }
#undef RG_ISSUE
    __syncthreads();
}
constexpr int RS_SC = 289;
constexpr int LDS_HIST = 100 * 1024;
struct P4Args { const bf16_t* r; const bf16_t* xb; const float* ln_g; const float* ln_b; bf16_t* x1; unsigned char* x1f8; const bf16_t* wt_r; const float* rbias;
                int* eidx; float* gate; int* counts; int* tokl; float* gatel; int* slot; };
DI void phase_router(const P4Args& a, const P0Args& cv, char* lds) {
    const int tid = tidx(), wid = tid >> 6, lane = tid & 63, wr = wid >> 2, wc = wid & 3, fr = lane & 15, fq = lane >> 4;
    float* sc = (float*)lds; int* hist = (int*)(lds + LDS_HIST); int* base = hist + 256;
    for (int u = vblock(); u < T_TOK / 128; u += GRID) {
        const int m0 = u * 128;
        if ((vblock() & 1) == 0) convert_moe_range(cv, lds, CV_GU, CV_GU + CV_DN);
        __syncthreads();
#pragma unroll 1
        for (int i0 = 0; i0 < 16; i0 += 4) {
            u32x4 r0[4], r1[4], x0[4], x1w[4];
#pragma unroll
            for (int j4 = 0; j4 < 4; ++j4) {
                const int t = m0 + wid * 16 + i0 + j4;
                r0[j4] = *(const u32x4*)(a.r + (size_t)t * D_MODEL + lane * 16); r1[j4] = *(const u32x4*)(a.r + (size_t)t * D_MODEL + lane * 16 + 8);
                x0[j4] = *(const u32x4*)(a.xb + (size_t)t * D_MODEL + lane * 16); x1w[j4] = *(const u32x4*)(a.xb + (size_t)t * D_MODEL + lane * 16 + 8);
            }
#pragma unroll
            for (int j4 = 0; j4 < 4; ++j4) {
                const int t = m0 + wid * 16 + i0 + j4;
                float v[16], xv[16]; unpack16(r0[j4], r1[j4], v); unpack16(x0[j4], x1w[j4], xv);
                float s = 0.f;
#pragma unroll
                for (int i = 0; i < 16; ++i) { v[i] = xv[i] * DN_ALPHA + v[i]; s += v[i]; }
#pragma unroll
                for (int o = 1; o <= 32; o <<= 1) s += __shfl_xor(s, o);
                const float mu = s * (1.f / 1024.f);
                float q = 0.f;
#pragma unroll
                for (int i = 0; i < 16; ++i) { const float d = v[i] - mu; q += d * d; }
#pragma unroll
                for (int o = 1; o <= 32; o <<= 1) q += __shfl_xor(q, o);
                const float rstd = rsqrtf(q * (1.f / 1024.f) + LN_EPS);
                u32x4 o0, o1, o8;
#pragma unroll
                for (int j = 0; j < 4; ++j) {
                    const f32x4 g = *(const f32x4*)(a.ln_g + lane * 16 + 4 * j), bb = *(const f32x4*)(a.ln_b + lane * 16 + 4 * j);
                    const float y0 = (v[4 * j] - mu) * rstd * g[0] + bb[0], y1 = (v[4 * j + 1] - mu) * rstd * g[1] + bb[1], y2 = (v[4 * j + 2] - mu) * rstd * g[2] + bb[2], y3 = (v[4 * j + 3] - mu) * rstd * g[3] + bb[3];
                    o8[j] = pack_fp8x4(y0 * XSCALE, y1 * XSCALE, y2 * XSCALE, y3 * XSCALE);
                    const unsigned p0 = cvt_pk_bf16(y0, y1), p1 = cvt_pk_bf16(y2, y3);
                    if (j < 2) { o0[2 * j] = p0; o0[2 * j + 1] = p1; } else { o1[2 * (j - 2)] = p0; o1[2 * (j - 2) + 1] = p1; }
                }
                *(u32x4*)(a.x1 + (size_t)t * D_MODEL + lane * 16) = o0; *(u32x4*)(a.x1 + (size_t)t * D_MODEL + lane * 16 + 8) = o1;
                *(u32x4*)(a.x1f8 + (size_t)t * D_MODEL + lane * 16) = o8;
            }
        }
        asm volatile("s_waitcnt vmcnt(0)" ::: "memory");
        __syncthreads();
        f32x4 acc[4][4];
        router_gemm(lds, a.x1 + (size_t)m0 * D_MODEL, a.wt_r, acc);
        if (tid < 256) hist[tid] = 0;
        int my_idx[2], my_rank[2]; float my_gate[2];
#pragma unroll
        for (int p = 0; p < 2; ++p) {
            __syncthreads();
            if (wr == p) {
#pragma unroll
                for (int m = 0; m < 4; ++m)
#pragma unroll
                    for (int n = 0; n < 4; ++n) {
                        const int c0 = 64 * wc + 16 * n + 4 * fq; const f32x4 rb = *(const f32x4*)(a.rbias + c0);
#pragma unroll
                        for (int j = 0; j < 4; ++j) { const int c = c0 + j; sc[(16 * m + fr) * RS_SC + (c >> 5) * 36 + (c & 31)] = 1.f / (1.f + __expf(-acc[m][n][j])) + rb[j]; }
                    }
            }
            __syncthreads();
            const int row = tid >> 3, g = tid & 7, t = m0 + 64 * p + row;
            float sel[32];
#pragma unroll
            for (int i = 0; i < 32; ++i) sel[i] = sc[row * RS_SC + g * 36 + i];
            float m1 = -INFINITY, m2 = -INFINITY;
#pragma unroll
            for (int i = 0; i < 32; ++i) { const float v = sel[i]; m2 = fmaxf(m2, fminf(m1, v)); m1 = fmaxf(m1, v); }
            const float gs = m1 + m2; int rank = 0;
#pragma unroll
            for (int d = 1; d < 8; ++d) { const float o = __shfl_xor(gs, d); const int og = g ^ d; rank += (o > gs || (o == gs && og < g)) ? 1 : 0; }
            const bool en = rank < TOPK_GROUPS;
            float lv = -INFINITY; int li = 1 << 20;
            if (en) {
#pragma unroll
                for (int i = 0; i < 32; ++i) { const float v = sel[i]; if (v > lv) { lv = v; li = g * 32 + i; } }
            }
            float myv = 0.f; int myi = 0;
#pragma unroll
            for (int k = 0; k < TOP_K; ++k) {
                float bv = lv; int bi = li;
#pragma unroll
                for (int d = 1; d < 8; d <<= 1) { const float ov = __shfl_xor(bv, d); const int oi = __shfl_xor(bi, d); if (ov > bv || (ov == bv && oi < bi)) { bv = ov; bi = oi; } }
                if (g == k) { myv = bv; myi = bi; }
                if (k + 1 < TOP_K && (bi >> 5) == g) {
                    lv = -INFINITY; li = 1 << 20;
#pragma unroll
                    for (int i = 0; i < 32; ++i) { if (g * 32 + i == bi) sel[i] = -INFINITY; const float v = sel[i]; if (v > lv) { lv = v; li = g * 32 + i; } }
                }
            }
            const float score = myv - a.rbias[myi];
            float gsum = score;
#pragma unroll
            for (int d = 1; d < 8; d <<= 1) gsum += __shfl_xor(gsum, d);
            const float gt = score / gsum * ROUTED_SCALE;
            a.eidx[t * TOP_K + g] = myi; a.gate[t * TOP_K + g] = gt;
            my_idx[p] = myi; my_gate[p] = gt; my_rank[p] = atomicAdd(&hist[myi], 1);
        }
        __syncthreads();
        if (tid < 256) { const int h = hist[tid]; base[tid] = h > 0 ? atomicAdd(&a.counts[tid * CSTR], h) : 0; }
        __syncthreads();
#pragma unroll
        for (int p = 0; p < 2; ++p) {
            const int row = tid >> 3, g = tid & 7, t = m0 + 64 * p + row, e = my_idx[p], pos = base[e] + my_rank[p];
            a.tokl[(size_t)e * CAP + pos] = t; a.gatel[(size_t)e * CAP + pos] = my_gate[p]; a.slot[t * TOP_K + g] = e * CAP + pos;
        }
        if ((vblock() & 1) == 1) convert_moe_range(cv, lds, CV_GU, CV_GU + CV_DN);
    }
}

constexpr int LDS_ROWTAB = 128 * 1024;
constexpr int LDS_GTAB = 139 * 1024;
constexpr int LDS_TAB = 150 * 1024;
constexpr int LDS_UTAB = 154 * 1024;
constexpr int MOE_BM = 256;
DI void build_moe_tab(const int* counts, char* lds) {
    int* tstart = (int*)(lds + LDS_TAB); int* rstart = tstart + 264; int* cnts = tstart + 528;
    const int tid = tidx(), lane = tid & 63;
    __syncthreads();
    if (tid < 64) {
        int c[4], tl[4], cs = 0, ts = 0;
#pragma unroll
        for (int i = 0; i < 4; ++i) { c[i] = counts[(lane * 4 + i) * CSTR]; tl[i] = (c[i] + MOE_BM - 1) / MOE_BM; cs += c[i]; ts += tl[i]; }
        int ci = cs, ti = ts;
#pragma unroll
        for (int o = 1; o < 64; o <<= 1) { const int n1 = __shfl_up(ci, o), n2 = __shfl_up(ti, o); if (lane >= o) { ci += n1; ti += n2; } }
        int ce = ci - cs, te = ti - ts;
#pragma unroll
        for (int i = 0; i < 4; ++i) { rstart[lane * 4 + i] = ce; tstart[lane * 4 + i] = te; cnts[lane * 4 + i] = c[i]; ce += c[i]; te += tl[i]; }
        if (lane == 63) { rstart[256] = ce; tstart[256] = te; cnts[256] = T_TOK; rstart[257] = ce + T_TOK; tstart[257] = te + T_TOK / MOE_BM; }
    }
    __syncthreads();
}
DI int find_expert(const int* tstart, int g) {
    int lo = 0, hi = 256;
#pragma unroll 1
    while (lo < hi) { const int mid = (lo + hi + 1) >> 1; if (tstart[mid] <= g) lo = mid; else hi = mid - 1; }
    return lo;
}
struct MoeU { const char* A; const char* B; int e, m0, sub, ui; };
typedef const LAS int* ltab_t;
DI int find_expert_l(ltab_t tstart, int g) { int lo = 0, hi = 256;
#pragma unroll 1
    while (lo < hi) { const int mid = (lo + hi + 1) >> 1; if (tstart[mid] <= g) lo = mid; else hi = mid - 1; }
    return lo; }

struct P6Args { const unsigned char* x1; const int* counts; const int* tokl; const float* gatel; const unsigned char* wgut; unsigned char* H; };
struct GuSched {
    typedef MoeU U;
    ltab_t tab; const LAS int* rowtab; const LAS int* utab; const unsigned char* x1; const unsigned char* wgut; int first, stride, nunits;
    DI bool next(int i, U& u) const {
        const int L = first + i * stride; if (L >= nunits) return false;
        const int g = L >> 1, e = utab[i];
        u.sub = L & 1; u.e = e; u.ui = i; u.m0 = (g - tab[e]) * MOE_BM;
        u.A = (const char*)x1; u.B = (const char*)(wgut + ((size_t)e * 512 + 256 * u.sub) * D_MODEL); return true;
    }
    DI unsigned a_voff(int i, int h, int R, int C) const { return (unsigned)(rowtab[i * 256 + 128 * h + R] * (D_MODEL / 2) + C) * 2u; }
};
struct EpiGU { unsigned char* H; const LAS float* gtab; ltab_t tab; static constexpr int MXS = 0x7A7A7A7A;
    DI void operator()(const f32x4 (&acc)[2][2][4][2], const MoeU& u, int wr, int wc, int fr, int fq) const {
        const int st = tab[264 + u.e], cnt = tab[528 + u.e];
#pragma unroll
        for (int ai = 0; ai < 2; ++ai)
#pragma unroll
            for (int m = 0; m < 4; ++m) {
                const int row = u.m0 + 128 * ai + 64 * wr + 16 * m + fr;
                if (row < cnt) {
                    const float gt = gtab[u.ui * 256 + 128 * ai + 64 * wr + 16 * m + fr] * HSCALE;
                    float h[8];
                    const f32x2 gt2 = {gt, gt}, nl2 = {-LOG2E, -LOG2E}, one2 = {1.f, 1.f};
#pragma unroll
                    for (int n = 0; n < 2; ++n)
#pragma unroll
                        for (int j = 0; j < 4; j += 2) {
                            const f32x2 g2 = {acc[ai][0][m][n][j], acc[ai][0][m][n][j + 1]}, u2 = {acc[ai][1][m][n][j], acc[ai][1][m][n][j + 1]};
                            const f32x2 a2 = g2 * nl2;
                            const f32x2 d2 = (f32x2){__builtin_amdgcn_exp2f(a2.x), __builtin_amdgcn_exp2f(a2.y)} + one2;
                            const f32x2 r2 = {__builtin_amdgcn_rcpf(d2.x), __builtin_amdgcn_rcpf(d2.y)};
                            const f32x2 h2 = (g2 * r2) * (u2 * gt2);
                            h[4 * n + j] = h2.x; h[4 * n + j + 1] = h2.y;
                        }
                    *(u32x2*)(H + (size_t)(st + row) * D_EXP + 128 * u.sub + 32 * wc + 8 * fq) = (u32x2){pack_fp8x4(h[0], h[1], h[2], h[3]), pack_fp8x4(h[4], h[5], h[6], h[7])};
                }
            }
    } };
DI void phase_moe_gu(const P6Args& a, char* smem, LAS unsigned char* lds) {
    build_moe_tab(a.counts, smem);
    const int* tstart = (const int*)(smem + LDS_TAB); const int* rstart = tstart + 264; int* rowtab = (int*)(smem + LDS_ROWTAB); float* gtab = (float*)(smem + LDS_GTAB);
    const int nunits = tstart[257] * 2, first = vblock();
    const int n_my = first < nunits ? (nunits - first + GRID - 1) / GRID : 0;
    for (int idx = tidx(); idx < n_my * 256; idx += NTHR) {
        const int i = idx >> 8, row = idx & 255, L = first + i * GRID, g = L >> 1, e = find_expert(tstart, g), m0 = (g - tstart[e]) * MOE_BM, cnt = tstart[528 + e];
        int rr = m0 + row; rr = rr < cnt ? rr : cnt - 1;
        rowtab[idx] = e < N_EXP ? a.tokl[(size_t)e * CAP + rr] : rr;
        gtab[idx] = e < N_EXP ? a.gatel[(size_t)e * CAP + rr] : 1.f;
    }
    if (tidx() < 32 && tidx() < n_my) ((int*)(smem + LDS_UTAB))[tidx()] = find_expert(tstart, (first + tidx() * GRID) >> 1);
    __syncthreads();
    GuSched S{(ltab_t)(lds + LDS_TAB), (const LAS int*)(lds + LDS_ROWTAB), (const LAS int*)(lds + LDS_UTAB), a.x1, a.wgut, first, GRID, nunits}; EpiGU E{a.H, (const LAS float*)(lds + LDS_GTAB), (ltab_t)(lds + LDS_TAB)};
    gs::gemm_stream<true, true, 2, false>(lds, D_MODEL / 2, S, E);
}
struct P7Args { const unsigned char* H; const int* counts; const unsigned char* wdt; unsigned char* Y; };
struct DownSched {
    typedef MoeU U;
    ltab_t tab; const LAS int* utab; const unsigned char* H; const unsigned char* wdt; int first, stride, nunits;
    DI bool next(int i, U& u) const {
        const int L = first + i * stride; if (L >= nunits) return false;
        const int g = L >> 2, e = utab[i];
        u.sub = L & 3; u.e = e; u.ui = i; u.m0 = (g - tab[e]) * MOE_BM;
        u.A = (const char*)(H + (size_t)(tab[264 + e] + u.m0) * D_EXP); u.B = (const char*)(wdt + ((size_t)e * D_MODEL + 256 * u.sub) * D_EXP); return true;
    }
    DI unsigned a_voff(int, int h, int R, int C) const { return (unsigned)((128 * h + R) * (D_EXP / 2) + C) * 2u; }
};
struct EpiDown { unsigned char* Y; ltab_t tab; static constexpr int MXS = 0x7D7D7D7D;
    DI void operator()(const f32x4 (&acc)[2][2][4][2], const MoeU& u, int wr, int wc, int fr, int fq) const {
        const int st = tab[264 + u.e], cnt = tab[528 + u.e];
#pragma unroll
        for (int ai = 0; ai < 2; ++ai)
#pragma unroll
            for (int m = 0; m < 4; ++m) {
                const int row = u.m0 + 128 * ai + 64 * wr + 16 * m + fr;
                if (row < cnt) {
                    u32x4 o;
#pragma unroll
                    for (int bj = 0; bj < 2; ++bj) {
                        const f32x4 v0 = acc[ai][bj][m][0], v1 = acc[ai][bj][m][1];
                        o[2 * bj] = pack_fp8x4(v0[0], v0[1], v0[2], v0[3]); o[2 * bj + 1] = pack_fp8x4(v1[0], v1[1], v1[2], v1[3]);
                    }
                    *(u32x4*)(Y + (size_t)(st + row) * D_MODEL + 256 * u.sub + 64 * wc + 16 * fq) = o;
                }
            }
    }
    DI void pack(const f32x4 (&acc)[2][2][4][2], const MoeU& u, int wr, int wc, int fr, int fq, u32x4 (&o)[6], unsigned& base, int& nv) const {
        const int st = tab[264 + u.e], cnt = tab[528 + u.e], row0 = u.m0 + 64 * wr + fr;
        nv = cnt - row0;
        base = (unsigned)(st + row0) * D_MODEL + 256 * u.sub + 64 * wc + 16 * fq;
#pragma unroll
        for (int ai = 0; ai < 2; ++ai)
#pragma unroll
            for (int m = 0; m < 4; ++m) {
                u32x4 w;
#pragma unroll
                for (int bj = 0; bj < 2; ++bj) {
                    const f32x4 v0 = acc[ai][bj][m][0], v1 = acc[ai][bj][m][1];
                    w[2 * bj] = pack_fp8x4(v0[0], v0[1], v0[2], v0[3]); w[2 * bj + 1] = pack_fp8x4(v1[0], v1[1], v1[2], v1[3]);
                }
                if (4 * ai + m < 2) store1(w, base, nv, 4 * ai + m); else o[4 * ai + m - 2] = w;
            }
    }
    DI void store1(const u32x4& v, unsigned base, int nv, int k) const { const int ro = 128 * (k >> 2) + 16 * (k & 3); if (ro < nv) *(u32x4*)(Y + (size_t)(base + (unsigned)ro * D_MODEL)) = v; }
};
DI void phase_moe_down(const P7Args& a, char* smem, LAS unsigned char* lds) {
    const int* tstart = (const int*)(smem + LDS_TAB); const int* rstart = tstart + 264;
    { const int nun = tstart[257] * 4, i = tidx(); if (i < 32 && vblock() + i * GRID < nun) ((int*)(smem + LDS_UTAB))[i] = find_expert(tstart, (vblock() + i * GRID) >> 2); }
    __syncthreads();
    DownSched S{(ltab_t)(lds + LDS_TAB), (const LAS int*)(lds + LDS_UTAB), a.H, a.wdt, vblock(), GRID, tstart[257] * 4}; EpiDown E{a.Y, (ltab_t)(lds + LDS_TAB)};
    gs::gemm_stream<true, true, 2, true>(lds, D_EXP / 2, S, E);
}
struct P8Args { const bf16_t* x1; const unsigned char* Y; const int* slot; const int* counts; const float* ln_g; const float* ln_b; float* out; };
DI void phase_combine(const P8Args& a, char* lds) {
    const int tid = tidx(), wid = tid >> 6, lane = tid & 63;
    const int* rstart = (const int*)(lds + LDS_TAB) + 264;
    const int sh0 = rstart[256];
    const int c0 = 256 * (lane >> 4) + 32 * ((lane >> 2) & 3) + 8 * (lane & 3);
    for (int t = vblock() * 8 + wid; t < T_TOK; t += GRID * 8) {
        float v[16], w[16];
        { const u32x4 p0 = *(const u32x4*)(a.x1 + (size_t)t * D_MODEL + c0), p1 = *(const u32x4*)(a.x1 + (size_t)t * D_MODEL + c0 + 128); unpack16(p0, p1, v); }
        int sl = 0; if (lane < TOP_K) sl = a.slot[t * TOP_K + lane];
        u32x4 yr[9];
        yr[8] = *(const u32x4*)(a.Y + (size_t)(sh0 + t) * D_MODEL + lane * 16);
#pragma unroll
        for (int k = 0; k < TOP_K; ++k) { const int s = __shfl(sl, k), e = s / CAP, pos = s % CAP; yr[k] = *(const u32x4*)(a.Y + (size_t)(rstart[e] + pos) * D_MODEL + lane * 16); }
#pragma unroll
        for (int i = 0; i < 16; ++i) w[i] = 0.f;
#pragma unroll
        for (int k = 0; k < 9; ++k)
#pragma unroll
            for (int j = 0; j < 4; ++j) { const f32x2 lo = __builtin_amdgcn_cvt_pk_f32_fp8((int)yr[k][j], false), hi = __builtin_amdgcn_cvt_pk_f32_fp8((int)yr[k][j], true); w[4 * j] += lo.x; w[4 * j + 1] += lo.y; w[4 * j + 2] += hi.x; w[4 * j + 3] += hi.y; }
#pragma unroll
        for (int i = 0; i < 16; ++i) v[i] = v[i] * DN_ALPHA + w[i] * (1.f / YSCALE);
        float s = 0.f;
#pragma unroll
        for (int i = 0; i < 16; ++i) s += v[i];
#pragma unroll
        for (int o = 32; o >= 1; o >>= 1) s += __shfl_xor(s, o);
        const float mu = s * (1.f / 1024.f);
        float q = 0.f;
#pragma unroll
        for (int i = 0; i < 16; ++i) { const float d = v[i] - mu; q += d * d; }
#pragma unroll
        for (int o = 32; o >= 1; o >>= 1) q += __shfl_xor(q, o);
        const float rstd = rsqrtf(q * (1.f / 1024.f) + LN_EPS);
#pragma unroll
        for (int j = 0; j < 4; ++j) {
            const int col = c0 + 128 * (j >> 1) + 4 * (j & 1);
            const f32x4 g = *(const f32x4*)(a.ln_g + col), bb = *(const f32x4*)(a.ln_b + col);
            f32x4 o; o[0] = (v[4 * j] - mu) * rstd * g[0] + bb[0]; o[1] = (v[4 * j + 1] - mu) * rstd * g[1] + bb[1]; o[2] = (v[4 * j + 2] - mu) * rstd * g[2] + bb[2]; o[3] = (v[4 * j + 3] - mu) * rstd * g[3] + bb[3];
            *(f32x4*)(a.out + (size_t)t * D_MODEL + col) = o;
        }
    }
}
#define MFMA32(a, b, c) __builtin_amdgcn_mfma_f32_32x32x16_bf16((a), (b), (c), 0, 0, 0)
constexpr float SB_EXIT_THR = 1e-30f;
struct P2Args { const bf16_t* Q; const bf16_t* Kb; const bf16_t* Vt; const float* rel_bias; const float* gain_a; const float* gain_b; bf16_t* y; };

DI bf16x8 pack8(const f32x16& x, int s) {
    u32x4 p;
    if (s == 0) { p.x = cvt_pk_bf16(x[0], x[1]); p.y = cvt_pk_bf16(x[2], x[3]); p.z = cvt_pk_bf16(x[4], x[5]); p.w = cvt_pk_bf16(x[6], x[7]); }
    else        { p.x = cvt_pk_bf16(x[8], x[9]); p.y = cvt_pk_bf16(x[10], x[11]); p.z = cvt_pk_bf16(x[12], x[13]); p.w = cvt_pk_bf16(x[14], x[15]); }
    return __builtin_bit_cast(bf16x8, p);
}
DI void load_k(bf16x8 (&k)[4], const bf16_t* kp, int k0) {
#pragma unroll
    for (int kk = 0; kk < 4; ++kk) k[kk] = *(const bf16x8*)(kp + (size_t)(k0 >> 5) * 2048 + kk * 512);
}
DI void load_v(bf16x8 (&v)[2][2], const bf16_t* vp, int k0) {
#pragma unroll
    for (int dt = 0; dt < 2; ++dt)
#pragma unroll
        for (int s = 0; s < 2; ++s) v[dt][s] = *(const bf16x8*)(vp + (size_t)(k0 >> 5) * 2048 + (dt * 2 + s) * 512);
}

constexpr int LDS_CVT = 16 * 1024;
DI void phase_attn(const P2Args& a, const P0Args& cv, char* lds) {
    const int tid = tidx(), wid = tid >> 6, lane = tid & 63, r = lane & 31, h = lane >> 5;
    float* tbl = (float*)lds;
    float* ssq = (float*)(lds + 8 * 260 * 4);
    __syncthreads();
    for (int i = tid; i < NHA * 257; i += NTHR) { const int hd = i / 257, j = i % 257; tbl[hd * 260 + j] = a.rel_bias[i] * LOG2E; }
    __syncthreads();
    const int cgrp = vblock() % 2;
#pragma unroll 1
    for (int slot = 0; slot < 5; ++slot) {
        if ((cgrp == 0 && slot == 0) || (cgrp == 1 && slot == 4)) convert_moe_range(cv, lds + LDS_CVT, 0, CV_GU);
        if (slot == 4) break;
        const int u = vblock() + GRID * (slot >> 1) + 2 * GRID * (slot & 1);
        const bool isB = u >= BATCH * (SEQ / 64); const int uu = isB ? u - BATCH * (SEQ / 64) : u;
        const int b = uu / (SEQ / 64), c = uu % (SEQ / 64), q0 = c * 64, hh = (isB ? NHA : 0) + wid;
        const size_t hb = (size_t)(b * NHH + hh) * SEQ * 64;
        const bf16_t* kp = a.Kb + hb + lane * 8;
        const bf16_t* vp = a.Vt + hb + lane * 8;
        bf16x8 qf[2][4];
#pragma unroll
        for (int qt = 0; qt < 2; ++qt)
#pragma unroll
            for (int kk = 0; kk < 4; ++kk) qf[qt][kk] = *(const bf16x8*)(a.Q + hb + (size_t)((q0 >> 5) + qt) * 2048 + kk * 512 + lane * 8);
        f32x16 ot[2][2];
#pragma unroll
        for (int dt = 0; dt < 2; ++dt)
#pragma unroll
            for (int qt = 0; qt < 2; ++qt)
#pragma unroll
                for (int i = 0; i < 16; ++i) ot[dt][qt][i] = 0.f;
        float linv[2] = {1.f, 1.f};
        if (!isB) {
            float mrun[2] = {-INFINITY, -INFINITY}, lrun[2] = {0.f, 0.f};
            const int klo = q0 - LEFT_CHUNKS * CHUNK < 0 ? 0 : q0 - LEFT_CHUNKS * CHUNK, khi = q0 + 64;
            const float cfar = tbl[wid * 260 + 256];
            bf16x8 kc[4], kn[4], vf[2][2]; load_k(kc, kp, klo);
            for (int k0 = klo; k0 < khi; k0 += 32) {
                load_v(vf, vp, k0);
                load_k(kn, kp, k0 + 32 < khi ? k0 + 32 : k0);
#pragma unroll
                for (int qt = 0; qt < 2; ++qt) {
                    bf16x8 pf[2];
                    f32x16 st;
#pragma unroll
                    for (int i = 0; i < 16; ++i) st[i] = 0.f;
#pragma unroll
                    for (int kk = 0; kk < 4; ++kk) st = MFMA32(kc[kk], qf[qt][kk], st);
                    const int dmin = q0 + 32 * qt - k0 - 31;
                    float boff = 0.f;
                    if (dmin >= MAX_REL) boff = cfar;
                    else {
                        const int bidx = q0 + 32 * qt + r - k0 - 4 * h + MAX_REL;
#pragma unroll
                        for (int i = 0; i < 16; ++i) { int ix = bidx - ((i & 3) + 8 * (i >> 2)); ix = ix < 0 ? 0 : (ix > 2 * MAX_REL ? 2 * MAX_REL : ix); st[i] += tbl[wid * 260 + ix]; }
                    }
                    float mx = st[0];
#pragma unroll
                    for (int i = 1; i < 16; ++i) mx = fmaxf(mx, st[i]);
                    mx = fmaxf(mx, __shfl_xor(mx, 32)) + boff;
                    const float mo = mrun[qt], mn = fmaxf(mo, mx);
                    mrun[qt] = mn;
                    const float eo = boff - mn;
                    float ps = 0.f;
#pragma unroll
                    for (int i = 0; i < 16; ++i) { st[i] = __builtin_amdgcn_exp2f(st[i] + eo); ps += st[i]; }
                    if (__all(mn == mo)) lrun[qt] += ps;
                    else {
                        const float alpha = __builtin_amdgcn_exp2f(mo - mn);
                        lrun[qt] = lrun[qt] * alpha + ps;
#pragma unroll
                        for (int i = 0; i < 16; ++i) { ot[0][qt][i] *= alpha; ot[1][qt][i] *= alpha; }
                    }
                    pf[0] = pack8(st, 0); pf[1] = pack8(st, 1);
#pragma unroll
                    for (int dt = 0; dt < 2; ++dt)
#pragma unroll
                        for (int s = 0; s < 2; ++s) ot[dt][qt] = MFMA32(vf[dt][s], pf[s], ot[dt][qt]);
                }
#pragma unroll
                for (int kk = 0; kk < 4; ++kk) kc[kk] = kn[kk];
            }
#pragma unroll
            for (int qt = 0; qt < 2; ++qt) { const float lt = lrun[qt] + __shfl_xor(lrun[qt], 32); linv[qt] = 1.f / lt; }
        } else {
            float carry[2] = {1.f, 1.f};
            bf16x8 kc[4], kn[4], vf[2][2]; load_k(kc, kp, q0 + 32);
            for (int k0 = q0 + 32; k0 >= 0; k0 -= 32) {
                load_v(vf, vp, k0);
                load_k(kn, kp, k0 >= 32 ? k0 - 32 : k0);
#pragma unroll
                for (int qt = 0; qt < 2; ++qt) {
                    bf16x8 pf[2];
                    f32x16 st;
#pragma unroll
                    for (int i = 0; i < 16; ++i) st[i] = 0.f;
                    const bool none = (k0 > q0 + 32 * qt + 30);
                    if (!none) {
#pragma unroll
                        for (int kk = 0; kk < 4; ++kk) st = MFMA32(kc[kk], qf[qt][kk], st);
                        const bool full = (k0 + 31 < q0 + 32 * qt);
                        const int lim = q0 + 32 * qt + r - k0 - 4 * h;
                        float om[16];
#pragma unroll
                        for (int i = 0; i < 16; ++i) {
                            const float e = __builtin_amdgcn_exp2f(-st[i]); float bta = __builtin_amdgcn_rcpf(1.f + e);
                            if (!full && !(((i & 3) + 8 * (i >> 2)) < lim)) bta = 0.f;
                            st[i] = bta; om[i] = 1.f - bta;
                        }
                        float G[4], Go[4];
#pragma unroll
                        for (int g = 0; g < 4; ++g) { G[g] = (om[4 * g] * om[4 * g + 1]) * (om[4 * g + 2] * om[4 * g + 3]); Go[g] = __shfl_xor(G[g], 32); }
                        float R = carry[qt];
#pragma unroll
                        for (int g = 3; g >= 0; --g) {
                            float run = h == 0 ? R * Go[g] : R;
#pragma unroll
                            for (int uu2 = 3; uu2 >= 0; --uu2) { const float bta = st[4 * g + uu2]; st[4 * g + uu2] = bta * run; run *= om[4 * g + uu2]; }
                            R = R * (G[g] * Go[g]);
                        }
                        carry[qt] = R;
                    }
                    if (!none) {
                        pf[0] = pack8(st, 0); pf[1] = pack8(st, 1);
#pragma unroll
                        for (int dt = 0; dt < 2; ++dt)
#pragma unroll
                            for (int s = 0; s < 2; ++s) ot[dt][qt] = MFMA32(vf[dt][s], pf[s], ot[dt][qt]);
                    }
                }
#pragma unroll
                for (int kk = 0; kk < 4; ++kk) kc[kk] = kn[kk];
                if (__all(carry[0] < SB_EXIT_THR && carry[1] < SB_EXIT_THR)) break;
            }
        }
        float ss[2];
#pragma unroll
        for (int qt = 0; qt < 2; ++qt) {
            float s2 = 0.f;
#pragma unroll
            for (int dt = 0; dt < 2; ++dt)
#pragma unroll
                for (int i = 0; i < 16; ++i) { ot[dt][qt][i] *= linv[qt]; s2 += ot[dt][qt][i] * ot[dt][qt][i]; }
            s2 += __shfl_xor(s2, 32); ss[qt] = s2;
        }
        __syncthreads();
        if (h == 0) { ssq[wid * 64 + r] = ss[0]; ssq[wid * 64 + 32 + r] = ss[1]; }
        __syncthreads();
        const float* gain = isB ? a.gain_b : a.gain_a;
#pragma unroll
        for (int qt = 0; qt < 2; ++qt) {
            float tot = 0.f;
#pragma unroll
            for (int w8 = 0; w8 < 8; ++w8) tot += ssq[w8 * 64 + 32 * qt + r];
            const float rs = rsqrtf(tot * (1.f / 512.f) + RMS_EPS);
            char* yst = lds + LDS_CVT + wid * (64 * 136);
#pragma unroll
            for (int dt = 0; dt < 2; ++dt)
#pragma unroll
                for (int g = 0; g < 4; ++g) {
                    const int d = 32 * dt + 8 * g + 4 * h; const f32x4 gn = *(const f32x4*)(gain + wid * 64 + d);
                    u32x2 o; o.x = cvt_pk_bf16(ot[dt][qt][4 * g] * rs * gn[0], ot[dt][qt][4 * g + 1] * rs * gn[1]); o.y = cvt_pk_bf16(ot[dt][qt][4 * g + 2] * rs * gn[2], ot[dt][qt][4 * g + 3] * rs * gn[3]);
                    *(u32x2*)(yst + (32 * qt + r) * 136 + d * 2) = o;
                }
        }
        {
            char* yst = lds + LDS_CVT + wid * (64 * 136);
            bf16_t* yb = a.y + (size_t)(b * SEQ + q0) * D_MODEL + (isB ? 512 : 0) + wid * 64;
#pragma unroll
            for (int j = 0; j < 8; ++j) {
                const int tok = (lane >> 3) + 8 * j, ch = lane & 7;
                const u32x2 lo = *(const u32x2*)(yst + tok * 136 + ch * 16), hi = *(const u32x2*)(yst + tok * 136 + ch * 16 + 8);
                *(u32x4*)(yb + (size_t)tok * D_MODEL + ch * 8) = (u32x4){lo.x, lo.y, hi.x, hi.y};
            }
        }
    }
}


#define XB_TMO      128
#define XB_XCNT(j)  (256  + 64 * (j))
#define XB_XSUB(j)  (1280 + 64 * (j))
#define XB_XGEN(j)  (2304 + 64 * (j))
#define XB_TOP      3328
#define XB_TOPGEN   3392
#define XCD_BAR_WORDS 3456
#define XB_SPIN_CAP (1u << 18)
#define LAS __attribute__((address_space(3)))

__device__ __forceinline__ unsigned xb_ld(unsigned* p)              { return __hip_atomic_load(p, __ATOMIC_RELAXED, __HIP_MEMORY_SCOPE_AGENT); }
__device__ __forceinline__ unsigned xb_add(unsigned* p, unsigned v) { return __hip_atomic_fetch_add(p, v, __ATOMIC_RELAXED, __HIP_MEMORY_SCOPE_AGENT); }
__device__ __forceinline__ unsigned xb_xcc_id() { return (unsigned)__builtin_amdgcn_s_getreg((3 << 11) | 20) & 0xFu; }
#define XB_SPIN(cond, bar) do { unsigned _sp = 0; while (cond) { __builtin_amdgcn_s_sleep(1); \
    if ((++_sp & 255u) == 0u) { if (xb_ld(&(bar)[XB_TMO])) break; if (_sp > XB_SPIN_CAP) { atomicAdd(&(bar)[XB_TMO], 1u); break; } } } } while (0)

struct XcdBarrier {
    unsigned* bar; unsigned x;
    volatile LAS unsigned* st;
};

__device__ __forceinline__ XcdBarrier xcd_barrier_post(unsigned* bar, volatile LAS unsigned* st) {
    XcdBarrier b; b.bar = bar; b.x = xb_xcc_id(); b.st = st;
    if (threadIdx.x == 0) (void)xb_add(&bar[XB_XCNT(b.x)], 1u);
    return b;
}
__device__ __forceinline__ void xcd_barrier_complete(unsigned* bar, unsigned x, unsigned& nloc, unsigned& nx) {
    const unsigned G = gridDim.x * gridDim.y * gridDim.z;
    unsigned sum, cnt, mine, sp = 0u;
    for (;;) {
        sum = 0u; cnt = 0u; mine = 0u;
#pragma unroll
        for (unsigned j = 0; j < 16; ++j) { const unsigned c = xb_ld(&bar[XB_XCNT(j)]); sum += c; cnt += (c > 0u) ? 1u : 0u; mine = (j == x) ? c : mine; }
        if (sum == G) break;
        __builtin_amdgcn_s_sleep(1);
        if ((++sp & 255u) == 0u) { if (xb_ld(&bar[XB_TMO])) break; if (sp > XB_SPIN_CAP) { atomicAdd(&bar[XB_TMO], 1u); break; } }
    }
    nloc = mine > 0u ? mine : 1u; nx = cnt > 0u ? cnt : 1u;
}

__device__ __forceinline__ void xcd_barrier(const XcdBarrier& b) {
    asm volatile("s_waitcnt vmcnt(0)" ::: "memory");
    __syncthreads();
    if (threadIdx.x == 0) {
        unsigned* bar = b.bar;
        __builtin_amdgcn_s_waitcnt(0);
        unsigned nloc = b.st[0], nx = b.st[1];
        if (nloc == 0u) { xcd_barrier_complete(bar, b.x, nloc, nx); b.st[0] = nloc; b.st[1] = nx; }
        const unsigned old = xb_add(&bar[XB_XSUB(b.x)], 1u);
        const unsigned gen = old / nloc;
        if (old + 1u == (gen + 1u) * nloc) {
            __builtin_amdgcn_fence(__ATOMIC_RELEASE, "agent");
            asm volatile("s_waitcnt vmcnt(0)" ::: "memory");
            const unsigned og = xb_add(&bar[XB_TOP], 1u);
            const unsigned tg = og / nx;
            if (og + 1u == (tg + 1u) * nx) xb_add(&bar[XB_TOPGEN], 1u);
            else XB_SPIN(xb_ld(&bar[XB_TOPGEN]) == tg, bar);
            __builtin_amdgcn_fence(__ATOMIC_ACQUIRE, "agent");
            xb_add(&bar[XB_XGEN(b.x)], 1u);
            asm volatile("s_waitcnt vmcnt(0)" ::: "memory");
        } else {
            XB_SPIN(xb_ld(&bar[XB_XGEN(b.x)]) == gen, bar);
            __builtin_amdgcn_fence(__ATOMIC_ACQUIRE, "agent");
            asm volatile("s_waitcnt vmcnt(0)" ::: "memory");
        }
    }
    __syncthreads();
}


struct MegaArgs { P0Args p0; P1Args p1; P2Args p2; P3Args p3; P4Args p4; P6Args p6; P7Args p7; P8Args p8; unsigned* bar; };
__global__ __launch_bounds__(NTHR, 2) void k_mega(MegaArgs a) {
    extern __shared__ __attribute__((aligned(16))) char smem[];
    asm volatile("s_setreg_imm32_b32 hwreg(HW_REG_MODE, 23, 1), 1");
    volatile LAS unsigned* xbw = (volatile LAS unsigned*)(smem + LDS_BYTES - 16);
    if (threadIdx.x == 0) { xbw[0] = 0u; xbw[1] = 0u; xbw[2] = 0u; xbw[3] = 0u; }
    __syncthreads();
    XcdBarrier bar = xcd_barrier_post(a.bar, xbw);
    LAS unsigned char* L = (LAS unsigned char*)smem;
    phase_prologue(a.p0, smem);     xcd_barrier(bar);
    phase_qkv(a.p1, L);             xcd_barrier(bar);
    phase_attn(a.p2, a.p0, smem);   xcd_barrier(bar);
    phase_outproj(a.p3, L);         xcd_barrier(bar);
    phase_router(a.p4, a.p0, smem); xcd_barrier(bar);
    phase_moe_gu(a.p6, smem, L);    xcd_barrier(bar);
    phase_moe_down(a.p7, smem, L);  xcd_barrier(bar);
    phase_combine(a.p8, smem);
}

extern "C" void kernel_launch(void* const* d_in, const int* in_sizes, int n_in, void* d_out, int out_size, void* d_ws, size_t ws_size, hipStream_t stream) {
    const float* x = (const float*)d_in[0];      const float* w_in = (const float*)d_in[1];   const float* rel_bias = (const float*)d_in[2];
    const float* gain_a = (const float*)d_in[3]; const float* gain_b = (const float*)d_in[4]; const float* w_out = (const float*)d_in[5];
    const float* ln1_g = (const float*)d_in[6];  const float* ln1_b = (const float*)d_in[7];  const float* router_w = (const float*)d_in[8];
    const float* router_bias = (const float*)d_in[9]; const float* w_gate = (const float*)d_in[10]; const float* w_up = (const float*)d_in[11];
    const float* w_down = (const float*)d_in[12]; const float* ws_gate = (const float*)d_in[13]; const float* ws_up = (const float*)d_in[14];
    const float* ws_down = (const float*)d_in[15]; const float* ln2_g = (const float*)d_in[16]; const float* ln2_b = (const float*)d_in[17];
    char* ws = (char*)d_ws; float* out = (float*)d_out;
    int* ctrl = (int*)(ws + OFF_CTRL); int* counts = ctrl + CW_COUNTS;
    bf16_t* X1 = (bf16_t*)(ws + OFF_X1); int* tokl = (int*)(ws + OFF_TOKL); float* gatel = (float*)(ws + OFF_GATEL);
    int* eidx = (int*)(ws + OFF_EIDX); float* gate = (float*)(ws + OFF_GATE); int* slot = (int*)(ws + OFF_SLOT);
    unsigned char* H = (unsigned char*)(ws + OFF_H); unsigned char* Y = (unsigned char*)(ws + OFF_Y); unsigned char* x1f8 = (unsigned char*)(ws + OFF_X1F8);
    bf16_t* Q = (bf16_t*)(ws + OFF_Q); bf16_t* Kb = (bf16_t*)(ws + OFF_K); bf16_t* Vt = (bf16_t*)(ws + OFF_VT);
    bf16_t* yatt = (bf16_t*)(ws + OFF_YATT); bf16_t* r = (bf16_t*)(ws + OFF_R);
    bf16_t* xb = (bf16_t*)(ws + OFF_XB);
    bf16_t* wt_in = (bf16_t*)(ws + OFF_WTIN); bf16_t* wt_out = (bf16_t*)(ws + OFF_WTOUT); bf16_t* wt_r = (bf16_t*)(ws + OFF_WTR);
    unsigned char* wgut = (unsigned char*)(ws + OFF_WGUT); unsigned char* wdt = (unsigned char*)(ws + OFF_WDT);
    if (ws_size < WS_NEEDED) { fprintf(stderr, "kernel_launch: workspace too small (%zu < %zu)\n", ws_size, (size_t)WS_NEEDED); return; }
    hipMemsetAsync(ctrl, 0, 128 * 1024, stream);
    static bool attr_done = false;
    if (!attr_done) {
        hipFuncSetAttribute((const void*)k_mega, hipFuncAttributeMaxDynamicSharedMemorySize, LDS_BYTES);
        attr_done = true;
    }
    MegaArgs m{};
    m.p0 = P0Args{x, w_in, w_out, router_w, xb, wt_in, wt_out, wt_r, w_gate, w_up, w_down, ws_gate, ws_up, ws_down, wgut, wdt};
    m.p1 = P1Args{xb, wt_in, Q, Kb, Vt};
    m.p2 = P2Args{Q, Kb, Vt, rel_bias, gain_a, gain_b, yatt};
    m.p3 = P3Args{yatt, wt_out, r};
    m.p4 = P4Args{r, xb, ln1_g, ln1_b, X1, x1f8, wt_r, router_bias, eidx, gate, counts, tokl, gatel, slot};
    m.p6 = P6Args{x1f8, counts, tokl, gatel, wgut, H};
    m.p7 = P7Args{H, counts, wdt, Y};
    m.p8 = P8Args{X1, Y, slot, counts, ln2_g, ln2_b, out};
    m.bar = (unsigned*)ctrl;
    k_mega<<<GRID, NTHR, LDS_BYTES, stream>>>(m);
}
```
